# Optimizing an MI355X kernel written in HIP

```python
import math
import jax, jax.numpy as jnp
from jax import lax
import numpy as np

D_MODEL = 1024
BATCH = 2
SEQ = 16384
DEPTH = 2

GRID_W = 64
CTX_LEN = 256

DA_HEADS = 4
DA_QK_DIM = 64
DA_V_DIM = 2 * DA_QK_DIM
ML_HEADS = 4
ML_DIM = 128
ML_CHUNK = 128
ML_CONV = 3
FN_GROUPS = 4
FN_GROUP_DIM = D_MODEL // FN_GROUPS
N_EXPERTS = 16
N_EXPERT_GROUPS = 4
EXPERTS_PER_GROUP = N_EXPERTS // N_EXPERT_GROUPS
TOP_K = 2
D_EXPERT = 512
ROPE_BASE = 10000.0
Q_BLOCK = 128
NORM_EPS = 1e-6
N_EVEN = (DEPTH + 1) // 2
N_ODD = DEPTH // 2

DA_QK_W = DA_HEADS * 2 * DA_QK_DIM
DA_V_W = DA_HEADS * DA_V_DIM
ML_W = ML_HEADS * ML_DIM
ML_GATE_W = 4 * ML_HEADS
IN_SPLITS = [DA_QK_W, 2 * DA_QK_W, 2 * DA_QK_W + DA_V_W, 2 * DA_QK_W + DA_V_W + 2 * ML_W,
             2 * DA_QK_W + DA_V_W + 3 * ML_W, 2 * DA_QK_W + DA_V_W + 4 * ML_W]
IN_COLS = 2 * DA_QK_W + DA_V_W + 4 * ML_W + ML_GATE_W
MIX_W = DA_V_W + ML_W

kernel_name = "hybrid_diffattn_mlstm_fnet_groupmoe_prefix"


def rmsnorm(x, g):
    xf = x.astype(jnp.float32)
    y = xf * lax.rsqrt(jnp.mean(xf * xf, axis=-1, keepdims=True) + NORM_EPS)
    return (y * g.astype(jnp.float32)).astype(x.dtype)


def modulate(h, shift, scale):
    return h * (1 + scale) + shift


def tokens_to_heads(a, n_heads):
    b, t, w = a.shape
    return a.reshape(b, t, n_heads, w // n_heads).transpose(0, 2, 1, 3)


def heads_to_tokens(a):
    b, h, t, d = a.shape
    return a.transpose(0, 2, 1, 3).reshape(b, t, h * d)


def axial_rope_tables(row, col):
    n_pairs_axis = DA_QK_DIM // 4
    inv = ROPE_BASE ** (-jnp.arange(n_pairs_axis, dtype=jnp.float32) / n_pairs_axis)
    ang = jnp.concatenate([row.astype(jnp.float32)[:, None] * inv,
                           col.astype(jnp.float32)[:, None] * inv], axis=-1)
    return jnp.cos(ang), jnp.sin(ang)


def apply_rope(x, cos, sin):
    xp = x.reshape(*x.shape[:-1], -1, 2)
    x0, x1 = xp[..., 0], xp[..., 1]
    cs, sn = cos.astype(x.dtype), sin.astype(x.dtype)
    return jnp.stack([x0 * cs - x1 * sn, x0 * sn + x1 * cs], axis=-1).reshape(x.shape)


def centred_dwconv(x, w):
    k = w.shape[0]
    p = k // 2
    t = x.shape[1]
    xp = jnp.pad(x, ((0, 0), (p, p), (0, 0)))
    out = xp[:, 0:t] * w[0]
    for j in range(1, k):
        out = out + xp[:, j:j + t] * w[j]
    return out


def split_projection(u, conv_w, gate_b):
    b, t, _ = u.shape
    da_q, da_k, da_v, ml_qk, ml_v, ml_o, gates = jnp.split(u, IN_SPLITS, axis=-1)
    dq = da_q.reshape(b, t, DA_HEADS, 2, DA_QK_DIM).transpose(3, 0, 2, 1, 4)
    dk = da_k.reshape(b, t, DA_HEADS, 2, DA_QK_DIM).transpose(3, 0, 2, 1, 4)
    dv = tokens_to_heads(da_v, DA_HEADS)
    qk = jax.nn.silu(centred_dwconv(ml_qk, conv_w))
    mq, mk = jnp.split(qk, 2, axis=-1)
    mq = tokens_to_heads(mq, ML_HEADS)
    mk = tokens_to_heads(mk, ML_HEADS) * (ML_DIM ** -0.5)
    mv = tokens_to_heads(ml_v, ML_HEADS)
    og = jax.nn.sigmoid(ml_o)
    g = (gates.astype(jnp.float32).reshape(b, t, 4, ML_HEADS)
         + gate_b.astype(jnp.float32)).transpose(2, 0, 3, 1)
    g = jnp.stack([g[0], jax.nn.log_sigmoid(g[1]), g[2], jax.nn.log_sigmoid(g[3])])
    return dq, dk, dv, mq, mk, mv, og, g


def diff_attn_block(q, k, v, lam):
    s = jnp.einsum("mbhqd,mbhkd->mbhqk", q, k).astype(jnp.float32) * (DA_QK_DIM ** -0.5)
    p = jax.nn.softmax(s, axis=-1)
    w = p[0] - lam * p[1]
    return jnp.einsum("bhqk,bhkd->bhqd", w.astype(v.dtype), v)


def diff_attention(q_c, k_c, v_c, q_l, k_l, v_l, lam, subln_g, lam_init, need_ctx):
    k_all = jnp.concatenate([k_c, k_l], axis=3)
    v_all = jnp.concatenate([v_c, v_l], axis=2)
    _, b, h, s, dq = q_l.shape
    nb = s // Q_BLOCK
    q_blocks = jnp.moveaxis(q_l.reshape(2, b, h, nb, Q_BLOCK, dq), 3, 0)
    o_blocks = lax.map(lambda qb: diff_attn_block(qb, k_all, v_all, lam), q_blocks)
    o_l = jnp.moveaxis(o_blocks, 0, 2).reshape(b, h, s, DA_V_DIM)
    o_l = rmsnorm(o_l, subln_g) * (1.0 - lam_init)
    o_c = None
    if need_ctx:
        o_c = rmsnorm(diff_attn_block(q_c, k_c, v_c, lam), subln_g) * (1.0 - lam_init)
    return o_c, o_l


def mlstm_chunkwise(q, k, v, log_i, log_f, state, with_output):
    b, h, t, d = q.shape
    nc = t // ML_CHUNK
    lc = ML_CHUNK

    def to_chunks(a):
        a = a.astype(jnp.float32)
        return jnp.moveaxis(a.reshape(b, h, nc, lc, *a.shape[3:]), 2, 0)

    xs = (to_chunks(q), to_chunks(k), to_chunks(v), to_chunks(log_i), to_chunks(log_f))
    causal = jnp.tril(jnp.ones((lc, lc), dtype=bool))

    def step(carry, inp):
        c_st, n_st, m_st = carry
        qc, kc, vc, lic, lfc = inp
        bcum = jnp.cumsum(lfc, axis=-1)
        b_last = bcum[..., -1]
        logw = b_last[..., None] - bcum + lic
        m_new = jnp.maximum(b_last + m_st, jnp.max(logw, axis=-1))
        wgt = jnp.exp(logw - m_new[..., None])
        decay = jnp.exp(b_last + m_st - m_new)
        c_new = decay[..., None, None] * c_st + jnp.einsum("bhl,bhlv,bhlk->bhvk", wgt, vc, kc)
        n_new = decay[..., None] * n_st + jnp.einsum("bhl,bhlk->bhk", wgt, kc)
        if not with_output:
            return (c_new, n_new, m_new), None
        log_d = bcum[..., :, None] - bcum[..., None, :] + lic[..., None, :]
        log_d = jnp.where(causal, log_d, -jnp.inf)
        m_inter = bcum + m_st[..., None]
        m_t = jnp.maximum(m_inter, jnp.max(log_d, axis=-1))
        dmat = jnp.exp(log_d - m_t[..., None])
        inter = jnp.exp(m_inter - m_t)
        sc = jnp.einsum("bhqd,bhkd->bhqk", qc, kc) * dmat
        num = (inter[..., None] * jnp.einsum("bhvk,bhqk->bhqv", c_st, qc)
               + jnp.einsum("bhqk,bhkv->bhqv", sc, vc))
        nq = inter * jnp.einsum("bhk,bhqk->bhq", n_st, qc) + jnp.sum(sc, axis=-1)
        den = jnp.maximum(jnp.abs(nq), jnp.exp(-m_t))
        return (c_new, n_new, m_new), num / den[..., None]

    final, hs = lax.scan(step, state, xs)
    if not with_output:
        return final, None
    out = jnp.moveaxis(hs, 0, 2).reshape(b, h, t, d).astype(q.dtype)
    return final, out


def mlstm_bidir(ctx_in, lat_in, need_ctx):
    q_c, k_c, v_c, g_c = ctx_in
    q_l, k_l, v_l, g_l = lat_in
    b, h, _, d = q_c.shape
    init = (jnp.zeros((b, h, d, d), jnp.float32), jnp.zeros((b, h, d), jnp.float32),
            jnp.zeros((b, h), jnp.float32))
    fl = lambda a: jnp.flip(a, axis=2)
    st_fc, h_fc = mlstm_chunkwise(q_c, k_c, v_c, g_c[0], g_c[1], init, need_ctx)
    _, h_fl = mlstm_chunkwise(q_l, k_l, v_l, g_l[0], g_l[1], st_fc, True)
    st_bc, h_bc = mlstm_chunkwise(fl(q_c), fl(k_c), fl(v_c), fl(g_c[2]), fl(g_c[3]), init, need_ctx)
    _, h_bl = mlstm_chunkwise(fl(q_l), fl(k_l), fl(v_l), fl(g_l[2]), fl(g_l[3]), st_bc, True)
    h_l = h_fl + fl(h_bl)
    h_c = h_fc + fl(h_bc) if need_ctx else None
    return h_c, h_l


def merge_groups(a, m, og):
    return jnp.concatenate([heads_to_tokens(a), heads_to_tokens(m) * og], axis=-1)


def even_mixer(h_c, h_l, w_in, w_out, conv_w, gate_b, lam_vec, subln_g, lam_init, cos, sin, need_ctx):
    dq_c, dk_c, dv_c, mq_c, mk_c, mv_c, og_c, g_c = split_projection(h_c @ w_in, conv_w, gate_b)
    dq_l, dk_l, dv_l, mq_l, mk_l, mv_l, og_l, g_l = split_projection(h_l @ w_in, conv_w, gate_b)
    dq_l = apply_rope(dq_l, cos, sin)
    dk_l = apply_rope(dk_l, cos, sin)
    lv = lam_vec.astype(jnp.float32)
    lam = jnp.exp(jnp.sum(lv[0] * lv[1])) - jnp.exp(jnp.sum(lv[2] * lv[3])) + lam_init
    a_c, a_l = diff_attention(dq_c, dk_c, dv_c, dq_l, dk_l, dv_l, lam, subln_g, lam_init, need_ctx)
    m_c, m_l = mlstm_bidir((mq_c, mk_c, mv_c, g_c), (mq_l, mk_l, mv_l, g_l), need_ctx)
    out_l = merge_groups(a_l, m_l, og_l) @ w_out
    out_c = merge_groups(a_c, m_c, og_c) @ w_out if need_ctx else None
    return out_c, out_l


def fourier_mix(h, w_fnet):
    b, t, d = h.shape
    hg = h.astype(jnp.float32).reshape(b, t, FN_GROUPS, FN_GROUP_DIM)
    f = jnp.fft.fft2(hg, axes=(1, 3), norm="ortho").real
    return f.reshape(b, t, d).astype(h.dtype) @ w_fnet


def grouped_moe(h, router_w, router_b, w_gate, w_up, w_down):
    aff = jax.nn.sigmoid((h @ router_w).astype(jnp.float32))
    biased = aff + router_b.astype(jnp.float32)
    grp = biased.reshape(*biased.shape[:-1], N_EXPERT_GROUPS, EXPERTS_PER_GROUP)
    grp_score = jnp.sum(lax.top_k(grp, TOP_K)[0], axis=-1)
    sel_group = jnp.argmax(grp_score, axis=-1)
    in_group = (jnp.arange(N_EXPERTS) // EXPERTS_PER_GROUP) == sel_group[..., None]
    _, idx = lax.top_k(jnp.where(in_group, biased, -jnp.inf), TOP_K)
    sel_aff = jnp.take_along_axis(aff, idx, axis=-1)
    wts = sel_aff / jnp.sum(sel_aff, axis=-1, keepdims=True)
    combine = jnp.sum(jax.nn.one_hot(idx, N_EXPERTS, dtype=jnp.float32) * wts[..., None], axis=-2)
    combine = combine.astype(h.dtype)
    y = jnp.zeros_like(h)
    for e in range(N_EXPERTS):
        he = jax.nn.silu(h @ w_gate[e]) * (h @ w_up[e])
        y = y + combine[..., e:e + 1] * (he @ w_down[e])
    return y


def setup_inputs(seed: int = 0) -> dict:
    key = jax.random.key(seed)
    ks = jax.random.split(key, 21)
    nrm = lambda k, shape, s: jax.random.normal(k, shape, jnp.float32) * s
    d = D_MODEL
    gate_base = jnp.array([0.0, 3.0, 0.0, 3.0], jnp.float32)[None, :, None]
    return {
        "x": nrm(ks[0], (BATCH, SEQ, d), 1.0),
        "c": nrm(ks[1], (BATCH, d), 1.0),
        "ctx": nrm(ks[2], (BATCH, CTX_LEN, d), 1.0),
        "c_ctx": nrm(ks[3], (d,), 1.0),
        "ada_w": nrm(ks[4], (DEPTH, d, 6 * d), 0.5 * d ** -0.5),
        "ada_b": nrm(ks[5], (DEPTH, 6 * d), 0.02),
        "norm_mix_g": 1.0 + nrm(ks[6], (DEPTH, d), 0.02),
        "norm_ffn_g": 1.0 + nrm(ks[7], (DEPTH, d), 0.02),
        "even_w_in": nrm(ks[8], (N_EVEN, d, IN_COLS), d ** -0.5),
        "even_w_out": nrm(ks[9], (N_EVEN, MIX_W, d), MIX_W ** -0.5),
        "even_conv_w": nrm(ks[10], (N_EVEN, ML_CONV, 2 * ML_W), ML_CONV ** -0.5),
        "even_gate_b": gate_base + nrm(ks[11], (N_EVEN, 4, ML_HEADS), 0.1),
        "even_lam": nrm(ks[12], (N_EVEN, 4, DA_QK_DIM), 0.1),
        "even_subln_g": 1.0 + nrm(ks[13], (N_EVEN, DA_V_DIM), 0.02),
        "odd_w_fnet": nrm(ks[14], (N_ODD, d, d), d ** -0.5),
        "router_w": nrm(ks[15], (d, N_EXPERTS), d ** -0.5),
        "router_b": nrm(ks[16], (N_EXPERTS,), 0.01),
        "exp_w_gate": nrm(ks[17], (DEPTH, N_EXPERTS, d, D_EXPERT), d ** -0.5),
        "exp_w_up": nrm(ks[18], (DEPTH, N_EXPERTS, d, D_EXPERT), d ** -0.5),
        "exp_w_down": nrm(ks[19], (DEPTH, N_EXPERTS, D_EXPERT, d), D_EXPERT ** -0.5),
        "final_g": 1.0 + nrm(ks[20], (d,), 0.02),
    }


def reference(x, c, ctx, c_ctx, ada_w, ada_b, norm_mix_g, norm_ffn_g, even_w_in, even_w_out,
              even_conv_w, even_gate_b, even_lam, even_subln_g, odd_w_fnet, router_w, router_b,
              exp_w_gate, exp_w_up, exp_w_down, final_g):
    n_lat = x.shape[1]
    rows = n_lat // GRID_W
    row = jnp.repeat(jnp.arange(rows, dtype=jnp.int32), GRID_W)
    col = jnp.tile(jnp.arange(GRID_W, dtype=jnp.int32), rows)
    cos, sin = axial_rope_tables(row, col)
    s_c = jax.nn.silu(c)
    s_cc = jax.nn.silu(c_ctx)
    x_l, x_c = x, ctx
    for i in range(DEPTH):
        last = i == DEPTH - 1
        even = i % 2 == 0
        ctx_out = not last
        ctx_in = ctx_out or even
        j = i // 2
        mod_l = jnp.split((s_c @ ada_w[i] + ada_b[i])[:, None, :], 6, axis=-1)
        h_l = modulate(rmsnorm(x_l, norm_mix_g[i]), mod_l[0], mod_l[1])
        h_c = None
        mod_c = None
        if ctx_in:
            mod_c = jnp.split(s_cc @ ada_w[i] + ada_b[i], 6, axis=-1)
            h_c = modulate(rmsnorm(x_c, norm_mix_g[i]), mod_c[0], mod_c[1])
        if even:
            lam_init = 0.8 - 0.6 * math.exp(-0.3 * i)
            o_c, o_l = even_mixer(h_c, h_l, even_w_in[j], even_w_out[j], even_conv_w[j],
                                  even_gate_b[j], even_lam[j], even_subln_g[j], lam_init,
                                  cos, sin, ctx_out)
        else:
            o_l = fourier_mix(h_l, odd_w_fnet[j])
            o_c = fourier_mix(h_c, odd_w_fnet[j]) if ctx_out else None
        x_l = x_l + mod_l[2] * o_l
        f_l = modulate(rmsnorm(x_l, norm_ffn_g[i]), mod_l[3], mod_l[4])
        if ctx_out:
            x_c = x_c + mod_c[2] * o_c
            f_c = modulate(rmsnorm(x_c, norm_ffn_g[i]), mod_c[3], mod_c[4])
            n_ctx = x_c.shape[1]
            y = grouped_moe(jnp.concatenate([f_c, f_l], axis=1), router_w, router_b,
                            exp_w_gate[i], exp_w_up[i], exp_w_down[i])
            x_c = x_c + mod_c[5] * y[:, :n_ctx]
            y_l = y[:, n_ctx:]
        else:
            y_l = grouped_moe(f_l, router_w, router_b, exp_w_gate[i], exp_w_up[i], exp_w_down[i])
        x_l = x_l + mod_l[5] * y_l
    return rmsnorm(x_l, final_g)
```

```cpp
#include <hip/hip_runtime.h>
#include <stdint.h>
#include <stdio.h>

#define DEVI __device__ __forceinline__
typedef unsigned short u16;
typedef unsigned int u32;
using bf16x8 = __attribute__((ext_vector_type(8))) short;
using s16x4  = __attribute__((ext_vector_type(4))) short;
using f32x16 = __attribute__((ext_vector_type(16))) float;
using f32x4  = __attribute__((ext_vector_type(4))) float;
using u32x4  = __attribute__((ext_vector_type(4))) unsigned;
using u32x2  = __attribute__((ext_vector_type(2))) unsigned;

constexpr int DM = 1024, NB = 2, TL = 16384, TC = 256, TT = TL + TC, NTOK = NB * TT, NLAT = NB * TL;
constexpr int NCH = TT / 128;
constexpr int NTHR = 512;
constexpr int LDS_BYTES = 147456;

constexpr size_t al256(size_t x) { return (x + 255) / 256 * 256; }
constexpr size_t OFF_BAR   = 0;
constexpr size_t OFF_CNT   = 16384;
constexpr size_t ZERO_BYTES = 20480;
constexpr size_t OFF_MOD   = ZERO_BYTES;
constexpr size_t OFF_ROPER = OFF_MOD + al256(2 * 3 * 6144 * 4);
constexpr size_t OFF_ROPEC = OFF_ROPER + 256 * 16 * 8;
constexpr size_t OFF_TW    = OFF_ROPEC + 64 * 16 * 8;
constexpr size_t OFF_DFTC  = OFF_TW + 16384 * 8;
constexpr size_t OFF_DFTS  = OFF_DFTC + 32768;
constexpr size_t OFF_LAM   = OFF_DFTS + 32768;
constexpr size_t OFF_WG16  = OFF_LAM + 256;
constexpr size_t OFF_MSCAL = OFF_WG16 + 65536;
constexpr size_t OFF_MST   = OFF_MSCAL + al256(16 * NCH * 8);
constexpr size_t OFF_WINT  = OFF_MST + al256(16 * NCH * 4);
constexpr size_t OFF_WOUTT = OFF_WINT + (size_t)3584 * 1024 * 2;
constexpr size_t OFF_FNT   = OFF_WOUTT + (size_t)1024 * 1024 * 2;
constexpr size_t OFF_WGU   = OFF_FNT + (size_t)2048 * 1024 * 2;
constexpr size_t OFF_WDT   = OFF_WGU + (size_t)16 * 1024 * 1024 * 2;
constexpr size_t OFF_ACT   = OFF_WDT + (size_t)16 * 1024 * 512 * 2;
constexpr size_t SZ_ACT    = (size_t)NTOK * 1024 * 2;
constexpr size_t OFF_XC    = OFF_ACT + SZ_ACT;
constexpr size_t OFF_GATES = OFF_XC + (size_t)NB * TC * 1024 * 4;
constexpr size_t OFF_TOKW  = OFF_GATES + (size_t)NTOK * 16 * 4;
constexpr size_t OFF_LIST  = OFF_TOKW + al256((size_t)NTOK * 8);
constexpr size_t OFF_NST   = OFF_LIST + (size_t)24 * NTOK * 4;
constexpr size_t OFF_CST   = OFF_NST + (size_t)16 * NCH * 128 * 4;
constexpr size_t SZ_CST    = (size_t)16 * NCH * 16384 * 2;
constexpr size_t OFF_BIG   = OFF_CST + SZ_CST;
constexpr size_t OFF_Q     = OFF_BIG;
constexpr size_t OFF_K     = OFF_Q + (size_t)NTOK * 512 * 2;
constexpr size_t OFF_V     = OFF_K + (size_t)NTOK * 512 * 2;
constexpr size_t OFF_MLQK  = OFF_V + (size_t)NTOK * 512 * 2;
constexpr size_t OFF_MLV   = OFF_MLQK + (size_t)NTOK * 1024 * 2;
constexpr size_t OFF_OG    = OFF_MLV + (size_t)NTOK * 512 * 2;
constexpr size_t OFF_END   = OFF_OG + (size_t)NTOK * 512 * 2;
constexpr size_t OFF_HE    = OFF_BIG;
constexpr size_t OFF_ZR    = OFF_BIG;
constexpr size_t OFF_ZI    = OFF_ZR + (size_t)NLAT * 1024 * 2;
constexpr size_t OFF_YR    = OFF_CST;
constexpr size_t OFF_YI    = OFF_ACT;
static_assert((size_t)NLAT * 1024 * 2 <= SZ_CST && (size_t)NLAT * 1024 * 2 <= SZ_ACT, "alias sizes");
static_assert(OFF_END < (size_t)500 * 1024 * 1024, "workspace");

struct P {
    const float *x, *c, *ctx, *c_ctx, *ada_w, *ada_b, *nmix_g, *nffn_g, *w_in, *w_out, *conv_w, *gate_b, *lamv, *subln_g,
                *w_fnet, *router_w, *router_b, *w_gate, *w_up, *w_down, *final_g;
    float* out;
    char* ws;
    int ph_lo, ph_hi;
};

#define XB_TMO      128
#define XB_XCNT(j)  (256  + 64 * (j))
#define XB_XSUB(j)  (1280 + 64 * (j))
#define XB_XGEN(j)  (2304 + 64 * (j))
#define XB_TOP      3328
#define XB_TOPGEN   3392
#define XCD_BAR_WORDS 3456
#define XB_SPIN_CAP (1u << 18)
#define LAS __attribute__((address_space(3)))

__device__ __forceinline__ unsigned xb_ld(unsigned* p)              { return __hip_atomic_load(p, __ATOMIC_RELAXED, __HIP_MEMORY_SCOPE_AGENT); }
__device__ __forceinline__ unsigned xb_add(unsigned* p, unsigned v) { return __hip_atomic_fetch_add(p, v, __ATOMIC_RELAXED, __HIP_MEMORY_SCOPE_AGENT); }
__device__ __forceinline__ unsigned xb_xcc_id() { return (unsigned)__builtin_amdgcn_s_getreg((3 << 11) | 20) & 0xFu; }
#define XB_SPIN(cond, bar) do { unsigned _sp = 0; while (cond) { __builtin_amdgcn_s_sleep(1); \
    if ((++_sp & 255u) == 0u) { if (xb_ld(&(bar)[XB_TMO])) break; if (_sp > XB_SPIN_CAP) { atomicAdd(&(bar)[XB_TMO], 1u); break; } } } } while (0)

struct XcdBarrier { unsigned* bar; unsigned x; volatile LAS unsigned* st; };

__device__ __forceinline__ XcdBarrier xcd_barrier_post(unsigned* bar, volatile LAS unsigned* st) {
    XcdBarrier b; b.bar = bar; b.x = xb_xcc_id(); b.st = st;
    if (threadIdx.x == 0) (void)xb_add(&bar[XB_XCNT(b.x)], 1u);
    return b;
}
__device__ __forceinline__ void xcd_barrier_complete(unsigned* bar, unsigned x, unsigned& nloc, unsigned& nx) {
    const unsigned G = gridDim.x * gridDim.y * gridDim.z;
    unsigned sum, cnt, mine, sp = 0u;
    for (;;) {
        sum = 0u; cnt = 0u; mine = 0u;
#pragma unroll
        for (unsigned j = 0; j < 16; ++j) { const unsigned c = xb_ld(&bar[XB_XCNT(j)]); sum += c; cnt += (c > 0u) ? 1u : 0u; mine = (j == x) ? c : mine; }
        if (sum == G) break;
        __builtin_amdgcn_s_sleep(1);
        if ((++sp & 255u) == 0u) { if (xb_ld(&bar[XB_TMO])) break; if (sp > XB_SPIN_CAP) { atomicAdd(&bar[XB_TMO], 1u); break; } }
    }
    nloc = mine > 0u ? mine : 1u; nx = cnt > 0u ? cnt : 1u;
}
__device__ __forceinline__ void xcd_barrier(const XcdBarrier& b) {
    asm volatile("s_waitcnt vmcnt(0)" ::: "memory");
    __syncthreads();
    if (threadIdx.x == 0) {
        unsigned* bar = b.bar;
        __builtin_amdgcn_s_waitcnt(0);
        unsigned nloc = b.st[0], nx = b.st[1];
        if (nloc == 0u) { xcd_barrier_complete(bar, b.x, nloc, nx); b.st[0] = nloc; b.st[1] = nx; }
        const unsigned old = xb_add(&bar[XB_XSUB(b.x)], 1u);
        const unsigned gen = old / nloc;
        if (old + 1u == (gen + 1u) * nloc) {
            __builtin_amdgcn_fence(__ATOMIC_RELEASE, "agent");
            asm volatile("s_waitcnt vmcnt(0)" ::: "memory");
            const unsigned og = xb_add(&bar[XB_TOP], 1u);
            const unsigned tg = og / nx;
            if (og + 1u == (tg + 1u) * nx) xb_add(&bar[XB_TOPGEN], 1u);
            else XB_SPIN(xb_ld(&bar[XB_TOPGEN]) == tg, bar);
            __builtin_amdgcn_fence(__ATOMIC_ACQUIRE, "agent");
            xb_add(&bar[XB_XGEN(b.x)], 1u);
            asm volatile("s_waitcnt vmcnt(0)" ::: "memory");
        } else {
            XB_SPIN(xb_ld(&bar[XB_XGEN(b.x)]) == gen, bar);
            __builtin_amdgcn_fence(__ATOMIC_ACQUIRE, "agent");
            asm volatile("s_waitcnt vmcnt(0)" ::: "memory");
        }
    }
    __syncthreads();
}

DEVI u16 f2bf(float f) { u32 u = __float_as_uint(f); u += 0x7fffu + ((u >> 16) & 1u); return (u16)(u >> 16); }
DEVI float bf2f(u32 h) { return __uint_as_float(h << 16); }
DEVI u32 cvtpk(float lo, float hi) { u32 r; asm("v_cvt_pk_bf16_f32 %0, %1, %2" : "=v"(r) : "v"(lo), "v"(hi)); return r; }
DEVI float bflo(u32 w) { return __uint_as_float(w << 16); }
DEVI float bfhi(u32 w) { return __uint_as_float(w & 0xffff0000u); }
DEVI int crow(int r, int hi) { return (r & 3) + 8 * (r >> 2) + 4 * hi; }
DEVI float wave_sum(float v) { for (int o = 32; o; o >>= 1) v += __shfl_xor(v, o); return v; }
DEVI float wave_max(float v) { for (int o = 32; o; o >>= 1) v = fmaxf(v, __shfl_xor(v, o)); return v; }
DEVI float sigmoidf_(float x) { return 1.f / (1.f + __expf(-x)); }
DEVI float siluf_(float x) { return x / (1.f + __expf(-x)); }
DEVI float logsigmoidf_(float x) { return fminf(x, 0.f) - log1pf(__expf(-fabsf(x))); }
#define SBAR() __builtin_amdgcn_sched_barrier(0)

DEVI void sincos2pi(double frac, double& s, double& c) {
    frac -= floor(frac);
    double q = rint(frac * 4.0);
    double r = (frac - q * 0.25) * 6.283185307179586476925;
    double r2 = r * r;
    double sr = r * (1.0 + r2 * (-1.0 / 6 + r2 * (1.0 / 120 + r2 * (-1.0 / 5040 + r2 * (1.0 / 362880 + r2 * (-1.0 / 39916800 + r2 * (1.0 / 6227020800.0 + r2 * (-1.0 / 1307674368000.0))))))));
    double cr = 1.0 + r2 * (-0.5 + r2 * (1.0 / 24 + r2 * (-1.0 / 720 + r2 * (1.0 / 40320 + r2 * (-1.0 / 3628800 + r2 * (1.0 / 479001600.0 + r2 * (-1.0 / 87178291200.0 + r2 * (1.0 / 20922789888000.0))))))));
    int qi = ((int)q) & 3;
    if (qi == 0) { s = sr; c = cr; } else if (qi == 1) { s = cr; c = -sr; } else if (qi == 2) { s = -sr; c = -cr; } else { s = -cr; c = sr; }
}

DEVI float* xs_ptr(const P& p, int layer, int tok) {
    if (layer == 0) {
        int b = tok >= TT ? 1 : 0, t = tok - b * TT;
        if (t < TC) return (float*)(p.ws + OFF_XC) + (size_t)(b * TC + t) * DM;
        return p.out + (size_t)(b * TL + t - TC) * DM;
    }
    return p.out + (size_t)tok * DM;
}
DEVI const float* xin_ptr(const P& p, int tok) {
    int b = tok >= TT ? 1 : 0, t = tok - b * TT;
    if (t < TC) return p.ctx + (size_t)(b * TC + t) * DM;
    return p.x + (size_t)(b * TL + t - TC) * DM;
}
DEVI int modsel(int layer, int tok) {
    if (layer == 0) { int b = tok >= TT ? 1 : 0, t = tok - b * TT; return t < TC ? 2 : b; }
    return tok >> 14;
}

DEVI int swz128(int row, int chunk) { return row * 144 + (chunk << 4); }
DEVI int swz256(int row, int chunk) { return row * 272 + (chunk << 4); }
DEVI int v_st(int k, int c) { const int kk = (k & ~0xC) | ((k & 4) << 1) | ((k & 8) >> 1); return ((kk >> 3) * 4 + (c >> 5)) * 512 + ((kk & 7) * 32 + (c & 31)) * 2; }
DEVI int v_rd_base(int lane) { return ((lane & 3) << 3) | (((lane >> 2) & 3) << 6) | (((lane >> 4) & 1) << 5) | (((lane >> 5) & 1) << 8); }
constexpr int v_rd_off(int d0, int ks, int half) { return d0 * 512 + ks * 4096 + half * 2048; }
template <int OFF> DEVI s16x4 tr_read(int vb) {
    s16x4 r; asm volatile("ds_read_b64_tr_b16 %0, %1 offset:%2" : "=&v"(r) : "v"(vb), "i"(OFF) : "memory"); return r;
}
#define PKLH(L, H) (bf16x8){L[0], L[1], L[2], L[3], H[0], H[1], H[2], H[3]}
template <int D0, int KS> DEVI void tr_frag_issue(int vb, s16x4& l, s16x4& h) { l = tr_read<v_rd_off(D0, KS, 0)>(vb); h = tr_read<v_rd_off(D0, KS, 1)>(vb); }
#define LGKM0() do { asm volatile("s_waitcnt lgkmcnt(0)" ::: "memory"); SBAR(); } while (0)

DEVI bf16x8 lds_b128(const char* base, int off) { return *reinterpret_cast<const bf16x8*>(base + off); }

DEVI void pack_p(const f32x16& pp, bf16x8& f0, bf16x8& f1) {
#define PK4(BASE, OUT) do { unsigned a0 = cvtpk(pp[BASE + 0], pp[BASE + 1]), a1 = cvtpk(pp[BASE + 2], pp[BASE + 3]);   \
    unsigned b0 = cvtpk(pp[BASE + 4], pp[BASE + 5]), b1 = cvtpk(pp[BASE + 6], pp[BASE + 7]);                            \
    auto r0 = __builtin_amdgcn_permlane32_swap(a0, b0, false, false); auto r1 = __builtin_amdgcn_permlane32_swap(a1, b1, false, false); \
    u32x4 w = {r0[0], r1[0], r0[1], r1[1]}; OUT = *reinterpret_cast<bf16x8*>(&w); } while (0)
    PK4(0, f0); PK4(8, f1);
#undef PK4
}

constexpr int G_STAGE = 55296;
template <class Epi>
DEVI void gemm_tile(const u16* (&ap)[4], const u16* (&bp0)[2], const u16* (&bp1)[2], int K, int ksplit, char* lds, Epi epi) {
    const int tid = threadIdx.x, lane = tid & 63, wid = tid >> 6, wm = wid >> 1, wn = wid & 1, r32 = lane & 31, hi = lane >> 5;
    const int srow = tid >> 3, sch = tid & 7;
    f32x16 acc[2][2] = {};
    u32x4 ra[4], rb[2];
    const int nk = K / 64;
#define GLOAD(kt) do { const int k0 = (kt) * 64; \
    _Pragma("unroll") for (int i = 0; i < 4; ++i) ra[i] = *reinterpret_cast<const u32x4*>(ap[i] + k0); \
    if (k0 < ksplit) { _Pragma("unroll") for (int i = 0; i < 2; ++i) rb[i] = *reinterpret_cast<const u32x4*>(bp0[i] + k0); } \
    else { _Pragma("unroll") for (int i = 0; i < 2; ++i) rb[i] = *reinterpret_cast<const u32x4*>(bp1[i] + (k0 - ksplit)); } } while (0)
#define GWRITE(st) do { char* sa = lds + (st) * G_STAGE; char* sb = sa + 36864; \
    _Pragma("unroll") for (int i = 0; i < 4; ++i) *reinterpret_cast<u32x4*>(sa + swz128(srow + 64 * i, sch)) = ra[i]; \
    _Pragma("unroll") for (int i = 0; i < 2; ++i) *reinterpret_cast<u32x4*>(sb + swz128(srow + 64 * i, sch)) = rb[i]; } while (0)
    GLOAD(0); GWRITE(0); __syncthreads();
    for (int kt = 0; kt < nk; ++kt) {
        if (kt + 1 < nk) GLOAD(kt + 1);
        const char* sa = lds + (kt & 1) * G_STAGE; const char* sb = sa + 36864;
#pragma unroll
        for (int ks = 0; ks < 4; ++ks) {
            bf16x8 a0 = lds_b128(sa, swz128(wm * 64 + r32, 2 * ks + hi));
            bf16x8 a1 = lds_b128(sa, swz128(wm * 64 + 32 + r32, 2 * ks + hi));
            bf16x8 b0 = lds_b128(sb, swz128(wn * 64 + r32, 2 * ks + hi));
            bf16x8 b1 = lds_b128(sb, swz128(wn * 64 + 32 + r32, 2 * ks + hi));
            acc[0][0] = __builtin_amdgcn_mfma_f32_32x32x16_bf16(a0, b0, acc[0][0], 0, 0, 0);
            acc[0][1] = __builtin_amdgcn_mfma_f32_32x32x16_bf16(a0, b1, acc[0][1], 0, 0, 0);
            acc[1][0] = __builtin_amdgcn_mfma_f32_32x32x16_bf16(a1, b0, acc[1][0], 0, 0, 0);
            acc[1][1] = __builtin_amdgcn_mfma_f32_32x32x16_bf16(a1, b1, acc[1][1], 0, 0, 0);
        }
        if (kt + 1 < nk) GWRITE((kt + 1) & 1);
        __syncthreads();
    }
#undef GLOAD
#undef GWRITE
    epi(acc, wm * 64, wn * 64, r32, hi);
}

template <class PF>
DEVI void transpose_tile(PF colptr, int ldsrc, u16* dst, int lddst, int k0, int n0, float* tl) {
    const int t = threadIdx.x, nn = t & 63, kk = t >> 6;
    const float* sp = colptr(n0 + nn);
#pragma unroll
    for (int i = 0; i < 8; ++i) tl[(kk + 8 * i) * 65 + nn] = sp[(size_t)(k0 + kk + 8 * i) * ldsrc];
    __syncthreads();
    const int n = t >> 3, kc = t & 7;
    u32x4 w;
    w[0] = cvtpk(tl[(kc * 8 + 0) * 65 + n], tl[(kc * 8 + 1) * 65 + n]);
    w[1] = cvtpk(tl[(kc * 8 + 2) * 65 + n], tl[(kc * 8 + 3) * 65 + n]);
    w[2] = cvtpk(tl[(kc * 8 + 4) * 65 + n], tl[(kc * 8 + 5) * 65 + n]);
    w[3] = cvtpk(tl[(kc * 8 + 6) * 65 + n], tl[(kc * 8 + 7) * 65 + n]);
    *reinterpret_cast<u32x4*>(dst + (size_t)(n0 + n) * lddst + k0 + kc * 8) = w;
    __syncthreads();
}

DEVI void convert_expert_item(const P& p, int layer, int it, float* tl) {
    const int e = it / 384, r = it % 384;
    const float* wg = p.w_gate + ((size_t)layer * 16 + e) * 1024 * 512;
    const float* wu = p.w_up   + ((size_t)layer * 16 + e) * 1024 * 512;
    const float* wd = p.w_down + ((size_t)layer * 16 + e) * 512 * 1024;
    if (r < 256) {
        u16* dst = (u16*)(p.ws + OFF_WGU) + (size_t)e * 1024 * 1024;
        const int kt = r >> 4, nt = r & 15;
        transpose_tile([&](int n) { const int ch = n >> 5, i = n & 31; return ((ch & 1) ? wu : wg) + (ch >> 1) * 32 + i; }, 512, dst, 1024, kt * 64, nt * 64, tl);
    } else {
        const int q = r - 256; u16* dst = (u16*)(p.ws + OFF_WDT) + (size_t)e * 1024 * 512;
        const int kt = q >> 4, nt = q & 15;
        transpose_tile([&](int n) { return wd + n; }, 1024, dst, 512, kt * 64, nt * 64, tl);
    }
}

constexpr int N0_WIN = 16 * 56, N0_WOUT = 256, N0_EXP = 16 * 384, N0_FN = 2048, N0_MOD = 192, N0_TAB = 128;
constexpr int N0_TOTAL = N0_WIN + N0_WOUT + N0_EXP + N0_FN + N0_MOD + N0_TAB;

DEVI void phase_prologue(const P& p, char* lds) {
    float* tl = (float*)lds;
    const int tid = threadIdx.x;
    for (int it = blockIdx.x; it < N0_TOTAL; it += gridDim.x) {
        int r = it;
        if (r < N0_WIN) {
            const int kt = r / 56, nt = r % 56;
            const float* w = p.w_in;
            transpose_tile([&](int n) { int sc = n; if (n < 1024) { const int j = n & 63; sc = (n & ~63) + (j < 32 ? 2 * j : 2 * (j - 32) + 1); } return w + sc; },
                           3600, (u16*)(p.ws + OFF_WINT), 1024, kt * 64, nt * 64, tl);
            continue;
        }
        r -= N0_WIN;
        if (r < N0_WOUT) {
            const int kt = r >> 4, nt = r & 15; const float* w = p.w_out;
            transpose_tile([&](int n) { return w + n; }, 1024, (u16*)(p.ws + OFF_WOUTT), 1024, kt * 64, nt * 64, tl);
            continue;
        }
        r -= N0_WOUT;
        if (r < N0_EXP) { convert_expert_item(p, 0, r, tl); continue; }
        r -= N0_EXP;
        if (r < N0_FN) {
            float* cs = tl; float* sn = tl + 256;
            if (tid < 256) { double s, c; sincos2pi(tid / 256.0, s, c); cs[tid] = (float)c; sn[tid] = (float)s; }
            __syncthreads();
            const int idx = r * 512 + tid, n = idx >> 10, k = idx & 1023, g = k >> 8, c = k & 255;
            const float* W = p.w_fnet + (size_t)(g * 256) * 1024 + n;
            float ac = 0.f, as = 0.f;
            for (int c2 = 0; c2 < 256; ++c2) { const float w = W[(size_t)c2 * 1024]; const int j = (c * c2) & 255; ac = fmaf(cs[j], w, ac); as = fmaf(sn[j], w, as); }
            u16* F = (u16*)(p.ws + OFF_FNT);
            F[(size_t)n * 1024 + k] = f2bf(ac * (1.f / 2048.f));
            F[(size_t)(1024 + n) * 1024 + k] = f2bf(-as * (1.f / 2048.f));
            __syncthreads();
            continue;
        }
        r -= N0_FN;
        if (r < N0_MOD) {
            float* sv = tl;
            float* part = tl + 3072;
            for (int i = tid; i < 3072; i += NTHR) { const int v = i >> 10, k = i & 1023; const float xv = v < 2 ? p.c[v * 1024 + k] : p.c_ctx[k]; sv[i] = siluf_(xv); }
            __syncthreads();
            const int j0 = r * 64, L = j0 / 6144, col0 = j0 % 6144, kg = tid >> 6, cl = tid & 63;
            const float* W = p.ada_w + (size_t)L * 1024 * 6144 + col0 + cl;
            float a0 = 0.f, a1 = 0.f, a2 = 0.f;
            for (int k = kg * 128; k < kg * 128 + 128; ++k) { const float w = W[(size_t)k * 6144]; a0 = fmaf(sv[k], w, a0); a1 = fmaf(sv[1024 + k], w, a1); a2 = fmaf(sv[2048 + k], w, a2); }
            part[(kg * 3 + 0) * 64 + cl] = a0; part[(kg * 3 + 1) * 64 + cl] = a1; part[(kg * 3 + 2) * 64 + cl] = a2;
            __syncthreads();
            if (tid < 192) {
                const int v = tid >> 6, c2 = tid & 63; float s = 0.f;
                for (int g = 0; g < 8; ++g) s += part[(g * 3 + v) * 64 + c2];
                ((float*)(p.ws + OFF_MOD))[(size_t)(L * 3 + v) * 6144 + col0 + c2] = s + p.ada_b[L * 6144 + col0 + c2];
            }
            __syncthreads();
            continue;
        }
        r -= N0_MOD;
        {
            const int e = r * 512 + tid;
            if (e < 4096 + 1024) {
                const bool isr = e < 4096; const int ee = isr ? e : e - 4096; const int pos = ee >> 4, j = ee & 15;
                double inv = 1.0; for (int q = 0; q < j; ++q) inv *= 0.56234132519034908;
                const float invf = (float)inv; const float ang = (float)pos * invf;
                double s, c; sincos2pi((double)ang * 0.15915494309189533577, s, c);
                float2 v = make_float2((float)c, (float)s);
                if (isr) ((float2*)(p.ws + OFF_ROPER))[ee] = v; else ((float2*)(p.ws + OFF_ROPEC))[ee] = v;
            } else if (e < 5120 + 16384) {
                const int m = e - 5120; double s, c; sincos2pi(m / 16384.0, s, c);
                ((float2*)(p.ws + OFF_TW))[m] = make_float2((float)c, (float)s);
            } else if (e < 5120 + 32768) {
                const int m = e - 5120 - 16384, k = m >> 7, t = m & 127; double s, c; sincos2pi(((k * t) & 127) / 128.0, s, c);
                ((u16*)(p.ws + OFF_DFTC))[m] = f2bf((float)c); ((u16*)(p.ws + OFF_DFTS))[m] = f2bf((float)s);
            } else if (e < 5120 + 49152) {
                const int m = e - 5120 - 32768, k = m >> 4, g = m & 15;
                ((float*)(p.ws + OFF_WG16))[m] = p.w_in[(size_t)k * 3600 + 3584 + g];
            } else if (e == 5120 + 49152) {
                float s01 = 0.f, s23 = 0.f;
                for (int i = 0; i < 64; ++i) { s01 += p.lamv[i] * p.lamv[64 + i]; s23 += p.lamv[128 + i] * p.lamv[192 + i]; }
                ((float*)(p.ws + OFF_LAM))[0] = expf(s01) - expf(s23) + 0.2f;
            }
        }
    }
}

template <int MODE>
DEVI void phase_norm(const P& p, char* lds) {
    constexpr int layer = (MODE == 0 || MODE == 1) ? 0 : 1;
    constexpr bool side = (MODE == 0 || MODE == 1 || MODE == 3);
    const int nrows = layer == 0 ? NTOK : NLAT;
    const int tid = threadIdx.x, lane = tid & 63, wid = tid >> 6;
    f32x4* sl = (f32x4*)lds;
    if (side) {
        const float* S = (MODE == 0) ? (const float*)(p.ws + OFF_WG16) : p.router_w;
        for (int i = tid; i < 4096; i += NTHR) { const int eg = i >> 10, col = i & 1023; sl[i] = *reinterpret_cast<const f32x4*>(S + col * 16 + eg * 4); }
        __syncthreads();
    }
    const float* g = MODE == 0 ? p.nmix_g : MODE == 1 ? p.nffn_g : MODE == 2 ? p.nmix_g + 1024 : MODE == 3 ? p.nffn_g + 1024 : p.final_g;
    const float* modb = (const float*)(p.ws + OFF_MOD) + (size_t)layer * 3 * 6144;
    constexpr int sh_i = (MODE == 0 || MODE == 2) ? 0 : 3;
    u16* act = (u16*)(p.ws + OFF_ACT);
    for (int row = blockIdx.x * 8 + wid; row < nrows; row += gridDim.x * 8) {
        const float* src = (MODE == 0) ? xin_ptr(p, row) : xs_ptr(p, layer, row);
        float xv[16]; float ss = 0.f;
#pragma unroll
        for (int m = 0; m < 16; ++m) { xv[m] = src[lane + 64 * m]; ss = fmaf(xv[m], xv[m], ss); }
        ss = wave_sum(ss);
        const float rstd = rsqrtf(ss * (1.f / 1024.f) + 1e-6f);
        if (MODE == 4) {
            float* dst = p.out + (size_t)row * DM;
#pragma unroll
            for (int m = 0; m < 16; ++m) dst[lane + 64 * m] = xv[m] * rstd * g[lane + 64 * m];
            continue;
        }
        const float* mv = modb + (size_t)modsel(layer, row) * 6144;
        float acc[16];
#pragma unroll
        for (int e = 0; e < 16; ++e) acc[e] = 0.f;
#pragma unroll
        for (int m = 0; m < 16; ++m) {
            const int col = lane + 64 * m;
            const float h = xv[m] * rstd * g[col] * (1.f + mv[(sh_i + 1) * 1024 + col]) + mv[sh_i * 1024 + col];
            act[(size_t)row * DM + col] = f2bf(h);
            if (side) {
                if ((m & 1) == 0) asm volatile("" ::: "memory");
#pragma unroll
                for (int eg = 0; eg < 4; ++eg) { const f32x4 w = sl[eg * 1024 + col]; acc[eg * 4 + 0] = fmaf(h, w[0], acc[eg * 4 + 0]); acc[eg * 4 + 1] = fmaf(h, w[1], acc[eg * 4 + 1]);
                    acc[eg * 4 + 2] = fmaf(h, w[2], acc[eg * 4 + 2]); acc[eg * 4 + 3] = fmaf(h, w[3], acc[eg * 4 + 3]); }
            }
        }
        if (side) {
#pragma unroll
            for (int e = 0; e < 16; ++e) acc[e] = wave_sum(acc[e]);
            if (MODE == 0) {
                float mine = 0.f;
#pragma unroll
                for (int e = 0; e < 16; ++e) mine = (lane == e) ? acc[e] : mine;
                if (lane < 16) {
                    float v = mine + p.gate_b[lane];
                    const int type = lane >> 2;
                    if (type == 1 || type == 3) v = logsigmoidf_(v);
                    ((float*)(p.ws + OFF_GATES))[(size_t)row * 16 + lane] = v;
                }
            } else if (lane == 0) {
                float aff[16], bi[16];
#pragma unroll
                for (int e = 0; e < 16; ++e) { aff[e] = sigmoidf_(acc[e]); bi[e] = aff[e] + p.router_b[e]; }
                int bg = 0, ba = 0, bb = 1; float bscore = -1e30f;
#pragma unroll
                for (int gq = 0; gq < 4; ++gq) {
                    int ia = 0; float va = bi[gq * 4];
#pragma unroll
                    for (int j = 1; j < 4; ++j) if (bi[gq * 4 + j] > va) { va = bi[gq * 4 + j]; ia = j; }
                    int ib = -1; float vb = -1e30f;
#pragma unroll
                    for (int j = 0; j < 4; ++j) if (j != ia && bi[gq * 4 + j] > vb) { vb = bi[gq * 4 + j]; ib = j; }
                    const float sc = va + vb;
                    if (sc > bscore) { bscore = sc; bg = gq; ba = ia; bb = ib; }
                }
                const int lo = ba < bb ? ba : bb, hi2 = ba < bb ? bb : ba;
                float alo = 0.f, ahi = 0.f;
#pragma unroll
                for (int e = 0; e < 16; ++e) { if (e == bg * 4 + lo) alo = aff[e]; if (e == bg * 4 + hi2) ahi = aff[e]; }
                const float inv = 1.f / (alo + ahi);
                const int pair = lo == 0 ? hi2 - 1 : (lo == 1 ? hi2 + 1 : 5);
                const int cls = bg * 6 + pair;
                unsigned* cnt = (unsigned*)(p.ws + OFF_CNT) + layer * 32;
                const unsigned slot = atomicAdd(&cnt[cls], 1u);
                ((int*)(p.ws + OFF_LIST))[(size_t)cls * NTOK + slot] = row;
                ((float2*)(p.ws + OFF_TOKW))[row] = make_float2(alo * inv, ahi * inv);
            }
        }
    }
}

DEVI void phase_inproj(const P& p, char* lds) {
    const int tid = threadIdx.x;
    const u16* A = (const u16*)(p.ws + OFF_ACT); const u16* B = (const u16*)(p.ws + OFF_WINT);
    const float2* tabR = (const float2*)(p.ws + OFF_ROPER); const float2* tabC = (const float2*)(p.ws + OFF_ROPEC);
    constexpr int NMT = NTOK / 256, NNT = 28;
    for (int u = blockIdx.x; u < NMT * NNT; u += gridDim.x) {
        const int mt = u / NNT, nt = u % NNT;
        const u16* ap[4]; const u16* bp[2];
#pragma unroll
        for (int i = 0; i < 4; ++i) ap[i] = A + (size_t)(mt * 256 + (tid >> 3) + 64 * i) * 1024 + (tid & 7) * 8;
#pragma unroll
        for (int i = 0; i < 2; ++i) bp[i] = B + (size_t)(nt * 128 + (tid >> 3) + 64 * i) * 1024 + (tid & 7) * 8;
        u16* dst; int ld, coff, kind;
        if (nt < 4)       { dst = (u16*)(p.ws + OFF_Q);    ld = 512;  coff = nt * 128;        kind = 1; }
        else if (nt < 8)  { dst = (u16*)(p.ws + OFF_K);    ld = 512;  coff = (nt - 4) * 128;  kind = 1; }
        else if (nt < 12) { dst = (u16*)(p.ws + OFF_V);    ld = 512;  coff = (nt - 8) * 128;  kind = 0; }
        else if (nt < 20) { dst = (u16*)(p.ws + OFF_MLQK); ld = 1024; coff = (nt - 12) * 128; kind = 0; }
        else if (nt < 24) { dst = (u16*)(p.ws + OFF_MLV);  ld = 512;  coff = (nt - 20) * 128; kind = 0; }
        else              { dst = (u16*)(p.ws + OFF_OG);   ld = 512;  coff = (nt - 24) * 128; kind = 2; }
        const int tb = mt % 65;
        gemm_tile(ap, bp, bp, 1024, 1024, lds, [&](f32x16 (&acc)[2][2], int rb, int cb, int r32, int hi) {
#pragma unroll
            for (int mi = 0; mi < 2; ++mi) {
#pragma unroll
                for (int r = 0; r < 16; ++r) {
                    const int row = rb + mi * 32 + crow(r, hi);
                    float v0 = acc[mi][0][r], v1 = acc[mi][1][r];
                    if (kind == 1 && tb > 0) {
                        const int tl = (tb - 1) * 256 + row;
                        const float2 cs = r32 < 16 ? tabR[(tl >> 6) * 16 + r32] : tabC[(tl & 63) * 16 + (r32 - 16)];
                        const float y0 = v0 * cs.x - v1 * cs.y, y1 = v0 * cs.y + v1 * cs.x; v0 = y0; v1 = y1;
                    } else if (kind == 2) { v0 = sigmoidf_(v0); v1 = sigmoidf_(v1); }
                    u16* d = dst + (size_t)(mt * 256 + row) * ld + coff + cb + r32;
                    d[0] = f2bf(v0); d[32] = f2bf(v1);
                }
            }
        });
    }
}

DEVI void phase_outproj(const P& p, char* lds) {
    const int tid = threadIdx.x;
    const u16* A = (const u16*)(p.ws + OFF_ACT); const u16* B = (const u16*)(p.ws + OFF_WOUTT);
    const float* modb = (const float*)(p.ws + OFF_MOD);
    constexpr int NMT = NTOK / 256, NNT = 8;
    for (int u = blockIdx.x; u < NMT * NNT; u += gridDim.x) {
        const int mt = u / NNT, nt = u % NNT;
        const u16* ap[4]; const u16* bp[2];
#pragma unroll
        for (int i = 0; i < 4; ++i) ap[i] = A + (size_t)(mt * 256 + (tid >> 3) + 64 * i) * 1024 + (tid & 7) * 8;
#pragma unroll
        for (int i = 0; i < 2; ++i) bp[i] = B + (size_t)(nt * 128 + (tid >> 3) + 64 * i) * 1024 + (tid & 7) * 8;
        const float* gate = modb + (size_t)modsel(0, mt * 256) * 6144 + 2 * 1024 + nt * 128;
        gemm_tile(ap, bp, bp, 1024, 1024, lds, [&](f32x16 (&acc)[2][2], int rb, int cb, int r32, int hi) {
            const float g0 = gate[cb + r32], g1 = gate[cb + 32 + r32];
#pragma unroll
            for (int mi = 0; mi < 2; ++mi) {
#pragma unroll
                for (int r = 0; r < 16; ++r) {
                    const int tok = mt * 256 + rb + mi * 32 + crow(r, hi);
                    const float* xi = xin_ptr(p, tok) + nt * 128 + cb + r32;
                    float* xo = xs_ptr(p, 0, tok) + nt * 128 + cb + r32;
                    xo[0] = xi[0] + g0 * acc[mi][0][r]; xo[32] = xi[32] + g1 * acc[mi][1][r];
                }
            }
        });
    }
}

DEVI int moe_table(const P& p, int layer, int* tb) {
    if (threadIdx.x == 0) {
        const unsigned* cnt = (const unsigned*)(p.ws + OFF_CNT) + layer * 32; int o = 0;
        for (int c = 0; c < 24; ++c) { tb[c] = o; tb[32 + c] = (int)cnt[c]; o += ((int)cnt[c] + 255) >> 8; }
        tb[24] = o;
    }
    __syncthreads();
    return tb[24];
}
DEVI void cls_experts(int cls, int& elo, int& ehi) {
    const int g = cls / 6, pr = cls % 6;
    const int lo = pr < 3 ? 0 : (pr < 5 ? 1 : 2); const int hi = pr < 3 ? pr + 1 : (pr < 5 ? pr - 1 : 3);
    elo = g * 4 + lo; ehi = g * 4 + hi;
}

DEVI void phase_moe_up(const P& p, int layer, char* lds) {
    const int tid = threadIdx.x;
    int* tb = (int*)(lds + 2 * G_STAGE);
    const int T = moe_table(p, layer, tb);
    const u16* A = (const u16*)(p.ws + OFF_ACT);
    const int* list = (const int*)(p.ws + OFF_LIST); const float2* tokw = (const float2*)(p.ws + OFF_TOKW);
    u16* HE = (u16*)(p.ws + OFF_HE);
    for (int u = blockIdx.x; u < T * 16; u += gridDim.x) {
        const int rt = u >> 4, ct = u & 15;
        int cls = 0; while (cls < 23 && tb[cls + 1] <= rt) ++cls;
        const int r0 = (rt - tb[cls]) * 256, ncls = tb[32 + cls];
        int elo, ehi; cls_experts(cls, elo, ehi);
        const int s = ct >> 3, c8 = ct & 7, e = s ? ehi : elo;
        const u16* B = (const u16*)(p.ws + OFF_WGU) + (size_t)e * 1024 * 1024 + (size_t)(c8 * 128) * 1024;
        const int* lst = list + (size_t)cls * NTOK + r0;
        const u16* ap[4]; const u16* bp[2];
#pragma unroll
        for (int i = 0; i < 4; ++i) { const int rr = (tid >> 3) + 64 * i; const int tok = (r0 + rr < ncls) ? lst[rr] : lst[0]; ap[i] = A + (size_t)tok * 1024 + (tid & 7) * 8; }
#pragma unroll
        for (int i = 0; i < 2; ++i) bp[i] = B + (size_t)((tid >> 3) + 64 * i) * 1024 + (tid & 7) * 8;
        gemm_tile(ap, bp, bp, 1024, 1024, lds, [&](f32x16 (&acc)[2][2], int rb, int cb, int r32, int hi) {
#pragma unroll
            for (int mi = 0; mi < 2; ++mi) {
#pragma unroll
                for (int r = 0; r < 16; ++r) {
                    const int row = rb + mi * 32 + crow(r, hi);
                    if (r0 + row < ncls) {
                        const int tok = lst[row]; const float2 w = tokw[tok];
                        const float gv = acc[mi][0][r], uv = acc[mi][1][r];
                        const float hv = siluf_(gv) * uv * (s ? w.y : w.x);
                        HE[(size_t)(rt * 256 + row) * 1024 + s * 512 + c8 * 64 + (cb >> 1) + r32] = f2bf(hv);
                    }
                }
            }
        });
    }
}

DEVI void phase_moe_down(const P& p, int layer, char* lds) {
    const int tid = threadIdx.x;
    int* tb = (int*)(lds + 2 * G_STAGE);
    const int T = moe_table(p, layer, tb);
    const u16* HE = (const u16*)(p.ws + OFF_HE);
    const int* list = (const int*)(p.ws + OFF_LIST);
    const float* modb = (const float*)(p.ws + OFF_MOD) + (size_t)layer * 3 * 6144;
    for (int u = blockIdx.x; u < T * 8; u += gridDim.x) {
        const int rt = u >> 3, nt = u & 7;
        int cls = 0; while (cls < 23 && tb[cls + 1] <= rt) ++cls;
        const int r0 = (rt - tb[cls]) * 256, ncls = tb[32 + cls];
        int elo, ehi; cls_experts(cls, elo, ehi);
        const u16* B0 = (const u16*)(p.ws + OFF_WDT) + (size_t)elo * 1024 * 512 + (size_t)(nt * 128) * 512;
        const u16* B1 = (const u16*)(p.ws + OFF_WDT) + (size_t)ehi * 1024 * 512 + (size_t)(nt * 128) * 512;
        const int* lst = list + (size_t)cls * NTOK + r0;
        const u16* ap[4]; const u16* bp0[2]; const u16* bp1[2];
#pragma unroll
        for (int i = 0; i < 4; ++i) { const int rr = (tid >> 3) + 64 * i; const int prow = (r0 + rr < ncls) ? rt * 256 + rr : rt * 256; ap[i] = HE + (size_t)prow * 1024 + (tid & 7) * 8; }
#pragma unroll
        for (int i = 0; i < 2; ++i) { bp0[i] = B0 + (size_t)((tid >> 3) + 64 * i) * 512 + (tid & 7) * 8; bp1[i] = B1 + (size_t)((tid >> 3) + 64 * i) * 512 + (tid & 7) * 8; }
        gemm_tile(ap, bp0, bp1, 1024, 512, lds, [&](f32x16 (&acc)[2][2], int rb, int cb, int r32, int hi) {
#pragma unroll
            for (int mi = 0; mi < 2; ++mi) {
#pragma unroll
                for (int r = 0; r < 16; ++r) {
                    const int row = rb + mi * 32 + crow(r, hi);
                    if (r0 + row < ncls) {
                        const int tok = lst[row];
                        const float* gate = modb + (size_t)modsel(layer, tok) * 6144 + 5 * 1024 + nt * 128 + cb + r32;
                        float* xo = xs_ptr(p, layer, tok) + nt * 128 + cb + r32;
                        xo[0] += gate[0] * acc[mi][0][r]; xo[32] += gate[32] * acc[mi][1][r];
                    }
                }
            }
        });
    }
}

DEVI void phase_fnet_gemm(const P& p, char* lds) {
    const int tid = threadIdx.x;
    const u16* A = (const u16*)(p.ws + OFF_ACT); const u16* B = (const u16*)(p.ws + OFF_FNT);
    constexpr int NMT = NLAT / 256, NNT = 16;
    for (int u = blockIdx.x; u < NMT * NNT; u += gridDim.x) {
        const int mt = u / NNT, nt = u % NNT;
        const u16* ap[4]; const u16* bp[2];
#pragma unroll
        for (int i = 0; i < 4; ++i) ap[i] = A + (size_t)(mt * 256 + (tid >> 3) + 64 * i) * 1024 + (tid & 7) * 8;
#pragma unroll
        for (int i = 0; i < 2; ++i) bp[i] = B + (size_t)(nt * 128 + (tid >> 3) + 64 * i) * 1024 + (tid & 7) * 8;
        u16* dst = (u16*)(p.ws + (nt < 8 ? OFF_ZR : OFF_ZI)) + (nt & 7) * 128;
        gemm_tile(ap, bp, bp, 1024, 1024, lds, [&](f32x16 (&acc)[2][2], int rb, int cb, int r32, int hi) {
#pragma unroll
            for (int mi = 0; mi < 2; ++mi) {
#pragma unroll
                for (int r = 0; r < 16; ++r) {
                    u16* d = dst + (size_t)(mt * 256 + rb + mi * 32 + crow(r, hi)) * 1024 + cb + r32;
                    d[0] = f2bf(acc[mi][0][r]); d[32] = f2bf(acc[mi][1][r]);
                }
            }
        });
    }
}

template <class RP>
DEVI void stage_tr128(RP rp, char* img) {
    const int tid = threadIdx.x;
#pragma unroll
    for (int i = 0; i < 4; ++i) {
        const int idx = tid + 512 * i, k = idx >> 4, c = (idx & 15) * 8;
        const u32x4 v = *reinterpret_cast<const u32x4*>(rp(k) + c);
        *reinterpret_cast<u32x4*>(img + (k >> 6) * 16384 + v_st(k & 63, c)) = v;
    }
}
DEVI void load_dft(const P& p, char* lds) {
    const int tid = threadIdx.x;
    for (int i = tid; i < 4096; i += NTHR) {
        const int m = i >> 11, j = i & 2047, row = j >> 4, ch = j & 15;
        const u32x4 v = *reinterpret_cast<const u32x4*>((const u16*)(p.ws + (m ? OFF_DFTS : OFF_DFTC)) + row * 128 + ch * 8);
        *reinterpret_cast<u32x4*>(lds + m * 34816 + swz256(row, ch)) = v;
    }
}
DEVI bf16x8 negbf(bf16x8 v) { u32x4 w = *reinterpret_cast<u32x4*>(&v); w[0] ^= 0x80008000u; w[1] ^= 0x80008000u; w[2] ^= 0x80008000u; w[3] ^= 0x80008000u; return *reinterpret_cast<bf16x8*>(&w); }

template <int KS, int WN, int MODE>
DEVI void fft_kstep(int vbr, int vbi, const bf16x8& aC, const bf16x8& aS, f32x16 (&yr)[2], f32x16 (&yi)[2]) {
    s16x4 rl0, rh0, rl1, rh1, il0, ih0, il1, ih1;
    tr_frag_issue<2 * WN, KS>(vbr, rl0, rh0); tr_frag_issue<2 * WN + 1, KS>(vbr, rl1, rh1);
    tr_frag_issue<2 * WN, KS>(vbi, il0, ih0); tr_frag_issue<2 * WN + 1, KS>(vbi, il1, ih1);
    LGKM0();
    const bf16x8 xr0 = PKLH(rl0, rh0), xr1 = PKLH(rl1, rh1), xi0 = PKLH(il0, ih0), xi1 = PKLH(il1, ih1);
    yr[0] = __builtin_amdgcn_mfma_f32_32x32x16_bf16(aC, xr0, yr[0], 0, 0, 0);
    yr[1] = __builtin_amdgcn_mfma_f32_32x32x16_bf16(aC, xr1, yr[1], 0, 0, 0);
    yr[0] = __builtin_amdgcn_mfma_f32_32x32x16_bf16(aS, xi0, yr[0], 0, 0, 0);
    yr[1] = __builtin_amdgcn_mfma_f32_32x32x16_bf16(aS, xi1, yr[1], 0, 0, 0);
    if (MODE == 0) {
        yi[0] = __builtin_amdgcn_mfma_f32_32x32x16_bf16(aC, xi0, yi[0], 0, 0, 0);
        yi[1] = __builtin_amdgcn_mfma_f32_32x32x16_bf16(aC, xi1, yi[1], 0, 0, 0);
        yi[0] = __builtin_amdgcn_mfma_f32_32x32x16_bf16(aS, negbf(xr0), yi[0], 0, 0, 0);
        yi[1] = __builtin_amdgcn_mfma_f32_32x32x16_bf16(aS, negbf(xr1), yi[1], 0, 0, 0);
    }
}
template <int WN, int MODE>
DEVI void fft_core(const char* lds, int xr_img, int xi_img, int wm, int lane, f32x16 (&yr)[2], f32x16 (&yi)[2]) {
    const int r32 = lane & 31, hi = lane >> 5;
    const char* Cm = lds; const char* Sm = lds + 34816;
    const int row = wm * 32 + r32;
    const int vb0 = xr_img + v_rd_base(lane), vb1 = xi_img + v_rd_base(lane);
#define KSTEP(H, KS) do { const int kk = (H) * 4 + (KS); \
        const bf16x8 aC = lds_b128(Cm, swz256(row, 2 * kk + hi)), aS = lds_b128(Sm, swz256(row, 2 * kk + hi)); \
        fft_kstep<KS, WN, MODE>(vb0 + (H) * 16384, vb1 + (H) * 16384, aC, aS, yr, yi); } while (0)
    KSTEP(0, 0); KSTEP(0, 1); KSTEP(0, 2); KSTEP(0, 3); KSTEP(1, 0); KSTEP(1, 1); KSTEP(1, 2); KSTEP(1, 3);
#undef KSTEP
}

DEVI void phase_fft1(const P& p, char* lds) {
    const int tid = threadIdx.x, lane = tid & 63, wid = tid >> 6, wm = wid >> 1, wn = wid & 1, r32 = lane & 31, hi = lane >> 5;
    load_dft(p, lds);
    char* imgR = lds + 69632; char* imgI = lds + 102400;
    const u16* Zr = (const u16*)(p.ws + OFF_ZR); const u16* Zi = (const u16*)(p.ws + OFF_ZI);
    u16* Yr = (u16*)(p.ws + OFF_YR); u16* Yi = (u16*)(p.ws + OFF_YI);
    const float2* TW = (const float2*)(p.ws + OFF_TW);
    for (int u = blockIdx.x; u < NB * 128 * 8; u += gridDim.x) {
        const int cb = u & 7, t2 = (u >> 3) & 127, b = u >> 10;
        __syncthreads();
        stage_tr128([&](int k) { return Zr + (size_t)(b * TL + 128 * k + t2) * 1024 + cb * 128; }, imgR);
        stage_tr128([&](int k) { return Zi + (size_t)(b * TL + 128 * k + t2) * 1024 + cb * 128; }, imgI);
        __syncthreads();
        f32x16 yr[2] = {}, yi[2] = {};
        const int xr_img = (int)(uintptr_t)imgR, xi_img = (int)(uintptr_t)imgI;
        if (wn == 0) fft_core<0, 0>(lds, xr_img, xi_img, wm, lane, yr, yi); else fft_core<1, 0>(lds, xr_img, xi_img, wm, lane, yr, yi);
#pragma unroll
        for (int r = 0; r < 16; ++r) {
            const int k1 = wm * 32 + crow(r, hi);
            const float2 w = TW[t2 * k1];
            const size_t o = ((size_t)(b * 128 + k1) * 128 + t2) * 1024 + cb * 128 + wn * 64 + r32;
#pragma unroll
            for (int ni = 0; ni < 2; ++ni) {
                const float a = yr[ni][r], bq = yi[ni][r];
                Yr[o + ni * 32] = f2bf(a * w.x + bq * w.y);
                Yi[o + ni * 32] = f2bf(bq * w.x - a * w.y);
            }
        }
    }
}
DEVI void phase_fft2(const P& p, char* lds) {
    const int tid = threadIdx.x, lane = tid & 63, wid = tid >> 6, wm = wid >> 1, wn = wid & 1, r32 = lane & 31, hi = lane >> 5;
    load_dft(p, lds);
    char* imgR = lds + 69632; char* imgI = lds + 102400;
    const u16* Yr = (const u16*)(p.ws + OFF_YR); const u16* Yi = (const u16*)(p.ws + OFF_YI);
    const float* modb = (const float*)(p.ws + OFF_MOD) + (size_t)3 * 6144;
    for (int u = blockIdx.x; u < NB * 128 * 8; u += gridDim.x) {
        const int cb = u & 7, k1 = (u >> 3) & 127, b = u >> 10;
        __syncthreads();
        stage_tr128([&](int k) { return Yr + ((size_t)(b * 128 + k1) * 128 + k) * 1024 + cb * 128; }, imgR);
        stage_tr128([&](int k) { return Yi + ((size_t)(b * 128 + k1) * 128 + k) * 1024 + cb * 128; }, imgI);
        __syncthreads();
        f32x16 yr[2] = {}, yi[2] = {};
        const int xr_img = (int)(uintptr_t)imgR, xi_img = (int)(uintptr_t)imgI;
        if (wn == 0) fft_core<0, 1>(lds, xr_img, xi_img, wm, lane, yr, yi); else fft_core<1, 1>(lds, xr_img, xi_img, wm, lane, yr, yi);
        const float* gate = modb + (size_t)b * 6144 + 2 * 1024 + cb * 128 + wn * 64 + r32;
        const float g0 = gate[0], g1 = gate[32];
#pragma unroll
        for (int r = 0; r < 16; ++r) {
            const int k2 = wm * 32 + crow(r, hi);
            float* xo = p.out + (size_t)(b * TL + k1 + 128 * k2) * 1024 + cb * 128 + wn * 64 + r32;
            xo[0] += g0 * yr[0][r]; xo[32] += g1 * yr[1][r];
        }
    }
}

constexpr int AT_V = 16384, AT_K = 17408;
template <int HF, int DB>
DEVI void attn_half(const char* Ks, const bf16x8 (&qr)[8], float& m_reg, float& l_reg, f32x16 (&o)[4], int vb, float* al, int r32, int hi) {
    constexpr float SC = 0.125f, C = SC * 1.4426950408889634f, THR = 8.f;
    f32x16 pp = {};
#pragma unroll
    for (int d0 = 0; d0 < 4; ++d0) pp = __builtin_amdgcn_mfma_f32_32x32x16_bf16(lds_b128(Ks, swz256(HF * 32 + r32, 2 * (DB + d0) + hi)), qr[DB + d0], pp, 0, 0, 0);
    float pmax = pp[0];
#pragma unroll
    for (int r = 1; r < 16; ++r) pmax = fmaxf(pmax, pp[r]);
    { auto rr = __builtin_amdgcn_permlane32_swap(__float_as_uint(pmax), __float_as_uint(pmax), false, false);
      pmax = fmaxf(__uint_as_float(rr[0]), __uint_as_float(rr[1])); }
    float alpha = 1.f;
    if (!__all(pmax - m_reg <= THR / SC)) {
        const float mn = fmaxf(m_reg, pmax); alpha = __builtin_amdgcn_exp2f((m_reg - mn) * C); m_reg = mn;
        if (hi == 0) al[r32] = alpha;
        asm volatile("s_waitcnt lgkmcnt(0)" ::: "memory");
#pragma unroll
        for (int d = 0; d < 4; ++d)
#pragma unroll
            for (int r = 0; r < 16; ++r) o[d][r] *= al[crow(r, hi)];
    }
    const float mnC = -m_reg * C;
    float ps = 0.f;
#pragma unroll
    for (int r = 0; r < 16; ++r) { pp[r] = __builtin_amdgcn_exp2f(fmaf(pp[r], C, mnC)); ps += pp[r]; }
    { auto rr = __builtin_amdgcn_permlane32_swap(__float_as_uint(ps), __float_as_uint(ps), false, false);
      ps = __uint_as_float(rr[0]) + __uint_as_float(rr[1]); }
    l_reg = l_reg * alpha + ps;
    bf16x8 pa0, pa1;
    pack_p(pp, pa0, pa1);
#define PVD(D0) do { s16x4 l0, h0, l1, h1; tr_frag_issue<D0, 2 * HF>(vb, l0, h0); tr_frag_issue<D0, 2 * HF + 1>(vb, l1, h1); LGKM0(); \
        o[D0] = __builtin_amdgcn_mfma_f32_32x32x16_bf16(pa0, PKLH(l0, h0), o[D0], 0, 0, 0); \
        o[D0] = __builtin_amdgcn_mfma_f32_32x32x16_bf16(pa1, PKLH(l1, h1), o[D0], 0, 0, 0); } while (0)
    PVD(0); PVD(1); PVD(2); PVD(3);
#undef PVD
}

DEVI void diffattn_item(const P& p, int q0, int k0row, int seq, int h, char* lds) {
    int tid = threadIdx.x; asm volatile("" : "+v"(tid));
    const int wid = tid >> 6, lane = tid & 63, r32 = lane & 31, hi = lane >> 5;
    const u16* Q = (const u16*)(p.ws + OFF_Q); const u16* Kg = (const u16*)(p.ws + OFF_K) + (size_t)k0row * 512 + h * 128;
    const u16* Vg = (const u16*)(p.ws + OFF_V) + (size_t)k0row * 512 + h * 128;
    char* V_lds = lds; char* K_lds = lds + 2 * AT_V;
    float* al = (float*)(lds + 2 * AT_V + 2 * AT_K) + wid * 64;
    bf16x8 qr[8];
    { const u16* Qw = Q + (size_t)(q0 + wid * 32 + r32) * 512 + h * 128 + hi * 8;
#pragma unroll
      for (int d0 = 0; d0 < 8; ++d0) qr[d0] = *reinterpret_cast<const bf16x8*>(Qw + d0 * 16); }
    const int sr = tid >> 4, sc = (tid & 15) * 8;
    const int vb0 = (int)(uintptr_t)V_lds + v_rd_base(lane);
    const int vc = ((tid >> 5) & 3) * 32 + (tid & 3) * 8;
    const int kk0 = (tid >> 7) * 8 + ((tid & 31) >> 2), kk1 = kk0 + 32;
    const int vk0 = (kk0 & ~0xC) | ((kk0 & 4) << 1) | ((kk0 & 8) >> 1), vk1 = (kk1 & ~0xC) | ((kk1 & 4) << 1) | ((kk1 & 8) >> 1);
    u32x4 sk0, sk1;
#define SLOAD(kk, b) do { \
    __builtin_amdgcn_global_load_lds((const unsigned*)(Vg + (size_t)((kk) + vk0) * 512 + vc), (LAS unsigned*)(V_lds + (b) * AT_V + tid * 16), 16, 0, 0); \
    __builtin_amdgcn_global_load_lds((const unsigned*)(Vg + (size_t)((kk) + vk1) * 512 + vc), (LAS unsigned*)(V_lds + (b) * AT_V + 8192 + tid * 16), 16, 0, 0); \
    sk0 = *reinterpret_cast<const u32x4*>(Kg + (size_t)((kk) + sr) * 512 + sc); sk1 = *reinterpret_cast<const u32x4*>(Kg + (size_t)((kk) + 32 + sr) * 512 + sc); } while (0)
#define SWRITE(b) do { *reinterpret_cast<u32x4*>(K_lds + (b) * AT_K + swz256(sr, tid & 15)) = sk0; *reinterpret_cast<u32x4*>(K_lds + (b) * AT_K + swz256(32 + sr, tid & 15)) = sk1; } while (0)
    float m0 = -1e30f, m1 = -1e30f, l0 = 0.f, l1 = 0.f;
    f32x16 o0[4] = {}, o1[4] = {};
    const int NT = seq / 64;
    __syncthreads();
    SLOAD(0, 0); SWRITE(0); asm volatile("s_waitcnt vmcnt(0)" ::: "memory"); __syncthreads();
    if (NT > 1) SLOAD(64, 1);
    for (int j = 0; j < NT; ++j) {
        const int cur = j & 1;
        const char* Ks = K_lds + cur * AT_K;
        attn_half<0, 0>(Ks, qr, m0, l0, o0, vb0 + cur * AT_V, al, r32, hi);
        attn_half<1, 0>(Ks, qr, m0, l0, o0, vb0 + cur * AT_V, al, r32, hi);
        attn_half<0, 4>(Ks, qr, m1, l1, o1, vb0 + cur * AT_V, al, r32, hi);
        attn_half<1, 4>(Ks, qr, m1, l1, o1, vb0 + cur * AT_V, al, r32, hi);
        if (j + 1 < NT) SWRITE(cur ^ 1);
        asm volatile("s_waitcnt vmcnt(0)" ::: "memory");
        __syncthreads();
        if (j + 2 < NT) SLOAD((j + 2) * 64, cur);
    }
#undef SLOAD
#undef SWRITE
    int tz = threadIdx.x; asm volatile("" : "+v"(tz));
    const int wid2 = tz >> 6, lane2 = tz & 63, r32e = lane2 & 31, hie = lane2 >> 5;
    const float lam = ((const float*)(p.ws + OFF_LAM))[0];
    float* sc0 = (float*)(lds + 2 * AT_V + 2 * AT_K) + wid2 * 64; float* sc1 = sc0 + 32;
    if (hie == 0) { sc0[r32e] = 1.f / l0; sc1[r32e] = -lam / l1; }
    asm volatile("s_waitcnt lgkmcnt(0)" ::: "memory");
    float ssq[16];
#pragma unroll
    for (int r = 0; r < 16; ++r) {
        const float a = sc0[crow(r, hie)], b = sc1[crow(r, hie)]; float s = 0.f;
#pragma unroll
        for (int d = 0; d < 4; ++d) { const float v = o0[d][r] * a + o1[d][r] * b; o0[d][r] = v; s = fmaf(v, v, s); }
        ssq[r] = s;
    }
#pragma unroll
    for (int r = 0; r < 16; ++r) { float s = ssq[r]; for (int o = 16; o; o >>= 1) s += __shfl_xor(s, o); ssq[r] = rsqrtf(s * (1.f / 128.f) + 1e-6f) * 0.8f; }
    u16* mix = (u16*)(p.ws + OFF_ACT);
    const float* sg = p.subln_g;
#pragma unroll
    for (int d = 0; d < 4; ++d) {
        const float gv = sg[d * 32 + r32e];
#pragma unroll
        for (int r = 0; r < 16; ++r) mix[(size_t)(q0 + wid2 * 32 + crow(r, hie)) * 1024 + h * 128 + d * 32 + r32e] = f2bf(o0[d][r] * ssq[r] * gv);
    }
}

DEVI void chunk_scan(const float* gates, int row0, int head, int dir, float* Bq, float* av, float* pm, float& total, float& amax) {
    const int lane = threadIdx.x & 63;
    const int e0 = dir ? 127 - 2 * lane : 2 * lane, e1 = dir ? 126 - 2 * lane : 2 * lane + 1;
    const float lf0 = gates[(size_t)(row0 + e0) * 16 + (dir ? 12 : 4) + head], lf1 = gates[(size_t)(row0 + e1) * 16 + (dir ? 12 : 4) + head];
    const float li0 = gates[(size_t)(row0 + e0) * 16 + (dir ? 8 : 0) + head],  li1 = gates[(size_t)(row0 + e1) * 16 + (dir ? 8 : 0) + head];
    const float s1 = lf0 + lf1; float inc = s1;
#pragma unroll
    for (int o = 1; o < 64; o <<= 1) { const float t = __shfl_up(inc, o); if (lane >= o) inc += t; }
    const float exc = inc - s1;
    const float B0 = exc + lf0, B1 = exc + s1;
    const float a0 = li0 - B0, a1 = li1 - B1;
    const float m1 = fmaxf(a0, a1); float mx = m1;
#pragma unroll
    for (int o = 1; o < 64; o <<= 1) { const float t = __shfl_up(mx, o); if (lane >= o) mx = fmaxf(mx, t); }
    float mprev = __shfl_up(mx, 1); if (lane == 0) mprev = -1e30f;
    Bq[e0] = B0; Bq[e1] = B1; av[e0] = a0; av[e1] = a1; pm[e0] = fmaxf(mprev, a0); pm[e1] = mx;
    total = __shfl(inc, 63); amax = __shfl(mx, 63);
}

DEVI void conv_silu8(const u32x4& xm, const u32x4& x0, const u32x4& xp, const float* wc, bool hasm, bool hasp, float (&out)[8]) {
#pragma unroll
    for (int j = 0; j < 4; ++j) {
        const float w00 = wc[2 * j], w01 = wc[2 * j + 1], w10 = wc[1024 + 2 * j], w11 = wc[1024 + 2 * j + 1], w20 = wc[2048 + 2 * j], w21 = wc[2048 + 2 * j + 1];
        float a = w10 * bflo(x0[j]), b = w11 * bfhi(x0[j]);
        if (hasm) { a = fmaf(w00, bflo(xm[j]), a); b = fmaf(w01, bfhi(xm[j]), b); }
        if (hasp) { a = fmaf(w20, bflo(xp[j]), a); b = fmaf(w21, bfhi(xp[j]), b); }
        out[2 * j] = siluf_(a); out[2 * j + 1] = siluf_(b);
    }
}
DEVI void seg_edges(int t  , bool& hasm, bool& hasp) {
    hasm = !(t == 0 || t == TC); hasp = !(t == TC - 1 || t == TT - 1);
}
DEVI int chain_slot(int dir, int b, int h, int cc) { return ((dir * 2 + b) * 4 + h) * NCH + cc; }

DEVI void phase_mlstm_a(const P& p, char* lds) {
    const int tid = threadIdx.x, wid = tid >> 6, lane = tid & 63, r32 = lane & 31, hi = lane >> 5;
    char* Vimg = lds; char* Kf = lds + 32768; char* Kb = lds + 65536;
    float* arr = (float*)(lds + 98304);
    const float* gates = (const float*)(p.ws + OFF_GATES);
    const u16* MLQK = (const u16*)(p.ws + OFF_MLQK); const u16* MLV = (const u16*)(p.ws + OFF_MLV);
    u16* CST = (u16*)(p.ws + OFF_CST); float* NST = (float*)(p.ws + OFF_NST);
    float2* scal = (float2*)(p.ws + OFF_MSCAL);
    for (int it = blockIdx.x; it < NB * 4 * NCH; it += gridDim.x) {
        const int cc = it % NCH, h = (it / NCH) & 3, b = it / (NCH * 4);
        const int row0 = b * TT + cc * 128;
        __syncthreads();
        if (wid < 2) {
            float total, amax; float* a4 = arr + wid * 512;
            chunk_scan(gates, row0, h, wid, a4, a4 + 128, a4 + 256, total, amax);
            a4[384 + lane] = __expf(a4[128 + lane] - amax); a4[384 + 64 + lane] = __expf(a4[128 + 64 + lane] - amax);
            if (lane == 0) scal[chain_slot(wid, b, h, 0) + cc] = make_float2(total + amax, total);
        }
        __syncthreads();
#pragma unroll
        for (int i = 0; i < 4; ++i) {
            const int idx = tid + 512 * i, l = idx >> 4, c = (idx & 15) * 8;
            const u32x4 v = *reinterpret_cast<const u32x4*>(MLV + (size_t)(row0 + l) * 512 + h * 128 + c);
            *reinterpret_cast<u32x4*>(Vimg + (l >> 6) * 16384 + v_st(l & 63, c)) = v;
            const int t = cc * 128 + l; bool hasm, hasp; seg_edges(t, hasm, hasp);
            const u16* kp = MLQK + (size_t)(row0 + l) * 1024 + 512 + h * 128 + c;
            const u32x4 x0 = *reinterpret_cast<const u32x4*>(kp);
            const u32x4 xm = hasm ? *reinterpret_cast<const u32x4*>(kp - 1024) : x0;
            const u32x4 xp = hasp ? *reinterpret_cast<const u32x4*>(kp + 1024) : x0;
            float kv[8]; conv_silu8(xm, x0, xp, p.conv_w + 512 + h * 128 + c, hasm, hasp, kv);
            const float wf = arr[384 + l] * 0.08838834764831845f, wb = arr[512 + 384 + l] * 0.08838834764831845f;
            u32x4 of, ob;
#pragma unroll
            for (int j = 0; j < 4; ++j) { of[j] = cvtpk(kv[2 * j] * wf, kv[2 * j + 1] * wf); ob[j] = cvtpk(kv[2 * j] * wb, kv[2 * j + 1] * wb); }
            *reinterpret_cast<u32x4*>(Kf + (l >> 6) * 16384 + v_st(l & 63, c)) = of;
            *reinterpret_cast<u32x4*>(Kb + (l >> 6) * 16384 + v_st(l & 63, c)) = ob;
        }
        __syncthreads();
        const int dir = wid >> 2, vblk = wid & 3;
        const int va = (int)(uintptr_t)Vimg + v_rd_base(lane), ka = (int)(uintptr_t)(dir ? Kb : Kf) + v_rd_base(lane);
        f32x16 acc[4] = {};
#define ASTEP(H, KS) do { s16x4 al_, ah_, b0l, b0h, b1l, b1h, b2l, b2h, b3l, b3h; \
        if (vblk == 0) tr_frag_issue<0, KS>(va + (H) * 16384, al_, ah_); else if (vblk == 1) tr_frag_issue<1, KS>(va + (H) * 16384, al_, ah_); \
        else if (vblk == 2) tr_frag_issue<2, KS>(va + (H) * 16384, al_, ah_); else tr_frag_issue<3, KS>(va + (H) * 16384, al_, ah_); \
        tr_frag_issue<0, KS>(ka + (H) * 16384, b0l, b0h); tr_frag_issue<1, KS>(ka + (H) * 16384, b1l, b1h); \
        tr_frag_issue<2, KS>(ka + (H) * 16384, b2l, b2h); tr_frag_issue<3, KS>(ka + (H) * 16384, b3l, b3h); LGKM0(); \
        const bf16x8 af = PKLH(al_, ah_); \
        acc[0] = __builtin_amdgcn_mfma_f32_32x32x16_bf16(af, PKLH(b0l, b0h), acc[0], 0, 0, 0); \
        acc[1] = __builtin_amdgcn_mfma_f32_32x32x16_bf16(af, PKLH(b1l, b1h), acc[1], 0, 0, 0); \
        acc[2] = __builtin_amdgcn_mfma_f32_32x32x16_bf16(af, PKLH(b2l, b2h), acc[2], 0, 0, 0); \
        acc[3] = __builtin_amdgcn_mfma_f32_32x32x16_bf16(af, PKLH(b3l, b3h), acc[3], 0, 0, 0); } while (0)
        ASTEP(0, 0); ASTEP(0, 1); ASTEP(0, 2); ASTEP(0, 3); ASTEP(1, 0); ASTEP(1, 1); ASTEP(1, 2); ASTEP(1, 3);
#undef ASTEP
        u16* Cd = CST + (size_t)chain_slot(dir, b, h, cc) * 16384;
#pragma unroll
        for (int kb = 0; kb < 4; ++kb)
#pragma unroll
            for (int r = 0; r < 16; ++r) Cd[(vblk * 32 + crow(r, hi)) * 128 + kb * 32 + r32] = f2bf(acc[kb][r]);
        if (tid < 256) {
            const int d2 = tid >> 7, k = tid & 127; const char* img = d2 ? Kb : Kf; float s = 0.f;
            for (int l = 0; l < 128; ++l) s += bf2f(*reinterpret_cast<const u16*>(img + (l >> 6) * 16384 + v_st(l & 63, k & ~7) + (k & 7) * 2));
            NST[(size_t)chain_slot(d2, b, h, cc) * 128 + k] = s;
        }
    }
}

DEVI int proc_chunk(int dir, int i) { return dir == 0 ? i : (i == 0 ? 1 : (i == 1 ? 0 : NCH + 1 - i)); }

DEVI void phase_mlstm_b(const P& p, char* lds) {
    const int tid = threadIdx.x;
    float* dec = (float*)lds; float* scl = dec + 160; float* mst = scl + 160;
    const float2* scal = (const float2*)(p.ws + OFF_MSCAL);
    u32* CST = (u32*)(p.ws + OFF_CST); float* NST = (float*)(p.ws + OFF_NST); float* MST = (float*)(p.ws + OFF_MST);
    for (int it = blockIdx.x; it < 16 * 16; it += gridDim.x) {
        const int chain = it >> 4, sub = it & 15, dir = chain >> 3;
        __syncthreads();
        if (tid == 0) {
            float m = 0.f;
            for (int i = 0; i < NCH; ++i) {
                const int cc = proc_chunk(dir, i); const float2 s = scal[chain * NCH + cc];
                const float mn = fmaxf(s.y + m, s.x);
                dec[i] = __expf(s.y + m - mn); scl[i] = __expf(s.x - mn); mst[i] = m;
                if (sub == 0) MST[chain * NCH + cc] = m;
                m = mn;
            }
        }
        __syncthreads();
        u32* base = CST + (size_t)chain * NCH * 8192 + sub * 512 + tid;
        float s0 = 0.f, s1 = 0.f;
        for (int i0 = 0; i0 < NCH; i0 += 10) {
            u32 v[10];
#pragma unroll
            for (int j = 0; j < 10; ++j) v[j] = base[(size_t)proc_chunk(dir, i0 + j) * 8192];
#pragma unroll
            for (int j = 0; j < 10; ++j) {
                base[(size_t)proc_chunk(dir, i0 + j) * 8192] = cvtpk(s0, s1);
                const float d = dec[i0 + j], sc = scl[i0 + j];
                s0 = fmaf(d, s0, sc * bflo(v[j])); s1 = fmaf(d, s1, sc * bfhi(v[j]));
            }
        }
        if (sub == 0 && tid < 128) {
            float* nb = NST + (size_t)chain * NCH * 128 + tid; float s = 0.f;
            for (int i = 0; i < NCH; ++i) { const int cc = proc_chunk(dir, i); const float v = nb[cc * 128]; nb[cc * 128] = s; s = fmaf(dec[i], s, scl[i] * v); }
        }
    }
}

DEVI void mlstm_c_item(const P& p, int it, char* lds) {
    const int tid = threadIdx.x, wid = tid >> 6, lane = tid & 63, r32 = lane & 31, hi = lane >> 5;
    const int cc = it % NCH, h = (it / NCH) & 3, b = it / (NCH * 4);
    const int row0 = b * TT + cc * 128;
    char* Kt = lds; char* Vimg = lds + 34816; char* Ct = lds + 67584;
    float* arr = (float*)(lds + 137216);
    float* wsc = arr + 1024 + wid * 64;
    float* xb = (float*)lds;
    const float* gates = (const float*)(p.ws + OFF_GATES);
    const u16* MLQK = (const u16*)(p.ws + OFF_MLQK); const u16* MLV = (const u16*)(p.ws + OFF_MLV);
    const u16* CST = (const u16*)(p.ws + OFF_CST); const float* NST = (const float*)(p.ws + OFF_NST); const float* MST = (const float*)(p.ws + OFF_MST);
    __syncthreads();
    if (wid < 2) { float total, amax; float* a4 = arr + wid * 512; chunk_scan(gates, row0, h, wid, a4, a4 + 128, a4 + 256, total, amax); }
    else if (wid < 6) { const int d2 = (wid - 2) >> 1, k = ((wid - 2) & 1) * 64 + lane; arr[d2 * 512 + 384 + k] = NST[(size_t)chain_slot(d2, b, h, cc) * 128 + k]; }
#pragma unroll
    for (int i = 0; i < 4; ++i) {
        const int idx = tid + 512 * i, l = idx >> 4, ch = idx & 15, c = ch * 8;
        const u32x4 v = *reinterpret_cast<const u32x4*>(MLV + (size_t)(row0 + l) * 512 + h * 128 + c);
        *reinterpret_cast<u32x4*>(Vimg + (l >> 6) * 16384 + v_st(l & 63, c)) = v;
        const int t = cc * 128 + l; bool hasm, hasp; seg_edges(t, hasm, hasp);
        const u16* kp = MLQK + (size_t)(row0 + l) * 1024 + 512 + h * 128 + c;
        const u32x4 x0 = *reinterpret_cast<const u32x4*>(kp);
        const u32x4 xm = hasm ? *reinterpret_cast<const u32x4*>(kp - 1024) : x0;
        const u32x4 xp = hasp ? *reinterpret_cast<const u32x4*>(kp + 1024) : x0;
        float kv[8]; conv_silu8(xm, x0, xp, p.conv_w + 512 + h * 128 + c, hasm, hasp, kv);
        u32x4 ok;
#pragma unroll
        for (int j = 0; j < 4; ++j) ok[j] = cvtpk(kv[2 * j] * 0.08838834764831845f, kv[2 * j + 1] * 0.08838834764831845f);
        *reinterpret_cast<u32x4*>(Kt + swz256(l, ch)) = ok;
#pragma unroll
        for (int d2 = 0; d2 < 2; ++d2) {
            const u32x4 cv = *reinterpret_cast<const u32x4*>(CST + (size_t)chain_slot(d2, b, h, cc) * 16384 + l * 128 + c);
            *reinterpret_cast<u32x4*>(Ct + d2 * 34816 + swz256(l, ch)) = cv;
        }
    }
    const int dir = wid >> 2, qb = wid & 3, q = qb * 32 + r32;
    bf16x8 qr[8];
    {
        const int t = cc * 128 + q; bool hasm, hasp; seg_edges(t, hasm, hasp);
        const u16* qp = MLQK + (size_t)(row0 + q) * 1024 + h * 128 + hi * 8;
#pragma unroll
        for (int d0 = 0; d0 < 8; ++d0) {
            const u32x4 x0 = *reinterpret_cast<const u32x4*>(qp + d0 * 16);
            const u32x4 xm = hasm ? *reinterpret_cast<const u32x4*>(qp + d0 * 16 - 1024) : x0;
            const u32x4 xp = hasp ? *reinterpret_cast<const u32x4*>(qp + d0 * 16 + 1024) : x0;
            float qv[8]; conv_silu8(xm, x0, xp, p.conv_w + h * 128 + d0 * 16 + hi * 8, hasm, hasp, qv);
            u32x4 w; w[0] = cvtpk(qv[0], qv[1]); w[1] = cvtpk(qv[2], qv[3]); w[2] = cvtpk(qv[4], qv[5]); w[3] = cvtpk(qv[6], qv[7]);
            qr[d0] = *reinterpret_cast<bf16x8*>(&w);
        }
    }
    __syncthreads();
    const float* a4 = arr + dir * 512;
    const float m_st = MST[chain_slot(dir, b, h, 0) + cc];
    const float Mq = fmaxf(m_st, a4[256 + q]);
    const float inter = __expf(m_st - Mq);
    float nq = 0.f;
#pragma unroll
    for (int d0 = 0; d0 < 8; ++d0) {
        const u32x4 w = *reinterpret_cast<const u32x4*>(&qr[d0]); const float* nn = a4 + 384 + d0 * 16 + hi * 8;
#pragma unroll
        for (int j = 0; j < 4; ++j) { nq = fmaf(bflo(w[j]), nn[2 * j], nq); nq = fmaf(bfhi(w[j]), nn[2 * j + 1], nq); }
    }
    { auto rr = __builtin_amdgcn_permlane32_swap(__float_as_uint(nq), __float_as_uint(nq), false, false); nq = __uint_as_float(rr[0]) + __uint_as_float(rr[1]); }
    f32x16 o[4] = {};
    const char* Cm = Ct + dir * 34816;
#pragma unroll
    for (int dk = 0; dk < 8; ++dk)
#pragma unroll
        for (int d0 = 0; d0 < 4; ++d0) o[d0] = __builtin_amdgcn_mfma_f32_32x32x16_bf16(qr[dk], lds_b128(Cm, swz256(d0 * 32 + r32, 2 * dk + hi)), o[d0], 0, 0, 0);
    if (hi == 0) wsc[r32] = inter;
    asm volatile("s_waitcnt lgkmcnt(0)" ::: "memory");
#pragma unroll
    for (int d0 = 0; d0 < 4; ++d0)
#pragma unroll
        for (int r = 0; r < 16; ++r) o[d0][r] *= wsc[crow(r, hi)];
    const int vb = (int)(uintptr_t)Vimg + v_rd_base(lane);
    float rs = 0.f;
#define KBLK(KB) do { if (dir == 0 ? (KB) <= qb : (KB) >= qb) { \
        f32x16 pp = {}; \
        _Pragma("unroll") for (int d0 = 0; d0 < 8; ++d0) pp = __builtin_amdgcn_mfma_f32_32x32x16_bf16(lds_b128(Kt, swz256((KB) * 32 + r32, 2 * d0 + hi)), qr[d0], pp, 0, 0, 0); \
        _Pragma("unroll") for (int g = 0; g < 4; ++g) { const f32x4 av4 = *reinterpret_cast<const f32x4*>(a4 + 128 + (KB) * 32 + 8 * g + 4 * hi); \
            _Pragma("unroll") for (int j = 0; j < 4; ++j) { const int key = (KB) * 32 + 8 * g + 4 * hi + j; const bool ok = dir == 0 ? key <= q : key >= q; \
                const float sv = ok ? pp[4 * g + j] * __expf(av4[j] - Mq) : 0.f; pp[4 * g + j] = sv; rs += sv; } } \
        bf16x8 f0, f1; pack_p(pp, f0, f1); \
        { s16x4 l0, h0, l1, h1, l2, h2, l3, h3; constexpr int HH = (KB) >> 1, K0 = ((KB) & 1) * 2; \
          tr_frag_issue<0, K0>(vb + HH * 16384, l0, h0); tr_frag_issue<1, K0>(vb + HH * 16384, l1, h1); tr_frag_issue<2, K0>(vb + HH * 16384, l2, h2); tr_frag_issue<3, K0>(vb + HH * 16384, l3, h3); LGKM0(); \
          o[0] = __builtin_amdgcn_mfma_f32_32x32x16_bf16(f0, PKLH(l0, h0), o[0], 0, 0, 0); o[1] = __builtin_amdgcn_mfma_f32_32x32x16_bf16(f0, PKLH(l1, h1), o[1], 0, 0, 0); \
          o[2] = __builtin_amdgcn_mfma_f32_32x32x16_bf16(f0, PKLH(l2, h2), o[2], 0, 0, 0); o[3] = __builtin_amdgcn_mfma_f32_32x32x16_bf16(f0, PKLH(l3, h3), o[3], 0, 0, 0); \
          tr_frag_issue<0, K0 + 1>(vb + HH * 16384, l0, h0); tr_frag_issue<1, K0 + 1>(vb + HH * 16384, l1, h1); tr_frag_issue<2, K0 + 1>(vb + HH * 16384, l2, h2); tr_frag_issue<3, K0 + 1>(vb + HH * 16384, l3, h3); LGKM0(); \
          o[0] = __builtin_amdgcn_mfma_f32_32x32x16_bf16(f1, PKLH(l0, h0), o[0], 0, 0, 0); o[1] = __builtin_amdgcn_mfma_f32_32x32x16_bf16(f1, PKLH(l1, h1), o[1], 0, 0, 0); \
          o[2] = __builtin_amdgcn_mfma_f32_32x32x16_bf16(f1, PKLH(l2, h2), o[2], 0, 0, 0); o[3] = __builtin_amdgcn_mfma_f32_32x32x16_bf16(f1, PKLH(l3, h3), o[3], 0, 0, 0); } } } while (0)
    KBLK(0); KBLK(1); KBLK(2); KBLK(3);
#undef KBLK
    { auto rr = __builtin_amdgcn_permlane32_swap(__float_as_uint(rs), __float_as_uint(rs), false, false); rs = __uint_as_float(rr[0]) + __uint_as_float(rr[1]); }
    const float nqt = inter * nq + rs;
    const float den = fmaxf(fabsf(nqt), __expf(-(a4[q] + Mq)));
    if (hi == 0) wsc[32 + r32] = 1.f / den;
    asm volatile("s_waitcnt lgkmcnt(0)" ::: "memory");
#pragma unroll
    for (int d0 = 0; d0 < 4; ++d0)
#pragma unroll
        for (int r = 0; r < 16; ++r) o[d0][r] *= wsc[32 + crow(r, hi)];
    __syncthreads();
    if (dir == 1) {
#pragma unroll
        for (int d0 = 0; d0 < 4; ++d0)
#pragma unroll
            for (int r = 0; r < 16; ++r) xb[(qb * 32 + crow(r, hi)) * 128 + d0 * 32 + r32] = o[d0][r];
    }
    __syncthreads();
    if (dir == 0) {
        const u16* OG = (const u16*)(p.ws + OFF_OG); u16* mix = (u16*)(p.ws + OFF_ACT);
#pragma unroll
        for (int d0 = 0; d0 < 4; ++d0)
#pragma unroll
            for (int r = 0; r < 16; ++r) {
                const int ql = qb * 32 + crow(r, hi), v = d0 * 32 + r32;
                const float hv = o[d0][r] + xb[ql * 128 + v];
                const float og = bf2f(OG[(size_t)(row0 + ql) * 512 + h * 128 + v]);
                mix[(size_t)(row0 + ql) * 1024 + 512 + h * 128 + v] = f2bf(hv * og);
            }
    }
}

DEVI void phase_attn(const P& p, char* lds) {
    const int G = gridDim.x;
    for (int it = blockIdx.x; it < 520; it += G) {
        int q0, k0, seq, h;
        if (it < 512) {
            int bh, qb;
            if ((G & 7) == 0) { bh = it & 7; qb = it >> 3; } else { bh = it >> 6; qb = it & 63; }
            const int b = bh >> 2; h = bh & 3; q0 = b * TT + TC + qb * 256; k0 = b * TT; seq = TT;
        } else { const int b = (it - 512) >> 2; h = (it - 512) & 3; q0 = b * TT; k0 = b * TT; seq = TC; }
        diffattn_item(p, q0, k0, seq, h, lds);
    }
}
DEVI void phase_mlstm_c(const P& p, char* lds) {
    for (int it = blockIdx.x; it < NB * 4 * NCH; it += gridDim.x) mlstm_c_item(p, it, lds);
}

DEVI void phase_convert_l1(const P& p, char* lds) {
    for (int it = blockIdx.x; it < N0_EXP; it += gridDim.x) convert_expert_item(p, 1, it, (float*)lds);
}

constexpr int NPHASE = 19;
__global__ void __launch_bounds__(NTHR, 2) fwd_kernel(P p_) {
    extern __shared__ __attribute__((aligned(16))) char lds[];
    volatile LAS unsigned* st = (volatile LAS unsigned*)(lds + LDS_BYTES - 16);
    if (threadIdx.x == 0) { st[0] = 0u; st[1] = 0u; st[2] = 0u; st[3] = 0u; }
    __syncthreads();
    const int lo = p_.ph_lo, hi = p_.ph_hi;
    XcdBarrier bar; bar.bar = (unsigned*)(p_.ws + OFF_BAR); bar.x = 0; bar.st = st;
    if (hi - lo > 1) bar = xcd_barrier_post((unsigned*)(p_.ws + OFF_BAR), st);
#define PARAMS() const char* kp_ = (const char*)__builtin_amdgcn_kernarg_segment_ptr(); asm volatile("" : "+s"(kp_)); const P& p = *(const P*)kp_
#ifndef PHSEL
#define PHON(k) true
#else
#define PHON(k) ((k) == PHSEL)
#endif
#define IN(k) (lo <= (k) && (k) < hi)
#define SEAM(k) do { if (IN(k) && IN((k) + 1)) xcd_barrier(bar); } while (0)
    if (PHON(0) && IN(0)) { PARAMS(); phase_prologue(p, lds); }            SEAM(0);
    if (PHON(1) && IN(1)) { PARAMS(); phase_norm<0>(p, lds); }             SEAM(1);
    if (PHON(2) && IN(2)) { PARAMS(); phase_inproj(p, lds); }              SEAM(2);
    if (PHON(3) && IN(3)) { PARAMS(); phase_mlstm_a(p, lds); }             SEAM(3);
    if (PHON(4) && IN(4)) { PARAMS(); phase_mlstm_b(p, lds); }             SEAM(4);
    if (PHON(5) && IN(5)) { PARAMS(); phase_attn(p, lds); }                SEAM(5);
    if (PHON(6) && IN(6)) { PARAMS(); phase_mlstm_c(p, lds); }             SEAM(6);
    if (PHON(7) && IN(7)) { PARAMS(); phase_outproj(p, lds); }             SEAM(7);
    if (PHON(8) && IN(8)) { PARAMS(); phase_norm<1>(p, lds); }             SEAM(8);
    if (PHON(9) && IN(9)) { PARAMS(); phase_moe_up(p, 0, lds); }           SEAM(9);
    if (PHON(10) && IN(10)) { PARAMS(); phase_moe_down(p, 0, lds); }        SEAM(10);
    if (PHON(11) && IN(11)) { PARAMS(); phase_norm<2>(p, lds); phase_convert_l1(p, lds); } SEAM(11);
    if (PHON(12) && IN(12)) { PARAMS(); phase_fnet_gemm(p, lds); }          SEAM(12);
    if (PHON(13) && IN(13)) { PARAMS(); phase_fft1(p, lds); }               SEAM(13);
    if (PHON(14) && IN(14)) { PARAMS(); phase_fft2(p, lds); }               SEAM(14);
    if (PHON(15) && IN(15)) { PARAMS(); phase_norm<3>(p, lds); }            SEAM(15);
    if (PHON(16) && IN(16)) { PARAMS(); phase_moe_up(p, 1, lds); }          SEAM(16);
    if (PHON(17) && IN(17)) { PARAMS(); phase_moe_down(p, 1, lds); }        SEAM(17);
    if (PHON(18) && IN(18)) { PARAMS(); phase_norm<4>(p, lds); }
#undef IN
#undef SEAM
}

#ifndef ONE_LAUNCH
#define ONE_LAUNCH 0
#endif
extern "C" void kernel_launch(void* const* d_in, const int* in_sizes, int n_in, void* d_out, int out_size, void* d_ws, size_t ws_size, hipStream_t stream) {
    static int grid = 0;
    if (grid == 0) {
        if (n_in != 21 || out_size != NLAT * DM || ws_size < OFF_END) { fprintf(stderr, "kernel_launch: unexpected shapes (n_in %d out %d ws %zu need %zu)\n", n_in, out_size, ws_size, (size_t)OFF_END); grid = -1; return; }
        int dev = 0, cus = 0;
        if (hipGetDevice(&dev) != hipSuccess || hipDeviceGetAttribute(&cus, hipDeviceAttributeMultiprocessorCount, dev) != hipSuccess) { grid = -1; return; }
        if (hipFuncSetAttribute((const void*)fwd_kernel, hipFuncAttributeMaxDynamicSharedMemorySize, LDS_BYTES) != hipSuccess) { fprintf(stderr, "kernel_launch: hipFuncSetAttribute failed\n"); grid = -1; return; }
        int per_cu = 0;
        if (hipOccupancyMaxActiveBlocksPerMultiprocessor(&per_cu, (const void*)fwd_kernel, NTHR, LDS_BYTES) != hipSuccess || per_cu < 1) { fprintf(stderr, "kernel_launch: occupancy query says %d\n", per_cu); (void)hipGetLastError(); grid = -1; return; }
        grid = cus;
    }
    if (grid < 0) return;
    (void)hipMemsetAsync(d_ws, 0, ZERO_BYTES, stream);
    P p{};
    const float* const* in = (const float* const*)d_in;
    p.x = in[0]; p.c = in[1]; p.ctx = in[2]; p.c_ctx = in[3]; p.ada_w = in[4]; p.ada_b = in[5]; p.nmix_g = in[6]; p.nffn_g = in[7];
    p.w_in = in[8]; p.w_out = in[9]; p.conv_w = in[10]; p.gate_b = in[11]; p.lamv = in[12]; p.subln_g = in[13]; p.w_fnet = in[14];
    p.router_w = in[15]; p.router_b = in[16]; p.w_gate = in[17]; p.w_up = in[18]; p.w_down = in[19]; p.final_g = in[20];
    p.out = (float*)d_out; p.ws = (char*)d_ws;
#if ONE_LAUNCH
    p.ph_lo = 0; p.ph_hi = NPHASE;
    hipLaunchKernelGGL(fwd_kernel, dim3(grid), dim3(NTHR), LDS_BYTES, stream, p);
#else
    for (int k = 0; k < NPHASE; ++k) { p.ph_lo = k; p.ph_hi = k + 1; hipLaunchKernelGGL(fwd_kernel, dim3(grid), dim3(NTHR), LDS_BYTES, stream, p); }
#endif
}
```

```cpp
#include <hip/hip_runtime.h>
#include <stdint.h>
#include <stdio.h>

#define DEVI __device__ __forceinline__
typedef unsigned short u16;
typedef unsigned int u32;
using bf16x8 = __attribute__((ext_vector_type(8))) short;
using s16x4  = __attribute__((ext_vector_type(4))) short;
using f32x16 = __attribute__((ext_vector_type(16))) float;
using f32x4  = __attribute__((ext_vector_type(4))) float;
using u32x4  = __attribute__((ext_vector_type(4))) unsigned;
using u32x2  = __attribute__((ext_vector_type(2))) unsigned;

constexpr int DM = 1024, NB = 2, TL = 16384, TC = 256, TT = TL + TC, NTOK = NB * TT, NLAT = NB * TL;
constexpr int NCH = TT / 128;
constexpr int NTHR = 512;
constexpr int LDS_BYTES = 147456;

constexpr size_t al256(size_t x) { return (x + 255) / 256 * 256; }
constexpr size_t OFF_BAR   = 0;
constexpr size_t OFF_CNT   = 16384;
constexpr size_t ZERO_BYTES = 20480;
constexpr size_t OFF_MOD   = ZERO_BYTES;
constexpr size_t OFF_ROPER = OFF_MOD + al256(2 * 3 * 6144 * 4);
constexpr size_t OFF_ROPEC = OFF_ROPER + 256 * 16 * 8;
constexpr size_t OFF_TW    = OFF_ROPEC + 64 * 16 * 8;
constexpr size_t OFF_DFTC  = OFF_TW + 16384 * 8;
constexpr size_t OFF_DFTS  = OFF_DFTC + 32768;
constexpr size_t OFF_LAM   = OFF_DFTS + 32768;
constexpr size_t OFF_WG16  = OFF_LAM + 256;
constexpr size_t OFF_MSCAL = OFF_WG16 + 65536;
constexpr size_t OFF_MST   = OFF_MSCAL + al256(16 * NCH * 8);
constexpr size_t OFF_WINT  = OFF_MST + al256(16 * NCH * 4);
constexpr size_t OFF_WOUTT = OFF_WINT + (size_t)3584 * 1024 * 2;
constexpr size_t OFF_FNT   = OFF_WOUTT + (size_t)1024 * 1024 * 2;
constexpr size_t OFF_WGU   = OFF_FNT + (size_t)2048 * 1024 * 2;
constexpr size_t OFF_WDT   = OFF_WGU + (size_t)16 * 1024 * 1024 * 2;
constexpr size_t OFF_ACT   = OFF_WDT + (size_t)16 * 1024 * 512 * 2;
constexpr size_t SZ_ACT    = (size_t)NTOK * 1024 * 2;
constexpr size_t OFF_XC    = OFF_ACT + SZ_ACT;
constexpr size_t OFF_GATES = OFF_XC + (size_t)NB * TC * 1024 * 4;
constexpr size_t OFF_TOKW  = OFF_GATES + (size_t)NTOK * 16 * 4;
constexpr size_t OFF_LIST  = OFF_TOKW + al256((size_t)NTOK * 8);
constexpr size_t OFF_NST   = OFF_LIST + (size_t)24 * NTOK * 4;
constexpr size_t OFF_CST   = OFF_NST + (size_t)16 * NCH * 128 * 4;
constexpr size_t SZ_CST    = (size_t)16 * NCH * 16384 * 2;
constexpr size_t OFF_BIG   = OFF_CST + SZ_CST;
constexpr size_t OFF_Q     = OFF_BIG;
constexpr size_t OFF_K     = OFF_Q + (size_t)NTOK * 512 * 2;
constexpr size_t OFF_V     = OFF_K + (size_t)NTOK * 512 * 2;
constexpr size_t OFF_MLQK  = OFF_V + (size_t)NTOK * 512 * 2;
constexpr size_t OFF_MLV   = OFF_MLQK + (size_t)NTOK * 1024 * 2;
constexpr size_t OFF_OG    = OFF_MLV + (size_t)NTOK * 512 * 2;
constexpr size_t OFF_END   = OFF_OG + (size_t)NTOK * 512 * 2;
constexpr size_t OFF_HE    = OFF_BIG;
constexpr size_t OFF_ZR    = OFF_BIG;
constexpr size_t OFF_ZI    = OFF_ZR + (size_t)NLAT * 1024 * 2;
constexpr size_t OFF_YR    = OFF_CST;
constexpr size_t OFF_YI    = OFF_ACT;
static_assert((size_t)NLAT * 1024 * 2 <= SZ_CST && (size_t)NLAT * 1024 * 2 <= SZ_ACT, "alias sizes");
static_assert(OFF_END < (size_t)500 * 1024 * 1024, "workspace");

struct P {
    const float *x, *c, *ctx, *c_ctx, *ada_w, *ada_b, *nmix_g, *nffn_g, *w_in, *w_out, *conv_w, *gate_b, *lamv, *subln_g,
                *w_fnet, *router_w, *router_b, *w_gate, *w_up, *w_down, *final_g;
    float* out;
    char* ws;
    int ph_lo, ph_hi;
};

#define XB_TMO      128
#define XB_XCNT(j)  (256  + 64 * (j))
#define XB_XSUB(j)  (1280 + 64 * (j))
#define XB_XGEN(j)  (2304 + 64 * (j))
#define XB_TOP      3328
#define XB_TOPGEN   3392
#define XCD_BAR_WORDS 3456
#define XB_SPIN_CAP (1u << 18)
#define LAS __attribute__((address_space(3)))

__device__ __forceinline__ unsigned xb_ld(unsigned* p)              { return __hip_atomic_load(p, __ATOMIC_RELAXED, __HIP_MEMORY_SCOPE_AGENT); }
__device__ __forceinline__ unsigned xb_add(unsigned* p, unsigned v) { return __hip_atomic_fetch_add(p, v, __ATOMIC_RELAXED, __HIP_MEMORY_SCOPE_AGENT); }
__device__ __forceinline__ unsigned xb_xcc_id() { return (unsigned)__builtin_amdgcn_s_getreg((3 << 11) | 20) & 0xFu; }
#define XB_SPIN(cond, bar) do { unsigned _sp = 0; while (cond) { __builtin_amdgcn_s_sleep(1); \
    if ((++_sp & 255u) == 0u) { if (xb_ld(&(bar)[XB_TMO])) break; if (_sp > XB_SPIN_CAP) { atomicAdd(&(bar)[XB_TMO], 1u); break; } } } } while (0)

struct XcdBarrier { unsigned* bar; unsigned x; volatile LAS unsigned* st; };

__device__ __forceinline__ XcdBarrier xcd_barrier_post(unsigned* bar, volatile LAS unsigned* st) {
    XcdBarrier b; b.bar = bar; b.x = xb_xcc_id(); b.st = st;
    if (threadIdx.x == 0) (void)xb_add(&bar[XB_XCNT(b.x)], 1u);
    return b;
}
__device__ __forceinline__ void xcd_barrier_complete(unsigned* bar, unsigned x, unsigned& nloc, unsigned& nx) {
    const unsigned G = gridDim.x * gridDim.y * gridDim.z;
    unsigned sum, cnt, mine, sp = 0u;
    for (;;) {
        sum = 0u; cnt = 0u; mine = 0u;
#pragma unroll
        for (unsigned j = 0; j < 16; ++j) { const unsigned c = xb_ld(&bar[XB_XCNT(j)]); sum += c; cnt += (c > 0u) ? 1u : 0u; mine = (j == x) ? c : mine; }
        if (sum == G) break;
        __builtin_amdgcn_s_sleep(1);
        if ((++sp & 255u) == 0u) { if (xb_ld(&bar[XB_TMO])) break; if (sp > XB_SPIN_CAP) { atomicAdd(&bar[XB_TMO], 1u); break; } }
    }
    nloc = mine > 0u ? mine : 1u; nx = cnt > 0u ? cnt : 1u;
}
__device__ __forceinline__ void xcd_barrier(const XcdBarrier& b) {
    asm volatile("s_waitcnt vmcnt(0)" ::: "memory");
    __syncthreads();
    if (threadIdx.x == 0) {
        unsigned* bar = b.bar;
        __builtin_amdgcn_s_waitcnt(0);
        unsigned nloc = b.st[0], nx = b.st[1];
        if (nloc == 0u) { xcd_barrier_complete(bar, b.x, nloc, nx); b.st[0] = nloc; b.st[1] = nx; }
        const unsigned old = xb_add(&bar[XB_XSUB(b.x)], 1u);
        const unsigned gen = old / nloc;
        if (old + 1u == (gen + 1u) * nloc) {
            __builtin_amdgcn_fence(__ATOMIC_RELEASE, "agent");
            asm volatile("s_waitcnt vmcnt(0)" ::: "memory");
            const unsigned og = xb_add(&bar[XB_TOP], 1u);
            const unsigned tg = og / nx;
            if (og + 1u == (tg + 1u) * nx) xb_add(&bar[XB_TOPGEN], 1u);
            else XB_SPIN(xb_ld(&bar[XB_TOPGEN]) == tg, bar);
            __builtin_amdgcn_fence(__ATOMIC_ACQUIRE, "agent");
            xb_add(&bar[XB_XGEN(b.x)], 1u);
            asm volatile("s_waitcnt vmcnt(0)" ::: "memory");
        } else {
            XB_SPIN(xb_ld(&bar[XB_XGEN(b.x)]) == gen, bar);
            __builtin_amdgcn_fence(__ATOMIC_ACQUIRE, "agent");
            asm volatile("s_waitcnt vmcnt(0)" ::: "memory");
        }
    }
    __syncthreads();
}

DEVI u16 f2bf(float f) { u32 u = __float_as_uint(f); u += 0x7fffu + ((u >> 16) & 1u); return (u16)(u >> 16); }
DEVI float bf2f(u32 h) { return __uint_as_float(h << 16); }
DEVI u32 cvtpk(float lo, float hi) { u32 r; asm("v_cvt_pk_bf16_f32 %0, %1, %2" : "=v"(r) : "v"(lo), "v"(hi)); return r; }
DEVI float bflo(u32 w) { return __uint_as_float(w << 16); }
DEVI float bfhi(u32 w) { return __uint_as_float(w & 0xffff0000u); }
DEVI int crow(int r, int hi) { return (r & 3) + 8 * (r >> 2) + 4 * hi; }
DEVI float wave_sum(float v) { for (int o = 32; o; o >>= 1) v += __shfl_xor(v, o); return v; }
DEVI float wave_max(float v) { for (int o = 32; o; o >>= 1) v = fmaxf(v, __shfl_xor(v, o)); return v; }
DEVI float sigmoidf_(float x) { return 1.f / (1.f + __expf(-x)); }
DEVI float siluf_(float x) { return x / (1.f + __expf(-x)); }
DEVI float logsigmoidf_(float x) { return fminf(x, 0.f) - log1pf(__expf(-fabsf(x))); }
#define SBAR() __builtin_amdgcn_sched_barrier(0)

DEVI void sincos2pi(double frac, double& s, double& c) {
    frac -= floor(frac);
    double q = rint(frac * 4.0);
    double r = (frac - q * 0.25) * 6.283185307179586476925;
    double r2 = r * r;
    double sr = r * (1.0 + r2 * (-1.0 / 6 + r2 * (1.0 / 120 + r2 * (-1.0 / 5040 + r2 * (1.0 / 362880 + r2 * (-1.0 / 39916800 + r2 * (1.0 / 6227020800.0 + r2 * (-1.0 / 1307674368000.0))))))));
    double cr = 1.0 + r2 * (-0.5 + r2 * (1.0 / 24 + r2 * (-1.0 / 720 + r2 * (1.0 / 40320 + r2 * (-1.0 / 3628800 + r2 * (1.0 / 479001600.0 + r2 * (-1.0 / 87178291200.0 + r2 * (1.0 / 20922789888000.0))))))));
    int qi = ((int)q) & 3;
    if (qi == 0) { s = sr; c = cr; } else if (qi == 1) { s = cr; c = -sr; } else if (qi == 2) { s = -sr; c = -cr; } else { s = -cr; c = sr; }
}

DEVI float* xs_ptr(const P& p, int layer, int tok) {
    if (layer == 0) {
        int b = tok >= TT ? 1 : 0, t = tok - b * TT;
        if (t < TC) return (float*)(p.ws + OFF_XC) + (size_t)(b * TC + t) * DM;
        return p.out + (size_t)(b * TL + t - TC) * DM;
    }
    return p.out + (size_t)tok * DM;
}
DEVI const float* xin_ptr(const P& p, int tok) {
    int b = tok >= TT ? 1 : 0, t = tok - b * TT;
    if (t < TC) return p.ctx + (size_t)(b * TC + t) * DM;
    return p.x + (size_t)(b * TL + t - TC) * DM;
}
DEVI int modsel(int layer, int tok) {
    if (layer == 0) { int b = tok >= TT ? 1 : 0, t = tok - b * TT; return t < TC ? 2 : b; }
    return tok >> 14;
}

DEVI int swz128(int row, int chunk) { return row * 144 + (chunk << 4); }
DEVI int swz256(int row, int chunk) { return row * 272 + (chunk << 4); }
DEVI int v_st(int k, int c) { const int kk = (k & ~0xC) | ((k & 4) << 1) | ((k & 8) >> 1); return ((kk >> 3) * 4 + (c >> 5)) * 512 + ((kk & 7) * 32 + (c & 31)) * 2; }
DEVI int v_rd_base(int lane) { return ((lane & 3) << 3) | (((lane >> 2) & 3) << 6) | (((lane >> 4) & 1) << 5) | (((lane >> 5) & 1) << 8); }
constexpr int v_rd_off(int d0, int ks, int half) { return d0 * 512 + ks * 4096 + half * 2048; }
template <int OFF> DEVI s16x4 tr_read(int vb) {
    s16x4 r; asm volatile("ds_read_b64_tr_b16 %0, %1 offset:%2" : "=&v"(r) : "v"(vb), "i"(OFF) : "memory"); return r;
}
#define PKLH(L, H) (bf16x8){L[0], L[1], L[2], L[3], H[0], H[1], H[2], H[3]}
template <int D0, int KS> DEVI void tr_frag_issue(int vb, s16x4& l, s16x4& h) { l = tr_read<v_rd_off(D0, KS, 0)>(vb); h = tr_read<v_rd_off(D0, KS, 1)>(vb); }
#define LGKM0() do { asm volatile("s_waitcnt lgkmcnt(0)" ::: "memory"); SBAR(); } while (0)

DEVI bf16x8 lds_b128(const char* base, int off) { return *reinterpret_cast<const bf16x8*>(base + off); }

DEVI void pack_p(const f32x16& pp, bf16x8& f0, bf16x8& f1) {
#define PK4(BASE, OUT) do { unsigned a0 = cvtpk(pp[BASE + 0], pp[BASE + 1]), a1 = cvtpk(pp[BASE + 2], pp[BASE + 3]);   \
    unsigned b0 = cvtpk(pp[BASE + 4], pp[BASE + 5]), b1 = cvtpk(pp[BASE + 6], pp[BASE + 7]);                            \
    auto r0 = __builtin_amdgcn_permlane32_swap(a0, b0, false, false); auto r1 = __builtin_amdgcn_permlane32_swap(a1, b1, false, false); \
    u32x4 w = {r0[0], r1[0], r0[1], r1[1]}; OUT = *reinterpret_cast<bf16x8*>(&w); } while (0)
    PK4(0, f0); PK4(8, f1);
#undef PK4
}

constexpr int G_STAGE = 55296;
template <class Epi>
DEVI void gemm_tile(const u16* (&ap)[4], const u16* (&bp0)[2], const u16* (&bp1)[2], int K, int ksplit, char* lds, Epi epi) {
    const int tid = threadIdx.x, lane = tid & 63, wid = tid >> 6, wm = wid >> 1, wn = wid & 1, r32 = lane & 31, hi = lane >> 5;
    const int srow = tid >> 3, sch = tid & 7;
    f32x16 acc[2][2] = {};
    u32x4 ra[4], rb[2];
    const int nk = K / 64;
#define GLOAD(kt) do { const int k0 = (kt) * 64; \
    _Pragma("unroll") for (int i = 0; i < 4; ++i) ra[i] = *reinterpret_cast<const u32x4*>(ap[i] + k0); \
    if (k0 < ksplit) { _Pragma("unroll") for (int i = 0; i < 2; ++i) rb[i] = *reinterpret_cast<const u32x4*>(bp0[i] + k0); } \
    else { _Pragma("unroll") for (int i = 0; i < 2; ++i) rb[i] = *reinterpret_cast<const u32x4*>(bp1[i] + (k0 - ksplit)); } } while (0)
#define GWRITE(st) do { char* sa = lds + (st) * G_STAGE; char* sb = sa + 36864; \
    _Pragma("unroll") for (int i = 0; i < 4; ++i) *reinterpret_cast<u32x4*>(sa + swz128(srow + 64 * i, sch)) = ra[i]; \
    _Pragma("unroll") for (int i = 0; i < 2; ++i) *reinterpret_cast<u32x4*>(sb + swz128(srow + 64 * i, sch)) = rb[i]; } while (0)
    GLOAD(0); GWRITE(0); __syncthreads();
    for (int kt = 0; kt < nk; ++kt) {
        if (kt + 1 < nk) GLOAD(kt + 1);
        const char* sa = lds + (kt & 1) * G_STAGE; const char* sb = sa + 36864;
#pragma unroll
        for (int ks = 0; ks < 4; ++ks) {
            bf16x8 a0 = lds_b128(sa, swz128(wm * 64 + r32, 2 * ks + hi));
            bf16x8 a1 = lds_b128(sa, swz128(wm * 64 + 32 + r32, 2 * ks + hi));
            bf16x8 b0 = lds_b128(sb, swz128(wn * 64 + r32, 2 * ks + hi));
            bf16x8 b1 = lds_b128(sb, swz128(wn * 64 + 32 + r32, 2 * ks + hi));
            acc[0][0] = __builtin_amdgcn_mfma_f32_32x32x16_bf16(a0, b0, acc[0][0], 0, 0, 0);
            acc[0][1] = __builtin_amdgcn_mfma_f32_32x32x16_bf16(a0, b1, acc[0][1], 0, 0, 0);
            acc[1][0] = __builtin_amdgcn_mfma_f32_32x32x16_bf16(a1, b0, acc[1][0], 0, 0, 0);
            acc[1][1] = __builtin_amdgcn_mfma_f32_32x32x16_bf16(a1, b1, acc[1][1], 0, 0, 0);
        }
        if (kt + 1 < nk) GWRITE((kt + 1) & 1);
        __syncthreads();
    }
#undef GLOAD
#undef GWRITE
    epi(acc, wm * 64, wn * 64, r32, hi);
}

template <class PF>
DEVI void transpose_tile(PF colptr, int ldsrc, u16* dst, int lddst, int k0, int n0, float* tl) {
    const int t = threadIdx.x, nn = t & 63, kk = t >> 6;
    const float* sp = colptr(n0 + nn);
#pragma unroll
    for (int i = 0; i < 8; ++i) tl[(kk + 8 * i) * 65 + nn] = sp[(size_t)(k0 + kk + 8 * i) * ldsrc];
    __syncthreads();
    const int n = t >> 3, kc = t & 7;
    u32x4 w;
    w[0] = cvtpk(tl[(kc * 8 + 0) * 65 + n], tl[(kc * 8 + 1) * 65 + n]);
    w[1] = cvtpk(tl[(kc * 8 + 2) * 65 + n], tl[(kc * 8 + 3) * 65 + n]);
    w[2] = cvtpk(tl[(kc * 8 + 4) * 65 + n], tl[(kc * 8 + 5) * 65 + n]);
    w[3] = cvtpk(tl[(kc * 8 + 6) * 65 + n], tl[(kc * 8 + 7) * 65 + n]);
    *reinterpret_cast<u32x4*>(dst + (size_t)(n0 + n) * lddst + k0 + kc * 8) = w;
    __syncthreads();
}

DEVI void convert_expert_item(const P& p, int layer, int it, float* tl) {
    const int e = it / 384, r = it % 384;
    const float* wg = p.w_gate + ((size_t)layer * 16 + e) * 1024 * 512;
    const float* wu = p.w_up   + ((size_t)layer * 16 + e) * 1024 * 512;
    const float* wd = p.w_down + ((size_t)layer * 16 + e) * 512 * 1024;
    if (r < 256) {
        u16* dst = (u16*)(p.ws + OFF_WGU) + (size_t)e * 1024 * 1024;
        const int kt = r >> 4, nt = r & 15;
        transpose_tile([&](int n) { const int ch = n >> 5, i = n & 31; return ((ch & 1) ? wu : wg) + (ch >> 1) * 32 + i; }, 512, dst, 1024, kt * 64, nt * 64, tl);
    } else {
        const int q = r - 256; u16* dst = (u16*)(p.ws + OFF_WDT) + (size_t)e * 1024 * 512;
        const int kt = q >> 4, nt = q & 15;
        transpose_tile([&](int n) { return wd + n; }, 1024, dst, 512, kt * 64, nt * 64, tl);
    }
}

constexpr int N0_WIN = 16 * 56, N0_WOUT = 256, N0_EXP = 16 * 384, N0_FN = 2048, N0_MOD = 192, N0_TAB = 128;
constexpr int N0_TOTAL = N0_WIN + N0_WOUT + N0_EXP + N0_FN + N0_MOD + N0_TAB;

DEVI void phase_prologue(const P& p, char* lds) {
    float* tl = (float*)lds;
    const int tid = threadIdx.x;
    for (int it = blockIdx.x; it < N0_TOTAL; it += gridDim.x) {
        int r = it;
        if (r < N0_WIN) {
            const int kt = r / 56, nt = r % 56;
            const float* w = p.w_in;
            transpose_tile([&](int n) { int sc = n; if (n < 1024) { const int j = n & 63; sc = (n & ~63) + (j < 32 ? 2 * j : 2 * (j - 32) + 1); } return w + sc; },
                           3600, (u16*)(p.ws + OFF_WINT), 1024, kt * 64, nt * 64, tl);
            continue;
        }
        r -= N0_WIN;
        if (r < N0_WOUT) {
            const int kt = r >> 4, nt = r & 15; const float* w = p.w_out;
            transpose_tile([&](int n) { return w + n; }, 1024, (u16*)(p.ws + OFF_WOUTT), 1024, kt * 64, nt * 64, tl);
            continue;
        }
        r -= N0_WOUT;
        if (r < N0_EXP) { convert_expert_item(p, 0, r, tl); continue; }
        r -= N0_EXP;
        if (r < N0_FN) {
            float* cs = tl; float* sn = tl + 256;
            if (tid < 256) { double s, c; sincos2pi(tid / 256.0, s, c); cs[tid] = (float)c; sn[tid] = (float)s; }
            __syncthreads();
            const int idx = r * 512 + tid, n = idx >> 10, k = idx & 1023, g = k >> 8, c = k & 255;
            const float* W = p.w_fnet + (size_t)(g * 256) * 1024 + n;
            float ac = 0.f, as = 0.f;
            for (int c2 = 0; c2 < 256; ++c2) { const float w = W[(size_t)c2 * 1024]; const int j = (c * c2) & 255; ac = fmaf(cs[j], w, ac); as = fmaf(sn[j], w, as); }
            u16* F = (u16*)(p.ws + OFF_FNT);
            F[(size_t)n * 1024 + k] = f2bf(ac * (1.f / 2048.f));
            F[(size_t)(1024 + n) * 1024 + k] = f2bf(-as * (1.f / 2048.f));
            __syncthreads();
            continue;
        }
        r -= N0_FN;
        if (r < N0_MOD) {
            float* sv = tl;
            float* part = tl + 3072;
            for (int i = tid; i < 3072; i += NTHR) { const int v = i >> 10, k = i & 1023; const float xv = v < 2 ? p.c[v * 1024 + k] : p.c_ctx[k]; sv[i] = siluf_(xv); }
            __syncthreads();
            const int j0 = r * 64, L = j0 / 6144, col0 = j0 % 6144, kg = tid >> 6, cl = tid & 63;
            const float* W = p.ada_w + (size_t)L * 1024 * 6144 + col0 + cl;
            float a0 = 0.f, a1 = 0.f, a2 = 0.f;
            for (int k = kg * 128; k < kg * 128 + 128; ++k) { const float w = W[(size_t)k * 6144]; a0 = fmaf(sv[k], w, a0); a1 = fmaf(sv[1024 + k], w, a1); a2 = fmaf(sv[2048 + k], w, a2); }
            part[(kg * 3 + 0) * 64 + cl] = a0; part[(kg * 3 + 1) * 64 + cl] = a1; part[(kg * 3 + 2) * 64 + cl] = a2;
            __syncthreads();
            if (tid < 192) {
                const int v = tid >> 6, c2 = tid & 63; float s = 0.f;
                for (int g = 0; g < 8; ++g) s += part[(g * 3 + v) * 64 + c2];
                ((float*)(p.ws + OFF_MOD))[(size_t)(L * 3 + v) * 6144 + col0 + c2] = s + p.ada_b[L * 6144 + col0 + c2];
            }
            __syncthreads();
            continue;
        }
        r -= N0_MOD;
        {
            const int e = r * 512 + tid;
            if (e < 4096 + 1024) {
                const bool isr = e < 4096; const int ee = isr ? e : e - 4096; const int pos = ee >> 4, j = ee & 15;
                double inv = 1.0; for (int q = 0; q < j; ++q) inv *= 0.56234132519034908;
                const float invf = (float)inv; const float ang = (float)pos * invf;
                double s, c; sincos2pi((double)ang * 0.15915494309189533577, s, c);
                float2 v = make_float2((float)c, (float)s);
                if (isr) ((float2*)(p.ws + OFF_ROPER))[ee] = v; else ((float2*)(p.ws + OFF_ROPEC))[ee] = v;
            } else if (e < 5120 + 16384) {
                const int m = e - 5120; double s, c; sincos2pi(m / 16384.0, s, c);
                ((float2*)(p.ws + OFF_TW))[m] = make_float2((float)c, (float)s);
            } else if (e < 5120 + 32768) {
                const int m = e - 5120 - 16384, k = m >> 7, t = m & 127; double s, c; sincos2pi(((k * t) & 127) / 128.0, s, c);
                ((u16*)(p.ws + OFF_DFTC))[m] = f2bf((float)c); ((u16*)(p.ws + OFF_DFTS))[m] = f2bf((float)s);
            } else if (e < 5120 + 49152) {
                const int m = e - 5120 - 32768, k = m >> 4, g = m & 15;
                ((float*)(p.ws + OFF_WG16))[m] = p.w_in[(size_t)k * 3600 + 3584 + g];
            } else if (e == 5120 + 49152) {
                float s01 = 0.f, s23 = 0.f;
                for (int i = 0; i < 64; ++i) { s01 += p.lamv[i] * p.lamv[64 + i]; s23 += p.lamv[128 + i] * p.lamv[192 + i]; }
                ((float*)(p.ws + OFF_LAM))[0] = expf(s01) - expf(s23) + 0.2f;
            }
        }
    }
}

template <int MODE>
DEVI void phase_norm(const P& p, char* lds) {
    constexpr int layer = (MODE == 0 || MODE == 1) ? 0 : 1;
    constexpr bool side = (MODE == 0 || MODE == 1 || MODE == 3);
    const int nrows = layer == 0 ? NTOK : NLAT;
    const int tid = threadIdx.x, lane = tid & 63, wid = tid >> 6;
    f32x4* sl = (f32x4*)lds;
    if (side) {
        const float* S = (MODE == 0) ? (const float*)(p.ws + OFF_WG16) : p.router_w;
        for (int i = tid; i < 4096; i += NTHR) { const int eg = i >> 10, col = i & 1023; sl[i] = *reinterpret_cast<const f32x4*>(S + col * 16 + eg * 4); }
        __syncthreads();
    }
    const float* g = MODE == 0 ? p.nmix_g : MODE == 1 ? p.nffn_g : MODE == 2 ? p.nmix_g + 1024 : MODE == 3 ? p.nffn_g + 1024 : p.final_g;
    const float* modb = (const float*)(p.ws + OFF_MOD) + (size_t)layer * 3 * 6144;
    constexpr int sh_i = (MODE == 0 || MODE == 2) ? 0 : 3;
    u16* act = (u16*)(p.ws + OFF_ACT);
    for (int row = blockIdx.x * 8 + wid; row < nrows; row += gridDim.x * 8) {
        const float* src = (MODE == 0) ? xin_ptr(p, row) : xs_ptr(p, layer, row);
        float xv[16]; float ss = 0.f;
#pragma unroll
        for (int m = 0; m < 16; ++m) { xv[m] = src[lane + 64 * m]; ss = fmaf(xv[m], xv[m], ss); }
        ss = wave_sum(ss);
        const float rstd = rsqrtf(ss * (1.f / 1024.f) + 1e-6f);
        if (MODE == 4) {
            float* dst = p.out + (size_t)row * DM;
#pragma unroll
            for (int m = 0; m < 16; ++m) dst[lane + 64 * m] = xv[m] * rstd * g[lane + 64 * m];
            continue;
        }
        const float* mv = modb + (size_t)modsel(layer, row) * 6144;
        float acc[16];
#pragma unroll
        for (int e = 0; e < 16; ++e) acc[e] = 0.f;
#pragma unroll
        for (int m = 0; m < 16; ++m) {
            const int col = lane + 64 * m;
            const float h = xv[m] * rstd * g[col] * (1.f + mv[(sh_i + 1) * 1024 + col]) + mv[sh_i * 1024 + col];
            act[(size_t)row * DM + col] = f2bf(h);
            if (side) {
                if ((m & 1) == 0) asm volatile("" ::: "memory");
#pragma unroll
                for (int eg = 0; eg < 4; ++eg) { const f32x4 w = sl[eg * 1024 + col]; acc[eg * 4 + 0] = fmaf(h, w[0], acc[eg * 4 + 0]); acc[eg * 4 + 1] = fmaf(h, w[1], acc[eg * 4 + 1]);
                    acc[eg * 4 + 2] = fmaf(h, w[2], acc[eg * 4 + 2]); acc[eg * 4 + 3] = fmaf(h, w[3], acc[eg * 4 + 3]); }
            }
        }
        if (side) {
#pragma unroll
            for (int e = 0; e < 16; ++e) acc[e] = wave_sum(acc[e]);
            if (MODE == 0) {
                float mine = 0.f;
#pragma unroll
                for (int e = 0; e < 16; ++e) mine = (lane == e) ? acc[e] : mine;
                if (lane < 16) {
                    float v = mine + p.gate_b[lane];
                    const int type = lane >> 2;
                    if (type == 1 || type == 3) v = logsigmoidf_(v);
                    ((float*)(p.ws + OFF_GATES))[(size_t)row * 16 + lane] = v;
                }
            } else if (lane == 0) {
                float aff[16], bi[16];
#pragma unroll
                for (int e = 0; e < 16; ++e) { aff[e] = sigmoidf_(acc[e]); bi[e] = aff[e] + p.router_b[e]; }
                int bg = 0, ba = 0, bb = 1; float bscore = -1e30f;
#pragma unroll
                for (int gq = 0; gq < 4; ++gq) {
                    int ia = 0; float va = bi[gq * 4];
#pragma unroll
                    for (int j = 1; j < 4; ++j) if (bi[gq * 4 + j] > va) { va = bi[gq * 4 + j]; ia = j; }
                    int ib = -1; float vb = -1e30f;
#pragma unroll
                    for (int j = 0; j < 4; ++j) if (j != ia && bi[gq * 4 + j] > vb) { vb = bi[gq * 4 + j]; ib = j; }
                    const float sc = va + vb;
                    if (sc > bscore) { bscore = sc; bg = gq; ba = ia; bb = ib; }
                }
                const int lo = ba < bb ? ba : bb, hi2 = ba < bb ? bb : ba;
                float alo = 0.f, ahi = 0.f;
#pragma unroll
                for (int e = 0; e < 16; ++e) { if (e == bg * 4 + lo) alo = aff[e]; if (e == bg * 4 + hi2) ahi = aff[e]; }
                const float inv = 1.f / (alo + ahi);
                const int pair = lo == 0 ? hi2 - 1 : (lo == 1 ? hi2 + 1 : 5);
                const int cls = bg * 6 + pair;
                unsigned* cnt = (unsigned*)(p.ws + OFF_CNT) + layer * 32;
                const unsigned slot = atomicAdd(&cnt[cls], 1u);
                ((int*)(p.ws + OFF_LIST))[(size_t)cls * NTOK + slot] = row;
                ((float2*)(p.ws + OFF_TOKW))[row] = make_float2(alo * inv, ahi * inv);
            }
        }
    }
}

DEVI void phase_inproj(const P& p, char* lds) {
    const int tid = threadIdx.x;
    const u16* A = (const u16*)(p.ws + OFF_ACT); const u16* B = (const u16*)(p.ws + OFF_WINT);
    const float2* tabR = (const float2*)(p.ws + OFF_ROPER); const float2* tabC = (const float2*)(p.ws + OFF_ROPEC);
    constexpr int NMT = NTOK / 256, NNT = 28;
    for (int u = blockIdx.x; u < NMT * NNT; u += gridDim.x) {
        const int mt = u / NNT, nt = u % NNT;
        const u16* ap[4]; const u16* bp[2];
#pragma unroll
        for (int i = 0; i < 4; ++i) ap[i] = A + (size_t)(mt * 256 + (tid >> 3) + 64 * i) * 1024 + (tid & 7) * 8;
#pragma unroll
        for (int i = 0; i < 2; ++i) bp[i] = B + (size_t)(nt * 128 + (tid >> 3) + 64 * i) * 1024 + (tid & 7) * 8;
        u16* dst; int ld, coff, kind;
        if (nt < 4)       { dst = (u16*)(p.ws + OFF_Q);    ld = 512;  coff = nt * 128;        kind = 1; }
        else if (nt < 8)  { dst = (u16*)(p.ws + OFF_K);    ld = 512;  coff = (nt - 4) * 128;  kind = 1; }
        else if (nt < 12) { dst = (u16*)(p.ws + OFF_V);    ld = 512;  coff = (nt - 8) * 128;  kind = 0; }
        else if (nt < 20) { dst = (u16*)(p.ws + OFF_MLQK); ld = 1024; coff = (nt - 12) * 128; kind = 0; }
        else if (nt < 24) { dst = (u16*)(p.ws + OFF_MLV);  ld = 512;  coff = (nt - 20) * 128; kind = 0; }
        else              { dst = (u16*)(p.ws + OFF_OG);   ld = 512;  coff = (nt - 24) * 128; kind = 2; }
        const int tb = mt % 65;
        gemm_tile(ap, bp, bp, 1024, 1024, lds, [&](f32x16 (&acc)[2][2], int rb, int cb, int r32, int hi) {
#pragma unroll
            for (int mi = 0; mi < 2; ++mi) {
#pragma unroll
                for (int r = 0; r < 16; ++r) {
                    const int row = rb + mi * 32 + crow(r, hi);
                    float v0 = acc[mi][0][r], v1 = acc[mi][1][r];
                    if (kind == 1 && tb > 0) {
                        const int tl = (tb - 1) * 256 + row;
                        const float2 cs = r32 < 16 ? tabR[(tl >> 6) * 16 + r32] : tabC[(tl & 63) * 16 + (r32 - 16)];
                        const float y0 = v0 * cs.x - v1 * cs.y, y1 = v0 * cs.y + v1 * cs.x; v0 = y0; v1 = y1;
                    } else if (kind == 2) { v0 = sigmoidf_(v0); v1 = sigmoidf_(v1); }
                    u16* d = dst + (size_t)(mt * 256 + row) * ld + coff + cb + r32;
                    d[0] = f2bf(v0); d[32] = f2bf(v1);
                }
            }
        });
    }
}

DEVI void phase_outproj(const P& p, char* lds) {
    const int tid = threadIdx.x;
    const u16* A = (const u16*)(p.ws + OFF_ACT); const u16* B = (const u16*)(p.ws + OFF_WOUTT);
    const float* modb = (const float*)(p.ws + OFF_MOD);
    constexpr int NMT = NTOK / 256, NNT = 8;
    for (int u = blockIdx.x; u < NMT * NNT; u += gridDim.x) {
        const int mt = u / NNT, nt = u % NNT;
        const u16* ap[4]; const u16* bp[2];
#pragma unroll
        for (int i = 0; i < 4; ++i) ap[i] = A + (size_t)(mt * 256 + (tid >> 3) + 64 * i) * 1024 + (tid & 7) * 8;
#pragma unroll
        for (int i = 0; i < 2; ++i) bp[i] = B + (size_t)(nt * 128 + (tid >> 3) + 64 * i) * 1024 + (tid & 7) * 8;
        const float* gate = modb + (size_t)modsel(0, mt * 256) * 6144 + 2 * 1024 + nt * 128;
        gemm_tile(ap, bp, bp, 1024, 1024, lds, [&](f32x16 (&acc)[2][2], int rb, int cb, int r32, int hi) {
            const float g0 = gate[cb + r32], g1 = gate[cb + 32 + r32];
#pragma unroll
            for (int mi = 0; mi < 2; ++mi) {
#pragma unroll
                for (int r = 0; r < 16; ++r) {
                    const int tok = mt * 256 + rb + mi * 32 + crow(r, hi);
                    const float* xi = xin_ptr(p, tok) + nt * 128 + cb + r32;
                    float* xo = xs_ptr(p, 0, tok) + nt * 128 + cb + r32;
                    xo[0] = xi[0] + g0 * acc[mi][0][r]; xo[32] = xi[32] + g1 * acc[mi][1][r];
                }
            }
        });
    }
}

DEVI int moe_table(const P& p, int layer, int* tb) {
    if (threadIdx.x == 0) {
        const unsigned* cnt = (const unsigned*)(p.ws + OFF_CNT) + layer * 32; int o = 0;
        for (int c = 0; c < 24; ++c) { tb[c] = o; tb[32 + c] = (int)cnt[c]; o += ((int)cnt[c] + 255) >> 8; }
        tb[24] = o;
    }
    __syncthreads();
    return tb[24];
}
DEVI void cls_experts(int cls, int& elo, int& ehi) {
    const int g = cls / 6, pr = cls % 6;
    const int lo = pr < 3 ? 0 : (pr < 5 ? 1 : 2); const int hi = pr < 3 ? pr + 1 : (pr < 5 ? pr - 1 : 3);
    elo = g * 4 + lo; ehi = g * 4 + hi;
}

DEVI void phase_moe_up(const P& p, int layer, char* lds) {
    const int tid = threadIdx.x;
    int* tb = (int*)(lds + 2 * G_STAGE);
    const int T = moe_table(p, layer, tb);
    const u16* A = (const u16*)(p.ws + OFF_ACT);
    const int* list = (const int*)(p.ws + OFF_LIST); const float2* tokw = (const float2*)(p.ws + OFF_TOKW);
    u16* HE = (u16*)(p.ws + OFF_HE);
    for (int u = blockIdx.x; u < T * 16; u += gridDim.x) {
        const int rt = u >> 4, ct = u & 15;
        int cls = 0; while (cls < 23 && tb[cls + 1] <= rt) ++cls;
        const int r0 = (rt - tb[cls]) * 256, ncls = tb[32 + cls];
        int elo, ehi; cls_experts(cls, elo, ehi);
        const int s = ct >> 3, c8 = ct & 7, e = s ? ehi : elo;
        const u16* B = (const u16*)(p.ws + OFF_WGU) + (size_t)e * 1024 * 1024 + (size_t)(c8 * 128) * 1024;
        const int* lst = list + (size_t)cls * NTOK + r0;
        const u16* ap[4]; const u16* bp[2];
#pragma unroll
        for (int i = 0; i < 4; ++i) { const int rr = (tid >> 3) + 64 * i; const int tok = (r0 + rr < ncls) ? lst[rr] : lst[0]; ap[i] = A + (size_t)tok * 1024 + (tid & 7) * 8; }
#pragma unroll
        for (int i = 0; i < 2; ++i) bp[i] = B + (size_t)((tid >> 3) + 64 * i) * 1024 + (tid & 7) * 8;
        gemm_tile(ap, bp, bp, 1024, 1024, lds, [&](f32x16 (&acc)[2][2], int rb, int cb, int r32, int hi) {
#pragma unroll
            for (int mi = 0; mi < 2; ++mi) {
#pragma unroll
                for (int r = 0; r < 16; ++r) {
                    const int row = rb + mi * 32 + crow(r, hi);
                    if (r0 + row < ncls) {
                        const int tok = lst[row]; const float2 w = tokw[tok];
                        const float gv = acc[mi][0][r], uv = acc[mi][1][r];
                        const float hv = siluf_(gv) * uv * (s ? w.y : w.x);
                        HE[(size_t)(rt * 256 + row) * 1024 + s * 512 + c8 * 64 + (cb >> 1) + r32] = f2bf(hv);
                    }
                }
            }
        });
    }
}

DEVI void phase_moe_down(const P& p, int layer, char* lds) {
    const int tid = threadIdx.x;
    int* tb = (int*)(lds + 2 * G_STAGE);
    const int T = moe_table(p, layer, tb);
    const u16* HE = (const u16*)(p.ws + OFF_HE);
    const int* list = (const int*)(p.ws + OFF_LIST);
    const float* modb = (const float*)(p.ws + OFF_MOD) + (size_t)layer * 3 * 6144;
    for (int u = blockIdx.x; u < T * 8; u += gridDim.x) {
        const int rt = u >> 3, nt = u & 7;
        int cls = 0; while (cls < 23 && tb[cls + 1] <= rt) ++cls;
        const int r0 = (rt - tb[cls]) * 256, ncls = tb[32 + cls];
        int elo, ehi; cls_experts(cls, elo, ehi);
        const u16* B0 = (const u16*)(p.ws + OFF_WDT) + (size_t)elo * 1024 * 512 + (size_t)(nt * 128) * 512;
        const u16* B1 = (const u16*)(p.ws + OFF_WDT) + (size_t)ehi * 1024 * 512 + (size_t)(nt * 128) * 512;
        const int* lst = list + (size_t)cls * NTOK + r0;
        const u16* ap[4]; const u16* bp0[2]; const u16* bp1[2];
#pragma unroll
        for (int i = 0; i < 4; ++i) { const int rr = (tid >> 3) + 64 * i; const int prow = (r0 + rr < ncls) ? rt * 256 + rr : rt * 256; ap[i] = HE + (size_t)prow * 1024 + (tid & 7) * 8; }
#pragma unroll
        for (int i = 0; i < 2; ++i) { bp0[i] = B0 + (size_t)((tid >> 3) + 64 * i) * 512 + (tid & 7) * 8; bp1[i] = B1 + (size_t)((tid >> 3) + 64 * i) * 512 + (tid & 7) * 8; }
        gemm_tile(ap, bp0, bp1, 1024, 512, lds, [&](f32x16 (&acc)[2][2], int rb, int cb, int r32, int hi) {
#pragma unroll
            for (int mi = 0; mi < 2; ++mi) {
#pragma unroll
                for (int r = 0; r < 16; ++r) {
                    const int row = rb + mi * 32 + crow(r, hi);
                    if (r0 + row < ncls) {
                        const int tok = lst[row];
                        const float* gate = modb + (size_t)modsel(layer, tok) * 6144 + 5 * 1024 + nt * 128 + cb + r32;
                        float* xo = xs_ptr(p, layer, tok) + nt * 128 + cb + r32;
                        xo[0] += gate[0] * acc[mi][0][r]; xo[32] += gate[32] * acc[mi][1][r];
                    }
                }
            }
        });
    }
}

DEVI void phase_fnet_gemm(const P& p, char* lds) {
    const int tid = threadIdx.x;
    const u16* A = (const u16*)(p.ws + OFF_ACT); const u16* B = (const u16*)(p.ws + OFF_FNT);
    constexpr int NMT = NLAT / 256, NNT = 16;
    for (int u = blockIdx.x; u < NMT * NNT; u += gridDim.x) {
        const int mt = u / NNT, nt = u % NNT;
        const u16* ap[4]; const u16* bp[2];
#pragma unroll
        for (int i = 0; i < 4; ++i) ap[i] = A + (size_t)(mt * 256 + (tid >> 3) + 64 * i) * 1024 + (tid & 7) * 8;
#pragma unroll
        for (int i = 0; i < 2; ++i) bp[i] = B + (size_t)(nt * 128 + (tid >> 3) + 64 * i) * 1024 + (tid & 7) * 8;
        u16* dst = (u16*)(p.ws + (nt < 8 ? OFF_ZR : OFF_ZI)) + (nt & 7) * 128;
        gemm_tile(ap, bp, bp, 1024, 1024, lds, [&](f32x16 (&acc)[2][2], int rb, int cb, int r32, int hi) {
#pragma unroll
            for (int mi = 0; mi < 2; ++mi) {
#pragma unroll
                for (int r = 0; r < 16; ++r) {
                    u16* d = dst + (size_t)(mt * 256 + rb + mi * 32 + crow(r, hi)) * 1024 + cb + r32;
                    d[0] = f2bf(acc[mi][0][r]); d[32] = f2bf(acc[mi][1][r]);
                }
            }
        });
    }
}

template <class RP>
DEVI void stage_tr128(RP rp, char* img) {
    const int tid = threadIdx.x;
#pragma unroll
    for (int i = 0; i < 4; ++i) {
        const int idx = tid + 512 * i, k = idx >> 4, c = (idx & 15) * 8;
        const u32x4 v = *reinterpret_cast<const u32x4*>(rp(k) + c);
        *reinterpret_cast<u32x4*>(img + (k >> 6) * 16384 + v_st(k & 63, c)) = v;
    }
}
DEVI void load_dft(const P& p, char* lds) {
    const int tid = threadIdx.x;
    for (int i = tid; i < 4096; i += NTHR) {
        const int m = i >> 11, j = i & 2047, row = j >> 4, ch = j & 15;
        const u32x4 v = *reinterpret_cast<const u32x4*>((const u16*)(p.ws + (m ? OFF_DFTS : OFF_DFTC)) + row * 128 + ch * 8);
        *reinterpret_cast<u32x4*>(lds + m * 34816 + swz256(row, ch)) = v;
    }
}
DEVI bf16x8 negbf(bf16x8 v) { u32x4 w = *reinterpret_cast<u32x4*>(&v); w[0] ^= 0x80008000u; w[1] ^= 0x80008000u; w[2] ^= 0x80008000u; w[3] ^= 0x80008000u; return *reinterpret_cast<bf16x8*>(&w); }

template <int KS, int WN, int MODE>
DEVI void fft_kstep(int vbr, int vbi, const bf16x8& aC, const bf16x8& aS, f32x16 (&yr)[2], f32x16 (&yi)[2]) {
    s16x4 rl0, rh0, rl1, rh1, il0, ih0, il1, ih1;
    tr_frag_issue<2 * WN, KS>(vbr, rl0, rh0); tr_frag_issue<2 * WN + 1, KS>(vbr, rl1, rh1);
    tr_frag_issue<2 * WN, KS>(vbi, il0, ih0); tr_frag_issue<2 * WN + 1, KS>(vbi, il1, ih1);
    LGKM0();
    const bf16x8 xr0 = PKLH(rl0, rh0), xr1 = PKLH(rl1, rh1), xi0 = PKLH(il0, ih0), xi1 = PKLH(il1, ih1);
    yr[0] = __builtin_amdgcn_mfma_f32_32x32x16_bf16(aC, xr0, yr[0], 0, 0, 0);
    yr[1] = __builtin_amdgcn_mfma_f32_32x32x16_bf16(aC, xr1, yr[1], 0, 0, 0);
    yr[0] = __builtin_amdgcn_mfma_f32_32x32x16_bf16(aS, xi0, yr[0], 0, 0, 0);
    yr[1] = __builtin_amdgcn_mfma_f32_32x32x16_bf16(aS, xi1, yr[1], 0, 0, 0);
    if (MODE == 0) {
        yi[0] = __builtin_amdgcn_mfma_f32_32x32x16_bf16(aC, xi0, yi[0], 0, 0, 0);
        yi[1] = __builtin_amdgcn_mfma_f32_32x32x16_bf16(aC, xi1, yi[1], 0, 0, 0);
        yi[0] = __builtin_amdgcn_mfma_f32_32x32x16_bf16(aS, negbf(xr0), yi[0], 0, 0, 0);
        yi[1] = __builtin_amdgcn_mfma_f32_32x32x16_bf16(aS, negbf(xr1), yi[1], 0, 0, 0);
    }
}
template <int WN, int MODE>
DEVI void fft_core(const char* lds, int xr_img, int xi_img, int wm, int lane, f32x16 (&yr)[2], f32x16 (&yi)[2]) {
    const int r32 = lane & 31, hi = lane >> 5;
    const char* Cm = lds; const char* Sm = lds + 34816;
    const int row = wm * 32 + r32;
    const int vb0 = xr_img + v_rd_base(lane), vb1 = xi_img + v_rd_base(lane);
#define KSTEP(H, KS) do { const int kk = (H) * 4 + (KS); \
        const bf16x8 aC = lds_b128(Cm, swz256(row, 2 * kk + hi)), aS = lds_b128(Sm, swz256(row, 2 * kk + hi)); \
        fft_kstep<KS, WN, MODE>(vb0 + (H) * 16384, vb1 + (H) * 16384, aC, aS, yr, yi); } while (0)
    KSTEP(0, 0); KSTEP(0, 1); KSTEP(0, 2); KSTEP(0, 3); KSTEP(1, 0); KSTEP(1, 1); KSTEP(1, 2); KSTEP(1, 3);
#undef KSTEP
}

DEVI void phase_fft1(const P& p, char* lds) {
    const int tid = threadIdx.x, lane = tid & 63, wid = tid >> 6, wm = wid >> 1, wn = wid & 1, r32 = lane & 31, hi = lane >> 5;
    load_dft(p, lds);
    char* imgR = lds + 69632; char* imgI = lds + 102400;
    const u16* Zr = (const u16*)(p.ws + OFF_ZR); const u16* Zi = (const u16*)(p.ws + OFF_ZI);
    u16* Yr = (u16*)(p.ws + OFF_YR); u16* Yi = (u16*)(p.ws + OFF_YI);
    const float2* TW = (const float2*)(p.ws + OFF_TW);
    for (int u = blockIdx.x; u < NB * 128 * 8; u += gridDim.x) {
        const int cb = u & 7, t2 = (u >> 3) & 127, b = u >> 10;
        __syncthreads();
        stage_tr128([&](int k) { return Zr + (size_t)(b * TL + 128 * k + t2) * 1024 + cb * 128; }, imgR);
        stage_tr128([&](int k) { return Zi + (size_t)(b * TL + 128 * k + t2) * 1024 + cb * 128; }, imgI);
        __syncthreads();
        f32x16 yr[2] = {}, yi[2] = {};
        const int xr_img = (int)(uintptr_t)imgR, xi_img = (int)(uintptr_t)imgI;
        if (wn == 0) fft_core<0, 0>(lds, xr_img, xi_img, wm, lane, yr, yi); else fft_core<1, 0>(lds, xr_img, xi_img, wm, lane, yr, yi);
#pragma unroll
        for (int r = 0; r < 16; ++r) {
            const int k1 = wm * 32 + crow(r, hi);
            const float2 w = TW[t2 * k1];
            const size_t o = ((size_t)(b * 128 + k1) * 128 + t2) * 1024 + cb * 128 + wn * 64 + r32;
#pragma unroll
            for (int ni = 0; ni < 2; ++ni) {
                const float a = yr[ni][r], bq = yi[ni][r];
                Yr[o + ni * 32] = f2bf(a * w.x + bq * w.y);
                Yi[o + ni * 32] = f2bf(bq * w.x - a * w.y);
            }
        }
    }
}
DEVI void phase_fft2(const P& p, char* lds) {
    const int tid = threadIdx.x, lane = tid & 63, wid = tid >> 6, wm = wid >> 1, wn = wid & 1, r32 = lane & 31, hi = lane >> 5;
    load_dft(p, lds);
    char* imgR = lds + 69632; char* imgI = lds + 102400;
    const u16* Yr = (const u16*)(p.ws + OFF_YR); const u16* Yi = (const u16*)(p.ws + OFF_YI);
    const float* modb = (const float*)(p.ws + OFF_MOD) + (size_t)3 * 6144;
    for (int u = blockIdx.x; u < NB * 128 * 8; u += gridDim.x) {
        const int cb = u & 7, k1 = (u >> 3) & 127, b = u >> 10;
        __syncthreads();
        stage_tr128([&](int k) { return Yr + ((size_t)(b * 128 + k1) * 128 + k) * 1024 + cb * 128; }, imgR);
        stage_tr128([&](int k) { return Yi + ((size_t)(b * 128 + k1) * 128 + k) * 1024 + cb * 128; }, imgI);
        __syncthreads();
        f32x16 yr[2] = {}, yi[2] = {};
        const int xr_img = (int)(uintptr_t)imgR, xi_img = (int)(uintptr_t)imgI;
        if (wn == 0) fft_core<0, 1>(lds, xr_img, xi_img, wm, lane, yr, yi); else fft_core<1, 1>(lds, xr_img, xi_img, wm, lane, yr, yi);
        const float* gate = modb + (size_t)b * 6144 + 2 * 1024 + cb * 128 + wn * 64 + r32;
        const float g0 = gate[0], g1 = gate[32];
#pragma unroll
        for (int r = 0; r < 16; ++r) {
            const int k2 = wm * 32 + crow(r, hi);
            float* xo = p.out + (size_t)(b * TL + k1 + 128 * k2) * 1024 + cb * 128 + wn * 64 + r32;
            xo[0] += g0 * yr[0][r]; xo[32] += g1 * yr[1][r];
        }
    }
}

constexpr int AT_V = 16384, AT_K = 17408;
template <int HF, int DB>
DEVI void attn_half(const char* Ks, const bf16x8 (&qr)[8], float& m_reg, float& l_reg, f32x16 (&o)[4], int vb, float* al, int r32, int hi) {
    constexpr float SC = 0.125f, C = SC * 1.4426950408889634f, THR = 8.f;
    f32x16 pp = {};
#pragma unroll
    for (int d0 = 0; d0 < 4; ++d0) pp = __builtin_amdgcn_mfma_f32_32x32x16_bf16(lds_b128(Ks, swz256(HF * 32 + r32, 2 * (DB + d0) + hi)), qr[DB + d0], pp, 0, 0, 0);
    float pmax = pp[0];
#pragma unroll
    for (int r = 1; r < 16; ++r) pmax = fmaxf(pmax, pp[r]);
    { auto rr = __builtin_amdgcn_permlane32_swap(__float_as_uint(pmax), __float_as_uint(pmax), false, false);
      pmax = fmaxf(__uint_as_float(rr[0]), __uint_as_float(rr[1])); }
    float alpha = 1.f;
    if (!__all(pmax - m_reg <= THR / SC)) {
        const float mn = fmaxf(m_reg, pmax); alpha = __builtin_amdgcn_exp2f((m_reg - mn) * C); m_reg = mn;
        if (hi == 0) al[r32] = alpha;
        asm volatile("s_waitcnt lgkmcnt(0)" ::: "memory");
#pragma unroll
        for (int d = 0; d < 4; ++d)
#pragma unroll
            for (int r = 0; r < 16; ++r) o[d][r] *= al[crow(r, hi)];
    }
    const float mnC = -m_reg * C;
    float ps = 0.f;
#pragma unroll
    for (int r = 0; r < 16; ++r) { pp[r] = __builtin_amdgcn_exp2f(fmaf(pp[r], C, mnC)); ps += pp[r]; }
    { auto rr = __builtin_amdgcn_permlane32_swap(__float_as_uint(ps), __float_as_uint(ps), false, false);
      ps = __uint_as_float(rr[0]) + __uint_as_float(rr[1]); }
    l_reg = l_reg * alpha + ps;
    bf16x8 pa0, pa1;
    pack_p(pp, pa0, pa1);
#define PVD(D0) do { s16x4 l0, h0, l1, h1; tr_frag_issue<D0, 2 * HF>(vb, l0, h0); tr_frag_issue<D0, 2 * HF + 1>(vb, l1, h1); LGKM0(); \
        o[D0] = __builtin_amdgcn_mfma_f32_32x32x16_bf16(pa0, PKLH(l0, h0), o[D0], 0, 0, 0); \
        o[D0] = __builtin_amdgcn_mfma_f32_32x32x16_bf16(pa1, PKLH(l1, h1), o[D0], 0, 0, 0); } while (0)
    PVD(0); PVD(1); PVD(2); PVD(3);
#undef PVD
}

DEVI void diffattn_item(const P& p, int q0, int k0row, int seq, int h, char* lds) {
    int tid = threadIdx.x; asm volatile("" : "+v"(tid));
    const int wid = tid >> 6, lane = tid & 63, r32 = lane & 31, hi = lane >> 5;
    const u16* Q = (const u16*)(p.ws + OFF_Q); const u16* Kg = (const u16*)(p.ws + OFF_K) + (size_t)k0row * 512 + h * 128;
    const u16* Vg = (const u16*)(p.ws + OFF_V) + (size_t)k0row * 512 + h * 128;
    char* V_lds = lds; char* K_lds = lds + 2 * AT_V;
    float* al = (float*)(lds + 2 * AT_V + 2 * AT_K) + wid * 64;
    bf16x8 qr[8];
    { const u16* Qw = Q + (size_t)(q0 + wid * 32 + r32) * 512 + h * 128 + hi * 8;
#pragma unroll
      for (int d0 = 0; d0 < 8; ++d0) qr[d0] = *reinterpret_cast<const bf16x8*>(Qw + d0 * 16); }
    const int sr = tid >> 4, sc = (tid & 15) * 8;
    const int vb0 = (int)(uintptr_t)V_lds + v_rd_base(lane);
    const int vc = ((tid >> 5) & 3) * 32 + (tid & 3) * 8;
    const int kk0 = (tid >> 7) * 8 + ((tid & 31) >> 2), kk1 = kk0 + 32;
    const int vk0 = (kk0 & ~0xC) | ((kk0 & 4) << 1) | ((kk0 & 8) >> 1), vk1 = (kk1 & ~0xC) | ((kk1 & 4) << 1) | ((kk1 & 8) >> 1);
    u32x4 sk0, sk1;
#define SLOAD(kk, b) do { \
    __builtin_amdgcn_global_load_lds((const unsigned*)(Vg + (size_t)((kk) + vk0) * 512 + vc), (LAS unsigned*)(V_lds + (b) * AT_V + tid * 16), 16, 0, 0); \
    __builtin_amdgcn_global_load_lds((const unsigned*)(Vg + (size_t)((kk) + vk1) * 512 + vc), (LAS unsigned*)(V_lds + (b) * AT_V + 8192 + tid * 16), 16, 0, 0); \
    sk0 = *reinterpret_cast<const u32x4*>(Kg + (size_t)((kk) + sr) * 512 + sc); sk1 = *reinterpret_cast<const u32x4*>(Kg + (size_t)((kk) + 32 + sr) * 512 + sc); } while (0)
#define SWRITE(b) do { *reinterpret_cast<u32x4*>(K_lds + (b) * AT_K + swz256(sr, tid & 15)) = sk0; *reinterpret_cast<u32x4*>(K_lds + (b) * AT_K + swz256(32 + sr, tid & 15)) = sk1; } while (0)
    float m0 = -1e30f, m1 = -1e30f, l0 = 0.f, l1 = 0.f;
    f32x16 o0[4] = {}, o1[4] = {};
    const int NT = seq / 64;
    __syncthreads();
    SLOAD(0, 0); SWRITE(0); asm volatile("s_waitcnt vmcnt(0)" ::: "memory"); __syncthreads();
    if (NT > 1) SLOAD(64, 1);
    for (int j = 0; j < NT; ++j) {
        const int cur = j & 1;
        const char* Ks = K_lds + cur * AT_K;
        attn_half<0, 0>(Ks, qr, m0, l0, o0, vb0 + cur * AT_V, al, r32, hi);
        attn_half<1, 0>(Ks, qr, m0, l0, o0, vb0 + cur * AT_V, al, r32, hi);
        attn_half<0, 4>(Ks, qr, m1, l1, o1, vb0 + cur * AT_V, al, r32, hi);
        attn_half<1, 4>(Ks, qr, m1, l1, o1, vb0 + cur * AT_V, al, r32, hi);
        if (j + 1 < NT) SWRITE(cur ^ 1);
        asm volatile("s_waitcnt vmcnt(0)" ::: "memory");
        __syncthreads();
        if (j + 2 < NT) SLOAD((j + 2) * 64, cur);
    }
#undef SLOAD
#undef SWRITE
    int tz = threadIdx.x; asm volatile("" : "+v"(tz));
    const int wid2 = tz >> 6, lane2 = tz & 63, r32e = lane2 & 31, hie = lane2 >> 5;
    const float lam = ((const float*)(p.ws + OFF_LAM))[0];
    float* sc0 = (float*)(lds + 2 * AT_V + 2 * AT_K) + wid2 * 64; float* sc1 = sc0 + 32;
    if (hie == 0) { sc0[r32e] = 1.f / l0; sc1[r32e] = -lam / l1; }
    asm volatile("s_waitcnt lgkmcnt(0)" ::: "memory");
    float ssq[16];
#pragma unroll
    for (int r = 0; r < 16; ++r) {
        const float a = sc0[crow(r, hie)], b = sc1[crow(r, hie)]; float s = 0.f;
#pragma unroll
        for (int d = 0; d < 4; ++d) { const float v = o0[d][r] * a + o1[d][r] * b; o0[d][r] = v; s = fmaf(v, v, s); }
        ssq[r] = s;
    }
#pragma unroll
    for (int r = 0; r < 16; ++r) { float s = ssq[r]; for (int o = 16; o; o >>= 1) s += __shfl_xor(s, o); ssq[r] = rsqrtf(s * (1.f / 128.f) + 1e-6f) * 0.8f; }
    u16* mix = (u16*)(p.ws + OFF_ACT);
    const float* sg = p.subln_g;
#pragma unroll
    for (int d = 0; d < 4; ++d) {
        const float gv = sg[d * 32 + r32e];
#pragma unroll
        for (int r = 0; r < 16; ++r) mix[(size_t)(q0 + wid2 * 32 + crow(r, hie)) * 1024 + h * 128 + d * 32 + r32e] = f2bf(o0[d][r] * ssq[r] * gv);
    }
}

DEVI void chunk_scan(const float* gates, int row0, int head, int dir, float* Bq, float* av, float* pm, float& total, float& amax) {
    const int lane = threadIdx.x & 63;
    const int e0 = dir ? 127 - 2 * lane : 2 * lane, e1 = dir ? 126 - 2 * lane : 2 * lane + 1;
    const float lf0 = gates[(size_t)(row0 + e0) * 16 + (dir ? 12 : 4) + head], lf1 = gates[(size_t)(row0 + e1) * 16 + (dir ? 12 : 4) + head];
    const float li0 = gates[(size_t)(row0 + e0) * 16 + (dir ? 8 : 0) + head],  li1 = gates[(size_t)(row0 + e1) * 16 + (dir ? 8 : 0) + head];
    const float s1 = lf0 + lf1; float inc = s1;
#pragma unroll
    for (int o = 1; o < 64; o <<= 1) { const float t = __shfl_up(inc, o); if (lane >= o) inc += t; }
    const float exc = inc - s1;
    const float B0 = exc + lf0, B1 = exc + s1;
    const float a0 = li0 - B0, a1 = li1 - B1;
    const float m1 = fmaxf(a0, a1); float mx = m1;
#pragma unroll
    for (int o = 1; o < 64; o <<= 1) { const float t = __shfl_up(mx, o); if (lane >= o) mx = fmaxf(mx, t); }
    float mprev = __shfl_up(mx, 1); if (lane == 0) mprev = -1e30f;
    Bq[e0] = B0; Bq[e1] = B1; av[e0] = a0; av[e1] = a1; pm[e0] = fmaxf(mprev, a0); pm[e1] = mx;
    total = __shfl(inc, 63); amax = __shfl(mx, 63);
}

DEVI void conv_silu8(const u32x4& xm, const u32x4& x0, const u32x4& xp, const float* wc, bool hasm, bool hasp, float (&out)[8]) {
#pragma unroll
    for (int j = 0; j < 4; ++j) {
        const float w00 = wc[2 * j], w01 = wc[2 * j + 1], w10 = wc[1024 + 2 * j], w11 = wc[1024 + 2 * j + 1], w20 = wc[2048 + 2 * j], w21 = wc[2048 + 2 * j + 1];
        float a = w10 * bflo(x0[j]), b = w11 * bfhi(x0[j]);
        if (hasm) { a = fmaf(w00, bflo(xm[j]), a); b = fmaf(w01, bfhi(xm[j]), b); }
        if (hasp) { a = fmaf(w20, bflo(xp[j]), a); b = fmaf(w21, bfhi(xp[j]), b); }
        out[2 * j] = siluf_(a); out[2 * j + 1] = siluf_(b);
    }
}
DEVI void seg_edges(int t  , bool& hasm, bool& hasp) {
    hasm = !(t == 0 || t == TC); hasp = !(t == TC - 1 || t == TT - 1);
}
DEVI int chain_slot(int dir, int b, int h, int cc) { return ((dir * 2 + b) * 4 + h) * NCH + cc; }

DEVI void phase_mlstm_a(const P& p, char* lds) {
    const int tid = threadIdx.x, wid = tid >> 6, lane = tid & 63, r32 = lane & 31, hi = lane >> 5;
    char* Vimg = lds; char* Kf = lds + 32768; char* Kb = lds + 65536;
    float* arr = (float*)(lds + 98304);
    const float* gates = (const float*)(p.ws + OFF_GATES);
    const u16* MLQK = (const u16*)(p.ws + OFF_MLQK); const u16* MLV = (const u16*)(p.ws + OFF_MLV);
    u16* CST = (u16*)(p.ws + OFF_CST); float* NST = (float*)(p.ws + OFF_NST);
    float2* scal = (float2*)(p.ws + OFF_MSCAL);
    for (int it = blockIdx.x; it < NB * 4 * NCH; it += gridDim.x) {
        const int cc = it % NCH, h = (it / NCH) & 3, b = it / (NCH * 4);
        const int row0 = b * TT + cc * 128;
        __syncthreads();
        if (wid < 2) {
            float total, amax; float* a4 = arr + wid * 512;
            chunk_scan(gates, row0, h, wid, a4, a4 + 128, a4 + 256, total, amax);
            a4[384 + lane] = __expf(a4[128 + lane] - amax); a4[384 + 64 + lane] = __expf(a4[128 + 64 + lane] - amax);
            if (lane == 0) scal[chain_slot(wid, b, h, 0) + cc] = make_float2(total + amax, total);
        }
        __syncthreads();
#pragma unroll
        for (int i = 0; i < 4; ++i) {
            const int idx = tid + 512 * i, l = idx >> 4, c = (idx & 15) * 8;
            const u32x4 v = *reinterpret_cast<const u32x4*>(MLV + (size_t)(row0 + l) * 512 + h * 128 + c);
            *reinterpret_cast<u32x4*>(Vimg + (l >> 6) * 16384 + v_st(l & 63, c)) = v;
            const int t = cc * 128 + l; bool hasm, hasp; seg_edges(t, hasm, hasp);
            const u16* kp = MLQK + (size_t)(row0 + l) * 1024 + 512 + h * 128 + c;
            const u32x4 x0 = *reinterpret_cast<const u32x4*>(kp);
            const u32x4 xm = hasm ? *reinterpret_cast<const u32x4*>(kp - 1024) : x0;
            const u32x4 xp = hasp ? *reinterpret_cast<const u32x4*>(kp + 1024) : x0;
            float kv[8]; conv_silu8(xm, x0, xp, p.conv_w + 512 + h * 128 + c, hasm, hasp, kv);
            const float wf = arr[384 + l] * 0.08838834764831845f, wb = arr[512 + 384 + l] * 0.08838834764831845f;
            u32x4 of, ob;
#pragma unroll
            for (int j = 0; j < 4; ++j) { of[j] = cvtpk(kv[2 * j] * wf, kv[2 * j + 1] * wf); ob[j] = cvtpk(kv[2 * j] * wb, kv[2 * j + 1] * wb); }
            *reinterpret_cast<u32x4*>(Kf + (l >> 6) * 16384 + v_st(l & 63, c)) = of;
            *reinterpret_cast<u32x4*>(Kb + (l >> 6) * 16384 + v_st(l & 63, c)) = ob;
        }
        __syncthreads();
        const int dir = wid >> 2, vblk = wid & 3;
        const int va = (int)(uintptr_t)Vimg + v_rd_base(lane), ka = (int)(uintptr_t)(dir ? Kb : Kf) + v_rd_base(lane);
        f32x16 acc[4] = {};
#define ASTEP(H, KS) do { s16x4 al_, ah_, b0l, b0h, b1l, b1h, b2l, b2h, b3l, b3h; \
        if (vblk == 0) tr_frag_issue<0, KS>(va + (H) * 16384, al_, ah_); else if (vblk == 1) tr_frag_issue<1, KS>(va + (H) * 16384, al_, ah_); \
        else if (vblk == 2) tr_frag_issue<2, KS>(va + (H) * 16384, al_, ah_); else tr_frag_issue<3, KS>(va + (H) * 16384, al_, ah_); \
        tr_frag_issue<0, KS>(ka + (H) * 16384, b0l, b0h); tr_frag_issue<1, KS>(ka + (H) * 16384, b1l, b1h); \
        tr_frag_issue<2, KS>(ka + (H) * 16384, b2l, b2h); tr_frag_issue<3, KS>(ka + (H) * 16384, b3l, b3h); LGKM0(); \
        const bf16x8 af = PKLH(al_, ah_); \
        acc[0] = __builtin_amdgcn_mfma_f32_32x32x16_bf16(af, PKLH(b0l, b0h), acc[0], 0, 0, 0); \
        acc[1] = __builtin_amdgcn_mfma_f32_32x32x16_bf16(af, PKLH(b1l, b1h), acc[1], 0, 0, 0); \
        acc[2] = __builtin_amdgcn_mfma_f32_32x32x16_bf16(af, PKLH(b2l, b2h), acc[2], 0, 0, 0); \
        acc[3] = __builtin_amdgcn_mfma_f32_32x32x16_bf16(af, PKLH(b3l, b3h), acc[3], 0, 0, 0); } while (0)
        ASTEP(0, 0); ASTEP(0, 1); ASTEP(0, 2); ASTEP(0, 3); ASTEP(1, 0); ASTEP(1, 1); ASTEP(1, 2); ASTEP(1, 3);
#undef ASTEP
        u16* Cd = CST + (size_t)chain_slot(dir, b, h, cc) * 16384;
#pragma unroll
        for (int kb = 0; kb < 4; ++kb)
#pragma unroll
            for (int r = 0; r < 16; ++r) Cd[(vblk * 32 + crow(r, hi)) * 128 + kb * 32 + r32] = f2bf(acc[kb][r]);
        if (tid < 256) {
            const int d2 = tid >> 7, k = tid & 127; const char* img = d2 ? Kb : Kf; float s = 0.f;
            for (int l = 0; l < 128; ++l) s += bf2f(*reinterpret_cast<const u16*>(img + (l >> 6) * 16384 + v_st(l & 63, k & ~7) + (k & 7) * 2));
            NST[(size_t)chain_slot(d2, b, h, cc) * 128 + k] = s;
        }
    }
}

DEVI int proc_chunk(int dir, int i) { return dir == 0 ? i : (i == 0 ? 1 : (i == 1 ? 0 : NCH + 1 - i)); }

DEVI void phase_mlstm_b(const P& p, char* lds) {
    const int tid = threadIdx.x;
    float* dec = (float*)lds; float* scl = dec + 160; float* mst = scl + 160;
    const float2* scal = (const float2*)(p.ws + OFF_MSCAL);
    u32* CST = (u32*)(p.ws + OFF_CST); float* NST = (float*)(p.ws + OFF_NST); float* MST = (float*)(p.ws + OFF_MST);
    for (int it = blockIdx.x; it < 16 * 16; it += gridDim.x) {
        const int chain = it >> 4, sub = it & 15, dir = chain >> 3;
        __syncthreads();
        if (tid == 0) {
            float m = 0.f;
            for (int i = 0; i < NCH; ++i) {
                const int cc = proc_chunk(dir, i); const float2 s = scal[chain * NCH + cc];
                const float mn = fmaxf(s.y + m, s.x);
                dec[i] = __expf(s.y + m - mn); scl[i] = __expf(s.x - mn); mst[i] = m;
                if (sub == 0) MST[chain * NCH + cc] = m;
                m = mn;
            }
        }
        __syncthreads();
        u32* base = CST + (size_t)chain * NCH * 8192 + sub * 512 + tid;
        float s0 = 0.f, s1 = 0.f;
        for (int i0 = 0; i0 < NCH; i0 += 10) {
            u32 v[10];
#pragma unroll
            for (int j = 0; j < 10; ++j) v[j] = base[(size_t)proc_chunk(dir, i0 + j) * 8192];
#pragma unroll
            for (int j = 0; j < 10; ++j) {
                base[(size_t)proc_chunk(dir, i0 + j) * 8192] = cvtpk(s0, s1);
                const float d = dec[i0 + j], sc = scl[i0 + j];
                s0 = fmaf(d, s0, sc * bflo(v[j])); s1 = fmaf(d, s1, sc * bfhi(v[j]));
            }
        }
        if (sub == 0 && tid < 128) {
            float* nb = NST + (size_t)chain * NCH * 128 + tid; float s = 0.f;
            for (int i = 0; i < NCH; ++i) { const int cc = proc_chunk(dir, i); const float v = nb[cc * 128]; nb[cc * 128] = s; s = fmaf(dec[i], s, scl[i] * v); }
        }
    }
}

DEVI void mlstm_c_item(const P& p, int it, char* lds) {
    const int tid = threadIdx.x, wid = tid >> 6, lane = tid & 63, r32 = lane & 31, hi = lane >> 5;
    const int cc = it % NCH, h = (it / NCH) & 3, b = it / (NCH * 4);
    const int row0 = b * TT + cc * 128;
    char* Kt = lds; char* Vimg = lds + 34816; char* Ct = lds + 67584;
    float* arr = (float*)(lds + 137216);
    float* wsc = arr + 1024 + wid * 64;
    float* xb = (float*)lds;
    const float* gates = (const float*)(p.ws + OFF_GATES);
    const u16* MLQK = (const u16*)(p.ws + OFF_MLQK); const u16* MLV = (const u16*)(p.ws + OFF_MLV);
    const u16* CST = (const u16*)(p.ws + OFF_CST); const float* NST = (const float*)(p.ws + OFF_NST); const float* MST = (const float*)(p.ws + OFF_MST);
    __syncthreads();
    if (wid < 2) { float total, amax; float* a4 = arr + wid * 512; chunk_scan(gates, row0, h, wid, a4, a4 + 128, a4 + 256, total, amax); }
    else if (wid < 6) { const int d2 = (wid - 2) >> 1, k = ((wid - 2) & 1) * 64 + lane; arr[d2 * 512 + 384 + k] = NST[(size_t)chain_slot(d2, b, h, cc) * 128 + k]; }
#pragma unroll
    for (int i = 0; i < 4; ++i) {
        const int idx = tid + 512 * i, l = idx >> 4, ch = idx & 15, c = ch * 8;
        const u32x4 v = *reinterpret_cast<const u32x4*>(MLV + (size_t)(row0 + l) * 512 + h * 128 + c);
        *reinterpret_cast<u32x4*>(Vimg + (l >> 6) * 16384 + v_st(l & 63, c)) = v;
        const int t = cc * 128 + l; bool hasm, hasp; seg_edges(t, hasm, hasp);
        const u16* kp = MLQK + (size_t)(row0 + l) * 1024 + 512 + h * 128 + c;
        const u32x4 x0 = *reinterpret_cast<const u32x4*>(kp);
        const u32x4 xm = hasm ? *reinterpret_cast<const u32x4*>(kp - 1024) : x0;
        const u32x4 xp = hasp ? *reinterpret_cast<const u32x4*>(kp + 1024) : x0;
        float kv[8]; conv_silu8(xm, x0, xp, p.conv_w + 512 + h * 128 + c, hasm, hasp, kv);
        u32x4 ok;
#pragma unroll
        for (int j = 0; j < 4; ++j) ok[j] = cvtpk(kv[2 * j] * 0.08838834764831845f, kv[2 * j + 1] * 0.08838834764831845f);
        *reinterpret_cast<u32x4*>(Kt + swz256(l, ch)) = ok;
#pragma unroll
        for (int d2 = 0; d2 < 2; ++d2) {
            const u32x4 cv = *reinterpret_cast<const u32x4*>(CST + (size_t)chain_slot(d2, b, h, cc) * 16384 + l * 128 + c);
            *reinterpret_cast<u32x4*>(Ct + d2 * 34816 + swz256(l, ch)) = cv;
        }
    }
    const int dir = wid >> 2, qb = wid & 3, q = qb * 32 + r32;
    bf16x8 qr[8];
    {
        const int t = cc * 128 + q; bool hasm, hasp; seg_edges(t, hasm, hasp);
        const u16* qp = MLQK + (size_t)(row0 + q) * 1024 + h * 128 + hi * 8;
#pragma unroll
        for (int d0 = 0; d0 < 8; ++d0) {
            const u32x4 x0 = *reinterpret_cast<const u32x4*>(qp + d0 * 16);
            const u32x4 xm = hasm ? *reinterpret_cast<const u32x4*>(qp + d0 * 16 - 1024) : x0;
            const u32x4 xp = hasp ? *reinterpret_cast<const u32x4*>(qp + d0 * 16 + 1024) : x0;
            float qv[8]; conv_silu8(xm, x0, xp, p.conv_w + h * 128 + d0 * 16 + hi * 8, hasm, hasp, qv);
            u32x4 w; w[0] = cvtpk(qv[0], qv[1]); w[1] = cvtpk(qv[2], qv[3]); w[2] = cvtpk(qv[4], qv[5]); w[3] = cvtpk(qv[6], qv[7]);
            qr[d0] = *reinterpret_cast<bf16x8*>(&w);
        }
    }
    __syncthreads();
    const float* a4 = arr + dir * 512;
    const float m_st = MST[chain_slot(dir, b, h, 0) + cc];
    const float Mq = fmaxf(m_st, a4[256 + q]);
    const float inter = __expf(m_st - Mq);
    float nq = 0.f;
#pragma unroll
    for (int d0 = 0; d0 < 8; ++d0) {
        const u32x4 w = *reinterpret_cast<const u32x4*>(&qr[d0]); const float* nn = a4 + 384 + d0 * 16 + hi * 8;
#pragma unroll
        for (int j = 0; j < 4; ++j) { nq = fmaf(bflo(w[j]), nn[2 * j], nq); nq = fmaf(bfhi(w[j]), nn[2 * j + 1], nq); }
    }
    { auto rr = __builtin_amdgcn_permlane32_swap(__float_as_uint(nq), __float_as_uint(nq), false, false); nq = __uint_as_float(rr[0]) + __uint_as_float(rr[1]); }
    f32x16 o[4] = {};
    const char* Cm = Ct + dir * 34816;
#pragma unroll
    for (int dk = 0; dk < 8; ++dk)
#pragma unroll
        for (int d0 = 0; d0 < 4; ++d0) o[d0] = __builtin_amdgcn_mfma_f32_32x32x16_bf16(qr[dk], lds_b128(Cm, swz256(d0 * 32 + r32, 2 * dk + hi)), o[d0], 0, 0, 0);
    if (hi == 0) wsc[r32] = inter;
    asm volatile("s_waitcnt lgkmcnt(0)" ::: "memory");
#pragma unroll
    for (int d0 = 0; d0 < 4; ++d0)
#pragma unroll
        for (int r = 0; r < 16; ++r) o[d0][r] *= wsc[crow(r, hi)];
    const int vb = (int)(uintptr_t)Vimg + v_rd_base(lane);
    float rs = 0.f;
#define KBLK(KB) do { if (dir == 0 ? (KB) <= qb : (KB) >= qb) { \
        f32x16 pp = {}; \
        _Pragma("unroll") for (int d0 = 0; d0 < 8; ++d0) pp = __builtin_amdgcn_mfma_f32_32x32x16_bf16(lds_b128(Kt, swz256((KB) * 32 + r32, 2 * d0 + hi)), qr[d0], pp, 0, 0, 0); \
        _Pragma("unroll") for (int g = 0; g < 4; ++g) { const f32x4 av4 = *reinterpret_cast<const f32x4*>(a4 + 128 + (KB) * 32 + 8 * g + 4 * hi); \
            _Pragma("unroll") for (int j = 0; j < 4; ++j) { const int key = (KB) * 32 + 8 * g + 4 * hi + j; const bool ok = dir == 0 ? key <= q : key >= q; \
                const float sv = ok ? pp[4 * g + j] * __expf(av4[j] - Mq) : 0.f; pp[4 * g + j] = sv; rs += sv; } } \
        bf16x8 f0, f1; pack_p(pp, f0, f1); \
        { s16x4 l0, h0, l1, h1, l2, h2, l3, h3; constexpr int HH = (KB) >> 1, K0 = ((KB) & 1) * 2; \
          tr_frag_issue<0, K0>(vb + HH * 16384, l0, h0); tr_frag_issue<1, K0>(vb + HH * 16384, l1, h1); tr_frag_issue<2, K0>(vb + HH * 16384, l2, h2); tr_frag_issue<3, K0>(vb + HH * 16384, l3, h3); LGKM0(); \
          o[0] = __builtin_amdgcn_mfma_f32_32x32x16_bf16(f0, PKLH(l0, h0), o[0], 0, 0, 0); o[1] = __builtin_amdgcn_mfma_f32_32x32x16_bf16(f0, PKLH(l1, h1), o[1], 0, 0, 0); \
          o[2] = __builtin_amdgcn_mfma_f32_32x32x16_bf16(f0, PKLH(l2, h2), o[2], 0, 0, 0); o[3] = __builtin_amdgcn_mfma_f32_32x32x16_bf16(f0, PKLH(l3, h3), o[3], 0, 0, 0); \
          tr_frag_issue<0, K0 + 1>(vb + HH * 16384, l0, h0); tr_frag_issue<1, K0 + 1>(vb + HH * 16384, l1, h1); tr_frag_issue<2, K0 + 1>(vb + HH * 16384, l2, h2); tr_frag_issue<3, K0 + 1>(vb + HH * 16384, l3, h3); LGKM0(); \
          o[0] = __builtin_amdgcn_mfma_f32_32x32x16_bf16(f1, PKLH(l0, h0), o[0], 0, 0, 0); o[1] = __builtin_amdgcn_mfma_f32_32x32x16_bf16(f1, PKLH(l1, h1), o[1], 0, 0, 0); \
          o[2] = __builtin_amdgcn_mfma_f32_32x32x16_bf16(f1, PKLH(l2, h2), o[2], 0, 0, 0); o[3] = __builtin_amdgcn_mfma_f32_32x32x16_bf16(f1, PKLH(l3, h3), o[3], 0, 0, 0); } } } while (0)
    KBLK(0); KBLK(1); KBLK(2); KBLK(3);
#undef KBLK
    { auto rr = __builtin_amdgcn_permlane32_swap(__float_as_uint(rs), __float_as_uint(rs), false, false); rs = __uint_as_float(rr[0]) + __uint_as_float(rr[1]); }
    const float nqt = inter * nq + rs;
    const float den = fmaxf(fabsf(nqt), __expf(-(a4[q] + Mq)));
    if (hi == 0) wsc[32 + r32] = 1.f / den;
    asm volatile("s_waitcnt lgkmcnt(0)" ::: "memory");
#pragma unroll
    for (int d0 = 0; d0 < 4; ++d0)
#pragma unroll
        for (int r = 0; r < 16; ++r) o[d0][r] *= wsc[32 + crow(r, hi)];
    __syncthreads();
    if (dir == 1) {
#pragma unroll
        for (int d0 = 0; d0 < 4; ++d0)
#pragma unroll
            for (int r = 0; r < 16; ++r) xb[(qb * 32 + crow(r, hi)) * 128 + d0 * 32 + r32] = o[d0][r];
    }
    __syncthreads();
    if (dir == 0) {
        const u16* OG = (const u16*)(p.ws + OFF_OG); u16* mix = (u16*)(p.ws + OFF_ACT);
#pragma unroll
        for (int d0 = 0; d0 < 4; ++d0)
#pragma unroll
            for (int r = 0; r < 16; ++r) {
                const int ql = qb * 32 + crow(r, hi), v = d0 * 32 + r32;
                const float hv = o[d0][r] + xb[ql * 128 + v];
                const float og = bf2f(OG[(size_t)(row0 + ql) * 512 + h * 128 + v]);
                mix[(size_t)(row0 + ql) * 1024 + 512 + h * 128 + v] = f2bf(hv * og);
            }
    }
}

DEVI void phase_attn(const P& p, char* lds) {
    const int G = gridDim.x;
    for (int it = blockIdx.x; it < 520; it += G) {
        int q0, k0, seq, h;
        if (it < 512) {
            int bh, qb;
            if ((G & 7) == 0) { bh = it & 7; qb = it >> 3; } else { bh = it >> 6; qb = it & 63; }
            const int b = bh >> 2; h = bh & 3; q0 = b * TT + TC + qb * 256; k0 = b * TT; seq = TT;
        } else { const int b = (it - 512) >> 2; h = (it - 512) & 3; q0 = b * TT; k0 = b * TT; seq = TC; }
        diffattn_item(p, q0, k0, seq, h, lds);
    }
}
DEVI void phase_mlstm_c(const P& p, char* lds) {
    for (int it = blockIdx.x; it < NB * 4 * NCH; it += gridDim.x) mlstm_c_item(p, it, lds);
}

DEVI void phase_convert_l1(const P& p, char* lds) {
    for (int it = blockIdx.x; it < N0_EXP; it += gridDim.x) convert_expert_item(p, 1, it, (float*)lds);
}

constexpr int NPHASE = 19;
__global__ void __launch_bounds__(NTHR, 2) fwd_kernel(P p_) {
    extern __shared__ __attribute__((aligned(16))) char lds[];
    volatile LAS unsigned* st = (volatile LAS unsigned*)(lds + LDS_BYTES - 16);
    if (threadIdx.x == 0) { st[0] = 0u; st[1] = 0u; st[2] = 0u; st[3] = 0u; }
    __syncthreads();
    const int lo = p_.ph_lo, hi = p_.ph_hi;
    XcdBarrier bar; bar.bar = (unsigned*)(p_.ws + OFF_BAR); bar.x = 0; bar.st = st;
    if (hi - lo > 1) bar = xcd_barrier_post((unsigned*)(p_.ws + OFF_BAR), st);
#define PARAMS() const char* kp_ = (const char*)__builtin_amdgcn_kernarg_segment_ptr(); asm volatile("" : "+s"(kp_)); const P& p = *(const P*)kp_
#ifndef PHSEL
#define PHON(k) true
#else
#define PHON(k) ((k) == PHSEL)
#endif
#define IN(k) (lo <= (k) && (k) < hi)
#define SEAM(k) do { if (IN(k) && IN((k) + 1)) xcd_barrier(bar); } while (0)
    if (PHON(0) && IN(0)) { PARAMS(); phase_prologue(p, lds); }            SEAM(0);
    if (PHON(1) && IN(1)) { PARAMS(); phase_norm<0>(p, lds); }             SEAM(1);
    if (PHON(2) && IN(2)) { PARAMS(); phase_inproj(p, lds); }              SEAM(2);
    if (PHON(3) && IN(3)) { PARAMS(); phase_mlstm_a(p, lds); }             SEAM(3);
    if (PHON(4) && IN(4)) { PARAMS(); phase_mlstm_b(p, lds); }             SEAM(4);
    if (PHON(5) && IN(5)) { PARAMS(); phase_attn(p, lds); }                SEAM(5);
    if (PHON(6) && IN(6)) { PARAMS(); phase_mlstm_c(p, lds); }             SEAM(6);
    if (PHON(7) && IN(7)) { PARAMS(); phase_outproj(p, lds); }             SEAM(7);
    if (PHON(8) && IN(8)) { PARAMS(); phase_norm<1>(p, lds); }             SEAM(8);
    if (PHON(9) && IN(9)) { PARAMS(); phase_moe_up(p, 0, lds); }           SEAM(9);
    if (PHON(10) && IN(10)) { PARAMS(); phase_moe_down(p, 0, lds); }        SEAM(10);
    if (PHON(11) && IN(11)) { PARAMS(); phase_norm<2>(p, lds); phase_convert_l1(p, lds); } SEAM(11);
    if (PHON(12) && IN(12)) { PARAMS(); phase_fnet_gemm(p, lds); }          SEAM(12);
    if (PHON(13) && IN(13)) { PARAMS(); phase_fft1(p, lds); }               SEAM(13);
    if (PHON(14) && IN(14)) { PARAMS(); phase_fft2(p, lds); }               SEAM(14);
    if (PHON(15) && IN(15)) { PARAMS(); phase_norm<3>(p, lds); }            SEAM(15);
    if (PHON(16) && IN(16)) { PARAMS(); phase_moe_up(p, 1, lds); }          SEAM(16);
    if (PHON(17) && IN(17)) { PARAMS(); phase_moe_down(p, 1, lds); }        SEAM(17);
    if (PHON(18) && IN(18)) { PARAMS(); phase_norm<4>(p, lds); }
#undef IN
#undef SEAM
}

#ifndef ONE_LAUNCH
#define ONE_LAUNCH 1
#endif
extern "C" void kernel_launch(void* const* d_in, const int* in_sizes, int n_in, void* d_out, int out_size, void* d_ws, size_t ws_size, hipStream_t stream) {
    static int grid = 0;
    if (grid == 0) {
        if (n_in != 21 || out_size != NLAT * DM || ws_size < OFF_END) { fprintf(stderr, "kernel_launch: unexpected shapes (n_in %d out %d ws %zu need %zu)\n", n_in, out_size, ws_size, (size_t)OFF_END); grid = -1; return; }
        int dev = 0, cus = 0;
        if (hipGetDevice(&dev) != hipSuccess || hipDeviceGetAttribute(&cus, hipDeviceAttributeMultiprocessorCount, dev) != hipSuccess) { grid = -1; return; }
        if (hipFuncSetAttribute((const void*)fwd_kernel, hipFuncAttributeMaxDynamicSharedMemorySize, LDS_BYTES) != hipSuccess) { fprintf(stderr, "kernel_launch: hipFuncSetAttribute failed\n"); grid = -1; return; }
        int per_cu = 0;
        if (hipOccupancyMaxActiveBlocksPerMultiprocessor(&per_cu, (const void*)fwd_kernel, NTHR, LDS_BYTES) != hipSuccess || per_cu < 1) { fprintf(stderr, "kernel_launch: occupancy query says %d\n", per_cu); (void)hipGetLastError(); grid = -1; return; }
        grid = cus;
    }
    if (grid < 0) return;
    (void)hipMemsetAsync(d_ws, 0, ZERO_BYTES, stream);
    P p{};
    const float* const* in = (const float* const*)d_in;
    p.x = in[0]; p.c = in[1]; p.ctx = in[2]; p.c_ctx = in[3]; p.ada_w = in[4]; p.ada_b = in[5]; p.nmix_g = in[6]; p.nffn_g = in[7];
    p.w_in = in[8]; p.w_out = in[9]; p.conv_w = in[10]; p.gate_b = in[11]; p.lamv = in[12]; p.subln_g = in[13]; p.w_fnet = in[14];
    p.router_w = in[15]; p.router_b = in[16]; p.w_gate = in[17]; p.w_up = in[18]; p.w_down = in[19]; p.final_g = in[20];
    p.out = (float*)d_out; p.ws = (char*)d_ws;
#if ONE_LAUNCH
    p.ph_lo = 0; p.ph_hi = NPHASE;
    hipLaunchKernelGGL(fwd_kernel, dim3(grid), dim3(NTHR), LDS_BYTES, stream, p);
#else
    for (int k = 0; k < NPHASE; ++k) { p.ph_lo = k; p.ph_hi = k + 1; hipLaunchKernelGGL(fwd_kernel, dim3(grid), dim3(NTHR), LDS_BYTES, stream, p); }
#endif
}
```

```cpp
#include <hip/hip_runtime.h>
#include <stdint.h>
#include <stdio.h>

#define DEVI __device__ __forceinline__
#define PROBE_DUP 0u
typedef unsigned short u16;
typedef unsigned int u32;
using bf16x8 = __attribute__((ext_vector_type(8))) short;
using s16x4  = __attribute__((ext_vector_type(4))) short;
using f32x16 = __attribute__((ext_vector_type(16))) float;
using f32x4  = __attribute__((ext_vector_type(4))) float;
using u32x4  = __attribute__((ext_vector_type(4))) unsigned;
using u32x2  = __attribute__((ext_vector_type(2))) unsigned;

constexpr int DM = 1024, NB = 2, TL = 16384, TC = 256, TT = TL + TC, NTOK = NB * TT, NLAT = NB * TL;
constexpr int NCH = TT / 128;
constexpr int NTHR = 512;
constexpr int LDS_BYTES = 147456;

constexpr size_t al256(size_t x) { return (x + 255) / 256 * 256; }
constexpr size_t OFF_BAR   = 0;
constexpr size_t OFF_CNT   = 16384;
constexpr size_t ZERO_BYTES = 20480;
constexpr size_t OFF_MOD   = ZERO_BYTES;
constexpr size_t OFF_ROPER = OFF_MOD + al256(2 * 3 * 6144 * 4);
constexpr size_t OFF_ROPEC = OFF_ROPER + 256 * 16 * 8;
constexpr size_t OFF_TW    = OFF_ROPEC + 64 * 16 * 8;
constexpr size_t OFF_DFTC  = OFF_TW + 16384 * 8;
constexpr size_t OFF_DFTS  = OFF_DFTC + 32768;
constexpr size_t OFF_LAM   = OFF_DFTS + 32768;
constexpr size_t OFF_WG16  = OFF_LAM + 256;
constexpr size_t OFF_MSCAL = OFF_WG16 + 65536;
constexpr size_t OFF_MST   = OFF_MSCAL + al256(16 * NCH * 8);
constexpr size_t OFF_WINT  = OFF_MST + al256(16 * NCH * 4);
constexpr size_t OFF_WOUTT = OFF_WINT + (size_t)3584 * 1024 * 2;
constexpr size_t OFF_FNT   = OFF_WOUTT + (size_t)1024 * 1024 * 2;
constexpr size_t OFF_WGU   = OFF_FNT + (size_t)2048 * 1024 * 2;
constexpr size_t OFF_WDT   = OFF_WGU + (size_t)16 * 1024 * 1024 * 2;
constexpr size_t OFF_ACT   = OFF_WDT + (size_t)16 * 1024 * 512 * 2;
constexpr size_t SZ_ACT    = (size_t)NTOK * 1024 * 2;
constexpr size_t OFF_XC    = OFF_ACT + SZ_ACT;
constexpr size_t OFF_GATES = OFF_XC + (size_t)NB * TC * 1024 * 4;
constexpr size_t OFF_TOKW  = OFF_GATES + (size_t)NTOK * 16 * 4;
constexpr size_t OFF_LIST  = OFF_TOKW + al256((size_t)NTOK * 8);
constexpr size_t OFF_NST   = OFF_LIST + (size_t)24 * NTOK * 4;
constexpr size_t OFF_CST   = OFF_NST + (size_t)16 * NCH * 128 * 4;
constexpr size_t SZ_CST    = (size_t)16 * NCH * 16384 * 2;
constexpr size_t OFF_BIG   = OFF_CST + SZ_CST;
constexpr size_t OFF_Q     = OFF_BIG;
constexpr size_t OFF_K     = OFF_Q + (size_t)NTOK * 512 * 2;
constexpr size_t OFF_V     = OFF_K + (size_t)NTOK * 512 * 2;
constexpr size_t OFF_MLQK  = OFF_V + (size_t)NTOK * 512 * 2;
constexpr size_t OFF_MLV   = OFF_MLQK + (size_t)NTOK * 1024 * 2;
constexpr size_t OFF_OG    = OFF_MLV + (size_t)NTOK * 512 * 2;
constexpr size_t OFF_END   = OFF_OG + (size_t)NTOK * 512 * 2;
constexpr size_t OFF_HE    = OFF_BIG;
constexpr size_t OFF_ZR    = OFF_BIG;
constexpr size_t OFF_ZI    = OFF_ZR + (size_t)NLAT * 1024 * 2;
constexpr size_t OFF_YR    = OFF_CST;
constexpr size_t OFF_YI    = OFF_ACT;
static_assert((size_t)NLAT * 1024 * 2 <= SZ_CST && (size_t)NLAT * 1024 * 2 <= SZ_ACT, "alias sizes");
static_assert(OFF_END < (size_t)500 * 1024 * 1024, "workspace");

struct P {
    const float *x, *c, *ctx, *c_ctx, *ada_w, *ada_b, *nmix_g, *nffn_g, *w_in, *w_out, *conv_w, *gate_b, *lamv, *subln_g,
                *w_fnet, *router_w, *router_b, *w_gate, *w_up, *w_down, *final_g;
    float* out;
    char* ws;
    int ph_lo, ph_hi;
};

#define XB_TMO      128
#define XB_XCNT(j)  (256  + 64 * (j))
#define XB_XSUB(j)  (1280 + 64 * (j))
#define XB_XGEN(j)  (2304 + 64 * (j))
#define XB_TOP      3328
#define XB_TOPGEN   3392
#define XCD_BAR_WORDS 3456
#define XB_SPIN_CAP (1u << 18)
#define LAS __attribute__((address_space(3)))

__device__ __forceinline__ unsigned xb_ld(unsigned* p)              { return __hip_atomic_load(p, __ATOMIC_RELAXED, __HIP_MEMORY_SCOPE_AGENT); }
__device__ __forceinline__ unsigned xb_add(unsigned* p, unsigned v) { return __hip_atomic_fetch_add(p, v, __ATOMIC_RELAXED, __HIP_MEMORY_SCOPE_AGENT); }
__device__ __forceinline__ unsigned xb_xcc_id() { return (unsigned)__builtin_amdgcn_s_getreg((3 << 11) | 20) & 0xFu; }
#define XB_SPIN(cond, bar) do { unsigned _sp = 0; while (cond) { __builtin_amdgcn_s_sleep(1); \
    if ((++_sp & 255u) == 0u) { if (xb_ld(&(bar)[XB_TMO])) break; if (_sp > XB_SPIN_CAP) { atomicAdd(&(bar)[XB_TMO], 1u); break; } } } } while (0)

struct XcdBarrier { unsigned* bar; unsigned x; volatile LAS unsigned* st; };

__device__ __forceinline__ XcdBarrier xcd_barrier_post(unsigned* bar, volatile LAS unsigned* st) {
    XcdBarrier b; b.bar = bar; b.x = xb_xcc_id(); b.st = st;
    if (threadIdx.x == 0) (void)xb_add(&bar[XB_XCNT(b.x)], 1u);
    return b;
}
__device__ __forceinline__ void xcd_barrier_complete(unsigned* bar, unsigned x, unsigned& nloc, unsigned& nx) {
    const unsigned G = gridDim.x * gridDim.y * gridDim.z;
    unsigned sum, cnt, mine, sp = 0u;
    for (;;) {
        sum = 0u; cnt = 0u; mine = 0u;
#pragma unroll
        for (unsigned j = 0; j < 16; ++j) { const unsigned c = xb_ld(&bar[XB_XCNT(j)]); sum += c; cnt += (c > 0u) ? 1u : 0u; mine = (j == x) ? c : mine; }
        if (sum == G) break;
        __builtin_amdgcn_s_sleep(1);
        if ((++sp & 255u) == 0u) { if (xb_ld(&bar[XB_TMO])) break; if (sp > XB_SPIN_CAP) { atomicAdd(&bar[XB_TMO], 1u); break; } }
    }
    nloc = mine > 0u ? mine : 1u; nx = cnt > 0u ? cnt : 1u;
}
__device__ __forceinline__ void xcd_barrier(const XcdBarrier& b) {
    asm volatile("s_waitcnt vmcnt(0)" ::: "memory");
    __syncthreads();
    if (threadIdx.x == 0) {
        unsigned* bar = b.bar;
        __builtin_amdgcn_s_waitcnt(0);
        unsigned nloc = b.st[0], nx = b.st[1];
        if (nloc == 0u) { xcd_barrier_complete(bar, b.x, nloc, nx); b.st[0] = nloc; b.st[1] = nx; }
        const unsigned old = xb_add(&bar[XB_XSUB(b.x)], 1u);
        const unsigned gen = old / nloc;
        if (old + 1u == (gen + 1u) * nloc) {
            __builtin_amdgcn_fence(__ATOMIC_RELEASE, "agent");
            asm volatile("s_waitcnt vmcnt(0)" ::: "memory");
            const unsigned og = xb_add(&bar[XB_TOP], 1u);
            const unsigned tg = og / nx;
            if (og + 1u == (tg + 1u) * nx) xb_add(&bar[XB_TOPGEN], 1u);
            else XB_SPIN(xb_ld(&bar[XB_TOPGEN]) == tg, bar);
            __builtin_amdgcn_fence(__ATOMIC_ACQUIRE, "agent");
            xb_add(&bar[XB_XGEN(b.x)], 1u);
            asm volatile("s_waitcnt vmcnt(0)" ::: "memory");
        } else {
            XB_SPIN(xb_ld(&bar[XB_XGEN(b.x)]) == gen, bar);
            __builtin_amdgcn_fence(__ATOMIC_ACQUIRE, "agent");
            asm volatile("s_waitcnt vmcnt(0)" ::: "memory");
        }
    }
    __syncthreads();
}

DEVI u16 f2bf(float f) { u32 u = __float_as_uint(f); u += 0x7fffu + ((u >> 16) & 1u); return (u16)(u >> 16); }
DEVI float bf2f(u32 h) { return __uint_as_float(h << 16); }
DEVI u32 cvtpk(float lo, float hi) { u32 r; asm("v_cvt_pk_bf16_f32 %0, %1, %2" : "=v"(r) : "v"(lo), "v"(hi)); return r; }
DEVI float bflo(u32 w) { return __uint_as_float(w << 16); }
DEVI float bfhi(u32 w) { return __uint_as_float(w & 0xffff0000u); }
DEVI int crow(int r, int hi) { return (r & 3) + 8 * (r >> 2) + 4 * hi; }
DEVI float wave_sum(float v) { for (int o = 32; o; o >>= 1) v += __shfl_xor(v, o); return v; }
DEVI float wave_max(float v) { for (int o = 32; o; o >>= 1) v = fmaxf(v, __shfl_xor(v, o)); return v; }
DEVI float sigmoidf_(float x) { return 1.f / (1.f + __expf(-x)); }
DEVI float siluf_(float x) { return x / (1.f + __expf(-x)); }
DEVI float logsigmoidf_(float x) { return fminf(x, 0.f) - log1pf(__expf(-fabsf(x))); }
#define SBAR() __builtin_amdgcn_sched_barrier(0)

DEVI void sincos2pi(double frac, double& s, double& c) {
    frac -= floor(frac);
    double q = rint(frac * 4.0);
    double r = (frac - q * 0.25) * 6.283185307179586476925;
    double r2 = r * r;
    double sr = r * (1.0 + r2 * (-1.0 / 6 + r2 * (1.0 / 120 + r2 * (-1.0 / 5040 + r2 * (1.0 / 362880 + r2 * (-1.0 / 39916800 + r2 * (1.0 / 6227020800.0 + r2 * (-1.0 / 1307674368000.0))))))));
    double cr = 1.0 + r2 * (-0.5 + r2 * (1.0 / 24 + r2 * (-1.0 / 720 + r2 * (1.0 / 40320 + r2 * (-1.0 / 3628800 + r2 * (1.0 / 479001600.0 + r2 * (-1.0 / 87178291200.0 + r2 * (1.0 / 20922789888000.0))))))));
    int qi = ((int)q) & 3;
    if (qi == 0) { s = sr; c = cr; } else if (qi == 1) { s = cr; c = -sr; } else if (qi == 2) { s = -sr; c = -cr; } else { s = -cr; c = sr; }
}

DEVI float* xs_ptr(const P& p, int layer, int tok) {
    if (layer == 0) {
        int b = tok >= TT ? 1 : 0, t = tok - b * TT;
        if (t < TC) return (float*)(p.ws + OFF_XC) + (size_t)(b * TC + t) * DM;
        return p.out + (size_t)(b * TL + t - TC) * DM;
    }
    return p.out + (size_t)tok * DM;
}
DEVI const float* xin_ptr(const P& p, int tok) {
    int b = tok >= TT ? 1 : 0, t = tok - b * TT;
    if (t < TC) return p.ctx + (size_t)(b * TC + t) * DM;
    return p.x + (size_t)(b * TL + t - TC) * DM;
}
DEVI int modsel(int layer, int tok) {
    if (layer == 0) { int b = tok >= TT ? 1 : 0, t = tok - b * TT; return t < TC ? 2 : b; }
    return tok >> 14;
}

DEVI int swz128(int row, int chunk) { return row * 144 + (chunk << 4); }
DEVI int swz256(int row, int chunk) { return row * 272 + (chunk << 4); }
DEVI int v_st(int k, int c) { const int kk = (k & ~0xC) | ((k & 4) << 1) | ((k & 8) >> 1); return ((kk >> 3) * 4 + (c >> 5)) * 512 + ((kk & 7) * 32 + (c & 31)) * 2; }
DEVI int v_rd_base(int lane) { return ((lane & 3) << 3) | (((lane >> 2) & 3) << 6) | (((lane >> 4) & 1) << 5) | (((lane >> 5) & 1) << 8); }
constexpr int v_rd_off(int d0, int ks, int half) { return d0 * 512 + ks * 4096 + half * 2048; }
template <int OFF> DEVI s16x4 tr_read(int vb) {
    s16x4 r; asm volatile("ds_read_b64_tr_b16 %0, %1 offset:%2" : "=&v"(r) : "v"(vb), "i"(OFF) : "memory"); return r;
}
#define PKLH(L, H) (bf16x8){L[0], L[1], L[2], L[3], H[0], H[1], H[2], H[3]}
template <int D0, int KS> DEVI void tr_frag_issue(int vb, s16x4& l, s16x4& h) { l = tr_read<v_rd_off(D0, KS, 0)>(vb); h = tr_read<v_rd_off(D0, KS, 1)>(vb); }
#define LGKM0() do { asm volatile("s_waitcnt lgkmcnt(0)" ::: "memory"); SBAR(); } while (0)

DEVI bf16x8 lds_b128(const char* base, int off) { return *reinterpret_cast<const bf16x8*>(base + off); }

DEVI void pack_p(const f32x16& pp, bf16x8& f0, bf16x8& f1) {
#define PK4(BASE, OUT) do { unsigned a0 = cvtpk(pp[BASE + 0], pp[BASE + 1]), a1 = cvtpk(pp[BASE + 2], pp[BASE + 3]);   \
    unsigned b0 = cvtpk(pp[BASE + 4], pp[BASE + 5]), b1 = cvtpk(pp[BASE + 6], pp[BASE + 7]);                            \
    auto r0 = __builtin_amdgcn_permlane32_swap(a0, b0, false, false); auto r1 = __builtin_amdgcn_permlane32_swap(a1, b1, false, false); \
    u32x4 w = {r0[0], r1[0], r0[1], r1[1]}; OUT = *reinterpret_cast<bf16x8*>(&w); } while (0)
    PK4(0, f0); PK4(8, f1);
#undef PK4
}

namespace g8 {
constexpr int BM = 256, BK = 64, HALF = 128, HTB = HALF * BK * 2, STAGE_BYTES = 8 * HTB, NXCD = 8, WGM = 8;
DEVI int lds_byte(int r, int c) { const int st = (r >> 4) * 2 + (c >> 5), rr = r & 15, cc = c & 31, ob = rr * 64 + cc * 2; return st * 1024 + (ob ^ (((ob >> 9) & 1) << 5)); }
DEVI void stage_rc(int b, int& R, int& C) { const int st = b / 1024, sb = b % 1024, swz = sb ^ (((sb >> 9) & 1) << 5); R = (st >> 1) * 16 + swz / 64; C = (st & 1) * 32 + (swz % 64) / 2; }
DEVI int perm32(int rho) { const int n = rho >> 4, i = rho & 15; return 8 * (i >> 2) + 4 * n + (i & 3); }
struct Unit { int pm, pn; const char* B0; const char* B1; int cls, r0, ncls; };
DEVI bool tile_order(int i, int G, int c, int nM, int nN, int& pm, int& pn) {
    const int nwg = nM * nN; const long L = (long)i * G + c; if (L >= nwg) return false;
    int wgid = (int)L; { const int q = nwg / NXCD, r = nwg % NXCD, xcd = wgid % NXCD, off = wgid / NXCD; wgid = (xcd < r ? xcd * (q + 1) : r * (q + 1) + (xcd - r) * q) + off; }
    const int nig = WGM * nN, gid = wgid / nig, fm = gid * WGM, gsz = (nM - fm) < WGM ? (nM - fm) : WGM;
    pm = fm + ((wgid % nig) % gsz); pn = (wgid % nig) / gsz; return true;
}
typedef float f32x4v __attribute__((ext_vector_type(4)));
template <class Epi, class Sched>
DEVI void gemm_phase(LAS unsigned char* lds, const char* Abase, int ldbB  , int ksplit  , const Sched& S, const Epi& E) {
    const int tid = threadIdx.x, wid = __builtin_amdgcn_readfirstlane(tid >> 6), lane = tid & 63, wr = wid >> 2, wc = wid & 3, fr = lane & 15, fq = lane >> 4;
    constexpr int nt = 1024 / BK;
    unsigned voffB[2];
#pragma unroll
    for (int i = 0; i < 2; ++i) { int R, C; stage_rc(tid * 16 + i * 8192, R, C); const int Rb = Epi::PERM ? ((R & ~31) + perm32(R & 31)) : R; voffB[i] = (unsigned)(Rb * ldbB + C * 2); }
    const size_t kstep = (size_t)(BK * 2);
    const size_t hstepB = (size_t)HALF * ldbB;
    const unsigned ldsw = (unsigned)wid * 1024u;
    const int aoff = lds_byte(wr * 64 + fr, fq * 8), boff = lds_byte(wc * 32 + fr, fq * 8);
#define G8_SA(b, h) (((b) * 2 + (h)) * HTB)
#define G8_SB(b, h) ((4 + (b) * 2 + (h)) * HTB)
#define G8_STAGE(bufoff, gbase, voff) do { _Pragma("unroll") for (int _i = 0; _i < 2; ++_i) \
        __builtin_amdgcn_global_load_lds((const unsigned*)((const char*)(gbase) + (voff)[_i]), (LAS unsigned*)(lds + (bufoff) + ldsw + _i * 8192), 16, 0, 0); } while (0)
#define G8_LDA(dst, b, h) do { _Pragma("unroll") for (int m = 0; m < 4; ++m) _Pragma("unroll") for (int k = 0; k < 2; ++k) dst[m][k] = *(const LAS bf16x8*)(lds + G8_SA(b, h) + aoff + m * 2048 + k * 1024); } while (0)
#define G8_LDB(dst, b, h) do { _Pragma("unroll") for (int n = 0; n < 2; ++n) _Pragma("unroll") for (int k = 0; k < 2; ++k) dst[n][k] = *(const LAS bf16x8*)(lds + G8_SB(b, h) + boff + n * 2048 + k * 1024); } while (0)
#define G8_MMA(ai, bj, At, Bt) do { __builtin_amdgcn_s_setprio(1); _Pragma("unroll") for (int m = 0; m < 4; ++m) _Pragma("unroll") for (int n = 0; n < 2; ++n) _Pragma("unroll") for (int k = 0; k < 2; ++k) \
        acc[ai][bj][m][n] = __builtin_amdgcn_mfma_f32_16x16x32_bf16(Bt[n][k], At[m][k], acc[ai][bj][m][n], 0, 0, 0); __builtin_amdgcn_s_setprio(0); } while (0)
#define G8_WAIT_V(n) asm volatile("s_waitcnt vmcnt(" #n ")" ::: "memory")
#define G8_WAIT_L(n) asm volatile("s_waitcnt lgkmcnt(" #n ")" ::: "memory")
#define G8_BAR __builtin_amdgcn_s_barrier()
#define G8_SCHED __builtin_amdgcn_sched_barrier(0)
#define G8_BPTR(u, kt) (((kt) < ksplit ? (u).B0 : (u).B1) + (size_t)(kt) * kstep)
    Unit cur, nxt; int ui = 0;
    if (!S.next(0, cur)) return;
    f32x4v acc[2][2][4][2];
#pragma unroll
    for (int a = 0; a < 2; ++a)
#pragma unroll
        for (int b = 0; b < 2; ++b)
#pragma unroll
            for (int m = 0; m < 4; ++m)
#pragma unroll
                for (int n = 0; n < 2; ++n) acc[a][b][m][n] = (f32x4v){0.f, 0.f, 0.f, 0.f};
    bf16x8 At[4][2], B0[2][2], B1[2][2];
    unsigned voffA[2]; unsigned vs[2][2];
    constexpr size_t hstepA = (size_t)HALF * 2048, tstepA = 2 * hstepA;
    if constexpr (Sched::GATHER) S.aoffs(cur, vs);
    else {
#pragma unroll
        for (int i = 0; i < 2; ++i) { int R, C; stage_rc(tid * 16 + i * 8192, R, C); voffA[i] = (unsigned)(R * 2048 + C * 2); }
    }
    const char* cA = Sched::GATHER ? Abase : Abase + (size_t)cur.pm * tstepA;
#define G8_STAGE_A(bufoff, ptr, h) do { if constexpr (Sched::GATHER) G8_STAGE(bufoff, ptr, vs[h]); else G8_STAGE(bufoff, (ptr) + (h) * hstepA, voffA); } while (0)
    { const char* cB = G8_BPTR(cur, 0); const char* cB1 = G8_BPTR(cur, 1);
      G8_STAGE(G8_SB(0, 0), cB, voffB); G8_STAGE_A(G8_SA(0, 0), cA, 0); G8_STAGE(G8_SB(0, 1), cB + hstepB, voffB); G8_STAGE_A(G8_SA(0, 1), cA, 1);
      if (wr == 1) G8_BAR;
      G8_WAIT_V(4); G8_BAR;
      G8_STAGE(G8_SB(1, 0), cB1, voffB); G8_STAGE_A(G8_SA(1, 0), cA + kstep, 0); G8_STAGE(G8_SB(1, 1), cB1 + hstepB, voffB);
      G8_WAIT_V(6); G8_BAR; }
    for (;;) {
        bool has_next = false; const char* nA = cA;
        for (int t = 0; t < nt; t += 2) {
            const bool last = (t == nt - 2);
            const char* a1 = cA + (size_t)(t + 1) * kstep;
            G8_LDB(B0, 0, 0); G8_SCHED; G8_LDA(At, 0, 0); G8_STAGE_A(G8_SA(1, 1), a1, 1);
            G8_WAIT_L(8); G8_BAR; G8_WAIT_L(0); G8_MMA(0, 0, At, B0); G8_BAR; G8_SCHED;
            if (last) {
                has_next = S.next(ui + 1, nxt);
                if (has_next) { if constexpr (Sched::GATHER) S.aoffs(nxt, vs); else nA = Abase + (size_t)nxt.pm * tstepA; } else nxt = cur;
            }
            const char* a2 = last ? nA : cA + (size_t)(t + 2) * kstep; const char* a3 = a2 + kstep;
            const char* b2 = last ? G8_BPTR(nxt, 0) : G8_BPTR(cur, t + 2); const char* b3 = last ? G8_BPTR(nxt, 1) : G8_BPTR(cur, t + 3);
            G8_LDB(B1, 0, 1); G8_STAGE(G8_SB(0, 0), b2, voffB);
            G8_BAR; G8_WAIT_L(0); G8_MMA(0, 1, At, B1); G8_BAR;
            G8_LDA(At, 0, 1); G8_STAGE_A(G8_SA(0, 0), a2, 0);
            G8_BAR; G8_WAIT_L(0); G8_MMA(1, 0, At, B0); G8_BAR; G8_SCHED;
            G8_STAGE(G8_SB(0, 1), b2 + hstepB, voffB);
            G8_WAIT_V(6); G8_BAR; G8_MMA(1, 1, At, B1); G8_BAR;
            G8_LDB(B0, 1, 0); G8_SCHED; G8_LDA(At, 1, 0); G8_STAGE_A(G8_SA(0, 1), a2, 1);
            G8_WAIT_L(8); G8_BAR; G8_WAIT_L(0); G8_MMA(0, 0, At, B0); G8_BAR; G8_SCHED;
            G8_LDB(B1, 1, 1); G8_STAGE(G8_SB(1, 0), b3, voffB);
            G8_BAR; G8_WAIT_L(0); G8_MMA(0, 1, At, B1); G8_BAR;
            G8_LDA(At, 1, 1); G8_STAGE_A(G8_SA(1, 0), a3, 0);
            G8_BAR; G8_WAIT_L(0); G8_MMA(1, 0, At, B0); G8_BAR; G8_SCHED;
            G8_STAGE(G8_SB(1, 1), b3 + hstepB, voffB);
            G8_WAIT_V(6); G8_BAR; G8_MMA(1, 1, At, B1); G8_BAR;
        }
        cA = nA;
        { int tz = threadIdx.x; asm volatile("" : "+v"(tz));
          const int w2 = tz >> 6, l2 = tz & 63; E(acc, cur, w2 >> 2, w2 & 3, l2 & 15, l2 >> 4); }
        if (!has_next) break;
#pragma unroll
        for (int a = 0; a < 2; ++a)
#pragma unroll
            for (int b = 0; b < 2; ++b)
#pragma unroll
                for (int m = 0; m < 4; ++m)
#pragma unroll
                    for (int n = 0; n < 2; ++n) acc[a][b][m][n] = (f32x4v){0.f, 0.f, 0.f, 0.f};
        cur = nxt; ++ui;
    }
    G8_WAIT_V(0);
    if (wr == 0) G8_BAR;
    G8_BAR;
#undef G8_SA
#undef G8_SB
#undef G8_STAGE
#undef G8_STAGE_A
#undef G8_LDA
#undef G8_LDB
#undef G8_MMA
#undef G8_WAIT_V
#undef G8_WAIT_L
#undef G8_BAR
#undef G8_SCHED
#undef G8_BPTR
}
DEVI void lane_rc(int i, int& R, int& C) { int tz = threadIdx.x; asm volatile("" : "+v"(tz)); stage_rc(tz * 16 + i * 8192, R, C); }
struct DenseSched {
    static constexpr bool GATHER = false;
    const char* Bt; int nM, nN, G, c; size_t btile;
    DEVI bool next(int i, Unit& u) const { if (!tile_order(i, G, c, nM, nN, u.pm, u.pn)) return false; u.B0 = u.B1 = Bt + (size_t)u.pn * btile; u.cls = 0; u.r0 = 0; u.ncls = 0; return true; }
    DEVI void aoffs(const Unit& u, unsigned (&v)[2][2]) const {
#pragma unroll
        for (int i = 0; i < 2; ++i) { int R, C; lane_rc(i, R, C);
#pragma unroll
            for (int h = 0; h < 2; ++h) v[h][i] = (unsigned)(((u.pm * 256 + h * 128 + R) * 1024 + C) * 2); }
    }
};
}

template <class PF>
DEVI void transpose_tile(PF colptr, int ldsrc, u16* dst, int lddst, int k0, int n0, float* tl) {
    const int t = threadIdx.x, nn = t & 63, kk = t >> 6;
    const float* sp = colptr(n0 + nn);
#pragma unroll
    for (int i = 0; i < 8; ++i) tl[(kk + 8 * i) * 65 + nn] = sp[(size_t)(k0 + kk + 8 * i) * ldsrc];
    __syncthreads();
    const int n = t >> 3, kc = t & 7;
    u32x4 w;
    w[0] = cvtpk(tl[(kc * 8 + 0) * 65 + n], tl[(kc * 8 + 1) * 65 + n]);
    w[1] = cvtpk(tl[(kc * 8 + 2) * 65 + n], tl[(kc * 8 + 3) * 65 + n]);
    w[2] = cvtpk(tl[(kc * 8 + 4) * 65 + n], tl[(kc * 8 + 5) * 65 + n]);
    w[3] = cvtpk(tl[(kc * 8 + 6) * 65 + n], tl[(kc * 8 + 7) * 65 + n]);
    *reinterpret_cast<u32x4*>(dst + (size_t)(n0 + n) * lddst + k0 + kc * 8) = w;
    __syncthreads();
}

DEVI void convert_expert_item(const P& p, int layer, int it, float* tl) {
    const int e = it / 384, r = it % 384;
    const float* wg = p.w_gate + ((size_t)layer * 16 + e) * 1024 * 512;
    const float* wu = p.w_up   + ((size_t)layer * 16 + e) * 1024 * 512;
    const float* wd = p.w_down + ((size_t)layer * 16 + e) * 512 * 1024;
    if (r < 256) {
        u16* dst = (u16*)(p.ws + OFF_WGU) + (size_t)e * 1024 * 1024;
        const int kt = r >> 4, nt = r & 15;
        transpose_tile([&](int n) { const int q = n >> 3, sgu = (n >> 2) & 1, j = n & 3; return (sgu ? wu : wg) + q * 4 + j; }, 512, dst, 1024, kt * 64, nt * 64, tl);
    } else {
        const int q = r - 256; u16* dst = (u16*)(p.ws + OFF_WDT) + (size_t)e * 1024 * 512;
        const int kt = q >> 4, nt = q & 15;
        transpose_tile([&](int n) { return wd + n; }, 1024, dst, 512, kt * 64, nt * 64, tl);
    }
}

constexpr int N0_WIN = 16 * 56, N0_WOUT = 256, N0_EXP = 16 * 384, N0_FN = 2048, N0_MOD = 192, N0_TAB = 128;
constexpr int N0_TOTAL = N0_WIN + N0_WOUT + N0_EXP + N0_FN + N0_MOD + N0_TAB;

DEVI void phase_prologue(const P& p, char* lds) {
    float* tl = (float*)lds;
    const int tid = threadIdx.x;
    for (int it = blockIdx.x; it < N0_TOTAL; it += gridDim.x) {
        int r = it;
        if (r < N0_WIN) {
            const int kt = r / 56, nt = r % 56;
            const float* w = p.w_in;
            transpose_tile([&](int n) { return w + n; },
                           3600, (u16*)(p.ws + OFF_WINT), 1024, kt * 64, nt * 64, tl);
            continue;
        }
        r -= N0_WIN;
        if (r < N0_WOUT) {
            const int kt = r >> 4, nt = r & 15; const float* w = p.w_out;
            transpose_tile([&](int n) { return w + n; }, 1024, (u16*)(p.ws + OFF_WOUTT), 1024, kt * 64, nt * 64, tl);
            continue;
        }
        r -= N0_WOUT;
        if (r < N0_EXP) { convert_expert_item(p, 0, r, tl); continue; }
        r -= N0_EXP;
        if (r < N0_FN) {
            float* cs = tl; float* sn = tl + 256;
            if (tid < 256) { double s, c; sincos2pi(tid / 256.0, s, c); cs[tid] = (float)c; sn[tid] = (float)s; }
            __syncthreads();
            const int idx = r * 512 + tid, n = idx >> 10, k = idx & 1023, g = k >> 8, c = k & 255;
            const float* W = p.w_fnet + (size_t)(g * 256) * 1024 + n;
            float ac = 0.f, as = 0.f;
            for (int c2 = 0; c2 < 256; ++c2) { const float w = W[(size_t)c2 * 1024]; const int j = (c * c2) & 255; ac = fmaf(cs[j], w, ac); as = fmaf(sn[j], w, as); }
            u16* F = (u16*)(p.ws + OFF_FNT);
            F[(size_t)n * 1024 + k] = f2bf(ac * (1.f / 2048.f));
            F[(size_t)(1024 + n) * 1024 + k] = f2bf(-as * (1.f / 2048.f));
            __syncthreads();
            continue;
        }
        r -= N0_FN;
        if (r < N0_MOD) {
            float* sv = tl;
            float* part = tl + 3072;
            for (int i = tid; i < 3072; i += NTHR) { const int v = i >> 10, k = i & 1023; const float xv = v < 2 ? p.c[v * 1024 + k] : p.c_ctx[k]; sv[i] = siluf_(xv); }
            __syncthreads();
            const int j0 = r * 64, L = j0 / 6144, col0 = j0 % 6144, kg = tid >> 6, cl = tid & 63;
            const float* W = p.ada_w + (size_t)L * 1024 * 6144 + col0 + cl;
            float a0 = 0.f, a1 = 0.f, a2 = 0.f;
            for (int k = kg * 128; k < kg * 128 + 128; ++k) { const float w = W[(size_t)k * 6144]; a0 = fmaf(sv[k], w, a0); a1 = fmaf(sv[1024 + k], w, a1); a2 = fmaf(sv[2048 + k], w, a2); }
            part[(kg * 3 + 0) * 64 + cl] = a0; part[(kg * 3 + 1) * 64 + cl] = a1; part[(kg * 3 + 2) * 64 + cl] = a2;
            __syncthreads();
            if (tid < 192) {
                const int v = tid >> 6, c2 = tid & 63; float s = 0.f;
                for (int g = 0; g < 8; ++g) s += part[(g * 3 + v) * 64 + c2];
                ((float*)(p.ws + OFF_MOD))[(size_t)(L * 3 + v) * 6144 + col0 + c2] = s + p.ada_b[L * 6144 + col0 + c2];
            }
            __syncthreads();
            continue;
        }
        r -= N0_MOD;
        {
            const int e = r * 512 + tid;
            if (e < 4096 + 1024) {
                const bool isr = e < 4096; const int ee = isr ? e : e - 4096; const int pos = ee >> 4, j = ee & 15;
                double inv = 1.0; for (int q = 0; q < j; ++q) inv *= 0.56234132519034908;
                const float invf = (float)inv; const float ang = (float)pos * invf;
                double s, c; sincos2pi((double)ang * 0.15915494309189533577, s, c);
                float2 v = make_float2((float)c, (float)s);
                if (isr) ((float2*)(p.ws + OFF_ROPER))[ee] = v; else ((float2*)(p.ws + OFF_ROPEC))[ee] = v;
            } else if (e < 5120 + 16384) {
                const int m = e - 5120; double s, c; sincos2pi(m / 16384.0, s, c);
                ((float2*)(p.ws + OFF_TW))[m] = make_float2((float)c, (float)s);
            } else if (e < 5120 + 32768) {
                const int m = e - 5120 - 16384, k = m >> 7, t = m & 127; double s, c; sincos2pi(((k * t) & 127) / 128.0, s, c);
                ((u16*)(p.ws + OFF_DFTC))[m] = f2bf((float)c); ((u16*)(p.ws + OFF_DFTS))[m] = f2bf((float)s);
            } else if (e < 5120 + 49152) {
                const int m = e - 5120 - 32768, k = m >> 4, g = m & 15;
                ((float*)(p.ws + OFF_WG16))[m] = p.w_in[(size_t)k * 3600 + 3584 + g];
            } else if (e == 5120 + 49152) {
                float s01 = 0.f, s23 = 0.f;
                for (int i = 0; i < 64; ++i) { s01 += p.lamv[i] * p.lamv[64 + i]; s23 += p.lamv[128 + i] * p.lamv[192 + i]; }
                ((float*)(p.ws + OFF_LAM))[0] = expf(s01) - expf(s23) + 0.2f;
            }
        }
    }
}

template <int MODE, bool DRY = false>
DEVI void phase_norm(const P& p, char* lds) {
    constexpr int layer = (MODE == 0 || MODE == 1) ? 0 : 1;
    constexpr bool side = (MODE == 0 || MODE == 1 || MODE == 3);
    const int nrows = layer == 0 ? NTOK : NLAT;
    const int tid = threadIdx.x, lane = tid & 63, wid = tid >> 6;
    f32x4* sl = (f32x4*)lds;
    if (side) {
        const float* S = (MODE == 0) ? (const float*)(p.ws + OFF_WG16) : p.router_w;
        for (int i = tid; i < 4096; i += NTHR) { const int eg = i >> 10, col = i & 1023; sl[i] = *reinterpret_cast<const f32x4*>(S + col * 16 + eg * 4); }
        __syncthreads();
    }
    const float* g = MODE == 0 ? p.nmix_g : MODE == 1 ? p.nffn_g : MODE == 2 ? p.nmix_g + 1024 : MODE == 3 ? p.nffn_g + 1024 : p.final_g;
    const float* modb = (const float*)(p.ws + OFF_MOD) + (size_t)layer * 3 * 6144;
    constexpr int sh_i = (MODE == 0 || MODE == 2) ? 0 : 3;
    u16* act = (u16*)(p.ws + OFF_ACT);
    int npend = 0, pcls = 0, prow = 0; float pwl = 0.f, pwh = 0.f;
    for (int row = blockIdx.x * 8 + wid; row < nrows; row += gridDim.x * 8) {
        const float* src = (MODE == 0) ? xin_ptr(p, row) : xs_ptr(p, layer, row);
        float xv[16]; float ss = 0.f;
#pragma unroll
        for (int m = 0; m < 16; ++m) { xv[m] = src[lane + 64 * m]; ss = fmaf(xv[m], xv[m], ss); }
        ss = wave_sum(ss);
        const float rstd = rsqrtf(ss * (1.f / 1024.f) + 1e-6f);
        if (MODE == 4) {
            float* dst = p.out + (size_t)row * DM;
#pragma unroll
            for (int m = 0; m < 16; ++m) dst[lane + 64 * m] = xv[m] * rstd * g[lane + 64 * m];
            continue;
        }
        const float* mv = modb + (size_t)modsel(layer, row) * 6144;
        float acc[16];
#pragma unroll
        for (int e = 0; e < 16; ++e) acc[e] = 0.f;
#pragma unroll
        for (int m = 0; m < 16; ++m) {
            const int col = lane + 64 * m;
            const float h = xv[m] * rstd * g[col] * (1.f + mv[(sh_i + 1) * 1024 + col]) + mv[sh_i * 1024 + col];
            act[(size_t)row * DM + col] = f2bf(h);
            if (side) {
                if ((m & 1) == 0) asm volatile("" ::: "memory");
#pragma unroll
                for (int eg = 0; eg < 4; ++eg) { const f32x4 w = sl[eg * 1024 + col]; acc[eg * 4 + 0] = fmaf(h, w[0], acc[eg * 4 + 0]); acc[eg * 4 + 1] = fmaf(h, w[1], acc[eg * 4 + 1]);
                    acc[eg * 4 + 2] = fmaf(h, w[2], acc[eg * 4 + 2]); acc[eg * 4 + 3] = fmaf(h, w[3], acc[eg * 4 + 3]); }
            }
        }
        if (side) {
#pragma unroll
            for (int e = 0; e < 16; ++e) acc[e] = wave_sum(acc[e]);
            if (MODE == 0) {
                float mine = 0.f;
#pragma unroll
                for (int e = 0; e < 16; ++e) mine = (lane == e) ? acc[e] : mine;
                if (lane < 16) {
                    float v = mine + p.gate_b[lane];
                    const int type = lane >> 2;
                    if (type == 1 || type == 3) v = logsigmoidf_(v);
                    ((float*)(p.ws + OFF_GATES))[(size_t)row * 16 + lane] = v;
                }
            } else {
                float aff[16], bi[16];
#pragma unroll
                for (int e = 0; e < 16; ++e) { aff[e] = sigmoidf_(acc[e]); bi[e] = aff[e] + p.router_b[e]; }
                int bg = 0, ba = 0, bb = 1; float bscore = -1e30f;
#pragma unroll
                for (int gq = 0; gq < 4; ++gq) {
                    int ia = 0; float va = bi[gq * 4];
#pragma unroll
                    for (int j = 1; j < 4; ++j) if (bi[gq * 4 + j] > va) { va = bi[gq * 4 + j]; ia = j; }
                    int ib = -1; float vb = -1e30f;
#pragma unroll
                    for (int j = 0; j < 4; ++j) if (j != ia && bi[gq * 4 + j] > vb) { vb = bi[gq * 4 + j]; ib = j; }
                    const float sc = va + vb;
                    if (sc > bscore) { bscore = sc; bg = gq; ba = ia; bb = ib; }
                }
                const int lo = ba < bb ? ba : bb, hi2 = ba < bb ? bb : ba;
                float alo = 0.f, ahi = 0.f;
#pragma unroll
                for (int e = 0; e < 16; ++e) { if (e == bg * 4 + lo) alo = aff[e]; if (e == bg * 4 + hi2) ahi = aff[e]; }
                const float inv = 1.f / (alo + ahi);
                const int pair = lo == 0 ? hi2 - 1 : (lo == 1 ? hi2 + 1 : 5);
                const int cls = bg * 6 + pair;
                if (lane == npend) { pcls = cls; prow = row; pwl = alo * inv; pwh = ahi * inv; }
                ++npend;
            }
        }
    }
    if ((MODE == 1 || MODE == 3) && lane < npend) {
        unsigned* cnt = (unsigned*)(p.ws + OFF_CNT) + (DRY ? 2 : layer) * 32;
        const unsigned slot = atomicAdd(&cnt[pcls], 1u);
        ((int*)(p.ws + (DRY ? OFF_BIG : OFF_LIST)))[(size_t)pcls * NTOK + slot] = prow;
        ((float2*)(p.ws + (DRY ? OFF_BIG + (size_t)32 * NTOK * 4 : OFF_TOKW)))[prow] = make_float2(pwl, pwh);
    }
}

using g8::f32x4v;
DEVI u32x4 pack8(const f32x4v& a, const f32x4v& b) { u32x4 w; w[0] = cvtpk(a[0], a[1]); w[1] = cvtpk(a[2], a[3]); w[2] = cvtpk(b[0], b[1]); w[3] = cvtpk(b[2], b[3]); return w; }

struct EpiInproj {
    static constexpr bool PERM = true;
    char* ws;
    DEVI void operator()(const f32x4v (&acc)[2][2][4][2], const g8::Unit& u, int wr, int wc, int fr, int fq) const {
        u16* dst; int ld, coff, kind;
        const int pn = u.pn;
        if (pn < 2)       { dst = (u16*)(ws + OFF_Q);    ld = 512;  coff = pn * 256;        kind = 1; }
        else if (pn < 4)  { dst = (u16*)(ws + OFF_K);    ld = 512;  coff = (pn - 2) * 256;  kind = 1; }
        else if (pn < 6)  { dst = (u16*)(ws + OFF_V);    ld = 512;  coff = (pn - 4) * 256;  kind = 0; }
        else if (pn < 10) { dst = (u16*)(ws + OFF_MLQK); ld = 1024; coff = (pn - 6) * 256;  kind = 0; }
        else if (pn < 12) { dst = (u16*)(ws + OFF_MLV);  ld = 512;  coff = (pn - 10) * 256; kind = 0; }
        else              { dst = (u16*)(ws + OFF_OG);   ld = 512;  coff = (pn - 12) * 256; kind = 2; }
        const int tb = u.pm % 65;
        const float2* tabR = (const float2*)(ws + OFF_ROPER); const float2* tabC = (const float2*)(ws + OFF_ROPEC);
#pragma unroll
        for (int ai = 0; ai < 2; ++ai)
#pragma unroll
            for (int m = 0; m < 4; ++m) {
                const int rl = ai * 128 + wr * 64 + m * 16 + fr;
                u16* rowp = dst + (size_t)(u.pm * 256 + rl) * ld + coff + wc * 32 + 8 * fq;
#pragma unroll
                for (int bj = 0; bj < 2; ++bj) {
                    f32x4v v0 = acc[ai][bj][m][0], v1 = acc[ai][bj][m][1];
                    if (kind == 1 && tb > 0) {
                        const int tl = (tb - 1) * 256 + rl;
                        const int p0 = ((wc * 32 + 8 * fq) & 63) >> 1;
                        const float* cs = (const float*)(p0 < 16 ? tabR + (tl >> 6) * 16 + p0 : tabC + (tl & 63) * 16 + (p0 - 16));
                        const f32x4v c01 = *reinterpret_cast<const f32x4v*>(cs), c23 = *reinterpret_cast<const f32x4v*>(cs + 4);
                        const f32x4v a = v0, b = v1;
                        v0[0] = a[0] * c01[0] - a[1] * c01[1]; v0[1] = a[0] * c01[1] + a[1] * c01[0];
                        v0[2] = a[2] * c01[2] - a[3] * c01[3]; v0[3] = a[2] * c01[3] + a[3] * c01[2];
                        v1[0] = b[0] * c23[0] - b[1] * c23[1]; v1[1] = b[0] * c23[1] + b[1] * c23[0];
                        v1[2] = b[2] * c23[2] - b[3] * c23[3]; v1[3] = b[2] * c23[3] + b[3] * c23[2];
                    } else if (kind == 2) {
#pragma unroll
                        for (int j = 0; j < 4; ++j) { v0[j] = sigmoidf_(v0[j]); v1[j] = sigmoidf_(v1[j]); }
                    }
                    *reinterpret_cast<u32x4*>(rowp + bj * 128) = pack8(v0, v1);
                }
            }
    }
};
DEVI void phase_inproj(const P& p, char* lds) {
    __syncthreads();
    g8::DenseSched S{p.ws + OFF_WINT, NTOK / 256, 14, (int)gridDim.x, (int)blockIdx.x, (size_t)256 * 2048};
    EpiInproj E{p.ws};
    g8::gemm_phase((LAS unsigned char*)lds, p.ws + OFF_ACT, 2048, 16, S, E);
}

struct EpiOutproj {
    static constexpr bool PERM = false;
    const float* xin_lat; const float* xin_ctx; float* xs_lat; float* xs_ctx; const float* modb;
    DEVI void operator()(const f32x4v (&acc)[2][2][4][2], const g8::Unit& u, int wr, int wc, int fr, int fq) const {
        const int b = u.pm / 65, tb = u.pm % 65;
        const float* xi = tb == 0 ? xin_ctx + (size_t)(b * TC) * DM : xin_lat + (size_t)(b * TL + (tb - 1) * 256) * DM;
        float* xo = tb == 0 ? xs_ctx + (size_t)(b * TC) * DM : xs_lat + (size_t)(b * TL + (tb - 1) * 256) * DM;
        const float* gate = modb + (size_t)(tb == 0 ? 2 : b) * 6144 + 2 * 1024;
        const int col0 = u.pn * 256 + wc * 32 + 4 * fq;
        f32x4v gv[2][2];
#pragma unroll
        for (int bj = 0; bj < 2; ++bj)
#pragma unroll
            for (int n = 0; n < 2; ++n) gv[bj][n] = *reinterpret_cast<const f32x4v*>(gate + col0 + bj * 128 + n * 16);
#pragma unroll
        for (int ai = 0; ai < 2; ++ai)
#pragma unroll
            for (int m = 0; m < 4; ++m) {
                const size_t ro = (size_t)(ai * 128 + wr * 64 + m * 16 + fr) * DM + col0;
#pragma unroll
                for (int bj = 0; bj < 2; ++bj)
#pragma unroll
                    for (int n = 0; n < 2; ++n) {
                        const f32x4v xv = *reinterpret_cast<const f32x4v*>(xi + ro + bj * 128 + n * 16);
                        *reinterpret_cast<f32x4v*>(xo + ro + bj * 128 + n * 16) = xv + gv[bj][n] * acc[ai][bj][m][n];
                    }
            }
    }
};
DEVI void phase_outproj(const P& p, char* lds) {
    __syncthreads();
    g8::DenseSched S{p.ws + OFF_WOUTT, NTOK / 256, 4, (int)gridDim.x, (int)blockIdx.x, (size_t)256 * 2048};
    EpiOutproj E{p.x, p.ctx, p.out, (float*)(p.ws + OFF_XC), (const float*)(p.ws + OFF_MOD)};
    g8::gemm_phase((LAS unsigned char*)lds, p.ws + OFF_ACT, 2048, 16, S, E);
}

DEVI int moe_table(const P& p, int layer, int* tb) {
    __syncthreads();
    if (threadIdx.x == 0) {
        const unsigned* cnt = (const unsigned*)(p.ws + OFF_CNT) + layer * 32; int o = 0;
        for (int c = 0; c < 24; ++c) { tb[c] = o; tb[32 + c] = (int)cnt[c]; o += ((int)cnt[c] + 255) >> 8; }
        tb[24] = o;
    }
    __syncthreads();
    return tb[24];
}
DEVI void cls_experts(int cls, int& elo, int& ehi) {
    const int g = cls / 6, pr = cls % 6;
    const int lo = pr < 3 ? 0 : (pr < 5 ? 1 : 2); const int hi = pr < 3 ? pr + 1 : (pr < 5 ? pr - 1 : 3);
    elo = g * 4 + lo; ehi = g * 4 + hi;
}
DEVI void moe_unit(const int* tb, int rt, g8::Unit& u) {
    int cls = 0; while (cls < 23 && tb[cls + 1] <= rt) ++cls;
    u.cls = cls; u.r0 = (rt - tb[cls]) * 256; u.ncls = tb[32 + cls];
}

struct MoeUpSched {
    static constexpr bool GATHER = true;
    const int* tb; int T, G, c; const int* list; const char* Wgu;
    DEVI bool next(int i, g8::Unit& u) const {
        if (!g8::tile_order(i, G, c, T, 8, u.pm, u.pn)) return false;
        moe_unit(tb, u.pm, u); int elo, ehi; cls_experts(u.cls, elo, ehi);
        const int e = u.pn < 4 ? elo : ehi;
        u.B0 = u.B1 = Wgu + ((size_t)e * 1024 + (size_t)(u.pn & 3) * 256) * 2048; return true;
    }
    DEVI void aoffs(const g8::Unit& u, unsigned (&v)[2][2]) const {
        const int* lst = list + (size_t)u.cls * NTOK + u.r0;
#pragma unroll
        for (int i = 0; i < 2; ++i) { int R, C; g8::lane_rc(i, R, C);
#pragma unroll
            for (int h = 0; h < 2; ++h) { const int rr = h * 128 + R; const int tok = lst[(u.r0 + rr < u.ncls) ? rr : 0]; v[h][i] = (unsigned)((tok * 1024 + C) * 2); } }
    }
};
struct EpiMoeUp {
    static constexpr bool PERM = true;
    const int* list; const float2* tokw; u16* HE;
    DEVI void operator()(const f32x4v (&acc)[2][2][4][2], const g8::Unit& u, int wr, int wc, int fr, int fq) const {
        const int* lst = list + (size_t)u.cls * NTOK + u.r0;
        const int s = u.pn >> 2;
#pragma unroll
        for (int ai = 0; ai < 2; ++ai)
#pragma unroll
            for (int m = 0; m < 4; ++m) {
                const int rl = ai * 128 + wr * 64 + m * 16 + fr;
                if (u.r0 + rl < u.ncls) {
                    const int tok = lst[rl]; const float2 w2 = tokw[tok]; const float w = s ? w2.y : w2.x;
                    u16* rowp = HE + (size_t)(u.pm * 256 + rl) * 1024 + s * 512 + (u.pn & 3) * 128 + wc * 16 + 4 * fq;
#pragma unroll
                    for (int bj = 0; bj < 2; ++bj) {
                        const f32x4v g = acc[ai][bj][m][0], up = acc[ai][bj][m][1];
                        u32x2 o; o[0] = cvtpk(siluf_(g[0]) * up[0] * w, siluf_(g[1]) * up[1] * w); o[1] = cvtpk(siluf_(g[2]) * up[2] * w, siluf_(g[3]) * up[3] * w);
                        *reinterpret_cast<u32x2*>(rowp + bj * 64) = o;
                    }
                }
            }
    }
};
DEVI void phase_moe_up(const P& p, int layer, char* lds) {
    int* tb = (int*)(lds + g8::STAGE_BYTES);
    const int T = moe_table(p, layer, tb);
    MoeUpSched S{tb, T, (int)gridDim.x, (int)blockIdx.x, (const int*)(p.ws + OFF_LIST), p.ws + OFF_WGU};
    EpiMoeUp E{(const int*)(p.ws + OFF_LIST), (const float2*)(p.ws + OFF_TOKW), (u16*)(p.ws + OFF_HE)};
    g8::gemm_phase((LAS unsigned char*)lds, p.ws + OFF_ACT, 2048, 16, S, E);
}

struct MoeDownSched {
    static constexpr bool GATHER = false;
    const int* tb; int T, G, c; const char* WdT;
    DEVI bool next(int i, g8::Unit& u) const {
        if (!g8::tile_order(i, G, c, T, 4, u.pm, u.pn)) return false;
        moe_unit(tb, u.pm, u); int elo, ehi; cls_experts(u.cls, elo, ehi);
        u.B0 = WdT + ((size_t)elo * 1024 + (size_t)u.pn * 256) * 1024;
        u.B1 = WdT + ((size_t)ehi * 1024 + (size_t)u.pn * 256) * 1024 - (size_t)8 * 128; return true;
    }
    DEVI void aoffs(const g8::Unit& u, unsigned (&v)[2][2]) const {
#pragma unroll
        for (int i = 0; i < 2; ++i) { int R, C; g8::lane_rc(i, R, C);
#pragma unroll
            for (int h = 0; h < 2; ++h) v[h][i] = (unsigned)(((u.pm * 256 + h * 128 + R) * 1024 + C) * 2); }
    }
};
template <bool DRY>
struct EpiMoeDown {
    static constexpr bool PERM = false;
    const P* pp; int layer; const int* list; const float* modb;
    DEVI void operator()(const f32x4v (&acc)[2][2][4][2], const g8::Unit& u, int wr, int wc, int fr, int fq) const {
        const P& p = *pp;
        const int* lst = list + (size_t)u.cls * NTOK + u.r0;
        const int col0 = u.pn * 256 + wc * 32 + 4 * fq;
#pragma unroll
        for (int ai = 0; ai < 2; ++ai)
#pragma unroll
            for (int m = 0; m < 4; ++m) {
                const int rl = ai * 128 + wr * 64 + m * 16 + fr;
                if (u.r0 + rl < u.ncls) {
                    const int tok = lst[rl];
                    const float* gate = modb + (size_t)modsel(layer, tok) * 6144 + 5 * 1024 + col0;
                    float* xo = xs_ptr(p, layer, tok) + col0;
                    float* xd = DRY ? (float*)(p.ws + OFF_MLQK) + (size_t)(tok & 8191) * 1024 + col0 : xo;
#pragma unroll
                    for (int bj = 0; bj < 2; ++bj)
#pragma unroll
                        for (int n = 0; n < 2; ++n) {
                            const f32x4v gv = *reinterpret_cast<const f32x4v*>(gate + bj * 128 + n * 16);
                            const f32x4v xv = *reinterpret_cast<const f32x4v*>(xo + bj * 128 + n * 16);
                            *reinterpret_cast<f32x4v*>(xd + bj * 128 + n * 16) = xv + gv * acc[ai][bj][m][n];
                        }
                }
            }
    }
};
template <bool DRY = false>
DEVI void phase_moe_down(const P& p, int layer, char* lds) {
    int* tb = (int*)(lds + g8::STAGE_BYTES);
    const int T = moe_table(p, layer, tb);
    MoeDownSched S{tb, T, (int)gridDim.x, (int)blockIdx.x, p.ws + OFF_WDT};
    EpiMoeDown<DRY> E{&p, layer, (const int*)(p.ws + OFF_LIST), (const float*)(p.ws + OFF_MOD) + (size_t)layer * 3 * 6144};
    g8::gemm_phase((LAS unsigned char*)lds, p.ws + OFF_HE, 1024, 8, S, E);
}

struct EpiFnet {
    static constexpr bool PERM = true;
    char* ws;
    DEVI void operator()(const f32x4v (&acc)[2][2][4][2], const g8::Unit& u, int wr, int wc, int fr, int fq) const {
        u16* dst = (u16*)(ws + (u.pn < 4 ? OFF_ZR : OFF_ZI)) + (u.pn & 3) * 256 + wc * 32 + 8 * fq;
#pragma unroll
        for (int ai = 0; ai < 2; ++ai)
#pragma unroll
            for (int m = 0; m < 4; ++m) {
                u16* rowp = dst + (size_t)(u.pm * 256 + ai * 128 + wr * 64 + m * 16 + fr) * 1024;
#pragma unroll
                for (int bj = 0; bj < 2; ++bj) *reinterpret_cast<u32x4*>(rowp + bj * 128) = pack8(acc[ai][bj][m][0], acc[ai][bj][m][1]);
            }
    }
};
DEVI void phase_fnet_gemm(const P& p, char* lds) {
    __syncthreads();
    g8::DenseSched S{p.ws + OFF_FNT, NLAT / 256, 8, (int)gridDim.x, (int)blockIdx.x, (size_t)256 * 2048};
    EpiFnet E{p.ws};
    g8::gemm_phase((LAS unsigned char*)lds, p.ws + OFF_ACT, 2048, 16, S, E);
}

template <class RP>
DEVI void stage_tr128(RP rp, char* img) {
    const int tid = threadIdx.x;
#pragma unroll
    for (int i = 0; i < 4; ++i) {
        const int idx = tid + 512 * i, k = idx >> 4, c = (idx & 15) * 8;
        const u32x4 v = *reinterpret_cast<const u32x4*>(rp(k) + c);
        *reinterpret_cast<u32x4*>(img + (k >> 6) * 16384 + v_st(k & 63, c)) = v;
    }
}
DEVI void load_dft(const P& p, char* lds) {
    const int tid = threadIdx.x;
    for (int i = tid; i < 4096; i += NTHR) {
        const int m = i >> 11, j = i & 2047, row = j >> 4, ch = j & 15;
        const u32x4 v = *reinterpret_cast<const u32x4*>((const u16*)(p.ws + (m ? OFF_DFTS : OFF_DFTC)) + row * 128 + ch * 8);
        *reinterpret_cast<u32x4*>(lds + m * 34816 + swz256(row, ch)) = v;
    }
}
DEVI bf16x8 negbf(bf16x8 v) { u32x4 w = *reinterpret_cast<u32x4*>(&v); w[0] ^= 0x80008000u; w[1] ^= 0x80008000u; w[2] ^= 0x80008000u; w[3] ^= 0x80008000u; return *reinterpret_cast<bf16x8*>(&w); }

template <int KS, int WN, int MODE>
DEVI void fft_kstep(int vbr, int vbi, const bf16x8& aC, const bf16x8& aS, f32x16 (&yr)[2], f32x16 (&yi)[2]) {
    s16x4 rl0, rh0, rl1, rh1, il0, ih0, il1, ih1;
    tr_frag_issue<2 * WN, KS>(vbr, rl0, rh0); tr_frag_issue<2 * WN + 1, KS>(vbr, rl1, rh1);
    tr_frag_issue<2 * WN, KS>(vbi, il0, ih0); tr_frag_issue<2 * WN + 1, KS>(vbi, il1, ih1);
    LGKM0();
    const bf16x8 xr0 = PKLH(rl0, rh0), xr1 = PKLH(rl1, rh1), xi0 = PKLH(il0, ih0), xi1 = PKLH(il1, ih1);
    yr[0] = __builtin_amdgcn_mfma_f32_32x32x16_bf16(aC, xr0, yr[0], 0, 0, 0);
    yr[1] = __builtin_amdgcn_mfma_f32_32x32x16_bf16(aC, xr1, yr[1], 0, 0, 0);
    yr[0] = __builtin_amdgcn_mfma_f32_32x32x16_bf16(aS, xi0, yr[0], 0, 0, 0);
    yr[1] = __builtin_amdgcn_mfma_f32_32x32x16_bf16(aS, xi1, yr[1], 0, 0, 0);
    if (MODE == 0) {
        yi[0] = __builtin_amdgcn_mfma_f32_32x32x16_bf16(aC, xi0, yi[0], 0, 0, 0);
        yi[1] = __builtin_amdgcn_mfma_f32_32x32x16_bf16(aC, xi1, yi[1], 0, 0, 0);
        yi[0] = __builtin_amdgcn_mfma_f32_32x32x16_bf16(aS, negbf(xr0), yi[0], 0, 0, 0);
        yi[1] = __builtin_amdgcn_mfma_f32_32x32x16_bf16(aS, negbf(xr1), yi[1], 0, 0, 0);
    }
}
template <int WN, int MODE>
DEVI void fft_core(const char* lds, int xr_img, int xi_img, int wm, int lane, f32x16 (&yr)[2], f32x16 (&yi)[2]) {
    const int r32 = lane & 31, hi = lane >> 5;
    const char* Cm = lds; const char* Sm = lds + 34816;
    const int row = wm * 32 + r32;
    const int vb0 = xr_img + v_rd_base(lane), vb1 = xi_img + v_rd_base(lane);
#define KSTEP(H, KS) do { const int kk = (H) * 4 + (KS); \
        const bf16x8 aC = lds_b128(Cm, swz256(row, 2 * kk + hi)), aS = lds_b128(Sm, swz256(row, 2 * kk + hi)); \
        fft_kstep<KS, WN, MODE>(vb0 + (H) * 16384, vb1 + (H) * 16384, aC, aS, yr, yi); } while (0)
    KSTEP(0, 0); KSTEP(0, 1); KSTEP(0, 2); KSTEP(0, 3); KSTEP(1, 0); KSTEP(1, 1); KSTEP(1, 2); KSTEP(1, 3);
#undef KSTEP
}

DEVI void phase_fft1(const P& p, char* lds) {
    const int tid = threadIdx.x, lane = tid & 63, wid = __builtin_amdgcn_readfirstlane(tid >> 6), wm = wid >> 1, wn = wid & 1, r32 = lane & 31, hi = lane >> 5;
    load_dft(p, lds);
    char* imgR = lds + 69632; char* imgI = lds + 102400;
    const u16* Zr = (const u16*)(p.ws + OFF_ZR); const u16* Zi = (const u16*)(p.ws + OFF_ZI);
    u16* Yr = (u16*)(p.ws + OFF_YR); u16* Yi = (u16*)(p.ws + OFF_YI);
    const float2* TW = (const float2*)(p.ws + OFF_TW);
    for (int u = blockIdx.x; u < NB * 128 * 8; u += gridDim.x) {
        const int cb = u & 7, t2 = (u >> 3) & 127, b = u >> 10;
        __syncthreads();
        stage_tr128([&](int k) { return Zr + (size_t)(b * TL + 128 * k + t2) * 1024 + cb * 128; }, imgR);
        stage_tr128([&](int k) { return Zi + (size_t)(b * TL + 128 * k + t2) * 1024 + cb * 128; }, imgI);
        __syncthreads();
        f32x16 yr[2] = {}, yi[2] = {};
        const int xr_img = (int)(uintptr_t)imgR, xi_img = (int)(uintptr_t)imgI;
        if (wn == 0) fft_core<0, 0>(lds, xr_img, xi_img, wm, lane, yr, yi); else fft_core<1, 0>(lds, xr_img, xi_img, wm, lane, yr, yi);
#pragma unroll
        for (int r = 0; r < 16; ++r) {
            const int k1 = wm * 32 + crow(r, hi);
            const float2 w = TW[t2 * k1];
            const size_t o = ((size_t)(b * 128 + k1) * 128 + t2) * 1024 + cb * 128 + wn * 64 + r32;
#pragma unroll
            for (int ni = 0; ni < 2; ++ni) {
                const float a = yr[ni][r], bq = yi[ni][r];
                Yr[o + ni * 32] = f2bf(a * w.x + bq * w.y);
                Yi[o + ni * 32] = f2bf(bq * w.x - a * w.y);
            }
        }
    }
}
template <bool DRY = false>
DEVI void phase_fft2(const P& p, char* lds) {
    const int tid = threadIdx.x, lane = tid & 63, wid = __builtin_amdgcn_readfirstlane(tid >> 6), wm = wid >> 1, wn = wid & 1, r32 = lane & 31, hi = lane >> 5;
    load_dft(p, lds);
    char* imgR = lds + 69632; char* imgI = lds + 102400;
    const u16* Yr = (const u16*)(p.ws + OFF_YR); const u16* Yi = (const u16*)(p.ws + OFF_YI);
    const float* modb = (const float*)(p.ws + OFF_MOD) + (size_t)3 * 6144;
    for (int u = blockIdx.x; u < NB * 128 * 8; u += gridDim.x) {
        const int cb = u & 7, k1 = (u >> 3) & 127, b = u >> 10;
        __syncthreads();
        stage_tr128([&](int k) { return Yr + ((size_t)(b * 128 + k1) * 128 + k) * 1024 + cb * 128; }, imgR);
        stage_tr128([&](int k) { return Yi + ((size_t)(b * 128 + k1) * 128 + k) * 1024 + cb * 128; }, imgI);
        __syncthreads();
        f32x16 yr[2] = {}, yi[2] = {};
        const int xr_img = (int)(uintptr_t)imgR, xi_img = (int)(uintptr_t)imgI;
        if (wn == 0) fft_core<0, 1>(lds, xr_img, xi_img, wm, lane, yr, yi); else fft_core<1, 1>(lds, xr_img, xi_img, wm, lane, yr, yi);
        const float* gate = modb + (size_t)b * 6144 + 2 * 1024 + cb * 128 + wn * 64 + r32;
        const float g0 = gate[0], g1 = gate[32];
#pragma unroll
        for (int r = 0; r < 16; ++r) {
            const int k2 = wm * 32 + crow(r, hi);
            float* xo = p.out + (size_t)(b * TL + k1 + 128 * k2) * 1024 + cb * 128 + wn * 64 + r32;
            if (DRY) { float* xd = (float*)(p.ws + OFF_ZR) + (size_t)(b * TL + k1 + 128 * k2) * 1024 + cb * 128 + wn * 64 + r32; xd[0] = xo[0] + g0 * yr[0][r]; xd[32] = xo[32] + g1 * yr[1][r]; }
            else { xo[0] += g0 * yr[0][r]; xo[32] += g1 * yr[1][r]; }
        }
    }
}

constexpr int AT_V = 16384, AT_K = 17408;
template <int HF, int DB>
DEVI void attn_half(const char* Ks, const bf16x8 (&qr)[8], float& m_reg, float& l_reg, f32x16 (&o)[4], int vb, float* al, int r32, int hi) {
    constexpr float SC = 0.125f, C = SC * 1.4426950408889634f, THR = 8.f;
    f32x16 pp = {};
#pragma unroll
    for (int d0 = 0; d0 < 4; ++d0) pp = __builtin_amdgcn_mfma_f32_32x32x16_bf16(lds_b128(Ks, swz256(HF * 32 + r32, 2 * (DB + d0) + hi)), qr[DB + d0], pp, 0, 0, 0);
    float pmax = pp[0];
#pragma unroll
    for (int r = 1; r < 16; ++r) pmax = fmaxf(pmax, pp[r]);
    { auto rr = __builtin_amdgcn_permlane32_swap(__float_as_uint(pmax), __float_as_uint(pmax), false, false);
      pmax = fmaxf(__uint_as_float(rr[0]), __uint_as_float(rr[1])); }
    float alpha = 1.f;
    if (!__all(pmax - m_reg <= THR / SC)) {
        const float mn = fmaxf(m_reg, pmax); alpha = __builtin_amdgcn_exp2f((m_reg - mn) * C); m_reg = mn;
        if (hi == 0) al[r32] = alpha;
        asm volatile("s_waitcnt lgkmcnt(0)" ::: "memory");
#pragma unroll
        for (int d = 0; d < 4; ++d)
#pragma unroll
            for (int r = 0; r < 16; ++r) o[d][r] *= al[crow(r, hi)];
    }
    const float mnC = -m_reg * C;
    float ps = 0.f;
#pragma unroll
    for (int r = 0; r < 16; ++r) { pp[r] = __builtin_amdgcn_exp2f(fmaf(pp[r], C, mnC)); ps += pp[r]; }
    { auto rr = __builtin_amdgcn_permlane32_swap(__float_as_uint(ps), __float_as_uint(ps), false, false);
      ps = __uint_as_float(rr[0]) + __uint_as_float(rr[1]); }
    l_reg = l_reg * alpha + ps;
    bf16x8 pa0, pa1;
    pack_p(pp, pa0, pa1);
#define PVD(D0) do { s16x4 l0, h0, l1, h1; tr_frag_issue<D0, 2 * HF>(vb, l0, h0); tr_frag_issue<D0, 2 * HF + 1>(vb, l1, h1); LGKM0(); \
        o[D0] = __builtin_amdgcn_mfma_f32_32x32x16_bf16(pa0, PKLH(l0, h0), o[D0], 0, 0, 0); \
        o[D0] = __builtin_amdgcn_mfma_f32_32x32x16_bf16(pa1, PKLH(l1, h1), o[D0], 0, 0, 0); } while (0)
    PVD(0); PVD(1); PVD(2); PVD(3);
#undef PVD
}

DEVI void diffattn_item(const P& p, int q0, int k0row, int seq, int h, char* lds) {
    int tid = threadIdx.x; asm volatile("" : "+v"(tid));
    const int wid = tid >> 6, lane = tid & 63, r32 = lane & 31, hi = lane >> 5;
    const u16* Q = (const u16*)(p.ws + OFF_Q); const u16* Kg = (const u16*)(p.ws + OFF_K) + (size_t)k0row * 512 + h * 128;
    const u16* Vg = (const u16*)(p.ws + OFF_V) + (size_t)k0row * 512 + h * 128;
    char* V_lds = lds; char* K_lds = lds + 2 * AT_V;
    float* al = (float*)(lds + 2 * AT_V + 2 * AT_K) + wid * 64;
    bf16x8 qr[8];
    { const u16* Qw = Q + (size_t)(q0 + wid * 32 + r32) * 512 + h * 128 + hi * 8;
#pragma unroll
      for (int d0 = 0; d0 < 8; ++d0) qr[d0] = *reinterpret_cast<const bf16x8*>(Qw + d0 * 16); }
    const int sr = tid >> 4, sc = (tid & 15) * 8;
    const int vb0 = (int)(uintptr_t)V_lds + v_rd_base(lane);
    const int vc = ((tid >> 5) & 3) * 32 + (tid & 3) * 8;
    const int kk0 = (tid >> 7) * 8 + ((tid & 31) >> 2), kk1 = kk0 + 32;
    const int vk0 = (kk0 & ~0xC) | ((kk0 & 4) << 1) | ((kk0 & 8) >> 1), vk1 = (kk1 & ~0xC) | ((kk1 & 4) << 1) | ((kk1 & 8) >> 1);
    u32x4 sk0, sk1;
#define SLOAD(kk, b) do { \
    __builtin_amdgcn_global_load_lds((const unsigned*)(Vg + (size_t)((kk) + vk0) * 512 + vc), (LAS unsigned*)(V_lds + (b) * AT_V + tid * 16), 16, 0, 0); \
    __builtin_amdgcn_global_load_lds((const unsigned*)(Vg + (size_t)((kk) + vk1) * 512 + vc), (LAS unsigned*)(V_lds + (b) * AT_V + 8192 + tid * 16), 16, 0, 0); \
    sk0 = *reinterpret_cast<const u32x4*>(Kg + (size_t)((kk) + sr) * 512 + sc); sk1 = *reinterpret_cast<const u32x4*>(Kg + (size_t)((kk) + 32 + sr) * 512 + sc); } while (0)
#define SWRITE(b) do { *reinterpret_cast<u32x4*>(K_lds + (b) * AT_K + swz256(sr, tid & 15)) = sk0; *reinterpret_cast<u32x4*>(K_lds + (b) * AT_K + swz256(32 + sr, tid & 15)) = sk1; } while (0)
    float m0 = -1e30f, m1 = -1e30f, l0 = 0.f, l1 = 0.f;
    f32x16 o0[4] = {}, o1[4] = {};
    const int NT = seq / 64;
    __syncthreads();
    SLOAD(0, 0); SWRITE(0); asm volatile("s_waitcnt vmcnt(0)" ::: "memory"); __syncthreads();
    if (NT > 1) SLOAD(64, 1);
    for (int j = 0; j < NT; ++j) {
        const int cur = j & 1;
        const char* Ks = K_lds + cur * AT_K;
        attn_half<0, 0>(Ks, qr, m0, l0, o0, vb0 + cur * AT_V, al, r32, hi);
        attn_half<1, 0>(Ks, qr, m0, l0, o0, vb0 + cur * AT_V, al, r32, hi);
        attn_half<0, 4>(Ks, qr, m1, l1, o1, vb0 + cur * AT_V, al, r32, hi);
        attn_half<1, 4>(Ks, qr, m1, l1, o1, vb0 + cur * AT_V, al, r32, hi);
        if (j + 1 < NT) SWRITE(cur ^ 1);
        asm volatile("s_waitcnt vmcnt(0)" ::: "memory");
        __syncthreads();
        if (j + 2 < NT) SLOAD((j + 2) * 64, cur);
    }
#undef SLOAD
#undef SWRITE
    int tz = threadIdx.x; asm volatile("" : "+v"(tz));
    const int wid2 = tz >> 6, lane2 = tz & 63, r32e = lane2 & 31, hie = lane2 >> 5;
    const float lam = ((const float*)(p.ws + OFF_LAM))[0];
    float* sc0 = (float*)(lds + 2 * AT_V + 2 * AT_K) + wid2 * 64; float* sc1 = sc0 + 32;
    if (hie == 0) { sc0[r32e] = 1.f / l0; sc1[r32e] = -lam / l1; }
    asm volatile("s_waitcnt lgkmcnt(0)" ::: "memory");
    float ssq[16];
#pragma unroll
    for (int r = 0; r < 16; ++r) {
        const float a = sc0[crow(r, hie)], b = sc1[crow(r, hie)]; float s = 0.f;
#pragma unroll
        for (int d = 0; d < 4; ++d) { const float v = o0[d][r] * a + o1[d][r] * b; o0[d][r] = v; s = fmaf(v, v, s); }
        ssq[r] = s;
    }
#pragma unroll
    for (int r = 0; r < 16; ++r) { float s = ssq[r]; for (int o = 16; o; o >>= 1) s += __shfl_xor(s, o); ssq[r] = rsqrtf(s * (1.f / 128.f) + 1e-6f) * 0.8f; }
    u16* mix = (u16*)(p.ws + OFF_ACT);
    const float* sg = p.subln_g;
#pragma unroll
    for (int d = 0; d < 4; ++d) {
        const float gv = sg[d * 32 + r32e];
#pragma unroll
        for (int r = 0; r < 16; ++r) mix[(size_t)(q0 + wid2 * 32 + crow(r, hie)) * 1024 + h * 128 + d * 32 + r32e] = f2bf(o0[d][r] * ssq[r] * gv);
    }
}

DEVI void chunk_scan(const float* gates, int row0, int head, int dir, float* Bq, float* av, float* pm, float& total, float& amax) {
    const int lane = threadIdx.x & 63;
    const int e0 = dir ? 127 - 2 * lane : 2 * lane, e1 = dir ? 126 - 2 * lane : 2 * lane + 1;
    const float lf0 = gates[(size_t)(row0 + e0) * 16 + (dir ? 12 : 4) + head], lf1 = gates[(size_t)(row0 + e1) * 16 + (dir ? 12 : 4) + head];
    const float li0 = gates[(size_t)(row0 + e0) * 16 + (dir ? 8 : 0) + head],  li1 = gates[(size_t)(row0 + e1) * 16 + (dir ? 8 : 0) + head];
    const float s1 = lf0 + lf1; float inc = s1;
#pragma unroll
    for (int o = 1; o < 64; o <<= 1) { const float t = __shfl_up(inc, o); if (lane >= o) inc += t; }
    const float exc = inc - s1;
    const float B0 = exc + lf0, B1 = exc + s1;
    const float a0 = li0 - B0, a1 = li1 - B1;
    const float m1 = fmaxf(a0, a1); float mx = m1;
#pragma unroll
    for (int o = 1; o < 64; o <<= 1) { const float t = __shfl_up(mx, o); if (lane >= o) mx = fmaxf(mx, t); }
    float mprev = __shfl_up(mx, 1); if (lane == 0) mprev = -1e30f;
    Bq[e0] = B0; Bq[e1] = B1; av[e0] = a0; av[e1] = a1; pm[e0] = fmaxf(mprev, a0); pm[e1] = mx;
    total = __shfl(inc, 63); amax = __shfl(mx, 63);
}

DEVI void conv_silu8(const u32x4& xm, const u32x4& x0, const u32x4& xp, const float* wc, bool hasm, bool hasp, float (&out)[8]) {
#pragma unroll
    for (int j = 0; j < 4; ++j) {
        const float w00 = wc[2 * j], w01 = wc[2 * j + 1], w10 = wc[1024 + 2 * j], w11 = wc[1024 + 2 * j + 1], w20 = wc[2048 + 2 * j], w21 = wc[2048 + 2 * j + 1];
        float a = w10 * bflo(x0[j]), b = w11 * bfhi(x0[j]);
        if (hasm) { a = fmaf(w00, bflo(xm[j]), a); b = fmaf(w01, bfhi(xm[j]), b); }
        if (hasp) { a = fmaf(w20, bflo(xp[j]), a); b = fmaf(w21, bfhi(xp[j]), b); }
        out[2 * j] = siluf_(a); out[2 * j + 1] = siluf_(b);
    }
}
DEVI void seg_edges(int t  , bool& hasm, bool& hasp) {
    hasm = !(t == 0 || t == TC); hasp = !(t == TC - 1 || t == TT - 1);
}
DEVI int chain_slot(int dir, int b, int h, int cc) { return ((dir * 2 + b) * 4 + h) * NCH + cc; }

DEVI void phase_mlstm_a(const P& p, char* lds) {
    const int tid = threadIdx.x, wid = __builtin_amdgcn_readfirstlane(tid >> 6), lane = tid & 63, r32 = lane & 31, hi = lane >> 5;
    char* Vimg = lds; char* Kf = lds + 32768; char* Kb = lds + 65536;
    float* arr = (float*)(lds + 98304);
    const float* gates = (const float*)(p.ws + OFF_GATES);
    const u16* MLQK = (const u16*)(p.ws + OFF_MLQK); const u16* MLV = (const u16*)(p.ws + OFF_MLV);
    u16* CST = (u16*)(p.ws + OFF_CST); float* NST = (float*)(p.ws + OFF_NST);
    float2* scal = (float2*)(p.ws + OFF_MSCAL);
    for (int it = blockIdx.x; it < NB * 4 * NCH; it += gridDim.x) {
        const int cc = it % NCH, h = (it / NCH) & 3, b = it / (NCH * 4);
        const int row0 = b * TT + cc * 128;
        __syncthreads();
        if (wid < 2) {
            float total, amax; float* a4 = arr + wid * 512;
            chunk_scan(gates, row0, h, wid, a4, a4 + 128, a4 + 256, total, amax);
            a4[384 + lane] = __expf(a4[128 + lane] - amax); a4[384 + 64 + lane] = __expf(a4[128 + 64 + lane] - amax);
            if (lane == 0) scal[chain_slot(wid, b, h, 0) + cc] = make_float2(total + amax, total);
        }
        __syncthreads();
#pragma unroll
        for (int i = 0; i < 4; ++i) {
            const int idx = tid + 512 * i, l = idx >> 4, c = (idx & 15) * 8;
            const u32x4 v = *reinterpret_cast<const u32x4*>(MLV + (size_t)(row0 + l) * 512 + h * 128 + c);
            *reinterpret_cast<u32x4*>(Vimg + (l >> 6) * 16384 + v_st(l & 63, c)) = v;
            const int t = cc * 128 + l; bool hasm, hasp; seg_edges(t, hasm, hasp);
            const u16* kp = MLQK + (size_t)(row0 + l) * 1024 + 512 + h * 128 + c;
            const u32x4 x0 = *reinterpret_cast<const u32x4*>(kp);
            const u32x4 xm = hasm ? *reinterpret_cast<const u32x4*>(kp - 1024) : x0;
            const u32x4 xp = hasp ? *reinterpret_cast<const u32x4*>(kp + 1024) : x0;
            float kv[8]; conv_silu8(xm, x0, xp, p.conv_w + 512 + h * 128 + c, hasm, hasp, kv);
            const float wf = arr[384 + l] * 0.08838834764831845f, wb = arr[512 + 384 + l] * 0.08838834764831845f;
            u32x4 of, ob;
#pragma unroll
            for (int j = 0; j < 4; ++j) { of[j] = cvtpk(kv[2 * j] * wf, kv[2 * j + 1] * wf); ob[j] = cvtpk(kv[2 * j] * wb, kv[2 * j + 1] * wb); }
            *reinterpret_cast<u32x4*>(Kf + (l >> 6) * 16384 + v_st(l & 63, c)) = of;
            *reinterpret_cast<u32x4*>(Kb + (l >> 6) * 16384 + v_st(l & 63, c)) = ob;
        }
        __syncthreads();
        const int dir = wid >> 2, vblk = wid & 3;
        const int va = (int)(uintptr_t)Vimg + v_rd_base(lane), ka = (int)(uintptr_t)(dir ? Kb : Kf) + v_rd_base(lane);
        f32x16 acc[4] = {};
#define ASTEP(H, KS) do { s16x4 al_, ah_, b0l, b0h, b1l, b1h, b2l, b2h, b3l, b3h; \
        if (vblk == 0) tr_frag_issue<0, KS>(va + (H) * 16384, al_, ah_); else if (vblk == 1) tr_frag_issue<1, KS>(va + (H) * 16384, al_, ah_); \
        else if (vblk == 2) tr_frag_issue<2, KS>(va + (H) * 16384, al_, ah_); else tr_frag_issue<3, KS>(va + (H) * 16384, al_, ah_); \
        tr_frag_issue<0, KS>(ka + (H) * 16384, b0l, b0h); tr_frag_issue<1, KS>(ka + (H) * 16384, b1l, b1h); \
        tr_frag_issue<2, KS>(ka + (H) * 16384, b2l, b2h); tr_frag_issue<3, KS>(ka + (H) * 16384, b3l, b3h); LGKM0(); \
        const bf16x8 af = PKLH(al_, ah_); \
        acc[0] = __builtin_amdgcn_mfma_f32_32x32x16_bf16(af, PKLH(b0l, b0h), acc[0], 0, 0, 0); \
        acc[1] = __builtin_amdgcn_mfma_f32_32x32x16_bf16(af, PKLH(b1l, b1h), acc[1], 0, 0, 0); \
        acc[2] = __builtin_amdgcn_mfma_f32_32x32x16_bf16(af, PKLH(b2l, b2h), acc[2], 0, 0, 0); \
        acc[3] = __builtin_amdgcn_mfma_f32_32x32x16_bf16(af, PKLH(b3l, b3h), acc[3], 0, 0, 0); } while (0)
        ASTEP(0, 0); ASTEP(0, 1); ASTEP(0, 2); ASTEP(0, 3); ASTEP(1, 0); ASTEP(1, 1); ASTEP(1, 2); ASTEP(1, 3);
#undef ASTEP
        u16* Cd = CST + (size_t)chain_slot(dir, b, h, cc) * 16384;
#pragma unroll
        for (int kb = 0; kb < 4; ++kb)
#pragma unroll
            for (int r = 0; r < 16; ++r) Cd[(vblk * 32 + crow(r, hi)) * 128 + kb * 32 + r32] = f2bf(acc[kb][r]);
        if (tid < 256) {
            const int d2 = tid >> 7, k = tid & 127; const char* img = d2 ? Kb : Kf; float s = 0.f;
            for (int l = 0; l < 128; ++l) s += bf2f(*reinterpret_cast<const u16*>(img + (l >> 6) * 16384 + v_st(l & 63, k & ~7) + (k & 7) * 2));
            NST[(size_t)chain_slot(d2, b, h, cc) * 128 + k] = s;
        }
    }
}

DEVI int proc_chunk(int dir, int i) { return dir == 0 ? i : (i == 0 ? 1 : (i == 1 ? 0 : NCH + 1 - i)); }

DEVI void phase_mlstm_b(const P& p, char* lds) {
    const int tid = threadIdx.x;
    float* dec = (float*)lds; float* scl = dec + 160; float* mst = scl + 160;
    const float2* scal = (const float2*)(p.ws + OFF_MSCAL);
    u32* CST = (u32*)(p.ws + OFF_CST); float* NST = (float*)(p.ws + OFF_NST); float* MST = (float*)(p.ws + OFF_MST);
    for (int it = blockIdx.x; it < 16 * 16; it += gridDim.x) {
        const int chain = it >> 4, sub = it & 15, dir = chain >> 3;
        __syncthreads();
        if (tid == 0) {
            float m = 0.f;
            for (int i = 0; i < NCH; ++i) {
                const int cc = proc_chunk(dir, i); const float2 s = scal[chain * NCH + cc];
                const float mn = fmaxf(s.y + m, s.x);
                dec[i] = __expf(s.y + m - mn); scl[i] = __expf(s.x - mn); mst[i] = m;
                if (sub == 0) MST[chain * NCH + cc] = m;
                m = mn;
            }
        }
        __syncthreads();
        u32* base = CST + (size_t)chain * NCH * 8192 + sub * 512 + tid;
        float s0 = 0.f, s1 = 0.f;
        for (int i0 = 0; i0 < NCH; i0 += 10) {
            u32 v[10];
#pragma unroll
            for (int j = 0; j < 10; ++j) v[j] = base[(size_t)proc_chunk(dir, i0 + j) * 8192];
#pragma unroll
            for (int j = 0; j < 10; ++j) {
                base[(size_t)proc_chunk(dir, i0 + j) * 8192] = cvtpk(s0, s1);
                const float d = dec[i0 + j], sc = scl[i0 + j];
                s0 = fmaf(d, s0, sc * bflo(v[j])); s1 = fmaf(d, s1, sc * bfhi(v[j]));
            }
        }
        if (sub == 0 && tid < 128) {
            float* nb = NST + (size_t)chain * NCH * 128 + tid; float s = 0.f;
            for (int i = 0; i < NCH; ++i) { const int cc = proc_chunk(dir, i); const float v = nb[cc * 128]; nb[cc * 128] = s; s = fmaf(dec[i], s, scl[i] * v); }
        }
    }
}

DEVI void mlstm_c_item(const P& p, int it, char* lds) {
    int tid = threadIdx.x; asm volatile("" : "+v"(tid));
    const int wid = __builtin_amdgcn_readfirstlane(tid >> 6), lane = tid & 63, r32 = lane & 31, hi = lane >> 5;
    const int cc = it % NCH, h = (it / NCH) & 3, b = it / (NCH * 4);
    const int row0 = b * TT + cc * 128;
    char* Kt = lds; char* Vimg = lds + 34816; char* Ct = lds + 67584;
    float* arr = (float*)(lds + 137216);
    float* wsc = arr + 1024 + wid * 64;
    float* xb = (float*)lds;
    const float* gates = (const float*)(p.ws + OFF_GATES);
    const u16* MLQK = (const u16*)(p.ws + OFF_MLQK); const u16* MLV = (const u16*)(p.ws + OFF_MLV);
    const u16* CST = (const u16*)(p.ws + OFF_CST); const float* NST = (const float*)(p.ws + OFF_NST); const float* MST = (const float*)(p.ws + OFF_MST);
    __syncthreads();
    if (wid < 2) { float total, amax; float* a4 = arr + wid * 512; chunk_scan(gates, row0, h, wid, a4, a4 + 128, a4 + 256, total, amax); }
    else if (wid < 6) { const int d2 = (wid - 2) >> 1, k = ((wid - 2) & 1) * 64 + lane; arr[d2 * 512 + 384 + k] = NST[(size_t)chain_slot(d2, b, h, cc) * 128 + k]; }
#pragma unroll
    for (int i = 0; i < 4; ++i) {
        const int idx = tid + 512 * i, l = idx >> 4, ch = idx & 15, c = ch * 8;
        const u32x4 v = *reinterpret_cast<const u32x4*>(MLV + (size_t)(row0 + l) * 512 + h * 128 + c);
        *reinterpret_cast<u32x4*>(Vimg + (l >> 6) * 16384 + v_st(l & 63, c)) = v;
        const int t = cc * 128 + l; bool hasm, hasp; seg_edges(t, hasm, hasp);
        const u16* kp = MLQK + (size_t)(row0 + l) * 1024 + 512 + h * 128 + c;
        const u32x4 x0 = *reinterpret_cast<const u32x4*>(kp);
        const u32x4 xm = hasm ? *reinterpret_cast<const u32x4*>(kp - 1024) : x0;
        const u32x4 xp = hasp ? *reinterpret_cast<const u32x4*>(kp + 1024) : x0;
        float kv[8]; conv_silu8(xm, x0, xp, p.conv_w + 512 + h * 128 + c, hasm, hasp, kv);
        u32x4 ok;
#pragma unroll
        for (int j = 0; j < 4; ++j) ok[j] = cvtpk(kv[2 * j] * 0.08838834764831845f, kv[2 * j + 1] * 0.08838834764831845f);
        *reinterpret_cast<u32x4*>(Kt + swz256(l, ch)) = ok;
#pragma unroll
        for (int d2 = 0; d2 < 2; ++d2) {
            const u32x4 cv = *reinterpret_cast<const u32x4*>(CST + (size_t)chain_slot(d2, b, h, cc) * 16384 + l * 128 + c);
            *reinterpret_cast<u32x4*>(Ct + d2 * 34816 + swz256(l, ch)) = cv;
        }
    }
    const int dir = wid >> 2, qb = wid & 3, q = qb * 32 + r32;
    bf16x8 qr[8];
    {
        const int t = cc * 128 + q; bool hasm, hasp; seg_edges(t, hasm, hasp);
        const u16* qp = MLQK + (size_t)(row0 + q) * 1024 + h * 128 + hi * 8;
#pragma unroll
        for (int d0 = 0; d0 < 8; ++d0) {
            const u32x4 x0 = *reinterpret_cast<const u32x4*>(qp + d0 * 16);
            const u32x4 xm = hasm ? *reinterpret_cast<const u32x4*>(qp + d0 * 16 - 1024) : x0;
            const u32x4 xp = hasp ? *reinterpret_cast<const u32x4*>(qp + d0 * 16 + 1024) : x0;
            float qv[8]; conv_silu8(xm, x0, xp, p.conv_w + h * 128 + d0 * 16 + hi * 8, hasm, hasp, qv);
            u32x4 w; w[0] = cvtpk(qv[0], qv[1]); w[1] = cvtpk(qv[2], qv[3]); w[2] = cvtpk(qv[4], qv[5]); w[3] = cvtpk(qv[6], qv[7]);
            qr[d0] = *reinterpret_cast<bf16x8*>(&w);
        }
    }
    __syncthreads();
    const float* a4 = arr + dir * 512;
    const float m_st = MST[chain_slot(dir, b, h, 0) + cc];
    const float Mq = fmaxf(m_st, a4[256 + q]);
    const float inter = __expf(m_st - Mq);
    float nq = 0.f;
#pragma unroll
    for (int d0 = 0; d0 < 8; ++d0) {
        const u32x4 w = *reinterpret_cast<const u32x4*>(&qr[d0]); const float* nn = a4 + 384 + d0 * 16 + hi * 8;
#pragma unroll
        for (int j = 0; j < 4; ++j) { nq = fmaf(bflo(w[j]), nn[2 * j], nq); nq = fmaf(bfhi(w[j]), nn[2 * j + 1], nq); }
    }
    { auto rr = __builtin_amdgcn_permlane32_swap(__float_as_uint(nq), __float_as_uint(nq), false, false); nq = __uint_as_float(rr[0]) + __uint_as_float(rr[1]); }
    f32x16 o[4] = {};
    const char* Cm = Ct + dir * 34816;
#pragma unroll
    for (int dk = 0; dk < 8; ++dk)
#pragma unroll
        for (int d0 = 0; d0 < 4; ++d0) o[d0] = __builtin_amdgcn_mfma_f32_32x32x16_bf16(qr[dk], lds_b128(Cm, swz256(d0 * 32 + r32, 2 * dk + hi)), o[d0], 0, 0, 0);
    if (hi == 0) wsc[r32] = inter;
    asm volatile("s_waitcnt lgkmcnt(0)" ::: "memory");
#pragma unroll
    for (int d0 = 0; d0 < 4; ++d0)
#pragma unroll
        for (int r = 0; r < 16; ++r) o[d0][r] *= wsc[crow(r, hi)];
    const int vb = (int)(uintptr_t)Vimg + v_rd_base(lane);
    float rs = 0.f;
#define KBLK(KB) do { if (dir == 0 ? (KB) <= qb : (KB) >= qb) { \
        f32x16 pp = {}; \
        _Pragma("unroll") for (int d0 = 0; d0 < 8; ++d0) pp = __builtin_amdgcn_mfma_f32_32x32x16_bf16(lds_b128(Kt, swz256((KB) * 32 + r32, 2 * d0 + hi)), qr[d0], pp, 0, 0, 0); \
        _Pragma("unroll") for (int g = 0; g < 4; ++g) { const f32x4 av4 = *reinterpret_cast<const f32x4*>(a4 + 128 + (KB) * 32 + 8 * g + 4 * hi); \
            _Pragma("unroll") for (int j = 0; j < 4; ++j) { const int key = (KB) * 32 + 8 * g + 4 * hi + j; const bool ok = dir == 0 ? key <= q : key >= q; \
                const float sv = ok ? pp[4 * g + j] * __expf(av4[j] - Mq) : 0.f; pp[4 * g + j] = sv; rs += sv; } } \
        bf16x8 f0, f1; pack_p(pp, f0, f1); \
        { s16x4 l0, h0, l1, h1, l2, h2, l3, h3; constexpr int HH = (KB) >> 1, K0 = ((KB) & 1) * 2; \
          tr_frag_issue<0, K0>(vb + HH * 16384, l0, h0); tr_frag_issue<1, K0>(vb + HH * 16384, l1, h1); tr_frag_issue<2, K0>(vb + HH * 16384, l2, h2); tr_frag_issue<3, K0>(vb + HH * 16384, l3, h3); LGKM0(); \
          o[0] = __builtin_amdgcn_mfma_f32_32x32x16_bf16(f0, PKLH(l0, h0), o[0], 0, 0, 0); o[1] = __builtin_amdgcn_mfma_f32_32x32x16_bf16(f0, PKLH(l1, h1), o[1], 0, 0, 0); \
          o[2] = __builtin_amdgcn_mfma_f32_32x32x16_bf16(f0, PKLH(l2, h2), o[2], 0, 0, 0); o[3] = __builtin_amdgcn_mfma_f32_32x32x16_bf16(f0, PKLH(l3, h3), o[3], 0, 0, 0); \
          tr_frag_issue<0, K0 + 1>(vb + HH * 16384, l0, h0); tr_frag_issue<1, K0 + 1>(vb + HH * 16384, l1, h1); tr_frag_issue<2, K0 + 1>(vb + HH * 16384, l2, h2); tr_frag_issue<3, K0 + 1>(vb + HH * 16384, l3, h3); LGKM0(); \
          o[0] = __builtin_amdgcn_mfma_f32_32x32x16_bf16(f1, PKLH(l0, h0), o[0], 0, 0, 0); o[1] = __builtin_amdgcn_mfma_f32_32x32x16_bf16(f1, PKLH(l1, h1), o[1], 0, 0, 0); \
          o[2] = __builtin_amdgcn_mfma_f32_32x32x16_bf16(f1, PKLH(l2, h2), o[2], 0, 0, 0); o[3] = __builtin_amdgcn_mfma_f32_32x32x16_bf16(f1, PKLH(l3, h3), o[3], 0, 0, 0); } } } while (0)
    KBLK(0); KBLK(1); KBLK(2); KBLK(3);
#undef KBLK
    { auto rr = __builtin_amdgcn_permlane32_swap(__float_as_uint(rs), __float_as_uint(rs), false, false); rs = __uint_as_float(rr[0]) + __uint_as_float(rr[1]); }
    const float nqt = inter * nq + rs;
    const float den = fmaxf(fabsf(nqt), __expf(-(a4[q] + Mq)));
    if (hi == 0) wsc[32 + r32] = 1.f / den;
    asm volatile("s_waitcnt lgkmcnt(0)" ::: "memory");
#pragma unroll
    for (int d0 = 0; d0 < 4; ++d0)
#pragma unroll
        for (int r = 0; r < 16; ++r) o[d0][r] *= wsc[32 + crow(r, hi)];
    __syncthreads();
    if (dir == 1) {
#pragma unroll
        for (int d0 = 0; d0 < 4; ++d0)
#pragma unroll
            for (int r = 0; r < 16; ++r) xb[(qb * 32 + crow(r, hi)) * 128 + d0 * 32 + r32] = o[d0][r];
    }
    __syncthreads();
    if (dir == 0) {
        const u16* OG = (const u16*)(p.ws + OFF_OG); u16* mix = (u16*)(p.ws + OFF_ACT);
#pragma unroll
        for (int d0 = 0; d0 < 4; ++d0)
#pragma unroll
            for (int r = 0; r < 16; ++r) {
                const int ql = qb * 32 + crow(r, hi), v = d0 * 32 + r32;
                const float hv = o[d0][r] + xb[ql * 128 + v];
                const float og = bf2f(OG[(size_t)(row0 + ql) * 512 + h * 128 + v]);
                mix[(size_t)(row0 + ql) * 1024 + 512 + h * 128 + v] = f2bf(hv * og);
            }
    }
}

DEVI void phase_attn(const P& p, char* lds) {
    const int G = gridDim.x;
    for (int it = blockIdx.x; it < 520; it += G) {
        int q0, k0, seq, h;
        if (it < 512) {
            int bh, qb;
            if ((G & 7) == 0) { bh = it & 7; qb = it >> 3; } else { bh = it >> 6; qb = it & 63; }
            const int b = bh >> 2; h = bh & 3; q0 = b * TT + TC + qb * 256; k0 = b * TT; seq = TT;
        } else { const int b = (it - 512) >> 2; h = (it - 512) & 3; q0 = b * TT; k0 = b * TT; seq = TC; }
        diffattn_item(p, q0, k0, seq, h, lds);
    }
}
DEVI void phase_mlstm_c(const P& p, char* lds) {
    for (int it = blockIdx.x; it < NB * 4 * NCH; it += gridDim.x) mlstm_c_item(p, it, lds);
}

DEVI void phase_convert_l1(const P& p, char* lds) {
    for (int it = blockIdx.x; it < N0_EXP; it += gridDim.x) convert_expert_item(p, 1, it, (float*)lds);
}

constexpr int NPHASE = 19;
__global__ void __launch_bounds__(NTHR, 2) fwd_kernel(P p_) {
    extern __shared__ __attribute__((aligned(16))) char lds[];
    volatile LAS unsigned* st = (volatile LAS unsigned*)(lds + LDS_BYTES - 16);
    if (threadIdx.x == 0) { st[0] = 0u; st[1] = 0u; st[2] = 0u; st[3] = 0u; }
    __syncthreads();
    const int lo = p_.ph_lo, hi = p_.ph_hi;
    XcdBarrier bar; bar.bar = (unsigned*)(p_.ws + OFF_BAR); bar.x = 0; bar.st = st;
    if (hi - lo > 1) bar = xcd_barrier_post((unsigned*)(p_.ws + OFF_BAR), st);
#if defined(__HIP_DEVICE_COMPILE__)
#define PARAMS() const __attribute__((address_space(4))) P* kp_ = (const __attribute__((address_space(4))) P*)__builtin_amdgcn_kernarg_segment_ptr(); asm volatile("" : "+s"(kp_)); const P p = *kp_
#else
#define PARAMS() const P p = p_
#endif
#ifndef PHSEL
#define PHON(k) true
#else
#define PHON(k) ((k) == PHSEL)
#endif
#define IN(k) (lo <= (k) && (k) < hi)
#define SEAM(k) do { if (IN(k) && IN((k) + 1)) xcd_barrier(bar); } while (0)
    if (PHON(0) && IN(0)) { PARAMS(); phase_prologue(p, lds); if (((PROBE_DUP) >> 0) & 1u) { phase_prologue(p, lds); } }            SEAM(0);
    if (PHON(1) && IN(1)) { PARAMS(); phase_norm<0>(p, lds); if (((PROBE_DUP) >> 1) & 1u) { phase_norm<0>(p, lds); } }             SEAM(1);
    if (PHON(2) && IN(2)) { PARAMS(); phase_inproj(p, lds); if (((PROBE_DUP) >> 2) & 1u) { phase_inproj(p, lds); } }              SEAM(2);
    if (PHON(3) && IN(3)) { PARAMS(); phase_mlstm_a(p, lds); if (((PROBE_DUP) >> 3) & 1u) { phase_mlstm_a(p, lds); } }             SEAM(3);
    if (PHON(4) && IN(4)) { PARAMS(); phase_mlstm_b(p, lds); if (((PROBE_DUP) >> 4) & 1u) { xcd_barrier(bar); phase_mlstm_a(p, lds); xcd_barrier(bar); phase_mlstm_b(p, lds); } }             SEAM(4);
    if (PHON(5) && IN(5)) { PARAMS(); phase_attn(p, lds); if (((PROBE_DUP) >> 5) & 1u) { phase_attn(p, lds); } }                SEAM(5);
    if (PHON(6) && IN(6)) { PARAMS(); phase_mlstm_c(p, lds); if (((PROBE_DUP) >> 6) & 1u) { phase_mlstm_c(p, lds); } }             SEAM(6);
    if (PHON(7) && IN(7)) { PARAMS(); phase_outproj(p, lds); if (((PROBE_DUP) >> 7) & 1u) { phase_outproj(p, lds); } }             SEAM(7);
    if (PHON(8) && IN(8)) { PARAMS(); phase_norm<1>(p, lds); if (((PROBE_DUP) >> 8) & 1u) { phase_norm<1, true>(p, lds); } }             SEAM(8);
    if (PHON(9) && IN(9)) { PARAMS(); phase_moe_up(p, 0, lds); if (((PROBE_DUP) >> 9) & 1u) { phase_moe_up(p, 0, lds); } }           SEAM(9);
    if (PHON(10) && IN(10)) { PARAMS(); phase_moe_down(p, 0, lds); if (((PROBE_DUP) >> 10) & 1u) { phase_moe_down<true>(p, 0, lds); } }        SEAM(10);
    if (PHON(11) && IN(11)) { PARAMS(); phase_norm<2>(p, lds); phase_convert_l1(p, lds); if (((PROBE_DUP) >> 11) & 1u) { phase_norm<2>(p, lds); phase_convert_l1(p, lds); } } SEAM(11);
    if (PHON(12) && IN(12)) { PARAMS(); phase_fnet_gemm(p, lds); if (((PROBE_DUP) >> 12) & 1u) { phase_fnet_gemm(p, lds); } }          SEAM(12);
    if (PHON(13) && IN(13)) { PARAMS(); phase_fft1(p, lds); if (((PROBE_DUP) >> 13) & 1u) { phase_fft1(p, lds); } }               SEAM(13);
    if (PHON(14) && IN(14)) { PARAMS(); phase_fft2(p, lds); if (((PROBE_DUP) >> 14) & 1u) { phase_fft2<true>(p, lds); } }               SEAM(14);
    if (PHON(15) && IN(15)) { PARAMS(); phase_norm<3>(p, lds); if (((PROBE_DUP) >> 15) & 1u) { phase_norm<3, true>(p, lds); } }            SEAM(15);
    if (PHON(16) && IN(16)) { PARAMS(); phase_moe_up(p, 1, lds); if (((PROBE_DUP) >> 16) & 1u) { phase_moe_up(p, 1, lds); } }          SEAM(16);
    if (PHON(17) && IN(17)) { PARAMS(); phase_moe_down(p, 1, lds); if (((PROBE_DUP) >> 17) & 1u) { phase_moe_down<true>(p, 1, lds); } }        SEAM(17);
    if (PHON(18) && IN(18)) { PARAMS(); phase_norm<4>(p, lds); if (((PROBE_DUP) >> 18) & 1u) { phase_norm<4>(p, lds); } }
#undef IN
#undef SEAM
}

#ifndef ONE_LAUNCH
#define ONE_LAUNCH 1
#endif
extern "C" void kernel_launch(void* const* d_in, const int* in_sizes, int n_in, void* d_out, int out_size, void* d_ws, size_t ws_size, hipStream_t stream) {
    static int grid = 0;
    if (grid == 0) {
        if (n_in != 21 || out_size != NLAT * DM || ws_size < OFF_END) { fprintf(stderr, "kernel_launch: unexpected shapes (n_in %d out %d ws %zu need %zu)\n", n_in, out_size, ws_size, (size_t)OFF_END); grid = -1; return; }
        int dev = 0, cus = 0;
        if (hipGetDevice(&dev) != hipSuccess || hipDeviceGetAttribute(&cus, hipDeviceAttributeMultiprocessorCount, dev) != hipSuccess) { grid = -1; return; }
        if (hipFuncSetAttribute((const void*)fwd_kernel, hipFuncAttributeMaxDynamicSharedMemorySize, LDS_BYTES) != hipSuccess) { fprintf(stderr, "kernel_launch: hipFuncSetAttribute failed\n"); grid = -1; return; }
        int per_cu = 0;
        if (hipOccupancyMaxActiveBlocksPerMultiprocessor(&per_cu, (const void*)fwd_kernel, NTHR, LDS_BYTES) != hipSuccess || per_cu < 1) { fprintf(stderr, "kernel_launch: occupancy query says %d\n", per_cu); (void)hipGetLastError(); grid = -1; return; }
        grid = cus;
    }
    if (grid < 0) return;
    (void)hipMemsetAsync(d_ws, 0, ZERO_BYTES, stream);
    P p{};
    const float* const* in = (const float* const*)d_in;
    p.x = in[0]; p.c = in[1]; p.ctx = in[2]; p.c_ctx = in[3]; p.ada_w = in[4]; p.ada_b = in[5]; p.nmix_g = in[6]; p.nffn_g = in[7];
    p.w_in = in[8]; p.w_out = in[9]; p.conv_w = in[10]; p.gate_b = in[11]; p.lamv = in[12]; p.subln_g = in[13]; p.w_fnet = in[14];
    p.router_w = in[15]; p.router_b = in[16]; p.w_gate = in[17]; p.w_up = in[18]; p.w_down = in[19]; p.final_g = in[20];
    p.out = (float*)d_out; p.ws = (char*)d_ws;
#if ONE_LAUNCH
    p.ph_lo = 0; p.ph_hi = NPHASE;
    hipLaunchKernelGGL(fwd_kernel, dim3(grid), dim3(NTHR), LDS_BYTES, stream, p);
#else
    for (int k = 0; k < NPHASE; ++k) { p.ph_lo = k; p.ph_hi = k + 1; hipLaunchKernelGGL(fwd_kernel, dim3(grid), dim3(NTHR), LDS_BYTES, stream, p); }
#endif
}
```

```cpp
#include <hip/hip_runtime.h>
#include <stdint.h>
#include <stdio.h>

#define DEVI __device__ __forceinline__
#define PROBE_DUP (0u)
typedef unsigned short u16;
typedef unsigned int u32;
using bf16x8 = __attribute__((ext_vector_type(8))) short;
using s16x4  = __attribute__((ext_vector_type(4))) short;
using f32x16 = __attribute__((ext_vector_type(16))) float;
using f32x4  = __attribute__((ext_vector_type(4))) float;
using u32x4  = __attribute__((ext_vector_type(4))) unsigned;
using u32x2  = __attribute__((ext_vector_type(2))) unsigned;

constexpr int DM = 1024, NB = 2, TL = 16384, TC = 256, TT = TL + TC, NTOK = NB * TT, NLAT = NB * TL;
constexpr int NCH = TT / 128;
constexpr int NTHR = 512;
constexpr int LDS_BYTES = 147456;

constexpr size_t al256(size_t x) { return (x + 255) / 256 * 256; }
constexpr size_t OFF_BAR   = 0;
constexpr size_t OFF_CNT   = 16384;
constexpr size_t ZERO_BYTES = 20480;
constexpr size_t OFF_MOD   = ZERO_BYTES;
constexpr size_t OFF_ROPER = OFF_MOD + al256(2 * 3 * 6144 * 4);
constexpr size_t OFF_ROPEC = OFF_ROPER + 256 * 16 * 8;
constexpr size_t OFF_TW    = OFF_ROPEC + 64 * 16 * 8;
constexpr size_t OFF_DFTC  = OFF_TW + 16384 * 8;
constexpr size_t OFF_DFTS  = OFF_DFTC + 32768;
constexpr size_t OFF_LAM   = OFF_DFTS + 32768;
constexpr size_t OFF_WG16  = OFF_LAM + 256;
constexpr size_t OFF_MSCAL = OFF_WG16 + 65536;
constexpr size_t OFF_MST   = OFF_MSCAL + al256(16 * NCH * 8);
constexpr size_t OFF_WINT  = OFF_MST + al256(16 * NCH * 4);
constexpr size_t OFF_WOUTT = OFF_WINT + (size_t)3584 * 1024 * 2;
constexpr size_t OFF_FNT   = OFF_WOUTT + (size_t)1024 * 1024 * 2;
constexpr size_t OFF_WGU   = OFF_FNT + (size_t)2048 * 1024 * 2;
constexpr size_t OFF_WDT   = OFF_WGU + (size_t)16 * 1024 * 1024 * 2;
constexpr size_t OFF_ACT   = OFF_WDT + (size_t)16 * 1024 * 512 * 2;
constexpr size_t SZ_ACT    = (size_t)NTOK * 1024 * 2;
constexpr size_t OFF_XC    = OFF_ACT + SZ_ACT;
constexpr size_t OFF_GATES = OFF_XC + (size_t)NB * TC * 1024 * 4;
constexpr size_t OFF_TOKW  = OFF_GATES + (size_t)NTOK * 16 * 4;
constexpr size_t OFF_LIST  = OFF_TOKW + al256((size_t)NTOK * 8);
constexpr size_t OFF_NST   = OFF_LIST + (size_t)24 * NTOK * 4;
constexpr size_t OFF_CST   = OFF_NST + (size_t)16 * NCH * 128 * 4;
constexpr size_t SZ_CST    = (size_t)16 * NCH * 16384 * 2;
constexpr size_t OFF_BIG   = OFF_CST + SZ_CST;
constexpr size_t OFF_Q     = OFF_BIG;
constexpr size_t OFF_K     = OFF_Q + (size_t)NTOK * 512 * 2;
constexpr size_t OFF_V     = OFF_K + (size_t)NTOK * 512 * 2;
constexpr size_t OFF_MLQK  = OFF_V + (size_t)NTOK * 512 * 2;
constexpr size_t OFF_MLV   = OFF_MLQK + (size_t)NTOK * 1024 * 2;
constexpr size_t OFF_OG    = OFF_MLV + (size_t)NTOK * 512 * 2;
constexpr size_t OFF_END   = OFF_OG + (size_t)NTOK * 512 * 2;
constexpr size_t OFF_HE    = OFF_BIG;
constexpr size_t OFF_ZR    = OFF_BIG;
constexpr size_t OFF_ZI    = OFF_ZR + (size_t)NLAT * 1024 * 2;
constexpr size_t OFF_YR    = OFF_CST;
constexpr size_t OFF_YI    = OFF_ACT;
static_assert((size_t)NLAT * 1024 * 2 <= SZ_CST && (size_t)NLAT * 1024 * 2 <= SZ_ACT, "alias sizes");
static_assert(OFF_END < (size_t)500 * 1024 * 1024, "workspace");

struct P {
    const float *x, *c, *ctx, *c_ctx, *ada_w, *ada_b, *nmix_g, *nffn_g, *w_in, *w_out, *conv_w, *gate_b, *lamv, *subln_g,
                *w_fnet, *router_w, *router_b, *w_gate, *w_up, *w_down, *final_g;
    float* out;
    char* ws;
    int ph_lo, ph_hi;
};

#define XB_TMO      128
#define XB_XCNT(j)  (256  + 64 * (j))
#define XB_XSUB(j)  (1280 + 64 * (j))
#define XB_XGEN(j)  (2304 + 64 * (j))
#define XB_TOP      3328
#define XB_TOPGEN   3392
#define XCD_BAR_WORDS 3456
#define XB_SPIN_CAP (1u << 18)
#define LAS __attribute__((address_space(3)))

__device__ __forceinline__ unsigned xb_ld(unsigned* p)              { return __hip_atomic_load(p, __ATOMIC_RELAXED, __HIP_MEMORY_SCOPE_AGENT); }
__device__ __forceinline__ unsigned xb_add(unsigned* p, unsigned v) { return __hip_atomic_fetch_add(p, v, __ATOMIC_RELAXED, __HIP_MEMORY_SCOPE_AGENT); }
__device__ __forceinline__ unsigned xb_xcc_id() { return (unsigned)__builtin_amdgcn_s_getreg((3 << 11) | 20) & 0xFu; }
#define XB_SPIN(cond, bar) do { unsigned _sp = 0; while (cond) { __builtin_amdgcn_s_sleep(1); \
    if ((++_sp & 255u) == 0u) { if (xb_ld(&(bar)[XB_TMO])) break; if (_sp > XB_SPIN_CAP) { atomicAdd(&(bar)[XB_TMO], 1u); break; } } } } while (0)

struct XcdBarrier { unsigned* bar; unsigned x; volatile LAS unsigned* st; };

__device__ __forceinline__ XcdBarrier xcd_barrier_post(unsigned* bar, volatile LAS unsigned* st) {
    XcdBarrier b; b.bar = bar; b.x = xb_xcc_id(); b.st = st;
    if (threadIdx.x == 0) (void)xb_add(&bar[XB_XCNT(b.x)], 1u);
    return b;
}
__device__ __forceinline__ void xcd_barrier_complete(unsigned* bar, unsigned x, unsigned& nloc, unsigned& nx) {
    const unsigned G = gridDim.x * gridDim.y * gridDim.z;
    unsigned sum, cnt, mine, sp = 0u;
    for (;;) {
        sum = 0u; cnt = 0u; mine = 0u;
#pragma unroll
        for (unsigned j = 0; j < 16; ++j) { const unsigned c = xb_ld(&bar[XB_XCNT(j)]); sum += c; cnt += (c > 0u) ? 1u : 0u; mine = (j == x) ? c : mine; }
        if (sum == G) break;
        __builtin_amdgcn_s_sleep(1);
        if ((++sp & 255u) == 0u) { if (xb_ld(&bar[XB_TMO])) break; if (sp > XB_SPIN_CAP) { atomicAdd(&bar[XB_TMO], 1u); break; } }
    }
    nloc = mine > 0u ? mine : 1u; nx = cnt > 0u ? cnt : 1u;
}
__device__ __forceinline__ void xcd_barrier(const XcdBarrier& b) {
    asm volatile("s_waitcnt vmcnt(0)" ::: "memory");
    __syncthreads();
    if (threadIdx.x == 0) {
        unsigned* bar = b.bar;
        __builtin_amdgcn_s_waitcnt(0);
        unsigned nloc = b.st[0], nx = b.st[1];
        if (nloc == 0u) { xcd_barrier_complete(bar, b.x, nloc, nx); b.st[0] = nloc; b.st[1] = nx; }
        const unsigned old = xb_add(&bar[XB_XSUB(b.x)], 1u);
        const unsigned gen = old / nloc;
        if (old + 1u == (gen + 1u) * nloc) {
            __builtin_amdgcn_fence(__ATOMIC_RELEASE, "agent");
            asm volatile("s_waitcnt vmcnt(0)" ::: "memory");
            const unsigned og = xb_add(&bar[XB_TOP], 1u);
            const unsigned tg = og / nx;
            if (og + 1u == (tg + 1u) * nx) xb_add(&bar[XB_TOPGEN], 1u);
            else XB_SPIN(xb_ld(&bar[XB_TOPGEN]) == tg, bar);
            __builtin_amdgcn_fence(__ATOMIC_ACQUIRE, "agent");
            xb_add(&bar[XB_XGEN(b.x)], 1u);
            asm volatile("s_waitcnt vmcnt(0)" ::: "memory");
        } else {
            XB_SPIN(xb_ld(&bar[XB_XGEN(b.x)]) == gen, bar);
            __builtin_amdgcn_fence(__ATOMIC_ACQUIRE, "agent");
            asm volatile("s_waitcnt vmcnt(0)" ::: "memory");
        }
    }
    __syncthreads();
}

DEVI u16 f2bf(float f) { u32 u = __float_as_uint(f); u += 0x7fffu + ((u >> 16) & 1u); return (u16)(u >> 16); }
DEVI float bf2f(u32 h) { return __uint_as_float(h << 16); }
DEVI u32 cvtpk(float lo, float hi) { u32 r; asm("v_cvt_pk_bf16_f32 %0, %1, %2" : "=v"(r) : "v"(lo), "v"(hi)); return r; }
DEVI float bflo(u32 w) { return __uint_as_float(w << 16); }
DEVI float bfhi(u32 w) { return __uint_as_float(w & 0xffff0000u); }
DEVI int crow(int r, int hi) { return (r & 3) + 8 * (r >> 2) + 4 * hi; }
DEVI float wave_sum(float v) { for (int o = 32; o; o >>= 1) v += __shfl_xor(v, o); return v; }
DEVI float wave_max(float v) { for (int o = 32; o; o >>= 1) v = fmaxf(v, __shfl_xor(v, o)); return v; }
DEVI float sigmoidf_(float x) { return 1.f / (1.f + __expf(-x)); }
DEVI float siluf_(float x) { return x / (1.f + __expf(-x)); }
DEVI float logsigmoidf_(float x) { return fminf(x, 0.f) - log1pf(__expf(-fabsf(x))); }
#define SBAR() __builtin_amdgcn_sched_barrier(0)

DEVI void sincos2pi(double frac, double& s, double& c) {
    frac -= floor(frac);
    double q = rint(frac * 4.0);
    double r = (frac - q * 0.25) * 6.283185307179586476925;
    double r2 = r * r;
    double sr = r * (1.0 + r2 * (-1.0 / 6 + r2 * (1.0 / 120 + r2 * (-1.0 / 5040 + r2 * (1.0 / 362880 + r2 * (-1.0 / 39916800 + r2 * (1.0 / 6227020800.0 + r2 * (-1.0 / 1307674368000.0))))))));
    double cr = 1.0 + r2 * (-0.5 + r2 * (1.0 / 24 + r2 * (-1.0 / 720 + r2 * (1.0 / 40320 + r2 * (-1.0 / 3628800 + r2 * (1.0 / 479001600.0 + r2 * (-1.0 / 87178291200.0 + r2 * (1.0 / 20922789888000.0))))))));
    int qi = ((int)q) & 3;
    if (qi == 0) { s = sr; c = cr; } else if (qi == 1) { s = cr; c = -sr; } else if (qi == 2) { s = -sr; c = -cr; } else { s = -cr; c = sr; }
}

DEVI float* xs_ptr(const P& p, int layer, int tok) {
    if (layer == 0) {
        int b = tok >= TT ? 1 : 0, t = tok - b * TT;
        if (t < TC) return (float*)(p.ws + OFF_XC) + (size_t)(b * TC + t) * DM;
        return p.out + (size_t)(b * TL + t - TC) * DM;
    }
    return p.out + (size_t)tok * DM;
}
DEVI const float* xin_ptr(const P& p, int tok) {
    int b = tok >= TT ? 1 : 0, t = tok - b * TT;
    if (t < TC) return p.ctx + (size_t)(b * TC + t) * DM;
    return p.x + (size_t)(b * TL + t - TC) * DM;
}
DEVI int modsel(int layer, int tok) {
    if (layer == 0) { int b = tok >= TT ? 1 : 0, t = tok - b * TT; return t < TC ? 2 : b; }
    return tok >> 14;
}

DEVI int swz128(int row, int chunk) { return row * 144 + (chunk << 4); }
DEVI int swz256(int row, int chunk) { return row * 272 + (chunk << 4); }
DEVI int v_st(int k, int c) { const int kk = (k & ~0xC) | ((k & 4) << 1) | ((k & 8) >> 1); return ((kk >> 3) * 4 + (c >> 5)) * 512 + ((kk & 7) * 32 + (c & 31)) * 2; }
DEVI int v_rd_base(int lane) { return ((lane & 3) << 3) | (((lane >> 2) & 3) << 6) | (((lane >> 4) & 1) << 5) | (((lane >> 5) & 1) << 8); }
constexpr int v_rd_off(int d0, int ks, int half) { return d0 * 512 + ks * 4096 + half * 2048; }
template <int OFF> DEVI s16x4 tr_read(int vb) {
    s16x4 r; asm volatile("ds_read_b64_tr_b16 %0, %1 offset:%2" : "=&v"(r) : "v"(vb), "i"(OFF) : "memory"); return r;
}
#define PKLH(L, H) (bf16x8){L[0], L[1], L[2], L[3], H[0], H[1], H[2], H[3]}
template <int D0, int KS> DEVI void tr_frag_issue(int vb, s16x4& l, s16x4& h) { l = tr_read<v_rd_off(D0, KS, 0)>(vb); h = tr_read<v_rd_off(D0, KS, 1)>(vb); }
#define LGKM0() do { asm volatile("s_waitcnt lgkmcnt(0)" ::: "memory"); SBAR(); } while (0)

DEVI bf16x8 lds_b128(const char* base, int off) { return *reinterpret_cast<const bf16x8*>(base + off); }

DEVI void pack_p(const f32x16& pp, bf16x8& f0, bf16x8& f1) {
#define PK4(BASE, OUT) do { unsigned a0 = cvtpk(pp[BASE + 0], pp[BASE + 1]), a1 = cvtpk(pp[BASE + 2], pp[BASE + 3]);   \
    unsigned b0 = cvtpk(pp[BASE + 4], pp[BASE + 5]), b1 = cvtpk(pp[BASE + 6], pp[BASE + 7]);                            \
    auto r0 = __builtin_amdgcn_permlane32_swap(a0, b0, false, false); auto r1 = __builtin_amdgcn_permlane32_swap(a1, b1, false, false); \
    u32x4 w = {r0[0], r1[0], r0[1], r1[1]}; OUT = *reinterpret_cast<bf16x8*>(&w); } while (0)
    PK4(0, f0); PK4(8, f1);
#undef PK4
}

namespace g8 {
constexpr int BM = 256, BK = 64, HALF = 128, HTB = HALF * BK * 2, STAGE_BYTES = 8 * HTB, NXCD = 8, WGM = 8;
DEVI int lds_byte(int r, int c) { const int st = (r >> 4) * 2 + (c >> 5), rr = r & 15, cc = c & 31, ob = rr * 64 + cc * 2; return st * 1024 + (ob ^ (((ob >> 9) & 1) << 5)); }
DEVI void stage_rc(int b, int& R, int& C) { const int st = b / 1024, sb = b % 1024, swz = sb ^ (((sb >> 9) & 1) << 5); R = (st >> 1) * 16 + swz / 64; C = (st & 1) * 32 + (swz % 64) / 2; }
DEVI int perm32(int rho) { const int n = rho >> 4, i = rho & 15; return 8 * (i >> 2) + 4 * n + (i & 3); }
struct Unit { int pm, pn; const char* B0; const char* B1; int cls, r0, ncls; };
DEVI bool tile_order(int i, int G, int c, int nM, int nN, int& pm, int& pn) {
    const int nwg = nM * nN; const long L = (long)i * G + c; if (L >= nwg) return false;
    int wgid = (int)L; { const int q = nwg / NXCD, r = nwg % NXCD, xcd = wgid % NXCD, off = wgid / NXCD; wgid = (xcd < r ? xcd * (q + 1) : r * (q + 1) + (xcd - r) * q) + off; }
    const int nig = WGM * nN, gid = wgid / nig, fm = gid * WGM, gsz = (nM - fm) < WGM ? (nM - fm) : WGM;
    pm = fm + ((wgid % nig) % gsz); pn = (wgid % nig) / gsz; return true;
}
typedef float f32x4v __attribute__((ext_vector_type(4)));
template <class Epi, class Sched>
DEVI void gemm_phase(LAS unsigned char* lds, const char* Abase, int ldbB  , int ksplit  , const Sched& S, const Epi& E) {
    const int tid = threadIdx.x, wid = __builtin_amdgcn_readfirstlane(tid >> 6), lane = tid & 63, wr = wid >> 2, wc = wid & 3, fr = lane & 15, fq = lane >> 4;
    constexpr int nt = 1024 / BK;
    unsigned voffB[2];
#pragma unroll
    for (int i = 0; i < 2; ++i) { int R, C; stage_rc(tid * 16 + i * 8192, R, C); const int Rb = Epi::PERM ? ((R & ~31) + perm32(R & 31)) : R; voffB[i] = (unsigned)(Rb * ldbB + C * 2); }
    const size_t kstep = (size_t)(BK * 2);
    const size_t hstepB = (size_t)HALF * ldbB;
    const unsigned ldsw = (unsigned)wid * 1024u;
    const int aoff = lds_byte(wr * 64 + fr, fq * 8), boff = lds_byte(wc * 32 + fr, fq * 8);
#define G8_SA(b, h) (((b) * 2 + (h)) * HTB)
#define G8_SB(b, h) ((4 + (b) * 2 + (h)) * HTB)
#define G8_STAGE(bufoff, gbase, voff) do { _Pragma("unroll") for (int _i = 0; _i < 2; ++_i) \
        __builtin_amdgcn_global_load_lds((const unsigned*)((const char*)(gbase) + (voff)[_i]), (LAS unsigned*)(lds + (bufoff) + ldsw + _i * 8192), 16, 0, 0); } while (0)
#define G8_LDA(dst, b, h) do { _Pragma("unroll") for (int m = 0; m < 4; ++m) _Pragma("unroll") for (int k = 0; k < 2; ++k) dst[m][k] = *(const LAS bf16x8*)(lds + G8_SA(b, h) + aoff + m * 2048 + k * 1024); } while (0)
#define G8_LDB(dst, b, h) do { _Pragma("unroll") for (int n = 0; n < 2; ++n) _Pragma("unroll") for (int k = 0; k < 2; ++k) dst[n][k] = *(const LAS bf16x8*)(lds + G8_SB(b, h) + boff + n * 2048 + k * 1024); } while (0)
#define G8_MMA(ai, bj, At, Bt) do { __builtin_amdgcn_s_setprio(1); _Pragma("unroll") for (int m = 0; m < 4; ++m) _Pragma("unroll") for (int n = 0; n < 2; ++n) _Pragma("unroll") for (int k = 0; k < 2; ++k) \
        acc[ai][bj][m][n] = __builtin_amdgcn_mfma_f32_16x16x32_bf16(Bt[n][k], At[m][k], acc[ai][bj][m][n], 0, 0, 0); __builtin_amdgcn_s_setprio(0); } while (0)
#define G8_WAIT_V(n) asm volatile("s_waitcnt vmcnt(" #n ")" ::: "memory")
#define G8_WAIT_L(n) asm volatile("s_waitcnt lgkmcnt(" #n ")" ::: "memory")
#define G8_BAR __builtin_amdgcn_s_barrier()
#define G8_SCHED __builtin_amdgcn_sched_barrier(0)
#define G8_BPTR(u, kt) (((kt) < ksplit ? (u).B0 : (u).B1) + (size_t)(kt) * kstep)
    Unit cur, nxt; int ui = 0;
    if (!S.next(0, cur)) return;
    f32x4v acc[2][2][4][2];
#pragma unroll
    for (int a = 0; a < 2; ++a)
#pragma unroll
        for (int b = 0; b < 2; ++b)
#pragma unroll
            for (int m = 0; m < 4; ++m)
#pragma unroll
                for (int n = 0; n < 2; ++n) acc[a][b][m][n] = (f32x4v){0.f, 0.f, 0.f, 0.f};
    bf16x8 At[4][2], B0[2][2], B1[2][2];
    unsigned voffA[2]; unsigned vs[2][2];
    constexpr size_t hstepA = (size_t)HALF * 2048, tstepA = 2 * hstepA;
    if constexpr (Sched::GATHER) S.aoffs(cur, vs);
    else {
#pragma unroll
        for (int i = 0; i < 2; ++i) { int R, C; stage_rc(tid * 16 + i * 8192, R, C); voffA[i] = (unsigned)(R * 2048 + C * 2); }
    }
    const char* cA = Sched::GATHER ? Abase : Abase + (size_t)cur.pm * tstepA;
#define G8_STAGE_A(bufoff, ptr, h) do { if constexpr (Sched::GATHER) G8_STAGE(bufoff, ptr, vs[h]); else G8_STAGE(bufoff, (ptr) + (h) * hstepA, voffA); } while (0)
    { const char* cB = G8_BPTR(cur, 0); const char* cB1 = G8_BPTR(cur, 1);
      G8_STAGE(G8_SB(0, 0), cB, voffB); G8_STAGE_A(G8_SA(0, 0), cA, 0); G8_STAGE(G8_SB(0, 1), cB + hstepB, voffB); G8_STAGE_A(G8_SA(0, 1), cA, 1);
      if (wr == 1) G8_BAR;
      G8_WAIT_V(4); G8_BAR;
      G8_STAGE(G8_SB(1, 0), cB1, voffB); G8_STAGE_A(G8_SA(1, 0), cA + kstep, 0); G8_STAGE(G8_SB(1, 1), cB1 + hstepB, voffB);
      G8_WAIT_V(6); G8_BAR; }
    for (;;) {
        bool has_next = false; const char* nA = cA;
        for (int t = 0; t < nt; t += 2) {
            const bool last = (t == nt - 2);
            const char* a1 = cA + (size_t)(t + 1) * kstep;
            G8_LDB(B0, 0, 0); G8_SCHED; G8_LDA(At, 0, 0); G8_STAGE_A(G8_SA(1, 1), a1, 1);
            G8_WAIT_L(8); G8_BAR; G8_WAIT_L(0); G8_MMA(0, 0, At, B0); G8_BAR; G8_SCHED;
            if (last) {
                has_next = S.next(ui + 1, nxt);
                if (has_next) { if constexpr (Sched::GATHER) S.aoffs(nxt, vs); else nA = Abase + (size_t)nxt.pm * tstepA; } else nxt = cur;
            }
            const char* a2 = last ? nA : cA + (size_t)(t + 2) * kstep; const char* a3 = a2 + kstep;
            const char* b2 = last ? G8_BPTR(nxt, 0) : G8_BPTR(cur, t + 2); const char* b3 = last ? G8_BPTR(nxt, 1) : G8_BPTR(cur, t + 3);
            G8_LDB(B1, 0, 1); G8_STAGE(G8_SB(0, 0), b2, voffB);
            G8_BAR; G8_WAIT_L(0); G8_MMA(0, 1, At, B1); G8_BAR;
            G8_LDA(At, 0, 1); G8_STAGE_A(G8_SA(0, 0), a2, 0);
            G8_BAR; G8_WAIT_L(0); G8_MMA(1, 0, At, B0); G8_BAR; G8_SCHED;
            G8_STAGE(G8_SB(0, 1), b2 + hstepB, voffB);
            G8_WAIT_V(6); G8_BAR; G8_MMA(1, 1, At, B1); G8_BAR;
            G8_LDB(B0, 1, 0); G8_SCHED; G8_LDA(At, 1, 0); G8_STAGE_A(G8_SA(0, 1), a2, 1);
            G8_WAIT_L(8); G8_BAR; G8_WAIT_L(0); G8_MMA(0, 0, At, B0); G8_BAR; G8_SCHED;
            G8_LDB(B1, 1, 1); G8_STAGE(G8_SB(1, 0), b3, voffB);
            G8_BAR; G8_WAIT_L(0); G8_MMA(0, 1, At, B1); G8_BAR;
            G8_LDA(At, 1, 1); G8_STAGE_A(G8_SA(1, 0), a3, 0);
            G8_BAR; G8_WAIT_L(0); G8_MMA(1, 0, At, B0); G8_BAR; G8_SCHED;
            G8_STAGE(G8_SB(1, 1), b3 + hstepB, voffB);
            G8_WAIT_V(6); G8_BAR; G8_MMA(1, 1, At, B1); G8_BAR;
        }
        cA = nA;
        { int tz = threadIdx.x; asm volatile("" : "+v"(tz));
          const int w2 = tz >> 6, l2 = tz & 63; E(acc, cur, w2 >> 2, w2 & 3, l2 & 15, l2 >> 4); }
        if (!has_next) break;
#pragma unroll
        for (int a = 0; a < 2; ++a)
#pragma unroll
            for (int b = 0; b < 2; ++b)
#pragma unroll
                for (int m = 0; m < 4; ++m)
#pragma unroll
                    for (int n = 0; n < 2; ++n) acc[a][b][m][n] = (f32x4v){0.f, 0.f, 0.f, 0.f};
        cur = nxt; ++ui;
    }
    G8_WAIT_V(0);
    if (wr == 0) G8_BAR;
    G8_BAR;
#undef G8_SA
#undef G8_SB
#undef G8_STAGE
#undef G8_STAGE_A
#undef G8_LDA
#undef G8_LDB
#undef G8_MMA
#undef G8_WAIT_V
#undef G8_WAIT_L
#undef G8_BAR
#undef G8_SCHED
#undef G8_BPTR
}
DEVI void lane_rc(int i, int& R, int& C) { int tz = threadIdx.x; asm volatile("" : "+v"(tz)); stage_rc(tz * 16 + i * 8192, R, C); }
struct DenseSched {
    static constexpr bool GATHER = false;
    const char* Bt; int nM, nN, G, c; size_t btile;
    DEVI bool next(int i, Unit& u) const { if (!tile_order(i, G, c, nM, nN, u.pm, u.pn)) return false; u.B0 = u.B1 = Bt + (size_t)u.pn * btile; u.cls = 0; u.r0 = 0; u.ncls = 0; return true; }
    DEVI void aoffs(const Unit& u, unsigned (&v)[2][2]) const {
#pragma unroll
        for (int i = 0; i < 2; ++i) { int R, C; lane_rc(i, R, C);
#pragma unroll
            for (int h = 0; h < 2; ++h) v[h][i] = (unsigned)(((u.pm * 256 + h * 128 + R) * 1024 + C) * 2); }
    }
};
}

template <class PF>
DEVI void transpose_tile(PF colptr, int ldsrc, u16* dst, int lddst, int k0, int n0, float* tl) {
    const int t = threadIdx.x, nn = t & 63, kk = t >> 6;
    const float* sp = colptr(n0 + nn);
#pragma unroll
    for (int i = 0; i < 8; ++i) tl[(kk + 8 * i) * 65 + nn] = sp[(size_t)(k0 + kk + 8 * i) * ldsrc];
    __syncthreads();
    const int n = t >> 3, kc = t & 7;
    u32x4 w;
    w[0] = cvtpk(tl[(kc * 8 + 0) * 65 + n], tl[(kc * 8 + 1) * 65 + n]);
    w[1] = cvtpk(tl[(kc * 8 + 2) * 65 + n], tl[(kc * 8 + 3) * 65 + n]);
    w[2] = cvtpk(tl[(kc * 8 + 4) * 65 + n], tl[(kc * 8 + 5) * 65 + n]);
    w[3] = cvtpk(tl[(kc * 8 + 6) * 65 + n], tl[(kc * 8 + 7) * 65 + n]);
    *reinterpret_cast<u32x4*>(dst + (size_t)(n0 + n) * lddst + k0 + kc * 8) = w;
    __syncthreads();
}

DEVI void convert_expert_item(const P& p, int layer, int it, float* tl) {
    const int e = it / 384, r = it % 384;
    const float* wg = p.w_gate + ((size_t)layer * 16 + e) * 1024 * 512;
    const float* wu = p.w_up   + ((size_t)layer * 16 + e) * 1024 * 512;
    const float* wd = p.w_down + ((size_t)layer * 16 + e) * 512 * 1024;
    if (r < 256) {
        u16* dst = (u16*)(p.ws + OFF_WGU) + (size_t)e * 1024 * 1024;
        const int kt = r >> 4, nt = r & 15;
        transpose_tile([&](int n) { const int q = n >> 3, sgu = (n >> 2) & 1, j = n & 3; return (sgu ? wu : wg) + q * 4 + j; }, 512, dst, 1024, kt * 64, nt * 64, tl);
    } else {
        const int q = r - 256; u16* dst = (u16*)(p.ws + OFF_WDT) + (size_t)e * 1024 * 512;
        const int kt = q >> 4, nt = q & 15;
        transpose_tile([&](int n) { return wd + n; }, 1024, dst, 512, kt * 64, nt * 64, tl);
    }
}

constexpr int N0_WIN = 16 * 56, N0_WOUT = 256, N0_EXP = 16 * 384, N0_FN = 2048, N0_MOD = 192, N0_TAB = 128;
constexpr int N0_TOTAL = N0_WIN + N0_WOUT + N0_EXP + N0_FN + N0_MOD + N0_TAB;

DEVI void phase_prologue(const P& p, char* lds) {
    float* tl = (float*)lds;
    const int tid = threadIdx.x;
    for (int it = blockIdx.x; it < N0_TOTAL; it += gridDim.x) {
        int r = it;
        if (r < N0_WIN) {
            const int kt = r / 56, nt = r % 56;
            const float* w = p.w_in;
            transpose_tile([&](int n) { return w + n; },
                           3600, (u16*)(p.ws + OFF_WINT), 1024, kt * 64, nt * 64, tl);
            continue;
        }
        r -= N0_WIN;
        if (r < N0_WOUT) {
            const int kt = r >> 4, nt = r & 15; const float* w = p.w_out;
            transpose_tile([&](int n) { return w + n; }, 1024, (u16*)(p.ws + OFF_WOUTT), 1024, kt * 64, nt * 64, tl);
            continue;
        }
        r -= N0_WOUT;
        if (r < N0_EXP) { convert_expert_item(p, 0, r, tl); continue; }
        r -= N0_EXP;
        if (r < N0_FN) {
            float* cs = tl; float* sn = tl + 256;
            if (tid < 256) { double s, c; sincos2pi(tid / 256.0, s, c); cs[tid] = (float)c; sn[tid] = (float)s; }
            __syncthreads();
            const int idx = r * 512 + tid, n = idx >> 10, k = idx & 1023, g = k >> 8, c = k & 255;
            const float* W = p.w_fnet + (size_t)(g * 256) * 1024 + n;
            float ac = 0.f, as = 0.f;
            for (int c2 = 0; c2 < 256; ++c2) { const float w = W[(size_t)c2 * 1024]; const int j = (c * c2) & 255; ac = fmaf(cs[j], w, ac); as = fmaf(sn[j], w, as); }
            u16* F = (u16*)(p.ws + OFF_FNT);
            F[(size_t)n * 1024 + k] = f2bf(ac * (1.f / 2048.f));
            F[(size_t)(1024 + n) * 1024 + k] = f2bf(-as * (1.f / 2048.f));
            __syncthreads();
            continue;
        }
        r -= N0_FN;
        if (r < N0_MOD) {
            float* sv = tl;
            float* part = tl + 3072;
            for (int i = tid; i < 3072; i += NTHR) { const int v = i >> 10, k = i & 1023; const float xv = v < 2 ? p.c[v * 1024 + k] : p.c_ctx[k]; sv[i] = siluf_(xv); }
            __syncthreads();
            const int j0 = r * 64, L = j0 / 6144, col0 = j0 % 6144, kg = tid >> 6, cl = tid & 63;
            const float* W = p.ada_w + (size_t)L * 1024 * 6144 + col0 + cl;
            float a0 = 0.f, a1 = 0.f, a2 = 0.f;
            for (int k = kg * 128; k < kg * 128 + 128; ++k) { const float w = W[(size_t)k * 6144]; a0 = fmaf(sv[k], w, a0); a1 = fmaf(sv[1024 + k], w, a1); a2 = fmaf(sv[2048 + k], w, a2); }
            part[(kg * 3 + 0) * 64 + cl] = a0; part[(kg * 3 + 1) * 64 + cl] = a1; part[(kg * 3 + 2) * 64 + cl] = a2;
            __syncthreads();
            if (tid < 192) {
                const int v = tid >> 6, c2 = tid & 63; float s = 0.f;
                for (int g = 0; g < 8; ++g) s += part[(g * 3 + v) * 64 + c2];
                ((float*)(p.ws + OFF_MOD))[(size_t)(L * 3 + v) * 6144 + col0 + c2] = s + p.ada_b[L * 6144 + col0 + c2];
            }
            __syncthreads();
            continue;
        }
        r -= N0_MOD;
        {
            const int e = r * 512 + tid;
            if (e < 4096 + 1024) {
                const bool isr = e < 4096; const int ee = isr ? e : e - 4096; const int pos = ee >> 4, j = ee & 15;
                double inv = 1.0; for (int q = 0; q < j; ++q) inv *= 0.56234132519034908;
                const float invf = (float)inv; const float ang = (float)pos * invf;
                double s, c; sincos2pi((double)ang * 0.15915494309189533577, s, c);
                float2 v = make_float2((float)c, (float)s);
                if (isr) ((float2*)(p.ws + OFF_ROPER))[ee] = v; else ((float2*)(p.ws + OFF_ROPEC))[ee] = v;
            } else if (e < 5120 + 16384) {
                const int m = e - 5120; double s, c; sincos2pi(m / 16384.0, s, c);
                ((float2*)(p.ws + OFF_TW))[m] = make_float2((float)c, (float)s);
            } else if (e < 5120 + 32768) {
                const int m = e - 5120 - 16384, k = m >> 7, t = m & 127; double s, c; sincos2pi(((k * t) & 127) / 128.0, s, c);
                ((u16*)(p.ws + OFF_DFTC))[m] = f2bf((float)c); ((u16*)(p.ws + OFF_DFTS))[m] = f2bf((float)s);
            } else if (e < 5120 + 49152) {
                const int m = e - 5120 - 32768, k = m >> 4, g = m & 15;
                ((float*)(p.ws + OFF_WG16))[m] = p.w_in[(size_t)k * 3600 + 3584 + g];
            } else if (e == 5120 + 49152) {
                float s01 = 0.f, s23 = 0.f;
                for (int i = 0; i < 64; ++i) { s01 += p.lamv[i] * p.lamv[64 + i]; s23 += p.lamv[128 + i] * p.lamv[192 + i]; }
                ((float*)(p.ws + OFF_LAM))[0] = expf(s01) - expf(s23) + 0.2f;
            }
        }
    }
}

template <int MODE, bool DRY = false>
DEVI void phase_norm(const P& p, char* lds) {
    constexpr int layer = (MODE == 0 || MODE == 1) ? 0 : 1;
    constexpr bool side = (MODE == 0 || MODE == 1 || MODE == 3);
    const int nrows = layer == 0 ? NTOK : NLAT;
    const int tid = threadIdx.x, lane = tid & 63, wid = tid >> 6;
    f32x4* sl = (f32x4*)lds;
    if (side) {
        const float* S = (MODE == 0) ? (const float*)(p.ws + OFF_WG16) : p.router_w;
        for (int i = tid; i < 4096; i += NTHR) { const int eg = i >> 10, col = i & 1023; sl[i] = *reinterpret_cast<const f32x4*>(S + col * 16 + eg * 4); }
        __syncthreads();
    }
    const float* g = MODE == 0 ? p.nmix_g : MODE == 1 ? p.nffn_g : MODE == 2 ? p.nmix_g + 1024 : MODE == 3 ? p.nffn_g + 1024 : p.final_g;
    const float* modb = (const float*)(p.ws + OFF_MOD) + (size_t)layer * 3 * 6144;
    constexpr int sh_i = (MODE == 0 || MODE == 2) ? 0 : 3;
    u16* act = (u16*)(p.ws + OFF_ACT);
    int npend = 0, pcls = 0, prow = 0; float pwl = 0.f, pwh = 0.f;
    for (int row = blockIdx.x * 8 + wid; row < nrows; row += gridDim.x * 8) {
        const float* src = (MODE == 0) ? xin_ptr(p, row) : xs_ptr(p, layer, row);
        float xv[16]; float ss = 0.f;
#pragma unroll
        for (int m = 0; m < 16; ++m) { xv[m] = src[lane + 64 * m]; ss = fmaf(xv[m], xv[m], ss); }
        ss = wave_sum(ss);
        const float rstd = rsqrtf(ss * (1.f / 1024.f) + 1e-6f);
        if (MODE == 4) {
            float* dst = p.out + (size_t)row * DM;
#pragma unroll
            for (int m = 0; m < 16; ++m) dst[lane + 64 * m] = xv[m] * rstd * g[lane + 64 * m];
            continue;
        }
        const float* mv = modb + (size_t)modsel(layer, row) * 6144;
        float acc[16];
#pragma unroll
        for (int e = 0; e < 16; ++e) acc[e] = 0.f;
#pragma unroll
        for (int m = 0; m < 16; ++m) {
            const int col = lane + 64 * m;
            const float h = xv[m] * rstd * g[col] * (1.f + mv[(sh_i + 1) * 1024 + col]) + mv[sh_i * 1024 + col];
            act[(size_t)row * DM + col] = f2bf(h);
            if (side) {
                if ((m & 1) == 0) asm volatile("" ::: "memory");
#pragma unroll
                for (int eg = 0; eg < 4; ++eg) { const f32x4 w = sl[eg * 1024 + col]; acc[eg * 4 + 0] = fmaf(h, w[0], acc[eg * 4 + 0]); acc[eg * 4 + 1] = fmaf(h, w[1], acc[eg * 4 + 1]);
                    acc[eg * 4 + 2] = fmaf(h, w[2], acc[eg * 4 + 2]); acc[eg * 4 + 3] = fmaf(h, w[3], acc[eg * 4 + 3]); }
            }
        }
        if (side) {
#pragma unroll
            for (int e = 0; e < 16; ++e) acc[e] = wave_sum(acc[e]);
            if (MODE == 0) {
                float mine = 0.f;
#pragma unroll
                for (int e = 0; e < 16; ++e) mine = (lane == e) ? acc[e] : mine;
                if (lane < 16) {
                    float v = mine + p.gate_b[lane];
                    const int type = lane >> 2;
                    if (type == 1 || type == 3) v = logsigmoidf_(v);
                    ((float*)(p.ws + OFF_GATES))[(size_t)row * 16 + lane] = v;
                }
            } else {
                float aff[16], bi[16];
#pragma unroll
                for (int e = 0; e < 16; ++e) { aff[e] = sigmoidf_(acc[e]); bi[e] = aff[e] + p.router_b[e]; }
                int bg = 0, ba = 0, bb = 1; float bscore = -1e30f;
#pragma unroll
                for (int gq = 0; gq < 4; ++gq) {
                    int ia = 0; float va = bi[gq * 4];
#pragma unroll
                    for (int j = 1; j < 4; ++j) if (bi[gq * 4 + j] > va) { va = bi[gq * 4 + j]; ia = j; }
                    int ib = -1; float vb = -1e30f;
#pragma unroll
                    for (int j = 0; j < 4; ++j) if (j != ia && bi[gq * 4 + j] > vb) { vb = bi[gq * 4 + j]; ib = j; }
                    const float sc = va + vb;
                    if (sc > bscore) { bscore = sc; bg = gq; ba = ia; bb = ib; }
                }
                const int lo = ba < bb ? ba : bb, hi2 = ba < bb ? bb : ba;
                float alo = 0.f, ahi = 0.f;
#pragma unroll
                for (int e = 0; e < 16; ++e) { if (e == bg * 4 + lo) alo = aff[e]; if (e == bg * 4 + hi2) ahi = aff[e]; }
                const float inv = 1.f / (alo + ahi);
                const int pair = lo == 0 ? hi2 - 1 : (lo == 1 ? hi2 + 1 : 5);
                const int cls = bg * 6 + pair;
                if (lane == npend) { pcls = cls; prow = row; pwl = alo * inv; pwh = ahi * inv; }
                ++npend;
            }
        }
    }
    if (MODE == 1 || MODE == 3) {
        unsigned* lc = (unsigned*)(lds + 65536);
        __syncthreads();
        if (tid < 64) lc[tid] = 0u;
        __syncthreads();
        unsigned myrank = 0u;
        if (lane < npend) myrank = atomicAdd(&lc[pcls], 1u);
        __syncthreads();
        if (tid < 24) { unsigned* cnt = (unsigned*)(p.ws + OFF_CNT) + (DRY ? 2 : layer) * 32; const unsigned n = lc[tid]; lc[32 + tid] = n ? atomicAdd(&cnt[tid], n) : 0u; }
        __syncthreads();
        if (lane < npend) {
            ((int*)(p.ws + (DRY ? OFF_BIG : OFF_LIST)))[(size_t)pcls * NTOK + lc[32 + pcls] + myrank] = prow;
            ((float2*)(p.ws + (DRY ? OFF_BIG + (size_t)32 * NTOK * 4 : OFF_TOKW)))[prow] = make_float2(pwl, pwh);
        }
    }
}

using g8::f32x4v;
DEVI u32x4 pack8(const f32x4v& a, const f32x4v& b) { u32x4 w; w[0] = cvtpk(a[0], a[1]); w[1] = cvtpk(a[2], a[3]); w[2] = cvtpk(b[0], b[1]); w[3] = cvtpk(b[2], b[3]); return w; }

struct EpiInproj {
    static constexpr bool PERM = true;
    char* ws;
    DEVI void operator()(const f32x4v (&acc)[2][2][4][2], const g8::Unit& u, int wr, int wc, int fr, int fq) const {
        u16* dst; int ld, coff, kind;
        const int pn = u.pn;
        if (pn < 2)       { dst = (u16*)(ws + OFF_Q);    ld = 512;  coff = pn * 256;        kind = 1; }
        else if (pn < 4)  { dst = (u16*)(ws + OFF_K);    ld = 512;  coff = (pn - 2) * 256;  kind = 1; }
        else if (pn < 6)  { dst = (u16*)(ws + OFF_V);    ld = 512;  coff = (pn - 4) * 256;  kind = 0; }
        else if (pn < 10) { dst = (u16*)(ws + OFF_MLQK); ld = 1024; coff = (pn - 6) * 256;  kind = 0; }
        else if (pn < 12) { dst = (u16*)(ws + OFF_MLV);  ld = 512;  coff = (pn - 10) * 256; kind = 0; }
        else              { dst = (u16*)(ws + OFF_OG);   ld = 512;  coff = (pn - 12) * 256; kind = 2; }
        const int tb = u.pm % 65;
        const float2* tabR = (const float2*)(ws + OFF_ROPER); const float2* tabC = (const float2*)(ws + OFF_ROPEC);
#pragma unroll
        for (int ai = 0; ai < 2; ++ai)
#pragma unroll
            for (int m = 0; m < 4; ++m) {
                const int rl = ai * 128 + wr * 64 + m * 16 + fr;
                u16* rowp = dst + (size_t)(u.pm * 256 + rl) * ld + coff + wc * 32 + 8 * fq;
#pragma unroll
                for (int bj = 0; bj < 2; ++bj) {
                    f32x4v v0 = acc[ai][bj][m][0], v1 = acc[ai][bj][m][1];
                    if (kind == 1 && tb > 0) {
                        const int tl = (tb - 1) * 256 + rl;
                        const int p0 = ((wc * 32 + 8 * fq) & 63) >> 1;
                        const float* cs = (const float*)(p0 < 16 ? tabR + (tl >> 6) * 16 + p0 : tabC + (tl & 63) * 16 + (p0 - 16));
                        const f32x4v c01 = *reinterpret_cast<const f32x4v*>(cs), c23 = *reinterpret_cast<const f32x4v*>(cs + 4);
                        const f32x4v a = v0, b = v1;
                        v0[0] = a[0] * c01[0] - a[1] * c01[1]; v0[1] = a[0] * c01[1] + a[1] * c01[0];
                        v0[2] = a[2] * c01[2] - a[3] * c01[3]; v0[3] = a[2] * c01[3] + a[3] * c01[2];
                        v1[0] = b[0] * c23[0] - b[1] * c23[1]; v1[1] = b[0] * c23[1] + b[1] * c23[0];
                        v1[2] = b[2] * c23[2] - b[3] * c23[3]; v1[3] = b[2] * c23[3] + b[3] * c23[2];
                    } else if (kind == 2) {
#pragma unroll
                        for (int j = 0; j < 4; ++j) { v0[j] = sigmoidf_(v0[j]); v1[j] = sigmoidf_(v1[j]); }
                    }
                    *reinterpret_cast<u32x4*>(rowp + bj * 128) = pack8(v0, v1);
                }
            }
    }
};
DEVI void phase_inproj(const P& p, char* lds) {
    __syncthreads();
    g8::DenseSched S{p.ws + OFF_WINT, NTOK / 256, 14, (int)gridDim.x, (int)blockIdx.x, (size_t)256 * 2048};
    EpiInproj E{p.ws};
    g8::gemm_phase((LAS unsigned char*)lds, p.ws + OFF_ACT, 2048, 16, S, E);
}

struct EpiOutproj {
    static constexpr bool PERM = false;
    const float* xin_lat; const float* xin_ctx; float* xs_lat; float* xs_ctx; const float* modb;
    DEVI void operator()(const f32x4v (&acc)[2][2][4][2], const g8::Unit& u, int wr, int wc, int fr, int fq) const {
        const int b = u.pm / 65, tb = u.pm % 65;
        const float* xi = tb == 0 ? xin_ctx + (size_t)(b * TC) * DM : xin_lat + (size_t)(b * TL + (tb - 1) * 256) * DM;
        float* xo = tb == 0 ? xs_ctx + (size_t)(b * TC) * DM : xs_lat + (size_t)(b * TL + (tb - 1) * 256) * DM;
        const float* gate = modb + (size_t)(tb == 0 ? 2 : b) * 6144 + 2 * 1024;
        const int col0 = u.pn * 256 + wc * 32 + 4 * fq;
        f32x4v gv[2][2];
#pragma unroll
        for (int bj = 0; bj < 2; ++bj)
#pragma unroll
            for (int n = 0; n < 2; ++n) gv[bj][n] = *reinterpret_cast<const f32x4v*>(gate + col0 + bj * 128 + n * 16);
#pragma unroll
        for (int ai = 0; ai < 2; ++ai) {
            f32x4v xv[4][2][2];
#pragma unroll
            for (int m = 0; m < 4; ++m) { const size_t ro = (size_t)(ai * 128 + wr * 64 + m * 16 + fr) * DM + col0;
#pragma unroll
                for (int bj = 0; bj < 2; ++bj)
#pragma unroll
                    for (int n = 0; n < 2; ++n) xv[m][bj][n] = *reinterpret_cast<const f32x4v*>(xi + ro + bj * 128 + n * 16); }
#pragma unroll
            for (int m = 0; m < 4; ++m) { const size_t ro = (size_t)(ai * 128 + wr * 64 + m * 16 + fr) * DM + col0;
#pragma unroll
                for (int bj = 0; bj < 2; ++bj)
#pragma unroll
                    for (int n = 0; n < 2; ++n) *reinterpret_cast<f32x4v*>(xo + ro + bj * 128 + n * 16) = xv[m][bj][n] + gv[bj][n] * acc[ai][bj][m][n]; }
        }
    }
};
DEVI void phase_outproj(const P& p, char* lds) {
    __syncthreads();
    g8::DenseSched S{p.ws + OFF_WOUTT, NTOK / 256, 4, (int)gridDim.x, (int)blockIdx.x, (size_t)256 * 2048};
    EpiOutproj E{p.x, p.ctx, p.out, (float*)(p.ws + OFF_XC), (const float*)(p.ws + OFF_MOD)};
    g8::gemm_phase((LAS unsigned char*)lds, p.ws + OFF_ACT, 2048, 16, S, E);
}

DEVI int moe_table(const P& p, int layer, int* tb) {
    __syncthreads();
    if (threadIdx.x == 0) {
        const unsigned* cnt = (const unsigned*)(p.ws + OFF_CNT) + layer * 32; int o = 0;
        for (int c = 0; c < 24; ++c) { tb[c] = o; tb[32 + c] = (int)cnt[c]; o += ((int)cnt[c] + 255) >> 8; }
        tb[24] = o;
    }
    __syncthreads();
    return tb[24];
}
DEVI void cls_experts(int cls, int& elo, int& ehi) {
    const int g = cls / 6, pr = cls % 6;
    const int lo = pr < 3 ? 0 : (pr < 5 ? 1 : 2); const int hi = pr < 3 ? pr + 1 : (pr < 5 ? pr - 1 : 3);
    elo = g * 4 + lo; ehi = g * 4 + hi;
}
DEVI void moe_unit(const int* tb, int rt, g8::Unit& u) {
    int cls = 0; while (cls < 23 && tb[cls + 1] <= rt) ++cls;
    u.cls = cls; u.r0 = (rt - tb[cls]) * 256; u.ncls = tb[32 + cls];
}

struct MoeUpSched {
    static constexpr bool GATHER = true;
    const int* tb; int T, G, c; const int* list; const char* Wgu;
    DEVI bool next(int i, g8::Unit& u) const {
        if (!g8::tile_order(i, G, c, T, 8, u.pm, u.pn)) return false;
        moe_unit(tb, u.pm, u); int elo, ehi; cls_experts(u.cls, elo, ehi);
        const int e = u.pn < 4 ? elo : ehi;
        u.B0 = u.B1 = Wgu + ((size_t)e * 1024 + (size_t)(u.pn & 3) * 256) * 2048; return true;
    }
    DEVI void aoffs(const g8::Unit& u, unsigned (&v)[2][2]) const {
        const int* lst = list + (size_t)u.cls * NTOK + u.r0;
#pragma unroll
        for (int i = 0; i < 2; ++i) { int R, C; g8::lane_rc(i, R, C);
#pragma unroll
            for (int h = 0; h < 2; ++h) { const int rr = h * 128 + R; const int tok = lst[(u.r0 + rr < u.ncls) ? rr : 0]; v[h][i] = (unsigned)((tok * 1024 + C) * 2); } }
    }
};
struct EpiMoeUp {
    static constexpr bool PERM = true;
    const int* list; const float2* tokw; u16* HE;
    DEVI void operator()(const f32x4v (&acc)[2][2][4][2], const g8::Unit& u, int wr, int wc, int fr, int fq) const {
        const int* lst = list + (size_t)u.cls * NTOK + u.r0;
        const int s = u.pn >> 2;
        float wv[2][4];
        { int tk[2][4];
#pragma unroll
          for (int ai = 0; ai < 2; ++ai)
#pragma unroll
              for (int m = 0; m < 4; ++m) { const int rl = ai * 128 + wr * 64 + m * 16 + fr; tk[ai][m] = lst[(u.r0 + rl < u.ncls) ? rl : 0]; }
#pragma unroll
          for (int ai = 0; ai < 2; ++ai)
#pragma unroll
              for (int m = 0; m < 4; ++m) { const float2 w2 = tokw[tk[ai][m]]; wv[ai][m] = s ? w2.y : w2.x; } }
#pragma unroll
        for (int ai = 0; ai < 2; ++ai)
#pragma unroll
            for (int m = 0; m < 4; ++m) {
                const int rl = ai * 128 + wr * 64 + m * 16 + fr;
                if (u.r0 + rl < u.ncls) {
                    const float w = wv[ai][m];
                    u16* rowp = HE + (size_t)(u.pm * 256 + rl) * 1024 + s * 512 + (u.pn & 3) * 128 + wc * 16 + 4 * fq;
#pragma unroll
                    for (int bj = 0; bj < 2; ++bj) {
                        const f32x4v g = acc[ai][bj][m][0], up = acc[ai][bj][m][1];
                        u32x2 o; o[0] = cvtpk(siluf_(g[0]) * up[0] * w, siluf_(g[1]) * up[1] * w); o[1] = cvtpk(siluf_(g[2]) * up[2] * w, siluf_(g[3]) * up[3] * w);
                        *reinterpret_cast<u32x2*>(rowp + bj * 64) = o;
                    }
                }
            }
    }
};
DEVI void phase_moe_up(const P& p, int layer, char* lds) {
    int* tb = (int*)(lds + g8::STAGE_BYTES);
    const int T = moe_table(p, layer, tb);
    MoeUpSched S{tb, T, (int)gridDim.x, (int)blockIdx.x, (const int*)(p.ws + OFF_LIST), p.ws + OFF_WGU};
    EpiMoeUp E{(const int*)(p.ws + OFF_LIST), (const float2*)(p.ws + OFF_TOKW), (u16*)(p.ws + OFF_HE)};
    g8::gemm_phase((LAS unsigned char*)lds, p.ws + OFF_ACT, 2048, 16, S, E);
}

struct MoeDownSched {
    static constexpr bool GATHER = false;
    const int* tb; int T, G, c; const char* WdT;
    DEVI bool next(int i, g8::Unit& u) const {
        if (!g8::tile_order(i, G, c, T, 4, u.pm, u.pn)) return false;
        moe_unit(tb, u.pm, u); int elo, ehi; cls_experts(u.cls, elo, ehi);
        u.B0 = WdT + ((size_t)elo * 1024 + (size_t)u.pn * 256) * 1024;
        u.B1 = WdT + ((size_t)ehi * 1024 + (size_t)u.pn * 256) * 1024 - (size_t)8 * 128; return true;
    }
    DEVI void aoffs(const g8::Unit& u, unsigned (&v)[2][2]) const {
#pragma unroll
        for (int i = 0; i < 2; ++i) { int R, C; g8::lane_rc(i, R, C);
#pragma unroll
            for (int h = 0; h < 2; ++h) v[h][i] = (unsigned)(((u.pm * 256 + h * 128 + R) * 1024 + C) * 2); }
    }
};
template <bool DRY>
struct EpiMoeDown {
    static constexpr bool PERM = false;
    const P* pp; int layer; const int* list; const float* modb;
    DEVI void operator()(const f32x4v (&acc)[2][2][4][2], const g8::Unit& u, int wr, int wc, int fr, int fq) const {
        const P& p = *pp;
        const int* lst = list + (size_t)u.cls * NTOK + u.r0;
        const int col0 = u.pn * 256 + wc * 32 + 4 * fq;
        int tk[2][4];
#pragma unroll
        for (int ai = 0; ai < 2; ++ai)
#pragma unroll
            for (int m = 0; m < 4; ++m) { const int rl = ai * 128 + wr * 64 + m * 16 + fr; tk[ai][m] = (u.r0 + rl < u.ncls) ? lst[rl] : -1; }
#pragma unroll
        for (int ai = 0; ai < 2; ++ai)
#pragma unroll
        for (int mh = 0; mh < 2; ++mh) {
            f32x4v xv[2][2][2], gv[2][2][2];
#pragma unroll
            for (int mm = 0; mm < 2; ++mm) { const int m = mh * 2 + mm; const int tok = tk[ai][m] < 0 ? lst[0] : tk[ai][m];
                const float* gate = modb + (size_t)modsel(layer, tok) * 6144 + 5 * 1024 + col0; const float* xo = xs_ptr(p, layer, tok) + col0;
#pragma unroll
                for (int bj = 0; bj < 2; ++bj)
#pragma unroll
                    for (int n = 0; n < 2; ++n) { gv[mm][bj][n] = *reinterpret_cast<const f32x4v*>(gate + bj * 128 + n * 16); xv[mm][bj][n] = *reinterpret_cast<const f32x4v*>(xo + bj * 128 + n * 16); } }
#pragma unroll
            for (int mm = 0; mm < 2; ++mm) { const int m = mh * 2 + mm; if (tk[ai][m] >= 0) { const int tok = tk[ai][m];
                float* xd = DRY ? (float*)(p.ws + OFF_MLQK) + (size_t)(tok & 8191) * 1024 + col0 : xs_ptr(p, layer, tok) + col0;
#pragma unroll
                for (int bj = 0; bj < 2; ++bj)
#pragma unroll
                    for (int n = 0; n < 2; ++n) *reinterpret_cast<f32x4v*>(xd + bj * 128 + n * 16) = xv[mm][bj][n] + gv[mm][bj][n] * acc[ai][bj][m][n]; } }
        }
    }
};
template <bool DRY = false>
DEVI void phase_moe_down(const P& p, int layer, char* lds) {
    int* tb = (int*)(lds + g8::STAGE_BYTES);
    const int T = moe_table(p, layer, tb);
    MoeDownSched S{tb, T, (int)gridDim.x, (int)blockIdx.x, p.ws + OFF_WDT};
    EpiMoeDown<DRY> E{&p, layer, (const int*)(p.ws + OFF_LIST), (const float*)(p.ws + OFF_MOD) + (size_t)layer * 3 * 6144};
    g8::gemm_phase((LAS unsigned char*)lds, p.ws + OFF_HE, 1024, 8, S, E);
}

struct EpiFnet {
    static constexpr bool PERM = true;
    char* ws;
    DEVI void operator()(const f32x4v (&acc)[2][2][4][2], const g8::Unit& u, int wr, int wc, int fr, int fq) const {
        u16* dst = (u16*)(ws + (u.pn < 4 ? OFF_ZR : OFF_ZI)) + (u.pn & 3) * 256 + wc * 32 + 8 * fq;
#pragma unroll
        for (int ai = 0; ai < 2; ++ai)
#pragma unroll
            for (int m = 0; m < 4; ++m) {
                u16* rowp = dst + (size_t)(u.pm * 256 + ai * 128 + wr * 64 + m * 16 + fr) * 1024;
#pragma unroll
                for (int bj = 0; bj < 2; ++bj) *reinterpret_cast<u32x4*>(rowp + bj * 128) = pack8(acc[ai][bj][m][0], acc[ai][bj][m][1]);
            }
    }
};
DEVI void phase_fnet_gemm(const P& p, char* lds) {
    __syncthreads();
    g8::DenseSched S{p.ws + OFF_FNT, NLAT / 256, 8, (int)gridDim.x, (int)blockIdx.x, (size_t)256 * 2048};
    EpiFnet E{p.ws};
    g8::gemm_phase((LAS unsigned char*)lds, p.ws + OFF_ACT, 2048, 16, S, E);
}

template <class RP>
DEVI void stage_tr128(RP rp, char* img) {
    const int tid = threadIdx.x;
#pragma unroll
    for (int i = 0; i < 4; ++i) {
        const int idx = tid + 512 * i, k = idx >> 4, c = (idx & 15) * 8;
        const u32x4 v = *reinterpret_cast<const u32x4*>(rp(k) + c);
        *reinterpret_cast<u32x4*>(img + (k >> 6) * 16384 + v_st(k & 63, c)) = v;
    }
}
DEVI void load_dft(const P& p, char* lds) {
    const int tid = threadIdx.x;
    for (int i = tid; i < 4096; i += NTHR) {
        const int m = i >> 11, j = i & 2047, row = j >> 4, ch = j & 15;
        const u32x4 v = *reinterpret_cast<const u32x4*>((const u16*)(p.ws + (m ? OFF_DFTS : OFF_DFTC)) + row * 128 + ch * 8);
        *reinterpret_cast<u32x4*>(lds + m * 34816 + swz256(row, ch)) = v;
    }
}
DEVI bf16x8 negbf(bf16x8 v) { u32x4 w = *reinterpret_cast<u32x4*>(&v); w[0] ^= 0x80008000u; w[1] ^= 0x80008000u; w[2] ^= 0x80008000u; w[3] ^= 0x80008000u; return *reinterpret_cast<bf16x8*>(&w); }

template <int KS, int WN, int MODE>
DEVI void fft_kstep(int vbr, int vbi, const bf16x8& aC, const bf16x8& aS, f32x16 (&yr)[2], f32x16 (&yi)[2]) {
    s16x4 rl0, rh0, rl1, rh1, il0, ih0, il1, ih1;
    tr_frag_issue<2 * WN, KS>(vbr, rl0, rh0); tr_frag_issue<2 * WN + 1, KS>(vbr, rl1, rh1);
    tr_frag_issue<2 * WN, KS>(vbi, il0, ih0); tr_frag_issue<2 * WN + 1, KS>(vbi, il1, ih1);
    LGKM0();
    const bf16x8 xr0 = PKLH(rl0, rh0), xr1 = PKLH(rl1, rh1), xi0 = PKLH(il0, ih0), xi1 = PKLH(il1, ih1);
    yr[0] = __builtin_amdgcn_mfma_f32_32x32x16_bf16(aC, xr0, yr[0], 0, 0, 0);
    yr[1] = __builtin_amdgcn_mfma_f32_32x32x16_bf16(aC, xr1, yr[1], 0, 0, 0);
    yr[0] = __builtin_amdgcn_mfma_f32_32x32x16_bf16(aS, xi0, yr[0], 0, 0, 0);
    yr[1] = __builtin_amdgcn_mfma_f32_32x32x16_bf16(aS, xi1, yr[1], 0, 0, 0);
    if (MODE == 0) {
        yi[0] = __builtin_amdgcn_mfma_f32_32x32x16_bf16(aC, xi0, yi[0], 0, 0, 0);
        yi[1] = __builtin_amdgcn_mfma_f32_32x32x16_bf16(aC, xi1, yi[1], 0, 0, 0);
        yi[0] = __builtin_amdgcn_mfma_f32_32x32x16_bf16(aS, negbf(xr0), yi[0], 0, 0, 0);
        yi[1] = __builtin_amdgcn_mfma_f32_32x32x16_bf16(aS, negbf(xr1), yi[1], 0, 0, 0);
    }
}
template <int WN, int MODE>
DEVI void fft_core(const char* lds, int xr_img, int xi_img, int wm, int lane, f32x16 (&yr)[2], f32x16 (&yi)[2]) {
    const int r32 = lane & 31, hi = lane >> 5;
    const char* Cm = lds; const char* Sm = lds + 34816;
    const int row = wm * 32 + r32;
    const int vb0 = xr_img + v_rd_base(lane), vb1 = xi_img + v_rd_base(lane);
#define KSTEP(H, KS) do { const int kk = (H) * 4 + (KS); \
        const bf16x8 aC = lds_b128(Cm, swz256(row, 2 * kk + hi)), aS = lds_b128(Sm, swz256(row, 2 * kk + hi)); \
        fft_kstep<KS, WN, MODE>(vb0 + (H) * 16384, vb1 + (H) * 16384, aC, aS, yr, yi); } while (0)
    KSTEP(0, 0); KSTEP(0, 1); KSTEP(0, 2); KSTEP(0, 3); KSTEP(1, 0); KSTEP(1, 1); KSTEP(1, 2); KSTEP(1, 3);
#undef KSTEP
}

DEVI void phase_fft1(const P& p, char* lds) {
    const int tid = threadIdx.x, lane = tid & 63, wid = __builtin_amdgcn_readfirstlane(tid >> 6), wm = wid >> 1, wn = wid & 1, r32 = lane & 31, hi = lane >> 5;
    load_dft(p, lds);
    char* imgR = lds + 69632; char* imgI = lds + 102400;
    const u16* Zr = (const u16*)(p.ws + OFF_ZR); const u16* Zi = (const u16*)(p.ws + OFF_ZI);
    u16* Yr = (u16*)(p.ws + OFF_YR); u16* Yi = (u16*)(p.ws + OFF_YI);
    const float2* TW = (const float2*)(p.ws + OFF_TW);
    for (int u = blockIdx.x; u < NB * 128 * 8; u += gridDim.x) {
        const int cb = u & 7, t2 = (u >> 3) & 127, b = u >> 10;
        __syncthreads();
        stage_tr128([&](int k) { return Zr + (size_t)(b * TL + 128 * k + t2) * 1024 + cb * 128; }, imgR);
        stage_tr128([&](int k) { return Zi + (size_t)(b * TL + 128 * k + t2) * 1024 + cb * 128; }, imgI);
        __syncthreads();
        f32x16 yr[2] = {}, yi[2] = {};
        const int xr_img = (int)(uintptr_t)imgR, xi_img = (int)(uintptr_t)imgI;
        if (wn == 0) fft_core<0, 0>(lds, xr_img, xi_img, wm, lane, yr, yi); else fft_core<1, 0>(lds, xr_img, xi_img, wm, lane, yr, yi);
#pragma unroll
        for (int r = 0; r < 16; ++r) {
            const int k1 = wm * 32 + crow(r, hi);
            const float2 w = TW[t2 * k1];
            const size_t o = ((size_t)(b * 128 + k1) * 128 + t2) * 1024 + cb * 128 + wn * 64 + r32;
#pragma unroll
            for (int ni = 0; ni < 2; ++ni) {
                const float a = yr[ni][r], bq = yi[ni][r];
                Yr[o + ni * 32] = f2bf(a * w.x + bq * w.y);
                Yi[o + ni * 32] = f2bf(bq * w.x - a * w.y);
            }
        }
    }
}
template <bool DRY = false>
DEVI void phase_fft2(const P& p, char* lds) {
    const int tid = threadIdx.x, lane = tid & 63, wid = __builtin_amdgcn_readfirstlane(tid >> 6), wm = wid >> 1, wn = wid & 1, r32 = lane & 31, hi = lane >> 5;
    load_dft(p, lds);
    char* imgR = lds + 69632; char* imgI = lds + 102400;
    const u16* Yr = (const u16*)(p.ws + OFF_YR); const u16* Yi = (const u16*)(p.ws + OFF_YI);
    const float* modb = (const float*)(p.ws + OFF_MOD) + (size_t)3 * 6144;
    for (int u = blockIdx.x; u < NB * 128 * 8; u += gridDim.x) {
        const int cb = u & 7, k1 = (u >> 3) & 127, b = u >> 10;
        __syncthreads();
        stage_tr128([&](int k) { return Yr + ((size_t)(b * 128 + k1) * 128 + k) * 1024 + cb * 128; }, imgR);
        stage_tr128([&](int k) { return Yi + ((size_t)(b * 128 + k1) * 128 + k) * 1024 + cb * 128; }, imgI);
        __syncthreads();
        f32x16 yr[2] = {}, yi[2] = {};
        const int xr_img = (int)(uintptr_t)imgR, xi_img = (int)(uintptr_t)imgI;
        if (wn == 0) fft_core<0, 1>(lds, xr_img, xi_img, wm, lane, yr, yi); else fft_core<1, 1>(lds, xr_img, xi_img, wm, lane, yr, yi);
        const float* gate = modb + (size_t)b * 6144 + 2 * 1024 + cb * 128 + wn * 64 + r32;
        const float g0 = gate[0], g1 = gate[32];
#pragma unroll
        for (int r = 0; r < 16; ++r) {
            const int k2 = wm * 32 + crow(r, hi);
            float* xo = p.out + (size_t)(b * TL + k1 + 128 * k2) * 1024 + cb * 128 + wn * 64 + r32;
            if (DRY) { float* xd = (float*)(p.ws + OFF_ZR) + (size_t)(b * TL + k1 + 128 * k2) * 1024 + cb * 128 + wn * 64 + r32; xd[0] = xo[0] + g0 * yr[0][r]; xd[32] = xo[32] + g1 * yr[1][r]; }
            else { xo[0] += g0 * yr[0][r]; xo[32] += g1 * yr[1][r]; }
        }
    }
}

constexpr int AT_V = 16384, AT_K = 17408;
template <int HF, int DB>
DEVI void attn_half(const char* Ks, const bf16x8 (&qr)[8], float& m_reg, float& l_reg, f32x16 (&o)[4], int vb, float* al, int r32, int hi) {
    constexpr float SC = 0.125f, C = SC * 1.4426950408889634f, THR = 8.f;
    f32x16 pp = {};
#pragma unroll
    for (int d0 = 0; d0 < 4; ++d0) pp = __builtin_amdgcn_mfma_f32_32x32x16_bf16(lds_b128(Ks, swz256(HF * 32 + r32, 2 * (DB + d0) + hi)), qr[DB + d0], pp, 0, 0, 0);
    float pmax = pp[0];
#pragma unroll
    for (int r = 1; r < 16; ++r) pmax = fmaxf(pmax, pp[r]);
    { auto rr = __builtin_amdgcn_permlane32_swap(__float_as_uint(pmax), __float_as_uint(pmax), false, false);
      pmax = fmaxf(__uint_as_float(rr[0]), __uint_as_float(rr[1])); }
    float alpha = 1.f;
    if (!__all(pmax - m_reg <= THR / SC)) {
        const float mn = fmaxf(m_reg, pmax); alpha = __builtin_amdgcn_exp2f((m_reg - mn) * C); m_reg = mn;
        if (hi == 0) al[r32] = alpha;
        asm volatile("s_waitcnt lgkmcnt(0)" ::: "memory");
#pragma unroll
        for (int d = 0; d < 4; ++d)
#pragma unroll
            for (int r = 0; r < 16; ++r) o[d][r] *= al[crow(r, hi)];
    }
    const float mnC = -m_reg * C;
    float ps = 0.f;
#pragma unroll
    for (int r = 0; r < 16; ++r) { pp[r] = __builtin_amdgcn_exp2f(fmaf(pp[r], C, mnC)); ps += pp[r]; }
    { auto rr = __builtin_amdgcn_permlane32_swap(__float_as_uint(ps), __float_as_uint(ps), false, false);
      ps = __uint_as_float(rr[0]) + __uint_as_float(rr[1]); }
    l_reg = l_reg * alpha + ps;
    bf16x8 pa0, pa1;
    pack_p(pp, pa0, pa1);
#define PVD(D0) do { s16x4 l0, h0, l1, h1; tr_frag_issue<D0, 2 * HF>(vb, l0, h0); tr_frag_issue<D0, 2 * HF + 1>(vb, l1, h1); LGKM0(); \
        o[D0] = __builtin_amdgcn_mfma_f32_32x32x16_bf16(pa0, PKLH(l0, h0), o[D0], 0, 0, 0); \
        o[D0] = __builtin_amdgcn_mfma_f32_32x32x16_bf16(pa1, PKLH(l1, h1), o[D0], 0, 0, 0); } while (0)
    PVD(0); PVD(1); PVD(2); PVD(3);
#undef PVD
}

DEVI void diffattn_item(const P& p, int q0, int k0row, int seq, int h, char* lds) {
    int tid = threadIdx.x; asm volatile("" : "+v"(tid));
    const int wid = tid >> 6, lane = tid & 63, r32 = lane & 31, hi = lane >> 5;
    const u16* Q = (const u16*)(p.ws + OFF_Q); const u16* Kg = (const u16*)(p.ws + OFF_K) + (size_t)k0row * 512 + h * 128;
    const u16* Vg = (const u16*)(p.ws + OFF_V) + (size_t)k0row * 512 + h * 128;
    char* V_lds = lds; char* K_lds = lds + 2 * AT_V;
    float* al = (float*)(lds + 2 * AT_V + 2 * AT_K) + wid * 64;
    bf16x8 qr[8];
    { const u16* Qw = Q + (size_t)(q0 + wid * 32 + r32) * 512 + h * 128 + hi * 8;
#pragma unroll
      for (int d0 = 0; d0 < 8; ++d0) qr[d0] = *reinterpret_cast<const bf16x8*>(Qw + d0 * 16); }
    const int sr = tid >> 4, sc = (tid & 15) * 8;
    const int vb0 = (int)(uintptr_t)V_lds + v_rd_base(lane);
    const int vc = ((tid >> 5) & 3) * 32 + (tid & 3) * 8;
    const int kk0 = (tid >> 7) * 8 + ((tid & 31) >> 2), kk1 = kk0 + 32;
    const int vk0 = (kk0 & ~0xC) | ((kk0 & 4) << 1) | ((kk0 & 8) >> 1), vk1 = (kk1 & ~0xC) | ((kk1 & 4) << 1) | ((kk1 & 8) >> 1);
    u32x4 sk0, sk1;
#define SLOAD(kk, b) do { \
    __builtin_amdgcn_global_load_lds((const unsigned*)(Vg + (size_t)((kk) + vk0) * 512 + vc), (LAS unsigned*)(V_lds + (b) * AT_V + tid * 16), 16, 0, 0); \
    __builtin_amdgcn_global_load_lds((const unsigned*)(Vg + (size_t)((kk) + vk1) * 512 + vc), (LAS unsigned*)(V_lds + (b) * AT_V + 8192 + tid * 16), 16, 0, 0); \
    sk0 = *reinterpret_cast<const u32x4*>(Kg + (size_t)((kk) + sr) * 512 + sc); sk1 = *reinterpret_cast<const u32x4*>(Kg + (size_t)((kk) + 32 + sr) * 512 + sc); } while (0)
#define SWRITE(b) do { *reinterpret_cast<u32x4*>(K_lds + (b) * AT_K + swz256(sr, tid & 15)) = sk0; *reinterpret_cast<u32x4*>(K_lds + (b) * AT_K + swz256(32 + sr, tid & 15)) = sk1; } while (0)
    float m0 = -1e30f, m1 = -1e30f, l0 = 0.f, l1 = 0.f;
    f32x16 o0[4] = {}, o1[4] = {};
    const int NT = seq / 64;
    __syncthreads();
    SLOAD(0, 0); SWRITE(0); asm volatile("s_waitcnt vmcnt(0)" ::: "memory"); __syncthreads();
    if (NT > 1) SLOAD(64, 1);
    for (int j = 0; j < NT; ++j) {
        const int cur = j & 1;
        const char* Ks = K_lds + cur * AT_K;
        attn_half<0, 0>(Ks, qr, m0, l0, o0, vb0 + cur * AT_V, al, r32, hi);
        attn_half<1, 0>(Ks, qr, m0, l0, o0, vb0 + cur * AT_V, al, r32, hi);
        attn_half<0, 4>(Ks, qr, m1, l1, o1, vb0 + cur * AT_V, al, r32, hi);
        attn_half<1, 4>(Ks, qr, m1, l1, o1, vb0 + cur * AT_V, al, r32, hi);
        if (j + 1 < NT) SWRITE(cur ^ 1);
        asm volatile("s_waitcnt vmcnt(0)" ::: "memory");
        __syncthreads();
        if (j + 2 < NT) SLOAD((j + 2) * 64, cur);
    }
#undef SLOAD
#undef SWRITE
    int tz = threadIdx.x; asm volatile("" : "+v"(tz));
    const int wid2 = tz >> 6, lane2 = tz & 63, r32e = lane2 & 31, hie = lane2 >> 5;
    const float lam = ((const float*)(p.ws + OFF_LAM))[0];
    float* sc0 = (float*)(lds + 2 * AT_V + 2 * AT_K) + wid2 * 64; float* sc1 = sc0 + 32;
    if (hie == 0) { sc0[r32e] = 1.f / l0; sc1[r32e] = -lam / l1; }
    asm volatile("s_waitcnt lgkmcnt(0)" ::: "memory");
    float ssq[16];
#pragma unroll
    for (int r = 0; r < 16; ++r) {
        const float a = sc0[crow(r, hie)], b = sc1[crow(r, hie)]; float s = 0.f;
#pragma unroll
        for (int d = 0; d < 4; ++d) { const float v = o0[d][r] * a + o1[d][r] * b; o0[d][r] = v; s = fmaf(v, v, s); }
        ssq[r] = s;
    }
#pragma unroll
    for (int r = 0; r < 16; ++r) { float s = ssq[r]; for (int o = 16; o; o >>= 1) s += __shfl_xor(s, o); ssq[r] = rsqrtf(s * (1.f / 128.f) + 1e-6f) * 0.8f; }
    u16* mix = (u16*)(p.ws + OFF_ACT);
    const float* sg = p.subln_g;
#pragma unroll
    for (int d = 0; d < 4; ++d) {
        const float gv = sg[d * 32 + r32e];
#pragma unroll
        for (int r = 0; r < 16; ++r) mix[(size_t)(q0 + wid2 * 32 + crow(r, hie)) * 1024 + h * 128 + d * 32 + r32e] = f2bf(o0[d][r] * ssq[r] * gv);
    }
}

DEVI void chunk_scan(const float* gates, int row0, int head, int dir, float* Bq, float* av, float* pm, float& total, float& amax) {
    const int lane = threadIdx.x & 63;
    const int e0 = dir ? 127 - 2 * lane : 2 * lane, e1 = dir ? 126 - 2 * lane : 2 * lane + 1;
    const float lf0 = gates[(size_t)(row0 + e0) * 16 + (dir ? 12 : 4) + head], lf1 = gates[(size_t)(row0 + e1) * 16 + (dir ? 12 : 4) + head];
    const float li0 = gates[(size_t)(row0 + e0) * 16 + (dir ? 8 : 0) + head],  li1 = gates[(size_t)(row0 + e1) * 16 + (dir ? 8 : 0) + head];
    const float s1 = lf0 + lf1; float inc = s1;
#pragma unroll
    for (int o = 1; o < 64; o <<= 1) { const float t = __shfl_up(inc, o); if (lane >= o) inc += t; }
    const float exc = inc - s1;
    const float B0 = exc + lf0, B1 = exc + s1;
    const float a0 = li0 - B0, a1 = li1 - B1;
    const float m1 = fmaxf(a0, a1); float mx = m1;
#pragma unroll
    for (int o = 1; o < 64; o <<= 1) { const float t = __shfl_up(mx, o); if (lane >= o) mx = fmaxf(mx, t); }
    float mprev = __shfl_up(mx, 1); if (lane == 0) mprev = -1e30f;
    Bq[e0] = B0; Bq[e1] = B1; av[e0] = a0; av[e1] = a1; pm[e0] = fmaxf(mprev, a0); pm[e1] = mx;
    total = __shfl(inc, 63); amax = __shfl(mx, 63);
}

DEVI void conv_silu8(const u32x4& xm, const u32x4& x0, const u32x4& xp, const float* wc, bool hasm, bool hasp, float (&out)[8]) {
#pragma unroll
    for (int j = 0; j < 4; ++j) {
        const float w00 = wc[2 * j], w01 = wc[2 * j + 1], w10 = wc[1024 + 2 * j], w11 = wc[1024 + 2 * j + 1], w20 = wc[2048 + 2 * j], w21 = wc[2048 + 2 * j + 1];
        float a = w10 * bflo(x0[j]), b = w11 * bfhi(x0[j]);
        if (hasm) { a = fmaf(w00, bflo(xm[j]), a); b = fmaf(w01, bfhi(xm[j]), b); }
        if (hasp) { a = fmaf(w20, bflo(xp[j]), a); b = fmaf(w21, bfhi(xp[j]), b); }
        out[2 * j] = siluf_(a); out[2 * j + 1] = siluf_(b);
    }
}
DEVI void seg_edges(int t  , bool& hasm, bool& hasp) {
    hasm = !(t == 0 || t == TC); hasp = !(t == TC - 1 || t == TT - 1);
}
DEVI int chain_slot(int dir, int b, int h, int cc) { return ((dir * 2 + b) * 4 + h) * NCH + cc; }

DEVI void phase_mlstm_a(const P& p, char* lds) {
    const int tid = threadIdx.x, wid = __builtin_amdgcn_readfirstlane(tid >> 6), lane = tid & 63, r32 = lane & 31, hi = lane >> 5;
    char* Vimg = lds; char* Kf = lds + 32768; char* Kb = lds + 65536;
    float* arr = (float*)(lds + 98304);
    const float* gates = (const float*)(p.ws + OFF_GATES);
    const u16* MLQK = (const u16*)(p.ws + OFF_MLQK); const u16* MLV = (const u16*)(p.ws + OFF_MLV);
    u16* CST = (u16*)(p.ws + OFF_CST); float* NST = (float*)(p.ws + OFF_NST);
    float2* scal = (float2*)(p.ws + OFF_MSCAL);
    for (int it = blockIdx.x; it < NB * 4 * NCH; it += gridDim.x) {
        const int cc = it % NCH, h = (it / NCH) & 3, b = it / (NCH * 4);
        const int row0 = b * TT + cc * 128;
        __syncthreads();
        if (wid < 2) {
            float total, amax; float* a4 = arr + wid * 512;
            chunk_scan(gates, row0, h, wid, a4, a4 + 128, a4 + 256, total, amax);
            a4[384 + lane] = __expf(a4[128 + lane] - amax); a4[384 + 64 + lane] = __expf(a4[128 + 64 + lane] - amax);
            if (lane == 0) scal[chain_slot(wid, b, h, 0) + cc] = make_float2(total + amax, total);
        }
        __syncthreads();
#pragma unroll
        for (int i = 0; i < 4; ++i) {
            const int idx = tid + 512 * i, l = idx >> 4, c = (idx & 15) * 8;
            const u32x4 v = *reinterpret_cast<const u32x4*>(MLV + (size_t)(row0 + l) * 512 + h * 128 + c);
            *reinterpret_cast<u32x4*>(Vimg + (l >> 6) * 16384 + v_st(l & 63, c)) = v;
            const int t = cc * 128 + l; bool hasm, hasp; seg_edges(t, hasm, hasp);
            const u16* kp = MLQK + (size_t)(row0 + l) * 1024 + 512 + h * 128 + c;
            const u32x4 x0 = *reinterpret_cast<const u32x4*>(kp);
            const u32x4 xm = hasm ? *reinterpret_cast<const u32x4*>(kp - 1024) : x0;
            const u32x4 xp = hasp ? *reinterpret_cast<const u32x4*>(kp + 1024) : x0;
            float kv[8]; conv_silu8(xm, x0, xp, p.conv_w + 512 + h * 128 + c, hasm, hasp, kv);
            const float wf = arr[384 + l] * 0.08838834764831845f, wb = arr[512 + 384 + l] * 0.08838834764831845f;
            u32x4 of, ob;
#pragma unroll
            for (int j = 0; j < 4; ++j) { of[j] = cvtpk(kv[2 * j] * wf, kv[2 * j + 1] * wf); ob[j] = cvtpk(kv[2 * j] * wb, kv[2 * j + 1] * wb); }
            *reinterpret_cast<u32x4*>(Kf + (l >> 6) * 16384 + v_st(l & 63, c)) = of;
            *reinterpret_cast<u32x4*>(Kb + (l >> 6) * 16384 + v_st(l & 63, c)) = ob;
        }
        __syncthreads();
        const int dir = wid >> 2, vblk = wid & 3;
        const int va = (int)(uintptr_t)Vimg + v_rd_base(lane), ka = (int)(uintptr_t)(dir ? Kb : Kf) + v_rd_base(lane);
        f32x16 acc[4] = {};
#define ASTEP(H, KS) do { s16x4 al_, ah_, b0l, b0h, b1l, b1h, b2l, b2h, b3l, b3h; \
        if (vblk == 0) tr_frag_issue<0, KS>(va + (H) * 16384, al_, ah_); else if (vblk == 1) tr_frag_issue<1, KS>(va + (H) * 16384, al_, ah_); \
        else if (vblk == 2) tr_frag_issue<2, KS>(va + (H) * 16384, al_, ah_); else tr_frag_issue<3, KS>(va + (H) * 16384, al_, ah_); \
        tr_frag_issue<0, KS>(ka + (H) * 16384, b0l, b0h); tr_frag_issue<1, KS>(ka + (H) * 16384, b1l, b1h); \
        tr_frag_issue<2, KS>(ka + (H) * 16384, b2l, b2h); tr_frag_issue<3, KS>(ka + (H) * 16384, b3l, b3h); LGKM0(); \
        const bf16x8 af = PKLH(al_, ah_); \
        acc[0] = __builtin_amdgcn_mfma_f32_32x32x16_bf16(af, PKLH(b0l, b0h), acc[0], 0, 0, 0); \
        acc[1] = __builtin_amdgcn_mfma_f32_32x32x16_bf16(af, PKLH(b1l, b1h), acc[1], 0, 0, 0); \
        acc[2] = __builtin_amdgcn_mfma_f32_32x32x16_bf16(af, PKLH(b2l, b2h), acc[2], 0, 0, 0); \
        acc[3] = __builtin_amdgcn_mfma_f32_32x32x16_bf16(af, PKLH(b3l, b3h), acc[3], 0, 0, 0); } while (0)
        ASTEP(0, 0); ASTEP(0, 1); ASTEP(0, 2); ASTEP(0, 3); ASTEP(1, 0); ASTEP(1, 1); ASTEP(1, 2); ASTEP(1, 3);
#undef ASTEP
        u16* Cd = CST + (size_t)chain_slot(dir, b, h, cc) * 16384;
#pragma unroll
        for (int kb = 0; kb < 4; ++kb)
#pragma unroll
            for (int r = 0; r < 16; ++r) Cd[(vblk * 32 + crow(r, hi)) * 128 + kb * 32 + r32] = f2bf(acc[kb][r]);
        if (tid < 256) {
            const int d2 = tid >> 7, k = tid & 127; const char* img = d2 ? Kb : Kf; float s = 0.f;
            for (int l = 0; l < 128; ++l) s += bf2f(*reinterpret_cast<const u16*>(img + (l >> 6) * 16384 + v_st(l & 63, k & ~7) + (k & 7) * 2));
            NST[(size_t)chain_slot(d2, b, h, cc) * 128 + k] = s;
        }
    }
}

DEVI void phase_kmax(const P& p, char* lds) {
    const int tid = threadIdx.x; unsigned* lm = (unsigned*)lds;
    __syncthreads();
    if (tid < 16) lm[tid] = 0u;
    __syncthreads();
    const u16* K = (const u16*)(p.ws + OFF_K); const int hm = tid & 7;
    float mx0 = 0.f, mx1 = 0.f;
    for (int idx = blockIdx.x * NTHR + tid; idx < NTOK * 8; idx += gridDim.x * NTHR) {
        const int tok = idx >> 3; const u16* kp = K + (size_t)tok * 512 + hm * 64; float ss = 0.f;
#pragma unroll
        for (int c = 0; c < 8; ++c) { const u32x4 w = *reinterpret_cast<const u32x4*>(kp + c * 8);
#pragma unroll
            for (int j = 0; j < 4; ++j) { const float a = bflo(w[j]), b = bfhi(w[j]); ss = fmaf(a, a, ss); ss = fmaf(b, b, ss); } }
        if (tok < TT) mx0 = fmaxf(mx0, ss); else mx1 = fmaxf(mx1, ss);
    }
    atomicMax(&lm[hm], __float_as_uint(mx0)); atomicMax(&lm[8 + hm], __float_as_uint(mx1));
    __syncthreads();
    if (tid < 16) atomicMax((unsigned*)(p.ws + OFF_CNT) + 128 + tid, lm[tid]);
    __syncthreads();
}

DEVI int proc_chunk(int dir, int i) { return dir == 0 ? i : (i == 0 ? 1 : (i == 1 ? 0 : NCH + 1 - i)); }

DEVI void phase_mlstm_b(const P& p, char* lds) {
    const int tid = threadIdx.x;
    float* dec = (float*)lds; float* scl = dec + 160; float* mst = scl + 160;
    const float2* scal = (const float2*)(p.ws + OFF_MSCAL);
    u32* CST = (u32*)(p.ws + OFF_CST); float* NST = (float*)(p.ws + OFF_NST); float* MST = (float*)(p.ws + OFF_MST);
    for (int it = blockIdx.x; it < 16 * 16; it += gridDim.x) {
        const int chain = it >> 4, sub = it & 15, dir = chain >> 3;
        __syncthreads();
        if (tid == 0) {
            float m = 0.f;
            for (int i = 0; i < NCH; ++i) {
                const int cc = proc_chunk(dir, i); const float2 s = scal[chain * NCH + cc];
                const float mn = fmaxf(s.y + m, s.x);
                dec[i] = __expf(s.y + m - mn); scl[i] = __expf(s.x - mn); mst[i] = m;
                if (sub == 0) MST[chain * NCH + cc] = m;
                m = mn;
            }
        }
        __syncthreads();
        u32* base = CST + (size_t)chain * NCH * 8192 + sub * 512 + tid;
        float s0 = 0.f, s1 = 0.f;
        for (int i0 = 0; i0 < NCH; i0 += 10) {
            u32 v[10];
#pragma unroll
            for (int j = 0; j < 10; ++j) v[j] = base[(size_t)proc_chunk(dir, i0 + j) * 8192];
#pragma unroll
            for (int j = 0; j < 10; ++j) {
                base[(size_t)proc_chunk(dir, i0 + j) * 8192] = cvtpk(s0, s1);
                const float d = dec[i0 + j], sc = scl[i0 + j];
                s0 = fmaf(d, s0, sc * bflo(v[j])); s1 = fmaf(d, s1, sc * bfhi(v[j]));
            }
        }
        if (sub == 0 && tid < 128) {
            float* nb = NST + (size_t)chain * NCH * 128 + tid; float s = 0.f;
            for (int i = 0; i < NCH; ++i) { const int cc = proc_chunk(dir, i); const float v = nb[cc * 128]; nb[cc * 128] = s; s = fmaf(dec[i], s, scl[i] * v); }
        }
    }
}

DEVI void mlstm_c_item(const P& p, int it, char* lds) {
    int tid = threadIdx.x; asm volatile("" : "+v"(tid));
    const int wid = __builtin_amdgcn_readfirstlane(tid >> 6), lane = tid & 63, r32 = lane & 31, hi = lane >> 5;
    const int cc = it % NCH, h = (it / NCH) & 3, b = it / (NCH * 4);
    const int row0 = b * TT + cc * 128;
    char* Kt = lds; char* Vimg = lds + 34816; char* Ct = lds + 67584;
    float* arr = (float*)(lds + 137216);
    float* wsc = arr + 1024 + wid * 64;
    float* xb = (float*)lds;
    const float* gates = (const float*)(p.ws + OFF_GATES);
    const u16* MLQK = (const u16*)(p.ws + OFF_MLQK); const u16* MLV = (const u16*)(p.ws + OFF_MLV);
    const u16* CST = (const u16*)(p.ws + OFF_CST); const float* NST = (const float*)(p.ws + OFF_NST); const float* MST = (const float*)(p.ws + OFF_MST);
    __syncthreads();
    if (wid < 2) { float total, amax; float* a4 = arr + wid * 512; chunk_scan(gates, row0, h, wid, a4, a4 + 128, a4 + 256, total, amax); }
    else if (wid < 6) { const int d2 = (wid - 2) >> 1, k = ((wid - 2) & 1) * 64 + lane; arr[d2 * 512 + 384 + k] = NST[(size_t)chain_slot(d2, b, h, cc) * 128 + k]; }
#pragma unroll
    for (int i = 0; i < 4; ++i) {
        const int idx = tid + 512 * i, l = idx >> 4, ch = idx & 15, c = ch * 8;
        const u32x4 v = *reinterpret_cast<const u32x4*>(MLV + (size_t)(row0 + l) * 512 + h * 128 + c);
        *reinterpret_cast<u32x4*>(Vimg + (l >> 6) * 16384 + v_st(l & 63, c)) = v;
        const int t = cc * 128 + l; bool hasm, hasp; seg_edges(t, hasm, hasp);
        const u16* kp = MLQK + (size_t)(row0 + l) * 1024 + 512 + h * 128 + c;
        const u32x4 x0 = *reinterpret_cast<const u32x4*>(kp);
        const u32x4 xm = hasm ? *reinterpret_cast<const u32x4*>(kp - 1024) : x0;
        const u32x4 xp = hasp ? *reinterpret_cast<const u32x4*>(kp + 1024) : x0;
        float kv[8]; conv_silu8(xm, x0, xp, p.conv_w + 512 + h * 128 + c, hasm, hasp, kv);
        u32x4 ok;
#pragma unroll
        for (int j = 0; j < 4; ++j) ok[j] = cvtpk(kv[2 * j] * 0.08838834764831845f, kv[2 * j + 1] * 0.08838834764831845f);
        *reinterpret_cast<u32x4*>(Kt + swz256(l, ch)) = ok;
#pragma unroll
        for (int d2 = 0; d2 < 2; ++d2) {
            const u32x4 cv = *reinterpret_cast<const u32x4*>(CST + (size_t)chain_slot(d2, b, h, cc) * 16384 + l * 128 + c);
            *reinterpret_cast<u32x4*>(Ct + d2 * 34816 + swz256(l, ch)) = cv;
        }
    }
    const int dir = wid >> 2, qb = wid & 3, q = qb * 32 + r32;
    bf16x8 qr[8];
    {
        const int t = cc * 128 + q; bool hasm, hasp; seg_edges(t, hasm, hasp);
        const u16* qp = MLQK + (size_t)(row0 + q) * 1024 + h * 128 + hi * 8;
#pragma unroll
        for (int d0 = 0; d0 < 8; ++d0) {
            const u32x4 x0 = *reinterpret_cast<const u32x4*>(qp + d0 * 16);
            const u32x4 xm = hasm ? *reinterpret_cast<const u32x4*>(qp + d0 * 16 - 1024) : x0;
            const u32x4 xp = hasp ? *reinterpret_cast<const u32x4*>(qp + d0 * 16 + 1024) : x0;
            float qv[8]; conv_silu8(xm, x0, xp, p.conv_w + h * 128 + d0 * 16 + hi * 8, hasm, hasp, qv);
            u32x4 w; w[0] = cvtpk(qv[0], qv[1]); w[1] = cvtpk(qv[2], qv[3]); w[2] = cvtpk(qv[4], qv[5]); w[3] = cvtpk(qv[6], qv[7]);
            qr[d0] = *reinterpret_cast<bf16x8*>(&w);
        }
    }
    __syncthreads();
    const float* a4 = arr + dir * 512;
    const float m_st = MST[chain_slot(dir, b, h, 0) + cc];
    const float Mq = fmaxf(m_st, a4[256 + q]);
    const float inter = __expf(m_st - Mq);
    float nq = 0.f;
#pragma unroll
    for (int d0 = 0; d0 < 8; ++d0) {
        const u32x4 w = *reinterpret_cast<const u32x4*>(&qr[d0]); const float* nn = a4 + 384 + d0 * 16 + hi * 8;
#pragma unroll
        for (int j = 0; j < 4; ++j) { nq = fmaf(bflo(w[j]), nn[2 * j], nq); nq = fmaf(bfhi(w[j]), nn[2 * j + 1], nq); }
    }
    { auto rr = __builtin_amdgcn_permlane32_swap(__float_as_uint(nq), __float_as_uint(nq), false, false); nq = __uint_as_float(rr[0]) + __uint_as_float(rr[1]); }
    f32x16 o[4] = {};
    const char* Cm = Ct + dir * 34816;
#pragma unroll
    for (int dk = 0; dk < 8; ++dk)
#pragma unroll
        for (int d0 = 0; d0 < 4; ++d0) o[d0] = __builtin_amdgcn_mfma_f32_32x32x16_bf16(qr[dk], lds_b128(Cm, swz256(d0 * 32 + r32, 2 * dk + hi)), o[d0], 0, 0, 0);
    if (hi == 0) wsc[r32] = inter;
    asm volatile("s_waitcnt lgkmcnt(0)" ::: "memory");
#pragma unroll
    for (int d0 = 0; d0 < 4; ++d0)
#pragma unroll
        for (int r = 0; r < 16; ++r) o[d0][r] *= wsc[crow(r, hi)];
    const int vb = (int)(uintptr_t)Vimg + v_rd_base(lane);
    float rs = 0.f;
#define KBLK(KB) do { if (dir == 0 ? (KB) <= qb : (KB) >= qb) { \
        f32x16 pp = {}; \
        _Pragma("unroll") for (int d0 = 0; d0 < 8; ++d0) pp = __builtin_amdgcn_mfma_f32_32x32x16_bf16(lds_b128(Kt, swz256((KB) * 32 + r32, 2 * d0 + hi)), qr[d0], pp, 0, 0, 0); \
        _Pragma("unroll") for (int g = 0; g < 4; ++g) { const f32x4 av4 = *reinterpret_cast<const f32x4*>(a4 + 128 + (KB) * 32 + 8 * g + 4 * hi); \
            _Pragma("unroll") for (int j = 0; j < 4; ++j) { const int key = (KB) * 32 + 8 * g + 4 * hi + j; const bool ok = dir == 0 ? key <= q : key >= q; \
                const float sv = ok ? pp[4 * g + j] * __expf(av4[j] - Mq) : 0.f; pp[4 * g + j] = sv; rs += sv; } } \
        bf16x8 f0, f1; pack_p(pp, f0, f1); \
        { s16x4 l0, h0, l1, h1, l2, h2, l3, h3; constexpr int HH = (KB) >> 1, K0 = ((KB) & 1) * 2; \
          tr_frag_issue<0, K0>(vb + HH * 16384, l0, h0); tr_frag_issue<1, K0>(vb + HH * 16384, l1, h1); tr_frag_issue<2, K0>(vb + HH * 16384, l2, h2); tr_frag_issue<3, K0>(vb + HH * 16384, l3, h3); LGKM0(); \
          o[0] = __builtin_amdgcn_mfma_f32_32x32x16_bf16(f0, PKLH(l0, h0), o[0], 0, 0, 0); o[1] = __builtin_amdgcn_mfma_f32_32x32x16_bf16(f0, PKLH(l1, h1), o[1], 0, 0, 0); \
          o[2] = __builtin_amdgcn_mfma_f32_32x32x16_bf16(f0, PKLH(l2, h2), o[2], 0, 0, 0); o[3] = __builtin_amdgcn_mfma_f32_32x32x16_bf16(f0, PKLH(l3, h3), o[3], 0, 0, 0); \
          tr_frag_issue<0, K0 + 1>(vb + HH * 16384, l0, h0); tr_frag_issue<1, K0 + 1>(vb + HH * 16384, l1, h1); tr_frag_issue<2, K0 + 1>(vb + HH * 16384, l2, h2); tr_frag_issue<3, K0 + 1>(vb + HH * 16384, l3, h3); LGKM0(); \
          o[0] = __builtin_amdgcn_mfma_f32_32x32x16_bf16(f1, PKLH(l0, h0), o[0], 0, 0, 0); o[1] = __builtin_amdgcn_mfma_f32_32x32x16_bf16(f1, PKLH(l1, h1), o[1], 0, 0, 0); \
          o[2] = __builtin_amdgcn_mfma_f32_32x32x16_bf16(f1, PKLH(l2, h2), o[2], 0, 0, 0); o[3] = __builtin_amdgcn_mfma_f32_32x32x16_bf16(f1, PKLH(l3, h3), o[3], 0, 0, 0); } } } while (0)
    KBLK(0); KBLK(1); KBLK(2); KBLK(3);
#undef KBLK
    { auto rr = __builtin_amdgcn_permlane32_swap(__float_as_uint(rs), __float_as_uint(rs), false, false); rs = __uint_as_float(rr[0]) + __uint_as_float(rr[1]); }
    const float nqt = inter * nq + rs;
    const float den = fmaxf(fabsf(nqt), __expf(-(a4[q] + Mq)));
    if (hi == 0) wsc[32 + r32] = 1.f / den;
    asm volatile("s_waitcnt lgkmcnt(0)" ::: "memory");
#pragma unroll
    for (int d0 = 0; d0 < 4; ++d0)
#pragma unroll
        for (int r = 0; r < 16; ++r) o[d0][r] *= wsc[32 + crow(r, hi)];
    __syncthreads();
    if (dir == 1) {
#pragma unroll
        for (int d0 = 0; d0 < 4; ++d0)
#pragma unroll
            for (int r = 0; r < 16; ++r) xb[(qb * 32 + crow(r, hi)) * 128 + d0 * 32 + r32] = o[d0][r];
    }
    __syncthreads();
    if (dir == 0) {
        const u16* OG = (const u16*)(p.ws + OFF_OG); u16* mix = (u16*)(p.ws + OFF_ACT);
#pragma unroll
        for (int d0 = 0; d0 < 4; ++d0)
#pragma unroll
            for (int r = 0; r < 16; ++r) {
                const int ql = qb * 32 + crow(r, hi), v = d0 * 32 + r32;
                const float hv = o[d0][r] + xb[ql * 128 + v];
                const float og = bf2f(OG[(size_t)(row0 + ql) * 512 + h * 128 + v]);
                mix[(size_t)(row0 + ql) * 1024 + 512 + h * 128 + v] = f2bf(hv * og);
            }
    }
}

#define KSWZ(row, colB) ((row) * 256 + ((colB) ^ (((row) & 15) << 4)))
constexpr float A2_SCALE = 0.125f, A2_THR = 8.f;
DEVI void a2_partialSM(f32x16& p0, f32x16& p1, float mnC) {
    constexpr float C = A2_SCALE * 1.4426950408889634f;
#pragma unroll
    for (int r = 0; r < 16; ++r) p0[r] = __builtin_amdgcn_exp2f(fmaf(p0[r], C, mnC));
#pragma unroll
    for (int r = 0; r < 16; ++r) p1[r] = fmaf(p1[r], C, mnC);
}
DEVI void a2_finishSM(f32x16& p0, f32x16& p1, float& l_reg, bf16x8& pa0, bf16x8& pa1, bf16x8& pa2, bf16x8& pa3) {
#pragma unroll
    for (int r = 0; r < 16; ++r) p1[r] = __builtin_amdgcn_exp2f(p1[r]);
    float ps = 0.f;
#pragma unroll
    for (int r = 0; r < 16; ++r) ps += p0[r];
#pragma unroll
    for (int r = 0; r < 16; ++r) ps += p1[r];
    l_reg += ps;
    pack_p(p0, pa0, pa1); pack_p(p1, pa2, pa3);
}
DEVI void a2_qkt(f32x16& p0, f32x16& p1, const char* Ks, const bf16x8 (&qr)[4], int r32, int hi, int grp) {
    p0 = f32x16{}; p1 = f32x16{};
#pragma unroll
    for (int d0 = 0; d0 < 4; ++d0) { const int cb = (grp * 64 + d0 * 16 + hi * 8) * 2;
        const bf16x8 b0 = lds_b128(Ks, KSWZ(r32, cb)), b1 = lds_b128(Ks, KSWZ(32 + r32, cb));
        p0 = __builtin_amdgcn_mfma_f32_32x32x16_bf16(b0, qr[d0], p0, 0, 0, 0);
        p1 = __builtin_amdgcn_mfma_f32_32x32x16_bf16(b1, qr[d0], p1, 0, 0, 0); }
}
#define A2_VISSUE(D0, F) do { tr_frag_issue<D0, 0>(vb, F##l0, F##h0); tr_frag_issue<D0, 1>(vb, F##l1, F##h1); tr_frag_issue<D0, 2>(vb, F##l2, F##h2); tr_frag_issue<D0, 3>(vb, F##l3, F##h3); } while (0)
#define A2_VMMA(D0, F) do { \
    o[D0] = __builtin_amdgcn_mfma_f32_32x32x16_bf16(pa0, PKLH(F##l0, F##h0), o[D0], 0, 0, 0); o[D0] = __builtin_amdgcn_mfma_f32_32x32x16_bf16(pa1, PKLH(F##l1, F##h1), o[D0], 0, 0, 0); \
    o[D0] = __builtin_amdgcn_mfma_f32_32x32x16_bf16(pa2, PKLH(F##l2, F##h2), o[D0], 0, 0, 0); o[D0] = __builtin_amdgcn_mfma_f32_32x32x16_bf16(pa3, PKLH(F##l3, F##h3), o[D0], 0, 0, 0); } while (0)
#define A2_LGKM(N) do { asm volatile("s_waitcnt lgkmcnt(" #N ")" ::: "memory"); SBAR(); } while (0)
DEVI void a2_pv(f32x16 (&o)[4], int vb, const bf16x8& pa0, const bf16x8& pa1, const bf16x8& pa2, const bf16x8& pa3) {
    s16x4 al0, ah0, al1, ah1, al2, ah2, al3, ah3, bl0, bh0, bl1, bh1, bl2, bh2, bl3, bh3;
    A2_VISSUE(0, a); A2_VISSUE(1, b);
    A2_LGKM(8); A2_VMMA(0, a);
    A2_VISSUE(2, a);
    A2_LGKM(8); A2_VMMA(1, b);
    A2_VISSUE(3, b);
    A2_LGKM(8); A2_VMMA(2, a);
    A2_LGKM(0); A2_VMMA(3, b);
}
constexpr int A2_T = 16384;
DEVI void a2_body(const P& p, int q0, int k0row, int seq, int h, char* lds, int tid) {
    const int GRP = __builtin_amdgcn_readfirstlane(tid >> 8); const int wid = tid >> 6, lane = tid & 63, r32 = lane & 31, hi = lane >> 5, wq = wid & 3;
    const u16* Kh = (const u16*)(p.ws + OFF_K) + (size_t)k0row * 512 + h * 128;
    const u16* Vh = (const u16*)(p.ws + OFF_V) + (size_t)k0row * 512 + h * 128;
    char* V_lds = lds; char* K_lds = lds + 3 * A2_T;
    float* wsc = (float*)(lds + 6 * A2_T) + wid * 64; float* li_l = wsc;
    float l_reg = 0.f; f32x16 o[4] = {}; bf16x8 qr[4];
    { const u16* Qw = (const u16*)(p.ws + OFF_Q) + (size_t)(q0 + wq * 32 + r32) * 512 + h * 128 + GRP * 64 + hi * 8;
#pragma unroll
      for (int d0 = 0; d0 < 4; ++d0) qr[d0] = *reinterpret_cast<const bf16x8*>(Qw + d0 * 16); }
    float mnC;
    { float qq = 0.f;
#pragma unroll
      for (int d0 = 0; d0 < 4; ++d0) { const u32x4 w = *reinterpret_cast<const u32x4*>(&qr[d0]);
#pragma unroll
          for (int j = 0; j < 4; ++j) { const float a = bflo(w[j]), b2 = bfhi(w[j]); qq = fmaf(a, a, qq); qq = fmaf(b2, b2, qq); } }
      { auto rr = __builtin_amdgcn_permlane32_swap(__float_as_uint(qq), __float_as_uint(qq), false, false); qq = __uint_as_float(rr[0]) + __uint_as_float(rr[1]); }
      const int bq = k0row >= TT ? 1 : 0;
      const float k2 = __uint_as_float(((const unsigned*)(p.ws + OFF_CNT))[128 + bq * 8 + h * 2 + GRP]);
      mnC = -sqrtf(qq * k2) * (A2_SCALE * 1.4426950408889634f) * 1.0001f; }
    const int sr = tid >> 4, sc = (tid & 15) * 8, vst0 = v_st(sr, sc), vst1 = v_st(32 + sr, sc);
    const int vb0 = (int)(uintptr_t)V_lds + v_rd_base(lane);
    u32x4 e_vs0, e_vs1, e_ks0, e_ks1;
#define A2_SLOAD(S, kk) do { S##_vs0 = *reinterpret_cast<const u32x4*>(Vh + (size_t)((kk) + sr) * 512 + sc); S##_vs1 = *reinterpret_cast<const u32x4*>(Vh + (size_t)((kk) + 32 + sr) * 512 + sc); \
    S##_ks0 = *reinterpret_cast<const u32x4*>(Kh + (size_t)((kk) + sr) * 512 + sc); S##_ks1 = *reinterpret_cast<const u32x4*>(Kh + (size_t)((kk) + 32 + sr) * 512 + sc); } while (0)
#define A2_SWRITE(b, S) do { *reinterpret_cast<u32x4*>(V_lds + (b) * A2_T + vst0) = S##_vs0; *reinterpret_cast<u32x4*>(V_lds + (b) * A2_T + vst1) = S##_vs1; \
    *reinterpret_cast<u32x4*>(K_lds + (b) * A2_T + KSWZ(sr, sc * 2)) = S##_ks0; *reinterpret_cast<u32x4*>(K_lds + (b) * A2_T + KSWZ(32 + sr, sc * 2)) = S##_ks1; } while (0)
#define A2_SWAIT() asm volatile("s_waitcnt vmcnt(0)" ::: "memory")
    f32x16 pA0, pA1, pB0, pB1; bf16x8 pa0, pa1, pa2, pa3; const int NT = seq / 64;
    __syncthreads();
    A2_SLOAD(e, 0); A2_SWAIT(); A2_SWRITE(0, e); A2_SLOAD(e, 64); __syncthreads();
    a2_qkt(pA0, pA1, K_lds, qr, r32, hi, GRP); a2_partialSM(pA0, pA1, mnC);
    A2_SWAIT(); A2_SWRITE(1, e); if (2 < NT) A2_SLOAD(e, 128); __syncthreads();
    int bp = 0, bc = 1, bn = 2;
#define A2_HALF(X0, X1, Y0, Y1, J) do { \
        SBAR(); a2_qkt(X0, X1, K_lds + bc * A2_T, qr, r32, hi, GRP); \
        a2_finishSM(Y0, Y1, l_reg, pa0, pa1, pa2, pa3); SBAR(); \
        if ((J) + 1 < NT) { A2_SWAIT(); A2_SWRITE(bn, e); if ((J) + 2 < NT) A2_SLOAD(e, ((J) + 2) * 64); } SBAR(); \
        a2_pv(o, vb0 + bp * A2_T, pa0, pa1, pa2, pa3); a2_partialSM(X0, X1, mnC); \
        __syncthreads(); \
        { const int t_ = bp; bp = bc; bc = bn; bn = t_; } } while (0)
    for (int j = 1; j + 1 < NT; j += 2) {
        A2_HALF(pB0, pB1, pA0, pA1, j);
        A2_HALF(pA0, pA1, pB0, pB1, j + 1);
    }
    A2_HALF(pB0, pB1, pA0, pA1, NT - 1);
    a2_finishSM(pB0, pB1, l_reg, pa0, pa1, pa2, pa3); SBAR();
    a2_pv(o, vb0 + bp * A2_T, pa0, pa1, pa2, pa3);
#undef A2_HALF
#undef A2_SLOAD
#undef A2_SWRITE
#undef A2_SWAIT
    asm volatile("s_waitcnt vmcnt(0)" ::: "memory");
    int tz = threadIdx.x; asm volatile("" : "+v"(tz));
    const int wq_e = (tz >> 6) & 3, r32e = tz & 31, hie = (tz >> 5) & 1;
    float* li_e = (float*)(lds + 6 * A2_T) + (tz >> 6) * 64;
    const float lam = ((const float*)(p.ws + OFF_LAM))[0];
    { auto rr = __builtin_amdgcn_permlane32_swap(__float_as_uint(l_reg), __float_as_uint(l_reg), false, false); l_reg = __uint_as_float(rr[0]) + __uint_as_float(rr[1]); }
    if (hie == 0) li_e[r32e] = (GRP == 0 ? 1.f : -lam) / l_reg;
    asm volatile("s_waitcnt lgkmcnt(0)" ::: "memory");
#pragma unroll
    for (int r = 0; r < 16; ++r) { const float sc_ = li_e[crow(r, hie)];
#pragma unroll
        for (int d = 0; d < 4; ++d) o[d][r] *= sc_; }
    float* xb = (float*)lds;
    __syncthreads();
    if (GRP == 1) {
#pragma unroll
        for (int d = 0; d < 4; ++d)
#pragma unroll
            for (int r = 0; r < 16; ++r) xb[(wq_e * 32 + crow(r, hie)) * 128 + d * 32 + r32e] = o[d][r];
    }
    __syncthreads();
    if (GRP == 0) {
        float ssq[16];
#pragma unroll
        for (int r = 0; r < 16; ++r) { float s_ = 0.f;
#pragma unroll
            for (int d = 0; d < 4; ++d) { const float v = o[d][r] + xb[(wq_e * 32 + crow(r, hie)) * 128 + d * 32 + r32e]; o[d][r] = v; s_ = fmaf(v, v, s_); }
            ssq[r] = s_; }
#pragma unroll
        for (int r = 0; r < 16; ++r) { float s_ = ssq[r]; for (int of = 16; of; of >>= 1) s_ += __shfl_xor(s_, of); ssq[r] = rsqrtf(s_ * (1.f / 128.f) + 1e-6f) * 0.8f; }
        u16* mix = (u16*)(p.ws + OFF_ACT);
#pragma unroll
        for (int d = 0; d < 4; ++d) { const float gv = p.subln_g[d * 32 + r32e];
#pragma unroll
            for (int r = 0; r < 16; ++r) mix[(size_t)(q0 + wq_e * 32 + crow(r, hie)) * 1024 + h * 128 + d * 32 + r32e] = f2bf(o[d][r] * ssq[r] * gv); }
    }
}
DEVI void phase_attn(const P& p, char* lds) {
    const int G = gridDim.x;
    for (int it = blockIdx.x; it < 1024 + 16; it += G) {
        int q0, k0, seq, h;
        if (it < 1024) {
            int bh, qb;
            if ((G & 7) == 0) { bh = it & 7; qb = it >> 3; } else { bh = it >> 7; qb = it & 127; }
            const int b = bh >> 2; h = bh & 3; q0 = b * TT + TC + qb * 128; k0 = b * TT; seq = TT;
        } else { const int j = it - 1024, b = j >> 3; h = (j >> 1) & 3; q0 = b * TT + (j & 1) * 128; k0 = b * TT; seq = TC; }
        int tid = threadIdx.x; asm volatile("" : "+v"(tid));
        a2_body(p, q0, k0, seq, h, lds, tid);
    }
}
DEVI void phase_mlstm_c(const P& p, char* lds) {
    for (int it = blockIdx.x; it < NB * 4 * NCH; it += gridDim.x) mlstm_c_item(p, it, lds);
}

DEVI void phase_convert_l1(const P& p, char* lds) {
    for (int it = blockIdx.x; it < N0_EXP; it += gridDim.x) convert_expert_item(p, 1, it, (float*)lds);
}

constexpr int NPHASE = 19;
__global__ void __launch_bounds__(NTHR, 2) fwd_kernel(P p_) {
    extern __shared__ __attribute__((aligned(16))) char lds[];
    volatile LAS unsigned* st = (volatile LAS unsigned*)(lds + LDS_BYTES - 16);
    if (threadIdx.x == 0) { st[0] = 0u; st[1] = 0u; st[2] = 0u; st[3] = 0u; }
    __syncthreads();
    const int lo = p_.ph_lo, hi = p_.ph_hi;
    XcdBarrier bar; bar.bar = (unsigned*)(p_.ws + OFF_BAR); bar.x = 0; bar.st = st;
    if (hi - lo > 1) bar = xcd_barrier_post((unsigned*)(p_.ws + OFF_BAR), st);
#if defined(__HIP_DEVICE_COMPILE__)
#define PARAMS() const __attribute__((address_space(4))) P* kp_ = (const __attribute__((address_space(4))) P*)__builtin_amdgcn_kernarg_segment_ptr(); asm volatile("" : "+s"(kp_)); const P p = *kp_
#else
#define PARAMS() const P p = p_
#endif
#ifndef PHSEL
#define PHON(k) true
#else
#define PHON(k) ((k) == PHSEL)
#endif
#define IN(k) (lo <= (k) && (k) < hi)
#define SEAM(k) do { if (IN(k) && IN((k) + ((k) == 5 ? 2 : 1))) xcd_barrier(bar); } while (0)
    if (PHON(0) && IN(0)) { PARAMS(); phase_prologue(p, lds); if (((PROBE_DUP) >> 0) & 1u) { phase_prologue(p, lds); } }            SEAM(0);
    if (PHON(1) && IN(1)) { PARAMS(); phase_norm<0>(p, lds); if (((PROBE_DUP) >> 1) & 1u) { phase_norm<0>(p, lds); } }             SEAM(1);
    if (PHON(2) && IN(2)) { PARAMS(); phase_inproj(p, lds); if (((PROBE_DUP) >> 2) & 1u) { phase_inproj(p, lds); } }              SEAM(2);
    if (PHON(3) && IN(3)) { PARAMS(); phase_mlstm_a(p, lds); if (((PROBE_DUP) >> 3) & 1u) { phase_mlstm_a(p, lds); } }             SEAM(3);
    if (PHON(4) && IN(4)) { PARAMS(); phase_kmax(p, lds); phase_mlstm_b(p, lds); if (((PROBE_DUP) >> 4) & 1u) { xcd_barrier(bar); phase_mlstm_a(p, lds); xcd_barrier(bar); phase_mlstm_b(p, lds); } }             SEAM(4);
    if (PHON(5) && IN(5)) { PARAMS(); phase_attn(p, lds); phase_mlstm_c(p, lds); if (((PROBE_DUP) >> 5) & 1u) { phase_attn(p, lds); } if (((PROBE_DUP) >> 6) & 1u) { phase_mlstm_c(p, lds); } }   SEAM(5);
    if (PHON(7) && IN(7)) { PARAMS(); phase_outproj(p, lds); if (((PROBE_DUP) >> 7) & 1u) { phase_outproj(p, lds); } }             SEAM(7);
    if (PHON(8) && IN(8)) { PARAMS(); phase_norm<1>(p, lds); if (((PROBE_DUP) >> 8) & 1u) { phase_norm<1, true>(p, lds); } }             SEAM(8);
    if (PHON(9) && IN(9)) { PARAMS(); phase_moe_up(p, 0, lds); if (((PROBE_DUP) >> 9) & 1u) { phase_moe_up(p, 0, lds); } }           SEAM(9);
    if (PHON(10) && IN(10)) { PARAMS(); phase_moe_down(p, 0, lds); if (((PROBE_DUP) >> 10) & 1u) { phase_moe_down<true>(p, 0, lds); } }        SEAM(10);
    if (PHON(11) && IN(11)) { PARAMS(); phase_norm<2>(p, lds); phase_convert_l1(p, lds); if (((PROBE_DUP) >> 11) & 1u) { phase_norm<2>(p, lds); phase_convert_l1(p, lds); } } SEAM(11);
    if (PHON(12) && IN(12)) { PARAMS(); phase_fnet_gemm(p, lds); if (((PROBE_DUP) >> 12) & 1u) { phase_fnet_gemm(p, lds); } }          SEAM(12);
    if (PHON(13) && IN(13)) { PARAMS(); phase_fft1(p, lds); if (((PROBE_DUP) >> 13) & 1u) { phase_fft1(p, lds); } }               SEAM(13);
    if (PHON(14) && IN(14)) { PARAMS(); phase_fft2(p, lds); if (((PROBE_DUP) >> 14) & 1u) { phase_fft2<true>(p, lds); } }               SEAM(14);
    if (PHON(15) && IN(15)) { PARAMS(); phase_norm<3>(p, lds); if (((PROBE_DUP) >> 15) & 1u) { phase_norm<3, true>(p, lds); } }            SEAM(15);
    if (PHON(16) && IN(16)) { PARAMS(); phase_moe_up(p, 1, lds); if (((PROBE_DUP) >> 16) & 1u) { phase_moe_up(p, 1, lds); } }          SEAM(16);
    if (PHON(17) && IN(17)) { PARAMS(); phase_moe_down(p, 1, lds); if (((PROBE_DUP) >> 17) & 1u) { phase_moe_down<true>(p, 1, lds); } }        SEAM(17);
    if (PHON(18) && IN(18)) { PARAMS(); phase_norm<4>(p, lds); if (((PROBE_DUP) >> 18) & 1u) { phase_norm<4>(p, lds); } }
#undef IN
#undef SEAM
}

#ifndef ONE_LAUNCH
#define ONE_LAUNCH 1
#endif
extern "C" void kernel_launch(void* const* d_in, const int* in_sizes, int n_in, void* d_out, int out_size, void* d_ws, size_t ws_size, hipStream_t stream) {
    static int grid = 0;
    if (grid == 0) {
        if (n_in != 21 || out_size != NLAT * DM || ws_size < OFF_END) { fprintf(stderr, "kernel_launch: unexpected shapes (n_in %d out %d ws %zu need %zu)\n", n_in, out_size, ws_size, (size_t)OFF_END); grid = -1; return; }
        int dev = 0, cus = 0;
        if (hipGetDevice(&dev) != hipSuccess || hipDeviceGetAttribute(&cus, hipDeviceAttributeMultiprocessorCount, dev) != hipSuccess) { grid = -1; return; }
        if (hipFuncSetAttribute((const void*)fwd_kernel, hipFuncAttributeMaxDynamicSharedMemorySize, LDS_BYTES) != hipSuccess) { fprintf(stderr, "kernel_launch: hipFuncSetAttribute failed\n"); grid = -1; return; }
        int per_cu = 0;
        if (hipOccupancyMaxActiveBlocksPerMultiprocessor(&per_cu, (const void*)fwd_kernel, NTHR, LDS_BYTES) != hipSuccess || per_cu < 1) { fprintf(stderr, "kernel_launch: occupancy query says %d\n", per_cu); (void)hipGetLastError(); grid = -1; return; }
        grid = cus;
    }
    if (grid < 0) return;
    (void)hipMemsetAsync(d_ws, 0, ZERO_BYTES, stream);
    P p{};
    const float* const* in = (const float* const*)d_in;
    p.x = in[0]; p.c = in[1]; p.ctx = in[2]; p.c_ctx = in[3]; p.ada_w = in[4]; p.ada_b = in[5]; p.nmix_g = in[6]; p.nffn_g = in[7];
    p.w_in = in[8]; p.w_out = in[9]; p.conv_w = in[10]; p.gate_b = in[11]; p.lamv = in[12]; p.subln_g = in[13]; p.w_fnet = in[14];
    p.router_w = in[15]; p.router_b = in[16]; p.w_gate = in[17]; p.w_up = in[18]; p.w_down = in[19]; p.final_g = in[20];
    p.out = (float*)d_out; p.ws = (char*)d_ws;
#if ONE_LAUNCH
    p.ph_lo = 0; p.ph_hi = NPHASE;
    hipLaunchKernelGGL(fwd_kernel, dim3(grid), dim3(NTHR), LDS_BYTES, stream, p);
#else
    for (int k = 0; k < NPHASE; ++k) { p.ph_lo = k; p.ph_hi = k + 1; hipLaunchKernelGGL(fwd_kernel, dim3(grid), dim3(NTHR), LDS_BYTES, stream, p); }
#endif
}
```

```cpp
#include <hip/hip_runtime.h>
#include <stdint.h>
#include <stdio.h>

#define DEVI __device__ __forceinline__
#define PROBE_DUP (0u)
typedef unsigned short u16;
typedef unsigned int u32;
using bf16x8 = __attribute__((ext_vector_type(8))) short;
using s16x4  = __attribute__((ext_vector_type(4))) short;
using f32x16 = __attribute__((ext_vector_type(16))) float;
using f32x4  = __attribute__((ext_vector_type(4))) float;
using u32x4  = __attribute__((ext_vector_type(4))) unsigned;
using u32x2  = __attribute__((ext_vector_type(2))) unsigned;

constexpr int DM = 1024, NB = 2, TL = 16384, TC = 256, TT = TL + TC, NTOK = NB * TT, NLAT = NB * TL;
constexpr int NCH = TT / 128;
constexpr int NTHR = 512;
constexpr int LDS_BYTES = 147456;

constexpr size_t al256(size_t x) { return (x + 255) / 256 * 256; }
constexpr size_t OFF_BAR   = 0;
constexpr size_t OFF_CNT   = 16384;
constexpr size_t ZERO_BYTES = 20480;
constexpr size_t OFF_MOD   = ZERO_BYTES;
constexpr size_t OFF_ROPER = OFF_MOD + al256(2 * 3 * 6144 * 4);
constexpr size_t OFF_ROPEC = OFF_ROPER + 256 * 16 * 8;
constexpr size_t OFF_TW    = OFF_ROPEC + 64 * 16 * 8;
constexpr size_t OFF_DFTC  = OFF_TW + 16384 * 8;
constexpr size_t OFF_DFTS  = OFF_DFTC + 32768;
constexpr size_t OFF_LAM   = OFF_DFTS + 32768;
constexpr size_t OFF_WG16  = OFF_LAM + 256;
constexpr size_t OFF_MSCAL = OFF_WG16 + 65536;
constexpr size_t OFF_MST   = OFF_MSCAL + al256(16 * NCH * 8);
constexpr size_t OFF_WINT  = OFF_MST + al256(16 * NCH * 4);
constexpr size_t OFF_WOUTT = OFF_WINT + (size_t)3584 * 1024 * 2;
constexpr size_t OFF_FNT   = OFF_WOUTT + (size_t)1024 * 1024 * 2;
constexpr size_t OFF_WGU   = OFF_FNT + (size_t)2048 * 1024 * 2;
constexpr size_t OFF_WDT   = OFF_WGU + (size_t)16 * 1024 * 1024 * 2;
constexpr size_t OFF_ACT   = OFF_WDT + (size_t)16 * 1024 * 512 * 2;
constexpr size_t SZ_ACT    = (size_t)NTOK * 1024 * 2;
constexpr size_t OFF_XC    = OFF_ACT + SZ_ACT;
constexpr size_t OFF_GATES = OFF_XC + (size_t)NB * TC * 1024 * 4;
constexpr size_t OFF_TOKW  = OFF_GATES + (size_t)NTOK * 16 * 4;
constexpr size_t OFF_LIST  = OFF_TOKW + al256((size_t)NTOK * 8);
constexpr size_t OFF_NST   = OFF_LIST + (size_t)24 * NTOK * 4;
constexpr size_t OFF_CST   = OFF_NST + (size_t)16 * NCH * 128 * 4;
constexpr size_t SZ_CST    = (size_t)16 * NCH * 16384 * 2;
constexpr size_t OFF_BIG   = OFF_CST + SZ_CST;
constexpr size_t OFF_Q     = OFF_BIG;
constexpr size_t OFF_K     = OFF_Q + (size_t)NTOK * 512 * 2;
constexpr size_t OFF_V     = OFF_K + (size_t)NTOK * 512 * 2;
constexpr size_t OFF_MLQK  = OFF_V + (size_t)NTOK * 512 * 2;
constexpr size_t OFF_MLV   = OFF_MLQK + (size_t)NTOK * 1024 * 2;
constexpr size_t OFF_OG    = OFF_MLV + (size_t)NTOK * 512 * 2;
constexpr size_t OFF_MLC   = OFF_OG + (size_t)NTOK * 512 * 2;
constexpr size_t OFF_END   = OFF_MLC + (size_t)NTOK * 1024 * 2;
constexpr size_t OFF_HE    = OFF_BIG;
constexpr size_t OFF_ZR    = OFF_BIG;
constexpr size_t OFF_ZI    = OFF_ZR + (size_t)NLAT * 1024 * 2;
constexpr size_t OFF_YR    = OFF_CST;
constexpr size_t OFF_YI    = OFF_ACT;
static_assert((size_t)NLAT * 1024 * 2 <= SZ_CST && (size_t)NLAT * 1024 * 2 <= SZ_ACT, "alias sizes");
static_assert(OFF_END < (size_t)508 * 1024 * 1024, "workspace");

struct P {
    const float *x, *c, *ctx, *c_ctx, *ada_w, *ada_b, *nmix_g, *nffn_g, *w_in, *w_out, *conv_w, *gate_b, *lamv, *subln_g,
                *w_fnet, *router_w, *router_b, *w_gate, *w_up, *w_down, *final_g;
    float* out;
    char* ws;
    int ph_lo, ph_hi;
};

#define XB_TMO      128
#define XB_XCNT(j)  (256  + 64 * (j))
#define XB_XSUB(j)  (1280 + 64 * (j))
#define XB_XGEN(j)  (2304 + 64 * (j))
#define XB_TOP      3328
#define XB_TOPGEN   3392
#define XCD_BAR_WORDS 3456
#define XB_SPIN_CAP (1u << 18)
#define LAS __attribute__((address_space(3)))

__device__ __forceinline__ unsigned xb_ld(unsigned* p)              { return __hip_atomic_load(p, __ATOMIC_RELAXED, __HIP_MEMORY_SCOPE_AGENT); }
__device__ __forceinline__ unsigned xb_add(unsigned* p, unsigned v) { return __hip_atomic_fetch_add(p, v, __ATOMIC_RELAXED, __HIP_MEMORY_SCOPE_AGENT); }
__device__ __forceinline__ unsigned xb_xcc_id() { return (unsigned)__builtin_amdgcn_s_getreg((3 << 11) | 20) & 0xFu; }
#define XB_SPIN(cond, bar) do { unsigned _sp = 0; while (cond) { __builtin_amdgcn_s_sleep(1); \
    if ((++_sp & 255u) == 0u) { if (xb_ld(&(bar)[XB_TMO])) break; if (_sp > XB_SPIN_CAP) { atomicAdd(&(bar)[XB_TMO], 1u); break; } } } } while (0)

struct XcdBarrier { unsigned* bar; unsigned x; volatile LAS unsigned* st; };

__device__ __forceinline__ XcdBarrier xcd_barrier_post(unsigned* bar, volatile LAS unsigned* st) {
    XcdBarrier b; b.bar = bar; b.x = xb_xcc_id(); b.st = st;
    if (threadIdx.x == 0) (void)xb_add(&bar[XB_XCNT(b.x)], 1u);
    return b;
}
__device__ __forceinline__ void xcd_barrier_complete(unsigned* bar, unsigned x, unsigned& nloc, unsigned& nx) {
    const unsigned G = gridDim.x * gridDim.y * gridDim.z;
    unsigned sum, cnt, mine, sp = 0u;
    for (;;) {
        sum = 0u; cnt = 0u; mine = 0u;
#pragma unroll
        for (unsigned j = 0; j < 16; ++j) { const unsigned c = xb_ld(&bar[XB_XCNT(j)]); sum += c; cnt += (c > 0u) ? 1u : 0u; mine = (j == x) ? c : mine; }
        if (sum == G) break;
        __builtin_amdgcn_s_sleep(1);
        if ((++sp & 255u) == 0u) { if (xb_ld(&bar[XB_TMO])) break; if (sp > XB_SPIN_CAP) { atomicAdd(&bar[XB_TMO], 1u); break; } }
    }
    nloc = mine > 0u ? mine : 1u; nx = cnt > 0u ? cnt : 1u;
}
__device__ __forceinline__ void xcd_barrier(const XcdBarrier& b) {
    asm volatile("s_waitcnt vmcnt(0)" ::: "memory");
    __syncthreads();
    if (threadIdx.x == 0) {
        unsigned* bar = b.bar;
        __builtin_amdgcn_s_waitcnt(0);
        unsigned nloc = b.st[0], nx = b.st[1];
        if (nloc == 0u) { xcd_barrier_complete(bar, b.x, nloc, nx); b.st[0] = nloc; b.st[1] = nx; }
        const unsigned old = xb_add(&bar[XB_XSUB(b.x)], 1u);
        const unsigned gen = old / nloc;
        if (old + 1u == (gen + 1u) * nloc) {
            __builtin_amdgcn_fence(__ATOMIC_RELEASE, "agent");
            asm volatile("s_waitcnt vmcnt(0)" ::: "memory");
            const unsigned og = xb_add(&bar[XB_TOP], 1u);
            const unsigned tg = og / nx;
            if (og + 1u == (tg + 1u) * nx) xb_add(&bar[XB_TOPGEN], 1u);
            else XB_SPIN(xb_ld(&bar[XB_TOPGEN]) == tg, bar);
            __builtin_amdgcn_fence(__ATOMIC_ACQUIRE, "agent");
            xb_add(&bar[XB_XGEN(b.x)], 1u);
            asm volatile("s_waitcnt vmcnt(0)" ::: "memory");
        } else {
            XB_SPIN(xb_ld(&bar[XB_XGEN(b.x)]) == gen, bar);
            __builtin_amdgcn_fence(__ATOMIC_ACQUIRE, "agent");
            asm volatile("s_waitcnt vmcnt(0)" ::: "memory");
        }
    }
    __syncthreads();
}

DEVI u16 f2bf(float f) { u32 u = __float_as_uint(f); u += 0x7fffu + ((u >> 16) & 1u); return (u16)(u >> 16); }
DEVI float bf2f(u32 h) { return __uint_as_float(h << 16); }
DEVI u32 cvtpk(float lo, float hi) { u32 r; asm("v_cvt_pk_bf16_f32 %0, %1, %2" : "=v"(r) : "v"(lo), "v"(hi)); return r; }
DEVI float bflo(u32 w) { return __uint_as_float(w << 16); }
DEVI float bfhi(u32 w) { return __uint_as_float(w & 0xffff0000u); }
DEVI int crow(int r, int hi) { return (r & 3) + 8 * (r >> 2) + 4 * hi; }
DEVI float wave_sum(float v) { for (int o = 32; o; o >>= 1) v += __shfl_xor(v, o); return v; }
DEVI float wave_max(float v) { for (int o = 32; o; o >>= 1) v = fmaxf(v, __shfl_xor(v, o)); return v; }
DEVI float sigmoidf_(float x) { return 1.f / (1.f + __expf(-x)); }
DEVI float siluf_(float x) { return x / (1.f + __expf(-x)); }
DEVI float logsigmoidf_(float x) { return fminf(x, 0.f) - log1pf(__expf(-fabsf(x))); }
#define SBAR() __builtin_amdgcn_sched_barrier(0)

DEVI void sincos2pi(double frac, double& s, double& c) {
    frac -= floor(frac);
    double q = rint(frac * 4.0);
    double r = (frac - q * 0.25) * 6.283185307179586476925;
    double r2 = r * r;
    double sr = r * (1.0 + r2 * (-1.0 / 6 + r2 * (1.0 / 120 + r2 * (-1.0 / 5040 + r2 * (1.0 / 362880 + r2 * (-1.0 / 39916800 + r2 * (1.0 / 6227020800.0 + r2 * (-1.0 / 1307674368000.0))))))));
    double cr = 1.0 + r2 * (-0.5 + r2 * (1.0 / 24 + r2 * (-1.0 / 720 + r2 * (1.0 / 40320 + r2 * (-1.0 / 3628800 + r2 * (1.0 / 479001600.0 + r2 * (-1.0 / 87178291200.0 + r2 * (1.0 / 20922789888000.0))))))));
    int qi = ((int)q) & 3;
    if (qi == 0) { s = sr; c = cr; } else if (qi == 1) { s = cr; c = -sr; } else if (qi == 2) { s = -sr; c = -cr; } else { s = -cr; c = sr; }
}

DEVI float* xs_ptr(const P& p, int layer, int tok) {
    if (layer == 0) {
        int b = tok >= TT ? 1 : 0, t = tok - b * TT;
        if (t < TC) return (float*)(p.ws + OFF_XC) + (size_t)(b * TC + t) * DM;
        return p.out + (size_t)(b * TL + t - TC) * DM;
    }
    return p.out + (size_t)tok * DM;
}
DEVI const float* xin_ptr(const P& p, int tok) {
    int b = tok >= TT ? 1 : 0, t = tok - b * TT;
    if (t < TC) return p.ctx + (size_t)(b * TC + t) * DM;
    return p.x + (size_t)(b * TL + t - TC) * DM;
}
DEVI int modsel(int layer, int tok) {
    if (layer == 0) { int b = tok >= TT ? 1 : 0, t = tok - b * TT; return t < TC ? 2 : b; }
    return tok >> 14;
}

DEVI int swz128(int row, int chunk) { return row * 144 + (chunk << 4); }
DEVI int swz256(int row, int chunk) { return row * 272 + (chunk << 4); }
DEVI int v_st(int k, int c) { const int kk = (k & ~0xC) | ((k & 4) << 1) | ((k & 8) >> 1); return ((kk >> 3) * 4 + (c >> 5)) * 512 + ((kk & 7) * 32 + (c & 31)) * 2; }
DEVI int v_rd_base(int lane) { return ((lane & 3) << 3) | (((lane >> 2) & 3) << 6) | (((lane >> 4) & 1) << 5) | (((lane >> 5) & 1) << 8); }
constexpr int v_rd_off(int d0, int ks, int half) { return d0 * 512 + ks * 4096 + half * 2048; }
template <int OFF> DEVI s16x4 tr_read(int vb) {
    s16x4 r; asm volatile("ds_read_b64_tr_b16 %0, %1 offset:%2" : "=&v"(r) : "v"(vb), "i"(OFF) : "memory"); return r;
}
#define PKLH(L, H) (bf16x8){L[0], L[1], L[2], L[3], H[0], H[1], H[2], H[3]}
template <int D0, int KS> DEVI void tr_frag_issue(int vb, s16x4& l, s16x4& h) { l = tr_read<v_rd_off(D0, KS, 0)>(vb); h = tr_read<v_rd_off(D0, KS, 1)>(vb); }
#define LGKM0() do { asm volatile("s_waitcnt lgkmcnt(0)" ::: "memory"); SBAR(); } while (0)

DEVI bf16x8 lds_b128(const char* base, int off) { return *reinterpret_cast<const bf16x8*>(base + off); }

DEVI void pack_p(const f32x16& pp, bf16x8& f0, bf16x8& f1) {
#define PK4(BASE, OUT) do { unsigned a0 = cvtpk(pp[BASE + 0], pp[BASE + 1]), a1 = cvtpk(pp[BASE + 2], pp[BASE + 3]);   \
    unsigned b0 = cvtpk(pp[BASE + 4], pp[BASE + 5]), b1 = cvtpk(pp[BASE + 6], pp[BASE + 7]);                            \
    auto r0 = __builtin_amdgcn_permlane32_swap(a0, b0, false, false); auto r1 = __builtin_amdgcn_permlane32_swap(a1, b1, false, false); \
    u32x4 w = {r0[0], r1[0], r0[1], r1[1]}; OUT = *reinterpret_cast<bf16x8*>(&w); } while (0)
    PK4(0, f0); PK4(8, f1);
#undef PK4
}

namespace g8 {
constexpr int BM = 256, BK = 64, HALF = 128, HTB = HALF * BK * 2, STAGE_BYTES = 8 * HTB, NXCD = 8, WGM = 8;
DEVI int lds_byte(int r, int c) { const int st = (r >> 4) * 2 + (c >> 5), rr = r & 15, cc = c & 31, ob = rr * 64 + cc * 2; return st * 1024 + (ob ^ (((ob >> 9) & 1) << 5)); }
DEVI void stage_rc(int b, int& R, int& C) { const int st = b / 1024, sb = b % 1024, swz = sb ^ (((sb >> 9) & 1) << 5); R = (st >> 1) * 16 + swz / 64; C = (st & 1) * 32 + (swz % 64) / 2; }
DEVI int perm32(int rho) { const int n = rho >> 4, i = rho & 15; return 8 * (i >> 2) + 4 * n + (i & 3); }
struct Unit { int pm, pn; const char* B0; const char* B1; int cls, r0, ncls; };
DEVI bool tile_order(int i, int G, int c, int nM, int nN, int& pm, int& pn) {
    const int nwg = nM * nN; const long L = (long)i * G + c; if (L >= nwg) return false;
    int wgid = (int)L; { const int q = nwg / NXCD, r = nwg % NXCD, xcd = wgid % NXCD, off = wgid / NXCD; wgid = (xcd < r ? xcd * (q + 1) : r * (q + 1) + (xcd - r) * q) + off; }
    const int nig = WGM * nN, gid = wgid / nig, fm = gid * WGM, gsz = (nM - fm) < WGM ? (nM - fm) : WGM;
    pm = fm + ((wgid % nig) % gsz); pn = (wgid % nig) / gsz; return true;
}
typedef float f32x4v __attribute__((ext_vector_type(4)));
template <class Epi, class Sched>
DEVI void gemm_phase(LAS unsigned char* lds, const char* Abase, int ldbB  , int ksplit  , const Sched& S, const Epi& E) {
    const int tid = threadIdx.x, wid = __builtin_amdgcn_readfirstlane(tid >> 6), lane = tid & 63, wr = wid >> 2, wc = wid & 3, fr = lane & 15, fq = lane >> 4;
    constexpr int nt = 1024 / BK;
    unsigned voffB[2];
#pragma unroll
    for (int i = 0; i < 2; ++i) { int R, C; stage_rc(tid * 16 + i * 8192, R, C); const int Rb = Epi::PERM ? ((R & ~31) + perm32(R & 31)) : R; voffB[i] = (unsigned)(Rb * ldbB + C * 2); }
    const size_t kstep = (size_t)(BK * 2);
    const size_t hstepB = (size_t)HALF * ldbB;
    const unsigned ldsw = (unsigned)wid * 1024u;
    const int aoff = lds_byte(wr * 64 + fr, fq * 8), boff = lds_byte(wc * 32 + fr, fq * 8);
#define G8_SA(b, h) (((b) * 2 + (h)) * HTB)
#define G8_SB(b, h) ((4 + (b) * 2 + (h)) * HTB)
#define G8_STAGE(bufoff, gbase, voff) do { _Pragma("unroll") for (int _i = 0; _i < 2; ++_i) \
        __builtin_amdgcn_global_load_lds((const unsigned*)((const char*)(gbase) + (voff)[_i]), (LAS unsigned*)(lds + (bufoff) + ldsw + _i * 8192), 16, 0, 0); } while (0)
#define G8_LDA(dst, b, h) do { _Pragma("unroll") for (int m = 0; m < 4; ++m) _Pragma("unroll") for (int k = 0; k < 2; ++k) dst[m][k] = *(const LAS bf16x8*)(lds + G8_SA(b, h) + aoff + m * 2048 + k * 1024); } while (0)
#define G8_LDB(dst, b, h) do { _Pragma("unroll") for (int n = 0; n < 2; ++n) _Pragma("unroll") for (int k = 0; k < 2; ++k) dst[n][k] = *(const LAS bf16x8*)(lds + G8_SB(b, h) + boff + n * 2048 + k * 1024); } while (0)
#define G8_MMA(ai, bj, At, Bt) do { __builtin_amdgcn_s_setprio(1); _Pragma("unroll") for (int m = 0; m < 4; ++m) _Pragma("unroll") for (int n = 0; n < 2; ++n) _Pragma("unroll") for (int k = 0; k < 2; ++k) \
        acc[ai][bj][m][n] = __builtin_amdgcn_mfma_f32_16x16x32_bf16(Bt[n][k], At[m][k], acc[ai][bj][m][n], 0, 0, 0); __builtin_amdgcn_s_setprio(0); } while (0)
#define G8_WAIT_V(n) asm volatile("s_waitcnt vmcnt(" #n ")" ::: "memory")
#define G8_WAIT_L(n) asm volatile("s_waitcnt lgkmcnt(" #n ")" ::: "memory")
#define G8_BAR __builtin_amdgcn_s_barrier()
#define G8_SCHED __builtin_amdgcn_sched_barrier(0)
#define G8_BPTR(u, kt) (((kt) < ksplit ? (u).B0 : (u).B1) + (size_t)(kt) * kstep)
    Unit cur, nxt; int ui = 0;
    if (!S.next(0, cur)) return;
    f32x4v acc[2][2][4][2];
#pragma unroll
    for (int a = 0; a < 2; ++a)
#pragma unroll
        for (int b = 0; b < 2; ++b)
#pragma unroll
            for (int m = 0; m < 4; ++m)
#pragma unroll
                for (int n = 0; n < 2; ++n) acc[a][b][m][n] = (f32x4v){0.f, 0.f, 0.f, 0.f};
    bf16x8 At[4][2], B0[2][2], B1[2][2];
    unsigned voffA[2]; unsigned vs[2][2];
    constexpr size_t hstepA = (size_t)HALF * 2048, tstepA = 2 * hstepA;
    if constexpr (Sched::GATHER) S.aoffs(cur, vs);
    else {
#pragma unroll
        for (int i = 0; i < 2; ++i) { int R, C; stage_rc(tid * 16 + i * 8192, R, C); voffA[i] = (unsigned)(R * 2048 + C * 2); }
    }
    const char* cA = Sched::GATHER ? Abase : Abase + (size_t)cur.pm * tstepA;
#define G8_STAGE_A(bufoff, ptr, h) do { if constexpr (Sched::GATHER) G8_STAGE(bufoff, ptr, vs[h]); else G8_STAGE(bufoff, (ptr) + (h) * hstepA, voffA); } while (0)
    { const char* cB = G8_BPTR(cur, 0); const char* cB1 = G8_BPTR(cur, 1);
      G8_STAGE(G8_SB(0, 0), cB, voffB); G8_STAGE_A(G8_SA(0, 0), cA, 0); G8_STAGE(G8_SB(0, 1), cB + hstepB, voffB); G8_STAGE_A(G8_SA(0, 1), cA, 1);
      if (wr == 1) G8_BAR;
      G8_WAIT_V(4); G8_BAR;
      G8_STAGE(G8_SB(1, 0), cB1, voffB); G8_STAGE_A(G8_SA(1, 0), cA + kstep, 0); G8_STAGE(G8_SB(1, 1), cB1 + hstepB, voffB);
      G8_WAIT_V(6); G8_BAR; }
    for (;;) {
        bool has_next = false; const char* nA = cA;
        for (int t = 0; t < nt; t += 2) {
            const bool last = (t == nt - 2);
            const char* a1 = cA + (size_t)(t + 1) * kstep;
            G8_LDB(B0, 0, 0); G8_SCHED; G8_LDA(At, 0, 0); G8_STAGE_A(G8_SA(1, 1), a1, 1);
            G8_WAIT_L(8); G8_BAR; G8_WAIT_L(0); G8_MMA(0, 0, At, B0); G8_BAR; G8_SCHED;
            if (last) {
                has_next = S.next(ui + 1, nxt);
                if (has_next) { if constexpr (Sched::GATHER) S.aoffs(nxt, vs); else nA = Abase + (size_t)nxt.pm * tstepA; } else nxt = cur;
            }
            const char* a2 = last ? nA : cA + (size_t)(t + 2) * kstep; const char* a3 = a2 + kstep;
            const char* b2 = last ? G8_BPTR(nxt, 0) : G8_BPTR(cur, t + 2); const char* b3 = last ? G8_BPTR(nxt, 1) : G8_BPTR(cur, t + 3);
            G8_LDB(B1, 0, 1); G8_STAGE(G8_SB(0, 0), b2, voffB);
            G8_BAR; G8_WAIT_L(0); G8_MMA(0, 1, At, B1); G8_BAR;
            G8_LDA(At, 0, 1); G8_STAGE_A(G8_SA(0, 0), a2, 0);
            G8_BAR; G8_WAIT_L(0); G8_MMA(1, 0, At, B0); G8_BAR; G8_SCHED;
            G8_STAGE(G8_SB(0, 1), b2 + hstepB, voffB);
            G8_WAIT_V(6); G8_BAR; G8_MMA(1, 1, At, B1); G8_BAR;
            G8_LDB(B0, 1, 0); G8_SCHED; G8_LDA(At, 1, 0); G8_STAGE_A(G8_SA(0, 1), a2, 1);
            G8_WAIT_L(8); G8_BAR; G8_WAIT_L(0); G8_MMA(0, 0, At, B0); G8_BAR; G8_SCHED;
            G8_LDB(B1, 1, 1); G8_STAGE(G8_SB(1, 0), b3, voffB);
            G8_BAR; G8_WAIT_L(0); G8_MMA(0, 1, At, B1); G8_BAR;
            G8_LDA(At, 1, 1); G8_STAGE_A(G8_SA(1, 0), a3, 0);
            G8_BAR; G8_WAIT_L(0); G8_MMA(1, 0, At, B0); G8_BAR; G8_SCHED;
            G8_STAGE(G8_SB(1, 1), b3 + hstepB, voffB);
            G8_WAIT_V(6); G8_BAR; G8_MMA(1, 1, At, B1); G8_BAR;
        }
        cA = nA;
        { int tz = threadIdx.x; asm volatile("" : "+v"(tz));
          const int w2 = tz >> 6, l2 = tz & 63; E(acc, cur, w2 >> 2, w2 & 3, l2 & 15, l2 >> 4); }
        if (!has_next) break;
#pragma unroll
        for (int a = 0; a < 2; ++a)
#pragma unroll
            for (int b = 0; b < 2; ++b)
#pragma unroll
                for (int m = 0; m < 4; ++m)
#pragma unroll
                    for (int n = 0; n < 2; ++n) acc[a][b][m][n] = (f32x4v){0.f, 0.f, 0.f, 0.f};
        cur = nxt; ++ui;
    }
    G8_WAIT_V(0);
    if (wr == 0) G8_BAR;
    G8_BAR;
#undef G8_SA
#undef G8_SB
#undef G8_STAGE
#undef G8_STAGE_A
#undef G8_LDA
#undef G8_LDB
#undef G8_MMA
#undef G8_WAIT_V
#undef G8_WAIT_L
#undef G8_BAR
#undef G8_SCHED
#undef G8_BPTR
}
DEVI void lane_rc(int i, int& R, int& C) { int tz = threadIdx.x; asm volatile("" : "+v"(tz)); stage_rc(tz * 16 + i * 8192, R, C); }
struct DenseSched {
    static constexpr bool GATHER = false;
    const char* Bt; int nM, nN, G, c; size_t btile;
    DEVI bool next(int i, Unit& u) const { if (!tile_order(i, G, c, nM, nN, u.pm, u.pn)) return false; u.B0 = u.B1 = Bt + (size_t)u.pn * btile; u.cls = 0; u.r0 = 0; u.ncls = 0; return true; }
    DEVI void aoffs(const Unit& u, unsigned (&v)[2][2]) const {
#pragma unroll
        for (int i = 0; i < 2; ++i) { int R, C; lane_rc(i, R, C);
#pragma unroll
            for (int h = 0; h < 2; ++h) v[h][i] = (unsigned)(((u.pm * 256 + h * 128 + R) * 1024 + C) * 2); }
    }
};
}

template <class PF>
DEVI void transpose_tile(PF colptr, int ldsrc, u16* dst, int lddst, int k0, int n0, float* tl) {
    const int t = threadIdx.x, nn = t & 63, kk = t >> 6;
    const float* sp = colptr(n0 + nn);
#pragma unroll
    for (int i = 0; i < 8; ++i) tl[(kk + 8 * i) * 65 + nn] = sp[(size_t)(k0 + kk + 8 * i) * ldsrc];
    __syncthreads();
    const int n = t >> 3, kc = t & 7;
    u32x4 w;
    w[0] = cvtpk(tl[(kc * 8 + 0) * 65 + n], tl[(kc * 8 + 1) * 65 + n]);
    w[1] = cvtpk(tl[(kc * 8 + 2) * 65 + n], tl[(kc * 8 + 3) * 65 + n]);
    w[2] = cvtpk(tl[(kc * 8 + 4) * 65 + n], tl[(kc * 8 + 5) * 65 + n]);
    w[3] = cvtpk(tl[(kc * 8 + 6) * 65 + n], tl[(kc * 8 + 7) * 65 + n]);
    *reinterpret_cast<u32x4*>(dst + (size_t)(n0 + n) * lddst + k0 + kc * 8) = w;
    __syncthreads();
}

DEVI void convert_expert_item(const P& p, int layer, int it, float* tl) {
    const int e = it / 384, r = it % 384;
    const float* wg = p.w_gate + ((size_t)layer * 16 + e) * 1024 * 512;
    const float* wu = p.w_up   + ((size_t)layer * 16 + e) * 1024 * 512;
    const float* wd = p.w_down + ((size_t)layer * 16 + e) * 512 * 1024;
    if (r < 256) {
        u16* dst = (u16*)(p.ws + OFF_WGU) + (size_t)e * 1024 * 1024;
        const int kt = r >> 4, nt = r & 15;
        transpose_tile([&](int n) { const int q = n >> 3, sgu = (n >> 2) & 1, j = n & 3; return (sgu ? wu : wg) + q * 4 + j; }, 512, dst, 1024, kt * 64, nt * 64, tl);
    } else {
        const int q = r - 256; u16* dst = (u16*)(p.ws + OFF_WDT) + (size_t)e * 1024 * 512;
        const int kt = q >> 4, nt = q & 15;
        transpose_tile([&](int n) { return wd + n; }, 1024, dst, 512, kt * 64, nt * 64, tl);
    }
}

constexpr int N0_WIN = 16 * 56, N0_WOUT = 256, N0_EXP = 16 * 384, N0_FN = 1024, N0_MOD = 192, N0_TAB = 128;
constexpr int N0_TOTAL = N0_WIN + N0_MOD + N0_TAB;
constexpr int NBG = N0_WOUT + N0_EXP + N0_FN;
DEVI void bg_item(const P& p, int it, float* tl) {
    const int tid = threadIdx.x;
    int r = it;
    if (r < N0_WOUT) {
        const int kt = r >> 4, nt = r & 15; const float* w = p.w_out;
        transpose_tile([&](int n) { return w + n; }, 1024, (u16*)(p.ws + OFF_WOUTT), 1024, kt * 64, nt * 64, tl);
        return;
    }
    r -= N0_WOUT;
    if (r < N0_EXP) { convert_expert_item(p, 0, r, tl); return; }
    r -= N0_EXP;
    {
        const int idx = r * 512 + tid, c = idx & 127, g = (idx >> 7) & 3, n = idx >> 9;
        double sd, cd; sincos2pi(c / 256.0, sd, cd);
        const float ct = (float)cd, st = (float)sd;
        const float* W = p.w_fnet + (size_t)(g * 256) * 1024 + n;
        float ac = 0.f, as = 0.f, a128 = 0.f, cr = 1.f, sr = 0.f, sg = 1.f;
        for (int c2 = 0; c2 < 256; ++c2) {
            const float w = W[(size_t)c2 * 1024];
            ac = fmaf(cr, w, ac); as = fmaf(sr, w, as); a128 = fmaf(sg, w, a128); sg = -sg;
            const float cn = cr * ct - sr * st; sr = fmaf(sr, ct, cr * st); cr = cn;
        }
        u16* F = (u16*)(p.ws + OFF_FNT);
        const size_t o0 = (size_t)n * 1024 + g * 256, o1 = (size_t)(1024 + n) * 1024 + g * 256;
        F[o0 + c] = f2bf(ac * (1.f / 2048.f)); F[o1 + c] = f2bf(-as * (1.f / 2048.f));
        if (c > 0) { F[o0 + 256 - c] = f2bf(ac * (1.f / 2048.f)); F[o1 + 256 - c] = f2bf(as * (1.f / 2048.f)); }
        else { F[o0 + 128] = f2bf(a128 * (1.f / 2048.f)); F[o1 + 128] = f2bf(0.f); }
    }
}
DEVI void bg_fill(const P& p, char* lds, int q, int lo, int hi) {
    int* sh = (int*)(lds + 32768);
    for (;;) {
        __syncthreads();
        if (threadIdx.x == 0) *sh = lo + 4 * (int)atomicAdd((unsigned*)(p.ws + OFF_CNT) + 160 + q, 1u);
        __syncthreads();
        const int it0 = *sh;
        if (it0 >= hi) break;
        for (int it = it0; it < it0 + 4 && it < hi; ++it) bg_item(p, it, (float*)lds);
    }
    __syncthreads();
}

DEVI void phase_prologue(const P& p, char* lds) {
    float* tl = (float*)lds;
    const int tid = threadIdx.x;
    for (int it = blockIdx.x; it < NBG; it += gridDim.x) bg_item(p, it, tl);
    for (int it = blockIdx.x; it < N0_TOTAL; it += gridDim.x) {
        int r = it;
        if (r < N0_WIN) {
            const int kt = r / 56, nt = r % 56;
            const float* w = p.w_in;
            transpose_tile([&](int n) { return w + n; },
                           3600, (u16*)(p.ws + OFF_WINT), 1024, kt * 64, nt * 64, tl);
            continue;
        }
        r -= N0_WIN;
        if (r < N0_MOD) {
            float* sv = tl;
            float* part = tl + 3072;
            for (int i = tid; i < 3072; i += NTHR) { const int v = i >> 10, k = i & 1023; const float xv = v < 2 ? p.c[v * 1024 + k] : p.c_ctx[k]; sv[i] = siluf_(xv); }
            __syncthreads();
            const int j0 = r * 64, L = j0 / 6144, col0 = j0 % 6144, kg = tid >> 6, cl = tid & 63;
            const float* W = p.ada_w + (size_t)L * 1024 * 6144 + col0 + cl;
            float a0 = 0.f, a1 = 0.f, a2 = 0.f;
            for (int k = kg * 128; k < kg * 128 + 128; ++k) { const float w = W[(size_t)k * 6144]; a0 = fmaf(sv[k], w, a0); a1 = fmaf(sv[1024 + k], w, a1); a2 = fmaf(sv[2048 + k], w, a2); }
            part[(kg * 3 + 0) * 64 + cl] = a0; part[(kg * 3 + 1) * 64 + cl] = a1; part[(kg * 3 + 2) * 64 + cl] = a2;
            __syncthreads();
            if (tid < 192) {
                const int v = tid >> 6, c2 = tid & 63; float s = 0.f;
                for (int g = 0; g < 8; ++g) s += part[(g * 3 + v) * 64 + c2];
                ((float*)(p.ws + OFF_MOD))[(size_t)(L * 3 + v) * 6144 + col0 + c2] = s + p.ada_b[L * 6144 + col0 + c2];
            }
            __syncthreads();
            continue;
        }
        r -= N0_MOD;
        {
            const int e = r * 512 + tid;
            if (e < 4096 + 1024) {
                const bool isr = e < 4096; const int ee = isr ? e : e - 4096; const int pos = ee >> 4, j = ee & 15;
                double inv = 1.0; for (int q = 0; q < j; ++q) inv *= 0.56234132519034908;
                const float invf = (float)inv; const float ang = (float)pos * invf;
                double s, c; sincos2pi((double)ang * 0.15915494309189533577, s, c);
                float2 v = make_float2((float)c, (float)s);
                if (isr) ((float2*)(p.ws + OFF_ROPER))[ee] = v; else ((float2*)(p.ws + OFF_ROPEC))[ee] = v;
            } else if (e < 5120 + 16384) {
                const int m = e - 5120; double s, c; sincos2pi(m / 16384.0, s, c);
                ((float2*)(p.ws + OFF_TW))[m] = make_float2((float)c, (float)s);
            } else if (e < 5120 + 32768) {
                const int m = e - 5120 - 16384, k = m >> 7, t = m & 127; double s, c; sincos2pi(((k * t) & 127) / 128.0, s, c);
                ((u16*)(p.ws + OFF_DFTC))[m] = f2bf((float)c); ((u16*)(p.ws + OFF_DFTS))[m] = f2bf((float)s);
            } else if (e < 5120 + 49152) {
                const int m = e - 5120 - 32768, k = m >> 4, g = m & 15;
                ((float*)(p.ws + OFF_WG16))[m] = p.w_in[(size_t)k * 3600 + 3584 + g];
            } else if (e == 5120 + 49152) {
                float s01 = 0.f, s23 = 0.f;
                for (int i = 0; i < 64; ++i) { s01 += p.lamv[i] * p.lamv[64 + i]; s23 += p.lamv[128 + i] * p.lamv[192 + i]; }
                ((float*)(p.ws + OFF_LAM))[0] = expf(s01) - expf(s23) + 0.2f;
            }
        }
    }
}

template <int MODE, bool DRY = false>
DEVI void phase_norm(const P& p, char* lds) {
    constexpr int layer = (MODE == 0 || MODE == 1) ? 0 : 1;
    constexpr bool side = (MODE == 0 || MODE == 1 || MODE == 3);
    const int nrows = layer == 0 ? NTOK : NLAT;
    const int tid = threadIdx.x, lane = tid & 63, wid = tid >> 6;
    f32x4* sl = (f32x4*)lds;
    if (side) {
        const float* S = (MODE == 0) ? (const float*)(p.ws + OFF_WG16) : p.router_w;
        for (int i = tid; i < 4096; i += NTHR) { const int eg = i >> 10, col = i & 1023; const int pc = (col >> 8) * 256 + (col & 3) * 64 + ((col >> 2) & 63);
            sl[eg * 1024 + pc] = *reinterpret_cast<const f32x4*>(S + col * 16 + eg * 4); }
        __syncthreads();
    }
    const float* g = MODE == 0 ? p.nmix_g : MODE == 1 ? p.nffn_g : MODE == 2 ? p.nmix_g + 1024 : MODE == 3 ? p.nffn_g + 1024 : p.final_g;
    const float* modb = (const float*)(p.ws + OFF_MOD) + (size_t)layer * 3 * 6144;
    constexpr int sh_i = (MODE == 0 || MODE == 2) ? 0 : 3;
    u16* act = (u16*)(p.ws + OFF_ACT);
    int npend = 0, pcls = 0, prow = 0; float pwl = 0.f, pwh = 0.f; float keep[16];
#pragma unroll
    for (int e = 0; e < 16; ++e) keep[e] = 0.f;
    const int c0 = 4 * lane;
    f32x4 xn[4];
    { const int row0 = blockIdx.x * 8 + wid;
      if (row0 < nrows) { const float* src = (MODE == 0) ? xin_ptr(p, row0) : xs_ptr(p, layer, row0);
#pragma unroll
          for (int i = 0; i < 4; ++i) xn[i] = *reinterpret_cast<const f32x4*>(src + c0 + 256 * i); } }
    for (int row = blockIdx.x * 8 + wid; row < nrows; row += gridDim.x * 8) {
        f32x4 xv[4]; float ss = 0.f;
#pragma unroll
        for (int i = 0; i < 4; ++i) xv[i] = xn[i];
        { const int nrow = row + gridDim.x * 8;
          if (nrow < nrows) { const float* src = (MODE == 0) ? xin_ptr(p, nrow) : xs_ptr(p, layer, nrow);
#pragma unroll
              for (int i = 0; i < 4; ++i) xn[i] = *reinterpret_cast<const f32x4*>(src + c0 + 256 * i); } }
#pragma unroll
        for (int i = 0; i < 4; ++i) { ss = fmaf(xv[i][0], xv[i][0], ss); ss = fmaf(xv[i][1], xv[i][1], ss); ss = fmaf(xv[i][2], xv[i][2], ss); ss = fmaf(xv[i][3], xv[i][3], ss); }
        ss = wave_sum(ss);
        const float rstd = rsqrtf(ss * (1.f / 1024.f) + 1e-6f);
        if (MODE == 4) {
            float* dst = p.out + (size_t)row * DM;
#pragma unroll
            for (int i = 0; i < 4; ++i) { const f32x4 gv = *reinterpret_cast<const f32x4*>(g + c0 + 256 * i); *reinterpret_cast<f32x4*>(dst + c0 + 256 * i) = xv[i] * rstd * gv; }
            continue;
        }
        const float* mv = modb + (size_t)modsel(layer, row) * 6144;
        float acc[16];
#pragma unroll
        for (int e = 0; e < 16; ++e) acc[e] = 0.f;
#pragma unroll
        for (int i = 0; i < 4; ++i) {
            const f32x4 gv = *reinterpret_cast<const f32x4*>(g + c0 + 256 * i), scv = *reinterpret_cast<const f32x4*>(mv + (sh_i + 1) * 1024 + c0 + 256 * i),
                        shv = *reinterpret_cast<const f32x4*>(mv + sh_i * 1024 + c0 + 256 * i);
            f32x4 h;
#pragma unroll
            for (int j = 0; j < 4; ++j) h[j] = xv[i][j] * rstd * gv[j] * (1.f + scv[j]) + shv[j];
            u32x2 w2; w2[0] = cvtpk(h[0], h[1]); w2[1] = cvtpk(h[2], h[3]);
            *reinterpret_cast<u32x2*>(act + (size_t)row * DM + c0 + 256 * i) = w2;
            if (side) {
#pragma unroll
                for (int j = 0; j < 4; ++j) {
#pragma unroll
                    for (int eg = 0; eg < 4; ++eg) { const f32x4 w = sl[eg * 1024 + i * 256 + j * 64 + lane]; acc[eg * 4 + 0] = fmaf(h[j], w[0], acc[eg * 4 + 0]); acc[eg * 4 + 1] = fmaf(h[j], w[1], acc[eg * 4 + 1]);
                        acc[eg * 4 + 2] = fmaf(h[j], w[2], acc[eg * 4 + 2]); acc[eg * 4 + 3] = fmaf(h[j], w[3], acc[eg * 4 + 3]); }
                    if (j & 1) asm volatile("" ::: "memory");
                }
            }
        }
        if (side) {
            float r8[8], r4[4], r2[2], tot;
            { const bool up = lane & 32;
#pragma unroll
              for (int i = 0; i < 8; ++i) { const float snd = up ? acc[i] : acc[i + 8], kp = up ? acc[i + 8] : acc[i]; r8[i] = kp + __shfl_xor(snd, 32); } }
            { const bool up = lane & 16;
#pragma unroll
              for (int i = 0; i < 4; ++i) { const float snd = up ? r8[i] : r8[i + 4], kp = up ? r8[i + 4] : r8[i]; r4[i] = kp + __shfl_xor(snd, 16); } }
            { const bool up = lane & 8;
#pragma unroll
              for (int i = 0; i < 2; ++i) { const float snd = up ? r4[i] : r4[i + 2], kp = up ? r4[i + 2] : r4[i]; r2[i] = kp + __shfl_xor(snd, 8); } }
            { const bool up = lane & 4; const float snd = up ? r2[0] : r2[1], kp = up ? r2[1] : r2[0]; tot = kp + __shfl_xor(snd, 4); }
            tot += __shfl_xor(tot, 1); tot += __shfl_xor(tot, 2);
            if (MODE == 0) {
                if ((lane & 3) == 0) {
                    const int e = lane >> 2;
                    float v = tot + p.gate_b[e];
                    const int type = e >> 2;
                    if (type == 1 || type == 3) v = logsigmoidf_(v);
                    ((float*)(p.ws + OFF_GATES))[(size_t)row * 16 + e] = v;
                }
            } else {
#pragma unroll
                for (int e = 0; e < 16; ++e) { const float te = __uint_as_float(__builtin_amdgcn_readlane(__float_as_uint(tot), e << 2)); keep[e] = (lane == npend) ? te : keep[e]; }
                if (lane == npend) prow = row;
                ++npend;
            }
        }
    }
    if (MODE == 1 || MODE == 3) {
        {
            float aff[16], bi[16];
#pragma unroll
            for (int e = 0; e < 16; ++e) { aff[e] = sigmoidf_(keep[e]); bi[e] = aff[e] + p.router_b[e]; }
            int bg = 0, ba = 0, bb = 1; float bscore = -1e30f;
#pragma unroll
            for (int gq = 0; gq < 4; ++gq) {
                int ia = 0; float va = bi[gq * 4];
#pragma unroll
                for (int j = 1; j < 4; ++j) if (bi[gq * 4 + j] > va) { va = bi[gq * 4 + j]; ia = j; }
                int ib = -1; float vb = -1e30f;
#pragma unroll
                for (int j = 0; j < 4; ++j) if (j != ia && bi[gq * 4 + j] > vb) { vb = bi[gq * 4 + j]; ib = j; }
                const float sc = va + vb;
                if (sc > bscore) { bscore = sc; bg = gq; ba = ia; bb = ib; }
            }
            const int lo = ba < bb ? ba : bb, hi2 = ba < bb ? bb : ba;
            float alo = 0.f, ahi = 0.f;
#pragma unroll
            for (int e = 0; e < 16; ++e) { if (e == bg * 4 + lo) alo = aff[e]; if (e == bg * 4 + hi2) ahi = aff[e]; }
            const float inv = 1.f / (alo + ahi);
            const int pair = lo == 0 ? hi2 - 1 : (lo == 1 ? hi2 + 1 : 5);
            pcls = bg * 6 + pair; pwl = alo * inv; pwh = ahi * inv;
        }
        unsigned* lc = (unsigned*)(lds + 65536);
        __syncthreads();
        if (tid < 64) lc[tid] = 0u;
        __syncthreads();
        unsigned myrank = 0u;
        if (lane < npend) myrank = atomicAdd(&lc[pcls], 1u);
        __syncthreads();
        if (tid < 24) { unsigned* cnt = (unsigned*)(p.ws + OFF_CNT) + (DRY ? 2 : layer) * 32; const unsigned n = lc[tid]; lc[32 + tid] = n ? atomicAdd(&cnt[tid], n) : 0u; }
        __syncthreads();
        if (lane < npend) {
            ((int*)(p.ws + (DRY ? OFF_BIG : OFF_LIST)))[(size_t)pcls * NTOK + lc[32 + pcls] + myrank] = prow;
            ((float2*)(p.ws + (DRY ? OFF_BIG + (size_t)32 * NTOK * 4 : OFF_TOKW)))[prow] = make_float2(pwl, pwh);
        }
    }
}

using g8::f32x4v;
DEVI u32x4 pack8(const f32x4v& a, const f32x4v& b) { u32x4 w; w[0] = cvtpk(a[0], a[1]); w[1] = cvtpk(a[2], a[3]); w[2] = cvtpk(b[0], b[1]); w[3] = cvtpk(b[2], b[3]); return w; }

struct EpiInproj {
    static constexpr bool PERM = true;
    char* ws;
    DEVI void operator()(const f32x4v (&acc)[2][2][4][2], const g8::Unit& u, int wr, int wc, int fr, int fq) const {
        u16* dst; int ld, coff, kind;
        const int pn = u.pn;
        if (pn < 2)       { dst = (u16*)(ws + OFF_Q);    ld = 512;  coff = pn * 256;        kind = 1; }
        else if (pn < 4)  { dst = (u16*)(ws + OFF_K);    ld = 512;  coff = (pn - 2) * 256;  kind = 1; }
        else if (pn < 6)  { dst = (u16*)(ws + OFF_V);    ld = 512;  coff = (pn - 4) * 256;  kind = 0; }
        else if (pn < 10) { dst = (u16*)(ws + OFF_MLQK); ld = 1024; coff = (pn - 6) * 256;  kind = 0; }
        else if (pn < 12) { dst = (u16*)(ws + OFF_MLV);  ld = 512;  coff = (pn - 10) * 256; kind = 0; }
        else              { dst = (u16*)(ws + OFF_OG);   ld = 512;  coff = (pn - 12) * 256; kind = 2; }
        const int tb = u.pm % 65;
        const float2* tabR = (const float2*)(ws + OFF_ROPER); const float2* tabC = (const float2*)(ws + OFF_ROPEC);
#pragma unroll
        for (int ai = 0; ai < 2; ++ai)
#pragma unroll
            for (int m = 0; m < 4; ++m) {
                const int rl = ai * 128 + wr * 64 + m * 16 + fr;
                u16* rowp = dst + (size_t)(u.pm * 256 + rl) * ld + coff + wc * 32 + 8 * fq;
#pragma unroll
                for (int bj = 0; bj < 2; ++bj) {
                    f32x4v v0 = acc[ai][bj][m][0], v1 = acc[ai][bj][m][1];
                    if (kind == 1 && tb > 0) {
                        const int tl = (tb - 1) * 256 + rl;
                        const int p0 = ((wc * 32 + 8 * fq) & 63) >> 1;
                        const float* cs = (const float*)(p0 < 16 ? tabR + (tl >> 6) * 16 + p0 : tabC + (tl & 63) * 16 + (p0 - 16));
                        const f32x4v c01 = *reinterpret_cast<const f32x4v*>(cs), c23 = *reinterpret_cast<const f32x4v*>(cs + 4);
                        const f32x4v a = v0, b = v1;
                        v0[0] = a[0] * c01[0] - a[1] * c01[1]; v0[1] = a[0] * c01[1] + a[1] * c01[0];
                        v0[2] = a[2] * c01[2] - a[3] * c01[3]; v0[3] = a[2] * c01[3] + a[3] * c01[2];
                        v1[0] = b[0] * c23[0] - b[1] * c23[1]; v1[1] = b[0] * c23[1] + b[1] * c23[0];
                        v1[2] = b[2] * c23[2] - b[3] * c23[3]; v1[3] = b[2] * c23[3] + b[3] * c23[2];
                    } else if (kind == 2) {
#pragma unroll
                        for (int j = 0; j < 4; ++j) { v0[j] = sigmoidf_(v0[j]); v1[j] = sigmoidf_(v1[j]); }
                    }
                    *reinterpret_cast<u32x4*>(rowp + bj * 128) = pack8(v0, v1);
                }
            }
    }
};
DEVI void phase_inproj(const P& p, char* lds) {
    __syncthreads();
    g8::DenseSched S{p.ws + OFF_WINT, NTOK / 256, 14, (int)gridDim.x, (int)blockIdx.x, (size_t)256 * 2048};
    EpiInproj E{p.ws};
    g8::gemm_phase((LAS unsigned char*)lds, p.ws + OFF_ACT, 2048, 16, S, E);
}

struct EpiOutproj {
    static constexpr bool PERM = false;
    const float* xin_lat; const float* xin_ctx; float* xs_lat; float* xs_ctx; const float* modb;
    DEVI void operator()(const f32x4v (&acc)[2][2][4][2], const g8::Unit& u, int wr, int wc, int fr, int fq) const {
        const int b = u.pm / 65, tb = u.pm % 65;
        const float* xi = tb == 0 ? xin_ctx + (size_t)(b * TC) * DM : xin_lat + (size_t)(b * TL + (tb - 1) * 256) * DM;
        float* xo = tb == 0 ? xs_ctx + (size_t)(b * TC) * DM : xs_lat + (size_t)(b * TL + (tb - 1) * 256) * DM;
        const float* gate = modb + (size_t)(tb == 0 ? 2 : b) * 6144 + 2 * 1024;
        const int col0 = u.pn * 256 + wc * 32 + 4 * fq;
        f32x4v gv[2][2];
#pragma unroll
        for (int bj = 0; bj < 2; ++bj)
#pragma unroll
            for (int n = 0; n < 2; ++n) gv[bj][n] = *reinterpret_cast<const f32x4v*>(gate + col0 + bj * 128 + n * 16);
#pragma unroll
        for (int ai = 0; ai < 2; ++ai) {
            f32x4v xv[4][2][2];
#pragma unroll
            for (int m = 0; m < 4; ++m) { const size_t ro = (size_t)(ai * 128 + wr * 64 + m * 16 + fr) * DM + col0;
#pragma unroll
                for (int bj = 0; bj < 2; ++bj)
#pragma unroll
                    for (int n = 0; n < 2; ++n) xv[m][bj][n] = *reinterpret_cast<const f32x4v*>(xi + ro + bj * 128 + n * 16); }
#pragma unroll
            for (int m = 0; m < 4; ++m) { const size_t ro = (size_t)(ai * 128 + wr * 64 + m * 16 + fr) * DM + col0;
#pragma unroll
                for (int bj = 0; bj < 2; ++bj)
#pragma unroll
                    for (int n = 0; n < 2; ++n) *reinterpret_cast<f32x4v*>(xo + ro + bj * 128 + n * 16) = xv[m][bj][n] + gv[bj][n] * acc[ai][bj][m][n]; }
        }
    }
};
DEVI void phase_outproj(const P& p, char* lds) {
    __syncthreads();
    g8::DenseSched S{p.ws + OFF_WOUTT, NTOK / 256, 4, (int)gridDim.x, (int)blockIdx.x, (size_t)256 * 2048};
    EpiOutproj E{p.x, p.ctx, p.out, (float*)(p.ws + OFF_XC), (const float*)(p.ws + OFF_MOD)};
    g8::gemm_phase((LAS unsigned char*)lds, p.ws + OFF_ACT, 2048, 16, S, E);
}

DEVI int moe_table(const P& p, int layer, int* tb) {
    __syncthreads();
    if (threadIdx.x == 0) {
        const unsigned* cnt = (const unsigned*)(p.ws + OFF_CNT) + layer * 32; int o = 0;
        for (int c = 0; c < 24; ++c) { tb[c] = o; tb[32 + c] = (int)cnt[c]; o += ((int)cnt[c] + 255) >> 8; }
        tb[24] = o;
    }
    __syncthreads();
    return tb[24];
}
DEVI void cls_experts(int cls, int& elo, int& ehi) {
    const int g = cls / 6, pr = cls % 6;
    const int lo = pr < 3 ? 0 : (pr < 5 ? 1 : 2); const int hi = pr < 3 ? pr + 1 : (pr < 5 ? pr - 1 : 3);
    elo = g * 4 + lo; ehi = g * 4 + hi;
}
DEVI void moe_unit(const int* tb, int rt, g8::Unit& u) {
    int cls = 0; while (cls < 23 && tb[cls + 1] <= rt) ++cls;
    u.cls = cls; u.r0 = (rt - tb[cls]) * 256; u.ncls = tb[32 + cls];
}

struct MoeUpSched {
    static constexpr bool GATHER = true;
    const int* tb; int T, G, c; const int* list; const char* Wgu;
    DEVI bool next(int i, g8::Unit& u) const {
        if (!g8::tile_order(i, G, c, T, 8, u.pm, u.pn)) return false;
        moe_unit(tb, u.pm, u); int elo, ehi; cls_experts(u.cls, elo, ehi);
        const int e = u.pn < 4 ? elo : ehi;
        u.B0 = u.B1 = Wgu + ((size_t)e * 1024 + (size_t)(u.pn & 3) * 256) * 2048; return true;
    }
    DEVI void aoffs(const g8::Unit& u, unsigned (&v)[2][2]) const {
        const int* lst = list + (size_t)u.cls * NTOK + u.r0;
#pragma unroll
        for (int i = 0; i < 2; ++i) { int R, C; g8::lane_rc(i, R, C);
#pragma unroll
            for (int h = 0; h < 2; ++h) { const int rr = h * 128 + R; const int tok = lst[(u.r0 + rr < u.ncls) ? rr : 0]; v[h][i] = (unsigned)((tok * 1024 + C) * 2); } }
    }
};
struct EpiMoeUp {
    static constexpr bool PERM = true;
    const int* list; const float2* tokw; u16* HE;
    DEVI void operator()(const f32x4v (&acc)[2][2][4][2], const g8::Unit& u, int wr, int wc, int fr, int fq) const {
        const int* lst = list + (size_t)u.cls * NTOK + u.r0;
        const int s = u.pn >> 2;
        float wv[2][4];
        { int tk[2][4];
#pragma unroll
          for (int ai = 0; ai < 2; ++ai)
#pragma unroll
              for (int m = 0; m < 4; ++m) { const int rl = ai * 128 + wr * 64 + m * 16 + fr; tk[ai][m] = lst[(u.r0 + rl < u.ncls) ? rl : 0]; }
#pragma unroll
          for (int ai = 0; ai < 2; ++ai)
#pragma unroll
              for (int m = 0; m < 4; ++m) { const float2 w2 = tokw[tk[ai][m]]; wv[ai][m] = s ? w2.y : w2.x; } }
#pragma unroll
        for (int ai = 0; ai < 2; ++ai)
#pragma unroll
            for (int m = 0; m < 4; ++m) {
                const int rl = ai * 128 + wr * 64 + m * 16 + fr;
                if (u.r0 + rl < u.ncls) {
                    const float w = wv[ai][m];
                    u16* rowp = HE + (size_t)(u.pm * 256 + rl) * 1024 + s * 512 + (u.pn & 3) * 128 + wc * 16 + 4 * fq;
#pragma unroll
                    for (int bj = 0; bj < 2; ++bj) {
                        const f32x4v g = acc[ai][bj][m][0], up = acc[ai][bj][m][1];
                        u32x2 o; o[0] = cvtpk(siluf_(g[0]) * up[0] * w, siluf_(g[1]) * up[1] * w); o[1] = cvtpk(siluf_(g[2]) * up[2] * w, siluf_(g[3]) * up[3] * w);
                        *reinterpret_cast<u32x2*>(rowp + bj * 64) = o;
                    }
                }
            }
    }
};
DEVI void phase_moe_up(const P& p, int layer, char* lds) {
    int* tb = (int*)(lds + g8::STAGE_BYTES);
    const int T = moe_table(p, layer, tb);
    MoeUpSched S{tb, T, (int)gridDim.x, (int)blockIdx.x, (const int*)(p.ws + OFF_LIST), p.ws + OFF_WGU};
    EpiMoeUp E{(const int*)(p.ws + OFF_LIST), (const float2*)(p.ws + OFF_TOKW), (u16*)(p.ws + OFF_HE)};
    g8::gemm_phase((LAS unsigned char*)lds, p.ws + OFF_ACT, 2048, 16, S, E);
}

struct MoeDownSched {
    static constexpr bool GATHER = false;
    const int* tb; int T, G, c; const char* WdT;
    DEVI bool next(int i, g8::Unit& u) const {
        if (!g8::tile_order(i, G, c, T, 4, u.pm, u.pn)) return false;
        moe_unit(tb, u.pm, u); int elo, ehi; cls_experts(u.cls, elo, ehi);
        u.B0 = WdT + ((size_t)elo * 1024 + (size_t)u.pn * 256) * 1024;
        u.B1 = WdT + ((size_t)ehi * 1024 + (size_t)u.pn * 256) * 1024 - (size_t)8 * 128; return true;
    }
    DEVI void aoffs(const g8::Unit& u, unsigned (&v)[2][2]) const {
#pragma unroll
        for (int i = 0; i < 2; ++i) { int R, C; g8::lane_rc(i, R, C);
#pragma unroll
            for (int h = 0; h < 2; ++h) v[h][i] = (unsigned)(((u.pm * 256 + h * 128 + R) * 1024 + C) * 2); }
    }
};
template <bool DRY>
struct EpiMoeDown {
    static constexpr bool PERM = false;
    const P* pp; int layer; const int* list; const float* modb;
    DEVI void operator()(const f32x4v (&acc)[2][2][4][2], const g8::Unit& u, int wr, int wc, int fr, int fq) const {
        const P& p = *pp;
        const int* lst = list + (size_t)u.cls * NTOK + u.r0;
        const int col0 = u.pn * 256 + wc * 32 + 4 * fq;
        int tk[2][4];
#pragma unroll
        for (int ai = 0; ai < 2; ++ai)
#pragma unroll
            for (int m = 0; m < 4; ++m) { const int rl = ai * 128 + wr * 64 + m * 16 + fr; tk[ai][m] = (u.r0 + rl < u.ncls) ? lst[rl] : -1; }
#pragma unroll
        for (int ai = 0; ai < 2; ++ai)
#pragma unroll
        for (int mh = 0; mh < 2; ++mh) {
            f32x4v xv[2][2][2], gv[2][2][2];
#pragma unroll
            for (int mm = 0; mm < 2; ++mm) { const int m = mh * 2 + mm; const int tok = tk[ai][m] < 0 ? lst[0] : tk[ai][m];
                const float* gate = modb + (size_t)modsel(layer, tok) * 6144 + 5 * 1024 + col0; const float* xo = xs_ptr(p, layer, tok) + col0;
#pragma unroll
                for (int bj = 0; bj < 2; ++bj)
#pragma unroll
                    for (int n = 0; n < 2; ++n) { gv[mm][bj][n] = *reinterpret_cast<const f32x4v*>(gate + bj * 128 + n * 16); xv[mm][bj][n] = *reinterpret_cast<const f32x4v*>(xo + bj * 128 + n * 16); } }
#pragma unroll
            for (int mm = 0; mm < 2; ++mm) { const int m = mh * 2 + mm; if (tk[ai][m] >= 0) { const int tok = tk[ai][m];
                float* xd = DRY ? (float*)(p.ws + OFF_MLQK) + (size_t)(tok & 8191) * 1024 + col0 : xs_ptr(p, layer, tok) + col0;
#pragma unroll
                for (int bj = 0; bj < 2; ++bj)
#pragma unroll
                    for (int n = 0; n < 2; ++n) *reinterpret_cast<f32x4v*>(xd + bj * 128 + n * 16) = xv[mm][bj][n] + gv[mm][bj][n] * acc[ai][bj][m][n]; } }
        }
    }
};
template <bool DRY = false>
DEVI void phase_moe_down(const P& p, int layer, char* lds) {
    int* tb = (int*)(lds + g8::STAGE_BYTES);
    const int T = moe_table(p, layer, tb);
    MoeDownSched S{tb, T, (int)gridDim.x, (int)blockIdx.x, p.ws + OFF_WDT};
    EpiMoeDown<DRY> E{&p, layer, (const int*)(p.ws + OFF_LIST), (const float*)(p.ws + OFF_MOD) + (size_t)layer * 3 * 6144};
    g8::gemm_phase((LAS unsigned char*)lds, p.ws + OFF_HE, 1024, 8, S, E);
}

struct EpiFnet {
    static constexpr bool PERM = true;
    char* ws;
    DEVI void operator()(const f32x4v (&acc)[2][2][4][2], const g8::Unit& u, int wr, int wc, int fr, int fq) const {
        u16* dst = (u16*)(ws + (u.pn < 4 ? OFF_ZR : OFF_ZI)) + (u.pn & 3) * 256 + wc * 32 + 8 * fq;
#pragma unroll
        for (int ai = 0; ai < 2; ++ai)
#pragma unroll
            for (int m = 0; m < 4; ++m) {
                u16* rowp = dst + (size_t)(u.pm * 256 + ai * 128 + wr * 64 + m * 16 + fr) * 1024;
#pragma unroll
                for (int bj = 0; bj < 2; ++bj) *reinterpret_cast<u32x4*>(rowp + bj * 128) = pack8(acc[ai][bj][m][0], acc[ai][bj][m][1]);
            }
    }
};
DEVI void phase_fnet_gemm(const P& p, char* lds) {
    __syncthreads();
    g8::DenseSched S{p.ws + OFF_FNT, NLAT / 256, 8, (int)gridDim.x, (int)blockIdx.x, (size_t)256 * 2048};
    EpiFnet E{p.ws};
    g8::gemm_phase((LAS unsigned char*)lds, p.ws + OFF_ACT, 2048, 16, S, E);
}

template <class RP>
DEVI void stage_tr128(RP rp, char* img) {
    const int tid = threadIdx.x;
#pragma unroll
    for (int i = 0; i < 4; ++i) {
        const int idx = tid + 512 * i, k = idx >> 4, c = (idx & 15) * 8;
        const u32x4 v = *reinterpret_cast<const u32x4*>(rp(k) + c);
        *reinterpret_cast<u32x4*>(img + (k >> 6) * 16384 + v_st(k & 63, c)) = v;
    }
}
DEVI void load_dft(const P& p, char* lds) {
    const int tid = threadIdx.x;
    for (int i = tid; i < 4096; i += NTHR) {
        const int m = i >> 11, j = i & 2047, row = j >> 4, ch = j & 15;
        const u32x4 v = *reinterpret_cast<const u32x4*>((const u16*)(p.ws + (m ? OFF_DFTS : OFF_DFTC)) + row * 128 + ch * 8);
        *reinterpret_cast<u32x4*>(lds + m * 34816 + swz256(row, ch)) = v;
    }
}
DEVI bf16x8 negbf(bf16x8 v) { u32x4 w = *reinterpret_cast<u32x4*>(&v); w[0] ^= 0x80008000u; w[1] ^= 0x80008000u; w[2] ^= 0x80008000u; w[3] ^= 0x80008000u; return *reinterpret_cast<bf16x8*>(&w); }

template <int KS, int WN, int MODE>
DEVI void fft_kstep(int vbr, int vbi, const bf16x8& aC, const bf16x8& aS, f32x16 (&yr)[2], f32x16 (&yi)[2]) {
    s16x4 rl0, rh0, rl1, rh1, il0, ih0, il1, ih1;
    tr_frag_issue<2 * WN, KS>(vbr, rl0, rh0); tr_frag_issue<2 * WN + 1, KS>(vbr, rl1, rh1);
    tr_frag_issue<2 * WN, KS>(vbi, il0, ih0); tr_frag_issue<2 * WN + 1, KS>(vbi, il1, ih1);
    LGKM0();
    const bf16x8 xr0 = PKLH(rl0, rh0), xr1 = PKLH(rl1, rh1), xi0 = PKLH(il0, ih0), xi1 = PKLH(il1, ih1);
    yr[0] = __builtin_amdgcn_mfma_f32_32x32x16_bf16(aC, xr0, yr[0], 0, 0, 0);
    yr[1] = __builtin_amdgcn_mfma_f32_32x32x16_bf16(aC, xr1, yr[1], 0, 0, 0);
    yr[0] = __builtin_amdgcn_mfma_f32_32x32x16_bf16(aS, xi0, yr[0], 0, 0, 0);
    yr[1] = __builtin_amdgcn_mfma_f32_32x32x16_bf16(aS, xi1, yr[1], 0, 0, 0);
    if (MODE == 0) {
        yi[0] = __builtin_amdgcn_mfma_f32_32x32x16_bf16(aC, xi0, yi[0], 0, 0, 0);
        yi[1] = __builtin_amdgcn_mfma_f32_32x32x16_bf16(aC, xi1, yi[1], 0, 0, 0);
        yi[0] = __builtin_amdgcn_mfma_f32_32x32x16_bf16(aS, negbf(xr0), yi[0], 0, 0, 0);
        yi[1] = __builtin_amdgcn_mfma_f32_32x32x16_bf16(aS, negbf(xr1), yi[1], 0, 0, 0);
    }
}
template <int WN, int MODE>
DEVI void fft_core(const char* lds, int xr_img, int xi_img, int wm, int lane, f32x16 (&yr)[2], f32x16 (&yi)[2]) {
    const int r32 = lane & 31, hi = lane >> 5;
    const char* Cm = lds; const char* Sm = lds + 34816;
    const int row = wm * 32 + r32;
    const int vb0 = xr_img + v_rd_base(lane), vb1 = xi_img + v_rd_base(lane);
#define KSTEP(H, KS) do { const int kk = (H) * 4 + (KS); \
        const bf16x8 aC = lds_b128(Cm, swz256(row, 2 * kk + hi)), aS = lds_b128(Sm, swz256(row, 2 * kk + hi)); \
        fft_kstep<KS, WN, MODE>(vb0 + (H) * 16384, vb1 + (H) * 16384, aC, aS, yr, yi); } while (0)
    KSTEP(0, 0); KSTEP(0, 1); KSTEP(0, 2); KSTEP(0, 3); KSTEP(1, 0); KSTEP(1, 1); KSTEP(1, 2); KSTEP(1, 3);
#undef KSTEP
}

DEVI void phase_fft1(const P& p, char* lds) {
    const int tid = threadIdx.x, lane = tid & 63, wid = __builtin_amdgcn_readfirstlane(tid >> 6), wm = wid >> 1, wn = wid & 1, r32 = lane & 31, hi = lane >> 5;
    load_dft(p, lds);
    char* imgR = lds + 69632; char* imgI = lds + 102400;
    const u16* Zr = (const u16*)(p.ws + OFF_ZR); const u16* Zi = (const u16*)(p.ws + OFF_ZI);
    u16* Yr = (u16*)(p.ws + OFF_YR); u16* Yi = (u16*)(p.ws + OFF_YI);
    const float2* TW = (const float2*)(p.ws + OFF_TW);
    for (int u = blockIdx.x; u < NB * 128 * 8; u += gridDim.x) {
        const int cb = u & 7, t2 = (u >> 3) & 127, b = u >> 10;
        __syncthreads();
        stage_tr128([&](int k) { return Zr + (size_t)(b * TL + 128 * k + t2) * 1024 + cb * 128; }, imgR);
        stage_tr128([&](int k) { return Zi + (size_t)(b * TL + 128 * k + t2) * 1024 + cb * 128; }, imgI);
        __syncthreads();
        f32x16 yr[2] = {}, yi[2] = {};
        const int xr_img = (int)(uintptr_t)imgR, xi_img = (int)(uintptr_t)imgI;
        if (wn == 0) fft_core<0, 0>(lds, xr_img, xi_img, wm, lane, yr, yi); else fft_core<1, 0>(lds, xr_img, xi_img, wm, lane, yr, yi);
#pragma unroll
        for (int r = 0; r < 16; ++r) {
            const int k1 = wm * 32 + crow(r, hi);
            const float2 w = TW[t2 * k1];
            const size_t o = ((size_t)(b * 128 + k1) * 128 + t2) * 1024 + cb * 128 + wn * 64 + r32;
#pragma unroll
            for (int ni = 0; ni < 2; ++ni) {
                const float a = yr[ni][r], bq = yi[ni][r];
                Yr[o + ni * 32] = f2bf(a * w.x + bq * w.y);
                Yi[o + ni * 32] = f2bf(bq * w.x - a * w.y);
            }
        }
    }
}
template <bool DRY = false>
DEVI void phase_fft2(const P& p, char* lds) {
    const int tid = threadIdx.x, lane = tid & 63, wid = __builtin_amdgcn_readfirstlane(tid >> 6), wm = wid >> 1, wn = wid & 1, r32 = lane & 31, hi = lane >> 5;
    load_dft(p, lds);
    char* imgR = lds + 69632; char* imgI = lds + 102400;
    const u16* Yr = (const u16*)(p.ws + OFF_YR); const u16* Yi = (const u16*)(p.ws + OFF_YI);
    const float* modb = (const float*)(p.ws + OFF_MOD) + (size_t)3 * 6144;
    for (int u = blockIdx.x; u < NB * 128 * 8; u += gridDim.x) {
        const int cb = u & 7, k1 = (u >> 3) & 127, b = u >> 10;
        __syncthreads();
        stage_tr128([&](int k) { return Yr + ((size_t)(b * 128 + k1) * 128 + k) * 1024 + cb * 128; }, imgR);
        stage_tr128([&](int k) { return Yi + ((size_t)(b * 128 + k1) * 128 + k) * 1024 + cb * 128; }, imgI);
        __syncthreads();
        f32x16 yr[2] = {}, yi[2] = {};
        const int xr_img = (int)(uintptr_t)imgR, xi_img = (int)(uintptr_t)imgI;
        if (wn == 0) fft_core<0, 1>(lds, xr_img, xi_img, wm, lane, yr, yi); else fft_core<1, 1>(lds, xr_img, xi_img, wm, lane, yr, yi);
        const float* gate = modb + (size_t)b * 6144 + 2 * 1024 + cb * 128 + wn * 64 + r32;
        const float g0 = gate[0], g1 = gate[32];
#pragma unroll
        for (int r = 0; r < 16; ++r) {
            const int k2 = wm * 32 + crow(r, hi);
            float* xo = p.out + (size_t)(b * TL + k1 + 128 * k2) * 1024 + cb * 128 + wn * 64 + r32;
            if (DRY) { float* xd = (float*)(p.ws + OFF_ZR) + (size_t)(b * TL + k1 + 128 * k2) * 1024 + cb * 128 + wn * 64 + r32; xd[0] = xo[0] + g0 * yr[0][r]; xd[32] = xo[32] + g1 * yr[1][r]; }
            else { xo[0] += g0 * yr[0][r]; xo[32] += g1 * yr[1][r]; }
        }
    }
}

constexpr int AT_V = 16384, AT_K = 17408;
template <int HF, int DB>
DEVI void attn_half(const char* Ks, const bf16x8 (&qr)[8], float& m_reg, float& l_reg, f32x16 (&o)[4], int vb, float* al, int r32, int hi) {
    constexpr float SC = 0.125f, C = SC * 1.4426950408889634f, THR = 8.f;
    f32x16 pp = {};
#pragma unroll
    for (int d0 = 0; d0 < 4; ++d0) pp = __builtin_amdgcn_mfma_f32_32x32x16_bf16(lds_b128(Ks, swz256(HF * 32 + r32, 2 * (DB + d0) + hi)), qr[DB + d0], pp, 0, 0, 0);
    float pmax = pp[0];
#pragma unroll
    for (int r = 1; r < 16; ++r) pmax = fmaxf(pmax, pp[r]);
    { auto rr = __builtin_amdgcn_permlane32_swap(__float_as_uint(pmax), __float_as_uint(pmax), false, false);
      pmax = fmaxf(__uint_as_float(rr[0]), __uint_as_float(rr[1])); }
    float alpha = 1.f;
    if (!__all(pmax - m_reg <= THR / SC)) {
        const float mn = fmaxf(m_reg, pmax); alpha = __builtin_amdgcn_exp2f((m_reg - mn) * C); m_reg = mn;
        if (hi == 0) al[r32] = alpha;
        asm volatile("s_waitcnt lgkmcnt(0)" ::: "memory");
#pragma unroll
        for (int d = 0; d < 4; ++d)
#pragma unroll
            for (int r = 0; r < 16; ++r) o[d][r] *= al[crow(r, hi)];
    }
    const float mnC = -m_reg * C;
    float ps = 0.f;
#pragma unroll
    for (int r = 0; r < 16; ++r) { pp[r] = __builtin_amdgcn_exp2f(fmaf(pp[r], C, mnC)); ps += pp[r]; }
    { auto rr = __builtin_amdgcn_permlane32_swap(__float_as_uint(ps), __float_as_uint(ps), false, false);
      ps = __uint_as_float(rr[0]) + __uint_as_float(rr[1]); }
    l_reg = l_reg * alpha + ps;
    bf16x8 pa0, pa1;
    pack_p(pp, pa0, pa1);
#define PVD(D0) do { s16x4 l0, h0, l1, h1; tr_frag_issue<D0, 2 * HF>(vb, l0, h0); tr_frag_issue<D0, 2 * HF + 1>(vb, l1, h1); LGKM0(); \
        o[D0] = __builtin_amdgcn_mfma_f32_32x32x16_bf16(pa0, PKLH(l0, h0), o[D0], 0, 0, 0); \
        o[D0] = __builtin_amdgcn_mfma_f32_32x32x16_bf16(pa1, PKLH(l1, h1), o[D0], 0, 0, 0); } while (0)
    PVD(0); PVD(1); PVD(2); PVD(3);
#undef PVD
}

DEVI void diffattn_item(const P& p, int q0, int k0row, int seq, int h, char* lds) {
    int tid = threadIdx.x; asm volatile("" : "+v"(tid));
    const int wid = tid >> 6, lane = tid & 63, r32 = lane & 31, hi = lane >> 5;
    const u16* Q = (const u16*)(p.ws + OFF_Q); const u16* Kg = (const u16*)(p.ws + OFF_K) + (size_t)k0row * 512 + h * 128;
    const u16* Vg = (const u16*)(p.ws + OFF_V) + (size_t)k0row * 512 + h * 128;
    char* V_lds = lds; char* K_lds = lds + 2 * AT_V;
    float* al = (float*)(lds + 2 * AT_V + 2 * AT_K) + wid * 64;
    bf16x8 qr[8];
    { const u16* Qw = Q + (size_t)(q0 + wid * 32 + r32) * 512 + h * 128 + hi * 8;
#pragma unroll
      for (int d0 = 0; d0 < 8; ++d0) qr[d0] = *reinterpret_cast<const bf16x8*>(Qw + d0 * 16); }
    const int sr = tid >> 4, sc = (tid & 15) * 8;
    const int vb0 = (int)(uintptr_t)V_lds + v_rd_base(lane);
    const int vc = ((tid >> 5) & 3) * 32 + (tid & 3) * 8;
    const int kk0 = (tid >> 7) * 8 + ((tid & 31) >> 2), kk1 = kk0 + 32;
    const int vk0 = (kk0 & ~0xC) | ((kk0 & 4) << 1) | ((kk0 & 8) >> 1), vk1 = (kk1 & ~0xC) | ((kk1 & 4) << 1) | ((kk1 & 8) >> 1);
    u32x4 sk0, sk1;
#define SLOAD(kk, b) do { \
    __builtin_amdgcn_global_load_lds((const unsigned*)(Vg + (size_t)((kk) + vk0) * 512 + vc), (LAS unsigned*)(V_lds + (b) * AT_V + tid * 16), 16, 0, 0); \
    __builtin_amdgcn_global_load_lds((const unsigned*)(Vg + (size_t)((kk) + vk1) * 512 + vc), (LAS unsigned*)(V_lds + (b) * AT_V + 8192 + tid * 16), 16, 0, 0); \
    sk0 = *reinterpret_cast<const u32x4*>(Kg + (size_t)((kk) + sr) * 512 + sc); sk1 = *reinterpret_cast<const u32x4*>(Kg + (size_t)((kk) + 32 + sr) * 512 + sc); } while (0)
#define SWRITE(b) do { *reinterpret_cast<u32x4*>(K_lds + (b) * AT_K + swz256(sr, tid & 15)) = sk0; *reinterpret_cast<u32x4*>(K_lds + (b) * AT_K + swz256(32 + sr, tid & 15)) = sk1; } while (0)
    float m0 = -1e30f, m1 = -1e30f, l0 = 0.f, l1 = 0.f;
    f32x16 o0[4] = {}, o1[4] = {};
    const int NT = seq / 64;
    __syncthreads();
    SLOAD(0, 0); SWRITE(0); asm volatile("s_waitcnt vmcnt(0)" ::: "memory"); __syncthreads();
    if (NT > 1) SLOAD(64, 1);
    for (int j = 0; j < NT; ++j) {
        const int cur = j & 1;
        const char* Ks = K_lds + cur * AT_K;
        attn_half<0, 0>(Ks, qr, m0, l0, o0, vb0 + cur * AT_V, al, r32, hi);
        attn_half<1, 0>(Ks, qr, m0, l0, o0, vb0 + cur * AT_V, al, r32, hi);
        attn_half<0, 4>(Ks, qr, m1, l1, o1, vb0 + cur * AT_V, al, r32, hi);
        attn_half<1, 4>(Ks, qr, m1, l1, o1, vb0 + cur * AT_V, al, r32, hi);
        if (j + 1 < NT) SWRITE(cur ^ 1);
        asm volatile("s_waitcnt vmcnt(0)" ::: "memory");
        __syncthreads();
        if (j + 2 < NT) SLOAD((j + 2) * 64, cur);
    }
#undef SLOAD
#undef SWRITE
    int tz = threadIdx.x; asm volatile("" : "+v"(tz));
    const int wid2 = tz >> 6, lane2 = tz & 63, r32e = lane2 & 31, hie = lane2 >> 5;
    const float lam = ((const float*)(p.ws + OFF_LAM))[0];
    float* sc0 = (float*)(lds + 2 * AT_V + 2 * AT_K) + wid2 * 64; float* sc1 = sc0 + 32;
    if (hie == 0) { sc0[r32e] = 1.f / l0; sc1[r32e] = -lam / l1; }
    asm volatile("s_waitcnt lgkmcnt(0)" ::: "memory");
    float ssq[16];
#pragma unroll
    for (int r = 0; r < 16; ++r) {
        const float a = sc0[crow(r, hie)], b = sc1[crow(r, hie)]; float s = 0.f;
#pragma unroll
        for (int d = 0; d < 4; ++d) { const float v = o0[d][r] * a + o1[d][r] * b; o0[d][r] = v; s = fmaf(v, v, s); }
        ssq[r] = s;
    }
#pragma unroll
    for (int r = 0; r < 16; ++r) { float s = ssq[r]; for (int o = 16; o; o >>= 1) s += __shfl_xor(s, o); ssq[r] = rsqrtf(s * (1.f / 128.f) + 1e-6f) * 0.8f; }
    u16* mix = (u16*)(p.ws + OFF_ACT);
    const float* sg = p.subln_g;
#pragma unroll
    for (int d = 0; d < 4; ++d) {
        const float gv = sg[d * 32 + r32e];
#pragma unroll
        for (int r = 0; r < 16; ++r) mix[(size_t)(q0 + wid2 * 32 + crow(r, hie)) * 1024 + h * 128 + d * 32 + r32e] = f2bf(o0[d][r] * ssq[r] * gv);
    }
}

DEVI void chunk_scan(const float* gates, int row0, int head, int dir, float* Bq, float* av, float* pm, float& total, float& amax) {
    const int lane = threadIdx.x & 63;
    const int e0 = dir ? 127 - 2 * lane : 2 * lane, e1 = dir ? 126 - 2 * lane : 2 * lane + 1;
    const float lf0 = gates[(size_t)(row0 + e0) * 16 + (dir ? 12 : 4) + head], lf1 = gates[(size_t)(row0 + e1) * 16 + (dir ? 12 : 4) + head];
    const float li0 = gates[(size_t)(row0 + e0) * 16 + (dir ? 8 : 0) + head],  li1 = gates[(size_t)(row0 + e1) * 16 + (dir ? 8 : 0) + head];
    const float s1 = lf0 + lf1; float inc = s1;
#pragma unroll
    for (int o = 1; o < 64; o <<= 1) { const float t = __shfl_up(inc, o); if (lane >= o) inc += t; }
    const float exc = inc - s1;
    const float B0 = exc + lf0, B1 = exc + s1;
    const float a0 = li0 - B0, a1 = li1 - B1;
    const float m1 = fmaxf(a0, a1); float mx = m1;
#pragma unroll
    for (int o = 1; o < 64; o <<= 1) { const float t = __shfl_up(mx, o); if (lane >= o) mx = fmaxf(mx, t); }
    float mprev = __shfl_up(mx, 1); if (lane == 0) mprev = -1e30f;
    Bq[e0] = B0; Bq[e1] = B1; av[e0] = a0; av[e1] = a1; pm[e0] = fmaxf(mprev, a0); pm[e1] = mx;
    total = __shfl(inc, 63); amax = __shfl(mx, 63);
}

DEVI void conv_silu8(const u32x4& xm, const u32x4& x0, const u32x4& xp, const float* wc, bool hasm, bool hasp, float (&out)[8]) {
#pragma unroll
    for (int j = 0; j < 4; ++j) {
        const float w00 = wc[2 * j], w01 = wc[2 * j + 1], w10 = wc[1024 + 2 * j], w11 = wc[1024 + 2 * j + 1], w20 = wc[2048 + 2 * j], w21 = wc[2048 + 2 * j + 1];
        float a = w10 * bflo(x0[j]), b = w11 * bfhi(x0[j]);
        if (hasm) { a = fmaf(w00, bflo(xm[j]), a); b = fmaf(w01, bfhi(xm[j]), b); }
        if (hasp) { a = fmaf(w20, bflo(xp[j]), a); b = fmaf(w21, bfhi(xp[j]), b); }
        out[2 * j] = siluf_(a); out[2 * j + 1] = siluf_(b);
    }
}
DEVI void seg_edges(int t  , bool& hasm, bool& hasp) {
    hasm = !(t == 0 || t == TC); hasp = !(t == TC - 1 || t == TT - 1);
}
DEVI int chain_slot(int dir, int b, int h, int cc) { return ((dir * 2 + b) * 4 + h) * NCH + cc; }

DEVI void phase_mlstm_a(const P& p, char* lds) {
    const int tid = threadIdx.x, wid = __builtin_amdgcn_readfirstlane(tid >> 6), lane = tid & 63, r32 = lane & 31, hi = lane >> 5;
    char* Vimg = lds; char* Kf = lds + 32768; char* Kb = lds + 65536;
    float* arr = (float*)(lds + 98304);
    const float* gates = (const float*)(p.ws + OFF_GATES);
    const u16* MLQK = (const u16*)(p.ws + OFF_MLQK); const u16* MLV = (const u16*)(p.ws + OFF_MLV);
    u16* CST = (u16*)(p.ws + OFF_CST); float* NST = (float*)(p.ws + OFF_NST); u16* MLC = (u16*)(p.ws + OFF_MLC);
    float2* scal = (float2*)(p.ws + OFF_MSCAL);
    for (int it = blockIdx.x; it < NB * 4 * NCH; it += gridDim.x) {
        const int cc = it % NCH, h = (it / NCH) & 3, b = it / (NCH * 4);
        const int row0 = b * TT + cc * 128;
        __syncthreads();
        if (wid < 2) {
            float total, amax; float* a4 = arr + wid * 512;
            chunk_scan(gates, row0, h, wid, a4, a4 + 128, a4 + 256, total, amax);
            a4[384 + lane] = __expf(a4[128 + lane] - amax); a4[384 + 64 + lane] = __expf(a4[128 + 64 + lane] - amax);
            if (lane == 0) scal[chain_slot(wid, b, h, 0) + cc] = make_float2(total + amax, total);
        }
        __syncthreads();
#pragma unroll
        for (int i = 0; i < 4; ++i) {
            const int idx = tid + 512 * i, l = idx >> 4, c = (idx & 15) * 8;
            const u32x4 v = *reinterpret_cast<const u32x4*>(MLV + (size_t)(row0 + l) * 512 + h * 128 + c);
            *reinterpret_cast<u32x4*>(Vimg + (l >> 6) * 16384 + v_st(l & 63, c)) = v;
            const int t = cc * 128 + l; bool hasm, hasp; seg_edges(t, hasm, hasp);
            const u16* kp = MLQK + (size_t)(row0 + l) * 1024 + 512 + h * 128 + c;
            const u32x4 x0 = *reinterpret_cast<const u32x4*>(kp);
            const u32x4 xm = hasm ? *reinterpret_cast<const u32x4*>(kp - 1024) : x0;
            const u32x4 xp = hasp ? *reinterpret_cast<const u32x4*>(kp + 1024) : x0;
            float kv[8]; conv_silu8(xm, x0, xp, p.conv_w + 512 + h * 128 + c, hasm, hasp, kv);
            const float wf = arr[384 + l] * 0.08838834764831845f, wb = arr[512 + 384 + l] * 0.08838834764831845f;
            u32x4 of, ob, ok;
#pragma unroll
            for (int j = 0; j < 4; ++j) { of[j] = cvtpk(kv[2 * j] * wf, kv[2 * j + 1] * wf); ob[j] = cvtpk(kv[2 * j] * wb, kv[2 * j + 1] * wb);
                ok[j] = cvtpk(kv[2 * j] * 0.08838834764831845f, kv[2 * j + 1] * 0.08838834764831845f); }
            *reinterpret_cast<u32x4*>(MLC + (size_t)(row0 + l) * 1024 + 512 + h * 128 + c) = ok;
            {
                const u16* qp = kp - 512;
                const u32x4 q0 = *reinterpret_cast<const u32x4*>(qp);
                const u32x4 qm = hasm ? *reinterpret_cast<const u32x4*>(qp - 1024) : q0;
                const u32x4 qn = hasp ? *reinterpret_cast<const u32x4*>(qp + 1024) : q0;
                float qv[8]; conv_silu8(qm, q0, qn, p.conv_w + h * 128 + c, hasm, hasp, qv);
                u32x4 oq;
#pragma unroll
                for (int j = 0; j < 4; ++j) oq[j] = cvtpk(qv[2 * j], qv[2 * j + 1]);
                *reinterpret_cast<u32x4*>(MLC + (size_t)(row0 + l) * 1024 + h * 128 + c) = oq;
            }
            *reinterpret_cast<u32x4*>(Kf + (l >> 6) * 16384 + v_st(l & 63, c)) = of;
            *reinterpret_cast<u32x4*>(Kb + (l >> 6) * 16384 + v_st(l & 63, c)) = ob;
        }
        __syncthreads();
        const int dir = wid >> 2, vblk = wid & 3;
        const int va = (int)(uintptr_t)Vimg + v_rd_base(lane), ka = (int)(uintptr_t)(dir ? Kb : Kf) + v_rd_base(lane);
        f32x16 acc[4] = {};
#define ASTEP(H, KS) do { s16x4 al_, ah_, b0l, b0h, b1l, b1h, b2l, b2h, b3l, b3h; \
        if (vblk == 0) tr_frag_issue<0, KS>(va + (H) * 16384, al_, ah_); else if (vblk == 1) tr_frag_issue<1, KS>(va + (H) * 16384, al_, ah_); \
        else if (vblk == 2) tr_frag_issue<2, KS>(va + (H) * 16384, al_, ah_); else tr_frag_issue<3, KS>(va + (H) * 16384, al_, ah_); \
        tr_frag_issue<0, KS>(ka + (H) * 16384, b0l, b0h); tr_frag_issue<1, KS>(ka + (H) * 16384, b1l, b1h); \
        tr_frag_issue<2, KS>(ka + (H) * 16384, b2l, b2h); tr_frag_issue<3, KS>(ka + (H) * 16384, b3l, b3h); LGKM0(); \
        const bf16x8 af = PKLH(al_, ah_); \
        acc[0] = __builtin_amdgcn_mfma_f32_32x32x16_bf16(af, PKLH(b0l, b0h), acc[0], 0, 0, 0); \
        acc[1] = __builtin_amdgcn_mfma_f32_32x32x16_bf16(af, PKLH(b1l, b1h), acc[1], 0, 0, 0); \
        acc[2] = __builtin_amdgcn_mfma_f32_32x32x16_bf16(af, PKLH(b2l, b2h), acc[2], 0, 0, 0); \
        acc[3] = __builtin_amdgcn_mfma_f32_32x32x16_bf16(af, PKLH(b3l, b3h), acc[3], 0, 0, 0); } while (0)
        ASTEP(0, 0); ASTEP(0, 1); ASTEP(0, 2); ASTEP(0, 3); ASTEP(1, 0); ASTEP(1, 1); ASTEP(1, 2); ASTEP(1, 3);
#undef ASTEP
        u16* Cd = CST + (size_t)chain_slot(dir, b, h, cc) * 16384;
#pragma unroll
        for (int kb = 0; kb < 4; ++kb)
#pragma unroll
            for (int r = 0; r < 16; ++r) Cd[(vblk * 32 + crow(r, hi)) * 128 + kb * 32 + r32] = f2bf(acc[kb][r]);
        if (tid < 256) {
            const int d2 = tid >> 7, k = tid & 127; const char* img = d2 ? Kb : Kf; float s = 0.f;
            for (int l = 0; l < 128; ++l) s += bf2f(*reinterpret_cast<const u16*>(img + (l >> 6) * 16384 + v_st(l & 63, k & ~7) + (k & 7) * 2));
            NST[(size_t)chain_slot(d2, b, h, cc) * 128 + k] = s;
        }
    }
}

DEVI void phase_kmax(const P& p, char* lds) {
    const int tid = threadIdx.x; unsigned* lm = (unsigned*)lds;
    __syncthreads();
    if (tid < 16) lm[tid] = 0u;
    __syncthreads();
    const u16* K = (const u16*)(p.ws + OFF_K); const int hm = tid & 7;
    float mx0 = 0.f, mx1 = 0.f;
    for (int idx = blockIdx.x * NTHR + tid; idx < NTOK * 8; idx += gridDim.x * NTHR) {
        const int tok = idx >> 3; const u16* kp = K + (size_t)tok * 512 + hm * 64; float ss = 0.f;
#pragma unroll
        for (int c = 0; c < 8; ++c) { const u32x4 w = *reinterpret_cast<const u32x4*>(kp + c * 8);
#pragma unroll
            for (int j = 0; j < 4; ++j) { const float a = bflo(w[j]), b = bfhi(w[j]); ss = fmaf(a, a, ss); ss = fmaf(b, b, ss); } }
        if (tok < TT) mx0 = fmaxf(mx0, ss); else mx1 = fmaxf(mx1, ss);
    }
    atomicMax(&lm[hm], __float_as_uint(mx0)); atomicMax(&lm[8 + hm], __float_as_uint(mx1));
    __syncthreads();
    if (tid < 16) atomicMax((unsigned*)(p.ws + OFF_CNT) + 128 + tid, lm[tid]);
    __syncthreads();
}

DEVI int proc_chunk(int dir, int i) { return dir == 0 ? i : (i == 0 ? 1 : (i == 1 ? 0 : NCH + 1 - i)); }

DEVI void phase_mlstm_b(const P& p, char* lds) {
    const int tid = threadIdx.x;
    float* dec = (float*)lds; float* scl = dec + 160; float* mst = scl + 160;
    const float2* scal = (const float2*)(p.ws + OFF_MSCAL);
    u32* CST = (u32*)(p.ws + OFF_CST); float* NST = (float*)(p.ws + OFF_NST); float* MST = (float*)(p.ws + OFF_MST);
    for (int it = blockIdx.x; it < 16 * 16; it += gridDim.x) {
        const int chain = it >> 4, sub = it & 15, dir = chain >> 3;
        __syncthreads();
        if (tid == 0) {
            float m = 0.f;
            for (int i = 0; i < NCH; ++i) {
                const int cc = proc_chunk(dir, i); const float2 s = scal[chain * NCH + cc];
                const float mn = fmaxf(s.y + m, s.x);
                dec[i] = __expf(s.y + m - mn); scl[i] = __expf(s.x - mn); mst[i] = m;
                if (sub == 0) MST[chain * NCH + cc] = m;
                m = mn;
            }
        }
        __syncthreads();
        u32* base = CST + (size_t)chain * NCH * 8192 + sub * 512 + tid;
        float s0 = 0.f, s1 = 0.f;
        for (int i0 = 0; i0 < NCH; i0 += 10) {
            u32 v[10];
#pragma unroll
            for (int j = 0; j < 10; ++j) v[j] = base[(size_t)proc_chunk(dir, i0 + j) * 8192];
#pragma unroll
            for (int j = 0; j < 10; ++j) {
                base[(size_t)proc_chunk(dir, i0 + j) * 8192] = cvtpk(s0, s1);
                const float d = dec[i0 + j], sc = scl[i0 + j];
                s0 = fmaf(d, s0, sc * bflo(v[j])); s1 = fmaf(d, s1, sc * bfhi(v[j]));
            }
        }
        if (sub == 0 && tid < 128) {
            float* nb = NST + (size_t)chain * NCH * 128 + tid; float s = 0.f;
            for (int i = 0; i < NCH; ++i) { const int cc = proc_chunk(dir, i); const float v = nb[cc * 128]; nb[cc * 128] = s; s = fmaf(dec[i], s, scl[i] * v); }
        }
    }
}

DEVI void mlstm_c_item(const P& p, int it, char* lds) {
    int tid = threadIdx.x; asm volatile("" : "+v"(tid));
    const int wid = __builtin_amdgcn_readfirstlane(tid >> 6), lane = tid & 63, r32 = lane & 31, hi = lane >> 5;
    const int cc = it % NCH, h = (it / NCH) & 3, b = it / (NCH * 4);
    const int row0 = b * TT + cc * 128;
    char* Kt = lds; char* Vimg = lds + 34816; char* Ct = lds + 67584;
    float* arr = (float*)(lds + 137216);
    float* wsc = arr + 1024 + wid * 64;
    float* xb = (float*)lds;
    const float* gates = (const float*)(p.ws + OFF_GATES);
    const u16* MLC = (const u16*)(p.ws + OFF_MLC); const u16* MLV = (const u16*)(p.ws + OFF_MLV);
    const u16* CST = (const u16*)(p.ws + OFF_CST); const float* NST = (const float*)(p.ws + OFF_NST); const float* MST = (const float*)(p.ws + OFF_MST);
    __syncthreads();
    if (wid < 2) { float total, amax; float* a4 = arr + wid * 512; chunk_scan(gates, row0, h, wid, a4, a4 + 128, a4 + 256, total, amax); }
    else if (wid < 6) { const int d2 = (wid - 2) >> 1, k = ((wid - 2) & 1) * 64 + lane; arr[d2 * 512 + 384 + k] = NST[(size_t)chain_slot(d2, b, h, cc) * 128 + k]; }
#pragma unroll
    for (int i = 0; i < 4; ++i) {
        const int idx = tid + 512 * i, l = idx >> 4, ch = idx & 15, c = ch * 8;
        const u32x4 v = *reinterpret_cast<const u32x4*>(MLV + (size_t)(row0 + l) * 512 + h * 128 + c);
        *reinterpret_cast<u32x4*>(Vimg + (l >> 6) * 16384 + v_st(l & 63, c)) = v;
        const u32x4 ok = *reinterpret_cast<const u32x4*>(MLC + (size_t)(row0 + l) * 1024 + 512 + h * 128 + c);
        *reinterpret_cast<u32x4*>(Kt + swz256(l, ch)) = ok;
#pragma unroll
        for (int d2 = 0; d2 < 2; ++d2) {
            const u32x4 cv = *reinterpret_cast<const u32x4*>(CST + (size_t)chain_slot(d2, b, h, cc) * 16384 + l * 128 + c);
            *reinterpret_cast<u32x4*>(Ct + d2 * 34816 + swz256(l, ch)) = cv;
        }
    }
    const int dir = wid >> 2, qb = wid & 3, q = qb * 32 + r32;
    bf16x8 qr[8];
    { const u16* qp = MLC + (size_t)(row0 + q) * 1024 + h * 128 + hi * 8;
#pragma unroll
      for (int d0 = 0; d0 < 8; ++d0) qr[d0] = *reinterpret_cast<const bf16x8*>(qp + d0 * 16); }
    __syncthreads();
    const float* a4 = arr + dir * 512;
    const float m_st = MST[chain_slot(dir, b, h, 0) + cc];
    const float Mq = fmaxf(m_st, a4[256 + q]);
    const float inter = __expf(m_st - Mq);
    float nq = 0.f;
#pragma unroll
    for (int d0 = 0; d0 < 8; ++d0) {
        const u32x4 w = *reinterpret_cast<const u32x4*>(&qr[d0]); const float* nn = a4 + 384 + d0 * 16 + hi * 8;
#pragma unroll
        for (int j = 0; j < 4; ++j) { nq = fmaf(bflo(w[j]), nn[2 * j], nq); nq = fmaf(bfhi(w[j]), nn[2 * j + 1], nq); }
    }
    { auto rr = __builtin_amdgcn_permlane32_swap(__float_as_uint(nq), __float_as_uint(nq), false, false); nq = __uint_as_float(rr[0]) + __uint_as_float(rr[1]); }
    f32x16 o[4] = {};
    const char* Cm = Ct + dir * 34816;
#pragma unroll
    for (int dk = 0; dk < 8; ++dk)
#pragma unroll
        for (int d0 = 0; d0 < 4; ++d0) o[d0] = __builtin_amdgcn_mfma_f32_32x32x16_bf16(qr[dk], lds_b128(Cm, swz256(d0 * 32 + r32, 2 * dk + hi)), o[d0], 0, 0, 0);
    if (hi == 0) wsc[r32] = inter;
    asm volatile("s_waitcnt lgkmcnt(0)" ::: "memory");
#pragma unroll
    for (int d0 = 0; d0 < 4; ++d0)
#pragma unroll
        for (int r = 0; r < 16; ++r) o[d0][r] *= wsc[crow(r, hi)];
    const int vb = (int)(uintptr_t)Vimg + v_rd_base(lane);
    float rs = 0.f;
#define KBLK(KB) do { if (dir == 0 ? (KB) <= qb : (KB) >= qb) { \
        f32x16 pp = {}; \
        _Pragma("unroll") for (int d0 = 0; d0 < 8; ++d0) pp = __builtin_amdgcn_mfma_f32_32x32x16_bf16(lds_b128(Kt, swz256((KB) * 32 + r32, 2 * d0 + hi)), qr[d0], pp, 0, 0, 0); \
        _Pragma("unroll") for (int g = 0; g < 4; ++g) { const f32x4 av4 = *reinterpret_cast<const f32x4*>(a4 + 128 + (KB) * 32 + 8 * g + 4 * hi); \
            _Pragma("unroll") for (int j = 0; j < 4; ++j) { const int key = (KB) * 32 + 8 * g + 4 * hi + j; const bool ok = dir == 0 ? key <= q : key >= q; \
                const float sv = ok ? pp[4 * g + j] * __expf(av4[j] - Mq) : 0.f; pp[4 * g + j] = sv; rs += sv; } } \
        bf16x8 f0, f1; pack_p(pp, f0, f1); \
        { s16x4 l0, h0, l1, h1, l2, h2, l3, h3; constexpr int HH = (KB) >> 1, K0 = ((KB) & 1) * 2; \
          tr_frag_issue<0, K0>(vb + HH * 16384, l0, h0); tr_frag_issue<1, K0>(vb + HH * 16384, l1, h1); tr_frag_issue<2, K0>(vb + HH * 16384, l2, h2); tr_frag_issue<3, K0>(vb + HH * 16384, l3, h3); LGKM0(); \
          o[0] = __builtin_amdgcn_mfma_f32_32x32x16_bf16(f0, PKLH(l0, h0), o[0], 0, 0, 0); o[1] = __builtin_amdgcn_mfma_f32_32x32x16_bf16(f0, PKLH(l1, h1), o[1], 0, 0, 0); \
          o[2] = __builtin_amdgcn_mfma_f32_32x32x16_bf16(f0, PKLH(l2, h2), o[2], 0, 0, 0); o[3] = __builtin_amdgcn_mfma_f32_32x32x16_bf16(f0, PKLH(l3, h3), o[3], 0, 0, 0); \
          tr_frag_issue<0, K0 + 1>(vb + HH * 16384, l0, h0); tr_frag_issue<1, K0 + 1>(vb + HH * 16384, l1, h1); tr_frag_issue<2, K0 + 1>(vb + HH * 16384, l2, h2); tr_frag_issue<3, K0 + 1>(vb + HH * 16384, l3, h3); LGKM0(); \
          o[0] = __builtin_amdgcn_mfma_f32_32x32x16_bf16(f1, PKLH(l0, h0), o[0], 0, 0, 0); o[1] = __builtin_amdgcn_mfma_f32_32x32x16_bf16(f1, PKLH(l1, h1), o[1], 0, 0, 0); \
          o[2] = __builtin_amdgcn_mfma_f32_32x32x16_bf16(f1, PKLH(l2, h2), o[2], 0, 0, 0); o[3] = __builtin_amdgcn_mfma_f32_32x32x16_bf16(f1, PKLH(l3, h3), o[3], 0, 0, 0); } } } while (0)
    KBLK(0); KBLK(1); KBLK(2); KBLK(3);
#undef KBLK
    { auto rr = __builtin_amdgcn_permlane32_swap(__float_as_uint(rs), __float_as_uint(rs), false, false); rs = __uint_as_float(rr[0]) + __uint_as_float(rr[1]); }
    const float nqt = inter * nq + rs;
    const float den = fmaxf(fabsf(nqt), __expf(-(a4[q] + Mq)));
    if (hi == 0) wsc[32 + r32] = 1.f / den;
    asm volatile("s_waitcnt lgkmcnt(0)" ::: "memory");
#pragma unroll
    for (int d0 = 0; d0 < 4; ++d0)
#pragma unroll
        for (int r = 0; r < 16; ++r) o[d0][r] *= wsc[32 + crow(r, hi)];
    __syncthreads();
    {
        float* xd = dir ? xb : (float*)(lds + 67584);
#pragma unroll
        for (int d0 = 0; d0 < 4; ++d0)
#pragma unroll
            for (int r = 0; r < 16; ++r) xd[(qb * 32 + crow(r, hi)) * 128 + d0 * 32 + r32] = o[d0][r];
    }
    __syncthreads();
    {
        const u16* OG = (const u16*)(p.ws + OFF_OG); u16* mix = (u16*)(p.ws + OFF_ACT);
        const float* xf = (const float*)(lds + 67584);
#pragma unroll
        for (int i = 0; i < 4; ++i) {
            const int idx = tid + 512 * i, ql = idx >> 4, c = (idx & 15) * 8;
            const f32x4 f0 = *reinterpret_cast<const f32x4*>(xf + ql * 128 + c), f1 = *reinterpret_cast<const f32x4*>(xf + ql * 128 + c + 4);
            const f32x4 b0 = *reinterpret_cast<const f32x4*>(xb + ql * 128 + c), b1 = *reinterpret_cast<const f32x4*>(xb + ql * 128 + c + 4);
            const u32x4 og = *reinterpret_cast<const u32x4*>(OG + (size_t)(row0 + ql) * 512 + h * 128 + c);
            u32x4 w;
            w[0] = cvtpk((f0[0] + b0[0]) * bflo(og[0]), (f0[1] + b0[1]) * bfhi(og[0]));
            w[1] = cvtpk((f0[2] + b0[2]) * bflo(og[1]), (f0[3] + b0[3]) * bfhi(og[1]));
            w[2] = cvtpk((f1[0] + b1[0]) * bflo(og[2]), (f1[1] + b1[1]) * bfhi(og[2]));
            w[3] = cvtpk((f1[2] + b1[2]) * bflo(og[3]), (f1[3] + b1[3]) * bfhi(og[3]));
            *reinterpret_cast<u32x4*>(mix + (size_t)(row0 + ql) * 1024 + 512 + h * 128 + c) = w;
        }
    }
}

#define KSWZ(row, colB) ((row) * 256 + ((colB) ^ (((row) & 15) << 4)))
constexpr float A2_SCALE = 0.125f, A2_THR = 8.f;
DEVI void a2_partialSM(f32x16& p0, f32x16& p1, float mnC) {
    constexpr float C = A2_SCALE * 1.4426950408889634f;
#pragma unroll
    for (int r = 0; r < 16; ++r) p0[r] = __builtin_amdgcn_exp2f(fmaf(p0[r], C, mnC));
#pragma unroll
    for (int r = 0; r < 16; ++r) p1[r] = fmaf(p1[r], C, mnC);
}
DEVI void a2_finishSM(f32x16& p0, f32x16& p1, float& l_reg, bf16x8& pa0, bf16x8& pa1, bf16x8& pa2, bf16x8& pa3) {
#pragma unroll
    for (int r = 0; r < 16; ++r) p1[r] = __builtin_amdgcn_exp2f(p1[r]);
    float ps = 0.f;
#pragma unroll
    for (int r = 0; r < 16; ++r) ps += p0[r];
#pragma unroll
    for (int r = 0; r < 16; ++r) ps += p1[r];
    l_reg += ps;
    pack_p(p0, pa0, pa1); pack_p(p1, pa2, pa3);
}
DEVI void a2_qkt(f32x16& p0, f32x16& p1, const char* Ks, const bf16x8 (&qr)[4], int r32, int hi, int grp) {
    p0 = f32x16{}; p1 = f32x16{};
#pragma unroll
    for (int d0 = 0; d0 < 4; ++d0) { const int cb = (grp * 64 + d0 * 16 + hi * 8) * 2;
        const bf16x8 b0 = lds_b128(Ks, KSWZ(r32, cb)), b1 = lds_b128(Ks, KSWZ(32 + r32, cb));
        p0 = __builtin_amdgcn_mfma_f32_32x32x16_bf16(b0, qr[d0], p0, 0, 0, 0);
        p1 = __builtin_amdgcn_mfma_f32_32x32x16_bf16(b1, qr[d0], p1, 0, 0, 0); }
}
#define A2_VISSUE(D0, F) do { tr_frag_issue<D0, 0>(vb, F##l0, F##h0); tr_frag_issue<D0, 1>(vb, F##l1, F##h1); tr_frag_issue<D0, 2>(vb, F##l2, F##h2); tr_frag_issue<D0, 3>(vb, F##l3, F##h3); } while (0)
#define A2_VMMA(D0, F) do { \
    o[D0] = __builtin_amdgcn_mfma_f32_32x32x16_bf16(pa0, PKLH(F##l0, F##h0), o[D0], 0, 0, 0); o[D0] = __builtin_amdgcn_mfma_f32_32x32x16_bf16(pa1, PKLH(F##l1, F##h1), o[D0], 0, 0, 0); \
    o[D0] = __builtin_amdgcn_mfma_f32_32x32x16_bf16(pa2, PKLH(F##l2, F##h2), o[D0], 0, 0, 0); o[D0] = __builtin_amdgcn_mfma_f32_32x32x16_bf16(pa3, PKLH(F##l3, F##h3), o[D0], 0, 0, 0); } while (0)
#define A2_LGKM(N) do { asm volatile("s_waitcnt lgkmcnt(" #N ")" ::: "memory"); SBAR(); } while (0)
template <int S> DEVI void a2_psm_slice(f32x16& x0, f32x16& x1, float mnC) {
    constexpr float C = A2_SCALE * 1.4426950408889634f;
#pragma unroll
    for (int r = 4 * S; r < 4 * S + 4; ++r) { x0[r] = __builtin_amdgcn_exp2f(fmaf(x0[r], C, mnC)); x1[r] = fmaf(x1[r], C, mnC); }
}
DEVI void a2_pv(f32x16 (&o)[4], int vb, const bf16x8& pa0, const bf16x8& pa1, const bf16x8& pa2, const bf16x8& pa3, f32x16& x0, f32x16& x1, float mnC) {
    s16x4 al0, ah0, al1, ah1, al2, ah2, al3, ah3, bl0, bh0, bl1, bh1, bl2, bh2, bl3, bh3;
    A2_VISSUE(0, a); A2_VISSUE(1, b);
    A2_LGKM(8); a2_psm_slice<0>(x0, x1, mnC); A2_VMMA(0, a);
    A2_VISSUE(2, a);
    A2_LGKM(8); a2_psm_slice<1>(x0, x1, mnC); A2_VMMA(1, b);
    A2_VISSUE(3, b);
    A2_LGKM(8); a2_psm_slice<2>(x0, x1, mnC); A2_VMMA(2, a);
    A2_LGKM(0); a2_psm_slice<3>(x0, x1, mnC); A2_VMMA(3, b);
}
DEVI void a2_pv_last(f32x16 (&o)[4], int vb, const bf16x8& pa0, const bf16x8& pa1, const bf16x8& pa2, const bf16x8& pa3) {
    s16x4 al0, ah0, al1, ah1, al2, ah2, al3, ah3, bl0, bh0, bl1, bh1, bl2, bh2, bl3, bh3;
    A2_VISSUE(0, a); A2_VISSUE(1, b);
    A2_LGKM(8); A2_VMMA(0, a);
    A2_VISSUE(2, a);
    A2_LGKM(8); A2_VMMA(1, b);
    A2_VISSUE(3, b);
    A2_LGKM(8); A2_VMMA(2, a);
    A2_LGKM(0); A2_VMMA(3, b);
}
constexpr int A2_T = 16384;
DEVI void a2_body(const P& p, int q0, int k0row, int seq, int h, char* lds, int tid) {
    const int GRP = __builtin_amdgcn_readfirstlane(tid >> 8); const int wid = tid >> 6, lane = tid & 63, r32 = lane & 31, hi = lane >> 5, wq = wid & 3;
    const u16* Kh = (const u16*)(p.ws + OFF_K) + (size_t)k0row * 512 + h * 128;
    const u16* Vh = (const u16*)(p.ws + OFF_V) + (size_t)k0row * 512 + h * 128;
    char* V_lds = lds; char* K_lds = lds + 3 * A2_T;
    float* wsc = (float*)(lds + 6 * A2_T) + wid * 64; float* li_l = wsc;
    float l_reg = 0.f; f32x16 o[4] = {}; bf16x8 qr[4];
    { const u16* Qw = (const u16*)(p.ws + OFF_Q) + (size_t)(q0 + wq * 32 + r32) * 512 + h * 128 + GRP * 64 + hi * 8;
#pragma unroll
      for (int d0 = 0; d0 < 4; ++d0) qr[d0] = *reinterpret_cast<const bf16x8*>(Qw + d0 * 16); }
    float mnC;
    { float qq = 0.f;
#pragma unroll
      for (int d0 = 0; d0 < 4; ++d0) { const u32x4 w = *reinterpret_cast<const u32x4*>(&qr[d0]);
#pragma unroll
          for (int j = 0; j < 4; ++j) { const float a = bflo(w[j]), b2 = bfhi(w[j]); qq = fmaf(a, a, qq); qq = fmaf(b2, b2, qq); } }
      { auto rr = __builtin_amdgcn_permlane32_swap(__float_as_uint(qq), __float_as_uint(qq), false, false); qq = __uint_as_float(rr[0]) + __uint_as_float(rr[1]); }
      const int bq = k0row >= TT ? 1 : 0;
      const float k2 = __uint_as_float(((const unsigned*)(p.ws + OFF_CNT))[128 + bq * 8 + h * 2 + GRP]);
      mnC = -sqrtf(qq * k2) * (A2_SCALE * 1.4426950408889634f) * 1.0001f; }
    const int sr = tid >> 4, sc = (tid & 15) * 8, vst0 = v_st(sr, sc), vst1 = v_st(32 + sr, sc);
    const int vb0 = (int)(uintptr_t)V_lds + v_rd_base(lane);
    u32x4 e_vs0, e_vs1, e_ks0, e_ks1;
#define A2_SLOAD(S, kk) do { S##_vs0 = *reinterpret_cast<const u32x4*>(Vh + (size_t)((kk) + sr) * 512 + sc); S##_vs1 = *reinterpret_cast<const u32x4*>(Vh + (size_t)((kk) + 32 + sr) * 512 + sc); \
    S##_ks0 = *reinterpret_cast<const u32x4*>(Kh + (size_t)((kk) + sr) * 512 + sc); S##_ks1 = *reinterpret_cast<const u32x4*>(Kh + (size_t)((kk) + 32 + sr) * 512 + sc); } while (0)
#define A2_SWRITE(b, S) do { *reinterpret_cast<u32x4*>(V_lds + (b) * A2_T + vst0) = S##_vs0; *reinterpret_cast<u32x4*>(V_lds + (b) * A2_T + vst1) = S##_vs1; \
    *reinterpret_cast<u32x4*>(K_lds + (b) * A2_T + KSWZ(sr, sc * 2)) = S##_ks0; *reinterpret_cast<u32x4*>(K_lds + (b) * A2_T + KSWZ(32 + sr, sc * 2)) = S##_ks1; } while (0)
#define A2_SWAIT() asm volatile("s_waitcnt vmcnt(0)" ::: "memory")
    f32x16 pA0, pA1, pB0, pB1; bf16x8 pa0, pa1, pa2, pa3; const int NT = seq / 64;
    __syncthreads();
    A2_SLOAD(e, 0); A2_SWAIT(); A2_SWRITE(0, e); A2_SLOAD(e, 64); __syncthreads();
    a2_qkt(pA0, pA1, K_lds, qr, r32, hi, GRP); a2_partialSM(pA0, pA1, mnC);
    A2_SWAIT(); A2_SWRITE(1, e); if (2 < NT) A2_SLOAD(e, 128); __syncthreads();
    int bp = 0, bc = 1, bn = 2;
#define A2_HALF(X0, X1, Y0, Y1, J) do { \
        SBAR(); a2_qkt(X0, X1, K_lds + bc * A2_T, qr, r32, hi, GRP); \
        a2_finishSM(Y0, Y1, l_reg, pa0, pa1, pa2, pa3); SBAR(); \
        if ((J) + 1 < NT) { A2_SWAIT(); A2_SWRITE(bn, e); if ((J) + 2 < NT) A2_SLOAD(e, ((J) + 2) * 64); } SBAR(); \
        a2_pv(o, vb0 + bp * A2_T, pa0, pa1, pa2, pa3, X0, X1, mnC); \
        __syncthreads(); \
        { const int t_ = bp; bp = bc; bc = bn; bn = t_; } } while (0)
    for (int j = 1; j + 1 < NT; j += 2) {
        A2_HALF(pB0, pB1, pA0, pA1, j);
        A2_HALF(pA0, pA1, pB0, pB1, j + 1);
    }
    A2_HALF(pB0, pB1, pA0, pA1, NT - 1);
    a2_finishSM(pB0, pB1, l_reg, pa0, pa1, pa2, pa3); SBAR();
    a2_pv_last(o, vb0 + bp * A2_T, pa0, pa1, pa2, pa3);
#undef A2_HALF
#undef A2_SLOAD
#undef A2_SWRITE
#undef A2_SWAIT
    asm volatile("s_waitcnt vmcnt(0)" ::: "memory");
    int tz = threadIdx.x; asm volatile("" : "+v"(tz));
    const int wq_e = (tz >> 6) & 3, r32e = tz & 31, hie = (tz >> 5) & 1;
    float* li_e = (float*)(lds + 6 * A2_T) + (tz >> 6) * 64;
    const float lam = ((const float*)(p.ws + OFF_LAM))[0];
    { auto rr = __builtin_amdgcn_permlane32_swap(__float_as_uint(l_reg), __float_as_uint(l_reg), false, false); l_reg = __uint_as_float(rr[0]) + __uint_as_float(rr[1]); }
    if (hie == 0) li_e[r32e] = (GRP == 0 ? 1.f : -lam) / l_reg;
    asm volatile("s_waitcnt lgkmcnt(0)" ::: "memory");
#pragma unroll
    for (int r = 0; r < 16; ++r) { const float sc_ = li_e[crow(r, hie)];
#pragma unroll
        for (int d = 0; d < 4; ++d) o[d][r] *= sc_; }
    float* xb = (float*)lds;
    __syncthreads();
    if (GRP == 1) {
#pragma unroll
        for (int d = 0; d < 4; ++d)
#pragma unroll
            for (int r = 0; r < 16; ++r) xb[(wq_e * 32 + crow(r, hie)) * 128 + d * 32 + r32e] = o[d][r];
    }
    __syncthreads();
    if (GRP == 0) {
        float ssq[16];
#pragma unroll
        for (int r = 0; r < 16; ++r) { float s_ = 0.f;
#pragma unroll
            for (int d = 0; d < 4; ++d) { const float v = o[d][r] + xb[(wq_e * 32 + crow(r, hie)) * 128 + d * 32 + r32e]; o[d][r] = v; s_ = fmaf(v, v, s_); }
            ssq[r] = s_; }
#pragma unroll
        for (int r = 0; r < 16; ++r) { float s_ = ssq[r]; for (int of = 16; of; of >>= 1) s_ += __shfl_xor(s_, of); ssq[r] = rsqrtf(s_ * (1.f / 128.f) + 1e-6f) * 0.8f; }
        u16* mix = (u16*)(p.ws + OFF_ACT);
#pragma unroll
        for (int d = 0; d < 4; ++d) { const float gv = p.subln_g[d * 32 + r32e];
#pragma unroll
            for (int r = 0; r < 16; ++r) mix[(size_t)(q0 + wq_e * 32 + crow(r, hie)) * 1024 + h * 128 + d * 32 + r32e] = f2bf(o[d][r] * ssq[r] * gv); }
    }
}
DEVI void phase_attn(const P& p, char* lds) {
    const int G = gridDim.x;
    for (int it = blockIdx.x; it < 1024 + 16; it += G) {
        int q0, k0, seq, h;
        if (it < 1024) {
            int bh, qb;
            if ((G & 7) == 0) { bh = it & 7; qb = it >> 3; } else { bh = it >> 7; qb = it & 127; }
            const int b = bh >> 2; h = bh & 3; q0 = b * TT + TC + qb * 128; k0 = b * TT; seq = TT;
        } else { const int j = it - 1024, b = j >> 3; h = (j >> 1) & 3; q0 = b * TT + (j & 1) * 128; k0 = b * TT; seq = TC; }
        int tid = threadIdx.x; asm volatile("" : "+v"(tid));
        a2_body(p, q0, k0, seq, h, lds, tid);
    }
}
DEVI void phase_mlstm_c(const P& p, char* lds) {
    for (int it = blockIdx.x; it < NB * 4 * NCH; it += gridDim.x) mlstm_c_item(p, it, lds);
}

DEVI void phase_convert_l1(const P& p, char* lds) {
    for (int it = blockIdx.x; it < N0_EXP; it += gridDim.x) convert_expert_item(p, 1, it, (float*)lds);
}

constexpr int NPHASE = 19;
__global__ void __launch_bounds__(NTHR, 2) fwd_kernel(P p_) {
    extern __shared__ __attribute__((aligned(16))) char lds[];
    volatile LAS unsigned* st = (volatile LAS unsigned*)(lds + LDS_BYTES - 16);
    if (threadIdx.x == 0) { st[0] = 0u; st[1] = 0u; st[2] = 0u; st[3] = 0u; }
    __syncthreads();
    const int lo = p_.ph_lo, hi = p_.ph_hi;
    XcdBarrier bar; bar.bar = (unsigned*)(p_.ws + OFF_BAR); bar.x = 0; bar.st = st;
    if (hi - lo > 1) bar = xcd_barrier_post((unsigned*)(p_.ws + OFF_BAR), st);
#if defined(__HIP_DEVICE_COMPILE__)
#define PARAMS() const __attribute__((address_space(4))) P* kp_ = (const __attribute__((address_space(4))) P*)__builtin_amdgcn_kernarg_segment_ptr(); asm volatile("" : "+s"(kp_)); const P p = *kp_
#else
#define PARAMS() const P p = p_
#endif
#ifndef PHSEL
#define PHON(k) true
#else
#define PHON(k) ((k) == PHSEL)
#endif
#define IN(k) (lo <= (k) && (k) < hi)
#define SEAM(k) do { if (IN(k) && IN((k) + ((k) == 5 ? 2 : 1))) xcd_barrier(bar); } while (0)
    if (PHON(0) && IN(0)) { PARAMS(); phase_prologue(p, lds); if (((PROBE_DUP) >> 0) & 1u) { phase_prologue(p, lds); } }            SEAM(0);
    if (PHON(1) && IN(1)) { PARAMS(); phase_norm<0>(p, lds); if (((PROBE_DUP) >> 1) & 1u) { phase_norm<0>(p, lds); } }             SEAM(1);
    if (PHON(2) && IN(2)) { PARAMS(); phase_inproj(p, lds); if (((PROBE_DUP) >> 2) & 1u) { phase_inproj(p, lds); } }              SEAM(2);
    if (PHON(3) && IN(3)) { PARAMS(); phase_mlstm_a(p, lds); if (((PROBE_DUP) >> 3) & 1u) { phase_mlstm_a(p, lds); } }             SEAM(3);
    if (PHON(4) && IN(4)) { PARAMS(); phase_kmax(p, lds); phase_mlstm_b(p, lds); if (((PROBE_DUP) >> 4) & 1u) { xcd_barrier(bar); phase_mlstm_a(p, lds); xcd_barrier(bar); phase_mlstm_b(p, lds); } }             SEAM(4);
    if (PHON(5) && IN(5)) { PARAMS(); phase_attn(p, lds); phase_mlstm_c(p, lds); if (((PROBE_DUP) >> 5) & 1u) { phase_attn(p, lds); } if (((PROBE_DUP) >> 6) & 1u) { phase_mlstm_c(p, lds); } }   SEAM(5);
    if (PHON(7) && IN(7)) { PARAMS(); phase_outproj(p, lds); if (((PROBE_DUP) >> 7) & 1u) { phase_outproj(p, lds); } }             SEAM(7);
    if (PHON(8) && IN(8)) { PARAMS(); phase_norm<1>(p, lds); if (((PROBE_DUP) >> 8) & 1u) { phase_norm<1, true>(p, lds); } }             SEAM(8);
    if (PHON(9) && IN(9)) { PARAMS(); phase_moe_up(p, 0, lds); if (((PROBE_DUP) >> 9) & 1u) { phase_moe_up(p, 0, lds); } }           SEAM(9);
    if (PHON(10) && IN(10)) { PARAMS(); phase_moe_down(p, 0, lds); if (((PROBE_DUP) >> 10) & 1u) { phase_moe_down<true>(p, 0, lds); } }        SEAM(10);
    if (PHON(11) && IN(11)) { PARAMS(); phase_norm<2>(p, lds); phase_convert_l1(p, lds); if (((PROBE_DUP) >> 11) & 1u) { phase_norm<2>(p, lds); phase_convert_l1(p, lds); } } SEAM(11);
    if (PHON(12) && IN(12)) { PARAMS(); phase_fnet_gemm(p, lds); if (((PROBE_DUP) >> 12) & 1u) { phase_fnet_gemm(p, lds); } }          SEAM(12);
    if (PHON(13) && IN(13)) { PARAMS(); phase_fft1(p, lds); if (((PROBE_DUP) >> 13) & 1u) { phase_fft1(p, lds); } }               SEAM(13);
    if (PHON(14) && IN(14)) { PARAMS(); phase_fft2(p, lds); if (((PROBE_DUP) >> 14) & 1u) { phase_fft2<true>(p, lds); } }               SEAM(14);
    if (PHON(15) && IN(15)) { PARAMS(); phase_norm<3>(p, lds); if (((PROBE_DUP) >> 15) & 1u) { phase_norm<3, true>(p, lds); } }            SEAM(15);
    if (PHON(16) && IN(16)) { PARAMS(); phase_moe_up(p, 1, lds); if (((PROBE_DUP) >> 16) & 1u) { phase_moe_up(p, 1, lds); } }          SEAM(16);
    if (PHON(17) && IN(17)) { PARAMS(); phase_moe_down(p, 1, lds); if (((PROBE_DUP) >> 17) & 1u) { phase_moe_down<true>(p, 1, lds); } }        SEAM(17);
    if (PHON(18) && IN(18)) { PARAMS(); phase_norm<4>(p, lds); if (((PROBE_DUP) >> 18) & 1u) { phase_norm<4>(p, lds); } }
#undef IN
#undef SEAM
}

#ifndef ONE_LAUNCH
#define ONE_LAUNCH 1
#endif
extern "C" void kernel_launch(void* const* d_in, const int* in_sizes, int n_in, void* d_out, int out_size, void* d_ws, size_t ws_size, hipStream_t stream) {
    static int grid = 0;
    if (grid == 0) {
        if (n_in != 21 || out_size != NLAT * DM || ws_size < OFF_END) { fprintf(stderr, "kernel_launch: unexpected shapes (n_in %d out %d ws %zu need %zu)\n", n_in, out_size, ws_size, (size_t)OFF_END); grid = -1; return; }
        int dev = 0, cus = 0;
        if (hipGetDevice(&dev) != hipSuccess || hipDeviceGetAttribute(&cus, hipDeviceAttributeMultiprocessorCount, dev) != hipSuccess) { grid = -1; return; }
        if (hipFuncSetAttribute((const void*)fwd_kernel, hipFuncAttributeMaxDynamicSharedMemorySize, LDS_BYTES) != hipSuccess) { fprintf(stderr, "kernel_launch: hipFuncSetAttribute failed\n"); grid = -1; return; }
        int per_cu = 0;
        if (hipOccupancyMaxActiveBlocksPerMultiprocessor(&per_cu, (const void*)fwd_kernel, NTHR, LDS_BYTES) != hipSuccess || per_cu < 1) { fprintf(stderr, "kernel_launch: occupancy query says %d\n", per_cu); (void)hipGetLastError(); grid = -1; return; }
        grid = cus;
    }
    if (grid < 0) return;
    (void)hipMemsetAsync(d_ws, 0, ZERO_BYTES, stream);
    P p{};
    const float* const* in = (const float* const*)d_in;
    p.x = in[0]; p.c = in[1]; p.ctx = in[2]; p.c_ctx = in[3]; p.ada_w = in[4]; p.ada_b = in[5]; p.nmix_g = in[6]; p.nffn_g = in[7];
    p.w_in = in[8]; p.w_out = in[9]; p.conv_w = in[10]; p.gate_b = in[11]; p.lamv = in[12]; p.subln_g = in[13]; p.w_fnet = in[14];
    p.router_w = in[15]; p.router_b = in[16]; p.w_gate = in[17]; p.w_up = in[18]; p.w_down = in[19]; p.final_g = in[20];
    p.out = (float*)d_out; p.ws = (char*)d_ws;
#if ONE_LAUNCH
    p.ph_lo = 0; p.ph_hi = NPHASE;
    hipLaunchKernelGGL(fwd_kernel, dim3(grid), dim3(NTHR), LDS_BYTES, stream, p);
#else
    for (int k = 0; k < NPHASE; ++k) { p.ph_lo = k; p.ph_hi = k + 1; hipLaunchKernelGGL(fwd_kernel, dim3(grid), dim3(NTHR), LDS_BYTES, stream, p); }
#endif
}
```

```cpp
#include <hip/hip_runtime.h>
#include <stdint.h>
#include <stdio.h>

#define DEVI __device__ __forceinline__
#define PROBE_DUP (0u)
typedef unsigned short u16;
typedef unsigned int u32;
using bf16x8 = __attribute__((ext_vector_type(8))) short;
using s16x4  = __attribute__((ext_vector_type(4))) short;
using f32x16 = __attribute__((ext_vector_type(16))) float;
using f32x4  = __attribute__((ext_vector_type(4))) float;
using u32x4  = __attribute__((ext_vector_type(4))) unsigned;
using u32x2  = __attribute__((ext_vector_type(2))) unsigned;

constexpr int DM = 1024, NB = 2, TL = 16384, TC = 256, TT = TL + TC, NTOK = NB * TT, NLAT = NB * TL;
constexpr int NCH = TT / 128;
constexpr int NTHR = 512;
constexpr int LDS_BYTES = 147456;

constexpr size_t al256(size_t x) { return (x + 255) / 256 * 256; }
constexpr size_t OFF_BAR   = 0;
constexpr size_t OFF_CNT   = 16384;
constexpr size_t ZERO_BYTES = 20480;
constexpr size_t OFF_MOD   = ZERO_BYTES;
constexpr size_t OFF_ROPER = OFF_MOD + al256(2 * 3 * 6144 * 4);
constexpr size_t OFF_ROPEC = OFF_ROPER + 256 * 16 * 8;
constexpr size_t OFF_TW    = OFF_ROPEC + 64 * 16 * 8;
constexpr size_t OFF_DFTC  = OFF_TW + 16384 * 8;
constexpr size_t OFF_DFTS  = OFF_DFTC + 32768;
constexpr size_t OFF_LAM   = OFF_DFTS + 32768;
constexpr size_t OFF_WG16  = OFF_LAM + 256;
constexpr size_t OFF_MSCAL = OFF_WG16 + 65536;
constexpr size_t OFF_MST   = OFF_MSCAL + al256(16 * NCH * 8);
constexpr size_t OFF_WINT  = OFF_MST + al256(16 * NCH * 4);
constexpr size_t OFF_WOUTT = OFF_WINT + (size_t)3584 * 1024 * 2;
constexpr size_t OFF_FNT   = OFF_WOUTT + (size_t)1024 * 1024 * 2;
constexpr size_t OFF_WGU   = OFF_FNT + (size_t)2048 * 1024 * 2;
constexpr size_t OFF_WDT   = OFF_WGU + (size_t)16 * 1024 * 1024 * 2;
constexpr size_t OFF_ACT   = OFF_WDT + (size_t)16 * 1024 * 512 * 2;
constexpr size_t SZ_ACT    = (size_t)NTOK * 1024 * 2;
constexpr size_t OFF_XC    = OFF_ACT + SZ_ACT;
constexpr size_t OFF_GATES = OFF_XC + (size_t)NB * TC * 1024 * 4;
constexpr size_t OFF_TOKW  = OFF_GATES + (size_t)NTOK * 16 * 4;
constexpr size_t OFF_LIST  = OFF_TOKW + al256((size_t)NTOK * 8);
constexpr size_t OFF_NST   = OFF_LIST + (size_t)24 * NTOK * 4;
constexpr size_t OFF_CST   = OFF_NST + (size_t)16 * NCH * 128 * 4;
constexpr size_t SZ_CST    = (size_t)16 * NCH * 16384 * 2;
constexpr size_t OFF_BIG   = OFF_CST + SZ_CST;
constexpr size_t OFF_Q     = OFF_BIG;
constexpr size_t OFF_K     = OFF_Q + (size_t)NTOK * 512 * 2;
constexpr size_t OFF_V     = OFF_K + (size_t)NTOK * 512 * 2;
constexpr size_t OFF_MLQK  = OFF_V + (size_t)NTOK * 512 * 2;
constexpr size_t OFF_MLV   = OFF_MLQK + (size_t)NTOK * 1024 * 2;
constexpr size_t OFF_OG    = OFF_MLV + (size_t)NTOK * 512 * 2;
constexpr size_t OFF_MLC   = OFF_OG + (size_t)NTOK * 512 * 2;
constexpr size_t OFF_END   = OFF_MLC + (size_t)NTOK * 1024 * 2;
constexpr size_t OFF_HE    = OFF_BIG;
constexpr size_t OFF_ZR    = OFF_BIG;
constexpr size_t OFF_ZI    = OFF_ZR + (size_t)NLAT * 1024 * 2;
constexpr size_t OFF_WGU1  = OFF_MLV + (size_t)2 * 1024 * 1024;
constexpr size_t OFF_WDT1  = OFF_WGU1 + (size_t)16 * 1024 * 1024 * 2;
static_assert(OFF_WDT1 + (size_t)16 * 1024 * 512 * 2 <= OFF_MLC && OFF_WGU1 >= OFF_BIG + (size_t)NLAT * 2048 * 2, "layer-1 expert region");
constexpr size_t OFF_YR    = OFF_CST;
constexpr size_t OFF_YI    = OFF_ACT;
static_assert((size_t)NLAT * 1024 * 2 <= SZ_CST && (size_t)NLAT * 1024 * 2 <= SZ_ACT, "alias sizes");
static_assert(OFF_END < (size_t)508 * 1024 * 1024, "workspace");

struct P {
    const float *x, *c, *ctx, *c_ctx, *ada_w, *ada_b, *nmix_g, *nffn_g, *w_in, *w_out, *conv_w, *gate_b, *lamv, *subln_g,
                *w_fnet, *router_w, *router_b, *w_gate, *w_up, *w_down, *final_g;
    float* out;
    char* ws;
    int ph_lo, ph_hi;
};

#define XB_TMO      128
#define XB_XCNT(j)  (256  + 64 * (j))
#define XB_XSUB(j)  (1280 + 64 * (j))
#define XB_XGEN(j)  (2304 + 64 * (j))
#define XB_TOP      3328
#define XB_TOPGEN   3392
#define XCD_BAR_WORDS 3456
#define XB_SPIN_CAP (1u << 18)
#define LAS __attribute__((address_space(3)))

__device__ __forceinline__ unsigned xb_ld(unsigned* p)              { return __hip_atomic_load(p, __ATOMIC_RELAXED, __HIP_MEMORY_SCOPE_AGENT); }
__device__ __forceinline__ unsigned xb_add(unsigned* p, unsigned v) { return __hip_atomic_fetch_add(p, v, __ATOMIC_RELAXED, __HIP_MEMORY_SCOPE_AGENT); }
__device__ __forceinline__ unsigned xb_xcc_id() { return (unsigned)__builtin_amdgcn_s_getreg((3 << 11) | 20) & 0xFu; }
#define XB_SPIN(cond, bar) do { unsigned _sp = 0; while (cond) { __builtin_amdgcn_s_sleep(1); \
    if ((++_sp & 255u) == 0u) { if (xb_ld(&(bar)[XB_TMO])) break; if (_sp > XB_SPIN_CAP) { atomicAdd(&(bar)[XB_TMO], 1u); break; } } } } while (0)

struct XcdBarrier { unsigned* bar; unsigned x; volatile LAS unsigned* st; };

__device__ __forceinline__ XcdBarrier xcd_barrier_post(unsigned* bar, volatile LAS unsigned* st) {
    XcdBarrier b; b.bar = bar; b.x = xb_xcc_id(); b.st = st;
    if (threadIdx.x == 0) (void)xb_add(&bar[XB_XCNT(b.x)], 1u);
    return b;
}
__device__ __forceinline__ void xcd_barrier_complete(unsigned* bar, unsigned x, unsigned& nloc, unsigned& nx) {
    const unsigned G = gridDim.x * gridDim.y * gridDim.z;
    unsigned sum, cnt, mine, sp = 0u;
    for (;;) {
        sum = 0u; cnt = 0u; mine = 0u;
#pragma unroll
        for (unsigned j = 0; j < 16; ++j) { const unsigned c = xb_ld(&bar[XB_XCNT(j)]); sum += c; cnt += (c > 0u) ? 1u : 0u; mine = (j == x) ? c : mine; }
        if (sum == G) break;
        __builtin_amdgcn_s_sleep(1);
        if ((++sp & 255u) == 0u) { if (xb_ld(&bar[XB_TMO])) break; if (sp > XB_SPIN_CAP) { atomicAdd(&bar[XB_TMO], 1u); break; } }
    }
    nloc = mine > 0u ? mine : 1u; nx = cnt > 0u ? cnt : 1u;
}
__device__ __forceinline__ void xcd_barrier(const XcdBarrier& b) {
    asm volatile("s_waitcnt vmcnt(0)" ::: "memory");
    __syncthreads();
    if (threadIdx.x == 0) {
        unsigned* bar = b.bar;
        __builtin_amdgcn_s_waitcnt(0);
        unsigned nloc = b.st[0], nx = b.st[1];
        if (nloc == 0u) { xcd_barrier_complete(bar, b.x, nloc, nx); b.st[0] = nloc; b.st[1] = nx; }
        const unsigned old = xb_add(&bar[XB_XSUB(b.x)], 1u);
        const unsigned gen = old / nloc;
        if (old + 1u == (gen + 1u) * nloc) {
            __builtin_amdgcn_fence(__ATOMIC_RELEASE, "agent");
            asm volatile("s_waitcnt vmcnt(0)" ::: "memory");
            const unsigned og = xb_add(&bar[XB_TOP], 1u);
            const unsigned tg = og / nx;
            if (og + 1u == (tg + 1u) * nx) xb_add(&bar[XB_TOPGEN], 1u);
            else XB_SPIN(xb_ld(&bar[XB_TOPGEN]) == tg, bar);
            __builtin_amdgcn_fence(__ATOMIC_ACQUIRE, "agent");
            xb_add(&bar[XB_XGEN(b.x)], 1u);
            asm volatile("s_waitcnt vmcnt(0)" ::: "memory");
        } else {
            XB_SPIN(xb_ld(&bar[XB_XGEN(b.x)]) == gen, bar);
            __builtin_amdgcn_fence(__ATOMIC_ACQUIRE, "agent");
            asm volatile("s_waitcnt vmcnt(0)" ::: "memory");
        }
    }
    __syncthreads();
}

DEVI u16 f2bf(float f) { u32 u = __float_as_uint(f); u += 0x7fffu + ((u >> 16) & 1u); return (u16)(u >> 16); }
DEVI float bf2f(u32 h) { return __uint_as_float(h << 16); }
DEVI u32 cvtpk(float lo, float hi) { u32 r; asm("v_cvt_pk_bf16_f32 %0, %1, %2" : "=v"(r) : "v"(lo), "v"(hi)); return r; }
DEVI float bflo(u32 w) { return __uint_as_float(w << 16); }
DEVI float bfhi(u32 w) { return __uint_as_float(w & 0xffff0000u); }
DEVI int crow(int r, int hi) { return (r & 3) + 8 * (r >> 2) + 4 * hi; }
DEVI float wave_sum(float v) { for (int o = 32; o; o >>= 1) v += __shfl_xor(v, o); return v; }
DEVI float wave_max(float v) { for (int o = 32; o; o >>= 1) v = fmaxf(v, __shfl_xor(v, o)); return v; }
DEVI float sigmoidf_(float x) { return 1.f / (1.f + __expf(-x)); }
DEVI float siluf_(float x) { return x / (1.f + __expf(-x)); }
DEVI float logsigmoidf_(float x) { return fminf(x, 0.f) - log1pf(__expf(-fabsf(x))); }
#define SBAR() __builtin_amdgcn_sched_barrier(0)

DEVI void sincos2pi(double frac, double& s, double& c) {
    frac -= floor(frac);
    double q = rint(frac * 4.0);
    double r = (frac - q * 0.25) * 6.283185307179586476925;
    double r2 = r * r;
    double sr = r * (1.0 + r2 * (-1.0 / 6 + r2 * (1.0 / 120 + r2 * (-1.0 / 5040 + r2 * (1.0 / 362880 + r2 * (-1.0 / 39916800 + r2 * (1.0 / 6227020800.0 + r2 * (-1.0 / 1307674368000.0))))))));
    double cr = 1.0 + r2 * (-0.5 + r2 * (1.0 / 24 + r2 * (-1.0 / 720 + r2 * (1.0 / 40320 + r2 * (-1.0 / 3628800 + r2 * (1.0 / 479001600.0 + r2 * (-1.0 / 87178291200.0 + r2 * (1.0 / 20922789888000.0))))))));
    int qi = ((int)q) & 3;
    if (qi == 0) { s = sr; c = cr; } else if (qi == 1) { s = cr; c = -sr; } else if (qi == 2) { s = -sr; c = -cr; } else { s = -cr; c = sr; }
}

DEVI float* xs_ptr(const P& p, int layer, int tok) {
    if (layer == 0) {
        int b = tok >= TT ? 1 : 0, t = tok - b * TT;
        if (t < TC) return (float*)(p.ws + OFF_XC) + (size_t)(b * TC + t) * DM;
        return p.out + (size_t)(b * TL + t - TC) * DM;
    }
    return p.out + (size_t)tok * DM;
}
DEVI const float* xin_ptr(const P& p, int tok) {
    int b = tok >= TT ? 1 : 0, t = tok - b * TT;
    if (t < TC) return p.ctx + (size_t)(b * TC + t) * DM;
    return p.x + (size_t)(b * TL + t - TC) * DM;
}
DEVI int modsel(int layer, int tok) {
    if (layer == 0) { int b = tok >= TT ? 1 : 0, t = tok - b * TT; return t < TC ? 2 : b; }
    return tok >> 14;
}

DEVI int swz128(int row, int chunk) { return row * 144 + (chunk << 4); }
DEVI int swz256(int row, int chunk) { return row * 272 + (chunk << 4); }
DEVI int v_st(int k, int c) { const int kk = (k & ~0xC) | ((k & 4) << 1) | ((k & 8) >> 1); return ((kk >> 3) * 4 + (c >> 5)) * 512 + ((kk & 7) * 32 + (c & 31)) * 2; }
DEVI int v_rd_base(int lane) { return ((lane & 3) << 3) | (((lane >> 2) & 3) << 6) | (((lane >> 4) & 1) << 5) | (((lane >> 5) & 1) << 8); }
constexpr int v_rd_off(int d0, int ks, int half) { return d0 * 512 + ks * 4096 + half * 2048; }
template <int OFF> DEVI s16x4 tr_read(int vb) {
    s16x4 r; asm volatile("ds_read_b64_tr_b16 %0, %1 offset:%2" : "=&v"(r) : "v"(vb), "i"(OFF) : "memory"); return r;
}
#define PKLH(L, H) (bf16x8){L[0], L[1], L[2], L[3], H[0], H[1], H[2], H[3]}
template <int D0, int KS> DEVI void tr_frag_issue(int vb, s16x4& l, s16x4& h) { l = tr_read<v_rd_off(D0, KS, 0)>(vb); h = tr_read<v_rd_off(D0, KS, 1)>(vb); }
#define LGKM0() do { asm volatile("s_waitcnt lgkmcnt(0)" ::: "memory"); SBAR(); } while (0)

DEVI bf16x8 lds_b128(const char* base, int off) { return *reinterpret_cast<const bf16x8*>(base + off); }

DEVI void pack_p(const f32x16& pp, bf16x8& f0, bf16x8& f1) {
#define PK4(BASE, OUT) do { unsigned a0 = cvtpk(pp[BASE + 0], pp[BASE + 1]), a1 = cvtpk(pp[BASE + 2], pp[BASE + 3]);   \
    unsigned b0 = cvtpk(pp[BASE + 4], pp[BASE + 5]), b1 = cvtpk(pp[BASE + 6], pp[BASE + 7]);                            \
    auto r0 = __builtin_amdgcn_permlane32_swap(a0, b0, false, false); auto r1 = __builtin_amdgcn_permlane32_swap(a1, b1, false, false); \
    u32x4 w = {r0[0], r1[0], r0[1], r1[1]}; OUT = *reinterpret_cast<bf16x8*>(&w); } while (0)
    PK4(0, f0); PK4(8, f1);
#undef PK4
}

namespace g8 {
constexpr int BM = 256, BK = 64, HALF = 128, HTB = HALF * BK * 2, STAGE_BYTES = 8 * HTB, NXCD = 8, WGM = 8;
DEVI int lds_byte(int r, int c) { const int st = (r >> 4) * 2 + (c >> 5), rr = r & 15, cc = c & 31, ob = rr * 64 + cc * 2; return st * 1024 + (ob ^ (((ob >> 9) & 1) << 5)); }
DEVI void stage_rc(int b, int& R, int& C) { const int st = b / 1024, sb = b % 1024, swz = sb ^ (((sb >> 9) & 1) << 5); R = (st >> 1) * 16 + swz / 64; C = (st & 1) * 32 + (swz % 64) / 2; }
DEVI int perm32(int rho) { const int n = rho >> 4, i = rho & 15; return 8 * (i >> 2) + 4 * n + (i & 3); }
struct Unit { int pm, pn; const char* B0; const char* B1; int cls, r0, ncls; };
DEVI bool tile_order(int i, int G, int c, int nM, int nN, int& pm, int& pn) {
    const int nwg = nM * nN; const long L = (long)i * G + c; if (L >= nwg) return false;
    int wgid = (int)L; { const int q = nwg / NXCD, r = nwg % NXCD, xcd = wgid % NXCD, off = wgid / NXCD; wgid = (xcd < r ? xcd * (q + 1) : r * (q + 1) + (xcd - r) * q) + off; }
    const int nig = WGM * nN, gid = wgid / nig, fm = gid * WGM, gsz = (nM - fm) < WGM ? (nM - fm) : WGM;
    pm = fm + ((wgid % nig) % gsz); pn = (wgid % nig) / gsz; return true;
}
typedef float f32x4v __attribute__((ext_vector_type(4)));
template <class Epi, class Sched>
DEVI void gemm_phase(LAS unsigned char* lds, const char* Abase, int ldbB  , int ksplit  , const Sched& S, const Epi& E) {
    const int tid = threadIdx.x, wid = __builtin_amdgcn_readfirstlane(tid >> 6), lane = tid & 63, wr = wid >> 2, wc = wid & 3, fr = lane & 15, fq = lane >> 4;
    constexpr int nt = 1024 / BK;
    unsigned voffB[2];
#pragma unroll
    for (int i = 0; i < 2; ++i) { int R, C; stage_rc(tid * 16 + i * 8192, R, C); const int Rb = Epi::PERM ? ((R & ~31) + perm32(R & 31)) : R; voffB[i] = (unsigned)(Rb * ldbB + C * 2); }
    const size_t kstep = (size_t)(BK * 2);
    const size_t hstepB = (size_t)HALF * ldbB;
    const unsigned ldsw = (unsigned)wid * 1024u;
    const int aoff = lds_byte(wr * 64 + fr, fq * 8), boff = lds_byte(wc * 32 + fr, fq * 8);
#define G8_SA(b, h) (((b) * 2 + (h)) * HTB)
#define G8_SB(b, h) ((4 + (b) * 2 + (h)) * HTB)
#define G8_STAGE(bufoff, gbase, voff) do { _Pragma("unroll") for (int _i = 0; _i < 2; ++_i) \
        __builtin_amdgcn_global_load_lds((const unsigned*)((const char*)(gbase) + (voff)[_i]), (LAS unsigned*)(lds + (bufoff) + ldsw + _i * 8192), 16, 0, 0); } while (0)
#define G8_LDA(dst, b, h) do { _Pragma("unroll") for (int m = 0; m < 4; ++m) _Pragma("unroll") for (int k = 0; k < 2; ++k) dst[m][k] = *(const LAS bf16x8*)(lds + G8_SA(b, h) + aoff + m * 2048 + k * 1024); } while (0)
#define G8_LDB(dst, b, h) do { _Pragma("unroll") for (int n = 0; n < 2; ++n) _Pragma("unroll") for (int k = 0; k < 2; ++k) dst[n][k] = *(const LAS bf16x8*)(lds + G8_SB(b, h) + boff + n * 2048 + k * 1024); } while (0)
#define G8_MMA(ai, bj, At, Bt) do { __builtin_amdgcn_s_setprio(1); _Pragma("unroll") for (int m = 0; m < 4; ++m) _Pragma("unroll") for (int n = 0; n < 2; ++n) _Pragma("unroll") for (int k = 0; k < 2; ++k) \
        acc[ai][bj][m][n] = __builtin_amdgcn_mfma_f32_16x16x32_bf16(Bt[n][k], At[m][k], acc[ai][bj][m][n], 0, 0, 0); __builtin_amdgcn_s_setprio(0); } while (0)
#define G8_WAIT_V(n) asm volatile("s_waitcnt vmcnt(" #n ")" ::: "memory")
#define G8_WAIT_L(n) asm volatile("s_waitcnt lgkmcnt(" #n ")" ::: "memory")
#define G8_BAR __builtin_amdgcn_s_barrier()
#define G8_SCHED __builtin_amdgcn_sched_barrier(0)
#define G8_BPTR(u, kt) (((kt) < ksplit ? (u).B0 : (u).B1) + (size_t)(kt) * kstep)
    Unit cur, nxt; int ui = 0;
    if (!S.next(0, cur)) return;
    f32x4v acc[2][2][4][2];
#pragma unroll
    for (int a = 0; a < 2; ++a)
#pragma unroll
        for (int b = 0; b < 2; ++b)
#pragma unroll
            for (int m = 0; m < 4; ++m)
#pragma unroll
                for (int n = 0; n < 2; ++n) acc[a][b][m][n] = (f32x4v){0.f, 0.f, 0.f, 0.f};
    bf16x8 At[4][2], B0[2][2], B1[2][2];
    unsigned voffA[2]; unsigned vs[2][2];
    constexpr size_t hstepA = (size_t)HALF * 2048, tstepA = 2 * hstepA;
    if constexpr (Sched::GATHER) S.aoffs(cur, vs);
    else {
#pragma unroll
        for (int i = 0; i < 2; ++i) { int R, C; stage_rc(tid * 16 + i * 8192, R, C); voffA[i] = (unsigned)(R * 2048 + C * 2); }
    }
    const char* cA = Sched::GATHER ? Abase : Abase + (size_t)cur.pm * tstepA;
#define G8_STAGE_A(bufoff, ptr, h) do { if constexpr (Sched::GATHER) G8_STAGE(bufoff, ptr, vs[h]); else G8_STAGE(bufoff, (ptr) + (h) * hstepA, voffA); } while (0)
    { const char* cB = G8_BPTR(cur, 0); const char* cB1 = G8_BPTR(cur, 1);
      G8_STAGE(G8_SB(0, 0), cB, voffB); G8_STAGE_A(G8_SA(0, 0), cA, 0); G8_STAGE(G8_SB(0, 1), cB + hstepB, voffB); G8_STAGE_A(G8_SA(0, 1), cA, 1);
      if (wr == 1) G8_BAR;
      G8_WAIT_V(4); G8_BAR;
      G8_STAGE(G8_SB(1, 0), cB1, voffB); G8_STAGE_A(G8_SA(1, 0), cA + kstep, 0); G8_STAGE(G8_SB(1, 1), cB1 + hstepB, voffB);
      G8_WAIT_V(6); G8_BAR; }
    for (;;) {
        bool has_next = false; const char* nA = cA;
        for (int t = 0; t < nt; t += 2) {
            const bool last = (t == nt - 2);
            const char* a1 = cA + (size_t)(t + 1) * kstep;
            G8_LDB(B0, 0, 0); G8_SCHED; G8_LDA(At, 0, 0); G8_STAGE_A(G8_SA(1, 1), a1, 1);
            G8_WAIT_L(8); G8_BAR; G8_WAIT_L(0); G8_MMA(0, 0, At, B0); G8_BAR; G8_SCHED;
            if (last) {
                has_next = S.next(ui + 1, nxt);
                if (has_next) { if constexpr (Sched::GATHER) S.aoffs(nxt, vs); else nA = Abase + (size_t)nxt.pm * tstepA; } else nxt = cur;
            }
            const char* a2 = last ? nA : cA + (size_t)(t + 2) * kstep; const char* a3 = a2 + kstep;
            const char* b2 = last ? G8_BPTR(nxt, 0) : G8_BPTR(cur, t + 2); const char* b3 = last ? G8_BPTR(nxt, 1) : G8_BPTR(cur, t + 3);
            G8_LDB(B1, 0, 1); G8_STAGE(G8_SB(0, 0), b2, voffB);
            G8_BAR; G8_WAIT_L(0); G8_MMA(0, 1, At, B1); G8_BAR;
            G8_LDA(At, 0, 1); G8_STAGE_A(G8_SA(0, 0), a2, 0);
            G8_BAR; G8_WAIT_L(0); G8_MMA(1, 0, At, B0); G8_BAR; G8_SCHED;
            G8_STAGE(G8_SB(0, 1), b2 + hstepB, voffB);
            G8_WAIT_V(6); G8_BAR; G8_MMA(1, 1, At, B1); G8_BAR;
            G8_LDB(B0, 1, 0); G8_SCHED; G8_LDA(At, 1, 0); G8_STAGE_A(G8_SA(0, 1), a2, 1);
            G8_WAIT_L(8); G8_BAR; G8_WAIT_L(0); G8_MMA(0, 0, At, B0); G8_BAR; G8_SCHED;
            G8_LDB(B1, 1, 1); G8_STAGE(G8_SB(1, 0), b3, voffB);
            G8_BAR; G8_WAIT_L(0); G8_MMA(0, 1, At, B1); G8_BAR;
            G8_LDA(At, 1, 1); G8_STAGE_A(G8_SA(1, 0), a3, 0);
            G8_BAR; G8_WAIT_L(0); G8_MMA(1, 0, At, B0); G8_BAR; G8_SCHED;
            G8_STAGE(G8_SB(1, 1), b3 + hstepB, voffB);
            G8_WAIT_V(6); G8_BAR; G8_MMA(1, 1, At, B1); G8_BAR;
        }
        cA = nA;
        { int tz = threadIdx.x; asm volatile("" : "+v"(tz));
          const int w2 = tz >> 6, l2 = tz & 63; E(acc, cur, w2 >> 2, w2 & 3, l2 & 15, l2 >> 4); }
        if (!has_next) break;
#pragma unroll
        for (int a = 0; a < 2; ++a)
#pragma unroll
            for (int b = 0; b < 2; ++b)
#pragma unroll
                for (int m = 0; m < 4; ++m)
#pragma unroll
                    for (int n = 0; n < 2; ++n) acc[a][b][m][n] = (f32x4v){0.f, 0.f, 0.f, 0.f};
        cur = nxt; ++ui;
    }
    G8_WAIT_V(0);
    if (wr == 0) G8_BAR;
    G8_BAR;
#undef G8_SA
#undef G8_SB
#undef G8_STAGE
#undef G8_STAGE_A
#undef G8_LDA
#undef G8_LDB
#undef G8_MMA
#undef G8_WAIT_V
#undef G8_WAIT_L
#undef G8_BAR
#undef G8_SCHED
#undef G8_BPTR
}
DEVI void lane_rc(int i, int& R, int& C) { int tz = threadIdx.x; asm volatile("" : "+v"(tz)); stage_rc(tz * 16 + i * 8192, R, C); }
struct DenseSched {
    static constexpr bool GATHER = false;
    const char* Bt; int nM, nN, G, c; size_t btile;
    DEVI bool next(int i, Unit& u) const { if (!tile_order(i, G, c, nM, nN, u.pm, u.pn)) return false; u.B0 = u.B1 = Bt + (size_t)u.pn * btile; u.cls = 0; u.r0 = 0; u.ncls = 0; return true; }
    DEVI void aoffs(const Unit& u, unsigned (&v)[2][2]) const {
#pragma unroll
        for (int i = 0; i < 2; ++i) { int R, C; lane_rc(i, R, C);
#pragma unroll
            for (int h = 0; h < 2; ++h) v[h][i] = (unsigned)(((u.pm * 256 + h * 128 + R) * 1024 + C) * 2); }
    }
};
}

template <class PF>
DEVI void transpose_tile(PF colptr, int ldsrc, u16* dst, int lddst, int k0, int n0, float* tl) {
    const int t = threadIdx.x, nn = t & 63, kk = t >> 6;
    const float* sp = colptr(n0 + nn);
#pragma unroll
    for (int i = 0; i < 8; ++i) tl[(kk + 8 * i) * 65 + nn] = sp[(size_t)(k0 + kk + 8 * i) * ldsrc];
    __syncthreads();
    const int n = t >> 3, kc = t & 7;
    u32x4 w;
    w[0] = cvtpk(tl[(kc * 8 + 0) * 65 + n], tl[(kc * 8 + 1) * 65 + n]);
    w[1] = cvtpk(tl[(kc * 8 + 2) * 65 + n], tl[(kc * 8 + 3) * 65 + n]);
    w[2] = cvtpk(tl[(kc * 8 + 4) * 65 + n], tl[(kc * 8 + 5) * 65 + n]);
    w[3] = cvtpk(tl[(kc * 8 + 6) * 65 + n], tl[(kc * 8 + 7) * 65 + n]);
    *reinterpret_cast<u32x4*>(dst + (size_t)(n0 + n) * lddst + k0 + kc * 8) = w;
    __syncthreads();
}

DEVI void convert_expert_item(const P& p, int layer, int it, float* tl) {
    const int e = it / 384, r = it % 384;
    const float* wg = p.w_gate + ((size_t)layer * 16 + e) * 1024 * 512;
    const float* wu = p.w_up   + ((size_t)layer * 16 + e) * 1024 * 512;
    const float* wd = p.w_down + ((size_t)layer * 16 + e) * 512 * 1024;
    if (r < 256) {
        u16* dst = (u16*)(p.ws + (layer ? OFF_WGU1 : OFF_WGU)) + (size_t)e * 1024 * 1024;
        const int kt = r >> 4, nt = r & 15;
        transpose_tile([&](int n) { const int q = n >> 3, sgu = (n >> 2) & 1, j = n & 3; return (sgu ? wu : wg) + q * 4 + j; }, 512, dst, 1024, kt * 64, nt * 64, tl);
    } else {
        const int q = r - 256; u16* dst = (u16*)(p.ws + (layer ? OFF_WDT1 : OFF_WDT)) + (size_t)e * 1024 * 512;
        const int kt = q >> 4, nt = q & 15;
        transpose_tile([&](int n) { return wd + n; }, 1024, dst, 512, kt * 64, nt * 64, tl);
    }
}

constexpr int N0_WIN = 16 * 56, N0_WOUT = 256, N0_EXP = 16 * 384, N0_FN = 1024, N0_MOD = 192, N0_TAB = 128;
constexpr int N0_TOTAL = N0_WIN + N0_MOD + N0_TAB;
constexpr int NBG = N0_WOUT + N0_FN;
DEVI void bg_item(const P& p, int it, float* tl) {
    const int tid = threadIdx.x;
    int r = it;
    if (r < N0_WOUT) {
        const int kt = r >> 4, nt = r & 15; const float* w = p.w_out;
        transpose_tile([&](int n) { return w + n; }, 1024, (u16*)(p.ws + OFF_WOUTT), 1024, kt * 64, nt * 64, tl);
        return;
    }
    r -= N0_WOUT;
    {
        const int idx = r * 512 + tid, c = idx & 127, g = (idx >> 7) & 3, n = idx >> 9;
        double sd, cd; sincos2pi(c / 256.0, sd, cd);
        const float ct = (float)cd, st = (float)sd;
        const float* W = p.w_fnet + (size_t)(g * 256) * 1024 + n;
        float ac = 0.f, as = 0.f, a128 = 0.f, cr = 1.f, sr = 0.f, sg = 1.f;
        for (int c2 = 0; c2 < 256; ++c2) {
            const float w = W[(size_t)c2 * 1024];
            ac = fmaf(cr, w, ac); as = fmaf(sr, w, as); a128 = fmaf(sg, w, a128); sg = -sg;
            const float cn = cr * ct - sr * st; sr = fmaf(sr, ct, cr * st); cr = cn;
        }
        u16* F = (u16*)(p.ws + OFF_FNT);
        const size_t o0 = (size_t)n * 1024 + g * 256, o1 = (size_t)(1024 + n) * 1024 + g * 256;
        F[o0 + c] = f2bf(ac * (1.f / 2048.f)); F[o1 + c] = f2bf(-as * (1.f / 2048.f));
        if (c > 0) { F[o0 + 256 - c] = f2bf(ac * (1.f / 2048.f)); F[o1 + 256 - c] = f2bf(as * (1.f / 2048.f)); }
        else { F[o0 + 128] = f2bf(a128 * (1.f / 2048.f)); F[o1 + 128] = f2bf(0.f); }
    }
}
DEVI void bg_fill(const P& p, char* lds, int q, int lo, int hi) {
    int* sh = (int*)(lds + 32768);
    for (;;) {
        __syncthreads();
        if (threadIdx.x == 0) *sh = lo + 4 * (int)atomicAdd((unsigned*)(p.ws + OFF_CNT) + 160 + q, 1u);
        __syncthreads();
        const int it0 = *sh;
        if (it0 >= hi) break;
        for (int it = it0; it < it0 + 4 && it < hi; ++it) bg_item(p, it, (float*)lds);
    }
    __syncthreads();
}

DEVI void phase_prologue(const P& p, char* lds) {
    float* tl = (float*)lds;
    const int tid = threadIdx.x;
    for (int it = blockIdx.x; it < N0_TOTAL; it += gridDim.x) {
        int r = it;
        if (r < N0_WIN) {
            const int kt = r / 56, nt = r % 56;
            const float* w = p.w_in;
            transpose_tile([&](int n) { return w + n; },
                           3600, (u16*)(p.ws + OFF_WINT), 1024, kt * 64, nt * 64, tl);
            continue;
        }
        r -= N0_WIN;
        if (r < N0_MOD) {
            float* sv = tl;
            float* part = tl + 3072;
            for (int i = tid; i < 3072; i += NTHR) { const int v = i >> 10, k = i & 1023; const float xv = v < 2 ? p.c[v * 1024 + k] : p.c_ctx[k]; sv[i] = siluf_(xv); }
            __syncthreads();
            const int j0 = r * 64, L = j0 / 6144, col0 = j0 % 6144, kg = tid >> 6, cl = tid & 63;
            const float* W = p.ada_w + (size_t)L * 1024 * 6144 + col0 + cl;
            float a0 = 0.f, a1 = 0.f, a2 = 0.f;
            for (int k = kg * 128; k < kg * 128 + 128; ++k) { const float w = W[(size_t)k * 6144]; a0 = fmaf(sv[k], w, a0); a1 = fmaf(sv[1024 + k], w, a1); a2 = fmaf(sv[2048 + k], w, a2); }
            part[(kg * 3 + 0) * 64 + cl] = a0; part[(kg * 3 + 1) * 64 + cl] = a1; part[(kg * 3 + 2) * 64 + cl] = a2;
            __syncthreads();
            if (tid < 192) {
                const int v = tid >> 6, c2 = tid & 63; float s = 0.f;
                for (int g = 0; g < 8; ++g) s += part[(g * 3 + v) * 64 + c2];
                ((float*)(p.ws + OFF_MOD))[(size_t)(L * 3 + v) * 6144 + col0 + c2] = s + p.ada_b[L * 6144 + col0 + c2];
            }
            __syncthreads();
            continue;
        }
        r -= N0_MOD;
        {
            const int e = r * 512 + tid;
            if (e < 4096 + 1024) {
                const bool isr = e < 4096; const int ee = isr ? e : e - 4096; const int pos = ee >> 4, j = ee & 15;
                double inv = 1.0; for (int q = 0; q < j; ++q) inv *= 0.56234132519034908;
                const float invf = (float)inv; const float ang = (float)pos * invf;
                double s, c; sincos2pi((double)ang * 0.15915494309189533577, s, c);
                float2 v = make_float2((float)c, (float)s);
                if (isr) ((float2*)(p.ws + OFF_ROPER))[ee] = v; else ((float2*)(p.ws + OFF_ROPEC))[ee] = v;
            } else if (e < 5120 + 16384) {
                const int m = e - 5120; double s, c; sincos2pi(m / 16384.0, s, c);
                ((float2*)(p.ws + OFF_TW))[m] = make_float2((float)c, (float)s);
            } else if (e < 5120 + 32768) {
                const int m = e - 5120 - 16384, k = m >> 7, t = m & 127; double s, c; sincos2pi(((k * t) & 127) / 128.0, s, c);
                ((u16*)(p.ws + OFF_DFTC))[m] = f2bf((float)c); ((u16*)(p.ws + OFF_DFTS))[m] = f2bf((float)s);
            } else if (e < 5120 + 49152) {
                const int m = e - 5120 - 32768, k = m >> 4, g = m & 15;
                ((float*)(p.ws + OFF_WG16))[m] = p.w_in[(size_t)k * 3600 + 3584 + g];
            } else if (e == 5120 + 49152) {
                float s01 = 0.f, s23 = 0.f;
                for (int i = 0; i < 64; ++i) { s01 += p.lamv[i] * p.lamv[64 + i]; s23 += p.lamv[128 + i] * p.lamv[192 + i]; }
                ((float*)(p.ws + OFF_LAM))[0] = expf(s01) - expf(s23) + 0.2f;
            }
        }
    }
}

template <int MODE, bool DRY = false>
DEVI void phase_norm(const P& p, char* lds) {
    constexpr int layer = (MODE == 0 || MODE == 1) ? 0 : 1;
    constexpr bool side = (MODE == 0 || MODE == 1 || MODE == 3);
    const int nrows = layer == 0 ? NTOK : NLAT;
    const int tid = threadIdx.x, lane = tid & 63, wid = tid >> 6;
    f32x4* sl = (f32x4*)lds;
    if (side) {
        const float* S = (MODE == 0) ? (const float*)(p.ws + OFF_WG16) : p.router_w;
        for (int i = tid; i < 4096; i += NTHR) { const int eg = i >> 10, col = i & 1023; const int pc = (col >> 8) * 256 + (col & 3) * 64 + ((col >> 2) & 63);
            sl[eg * 1024 + pc] = *reinterpret_cast<const f32x4*>(S + col * 16 + eg * 4); }
        __syncthreads();
    }
    const float* g = MODE == 0 ? p.nmix_g : MODE == 1 ? p.nffn_g : MODE == 2 ? p.nmix_g + 1024 : MODE == 3 ? p.nffn_g + 1024 : p.final_g;
    const float* modb = (const float*)(p.ws + OFF_MOD) + (size_t)layer * 3 * 6144;
    constexpr int sh_i = (MODE == 0 || MODE == 2) ? 0 : 3;
    u16* act = (u16*)(p.ws + OFF_ACT);
    int npend = 0, pcls = 0, prow = 0; float pwl = 0.f, pwh = 0.f; float keep[16];
#pragma unroll
    for (int e = 0; e < 16; ++e) keep[e] = 0.f;
    const int c0 = 4 * lane;
    f32x4 xn[4];
    { const int row0 = blockIdx.x * 8 + wid;
      if (row0 < nrows) { const float* src = (MODE == 0) ? xin_ptr(p, row0) : xs_ptr(p, layer, row0);
#pragma unroll
          for (int i = 0; i < 4; ++i) xn[i] = *reinterpret_cast<const f32x4*>(src + c0 + 256 * i); } }
    for (int row = blockIdx.x * 8 + wid; row < nrows; row += gridDim.x * 8) {
        f32x4 xv[4]; float ss = 0.f;
#pragma unroll
        for (int i = 0; i < 4; ++i) xv[i] = xn[i];
        { const int nrow = row + gridDim.x * 8;
          if (nrow < nrows) { const float* src = (MODE == 0) ? xin_ptr(p, nrow) : xs_ptr(p, layer, nrow);
#pragma unroll
              for (int i = 0; i < 4; ++i) xn[i] = *reinterpret_cast<const f32x4*>(src + c0 + 256 * i); } }
#pragma unroll
        for (int i = 0; i < 4; ++i) { ss = fmaf(xv[i][0], xv[i][0], ss); ss = fmaf(xv[i][1], xv[i][1], ss); ss = fmaf(xv[i][2], xv[i][2], ss); ss = fmaf(xv[i][3], xv[i][3], ss); }
        ss = wave_sum(ss);
        const float rstd = rsqrtf(ss * (1.f / 1024.f) + 1e-6f);
        if (MODE == 4) {
            float* dst = p.out + (size_t)row * DM;
#pragma unroll
            for (int i = 0; i < 4; ++i) { const f32x4 gv = *reinterpret_cast<const f32x4*>(g + c0 + 256 * i); *reinterpret_cast<f32x4*>(dst + c0 + 256 * i) = xv[i] * rstd * gv; }
            continue;
        }
        const float* mv = modb + (size_t)modsel(layer, row) * 6144;
        float acc[16];
#pragma unroll
        for (int e = 0; e < 16; ++e) acc[e] = 0.f;
#pragma unroll
        for (int i = 0; i < 4; ++i) {
            const f32x4 gv = *reinterpret_cast<const f32x4*>(g + c0 + 256 * i), scv = *reinterpret_cast<const f32x4*>(mv + (sh_i + 1) * 1024 + c0 + 256 * i),
                        shv = *reinterpret_cast<const f32x4*>(mv + sh_i * 1024 + c0 + 256 * i);
            f32x4 h;
#pragma unroll
            for (int j = 0; j < 4; ++j) h[j] = xv[i][j] * rstd * gv[j] * (1.f + scv[j]) + shv[j];
            u32x2 w2; w2[0] = cvtpk(h[0], h[1]); w2[1] = cvtpk(h[2], h[3]);
            *reinterpret_cast<u32x2*>(act + (size_t)row * DM + c0 + 256 * i) = w2;
            if (side) {
#pragma unroll
                for (int j = 0; j < 4; ++j) {
#pragma unroll
                    for (int eg = 0; eg < 4; ++eg) { const f32x4 w = sl[eg * 1024 + i * 256 + j * 64 + lane]; acc[eg * 4 + 0] = fmaf(h[j], w[0], acc[eg * 4 + 0]); acc[eg * 4 + 1] = fmaf(h[j], w[1], acc[eg * 4 + 1]);
                        acc[eg * 4 + 2] = fmaf(h[j], w[2], acc[eg * 4 + 2]); acc[eg * 4 + 3] = fmaf(h[j], w[3], acc[eg * 4 + 3]); }
                    if (j & 1) asm volatile("" ::: "memory");
                }
            }
        }
        if (side) {
            float r8[8], r4[4], r2[2], tot;
            { const bool up = lane & 32;
#pragma unroll
              for (int i = 0; i < 8; ++i) { const float snd = up ? acc[i] : acc[i + 8], kp = up ? acc[i + 8] : acc[i]; r8[i] = kp + __shfl_xor(snd, 32); } }
            { const bool up = lane & 16;
#pragma unroll
              for (int i = 0; i < 4; ++i) { const float snd = up ? r8[i] : r8[i + 4], kp = up ? r8[i + 4] : r8[i]; r4[i] = kp + __shfl_xor(snd, 16); } }
            { const bool up = lane & 8;
#pragma unroll
              for (int i = 0; i < 2; ++i) { const float snd = up ? r4[i] : r4[i + 2], kp = up ? r4[i + 2] : r4[i]; r2[i] = kp + __shfl_xor(snd, 8); } }
            { const bool up = lane & 4; const float snd = up ? r2[0] : r2[1], kp = up ? r2[1] : r2[0]; tot = kp + __shfl_xor(snd, 4); }
            tot += __shfl_xor(tot, 1); tot += __shfl_xor(tot, 2);
            if (MODE == 0) {
                if ((lane & 3) == 0) {
                    const int e = lane >> 2;
                    float v = tot + p.gate_b[e];
                    const int type = e >> 2;
                    if (type == 1 || type == 3) v = logsigmoidf_(v);
                    ((float*)(p.ws + OFF_GATES))[(size_t)row * 16 + e] = v;
                }
            } else {
#pragma unroll
                for (int e = 0; e < 16; ++e) { const float te = __uint_as_float(__builtin_amdgcn_readlane(__float_as_uint(tot), e << 2)); keep[e] = (lane == npend) ? te : keep[e]; }
                if (lane == npend) prow = row;
                ++npend;
            }
        }
    }
    if (MODE == 1 || MODE == 3) {
        {
            float aff[16], bi[16];
#pragma unroll
            for (int e = 0; e < 16; ++e) { aff[e] = sigmoidf_(keep[e]); bi[e] = aff[e] + p.router_b[e]; }
            int bg = 0, ba = 0, bb = 1; float bscore = -1e30f;
#pragma unroll
            for (int gq = 0; gq < 4; ++gq) {
                int ia = 0; float va = bi[gq * 4];
#pragma unroll
                for (int j = 1; j < 4; ++j) if (bi[gq * 4 + j] > va) { va = bi[gq * 4 + j]; ia = j; }
                int ib = -1; float vb = -1e30f;
#pragma unroll
                for (int j = 0; j < 4; ++j) if (j != ia && bi[gq * 4 + j] > vb) { vb = bi[gq * 4 + j]; ib = j; }
                const float sc = va + vb;
                if (sc > bscore) { bscore = sc; bg = gq; ba = ia; bb = ib; }
            }
            const int lo = ba < bb ? ba : bb, hi2 = ba < bb ? bb : ba;
            float alo = 0.f, ahi = 0.f;
#pragma unroll
            for (int e = 0; e < 16; ++e) { if (e == bg * 4 + lo) alo = aff[e]; if (e == bg * 4 + hi2) ahi = aff[e]; }
            const float inv = 1.f / (alo + ahi);
            const int pair = lo == 0 ? hi2 - 1 : (lo == 1 ? hi2 + 1 : 5);
            pcls = bg * 6 + pair; pwl = alo * inv; pwh = ahi * inv;
        }
        unsigned* lc = (unsigned*)(lds + 65536);
        __syncthreads();
        if (tid < 64) lc[tid] = 0u;
        __syncthreads();
        unsigned myrank = 0u;
        if (lane < npend) myrank = atomicAdd(&lc[pcls], 1u);
        __syncthreads();
        if (tid < 24) { unsigned* cnt = (unsigned*)(p.ws + OFF_CNT) + (DRY ? 2 : layer) * 32; const unsigned n = lc[tid]; lc[32 + tid] = n ? atomicAdd(&cnt[tid], n) : 0u; }
        __syncthreads();
        if (lane < npend) {
            ((int*)(p.ws + (DRY ? OFF_BIG : OFF_LIST)))[(size_t)pcls * NTOK + lc[32 + pcls] + myrank] = prow;
            ((float2*)(p.ws + (DRY ? OFF_BIG + (size_t)32 * NTOK * 4 : OFF_TOKW)))[prow] = make_float2(pwl, pwh);
        }
    }
}

using g8::f32x4v;
DEVI u32x4 pack8(const f32x4v& a, const f32x4v& b) { u32x4 w; w[0] = cvtpk(a[0], a[1]); w[1] = cvtpk(a[2], a[3]); w[2] = cvtpk(b[0], b[1]); w[3] = cvtpk(b[2], b[3]); return w; }

struct EpiInproj {
    static constexpr bool PERM = true;
    char* ws;
    DEVI void operator()(const f32x4v (&acc)[2][2][4][2], const g8::Unit& u, int wr, int wc, int fr, int fq) const {
        u16* dst; int ld, coff, kind;
        const int pn = u.pn;
        if (pn < 2)       { dst = (u16*)(ws + OFF_Q);    ld = 512;  coff = pn * 256;        kind = 1; }
        else if (pn < 4)  { dst = (u16*)(ws + OFF_K);    ld = 512;  coff = (pn - 2) * 256;  kind = 1; }
        else if (pn < 6)  { dst = (u16*)(ws + OFF_V);    ld = 512;  coff = (pn - 4) * 256;  kind = 0; }
        else if (pn < 10) { dst = (u16*)(ws + OFF_MLQK); ld = 1024; coff = (pn - 6) * 256;  kind = 0; }
        else if (pn < 12) { dst = (u16*)(ws + OFF_MLV);  ld = 512;  coff = (pn - 10) * 256; kind = 0; }
        else              { dst = (u16*)(ws + OFF_OG);   ld = 512;  coff = (pn - 12) * 256; kind = 2; }
        const int tb = u.pm % 65;
        const float2* tabR = (const float2*)(ws + OFF_ROPER); const float2* tabC = (const float2*)(ws + OFF_ROPEC);
#pragma unroll
        for (int ai = 0; ai < 2; ++ai)
#pragma unroll
            for (int m = 0; m < 4; ++m) {
                const int rl = ai * 128 + wr * 64 + m * 16 + fr;
                u16* rowp = dst + (size_t)(u.pm * 256 + rl) * ld + coff + wc * 32 + 8 * fq;
#pragma unroll
                for (int bj = 0; bj < 2; ++bj) {
                    f32x4v v0 = acc[ai][bj][m][0], v1 = acc[ai][bj][m][1];
                    if (kind == 1 && tb > 0) {
                        const int tl = (tb - 1) * 256 + rl;
                        const int p0 = ((wc * 32 + 8 * fq) & 63) >> 1;
                        const float* cs = (const float*)(p0 < 16 ? tabR + (tl >> 6) * 16 + p0 : tabC + (tl & 63) * 16 + (p0 - 16));
                        const f32x4v c01 = *reinterpret_cast<const f32x4v*>(cs), c23 = *reinterpret_cast<const f32x4v*>(cs + 4);
                        const f32x4v a = v0, b = v1;
                        v0[0] = a[0] * c01[0] - a[1] * c01[1]; v0[1] = a[0] * c01[1] + a[1] * c01[0];
                        v0[2] = a[2] * c01[2] - a[3] * c01[3]; v0[3] = a[2] * c01[3] + a[3] * c01[2];
                        v1[0] = b[0] * c23[0] - b[1] * c23[1]; v1[1] = b[0] * c23[1] + b[1] * c23[0];
                        v1[2] = b[2] * c23[2] - b[3] * c23[3]; v1[3] = b[2] * c23[3] + b[3] * c23[2];
                    } else if (kind == 2) {
#pragma unroll
                        for (int j = 0; j < 4; ++j) { v0[j] = sigmoidf_(v0[j]); v1[j] = sigmoidf_(v1[j]); }
                    }
                    *reinterpret_cast<u32x4*>(rowp + bj * 128) = pack8(v0, v1);
                }
            }
    }
};
DEVI void phase_inproj(const P& p, char* lds) {
    __syncthreads();
    g8::DenseSched S{p.ws + OFF_WINT, NTOK / 256, 14, (int)gridDim.x, (int)blockIdx.x, (size_t)256 * 2048};
    EpiInproj E{p.ws};
    g8::gemm_phase((LAS unsigned char*)lds, p.ws + OFF_ACT, 2048, 16, S, E);
}

struct EpiOutproj {
    static constexpr bool PERM = false;
    const float* xin_lat; const float* xin_ctx; float* xs_lat; float* xs_ctx; const float* modb;
    DEVI void operator()(const f32x4v (&acc)[2][2][4][2], const g8::Unit& u, int wr, int wc, int fr, int fq) const {
        const int b = u.pm / 65, tb = u.pm % 65;
        const float* xi = tb == 0 ? xin_ctx + (size_t)(b * TC) * DM : xin_lat + (size_t)(b * TL + (tb - 1) * 256) * DM;
        float* xo = tb == 0 ? xs_ctx + (size_t)(b * TC) * DM : xs_lat + (size_t)(b * TL + (tb - 1) * 256) * DM;
        const float* gate = modb + (size_t)(tb == 0 ? 2 : b) * 6144 + 2 * 1024;
        const int col0 = u.pn * 256 + wc * 32 + 4 * fq;
        f32x4v gv[2][2];
#pragma unroll
        for (int bj = 0; bj < 2; ++bj)
#pragma unroll
            for (int n = 0; n < 2; ++n) gv[bj][n] = *reinterpret_cast<const f32x4v*>(gate + col0 + bj * 128 + n * 16);
#pragma unroll
        for (int ai = 0; ai < 2; ++ai) {
            f32x4v xv[4][2][2];
#pragma unroll
            for (int m = 0; m < 4; ++m) { const size_t ro = (size_t)(ai * 128 + wr * 64 + m * 16 + fr) * DM + col0;
#pragma unroll
                for (int bj = 0; bj < 2; ++bj)
#pragma unroll
                    for (int n = 0; n < 2; ++n) xv[m][bj][n] = *reinterpret_cast<const f32x4v*>(xi + ro + bj * 128 + n * 16); }
#pragma unroll
            for (int m = 0; m < 4; ++m) { const size_t ro = (size_t)(ai * 128 + wr * 64 + m * 16 + fr) * DM + col0;
#pragma unroll
                for (int bj = 0; bj < 2; ++bj)
#pragma unroll
                    for (int n = 0; n < 2; ++n) *reinterpret_cast<f32x4v*>(xo + ro + bj * 128 + n * 16) = xv[m][bj][n] + gv[bj][n] * acc[ai][bj][m][n]; }
        }
    }
};
DEVI void phase_outproj(const P& p, char* lds) {
    __syncthreads();
    g8::DenseSched S{p.ws + OFF_WOUTT, NTOK / 256, 4, (int)gridDim.x, (int)blockIdx.x, (size_t)256 * 2048};
    EpiOutproj E{p.x, p.ctx, p.out, (float*)(p.ws + OFF_XC), (const float*)(p.ws + OFF_MOD)};
    g8::gemm_phase((LAS unsigned char*)lds, p.ws + OFF_ACT, 2048, 16, S, E);
}

DEVI int moe_table(const P& p, int layer, int* tb) {
    __syncthreads();
    if (threadIdx.x == 0) {
        const unsigned* cnt = (const unsigned*)(p.ws + OFF_CNT) + layer * 32; int o = 0;
        for (int c = 0; c < 24; ++c) { tb[c] = o; tb[32 + c] = (int)cnt[c]; o += ((int)cnt[c] + 255) >> 8; }
        tb[24] = o;
    }
    __syncthreads();
    return tb[24];
}
DEVI void cls_experts(int cls, int& elo, int& ehi) {
    const int g = cls / 6, pr = cls % 6;
    const int lo = pr < 3 ? 0 : (pr < 5 ? 1 : 2); const int hi = pr < 3 ? pr + 1 : (pr < 5 ? pr - 1 : 3);
    elo = g * 4 + lo; ehi = g * 4 + hi;
}
DEVI void moe_unit(const int* tb, int rt, g8::Unit& u) {
    int cls = 0; while (cls < 23 && tb[cls + 1] <= rt) ++cls;
    u.cls = cls; u.r0 = (rt - tb[cls]) * 256; u.ncls = tb[32 + cls];
}

struct MoeUpSched {
    static constexpr bool GATHER = true;
    const int* tb; int T, G, c; const int* list; const char* Wgu;
    DEVI bool next(int i, g8::Unit& u) const {
        if (!g8::tile_order(i, G, c, T, 8, u.pm, u.pn)) return false;
        moe_unit(tb, u.pm, u); int elo, ehi; cls_experts(u.cls, elo, ehi);
        const int e = u.pn < 4 ? elo : ehi;
        u.B0 = u.B1 = Wgu + ((size_t)e * 1024 + (size_t)(u.pn & 3) * 256) * 2048; return true;
    }
    DEVI void aoffs(const g8::Unit& u, unsigned (&v)[2][2]) const {
        const int* lst = list + (size_t)u.cls * NTOK + u.r0;
#pragma unroll
        for (int i = 0; i < 2; ++i) { int R, C; g8::lane_rc(i, R, C);
#pragma unroll
            for (int h = 0; h < 2; ++h) { const int rr = h * 128 + R; const int tok = lst[(u.r0 + rr < u.ncls) ? rr : 0]; v[h][i] = (unsigned)((tok * 1024 + C) * 2); } }
    }
};
struct EpiMoeUp {
    static constexpr bool PERM = true;
    const int* list; const float2* tokw; u16* HE;
    DEVI void operator()(const f32x4v (&acc)[2][2][4][2], const g8::Unit& u, int wr, int wc, int fr, int fq) const {
        const int* lst = list + (size_t)u.cls * NTOK + u.r0;
        const int s = u.pn >> 2;
        float wv[2][4];
        { int tk[2][4];
#pragma unroll
          for (int ai = 0; ai < 2; ++ai)
#pragma unroll
              for (int m = 0; m < 4; ++m) { const int rl = ai * 128 + wr * 64 + m * 16 + fr; tk[ai][m] = lst[(u.r0 + rl < u.ncls) ? rl : 0]; }
#pragma unroll
          for (int ai = 0; ai < 2; ++ai)
#pragma unroll
              for (int m = 0; m < 4; ++m) { const float2 w2 = tokw[tk[ai][m]]; wv[ai][m] = s ? w2.y : w2.x; } }
#pragma unroll
        for (int ai = 0; ai < 2; ++ai)
#pragma unroll
            for (int m = 0; m < 4; ++m) {
                const int rl = ai * 128 + wr * 64 + m * 16 + fr;
                if (u.r0 + rl < u.ncls) {
                    const float w = wv[ai][m];
                    u16* rowp = HE + (size_t)(u.pm * 256 + rl) * 1024 + s * 512 + (u.pn & 3) * 128 + wc * 16 + 4 * fq;
#pragma unroll
                    for (int bj = 0; bj < 2; ++bj) {
                        const f32x4v g = acc[ai][bj][m][0], up = acc[ai][bj][m][1];
                        u32x2 o; o[0] = cvtpk(siluf_(g[0]) * up[0] * w, siluf_(g[1]) * up[1] * w); o[1] = cvtpk(siluf_(g[2]) * up[2] * w, siluf_(g[3]) * up[3] * w);
                        *reinterpret_cast<u32x2*>(rowp + bj * 64) = o;
                    }
                }
            }
    }
};
DEVI void phase_moe_up(const P& p, int layer, char* lds) {
    int* tb = (int*)(lds + g8::STAGE_BYTES);
    const int T = moe_table(p, layer, tb);
    MoeUpSched S{tb, T, (int)gridDim.x, (int)blockIdx.x, (const int*)(p.ws + OFF_LIST), p.ws + (layer ? OFF_WGU1 : OFF_WGU)};
    EpiMoeUp E{(const int*)(p.ws + OFF_LIST), (const float2*)(p.ws + OFF_TOKW), (u16*)(p.ws + OFF_HE)};
    g8::gemm_phase((LAS unsigned char*)lds, p.ws + OFF_ACT, 2048, 16, S, E);
}

struct MoeDownSched {
    static constexpr bool GATHER = false;
    const int* tb; int T, G, c; const char* WdT;
    DEVI bool next(int i, g8::Unit& u) const {
        if (!g8::tile_order(i, G, c, T, 4, u.pm, u.pn)) return false;
        moe_unit(tb, u.pm, u); int elo, ehi; cls_experts(u.cls, elo, ehi);
        u.B0 = WdT + ((size_t)elo * 1024 + (size_t)u.pn * 256) * 1024;
        u.B1 = WdT + ((size_t)ehi * 1024 + (size_t)u.pn * 256) * 1024 - (size_t)8 * 128; return true;
    }
    DEVI void aoffs(const g8::Unit& u, unsigned (&v)[2][2]) const {
#pragma unroll
        for (int i = 0; i < 2; ++i) { int R, C; g8::lane_rc(i, R, C);
#pragma unroll
            for (int h = 0; h < 2; ++h) v[h][i] = (unsigned)(((u.pm * 256 + h * 128 + R) * 1024 + C) * 2); }
    }
};
template <bool DRY>
struct EpiMoeDown {
    static constexpr bool PERM = false;
    const P* pp; int layer; const int* list; const float* modb;
    DEVI void operator()(const f32x4v (&acc)[2][2][4][2], const g8::Unit& u, int wr, int wc, int fr, int fq) const {
        const P& p = *pp;
        const int* lst = list + (size_t)u.cls * NTOK + u.r0;
        const int col0 = u.pn * 256 + wc * 32 + 4 * fq;
        int tk[2][4];
#pragma unroll
        for (int ai = 0; ai < 2; ++ai)
#pragma unroll
            for (int m = 0; m < 4; ++m) { const int rl = ai * 128 + wr * 64 + m * 16 + fr; tk[ai][m] = (u.r0 + rl < u.ncls) ? lst[rl] : -1; }
#pragma unroll
        for (int ai = 0; ai < 2; ++ai)
#pragma unroll
        for (int mh = 0; mh < 2; ++mh) {
            f32x4v xv[2][2][2], gv[2][2][2];
#pragma unroll
            for (int mm = 0; mm < 2; ++mm) { const int m = mh * 2 + mm; const int tok = tk[ai][m] < 0 ? lst[0] : tk[ai][m];
                const float* gate = modb + (size_t)modsel(layer, tok) * 6144 + 5 * 1024 + col0; const float* xo = xs_ptr(p, layer, tok) + col0;
#pragma unroll
                for (int bj = 0; bj < 2; ++bj)
#pragma unroll
                    for (int n = 0; n < 2; ++n) { gv[mm][bj][n] = *reinterpret_cast<const f32x4v*>(gate + bj * 128 + n * 16); xv[mm][bj][n] = *reinterpret_cast<const f32x4v*>(xo + bj * 128 + n * 16); } }
#pragma unroll
            for (int mm = 0; mm < 2; ++mm) { const int m = mh * 2 + mm; if (tk[ai][m] >= 0) { const int tok = tk[ai][m];
                float* xd = DRY ? (float*)(p.ws + OFF_MLQK) + (size_t)(tok & 8191) * 1024 + col0 : xs_ptr(p, layer, tok) + col0;
#pragma unroll
                for (int bj = 0; bj < 2; ++bj)
#pragma unroll
                    for (int n = 0; n < 2; ++n) *reinterpret_cast<f32x4v*>(xd + bj * 128 + n * 16) = xv[mm][bj][n] + gv[mm][bj][n] * acc[ai][bj][m][n]; } }
        }
    }
};
template <bool DRY = false>
DEVI void phase_moe_down(const P& p, int layer, char* lds) {
    int* tb = (int*)(lds + g8::STAGE_BYTES);
    const int T = moe_table(p, layer, tb);
    MoeDownSched S{tb, T, (int)gridDim.x, (int)blockIdx.x, p.ws + (layer ? OFF_WDT1 : OFF_WDT)};
    EpiMoeDown<DRY> E{&p, layer, (const int*)(p.ws + OFF_LIST), (const float*)(p.ws + OFF_MOD) + (size_t)layer * 3 * 6144};
    g8::gemm_phase((LAS unsigned char*)lds, p.ws + OFF_HE, 1024, 8, S, E);
}

struct EpiFnet {
    static constexpr bool PERM = true;
    char* ws;
    DEVI void operator()(const f32x4v (&acc)[2][2][4][2], const g8::Unit& u, int wr, int wc, int fr, int fq) const {
        u16* dst = (u16*)(ws + (u.pn < 4 ? OFF_ZR : OFF_ZI)) + (u.pn & 3) * 256 + wc * 32 + 8 * fq;
#pragma unroll
        for (int ai = 0; ai < 2; ++ai)
#pragma unroll
            for (int m = 0; m < 4; ++m) {
                u16* rowp = dst + (size_t)(u.pm * 256 + ai * 128 + wr * 64 + m * 16 + fr) * 1024;
#pragma unroll
                for (int bj = 0; bj < 2; ++bj) *reinterpret_cast<u32x4*>(rowp + bj * 128) = pack8(acc[ai][bj][m][0], acc[ai][bj][m][1]);
            }
    }
};
DEVI void phase_fnet_gemm(const P& p, char* lds) {
    __syncthreads();
    g8::DenseSched S{p.ws + OFF_FNT, NLAT / 256, 8, (int)gridDim.x, (int)blockIdx.x, (size_t)256 * 2048};
    EpiFnet E{p.ws};
    g8::gemm_phase((LAS unsigned char*)lds, p.ws + OFF_ACT, 2048, 16, S, E);
}

template <class RP>
DEVI void stage_tr128_load(RP rp, u32x4 (&v)[4]) {
    const int tid = threadIdx.x;
#pragma unroll
    for (int i = 0; i < 4; ++i) { const int idx = tid + 512 * i, k = idx >> 4, c = (idx & 15) * 8; v[i] = *reinterpret_cast<const u32x4*>(rp(k) + c); }
}
DEVI void stage_tr128_write(const u32x4 (&v)[4], char* img) {
    const int tid = threadIdx.x;
#pragma unroll
    for (int i = 0; i < 4; ++i) { const int idx = tid + 512 * i, k = idx >> 4, c = (idx & 15) * 8; *reinterpret_cast<u32x4*>(img + (k >> 6) * 16384 + v_st(k & 63, c)) = v[i]; }
}
DEVI void load_dft(const P& p, char* lds) {
    const int tid = threadIdx.x;
    for (int i = tid; i < 4096; i += NTHR) {
        const int m = i >> 11, j = i & 2047, row = j >> 4, ch = j & 15;
        const u32x4 v = *reinterpret_cast<const u32x4*>((const u16*)(p.ws + (m ? OFF_DFTS : OFF_DFTC)) + row * 128 + ch * 8);
        *reinterpret_cast<u32x4*>(lds + m * 34816 + swz256(row, ch)) = v;
    }
}
DEVI bf16x8 negbf(bf16x8 v) { u32x4 w = *reinterpret_cast<u32x4*>(&v); w[0] ^= 0x80008000u; w[1] ^= 0x80008000u; w[2] ^= 0x80008000u; w[3] ^= 0x80008000u; return *reinterpret_cast<bf16x8*>(&w); }

template <int KS, int WN, int MODE>
DEVI void fft_kstep(int vbr, int vbi, const bf16x8& aC, const bf16x8& aS, f32x16 (&yr)[2], f32x16 (&yi)[2]) {
    s16x4 rl0, rh0, rl1, rh1, il0, ih0, il1, ih1;
    tr_frag_issue<2 * WN, KS>(vbr, rl0, rh0); tr_frag_issue<2 * WN + 1, KS>(vbr, rl1, rh1);
    tr_frag_issue<2 * WN, KS>(vbi, il0, ih0); tr_frag_issue<2 * WN + 1, KS>(vbi, il1, ih1);
    LGKM0();
    const bf16x8 xr0 = PKLH(rl0, rh0), xr1 = PKLH(rl1, rh1), xi0 = PKLH(il0, ih0), xi1 = PKLH(il1, ih1);
    yr[0] = __builtin_amdgcn_mfma_f32_32x32x16_bf16(xr0, aC, yr[0], 0, 0, 0);
    yr[1] = __builtin_amdgcn_mfma_f32_32x32x16_bf16(xr1, aC, yr[1], 0, 0, 0);
    yr[0] = __builtin_amdgcn_mfma_f32_32x32x16_bf16(xi0, aS, yr[0], 0, 0, 0);
    yr[1] = __builtin_amdgcn_mfma_f32_32x32x16_bf16(xi1, aS, yr[1], 0, 0, 0);
    if (MODE == 0) {
        yi[0] = __builtin_amdgcn_mfma_f32_32x32x16_bf16(xi0, aC, yi[0], 0, 0, 0);
        yi[1] = __builtin_amdgcn_mfma_f32_32x32x16_bf16(xi1, aC, yi[1], 0, 0, 0);
        yi[0] = __builtin_amdgcn_mfma_f32_32x32x16_bf16(negbf(xr0), aS, yi[0], 0, 0, 0);
        yi[1] = __builtin_amdgcn_mfma_f32_32x32x16_bf16(negbf(xr1), aS, yi[1], 0, 0, 0);
    }
}
template <int WN, int MODE>
DEVI void fft_core(const char* lds, int xr_img, int xi_img, int wm, int lane, f32x16 (&yr)[2], f32x16 (&yi)[2]) {
    const int r32 = lane & 31, hi = lane >> 5;
    const char* Cm = lds; const char* Sm = lds + 34816;
    const int row = wm * 32 + r32;
    const int vb0 = xr_img + v_rd_base(lane), vb1 = xi_img + v_rd_base(lane);
#define KSTEP(H, KS) do { const int kk = (H) * 4 + (KS); \
        const bf16x8 aC = lds_b128(Cm, swz256(row, 2 * kk + hi)), aS = lds_b128(Sm, swz256(row, 2 * kk + hi)); \
        fft_kstep<KS, WN, MODE>(vb0 + (H) * 16384, vb1 + (H) * 16384, aC, aS, yr, yi); } while (0)
    KSTEP(0, 0); KSTEP(0, 1); KSTEP(0, 2); KSTEP(0, 3); KSTEP(1, 0); KSTEP(1, 1); KSTEP(1, 2); KSTEP(1, 3);
#undef KSTEP
}

DEVI void phase_fft1(const P& p, char* lds) {
    const int tid = threadIdx.x, lane = tid & 63, wid = __builtin_amdgcn_readfirstlane(tid >> 6), wm = wid >> 1, wn = wid & 1, r32 = lane & 31, hi = lane >> 5;
    load_dft(p, lds);
    char* imgR = lds + 69632; char* imgI = lds + 102400;
    const u16* Zr = (const u16*)(p.ws + OFF_ZR); const u16* Zi = (const u16*)(p.ws + OFF_ZI);
    u16* Yr = (u16*)(p.ws + OFF_YR); u16* Yi = (u16*)(p.ws + OFF_YI);
    const float2* TW = (const float2*)(p.ws + OFF_TW);
    u32x4 pr[4], pi[4];
#define FFT1_LOAD(U) do { const int cb_ = (U) & 7, t2_ = ((U) >> 3) & 127, b_ = (U) >> 10; \
        stage_tr128_load([&](int k) { return Zr + (size_t)(b_ * TL + 128 * k + t2_) * 1024 + cb_ * 128; }, pr); \
        stage_tr128_load([&](int k) { return Zi + (size_t)(b_ * TL + 128 * k + t2_) * 1024 + cb_ * 128; }, pi); } while (0)
    if ((int)blockIdx.x < NB * 128 * 8) FFT1_LOAD((int)blockIdx.x);
    for (int u = blockIdx.x; u < NB * 128 * 8; u += gridDim.x) {
        const int cb = u & 7, t2 = (u >> 3) & 127, b = u >> 10;
        __syncthreads();
        stage_tr128_write(pr, imgR); stage_tr128_write(pi, imgI);
        __syncthreads();
        if (u + (int)gridDim.x < NB * 128 * 8) FFT1_LOAD(u + (int)gridDim.x);
        f32x16 yr[2] = {}, yi[2] = {};
        const int xr_img = (int)(uintptr_t)imgR, xi_img = (int)(uintptr_t)imgI;
        if (wn == 0) fft_core<0, 0>(lds, xr_img, xi_img, wm, lane, yr, yi); else fft_core<1, 0>(lds, xr_img, xi_img, wm, lane, yr, yi);
        __syncthreads();
        {
            const int k1 = wm * 32 + r32;
            const float2 w = TW[t2 * k1];
            char* oR = imgR + k1 * 272; char* oI = imgR + 34816 + k1 * 272;
#pragma unroll
            for (int ni = 0; ni < 2; ++ni)
#pragma unroll
                for (int g = 0; g < 4; ++g) {
                    const int cbase = wn * 64 + ni * 32 + 8 * g + 4 * hi;
                    float re[4], im[4];
#pragma unroll
                    for (int j = 0; j < 4; ++j) { const float a = yr[ni][4 * g + j], bq = yi[ni][4 * g + j]; re[j] = a * w.x + bq * w.y; im[j] = bq * w.x - a * w.y; }
                    u32x2 pr, pi; pr[0] = cvtpk(re[0], re[1]); pr[1] = cvtpk(re[2], re[3]); pi[0] = cvtpk(im[0], im[1]); pi[1] = cvtpk(im[2], im[3]);
                    *reinterpret_cast<u32x2*>(oR + cbase * 2) = pr; *reinterpret_cast<u32x2*>(oI + cbase * 2) = pi;
                }
        }
        __syncthreads();
#pragma unroll
        for (int i = 0; i < 8; ++i) {
            const int idx = tid + 512 * i, pl = idx >> 11, j = idx & 2047, row = j >> 4, ch = j & 15;
            const u32x4 v = *reinterpret_cast<const u32x4*>(imgR + pl * 34816 + row * 272 + ch * 16);
            *reinterpret_cast<u32x4*>((pl ? Yi : Yr) + ((size_t)(b * 128 + row) * 128 + t2) * 1024 + cb * 128 + ch * 8) = v;
        }
    }
}
template <bool DRY = false>
DEVI void phase_fft2(const P& p, char* lds) {
    const int tid = threadIdx.x, lane = tid & 63, wid = __builtin_amdgcn_readfirstlane(tid >> 6), wm = wid >> 1, wn = wid & 1, r32 = lane & 31, hi = lane >> 5;
    load_dft(p, lds);
    char* imgR = lds + 69632; char* imgI = lds + 102400;
    const u16* Yr = (const u16*)(p.ws + OFF_YR); const u16* Yi = (const u16*)(p.ws + OFF_YI);
    const float* modb = (const float*)(p.ws + OFF_MOD) + (size_t)3 * 6144;
    u32x4 pr[4], pi[4];
#define FFT2_LOAD(U) do { const int cb_ = (U) & 7, k1_ = ((U) >> 3) & 127, b_ = (U) >> 10; \
        stage_tr128_load([&](int k) { return Yr + ((size_t)(b_ * 128 + k1_) * 128 + k) * 1024 + cb_ * 128; }, pr); \
        stage_tr128_load([&](int k) { return Yi + ((size_t)(b_ * 128 + k1_) * 128 + k) * 1024 + cb_ * 128; }, pi); } while (0)
    if ((int)blockIdx.x < NB * 128 * 8) FFT2_LOAD((int)blockIdx.x);
    for (int u = blockIdx.x; u < NB * 128 * 8; u += gridDim.x) {
        const int cb = u & 7, k1 = (u >> 3) & 127, b = u >> 10;
        __syncthreads();
        stage_tr128_write(pr, imgR); stage_tr128_write(pi, imgI);
        __syncthreads();
        if (u + (int)gridDim.x < NB * 128 * 8) FFT2_LOAD(u + (int)gridDim.x);
        f32x16 yr[2] = {}, yi[2] = {};
        const int xr_img = (int)(uintptr_t)imgR, xi_img = (int)(uintptr_t)imgI;
        if (wn == 0) fft_core<0, 1>(lds, xr_img, xi_img, wm, lane, yr, yi); else fft_core<1, 1>(lds, xr_img, xi_img, wm, lane, yr, yi);
        __syncthreads();
        {
            char* oR = imgR + (wm * 32 + r32) * 528;
#pragma unroll
            for (int ni = 0; ni < 2; ++ni)
#pragma unroll
                for (int g = 0; g < 4; ++g) {
                    const int cbase = wn * 64 + ni * 32 + 8 * g + 4 * hi;
                    f32x4 v; v[0] = yr[ni][4 * g]; v[1] = yr[ni][4 * g + 1]; v[2] = yr[ni][4 * g + 2]; v[3] = yr[ni][4 * g + 3];
                    *reinterpret_cast<f32x4*>(oR + cbase * 4) = v;
                }
        }
        __syncthreads();
        const float* gate = modb + (size_t)b * 6144 + 2 * 1024 + cb * 128;
#pragma unroll
        for (int i = 0; i < 8; ++i) {
            const int idx = tid + 512 * i, row = idx >> 5, ch = idx & 31;
            const f32x4 v = *reinterpret_cast<const f32x4*>(imgR + row * 528 + ch * 16);
            const f32x4 gv = *reinterpret_cast<const f32x4*>(gate + ch * 4);
            float* xo = p.out + (size_t)(b * TL + k1 + 128 * row) * 1024 + cb * 128 + ch * 4;
            float* xd = DRY ? (float*)(p.ws + OFF_ZR) + (size_t)(b * TL + k1 + 128 * row) * 1024 + cb * 128 + ch * 4 : xo;
            *reinterpret_cast<f32x4*>(xd) = *reinterpret_cast<const f32x4*>(xo) + gv * v;
        }
    }
}

constexpr int AT_V = 16384, AT_K = 17408;
template <int HF, int DB>
DEVI void attn_half(const char* Ks, const bf16x8 (&qr)[8], float& m_reg, float& l_reg, f32x16 (&o)[4], int vb, float* al, int r32, int hi) {
    constexpr float SC = 0.125f, C = SC * 1.4426950408889634f, THR = 8.f;
    f32x16 pp = {};
#pragma unroll
    for (int d0 = 0; d0 < 4; ++d0) pp = __builtin_amdgcn_mfma_f32_32x32x16_bf16(lds_b128(Ks, swz256(HF * 32 + r32, 2 * (DB + d0) + hi)), qr[DB + d0], pp, 0, 0, 0);
    float pmax = pp[0];
#pragma unroll
    for (int r = 1; r < 16; ++r) pmax = fmaxf(pmax, pp[r]);
    { auto rr = __builtin_amdgcn_permlane32_swap(__float_as_uint(pmax), __float_as_uint(pmax), false, false);
      pmax = fmaxf(__uint_as_float(rr[0]), __uint_as_float(rr[1])); }
    float alpha = 1.f;
    if (!__all(pmax - m_reg <= THR / SC)) {
        const float mn = fmaxf(m_reg, pmax); alpha = __builtin_amdgcn_exp2f((m_reg - mn) * C); m_reg = mn;
        if (hi == 0) al[r32] = alpha;
        asm volatile("s_waitcnt lgkmcnt(0)" ::: "memory");
#pragma unroll
        for (int d = 0; d < 4; ++d)
#pragma unroll
            for (int r = 0; r < 16; ++r) o[d][r] *= al[crow(r, hi)];
    }
    const float mnC = -m_reg * C;
    float ps = 0.f;
#pragma unroll
    for (int r = 0; r < 16; ++r) { pp[r] = __builtin_amdgcn_exp2f(fmaf(pp[r], C, mnC)); ps += pp[r]; }
    { auto rr = __builtin_amdgcn_permlane32_swap(__float_as_uint(ps), __float_as_uint(ps), false, false);
      ps = __uint_as_float(rr[0]) + __uint_as_float(rr[1]); }
    l_reg = l_reg * alpha + ps;
    bf16x8 pa0, pa1;
    pack_p(pp, pa0, pa1);
#define PVD(D0) do { s16x4 l0, h0, l1, h1; tr_frag_issue<D0, 2 * HF>(vb, l0, h0); tr_frag_issue<D0, 2 * HF + 1>(vb, l1, h1); LGKM0(); \
        o[D0] = __builtin_amdgcn_mfma_f32_32x32x16_bf16(pa0, PKLH(l0, h0), o[D0], 0, 0, 0); \
        o[D0] = __builtin_amdgcn_mfma_f32_32x32x16_bf16(pa1, PKLH(l1, h1), o[D0], 0, 0, 0); } while (0)
    PVD(0); PVD(1); PVD(2); PVD(3);
#undef PVD
}

DEVI void diffattn_item(const P& p, int q0, int k0row, int seq, int h, char* lds) {
    int tid = threadIdx.x; asm volatile("" : "+v"(tid));
    const int wid = tid >> 6, lane = tid & 63, r32 = lane & 31, hi = lane >> 5;
    const u16* Q = (const u16*)(p.ws + OFF_Q); const u16* Kg = (const u16*)(p.ws + OFF_K) + (size_t)k0row * 512 + h * 128;
    const u16* Vg = (const u16*)(p.ws + OFF_V) + (size_t)k0row * 512 + h * 128;
    char* V_lds = lds; char* K_lds = lds + 2 * AT_V;
    float* al = (float*)(lds + 2 * AT_V + 2 * AT_K) + wid * 64;
    bf16x8 qr[8];
    { const u16* Qw = Q + (size_t)(q0 + wid * 32 + r32) * 512 + h * 128 + hi * 8;
#pragma unroll
      for (int d0 = 0; d0 < 8; ++d0) qr[d0] = *reinterpret_cast<const bf16x8*>(Qw + d0 * 16); }
    const int sr = tid >> 4, sc = (tid & 15) * 8;
    const int vb0 = (int)(uintptr_t)V_lds + v_rd_base(lane);
    const int vc = ((tid >> 5) & 3) * 32 + (tid & 3) * 8;
    const int kk0 = (tid >> 7) * 8 + ((tid & 31) >> 2), kk1 = kk0 + 32;
    const int vk0 = (kk0 & ~0xC) | ((kk0 & 4) << 1) | ((kk0 & 8) >> 1), vk1 = (kk1 & ~0xC) | ((kk1 & 4) << 1) | ((kk1 & 8) >> 1);
    u32x4 sk0, sk1;
#define SLOAD(kk, b) do { \
    __builtin_amdgcn_global_load_lds((const unsigned*)(Vg + (size_t)((kk) + vk0) * 512 + vc), (LAS unsigned*)(V_lds + (b) * AT_V + tid * 16), 16, 0, 0); \
    __builtin_amdgcn_global_load_lds((const unsigned*)(Vg + (size_t)((kk) + vk1) * 512 + vc), (LAS unsigned*)(V_lds + (b) * AT_V + 8192 + tid * 16), 16, 0, 0); \
    sk0 = *reinterpret_cast<const u32x4*>(Kg + (size_t)((kk) + sr) * 512 + sc); sk1 = *reinterpret_cast<const u32x4*>(Kg + (size_t)((kk) + 32 + sr) * 512 + sc); } while (0)
#define SWRITE(b) do { *reinterpret_cast<u32x4*>(K_lds + (b) * AT_K + swz256(sr, tid & 15)) = sk0; *reinterpret_cast<u32x4*>(K_lds + (b) * AT_K + swz256(32 + sr, tid & 15)) = sk1; } while (0)
    float m0 = -1e30f, m1 = -1e30f, l0 = 0.f, l1 = 0.f;
    f32x16 o0[4] = {}, o1[4] = {};
    const int NT = seq / 64;
    __syncthreads();
    SLOAD(0, 0); SWRITE(0); asm volatile("s_waitcnt vmcnt(0)" ::: "memory"); __syncthreads();
    if (NT > 1) SLOAD(64, 1);
    for (int j = 0; j < NT; ++j) {
        const int cur = j & 1;
        const char* Ks = K_lds + cur * AT_K;
        attn_half<0, 0>(Ks, qr, m0, l0, o0, vb0 + cur * AT_V, al, r32, hi);
        attn_half<1, 0>(Ks, qr, m0, l0, o0, vb0 + cur * AT_V, al, r32, hi);
        attn_half<0, 4>(Ks, qr, m1, l1, o1, vb0 + cur * AT_V, al, r32, hi);
        attn_half<1, 4>(Ks, qr, m1, l1, o1, vb0 + cur * AT_V, al, r32, hi);
        if (j + 1 < NT) SWRITE(cur ^ 1);
        asm volatile("s_waitcnt vmcnt(0)" ::: "memory");
        __syncthreads();
        if (j + 2 < NT) SLOAD((j + 2) * 64, cur);
    }
#undef SLOAD
#undef SWRITE
    int tz = threadIdx.x; asm volatile("" : "+v"(tz));
    const int wid2 = tz >> 6, lane2 = tz & 63, r32e = lane2 & 31, hie = lane2 >> 5;
    const float lam = ((const float*)(p.ws + OFF_LAM))[0];
    float* sc0 = (float*)(lds + 2 * AT_V + 2 * AT_K) + wid2 * 64; float* sc1 = sc0 + 32;
    if (hie == 0) { sc0[r32e] = 1.f / l0; sc1[r32e] = -lam / l1; }
    asm volatile("s_waitcnt lgkmcnt(0)" ::: "memory");
    float ssq[16];
#pragma unroll
    for (int r = 0; r < 16; ++r) {
        const float a = sc0[crow(r, hie)], b = sc1[crow(r, hie)]; float s = 0.f;
#pragma unroll
        for (int d = 0; d < 4; ++d) { const float v = o0[d][r] * a + o1[d][r] * b; o0[d][r] = v; s = fmaf(v, v, s); }
        ssq[r] = s;
    }
#pragma unroll
    for (int r = 0; r < 16; ++r) { float s = ssq[r]; for (int o = 16; o; o >>= 1) s += __shfl_xor(s, o); ssq[r] = rsqrtf(s * (1.f / 128.f) + 1e-6f) * 0.8f; }
    u16* mix = (u16*)(p.ws + OFF_ACT);
    const float* sg = p.subln_g;
#pragma unroll
    for (int d = 0; d < 4; ++d) {
        const float gv = sg[d * 32 + r32e];
#pragma unroll
        for (int r = 0; r < 16; ++r) mix[(size_t)(q0 + wid2 * 32 + crow(r, hie)) * 1024 + h * 128 + d * 32 + r32e] = f2bf(o0[d][r] * ssq[r] * gv);
    }
}

DEVI void chunk_scan(const float* gates, int row0, int head, int dir, float* Bq, float* av, float* pm, float& total, float& amax) {
    const int lane = threadIdx.x & 63;
    const int e0 = dir ? 127 - 2 * lane : 2 * lane, e1 = dir ? 126 - 2 * lane : 2 * lane + 1;
    const float lf0 = gates[(size_t)(row0 + e0) * 16 + (dir ? 12 : 4) + head], lf1 = gates[(size_t)(row0 + e1) * 16 + (dir ? 12 : 4) + head];
    const float li0 = gates[(size_t)(row0 + e0) * 16 + (dir ? 8 : 0) + head],  li1 = gates[(size_t)(row0 + e1) * 16 + (dir ? 8 : 0) + head];
    const float s1 = lf0 + lf1; float inc = s1;
#pragma unroll
    for (int o = 1; o < 64; o <<= 1) { const float t = __shfl_up(inc, o); if (lane >= o) inc += t; }
    const float exc = inc - s1;
    const float B0 = exc + lf0, B1 = exc + s1;
    const float a0 = li0 - B0, a1 = li1 - B1;
    const float m1 = fmaxf(a0, a1); float mx = m1;
#pragma unroll
    for (int o = 1; o < 64; o <<= 1) { const float t = __shfl_up(mx, o); if (lane >= o) mx = fmaxf(mx, t); }
    float mprev = __shfl_up(mx, 1); if (lane == 0) mprev = -1e30f;
    Bq[e0] = B0; Bq[e1] = B1; av[e0] = a0; av[e1] = a1; pm[e0] = fmaxf(mprev, a0); pm[e1] = mx;
    total = __shfl(inc, 63); amax = __shfl(mx, 63);
}

DEVI void conv_silu8(const u32x4& xm, const u32x4& x0, const u32x4& xp, const float* wc, bool hasm, bool hasp, float (&out)[8]) {
#pragma unroll
    for (int j = 0; j < 4; ++j) {
        const float w00 = wc[2 * j], w01 = wc[2 * j + 1], w10 = wc[1024 + 2 * j], w11 = wc[1024 + 2 * j + 1], w20 = wc[2048 + 2 * j], w21 = wc[2048 + 2 * j + 1];
        float a = w10 * bflo(x0[j]), b = w11 * bfhi(x0[j]);
        if (hasm) { a = fmaf(w00, bflo(xm[j]), a); b = fmaf(w01, bfhi(xm[j]), b); }
        if (hasp) { a = fmaf(w20, bflo(xp[j]), a); b = fmaf(w21, bfhi(xp[j]), b); }
        out[2 * j] = siluf_(a); out[2 * j + 1] = siluf_(b);
    }
}
DEVI void seg_edges(int t  , bool& hasm, bool& hasp) {
    hasm = !(t == 0 || t == TC); hasp = !(t == TC - 1 || t == TT - 1);
}
DEVI int chain_slot(int dir, int b, int h, int cc) { return ((dir * 2 + b) * 4 + h) * NCH + cc; }

DEVI void phase_mlstm_a(const P& p, char* lds) {
    const int tid = threadIdx.x, wid = __builtin_amdgcn_readfirstlane(tid >> 6), lane = tid & 63, r32 = lane & 31, hi = lane >> 5;
    char* Vimg = lds; char* Kf = lds + 32768; char* Kb = lds + 65536;
    float* arr = (float*)(lds + 98304);
    const float* gates = (const float*)(p.ws + OFF_GATES);
    const u16* MLQK = (const u16*)(p.ws + OFF_MLQK); const u16* MLV = (const u16*)(p.ws + OFF_MLV);
    u16* CST = (u16*)(p.ws + OFF_CST); float* NST = (float*)(p.ws + OFF_NST); u16* MLC = (u16*)(p.ws + OFF_MLC);
    float2* scal = (float2*)(p.ws + OFF_MSCAL);
    for (int it = blockIdx.x; it < NB * 4 * NCH; it += gridDim.x) {
        const int cc = it % NCH, h = (it / NCH) & 3, b = it / (NCH * 4);
        const int row0 = b * TT + cc * 128;
        __syncthreads();
        if (wid < 2) {
            float total, amax; float* a4 = arr + wid * 512;
            chunk_scan(gates, row0, h, wid, a4, a4 + 128, a4 + 256, total, amax);
            a4[384 + lane] = __expf(a4[128 + lane] - amax); a4[384 + 64 + lane] = __expf(a4[128 + 64 + lane] - amax);
            if (lane == 0) scal[chain_slot(wid, b, h, 0) + cc] = make_float2(total + amax, total);
        }
        __syncthreads();
#pragma unroll
        for (int i = 0; i < 4; ++i) {
            const int idx = tid + 512 * i, l = idx >> 4, c = (idx & 15) * 8;
            const u32x4 v = *reinterpret_cast<const u32x4*>(MLV + (size_t)(row0 + l) * 512 + h * 128 + c);
            *reinterpret_cast<u32x4*>(Vimg + (l >> 6) * 16384 + v_st(l & 63, c)) = v;
            const int t = cc * 128 + l; bool hasm, hasp; seg_edges(t, hasm, hasp);
            const u16* kp = MLQK + (size_t)(row0 + l) * 1024 + 512 + h * 128 + c;
            const u32x4 x0 = *reinterpret_cast<const u32x4*>(kp);
            const u32x4 xm = hasm ? *reinterpret_cast<const u32x4*>(kp - 1024) : x0;
            const u32x4 xp = hasp ? *reinterpret_cast<const u32x4*>(kp + 1024) : x0;
            float kv[8]; conv_silu8(xm, x0, xp, p.conv_w + 512 + h * 128 + c, hasm, hasp, kv);
            const float wf = arr[384 + l] * 0.08838834764831845f, wb = arr[512 + 384 + l] * 0.08838834764831845f;
            u32x4 of, ob, ok;
#pragma unroll
            for (int j = 0; j < 4; ++j) { of[j] = cvtpk(kv[2 * j] * wf, kv[2 * j + 1] * wf); ob[j] = cvtpk(kv[2 * j] * wb, kv[2 * j + 1] * wb);
                ok[j] = cvtpk(kv[2 * j] * 0.08838834764831845f, kv[2 * j + 1] * 0.08838834764831845f); }
            *reinterpret_cast<u32x4*>(MLC + (size_t)(row0 + l) * 1024 + 512 + h * 128 + c) = ok;
            {
                const u16* qp = kp - 512;
                const u32x4 q0 = *reinterpret_cast<const u32x4*>(qp);
                const u32x4 qm = hasm ? *reinterpret_cast<const u32x4*>(qp - 1024) : q0;
                const u32x4 qn = hasp ? *reinterpret_cast<const u32x4*>(qp + 1024) : q0;
                float qv[8]; conv_silu8(qm, q0, qn, p.conv_w + h * 128 + c, hasm, hasp, qv);
                u32x4 oq;
#pragma unroll
                for (int j = 0; j < 4; ++j) oq[j] = cvtpk(qv[2 * j], qv[2 * j + 1]);
                *reinterpret_cast<u32x4*>(MLC + (size_t)(row0 + l) * 1024 + h * 128 + c) = oq;
            }
            *reinterpret_cast<u32x4*>(Kf + (l >> 6) * 16384 + v_st(l & 63, c)) = of;
            *reinterpret_cast<u32x4*>(Kb + (l >> 6) * 16384 + v_st(l & 63, c)) = ob;
        }
        __syncthreads();
        const int dir = wid >> 2, vblk = wid & 3;
        const int va = (int)(uintptr_t)Vimg + v_rd_base(lane), ka = (int)(uintptr_t)(dir ? Kb : Kf) + v_rd_base(lane);
        f32x16 acc[4] = {};
#define ASTEP(H, KS) do { s16x4 al_, ah_, b0l, b0h, b1l, b1h, b2l, b2h, b3l, b3h; \
        if (vblk == 0) tr_frag_issue<0, KS>(va + (H) * 16384, al_, ah_); else if (vblk == 1) tr_frag_issue<1, KS>(va + (H) * 16384, al_, ah_); \
        else if (vblk == 2) tr_frag_issue<2, KS>(va + (H) * 16384, al_, ah_); else tr_frag_issue<3, KS>(va + (H) * 16384, al_, ah_); \
        tr_frag_issue<0, KS>(ka + (H) * 16384, b0l, b0h); tr_frag_issue<1, KS>(ka + (H) * 16384, b1l, b1h); \
        tr_frag_issue<2, KS>(ka + (H) * 16384, b2l, b2h); tr_frag_issue<3, KS>(ka + (H) * 16384, b3l, b3h); LGKM0(); \
        const bf16x8 af = PKLH(al_, ah_); \
        acc[0] = __builtin_amdgcn_mfma_f32_32x32x16_bf16(af, PKLH(b0l, b0h), acc[0], 0, 0, 0); \
        acc[1] = __builtin_amdgcn_mfma_f32_32x32x16_bf16(af, PKLH(b1l, b1h), acc[1], 0, 0, 0); \
        acc[2] = __builtin_amdgcn_mfma_f32_32x32x16_bf16(af, PKLH(b2l, b2h), acc[2], 0, 0, 0); \
        acc[3] = __builtin_amdgcn_mfma_f32_32x32x16_bf16(af, PKLH(b3l, b3h), acc[3], 0, 0, 0); } while (0)
        ASTEP(0, 0); ASTEP(0, 1); ASTEP(0, 2); ASTEP(0, 3); ASTEP(1, 0); ASTEP(1, 1); ASTEP(1, 2); ASTEP(1, 3);
#undef ASTEP
        u16* Cd = CST + (size_t)chain_slot(dir, b, h, cc) * 16384;
#pragma unroll
        for (int kb = 0; kb < 4; ++kb)
#pragma unroll
            for (int r = 0; r < 16; ++r) Cd[(vblk * 32 + crow(r, hi)) * 128 + kb * 32 + r32] = f2bf(acc[kb][r]);
        if (tid < 256) {
            const int d2 = tid >> 7, k = tid & 127; const char* img = d2 ? Kb : Kf; float s = 0.f;
            for (int l = 0; l < 128; ++l) s += bf2f(*reinterpret_cast<const u16*>(img + (l >> 6) * 16384 + v_st(l & 63, k & ~7) + (k & 7) * 2));
            NST[(size_t)chain_slot(d2, b, h, cc) * 128 + k] = s;
        }
    }
}

DEVI void phase_kmax(const P& p, char* lds) {
    const int tid = threadIdx.x; unsigned* lm = (unsigned*)lds;
    __syncthreads();
    if (tid < 16) lm[tid] = 0u;
    __syncthreads();
    const u16* K = (const u16*)(p.ws + OFF_K); const int hm = tid & 7;
    float mx0 = 0.f, mx1 = 0.f;
    for (int idx = blockIdx.x * NTHR + tid; idx < NTOK * 8; idx += gridDim.x * NTHR) {
        const int tok = idx >> 3; const u16* kp = K + (size_t)tok * 512 + hm * 64; float ss = 0.f;
#pragma unroll
        for (int c = 0; c < 8; ++c) { const u32x4 w = *reinterpret_cast<const u32x4*>(kp + c * 8);
#pragma unroll
            for (int j = 0; j < 4; ++j) { const float a = bflo(w[j]), b = bfhi(w[j]); ss = fmaf(a, a, ss); ss = fmaf(b, b, ss); } }
        if (tok < TT) mx0 = fmaxf(mx0, ss); else mx1 = fmaxf(mx1, ss);
    }
    atomicMax(&lm[hm], __float_as_uint(mx0)); atomicMax(&lm[8 + hm], __float_as_uint(mx1));
    __syncthreads();
    if (tid < 16) atomicMax((unsigned*)(p.ws + OFF_CNT) + 128 + tid, lm[tid]);
    __syncthreads();
}

DEVI int proc_chunk(int dir, int i) { return dir == 0 ? i : (i == 0 ? 1 : (i == 1 ? 0 : NCH + 1 - i)); }

DEVI void phase_mlstm_b(const P& p, char* lds) {
    const int tid = threadIdx.x;
    float* dec = (float*)lds; float* scl = dec + 160; float* mst = scl + 160;
    const float2* scal = (const float2*)(p.ws + OFF_MSCAL);
    u32* CST = (u32*)(p.ws + OFF_CST); float* NST = (float*)(p.ws + OFF_NST); float* MST = (float*)(p.ws + OFF_MST);
    for (int it = blockIdx.x; it < 16 * 16; it += gridDim.x) {
        const int chain = it >> 4, sub = it & 15, dir = chain >> 3;
        __syncthreads();
        if (tid == 0) {
            float m = 0.f;
            for (int i = 0; i < NCH; ++i) {
                const int cc = proc_chunk(dir, i); const float2 s = scal[chain * NCH + cc];
                const float mn = fmaxf(s.y + m, s.x);
                dec[i] = __expf(s.y + m - mn); scl[i] = __expf(s.x - mn); mst[i] = m;
                if (sub == 0) MST[chain * NCH + cc] = m;
                m = mn;
            }
        }
        __syncthreads();
        u32* base = CST + (size_t)chain * NCH * 8192 + sub * 512 + tid;
        float s0 = 0.f, s1 = 0.f;
        for (int i0 = 0; i0 < NCH; i0 += 10) {
            u32 v[10];
#pragma unroll
            for (int j = 0; j < 10; ++j) v[j] = base[(size_t)proc_chunk(dir, i0 + j) * 8192];
#pragma unroll
            for (int j = 0; j < 10; ++j) {
                base[(size_t)proc_chunk(dir, i0 + j) * 8192] = cvtpk(s0, s1);
                const float d = dec[i0 + j], sc = scl[i0 + j];
                s0 = fmaf(d, s0, sc * bflo(v[j])); s1 = fmaf(d, s1, sc * bfhi(v[j]));
            }
        }
        if (sub == 0 && tid < 128) {
            float* nb = NST + (size_t)chain * NCH * 128 + tid; float s = 0.f;
            for (int i = 0; i < NCH; ++i) { const int cc = proc_chunk(dir, i); const float v = nb[cc * 128]; nb[cc * 128] = s; s = fmaf(dec[i], s, scl[i] * v); }
        }
    }
}

DEVI void mlstm_c_item(const P& p, int it, char* lds) {
    int tid = threadIdx.x; asm volatile("" : "+v"(tid));
    const int wid = __builtin_amdgcn_readfirstlane(tid >> 6), lane = tid & 63, r32 = lane & 31, hi = lane >> 5;
    const int cc = it % NCH, h = (it / NCH) & 3, b = it / (NCH * 4);
    const int row0 = b * TT + cc * 128;
    char* Kt = lds; char* Vimg = lds + 34816; char* Ct = lds + 67584;
    float* arr = (float*)(lds + 137216);
    float* wsc = arr + 1024 + wid * 64;
    float* xb = (float*)lds;
    const float* gates = (const float*)(p.ws + OFF_GATES);
    const u16* MLC = (const u16*)(p.ws + OFF_MLC); const u16* MLV = (const u16*)(p.ws + OFF_MLV);
    const u16* CST = (const u16*)(p.ws + OFF_CST); const float* NST = (const float*)(p.ws + OFF_NST); const float* MST = (const float*)(p.ws + OFF_MST);
    __syncthreads();
    if (wid < 2) { float total, amax; float* a4 = arr + wid * 512; chunk_scan(gates, row0, h, wid, a4, a4 + 128, a4 + 256, total, amax); }
    else if (wid < 6) { const int d2 = (wid - 2) >> 1, k = ((wid - 2) & 1) * 64 + lane; arr[d2 * 512 + 384 + k] = NST[(size_t)chain_slot(d2, b, h, cc) * 128 + k]; }
#pragma unroll
    for (int i = 0; i < 4; ++i) {
        const int idx = tid + 512 * i, l = idx >> 4, ch = idx & 15, c = ch * 8;
        const u32x4 v = *reinterpret_cast<const u32x4*>(MLV + (size_t)(row0 + l) * 512 + h * 128 + c);
        *reinterpret_cast<u32x4*>(Vimg + (l >> 6) * 16384 + v_st(l & 63, c)) = v;
        const u32x4 ok = *reinterpret_cast<const u32x4*>(MLC + (size_t)(row0 + l) * 1024 + 512 + h * 128 + c);
        *reinterpret_cast<u32x4*>(Kt + swz256(l, ch)) = ok;
#pragma unroll
        for (int d2 = 0; d2 < 2; ++d2) {
            const u32x4 cv = *reinterpret_cast<const u32x4*>(CST + (size_t)chain_slot(d2, b, h, cc) * 16384 + l * 128 + c);
            *reinterpret_cast<u32x4*>(Ct + d2 * 34816 + swz256(l, ch)) = cv;
        }
    }
    const int dir = wid >> 2, qb = wid & 3, q = qb * 32 + r32;
    bf16x8 qr[8];
    { const u16* qp = MLC + (size_t)(row0 + q) * 1024 + h * 128 + hi * 8;
#pragma unroll
      for (int d0 = 0; d0 < 8; ++d0) qr[d0] = *reinterpret_cast<const bf16x8*>(qp + d0 * 16); }
    __syncthreads();
    const float* a4 = arr + dir * 512;
    const float m_st = MST[chain_slot(dir, b, h, 0) + cc];
    const float Mq = fmaxf(m_st, a4[256 + q]);
    const float inter = __expf(m_st - Mq);
    float nq = 0.f;
#pragma unroll
    for (int d0 = 0; d0 < 8; ++d0) {
        const u32x4 w = *reinterpret_cast<const u32x4*>(&qr[d0]); const float* nn = a4 + 384 + d0 * 16 + hi * 8;
#pragma unroll
        for (int j = 0; j < 4; ++j) { nq = fmaf(bflo(w[j]), nn[2 * j], nq); nq = fmaf(bfhi(w[j]), nn[2 * j + 1], nq); }
    }
    { auto rr = __builtin_amdgcn_permlane32_swap(__float_as_uint(nq), __float_as_uint(nq), false, false); nq = __uint_as_float(rr[0]) + __uint_as_float(rr[1]); }
    f32x16 o[4] = {};
    const char* Cm = Ct + dir * 34816;
#pragma unroll
    for (int dk = 0; dk < 8; ++dk)
#pragma unroll
        for (int d0 = 0; d0 < 4; ++d0) o[d0] = __builtin_amdgcn_mfma_f32_32x32x16_bf16(qr[dk], lds_b128(Cm, swz256(d0 * 32 + r32, 2 * dk + hi)), o[d0], 0, 0, 0);
    if (hi == 0) wsc[r32] = inter;
    asm volatile("s_waitcnt lgkmcnt(0)" ::: "memory");
#pragma unroll
    for (int d0 = 0; d0 < 4; ++d0)
#pragma unroll
        for (int r = 0; r < 16; ++r) o[d0][r] *= wsc[crow(r, hi)];
    const int vb = (int)(uintptr_t)Vimg + v_rd_base(lane);
    float rs = 0.f;
#define KBLK(KB) do { if (dir == 0 ? (KB) <= qb : (KB) >= qb) { \
        f32x16 pp = {}; \
        _Pragma("unroll") for (int d0 = 0; d0 < 8; ++d0) pp = __builtin_amdgcn_mfma_f32_32x32x16_bf16(lds_b128(Kt, swz256((KB) * 32 + r32, 2 * d0 + hi)), qr[d0], pp, 0, 0, 0); \
        _Pragma("unroll") for (int g = 0; g < 4; ++g) { const f32x4 av4 = *reinterpret_cast<const f32x4*>(a4 + 128 + (KB) * 32 + 8 * g + 4 * hi); \
            _Pragma("unroll") for (int j = 0; j < 4; ++j) { const int key = (KB) * 32 + 8 * g + 4 * hi + j; const bool ok = dir == 0 ? key <= q : key >= q; \
                const float sv = ok ? pp[4 * g + j] * __expf(av4[j] - Mq) : 0.f; pp[4 * g + j] = sv; rs += sv; } } \
        bf16x8 f0, f1; pack_p(pp, f0, f1); \
        { s16x4 l0, h0, l1, h1, l2, h2, l3, h3; constexpr int HH = (KB) >> 1, K0 = ((KB) & 1) * 2; \
          tr_frag_issue<0, K0>(vb + HH * 16384, l0, h0); tr_frag_issue<1, K0>(vb + HH * 16384, l1, h1); tr_frag_issue<2, K0>(vb + HH * 16384, l2, h2); tr_frag_issue<3, K0>(vb + HH * 16384, l3, h3); LGKM0(); \
          o[0] = __builtin_amdgcn_mfma_f32_32x32x16_bf16(f0, PKLH(l0, h0), o[0], 0, 0, 0); o[1] = __builtin_amdgcn_mfma_f32_32x32x16_bf16(f0, PKLH(l1, h1), o[1], 0, 0, 0); \
          o[2] = __builtin_amdgcn_mfma_f32_32x32x16_bf16(f0, PKLH(l2, h2), o[2], 0, 0, 0); o[3] = __builtin_amdgcn_mfma_f32_32x32x16_bf16(f0, PKLH(l3, h3), o[3], 0, 0, 0); \
          tr_frag_issue<0, K0 + 1>(vb + HH * 16384, l0, h0); tr_frag_issue<1, K0 + 1>(vb + HH * 16384, l1, h1); tr_frag_issue<2, K0 + 1>(vb + HH * 16384, l2, h2); tr_frag_issue<3, K0 + 1>(vb + HH * 16384, l3, h3); LGKM0(); \
          o[0] = __builtin_amdgcn_mfma_f32_32x32x16_bf16(f1, PKLH(l0, h0), o[0], 0, 0, 0); o[1] = __builtin_amdgcn_mfma_f32_32x32x16_bf16(f1, PKLH(l1, h1), o[1], 0, 0, 0); \
          o[2] = __builtin_amdgcn_mfma_f32_32x32x16_bf16(f1, PKLH(l2, h2), o[2], 0, 0, 0); o[3] = __builtin_amdgcn_mfma_f32_32x32x16_bf16(f1, PKLH(l3, h3), o[3], 0, 0, 0); } } } while (0)
    KBLK(0); KBLK(1); KBLK(2); KBLK(3);
#undef KBLK
    { auto rr = __builtin_amdgcn_permlane32_swap(__float_as_uint(rs), __float_as_uint(rs), false, false); rs = __uint_as_float(rr[0]) + __uint_as_float(rr[1]); }
    const float nqt = inter * nq + rs;
    const float den = fmaxf(fabsf(nqt), __expf(-(a4[q] + Mq)));
    if (hi == 0) wsc[32 + r32] = 1.f / den;
    asm volatile("s_waitcnt lgkmcnt(0)" ::: "memory");
#pragma unroll
    for (int d0 = 0; d0 < 4; ++d0)
#pragma unroll
        for (int r = 0; r < 16; ++r) o[d0][r] *= wsc[32 + crow(r, hi)];
    __syncthreads();
    {
        float* xd = dir ? xb : (float*)(lds + 67584);
#pragma unroll
        for (int d0 = 0; d0 < 4; ++d0)
#pragma unroll
            for (int r = 0; r < 16; ++r) xd[(qb * 32 + crow(r, hi)) * 128 + d0 * 32 + r32] = o[d0][r];
    }
    __syncthreads();
    {
        const u16* OG = (const u16*)(p.ws + OFF_OG); u16* mix = (u16*)(p.ws + OFF_ACT);
        const float* xf = (const float*)(lds + 67584);
#pragma unroll
        for (int i = 0; i < 4; ++i) {
            const int idx = tid + 512 * i, ql = idx >> 4, c = (idx & 15) * 8;
            const f32x4 f0 = *reinterpret_cast<const f32x4*>(xf + ql * 128 + c), f1 = *reinterpret_cast<const f32x4*>(xf + ql * 128 + c + 4);
            const f32x4 b0 = *reinterpret_cast<const f32x4*>(xb + ql * 128 + c), b1 = *reinterpret_cast<const f32x4*>(xb + ql * 128 + c + 4);
            const u32x4 og = *reinterpret_cast<const u32x4*>(OG + (size_t)(row0 + ql) * 512 + h * 128 + c);
            u32x4 w;
            w[0] = cvtpk((f0[0] + b0[0]) * bflo(og[0]), (f0[1] + b0[1]) * bfhi(og[0]));
            w[1] = cvtpk((f0[2] + b0[2]) * bflo(og[1]), (f0[3] + b0[3]) * bfhi(og[1]));
            w[2] = cvtpk((f1[0] + b1[0]) * bflo(og[2]), (f1[1] + b1[1]) * bfhi(og[2]));
            w[3] = cvtpk((f1[2] + b1[2]) * bflo(og[3]), (f1[3] + b1[3]) * bfhi(og[3]));
            *reinterpret_cast<u32x4*>(mix + (size_t)(row0 + ql) * 1024 + 512 + h * 128 + c) = w;
        }
    }
}

#define KSWZ(row, colB) ((row) * 256 + ((colB) ^ (((row) & 15) << 4)))
constexpr float A2_SCALE = 0.125f, A2_THR = 8.f;
DEVI void a2_partialSM(f32x16& p0, f32x16& p1, float) {
#pragma unroll
    for (int r = 0; r < 16; ++r) p0[r] = __builtin_amdgcn_exp2f(p0[r]);
}
DEVI void a2_finishSM(f32x16& p0, f32x16& p1, float& l_reg, bf16x8& pa0, bf16x8& pa1, bf16x8& pa2, bf16x8& pa3) {
#pragma unroll
    for (int r = 0; r < 16; ++r) p1[r] = __builtin_amdgcn_exp2f(p1[r]);
    float ps = 0.f;
#pragma unroll
    for (int r = 0; r < 16; ++r) ps += p0[r];
#pragma unroll
    for (int r = 0; r < 16; ++r) ps += p1[r];
    l_reg += ps;
    pack_p(p0, pa0, pa1); pack_p(p1, pa2, pa3);
}
DEVI void a2_qkt(f32x16& p0, f32x16& p1, const char* Ks, const bf16x8 (&qr)[4], int r32, int hi, int grp, float mnC) {
#pragma unroll
    for (int r = 0; r < 16; ++r) { p0[r] = mnC; p1[r] = mnC; }
#pragma unroll
    for (int d0 = 0; d0 < 4; ++d0) { const int cb = (grp * 64 + d0 * 16 + hi * 8) * 2;
        const bf16x8 b0 = lds_b128(Ks, KSWZ(r32, cb)), b1 = lds_b128(Ks, KSWZ(32 + r32, cb));
        p0 = __builtin_amdgcn_mfma_f32_32x32x16_bf16(b0, qr[d0], p0, 0, 0, 0);
        p1 = __builtin_amdgcn_mfma_f32_32x32x16_bf16(b1, qr[d0], p1, 0, 0, 0); }
}
#define A2_VISSUE(D0, F) do { tr_frag_issue<D0, 0>(vb, F##l0, F##h0); tr_frag_issue<D0, 1>(vb, F##l1, F##h1); tr_frag_issue<D0, 2>(vb, F##l2, F##h2); tr_frag_issue<D0, 3>(vb, F##l3, F##h3); } while (0)
#define A2_VMMA(D0, F) do { \
    o[D0] = __builtin_amdgcn_mfma_f32_32x32x16_bf16(pa0, PKLH(F##l0, F##h0), o[D0], 0, 0, 0); o[D0] = __builtin_amdgcn_mfma_f32_32x32x16_bf16(pa1, PKLH(F##l1, F##h1), o[D0], 0, 0, 0); \
    o[D0] = __builtin_amdgcn_mfma_f32_32x32x16_bf16(pa2, PKLH(F##l2, F##h2), o[D0], 0, 0, 0); o[D0] = __builtin_amdgcn_mfma_f32_32x32x16_bf16(pa3, PKLH(F##l3, F##h3), o[D0], 0, 0, 0); } while (0)
#define A2_LGKM(N) do { asm volatile("s_waitcnt lgkmcnt(" #N ")" ::: "memory"); SBAR(); } while (0)
template <int S> DEVI void a2_psm_slice(f32x16& x0, f32x16&, float) {
#pragma unroll
    for (int r = 4 * S; r < 4 * S + 4; ++r) x0[r] = __builtin_amdgcn_exp2f(x0[r]);
}
DEVI void a2_pv(f32x16 (&o)[4], int vb, const bf16x8& pa0, const bf16x8& pa1, const bf16x8& pa2, const bf16x8& pa3, f32x16& x0, f32x16& x1, float mnC) {
    s16x4 al0, ah0, al1, ah1, al2, ah2, al3, ah3, bl0, bh0, bl1, bh1, bl2, bh2, bl3, bh3;
    A2_VISSUE(0, a); A2_VISSUE(1, b);
    A2_LGKM(8); a2_psm_slice<0>(x0, x1, mnC); A2_VMMA(0, a);
    A2_VISSUE(2, a);
    A2_LGKM(8); a2_psm_slice<1>(x0, x1, mnC); A2_VMMA(1, b);
    A2_VISSUE(3, b);
    A2_LGKM(8); a2_psm_slice<2>(x0, x1, mnC); A2_VMMA(2, a);
    A2_LGKM(0); a2_psm_slice<3>(x0, x1, mnC); A2_VMMA(3, b);
}
DEVI void a2_pv_last(f32x16 (&o)[4], int vb, const bf16x8& pa0, const bf16x8& pa1, const bf16x8& pa2, const bf16x8& pa3) {
    s16x4 al0, ah0, al1, ah1, al2, ah2, al3, ah3, bl0, bh0, bl1, bh1, bl2, bh2, bl3, bh3;
    A2_VISSUE(0, a); A2_VISSUE(1, b);
    A2_LGKM(8); A2_VMMA(0, a);
    A2_VISSUE(2, a);
    A2_LGKM(8); A2_VMMA(1, b);
    A2_VISSUE(3, b);
    A2_LGKM(8); A2_VMMA(2, a);
    A2_LGKM(0); A2_VMMA(3, b);
}
constexpr int A2_T = 16384;
DEVI void a2_body(const P& p, int q0, int k0row, int seq, int h, char* lds, int tid) {
    const int GRP = __builtin_amdgcn_readfirstlane(tid >> 8); const int wid = tid >> 6, lane = tid & 63, r32 = lane & 31, hi = lane >> 5, wq = wid & 3;
    const u16* Kh = (const u16*)(p.ws + OFF_K) + (size_t)k0row * 512 + h * 128;
    const u16* Vh = (const u16*)(p.ws + OFF_V) + (size_t)k0row * 512 + h * 128;
    char* V_lds = lds; char* K_lds = lds + 3 * A2_T;
    float* wsc = (float*)(lds + 6 * A2_T) + wid * 64; float* li_l = wsc;
    float l_reg = 0.f; f32x16 o[4] = {}; bf16x8 qr[4];
    { const u16* Qw = (const u16*)(p.ws + OFF_Q) + (size_t)(q0 + wq * 32 + r32) * 512 + h * 128 + GRP * 64 + hi * 8;
#pragma unroll
      for (int d0 = 0; d0 < 4; ++d0) qr[d0] = *reinterpret_cast<const bf16x8*>(Qw + d0 * 16); }
    float mnC;
    { float qq = 0.f;
#pragma unroll
      for (int d0 = 0; d0 < 4; ++d0) { const u32x4 w = *reinterpret_cast<const u32x4*>(&qr[d0]);
#pragma unroll
          for (int j = 0; j < 4; ++j) { const float a = bflo(w[j]), b2 = bfhi(w[j]); qq = fmaf(a, a, qq); qq = fmaf(b2, b2, qq); } }
      { auto rr = __builtin_amdgcn_permlane32_swap(__float_as_uint(qq), __float_as_uint(qq), false, false); qq = __uint_as_float(rr[0]) + __uint_as_float(rr[1]); }
      const int bq = k0row >= TT ? 1 : 0;
      const float k2 = __uint_as_float(((const unsigned*)(p.ws + OFF_CNT))[128 + bq * 8 + h * 2 + GRP]);
      mnC = -sqrtf(qq * k2) * (A2_SCALE * 1.4426950408889634f) * 1.001f;
#pragma unroll
      for (int d0 = 0; d0 < 4; ++d0) { u32x4 w = *reinterpret_cast<u32x4*>(&qr[d0]);
#pragma unroll
          for (int j = 0; j < 4; ++j) w[j] = cvtpk(bflo(w[j]) * (A2_SCALE * 1.4426950408889634f), bfhi(w[j]) * (A2_SCALE * 1.4426950408889634f));
          qr[d0] = *reinterpret_cast<bf16x8*>(&w); } }
    const int vb0 = (int)(uintptr_t)V_lds + v_rd_base(lane);
    const int krow = tid >> 4, kch = (tid & 15) ^ (krow & 15);
    const int vc = ((tid >> 5) & 3) * 32 + (tid & 3) * 8;
    const int kk0 = (tid >> 7) * 8 + ((tid & 31) >> 2), kk1 = kk0 + 32;
    const int vk0 = (kk0 & ~0xC) | ((kk0 & 4) << 1) | ((kk0 & 8) >> 1), vk1 = (kk1 & ~0xC) | ((kk1 & 4) << 1) | ((kk1 & 8) >> 1);
#define A2_DMA(slot, kk) do { \
    __builtin_amdgcn_global_load_lds((const unsigned*)(Kh + (size_t)((kk) + krow) * 512 + kch * 8), (LAS unsigned*)(K_lds + (slot) * A2_T + tid * 16), 16, 0, 0); \
    __builtin_amdgcn_global_load_lds((const unsigned*)(Kh + (size_t)((kk) + 32 + krow) * 512 + kch * 8), (LAS unsigned*)(K_lds + (slot) * A2_T + 8192 + tid * 16), 16, 0, 0); \
    __builtin_amdgcn_global_load_lds((const unsigned*)(Vh + (size_t)((kk) + vk0) * 512 + vc), (LAS unsigned*)(V_lds + (slot) * A2_T + tid * 16), 16, 0, 0); \
    __builtin_amdgcn_global_load_lds((const unsigned*)(Vh + (size_t)((kk) + vk1) * 512 + vc), (LAS unsigned*)(V_lds + (slot) * A2_T + 8192 + tid * 16), 16, 0, 0); } while (0)
    f32x16 pA0, pA1, pB0, pB1; bf16x8 pa0, pa1, pa2, pa3; const int NT = seq / 64;
    __syncthreads();
    A2_DMA(0, 0); asm volatile("s_waitcnt vmcnt(0)" ::: "memory"); __syncthreads();
    A2_DMA(1, 64);
    a2_qkt(pA0, pA1, K_lds, qr, r32, hi, GRP, mnC); a2_partialSM(pA0, pA1, mnC);
    asm volatile("s_waitcnt vmcnt(0)" ::: "memory"); __syncthreads();
    int bp = 0, bc = 1, bn = 2;
#define A2_HALF(X0, X1, Y0, Y1, J) do { \
        if ((J) + 1 < NT) A2_DMA(bn, ((J) + 1) * 64); \
        SBAR(); a2_qkt(X0, X1, K_lds + bc * A2_T, qr, r32, hi, GRP, mnC); \
        a2_finishSM(Y0, Y1, l_reg, pa0, pa1, pa2, pa3); SBAR(); \
        a2_pv(o, vb0 + bp * A2_T, pa0, pa1, pa2, pa3, X0, X1, mnC); \
        asm volatile("s_waitcnt vmcnt(0)" ::: "memory"); __syncthreads(); \
        { const int t_ = bp; bp = bc; bc = bn; bn = t_; } } while (0)
    for (int j = 1; j + 1 < NT; j += 2) {
        A2_HALF(pB0, pB1, pA0, pA1, j);
        A2_HALF(pA0, pA1, pB0, pB1, j + 1);
    }
    A2_HALF(pB0, pB1, pA0, pA1, NT - 1);
    a2_finishSM(pB0, pB1, l_reg, pa0, pa1, pa2, pa3); SBAR();
    a2_pv_last(o, vb0 + bp * A2_T, pa0, pa1, pa2, pa3);
#undef A2_HALF
#undef A2_DMA
    asm volatile("s_waitcnt vmcnt(0)" ::: "memory");
    int tz = threadIdx.x; asm volatile("" : "+v"(tz));
    const int wq_e = (tz >> 6) & 3, r32e = tz & 31, hie = (tz >> 5) & 1;
    float* li_e = (float*)(lds + 6 * A2_T) + (tz >> 6) * 64;
    const float lam = ((const float*)(p.ws + OFF_LAM))[0];
    { auto rr = __builtin_amdgcn_permlane32_swap(__float_as_uint(l_reg), __float_as_uint(l_reg), false, false); l_reg = __uint_as_float(rr[0]) + __uint_as_float(rr[1]); }
    if (hie == 0) li_e[r32e] = (GRP == 0 ? 1.f : -lam) / l_reg;
    asm volatile("s_waitcnt lgkmcnt(0)" ::: "memory");
#pragma unroll
    for (int r = 0; r < 16; ++r) { const float sc_ = li_e[crow(r, hie)];
#pragma unroll
        for (int d = 0; d < 4; ++d) o[d][r] *= sc_; }
    float* xb = (float*)lds;
    __syncthreads();
    if (GRP == 1) {
#pragma unroll
        for (int d = 0; d < 4; ++d)
#pragma unroll
            for (int r = 0; r < 16; ++r) xb[(wq_e * 32 + crow(r, hie)) * 128 + d * 32 + r32e] = o[d][r];
    }
    __syncthreads();
    if (GRP == 0) {
        float ssq[16];
#pragma unroll
        for (int r = 0; r < 16; ++r) { float s_ = 0.f;
#pragma unroll
            for (int d = 0; d < 4; ++d) { const float v = o[d][r] + xb[(wq_e * 32 + crow(r, hie)) * 128 + d * 32 + r32e]; o[d][r] = v; s_ = fmaf(v, v, s_); }
            ssq[r] = s_; }
#pragma unroll
        for (int r = 0; r < 16; ++r) { float s_ = ssq[r]; for (int of = 16; of; of >>= 1) s_ += __shfl_xor(s_, of); ssq[r] = rsqrtf(s_ * (1.f / 128.f) + 1e-6f) * 0.8f; }
        u16* mix = (u16*)(p.ws + OFF_ACT);
#pragma unroll
        for (int d = 0; d < 4; ++d) { const float gv = p.subln_g[d * 32 + r32e];
#pragma unroll
            for (int r = 0; r < 16; ++r) mix[(size_t)(q0 + wq_e * 32 + crow(r, hie)) * 1024 + h * 128 + d * 32 + r32e] = f2bf(o[d][r] * ssq[r] * gv); }
    }
}
DEVI void phase_attn(const P& p, char* lds) {
    const int G = gridDim.x;
    for (int it = blockIdx.x; it < 1024 + 16; it += G) {
        int q0, k0, seq, h;
        if (it < 1024) {
            int bh, qb;
            if ((G & 7) == 0) { bh = it & 7; qb = it >> 3; } else { bh = it >> 7; qb = it & 127; }
            const int b = bh >> 2; h = bh & 3; q0 = b * TT + TC + qb * 128; k0 = b * TT; seq = TT;
        } else { const int j = it - 1024, b = j >> 3; h = (j >> 1) & 3; q0 = b * TT + (j & 1) * 128; k0 = b * TT; seq = TC; }
        int tid = threadIdx.x; asm volatile("" : "+v"(tid));
        a2_body(p, q0, k0, seq, h, lds, tid);
    }
}
DEVI void phase_mlstm_c(const P& p, char* lds) {
    for (int it = blockIdx.x; it < NB * 4 * NCH; it += gridDim.x) mlstm_c_item(p, it, lds);
}

DEVI void tail_bg(const P& p, char* lds, int nunits, int first, int nitems) {
    const int G = gridDim.x, c = blockIdx.x, full = nunits / G, rem = nunits - full * G;
    __syncthreads();
    if (rem == 0) { for (int it = c; it < nitems; it += G) bg_item(p, first + it, (float*)lds); }
    else if (c >= rem) { for (int it = c - rem; it < nitems; it += G - rem) bg_item(p, first + it, (float*)lds); }
    __syncthreads();
}
DEVI void tail_convert(const P& p, char* lds, int layer, int nunits) {
    const int G = gridDim.x, c = blockIdx.x, full = nunits / G, rem = nunits - full * G;
    __syncthreads();
    if (rem == 0) { for (int it = c; it < N0_EXP; it += G) convert_expert_item(p, layer, it, (float*)lds); }
    else if (c >= rem) { for (int it = c - rem; it < N0_EXP; it += G - rem) convert_expert_item(p, layer, it, (float*)lds); }
    __syncthreads();
}
DEVI void phase_convert_l1(const P& p, char* lds) {
    for (int it = blockIdx.x; it < N0_EXP; it += gridDim.x) convert_expert_item(p, 1, it, (float*)lds);
}

constexpr int NPHASE = 19;
__global__ void __launch_bounds__(NTHR, 2) fwd_kernel(P p_) {
    extern __shared__ __attribute__((aligned(16))) char lds[];
    volatile LAS unsigned* st = (volatile LAS unsigned*)(lds + LDS_BYTES - 16);
    if (threadIdx.x == 0) { st[0] = 0u; st[1] = 0u; st[2] = 0u; st[3] = 0u; }
    __syncthreads();
    const int lo = p_.ph_lo, hi = p_.ph_hi;
    XcdBarrier bar; bar.bar = (unsigned*)(p_.ws + OFF_BAR); bar.x = 0; bar.st = st;
    if (hi - lo > 1) bar = xcd_barrier_post((unsigned*)(p_.ws + OFF_BAR), st);
#if defined(__HIP_DEVICE_COMPILE__)
#define PARAMS() const __attribute__((address_space(4))) P* kp_ = (const __attribute__((address_space(4))) P*)__builtin_amdgcn_kernarg_segment_ptr(); asm volatile("" : "+s"(kp_)); const P p = *kp_
#else
#define PARAMS() const P p = p_
#endif
#ifndef PHSEL
#define PHON(k) true
#else
#define PHON(k) ((k) == PHSEL)
#endif
#define IN(k) (lo <= (k) && (k) < hi)
#define SEAM(k) do { if (IN(k) && IN((k) + ((k) == 5 ? 2 : 1))) xcd_barrier(bar); } while (0)
    if (PHON(0) && IN(0)) { PARAMS(); phase_prologue(p, lds); if (((PROBE_DUP) >> 0) & 1u) { phase_prologue(p, lds); } }            SEAM(0);
    if (PHON(1) && IN(1)) { PARAMS(); phase_norm<0>(p, lds); if (((PROBE_DUP) >> 1) & 1u) { phase_norm<0>(p, lds); } }             SEAM(1);
    if (PHON(2) && IN(2)) { PARAMS(); phase_inproj(p, lds); tail_convert(p, lds, 0, (NTOK / 256) * 14); if (((PROBE_DUP) >> 2) & 1u) { phase_inproj(p, lds); } }              SEAM(2);
    if (PHON(3) && IN(3)) { PARAMS(); phase_mlstm_a(p, lds); tail_bg(p, lds, NB * 4 * NCH, 0, N0_WOUT); if (((PROBE_DUP) >> 3) & 1u) { phase_mlstm_a(p, lds); } }             SEAM(3);
    if (PHON(4) && IN(4)) { PARAMS(); phase_kmax(p, lds); phase_mlstm_b(p, lds); if (((PROBE_DUP) >> 4) & 1u) { xcd_barrier(bar); phase_mlstm_a(p, lds); xcd_barrier(bar); phase_mlstm_b(p, lds); } }             SEAM(4);
    if (PHON(5) && IN(5)) { PARAMS(); phase_attn(p, lds); phase_mlstm_c(p, lds); tail_bg(p, lds, NB * 4 * NCH, N0_WOUT, N0_FN); if (((PROBE_DUP) >> 5) & 1u) { phase_attn(p, lds); } if (((PROBE_DUP) >> 6) & 1u) { phase_mlstm_c(p, lds); } }   SEAM(5);
    if (PHON(7) && IN(7)) { PARAMS(); phase_outproj(p, lds); tail_convert(p, lds, 1, (NTOK / 256) * 4); if (((PROBE_DUP) >> 7) & 1u) { phase_outproj(p, lds); } }             SEAM(7);
    if (PHON(8) && IN(8)) { PARAMS(); phase_norm<1>(p, lds); if (((PROBE_DUP) >> 8) & 1u) { phase_norm<1, true>(p, lds); } }             SEAM(8);
    if (PHON(9) && IN(9)) { PARAMS(); phase_moe_up(p, 0, lds); if (((PROBE_DUP) >> 9) & 1u) { phase_moe_up(p, 0, lds); } }           SEAM(9);
    if (PHON(10) && IN(10)) { PARAMS(); phase_moe_down(p, 0, lds); if (((PROBE_DUP) >> 10) & 1u) { phase_moe_down<true>(p, 0, lds); } }        SEAM(10);
    if (PHON(11) && IN(11)) { PARAMS(); phase_norm<2>(p, lds); if (((PROBE_DUP) >> 11) & 1u) { phase_norm<2>(p, lds); } } SEAM(11);
    if (PHON(12) && IN(12)) { PARAMS(); phase_fnet_gemm(p, lds); if (((PROBE_DUP) >> 12) & 1u) { phase_fnet_gemm(p, lds); } }          SEAM(12);
    if (PHON(13) && IN(13)) { PARAMS(); phase_fft1(p, lds); if (((PROBE_DUP) >> 13) & 1u) { phase_fft1(p, lds); } }               SEAM(13);
    if (PHON(14) && IN(14)) { PARAMS(); phase_fft2(p, lds); if (((PROBE_DUP) >> 14) & 1u) { phase_fft2<true>(p, lds); } }               SEAM(14);
    if (PHON(15) && IN(15)) { PARAMS(); phase_norm<3>(p, lds); if (((PROBE_DUP) >> 15) & 1u) { phase_norm<3, true>(p, lds); } }            SEAM(15);
    if (PHON(16) && IN(16)) { PARAMS(); phase_moe_up(p, 1, lds); if (((PROBE_DUP) >> 16) & 1u) { phase_moe_up(p, 1, lds); } }          SEAM(16);
    if (PHON(17) && IN(17)) { PARAMS(); phase_moe_down(p, 1, lds); if (((PROBE_DUP) >> 17) & 1u) { phase_moe_down<true>(p, 1, lds); } }        SEAM(17);
    if (PHON(18) && IN(18)) { PARAMS(); phase_norm<4>(p, lds); if (((PROBE_DUP) >> 18) & 1u) { phase_norm<4>(p, lds); } }
#undef IN
#undef SEAM
}

#ifndef ONE_LAUNCH
#define ONE_LAUNCH 1
#endif
extern "C" void kernel_launch(void* const* d_in, const int* in_sizes, int n_in, void* d_out, int out_size, void* d_ws, size_t ws_size, hipStream_t stream) {
    static int grid = 0;
    if (grid == 0) {
        if (n_in != 21 || out_size != NLAT * DM || ws_size < OFF_END) { fprintf(stderr, "kernel_launch: unexpected shapes (n_in %d out %d ws %zu need %zu)\n", n_in, out_size, ws_size, (size_t)OFF_END); grid = -1; return; }
        int dev = 0, cus = 0;
        if (hipGetDevice(&dev) != hipSuccess || hipDeviceGetAttribute(&cus, hipDeviceAttributeMultiprocessorCount, dev) != hipSuccess) { grid = -1; return; }
        if (hipFuncSetAttribute((const void*)fwd_kernel, hipFuncAttributeMaxDynamicSharedMemorySize, LDS_BYTES) != hipSuccess) { fprintf(stderr, "kernel_launch: hipFuncSetAttribute failed\n"); grid = -1; return; }
        int per_cu = 0;
        if (hipOccupancyMaxActiveBlocksPerMultiprocessor(&per_cu, (const void*)fwd_kernel, NTHR, LDS_BYTES) != hipSuccess || per_cu < 1) { fprintf(stderr, "kernel_launch: occupancy query says %d\n", per_cu); (void)hipGetLastError(); grid = -1; return; }
        grid = cus;
    }
    if (grid < 0) return;
    (void)hipMemsetAsync(d_ws, 0, ZERO_BYTES, stream);
    P p{};
    const float* const* in = (const float* const*)d_in;
    p.x = in[0]; p.c = in[1]; p.ctx = in[2]; p.c_ctx = in[3]; p.ada_w = in[4]; p.ada_b = in[5]; p.nmix_g = in[6]; p.nffn_g = in[7];
    p.w_in = in[8]; p.w_out = in[9]; p.conv_w = in[10]; p.gate_b = in[11]; p.lamv = in[12]; p.subln_g = in[13]; p.w_fnet = in[14];
    p.router_w = in[15]; p.router_b = in[16]; p.w_gate = in[17]; p.w_up = in[18]; p.w_down = in[19]; p.final_g = in[20];
    p.out = (float*)d_out; p.ws = (char*)d_ws;
#if ONE_LAUNCH
    p.ph_lo = 0; p.ph_hi = NPHASE;
    hipLaunchKernelGGL(fwd_kernel, dim3(grid), dim3(NTHR), LDS_BYTES, stream, p);
#else
    for (int k = 0; k < NPHASE; ++k) { p.ph_lo = k; p.ph_hi = k + 1; hipLaunchKernelGGL(fwd_kernel, dim3(grid), dim3(NTHR), LDS_BYTES, stream, p); }
#endif
}
```

```cpp
#include <hip/hip_runtime.h>
#include <stdint.h>
#include <stdio.h>

#define DEVI __device__ __forceinline__
#define PROBE_DUP (0u)
typedef unsigned short u16;
typedef unsigned int u32;
using bf16x8 = __attribute__((ext_vector_type(8))) short;
using s16x4  = __attribute__((ext_vector_type(4))) short;
using f32x16 = __attribute__((ext_vector_type(16))) float;
using f32x4  = __attribute__((ext_vector_type(4))) float;
using u32x4  = __attribute__((ext_vector_type(4))) unsigned;
using u32x2  = __attribute__((ext_vector_type(2))) unsigned;

constexpr int DM = 1024, NB = 2, TL = 16384, TC = 256, TT = TL + TC, NTOK = NB * TT, NLAT = NB * TL;
constexpr int NCH = TT / 128;
constexpr int NTHR = 512;
constexpr int LDS_BYTES = 147456;

constexpr size_t al256(size_t x) { return (x + 255) / 256 * 256; }
constexpr size_t OFF_BAR   = 0;
constexpr size_t OFF_CNT   = 16384;
constexpr size_t ZERO_BYTES = 20480;
constexpr size_t OFF_MOD   = ZERO_BYTES;
constexpr size_t OFF_ROPER = OFF_MOD + al256(2 * 3 * 6144 * 4);
constexpr size_t OFF_ROPEC = OFF_ROPER + 256 * 16 * 8;
constexpr size_t OFF_TW    = OFF_ROPEC + 64 * 16 * 8;
constexpr size_t OFF_DFTC  = OFF_TW + 16384 * 8;
constexpr size_t OFF_DFTS  = OFF_DFTC + 32768;
constexpr size_t OFF_LAM   = OFF_DFTS + 32768;
constexpr size_t OFF_WG16  = OFF_LAM + 256;
constexpr size_t OFF_MSCAL = OFF_WG16 + 65536;
constexpr size_t OFF_MST   = OFF_MSCAL + al256(16 * NCH * 8);
constexpr size_t OFF_WINT  = OFF_MST + al256(16 * NCH * 4);
constexpr size_t OFF_WOUTT = OFF_WINT + (size_t)3584 * 1024 * 2;
constexpr size_t OFF_FNT   = OFF_WOUTT + (size_t)1024 * 1024 * 2;
constexpr size_t OFF_WGU   = OFF_FNT + (size_t)2048 * 1024 * 2;
constexpr size_t OFF_WDT   = OFF_WGU + (size_t)16 * 1024 * 1024 * 2;
constexpr size_t OFF_ACT   = OFF_WDT + (size_t)16 * 1024 * 512 * 2;
constexpr size_t SZ_ACT    = (size_t)NTOK * 1024 * 2;
constexpr size_t OFF_XC    = OFF_ACT + SZ_ACT;
constexpr size_t OFF_GATES = OFF_XC + (size_t)NB * TC * 1024 * 4;
constexpr size_t OFF_TOKW  = OFF_GATES + (size_t)NTOK * 16 * 4;
constexpr size_t OFF_LIST  = OFF_TOKW + al256((size_t)NTOK * 8);
constexpr size_t OFF_NST   = OFF_LIST + (size_t)24 * NTOK * 4;
constexpr size_t OFF_CST   = OFF_NST + (size_t)16 * NCH * 128 * 4;
constexpr size_t SZ_CST    = (size_t)16 * NCH * 16384 * 2;
constexpr size_t OFF_BIG   = OFF_CST + SZ_CST;
constexpr size_t OFF_Q     = OFF_BIG;
constexpr size_t OFF_K     = OFF_Q + (size_t)NTOK * 512 * 2;
constexpr size_t OFF_V     = OFF_K + (size_t)NTOK * 512 * 2;
constexpr size_t OFF_MLQK  = OFF_V + (size_t)NTOK * 512 * 2;
constexpr size_t OFF_MLV   = OFF_MLQK + (size_t)NTOK * 1024 * 2;
constexpr size_t OFF_OG    = OFF_MLV + (size_t)NTOK * 512 * 2;
constexpr size_t OFF_MLC   = OFF_OG + (size_t)NTOK * 512 * 2;
constexpr size_t OFF_END   = OFF_MLC + (size_t)NTOK * 1024 * 2;
constexpr size_t OFF_HE    = OFF_BIG;
constexpr size_t OFF_ZR    = OFF_BIG;
constexpr size_t OFF_ZI    = OFF_ZR + (size_t)NLAT * 1024 * 2;
constexpr size_t OFF_WGU1  = OFF_MLV + (size_t)2 * 1024 * 1024;
constexpr size_t OFF_WDT1  = OFF_WGU1 + (size_t)16 * 1024 * 1024 * 2;
static_assert(OFF_WDT1 + (size_t)16 * 1024 * 512 * 2 <= OFF_MLC && OFF_WGU1 >= OFF_BIG + (size_t)NLAT * 2048 * 2, "layer-1 expert region");
constexpr size_t OFF_YR    = OFF_CST;
constexpr size_t OFF_YI    = OFF_ACT;
static_assert((size_t)NLAT * 1024 * 2 <= SZ_CST && (size_t)NLAT * 1024 * 2 <= SZ_ACT, "alias sizes");
static_assert(OFF_END < (size_t)508 * 1024 * 1024, "workspace");

struct P {
    const float *x, *c, *ctx, *c_ctx, *ada_w, *ada_b, *nmix_g, *nffn_g, *w_in, *w_out, *conv_w, *gate_b, *lamv, *subln_g,
                *w_fnet, *router_w, *router_b, *w_gate, *w_up, *w_down, *final_g;
    float* out;
    char* ws;
    int ph_lo, ph_hi;
};

#define XB_TMO      128
#define XB_XCNT(j)  (256  + 64 * (j))
#define XB_XSUB(j)  (1280 + 64 * (j))
#define XB_XGEN(j)  (2304 + 64 * (j))
#define XB_TOP      3328
#define XB_TOPGEN   3392
#define XCD_BAR_WORDS 3456
#define XB_SPIN_CAP (1u << 18)
#define LAS __attribute__((address_space(3)))

__device__ __forceinline__ unsigned xb_ld(unsigned* p)              { return __hip_atomic_load(p, __ATOMIC_RELAXED, __HIP_MEMORY_SCOPE_AGENT); }
__device__ __forceinline__ unsigned xb_add(unsigned* p, unsigned v) { return __hip_atomic_fetch_add(p, v, __ATOMIC_RELAXED, __HIP_MEMORY_SCOPE_AGENT); }
__device__ __forceinline__ unsigned xb_xcc_id() { return (unsigned)__builtin_amdgcn_s_getreg((3 << 11) | 20) & 0xFu; }
#define XB_SPIN(cond, bar) do { unsigned _sp = 0; while (cond) { __builtin_amdgcn_s_sleep(1); \
    if ((++_sp & 255u) == 0u) { if (xb_ld(&(bar)[XB_TMO])) break; if (_sp > XB_SPIN_CAP) { atomicAdd(&(bar)[XB_TMO], 1u); break; } } } } while (0)

struct XcdBarrier { unsigned* bar; unsigned x; volatile LAS unsigned* st; };

__device__ __forceinline__ XcdBarrier xcd_barrier_post(unsigned* bar, volatile LAS unsigned* st) {
    XcdBarrier b; b.bar = bar; b.x = xb_xcc_id(); b.st = st;
    if (threadIdx.x == 0) (void)xb_add(&bar[XB_XCNT(b.x)], 1u);
    return b;
}
__device__ __forceinline__ void xcd_barrier_complete(unsigned* bar, unsigned x, unsigned& nloc, unsigned& nx) {
    const unsigned G = gridDim.x * gridDim.y * gridDim.z;
    unsigned sum, cnt, mine, sp = 0u;
    for (;;) {
        sum = 0u; cnt = 0u; mine = 0u;
#pragma unroll
        for (unsigned j = 0; j < 16; ++j) { const unsigned c = xb_ld(&bar[XB_XCNT(j)]); sum += c; cnt += (c > 0u) ? 1u : 0u; mine = (j == x) ? c : mine; }
        if (sum == G) break;
        __builtin_amdgcn_s_sleep(1);
        if ((++sp & 255u) == 0u) { if (xb_ld(&bar[XB_TMO])) break; if (sp > XB_SPIN_CAP) { atomicAdd(&bar[XB_TMO], 1u); break; } }
    }
    nloc = mine > 0u ? mine : 1u; nx = cnt > 0u ? cnt : 1u;
}
__device__ __forceinline__ void xcd_barrier(const XcdBarrier& b) {
    asm volatile("s_waitcnt vmcnt(0)" ::: "memory");
    __syncthreads();
    if (threadIdx.x == 0) {
        unsigned* bar = b.bar;
        __builtin_amdgcn_s_waitcnt(0);
        unsigned nloc = b.st[0], nx = b.st[1];
        if (nloc == 0u) { xcd_barrier_complete(bar, b.x, nloc, nx); b.st[0] = nloc; b.st[1] = nx; }
        const unsigned old = xb_add(&bar[XB_XSUB(b.x)], 1u);
        const unsigned gen = old / nloc;
        if (old + 1u == (gen + 1u) * nloc) {
            __builtin_amdgcn_fence(__ATOMIC_RELEASE, "agent");
            asm volatile("s_waitcnt vmcnt(0)" ::: "memory");
            const unsigned og = xb_add(&bar[XB_TOP], 1u);
            const unsigned tg = og / nx;
            if (og + 1u == (tg + 1u) * nx) xb_add(&bar[XB_TOPGEN], 1u);
            else XB_SPIN(xb_ld(&bar[XB_TOPGEN]) == tg, bar);
            __builtin_amdgcn_fence(__ATOMIC_ACQUIRE, "agent");
            xb_add(&bar[XB_XGEN(b.x)], 1u);
            asm volatile("s_waitcnt vmcnt(0)" ::: "memory");
        } else {
            XB_SPIN(xb_ld(&bar[XB_XGEN(b.x)]) == gen, bar);
            __builtin_amdgcn_fence(__ATOMIC_ACQUIRE, "agent");
            asm volatile("s_waitcnt vmcnt(0)" ::: "memory");
        }
    }
    __syncthreads();
}

DEVI u16 f2bf(float f) { u32 u = __float_as_uint(f); u += 0x7fffu + ((u >> 16) & 1u); return (u16)(u >> 16); }
DEVI float bf2f(u32 h) { return __uint_as_float(h << 16); }
DEVI u32 cvtpk(float lo, float hi) { u32 r; asm("v_cvt_pk_bf16_f32 %0, %1, %2" : "=v"(r) : "v"(lo), "v"(hi)); return r; }
DEVI float bflo(u32 w) { return __uint_as_float(w << 16); }
DEVI float bfhi(u32 w) { return __uint_as_float(w & 0xffff0000u); }
DEVI int crow(int r, int hi) { return (r & 3) + 8 * (r >> 2) + 4 * hi; }
DEVI float wave_sum(float v) { for (int o = 32; o; o >>= 1) v += __shfl_xor(v, o); return v; }
DEVI float wave_max(float v) { for (int o = 32; o; o >>= 1) v = fmaxf(v, __shfl_xor(v, o)); return v; }
DEVI float sigmoidf_(float x) { return 1.f / (1.f + __expf(-x)); }
DEVI float siluf_(float x) { return x / (1.f + __expf(-x)); }
DEVI float logsigmoidf_(float x) { return fminf(x, 0.f) - log1pf(__expf(-fabsf(x))); }
#define SBAR() __builtin_amdgcn_sched_barrier(0)

DEVI void sincos2pi(double frac, double& s, double& c) {
    frac -= floor(frac);
    double q = rint(frac * 4.0);
    double r = (frac - q * 0.25) * 6.283185307179586476925;
    double r2 = r * r;
    double sr = r * (1.0 + r2 * (-1.0 / 6 + r2 * (1.0 / 120 + r2 * (-1.0 / 5040 + r2 * (1.0 / 362880 + r2 * (-1.0 / 39916800 + r2 * (1.0 / 6227020800.0 + r2 * (-1.0 / 1307674368000.0))))))));
    double cr = 1.0 + r2 * (-0.5 + r2 * (1.0 / 24 + r2 * (-1.0 / 720 + r2 * (1.0 / 40320 + r2 * (-1.0 / 3628800 + r2 * (1.0 / 479001600.0 + r2 * (-1.0 / 87178291200.0 + r2 * (1.0 / 20922789888000.0))))))));
    int qi = ((int)q) & 3;
    if (qi == 0) { s = sr; c = cr; } else if (qi == 1) { s = cr; c = -sr; } else if (qi == 2) { s = -sr; c = -cr; } else { s = -cr; c = sr; }
}

DEVI u16* xs_ptr(const P& p, int layer, int tok) {
    const int row = layer == 0 ? tok : (tok >> 14) * TT + TC + (tok & (TL - 1));
    return (u16*)(p.ws + OFF_MLC) + (size_t)row * DM;
}
DEVI f32x4 bf4_to_f32(u32x2 w) { f32x4 v; v[0] = bflo(w[0]); v[1] = bfhi(w[0]); v[2] = bflo(w[1]); v[3] = bfhi(w[1]); return v; }
DEVI const float* xin_ptr(const P& p, int tok) {
    int b = tok >= TT ? 1 : 0, t = tok - b * TT;
    if (t < TC) return p.ctx + (size_t)(b * TC + t) * DM;
    return p.x + (size_t)(b * TL + t - TC) * DM;
}
DEVI int modsel(int layer, int tok) {
    if (layer == 0) { int b = tok >= TT ? 1 : 0, t = tok - b * TT; return t < TC ? 2 : b; }
    return tok >> 14;
}

DEVI int swz128(int row, int chunk) { return row * 144 + (chunk << 4); }
DEVI int swz256(int row, int chunk) { return row * 272 + (chunk << 4); }
DEVI int v_st(int k, int c) { const int kk = (k & ~0xC) | ((k & 4) << 1) | ((k & 8) >> 1); return ((kk >> 3) * 4 + (c >> 5)) * 512 + ((kk & 7) * 32 + (c & 31)) * 2; }
DEVI int v_rd_base(int lane) { return ((lane & 3) << 3) | (((lane >> 2) & 3) << 6) | (((lane >> 4) & 1) << 5) | (((lane >> 5) & 1) << 8); }
constexpr int v_rd_off(int d0, int ks, int half) { return d0 * 512 + ks * 4096 + half * 2048; }
template <int OFF> DEVI s16x4 tr_read(int vb) {
    s16x4 r; asm volatile("ds_read_b64_tr_b16 %0, %1 offset:%2" : "=&v"(r) : "v"(vb), "i"(OFF) : "memory"); return r;
}
#define PKLH(L, H) (bf16x8){L[0], L[1], L[2], L[3], H[0], H[1], H[2], H[3]}
template <int D0, int KS> DEVI void tr_frag_issue(int vb, s16x4& l, s16x4& h) { l = tr_read<v_rd_off(D0, KS, 0)>(vb); h = tr_read<v_rd_off(D0, KS, 1)>(vb); }
#define LGKM0() do { asm volatile("s_waitcnt lgkmcnt(0)" ::: "memory"); SBAR(); } while (0)

DEVI bf16x8 lds_b128(const char* base, int off) { return *reinterpret_cast<const bf16x8*>(base + off); }

DEVI void pack_p(const f32x16& pp, bf16x8& f0, bf16x8& f1) {
#define PK4(BASE, OUT) do { unsigned a0 = cvtpk(pp[BASE + 0], pp[BASE + 1]), a1 = cvtpk(pp[BASE + 2], pp[BASE + 3]);   \
    unsigned b0 = cvtpk(pp[BASE + 4], pp[BASE + 5]), b1 = cvtpk(pp[BASE + 6], pp[BASE + 7]);                            \
    auto r0 = __builtin_amdgcn_permlane32_swap(a0, b0, false, false); auto r1 = __builtin_amdgcn_permlane32_swap(a1, b1, false, false); \
    u32x4 w = {r0[0], r1[0], r0[1], r1[1]}; OUT = *reinterpret_cast<bf16x8*>(&w); } while (0)
    PK4(0, f0); PK4(8, f1);
#undef PK4
}

namespace g8 {
constexpr int BM = 256, BK = 64, HALF = 128, HTB = HALF * BK * 2, STAGE_BYTES = 8 * HTB, NXCD = 8, WGM = 8;
DEVI int lds_byte(int r, int c) { const int st = (r >> 4) * 2 + (c >> 5), rr = r & 15, cc = c & 31, ob = rr * 64 + cc * 2; return st * 1024 + (ob ^ (((ob >> 9) & 1) << 5)); }
DEVI void stage_rc(int b, int& R, int& C) { const int st = b / 1024, sb = b % 1024, swz = sb ^ (((sb >> 9) & 1) << 5); R = (st >> 1) * 16 + swz / 64; C = (st & 1) * 32 + (swz % 64) / 2; }
DEVI int perm32(int rho) { const int n = rho >> 4, i = rho & 15; return 8 * (i >> 2) + 4 * n + (i & 3); }
struct Unit { int pm, pn; const char* B0; const char* B1; int cls, r0, ncls; };
DEVI bool tile_order(int i, int G, int c, int nM, int nN, int& pm, int& pn) {
    const int nwg = nM * nN; const long L = (long)i * G + c; if (L >= nwg) return false;
    int wgid = (int)L; { const int q = nwg / NXCD, r = nwg % NXCD, xcd = wgid % NXCD, off = wgid / NXCD; wgid = (xcd < r ? xcd * (q + 1) : r * (q + 1) + (xcd - r) * q) + off; }
    const int nig = WGM * nN, gid = wgid / nig, fm = gid * WGM, gsz = (nM - fm) < WGM ? (nM - fm) : WGM;
    pm = fm + ((wgid % nig) % gsz); pn = (wgid % nig) / gsz; return true;
}
typedef float f32x4v __attribute__((ext_vector_type(4)));
template <class Epi, class Sched>
DEVI void gemm_phase(LAS unsigned char* lds, const char* Abase, int ldbB  , int ksplit  , const Sched& S, const Epi& E) {
    const int tid = threadIdx.x, wid = __builtin_amdgcn_readfirstlane(tid >> 6), lane = tid & 63, wr = wid >> 2, wc = wid & 3, fr = lane & 15, fq = lane >> 4;
    constexpr int nt = 1024 / BK;
    unsigned voffB[2];
#pragma unroll
    for (int i = 0; i < 2; ++i) { int R, C; stage_rc(tid * 16 + i * 8192, R, C); const int Rb = Epi::PERM ? ((R & ~31) + perm32(R & 31)) : R; voffB[i] = (unsigned)(Rb * ldbB + C * 2); }
    const size_t kstep = (size_t)(BK * 2);
    const size_t hstepB = (size_t)HALF * ldbB;
    const unsigned ldsw = (unsigned)wid * 1024u;
    const int aoff = lds_byte(wr * 64 + fr, fq * 8), boff = lds_byte(wc * 32 + fr, fq * 8);
#define G8_SA(b, h) (((b) * 2 + (h)) * HTB)
#define G8_SB(b, h) ((4 + (b) * 2 + (h)) * HTB)
#define G8_STAGE(bufoff, gbase, voff) do { _Pragma("unroll") for (int _i = 0; _i < 2; ++_i) \
        __builtin_amdgcn_global_load_lds((const unsigned*)((const char*)(gbase) + (voff)[_i]), (LAS unsigned*)(lds + (bufoff) + ldsw + _i * 8192), 16, 0, 0); } while (0)
#define G8_LDA(dst, b, h) do { _Pragma("unroll") for (int m = 0; m < 4; ++m) _Pragma("unroll") for (int k = 0; k < 2; ++k) dst[m][k] = *(const LAS bf16x8*)(lds + G8_SA(b, h) + aoff + m * 2048 + k * 1024); } while (0)
#define G8_LDB(dst, b, h) do { _Pragma("unroll") for (int n = 0; n < 2; ++n) _Pragma("unroll") for (int k = 0; k < 2; ++k) dst[n][k] = *(const LAS bf16x8*)(lds + G8_SB(b, h) + boff + n * 2048 + k * 1024); } while (0)
#define G8_MMA(ai, bj, At, Bt) do { __builtin_amdgcn_s_setprio(1); _Pragma("unroll") for (int m = 0; m < 4; ++m) _Pragma("unroll") for (int n = 0; n < 2; ++n) _Pragma("unroll") for (int k = 0; k < 2; ++k) \
        acc[ai][bj][m][n] = __builtin_amdgcn_mfma_f32_16x16x32_bf16(Bt[n][k], At[m][k], acc[ai][bj][m][n], 0, 0, 0); __builtin_amdgcn_s_setprio(0); } while (0)
#define G8_WAIT_V(n) asm volatile("s_waitcnt vmcnt(" #n ")" ::: "memory")
#define G8_WAIT_L(n) asm volatile("s_waitcnt lgkmcnt(" #n ")" ::: "memory")
#define G8_BAR __builtin_amdgcn_s_barrier()
#define G8_SCHED __builtin_amdgcn_sched_barrier(0)
#define G8_BPTR(u, kt) (((kt) < ksplit ? (u).B0 : (u).B1) + (size_t)(kt) * kstep)
    Unit cur, nxt; int ui = 0;
    if (!S.next(0, cur)) return;
    f32x4v acc[2][2][4][2];
#pragma unroll
    for (int a = 0; a < 2; ++a)
#pragma unroll
        for (int b = 0; b < 2; ++b)
#pragma unroll
            for (int m = 0; m < 4; ++m)
#pragma unroll
                for (int n = 0; n < 2; ++n) acc[a][b][m][n] = (f32x4v){0.f, 0.f, 0.f, 0.f};
    bf16x8 At[4][2], B0[2][2], B1[2][2];
    unsigned voffA[2]; unsigned vs[2][2];
    constexpr size_t hstepA = (size_t)HALF * 2048, tstepA = 2 * hstepA;
    if constexpr (Sched::GATHER) S.aoffs(cur, vs);
    else {
#pragma unroll
        for (int i = 0; i < 2; ++i) { int R, C; stage_rc(tid * 16 + i * 8192, R, C); voffA[i] = (unsigned)(R * 2048 + C * 2); }
    }
    const char* cA = Sched::GATHER ? Abase : Abase + (size_t)cur.pm * tstepA;
#define G8_STAGE_A(bufoff, ptr, h) do { if constexpr (Sched::GATHER) G8_STAGE(bufoff, ptr, vs[h]); else G8_STAGE(bufoff, (ptr) + (h) * hstepA, voffA); } while (0)
    { const char* cB = G8_BPTR(cur, 0); const char* cB1 = G8_BPTR(cur, 1);
      G8_STAGE(G8_SB(0, 0), cB, voffB); G8_STAGE_A(G8_SA(0, 0), cA, 0); G8_STAGE(G8_SB(0, 1), cB + hstepB, voffB); G8_STAGE_A(G8_SA(0, 1), cA, 1);
      if (wr == 1) G8_BAR;
      G8_WAIT_V(4); G8_BAR;
      G8_STAGE(G8_SB(1, 0), cB1, voffB); G8_STAGE_A(G8_SA(1, 0), cA + kstep, 0); G8_STAGE(G8_SB(1, 1), cB1 + hstepB, voffB);
      G8_WAIT_V(6); G8_BAR; }
    for (;;) {
        bool has_next = false; const char* nA = cA;
        for (int t = 0; t < nt; t += 2) {
            const bool last = (t == nt - 2);
            const char* a1 = cA + (size_t)(t + 1) * kstep;
            G8_LDB(B0, 0, 0); G8_SCHED; G8_LDA(At, 0, 0); G8_STAGE_A(G8_SA(1, 1), a1, 1);
            G8_WAIT_L(8); G8_BAR; G8_WAIT_L(0); G8_MMA(0, 0, At, B0); G8_BAR; G8_SCHED;
            if (last) {
                has_next = S.next(ui + 1, nxt);
                if (has_next) { if constexpr (Sched::GATHER) S.aoffs(nxt, vs); else nA = Abase + (size_t)nxt.pm * tstepA; } else nxt = cur;
            }
            const char* a2 = last ? nA : cA + (size_t)(t + 2) * kstep; const char* a3 = a2 + kstep;
            const char* b2 = last ? G8_BPTR(nxt, 0) : G8_BPTR(cur, t + 2); const char* b3 = last ? G8_BPTR(nxt, 1) : G8_BPTR(cur, t + 3);
            G8_LDB(B1, 0, 1); G8_STAGE(G8_SB(0, 0), b2, voffB);
            G8_BAR; G8_WAIT_L(0); G8_MMA(0, 1, At, B1); G8_BAR;
            G8_LDA(At, 0, 1); G8_STAGE_A(G8_SA(0, 0), a2, 0);
            G8_BAR; G8_WAIT_L(0); G8_MMA(1, 0, At, B0); G8_BAR; G8_SCHED;
            G8_STAGE(G8_SB(0, 1), b2 + hstepB, voffB);
            G8_WAIT_V(6); G8_BAR; G8_MMA(1, 1, At, B1); G8_BAR;
            G8_LDB(B0, 1, 0); G8_SCHED; G8_LDA(At, 1, 0); G8_STAGE_A(G8_SA(0, 1), a2, 1);
            G8_WAIT_L(8); G8_BAR; G8_WAIT_L(0); G8_MMA(0, 0, At, B0); G8_BAR; G8_SCHED;
            G8_LDB(B1, 1, 1); G8_STAGE(G8_SB(1, 0), b3, voffB);
            G8_BAR; G8_WAIT_L(0); G8_MMA(0, 1, At, B1); G8_BAR;
            G8_LDA(At, 1, 1); G8_STAGE_A(G8_SA(1, 0), a3, 0);
            G8_BAR; G8_WAIT_L(0); G8_MMA(1, 0, At, B0); G8_BAR; G8_SCHED;
            G8_STAGE(G8_SB(1, 1), b3 + hstepB, voffB);
            G8_WAIT_V(6); G8_BAR; G8_MMA(1, 1, At, B1); G8_BAR;
        }
        cA = nA;
        { int tz = threadIdx.x; asm volatile("" : "+v"(tz));
          const int w2 = tz >> 6, l2 = tz & 63; E(acc, cur, w2 >> 2, w2 & 3, l2 & 15, l2 >> 4); }
        if (!has_next) break;
#pragma unroll
        for (int a = 0; a < 2; ++a)
#pragma unroll
            for (int b = 0; b < 2; ++b)
#pragma unroll
                for (int m = 0; m < 4; ++m)
#pragma unroll
                    for (int n = 0; n < 2; ++n) acc[a][b][m][n] = (f32x4v){0.f, 0.f, 0.f, 0.f};
        cur = nxt; ++ui;
    }
    G8_WAIT_V(0);
    if (wr == 0) G8_BAR;
    G8_BAR;
#undef G8_SA
#undef G8_SB
#undef G8_STAGE
#undef G8_STAGE_A
#undef G8_LDA
#undef G8_LDB
#undef G8_MMA
#undef G8_WAIT_V
#undef G8_WAIT_L
#undef G8_BAR
#undef G8_SCHED
#undef G8_BPTR
}
DEVI void lane_rc(int i, int& R, int& C) { int tz = threadIdx.x; asm volatile("" : "+v"(tz)); stage_rc(tz * 16 + i * 8192, R, C); }
struct DenseSched {
    static constexpr bool GATHER = false;
    const char* Bt; int nM, nN, G, c; size_t btile;
    DEVI bool next(int i, Unit& u) const { if (!tile_order(i, G, c, nM, nN, u.pm, u.pn)) return false; u.B0 = u.B1 = Bt + (size_t)u.pn * btile; u.cls = 0; u.r0 = 0; u.ncls = 0; return true; }
    DEVI void aoffs(const Unit& u, unsigned (&v)[2][2]) const {
#pragma unroll
        for (int i = 0; i < 2; ++i) { int R, C; lane_rc(i, R, C);
#pragma unroll
            for (int h = 0; h < 2; ++h) v[h][i] = (unsigned)(((u.pm * 256 + h * 128 + R) * 1024 + C) * 2); }
    }
};
}

template <class PF>
DEVI void transpose_tile(PF colptr, int ldsrc, u16* dst, int lddst, int k0, int n0, float* tl) {
    const int t = threadIdx.x, nn = t & 63, kk = t >> 6;
    const float* sp = colptr(n0 + nn);
#pragma unroll
    for (int i = 0; i < 8; ++i) tl[(kk + 8 * i) * 65 + nn] = sp[(size_t)(k0 + kk + 8 * i) * ldsrc];
    __syncthreads();
    const int n = t >> 3, kc = t & 7;
    u32x4 w;
    w[0] = cvtpk(tl[(kc * 8 + 0) * 65 + n], tl[(kc * 8 + 1) * 65 + n]);
    w[1] = cvtpk(tl[(kc * 8 + 2) * 65 + n], tl[(kc * 8 + 3) * 65 + n]);
    w[2] = cvtpk(tl[(kc * 8 + 4) * 65 + n], tl[(kc * 8 + 5) * 65 + n]);
    w[3] = cvtpk(tl[(kc * 8 + 6) * 65 + n], tl[(kc * 8 + 7) * 65 + n]);
    *reinterpret_cast<u32x4*>(dst + (size_t)(n0 + n) * lddst + k0 + kc * 8) = w;
    __syncthreads();
}

DEVI void convert_expert_item(const P& p, int layer, int it, float* tl) {
    const int e = it / 384, r = it % 384;
    const float* wg = p.w_gate + ((size_t)layer * 16 + e) * 1024 * 512;
    const float* wu = p.w_up   + ((size_t)layer * 16 + e) * 1024 * 512;
    const float* wd = p.w_down + ((size_t)layer * 16 + e) * 512 * 1024;
    if (r < 256) {
        u16* dst = (u16*)(p.ws + (layer ? OFF_WGU1 : OFF_WGU)) + (size_t)e * 1024 * 1024;
        const int kt = r >> 4, nt = r & 15;
        transpose_tile([&](int n) { const int q = n >> 3, sgu = (n >> 2) & 1, j = n & 3; return (sgu ? wu : wg) + q * 4 + j; }, 512, dst, 1024, kt * 64, nt * 64, tl);
    } else {
        const int q = r - 256; u16* dst = (u16*)(p.ws + (layer ? OFF_WDT1 : OFF_WDT)) + (size_t)e * 1024 * 512;
        const int kt = q >> 4, nt = q & 15;
        transpose_tile([&](int n) { return wd + n; }, 1024, dst, 512, kt * 64, nt * 64, tl);
    }
}

constexpr int N0_WIN = 16 * 56, N0_WOUT = 256, N0_EXP = 16 * 384, N0_FN = 1024, N0_MOD = 192, N0_TAB = 128;
constexpr int N0_TOTAL = N0_WIN + N0_MOD + N0_TAB;
constexpr int NBG = N0_WOUT + N0_FN;
DEVI void bg_item(const P& p, int it, float* tl) {
    const int tid = threadIdx.x;
    int r = it;
    if (r < N0_WOUT) {
        const int kt = r >> 4, nt = r & 15; const float* w = p.w_out;
        transpose_tile([&](int n) { return w + n; }, 1024, (u16*)(p.ws + OFF_WOUTT), 1024, kt * 64, nt * 64, tl);
        return;
    }
    r -= N0_WOUT;
    {
        const int idx = r * 512 + tid, c = idx & 127, g = (idx >> 7) & 3, n = idx >> 9;
        double sd, cd; sincos2pi(c / 256.0, sd, cd);
        const float ct = (float)cd, st = (float)sd;
        const float* W = p.w_fnet + (size_t)(g * 256) * 1024 + n;
        float ac = 0.f, as = 0.f, a128 = 0.f, cr = 1.f, sr = 0.f, sg = 1.f;
        for (int c2 = 0; c2 < 256; ++c2) {
            const float w = W[(size_t)c2 * 1024];
            ac = fmaf(cr, w, ac); as = fmaf(sr, w, as); a128 = fmaf(sg, w, a128); sg = -sg;
            const float cn = cr * ct - sr * st; sr = fmaf(sr, ct, cr * st); cr = cn;
        }
        u16* F = (u16*)(p.ws + OFF_FNT);
        const size_t o0 = (size_t)n * 1024 + g * 256, o1 = (size_t)(1024 + n) * 1024 + g * 256;
        F[o0 + c] = f2bf(ac * (1.f / 2048.f)); F[o1 + c] = f2bf(-as * (1.f / 2048.f));
        if (c > 0) { F[o0 + 256 - c] = f2bf(ac * (1.f / 2048.f)); F[o1 + 256 - c] = f2bf(as * (1.f / 2048.f)); }
        else { F[o0 + 128] = f2bf(a128 * (1.f / 2048.f)); F[o1 + 128] = f2bf(0.f); }
    }
}
DEVI void bg_fill(const P& p, char* lds, int q, int lo, int hi) {
    int* sh = (int*)(lds + 32768);
    for (;;) {
        __syncthreads();
        if (threadIdx.x == 0) *sh = lo + 4 * (int)atomicAdd((unsigned*)(p.ws + OFF_CNT) + 160 + q, 1u);
        __syncthreads();
        const int it0 = *sh;
        if (it0 >= hi) break;
        for (int it = it0; it < it0 + 4 && it < hi; ++it) bg_item(p, it, (float*)lds);
    }
    __syncthreads();
}

DEVI void phase_prologue(const P& p, char* lds) {
    float* tl = (float*)lds;
    const int tid = threadIdx.x;
    for (int it = blockIdx.x; it < N0_TOTAL; it += gridDim.x) {
        int r = it;
        if (r < N0_WIN) {
            const int kt = r / 56, nt = r % 56;
            const float* w = p.w_in;
            transpose_tile([&](int n) { return w + n; },
                           3600, (u16*)(p.ws + OFF_WINT), 1024, kt * 64, nt * 64, tl);
            continue;
        }
        r -= N0_WIN;
        if (r < N0_MOD) {
            float* sv = tl;
            float* part = tl + 3072;
            for (int i = tid; i < 3072; i += NTHR) { const int v = i >> 10, k = i & 1023; const float xv = v < 2 ? p.c[v * 1024 + k] : p.c_ctx[k]; sv[i] = siluf_(xv); }
            __syncthreads();
            const int j0 = r * 64, L = j0 / 6144, col0 = j0 % 6144, kg = tid >> 6, cl = tid & 63;
            const float* W = p.ada_w + (size_t)L * 1024 * 6144 + col0 + cl;
            float a0 = 0.f, a1 = 0.f, a2 = 0.f;
            for (int k = kg * 128; k < kg * 128 + 128; ++k) { const float w = W[(size_t)k * 6144]; a0 = fmaf(sv[k], w, a0); a1 = fmaf(sv[1024 + k], w, a1); a2 = fmaf(sv[2048 + k], w, a2); }
            part[(kg * 3 + 0) * 64 + cl] = a0; part[(kg * 3 + 1) * 64 + cl] = a1; part[(kg * 3 + 2) * 64 + cl] = a2;
            __syncthreads();
            if (tid < 192) {
                const int v = tid >> 6, c2 = tid & 63; float s = 0.f;
                for (int g = 0; g < 8; ++g) s += part[(g * 3 + v) * 64 + c2];
                ((float*)(p.ws + OFF_MOD))[(size_t)(L * 3 + v) * 6144 + col0 + c2] = s + p.ada_b[L * 6144 + col0 + c2];
            }
            __syncthreads();
            continue;
        }
        r -= N0_MOD;
        {
            const int e = r * 512 + tid;
            if (e < 4096 + 1024) {
                const bool isr = e < 4096; const int ee = isr ? e : e - 4096; const int pos = ee >> 4, j = ee & 15;
                double inv = 1.0; for (int q = 0; q < j; ++q) inv *= 0.56234132519034908;
                const float invf = (float)inv; const float ang = (float)pos * invf;
                double s, c; sincos2pi((double)ang * 0.15915494309189533577, s, c);
                float2 v = make_float2((float)c, (float)s);
                if (isr) ((float2*)(p.ws + OFF_ROPER))[ee] = v; else ((float2*)(p.ws + OFF_ROPEC))[ee] = v;
            } else if (e < 5120 + 16384) {
                const int m = e - 5120; double s, c; sincos2pi(m / 16384.0, s, c);
                ((float2*)(p.ws + OFF_TW))[m] = make_float2((float)c, (float)s);
            } else if (e < 5120 + 32768) {
                const int m = e - 5120 - 16384, k = m >> 7, t = m & 127; double s, c; sincos2pi(((k * t) & 127) / 128.0, s, c);
                ((u16*)(p.ws + OFF_DFTC))[m] = f2bf((float)c); ((u16*)(p.ws + OFF_DFTS))[m] = f2bf((float)s);
            } else if (e < 5120 + 49152) {
                const int m = e - 5120 - 32768, k = m >> 4, g = m & 15;
                ((float*)(p.ws + OFF_WG16))[m] = p.w_in[(size_t)k * 3600 + 3584 + g];
            } else if (e == 5120 + 49152) {
                float s01 = 0.f, s23 = 0.f;
                for (int i = 0; i < 64; ++i) { s01 += p.lamv[i] * p.lamv[64 + i]; s23 += p.lamv[128 + i] * p.lamv[192 + i]; }
                ((float*)(p.ws + OFF_LAM))[0] = expf(s01) - expf(s23) + 0.2f;
            }
        }
    }
}

template <int MODE, bool DRY = false>
DEVI void phase_norm(const P& p, char* lds) {
    constexpr int layer = (MODE == 0 || MODE == 1) ? 0 : 1;
    constexpr bool side = (MODE == 0 || MODE == 1 || MODE == 3);
    const int nrows = layer == 0 ? NTOK : NLAT;
    const int tid = threadIdx.x, lane = tid & 63, wid = tid >> 6;
    f32x4* sl = (f32x4*)lds;
    if (side) {
        const float* S = (MODE == 0) ? (const float*)(p.ws + OFF_WG16) : p.router_w;
        for (int i = tid; i < 4096; i += NTHR) { const int eg = i >> 10, col = i & 1023; const int pc = (col >> 8) * 256 + (col & 3) * 64 + ((col >> 2) & 63);
            sl[eg * 1024 + pc] = *reinterpret_cast<const f32x4*>(S + col * 16 + eg * 4); }
        __syncthreads();
    }
    const float* g = MODE == 0 ? p.nmix_g : MODE == 1 ? p.nffn_g : MODE == 2 ? p.nmix_g + 1024 : MODE == 3 ? p.nffn_g + 1024 : p.final_g;
    const float* modb = (const float*)(p.ws + OFF_MOD) + (size_t)layer * 3 * 6144;
    constexpr int sh_i = (MODE == 0 || MODE == 2) ? 0 : 3;
    u16* act = (u16*)(p.ws + OFF_ACT);
    int npend = 0, pcls = 0, prow = 0; float pwl = 0.f, pwh = 0.f; float keep[16];
#pragma unroll
    for (int e = 0; e < 16; ++e) keep[e] = 0.f;
    const int c0 = 4 * lane;
    f32x4 xn[4];
    { const int row0 = blockIdx.x * 8 + wid;
      if (row0 < nrows) {
          if (MODE == 0) { const float* src = xin_ptr(p, row0);
#pragma unroll
              for (int i = 0; i < 4; ++i) xn[i] = *reinterpret_cast<const f32x4*>(src + c0 + 256 * i); }
          else { const u16* src = xs_ptr(p, layer, row0);
#pragma unroll
              for (int i = 0; i < 4; ++i) xn[i] = bf4_to_f32(*reinterpret_cast<const u32x2*>(src + c0 + 256 * i)); } } }
    for (int row = blockIdx.x * 8 + wid; row < nrows; row += gridDim.x * 8) {
        f32x4 xv[4]; float ss = 0.f;
#pragma unroll
        for (int i = 0; i < 4; ++i) xv[i] = xn[i];
        { const int nrow = row + gridDim.x * 8;
          if (nrow < nrows) {
              if (MODE == 0) { const float* src = xin_ptr(p, nrow);
#pragma unroll
                  for (int i = 0; i < 4; ++i) xn[i] = *reinterpret_cast<const f32x4*>(src + c0 + 256 * i); }
              else { const u16* src = xs_ptr(p, layer, nrow);
#pragma unroll
                  for (int i = 0; i < 4; ++i) xn[i] = bf4_to_f32(*reinterpret_cast<const u32x2*>(src + c0 + 256 * i)); } } }
#pragma unroll
        for (int i = 0; i < 4; ++i) { ss = fmaf(xv[i][0], xv[i][0], ss); ss = fmaf(xv[i][1], xv[i][1], ss); ss = fmaf(xv[i][2], xv[i][2], ss); ss = fmaf(xv[i][3], xv[i][3], ss); }
        ss = wave_sum(ss);
        const float rstd = rsqrtf(ss * (1.f / 1024.f) + 1e-6f);
        if (MODE == 4) {
            float* dst = p.out + (size_t)row * DM;
#pragma unroll
            for (int i = 0; i < 4; ++i) { const f32x4 gv = *reinterpret_cast<const f32x4*>(g + c0 + 256 * i); *reinterpret_cast<f32x4*>(dst + c0 + 256 * i) = xv[i] * rstd * gv; }
            continue;
        }
        const float* mv = modb + (size_t)modsel(layer, row) * 6144;
        float acc[16];
#pragma unroll
        for (int e = 0; e < 16; ++e) acc[e] = 0.f;
#pragma unroll
        for (int i = 0; i < 4; ++i) {
            const f32x4 gv = *reinterpret_cast<const f32x4*>(g + c0 + 256 * i), scv = *reinterpret_cast<const f32x4*>(mv + (sh_i + 1) * 1024 + c0 + 256 * i),
                        shv = *reinterpret_cast<const f32x4*>(mv + sh_i * 1024 + c0 + 256 * i);
            f32x4 h;
#pragma unroll
            for (int j = 0; j < 4; ++j) h[j] = xv[i][j] * rstd * gv[j] * (1.f + scv[j]) + shv[j];
            u32x2 w2; w2[0] = cvtpk(h[0], h[1]); w2[1] = cvtpk(h[2], h[3]);
            *reinterpret_cast<u32x2*>(act + (size_t)row * DM + c0 + 256 * i) = w2;
            if (side) {
#pragma unroll
                for (int j = 0; j < 4; ++j) {
#pragma unroll
                    for (int eg = 0; eg < 4; ++eg) { const f32x4 w = sl[eg * 1024 + i * 256 + j * 64 + lane]; acc[eg * 4 + 0] = fmaf(h[j], w[0], acc[eg * 4 + 0]); acc[eg * 4 + 1] = fmaf(h[j], w[1], acc[eg * 4 + 1]);
                        acc[eg * 4 + 2] = fmaf(h[j], w[2], acc[eg * 4 + 2]); acc[eg * 4 + 3] = fmaf(h[j], w[3], acc[eg * 4 + 3]); }
                    if (j & 1) asm volatile("" ::: "memory");
                }
            }
        }
        if (side) {
            float r8[8], r4[4], r2[2], tot;
            { const bool up = lane & 32;
#pragma unroll
              for (int i = 0; i < 8; ++i) { const float snd = up ? acc[i] : acc[i + 8], kp = up ? acc[i + 8] : acc[i]; r8[i] = kp + __shfl_xor(snd, 32); } }
            { const bool up = lane & 16;
#pragma unroll
              for (int i = 0; i < 4; ++i) { const float snd = up ? r8[i] : r8[i + 4], kp = up ? r8[i + 4] : r8[i]; r4[i] = kp + __shfl_xor(snd, 16); } }
            { const bool up = lane & 8;
#pragma unroll
              for (int i = 0; i < 2; ++i) { const float snd = up ? r4[i] : r4[i + 2], kp = up ? r4[i + 2] : r4[i]; r2[i] = kp + __shfl_xor(snd, 8); } }
            { const bool up = lane & 4; const float snd = up ? r2[0] : r2[1], kp = up ? r2[1] : r2[0]; tot = kp + __shfl_xor(snd, 4); }
            tot += __shfl_xor(tot, 1); tot += __shfl_xor(tot, 2);
            if (MODE == 0) {
                if ((lane & 3) == 0) {
                    const int e = lane >> 2;
                    float v = tot + p.gate_b[e];
                    const int type = e >> 2;
                    if (type == 1 || type == 3) v = logsigmoidf_(v);
                    ((float*)(p.ws + OFF_GATES))[(size_t)row * 16 + e] = v;
                }
            } else {
#pragma unroll
                for (int e = 0; e < 16; ++e) { const float te = __uint_as_float(__builtin_amdgcn_readlane(__float_as_uint(tot), e << 2)); keep[e] = (lane == npend) ? te : keep[e]; }
                if (lane == npend) prow = row;
                ++npend;
            }
        }
    }
    if (MODE == 1 || MODE == 3) {
        {
            float aff[16], bi[16];
#pragma unroll
            for (int e = 0; e < 16; ++e) { aff[e] = sigmoidf_(keep[e]); bi[e] = aff[e] + p.router_b[e]; }
            int bg = 0, ba = 0, bb = 1; float bscore = -1e30f;
#pragma unroll
            for (int gq = 0; gq < 4; ++gq) {
                int ia = 0; float va = bi[gq * 4];
#pragma unroll
                for (int j = 1; j < 4; ++j) if (bi[gq * 4 + j] > va) { va = bi[gq * 4 + j]; ia = j; }
                int ib = -1; float vb = -1e30f;
#pragma unroll
                for (int j = 0; j < 4; ++j) if (j != ia && bi[gq * 4 + j] > vb) { vb = bi[gq * 4 + j]; ib = j; }
                const float sc = va + vb;
                if (sc > bscore) { bscore = sc; bg = gq; ba = ia; bb = ib; }
            }
            const int lo = ba < bb ? ba : bb, hi2 = ba < bb ? bb : ba;
            float alo = 0.f, ahi = 0.f;
#pragma unroll
            for (int e = 0; e < 16; ++e) { if (e == bg * 4 + lo) alo = aff[e]; if (e == bg * 4 + hi2) ahi = aff[e]; }
            const float inv = 1.f / (alo + ahi);
            const int pair = lo == 0 ? hi2 - 1 : (lo == 1 ? hi2 + 1 : 5);
            pcls = bg * 6 + pair; pwl = alo * inv; pwh = ahi * inv;
        }
        unsigned* lc = (unsigned*)(lds + 65536);
        __syncthreads();
        if (tid < 64) lc[tid] = 0u;
        __syncthreads();
        unsigned myrank = 0u;
        if (lane < npend) myrank = atomicAdd(&lc[pcls], 1u);
        __syncthreads();
        if (tid < 24) { unsigned* cnt = (unsigned*)(p.ws + OFF_CNT) + (DRY ? 2 : layer) * 32; const unsigned n = lc[tid]; lc[32 + tid] = n ? atomicAdd(&cnt[tid], n) : 0u; }
        __syncthreads();
        if (lane < npend) {
            ((int*)(p.ws + (DRY ? OFF_BIG : OFF_LIST)))[(size_t)pcls * NTOK + lc[32 + pcls] + myrank] = prow;
            ((float2*)(p.ws + (DRY ? OFF_BIG + (size_t)32 * NTOK * 4 : OFF_TOKW)))[prow] = make_float2(pwl, pwh);
        }
    }
}

using g8::f32x4v;
DEVI u32x4 pack8(const f32x4v& a, const f32x4v& b) { u32x4 w; w[0] = cvtpk(a[0], a[1]); w[1] = cvtpk(a[2], a[3]); w[2] = cvtpk(b[0], b[1]); w[3] = cvtpk(b[2], b[3]); return w; }

struct EpiInproj {
    static constexpr bool PERM = true;
    char* ws;
    DEVI void operator()(const f32x4v (&acc)[2][2][4][2], const g8::Unit& u, int wr, int wc, int fr, int fq) const {
        u16* dst; int ld, coff, kind;
        const int pn = u.pn;
        if (pn < 2)       { dst = (u16*)(ws + OFF_Q);    ld = 512;  coff = pn * 256;        kind = 1; }
        else if (pn < 4)  { dst = (u16*)(ws + OFF_K);    ld = 512;  coff = (pn - 2) * 256;  kind = 1; }
        else if (pn < 6)  { dst = (u16*)(ws + OFF_V);    ld = 512;  coff = (pn - 4) * 256;  kind = 0; }
        else if (pn < 10) { dst = (u16*)(ws + OFF_MLQK); ld = 1024; coff = (pn - 6) * 256;  kind = 0; }
        else if (pn < 12) { dst = (u16*)(ws + OFF_MLV);  ld = 512;  coff = (pn - 10) * 256; kind = 0; }
        else              { dst = (u16*)(ws + OFF_OG);   ld = 512;  coff = (pn - 12) * 256; kind = 2; }
        const int tb = u.pm % 65;
        const float2* tabR = (const float2*)(ws + OFF_ROPER); const float2* tabC = (const float2*)(ws + OFF_ROPEC);
#pragma unroll
        for (int ai = 0; ai < 2; ++ai)
#pragma unroll
            for (int m = 0; m < 4; ++m) {
                const int rl = ai * 128 + wr * 64 + m * 16 + fr;
                u16* rowp = dst + (size_t)(u.pm * 256 + rl) * ld + coff + wc * 32 + 8 * fq;
#pragma unroll
                for (int bj = 0; bj < 2; ++bj) {
                    f32x4v v0 = acc[ai][bj][m][0], v1 = acc[ai][bj][m][1];
                    if (kind == 1 && tb > 0) {
                        const int tl = (tb - 1) * 256 + rl;
                        const int p0 = ((wc * 32 + 8 * fq) & 63) >> 1;
                        const float* cs = (const float*)(p0 < 16 ? tabR + (tl >> 6) * 16 + p0 : tabC + (tl & 63) * 16 + (p0 - 16));
                        const f32x4v c01 = *reinterpret_cast<const f32x4v*>(cs), c23 = *reinterpret_cast<const f32x4v*>(cs + 4);
                        const f32x4v a = v0, b = v1;
                        v0[0] = a[0] * c01[0] - a[1] * c01[1]; v0[1] = a[0] * c01[1] + a[1] * c01[0];
                        v0[2] = a[2] * c01[2] - a[3] * c01[3]; v0[3] = a[2] * c01[3] + a[3] * c01[2];
                        v1[0] = b[0] * c23[0] - b[1] * c23[1]; v1[1] = b[0] * c23[1] + b[1] * c23[0];
                        v1[2] = b[2] * c23[2] - b[3] * c23[3]; v1[3] = b[2] * c23[3] + b[3] * c23[2];
                    } else if (kind == 2) {
#pragma unroll
                        for (int j = 0; j < 4; ++j) { v0[j] = sigmoidf_(v0[j]); v1[j] = sigmoidf_(v1[j]); }
                    }
                    *reinterpret_cast<u32x4*>(rowp + bj * 128) = pack8(v0, v1);
                }
            }
    }
};
DEVI void phase_inproj(const P& p, char* lds) {
    __syncthreads();
    g8::DenseSched S{p.ws + OFF_WINT, NTOK / 256, 14, (int)gridDim.x, (int)blockIdx.x, (size_t)256 * 2048};
    EpiInproj E{p.ws};
    g8::gemm_phase((LAS unsigned char*)lds, p.ws + OFF_ACT, 2048, 16, S, E);
}

struct EpiOutproj {
    static constexpr bool PERM = true;
    const float* xin_lat; const float* xin_ctx; u16* xs; const float* modb;
    DEVI void operator()(const f32x4v (&acc)[2][2][4][2], const g8::Unit& u, int wr, int wc, int fr, int fq) const {
        const int b = u.pm / 65, tb = u.pm % 65;
        const float* xi = tb == 0 ? xin_ctx + (size_t)(b * TC) * DM : xin_lat + (size_t)(b * TL + (tb - 1) * 256) * DM;
        u16* xo = xs + (size_t)(u.pm * 256) * DM;
        const float* gate = modb + (size_t)(tb == 0 ? 2 : b) * 6144 + 2 * 1024;
        const int col0 = u.pn * 256 + wc * 32 + 8 * fq;
        f32x4v gv[2][2];
#pragma unroll
        for (int bj = 0; bj < 2; ++bj)
#pragma unroll
            for (int n = 0; n < 2; ++n) gv[bj][n] = *reinterpret_cast<const f32x4v*>(gate + col0 + bj * 128 + n * 4);
#pragma unroll
        for (int ai = 0; ai < 2; ++ai) {
            f32x4v xv[4][2][2];
#pragma unroll
            for (int m = 0; m < 4; ++m) { const size_t ro = (size_t)(ai * 128 + wr * 64 + m * 16 + fr) * DM + col0;
#pragma unroll
                for (int bj = 0; bj < 2; ++bj)
#pragma unroll
                    for (int n = 0; n < 2; ++n) xv[m][bj][n] = *reinterpret_cast<const f32x4v*>(xi + ro + bj * 128 + n * 4); }
#pragma unroll
            for (int m = 0; m < 4; ++m) { const size_t ro = (size_t)(ai * 128 + wr * 64 + m * 16 + fr) * DM + col0;
#pragma unroll
                for (int bj = 0; bj < 2; ++bj)
                    *reinterpret_cast<u32x4*>(xo + ro + bj * 128) = pack8(xv[m][bj][0] + gv[bj][0] * acc[ai][bj][m][0], xv[m][bj][1] + gv[bj][1] * acc[ai][bj][m][1]); }
        }
    }
};
DEVI void phase_outproj(const P& p, char* lds) {
    __syncthreads();
    g8::DenseSched S{p.ws + OFF_WOUTT, NTOK / 256, 4, (int)gridDim.x, (int)blockIdx.x, (size_t)256 * 2048};
    EpiOutproj E{p.x, p.ctx, (u16*)(p.ws + OFF_MLC), (const float*)(p.ws + OFF_MOD)};
    g8::gemm_phase((LAS unsigned char*)lds, p.ws + OFF_ACT, 2048, 16, S, E);
}

DEVI int moe_table(const P& p, int layer, int* tb) {
    __syncthreads();
    if (threadIdx.x == 0) {
        const unsigned* cnt = (const unsigned*)(p.ws + OFF_CNT) + layer * 32; int o = 0;
        for (int c = 0; c < 24; ++c) { tb[c] = o; tb[32 + c] = (int)cnt[c]; o += ((int)cnt[c] + 255) >> 8; }
        tb[24] = o;
    }
    __syncthreads();
    return tb[24];
}
DEVI void cls_experts(int cls, int& elo, int& ehi) {
    const int g = cls / 6, pr = cls % 6;
    const int lo = pr < 3 ? 0 : (pr < 5 ? 1 : 2); const int hi = pr < 3 ? pr + 1 : (pr < 5 ? pr - 1 : 3);
    elo = g * 4 + lo; ehi = g * 4 + hi;
}
DEVI void moe_unit(const int* tb, int rt, g8::Unit& u) {
    int cls = 0; while (cls < 23 && tb[cls + 1] <= rt) ++cls;
    u.cls = cls; u.r0 = (rt - tb[cls]) * 256; u.ncls = tb[32 + cls];
}

struct MoeUpSched {
    static constexpr bool GATHER = true;
    const int* tb; int T, G, c; const int* list; const char* Wgu;
    DEVI bool next(int i, g8::Unit& u) const {
        if (!g8::tile_order(i, G, c, T, 8, u.pm, u.pn)) return false;
        moe_unit(tb, u.pm, u); int elo, ehi; cls_experts(u.cls, elo, ehi);
        const int e = u.pn < 4 ? elo : ehi;
        u.B0 = u.B1 = Wgu + ((size_t)e * 1024 + (size_t)(u.pn & 3) * 256) * 2048; return true;
    }
    DEVI void aoffs(const g8::Unit& u, unsigned (&v)[2][2]) const {
        const int* lst = list + (size_t)u.cls * NTOK + u.r0;
#pragma unroll
        for (int i = 0; i < 2; ++i) { int R, C; g8::lane_rc(i, R, C);
#pragma unroll
            for (int h = 0; h < 2; ++h) { const int rr = h * 128 + R; const int tok = lst[(u.r0 + rr < u.ncls) ? rr : 0]; v[h][i] = (unsigned)((tok * 1024 + C) * 2); } }
    }
};
struct EpiMoeUp {
    static constexpr bool PERM = true;
    const int* list; const float2* tokw; u16* HE;
    DEVI void operator()(const f32x4v (&acc)[2][2][4][2], const g8::Unit& u, int wr, int wc, int fr, int fq) const {
        const int* lst = list + (size_t)u.cls * NTOK + u.r0;
        const int s = u.pn >> 2;
        float wv[2][4];
        { int tk[2][4];
#pragma unroll
          for (int ai = 0; ai < 2; ++ai)
#pragma unroll
              for (int m = 0; m < 4; ++m) { const int rl = ai * 128 + wr * 64 + m * 16 + fr; tk[ai][m] = lst[(u.r0 + rl < u.ncls) ? rl : 0]; }
#pragma unroll
          for (int ai = 0; ai < 2; ++ai)
#pragma unroll
              for (int m = 0; m < 4; ++m) { const float2 w2 = tokw[tk[ai][m]]; wv[ai][m] = s ? w2.y : w2.x; } }
#pragma unroll
        for (int ai = 0; ai < 2; ++ai)
#pragma unroll
            for (int m = 0; m < 4; ++m) {
                const int rl = ai * 128 + wr * 64 + m * 16 + fr;
                if (u.r0 + rl < u.ncls) {
                    const float w = wv[ai][m];
                    u16* rowp = HE + (size_t)(u.pm * 256 + rl) * 1024 + s * 512 + (u.pn & 3) * 128 + wc * 16 + 4 * fq;
#pragma unroll
                    for (int bj = 0; bj < 2; ++bj) {
                        const f32x4v g = acc[ai][bj][m][0], up = acc[ai][bj][m][1];
                        u32x2 o; o[0] = cvtpk(siluf_(g[0]) * up[0] * w, siluf_(g[1]) * up[1] * w); o[1] = cvtpk(siluf_(g[2]) * up[2] * w, siluf_(g[3]) * up[3] * w);
                        *reinterpret_cast<u32x2*>(rowp + bj * 64) = o;
                    }
                }
            }
    }
};
DEVI void phase_moe_up(const P& p, int layer, char* lds) {
    int* tb = (int*)(lds + g8::STAGE_BYTES);
    const int T = moe_table(p, layer, tb);
    MoeUpSched S{tb, T, (int)gridDim.x, (int)blockIdx.x, (const int*)(p.ws + OFF_LIST), p.ws + (layer ? OFF_WGU1 : OFF_WGU)};
    EpiMoeUp E{(const int*)(p.ws + OFF_LIST), (const float2*)(p.ws + OFF_TOKW), (u16*)(p.ws + OFF_HE)};
    g8::gemm_phase((LAS unsigned char*)lds, p.ws + OFF_ACT, 2048, 16, S, E);
}

struct MoeDownSched {
    static constexpr bool GATHER = false;
    const int* tb; int T, G, c; const char* WdT;
    DEVI bool next(int i, g8::Unit& u) const {
        if (!g8::tile_order(i, G, c, T, 4, u.pm, u.pn)) return false;
        moe_unit(tb, u.pm, u); int elo, ehi; cls_experts(u.cls, elo, ehi);
        u.B0 = WdT + ((size_t)elo * 1024 + (size_t)u.pn * 256) * 1024;
        u.B1 = WdT + ((size_t)ehi * 1024 + (size_t)u.pn * 256) * 1024 - (size_t)8 * 128; return true;
    }
    DEVI void aoffs(const g8::Unit& u, unsigned (&v)[2][2]) const {
#pragma unroll
        for (int i = 0; i < 2; ++i) { int R, C; g8::lane_rc(i, R, C);
#pragma unroll
            for (int h = 0; h < 2; ++h) v[h][i] = (unsigned)(((u.pm * 256 + h * 128 + R) * 1024 + C) * 2); }
    }
};
template <bool DRY>
struct EpiMoeDown {
    static constexpr bool PERM = true;
    const P* pp; int layer; const int* list; const float* modb;
    DEVI void operator()(const f32x4v (&acc)[2][2][4][2], const g8::Unit& u, int wr, int wc, int fr, int fq) const {
        const P& p = *pp;
        const int* lst = list + (size_t)u.cls * NTOK + u.r0;
        const int col0 = u.pn * 256 + wc * 32 + 8 * fq;
        int tk[2][4];
#pragma unroll
        for (int ai = 0; ai < 2; ++ai)
#pragma unroll
            for (int m = 0; m < 4; ++m) { const int rl = ai * 128 + wr * 64 + m * 16 + fr; tk[ai][m] = (u.r0 + rl < u.ncls) ? lst[rl] : -1; }
#pragma unroll
        for (int ai = 0; ai < 2; ++ai)
#pragma unroll
        for (int mh = 0; mh < 2; ++mh) {
            u32x4 xw[2][2]; f32x4v gv[2][2][2];
#pragma unroll
            for (int mm = 0; mm < 2; ++mm) { const int m = mh * 2 + mm; const int tok = tk[ai][m] < 0 ? lst[0] : tk[ai][m];
                const float* gate = modb + (size_t)modsel(layer, tok) * 6144 + 5 * 1024 + col0; const u16* xo = xs_ptr(p, layer, tok) + col0;
#pragma unroll
                for (int bj = 0; bj < 2; ++bj) { xw[mm][bj] = *reinterpret_cast<const u32x4*>(xo + bj * 128);
#pragma unroll
                    for (int n = 0; n < 2; ++n) gv[mm][bj][n] = *reinterpret_cast<const f32x4v*>(gate + bj * 128 + n * 4); } }
#pragma unroll
            for (int mm = 0; mm < 2; ++mm) { const int m = mh * 2 + mm; if (tk[ai][m] >= 0) { const int tok = tk[ai][m];
                u16* xd = DRY ? (u16*)(p.ws + OFF_MLQK) + (size_t)(tok & 8191) * 1024 + col0 : xs_ptr(p, layer, tok) + col0;
#pragma unroll
                for (int bj = 0; bj < 2; ++bj) {
                    f32x4v x0, x1; x0[0] = bflo(xw[mm][bj][0]); x0[1] = bfhi(xw[mm][bj][0]); x0[2] = bflo(xw[mm][bj][1]); x0[3] = bfhi(xw[mm][bj][1]);
                    x1[0] = bflo(xw[mm][bj][2]); x1[1] = bfhi(xw[mm][bj][2]); x1[2] = bflo(xw[mm][bj][3]); x1[3] = bfhi(xw[mm][bj][3]);
                    *reinterpret_cast<u32x4*>(xd + bj * 128) = pack8(x0 + gv[mm][bj][0] * acc[ai][bj][m][0], x1 + gv[mm][bj][1] * acc[ai][bj][m][1]); } } }
        }
    }
};
template <bool DRY = false>
DEVI void phase_moe_down(const P& p, int layer, char* lds) {
    int* tb = (int*)(lds + g8::STAGE_BYTES);
    const int T = moe_table(p, layer, tb);
    MoeDownSched S{tb, T, (int)gridDim.x, (int)blockIdx.x, p.ws + (layer ? OFF_WDT1 : OFF_WDT)};
    EpiMoeDown<DRY> E{&p, layer, (const int*)(p.ws + OFF_LIST), (const float*)(p.ws + OFF_MOD) + (size_t)layer * 3 * 6144};
    g8::gemm_phase((LAS unsigned char*)lds, p.ws + OFF_HE, 1024, 8, S, E);
}

struct EpiFnet {
    static constexpr bool PERM = true;
    char* ws;
    DEVI void operator()(const f32x4v (&acc)[2][2][4][2], const g8::Unit& u, int wr, int wc, int fr, int fq) const {
        u16* dst = (u16*)(ws + (u.pn < 4 ? OFF_ZR : OFF_ZI)) + (u.pn & 3) * 256 + wc * 32 + 8 * fq;
#pragma unroll
        for (int ai = 0; ai < 2; ++ai)
#pragma unroll
            for (int m = 0; m < 4; ++m) {
                u16* rowp = dst + (size_t)(u.pm * 256 + ai * 128 + wr * 64 + m * 16 + fr) * 1024;
#pragma unroll
                for (int bj = 0; bj < 2; ++bj) *reinterpret_cast<u32x4*>(rowp + bj * 128) = pack8(acc[ai][bj][m][0], acc[ai][bj][m][1]);
            }
    }
};
DEVI void phase_fnet_gemm(const P& p, char* lds) {
    __syncthreads();
    g8::DenseSched S{p.ws + OFF_FNT, NLAT / 256, 8, (int)gridDim.x, (int)blockIdx.x, (size_t)256 * 2048};
    EpiFnet E{p.ws};
    g8::gemm_phase((LAS unsigned char*)lds, p.ws + OFF_ACT, 2048, 16, S, E);
}

template <class RP>
DEVI void stage_tr128_load(RP rp, u32x4 (&v)[4]) {
    const int tid = threadIdx.x;
#pragma unroll
    for (int i = 0; i < 4; ++i) { const int idx = tid + 512 * i, k = idx >> 4, c = (idx & 15) * 8; v[i] = *reinterpret_cast<const u32x4*>(rp(k) + c); }
}
DEVI void stage_tr128_write(const u32x4 (&v)[4], char* img) {
    const int tid = threadIdx.x;
#pragma unroll
    for (int i = 0; i < 4; ++i) { const int idx = tid + 512 * i, k = idx >> 4, c = (idx & 15) * 8; *reinterpret_cast<u32x4*>(img + (k >> 6) * 16384 + v_st(k & 63, c)) = v[i]; }
}
DEVI void load_dft(const P& p, char* lds) {
    const int tid = threadIdx.x;
    for (int i = tid; i < 4096; i += NTHR) {
        const int m = i >> 11, j = i & 2047, row = j >> 4, ch = j & 15;
        const u32x4 v = *reinterpret_cast<const u32x4*>((const u16*)(p.ws + (m ? OFF_DFTS : OFF_DFTC)) + row * 128 + ch * 8);
        *reinterpret_cast<u32x4*>(lds + m * 34816 + swz256(row, ch)) = v;
    }
}
DEVI bf16x8 negbf(bf16x8 v) { u32x4 w = *reinterpret_cast<u32x4*>(&v); w[0] ^= 0x80008000u; w[1] ^= 0x80008000u; w[2] ^= 0x80008000u; w[3] ^= 0x80008000u; return *reinterpret_cast<bf16x8*>(&w); }

template <int KS, int WN, int MODE>
DEVI void fft_kstep(int vbr, int vbi, const bf16x8& aC, const bf16x8& aS, f32x16 (&yr)[2], f32x16 (&yi)[2]) {
    s16x4 rl0, rh0, rl1, rh1, il0, ih0, il1, ih1;
    tr_frag_issue<2 * WN, KS>(vbr, rl0, rh0); tr_frag_issue<2 * WN + 1, KS>(vbr, rl1, rh1);
    tr_frag_issue<2 * WN, KS>(vbi, il0, ih0); tr_frag_issue<2 * WN + 1, KS>(vbi, il1, ih1);
    LGKM0();
    const bf16x8 xr0 = PKLH(rl0, rh0), xr1 = PKLH(rl1, rh1), xi0 = PKLH(il0, ih0), xi1 = PKLH(il1, ih1);
    yr[0] = __builtin_amdgcn_mfma_f32_32x32x16_bf16(xr0, aC, yr[0], 0, 0, 0);
    yr[1] = __builtin_amdgcn_mfma_f32_32x32x16_bf16(xr1, aC, yr[1], 0, 0, 0);
    yr[0] = __builtin_amdgcn_mfma_f32_32x32x16_bf16(xi0, aS, yr[0], 0, 0, 0);
    yr[1] = __builtin_amdgcn_mfma_f32_32x32x16_bf16(xi1, aS, yr[1], 0, 0, 0);
    if (MODE == 0) {
        yi[0] = __builtin_amdgcn_mfma_f32_32x32x16_bf16(xi0, aC, yi[0], 0, 0, 0);
        yi[1] = __builtin_amdgcn_mfma_f32_32x32x16_bf16(xi1, aC, yi[1], 0, 0, 0);
        yi[0] = __builtin_amdgcn_mfma_f32_32x32x16_bf16(negbf(xr0), aS, yi[0], 0, 0, 0);
        yi[1] = __builtin_amdgcn_mfma_f32_32x32x16_bf16(negbf(xr1), aS, yi[1], 0, 0, 0);
    }
}
template <int WN, int MODE>
DEVI void fft_core(const char* lds, int xr_img, int xi_img, int wm, int lane, f32x16 (&yr)[2], f32x16 (&yi)[2]) {
    const int r32 = lane & 31, hi = lane >> 5;
    const char* Cm = lds; const char* Sm = lds + 34816;
    const int row = wm * 32 + r32;
    const int vb0 = xr_img + v_rd_base(lane), vb1 = xi_img + v_rd_base(lane);
#define KSTEP(H, KS) do { const int kk = (H) * 4 + (KS); \
        const bf16x8 aC = lds_b128(Cm, swz256(row, 2 * kk + hi)), aS = lds_b128(Sm, swz256(row, 2 * kk + hi)); \
        fft_kstep<KS, WN, MODE>(vb0 + (H) * 16384, vb1 + (H) * 16384, aC, aS, yr, yi); } while (0)
    KSTEP(0, 0); KSTEP(0, 1); KSTEP(0, 2); KSTEP(0, 3); KSTEP(1, 0); KSTEP(1, 1); KSTEP(1, 2); KSTEP(1, 3);
#undef KSTEP
}

DEVI void phase_fft1(const P& p, char* lds) {
    const int tid = threadIdx.x, lane = tid & 63, wid = __builtin_amdgcn_readfirstlane(tid >> 6), wm = wid >> 1, wn = wid & 1, r32 = lane & 31, hi = lane >> 5;
    load_dft(p, lds);
    char* imgR = lds + 69632; char* imgI = lds + 102400;
    const u16* Zr = (const u16*)(p.ws + OFF_ZR); const u16* Zi = (const u16*)(p.ws + OFF_ZI);
    u16* Yr = (u16*)(p.ws + OFF_YR); u16* Yi = (u16*)(p.ws + OFF_YI);
    const float2* TW = (const float2*)(p.ws + OFF_TW);
    u32x4 pr[4], pi[4];
#define FFT1_LOAD(U) do { const int cb_ = (U) & 7, t2_ = ((U) >> 3) & 127, b_ = (U) >> 10; \
        stage_tr128_load([&](int k) { return Zr + (size_t)(b_ * TL + 128 * k + t2_) * 1024 + cb_ * 128; }, pr); \
        stage_tr128_load([&](int k) { return Zi + (size_t)(b_ * TL + 128 * k + t2_) * 1024 + cb_ * 128; }, pi); } while (0)
    if ((int)blockIdx.x < NB * 128 * 8) FFT1_LOAD((int)blockIdx.x);
    for (int u = blockIdx.x; u < NB * 128 * 8; u += gridDim.x) {
        const int cb = u & 7, t2 = (u >> 3) & 127, b = u >> 10;
        __syncthreads();
        stage_tr128_write(pr, imgR); stage_tr128_write(pi, imgI);
        __syncthreads();
        if (u + (int)gridDim.x < NB * 128 * 8) FFT1_LOAD(u + (int)gridDim.x);
        f32x16 yr[2] = {}, yi[2] = {};
        const int xr_img = (int)(uintptr_t)imgR, xi_img = (int)(uintptr_t)imgI;
        if (wn == 0) fft_core<0, 0>(lds, xr_img, xi_img, wm, lane, yr, yi); else fft_core<1, 0>(lds, xr_img, xi_img, wm, lane, yr, yi);
        __syncthreads();
        {
            const int k1 = wm * 32 + r32;
            const float2 w = TW[t2 * k1];
            char* oR = imgR + k1 * 272; char* oI = imgR + 34816 + k1 * 272;
#pragma unroll
            for (int ni = 0; ni < 2; ++ni)
#pragma unroll
                for (int g = 0; g < 4; ++g) {
                    const int cbase = wn * 64 + ni * 32 + 8 * g + 4 * hi;
                    float re[4], im[4];
#pragma unroll
                    for (int j = 0; j < 4; ++j) { const float a = yr[ni][4 * g + j], bq = yi[ni][4 * g + j]; re[j] = a * w.x + bq * w.y; im[j] = bq * w.x - a * w.y; }
                    u32x2 pr, pi; pr[0] = cvtpk(re[0], re[1]); pr[1] = cvtpk(re[2], re[3]); pi[0] = cvtpk(im[0], im[1]); pi[1] = cvtpk(im[2], im[3]);
                    *reinterpret_cast<u32x2*>(oR + cbase * 2) = pr; *reinterpret_cast<u32x2*>(oI + cbase * 2) = pi;
                }
        }
        __syncthreads();
#pragma unroll
        for (int i = 0; i < 8; ++i) {
            const int idx = tid + 512 * i, pl = idx >> 11, j = idx & 2047, row = j >> 4, ch = j & 15;
            const u32x4 v = *reinterpret_cast<const u32x4*>(imgR + pl * 34816 + row * 272 + ch * 16);
            *reinterpret_cast<u32x4*>((pl ? Yi : Yr) + ((size_t)(b * 128 + row) * 128 + t2) * 1024 + cb * 128 + ch * 8) = v;
        }
    }
}
template <bool DRY = false>
DEVI void phase_fft2(const P& p, char* lds) {
    const int tid = threadIdx.x, lane = tid & 63, wid = __builtin_amdgcn_readfirstlane(tid >> 6), wm = wid >> 1, wn = wid & 1, r32 = lane & 31, hi = lane >> 5;
    load_dft(p, lds);
    char* imgR = lds + 69632; char* imgI = lds + 102400;
    const u16* Yr = (const u16*)(p.ws + OFF_YR); const u16* Yi = (const u16*)(p.ws + OFF_YI);
    const float* modb = (const float*)(p.ws + OFF_MOD) + (size_t)3 * 6144;
    u32x4 pr[4], pi[4];
#define FFT2_LOAD(U) do { const int cb_ = (U) & 7, k1_ = ((U) >> 3) & 127, b_ = (U) >> 10; \
        stage_tr128_load([&](int k) { return Yr + ((size_t)(b_ * 128 + k1_) * 128 + k) * 1024 + cb_ * 128; }, pr); \
        stage_tr128_load([&](int k) { return Yi + ((size_t)(b_ * 128 + k1_) * 128 + k) * 1024 + cb_ * 128; }, pi); } while (0)
    if ((int)blockIdx.x < NB * 128 * 8) FFT2_LOAD((int)blockIdx.x);
    for (int u = blockIdx.x; u < NB * 128 * 8; u += gridDim.x) {
        const int cb = u & 7, k1 = (u >> 3) & 127, b = u >> 10;
        __syncthreads();
        stage_tr128_write(pr, imgR); stage_tr128_write(pi, imgI);
        __syncthreads();
        if (u + (int)gridDim.x < NB * 128 * 8) FFT2_LOAD(u + (int)gridDim.x);
        f32x16 yr[2] = {}, yi[2] = {};
        const int xr_img = (int)(uintptr_t)imgR, xi_img = (int)(uintptr_t)imgI;
        if (wn == 0) fft_core<0, 1>(lds, xr_img, xi_img, wm, lane, yr, yi); else fft_core<1, 1>(lds, xr_img, xi_img, wm, lane, yr, yi);
        __syncthreads();
        {
            char* oR = imgR + (wm * 32 + r32) * 528;
#pragma unroll
            for (int ni = 0; ni < 2; ++ni)
#pragma unroll
                for (int g = 0; g < 4; ++g) {
                    const int cbase = wn * 64 + ni * 32 + 8 * g + 4 * hi;
                    f32x4 v; v[0] = yr[ni][4 * g]; v[1] = yr[ni][4 * g + 1]; v[2] = yr[ni][4 * g + 2]; v[3] = yr[ni][4 * g + 3];
                    *reinterpret_cast<f32x4*>(oR + cbase * 4) = v;
                }
        }
        __syncthreads();
        const float* gate = modb + (size_t)b * 6144 + 2 * 1024 + cb * 128;
#pragma unroll
        for (int i = 0; i < 4; ++i) {
            const int idx = tid + 512 * i, row = idx >> 4, ch = idx & 15;
            const f32x4 v0 = *reinterpret_cast<const f32x4*>(imgR + row * 528 + ch * 32), v1 = *reinterpret_cast<const f32x4*>(imgR + row * 528 + ch * 32 + 16);
            const f32x4 g0 = *reinterpret_cast<const f32x4*>(gate + ch * 8), g1 = *reinterpret_cast<const f32x4*>(gate + ch * 8 + 4);
            u16* xo = xs_ptr(p, 1, b * TL + k1 + 128 * row) + cb * 128 + ch * 8;
            u16* xd = DRY ? (u16*)(p.ws + OFF_ZR) + (size_t)(b * TL + k1 + 128 * row) * 1024 + cb * 128 + ch * 8 : xo;
            const u32x4 xw = *reinterpret_cast<const u32x4*>(xo);
            f32x4 x0, x1; x0[0] = bflo(xw[0]); x0[1] = bfhi(xw[0]); x0[2] = bflo(xw[1]); x0[3] = bfhi(xw[1]); x1[0] = bflo(xw[2]); x1[1] = bfhi(xw[2]); x1[2] = bflo(xw[3]); x1[3] = bfhi(xw[3]);
            const f32x4 r0 = x0 + g0 * v0, r1 = x1 + g1 * v1;
            u32x4 w; w[0] = cvtpk(r0[0], r0[1]); w[1] = cvtpk(r0[2], r0[3]); w[2] = cvtpk(r1[0], r1[1]); w[3] = cvtpk(r1[2], r1[3]);
            *reinterpret_cast<u32x4*>(xd) = w;
        }
    }
}

constexpr int AT_V = 16384, AT_K = 17408;
template <int HF, int DB>
DEVI void attn_half(const char* Ks, const bf16x8 (&qr)[8], float& m_reg, float& l_reg, f32x16 (&o)[4], int vb, float* al, int r32, int hi) {
    constexpr float SC = 0.125f, C = SC * 1.4426950408889634f, THR = 8.f;
    f32x16 pp = {};
#pragma unroll
    for (int d0 = 0; d0 < 4; ++d0) pp = __builtin_amdgcn_mfma_f32_32x32x16_bf16(lds_b128(Ks, swz256(HF * 32 + r32, 2 * (DB + d0) + hi)), qr[DB + d0], pp, 0, 0, 0);
    float pmax = pp[0];
#pragma unroll
    for (int r = 1; r < 16; ++r) pmax = fmaxf(pmax, pp[r]);
    { auto rr = __builtin_amdgcn_permlane32_swap(__float_as_uint(pmax), __float_as_uint(pmax), false, false);
      pmax = fmaxf(__uint_as_float(rr[0]), __uint_as_float(rr[1])); }
    float alpha = 1.f;
    if (!__all(pmax - m_reg <= THR / SC)) {
        const float mn = fmaxf(m_reg, pmax); alpha = __builtin_amdgcn_exp2f((m_reg - mn) * C); m_reg = mn;
        if (hi == 0) al[r32] = alpha;
        asm volatile("s_waitcnt lgkmcnt(0)" ::: "memory");
#pragma unroll
        for (int d = 0; d < 4; ++d)
#pragma unroll
            for (int r = 0; r < 16; ++r) o[d][r] *= al[crow(r, hi)];
    }
    const float mnC = -m_reg * C;
    float ps = 0.f;
#pragma unroll
    for (int r = 0; r < 16; ++r) { pp[r] = __builtin_amdgcn_exp2f(fmaf(pp[r], C, mnC)); ps += pp[r]; }
    { auto rr = __builtin_amdgcn_permlane32_swap(__float_as_uint(ps), __float_as_uint(ps), false, false);
      ps = __uint_as_float(rr[0]) + __uint_as_float(rr[1]); }
    l_reg = l_reg * alpha + ps;
    bf16x8 pa0, pa1;
    pack_p(pp, pa0, pa1);
#define PVD(D0) do { s16x4 l0, h0, l1, h1; tr_frag_issue<D0, 2 * HF>(vb, l0, h0); tr_frag_issue<D0, 2 * HF + 1>(vb, l1, h1); LGKM0(); \
        o[D0] = __builtin_amdgcn_mfma_f32_32x32x16_bf16(pa0, PKLH(l0, h0), o[D0], 0, 0, 0); \
        o[D0] = __builtin_amdgcn_mfma_f32_32x32x16_bf16(pa1, PKLH(l1, h1), o[D0], 0, 0, 0); } while (0)
    PVD(0); PVD(1); PVD(2); PVD(3);
#undef PVD
}

DEVI void diffattn_item(const P& p, int q0, int k0row, int seq, int h, char* lds) {
    int tid = threadIdx.x; asm volatile("" : "+v"(tid));
    const int wid = tid >> 6, lane = tid & 63, r32 = lane & 31, hi = lane >> 5;
    const u16* Q = (const u16*)(p.ws + OFF_Q); const u16* Kg = (const u16*)(p.ws + OFF_K) + (size_t)k0row * 512 + h * 128;
    const u16* Vg = (const u16*)(p.ws + OFF_V) + (size_t)k0row * 512 + h * 128;
    char* V_lds = lds; char* K_lds = lds + 2 * AT_V;
    float* al = (float*)(lds + 2 * AT_V + 2 * AT_K) + wid * 64;
    bf16x8 qr[8];
    { const u16* Qw = Q + (size_t)(q0 + wid * 32 + r32) * 512 + h * 128 + hi * 8;
#pragma unroll
      for (int d0 = 0; d0 < 8; ++d0) qr[d0] = *reinterpret_cast<const bf16x8*>(Qw + d0 * 16); }
    const int sr = tid >> 4, sc = (tid & 15) * 8;
    const int vb0 = (int)(uintptr_t)V_lds + v_rd_base(lane);
    const int vc = ((tid >> 5) & 3) * 32 + (tid & 3) * 8;
    const int kk0 = (tid >> 7) * 8 + ((tid & 31) >> 2), kk1 = kk0 + 32;
    const int vk0 = (kk0 & ~0xC) | ((kk0 & 4) << 1) | ((kk0 & 8) >> 1), vk1 = (kk1 & ~0xC) | ((kk1 & 4) << 1) | ((kk1 & 8) >> 1);
    u32x4 sk0, sk1;
#define SLOAD(kk, b) do { \
    __builtin_amdgcn_global_load_lds((const unsigned*)(Vg + (size_t)((kk) + vk0) * 512 + vc), (LAS unsigned*)(V_lds + (b) * AT_V + tid * 16), 16, 0, 0); \
    __builtin_amdgcn_global_load_lds((const unsigned*)(Vg + (size_t)((kk) + vk1) * 512 + vc), (LAS unsigned*)(V_lds + (b) * AT_V + 8192 + tid * 16), 16, 0, 0); \
    sk0 = *reinterpret_cast<const u32x4*>(Kg + (size_t)((kk) + sr) * 512 + sc); sk1 = *reinterpret_cast<const u32x4*>(Kg + (size_t)((kk) + 32 + sr) * 512 + sc); } while (0)
#define SWRITE(b) do { *reinterpret_cast<u32x4*>(K_lds + (b) * AT_K + swz256(sr, tid & 15)) = sk0; *reinterpret_cast<u32x4*>(K_lds + (b) * AT_K + swz256(32 + sr, tid & 15)) = sk1; } while (0)
    float m0 = -1e30f, m1 = -1e30f, l0 = 0.f, l1 = 0.f;
    f32x16 o0[4] = {}, o1[4] = {};
    const int NT = seq / 64;
    __syncthreads();
    SLOAD(0, 0); SWRITE(0); asm volatile("s_waitcnt vmcnt(0)" ::: "memory"); __syncthreads();
    if (NT > 1) SLOAD(64, 1);
    for (int j = 0; j < NT; ++j) {
        const int cur = j & 1;
        const char* Ks = K_lds + cur * AT_K;
        attn_half<0, 0>(Ks, qr, m0, l0, o0, vb0 + cur * AT_V, al, r32, hi);
        attn_half<1, 0>(Ks, qr, m0, l0, o0, vb0 + cur * AT_V, al, r32, hi);
        attn_half<0, 4>(Ks, qr, m1, l1, o1, vb0 + cur * AT_V, al, r32, hi);
        attn_half<1, 4>(Ks, qr, m1, l1, o1, vb0 + cur * AT_V, al, r32, hi);
        if (j + 1 < NT) SWRITE(cur ^ 1);
        asm volatile("s_waitcnt vmcnt(0)" ::: "memory");
        __syncthreads();
        if (j + 2 < NT) SLOAD((j + 2) * 64, cur);
    }
#undef SLOAD
#undef SWRITE
    int tz = threadIdx.x; asm volatile("" : "+v"(tz));
    const int wid2 = tz >> 6, lane2 = tz & 63, r32e = lane2 & 31, hie = lane2 >> 5;
    const float lam = ((const float*)(p.ws + OFF_LAM))[0];
    float* sc0 = (float*)(lds + 2 * AT_V + 2 * AT_K) + wid2 * 64; float* sc1 = sc0 + 32;
    if (hie == 0) { sc0[r32e] = 1.f / l0; sc1[r32e] = -lam / l1; }
    asm volatile("s_waitcnt lgkmcnt(0)" ::: "memory");
    float ssq[16];
#pragma unroll
    for (int r = 0; r < 16; ++r) {
        const float a = sc0[crow(r, hie)], b = sc1[crow(r, hie)]; float s = 0.f;
#pragma unroll
        for (int d = 0; d < 4; ++d) { const float v = o0[d][r] * a + o1[d][r] * b; o0[d][r] = v; s = fmaf(v, v, s); }
        ssq[r] = s;
    }
#pragma unroll
    for (int r = 0; r < 16; ++r) { float s = ssq[r]; for (int o = 16; o; o >>= 1) s += __shfl_xor(s, o); ssq[r] = rsqrtf(s * (1.f / 128.f) + 1e-6f) * 0.8f; }
    u16* mix = (u16*)(p.ws + OFF_ACT);
    const float* sg = p.subln_g;
#pragma unroll
    for (int d = 0; d < 4; ++d) {
        const float gv = sg[d * 32 + r32e];
#pragma unroll
        for (int r = 0; r < 16; ++r) mix[(size_t)(q0 + wid2 * 32 + crow(r, hie)) * 1024 + h * 128 + d * 32 + r32e] = f2bf(o0[d][r] * ssq[r] * gv);
    }
}

DEVI void chunk_scan(const float* gates, int row0, int head, int dir, float* Bq, float* av, float* pm, float& total, float& amax) {
    const int lane = threadIdx.x & 63;
    const int e0 = dir ? 127 - 2 * lane : 2 * lane, e1 = dir ? 126 - 2 * lane : 2 * lane + 1;
    const float lf0 = gates[(size_t)(row0 + e0) * 16 + (dir ? 12 : 4) + head], lf1 = gates[(size_t)(row0 + e1) * 16 + (dir ? 12 : 4) + head];
    const float li0 = gates[(size_t)(row0 + e0) * 16 + (dir ? 8 : 0) + head],  li1 = gates[(size_t)(row0 + e1) * 16 + (dir ? 8 : 0) + head];
    const float s1 = lf0 + lf1; float inc = s1;
#pragma unroll
    for (int o = 1; o < 64; o <<= 1) { const float t = __shfl_up(inc, o); if (lane >= o) inc += t; }
    const float exc = inc - s1;
    const float B0 = exc + lf0, B1 = exc + s1;
    const float a0 = li0 - B0, a1 = li1 - B1;
    const float m1 = fmaxf(a0, a1); float mx = m1;
#pragma unroll
    for (int o = 1; o < 64; o <<= 1) { const float t = __shfl_up(mx, o); if (lane >= o) mx = fmaxf(mx, t); }
    float mprev = __shfl_up(mx, 1); if (lane == 0) mprev = -1e30f;
    Bq[e0] = B0; Bq[e1] = B1; av[e0] = a0; av[e1] = a1; pm[e0] = fmaxf(mprev, a0); pm[e1] = mx;
    total = __shfl(inc, 63); amax = __shfl(mx, 63);
}

DEVI void conv_silu8(const u32x4& xm, const u32x4& x0, const u32x4& xp, const float* wc, bool hasm, bool hasp, float (&out)[8]) {
#pragma unroll
    for (int j = 0; j < 4; ++j) {
        const float w00 = wc[2 * j], w01 = wc[2 * j + 1], w10 = wc[1024 + 2 * j], w11 = wc[1024 + 2 * j + 1], w20 = wc[2048 + 2 * j], w21 = wc[2048 + 2 * j + 1];
        float a = w10 * bflo(x0[j]), b = w11 * bfhi(x0[j]);
        if (hasm) { a = fmaf(w00, bflo(xm[j]), a); b = fmaf(w01, bfhi(xm[j]), b); }
        if (hasp) { a = fmaf(w20, bflo(xp[j]), a); b = fmaf(w21, bfhi(xp[j]), b); }
        out[2 * j] = siluf_(a); out[2 * j + 1] = siluf_(b);
    }
}
DEVI void seg_edges(int t  , bool& hasm, bool& hasp) {
    hasm = !(t == 0 || t == TC); hasp = !(t == TC - 1 || t == TT - 1);
}
DEVI int chain_slot(int dir, int b, int h, int cc) { return ((dir * 2 + b) * 4 + h) * NCH + cc; }

DEVI void phase_mlstm_a(const P& p, char* lds) {
    const int tid = threadIdx.x, wid = __builtin_amdgcn_readfirstlane(tid >> 6), lane = tid & 63, r32 = lane & 31, hi = lane >> 5;
    char* Vimg = lds; char* Kf = lds + 32768; char* Kb = lds + 65536;
    float* arr = (float*)(lds + 98304);
    const float* gates = (const float*)(p.ws + OFF_GATES);
    const u16* MLQK = (const u16*)(p.ws + OFF_MLQK); const u16* MLV = (const u16*)(p.ws + OFF_MLV);
    u16* CST = (u16*)(p.ws + OFF_CST); float* NST = (float*)(p.ws + OFF_NST); u16* MLC = (u16*)(p.ws + OFF_MLC);
    float2* scal = (float2*)(p.ws + OFF_MSCAL);
    for (int it = blockIdx.x; it < NB * 4 * NCH; it += gridDim.x) {
        const int cc = it % NCH, h = (it / NCH) & 3, b = it / (NCH * 4);
        const int row0 = b * TT + cc * 128;
        __syncthreads();
        if (wid < 2) {
            float total, amax; float* a4 = arr + wid * 512;
            chunk_scan(gates, row0, h, wid, a4, a4 + 128, a4 + 256, total, amax);
            a4[384 + lane] = __expf(a4[128 + lane] - amax); a4[384 + 64 + lane] = __expf(a4[128 + 64 + lane] - amax);
            if (lane == 0) scal[chain_slot(wid, b, h, 0) + cc] = make_float2(total + amax, total);
        }
        __syncthreads();
#pragma unroll
        for (int i = 0; i < 4; ++i) {
            const int idx = tid + 512 * i, l = idx >> 4, c = (idx & 15) * 8;
            const u32x4 v = *reinterpret_cast<const u32x4*>(MLV + (size_t)(row0 + l) * 512 + h * 128 + c);
            *reinterpret_cast<u32x4*>(Vimg + (l >> 6) * 16384 + v_st(l & 63, c)) = v;
            const int t = cc * 128 + l; bool hasm, hasp; seg_edges(t, hasm, hasp);
            const u16* kp = MLQK + (size_t)(row0 + l) * 1024 + 512 + h * 128 + c;
            const u32x4 x0 = *reinterpret_cast<const u32x4*>(kp);
            const u32x4 xm = hasm ? *reinterpret_cast<const u32x4*>(kp - 1024) : x0;
            const u32x4 xp = hasp ? *reinterpret_cast<const u32x4*>(kp + 1024) : x0;
            float kv[8]; conv_silu8(xm, x0, xp, p.conv_w + 512 + h * 128 + c, hasm, hasp, kv);
            const float wf = arr[384 + l] * 0.08838834764831845f, wb = arr[512 + 384 + l] * 0.08838834764831845f;
            u32x4 of, ob, ok;
#pragma unroll
            for (int j = 0; j < 4; ++j) { of[j] = cvtpk(kv[2 * j] * wf, kv[2 * j + 1] * wf); ob[j] = cvtpk(kv[2 * j] * wb, kv[2 * j + 1] * wb);
                ok[j] = cvtpk(kv[2 * j] * 0.08838834764831845f, kv[2 * j + 1] * 0.08838834764831845f); }
            *reinterpret_cast<u32x4*>(MLC + (size_t)(row0 + l) * 1024 + 512 + h * 128 + c) = ok;
            {
                const u16* qp = kp - 512;
                const u32x4 q0 = *reinterpret_cast<const u32x4*>(qp);
                const u32x4 qm = hasm ? *reinterpret_cast<const u32x4*>(qp - 1024) : q0;
                const u32x4 qn = hasp ? *reinterpret_cast<const u32x4*>(qp + 1024) : q0;
                float qv[8]; conv_silu8(qm, q0, qn, p.conv_w + h * 128 + c, hasm, hasp, qv);
                u32x4 oq;
#pragma unroll
                for (int j = 0; j < 4; ++j) oq[j] = cvtpk(qv[2 * j], qv[2 * j + 1]);
                *reinterpret_cast<u32x4*>(MLC + (size_t)(row0 + l) * 1024 + h * 128 + c) = oq;
            }
            *reinterpret_cast<u32x4*>(Kf + (l >> 6) * 16384 + v_st(l & 63, c)) = of;
            *reinterpret_cast<u32x4*>(Kb + (l >> 6) * 16384 + v_st(l & 63, c)) = ob;
        }
        __syncthreads();
        const int dir = wid >> 2, vblk = wid & 3;
        const int va = (int)(uintptr_t)Vimg + v_rd_base(lane), ka = (int)(uintptr_t)(dir ? Kb : Kf) + v_rd_base(lane);
        f32x16 acc[4] = {};
#define ASTEP(H, KS) do { s16x4 al_, ah_, b0l, b0h, b1l, b1h, b2l, b2h, b3l, b3h; \
        if (vblk == 0) tr_frag_issue<0, KS>(va + (H) * 16384, al_, ah_); else if (vblk == 1) tr_frag_issue<1, KS>(va + (H) * 16384, al_, ah_); \
        else if (vblk == 2) tr_frag_issue<2, KS>(va + (H) * 16384, al_, ah_); else tr_frag_issue<3, KS>(va + (H) * 16384, al_, ah_); \
        tr_frag_issue<0, KS>(ka + (H) * 16384, b0l, b0h); tr_frag_issue<1, KS>(ka + (H) * 16384, b1l, b1h); \
        tr_frag_issue<2, KS>(ka + (H) * 16384, b2l, b2h); tr_frag_issue<3, KS>(ka + (H) * 16384, b3l, b3h); LGKM0(); \
        const bf16x8 af = PKLH(al_, ah_); \
        acc[0] = __builtin_amdgcn_mfma_f32_32x32x16_bf16(af, PKLH(b0l, b0h), acc[0], 0, 0, 0); \
        acc[1] = __builtin_amdgcn_mfma_f32_32x32x16_bf16(af, PKLH(b1l, b1h), acc[1], 0, 0, 0); \
        acc[2] = __builtin_amdgcn_mfma_f32_32x32x16_bf16(af, PKLH(b2l, b2h), acc[2], 0, 0, 0); \
        acc[3] = __builtin_amdgcn_mfma_f32_32x32x16_bf16(af, PKLH(b3l, b3h), acc[3], 0, 0, 0); } while (0)
        ASTEP(0, 0); ASTEP(0, 1); ASTEP(0, 2); ASTEP(0, 3); ASTEP(1, 0); ASTEP(1, 1); ASTEP(1, 2); ASTEP(1, 3);
#undef ASTEP
        u16* Cd = CST + (size_t)chain_slot(dir, b, h, cc) * 16384;
#pragma unroll
        for (int kb = 0; kb < 4; ++kb)
#pragma unroll
            for (int r = 0; r < 16; ++r) Cd[(vblk * 32 + crow(r, hi)) * 128 + kb * 32 + r32] = f2bf(acc[kb][r]);
        if (tid < 256) {
            const int d2 = tid >> 7, k = tid & 127; const char* img = d2 ? Kb : Kf; float s = 0.f;
            for (int l = 0; l < 128; ++l) s += bf2f(*reinterpret_cast<const u16*>(img + (l >> 6) * 16384 + v_st(l & 63, k & ~7) + (k & 7) * 2));
            NST[(size_t)chain_slot(d2, b, h, cc) * 128 + k] = s;
        }
    }
}

DEVI void phase_kmax(const P& p, char* lds) {
    const int tid = threadIdx.x; unsigned* lm = (unsigned*)lds;
    __syncthreads();
    if (tid < 16) lm[tid] = 0u;
    __syncthreads();
    const u16* K = (const u16*)(p.ws + OFF_K); const int hm = tid & 7;
    float mx0 = 0.f, mx1 = 0.f;
    for (int idx = blockIdx.x * NTHR + tid; idx < NTOK * 8; idx += gridDim.x * NTHR) {
        const int tok = idx >> 3; const u16* kp = K + (size_t)tok * 512 + hm * 64; float ss = 0.f;
#pragma unroll
        for (int c = 0; c < 8; ++c) { const u32x4 w = *reinterpret_cast<const u32x4*>(kp + c * 8);
#pragma unroll
            for (int j = 0; j < 4; ++j) { const float a = bflo(w[j]), b = bfhi(w[j]); ss = fmaf(a, a, ss); ss = fmaf(b, b, ss); } }
        if (tok < TT) mx0 = fmaxf(mx0, ss); else mx1 = fmaxf(mx1, ss);
    }
    atomicMax(&lm[hm], __float_as_uint(mx0)); atomicMax(&lm[8 + hm], __float_as_uint(mx1));
    __syncthreads();
    if (tid < 16) atomicMax((unsigned*)(p.ws + OFF_CNT) + 128 + tid, lm[tid]);
    __syncthreads();
}

DEVI int proc_chunk(int dir, int i) { return dir == 0 ? i : (i == 0 ? 1 : (i == 1 ? 0 : NCH + 1 - i)); }

DEVI void phase_mlstm_b(const P& p, char* lds) {
    const int tid = threadIdx.x;
    float* dec = (float*)lds; float* scl = dec + 160; float* mst = scl + 160;
    const float2* scal = (const float2*)(p.ws + OFF_MSCAL);
    u32* CST = (u32*)(p.ws + OFF_CST); float* NST = (float*)(p.ws + OFF_NST); float* MST = (float*)(p.ws + OFF_MST);
    for (int it = blockIdx.x; it < 16 * 16; it += gridDim.x) {
        const int chain = it >> 4, sub = it & 15, dir = chain >> 3;
        __syncthreads();
        if (tid == 0) {
            float m = 0.f;
            for (int i = 0; i < NCH; ++i) {
                const int cc = proc_chunk(dir, i); const float2 s = scal[chain * NCH + cc];
                const float mn = fmaxf(s.y + m, s.x);
                dec[i] = __expf(s.y + m - mn); scl[i] = __expf(s.x - mn); mst[i] = m;
                if (sub == 0) MST[chain * NCH + cc] = m;
                m = mn;
            }
        }
        __syncthreads();
        u32* base = CST + (size_t)chain * NCH * 8192 + sub * 512 + tid;
        float s0 = 0.f, s1 = 0.f;
        for (int i0 = 0; i0 < NCH; i0 += 10) {
            u32 v[10];
#pragma unroll
            for (int j = 0; j < 10; ++j) v[j] = base[(size_t)proc_chunk(dir, i0 + j) * 8192];
#pragma unroll
            for (int j = 0; j < 10; ++j) {
                base[(size_t)proc_chunk(dir, i0 + j) * 8192] = cvtpk(s0, s1);
                const float d = dec[i0 + j], sc = scl[i0 + j];
                s0 = fmaf(d, s0, sc * bflo(v[j])); s1 = fmaf(d, s1, sc * bfhi(v[j]));
            }
        }
        if (sub == 0 && tid < 128) {
            float* nb = NST + (size_t)chain * NCH * 128 + tid; float s = 0.f;
            for (int i = 0; i < NCH; ++i) { const int cc = proc_chunk(dir, i); const float v = nb[cc * 128]; nb[cc * 128] = s; s = fmaf(dec[i], s, scl[i] * v); }
        }
    }
}

DEVI void mlstm_c_item(const P& p, int it, char* lds) {
    int tid = threadIdx.x; asm volatile("" : "+v"(tid));
    const int wid = __builtin_amdgcn_readfirstlane(tid >> 6), lane = tid & 63, r32 = lane & 31, hi = lane >> 5;
    const int cc = it % NCH, h = (it / NCH) & 3, b = it / (NCH * 4);
    const int row0 = b * TT + cc * 128;
    char* Kt = lds; char* Vimg = lds + 34816; char* Ct = lds + 67584;
    float* arr = (float*)(lds + 137216);
    float* wsc = arr + 1024 + wid * 64;
    float* xb = (float*)lds;
    const float* gates = (const float*)(p.ws + OFF_GATES);
    const u16* MLC = (const u16*)(p.ws + OFF_MLC); const u16* MLV = (const u16*)(p.ws + OFF_MLV);
    const u16* CST = (const u16*)(p.ws + OFF_CST); const float* NST = (const float*)(p.ws + OFF_NST); const float* MST = (const float*)(p.ws + OFF_MST);
    __syncthreads();
    if (wid < 2) { float total, amax; float* a4 = arr + wid * 512; chunk_scan(gates, row0, h, wid, a4, a4 + 128, a4 + 256, total, amax); }
    else if (wid < 6) { const int d2 = (wid - 2) >> 1, k = ((wid - 2) & 1) * 64 + lane; arr[d2 * 512 + 384 + k] = NST[(size_t)chain_slot(d2, b, h, cc) * 128 + k]; }
#pragma unroll
    for (int i = 0; i < 4; ++i) {
        const int idx = tid + 512 * i, l = idx >> 4, ch = idx & 15, c = ch * 8;
        const u32x4 v = *reinterpret_cast<const u32x4*>(MLV + (size_t)(row0 + l) * 512 + h * 128 + c);
        *reinterpret_cast<u32x4*>(Vimg + (l >> 6) * 16384 + v_st(l & 63, c)) = v;
        const u32x4 ok = *reinterpret_cast<const u32x4*>(MLC + (size_t)(row0 + l) * 1024 + 512 + h * 128 + c);
        *reinterpret_cast<u32x4*>(Kt + swz256(l, ch)) = ok;
#pragma unroll
        for (int d2 = 0; d2 < 2; ++d2) {
            const u32x4 cv = *reinterpret_cast<const u32x4*>(CST + (size_t)chain_slot(d2, b, h, cc) * 16384 + l * 128 + c);
            *reinterpret_cast<u32x4*>(Ct + d2 * 34816 + swz256(l, ch)) = cv;
        }
    }
    const int dir = wid >> 2, qb = wid & 3, q = qb * 32 + r32;
    bf16x8 qr[8];
    { const u16* qp = MLC + (size_t)(row0 + q) * 1024 + h * 128 + hi * 8;
#pragma unroll
      for (int d0 = 0; d0 < 8; ++d0) qr[d0] = *reinterpret_cast<const bf16x8*>(qp + d0 * 16); }
    __syncthreads();
    const float* a4 = arr + dir * 512;
    const float m_st = MST[chain_slot(dir, b, h, 0) + cc];
    const float Mq = fmaxf(m_st, a4[256 + q]);
    const float inter = __expf(m_st - Mq);
    float nq = 0.f;
#pragma unroll
    for (int d0 = 0; d0 < 8; ++d0) {
        const u32x4 w = *reinterpret_cast<const u32x4*>(&qr[d0]); const float* nn = a4 + 384 + d0 * 16 + hi * 8;
#pragma unroll
        for (int j = 0; j < 4; ++j) { nq = fmaf(bflo(w[j]), nn[2 * j], nq); nq = fmaf(bfhi(w[j]), nn[2 * j + 1], nq); }
    }
    { auto rr = __builtin_amdgcn_permlane32_swap(__float_as_uint(nq), __float_as_uint(nq), false, false); nq = __uint_as_float(rr[0]) + __uint_as_float(rr[1]); }
    f32x16 o[4] = {};
    const char* Cm = Ct + dir * 34816;
#pragma unroll
    for (int dk = 0; dk < 8; ++dk)
#pragma unroll
        for (int d0 = 0; d0 < 4; ++d0) o[d0] = __builtin_amdgcn_mfma_f32_32x32x16_bf16(qr[dk], lds_b128(Cm, swz256(d0 * 32 + r32, 2 * dk + hi)), o[d0], 0, 0, 0);
    if (hi == 0) wsc[r32] = inter;
    asm volatile("s_waitcnt lgkmcnt(0)" ::: "memory");
#pragma unroll
    for (int d0 = 0; d0 < 4; ++d0)
#pragma unroll
        for (int r = 0; r < 16; ++r) o[d0][r] *= wsc[crow(r, hi)];
    const int vb = (int)(uintptr_t)Vimg + v_rd_base(lane);
    float rs = 0.f;
#define KBLK(KB) do { if (dir == 0 ? (KB) <= qb : (KB) >= qb) { \
        f32x16 pp = {}; \
        _Pragma("unroll") for (int d0 = 0; d0 < 8; ++d0) pp = __builtin_amdgcn_mfma_f32_32x32x16_bf16(lds_b128(Kt, swz256((KB) * 32 + r32, 2 * d0 + hi)), qr[d0], pp, 0, 0, 0); \
        _Pragma("unroll") for (int g = 0; g < 4; ++g) { const f32x4 av4 = *reinterpret_cast<const f32x4*>(a4 + 128 + (KB) * 32 + 8 * g + 4 * hi); \
            _Pragma("unroll") for (int j = 0; j < 4; ++j) { const int key = (KB) * 32 + 8 * g + 4 * hi + j; const bool ok = dir == 0 ? key <= q : key >= q; \
                const float sv = ok ? pp[4 * g + j] * __expf(av4[j] - Mq) : 0.f; pp[4 * g + j] = sv; rs += sv; } } \
        bf16x8 f0, f1; pack_p(pp, f0, f1); \
        { s16x4 l0, h0, l1, h1, l2, h2, l3, h3; constexpr int HH = (KB) >> 1, K0 = ((KB) & 1) * 2; \
          tr_frag_issue<0, K0>(vb + HH * 16384, l0, h0); tr_frag_issue<1, K0>(vb + HH * 16384, l1, h1); tr_frag_issue<2, K0>(vb + HH * 16384, l2, h2); tr_frag_issue<3, K0>(vb + HH * 16384, l3, h3); LGKM0(); \
          o[0] = __builtin_amdgcn_mfma_f32_32x32x16_bf16(f0, PKLH(l0, h0), o[0], 0, 0, 0); o[1] = __builtin_amdgcn_mfma_f32_32x32x16_bf16(f0, PKLH(l1, h1), o[1], 0, 0, 0); \
          o[2] = __builtin_amdgcn_mfma_f32_32x32x16_bf16(f0, PKLH(l2, h2), o[2], 0, 0, 0); o[3] = __builtin_amdgcn_mfma_f32_32x32x16_bf16(f0, PKLH(l3, h3), o[3], 0, 0, 0); \
          tr_frag_issue<0, K0 + 1>(vb + HH * 16384, l0, h0); tr_frag_issue<1, K0 + 1>(vb + HH * 16384, l1, h1); tr_frag_issue<2, K0 + 1>(vb + HH * 16384, l2, h2); tr_frag_issue<3, K0 + 1>(vb + HH * 16384, l3, h3); LGKM0(); \
          o[0] = __builtin_amdgcn_mfma_f32_32x32x16_bf16(f1, PKLH(l0, h0), o[0], 0, 0, 0); o[1] = __builtin_amdgcn_mfma_f32_32x32x16_bf16(f1, PKLH(l1, h1), o[1], 0, 0, 0); \
          o[2] = __builtin_amdgcn_mfma_f32_32x32x16_bf16(f1, PKLH(l2, h2), o[2], 0, 0, 0); o[3] = __builtin_amdgcn_mfma_f32_32x32x16_bf16(f1, PKLH(l3, h3), o[3], 0, 0, 0); } } } while (0)
    KBLK(0); KBLK(1); KBLK(2); KBLK(3);
#undef KBLK
    { auto rr = __builtin_amdgcn_permlane32_swap(__float_as_uint(rs), __float_as_uint(rs), false, false); rs = __uint_as_float(rr[0]) + __uint_as_float(rr[1]); }
    const float nqt = inter * nq + rs;
    const float den = fmaxf(fabsf(nqt), __expf(-(a4[q] + Mq)));
    if (hi == 0) wsc[32 + r32] = 1.f / den;
    asm volatile("s_waitcnt lgkmcnt(0)" ::: "memory");
#pragma unroll
    for (int d0 = 0; d0 < 4; ++d0)
#pragma unroll
        for (int r = 0; r < 16; ++r) o[d0][r] *= wsc[32 + crow(r, hi)];
    __syncthreads();
    {
        float* xd = dir ? xb : (float*)(lds + 67584);
#pragma unroll
        for (int d0 = 0; d0 < 4; ++d0)
#pragma unroll
            for (int r = 0; r < 16; ++r) xd[(qb * 32 + crow(r, hi)) * 128 + d0 * 32 + r32] = o[d0][r];
    }
    __syncthreads();
    {
        const u16* OG = (const u16*)(p.ws + OFF_OG); u16* mix = (u16*)(p.ws + OFF_ACT);
        const float* xf = (const float*)(lds + 67584);
#pragma unroll
        for (int i = 0; i < 4; ++i) {
            const int idx = tid + 512 * i, ql = idx >> 4, c = (idx & 15) * 8;
            const f32x4 f0 = *reinterpret_cast<const f32x4*>(xf + ql * 128 + c), f1 = *reinterpret_cast<const f32x4*>(xf + ql * 128 + c + 4);
            const f32x4 b0 = *reinterpret_cast<const f32x4*>(xb + ql * 128 + c), b1 = *reinterpret_cast<const f32x4*>(xb + ql * 128 + c + 4);
            const u32x4 og = *reinterpret_cast<const u32x4*>(OG + (size_t)(row0 + ql) * 512 + h * 128 + c);
            u32x4 w;
            w[0] = cvtpk((f0[0] + b0[0]) * bflo(og[0]), (f0[1] + b0[1]) * bfhi(og[0]));
            w[1] = cvtpk((f0[2] + b0[2]) * bflo(og[1]), (f0[3] + b0[3]) * bfhi(og[1]));
            w[2] = cvtpk((f1[0] + b1[0]) * bflo(og[2]), (f1[1] + b1[1]) * bfhi(og[2]));
            w[3] = cvtpk((f1[2] + b1[2]) * bflo(og[3]), (f1[3] + b1[3]) * bfhi(og[3]));
            *reinterpret_cast<u32x4*>(mix + (size_t)(row0 + ql) * 1024 + 512 + h * 128 + c) = w;
        }
    }
}

#define KSWZ(row, colB) ((row) * 256 + ((colB) ^ (((row) & 15) << 4)))
constexpr float A2_SCALE = 0.125f, A2_THR = 8.f;
DEVI void a2_partialSM(f32x16& p0, f32x16& p1, float) {
#pragma unroll
    for (int r = 0; r < 16; ++r) p0[r] = __builtin_amdgcn_exp2f(p0[r]);
}
DEVI void a2_finishSM(f32x16& p0, f32x16& p1, float& l_reg, bf16x8& pa0, bf16x8& pa1, bf16x8& pa2, bf16x8& pa3) {
#pragma unroll
    for (int r = 0; r < 16; ++r) p1[r] = __builtin_amdgcn_exp2f(p1[r]);
    float ps = 0.f;
#pragma unroll
    for (int r = 0; r < 16; ++r) ps += p0[r];
#pragma unroll
    for (int r = 0; r < 16; ++r) ps += p1[r];
    l_reg += ps;
    pack_p(p0, pa0, pa1); pack_p(p1, pa2, pa3);
}
DEVI void a2_qkt(f32x16& p0, f32x16& p1, const char* Ks, const bf16x8 (&qr)[4], int r32, int hi, int grp, float mnC) {
#pragma unroll
    for (int r = 0; r < 16; ++r) { p0[r] = mnC; p1[r] = mnC; }
#pragma unroll
    for (int d0 = 0; d0 < 4; ++d0) { const int cb = (grp * 64 + d0 * 16 + hi * 8) * 2;
        const bf16x8 b0 = lds_b128(Ks, KSWZ(r32, cb)), b1 = lds_b128(Ks, KSWZ(32 + r32, cb));
        p0 = __builtin_amdgcn_mfma_f32_32x32x16_bf16(b0, qr[d0], p0, 0, 0, 0);
        p1 = __builtin_amdgcn_mfma_f32_32x32x16_bf16(b1, qr[d0], p1, 0, 0, 0); }
}
#define A2_VISSUE(D0, F) do { tr_frag_issue<D0, 0>(vb, F##l0, F##h0); tr_frag_issue<D0, 1>(vb, F##l1, F##h1); tr_frag_issue<D0, 2>(vb, F##l2, F##h2); tr_frag_issue<D0, 3>(vb, F##l3, F##h3); } while (0)
#define A2_VMMA(D0, F) do { \
    o[D0] = __builtin_amdgcn_mfma_f32_32x32x16_bf16(pa0, PKLH(F##l0, F##h0), o[D0], 0, 0, 0); o[D0] = __builtin_amdgcn_mfma_f32_32x32x16_bf16(pa1, PKLH(F##l1, F##h1), o[D0], 0, 0, 0); \
    o[D0] = __builtin_amdgcn_mfma_f32_32x32x16_bf16(pa2, PKLH(F##l2, F##h2), o[D0], 0, 0, 0); o[D0] = __builtin_amdgcn_mfma_f32_32x32x16_bf16(pa3, PKLH(F##l3, F##h3), o[D0], 0, 0, 0); } while (0)
#define A2_LGKM(N) do { asm volatile("s_waitcnt lgkmcnt(" #N ")" ::: "memory"); SBAR(); } while (0)
template <int S> DEVI void a2_psm_slice(f32x16& x0, f32x16&, float) {
#pragma unroll
    for (int r = 4 * S; r < 4 * S + 4; ++r) x0[r] = __builtin_amdgcn_exp2f(x0[r]);
}
DEVI void a2_pv(f32x16 (&o)[4], int vb, const bf16x8& pa0, const bf16x8& pa1, const bf16x8& pa2, const bf16x8& pa3, f32x16& x0, f32x16& x1, float mnC) {
    s16x4 al0, ah0, al1, ah1, al2, ah2, al3, ah3, bl0, bh0, bl1, bh1, bl2, bh2, bl3, bh3;
    A2_VISSUE(0, a); A2_VISSUE(1, b);
    A2_LGKM(8); a2_psm_slice<0>(x0, x1, mnC); A2_VMMA(0, a);
    A2_VISSUE(2, a);
    A2_LGKM(8); a2_psm_slice<1>(x0, x1, mnC); A2_VMMA(1, b);
    A2_VISSUE(3, b);
    A2_LGKM(8); a2_psm_slice<2>(x0, x1, mnC); A2_VMMA(2, a);
    A2_LGKM(0); a2_psm_slice<3>(x0, x1, mnC); A2_VMMA(3, b);
}
DEVI void a2_pv_last(f32x16 (&o)[4], int vb, const bf16x8& pa0, const bf16x8& pa1, const bf16x8& pa2, const bf16x8& pa3) {
    s16x4 al0, ah0, al1, ah1, al2, ah2, al3, ah3, bl0, bh0, bl1, bh1, bl2, bh2, bl3, bh3;
    A2_VISSUE(0, a); A2_VISSUE(1, b);
    A2_LGKM(8); A2_VMMA(0, a);
    A2_VISSUE(2, a);
    A2_LGKM(8); A2_VMMA(1, b);
    A2_VISSUE(3, b);
    A2_LGKM(8); A2_VMMA(2, a);
    A2_LGKM(0); A2_VMMA(3, b);
}
constexpr int A2_T = 16384;
DEVI void a2_body(const P& p, int q0, int k0row, int seq, int h, char* lds, int tid) {
    const int GRP = __builtin_amdgcn_readfirstlane(tid >> 8); const int wid = tid >> 6, lane = tid & 63, r32 = lane & 31, hi = lane >> 5, wq = wid & 3;
    const u16* Kh = (const u16*)(p.ws + OFF_K) + (size_t)k0row * 512 + h * 128;
    const u16* Vh = (const u16*)(p.ws + OFF_V) + (size_t)k0row * 512 + h * 128;
    char* V_lds = lds; char* K_lds = lds + 3 * A2_T;
    float* wsc = (float*)(lds + 6 * A2_T) + wid * 64; float* li_l = wsc;
    float l_reg = 0.f; f32x16 o[4] = {}; bf16x8 qr[4];
    { const u16* Qw = (const u16*)(p.ws + OFF_Q) + (size_t)(q0 + wq * 32 + r32) * 512 + h * 128 + GRP * 64 + hi * 8;
#pragma unroll
      for (int d0 = 0; d0 < 4; ++d0) qr[d0] = *reinterpret_cast<const bf16x8*>(Qw + d0 * 16); }
    float mnC;
    { float qq = 0.f;
#pragma unroll
      for (int d0 = 0; d0 < 4; ++d0) { const u32x4 w = *reinterpret_cast<const u32x4*>(&qr[d0]);
#pragma unroll
          for (int j = 0; j < 4; ++j) { const float a = bflo(w[j]), b2 = bfhi(w[j]); qq = fmaf(a, a, qq); qq = fmaf(b2, b2, qq); } }
      { auto rr = __builtin_amdgcn_permlane32_swap(__float_as_uint(qq), __float_as_uint(qq), false, false); qq = __uint_as_float(rr[0]) + __uint_as_float(rr[1]); }
      const int bq = k0row >= TT ? 1 : 0;
      const float k2 = __uint_as_float(((const unsigned*)(p.ws + OFF_CNT))[128 + bq * 8 + h * 2 + GRP]);
      mnC = -sqrtf(qq * k2) * (A2_SCALE * 1.4426950408889634f) * 1.001f;
#pragma unroll
      for (int d0 = 0; d0 < 4; ++d0) { u32x4 w = *reinterpret_cast<u32x4*>(&qr[d0]);
#pragma unroll
          for (int j = 0; j < 4; ++j) w[j] = cvtpk(bflo(w[j]) * (A2_SCALE * 1.4426950408889634f), bfhi(w[j]) * (A2_SCALE * 1.4426950408889634f));
          qr[d0] = *reinterpret_cast<bf16x8*>(&w); } }
    const int vb0 = (int)(uintptr_t)V_lds + v_rd_base(lane);
    const int krow = tid >> 4, kch = (tid & 15) ^ (krow & 15);
    const int vc = ((tid >> 5) & 3) * 32 + (tid & 3) * 8;
    const int kk0 = (tid >> 7) * 8 + ((tid & 31) >> 2), kk1 = kk0 + 32;
    const int vk0 = (kk0 & ~0xC) | ((kk0 & 4) << 1) | ((kk0 & 8) >> 1), vk1 = (kk1 & ~0xC) | ((kk1 & 4) << 1) | ((kk1 & 8) >> 1);
#define A2_DMA(slot, kk) do { \
    __builtin_amdgcn_global_load_lds((const unsigned*)(Kh + (size_t)((kk) + krow) * 512 + kch * 8), (LAS unsigned*)(K_lds + (slot) * A2_T + tid * 16), 16, 0, 0); \
    __builtin_amdgcn_global_load_lds((const unsigned*)(Kh + (size_t)((kk) + 32 + krow) * 512 + kch * 8), (LAS unsigned*)(K_lds + (slot) * A2_T + 8192 + tid * 16), 16, 0, 0); \
    __builtin_amdgcn_global_load_lds((const unsigned*)(Vh + (size_t)((kk) + vk0) * 512 + vc), (LAS unsigned*)(V_lds + (slot) * A2_T + tid * 16), 16, 0, 0); \
    __builtin_amdgcn_global_load_lds((const unsigned*)(Vh + (size_t)((kk) + vk1) * 512 + vc), (LAS unsigned*)(V_lds + (slot) * A2_T + 8192 + tid * 16), 16, 0, 0); } while (0)
    f32x16 pA0, pA1, pB0, pB1; bf16x8 pa0, pa1, pa2, pa3; const int NT = seq / 64;
    __syncthreads();
    A2_DMA(0, 0); asm volatile("s_waitcnt vmcnt(0)" ::: "memory"); __syncthreads();
    A2_DMA(1, 64);
    a2_qkt(pA0, pA1, K_lds, qr, r32, hi, GRP, mnC); a2_partialSM(pA0, pA1, mnC);
    asm volatile("s_waitcnt vmcnt(0)" ::: "memory"); __syncthreads();
    int bp = 0, bc = 1, bn = 2;
#define A2_HALF(X0, X1, Y0, Y1, J) do { \
        if ((J) + 1 < NT) A2_DMA(bn, ((J) + 1) * 64); \
        SBAR(); a2_qkt(X0, X1, K_lds + bc * A2_T, qr, r32, hi, GRP, mnC); \
        a2_finishSM(Y0, Y1, l_reg, pa0, pa1, pa2, pa3); SBAR(); \
        a2_pv(o, vb0 + bp * A2_T, pa0, pa1, pa2, pa3, X0, X1, mnC); \
        asm volatile("s_waitcnt vmcnt(0)" ::: "memory"); __syncthreads(); \
        { const int t_ = bp; bp = bc; bc = bn; bn = t_; } } while (0)
    for (int j = 1; j + 1 < NT; j += 2) {
        A2_HALF(pB0, pB1, pA0, pA1, j);
        A2_HALF(pA0, pA1, pB0, pB1, j + 1);
    }
    A2_HALF(pB0, pB1, pA0, pA1, NT - 1);
    a2_finishSM(pB0, pB1, l_reg, pa0, pa1, pa2, pa3); SBAR();
    a2_pv_last(o, vb0 + bp * A2_T, pa0, pa1, pa2, pa3);
#undef A2_HALF
#undef A2_DMA
    asm volatile("s_waitcnt vmcnt(0)" ::: "memory");
    int tz = threadIdx.x; asm volatile("" : "+v"(tz));
    const int wq_e = (tz >> 6) & 3, r32e = tz & 31, hie = (tz >> 5) & 1;
    float* li_e = (float*)(lds + 6 * A2_T) + (tz >> 6) * 64;
    const float lam = ((const float*)(p.ws + OFF_LAM))[0];
    { auto rr = __builtin_amdgcn_permlane32_swap(__float_as_uint(l_reg), __float_as_uint(l_reg), false, false); l_reg = __uint_as_float(rr[0]) + __uint_as_float(rr[1]); }
    if (hie == 0) li_e[r32e] = (GRP == 0 ? 1.f : -lam) / l_reg;
    asm volatile("s_waitcnt lgkmcnt(0)" ::: "memory");
#pragma unroll
    for (int r = 0; r < 16; ++r) { const float sc_ = li_e[crow(r, hie)];
#pragma unroll
        for (int d = 0; d < 4; ++d) o[d][r] *= sc_; }
    float* xb = (float*)lds;
    __syncthreads();
    if (GRP == 1) {
#pragma unroll
        for (int d = 0; d < 4; ++d)
#pragma unroll
            for (int r = 0; r < 16; ++r) xb[(wq_e * 32 + crow(r, hie)) * 128 + d * 32 + r32e] = o[d][r];
    }
    __syncthreads();
    if (GRP == 0) {
        float ssq[16];
#pragma unroll
        for (int r = 0; r < 16; ++r) { float s_ = 0.f;
#pragma unroll
            for (int d = 0; d < 4; ++d) { const float v = o[d][r] + xb[(wq_e * 32 + crow(r, hie)) * 128 + d * 32 + r32e]; o[d][r] = v; s_ = fmaf(v, v, s_); }
            ssq[r] = s_; }
#pragma unroll
        for (int r = 0; r < 16; ++r) { float s_ = ssq[r]; for (int of = 16; of; of >>= 1) s_ += __shfl_xor(s_, of); ssq[r] = rsqrtf(s_ * (1.f / 128.f) + 1e-6f) * 0.8f; }
        u16* mix = (u16*)(p.ws + OFF_ACT);
#pragma unroll
        for (int d = 0; d < 4; ++d) { const float gv = p.subln_g[d * 32 + r32e];
#pragma unroll
            for (int r = 0; r < 16; ++r) mix[(size_t)(q0 + wq_e * 32 + crow(r, hie)) * 1024 + h * 128 + d * 32 + r32e] = f2bf(o[d][r] * ssq[r] * gv); }
    }
}
DEVI void phase_attn(const P& p, char* lds) {
    const int G = gridDim.x;
    for (int it = blockIdx.x; it < 1024 + 16; it += G) {
        int q0, k0, seq, h;
        if (it < 1024) {
            int bh, qb;
            if ((G & 7) == 0) { bh = it & 7; qb = it >> 3; } else { bh = it >> 7; qb = it & 127; }
            const int b = bh >> 2; h = bh & 3; q0 = b * TT + TC + qb * 128; k0 = b * TT; seq = TT;
        } else { const int j = it - 1024, b = j >> 3; h = (j >> 1) & 3; q0 = b * TT + (j & 1) * 128; k0 = b * TT; seq = TC; }
        int tid = threadIdx.x; asm volatile("" : "+v"(tid));
        a2_body(p, q0, k0, seq, h, lds, tid);
    }
}
DEVI void phase_mlstm_c(const P& p, char* lds) {
    for (int it = blockIdx.x; it < NB * 4 * NCH; it += gridDim.x) mlstm_c_item(p, it, lds);
}

DEVI void tail_bg(const P& p, char* lds, int nunits, int first, int nitems) {
    const int G = gridDim.x, c = blockIdx.x, full = nunits / G, rem = nunits - full * G;
    __syncthreads();
    if (rem == 0) { for (int it = c; it < nitems; it += G) bg_item(p, first + it, (float*)lds); }
    else if (c >= rem) { for (int it = c - rem; it < nitems; it += G - rem) bg_item(p, first + it, (float*)lds); }
    __syncthreads();
}
DEVI void tail_convert(const P& p, char* lds, int layer, int nunits) {
    const int G = gridDim.x, c = blockIdx.x, full = nunits / G, rem = nunits - full * G;
    __syncthreads();
    if (rem == 0) { for (int it = c; it < N0_EXP; it += G) convert_expert_item(p, layer, it, (float*)lds); }
    else if (c >= rem) { for (int it = c - rem; it < N0_EXP; it += G - rem) convert_expert_item(p, layer, it, (float*)lds); }
    __syncthreads();
}
DEVI void phase_convert_l1(const P& p, char* lds) {
    for (int it = blockIdx.x; it < N0_EXP; it += gridDim.x) convert_expert_item(p, 1, it, (float*)lds);
}

constexpr int NPHASE = 19;
__global__ void __launch_bounds__(NTHR, 2) fwd_kernel(P p_) {
    extern __shared__ __attribute__((aligned(16))) char lds[];
    volatile LAS unsigned* st = (volatile LAS unsigned*)(lds + LDS_BYTES - 16);
    if (threadIdx.x == 0) { st[0] = 0u; st[1] = 0u; st[2] = 0u; st[3] = 0u; }
    __syncthreads();
    const int lo = p_.ph_lo, hi = p_.ph_hi;
    XcdBarrier bar; bar.bar = (unsigned*)(p_.ws + OFF_BAR); bar.x = 0; bar.st = st;
    if (hi - lo > 1) bar = xcd_barrier_post((unsigned*)(p_.ws + OFF_BAR), st);
#if defined(__HIP_DEVICE_COMPILE__)
#define PARAMS() const __attribute__((address_space(4))) P* kp_ = (const __attribute__((address_space(4))) P*)__builtin_amdgcn_kernarg_segment_ptr(); asm volatile("" : "+s"(kp_)); const P p = *kp_
#else
#define PARAMS() const P p = p_
#endif
#ifndef PHSEL
#define PHON(k) true
#else
#define PHON(k) ((k) == PHSEL)
#endif
#define IN(k) (lo <= (k) && (k) < hi)
#define SEAM(k) do { if (IN(k) && IN((k) + ((k) == 5 ? 2 : 1))) xcd_barrier(bar); } while (0)
    if (PHON(0) && IN(0)) { PARAMS(); phase_prologue(p, lds); if (((PROBE_DUP) >> 0) & 1u) { phase_prologue(p, lds); } }            SEAM(0);
    if (PHON(1) && IN(1)) { PARAMS(); phase_norm<0>(p, lds); if (((PROBE_DUP) >> 1) & 1u) { phase_norm<0>(p, lds); } }             SEAM(1);
    if (PHON(2) && IN(2)) { PARAMS(); phase_inproj(p, lds); tail_convert(p, lds, 0, (NTOK / 256) * 14); if (((PROBE_DUP) >> 2) & 1u) { phase_inproj(p, lds); } }              SEAM(2);
    if (PHON(3) && IN(3)) { PARAMS(); phase_mlstm_a(p, lds); tail_bg(p, lds, NB * 4 * NCH, 0, N0_WOUT); if (((PROBE_DUP) >> 3) & 1u) { phase_mlstm_a(p, lds); } }             SEAM(3);
    if (PHON(4) && IN(4)) { PARAMS(); phase_kmax(p, lds); phase_mlstm_b(p, lds); if (((PROBE_DUP) >> 4) & 1u) { xcd_barrier(bar); phase_mlstm_a(p, lds); xcd_barrier(bar); phase_mlstm_b(p, lds); } }             SEAM(4);
    if (PHON(5) && IN(5)) { PARAMS(); phase_attn(p, lds); phase_mlstm_c(p, lds); tail_bg(p, lds, NB * 4 * NCH, N0_WOUT, N0_FN); if (((PROBE_DUP) >> 5) & 1u) { phase_attn(p, lds); } if (((PROBE_DUP) >> 6) & 1u) { phase_mlstm_c(p, lds); } }   SEAM(5);
    if (PHON(7) && IN(7)) { PARAMS(); phase_outproj(p, lds); tail_convert(p, lds, 1, (NTOK / 256) * 4); if (((PROBE_DUP) >> 7) & 1u) { phase_outproj(p, lds); } }             SEAM(7);
    if (PHON(8) && IN(8)) { PARAMS(); phase_norm<1>(p, lds); if (((PROBE_DUP) >> 8) & 1u) { phase_norm<1, true>(p, lds); } }             SEAM(8);
    if (PHON(9) && IN(9)) { PARAMS(); phase_moe_up(p, 0, lds); if (((PROBE_DUP) >> 9) & 1u) { phase_moe_up(p, 0, lds); } }           SEAM(9);
    if (PHON(10) && IN(10)) { PARAMS(); phase_moe_down(p, 0, lds); if (((PROBE_DUP) >> 10) & 1u) { phase_moe_down<true>(p, 0, lds); } }        SEAM(10);
    if (PHON(11) && IN(11)) { PARAMS(); phase_norm<2>(p, lds); if (((PROBE_DUP) >> 11) & 1u) { phase_norm<2>(p, lds); } } SEAM(11);
    if (PHON(12) && IN(12)) { PARAMS(); phase_fnet_gemm(p, lds); if (((PROBE_DUP) >> 12) & 1u) { phase_fnet_gemm(p, lds); } }          SEAM(12);
    if (PHON(13) && IN(13)) { PARAMS(); phase_fft1(p, lds); if (((PROBE_DUP) >> 13) & 1u) { phase_fft1(p, lds); } }               SEAM(13);
    if (PHON(14) && IN(14)) { PARAMS(); phase_fft2(p, lds); if (((PROBE_DUP) >> 14) & 1u) { phase_fft2<true>(p, lds); } }               SEAM(14);
    if (PHON(15) && IN(15)) { PARAMS(); phase_norm<3>(p, lds); if (((PROBE_DUP) >> 15) & 1u) { phase_norm<3, true>(p, lds); } }            SEAM(15);
    if (PHON(16) && IN(16)) { PARAMS(); phase_moe_up(p, 1, lds); if (((PROBE_DUP) >> 16) & 1u) { phase_moe_up(p, 1, lds); } }          SEAM(16);
    if (PHON(17) && IN(17)) { PARAMS(); phase_moe_down(p, 1, lds); if (((PROBE_DUP) >> 17) & 1u) { phase_moe_down<true>(p, 1, lds); } }        SEAM(17);
    if (PHON(18) && IN(18)) { PARAMS(); phase_norm<4>(p, lds); if (((PROBE_DUP) >> 18) & 1u) { phase_norm<4>(p, lds); } }
#undef IN
#undef SEAM
}

#ifndef ONE_LAUNCH
#define ONE_LAUNCH 1
#endif
extern "C" void kernel_launch(void* const* d_in, const int* in_sizes, int n_in, void* d_out, int out_size, void* d_ws, size_t ws_size, hipStream_t stream) {
    static int grid = 0;
    if (grid == 0) {
        if (n_in != 21 || out_size != NLAT * DM || ws_size < OFF_END) { fprintf(stderr, "kernel_launch: unexpected shapes (n_in %d out %d ws %zu need %zu)\n", n_in, out_size, ws_size, (size_t)OFF_END); grid = -1; return; }
        int dev = 0, cus = 0;
        if (hipGetDevice(&dev) != hipSuccess || hipDeviceGetAttribute(&cus, hipDeviceAttributeMultiprocessorCount, dev) != hipSuccess) { grid = -1; return; }
        if (hipFuncSetAttribute((const void*)fwd_kernel, hipFuncAttributeMaxDynamicSharedMemorySize, LDS_BYTES) != hipSuccess) { fprintf(stderr, "kernel_launch: hipFuncSetAttribute failed\n"); grid = -1; return; }
        int per_cu = 0;
        if (hipOccupancyMaxActiveBlocksPerMultiprocessor(&per_cu, (const void*)fwd_kernel, NTHR, LDS_BYTES) != hipSuccess || per_cu < 1) { fprintf(stderr, "kernel_launch: occupancy query says %d\n", per_cu); (void)hipGetLastError(); grid = -1; return; }
        grid = cus;
    }
    if (grid < 0) return;
    (void)hipMemsetAsync(d_ws, 0, ZERO_BYTES, stream);
    P p{};
    const float* const* in = (const float* const*)d_in;
    p.x = in[0]; p.c = in[1]; p.ctx = in[2]; p.c_ctx = in[3]; p.ada_w = in[4]; p.ada_b = in[5]; p.nmix_g = in[6]; p.nffn_g = in[7];
    p.w_in = in[8]; p.w_out = in[9]; p.conv_w = in[10]; p.gate_b = in[11]; p.lamv = in[12]; p.subln_g = in[13]; p.w_fnet = in[14];
    p.router_w = in[15]; p.router_b = in[16]; p.w_gate = in[17]; p.w_up = in[18]; p.w_down = in[19]; p.final_g = in[20];
    p.out = (float*)d_out; p.ws = (char*)d_ws;
#if ONE_LAUNCH
    p.ph_lo = 0; p.ph_hi = NPHASE;
    hipLaunchKernelGGL(fwd_kernel, dim3(grid), dim3(NTHR), LDS_BYTES, stream, p);
#else
    for (int k = 0; k < NPHASE; ++k) { p.ph_lo = k; p.ph_hi = k + 1; hipLaunchKernelGGL(fwd_kernel, dim3(grid), dim3(NTHR), LDS_BYTES, stream, p); }
#endif
}
```

```cpp
#include <hip/hip_runtime.h>
#include <stdint.h>
#include <stdio.h>

#define DEVI __device__ __forceinline__
#define PROBE_DUP (0u)
typedef unsigned short u16;
typedef unsigned int u32;
using bf16x8 = __attribute__((ext_vector_type(8))) short;
using s16x4  = __attribute__((ext_vector_type(4))) short;
using f32x16 = __attribute__((ext_vector_type(16))) float;
using f32x4  = __attribute__((ext_vector_type(4))) float;
using u32x4  = __attribute__((ext_vector_type(4))) unsigned;
using u32x2  = __attribute__((ext_vector_type(2))) unsigned;

constexpr int DM = 1024, NB = 2, TL = 16384, TC = 256, TT = TL + TC, NTOK = NB * TT, NLAT = NB * TL;
constexpr int NCH = TT / 128;
constexpr int NTHR = 512;
constexpr int LDS_BYTES = 147456;

constexpr size_t al256(size_t x) { return (x + 255) / 256 * 256; }
constexpr size_t OFF_BAR   = 0;
constexpr size_t OFF_CNT   = 16384;
constexpr size_t ZERO_BYTES = 20480;
constexpr size_t OFF_MOD   = ZERO_BYTES;
constexpr size_t OFF_ROPER = OFF_MOD + al256(2 * 3 * 6144 * 4);
constexpr size_t OFF_ROPEC = OFF_ROPER + 256 * 16 * 8;
constexpr size_t OFF_TW    = OFF_ROPEC + 64 * 16 * 8;
constexpr size_t OFF_DFTC  = OFF_TW + 16384 * 8;
constexpr size_t OFF_DFTS  = OFF_DFTC + 32768;
constexpr size_t OFF_LAM   = OFF_DFTS + 32768;
constexpr size_t OFF_WG16  = OFF_LAM + 256;
constexpr size_t OFF_MSCAL = OFF_WG16 + 65536;
constexpr size_t OFF_MST   = OFF_MSCAL + al256(16 * NCH * 8);
constexpr size_t OFF_WINT  = OFF_MST + al256(16 * NCH * 4);
constexpr size_t OFF_WOUTT = OFF_WINT + (size_t)3584 * 1024 * 2;
constexpr size_t OFF_FNT   = OFF_WOUTT + (size_t)1024 * 1024 * 2;
constexpr size_t OFF_WGU   = OFF_FNT + (size_t)2048 * 1024 * 2;
constexpr size_t OFF_WDT   = OFF_WGU + (size_t)16 * 1024 * 1024 * 2;
constexpr size_t OFF_ACT   = OFF_WDT + (size_t)16 * 1024 * 512 * 2;
constexpr size_t SZ_ACT    = (size_t)NTOK * 1024 * 2;
constexpr size_t OFF_XC    = OFF_ACT + SZ_ACT;
constexpr size_t OFF_GATES = OFF_XC + (size_t)NB * TC * 1024 * 4;
constexpr size_t OFF_TOKW  = OFF_GATES + (size_t)NTOK * 16 * 4;
constexpr size_t OFF_LIST  = OFF_TOKW + al256((size_t)NTOK * 8);
constexpr size_t OFF_NST   = OFF_LIST + (size_t)24 * NTOK * 4;
constexpr size_t OFF_CST   = OFF_NST + (size_t)16 * NCH * 128 * 4;
constexpr size_t SZ_CST    = (size_t)16 * NCH * 16384 * 2;
constexpr size_t OFF_BIG   = OFF_CST + SZ_CST;
constexpr size_t OFF_Q     = OFF_BIG;
constexpr size_t OFF_K     = OFF_Q + (size_t)NTOK * 512 * 2;
constexpr size_t OFF_V     = OFF_K + (size_t)NTOK * 512 * 2;
constexpr size_t OFF_MLQK  = OFF_V + (size_t)NTOK * 512 * 2;
constexpr size_t OFF_MLV   = OFF_MLQK + (size_t)NTOK * 1024 * 2;
constexpr size_t OFF_OG    = OFF_MLV + (size_t)NTOK * 512 * 2;
constexpr size_t OFF_MLC   = OFF_OG + (size_t)NTOK * 512 * 2;
constexpr size_t OFF_END   = OFF_MLC + (size_t)NTOK * 1024 * 2;
constexpr size_t OFF_HE    = OFF_BIG;
constexpr size_t OFF_ZR    = OFF_BIG;
constexpr size_t OFF_ZI    = OFF_ZR + (size_t)NLAT * 1024 * 2;
constexpr size_t OFF_WGU1  = OFF_MLV + (size_t)2 * 1024 * 1024;
constexpr size_t OFF_WDT1  = OFF_WGU1 + (size_t)16 * 1024 * 1024 * 2;
static_assert(OFF_WDT1 + (size_t)16 * 1024 * 512 * 2 <= OFF_MLC && OFF_WGU1 >= OFF_BIG + (size_t)NLAT * 2048 * 2, "layer-1 expert region");
constexpr size_t OFF_YR    = OFF_CST;
constexpr size_t OFF_YI    = OFF_ACT;
static_assert((size_t)NLAT * 1024 * 2 <= SZ_CST && (size_t)NLAT * 1024 * 2 <= SZ_ACT, "alias sizes");
static_assert(OFF_END < (size_t)508 * 1024 * 1024, "workspace");

struct P {
    const float *x, *c, *ctx, *c_ctx, *ada_w, *ada_b, *nmix_g, *nffn_g, *w_in, *w_out, *conv_w, *gate_b, *lamv, *subln_g,
                *w_fnet, *router_w, *router_b, *w_gate, *w_up, *w_down, *final_g;
    float* out;
    char* ws;
    int ph_lo, ph_hi;
};

#define XB_TMO      128
#define XB_XCNT(j)  (256  + 64 * (j))
#define XB_XSUB(j)  (1280 + 64 * (j))
#define XB_XGEN(j)  (2304 + 64 * (j))
#define XB_TOP      3328
#define XB_TOPGEN   3392
#define XCD_BAR_WORDS 3456
#define XB_SPIN_CAP (1u << 18)
#define LAS __attribute__((address_space(3)))

__device__ __forceinline__ unsigned xb_ld(unsigned* p)              { return __hip_atomic_load(p, __ATOMIC_RELAXED, __HIP_MEMORY_SCOPE_AGENT); }
__device__ __forceinline__ unsigned xb_add(unsigned* p, unsigned v) { return __hip_atomic_fetch_add(p, v, __ATOMIC_RELAXED, __HIP_MEMORY_SCOPE_AGENT); }
__device__ __forceinline__ unsigned xb_xcc_id() { return (unsigned)__builtin_amdgcn_s_getreg((3 << 11) | 20) & 0xFu; }
#define XB_SPIN(cond, bar) do { unsigned _sp = 0; while (cond) { __builtin_amdgcn_s_sleep(1); \
    if ((++_sp & 255u) == 0u) { if (xb_ld(&(bar)[XB_TMO])) break; if (_sp > XB_SPIN_CAP) { atomicAdd(&(bar)[XB_TMO], 1u); break; } } } } while (0)

struct XcdBarrier { unsigned* bar; unsigned x; volatile LAS unsigned* st; };

__device__ __forceinline__ XcdBarrier xcd_barrier_post(unsigned* bar, volatile LAS unsigned* st) {
    XcdBarrier b; b.bar = bar; b.x = xb_xcc_id(); b.st = st;
    if (threadIdx.x == 0) (void)xb_add(&bar[XB_XCNT(b.x)], 1u);
    return b;
}
__device__ __forceinline__ void xcd_barrier_complete(unsigned* bar, unsigned x, unsigned& nloc, unsigned& nx) {
    const unsigned G = gridDim.x * gridDim.y * gridDim.z;
    unsigned sum, cnt, mine, sp = 0u;
    for (;;) {
        sum = 0u; cnt = 0u; mine = 0u;
#pragma unroll
        for (unsigned j = 0; j < 16; ++j) { const unsigned c = xb_ld(&bar[XB_XCNT(j)]); sum += c; cnt += (c > 0u) ? 1u : 0u; mine = (j == x) ? c : mine; }
        if (sum == G) break;
        __builtin_amdgcn_s_sleep(1);
        if ((++sp & 255u) == 0u) { if (xb_ld(&bar[XB_TMO])) break; if (sp > XB_SPIN_CAP) { atomicAdd(&bar[XB_TMO], 1u); break; } }
    }
    nloc = mine > 0u ? mine : 1u; nx = cnt > 0u ? cnt : 1u;
}
__device__ __forceinline__ void xcd_barrier(const XcdBarrier& b) {
    asm volatile("s_waitcnt vmcnt(0)" ::: "memory");
    __syncthreads();
    if (threadIdx.x == 0) {
        unsigned* bar = b.bar;
        __builtin_amdgcn_s_waitcnt(0);
        unsigned nloc = b.st[0], nx = b.st[1];
        if (nloc == 0u) { xcd_barrier_complete(bar, b.x, nloc, nx); b.st[0] = nloc; b.st[1] = nx; }
        const unsigned old = xb_add(&bar[XB_XSUB(b.x)], 1u);
        const unsigned gen = old / nloc;
        if (old + 1u == (gen + 1u) * nloc) {
            __builtin_amdgcn_fence(__ATOMIC_RELEASE, "agent");
            asm volatile("s_waitcnt vmcnt(0)" ::: "memory");
            const unsigned og = xb_add(&bar[XB_TOP], 1u);
            const unsigned tg = og / nx;
            if (og + 1u == (tg + 1u) * nx) xb_add(&bar[XB_TOPGEN], 1u);
            else XB_SPIN(xb_ld(&bar[XB_TOPGEN]) == tg, bar);
            __builtin_amdgcn_fence(__ATOMIC_ACQUIRE, "agent");
            xb_add(&bar[XB_XGEN(b.x)], 1u);
            asm volatile("s_waitcnt vmcnt(0)" ::: "memory");
        } else {
            XB_SPIN(xb_ld(&bar[XB_XGEN(b.x)]) == gen, bar);
            __builtin_amdgcn_fence(__ATOMIC_ACQUIRE, "agent");
            asm volatile("s_waitcnt vmcnt(0)" ::: "memory");
        }
    }
    __syncthreads();
}

DEVI u16 f2bf(float f) { u32 u = __float_as_uint(f); u += 0x7fffu + ((u >> 16) & 1u); return (u16)(u >> 16); }
DEVI float bf2f(u32 h) { return __uint_as_float(h << 16); }
DEVI u32 cvtpk(float lo, float hi) { u32 r; asm("v_cvt_pk_bf16_f32 %0, %1, %2" : "=v"(r) : "v"(lo), "v"(hi)); return r; }
DEVI float bflo(u32 w) { return __uint_as_float(w << 16); }
DEVI float bfhi(u32 w) { return __uint_as_float(w & 0xffff0000u); }
DEVI int crow(int r, int hi) { return (r & 3) + 8 * (r >> 2) + 4 * hi; }
DEVI float wave_sum(float v) { for (int o = 32; o; o >>= 1) v += __shfl_xor(v, o); return v; }
DEVI float wave_max(float v) { for (int o = 32; o; o >>= 1) v = fmaxf(v, __shfl_xor(v, o)); return v; }
DEVI float sigmoidf_(float x) { return 1.f / (1.f + __expf(-x)); }
DEVI float siluf_(float x) { return x / (1.f + __expf(-x)); }
DEVI float logsigmoidf_(float x) { return fminf(x, 0.f) - log1pf(__expf(-fabsf(x))); }
#define SBAR() __builtin_amdgcn_sched_barrier(0)

DEVI void sincos2pi(double frac, double& s, double& c) {
    frac -= floor(frac);
    double q = rint(frac * 4.0);
    double r = (frac - q * 0.25) * 6.283185307179586476925;
    double r2 = r * r;
    double sr = r * (1.0 + r2 * (-1.0 / 6 + r2 * (1.0 / 120 + r2 * (-1.0 / 5040 + r2 * (1.0 / 362880 + r2 * (-1.0 / 39916800 + r2 * (1.0 / 6227020800.0 + r2 * (-1.0 / 1307674368000.0))))))));
    double cr = 1.0 + r2 * (-0.5 + r2 * (1.0 / 24 + r2 * (-1.0 / 720 + r2 * (1.0 / 40320 + r2 * (-1.0 / 3628800 + r2 * (1.0 / 479001600.0 + r2 * (-1.0 / 87178291200.0 + r2 * (1.0 / 20922789888000.0))))))));
    int qi = ((int)q) & 3;
    if (qi == 0) { s = sr; c = cr; } else if (qi == 1) { s = cr; c = -sr; } else if (qi == 2) { s = -sr; c = -cr; } else { s = -cr; c = sr; }
}

DEVI u16* xs_ptr(const P& p, int layer, int tok) {
    const int row = layer == 0 ? tok : (tok >> 14) * TT + TC + (tok & (TL - 1));
    return (u16*)(p.ws + OFF_MLC) + (size_t)row * DM;
}
DEVI f32x4 bf4_to_f32(u32x2 w) { f32x4 v; v[0] = bflo(w[0]); v[1] = bfhi(w[0]); v[2] = bflo(w[1]); v[3] = bfhi(w[1]); return v; }
DEVI const float* xin_ptr(const P& p, int tok) {
    int b = tok >= TT ? 1 : 0, t = tok - b * TT;
    if (t < TC) return p.ctx + (size_t)(b * TC + t) * DM;
    return p.x + (size_t)(b * TL + t - TC) * DM;
}
DEVI int modsel(int layer, int tok) {
    if (layer == 0) { int b = tok >= TT ? 1 : 0, t = tok - b * TT; return t < TC ? 2 : b; }
    return tok >> 14;
}

DEVI int swz128(int row, int chunk) { return row * 144 + (chunk << 4); }
DEVI int swz256(int row, int chunk) { return row * 272 + (chunk << 4); }
DEVI int v_st(int k, int c) { const int kk = (k & ~0xC) | ((k & 4) << 1) | ((k & 8) >> 1); return ((kk >> 3) * 4 + (c >> 5)) * 512 + ((kk & 7) * 32 + (c & 31)) * 2; }
DEVI int v_rd_base(int lane) { return ((lane & 3) << 3) | (((lane >> 2) & 3) << 6) | (((lane >> 4) & 1) << 5) | (((lane >> 5) & 1) << 8); }
constexpr int v_rd_off(int d0, int ks, int half) { return d0 * 512 + ks * 4096 + half * 2048; }
template <int OFF> DEVI s16x4 tr_read(int vb) {
    s16x4 r; asm volatile("ds_read_b64_tr_b16 %0, %1 offset:%2" : "=&v"(r) : "v"(vb), "i"(OFF) : "memory"); return r;
}
#define PKLH(L, H) (bf16x8){L[0], L[1], L[2], L[3], H[0], H[1], H[2], H[3]}
template <int D0, int KS> DEVI void tr_frag_issue(int vb, s16x4& l, s16x4& h) { l = tr_read<v_rd_off(D0, KS, 0)>(vb); h = tr_read<v_rd_off(D0, KS, 1)>(vb); }
#define LGKM0() do { asm volatile("s_waitcnt lgkmcnt(0)" ::: "memory"); SBAR(); } while (0)

DEVI bf16x8 lds_b128(const char* base, int off) { return *reinterpret_cast<const bf16x8*>(base + off); }

DEVI void pack_p(const f32x16& pp, bf16x8& f0, bf16x8& f1) {
#define PK4(BASE, OUT) do { unsigned a0 = cvtpk(pp[BASE + 0], pp[BASE + 1]), a1 = cvtpk(pp[BASE + 2], pp[BASE + 3]);   \
    unsigned b0 = cvtpk(pp[BASE + 4], pp[BASE + 5]), b1 = cvtpk(pp[BASE + 6], pp[BASE + 7]);                            \
    auto r0 = __builtin_amdgcn_permlane32_swap(a0, b0, false, false); auto r1 = __builtin_amdgcn_permlane32_swap(a1, b1, false, false); \
    u32x4 w = {r0[0], r1[0], r0[1], r1[1]}; OUT = *reinterpret_cast<bf16x8*>(&w); } while (0)
    PK4(0, f0); PK4(8, f1);
#undef PK4
}

namespace g8 {
constexpr int BM = 256, BK = 64, HALF = 128, HTB = HALF * BK * 2, STAGE_BYTES = 8 * HTB, NXCD = 8, WGM = 8;
DEVI int lds_byte(int r, int c) { const int st = (r >> 4) * 2 + (c >> 5), rr = r & 15, cc = c & 31, ob = rr * 64 + cc * 2; return st * 1024 + (ob ^ (((ob >> 9) & 1) << 5)); }
DEVI void stage_rc(int b, int& R, int& C) { const int st = b / 1024, sb = b % 1024, swz = sb ^ (((sb >> 9) & 1) << 5); R = (st >> 1) * 16 + swz / 64; C = (st & 1) * 32 + (swz % 64) / 2; }
DEVI int perm32(int rho) { const int n = rho >> 4, i = rho & 15; return 8 * (i >> 2) + 4 * n + (i & 3); }
struct Unit { int pm, pn; const char* B0; const char* B1; int cls, r0, ncls; };
DEVI bool tile_order(int i, int G, int c, int nM, int nN, int& pm, int& pn) {
    const int nwg = nM * nN; const long L = (long)i * G + c; if (L >= nwg) return false;
    int wgid = (int)L; { const int q = nwg / NXCD, r = nwg % NXCD, xcd = wgid % NXCD, off = wgid / NXCD; wgid = (xcd < r ? xcd * (q + 1) : r * (q + 1) + (xcd - r) * q) + off; }
    const int nig = WGM * nN, gid = wgid / nig, fm = gid * WGM, gsz = (nM - fm) < WGM ? (nM - fm) : WGM;
    pm = fm + ((wgid % nig) % gsz); pn = (wgid % nig) / gsz; return true;
}
typedef float f32x4v __attribute__((ext_vector_type(4)));
template <class Epi, class Sched, int NT = 16  , int LDA = 2048  >
DEVI void gemm_phase(LAS unsigned char* lds, const char* Abase, int ldbB  , int ksplit  , const Sched& S, const Epi& E) {
    const int tid = threadIdx.x, wid = __builtin_amdgcn_readfirstlane(tid >> 6), lane = tid & 63, wr = wid >> 2, wc = wid & 3, fr = lane & 15, fq = lane >> 4;
    constexpr int nt = NT;
    unsigned voffB[2];
#pragma unroll
    for (int i = 0; i < 2; ++i) { int R, C; stage_rc(tid * 16 + i * 8192, R, C); const int Rb = Epi::PERM ? ((R & ~31) + perm32(R & 31)) : R; voffB[i] = (unsigned)(Rb * ldbB + C * 2); }
    const size_t kstep = (size_t)(BK * 2);
    const size_t hstepB = (size_t)HALF * ldbB;
    const unsigned ldsw = (unsigned)wid * 1024u;
    const int aoff = lds_byte(wr * 64 + fr, fq * 8), boff = lds_byte(wc * 32 + fr, fq * 8);
#define G8_SA(b, h) (((b) * 2 + (h)) * HTB)
#define G8_SB(b, h) ((4 + (b) * 2 + (h)) * HTB)
#define G8_STAGE(bufoff, gbase, voff) do { _Pragma("unroll") for (int _i = 0; _i < 2; ++_i) \
        __builtin_amdgcn_global_load_lds((const unsigned*)((const char*)(gbase) + (voff)[_i]), (LAS unsigned*)(lds + (bufoff) + ldsw + _i * 8192), 16, 0, 0); } while (0)
#define G8_LDA(dst, b, h) do { _Pragma("unroll") for (int m = 0; m < 4; ++m) _Pragma("unroll") for (int k = 0; k < 2; ++k) dst[m][k] = *(const LAS bf16x8*)(lds + G8_SA(b, h) + aoff + m * 2048 + k * 1024); } while (0)
#define G8_LDB(dst, b, h) do { _Pragma("unroll") for (int n = 0; n < 2; ++n) _Pragma("unroll") for (int k = 0; k < 2; ++k) dst[n][k] = *(const LAS bf16x8*)(lds + G8_SB(b, h) + boff + n * 2048 + k * 1024); } while (0)
#define G8_MMA(ai, bj, At, Bt) do { __builtin_amdgcn_s_setprio(1); _Pragma("unroll") for (int m = 0; m < 4; ++m) _Pragma("unroll") for (int n = 0; n < 2; ++n) _Pragma("unroll") for (int k = 0; k < 2; ++k) \
        acc[ai][bj][m][n] = __builtin_amdgcn_mfma_f32_16x16x32_bf16(Bt[n][k], At[m][k], acc[ai][bj][m][n], 0, 0, 0); __builtin_amdgcn_s_setprio(0); } while (0)
#define G8_WAIT_V(n) asm volatile("s_waitcnt vmcnt(" #n ")" ::: "memory")
#define G8_WAIT_L(n) asm volatile("s_waitcnt lgkmcnt(" #n ")" ::: "memory")
#define G8_BAR __builtin_amdgcn_s_barrier()
#define G8_SCHED __builtin_amdgcn_sched_barrier(0)
#define G8_BPTR(u, kt) (((kt) < ksplit ? (u).B0 : (u).B1) + (size_t)(kt) * kstep)
    Unit cur, nxt; int ui = 0;
    if (!S.next(0, cur)) return;
    f32x4v acc[2][2][4][2];
#pragma unroll
    for (int a = 0; a < 2; ++a)
#pragma unroll
        for (int b = 0; b < 2; ++b)
#pragma unroll
            for (int m = 0; m < 4; ++m)
#pragma unroll
                for (int n = 0; n < 2; ++n) acc[a][b][m][n] = (f32x4v){0.f, 0.f, 0.f, 0.f};
    bf16x8 At[4][2], B0[2][2], B1[2][2];
    unsigned voffA[2]; unsigned vs[2][2];
    constexpr size_t hstepA = (size_t)HALF * LDA, tstepA = 2 * hstepA;
    if constexpr (Sched::GATHER) S.aoffs(cur, vs);
    else {
#pragma unroll
        for (int i = 0; i < 2; ++i) { int R, C; stage_rc(tid * 16 + i * 8192, R, C); voffA[i] = (unsigned)(R * LDA + C * 2); }
    }
    const char* cA = Sched::GATHER ? Abase : S.abase(cur, Abase) + (size_t)cur.pm * tstepA;
#define G8_STAGE_A(bufoff, ptr, h) do { if constexpr (Sched::GATHER) G8_STAGE(bufoff, ptr, vs[h]); else G8_STAGE(bufoff, (ptr) + (h) * hstepA, voffA); } while (0)
    { const char* cB = G8_BPTR(cur, 0); const char* cB1 = G8_BPTR(cur, 1);
      G8_STAGE(G8_SB(0, 0), cB, voffB); G8_STAGE_A(G8_SA(0, 0), cA, 0); G8_STAGE(G8_SB(0, 1), cB + hstepB, voffB); G8_STAGE_A(G8_SA(0, 1), cA, 1);
      if (wr == 1) G8_BAR;
      G8_WAIT_V(4); G8_BAR;
      G8_STAGE(G8_SB(1, 0), cB1, voffB); G8_STAGE_A(G8_SA(1, 0), cA + kstep, 0); G8_STAGE(G8_SB(1, 1), cB1 + hstepB, voffB);
      G8_WAIT_V(6); G8_BAR; }
    for (;;) {
        bool has_next = false; const char* nA = cA;
        for (int t = 0; t < nt; t += 2) {
            const bool last = (t == nt - 2);
            const char* a1 = cA + (size_t)(t + 1) * kstep;
            G8_LDB(B0, 0, 0); G8_SCHED; G8_LDA(At, 0, 0); G8_STAGE_A(G8_SA(1, 1), a1, 1);
            G8_WAIT_L(8); G8_BAR; G8_WAIT_L(0); G8_MMA(0, 0, At, B0); G8_BAR; G8_SCHED;
            if (last) {
                has_next = S.next(ui + 1, nxt);
                if (has_next) { if constexpr (Sched::GATHER) S.aoffs(nxt, vs); else nA = S.abase(nxt, Abase) + (size_t)nxt.pm * tstepA; } else nxt = cur;
            }
            const char* a2 = last ? nA : cA + (size_t)(t + 2) * kstep; const char* a3 = a2 + kstep;
            const char* b2 = last ? G8_BPTR(nxt, 0) : G8_BPTR(cur, t + 2); const char* b3 = last ? G8_BPTR(nxt, 1) : G8_BPTR(cur, t + 3);
            G8_LDB(B1, 0, 1); G8_STAGE(G8_SB(0, 0), b2, voffB);
            G8_BAR; G8_WAIT_L(0); G8_MMA(0, 1, At, B1); G8_BAR;
            G8_LDA(At, 0, 1); G8_STAGE_A(G8_SA(0, 0), a2, 0);
            G8_BAR; G8_WAIT_L(0); G8_MMA(1, 0, At, B0); G8_BAR; G8_SCHED;
            G8_STAGE(G8_SB(0, 1), b2 + hstepB, voffB);
            G8_WAIT_V(6); G8_BAR; G8_MMA(1, 1, At, B1); G8_BAR;
            G8_LDB(B0, 1, 0); G8_SCHED; G8_LDA(At, 1, 0); G8_STAGE_A(G8_SA(0, 1), a2, 1);
            G8_WAIT_L(8); G8_BAR; G8_WAIT_L(0); G8_MMA(0, 0, At, B0); G8_BAR; G8_SCHED;
            G8_LDB(B1, 1, 1); G8_STAGE(G8_SB(1, 0), b3, voffB);
            G8_BAR; G8_WAIT_L(0); G8_MMA(0, 1, At, B1); G8_BAR;
            G8_LDA(At, 1, 1); G8_STAGE_A(G8_SA(1, 0), a3, 0);
            G8_BAR; G8_WAIT_L(0); G8_MMA(1, 0, At, B0); G8_BAR; G8_SCHED;
            G8_STAGE(G8_SB(1, 1), b3 + hstepB, voffB);
            G8_WAIT_V(6); G8_BAR; G8_MMA(1, 1, At, B1); G8_BAR;
        }
        cA = nA;
        { int tz = threadIdx.x; asm volatile("" : "+v"(tz));
          const int w2 = tz >> 6, l2 = tz & 63; E(acc, cur, w2 >> 2, w2 & 3, l2 & 15, l2 >> 4); }
        if (!has_next) break;
#pragma unroll
        for (int a = 0; a < 2; ++a)
#pragma unroll
            for (int b = 0; b < 2; ++b)
#pragma unroll
                for (int m = 0; m < 4; ++m)
#pragma unroll
                    for (int n = 0; n < 2; ++n) acc[a][b][m][n] = (f32x4v){0.f, 0.f, 0.f, 0.f};
        cur = nxt; ++ui;
    }
    G8_WAIT_V(0);
    if (wr == 0) G8_BAR;
    G8_BAR;
#undef G8_SA
#undef G8_SB
#undef G8_STAGE
#undef G8_STAGE_A
#undef G8_LDA
#undef G8_LDB
#undef G8_MMA
#undef G8_WAIT_V
#undef G8_WAIT_L
#undef G8_BAR
#undef G8_SCHED
#undef G8_BPTR
}
DEVI void lane_rc(int i, int& R, int& C) { int tz = threadIdx.x; asm volatile("" : "+v"(tz)); stage_rc(tz * 16 + i * 8192, R, C); }
struct DenseSched {
    static constexpr bool GATHER = false;
    const char* Bt; int nM, nN, G, c; size_t btile;
    DEVI const char* abase(const Unit&, const char* a) const { return a; }
    DEVI bool next(int i, Unit& u) const { if (!tile_order(i, G, c, nM, nN, u.pm, u.pn)) return false; u.B0 = u.B1 = Bt + (size_t)u.pn * btile; u.cls = 0; u.r0 = 0; u.ncls = 0; return true; }
    DEVI void aoffs(const Unit& u, unsigned (&v)[2][2]) const {
#pragma unroll
        for (int i = 0; i < 2; ++i) { int R, C; lane_rc(i, R, C);
#pragma unroll
            for (int h = 0; h < 2; ++h) v[h][i] = (unsigned)(((u.pm * 256 + h * 128 + R) * 1024 + C) * 2); }
    }
};
}

template <class PF>
DEVI void transpose_tile(PF colptr, int ldsrc, u16* dst, int lddst, int k0, int n0, float* tl) {
    const int t = threadIdx.x, nn = t & 63, kk = t >> 6;
    const float* sp = colptr(n0 + nn);
#pragma unroll
    for (int i = 0; i < 8; ++i) tl[(kk + 8 * i) * 65 + nn] = sp[(size_t)(k0 + kk + 8 * i) * ldsrc];
    __syncthreads();
    const int n = t >> 3, kc = t & 7;
    u32x4 w;
    w[0] = cvtpk(tl[(kc * 8 + 0) * 65 + n], tl[(kc * 8 + 1) * 65 + n]);
    w[1] = cvtpk(tl[(kc * 8 + 2) * 65 + n], tl[(kc * 8 + 3) * 65 + n]);
    w[2] = cvtpk(tl[(kc * 8 + 4) * 65 + n], tl[(kc * 8 + 5) * 65 + n]);
    w[3] = cvtpk(tl[(kc * 8 + 6) * 65 + n], tl[(kc * 8 + 7) * 65 + n]);
    *reinterpret_cast<u32x4*>(dst + (size_t)(n0 + n) * lddst + k0 + kc * 8) = w;
    __syncthreads();
}

DEVI void convert_expert_item(const P& p, int layer, int it, float* tl) {
    const int e = it / 384, r = it % 384;
    const float* wg = p.w_gate + ((size_t)layer * 16 + e) * 1024 * 512;
    const float* wu = p.w_up   + ((size_t)layer * 16 + e) * 1024 * 512;
    const float* wd = p.w_down + ((size_t)layer * 16 + e) * 512 * 1024;
    if (r < 256) {
        u16* dst = (u16*)(p.ws + (layer ? OFF_WGU1 : OFF_WGU)) + (size_t)e * 1024 * 1024;
        const int kt = r >> 4, nt = r & 15;
        transpose_tile([&](int n) { const int q = n >> 3, sgu = (n >> 2) & 1, j = n & 3; return (sgu ? wu : wg) + q * 4 + j; }, 512, dst, 1024, kt * 64, nt * 64, tl);
    } else {
        const int q = r - 256; u16* dst = (u16*)(p.ws + (layer ? OFF_WDT1 : OFF_WDT)) + (size_t)e * 1024 * 512;
        const int kt = q >> 4, nt = q & 15;
        transpose_tile([&](int n) { return wd + n; }, 1024, dst, 512, kt * 64, nt * 64, tl);
    }
}

constexpr int N0_WIN = 16 * 56, N0_WOUT = 256, N0_EXP = 16 * 384, N0_FN = 1024, N0_MOD = 192, N0_TAB = 128;
constexpr int N0_TOTAL = N0_WIN + N0_MOD + N0_TAB;
constexpr int NBG = N0_WOUT + N0_FN;
DEVI void bg_item(const P& p, int it, float* tl) {
    const int tid = threadIdx.x;
    int r = it;
    if (r < N0_WOUT) {
        const int kt = r >> 4, nt = r & 15; const float* w = p.w_out;
        transpose_tile([&](int n) { return w + n; }, 1024, (u16*)(p.ws + OFF_WOUTT), 1024, kt * 64, nt * 64, tl);
        return;
    }
    r -= N0_WOUT;
    {
        const int idx = r * 512 + tid, c = idx & 127, g = (idx >> 7) & 3, n = idx >> 9;
        double sd, cd; sincos2pi(c / 256.0, sd, cd);
        const float ct = (float)cd, st = (float)sd;
        const float* W = p.w_fnet + (size_t)(g * 256) * 1024 + n;
        float ac = 0.f, as = 0.f, a128 = 0.f, cr = 1.f, sr = 0.f, sg = 1.f;
        for (int c2 = 0; c2 < 256; ++c2) {
            const float w = W[(size_t)c2 * 1024];
            ac = fmaf(cr, w, ac); as = fmaf(sr, w, as); a128 = fmaf(sg, w, a128); sg = -sg;
            const float cn = cr * ct - sr * st; sr = fmaf(sr, ct, cr * st); cr = cn;
        }
        u16* Ah = (u16*)(p.ws + OFF_FNT); u16* Bh = Ah + (size_t)1024 * 512; float* A128 = (float*)(p.ws + OFF_FNT + (size_t)2 * 1024 * 512 * 2);
        Ah[(size_t)n * 512 + g * 128 + c] = f2bf(ac * (1.f / 2048.f)); Bh[(size_t)n * 512 + g * 128 + c] = f2bf(-as * (1.f / 2048.f));
        if (c == 0) A128[g * 1024 + n] = a128 * (1.f / 2048.f);
    }
}
DEVI void bg_fill(const P& p, char* lds, int q, int lo, int hi) {
    int* sh = (int*)(lds + 32768);
    for (;;) {
        __syncthreads();
        if (threadIdx.x == 0) *sh = lo + 4 * (int)atomicAdd((unsigned*)(p.ws + OFF_CNT) + 160 + q, 1u);
        __syncthreads();
        const int it0 = *sh;
        if (it0 >= hi) break;
        for (int it = it0; it < it0 + 4 && it < hi; ++it) bg_item(p, it, (float*)lds);
    }
    __syncthreads();
}

DEVI void phase_prologue(const P& p, char* lds) {
    float* tl = (float*)lds;
    const int tid = threadIdx.x;
    for (int it = blockIdx.x; it < N0_TOTAL; it += gridDim.x) {
        int r = it;
        if (r < N0_WIN) {
            const int kt = r / 56, nt = r % 56;
            const float* w = p.w_in;
            transpose_tile([&](int n) { return w + n; },
                           3600, (u16*)(p.ws + OFF_WINT), 1024, kt * 64, nt * 64, tl);
            continue;
        }
        r -= N0_WIN;
        if (r < N0_MOD) {
            float* sv = tl;
            float* part = tl + 3072;
            for (int i = tid; i < 3072; i += NTHR) { const int v = i >> 10, k = i & 1023; const float xv = v < 2 ? p.c[v * 1024 + k] : p.c_ctx[k]; sv[i] = siluf_(xv); }
            __syncthreads();
            const int j0 = r * 64, L = j0 / 6144, col0 = j0 % 6144, kg = tid >> 6, cl = tid & 63;
            const float* W = p.ada_w + (size_t)L * 1024 * 6144 + col0 + cl;
            float a0 = 0.f, a1 = 0.f, a2 = 0.f;
            for (int k = kg * 128; k < kg * 128 + 128; ++k) { const float w = W[(size_t)k * 6144]; a0 = fmaf(sv[k], w, a0); a1 = fmaf(sv[1024 + k], w, a1); a2 = fmaf(sv[2048 + k], w, a2); }
            part[(kg * 3 + 0) * 64 + cl] = a0; part[(kg * 3 + 1) * 64 + cl] = a1; part[(kg * 3 + 2) * 64 + cl] = a2;
            __syncthreads();
            if (tid < 192) {
                const int v = tid >> 6, c2 = tid & 63; float s = 0.f;
                for (int g = 0; g < 8; ++g) s += part[(g * 3 + v) * 64 + c2];
                ((float*)(p.ws + OFF_MOD))[(size_t)(L * 3 + v) * 6144 + col0 + c2] = s + p.ada_b[L * 6144 + col0 + c2];
            }
            __syncthreads();
            continue;
        }
        r -= N0_MOD;
        {
            const int e = r * 512 + tid;
            if (e < 4096 + 1024) {
                const bool isr = e < 4096; const int ee = isr ? e : e - 4096; const int pos = ee >> 4, j = ee & 15;
                double inv = 1.0; for (int q = 0; q < j; ++q) inv *= 0.56234132519034908;
                const float invf = (float)inv; const float ang = (float)pos * invf;
                double s, c; sincos2pi((double)ang * 0.15915494309189533577, s, c);
                float2 v = make_float2((float)c, (float)s);
                if (isr) ((float2*)(p.ws + OFF_ROPER))[ee] = v; else ((float2*)(p.ws + OFF_ROPEC))[ee] = v;
            } else if (e < 5120 + 16384) {
                const int m = e - 5120; double s, c; sincos2pi(m / 16384.0, s, c);
                ((float2*)(p.ws + OFF_TW))[m] = make_float2((float)c, (float)s);
            } else if (e < 5120 + 32768) {
                const int m = e - 5120 - 16384, k = m >> 7, t = m & 127; double s, c; sincos2pi(((k * t) & 127) / 128.0, s, c);
                ((u16*)(p.ws + OFF_DFTC))[m] = f2bf((float)c); ((u16*)(p.ws + OFF_DFTS))[m] = f2bf((float)s);
            } else if (e < 5120 + 49152) {
                const int m = e - 5120 - 32768, k = m >> 4, g = m & 15;
                ((float*)(p.ws + OFF_WG16))[m] = p.w_in[(size_t)k * 3600 + 3584 + g];
            } else if (e == 5120 + 49152) {
                float s01 = 0.f, s23 = 0.f;
                for (int i = 0; i < 64; ++i) { s01 += p.lamv[i] * p.lamv[64 + i]; s23 += p.lamv[128 + i] * p.lamv[192 + i]; }
                ((float*)(p.ws + OFF_LAM))[0] = expf(s01) - expf(s23) + 0.2f;
            }
        }
    }
}

template <int MODE, bool DRY = false>
DEVI void phase_norm(const P& p, char* lds) {
    constexpr int layer = (MODE == 0 || MODE == 1) ? 0 : 1;
    constexpr bool side = (MODE == 0 || MODE == 1 || MODE == 3);
    const int nrows = layer == 0 ? NTOK : NLAT;
    const int tid = threadIdx.x, lane = tid & 63, wid = tid >> 6;
    f32x4* sl = (f32x4*)lds;
    if (side) {
        const float* S = (MODE == 0) ? (const float*)(p.ws + OFF_WG16) : p.router_w;
        for (int i = tid; i < 4096; i += NTHR) { const int eg = i >> 10, col = i & 1023; const int pc = (col >> 8) * 256 + (col & 3) * 64 + ((col >> 2) & 63);
            sl[eg * 1024 + pc] = *reinterpret_cast<const f32x4*>(S + col * 16 + eg * 4); }
        __syncthreads();
    }
    const float* g = MODE == 0 ? p.nmix_g : MODE == 1 ? p.nffn_g : MODE == 2 ? p.nmix_g + 1024 : MODE == 3 ? p.nffn_g + 1024 : p.final_g;
    const float* modb = (const float*)(p.ws + OFF_MOD) + (size_t)layer * 3 * 6144;
    constexpr int sh_i = (MODE == 0 || MODE == 2) ? 0 : 3;
    u16* act = (u16*)(p.ws + OFF_ACT);
    int npend = 0, pcls = 0, prow = 0; float pwl = 0.f, pwh = 0.f; float keep[16];
#pragma unroll
    for (int e = 0; e < 16; ++e) keep[e] = 0.f;
    const int c0 = 4 * lane;
    f32x4 xn[4];
    { const int row0 = blockIdx.x * 8 + wid;
      if (row0 < nrows) {
          if (MODE == 0) { const float* src = xin_ptr(p, row0);
#pragma unroll
              for (int i = 0; i < 4; ++i) xn[i] = *reinterpret_cast<const f32x4*>(src + c0 + 256 * i); }
          else { const u16* src = xs_ptr(p, layer, row0);
#pragma unroll
              for (int i = 0; i < 4; ++i) xn[i] = bf4_to_f32(*reinterpret_cast<const u32x2*>(src + c0 + 256 * i)); } } }
    for (int row = blockIdx.x * 8 + wid; row < nrows; row += gridDim.x * 8) {
        f32x4 xv[4]; float ss = 0.f;
#pragma unroll
        for (int i = 0; i < 4; ++i) xv[i] = xn[i];
        { const int nrow = row + gridDim.x * 8;
          if (nrow < nrows) {
              if (MODE == 0) { const float* src = xin_ptr(p, nrow);
#pragma unroll
                  for (int i = 0; i < 4; ++i) xn[i] = *reinterpret_cast<const f32x4*>(src + c0 + 256 * i); }
              else { const u16* src = xs_ptr(p, layer, nrow);
#pragma unroll
                  for (int i = 0; i < 4; ++i) xn[i] = bf4_to_f32(*reinterpret_cast<const u32x2*>(src + c0 + 256 * i)); } } }
#pragma unroll
        for (int i = 0; i < 4; ++i) { ss = fmaf(xv[i][0], xv[i][0], ss); ss = fmaf(xv[i][1], xv[i][1], ss); ss = fmaf(xv[i][2], xv[i][2], ss); ss = fmaf(xv[i][3], xv[i][3], ss); }
        ss = wave_sum(ss);
        const float rstd = rsqrtf(ss * (1.f / 1024.f) + 1e-6f);
        if (MODE == 4) {
            float* dst = p.out + (size_t)row * DM;
#pragma unroll
            for (int i = 0; i < 4; ++i) { const f32x4 gv = *reinterpret_cast<const f32x4*>(g + c0 + 256 * i); *reinterpret_cast<f32x4*>(dst + c0 + 256 * i) = xv[i] * rstd * gv; }
            continue;
        }
        const float* mv = modb + (size_t)modsel(layer, row) * 6144;
        float acc[16];
#pragma unroll
        for (int e = 0; e < 16; ++e) acc[e] = 0.f;
#pragma unroll
        for (int i = 0; i < 4; ++i) {
            const f32x4 gv = *reinterpret_cast<const f32x4*>(g + c0 + 256 * i), scv = *reinterpret_cast<const f32x4*>(mv + (sh_i + 1) * 1024 + c0 + 256 * i),
                        shv = *reinterpret_cast<const f32x4*>(mv + sh_i * 1024 + c0 + 256 * i);
            f32x4 h;
#pragma unroll
            for (int j = 0; j < 4; ++j) h[j] = xv[i][j] * rstd * gv[j] * (1.f + scv[j]) + shv[j];
            if (MODE == 2) {
                const float p0 = __shfl(h[0], (64 - lane) & 63), p1 = __shfl(h[3], 63 - lane), p2 = __shfl(h[2], 63 - lane), p3 = __shfl(h[1], 63 - lane), h128 = __shfl(h[0], 32);
                const float u0 = lane == 0 ? h[0] : h[0] + p0, v0 = lane == 0 ? h128 : h[0] - p0;
                if (lane < 32) {
                    u32x2 wu, wv; wu[0] = cvtpk(u0, h[1] + p1); wu[1] = cvtpk(h[2] + p2, h[3] + p3); wv[0] = cvtpk(v0, h[1] - p1); wv[1] = cvtpk(h[2] - p2, h[3] - p3);
                    *reinterpret_cast<u32x2*>((u16*)(p.ws + OFF_ACT) + (size_t)row * 512 + i * 128 + c0) = wu;
                    *reinterpret_cast<u32x2*>((u16*)(p.ws + OFF_ACT) + (size_t)NLAT * 512 + (size_t)row * 512 + i * 128 + c0) = wv;
                }
            } else {
                u32x2 w2; w2[0] = cvtpk(h[0], h[1]); w2[1] = cvtpk(h[2], h[3]);
                *reinterpret_cast<u32x2*>(act + (size_t)row * DM + c0 + 256 * i) = w2;
            }
            if (side) {
#pragma unroll
                for (int j = 0; j < 4; ++j) {
#pragma unroll
                    for (int eg = 0; eg < 4; ++eg) { const f32x4 w = sl[eg * 1024 + i * 256 + j * 64 + lane]; acc[eg * 4 + 0] = fmaf(h[j], w[0], acc[eg * 4 + 0]); acc[eg * 4 + 1] = fmaf(h[j], w[1], acc[eg * 4 + 1]);
                        acc[eg * 4 + 2] = fmaf(h[j], w[2], acc[eg * 4 + 2]); acc[eg * 4 + 3] = fmaf(h[j], w[3], acc[eg * 4 + 3]); }
                    if (j & 1) asm volatile("" ::: "memory");
                }
            }
        }
        if (side) {
            float r8[8], r4[4], r2[2], tot;
            { const bool up = lane & 32;
#pragma unroll
              for (int i = 0; i < 8; ++i) { const float snd = up ? acc[i] : acc[i + 8], kp = up ? acc[i + 8] : acc[i]; r8[i] = kp + __shfl_xor(snd, 32); } }
            { const bool up = lane & 16;
#pragma unroll
              for (int i = 0; i < 4; ++i) { const float snd = up ? r8[i] : r8[i + 4], kp = up ? r8[i + 4] : r8[i]; r4[i] = kp + __shfl_xor(snd, 16); } }
            { const bool up = lane & 8;
#pragma unroll
              for (int i = 0; i < 2; ++i) { const float snd = up ? r4[i] : r4[i + 2], kp = up ? r4[i + 2] : r4[i]; r2[i] = kp + __shfl_xor(snd, 8); } }
            { const bool up = lane & 4; const float snd = up ? r2[0] : r2[1], kp = up ? r2[1] : r2[0]; tot = kp + __shfl_xor(snd, 4); }
            tot += __shfl_xor(tot, 1); tot += __shfl_xor(tot, 2);
            if (MODE == 0) {
                if ((lane & 3) == 0) {
                    const int e = lane >> 2;
                    float v = tot + p.gate_b[e];
                    const int type = e >> 2;
                    if (type == 1 || type == 3) v = logsigmoidf_(v);
                    ((float*)(p.ws + OFF_GATES))[(size_t)row * 16 + e] = v;
                }
            } else {
#pragma unroll
                for (int e = 0; e < 16; ++e) { const float te = __uint_as_float(__builtin_amdgcn_readlane(__float_as_uint(tot), e << 2)); keep[e] = (lane == npend) ? te : keep[e]; }
                if (lane == npend) prow = row;
                ++npend;
            }
        }
    }
    if (MODE == 1 || MODE == 3) {
        {
            float aff[16], bi[16];
#pragma unroll
            for (int e = 0; e < 16; ++e) { aff[e] = sigmoidf_(keep[e]); bi[e] = aff[e] + p.router_b[e]; }
            int bg = 0, ba = 0, bb = 1; float bscore = -1e30f;
#pragma unroll
            for (int gq = 0; gq < 4; ++gq) {
                int ia = 0; float va = bi[gq * 4];
#pragma unroll
                for (int j = 1; j < 4; ++j) if (bi[gq * 4 + j] > va) { va = bi[gq * 4 + j]; ia = j; }
                int ib = -1; float vb = -1e30f;
#pragma unroll
                for (int j = 0; j < 4; ++j) if (j != ia && bi[gq * 4 + j] > vb) { vb = bi[gq * 4 + j]; ib = j; }
                const float sc = va + vb;
                if (sc > bscore) { bscore = sc; bg = gq; ba = ia; bb = ib; }
            }
            const int lo = ba < bb ? ba : bb, hi2 = ba < bb ? bb : ba;
            float alo = 0.f, ahi = 0.f;
#pragma unroll
            for (int e = 0; e < 16; ++e) { if (e == bg * 4 + lo) alo = aff[e]; if (e == bg * 4 + hi2) ahi = aff[e]; }
            const float inv = 1.f / (alo + ahi);
            const int pair = lo == 0 ? hi2 - 1 : (lo == 1 ? hi2 + 1 : 5);
            pcls = bg * 6 + pair; pwl = alo * inv; pwh = ahi * inv;
        }
        unsigned* lc = (unsigned*)(lds + 65536);
        __syncthreads();
        if (tid < 64) lc[tid] = 0u;
        __syncthreads();
        unsigned myrank = 0u;
        if (lane < npend) myrank = atomicAdd(&lc[pcls], 1u);
        __syncthreads();
        if (tid < 24) { unsigned* cnt = (unsigned*)(p.ws + OFF_CNT) + (DRY ? 2 : layer) * 32; const unsigned n = lc[tid]; lc[32 + tid] = n ? atomicAdd(&cnt[tid], n) : 0u; }
        __syncthreads();
        if (lane < npend) {
            ((int*)(p.ws + (DRY ? OFF_BIG : OFF_LIST)))[(size_t)pcls * NTOK + lc[32 + pcls] + myrank] = prow;
            ((float2*)(p.ws + (DRY ? OFF_BIG + (size_t)32 * NTOK * 4 : OFF_TOKW)))[prow] = make_float2(pwl, pwh);
        }
    }
}

using g8::f32x4v;
DEVI u32x4 pack8(const f32x4v& a, const f32x4v& b) { u32x4 w; w[0] = cvtpk(a[0], a[1]); w[1] = cvtpk(a[2], a[3]); w[2] = cvtpk(b[0], b[1]); w[3] = cvtpk(b[2], b[3]); return w; }

struct EpiInproj {
    static constexpr bool PERM = true;
    char* ws;
    DEVI void operator()(const f32x4v (&acc)[2][2][4][2], const g8::Unit& u, int wr, int wc, int fr, int fq) const {
        u16* dst; int ld, coff, kind;
        const int pn = u.pn;
        if (pn < 2)       { dst = (u16*)(ws + OFF_Q);    ld = 512;  coff = pn * 256;        kind = 1; }
        else if (pn < 4)  { dst = (u16*)(ws + OFF_K);    ld = 512;  coff = (pn - 2) * 256;  kind = 1; }
        else if (pn < 6)  { dst = (u16*)(ws + OFF_V);    ld = 512;  coff = (pn - 4) * 256;  kind = 0; }
        else if (pn < 10) { dst = (u16*)(ws + OFF_MLQK); ld = 1024; coff = (pn - 6) * 256;  kind = 0; }
        else if (pn < 12) { dst = (u16*)(ws + OFF_MLV);  ld = 512;  coff = (pn - 10) * 256; kind = 0; }
        else              { dst = (u16*)(ws + OFF_OG);   ld = 512;  coff = (pn - 12) * 256; kind = 2; }
        const int tb = u.pm % 65;
        const float2* tabR = (const float2*)(ws + OFF_ROPER); const float2* tabC = (const float2*)(ws + OFF_ROPEC);
#pragma unroll
        for (int ai = 0; ai < 2; ++ai)
#pragma unroll
            for (int m = 0; m < 4; ++m) {
                const int rl = ai * 128 + wr * 64 + m * 16 + fr;
                u16* rowp = dst + (size_t)(u.pm * 256 + rl) * ld + coff + wc * 32 + 8 * fq;
#pragma unroll
                for (int bj = 0; bj < 2; ++bj) {
                    f32x4v v0 = acc[ai][bj][m][0], v1 = acc[ai][bj][m][1];
                    if (kind == 1 && tb > 0) {
                        const int tl = (tb - 1) * 256 + rl;
                        const int p0 = ((wc * 32 + 8 * fq) & 63) >> 1;
                        const float* cs = (const float*)(p0 < 16 ? tabR + (tl >> 6) * 16 + p0 : tabC + (tl & 63) * 16 + (p0 - 16));
                        const f32x4v c01 = *reinterpret_cast<const f32x4v*>(cs), c23 = *reinterpret_cast<const f32x4v*>(cs + 4);
                        const f32x4v a = v0, b = v1;
                        v0[0] = a[0] * c01[0] - a[1] * c01[1]; v0[1] = a[0] * c01[1] + a[1] * c01[0];
                        v0[2] = a[2] * c01[2] - a[3] * c01[3]; v0[3] = a[2] * c01[3] + a[3] * c01[2];
                        v1[0] = b[0] * c23[0] - b[1] * c23[1]; v1[1] = b[0] * c23[1] + b[1] * c23[0];
                        v1[2] = b[2] * c23[2] - b[3] * c23[3]; v1[3] = b[2] * c23[3] + b[3] * c23[2];
                    } else if (kind == 2) {
#pragma unroll
                        for (int j = 0; j < 4; ++j) { v0[j] = sigmoidf_(v0[j]); v1[j] = sigmoidf_(v1[j]); }
                    }
                    *reinterpret_cast<u32x4*>(rowp + bj * 128) = pack8(v0, v1);
                }
            }
    }
};
DEVI void phase_inproj(const P& p, char* lds) {
    __syncthreads();
    g8::DenseSched S{p.ws + OFF_WINT, NTOK / 256, 14, (int)gridDim.x, (int)blockIdx.x, (size_t)256 * 2048};
    EpiInproj E{p.ws};
    g8::gemm_phase((LAS unsigned char*)lds, p.ws + OFF_ACT, 2048, 16, S, E);
}

struct EpiOutproj {
    static constexpr bool PERM = true;
    const float* xin_lat; const float* xin_ctx; u16* xs; const float* modb;
    DEVI void operator()(const f32x4v (&acc)[2][2][4][2], const g8::Unit& u, int wr, int wc, int fr, int fq) const {
        const int b = u.pm / 65, tb = u.pm % 65;
        const float* xi = tb == 0 ? xin_ctx + (size_t)(b * TC) * DM : xin_lat + (size_t)(b * TL + (tb - 1) * 256) * DM;
        u16* xo = xs + (size_t)(u.pm * 256) * DM;
        const float* gate = modb + (size_t)(tb == 0 ? 2 : b) * 6144 + 2 * 1024;
        const int col0 = u.pn * 256 + wc * 32 + 8 * fq;
        f32x4v gv[2][2];
#pragma unroll
        for (int bj = 0; bj < 2; ++bj)
#pragma unroll
            for (int n = 0; n < 2; ++n) gv[bj][n] = *reinterpret_cast<const f32x4v*>(gate + col0 + bj * 128 + n * 4);
#pragma unroll
        for (int ai = 0; ai < 2; ++ai) {
            f32x4v xv[4][2][2];
#pragma unroll
            for (int m = 0; m < 4; ++m) { const size_t ro = (size_t)(ai * 128 + wr * 64 + m * 16 + fr) * DM + col0;
#pragma unroll
                for (int bj = 0; bj < 2; ++bj)
#pragma unroll
                    for (int n = 0; n < 2; ++n) xv[m][bj][n] = *reinterpret_cast<const f32x4v*>(xi + ro + bj * 128 + n * 4); }
#pragma unroll
            for (int m = 0; m < 4; ++m) { const size_t ro = (size_t)(ai * 128 + wr * 64 + m * 16 + fr) * DM + col0;
#pragma unroll
                for (int bj = 0; bj < 2; ++bj)
                    *reinterpret_cast<u32x4*>(xo + ro + bj * 128) = pack8(xv[m][bj][0] + gv[bj][0] * acc[ai][bj][m][0], xv[m][bj][1] + gv[bj][1] * acc[ai][bj][m][1]); }
        }
    }
};
DEVI void phase_outproj(const P& p, char* lds) {
    __syncthreads();
    g8::DenseSched S{p.ws + OFF_WOUTT, NTOK / 256, 4, (int)gridDim.x, (int)blockIdx.x, (size_t)256 * 2048};
    EpiOutproj E{p.x, p.ctx, (u16*)(p.ws + OFF_MLC), (const float*)(p.ws + OFF_MOD)};
    g8::gemm_phase((LAS unsigned char*)lds, p.ws + OFF_ACT, 2048, 16, S, E);
}

DEVI int moe_table(const P& p, int layer, int* tb) {
    __syncthreads();
    if (threadIdx.x == 0) {
        const unsigned* cnt = (const unsigned*)(p.ws + OFF_CNT) + layer * 32; int o = 0;
        for (int c = 0; c < 24; ++c) { tb[c] = o; tb[32 + c] = (int)cnt[c]; o += ((int)cnt[c] + 255) >> 8; }
        tb[24] = o;
    }
    __syncthreads();
    return tb[24];
}
DEVI void cls_experts(int cls, int& elo, int& ehi) {
    const int g = cls / 6, pr = cls % 6;
    const int lo = pr < 3 ? 0 : (pr < 5 ? 1 : 2); const int hi = pr < 3 ? pr + 1 : (pr < 5 ? pr - 1 : 3);
    elo = g * 4 + lo; ehi = g * 4 + hi;
}
DEVI void moe_unit(const int* tb, int rt, g8::Unit& u) {
    int cls = 0; while (cls < 23 && tb[cls + 1] <= rt) ++cls;
    u.cls = cls; u.r0 = (rt - tb[cls]) * 256; u.ncls = tb[32 + cls];
}

struct MoeUpSched {
    static constexpr bool GATHER = true;
    DEVI const char* abase(const g8::Unit&, const char* a) const { return a; }
    const int* tb; int T, G, c; const int* list; const char* Wgu;
    DEVI bool next(int i, g8::Unit& u) const {
        if (!g8::tile_order(i, G, c, T, 8, u.pm, u.pn)) return false;
        moe_unit(tb, u.pm, u); int elo, ehi; cls_experts(u.cls, elo, ehi);
        const int e = u.pn < 4 ? elo : ehi;
        u.B0 = u.B1 = Wgu + ((size_t)e * 1024 + (size_t)(u.pn & 3) * 256) * 2048; return true;
    }
    DEVI void aoffs(const g8::Unit& u, unsigned (&v)[2][2]) const {
        const int* lst = list + (size_t)u.cls * NTOK + u.r0;
#pragma unroll
        for (int i = 0; i < 2; ++i) { int R, C; g8::lane_rc(i, R, C);
#pragma unroll
            for (int h = 0; h < 2; ++h) { const int rr = h * 128 + R; const int tok = lst[(u.r0 + rr < u.ncls) ? rr : 0]; v[h][i] = (unsigned)((tok * 1024 + C) * 2); } }
    }
};
struct EpiMoeUp {
    static constexpr bool PERM = true;
    const int* list; const float2* tokw; u16* HE;
    DEVI void operator()(const f32x4v (&acc)[2][2][4][2], const g8::Unit& u, int wr, int wc, int fr, int fq) const {
        const int* lst = list + (size_t)u.cls * NTOK + u.r0;
        const int s = u.pn >> 2;
        float wv[2][4];
        { int tk[2][4];
#pragma unroll
          for (int ai = 0; ai < 2; ++ai)
#pragma unroll
              for (int m = 0; m < 4; ++m) { const int rl = ai * 128 + wr * 64 + m * 16 + fr; tk[ai][m] = lst[(u.r0 + rl < u.ncls) ? rl : 0]; }
#pragma unroll
          for (int ai = 0; ai < 2; ++ai)
#pragma unroll
              for (int m = 0; m < 4; ++m) { const float2 w2 = tokw[tk[ai][m]]; wv[ai][m] = s ? w2.y : w2.x; } }
#pragma unroll
        for (int ai = 0; ai < 2; ++ai)
#pragma unroll
            for (int m = 0; m < 4; ++m) {
                const int rl = ai * 128 + wr * 64 + m * 16 + fr;
                if (u.r0 + rl < u.ncls) {
                    const float w = wv[ai][m];
                    u16* rowp = HE + (size_t)(u.pm * 256 + rl) * 1024 + s * 512 + (u.pn & 3) * 128 + wc * 16 + 4 * fq;
#pragma unroll
                    for (int bj = 0; bj < 2; ++bj) {
                        const f32x4v g = acc[ai][bj][m][0], up = acc[ai][bj][m][1];
                        u32x2 o; o[0] = cvtpk(siluf_(g[0]) * up[0] * w, siluf_(g[1]) * up[1] * w); o[1] = cvtpk(siluf_(g[2]) * up[2] * w, siluf_(g[3]) * up[3] * w);
                        *reinterpret_cast<u32x2*>(rowp + bj * 64) = o;
                    }
                }
            }
    }
};
DEVI void phase_moe_up(const P& p, int layer, char* lds) {
    int* tb = (int*)(lds + g8::STAGE_BYTES);
    const int T = moe_table(p, layer, tb);
    MoeUpSched S{tb, T, (int)gridDim.x, (int)blockIdx.x, (const int*)(p.ws + OFF_LIST), p.ws + (layer ? OFF_WGU1 : OFF_WGU)};
    EpiMoeUp E{(const int*)(p.ws + OFF_LIST), (const float2*)(p.ws + OFF_TOKW), (u16*)(p.ws + OFF_HE)};
    g8::gemm_phase((LAS unsigned char*)lds, p.ws + OFF_ACT, 2048, 16, S, E);
}

struct MoeDownSched {
    static constexpr bool GATHER = false;
    DEVI const char* abase(const g8::Unit&, const char* a) const { return a; }
    const int* tb; int T, G, c; const char* WdT;
    DEVI bool next(int i, g8::Unit& u) const {
        if (!g8::tile_order(i, G, c, T, 4, u.pm, u.pn)) return false;
        moe_unit(tb, u.pm, u); int elo, ehi; cls_experts(u.cls, elo, ehi);
        u.B0 = WdT + ((size_t)elo * 1024 + (size_t)u.pn * 256) * 1024;
        u.B1 = WdT + ((size_t)ehi * 1024 + (size_t)u.pn * 256) * 1024 - (size_t)8 * 128; return true;
    }
    DEVI void aoffs(const g8::Unit& u, unsigned (&v)[2][2]) const {
#pragma unroll
        for (int i = 0; i < 2; ++i) { int R, C; g8::lane_rc(i, R, C);
#pragma unroll
            for (int h = 0; h < 2; ++h) v[h][i] = (unsigned)(((u.pm * 256 + h * 128 + R) * 1024 + C) * 2); }
    }
};
template <bool DRY>
struct EpiMoeDown {
    static constexpr bool PERM = true;
    const P* pp; int layer; const int* list; const float* modb;
    DEVI void operator()(const f32x4v (&acc)[2][2][4][2], const g8::Unit& u, int wr, int wc, int fr, int fq) const {
        const P& p = *pp;
        const int* lst = list + (size_t)u.cls * NTOK + u.r0;
        const int col0 = u.pn * 256 + wc * 32 + 8 * fq;
        int tk[2][4];
#pragma unroll
        for (int ai = 0; ai < 2; ++ai)
#pragma unroll
            for (int m = 0; m < 4; ++m) { const int rl = ai * 128 + wr * 64 + m * 16 + fr; tk[ai][m] = (u.r0 + rl < u.ncls) ? lst[rl] : -1; }
#pragma unroll
        for (int ai = 0; ai < 2; ++ai)
#pragma unroll
        for (int mh = 0; mh < 2; ++mh) {
            u32x4 xw[2][2]; f32x4v gv[2][2][2];
#pragma unroll
            for (int mm = 0; mm < 2; ++mm) { const int m = mh * 2 + mm; const int tok = tk[ai][m] < 0 ? lst[0] : tk[ai][m];
                const float* gate = modb + (size_t)modsel(layer, tok) * 6144 + 5 * 1024 + col0; const u16* xo = xs_ptr(p, layer, tok) + col0;
#pragma unroll
                for (int bj = 0; bj < 2; ++bj) { xw[mm][bj] = *reinterpret_cast<const u32x4*>(xo + bj * 128);
#pragma unroll
                    for (int n = 0; n < 2; ++n) gv[mm][bj][n] = *reinterpret_cast<const f32x4v*>(gate + bj * 128 + n * 4); } }
#pragma unroll
            for (int mm = 0; mm < 2; ++mm) { const int m = mh * 2 + mm; if (tk[ai][m] >= 0) { const int tok = tk[ai][m];
                u16* xd = DRY ? (u16*)(p.ws + OFF_MLQK) + (size_t)(tok & 8191) * 1024 + col0 : xs_ptr(p, layer, tok) + col0;
#pragma unroll
                for (int bj = 0; bj < 2; ++bj) {
                    f32x4v x0, x1; x0[0] = bflo(xw[mm][bj][0]); x0[1] = bfhi(xw[mm][bj][0]); x0[2] = bflo(xw[mm][bj][1]); x0[3] = bfhi(xw[mm][bj][1]);
                    x1[0] = bflo(xw[mm][bj][2]); x1[1] = bfhi(xw[mm][bj][2]); x1[2] = bflo(xw[mm][bj][3]); x1[3] = bfhi(xw[mm][bj][3]);
                    *reinterpret_cast<u32x4*>(xd + bj * 128) = pack8(x0 + gv[mm][bj][0] * acc[ai][bj][m][0], x1 + gv[mm][bj][1] * acc[ai][bj][m][1]); } } }
        }
    }
};
template <bool DRY = false>
DEVI void phase_moe_down(const P& p, int layer, char* lds) {
    int* tb = (int*)(lds + g8::STAGE_BYTES);
    const int T = moe_table(p, layer, tb);
    MoeDownSched S{tb, T, (int)gridDim.x, (int)blockIdx.x, p.ws + (layer ? OFF_WDT1 : OFF_WDT)};
    EpiMoeDown<DRY> E{&p, layer, (const int*)(p.ws + OFF_LIST), (const float*)(p.ws + OFF_MOD) + (size_t)layer * 3 * 6144};
    g8::gemm_phase((LAS unsigned char*)lds, p.ws + OFF_HE, 1024, 8, S, E);
}

constexpr size_t OFF_FU = OFF_ACT, OFF_FV = OFF_ACT + (size_t)NLAT * 512 * 2;
constexpr size_t OFF_FAH = OFF_FNT, OFF_FBH = OFF_FNT + (size_t)1024 * 512 * 2, OFF_FA128 = OFF_FNT + (size_t)2 * 1024 * 512 * 2;
struct FnetSched {
    static constexpr bool GATHER = false;
    const char* ws; int G, c;
    DEVI const char* abase(const g8::Unit& u, const char*) const { return ws + (u.pn < 4 ? OFF_FU : OFF_FV); }
    DEVI bool next(int i, g8::Unit& u) const {
        if (!g8::tile_order(i, G, c, NLAT / 256, 8, u.pm, u.pn)) return false;
        u.B0 = u.B1 = ws + (u.pn < 4 ? OFF_FAH : OFF_FBH) + (size_t)(u.pn & 3) * 256 * 1024; u.cls = 0; u.r0 = 0; u.ncls = 0; return true;
    }
    DEVI void aoffs(const g8::Unit&, unsigned (&)[2][2]) const {}
};
struct EpiFnet {
    static constexpr bool PERM = true;
    char* ws;
    DEVI void operator()(const f32x4v (&acc)[2][2][4][2], const g8::Unit& u, int wr, int wc, int fr, int fq) const {
        const int colt = (u.pn & 3) * 256 + wc * 32 + 8 * fq;
        u16* dst = (u16*)(ws + (u.pn < 4 ? OFF_ZR : OFF_ZI)) + colt;
        const u16* V = (const u16*)(ws + OFF_FV); const float* A128 = (const float*)(ws + OFF_FA128);
#pragma unroll
        for (int bj = 0; bj < 2; ++bj) {
            f32x4v a128[4][2];
            if (u.pn < 4) {
#pragma unroll
                for (int g = 0; g < 4; ++g) { a128[g][0] = *reinterpret_cast<const f32x4v*>(A128 + g * 1024 + colt + bj * 128); a128[g][1] = *reinterpret_cast<const f32x4v*>(A128 + g * 1024 + colt + bj * 128 + 4); }
            }
#pragma unroll
            for (int ai = 0; ai < 2; ++ai)
#pragma unroll
                for (int m = 0; m < 4; ++m) {
                    const size_t row = (size_t)(u.pm * 256 + ai * 128 + wr * 64 + m * 16 + fr);
                    f32x4v v0 = acc[ai][bj][m][0], v1 = acc[ai][bj][m][1];
                    if (u.pn < 4) {
#pragma unroll
                        for (int g = 0; g < 4; ++g) { const float hv = bf2f(V[row * 512 + g * 128]); v0 += a128[g][0] * hv; v1 += a128[g][1] * hv; }
                    }
                    *reinterpret_cast<u32x4*>(dst + row * 1024 + bj * 128) = pack8(v0, v1);
                }
        }
    }
};
DEVI void phase_fnet_gemm(const P& p, char* lds) {
    __syncthreads();
    FnetSched S{p.ws, (int)gridDim.x, (int)blockIdx.x};
    EpiFnet E{p.ws};
    g8::gemm_phase<EpiFnet, FnetSched, 8, 1024>((LAS unsigned char*)lds, p.ws, 1024, 8, S, E);
}

template <class RP>
DEVI void stage_tr128_load(RP rp, u32x4 (&v)[4]) {
    const int tid = threadIdx.x;
#pragma unroll
    for (int i = 0; i < 4; ++i) { const int idx = tid + 512 * i, k = idx >> 4, c = (idx & 15) * 8; v[i] = *reinterpret_cast<const u32x4*>(rp(k) + c); }
}
DEVI void stage_tr128_write(const u32x4 (&v)[4], char* img) {
    const int tid = threadIdx.x;
#pragma unroll
    for (int i = 0; i < 4; ++i) { const int idx = tid + 512 * i, k = idx >> 4, c = (idx & 15) * 8; *reinterpret_cast<u32x4*>(img + (k >> 6) * 16384 + v_st(k & 63, c)) = v[i]; }
}
DEVI void load_dft(const P& p, char* lds) {
    const int tid = threadIdx.x;
    for (int i = tid; i < 4096; i += NTHR) {
        const int m = i >> 11, j = i & 2047, row = j >> 4, ch = j & 15;
        const u32x4 v = *reinterpret_cast<const u32x4*>((const u16*)(p.ws + (m ? OFF_DFTS : OFF_DFTC)) + row * 128 + ch * 8);
        *reinterpret_cast<u32x4*>(lds + m * 34816 + swz256(row, ch)) = v;
    }
}
DEVI bf16x8 negbf(bf16x8 v) { u32x4 w = *reinterpret_cast<u32x4*>(&v); w[0] ^= 0x80008000u; w[1] ^= 0x80008000u; w[2] ^= 0x80008000u; w[3] ^= 0x80008000u; return *reinterpret_cast<bf16x8*>(&w); }

template <int KS, int WN, int MODE>
DEVI void fft_kstep(int vbr, int vbi, const bf16x8& aC, const bf16x8& aS, f32x16 (&yr)[2], f32x16 (&yi)[2]) {
    s16x4 rl0, rh0, rl1, rh1, il0, ih0, il1, ih1;
    tr_frag_issue<2 * WN, KS>(vbr, rl0, rh0); tr_frag_issue<2 * WN + 1, KS>(vbr, rl1, rh1);
    tr_frag_issue<2 * WN, KS>(vbi, il0, ih0); tr_frag_issue<2 * WN + 1, KS>(vbi, il1, ih1);
    LGKM0();
    const bf16x8 xr0 = PKLH(rl0, rh0), xr1 = PKLH(rl1, rh1), xi0 = PKLH(il0, ih0), xi1 = PKLH(il1, ih1);
    yr[0] = __builtin_amdgcn_mfma_f32_32x32x16_bf16(xr0, aC, yr[0], 0, 0, 0);
    yr[1] = __builtin_amdgcn_mfma_f32_32x32x16_bf16(xr1, aC, yr[1], 0, 0, 0);
    yr[0] = __builtin_amdgcn_mfma_f32_32x32x16_bf16(xi0, aS, yr[0], 0, 0, 0);
    yr[1] = __builtin_amdgcn_mfma_f32_32x32x16_bf16(xi1, aS, yr[1], 0, 0, 0);
    if (MODE == 0) {
        yi[0] = __builtin_amdgcn_mfma_f32_32x32x16_bf16(xi0, aC, yi[0], 0, 0, 0);
        yi[1] = __builtin_amdgcn_mfma_f32_32x32x16_bf16(xi1, aC, yi[1], 0, 0, 0);
        yi[0] = __builtin_amdgcn_mfma_f32_32x32x16_bf16(negbf(xr0), aS, yi[0], 0, 0, 0);
        yi[1] = __builtin_amdgcn_mfma_f32_32x32x16_bf16(negbf(xr1), aS, yi[1], 0, 0, 0);
    }
}
template <int WN, int MODE>
DEVI void fft_core(const char* lds, int xr_img, int xi_img, int wm, int lane, f32x16 (&yr)[2], f32x16 (&yi)[2]) {
    const int r32 = lane & 31, hi = lane >> 5;
    const char* Cm = lds; const char* Sm = lds + 34816;
    const int row = wm * 32 + r32;
    const int vb0 = xr_img + v_rd_base(lane), vb1 = xi_img + v_rd_base(lane);
#define KSTEP(H, KS) do { const int kk = (H) * 4 + (KS); \
        const bf16x8 aC = lds_b128(Cm, swz256(row, 2 * kk + hi)), aS = lds_b128(Sm, swz256(row, 2 * kk + hi)); \
        fft_kstep<KS, WN, MODE>(vb0 + (H) * 16384, vb1 + (H) * 16384, aC, aS, yr, yi); } while (0)
    KSTEP(0, 0); KSTEP(0, 1); KSTEP(0, 2); KSTEP(0, 3); KSTEP(1, 0); KSTEP(1, 1); KSTEP(1, 2); KSTEP(1, 3);
#undef KSTEP
}

DEVI void phase_fft1(const P& p, char* lds) {
    const int tid = threadIdx.x, lane = tid & 63, wid = __builtin_amdgcn_readfirstlane(tid >> 6), wm = wid >> 1, wn = wid & 1, r32 = lane & 31, hi = lane >> 5;
    load_dft(p, lds);
    char* imgR = lds + 69632; char* imgI = lds + 102400;
    const u16* Zr = (const u16*)(p.ws + OFF_ZR); const u16* Zi = (const u16*)(p.ws + OFF_ZI);
    u16* Yr = (u16*)(p.ws + OFF_YR); u16* Yi = (u16*)(p.ws + OFF_YI);
    const float2* TW = (const float2*)(p.ws + OFF_TW);
    u32x4 pr[4], pi[4];
#define FFT1_LOAD(U) do { const int cb_ = (U) & 7, t2_ = ((U) >> 3) & 127, b_ = (U) >> 10; \
        stage_tr128_load([&](int k) { return Zr + (size_t)(b_ * TL + 128 * k + t2_) * 1024 + cb_ * 128; }, pr); \
        stage_tr128_load([&](int k) { return Zi + (size_t)(b_ * TL + 128 * k + t2_) * 1024 + cb_ * 128; }, pi); } while (0)
    if ((int)blockIdx.x < NB * 128 * 8) FFT1_LOAD((int)blockIdx.x);
    for (int u = blockIdx.x; u < NB * 128 * 8; u += gridDim.x) {
        const int cb = u & 7, t2 = (u >> 3) & 127, b = u >> 10;
        __syncthreads();
        stage_tr128_write(pr, imgR); stage_tr128_write(pi, imgI);
        __syncthreads();
        if (u + (int)gridDim.x < NB * 128 * 8) FFT1_LOAD(u + (int)gridDim.x);
        f32x16 yr[2] = {}, yi[2] = {};
        const int xr_img = (int)(uintptr_t)imgR, xi_img = (int)(uintptr_t)imgI;
        if (wn == 0) fft_core<0, 0>(lds, xr_img, xi_img, wm, lane, yr, yi); else fft_core<1, 0>(lds, xr_img, xi_img, wm, lane, yr, yi);
        __syncthreads();
        {
            const int k1 = wm * 32 + r32;
            const float2 w = TW[t2 * k1];
            char* oR = imgR + k1 * 272; char* oI = imgR + 34816 + k1 * 272;
#pragma unroll
            for (int ni = 0; ni < 2; ++ni)
#pragma unroll
                for (int g = 0; g < 4; ++g) {
                    const int cbase = wn * 64 + ni * 32 + 8 * g + 4 * hi;
                    float re[4], im[4];
#pragma unroll
                    for (int j = 0; j < 4; ++j) { const float a = yr[ni][4 * g + j], bq = yi[ni][4 * g + j]; re[j] = a * w.x + bq * w.y; im[j] = bq * w.x - a * w.y; }
                    u32x2 pr, pi; pr[0] = cvtpk(re[0], re[1]); pr[1] = cvtpk(re[2], re[3]); pi[0] = cvtpk(im[0], im[1]); pi[1] = cvtpk(im[2], im[3]);
                    *reinterpret_cast<u32x2*>(oR + cbase * 2) = pr; *reinterpret_cast<u32x2*>(oI + cbase * 2) = pi;
                }
        }
        __syncthreads();
#pragma unroll
        for (int i = 0; i < 8; ++i) {
            const int idx = tid + 512 * i, pl = idx >> 11, j = idx & 2047, row = j >> 4, ch = j & 15;
            const u32x4 v = *reinterpret_cast<const u32x4*>(imgR + pl * 34816 + row * 272 + ch * 16);
            *reinterpret_cast<u32x4*>((pl ? Yi : Yr) + ((size_t)(b * 128 + row) * 128 + t2) * 1024 + cb * 128 + ch * 8) = v;
        }
    }
}
template <bool DRY = false>
DEVI void phase_fft2(const P& p, char* lds) {
    const int tid = threadIdx.x, lane = tid & 63, wid = __builtin_amdgcn_readfirstlane(tid >> 6), wm = wid >> 1, wn = wid & 1, r32 = lane & 31, hi = lane >> 5;
    load_dft(p, lds);
    char* imgR = lds + 69632; char* imgI = lds + 102400;
    const u16* Yr = (const u16*)(p.ws + OFF_YR); const u16* Yi = (const u16*)(p.ws + OFF_YI);
    const float* modb = (const float*)(p.ws + OFF_MOD) + (size_t)3 * 6144;
    u32x4 pr[4], pi[4];
#define FFT2_LOAD(U) do { const int cb_ = (U) & 7, k1_ = ((U) >> 3) & 127, b_ = (U) >> 10; \
        stage_tr128_load([&](int k) { return Yr + ((size_t)(b_ * 128 + k1_) * 128 + k) * 1024 + cb_ * 128; }, pr); \
        stage_tr128_load([&](int k) { return Yi + ((size_t)(b_ * 128 + k1_) * 128 + k) * 1024 + cb_ * 128; }, pi); } while (0)
    if ((int)blockIdx.x < NB * 128 * 8) FFT2_LOAD((int)blockIdx.x);
    for (int u = blockIdx.x; u < NB * 128 * 8; u += gridDim.x) {
        const int cb = u & 7, k1 = (u >> 3) & 127, b = u >> 10;
        __syncthreads();
        stage_tr128_write(pr, imgR); stage_tr128_write(pi, imgI);
        __syncthreads();
        if (u + (int)gridDim.x < NB * 128 * 8) FFT2_LOAD(u + (int)gridDim.x);
        f32x16 yr[2] = {}, yi[2] = {};
        const int xr_img = (int)(uintptr_t)imgR, xi_img = (int)(uintptr_t)imgI;
        if (wn == 0) fft_core<0, 1>(lds, xr_img, xi_img, wm, lane, yr, yi); else fft_core<1, 1>(lds, xr_img, xi_img, wm, lane, yr, yi);
        __syncthreads();
        {
            char* oR = imgR + (wm * 32 + r32) * 528;
#pragma unroll
            for (int ni = 0; ni < 2; ++ni)
#pragma unroll
                for (int g = 0; g < 4; ++g) {
                    const int cbase = wn * 64 + ni * 32 + 8 * g + 4 * hi;
                    f32x4 v; v[0] = yr[ni][4 * g]; v[1] = yr[ni][4 * g + 1]; v[2] = yr[ni][4 * g + 2]; v[3] = yr[ni][4 * g + 3];
                    *reinterpret_cast<f32x4*>(oR + cbase * 4) = v;
                }
        }
        __syncthreads();
        const float* gate = modb + (size_t)b * 6144 + 2 * 1024 + cb * 128;
#pragma unroll
        for (int i = 0; i < 4; ++i) {
            const int idx = tid + 512 * i, row = idx >> 4, ch = idx & 15;
            const f32x4 v0 = *reinterpret_cast<const f32x4*>(imgR + row * 528 + ch * 32), v1 = *reinterpret_cast<const f32x4*>(imgR + row * 528 + ch * 32 + 16);
            const f32x4 g0 = *reinterpret_cast<const f32x4*>(gate + ch * 8), g1 = *reinterpret_cast<const f32x4*>(gate + ch * 8 + 4);
            u16* xo = xs_ptr(p, 1, b * TL + k1 + 128 * row) + cb * 128 + ch * 8;
            u16* xd = DRY ? (u16*)(p.ws + OFF_ZR) + (size_t)(b * TL + k1 + 128 * row) * 1024 + cb * 128 + ch * 8 : xo;
            const u32x4 xw = *reinterpret_cast<const u32x4*>(xo);
            f32x4 x0, x1; x0[0] = bflo(xw[0]); x0[1] = bfhi(xw[0]); x0[2] = bflo(xw[1]); x0[3] = bfhi(xw[1]); x1[0] = bflo(xw[2]); x1[1] = bfhi(xw[2]); x1[2] = bflo(xw[3]); x1[3] = bfhi(xw[3]);
            const f32x4 r0 = x0 + g0 * v0, r1 = x1 + g1 * v1;
            u32x4 w; w[0] = cvtpk(r0[0], r0[1]); w[1] = cvtpk(r0[2], r0[3]); w[2] = cvtpk(r1[0], r1[1]); w[3] = cvtpk(r1[2], r1[3]);
            *reinterpret_cast<u32x4*>(xd) = w;
        }
    }
}

constexpr int AT_V = 16384, AT_K = 17408;
template <int HF, int DB>
DEVI void attn_half(const char* Ks, const bf16x8 (&qr)[8], float& m_reg, float& l_reg, f32x16 (&o)[4], int vb, float* al, int r32, int hi) {
    constexpr float SC = 0.125f, C = SC * 1.4426950408889634f, THR = 8.f;
    f32x16 pp = {};
#pragma unroll
    for (int d0 = 0; d0 < 4; ++d0) pp = __builtin_amdgcn_mfma_f32_32x32x16_bf16(lds_b128(Ks, swz256(HF * 32 + r32, 2 * (DB + d0) + hi)), qr[DB + d0], pp, 0, 0, 0);
    float pmax = pp[0];
#pragma unroll
    for (int r = 1; r < 16; ++r) pmax = fmaxf(pmax, pp[r]);
    { auto rr = __builtin_amdgcn_permlane32_swap(__float_as_uint(pmax), __float_as_uint(pmax), false, false);
      pmax = fmaxf(__uint_as_float(rr[0]), __uint_as_float(rr[1])); }
    float alpha = 1.f;
    if (!__all(pmax - m_reg <= THR / SC)) {
        const float mn = fmaxf(m_reg, pmax); alpha = __builtin_amdgcn_exp2f((m_reg - mn) * C); m_reg = mn;
        if (hi == 0) al[r32] = alpha;
        asm volatile("s_waitcnt lgkmcnt(0)" ::: "memory");
#pragma unroll
        for (int d = 0; d < 4; ++d)
#pragma unroll
            for (int r = 0; r < 16; ++r) o[d][r] *= al[crow(r, hi)];
    }
    const float mnC = -m_reg * C;
    float ps = 0.f;
#pragma unroll
    for (int r = 0; r < 16; ++r) { pp[r] = __builtin_amdgcn_exp2f(fmaf(pp[r], C, mnC)); ps += pp[r]; }
    { auto rr = __builtin_amdgcn_permlane32_swap(__float_as_uint(ps), __float_as_uint(ps), false, false);
      ps = __uint_as_float(rr[0]) + __uint_as_float(rr[1]); }
    l_reg = l_reg * alpha + ps;
    bf16x8 pa0, pa1;
    pack_p(pp, pa0, pa1);
#define PVD(D0) do { s16x4 l0, h0, l1, h1; tr_frag_issue<D0, 2 * HF>(vb, l0, h0); tr_frag_issue<D0, 2 * HF + 1>(vb, l1, h1); LGKM0(); \
        o[D0] = __builtin_amdgcn_mfma_f32_32x32x16_bf16(pa0, PKLH(l0, h0), o[D0], 0, 0, 0); \
        o[D0] = __builtin_amdgcn_mfma_f32_32x32x16_bf16(pa1, PKLH(l1, h1), o[D0], 0, 0, 0); } while (0)
    PVD(0); PVD(1); PVD(2); PVD(3);
#undef PVD
}

DEVI void diffattn_item(const P& p, int q0, int k0row, int seq, int h, char* lds) {
    int tid = threadIdx.x; asm volatile("" : "+v"(tid));
    const int wid = tid >> 6, lane = tid & 63, r32 = lane & 31, hi = lane >> 5;
    const u16* Q = (const u16*)(p.ws + OFF_Q); const u16* Kg = (const u16*)(p.ws + OFF_K) + (size_t)k0row * 512 + h * 128;
    const u16* Vg = (const u16*)(p.ws + OFF_V) + (size_t)k0row * 512 + h * 128;
    char* V_lds = lds; char* K_lds = lds + 2 * AT_V;
    float* al = (float*)(lds + 2 * AT_V + 2 * AT_K) + wid * 64;
    bf16x8 qr[8];
    { const u16* Qw = Q + (size_t)(q0 + wid * 32 + r32) * 512 + h * 128 + hi * 8;
#pragma unroll
      for (int d0 = 0; d0 < 8; ++d0) qr[d0] = *reinterpret_cast<const bf16x8*>(Qw + d0 * 16); }
    const int sr = tid >> 4, sc = (tid & 15) * 8;
    const int vb0 = (int)(uintptr_t)V_lds + v_rd_base(lane);
    const int vc = ((tid >> 5) & 3) * 32 + (tid & 3) * 8;
    const int kk0 = (tid >> 7) * 8 + ((tid & 31) >> 2), kk1 = kk0 + 32;
    const int vk0 = (kk0 & ~0xC) | ((kk0 & 4) << 1) | ((kk0 & 8) >> 1), vk1 = (kk1 & ~0xC) | ((kk1 & 4) << 1) | ((kk1 & 8) >> 1);
    u32x4 sk0, sk1;
#define SLOAD(kk, b) do { \
    __builtin_amdgcn_global_load_lds((const unsigned*)(Vg + (size_t)((kk) + vk0) * 512 + vc), (LAS unsigned*)(V_lds + (b) * AT_V + tid * 16), 16, 0, 0); \
    __builtin_amdgcn_global_load_lds((const unsigned*)(Vg + (size_t)((kk) + vk1) * 512 + vc), (LAS unsigned*)(V_lds + (b) * AT_V + 8192 + tid * 16), 16, 0, 0); \
    sk0 = *reinterpret_cast<const u32x4*>(Kg + (size_t)((kk) + sr) * 512 + sc); sk1 = *reinterpret_cast<const u32x4*>(Kg + (size_t)((kk) + 32 + sr) * 512 + sc); } while (0)
#define SWRITE(b) do { *reinterpret_cast<u32x4*>(K_lds + (b) * AT_K + swz256(sr, tid & 15)) = sk0; *reinterpret_cast<u32x4*>(K_lds + (b) * AT_K + swz256(32 + sr, tid & 15)) = sk1; } while (0)
    float m0 = -1e30f, m1 = -1e30f, l0 = 0.f, l1 = 0.f;
    f32x16 o0[4] = {}, o1[4] = {};
    const int NT = seq / 64;
    __syncthreads();
    SLOAD(0, 0); SWRITE(0); asm volatile("s_waitcnt vmcnt(0)" ::: "memory"); __syncthreads();
    if (NT > 1) SLOAD(64, 1);
    for (int j = 0; j < NT; ++j) {
        const int cur = j & 1;
        const char* Ks = K_lds + cur * AT_K;
        attn_half<0, 0>(Ks, qr, m0, l0, o0, vb0 + cur * AT_V, al, r32, hi);
        attn_half<1, 0>(Ks, qr, m0, l0, o0, vb0 + cur * AT_V, al, r32, hi);
        attn_half<0, 4>(Ks, qr, m1, l1, o1, vb0 + cur * AT_V, al, r32, hi);
        attn_half<1, 4>(Ks, qr, m1, l1, o1, vb0 + cur * AT_V, al, r32, hi);
        if (j + 1 < NT) SWRITE(cur ^ 1);
        asm volatile("s_waitcnt vmcnt(0)" ::: "memory");
        __syncthreads();
        if (j + 2 < NT) SLOAD((j + 2) * 64, cur);
    }
#undef SLOAD
#undef SWRITE
    int tz = threadIdx.x; asm volatile("" : "+v"(tz));
    const int wid2 = tz >> 6, lane2 = tz & 63, r32e = lane2 & 31, hie = lane2 >> 5;
    const float lam = ((const float*)(p.ws + OFF_LAM))[0];
    float* sc0 = (float*)(lds + 2 * AT_V + 2 * AT_K) + wid2 * 64; float* sc1 = sc0 + 32;
    if (hie == 0) { sc0[r32e] = 1.f / l0; sc1[r32e] = -lam / l1; }
    asm volatile("s_waitcnt lgkmcnt(0)" ::: "memory");
    float ssq[16];
#pragma unroll
    for (int r = 0; r < 16; ++r) {
        const float a = sc0[crow(r, hie)], b = sc1[crow(r, hie)]; float s = 0.f;
#pragma unroll
        for (int d = 0; d < 4; ++d) { const float v = o0[d][r] * a + o1[d][r] * b; o0[d][r] = v; s = fmaf(v, v, s); }
        ssq[r] = s;
    }
#pragma unroll
    for (int r = 0; r < 16; ++r) { float s = ssq[r]; for (int o = 16; o; o >>= 1) s += __shfl_xor(s, o); ssq[r] = rsqrtf(s * (1.f / 128.f) + 1e-6f) * 0.8f; }
    u16* mix = (u16*)(p.ws + OFF_ACT);
    const float* sg = p.subln_g;
#pragma unroll
    for (int d = 0; d < 4; ++d) {
        const float gv = sg[d * 32 + r32e];
#pragma unroll
        for (int r = 0; r < 16; ++r) mix[(size_t)(q0 + wid2 * 32 + crow(r, hie)) * 1024 + h * 128 + d * 32 + r32e] = f2bf(o0[d][r] * ssq[r] * gv);
    }
}

DEVI void chunk_scan(const float* gates, int row0, int head, int dir, float* Bq, float* av, float* pm, float& total, float& amax) {
    const int lane = threadIdx.x & 63;
    const int e0 = dir ? 127 - 2 * lane : 2 * lane, e1 = dir ? 126 - 2 * lane : 2 * lane + 1;
    const float lf0 = gates[(size_t)(row0 + e0) * 16 + (dir ? 12 : 4) + head], lf1 = gates[(size_t)(row0 + e1) * 16 + (dir ? 12 : 4) + head];
    const float li0 = gates[(size_t)(row0 + e0) * 16 + (dir ? 8 : 0) + head],  li1 = gates[(size_t)(row0 + e1) * 16 + (dir ? 8 : 0) + head];
    const float s1 = lf0 + lf1; float inc = s1;
#pragma unroll
    for (int o = 1; o < 64; o <<= 1) { const float t = __shfl_up(inc, o); if (lane >= o) inc += t; }
    const float exc = inc - s1;
    const float B0 = exc + lf0, B1 = exc + s1;
    const float a0 = li0 - B0, a1 = li1 - B1;
    const float m1 = fmaxf(a0, a1); float mx = m1;
#pragma unroll
    for (int o = 1; o < 64; o <<= 1) { const float t = __shfl_up(mx, o); if (lane >= o) mx = fmaxf(mx, t); }
    float mprev = __shfl_up(mx, 1); if (lane == 0) mprev = -1e30f;
    Bq[e0] = B0; Bq[e1] = B1; av[e0] = a0; av[e1] = a1; pm[e0] = fmaxf(mprev, a0); pm[e1] = mx;
    total = __shfl(inc, 63); amax = __shfl(mx, 63);
}

DEVI void conv_silu8(const u32x4& xm, const u32x4& x0, const u32x4& xp, const float* wc, bool hasm, bool hasp, float (&out)[8]) {
#pragma unroll
    for (int j = 0; j < 4; ++j) {
        const float w00 = wc[2 * j], w01 = wc[2 * j + 1], w10 = wc[1024 + 2 * j], w11 = wc[1024 + 2 * j + 1], w20 = wc[2048 + 2 * j], w21 = wc[2048 + 2 * j + 1];
        float a = w10 * bflo(x0[j]), b = w11 * bfhi(x0[j]);
        if (hasm) { a = fmaf(w00, bflo(xm[j]), a); b = fmaf(w01, bfhi(xm[j]), b); }
        if (hasp) { a = fmaf(w20, bflo(xp[j]), a); b = fmaf(w21, bfhi(xp[j]), b); }
        out[2 * j] = siluf_(a); out[2 * j + 1] = siluf_(b);
    }
}
DEVI void seg_edges(int t  , bool& hasm, bool& hasp) {
    hasm = !(t == 0 || t == TC); hasp = !(t == TC - 1 || t == TT - 1);
}
DEVI int chain_slot(int dir, int b, int h, int cc) { return ((dir * 2 + b) * 4 + h) * NCH + cc; }

DEVI void phase_mlstm_a(const P& p, char* lds) {
    const int tid = threadIdx.x, wid = __builtin_amdgcn_readfirstlane(tid >> 6), lane = tid & 63, r32 = lane & 31, hi = lane >> 5;
    char* Vimg = lds; char* Kf = lds + 32768; char* Kb = lds + 65536;
    float* arr = (float*)(lds + 98304);
    const float* gates = (const float*)(p.ws + OFF_GATES);
    const u16* MLQK = (const u16*)(p.ws + OFF_MLQK); const u16* MLV = (const u16*)(p.ws + OFF_MLV);
    u16* CST = (u16*)(p.ws + OFF_CST); float* NST = (float*)(p.ws + OFF_NST); u16* MLC = (u16*)(p.ws + OFF_MLC);
    float2* scal = (float2*)(p.ws + OFF_MSCAL);
    for (int it = blockIdx.x; it < NB * 4 * NCH; it += gridDim.x) {
        const int cc = it % NCH, h = (it / NCH) & 3, b = it / (NCH * 4);
        const int row0 = b * TT + cc * 128;
        __syncthreads();
        if (wid < 2) {
            float total, amax; float* a4 = arr + wid * 512;
            chunk_scan(gates, row0, h, wid, a4, a4 + 128, a4 + 256, total, amax);
            a4[384 + lane] = __expf(a4[128 + lane] - amax); a4[384 + 64 + lane] = __expf(a4[128 + 64 + lane] - amax);
            if (lane == 0) scal[chain_slot(wid, b, h, 0) + cc] = make_float2(total + amax, total);
        }
        __syncthreads();
#pragma unroll
        for (int i = 0; i < 4; ++i) {
            const int idx = tid + 512 * i, l = idx >> 4, c = (idx & 15) * 8;
            const u32x4 v = *reinterpret_cast<const u32x4*>(MLV + (size_t)(row0 + l) * 512 + h * 128 + c);
            *reinterpret_cast<u32x4*>(Vimg + (l >> 6) * 16384 + v_st(l & 63, c)) = v;
            const int t = cc * 128 + l; bool hasm, hasp; seg_edges(t, hasm, hasp);
            const u16* kp = MLQK + (size_t)(row0 + l) * 1024 + 512 + h * 128 + c;
            const u32x4 x0 = *reinterpret_cast<const u32x4*>(kp);
            const u32x4 xm = hasm ? *reinterpret_cast<const u32x4*>(kp - 1024) : x0;
            const u32x4 xp = hasp ? *reinterpret_cast<const u32x4*>(kp + 1024) : x0;
            float kv[8]; conv_silu8(xm, x0, xp, p.conv_w + 512 + h * 128 + c, hasm, hasp, kv);
            const float wf = arr[384 + l] * 0.08838834764831845f, wb = arr[512 + 384 + l] * 0.08838834764831845f;
            u32x4 of, ob, ok;
#pragma unroll
            for (int j = 0; j < 4; ++j) { of[j] = cvtpk(kv[2 * j] * wf, kv[2 * j + 1] * wf); ob[j] = cvtpk(kv[2 * j] * wb, kv[2 * j + 1] * wb);
                ok[j] = cvtpk(kv[2 * j] * 0.08838834764831845f, kv[2 * j + 1] * 0.08838834764831845f); }
            *reinterpret_cast<u32x4*>(MLC + (size_t)(row0 + l) * 1024 + 512 + h * 128 + c) = ok;
            {
                const u16* qp = kp - 512;
                const u32x4 q0 = *reinterpret_cast<const u32x4*>(qp);
                const u32x4 qm = hasm ? *reinterpret_cast<const u32x4*>(qp - 1024) : q0;
                const u32x4 qn = hasp ? *reinterpret_cast<const u32x4*>(qp + 1024) : q0;
                float qv[8]; conv_silu8(qm, q0, qn, p.conv_w + h * 128 + c, hasm, hasp, qv);
                u32x4 oq;
#pragma unroll
                for (int j = 0; j < 4; ++j) oq[j] = cvtpk(qv[2 * j], qv[2 * j + 1]);
                *reinterpret_cast<u32x4*>(MLC + (size_t)(row0 + l) * 1024 + h * 128 + c) = oq;
            }
            *reinterpret_cast<u32x4*>(Kf + (l >> 6) * 16384 + v_st(l & 63, c)) = of;
            *reinterpret_cast<u32x4*>(Kb + (l >> 6) * 16384 + v_st(l & 63, c)) = ob;
        }
        __syncthreads();
        const int dir = wid >> 2, vblk = wid & 3;
        const int va = (int)(uintptr_t)Vimg + v_rd_base(lane), ka = (int)(uintptr_t)(dir ? Kb : Kf) + v_rd_base(lane);
        f32x16 acc[4] = {};
#define ASTEP(H, KS) do { s16x4 al_, ah_, b0l, b0h, b1l, b1h, b2l, b2h, b3l, b3h; \
        if (vblk == 0) tr_frag_issue<0, KS>(va + (H) * 16384, al_, ah_); else if (vblk == 1) tr_frag_issue<1, KS>(va + (H) * 16384, al_, ah_); \
        else if (vblk == 2) tr_frag_issue<2, KS>(va + (H) * 16384, al_, ah_); else tr_frag_issue<3, KS>(va + (H) * 16384, al_, ah_); \
        tr_frag_issue<0, KS>(ka + (H) * 16384, b0l, b0h); tr_frag_issue<1, KS>(ka + (H) * 16384, b1l, b1h); \
        tr_frag_issue<2, KS>(ka + (H) * 16384, b2l, b2h); tr_frag_issue<3, KS>(ka + (H) * 16384, b3l, b3h); LGKM0(); \
        const bf16x8 af = PKLH(al_, ah_); \
        acc[0] = __builtin_amdgcn_mfma_f32_32x32x16_bf16(af, PKLH(b0l, b0h), acc[0], 0, 0, 0); \
        acc[1] = __builtin_amdgcn_mfma_f32_32x32x16_bf16(af, PKLH(b1l, b1h), acc[1], 0, 0, 0); \
        acc[2] = __builtin_amdgcn_mfma_f32_32x32x16_bf16(af, PKLH(b2l, b2h), acc[2], 0, 0, 0); \
        acc[3] = __builtin_amdgcn_mfma_f32_32x32x16_bf16(af, PKLH(b3l, b3h), acc[3], 0, 0, 0); } while (0)
        ASTEP(0, 0); ASTEP(0, 1); ASTEP(0, 2); ASTEP(0, 3); ASTEP(1, 0); ASTEP(1, 1); ASTEP(1, 2); ASTEP(1, 3);
#undef ASTEP
        u16* Cd = CST + (size_t)chain_slot(dir, b, h, cc) * 16384;
#pragma unroll
        for (int kb = 0; kb < 4; ++kb)
#pragma unroll
            for (int r = 0; r < 16; ++r) Cd[(vblk * 32 + crow(r, hi)) * 128 + kb * 32 + r32] = f2bf(acc[kb][r]);
        if (tid < 256) {
            const int d2 = tid >> 7, k = tid & 127; const char* img = d2 ? Kb : Kf; float s = 0.f;
            for (int l = 0; l < 128; ++l) s += bf2f(*reinterpret_cast<const u16*>(img + (l >> 6) * 16384 + v_st(l & 63, k & ~7) + (k & 7) * 2));
            NST[(size_t)chain_slot(d2, b, h, cc) * 128 + k] = s;
        }
    }
}

DEVI void phase_kmax(const P& p, char* lds) {
    const int tid = threadIdx.x; unsigned* lm = (unsigned*)lds;
    __syncthreads();
    if (tid < 16) lm[tid] = 0u;
    __syncthreads();
    const u16* K = (const u16*)(p.ws + OFF_K); const int hm = tid & 7;
    float mx0 = 0.f, mx1 = 0.f;
    for (int idx = blockIdx.x * NTHR + tid; idx < NTOK * 8; idx += gridDim.x * NTHR) {
        const int tok = idx >> 3; const u16* kp = K + (size_t)tok * 512 + hm * 64; float ss = 0.f;
#pragma unroll
        for (int c = 0; c < 8; ++c) { const u32x4 w = *reinterpret_cast<const u32x4*>(kp + c * 8);
#pragma unroll
            for (int j = 0; j < 4; ++j) { const float a = bflo(w[j]), b = bfhi(w[j]); ss = fmaf(a, a, ss); ss = fmaf(b, b, ss); } }
        if (tok < TT) mx0 = fmaxf(mx0, ss); else mx1 = fmaxf(mx1, ss);
    }
    atomicMax(&lm[hm], __float_as_uint(mx0)); atomicMax(&lm[8 + hm], __float_as_uint(mx1));
    __syncthreads();
    if (tid < 16) atomicMax((unsigned*)(p.ws + OFF_CNT) + 128 + tid, lm[tid]);
    __syncthreads();
}

DEVI int proc_chunk(int dir, int i) { return dir == 0 ? i : (i == 0 ? 1 : (i == 1 ? 0 : NCH + 1 - i)); }

DEVI void phase_mlstm_b(const P& p, char* lds) {
    const int tid = threadIdx.x;
    float* dec = (float*)lds; float* scl = dec + 160; float* mst = scl + 160;
    const float2* scal = (const float2*)(p.ws + OFF_MSCAL);
    u32* CST = (u32*)(p.ws + OFF_CST); float* NST = (float*)(p.ws + OFF_NST); float* MST = (float*)(p.ws + OFF_MST);
    for (int it = blockIdx.x; it < 16 * 16; it += gridDim.x) {
        const int chain = it >> 4, sub = it & 15, dir = chain >> 3;
        __syncthreads();
        if (tid == 0) {
            float m = 0.f;
            for (int i = 0; i < NCH; ++i) {
                const int cc = proc_chunk(dir, i); const float2 s = scal[chain * NCH + cc];
                const float mn = fmaxf(s.y + m, s.x);
                dec[i] = __expf(s.y + m - mn); scl[i] = __expf(s.x - mn); mst[i] = m;
                if (sub == 0) MST[chain * NCH + cc] = m;
                m = mn;
            }
        }
        __syncthreads();
        u32* base = CST + (size_t)chain * NCH * 8192 + sub * 512 + tid;
        float s0 = 0.f, s1 = 0.f;
        for (int i0 = 0; i0 < NCH; i0 += 10) {
            u32 v[10];
#pragma unroll
            for (int j = 0; j < 10; ++j) v[j] = base[(size_t)proc_chunk(dir, i0 + j) * 8192];
#pragma unroll
            for (int j = 0; j < 10; ++j) {
                base[(size_t)proc_chunk(dir, i0 + j) * 8192] = cvtpk(s0, s1);
                const float d = dec[i0 + j], sc = scl[i0 + j];
                s0 = fmaf(d, s0, sc * bflo(v[j])); s1 = fmaf(d, s1, sc * bfhi(v[j]));
            }
        }
        if (sub == 0 && tid < 128) {
            float* nb = NST + (size_t)chain * NCH * 128 + tid; float s = 0.f;
            for (int i = 0; i < NCH; ++i) { const int cc = proc_chunk(dir, i); const float v = nb[cc * 128]; nb[cc * 128] = s; s = fmaf(dec[i], s, scl[i] * v); }
        }
    }
}

DEVI void mlstm_c_item(const P& p, int it, char* lds) {
    int tid = threadIdx.x; asm volatile("" : "+v"(tid));
    const int wid = __builtin_amdgcn_readfirstlane(tid >> 6), lane = tid & 63, r32 = lane & 31, hi = lane >> 5;
    const int cc = it % NCH, h = (it / NCH) & 3, b = it / (NCH * 4);
    const int row0 = b * TT + cc * 128;
    char* Kt = lds; char* Vimg = lds + 34816; char* Ct = lds + 67584;
    float* arr = (float*)(lds + 137216);
    float* wsc = arr + 1024 + wid * 64;
    float* xb = (float*)lds;
    const float* gates = (const float*)(p.ws + OFF_GATES);
    const u16* MLC = (const u16*)(p.ws + OFF_MLC); const u16* MLV = (const u16*)(p.ws + OFF_MLV);
    const u16* CST = (const u16*)(p.ws + OFF_CST); const float* NST = (const float*)(p.ws + OFF_NST); const float* MST = (const float*)(p.ws + OFF_MST);
    __syncthreads();
    if (wid < 2) { float total, amax; float* a4 = arr + wid * 512; chunk_scan(gates, row0, h, wid, a4, a4 + 128, a4 + 256, total, amax); }
    else if (wid < 6) { const int d2 = (wid - 2) >> 1, k = ((wid - 2) & 1) * 64 + lane; arr[d2 * 512 + 384 + k] = NST[(size_t)chain_slot(d2, b, h, cc) * 128 + k]; }
#pragma unroll
    for (int i = 0; i < 4; ++i) {
        const int idx = tid + 512 * i, l = idx >> 4, ch = idx & 15, c = ch * 8;
        const u32x4 v = *reinterpret_cast<const u32x4*>(MLV + (size_t)(row0 + l) * 512 + h * 128 + c);
        *reinterpret_cast<u32x4*>(Vimg + (l >> 6) * 16384 + v_st(l & 63, c)) = v;
        const u32x4 ok = *reinterpret_cast<const u32x4*>(MLC + (size_t)(row0 + l) * 1024 + 512 + h * 128 + c);
        *reinterpret_cast<u32x4*>(Kt + swz256(l, ch)) = ok;
#pragma unroll
        for (int d2 = 0; d2 < 2; ++d2) {
            const u32x4 cv = *reinterpret_cast<const u32x4*>(CST + (size_t)chain_slot(d2, b, h, cc) * 16384 + l * 128 + c);
            *reinterpret_cast<u32x4*>(Ct + d2 * 34816 + swz256(l, ch)) = cv;
        }
    }
    const int dir = wid >> 2, qb = wid & 3, q = qb * 32 + r32;
    bf16x8 qr[8];
    { const u16* qp = MLC + (size_t)(row0 + q) * 1024 + h * 128 + hi * 8;
#pragma unroll
      for (int d0 = 0; d0 < 8; ++d0) qr[d0] = *reinterpret_cast<const bf16x8*>(qp + d0 * 16); }
    __syncthreads();
    const float* a4 = arr + dir * 512;
    const float m_st = MST[chain_slot(dir, b, h, 0) + cc];
    const float Mq = fmaxf(m_st, a4[256 + q]);
    const float inter = __expf(m_st - Mq);
    float nq = 0.f;
#pragma unroll
    for (int d0 = 0; d0 < 8; ++d0) {
        const u32x4 w = *reinterpret_cast<const u32x4*>(&qr[d0]); const float* nn = a4 + 384 + d0 * 16 + hi * 8;
#pragma unroll
        for (int j = 0; j < 4; ++j) { nq = fmaf(bflo(w[j]), nn[2 * j], nq); nq = fmaf(bfhi(w[j]), nn[2 * j + 1], nq); }
    }
    { auto rr = __builtin_amdgcn_permlane32_swap(__float_as_uint(nq), __float_as_uint(nq), false, false); nq = __uint_as_float(rr[0]) + __uint_as_float(rr[1]); }
    f32x16 o[4] = {};
    const char* Cm = Ct + dir * 34816;
#pragma unroll
    for (int dk = 0; dk < 8; ++dk)
#pragma unroll
        for (int d0 = 0; d0 < 4; ++d0) o[d0] = __builtin_amdgcn_mfma_f32_32x32x16_bf16(qr[dk], lds_b128(Cm, swz256(d0 * 32 + r32, 2 * dk + hi)), o[d0], 0, 0, 0);
    if (hi == 0) wsc[r32] = inter;
    asm volatile("s_waitcnt lgkmcnt(0)" ::: "memory");
#pragma unroll
    for (int d0 = 0; d0 < 4; ++d0)
#pragma unroll
        for (int r = 0; r < 16; ++r) o[d0][r] *= wsc[crow(r, hi)];
    const int vb = (int)(uintptr_t)Vimg + v_rd_base(lane);
    float rs = 0.f;
#define KBLK(KB) do { if (dir == 0 ? (KB) <= qb : (KB) >= qb) { \
        f32x16 pp = {}; \
        _Pragma("unroll") for (int d0 = 0; d0 < 8; ++d0) pp = __builtin_amdgcn_mfma_f32_32x32x16_bf16(lds_b128(Kt, swz256((KB) * 32 + r32, 2 * d0 + hi)), qr[d0], pp, 0, 0, 0); \
        _Pragma("unroll") for (int g = 0; g < 4; ++g) { const f32x4 av4 = *reinterpret_cast<const f32x4*>(a4 + 128 + (KB) * 32 + 8 * g + 4 * hi); \
            _Pragma("unroll") for (int j = 0; j < 4; ++j) { const int key = (KB) * 32 + 8 * g + 4 * hi + j; const bool ok = dir == 0 ? key <= q : key >= q; \
                const float sv = ok ? pp[4 * g + j] * __expf(av4[j] - Mq) : 0.f; pp[4 * g + j] = sv; rs += sv; } } \
        bf16x8 f0, f1; pack_p(pp, f0, f1); \
        { s16x4 l0, h0, l1, h1, l2, h2, l3, h3; constexpr int HH = (KB) >> 1, K0 = ((KB) & 1) * 2; \
          tr_frag_issue<0, K0>(vb + HH * 16384, l0, h0); tr_frag_issue<1, K0>(vb + HH * 16384, l1, h1); tr_frag_issue<2, K0>(vb + HH * 16384, l2, h2); tr_frag_issue<3, K0>(vb + HH * 16384, l3, h3); LGKM0(); \
          o[0] = __builtin_amdgcn_mfma_f32_32x32x16_bf16(f0, PKLH(l0, h0), o[0], 0, 0, 0); o[1] = __builtin_amdgcn_mfma_f32_32x32x16_bf16(f0, PKLH(l1, h1), o[1], 0, 0, 0); \
          o[2] = __builtin_amdgcn_mfma_f32_32x32x16_bf16(f0, PKLH(l2, h2), o[2], 0, 0, 0); o[3] = __builtin_amdgcn_mfma_f32_32x32x16_bf16(f0, PKLH(l3, h3), o[3], 0, 0, 0); \
          tr_frag_issue<0, K0 + 1>(vb + HH * 16384, l0, h0); tr_frag_issue<1, K0 + 1>(vb + HH * 16384, l1, h1); tr_frag_issue<2, K0 + 1>(vb + HH * 16384, l2, h2); tr_frag_issue<3, K0 + 1>(vb + HH * 16384, l3, h3); LGKM0(); \
          o[0] = __builtin_amdgcn_mfma_f32_32x32x16_bf16(f1, PKLH(l0, h0), o[0], 0, 0, 0); o[1] = __builtin_amdgcn_mfma_f32_32x32x16_bf16(f1, PKLH(l1, h1), o[1], 0, 0, 0); \
          o[2] = __builtin_amdgcn_mfma_f32_32x32x16_bf16(f1, PKLH(l2, h2), o[2], 0, 0, 0); o[3] = __builtin_amdgcn_mfma_f32_32x32x16_bf16(f1, PKLH(l3, h3), o[3], 0, 0, 0); } } } while (0)
    KBLK(0); KBLK(1); KBLK(2); KBLK(3);
#undef KBLK
    { auto rr = __builtin_amdgcn_permlane32_swap(__float_as_uint(rs), __float_as_uint(rs), false, false); rs = __uint_as_float(rr[0]) + __uint_as_float(rr[1]); }
    const float nqt = inter * nq + rs;
    const float den = fmaxf(fabsf(nqt), __expf(-(a4[q] + Mq)));
    if (hi == 0) wsc[32 + r32] = 1.f / den;
    asm volatile("s_waitcnt lgkmcnt(0)" ::: "memory");
#pragma unroll
    for (int d0 = 0; d0 < 4; ++d0)
#pragma unroll
        for (int r = 0; r < 16; ++r) o[d0][r] *= wsc[32 + crow(r, hi)];
    __syncthreads();
    {
        float* xd = dir ? xb : (float*)(lds + 67584);
#pragma unroll
        for (int d0 = 0; d0 < 4; ++d0)
#pragma unroll
            for (int r = 0; r < 16; ++r) xd[(qb * 32 + crow(r, hi)) * 128 + d0 * 32 + r32] = o[d0][r];
    }
    __syncthreads();
    {
        const u16* OG = (const u16*)(p.ws + OFF_OG); u16* mix = (u16*)(p.ws + OFF_ACT);
        const float* xf = (const float*)(lds + 67584);
#pragma unroll
        for (int i = 0; i < 4; ++i) {
            const int idx = tid + 512 * i, ql = idx >> 4, c = (idx & 15) * 8;
            const f32x4 f0 = *reinterpret_cast<const f32x4*>(xf + ql * 128 + c), f1 = *reinterpret_cast<const f32x4*>(xf + ql * 128 + c + 4);
            const f32x4 b0 = *reinterpret_cast<const f32x4*>(xb + ql * 128 + c), b1 = *reinterpret_cast<const f32x4*>(xb + ql * 128 + c + 4);
            const u32x4 og = *reinterpret_cast<const u32x4*>(OG + (size_t)(row0 + ql) * 512 + h * 128 + c);
            u32x4 w;
            w[0] = cvtpk((f0[0] + b0[0]) * bflo(og[0]), (f0[1] + b0[1]) * bfhi(og[0]));
            w[1] = cvtpk((f0[2] + b0[2]) * bflo(og[1]), (f0[3] + b0[3]) * bfhi(og[1]));
            w[2] = cvtpk((f1[0] + b1[0]) * bflo(og[2]), (f1[1] + b1[1]) * bfhi(og[2]));
            w[3] = cvtpk((f1[2] + b1[2]) * bflo(og[3]), (f1[3] + b1[3]) * bfhi(og[3]));
            *reinterpret_cast<u32x4*>(mix + (size_t)(row0 + ql) * 1024 + 512 + h * 128 + c) = w;
        }
    }
}

#define KSWZ(row, colB) ((row) * 256 + ((colB) ^ (((row) & 15) << 4)))
constexpr float A2_SCALE = 0.125f, A2_THR = 8.f;
DEVI void a2_partialSM(f32x16& p0, f32x16& p1, float) {
#pragma unroll
    for (int r = 0; r < 16; ++r) p0[r] = __builtin_amdgcn_exp2f(p0[r]);
}
DEVI void a2_finishSM(f32x16& p0, f32x16& p1, float& l_reg, bf16x8& pa0, bf16x8& pa1, bf16x8& pa2, bf16x8& pa3) {
#pragma unroll
    for (int r = 0; r < 16; ++r) p1[r] = __builtin_amdgcn_exp2f(p1[r]);
    float ps = 0.f;
#pragma unroll
    for (int r = 0; r < 16; ++r) ps += p0[r];
#pragma unroll
    for (int r = 0; r < 16; ++r) ps += p1[r];
    l_reg += ps;
    pack_p(p0, pa0, pa1); pack_p(p1, pa2, pa3);
}
DEVI void a2_qkt(f32x16& p0, f32x16& p1, const char* Ks, const bf16x8 (&qr)[4], int r32, int hi, int grp, float mnC) {
#pragma unroll
    for (int r = 0; r < 16; ++r) { p0[r] = mnC; p1[r] = mnC; }
#pragma unroll
    for (int d0 = 0; d0 < 4; ++d0) { const int cb = (grp * 64 + d0 * 16 + hi * 8) * 2;
        const bf16x8 b0 = lds_b128(Ks, KSWZ(r32, cb)), b1 = lds_b128(Ks, KSWZ(32 + r32, cb));
        p0 = __builtin_amdgcn_mfma_f32_32x32x16_bf16(b0, qr[d0], p0, 0, 0, 0);
        p1 = __builtin_amdgcn_mfma_f32_32x32x16_bf16(b1, qr[d0], p1, 0, 0, 0); }
}
#define A2_VISSUE(D0, F) do { tr_frag_issue<D0, 0>(vb, F##l0, F##h0); tr_frag_issue<D0, 1>(vb, F##l1, F##h1); tr_frag_issue<D0, 2>(vb, F##l2, F##h2); tr_frag_issue<D0, 3>(vb, F##l3, F##h3); } while (0)
#define A2_VMMA(D0, F) do { \
    o[D0] = __builtin_amdgcn_mfma_f32_32x32x16_bf16(pa0, PKLH(F##l0, F##h0), o[D0], 0, 0, 0); o[D0] = __builtin_amdgcn_mfma_f32_32x32x16_bf16(pa1, PKLH(F##l1, F##h1), o[D0], 0, 0, 0); \
    o[D0] = __builtin_amdgcn_mfma_f32_32x32x16_bf16(pa2, PKLH(F##l2, F##h2), o[D0], 0, 0, 0); o[D0] = __builtin_amdgcn_mfma_f32_32x32x16_bf16(pa3, PKLH(F##l3, F##h3), o[D0], 0, 0, 0); } while (0)
#define A2_LGKM(N) do { asm volatile("s_waitcnt lgkmcnt(" #N ")" ::: "memory"); SBAR(); } while (0)
template <int S> DEVI void a2_psm_slice(f32x16& x0, f32x16&, float) {
#pragma unroll
    for (int r = 4 * S; r < 4 * S + 4; ++r) x0[r] = __builtin_amdgcn_exp2f(x0[r]);
}
DEVI void a2_pv(f32x16 (&o)[4], int vb, const bf16x8& pa0, const bf16x8& pa1, const bf16x8& pa2, const bf16x8& pa3, f32x16& x0, f32x16& x1, float mnC) {
    s16x4 al0, ah0, al1, ah1, al2, ah2, al3, ah3, bl0, bh0, bl1, bh1, bl2, bh2, bl3, bh3;
    A2_VISSUE(0, a); A2_VISSUE(1, b);
    A2_LGKM(8); a2_psm_slice<0>(x0, x1, mnC); A2_VMMA(0, a);
    A2_VISSUE(2, a);
    A2_LGKM(8); a2_psm_slice<1>(x0, x1, mnC); A2_VMMA(1, b);
    A2_VISSUE(3, b);
    A2_LGKM(8); a2_psm_slice<2>(x0, x1, mnC); A2_VMMA(2, a);
    A2_LGKM(0); a2_psm_slice<3>(x0, x1, mnC); A2_VMMA(3, b);
}
DEVI void a2_pv_last(f32x16 (&o)[4], int vb, const bf16x8& pa0, const bf16x8& pa1, const bf16x8& pa2, const bf16x8& pa3) {
    s16x4 al0, ah0, al1, ah1, al2, ah2, al3, ah3, bl0, bh0, bl1, bh1, bl2, bh2, bl3, bh3;
    A2_VISSUE(0, a); A2_VISSUE(1, b);
    A2_LGKM(8); A2_VMMA(0, a);
    A2_VISSUE(2, a);
    A2_LGKM(8); A2_VMMA(1, b);
    A2_VISSUE(3, b);
    A2_LGKM(8); A2_VMMA(2, a);
    A2_LGKM(0); A2_VMMA(3, b);
}
constexpr int A2_T = 16384;
DEVI void a2_body(const P& p, int q0, int k0row, int seq, int h, char* lds, int tid) {
    const int GRP = __builtin_amdgcn_readfirstlane(tid >> 8); const int wid = tid >> 6, lane = tid & 63, r32 = lane & 31, hi = lane >> 5, wq = wid & 3;
    const u16* Kh = (const u16*)(p.ws + OFF_K) + (size_t)k0row * 512 + h * 128;
    const u16* Vh = (const u16*)(p.ws + OFF_V) + (size_t)k0row * 512 + h * 128;
    char* V_lds = lds; char* K_lds = lds + 3 * A2_T;
    float* wsc = (float*)(lds + 6 * A2_T) + wid * 64; float* li_l = wsc;
    float l_reg = 0.f; f32x16 o[4] = {}; bf16x8 qr[4];
    { const u16* Qw = (const u16*)(p.ws + OFF_Q) + (size_t)(q0 + wq * 32 + r32) * 512 + h * 128 + GRP * 64 + hi * 8;
#pragma unroll
      for (int d0 = 0; d0 < 4; ++d0) qr[d0] = *reinterpret_cast<const bf16x8*>(Qw + d0 * 16); }
    float mnC;
    { float qq = 0.f;
#pragma unroll
      for (int d0 = 0; d0 < 4; ++d0) { const u32x4 w = *reinterpret_cast<const u32x4*>(&qr[d0]);
#pragma unroll
          for (int j = 0; j < 4; ++j) { const float a = bflo(w[j]), b2 = bfhi(w[j]); qq = fmaf(a, a, qq); qq = fmaf(b2, b2, qq); } }
      { auto rr = __builtin_amdgcn_permlane32_swap(__float_as_uint(qq), __float_as_uint(qq), false, false); qq = __uint_as_float(rr[0]) + __uint_as_float(rr[1]); }
      const int bq = k0row >= TT ? 1 : 0;
      const float k2 = __uint_as_float(((const unsigned*)(p.ws + OFF_CNT))[128 + bq * 8 + h * 2 + GRP]);
      mnC = -sqrtf(qq * k2) * (A2_SCALE * 1.4426950408889634f) * 1.001f;
#pragma unroll
      for (int d0 = 0; d0 < 4; ++d0) { u32x4 w = *reinterpret_cast<u32x4*>(&qr[d0]);
#pragma unroll
          for (int j = 0; j < 4; ++j) w[j] = cvtpk(bflo(w[j]) * (A2_SCALE * 1.4426950408889634f), bfhi(w[j]) * (A2_SCALE * 1.4426950408889634f));
          qr[d0] = *reinterpret_cast<bf16x8*>(&w); } }
    const int vb0 = (int)(uintptr_t)V_lds + v_rd_base(lane);
    const int krow = tid >> 4, kch = (tid & 15) ^ (krow & 15);
    const int vc = ((tid >> 5) & 3) * 32 + (tid & 3) * 8;
    const int kk0 = (tid >> 7) * 8 + ((tid & 31) >> 2), kk1 = kk0 + 32;
    const int vk0 = (kk0 & ~0xC) | ((kk0 & 4) << 1) | ((kk0 & 8) >> 1), vk1 = (kk1 & ~0xC) | ((kk1 & 4) << 1) | ((kk1 & 8) >> 1);
#define A2_DMA(slot, kk) do { \
    __builtin_amdgcn_global_load_lds((const unsigned*)(Kh + (size_t)((kk) + krow) * 512 + kch * 8), (LAS unsigned*)(K_lds + (slot) * A2_T + tid * 16), 16, 0, 0); \
    __builtin_amdgcn_global_load_lds((const unsigned*)(Kh + (size_t)((kk) + 32 + krow) * 512 + kch * 8), (LAS unsigned*)(K_lds + (slot) * A2_T + 8192 + tid * 16), 16, 0, 0); \
    __builtin_amdgcn_global_load_lds((const unsigned*)(Vh + (size_t)((kk) + vk0) * 512 + vc), (LAS unsigned*)(V_lds + (slot) * A2_T + tid * 16), 16, 0, 0); \
    __builtin_amdgcn_global_load_lds((const unsigned*)(Vh + (size_t)((kk) + vk1) * 512 + vc), (LAS unsigned*)(V_lds + (slot) * A2_T + 8192 + tid * 16), 16, 0, 0); } while (0)
    f32x16 pA0, pA1, pB0, pB1; bf16x8 pa0, pa1, pa2, pa3; const int NT = seq / 64;
    __syncthreads();
    A2_DMA(0, 0); asm volatile("s_waitcnt vmcnt(0)" ::: "memory"); __syncthreads();
    A2_DMA(1, 64);
    a2_qkt(pA0, pA1, K_lds, qr, r32, hi, GRP, mnC); a2_partialSM(pA0, pA1, mnC);
    asm volatile("s_waitcnt vmcnt(0)" ::: "memory"); __syncthreads();
    int bp = 0, bc = 1, bn = 2;
#define A2_HALF(X0, X1, Y0, Y1, J) do { \
        if ((J) + 1 < NT) A2_DMA(bn, ((J) + 1) * 64); \
        SBAR(); a2_qkt(X0, X1, K_lds + bc * A2_T, qr, r32, hi, GRP, mnC); \
        a2_finishSM(Y0, Y1, l_reg, pa0, pa1, pa2, pa3); SBAR(); \
        a2_pv(o, vb0 + bp * A2_T, pa0, pa1, pa2, pa3, X0, X1, mnC); \
        asm volatile("s_waitcnt vmcnt(0)" ::: "memory"); __syncthreads(); \
        { const int t_ = bp; bp = bc; bc = bn; bn = t_; } } while (0)
    for (int j = 1; j + 1 < NT; j += 2) {
        A2_HALF(pB0, pB1, pA0, pA1, j);
        A2_HALF(pA0, pA1, pB0, pB1, j + 1);
    }
    A2_HALF(pB0, pB1, pA0, pA1, NT - 1);
    a2_finishSM(pB0, pB1, l_reg, pa0, pa1, pa2, pa3); SBAR();
    a2_pv_last(o, vb0 + bp * A2_T, pa0, pa1, pa2, pa3);
#undef A2_HALF
#undef A2_DMA
    asm volatile("s_waitcnt vmcnt(0)" ::: "memory");
    int tz = threadIdx.x; asm volatile("" : "+v"(tz));
    const int wq_e = (tz >> 6) & 3, r32e = tz & 31, hie = (tz >> 5) & 1;
    float* li_e = (float*)(lds + 6 * A2_T) + (tz >> 6) * 64;
    const float lam = ((const float*)(p.ws + OFF_LAM))[0];
    { auto rr = __builtin_amdgcn_permlane32_swap(__float_as_uint(l_reg), __float_as_uint(l_reg), false, false); l_reg = __uint_as_float(rr[0]) + __uint_as_float(rr[1]); }
    if (hie == 0) li_e[r32e] = (GRP == 0 ? 1.f : -lam) / l_reg;
    asm volatile("s_waitcnt lgkmcnt(0)" ::: "memory");
#pragma unroll
    for (int r = 0; r < 16; ++r) { const float sc_ = li_e[crow(r, hie)];
#pragma unroll
        for (int d = 0; d < 4; ++d) o[d][r] *= sc_; }
    float* xb = (float*)lds;
    __syncthreads();
    if (GRP == 1) {
#pragma unroll
        for (int d = 0; d < 4; ++d)
#pragma unroll
            for (int r = 0; r < 16; ++r) xb[(wq_e * 32 + crow(r, hie)) * 128 + d * 32 + r32e] = o[d][r];
    }
    __syncthreads();
    if (GRP == 0) {
        float ssq[16];
#pragma unroll
        for (int r = 0; r < 16; ++r) { float s_ = 0.f;
#pragma unroll
            for (int d = 0; d < 4; ++d) { const float v = o[d][r] + xb[(wq_e * 32 + crow(r, hie)) * 128 + d * 32 + r32e]; o[d][r] = v; s_ = fmaf(v, v, s_); }
            ssq[r] = s_; }
#pragma unroll
        for (int r = 0; r < 16; ++r) { float s_ = ssq[r]; for (int of = 16; of; of >>= 1) s_ += __shfl_xor(s_, of); ssq[r] = rsqrtf(s_ * (1.f / 128.f) + 1e-6f) * 0.8f; }
        u16* mix = (u16*)(p.ws + OFF_ACT);
#pragma unroll
        for (int d = 0; d < 4; ++d) { const float gv = p.subln_g[d * 32 + r32e];
#pragma unroll
            for (int r = 0; r < 16; ++r) mix[(size_t)(q0 + wq_e * 32 + crow(r, hie)) * 1024 + h * 128 + d * 32 + r32e] = f2bf(o[d][r] * ssq[r] * gv); }
    }
}
DEVI void phase_attn(const P& p, char* lds) {
    const int G = gridDim.x;
    for (int it = blockIdx.x; it < 1024 + 16; it += G) {
        int q0, k0, seq, h;
        if (it < 1024) {
            int bh, qb;
            if ((G & 7) == 0) { bh = it & 7; qb = it >> 3; } else { bh = it >> 7; qb = it & 127; }
            const int b = bh >> 2; h = bh & 3; q0 = b * TT + TC + qb * 128; k0 = b * TT; seq = TT;
        } else { const int j = it - 1024, b = j >> 3; h = (j >> 1) & 3; q0 = b * TT + (j & 1) * 128; k0 = b * TT; seq = TC; }
        int tid = threadIdx.x; asm volatile("" : "+v"(tid));
        a2_body(p, q0, k0, seq, h, lds, tid);
    }
}
DEVI void phase_mlstm_c(const P& p, char* lds) {
    for (int it = blockIdx.x; it < NB * 4 * NCH; it += gridDim.x) mlstm_c_item(p, it, lds);
}

DEVI void tail_bg(const P& p, char* lds, int nunits, int first, int nitems) {
    const int G = gridDim.x, c = blockIdx.x, full = nunits / G, rem = nunits - full * G;
    __syncthreads();
    if (rem == 0) { for (int it = c; it < nitems; it += G) bg_item(p, first + it, (float*)lds); }
    else if (c >= rem) { for (int it = c - rem; it < nitems; it += G - rem) bg_item(p, first + it, (float*)lds); }
    __syncthreads();
}
DEVI void tail_convert(const P& p, char* lds, int layer, int nunits) {
    const int G = gridDim.x, c = blockIdx.x, full = nunits / G, rem = nunits - full * G;
    __syncthreads();
    if (rem == 0) { for (int it = c; it < N0_EXP; it += G) convert_expert_item(p, layer, it, (float*)lds); }
    else if (c >= rem) { for (int it = c - rem; it < N0_EXP; it += G - rem) convert_expert_item(p, layer, it, (float*)lds); }
    __syncthreads();
}
DEVI void phase_convert_l1(const P& p, char* lds) {
    for (int it = blockIdx.x; it < N0_EXP; it += gridDim.x) convert_expert_item(p, 1, it, (float*)lds);
}

constexpr int NPHASE = 19;
__global__ void __launch_bounds__(NTHR, 2) fwd_kernel(P p_) {
    extern __shared__ __attribute__((aligned(16))) char lds[];
    volatile LAS unsigned* st = (volatile LAS unsigned*)(lds + LDS_BYTES - 16);
    if (threadIdx.x == 0) { st[0] = 0u; st[1] = 0u; st[2] = 0u; st[3] = 0u; }
    __syncthreads();
    const int lo = p_.ph_lo, hi = p_.ph_hi;
    XcdBarrier bar; bar.bar = (unsigned*)(p_.ws + OFF_BAR); bar.x = 0; bar.st = st;
    if (hi - lo > 1) bar = xcd_barrier_post((unsigned*)(p_.ws + OFF_BAR), st);
#if defined(__HIP_DEVICE_COMPILE__)
#define PARAMS() const __attribute__((address_space(4))) P* kp_ = (const __attribute__((address_space(4))) P*)__builtin_amdgcn_kernarg_segment_ptr(); asm volatile("" : "+s"(kp_)); const P p = *kp_
#else
#define PARAMS() const P p = p_
#endif
#ifndef PHSEL
#define PHON(k) true
#else
#define PHON(k) ((k) == PHSEL)
#endif
#define IN(k) (lo <= (k) && (k) < hi)
#define SEAM(k) do { if (IN(k) && IN((k) + ((k) == 5 ? 2 : 1))) xcd_barrier(bar); } while (0)
    if (PHON(0) && IN(0)) { PARAMS(); phase_prologue(p, lds); if (((PROBE_DUP) >> 0) & 1u) { phase_prologue(p, lds); } }            SEAM(0);
    if (PHON(1) && IN(1)) { PARAMS(); phase_norm<0>(p, lds); if (((PROBE_DUP) >> 1) & 1u) { phase_norm<0>(p, lds); } }             SEAM(1);
    if (PHON(2) && IN(2)) { PARAMS(); phase_inproj(p, lds); tail_convert(p, lds, 0, (NTOK / 256) * 14); if (((PROBE_DUP) >> 2) & 1u) { phase_inproj(p, lds); } }              SEAM(2);
    if (PHON(3) && IN(3)) { PARAMS(); phase_mlstm_a(p, lds); tail_bg(p, lds, NB * 4 * NCH, 0, N0_WOUT); if (((PROBE_DUP) >> 3) & 1u) { phase_mlstm_a(p, lds); } }             SEAM(3);
    if (PHON(4) && IN(4)) { PARAMS(); phase_kmax(p, lds); phase_mlstm_b(p, lds); if (((PROBE_DUP) >> 4) & 1u) { xcd_barrier(bar); phase_mlstm_a(p, lds); xcd_barrier(bar); phase_mlstm_b(p, lds); } }             SEAM(4);
    if (PHON(5) && IN(5)) { PARAMS(); phase_attn(p, lds); phase_mlstm_c(p, lds); tail_bg(p, lds, NB * 4 * NCH, N0_WOUT, N0_FN); if (((PROBE_DUP) >> 5) & 1u) { phase_attn(p, lds); } if (((PROBE_DUP) >> 6) & 1u) { phase_mlstm_c(p, lds); } }   SEAM(5);
    if (PHON(7) && IN(7)) { PARAMS(); phase_outproj(p, lds); tail_convert(p, lds, 1, (NTOK / 256) * 4); if (((PROBE_DUP) >> 7) & 1u) { phase_outproj(p, lds); } }             SEAM(7);
    if (PHON(8) && IN(8)) { PARAMS(); phase_norm<1>(p, lds); if (((PROBE_DUP) >> 8) & 1u) { phase_norm<1, true>(p, lds); } }             SEAM(8);
    if (PHON(9) && IN(9)) { PARAMS(); phase_moe_up(p, 0, lds); if (((PROBE_DUP) >> 9) & 1u) { phase_moe_up(p, 0, lds); } }           SEAM(9);
    if (PHON(10) && IN(10)) { PARAMS(); phase_moe_down(p, 0, lds); if (((PROBE_DUP) >> 10) & 1u) { phase_moe_down<true>(p, 0, lds); } }        SEAM(10);
    if (PHON(11) && IN(11)) { PARAMS(); phase_norm<2>(p, lds); if (((PROBE_DUP) >> 11) & 1u) { phase_norm<2>(p, lds); } } SEAM(11);
    if (PHON(12) && IN(12)) { PARAMS(); phase_fnet_gemm(p, lds); if (((PROBE_DUP) >> 12) & 1u) { phase_fnet_gemm(p, lds); } }          SEAM(12);
    if (PHON(13) && IN(13)) { PARAMS(); phase_fft1(p, lds); if (((PROBE_DUP) >> 13) & 1u) { phase_fft1(p, lds); } }               SEAM(13);
    if (PHON(14) && IN(14)) { PARAMS(); phase_fft2(p, lds); if (((PROBE_DUP) >> 14) & 1u) { phase_fft2<true>(p, lds); } }               SEAM(14);
    if (PHON(15) && IN(15)) { PARAMS(); phase_norm<3>(p, lds); if (((PROBE_DUP) >> 15) & 1u) { phase_norm<3, true>(p, lds); } }            SEAM(15);
    if (PHON(16) && IN(16)) { PARAMS(); phase_moe_up(p, 1, lds); if (((PROBE_DUP) >> 16) & 1u) { phase_moe_up(p, 1, lds); } }          SEAM(16);
    if (PHON(17) && IN(17)) { PARAMS(); phase_moe_down(p, 1, lds); if (((PROBE_DUP) >> 17) & 1u) { phase_moe_down<true>(p, 1, lds); } }        SEAM(17);
    if (PHON(18) && IN(18)) { PARAMS(); phase_norm<4>(p, lds); if (((PROBE_DUP) >> 18) & 1u) { phase_norm<4>(p, lds); } }
#undef IN
#undef SEAM
}

#ifndef ONE_LAUNCH
#define ONE_LAUNCH 1
#endif
extern "C" void kernel_launch(void* const* d_in, const int* in_sizes, int n_in, void* d_out, int out_size, void* d_ws, size_t ws_size, hipStream_t stream) {
    static int grid = 0;
    if (grid == 0) {
        if (n_in != 21 || out_size != NLAT * DM || ws_size < OFF_END) { fprintf(stderr, "kernel_launch: unexpected shapes (n_in %d out %d ws %zu need %zu)\n", n_in, out_size, ws_size, (size_t)OFF_END); grid = -1; return; }
        int dev = 0, cus = 0;
        if (hipGetDevice(&dev) != hipSuccess || hipDeviceGetAttribute(&cus, hipDeviceAttributeMultiprocessorCount, dev) != hipSuccess) { grid = -1; return; }
        if (hipFuncSetAttribute((const void*)fwd_kernel, hipFuncAttributeMaxDynamicSharedMemorySize, LDS_BYTES) != hipSuccess) { fprintf(stderr, "kernel_launch: hipFuncSetAttribute failed\n"); grid = -1; return; }
        int per_cu = 0;
        if (hipOccupancyMaxActiveBlocksPerMultiprocessor(&per_cu, (const void*)fwd_kernel, NTHR, LDS_BYTES) != hipSuccess || per_cu < 1) { fprintf(stderr, "kernel_launch: occupancy query says %d\n", per_cu); (void)hipGetLastError(); grid = -1; return; }
        grid = cus;
    }
    if (grid < 0) return;
    (void)hipMemsetAsync(d_ws, 0, ZERO_BYTES, stream);
    P p{};
    const float* const* in = (const float* const*)d_in;
    p.x = in[0]; p.c = in[1]; p.ctx = in[2]; p.c_ctx = in[3]; p.ada_w = in[4]; p.ada_b = in[5]; p.nmix_g = in[6]; p.nffn_g = in[7];
    p.w_in = in[8]; p.w_out = in[9]; p.conv_w = in[10]; p.gate_b = in[11]; p.lamv = in[12]; p.subln_g = in[13]; p.w_fnet = in[14];
    p.router_w = in[15]; p.router_b = in[16]; p.w_gate = in[17]; p.w_up = in[18]; p.w_down = in[19]; p.final_g = in[20];
    p.out = (float*)d_out; p.ws = (char*)d_ws;
#if ONE_LAUNCH
    p.ph_lo = 0; p.ph_hi = NPHASE;
    hipLaunchKernelGGL(fwd_kernel, dim3(grid), dim3(NTHR), LDS_BYTES, stream, p);
#else
    for (int k = 0; k < NPHASE; ++k) { p.ph_lo = k; p.ph_hi = k + 1; hipLaunchKernelGGL(fwd_kernel, dim3(grid), dim3(NTHR), LDS_BYTES, stream, p); }
#endif
}
```

```cpp
#include <hip/hip_runtime.h>
#include <stdint.h>
#include <stdio.h>

#define DEVI __device__ __forceinline__
#define PROBE_DUP (0u)
typedef unsigned short u16;
typedef unsigned int u32;
using bf16x8 = __attribute__((ext_vector_type(8))) short;
using s16x4  = __attribute__((ext_vector_type(4))) short;
using f32x16 = __attribute__((ext_vector_type(16))) float;
using f32x4  = __attribute__((ext_vector_type(4))) float;
using u32x4  = __attribute__((ext_vector_type(4))) unsigned;
using u32x2  = __attribute__((ext_vector_type(2))) unsigned;

constexpr int DM = 1024, NB = 2, TL = 16384, TC = 256, TT = TL + TC, NTOK = NB * TT, NLAT = NB * TL;
constexpr int NCH = TT / 128;
constexpr int NTHR = 512;
constexpr int LDS_BYTES = 147456;

constexpr size_t al256(size_t x) { return (x + 255) / 256 * 256; }
constexpr size_t OFF_BAR   = 0;
constexpr size_t OFF_CNT   = 16384;
constexpr size_t ZERO_BYTES = 20480;
constexpr size_t OFF_MOD   = ZERO_BYTES;
constexpr size_t OFF_ROPER = OFF_MOD + al256(2 * 3 * 6144 * 4);
constexpr size_t OFF_ROPEC = OFF_ROPER + 256 * 16 * 8;
constexpr size_t OFF_TW    = OFF_ROPEC + 64 * 16 * 8;
constexpr size_t OFF_DFTC  = OFF_TW + 16384 * 8;
constexpr size_t OFF_DFTS  = OFF_DFTC + 32768;
constexpr size_t OFF_LAM   = OFF_DFTS + 32768;
constexpr size_t OFF_WG16  = OFF_LAM + 256;
constexpr size_t OFF_MSCAL = OFF_WG16 + 65536;
constexpr size_t OFF_MST   = OFF_MSCAL + al256(16 * NCH * 8);
constexpr size_t OFF_WINT  = OFF_MST + al256(16 * NCH * 4);
constexpr size_t OFF_WOUTT = OFF_WINT + (size_t)3584 * 1024 * 2;
constexpr size_t OFF_FNT   = OFF_WOUTT + (size_t)1024 * 1024 * 2;
constexpr size_t OFF_WGU   = OFF_FNT + (size_t)2048 * 1024 * 2;
constexpr size_t OFF_WDT   = OFF_WGU + (size_t)16 * 1024 * 1024 * 2;
constexpr size_t OFF_ACT   = OFF_WDT + (size_t)16 * 1024 * 512 * 2;
constexpr size_t SZ_ACT    = (size_t)NTOK * 1024 * 2;
constexpr size_t OFF_XC    = OFF_ACT + SZ_ACT;
constexpr size_t OFF_GATES = OFF_XC + (size_t)NB * TC * 1024 * 4;
constexpr size_t OFF_TOKW  = OFF_GATES + (size_t)NTOK * 16 * 4;
constexpr size_t OFF_LIST  = OFF_TOKW + al256((size_t)NTOK * 8);
constexpr size_t OFF_NST   = OFF_LIST + (size_t)24 * NTOK * 4;
constexpr size_t OFF_CST   = OFF_NST + (size_t)16 * NCH * 128 * 4;
constexpr size_t SZ_CST    = (size_t)16 * NCH * 16384 * 2;
constexpr size_t OFF_BIG   = OFF_CST + SZ_CST;
constexpr size_t OFF_Q     = OFF_BIG;
constexpr size_t OFF_K     = OFF_Q + (size_t)NTOK * 512 * 2;
constexpr size_t OFF_V     = OFF_K + (size_t)NTOK * 512 * 2;
constexpr size_t OFF_MLQK  = OFF_V + (size_t)NTOK * 512 * 2;
constexpr size_t OFF_MLV   = OFF_MLQK + (size_t)NTOK * 1024 * 2;
constexpr size_t OFF_OG    = OFF_MLV + (size_t)NTOK * 512 * 2;
constexpr size_t OFF_MLC   = OFF_OG + (size_t)NTOK * 512 * 2;
constexpr size_t OFF_END   = OFF_MLC + (size_t)NTOK * 1024 * 2;
constexpr size_t OFF_HE    = OFF_BIG;
constexpr size_t OFF_ZR    = OFF_BIG;
constexpr size_t OFF_ZI    = OFF_ZR + (size_t)NLAT * 1024 * 2;
constexpr size_t OFF_WGU1  = OFF_MLV + (size_t)2 * 1024 * 1024;
constexpr size_t OFF_WDT1  = OFF_WGU1 + (size_t)16 * 1024 * 1024 * 2;
static_assert(OFF_WDT1 + (size_t)16 * 1024 * 512 * 2 <= OFF_MLC && OFF_WGU1 >= OFF_BIG + (size_t)NLAT * 2048 * 2, "layer-1 expert region");
constexpr size_t OFF_YR    = OFF_CST;
constexpr size_t OFF_YI    = OFF_ACT;
static_assert((size_t)NLAT * 1024 * 2 <= SZ_CST && (size_t)NLAT * 1024 * 2 <= SZ_ACT, "alias sizes");
static_assert(OFF_END < (size_t)508 * 1024 * 1024, "workspace");

struct P {
    const float *x, *c, *ctx, *c_ctx, *ada_w, *ada_b, *nmix_g, *nffn_g, *w_in, *w_out, *conv_w, *gate_b, *lamv, *subln_g,
                *w_fnet, *router_w, *router_b, *w_gate, *w_up, *w_down, *final_g;
    float* out;
    char* ws;
    int ph_lo, ph_hi;
};

#define XB_TMO      128
#define XB_XCNT(j)  (256  + 64 * (j))
#define XB_XSUB(j)  (1280 + 64 * (j))
#define XB_XGEN(j)  (2304 + 64 * (j))
#define XB_TOP      3328
#define XB_TOPGEN   3392
#define XCD_BAR_WORDS 3456
#define XB_SPIN_CAP (1u << 18)
#define LAS __attribute__((address_space(3)))

__device__ __forceinline__ unsigned xb_ld(unsigned* p)              { return __hip_atomic_load(p, __ATOMIC_RELAXED, __HIP_MEMORY_SCOPE_AGENT); }
__device__ __forceinline__ unsigned xb_add(unsigned* p, unsigned v) { return __hip_atomic_fetch_add(p, v, __ATOMIC_RELAXED, __HIP_MEMORY_SCOPE_AGENT); }
__device__ __forceinline__ unsigned xb_xcc_id() { return (unsigned)__builtin_amdgcn_s_getreg((3 << 11) | 20) & 0xFu; }
#define XB_SPIN(cond, bar) do { unsigned _sp = 0; while (cond) { __builtin_amdgcn_s_sleep(1); \
    if ((++_sp & 255u) == 0u) { if (xb_ld(&(bar)[XB_TMO])) break; if (_sp > XB_SPIN_CAP) { atomicAdd(&(bar)[XB_TMO], 1u); break; } } } } while (0)

struct XcdBarrier { unsigned* bar; unsigned x; volatile LAS unsigned* st; };

__device__ __forceinline__ XcdBarrier xcd_barrier_post(unsigned* bar, volatile LAS unsigned* st) {
    XcdBarrier b; b.bar = bar; b.x = xb_xcc_id(); b.st = st;
    if (threadIdx.x == 0) (void)xb_add(&bar[XB_XCNT(b.x)], 1u);
    return b;
}
__device__ __forceinline__ void xcd_barrier_complete(unsigned* bar, unsigned x, unsigned& nloc, unsigned& nx) {
    const unsigned G = gridDim.x * gridDim.y * gridDim.z;
    unsigned sum, cnt, mine, sp = 0u;
    for (;;) {
        sum = 0u; cnt = 0u; mine = 0u;
#pragma unroll
        for (unsigned j = 0; j < 16; ++j) { const unsigned c = xb_ld(&bar[XB_XCNT(j)]); sum += c; cnt += (c > 0u) ? 1u : 0u; mine = (j == x) ? c : mine; }
        if (sum == G) break;
        __builtin_amdgcn_s_sleep(1);
        if ((++sp & 255u) == 0u) { if (xb_ld(&bar[XB_TMO])) break; if (sp > XB_SPIN_CAP) { atomicAdd(&bar[XB_TMO], 1u); break; } }
    }
    nloc = mine > 0u ? mine : 1u; nx = cnt > 0u ? cnt : 1u;
}
__device__ __forceinline__ void xcd_barrier(const XcdBarrier& b) {
    asm volatile("s_waitcnt vmcnt(0)" ::: "memory");
    __syncthreads();
    if (threadIdx.x == 0) {
        unsigned* bar = b.bar;
        __builtin_amdgcn_s_waitcnt(0);
        unsigned nloc = b.st[0], nx = b.st[1];
        if (nloc == 0u) { xcd_barrier_complete(bar, b.x, nloc, nx); b.st[0] = nloc; b.st[1] = nx; }
        const unsigned old = xb_add(&bar[XB_XSUB(b.x)], 1u);
        const unsigned gen = old / nloc;
        if (old + 1u == (gen + 1u) * nloc) {
            __builtin_amdgcn_fence(__ATOMIC_RELEASE, "agent");
            asm volatile("s_waitcnt vmcnt(0)" ::: "memory");
            const unsigned og = xb_add(&bar[XB_TOP], 1u);
            const unsigned tg = og / nx;
            if (og + 1u == (tg + 1u) * nx) xb_add(&bar[XB_TOPGEN], 1u);
            else XB_SPIN(xb_ld(&bar[XB_TOPGEN]) == tg, bar);
            __builtin_amdgcn_fence(__ATOMIC_ACQUIRE, "agent");
            xb_add(&bar[XB_XGEN(b.x)], 1u);
            asm volatile("s_waitcnt vmcnt(0)" ::: "memory");
        } else {
            XB_SPIN(xb_ld(&bar[XB_XGEN(b.x)]) == gen, bar);
            __builtin_amdgcn_fence(__ATOMIC_ACQUIRE, "agent");
            asm volatile("s_waitcnt vmcnt(0)" ::: "memory");
        }
    }
    __syncthreads();
}

DEVI u16 f2bf(float f) { u32 u = __float_as_uint(f); u += 0x7fffu + ((u >> 16) & 1u); return (u16)(u >> 16); }
DEVI float bf2f(u32 h) { return __uint_as_float(h << 16); }
DEVI u32 cvtpk(float lo, float hi) { u32 r; asm("v_cvt_pk_bf16_f32 %0, %1, %2" : "=v"(r) : "v"(lo), "v"(hi)); return r; }
DEVI float bflo(u32 w) { return __uint_as_float(w << 16); }
DEVI float bfhi(u32 w) { return __uint_as_float(w & 0xffff0000u); }
DEVI int crow(int r, int hi) { return (r & 3) + 8 * (r >> 2) + 4 * hi; }
DEVI float wave_sum(float v) { for (int o = 32; o; o >>= 1) v += __shfl_xor(v, o); return v; }
DEVI float wave_max(float v) { for (int o = 32; o; o >>= 1) v = fmaxf(v, __shfl_xor(v, o)); return v; }
DEVI float sigmoidf_(float x) { return __builtin_amdgcn_rcpf(1.f + __expf(-x)); }
DEVI float siluf_(float x) { return x * __builtin_amdgcn_rcpf(1.f + __expf(-x)); }
DEVI float logsigmoidf_(float x) { return fminf(x, 0.f) - log1pf(__expf(-fabsf(x))); }
#define SBAR() __builtin_amdgcn_sched_barrier(0)

DEVI void sincos2pi(double frac, double& s, double& c) {
    frac -= floor(frac);
    double q = rint(frac * 4.0);
    double r = (frac - q * 0.25) * 6.283185307179586476925;
    double r2 = r * r;
    double sr = r * (1.0 + r2 * (-1.0 / 6 + r2 * (1.0 / 120 + r2 * (-1.0 / 5040 + r2 * (1.0 / 362880 + r2 * (-1.0 / 39916800 + r2 * (1.0 / 6227020800.0 + r2 * (-1.0 / 1307674368000.0))))))));
    double cr = 1.0 + r2 * (-0.5 + r2 * (1.0 / 24 + r2 * (-1.0 / 720 + r2 * (1.0 / 40320 + r2 * (-1.0 / 3628800 + r2 * (1.0 / 479001600.0 + r2 * (-1.0 / 87178291200.0 + r2 * (1.0 / 20922789888000.0))))))));
    int qi = ((int)q) & 3;
    if (qi == 0) { s = sr; c = cr; } else if (qi == 1) { s = cr; c = -sr; } else if (qi == 2) { s = -sr; c = -cr; } else { s = -cr; c = sr; }
}

DEVI u16* xs_ptr(const P& p, int layer, int tok) {
    const int row = layer == 0 ? tok : (tok >> 14) * TT + TC + (tok & (TL - 1));
    return (u16*)(p.ws + OFF_MLC) + (size_t)row * DM;
}
DEVI f32x4 bf4_to_f32(u32x2 w) { f32x4 v; v[0] = bflo(w[0]); v[1] = bfhi(w[0]); v[2] = bflo(w[1]); v[3] = bfhi(w[1]); return v; }
DEVI const float* xin_ptr(const P& p, int tok) {
    int b = tok >= TT ? 1 : 0, t = tok - b * TT;
    if (t < TC) return p.ctx + (size_t)(b * TC + t) * DM;
    return p.x + (size_t)(b * TL + t - TC) * DM;
}
DEVI int modsel(int layer, int tok) {
    if (layer == 0) { int b = tok >= TT ? 1 : 0, t = tok - b * TT; return t < TC ? 2 : b; }
    return tok >> 14;
}

DEVI int swz128(int row, int chunk) { return row * 144 + (chunk << 4); }
DEVI int swz256(int row, int chunk) { return row * 272 + (chunk << 4); }
DEVI int v_st(int k, int c) { const int kk = (k & ~0xC) | ((k & 4) << 1) | ((k & 8) >> 1); return ((kk >> 3) * 4 + (c >> 5)) * 512 + ((kk & 7) * 32 + (c & 31)) * 2; }
DEVI int v_rd_base(int lane) { return ((lane & 3) << 3) | (((lane >> 2) & 3) << 6) | (((lane >> 4) & 1) << 5) | (((lane >> 5) & 1) << 8); }
constexpr int v_rd_off(int d0, int ks, int half) { return d0 * 512 + ks * 4096 + half * 2048; }
template <int OFF> DEVI s16x4 tr_read(int vb) {
    s16x4 r; asm volatile("ds_read_b64_tr_b16 %0, %1 offset:%2" : "=&v"(r) : "v"(vb), "i"(OFF) : "memory"); return r;
}
#define PKLH(L, H) (bf16x8){L[0], L[1], L[2], L[3], H[0], H[1], H[2], H[3]}
template <int D0, int KS> DEVI void tr_frag_issue(int vb, s16x4& l, s16x4& h) { l = tr_read<v_rd_off(D0, KS, 0)>(vb); h = tr_read<v_rd_off(D0, KS, 1)>(vb); }
#define LGKM0() do { asm volatile("s_waitcnt lgkmcnt(0)" ::: "memory"); SBAR(); } while (0)

DEVI bf16x8 lds_b128(const char* base, int off) { return *reinterpret_cast<const bf16x8*>(base + off); }

DEVI void pack_p(const f32x16& pp, bf16x8& f0, bf16x8& f1) {
#define PK4(BASE, OUT) do { unsigned a0 = cvtpk(pp[BASE + 0], pp[BASE + 1]), a1 = cvtpk(pp[BASE + 2], pp[BASE + 3]);   \
    unsigned b0 = cvtpk(pp[BASE + 4], pp[BASE + 5]), b1 = cvtpk(pp[BASE + 6], pp[BASE + 7]);                            \
    auto r0 = __builtin_amdgcn_permlane32_swap(a0, b0, false, false); auto r1 = __builtin_amdgcn_permlane32_swap(a1, b1, false, false); \
    u32x4 w = {r0[0], r1[0], r0[1], r1[1]}; OUT = *reinterpret_cast<bf16x8*>(&w); } while (0)
    PK4(0, f0); PK4(8, f1);
#undef PK4
}

DEVI void pack_p_perm(const f32x16& pp, bf16x8& f0, bf16x8& f1) {
    u32x4 a, b;
    a[0] = cvtpk(pp[0], pp[1]); a[1] = cvtpk(pp[2], pp[3]); a[2] = cvtpk(pp[4], pp[5]); a[3] = cvtpk(pp[6], pp[7]);
    b[0] = cvtpk(pp[8], pp[9]); b[1] = cvtpk(pp[10], pp[11]); b[2] = cvtpk(pp[12], pp[13]); b[3] = cvtpk(pp[14], pp[15]);
    f0 = *reinterpret_cast<bf16x8*>(&a); f1 = *reinterpret_cast<bf16x8*>(&b);
}
namespace g8 {
constexpr int BM = 256, BK = 64, HALF = 128, HTB = HALF * BK * 2, STAGE_BYTES = 8 * HTB, NXCD = 8, WGM = 8;
DEVI int lds_byte(int r, int c) { const int st = (r >> 4) * 2 + (c >> 5), rr = r & 15, cc = c & 31, ob = rr * 64 + cc * 2; return st * 1024 + (ob ^ (((ob >> 9) & 1) << 5)); }
DEVI void stage_rc(int b, int& R, int& C) { const int st = b / 1024, sb = b % 1024, swz = sb ^ (((sb >> 9) & 1) << 5); R = (st >> 1) * 16 + swz / 64; C = (st & 1) * 32 + (swz % 64) / 2; }
DEVI int perm32(int rho) { const int n = rho >> 4, i = rho & 15; return 8 * (i >> 2) + 4 * n + (i & 3); }
struct Unit { int pm, pn; const char* B0; const char* B1; int cls, r0, ncls; };
DEVI bool tile_order(int i, int G, int c, int nM, int nN, int& pm, int& pn) {
    const int nwg = nM * nN; const long L = (long)i * G + c; if (L >= nwg) return false;
    int wgid = (int)L; { const int q = nwg / NXCD, r = nwg % NXCD, xcd = wgid % NXCD, off = wgid / NXCD; wgid = (xcd < r ? xcd * (q + 1) : r * (q + 1) + (xcd - r) * q) + off; }
    const int nig = WGM * nN, gid = wgid / nig, fm = gid * WGM, gsz = (nM - fm) < WGM ? (nM - fm) : WGM;
    pm = fm + ((wgid % nig) % gsz); pn = (wgid % nig) / gsz; return true;
}
typedef float f32x4v __attribute__((ext_vector_type(4)));
template <class Epi, class Sched, int NT = 16  , int LDA = 2048  >
DEVI void gemm_phase(LAS unsigned char* lds, const char* Abase, int ldbB  , int ksplit  , const Sched& S, const Epi& E) {
    const int tid = threadIdx.x, wid = __builtin_amdgcn_readfirstlane(tid >> 6), lane = tid & 63, wr = wid >> 2, wc = wid & 3, fr = lane & 15, fq = lane >> 4;
    constexpr int nt = NT;
    unsigned voffB[2];
#pragma unroll
    for (int i = 0; i < 2; ++i) { int R, C; stage_rc(tid * 16 + i * 8192, R, C); const int Rb = Epi::PERM ? ((R & ~31) + perm32(R & 31)) : R; voffB[i] = (unsigned)(Rb * ldbB + C * 2); }
    const size_t kstep = (size_t)(BK * 2);
    const size_t hstepB = (size_t)HALF * ldbB;
    const unsigned ldsw = (unsigned)wid * 1024u;
    const int aoff = lds_byte(wr * 64 + fr, fq * 8), boff = lds_byte(wc * 32 + fr, fq * 8);
#define G8_SA(b, h) (((b) * 2 + (h)) * HTB)
#define G8_SB(b, h) ((4 + (b) * 2 + (h)) * HTB)
#define G8_STAGE(bufoff, gbase, voff) do { _Pragma("unroll") for (int _i = 0; _i < 2; ++_i) \
        __builtin_amdgcn_global_load_lds((const unsigned*)((const char*)(gbase) + (voff)[_i]), (LAS unsigned*)(lds + (bufoff) + ldsw + _i * 8192), 16, 0, 0); } while (0)
#define G8_LDA(dst, b, h) do { _Pragma("unroll") for (int m = 0; m < 4; ++m) _Pragma("unroll") for (int k = 0; k < 2; ++k) dst[m][k] = *(const LAS bf16x8*)(lds + G8_SA(b, h) + aoff + m * 2048 + k * 1024); } while (0)
#define G8_LDB(dst, b, h) do { _Pragma("unroll") for (int n = 0; n < 2; ++n) _Pragma("unroll") for (int k = 0; k < 2; ++k) dst[n][k] = *(const LAS bf16x8*)(lds + G8_SB(b, h) + boff + n * 2048 + k * 1024); } while (0)
#define G8_MMA(ai, bj, At, Bt) do { __builtin_amdgcn_s_setprio(1); _Pragma("unroll") for (int m = 0; m < 4; ++m) _Pragma("unroll") for (int n = 0; n < 2; ++n) _Pragma("unroll") for (int k = 0; k < 2; ++k) \
        acc[ai][bj][m][n] = __builtin_amdgcn_mfma_f32_16x16x32_bf16(Bt[n][k], At[m][k], acc[ai][bj][m][n], 0, 0, 0); __builtin_amdgcn_s_setprio(0); } while (0)
#define G8_WAIT_V(n) asm volatile("s_waitcnt vmcnt(" #n ")" ::: "memory")
#define G8_WAIT_L(n) asm volatile("s_waitcnt lgkmcnt(" #n ")" ::: "memory")
#define G8_BAR __builtin_amdgcn_s_barrier()
#define G8_SCHED __builtin_amdgcn_sched_barrier(0)
#define G8_BPTR(u, kt) (((kt) < ksplit ? (u).B0 : (u).B1) + (size_t)(kt) * kstep)
    Unit cur, nxt; int ui = 0;
    if (!S.next(0, cur)) return;
    f32x4v acc[2][2][4][2];
#pragma unroll
    for (int a = 0; a < 2; ++a)
#pragma unroll
        for (int b = 0; b < 2; ++b)
#pragma unroll
            for (int m = 0; m < 4; ++m)
#pragma unroll
                for (int n = 0; n < 2; ++n) acc[a][b][m][n] = (f32x4v){0.f, 0.f, 0.f, 0.f};
    bf16x8 At[4][2], B0[2][2], B1[2][2];
    unsigned voffA[2]; unsigned vs[2][2];
    constexpr size_t hstepA = (size_t)HALF * LDA, tstepA = 2 * hstepA;
    if constexpr (Sched::GATHER) S.aoffs(cur, vs);
    else {
#pragma unroll
        for (int i = 0; i < 2; ++i) { int R, C; stage_rc(tid * 16 + i * 8192, R, C); voffA[i] = (unsigned)(R * LDA + C * 2); }
    }
    const char* cA = Sched::GATHER ? Abase : S.abase(cur, Abase) + (size_t)cur.pm * tstepA;
#define G8_STAGE_A(bufoff, ptr, h) do { if constexpr (Sched::GATHER) G8_STAGE(bufoff, ptr, vs[h]); else G8_STAGE(bufoff, (ptr) + (h) * hstepA, voffA); } while (0)
    { const char* cB = G8_BPTR(cur, 0); const char* cB1 = G8_BPTR(cur, 1);
      G8_STAGE(G8_SB(0, 0), cB, voffB); G8_STAGE_A(G8_SA(0, 0), cA, 0); G8_STAGE(G8_SB(0, 1), cB + hstepB, voffB); G8_STAGE_A(G8_SA(0, 1), cA, 1);
      if (wr == 1) G8_BAR;
      G8_WAIT_V(4); G8_BAR;
      G8_STAGE(G8_SB(1, 0), cB1, voffB); G8_STAGE_A(G8_SA(1, 0), cA + kstep, 0); G8_STAGE(G8_SB(1, 1), cB1 + hstepB, voffB);
      G8_WAIT_V(6); G8_BAR; }
    for (;;) {
        bool has_next = false; const char* nA = cA;
        for (int t = 0; t < nt; t += 2) {
            const bool last = (t == nt - 2);
            const char* a1 = cA + (size_t)(t + 1) * kstep;
            G8_LDB(B0, 0, 0); G8_SCHED; G8_LDA(At, 0, 0); G8_STAGE_A(G8_SA(1, 1), a1, 1);
            G8_WAIT_L(8); G8_BAR; G8_WAIT_L(0); G8_MMA(0, 0, At, B0); G8_BAR; G8_SCHED;
            if (last) {
                has_next = S.next(ui + 1, nxt);
                if (has_next) { if constexpr (Sched::GATHER) S.aoffs(nxt, vs); else nA = S.abase(nxt, Abase) + (size_t)nxt.pm * tstepA; } else nxt = cur;
            }
            const char* a2 = last ? nA : cA + (size_t)(t + 2) * kstep; const char* a3 = a2 + kstep;
            const char* b2 = last ? G8_BPTR(nxt, 0) : G8_BPTR(cur, t + 2); const char* b3 = last ? G8_BPTR(nxt, 1) : G8_BPTR(cur, t + 3);
            G8_LDB(B1, 0, 1); G8_STAGE(G8_SB(0, 0), b2, voffB);
            G8_BAR; G8_WAIT_L(0); G8_MMA(0, 1, At, B1); G8_BAR;
            G8_LDA(At, 0, 1); G8_STAGE_A(G8_SA(0, 0), a2, 0);
            G8_BAR; G8_WAIT_L(0); G8_MMA(1, 0, At, B0); G8_BAR; G8_SCHED;
            G8_STAGE(G8_SB(0, 1), b2 + hstepB, voffB);
            G8_WAIT_V(6); G8_BAR; G8_MMA(1, 1, At, B1); G8_BAR;
            G8_LDB(B0, 1, 0); G8_SCHED; G8_LDA(At, 1, 0); G8_STAGE_A(G8_SA(0, 1), a2, 1);
            G8_WAIT_L(8); G8_BAR; G8_WAIT_L(0); G8_MMA(0, 0, At, B0); G8_BAR; G8_SCHED;
            G8_LDB(B1, 1, 1); G8_STAGE(G8_SB(1, 0), b3, voffB);
            G8_BAR; G8_WAIT_L(0); G8_MMA(0, 1, At, B1); G8_BAR;
            G8_LDA(At, 1, 1); G8_STAGE_A(G8_SA(1, 0), a3, 0);
            G8_BAR; G8_WAIT_L(0); G8_MMA(1, 0, At, B0); G8_BAR; G8_SCHED;
            G8_STAGE(G8_SB(1, 1), b3 + hstepB, voffB);
            G8_WAIT_V(6); G8_BAR; G8_MMA(1, 1, At, B1); G8_BAR;
        }
        cA = nA;
        { int tz = threadIdx.x; asm volatile("" : "+v"(tz));
          const int w2 = tz >> 6, l2 = tz & 63; E(acc, cur, w2 >> 2, w2 & 3, l2 & 15, l2 >> 4); }
        if (!has_next) break;
#pragma unroll
        for (int a = 0; a < 2; ++a)
#pragma unroll
            for (int b = 0; b < 2; ++b)
#pragma unroll
                for (int m = 0; m < 4; ++m)
#pragma unroll
                    for (int n = 0; n < 2; ++n) acc[a][b][m][n] = (f32x4v){0.f, 0.f, 0.f, 0.f};
        cur = nxt; ++ui;
    }
    G8_WAIT_V(0);
    if (wr == 0) G8_BAR;
    G8_BAR;
#undef G8_SA
#undef G8_SB
#undef G8_STAGE
#undef G8_STAGE_A
#undef G8_LDA
#undef G8_LDB
#undef G8_MMA
#undef G8_WAIT_V
#undef G8_WAIT_L
#undef G8_BAR
#undef G8_SCHED
#undef G8_BPTR
}
DEVI void lane_rc(int i, int& R, int& C) { int tz = threadIdx.x; asm volatile("" : "+v"(tz)); stage_rc(tz * 16 + i * 8192, R, C); }
struct DenseSched {
    static constexpr bool GATHER = false;
    const char* Bt; int nM, nN, G, c; size_t btile;
    DEVI const char* abase(const Unit&, const char* a) const { return a; }
    DEVI bool next(int i, Unit& u) const { if (!tile_order(i, G, c, nM, nN, u.pm, u.pn)) return false; u.B0 = u.B1 = Bt + (size_t)u.pn * btile; u.cls = 0; u.r0 = 0; u.ncls = 0; return true; }
    DEVI void aoffs(const Unit& u, unsigned (&v)[2][2]) const {
#pragma unroll
        for (int i = 0; i < 2; ++i) { int R, C; lane_rc(i, R, C);
#pragma unroll
            for (int h = 0; h < 2; ++h) v[h][i] = (unsigned)(((u.pm * 256 + h * 128 + R) * 1024 + C) * 2); }
    }
};
}

template <class PF>
DEVI void transpose_tile(PF colptr, int ldsrc, u16* dst, int lddst, int k0, int n0, float* tl) {
    const int t = threadIdx.x, nn = t & 63, kk = t >> 6;
    const float* sp = colptr(n0 + nn);
#pragma unroll
    for (int i = 0; i < 8; ++i) tl[(kk + 8 * i) * 65 + nn] = sp[(size_t)(k0 + kk + 8 * i) * ldsrc];
    __syncthreads();
    const int n = t >> 3, kc = t & 7;
    u32x4 w;
    w[0] = cvtpk(tl[(kc * 8 + 0) * 65 + n], tl[(kc * 8 + 1) * 65 + n]);
    w[1] = cvtpk(tl[(kc * 8 + 2) * 65 + n], tl[(kc * 8 + 3) * 65 + n]);
    w[2] = cvtpk(tl[(kc * 8 + 4) * 65 + n], tl[(kc * 8 + 5) * 65 + n]);
    w[3] = cvtpk(tl[(kc * 8 + 6) * 65 + n], tl[(kc * 8 + 7) * 65 + n]);
    *reinterpret_cast<u32x4*>(dst + (size_t)(n0 + n) * lddst + k0 + kc * 8) = w;
    __syncthreads();
}

DEVI void convert_expert_item(const P& p, int layer, int it, float* tl) {
    const int e = it / 384, r = it % 384;
    const float* wg = p.w_gate + ((size_t)layer * 16 + e) * 1024 * 512;
    const float* wu = p.w_up   + ((size_t)layer * 16 + e) * 1024 * 512;
    const float* wd = p.w_down + ((size_t)layer * 16 + e) * 512 * 1024;
    if (r < 256) {
        u16* dst = (u16*)(p.ws + (layer ? OFF_WGU1 : OFF_WGU)) + (size_t)e * 1024 * 1024;
        const int kt = r >> 4, nt = r & 15;
        transpose_tile([&](int n) { const int q = n >> 8, sgu = (n >> 7) & 1, j = n & 127; return (sgu ? wu : wg) + q * 128 + j; }, 512, dst, 1024, kt * 64, nt * 64, tl);
    } else {
        const int q = r - 256; u16* dst = (u16*)(p.ws + (layer ? OFF_WDT1 : OFF_WDT)) + (size_t)e * 1024 * 512;
        const int kt = q >> 4, nt = q & 15;
        transpose_tile([&](int n) { return wd + n; }, 1024, dst, 512, kt * 64, nt * 64, tl);
    }
}

constexpr int N0_WIN = 16 * 56, N0_WOUT = 256, N0_EXP = 16 * 384, N0_FN = 1024, N0_MOD = 192, N0_TAB = 128;
constexpr int N0_TOTAL = N0_WIN + N0_MOD + N0_TAB;
constexpr int NBG = N0_WOUT + N0_FN;
DEVI void bg_item(const P& p, int it, float* tl) {
    const int tid = threadIdx.x;
    int r = it;
    if (r < N0_WOUT) {
        const int kt = r >> 4, nt = r & 15; const float* w = p.w_out;
        transpose_tile([&](int n) { return w + n; }, 1024, (u16*)(p.ws + OFF_WOUTT), 1024, kt * 64, nt * 64, tl);
        return;
    }
    r -= N0_WOUT;
    {
        const int idx = r * 512 + tid, c = idx & 127, g = (idx >> 7) & 3, n = idx >> 9;
        double sd, cd; sincos2pi(c / 256.0, sd, cd);
        const float ct = (float)cd, st = (float)sd;
        const float* W = p.w_fnet + (size_t)(g * 256) * 1024 + n;
        float ac = 0.f, as = 0.f, a128 = 0.f, cr = 1.f, sr = 0.f, sg = 1.f;
        for (int c2 = 0; c2 < 256; ++c2) {
            const float w = W[(size_t)c2 * 1024];
            ac = fmaf(cr, w, ac); as = fmaf(sr, w, as); a128 = fmaf(sg, w, a128); sg = -sg;
            const float cn = cr * ct - sr * st; sr = fmaf(sr, ct, cr * st); cr = cn;
        }
        u16* Ah = (u16*)(p.ws + OFF_FNT); u16* Bh = Ah + (size_t)1024 * 512; float* A128 = (float*)(p.ws + OFF_FNT + (size_t)2 * 1024 * 512 * 2);
        Ah[(size_t)n * 512 + g * 128 + c] = f2bf(ac * (1.f / 2048.f)); Bh[(size_t)n * 512 + g * 128 + c] = f2bf(-as * (1.f / 2048.f));
        if (c == 0) A128[g * 1024 + n] = a128 * (1.f / 2048.f);
    }
}
DEVI void bg_fill(const P& p, char* lds, int q, int lo, int hi) {
    int* sh = (int*)(lds + 32768);
    for (;;) {
        __syncthreads();
        if (threadIdx.x == 0) *sh = lo + 4 * (int)atomicAdd((unsigned*)(p.ws + OFF_CNT) + 160 + q, 1u);
        __syncthreads();
        const int it0 = *sh;
        if (it0 >= hi) break;
        for (int it = it0; it < it0 + 4 && it < hi; ++it) bg_item(p, it, (float*)lds);
    }
    __syncthreads();
}

DEVI void phase_prologue(const P& p, char* lds) {
    float* tl = (float*)lds;
    const int tid = threadIdx.x;
    for (int it = blockIdx.x; it < N0_TOTAL; it += gridDim.x) {
        int r = it;
        if (r < N0_WIN) {
            const int kt = r / 56, nt = r % 56;
            const float* w = p.w_in;
            transpose_tile([&](int n) { return w + n; },
                           3600, (u16*)(p.ws + OFF_WINT), 1024, kt * 64, nt * 64, tl);
            continue;
        }
        r -= N0_WIN;
        if (r < N0_MOD) {
            float* sv = tl;
            float* part = tl + 3072;
            for (int i = tid; i < 3072; i += NTHR) { const int v = i >> 10, k = i & 1023; const float xv = v < 2 ? p.c[v * 1024 + k] : p.c_ctx[k]; sv[i] = siluf_(xv); }
            __syncthreads();
            const int j0 = r * 64, L = j0 / 6144, col0 = j0 % 6144, kg = tid >> 6, cl = tid & 63;
            const float* W = p.ada_w + (size_t)L * 1024 * 6144 + col0 + cl;
            float a0 = 0.f, a1 = 0.f, a2 = 0.f;
            for (int k = kg * 128; k < kg * 128 + 128; ++k) { const float w = W[(size_t)k * 6144]; a0 = fmaf(sv[k], w, a0); a1 = fmaf(sv[1024 + k], w, a1); a2 = fmaf(sv[2048 + k], w, a2); }
            part[(kg * 3 + 0) * 64 + cl] = a0; part[(kg * 3 + 1) * 64 + cl] = a1; part[(kg * 3 + 2) * 64 + cl] = a2;
            __syncthreads();
            if (tid < 192) {
                const int v = tid >> 6, c2 = tid & 63; float s = 0.f;
                for (int g = 0; g < 8; ++g) s += part[(g * 3 + v) * 64 + c2];
                ((float*)(p.ws + OFF_MOD))[(size_t)(L * 3 + v) * 6144 + col0 + c2] = s + p.ada_b[L * 6144 + col0 + c2];
            }
            __syncthreads();
            continue;
        }
        r -= N0_MOD;
        {
            const int e = r * 512 + tid;
            if (e < 4096 + 1024) {
                const bool isr = e < 4096; const int ee = isr ? e : e - 4096; const int pos = ee >> 4, j = ee & 15;
                double inv = 1.0; for (int q = 0; q < j; ++q) inv *= 0.56234132519034908;
                const float invf = (float)inv; const float ang = (float)pos * invf;
                double s, c; sincos2pi((double)ang * 0.15915494309189533577, s, c);
                float2 v = make_float2((float)c, (float)s);
                if (isr) ((float2*)(p.ws + OFF_ROPER))[ee] = v; else ((float2*)(p.ws + OFF_ROPEC))[ee] = v;
            } else if (e < 5120 + 16384) {
                const int m = e - 5120; double s, c; sincos2pi(m / 16384.0, s, c);
                ((float2*)(p.ws + OFF_TW))[m] = make_float2((float)c, (float)s);
            } else if (e < 5120 + 32768) {
                const int m = e - 5120 - 16384, k = m >> 7, t = m & 127; double s, c; sincos2pi(((k * t) & 127) / 128.0, s, c);
                ((u16*)(p.ws + OFF_DFTC))[m] = f2bf((float)c); ((u16*)(p.ws + OFF_DFTS))[m] = f2bf((float)s);
            } else if (e < 5120 + 49152) {
                const int m = e - 5120 - 32768, k = m >> 4, g = m & 15;
                ((float*)(p.ws + OFF_WG16))[m] = p.w_in[(size_t)k * 3600 + 3584 + g];
            } else if (e == 5120 + 49152) {
                float s01 = 0.f, s23 = 0.f;
                for (int i = 0; i < 64; ++i) { s01 += p.lamv[i] * p.lamv[64 + i]; s23 += p.lamv[128 + i] * p.lamv[192 + i]; }
                ((float*)(p.ws + OFF_LAM))[0] = expf(s01) - expf(s23) + 0.2f;
            }
        }
    }
}

template <int MODE, bool DRY = false>
DEVI void phase_norm(const P& p, char* lds) {
    constexpr int layer = (MODE == 0 || MODE == 1) ? 0 : 1;
    constexpr bool side = (MODE == 0 || MODE == 1 || MODE == 3);
    const int nrows = layer == 0 ? NTOK : NLAT;
    const int tid = threadIdx.x, lane = tid & 63, wid = tid >> 6;
    f32x4* sl = (f32x4*)lds;
    if (side) {
        const float* S = (MODE == 0) ? (const float*)(p.ws + OFF_WG16) : p.router_w;
        for (int i = tid; i < 4096; i += NTHR) { const int eg = i >> 10, col = i & 1023; const int pc = (col >> 8) * 256 + (col & 3) * 64 + ((col >> 2) & 63);
            sl[eg * 1024 + pc] = *reinterpret_cast<const f32x4*>(S + col * 16 + eg * 4); }
        __syncthreads();
    }
    const float* g = MODE == 0 ? p.nmix_g : MODE == 1 ? p.nffn_g : MODE == 2 ? p.nmix_g + 1024 : MODE == 3 ? p.nffn_g + 1024 : p.final_g;
    const float* modb = (const float*)(p.ws + OFF_MOD) + (size_t)layer * 3 * 6144;
    constexpr int sh_i = (MODE == 0 || MODE == 2) ? 0 : 3;
    u16* act = (u16*)(p.ws + OFF_ACT);
    int npend = 0, pcls = 0, prow = 0; float pwl = 0.f, pwh = 0.f; float keep[16];
#pragma unroll
    for (int e = 0; e < 16; ++e) keep[e] = 0.f;
    const int c0 = 4 * lane;
    f32x4 xn[4];
    { const int row0 = blockIdx.x * 8 + wid;
      if (row0 < nrows) {
          if (MODE == 0) { const float* src = xin_ptr(p, row0);
#pragma unroll
              for (int i = 0; i < 4; ++i) xn[i] = *reinterpret_cast<const f32x4*>(src + c0 + 256 * i); }
          else { const u16* src = xs_ptr(p, layer, row0);
#pragma unroll
              for (int i = 0; i < 4; ++i) xn[i] = bf4_to_f32(*reinterpret_cast<const u32x2*>(src + c0 + 256 * i)); } } }
    for (int row = blockIdx.x * 8 + wid; row < nrows; row += gridDim.x * 8) {
        f32x4 xv[4]; float ss = 0.f;
#pragma unroll
        for (int i = 0; i < 4; ++i) xv[i] = xn[i];
        { const int nrow = row + gridDim.x * 8;
          if (nrow < nrows) {
              if (MODE == 0) { const float* src = xin_ptr(p, nrow);
#pragma unroll
                  for (int i = 0; i < 4; ++i) xn[i] = *reinterpret_cast<const f32x4*>(src + c0 + 256 * i); }
              else { const u16* src = xs_ptr(p, layer, nrow);
#pragma unroll
                  for (int i = 0; i < 4; ++i) xn[i] = bf4_to_f32(*reinterpret_cast<const u32x2*>(src + c0 + 256 * i)); } } }
#pragma unroll
        for (int i = 0; i < 4; ++i) { ss = fmaf(xv[i][0], xv[i][0], ss); ss = fmaf(xv[i][1], xv[i][1], ss); ss = fmaf(xv[i][2], xv[i][2], ss); ss = fmaf(xv[i][3], xv[i][3], ss); }
        ss = wave_sum(ss);
        const float rstd = rsqrtf(ss * (1.f / 1024.f) + 1e-6f);
        if (MODE == 4) {
            float* dst = p.out + (size_t)row * DM;
#pragma unroll
            for (int i = 0; i < 4; ++i) { const f32x4 gv = *reinterpret_cast<const f32x4*>(g + c0 + 256 * i); *reinterpret_cast<f32x4*>(dst + c0 + 256 * i) = xv[i] * rstd * gv; }
            continue;
        }
        const float* mv = modb + (size_t)modsel(layer, row) * 6144;
        float acc[16];
#pragma unroll
        for (int e = 0; e < 16; ++e) acc[e] = 0.f;
#pragma unroll
        for (int i = 0; i < 4; ++i) {
            const f32x4 gv = *reinterpret_cast<const f32x4*>(g + c0 + 256 * i), scv = *reinterpret_cast<const f32x4*>(mv + (sh_i + 1) * 1024 + c0 + 256 * i),
                        shv = *reinterpret_cast<const f32x4*>(mv + sh_i * 1024 + c0 + 256 * i);
            f32x4 h;
#pragma unroll
            for (int j = 0; j < 4; ++j) h[j] = xv[i][j] * rstd * gv[j] * (1.f + scv[j]) + shv[j];
            if (MODE == 2) {
                const float p0 = __shfl(h[0], (64 - lane) & 63), p1 = __shfl(h[3], 63 - lane), p2 = __shfl(h[2], 63 - lane), p3 = __shfl(h[1], 63 - lane), h128 = __shfl(h[0], 32);
                const float u0 = lane == 0 ? h[0] : h[0] + p0, v0 = lane == 0 ? h128 : h[0] - p0;
                if (lane < 32) {
                    u32x2 wu, wv; wu[0] = cvtpk(u0, h[1] + p1); wu[1] = cvtpk(h[2] + p2, h[3] + p3); wv[0] = cvtpk(v0, h[1] - p1); wv[1] = cvtpk(h[2] - p2, h[3] - p3);
                    *reinterpret_cast<u32x2*>((u16*)(p.ws + OFF_ACT) + (size_t)row * 512 + i * 128 + c0) = wu;
                    *reinterpret_cast<u32x2*>((u16*)(p.ws + OFF_ACT) + (size_t)NLAT * 512 + (size_t)row * 512 + i * 128 + c0) = wv;
                }
            } else {
                u32x2 w2; w2[0] = cvtpk(h[0], h[1]); w2[1] = cvtpk(h[2], h[3]);
                *reinterpret_cast<u32x2*>(act + (size_t)row * DM + c0 + 256 * i) = w2;
            }
            if (side) {
#pragma unroll
                for (int j = 0; j < 4; ++j) {
#pragma unroll
                    for (int eg = 0; eg < 4; ++eg) { const f32x4 w = sl[eg * 1024 + i * 256 + j * 64 + lane]; acc[eg * 4 + 0] = fmaf(h[j], w[0], acc[eg * 4 + 0]); acc[eg * 4 + 1] = fmaf(h[j], w[1], acc[eg * 4 + 1]);
                        acc[eg * 4 + 2] = fmaf(h[j], w[2], acc[eg * 4 + 2]); acc[eg * 4 + 3] = fmaf(h[j], w[3], acc[eg * 4 + 3]); }
                    if (j & 1) asm volatile("" ::: "memory");
                }
            }
        }
        if (side) {
            float r8[8], r4[4], r2[2], tot;
            { const bool up = lane & 32;
#pragma unroll
              for (int i = 0; i < 8; ++i) { const float snd = up ? acc[i] : acc[i + 8], kp = up ? acc[i + 8] : acc[i]; r8[i] = kp + __shfl_xor(snd, 32); } }
            { const bool up = lane & 16;
#pragma unroll
              for (int i = 0; i < 4; ++i) { const float snd = up ? r8[i] : r8[i + 4], kp = up ? r8[i + 4] : r8[i]; r4[i] = kp + __shfl_xor(snd, 16); } }
            { const bool up = lane & 8;
#pragma unroll
              for (int i = 0; i < 2; ++i) { const float snd = up ? r4[i] : r4[i + 2], kp = up ? r4[i + 2] : r4[i]; r2[i] = kp + __shfl_xor(snd, 8); } }
            { const bool up = lane & 4; const float snd = up ? r2[0] : r2[1], kp = up ? r2[1] : r2[0]; tot = kp + __shfl_xor(snd, 4); }
            tot += __shfl_xor(tot, 1); tot += __shfl_xor(tot, 2);
            if (MODE == 0) {
                if ((lane & 3) == 0) {
                    const int e = lane >> 2;
                    float v = tot + p.gate_b[e];
                    const int type = e >> 2;
                    if (type == 1 || type == 3) v = logsigmoidf_(v);
                    ((float*)(p.ws + OFF_GATES))[(size_t)row * 16 + e] = v;
                }
            } else {
#pragma unroll
                for (int e = 0; e < 16; ++e) { const float te = __uint_as_float(__builtin_amdgcn_readlane(__float_as_uint(tot), e << 2)); keep[e] = (lane == npend) ? te : keep[e]; }
                if (lane == npend) prow = row;
                ++npend;
            }
        }
    }
    if (MODE == 1 || MODE == 3) {
        {
            float aff[16], bi[16];
#pragma unroll
            for (int e = 0; e < 16; ++e) { aff[e] = sigmoidf_(keep[e]); bi[e] = aff[e] + p.router_b[e]; }
            int bg = 0, ba = 0, bb = 1; float bscore = -1e30f;
#pragma unroll
            for (int gq = 0; gq < 4; ++gq) {
                int ia = 0; float va = bi[gq * 4];
#pragma unroll
                for (int j = 1; j < 4; ++j) if (bi[gq * 4 + j] > va) { va = bi[gq * 4 + j]; ia = j; }
                int ib = -1; float vb = -1e30f;
#pragma unroll
                for (int j = 0; j < 4; ++j) if (j != ia && bi[gq * 4 + j] > vb) { vb = bi[gq * 4 + j]; ib = j; }
                const float sc = va + vb;
                if (sc > bscore) { bscore = sc; bg = gq; ba = ia; bb = ib; }
            }
            const int lo = ba < bb ? ba : bb, hi2 = ba < bb ? bb : ba;
            float alo = 0.f, ahi = 0.f;
#pragma unroll
            for (int e = 0; e < 16; ++e) { if (e == bg * 4 + lo) alo = aff[e]; if (e == bg * 4 + hi2) ahi = aff[e]; }
            const float inv = 1.f / (alo + ahi);
            const int pair = lo == 0 ? hi2 - 1 : (lo == 1 ? hi2 + 1 : 5);
            pcls = bg * 6 + pair; pwl = alo * inv; pwh = ahi * inv;
        }
        unsigned* lc = (unsigned*)(lds + 65536);
        __syncthreads();
        if (tid < 64) lc[tid] = 0u;
        __syncthreads();
        unsigned myrank = 0u;
        if (lane < npend) myrank = atomicAdd(&lc[pcls], 1u);
        __syncthreads();
        if (tid < 24) { unsigned* cnt = (unsigned*)(p.ws + OFF_CNT) + (DRY ? 2 : layer) * 32; const unsigned n = lc[tid]; lc[32 + tid] = n ? atomicAdd(&cnt[tid], n) : 0u; }
        __syncthreads();
        if (lane < npend) {
            ((int*)(p.ws + (DRY ? OFF_BIG : OFF_LIST)))[(size_t)pcls * NTOK + lc[32 + pcls] + myrank] = prow;
            ((float2*)(p.ws + (DRY ? OFF_BIG + (size_t)32 * NTOK * 4 : OFF_TOKW)))[prow] = make_float2(pwl, pwh);
        }
    }
}

using g8::f32x4v;
DEVI u32x4 pack8(const f32x4v& a, const f32x4v& b) { u32x4 w; w[0] = cvtpk(a[0], a[1]); w[1] = cvtpk(a[2], a[3]); w[2] = cvtpk(b[0], b[1]); w[3] = cvtpk(b[2], b[3]); return w; }

struct EpiInproj {
    static constexpr bool PERM = true;
    char* ws;
    DEVI void operator()(const f32x4v (&acc)[2][2][4][2], const g8::Unit& u, int wr, int wc, int fr, int fq) const {
        u16* dst; int ld, coff, kind;
        const int pn = u.pn;
        if (pn < 2)       { dst = (u16*)(ws + OFF_Q);    ld = 512;  coff = pn * 256;        kind = 1; }
        else if (pn < 4)  { dst = (u16*)(ws + OFF_K);    ld = 512;  coff = (pn - 2) * 256;  kind = 1; }
        else if (pn < 6)  { dst = (u16*)(ws + OFF_V);    ld = 512;  coff = (pn - 4) * 256;  kind = 0; }
        else if (pn < 10) { dst = (u16*)(ws + OFF_MLQK); ld = 1024; coff = (pn - 6) * 256;  kind = 0; }
        else if (pn < 12) { dst = (u16*)(ws + OFF_MLV);  ld = 512;  coff = (pn - 10) * 256; kind = 0; }
        else              { dst = (u16*)(ws + OFF_OG);   ld = 512;  coff = (pn - 12) * 256; kind = 2; }
        const int tb = u.pm % 65;
        const float2* tabR = (const float2*)(ws + OFF_ROPER); const float2* tabC = (const float2*)(ws + OFF_ROPEC);
#pragma unroll
        for (int ai = 0; ai < 2; ++ai)
#pragma unroll
            for (int m = 0; m < 4; ++m) {
                const int rl = ai * 128 + wr * 64 + m * 16 + fr;
                u16* rowp = dst + (size_t)(u.pm * 256 + rl) * ld + coff + wc * 32 + 8 * fq;
#pragma unroll
                for (int bj = 0; bj < 2; ++bj) {
                    f32x4v v0 = acc[ai][bj][m][0], v1 = acc[ai][bj][m][1];
                    if (kind == 1 && tb > 0) {
                        const int tl = (tb - 1) * 256 + rl;
                        const int p0 = ((wc * 32 + 8 * fq) & 63) >> 1;
                        const float* cs = (const float*)(p0 < 16 ? tabR + (tl >> 6) * 16 + p0 : tabC + (tl & 63) * 16 + (p0 - 16));
                        const f32x4v c01 = *reinterpret_cast<const f32x4v*>(cs), c23 = *reinterpret_cast<const f32x4v*>(cs + 4);
                        const f32x4v a = v0, b = v1;
                        v0[0] = a[0] * c01[0] - a[1] * c01[1]; v0[1] = a[0] * c01[1] + a[1] * c01[0];
                        v0[2] = a[2] * c01[2] - a[3] * c01[3]; v0[3] = a[2] * c01[3] + a[3] * c01[2];
                        v1[0] = b[0] * c23[0] - b[1] * c23[1]; v1[1] = b[0] * c23[1] + b[1] * c23[0];
                        v1[2] = b[2] * c23[2] - b[3] * c23[3]; v1[3] = b[2] * c23[3] + b[3] * c23[2];
                    } else if (kind == 2) {
#pragma unroll
                        for (int j = 0; j < 4; ++j) { v0[j] = sigmoidf_(v0[j]); v1[j] = sigmoidf_(v1[j]); }
                    }
                    *reinterpret_cast<u32x4*>(rowp + bj * 128) = pack8(v0, v1);
                }
            }
    }
};
DEVI void phase_inproj(const P& p, char* lds) {
    __syncthreads();
    g8::DenseSched S{p.ws + OFF_WINT, NTOK / 256, 14, (int)gridDim.x, (int)blockIdx.x, (size_t)256 * 2048};
    EpiInproj E{p.ws};
    g8::gemm_phase((LAS unsigned char*)lds, p.ws + OFF_ACT, 2048, 16, S, E);
}

struct EpiOutproj {
    static constexpr bool PERM = true;
    const float* xin_lat; const float* xin_ctx; u16* xs; const float* modb;
    DEVI void operator()(const f32x4v (&acc)[2][2][4][2], const g8::Unit& u, int wr, int wc, int fr, int fq) const {
        const int b = u.pm / 65, tb = u.pm % 65;
        const float* xi = tb == 0 ? xin_ctx + (size_t)(b * TC) * DM : xin_lat + (size_t)(b * TL + (tb - 1) * 256) * DM;
        u16* xo = xs + (size_t)(u.pm * 256) * DM;
        const float* gate = modb + (size_t)(tb == 0 ? 2 : b) * 6144 + 2 * 1024;
        const int col0 = u.pn * 256 + wc * 32 + 8 * fq;
        f32x4v gv[2][2];
#pragma unroll
        for (int bj = 0; bj < 2; ++bj)
#pragma unroll
            for (int n = 0; n < 2; ++n) gv[bj][n] = *reinterpret_cast<const f32x4v*>(gate + col0 + bj * 128 + n * 4);
#pragma unroll
        for (int ai = 0; ai < 2; ++ai) {
            f32x4v xv[4][2][2];
#pragma unroll
            for (int m = 0; m < 4; ++m) { const size_t ro = (size_t)(ai * 128 + wr * 64 + m * 16 + fr) * DM + col0;
#pragma unroll
                for (int bj = 0; bj < 2; ++bj)
#pragma unroll
                    for (int n = 0; n < 2; ++n) xv[m][bj][n] = *reinterpret_cast<const f32x4v*>(xi + ro + bj * 128 + n * 4); }
#pragma unroll
            for (int m = 0; m < 4; ++m) { const size_t ro = (size_t)(ai * 128 + wr * 64 + m * 16 + fr) * DM + col0;
#pragma unroll
                for (int bj = 0; bj < 2; ++bj)
                    *reinterpret_cast<u32x4*>(xo + ro + bj * 128) = pack8(xv[m][bj][0] + gv[bj][0] * acc[ai][bj][m][0], xv[m][bj][1] + gv[bj][1] * acc[ai][bj][m][1]); }
        }
    }
};
DEVI void phase_outproj(const P& p, char* lds) {
    __syncthreads();
    g8::DenseSched S{p.ws + OFF_WOUTT, NTOK / 256, 4, (int)gridDim.x, (int)blockIdx.x, (size_t)256 * 2048};
    EpiOutproj E{p.x, p.ctx, (u16*)(p.ws + OFF_MLC), (const float*)(p.ws + OFF_MOD)};
    g8::gemm_phase((LAS unsigned char*)lds, p.ws + OFF_ACT, 2048, 16, S, E);
}

DEVI int moe_table(const P& p, int layer, int* tb) {
    __syncthreads();
    if (threadIdx.x == 0) {
        const unsigned* cnt = (const unsigned*)(p.ws + OFF_CNT) + layer * 32; int o = 0;
        for (int c = 0; c < 24; ++c) { tb[c] = o; tb[32 + c] = (int)cnt[c]; o += ((int)cnt[c] + 255) >> 8; }
        tb[24] = o;
    }
    __syncthreads();
    return tb[24];
}
DEVI void cls_experts(int cls, int& elo, int& ehi) {
    const int g = cls / 6, pr = cls % 6;
    const int lo = pr < 3 ? 0 : (pr < 5 ? 1 : 2); const int hi = pr < 3 ? pr + 1 : (pr < 5 ? pr - 1 : 3);
    elo = g * 4 + lo; ehi = g * 4 + hi;
}
DEVI void moe_unit(const int* tb, int rt, g8::Unit& u) {
    int cls = 0; while (cls < 23 && tb[cls + 1] <= rt) ++cls;
    u.cls = cls; u.r0 = (rt - tb[cls]) * 256; u.ncls = tb[32 + cls];
}

struct MoeUpSched {
    static constexpr bool GATHER = true;
    DEVI const char* abase(const g8::Unit&, const char* a) const { return a; }
    const int* tb; int T, G, c; const int* list; const char* Wgu;
    DEVI bool next(int i, g8::Unit& u) const {
        if (!g8::tile_order(i, G, c, T, 8, u.pm, u.pn)) return false;
        moe_unit(tb, u.pm, u); int elo, ehi; cls_experts(u.cls, elo, ehi);
        const int e = u.pn < 4 ? elo : ehi;
        u.B0 = u.B1 = Wgu + ((size_t)e * 1024 + (size_t)(u.pn & 3) * 256) * 2048; return true;
    }
    DEVI void aoffs(const g8::Unit& u, unsigned (&v)[2][2]) const {
        const int* lst = list + (size_t)u.cls * NTOK + u.r0;
#pragma unroll
        for (int i = 0; i < 2; ++i) { int R, C; g8::lane_rc(i, R, C);
#pragma unroll
            for (int h = 0; h < 2; ++h) { const int rr = h * 128 + R; const int tok = lst[(u.r0 + rr < u.ncls) ? rr : 0]; v[h][i] = (unsigned)((tok * 1024 + C) * 2); } }
    }
};
struct EpiMoeUp {
    static constexpr bool PERM = true;
    const int* list; const float2* tokw; u16* HE;
    DEVI void operator()(const f32x4v (&acc)[2][2][4][2], const g8::Unit& u, int wr, int wc, int fr, int fq) const {
        const int* lst = list + (size_t)u.cls * NTOK + u.r0;
        const int s = u.pn >> 2;
        float wv[2][4];
        { int tk[2][4];
#pragma unroll
          for (int ai = 0; ai < 2; ++ai)
#pragma unroll
              for (int m = 0; m < 4; ++m) { const int rl = ai * 128 + wr * 64 + m * 16 + fr; tk[ai][m] = lst[(u.r0 + rl < u.ncls) ? rl : 0]; }
#pragma unroll
          for (int ai = 0; ai < 2; ++ai)
#pragma unroll
              for (int m = 0; m < 4; ++m) { const float2 w2 = tokw[tk[ai][m]]; wv[ai][m] = s ? w2.y : w2.x; } }
#pragma unroll
        for (int ai = 0; ai < 2; ++ai)
#pragma unroll
            for (int m = 0; m < 4; ++m) {
                const int rl = ai * 128 + wr * 64 + m * 16 + fr;
                if (u.r0 + rl < u.ncls) {
                    const float w = wv[ai][m];
                    u16* rowp = HE + (size_t)(u.pm * 256 + rl) * 1024 + s * 512 + (u.pn & 3) * 128 + wc * 32 + 8 * fq;
                    f32x4v h0, h1;
#pragma unroll
                    for (int j = 0; j < 4; ++j) { h0[j] = siluf_(acc[ai][0][m][0][j]) * acc[ai][1][m][0][j] * w; h1[j] = siluf_(acc[ai][0][m][1][j]) * acc[ai][1][m][1][j] * w; }
                    *reinterpret_cast<u32x4*>(rowp) = pack8(h0, h1);
                }
            }
    }
};
DEVI void phase_moe_up(const P& p, int layer, char* lds) {
    int* tb = (int*)(lds + g8::STAGE_BYTES);
    const int T = moe_table(p, layer, tb);
    MoeUpSched S{tb, T, (int)gridDim.x, (int)blockIdx.x, (const int*)(p.ws + OFF_LIST), p.ws + (layer ? OFF_WGU1 : OFF_WGU)};
    EpiMoeUp E{(const int*)(p.ws + OFF_LIST), (const float2*)(p.ws + OFF_TOKW), (u16*)(p.ws + OFF_HE)};
    g8::gemm_phase((LAS unsigned char*)lds, p.ws + OFF_ACT, 2048, 16, S, E);
}

struct MoeDownSched {
    static constexpr bool GATHER = false;
    DEVI const char* abase(const g8::Unit&, const char* a) const { return a; }
    const int* tb; int T, G, c; const char* WdT;
    DEVI bool next(int i, g8::Unit& u) const {
        if (!g8::tile_order(i, G, c, T, 4, u.pm, u.pn)) return false;
        moe_unit(tb, u.pm, u); int elo, ehi; cls_experts(u.cls, elo, ehi);
        u.B0 = WdT + ((size_t)elo * 1024 + (size_t)u.pn * 256) * 1024;
        u.B1 = WdT + ((size_t)ehi * 1024 + (size_t)u.pn * 256) * 1024 - (size_t)8 * 128; return true;
    }
    DEVI void aoffs(const g8::Unit& u, unsigned (&v)[2][2]) const {
#pragma unroll
        for (int i = 0; i < 2; ++i) { int R, C; g8::lane_rc(i, R, C);
#pragma unroll
            for (int h = 0; h < 2; ++h) v[h][i] = (unsigned)(((u.pm * 256 + h * 128 + R) * 1024 + C) * 2); }
    }
};
template <bool DRY>
struct EpiMoeDown {
    static constexpr bool PERM = true;
    const P* pp; int layer; const int* list; const float* modb;
    DEVI void operator()(const f32x4v (&acc)[2][2][4][2], const g8::Unit& u, int wr, int wc, int fr, int fq) const {
        const P& p = *pp;
        const int* lst = list + (size_t)u.cls * NTOK + u.r0;
        const int col0 = u.pn * 256 + wc * 32 + 8 * fq;
        int tk[2][4];
#pragma unroll
        for (int ai = 0; ai < 2; ++ai)
#pragma unroll
            for (int m = 0; m < 4; ++m) { const int rl = ai * 128 + wr * 64 + m * 16 + fr; tk[ai][m] = (u.r0 + rl < u.ncls) ? lst[rl] : -1; }
#pragma unroll
        for (int ai = 0; ai < 2; ++ai)
#pragma unroll
        for (int mh = 0; mh < 2; ++mh) {
            u32x4 xw[2][2]; f32x4v gv[2][2][2];
#pragma unroll
            for (int mm = 0; mm < 2; ++mm) { const int m = mh * 2 + mm; const int tok = tk[ai][m] < 0 ? lst[0] : tk[ai][m];
                const float* gate = modb + (size_t)modsel(layer, tok) * 6144 + 5 * 1024 + col0; const u16* xo = xs_ptr(p, layer, tok) + col0;
#pragma unroll
                for (int bj = 0; bj < 2; ++bj) { xw[mm][bj] = *reinterpret_cast<const u32x4*>(xo + bj * 128);
#pragma unroll
                    for (int n = 0; n < 2; ++n) gv[mm][bj][n] = *reinterpret_cast<const f32x4v*>(gate + bj * 128 + n * 4); } }
#pragma unroll
            for (int mm = 0; mm < 2; ++mm) { const int m = mh * 2 + mm; if (tk[ai][m] >= 0) { const int tok = tk[ai][m];
                u16* xd = DRY ? (u16*)(p.ws + OFF_MLQK) + (size_t)(tok & 8191) * 1024 + col0 : xs_ptr(p, layer, tok) + col0;
#pragma unroll
                for (int bj = 0; bj < 2; ++bj) {
                    f32x4v x0, x1; x0[0] = bflo(xw[mm][bj][0]); x0[1] = bfhi(xw[mm][bj][0]); x0[2] = bflo(xw[mm][bj][1]); x0[3] = bfhi(xw[mm][bj][1]);
                    x1[0] = bflo(xw[mm][bj][2]); x1[1] = bfhi(xw[mm][bj][2]); x1[2] = bflo(xw[mm][bj][3]); x1[3] = bfhi(xw[mm][bj][3]);
                    *reinterpret_cast<u32x4*>(xd + bj * 128) = pack8(x0 + gv[mm][bj][0] * acc[ai][bj][m][0], x1 + gv[mm][bj][1] * acc[ai][bj][m][1]); } } }
        }
    }
};
template <bool DRY = false>
DEVI void phase_moe_down(const P& p, int layer, char* lds) {
    int* tb = (int*)(lds + g8::STAGE_BYTES);
    const int T = moe_table(p, layer, tb);
    MoeDownSched S{tb, T, (int)gridDim.x, (int)blockIdx.x, p.ws + (layer ? OFF_WDT1 : OFF_WDT)};
    EpiMoeDown<DRY> E{&p, layer, (const int*)(p.ws + OFF_LIST), (const float*)(p.ws + OFF_MOD) + (size_t)layer * 3 * 6144};
    g8::gemm_phase((LAS unsigned char*)lds, p.ws + OFF_HE, 1024, 8, S, E);
}

constexpr size_t OFF_FU = OFF_ACT, OFF_FV = OFF_ACT + (size_t)NLAT * 512 * 2;
constexpr size_t OFF_FAH = OFF_FNT, OFF_FBH = OFF_FNT + (size_t)1024 * 512 * 2, OFF_FA128 = OFF_FNT + (size_t)2 * 1024 * 512 * 2;
struct FnetSched {
    static constexpr bool GATHER = false;
    const char* ws; int G, c;
    DEVI const char* abase(const g8::Unit& u, const char*) const { return ws + (u.pn < 4 ? OFF_FU : OFF_FV); }
    DEVI bool next(int i, g8::Unit& u) const {
        if (!g8::tile_order(i, G, c, NLAT / 256, 8, u.pm, u.pn)) return false;
        u.B0 = u.B1 = ws + (u.pn < 4 ? OFF_FAH : OFF_FBH) + (size_t)(u.pn & 3) * 256 * 1024; u.cls = 0; u.r0 = 0; u.ncls = 0; return true;
    }
    DEVI void aoffs(const g8::Unit&, unsigned (&)[2][2]) const {}
};
struct EpiFnet {
    static constexpr bool PERM = true;
    char* ws;
    DEVI void operator()(const f32x4v (&acc)[2][2][4][2], const g8::Unit& u, int wr, int wc, int fr, int fq) const {
        const int colt = (u.pn & 3) * 256 + wc * 32 + 8 * fq;
        u16* dst = (u16*)(ws + (u.pn < 4 ? OFF_ZR : OFF_ZI)) + colt;
        const u16* V = (const u16*)(ws + OFF_FV); const float* A128 = (const float*)(ws + OFF_FA128);
#pragma unroll
        for (int bj = 0; bj < 2; ++bj) {
            f32x4v a128[4][2];
            if (u.pn < 4) {
#pragma unroll
                for (int g = 0; g < 4; ++g) { a128[g][0] = *reinterpret_cast<const f32x4v*>(A128 + g * 1024 + colt + bj * 128); a128[g][1] = *reinterpret_cast<const f32x4v*>(A128 + g * 1024 + colt + bj * 128 + 4); }
            }
#pragma unroll
            for (int ai = 0; ai < 2; ++ai)
#pragma unroll
                for (int m = 0; m < 4; ++m) {
                    const size_t row = (size_t)(u.pm * 256 + ai * 128 + wr * 64 + m * 16 + fr);
                    f32x4v v0 = acc[ai][bj][m][0], v1 = acc[ai][bj][m][1];
                    if (u.pn < 4) {
#pragma unroll
                        for (int g = 0; g < 4; ++g) { const float hv = bf2f(V[row * 512 + g * 128]); v0 += a128[g][0] * hv; v1 += a128[g][1] * hv; }
                    }
                    *reinterpret_cast<u32x4*>(dst + row * 1024 + bj * 128) = pack8(v0, v1);
                }
        }
    }
};
DEVI void phase_fnet_gemm(const P& p, char* lds) {
    __syncthreads();
    FnetSched S{p.ws, (int)gridDim.x, (int)blockIdx.x};
    EpiFnet E{p.ws};
    g8::gemm_phase<EpiFnet, FnetSched, 8, 1024>((LAS unsigned char*)lds, p.ws, 1024, 8, S, E);
}

template <class RP>
DEVI void stage_tr128_load(RP rp, u32x4 (&v)[4]) {
    const int tid = threadIdx.x;
#pragma unroll
    for (int i = 0; i < 4; ++i) { const int idx = tid + 512 * i, k = idx >> 4, c = (idx & 15) * 8; v[i] = *reinterpret_cast<const u32x4*>(rp(k) + c); }
}
DEVI void stage_tr128_write(const u32x4 (&v)[4], char* img) {
    const int tid = threadIdx.x;
#pragma unroll
    for (int i = 0; i < 4; ++i) { const int idx = tid + 512 * i, k = idx >> 4, c = (idx & 15) * 8; *reinterpret_cast<u32x4*>(img + (k >> 6) * 16384 + v_st(k & 63, c)) = v[i]; }
}
DEVI void load_dft(const P& p, char* lds) {
    const int tid = threadIdx.x;
    for (int i = tid; i < 4096; i += NTHR) {
        const int m = i >> 11, j = i & 2047, row = j >> 4, ch = j & 15;
        const u32x4 v = *reinterpret_cast<const u32x4*>((const u16*)(p.ws + (m ? OFF_DFTS : OFF_DFTC)) + row * 128 + ch * 8);
        *reinterpret_cast<u32x4*>(lds + m * 34816 + swz256(row, ch)) = v;
    }
}
DEVI bf16x8 negbf(bf16x8 v) { u32x4 w = *reinterpret_cast<u32x4*>(&v); w[0] ^= 0x80008000u; w[1] ^= 0x80008000u; w[2] ^= 0x80008000u; w[3] ^= 0x80008000u; return *reinterpret_cast<bf16x8*>(&w); }

template <int KS, int WN, int MODE>
DEVI void fft_kstep(int vbr, int vbi, const bf16x8& aC, const bf16x8& aS, f32x16 (&yr)[2], f32x16 (&yi)[2]) {
    s16x4 rl0, rh0, rl1, rh1, il0, ih0, il1, ih1;
    tr_frag_issue<2 * WN, KS>(vbr, rl0, rh0); tr_frag_issue<2 * WN + 1, KS>(vbr, rl1, rh1);
    tr_frag_issue<2 * WN, KS>(vbi, il0, ih0); tr_frag_issue<2 * WN + 1, KS>(vbi, il1, ih1);
    LGKM0();
    const bf16x8 xr0 = PKLH(rl0, rh0), xr1 = PKLH(rl1, rh1), xi0 = PKLH(il0, ih0), xi1 = PKLH(il1, ih1);
    yr[0] = __builtin_amdgcn_mfma_f32_32x32x16_bf16(xr0, aC, yr[0], 0, 0, 0);
    yr[1] = __builtin_amdgcn_mfma_f32_32x32x16_bf16(xr1, aC, yr[1], 0, 0, 0);
    yr[0] = __builtin_amdgcn_mfma_f32_32x32x16_bf16(xi0, aS, yr[0], 0, 0, 0);
    yr[1] = __builtin_amdgcn_mfma_f32_32x32x16_bf16(xi1, aS, yr[1], 0, 0, 0);
    if (MODE == 0) {
        yi[0] = __builtin_amdgcn_mfma_f32_32x32x16_bf16(xi0, aC, yi[0], 0, 0, 0);
        yi[1] = __builtin_amdgcn_mfma_f32_32x32x16_bf16(xi1, aC, yi[1], 0, 0, 0);
        yi[0] = __builtin_amdgcn_mfma_f32_32x32x16_bf16(negbf(xr0), aS, yi[0], 0, 0, 0);
        yi[1] = __builtin_amdgcn_mfma_f32_32x32x16_bf16(negbf(xr1), aS, yi[1], 0, 0, 0);
    }
}
template <int WN, int MODE>
DEVI void fft_core(const char* lds, int xr_img, int xi_img, int wm, int lane, f32x16 (&yr)[2], f32x16 (&yi)[2]) {
    const int r32 = lane & 31, hi = lane >> 5;
    const char* Cm = lds; const char* Sm = lds + 34816;
    const int row = wm * 32 + r32;
    const int vb0 = xr_img + v_rd_base(lane), vb1 = xi_img + v_rd_base(lane);
#define KSTEP(H, KS) do { const int kk = (H) * 4 + (KS); \
        const bf16x8 aC = lds_b128(Cm, swz256(row, 2 * kk + hi)), aS = lds_b128(Sm, swz256(row, 2 * kk + hi)); \
        fft_kstep<KS, WN, MODE>(vb0 + (H) * 16384, vb1 + (H) * 16384, aC, aS, yr, yi); } while (0)
    KSTEP(0, 0); KSTEP(0, 1); KSTEP(0, 2); KSTEP(0, 3); KSTEP(1, 0); KSTEP(1, 1); KSTEP(1, 2); KSTEP(1, 3);
#undef KSTEP
}

DEVI void phase_fft1(const P& p, char* lds) {
    const int tid = threadIdx.x, lane = tid & 63, wid = __builtin_amdgcn_readfirstlane(tid >> 6), wm = wid >> 1, wn = wid & 1, r32 = lane & 31, hi = lane >> 5;
    load_dft(p, lds);
    char* imgR = lds + 69632; char* imgI = lds + 102400;
    const u16* Zr = (const u16*)(p.ws + OFF_ZR); const u16* Zi = (const u16*)(p.ws + OFF_ZI);
    u16* Yr = (u16*)(p.ws + OFF_YR); u16* Yi = (u16*)(p.ws + OFF_YI);
    const float2* TW = (const float2*)(p.ws + OFF_TW);
    u32x4 pr[4], pi[4];
#define FFT1_LOAD(U) do { const int cb_ = (U) & 7, t2_ = ((U) >> 3) & 127, b_ = (U) >> 10; \
        stage_tr128_load([&](int k) { return Zr + (size_t)(b_ * TL + 128 * k + t2_) * 1024 + cb_ * 128; }, pr); \
        stage_tr128_load([&](int k) { return Zi + (size_t)(b_ * TL + 128 * k + t2_) * 1024 + cb_ * 128; }, pi); } while (0)
    if ((int)blockIdx.x < NB * 128 * 8) FFT1_LOAD((int)blockIdx.x);
    for (int u = blockIdx.x; u < NB * 128 * 8; u += gridDim.x) {
        const int cb = u & 7, t2 = (u >> 3) & 127, b = u >> 10;
        __syncthreads();
        stage_tr128_write(pr, imgR); stage_tr128_write(pi, imgI);
        __syncthreads();
        if (u + (int)gridDim.x < NB * 128 * 8) FFT1_LOAD(u + (int)gridDim.x);
        f32x16 yr[2] = {}, yi[2] = {};
        const int xr_img = (int)(uintptr_t)imgR, xi_img = (int)(uintptr_t)imgI;
        if (wn == 0) fft_core<0, 0>(lds, xr_img, xi_img, wm, lane, yr, yi); else fft_core<1, 0>(lds, xr_img, xi_img, wm, lane, yr, yi);
        __syncthreads();
        {
            const int k1 = wm * 32 + r32;
            const float2 w = TW[t2 * k1];
            char* oR = imgR + k1 * 272; char* oI = imgR + 34816 + k1 * 272;
#pragma unroll
            for (int ni = 0; ni < 2; ++ni)
#pragma unroll
                for (int g = 0; g < 4; ++g) {
                    const int cbase = wn * 64 + ni * 32 + 8 * g + 4 * hi;
                    float re[4], im[4];
#pragma unroll
                    for (int j = 0; j < 4; ++j) { const float a = yr[ni][4 * g + j], bq = yi[ni][4 * g + j]; re[j] = a * w.x + bq * w.y; im[j] = bq * w.x - a * w.y; }
                    u32x2 pr, pi; pr[0] = cvtpk(re[0], re[1]); pr[1] = cvtpk(re[2], re[3]); pi[0] = cvtpk(im[0], im[1]); pi[1] = cvtpk(im[2], im[3]);
                    *reinterpret_cast<u32x2*>(oR + cbase * 2) = pr; *reinterpret_cast<u32x2*>(oI + cbase * 2) = pi;
                }
        }
        __syncthreads();
#pragma unroll
        for (int i = 0; i < 8; ++i) {
            const int idx = tid + 512 * i, pl = idx >> 11, j = idx & 2047, row = j >> 4, ch = j & 15;
            const u32x4 v = *reinterpret_cast<const u32x4*>(imgR + pl * 34816 + row * 272 + ch * 16);
            *reinterpret_cast<u32x4*>((pl ? Yi : Yr) + ((size_t)(b * 128 + row) * 128 + t2) * 1024 + cb * 128 + ch * 8) = v;
        }
    }
}
template <bool DRY = false>
DEVI void phase_fft2(const P& p, char* lds) {
    const int tid = threadIdx.x, lane = tid & 63, wid = __builtin_amdgcn_readfirstlane(tid >> 6), wm = wid >> 1, wn = wid & 1, r32 = lane & 31, hi = lane >> 5;
    load_dft(p, lds);
    char* imgR = lds + 69632; char* imgI = lds + 102400;
    const u16* Yr = (const u16*)(p.ws + OFF_YR); const u16* Yi = (const u16*)(p.ws + OFF_YI);
    const float* modb = (const float*)(p.ws + OFF_MOD) + (size_t)3 * 6144;
    u32x4 pr[4], pi[4];
#define FFT2_LOAD(U) do { const int cb_ = (U) & 7, k1_ = ((U) >> 3) & 127, b_ = (U) >> 10; \
        stage_tr128_load([&](int k) { return Yr + ((size_t)(b_ * 128 + k1_) * 128 + k) * 1024 + cb_ * 128; }, pr); \
        stage_tr128_load([&](int k) { return Yi + ((size_t)(b_ * 128 + k1_) * 128 + k) * 1024 + cb_ * 128; }, pi); } while (0)
    if ((int)blockIdx.x < NB * 128 * 8) FFT2_LOAD((int)blockIdx.x);
    for (int u = blockIdx.x; u < NB * 128 * 8; u += gridDim.x) {
        const int cb = u & 7, k1 = (u >> 3) & 127, b = u >> 10;
        __syncthreads();
        stage_tr128_write(pr, imgR); stage_tr128_write(pi, imgI);
        __syncthreads();
        if (u + (int)gridDim.x < NB * 128 * 8) FFT2_LOAD(u + (int)gridDim.x);
        f32x16 yr[2] = {}, yi[2] = {};
        const int xr_img = (int)(uintptr_t)imgR, xi_img = (int)(uintptr_t)imgI;
        if (wn == 0) fft_core<0, 1>(lds, xr_img, xi_img, wm, lane, yr, yi); else fft_core<1, 1>(lds, xr_img, xi_img, wm, lane, yr, yi);
        __syncthreads();
        {
            char* oR = imgR + (wm * 32 + r32) * 528;
#pragma unroll
            for (int ni = 0; ni < 2; ++ni)
#pragma unroll
                for (int g = 0; g < 4; ++g) {
                    const int cbase = wn * 64 + ni * 32 + 8 * g + 4 * hi;
                    f32x4 v; v[0] = yr[ni][4 * g]; v[1] = yr[ni][4 * g + 1]; v[2] = yr[ni][4 * g + 2]; v[3] = yr[ni][4 * g + 3];
                    *reinterpret_cast<f32x4*>(oR + cbase * 4) = v;
                }
        }
        __syncthreads();
        const float* gate = modb + (size_t)b * 6144 + 2 * 1024 + cb * 128;
#pragma unroll
        for (int i = 0; i < 4; ++i) {
            const int idx = tid + 512 * i, row = idx >> 4, ch = idx & 15;
            const f32x4 v0 = *reinterpret_cast<const f32x4*>(imgR + row * 528 + ch * 32), v1 = *reinterpret_cast<const f32x4*>(imgR + row * 528 + ch * 32 + 16);
            const f32x4 g0 = *reinterpret_cast<const f32x4*>(gate + ch * 8), g1 = *reinterpret_cast<const f32x4*>(gate + ch * 8 + 4);
            u16* xo = xs_ptr(p, 1, b * TL + k1 + 128 * row) + cb * 128 + ch * 8;
            u16* xd = DRY ? (u16*)(p.ws + OFF_ZR) + (size_t)(b * TL + k1 + 128 * row) * 1024 + cb * 128 + ch * 8 : xo;
            const u32x4 xw = *reinterpret_cast<const u32x4*>(xo);
            f32x4 x0, x1; x0[0] = bflo(xw[0]); x0[1] = bfhi(xw[0]); x0[2] = bflo(xw[1]); x0[3] = bfhi(xw[1]); x1[0] = bflo(xw[2]); x1[1] = bfhi(xw[2]); x1[2] = bflo(xw[3]); x1[3] = bfhi(xw[3]);
            const f32x4 r0 = x0 + g0 * v0, r1 = x1 + g1 * v1;
            u32x4 w; w[0] = cvtpk(r0[0], r0[1]); w[1] = cvtpk(r0[2], r0[3]); w[2] = cvtpk(r1[0], r1[1]); w[3] = cvtpk(r1[2], r1[3]);
            *reinterpret_cast<u32x4*>(xd) = w;
        }
    }
}

constexpr int AT_V = 16384, AT_K = 17408;
template <int HF, int DB>
DEVI void attn_half(const char* Ks, const bf16x8 (&qr)[8], float& m_reg, float& l_reg, f32x16 (&o)[4], int vb, float* al, int r32, int hi) {
    constexpr float SC = 0.125f, C = SC * 1.4426950408889634f, THR = 8.f;
    f32x16 pp = {};
#pragma unroll
    for (int d0 = 0; d0 < 4; ++d0) pp = __builtin_amdgcn_mfma_f32_32x32x16_bf16(lds_b128(Ks, swz256(HF * 32 + r32, 2 * (DB + d0) + hi)), qr[DB + d0], pp, 0, 0, 0);
    float pmax = pp[0];
#pragma unroll
    for (int r = 1; r < 16; ++r) pmax = fmaxf(pmax, pp[r]);
    { auto rr = __builtin_amdgcn_permlane32_swap(__float_as_uint(pmax), __float_as_uint(pmax), false, false);
      pmax = fmaxf(__uint_as_float(rr[0]), __uint_as_float(rr[1])); }
    float alpha = 1.f;
    if (!__all(pmax - m_reg <= THR / SC)) {
        const float mn = fmaxf(m_reg, pmax); alpha = __builtin_amdgcn_exp2f((m_reg - mn) * C); m_reg = mn;
        if (hi == 0) al[r32] = alpha;
        asm volatile("s_waitcnt lgkmcnt(0)" ::: "memory");
#pragma unroll
        for (int d = 0; d < 4; ++d)
#pragma unroll
            for (int r = 0; r < 16; ++r) o[d][r] *= al[crow(r, hi)];
    }
    const float mnC = -m_reg * C;
    float ps = 0.f;
#pragma unroll
    for (int r = 0; r < 16; ++r) { pp[r] = __builtin_amdgcn_exp2f(fmaf(pp[r], C, mnC)); ps += pp[r]; }
    { auto rr = __builtin_amdgcn_permlane32_swap(__float_as_uint(ps), __float_as_uint(ps), false, false);
      ps = __uint_as_float(rr[0]) + __uint_as_float(rr[1]); }
    l_reg = l_reg * alpha + ps;
    bf16x8 pa0, pa1;
    pack_p(pp, pa0, pa1);
#define PVD(D0) do { s16x4 l0, h0, l1, h1; tr_frag_issue<D0, 2 * HF>(vb, l0, h0); tr_frag_issue<D0, 2 * HF + 1>(vb, l1, h1); LGKM0(); \
        o[D0] = __builtin_amdgcn_mfma_f32_32x32x16_bf16(pa0, PKLH(l0, h0), o[D0], 0, 0, 0); \
        o[D0] = __builtin_amdgcn_mfma_f32_32x32x16_bf16(pa1, PKLH(l1, h1), o[D0], 0, 0, 0); } while (0)
    PVD(0); PVD(1); PVD(2); PVD(3);
#undef PVD
}

DEVI void diffattn_item(const P& p, int q0, int k0row, int seq, int h, char* lds) {
    int tid = threadIdx.x; asm volatile("" : "+v"(tid));
    const int wid = tid >> 6, lane = tid & 63, r32 = lane & 31, hi = lane >> 5;
    const u16* Q = (const u16*)(p.ws + OFF_Q); const u16* Kg = (const u16*)(p.ws + OFF_K) + (size_t)k0row * 512 + h * 128;
    const u16* Vg = (const u16*)(p.ws + OFF_V) + (size_t)k0row * 512 + h * 128;
    char* V_lds = lds; char* K_lds = lds + 2 * AT_V;
    float* al = (float*)(lds + 2 * AT_V + 2 * AT_K) + wid * 64;
    bf16x8 qr[8];
    { const u16* Qw = Q + (size_t)(q0 + wid * 32 + r32) * 512 + h * 128 + hi * 8;
#pragma unroll
      for (int d0 = 0; d0 < 8; ++d0) qr[d0] = *reinterpret_cast<const bf16x8*>(Qw + d0 * 16); }
    const int sr = tid >> 4, sc = (tid & 15) * 8;
    const int vb0 = (int)(uintptr_t)V_lds + v_rd_base(lane);
    const int vc = ((tid >> 5) & 3) * 32 + (tid & 3) * 8;
    const int kk0 = (tid >> 7) * 8 + ((tid & 31) >> 2), kk1 = kk0 + 32;
    const int vk0 = (kk0 & ~0xC) | ((kk0 & 4) << 1) | ((kk0 & 8) >> 1), vk1 = (kk1 & ~0xC) | ((kk1 & 4) << 1) | ((kk1 & 8) >> 1);
    u32x4 sk0, sk1;
#define SLOAD(kk, b) do { \
    __builtin_amdgcn_global_load_lds((const unsigned*)(Vg + (size_t)((kk) + vk0) * 512 + vc), (LAS unsigned*)(V_lds + (b) * AT_V + tid * 16), 16, 0, 0); \
    __builtin_amdgcn_global_load_lds((const unsigned*)(Vg + (size_t)((kk) + vk1) * 512 + vc), (LAS unsigned*)(V_lds + (b) * AT_V + 8192 + tid * 16), 16, 0, 0); \
    sk0 = *reinterpret_cast<const u32x4*>(Kg + (size_t)((kk) + sr) * 512 + sc); sk1 = *reinterpret_cast<const u32x4*>(Kg + (size_t)((kk) + 32 + sr) * 512 + sc); } while (0)
#define SWRITE(b) do { *reinterpret_cast<u32x4*>(K_lds + (b) * AT_K + swz256(sr, tid & 15)) = sk0; *reinterpret_cast<u32x4*>(K_lds + (b) * AT_K + swz256(32 + sr, tid & 15)) = sk1; } while (0)
    float m0 = -1e30f, m1 = -1e30f, l0 = 0.f, l1 = 0.f;
    f32x16 o0[4] = {}, o1[4] = {};
    const int NT = seq / 64;
    __syncthreads();
    SLOAD(0, 0); SWRITE(0); asm volatile("s_waitcnt vmcnt(0)" ::: "memory"); __syncthreads();
    if (NT > 1) SLOAD(64, 1);
    for (int j = 0; j < NT; ++j) {
        const int cur = j & 1;
        const char* Ks = K_lds + cur * AT_K;
        attn_half<0, 0>(Ks, qr, m0, l0, o0, vb0 + cur * AT_V, al, r32, hi);
        attn_half<1, 0>(Ks, qr, m0, l0, o0, vb0 + cur * AT_V, al, r32, hi);
        attn_half<0, 4>(Ks, qr, m1, l1, o1, vb0 + cur * AT_V, al, r32, hi);
        attn_half<1, 4>(Ks, qr, m1, l1, o1, vb0 + cur * AT_V, al, r32, hi);
        if (j + 1 < NT) SWRITE(cur ^ 1);
        asm volatile("s_waitcnt vmcnt(0)" ::: "memory");
        __syncthreads();
        if (j + 2 < NT) SLOAD((j + 2) * 64, cur);
    }
#undef SLOAD
#undef SWRITE
    int tz = threadIdx.x; asm volatile("" : "+v"(tz));
    const int wid2 = tz >> 6, lane2 = tz & 63, r32e = lane2 & 31, hie = lane2 >> 5;
    const float lam = ((const float*)(p.ws + OFF_LAM))[0];
    float* sc0 = (float*)(lds + 2 * AT_V + 2 * AT_K) + wid2 * 64; float* sc1 = sc0 + 32;
    if (hie == 0) { sc0[r32e] = 1.f / l0; sc1[r32e] = -lam / l1; }
    asm volatile("s_waitcnt lgkmcnt(0)" ::: "memory");
    float ssq[16];
#pragma unroll
    for (int r = 0; r < 16; ++r) {
        const float a = sc0[crow(r, hie)], b = sc1[crow(r, hie)]; float s = 0.f;
#pragma unroll
        for (int d = 0; d < 4; ++d) { const float v = o0[d][r] * a + o1[d][r] * b; o0[d][r] = v; s = fmaf(v, v, s); }
        ssq[r] = s;
    }
#pragma unroll
    for (int r = 0; r < 16; ++r) { float s = ssq[r]; for (int o = 16; o; o >>= 1) s += __shfl_xor(s, o); ssq[r] = rsqrtf(s * (1.f / 128.f) + 1e-6f) * 0.8f; }
    u16* mix = (u16*)(p.ws + OFF_ACT);
    const float* sg = p.subln_g;
#pragma unroll
    for (int d = 0; d < 4; ++d) {
        const float gv = sg[d * 32 + r32e];
#pragma unroll
        for (int r = 0; r < 16; ++r) mix[(size_t)(q0 + wid2 * 32 + crow(r, hie)) * 1024 + h * 128 + d * 32 + r32e] = f2bf(o0[d][r] * ssq[r] * gv);
    }
}

DEVI void chunk_scan(const float* gates, int row0, int head, int dir, float* Bq, float* av, float* pm, float& total, float& amax) {
    const int lane = threadIdx.x & 63;
    const int e0 = dir ? 127 - 2 * lane : 2 * lane, e1 = dir ? 126 - 2 * lane : 2 * lane + 1;
    const float lf0 = gates[(size_t)(row0 + e0) * 16 + (dir ? 12 : 4) + head], lf1 = gates[(size_t)(row0 + e1) * 16 + (dir ? 12 : 4) + head];
    const float li0 = gates[(size_t)(row0 + e0) * 16 + (dir ? 8 : 0) + head],  li1 = gates[(size_t)(row0 + e1) * 16 + (dir ? 8 : 0) + head];
    const float s1 = lf0 + lf1; float inc = s1;
#pragma unroll
    for (int o = 1; o < 64; o <<= 1) { const float t = __shfl_up(inc, o); if (lane >= o) inc += t; }
    const float exc = inc - s1;
    const float B0 = exc + lf0, B1 = exc + s1;
    const float a0 = li0 - B0, a1 = li1 - B1;
    const float m1 = fmaxf(a0, a1); float mx = m1;
#pragma unroll
    for (int o = 1; o < 64; o <<= 1) { const float t = __shfl_up(mx, o); if (lane >= o) mx = fmaxf(mx, t); }
    float mprev = __shfl_up(mx, 1); if (lane == 0) mprev = -1e30f;
    Bq[e0] = B0; Bq[e1] = B1; av[e0] = a0; av[e1] = a1; pm[e0] = fmaxf(mprev, a0); pm[e1] = mx;
    total = __shfl(inc, 63); amax = __shfl(mx, 63);
}

DEVI void conv_silu8(const u32x4& xm, const u32x4& x0, const u32x4& xp, const float* wc, bool hasm, bool hasp, float (&out)[8]) {
#pragma unroll
    for (int j = 0; j < 4; ++j) {
        const float w00 = wc[2 * j], w01 = wc[2 * j + 1], w10 = wc[1024 + 2 * j], w11 = wc[1024 + 2 * j + 1], w20 = wc[2048 + 2 * j], w21 = wc[2048 + 2 * j + 1];
        float a = w10 * bflo(x0[j]), b = w11 * bfhi(x0[j]);
        if (hasm) { a = fmaf(w00, bflo(xm[j]), a); b = fmaf(w01, bfhi(xm[j]), b); }
        if (hasp) { a = fmaf(w20, bflo(xp[j]), a); b = fmaf(w21, bfhi(xp[j]), b); }
        out[2 * j] = siluf_(a); out[2 * j + 1] = siluf_(b);
    }
}
DEVI void seg_edges(int t  , bool& hasm, bool& hasp) {
    hasm = !(t == 0 || t == TC); hasp = !(t == TC - 1 || t == TT - 1);
}
DEVI int chain_slot(int dir, int b, int h, int cc) { return ((dir * 2 + b) * 4 + h) * NCH + cc; }

DEVI void phase_mlstm_a(const P& p, char* lds) {
    const int tid = threadIdx.x, wid = __builtin_amdgcn_readfirstlane(tid >> 6), lane = tid & 63, r32 = lane & 31, hi = lane >> 5;
    char* Vimg = lds; char* Kf = lds + 32768; char* Kb = lds + 65536;
    float* arr = (float*)(lds + 98304);
    const float* gates = (const float*)(p.ws + OFF_GATES);
    const u16* MLQK = (const u16*)(p.ws + OFF_MLQK); const u16* MLV = (const u16*)(p.ws + OFF_MLV);
    u16* CST = (u16*)(p.ws + OFF_CST); float* NST = (float*)(p.ws + OFF_NST); u16* MLC = (u16*)(p.ws + OFF_MLC);
    float2* scal = (float2*)(p.ws + OFF_MSCAL);
    for (int it = blockIdx.x; it < NB * 4 * NCH; it += gridDim.x) {
        const int cc = it % NCH, h = (it / NCH) & 3, b = it / (NCH * 4);
        const int row0 = b * TT + cc * 128;
        __syncthreads();
        if (wid < 2) {
            float total, amax; float* a4 = arr + wid * 512;
            chunk_scan(gates, row0, h, wid, a4, a4 + 128, a4 + 256, total, amax);
            a4[384 + lane] = __expf(a4[128 + lane] - amax); a4[384 + 64 + lane] = __expf(a4[128 + 64 + lane] - amax);
            if (lane == 0) scal[chain_slot(wid, b, h, 0) + cc] = make_float2(total + amax, total);
        }
        __syncthreads();
#pragma unroll
        for (int i = 0; i < 4; ++i) {
            const int idx = tid + 512 * i, l = idx >> 4, c = (idx & 15) * 8;
            const u32x4 v = *reinterpret_cast<const u32x4*>(MLV + (size_t)(row0 + l) * 512 + h * 128 + c);
            *reinterpret_cast<u32x4*>(Vimg + (l >> 6) * 16384 + v_st(l & 63, c)) = v;
            const int t = cc * 128 + l; bool hasm, hasp; seg_edges(t, hasm, hasp);
            const u16* kp = MLQK + (size_t)(row0 + l) * 1024 + 512 + h * 128 + c;
            const u32x4 x0 = *reinterpret_cast<const u32x4*>(kp);
            const u32x4 xm = hasm ? *reinterpret_cast<const u32x4*>(kp - 1024) : x0;
            const u32x4 xp = hasp ? *reinterpret_cast<const u32x4*>(kp + 1024) : x0;
            float kv[8]; conv_silu8(xm, x0, xp, p.conv_w + 512 + h * 128 + c, hasm, hasp, kv);
            const float wf = arr[384 + l] * 0.08838834764831845f, wb = arr[512 + 384 + l] * 0.08838834764831845f;
            u32x4 of, ob, ok;
#pragma unroll
            for (int j = 0; j < 4; ++j) { of[j] = cvtpk(kv[2 * j] * wf, kv[2 * j + 1] * wf); ob[j] = cvtpk(kv[2 * j] * wb, kv[2 * j + 1] * wb);
                ok[j] = cvtpk(kv[2 * j] * 0.08838834764831845f, kv[2 * j + 1] * 0.08838834764831845f); }
            *reinterpret_cast<u32x4*>(MLC + (size_t)(row0 + l) * 1024 + 512 + h * 128 + c) = ok;
            {
                const u16* qp = kp - 512;
                const u32x4 q0 = *reinterpret_cast<const u32x4*>(qp);
                const u32x4 qm = hasm ? *reinterpret_cast<const u32x4*>(qp - 1024) : q0;
                const u32x4 qn = hasp ? *reinterpret_cast<const u32x4*>(qp + 1024) : q0;
                float qv[8]; conv_silu8(qm, q0, qn, p.conv_w + h * 128 + c, hasm, hasp, qv);
                u32x4 oq;
#pragma unroll
                for (int j = 0; j < 4; ++j) oq[j] = cvtpk(qv[2 * j], qv[2 * j + 1]);
                *reinterpret_cast<u32x4*>(MLC + (size_t)(row0 + l) * 1024 + h * 128 + c) = oq;
            }
            *reinterpret_cast<u32x4*>(Kf + (l >> 6) * 16384 + v_st(l & 63, c)) = of;
            *reinterpret_cast<u32x4*>(Kb + (l >> 6) * 16384 + v_st(l & 63, c)) = ob;
        }
        __syncthreads();
        const int dir = wid >> 2, vblk = wid & 3;
        const int va = (int)(uintptr_t)Vimg + v_rd_base(lane), ka = (int)(uintptr_t)(dir ? Kb : Kf) + v_rd_base(lane);
        f32x16 acc[4] = {};
#define ASTEP(H, KS) do { s16x4 al_, ah_, b0l, b0h, b1l, b1h, b2l, b2h, b3l, b3h; \
        if (vblk == 0) tr_frag_issue<0, KS>(va + (H) * 16384, al_, ah_); else if (vblk == 1) tr_frag_issue<1, KS>(va + (H) * 16384, al_, ah_); \
        else if (vblk == 2) tr_frag_issue<2, KS>(va + (H) * 16384, al_, ah_); else tr_frag_issue<3, KS>(va + (H) * 16384, al_, ah_); \
        tr_frag_issue<0, KS>(ka + (H) * 16384, b0l, b0h); tr_frag_issue<1, KS>(ka + (H) * 16384, b1l, b1h); \
        tr_frag_issue<2, KS>(ka + (H) * 16384, b2l, b2h); tr_frag_issue<3, KS>(ka + (H) * 16384, b3l, b3h); LGKM0(); \
        const bf16x8 af = PKLH(al_, ah_); \
        acc[0] = __builtin_amdgcn_mfma_f32_32x32x16_bf16(af, PKLH(b0l, b0h), acc[0], 0, 0, 0); \
        acc[1] = __builtin_amdgcn_mfma_f32_32x32x16_bf16(af, PKLH(b1l, b1h), acc[1], 0, 0, 0); \
        acc[2] = __builtin_amdgcn_mfma_f32_32x32x16_bf16(af, PKLH(b2l, b2h), acc[2], 0, 0, 0); \
        acc[3] = __builtin_amdgcn_mfma_f32_32x32x16_bf16(af, PKLH(b3l, b3h), acc[3], 0, 0, 0); } while (0)
        ASTEP(0, 0); ASTEP(0, 1); ASTEP(0, 2); ASTEP(0, 3); ASTEP(1, 0); ASTEP(1, 1); ASTEP(1, 2); ASTEP(1, 3);
#undef ASTEP
        u16* Cd = CST + (size_t)chain_slot(dir, b, h, cc) * 16384;
#pragma unroll
        for (int kb = 0; kb < 4; ++kb)
#pragma unroll
            for (int r = 0; r < 16; ++r) Cd[(vblk * 32 + crow(r, hi)) * 128 + kb * 32 + r32] = f2bf(acc[kb][r]);
        if (tid < 256) {
            const int d2 = tid >> 7, k = tid & 127; const char* img = d2 ? Kb : Kf; float s = 0.f;
            for (int l = 0; l < 128; ++l) s += bf2f(*reinterpret_cast<const u16*>(img + (l >> 6) * 16384 + v_st(l & 63, k & ~7) + (k & 7) * 2));
            NST[(size_t)chain_slot(d2, b, h, cc) * 128 + k] = s;
        }
    }
}

DEVI void phase_kmax(const P& p, char* lds) {
    const int tid = threadIdx.x; unsigned* lm = (unsigned*)lds;
    __syncthreads();
    if (tid < 16) lm[tid] = 0u;
    __syncthreads();
    const u16* K = (const u16*)(p.ws + OFF_K); const int hm = tid & 7;
    float mx0 = 0.f, mx1 = 0.f;
    for (int idx = blockIdx.x * NTHR + tid; idx < NTOK * 8; idx += gridDim.x * NTHR) {
        const int tok = idx >> 3; const u16* kp = K + (size_t)tok * 512 + hm * 64; float ss = 0.f;
#pragma unroll
        for (int c = 0; c < 8; ++c) { const u32x4 w = *reinterpret_cast<const u32x4*>(kp + c * 8);
#pragma unroll
            for (int j = 0; j < 4; ++j) { const float a = bflo(w[j]), b = bfhi(w[j]); ss = fmaf(a, a, ss); ss = fmaf(b, b, ss); } }
        if (tok < TT) mx0 = fmaxf(mx0, ss); else mx1 = fmaxf(mx1, ss);
    }
    atomicMax(&lm[hm], __float_as_uint(mx0)); atomicMax(&lm[8 + hm], __float_as_uint(mx1));
    __syncthreads();
    if (tid < 16) atomicMax((unsigned*)(p.ws + OFF_CNT) + 128 + tid, lm[tid]);
    __syncthreads();
}

DEVI int proc_chunk(int dir, int i) { return dir == 0 ? i : (i == 0 ? 1 : (i == 1 ? 0 : NCH + 1 - i)); }

DEVI void phase_mlstm_b(const P& p, char* lds) {
    const int tid = threadIdx.x;
    float* dec = (float*)lds; float* scl = dec + 160; float* mst = scl + 160;
    const float2* scal = (const float2*)(p.ws + OFF_MSCAL);
    u32* CST = (u32*)(p.ws + OFF_CST); float* NST = (float*)(p.ws + OFF_NST); float* MST = (float*)(p.ws + OFF_MST);
    for (int it = blockIdx.x; it < 16 * 16; it += gridDim.x) {
        const int chain = it >> 4, sub = it & 15, dir = chain >> 3;
        __syncthreads();
        if (tid == 0) {
            float m = 0.f;
            for (int i = 0; i < NCH; ++i) {
                const int cc = proc_chunk(dir, i); const float2 s = scal[chain * NCH + cc];
                const float mn = fmaxf(s.y + m, s.x);
                dec[i] = __expf(s.y + m - mn); scl[i] = __expf(s.x - mn); mst[i] = m;
                if (sub == 0) MST[chain * NCH + cc] = m;
                m = mn;
            }
        }
        __syncthreads();
        u32* base = CST + (size_t)chain * NCH * 8192 + sub * 512 + tid;
        float s0 = 0.f, s1 = 0.f;
        for (int i0 = 0; i0 < NCH; i0 += 10) {
            u32 v[10];
#pragma unroll
            for (int j = 0; j < 10; ++j) v[j] = base[(size_t)proc_chunk(dir, i0 + j) * 8192];
#pragma unroll
            for (int j = 0; j < 10; ++j) {
                base[(size_t)proc_chunk(dir, i0 + j) * 8192] = cvtpk(s0, s1);
                const float d = dec[i0 + j], sc = scl[i0 + j];
                s0 = fmaf(d, s0, sc * bflo(v[j])); s1 = fmaf(d, s1, sc * bfhi(v[j]));
            }
        }
        if (sub == 0 && tid < 128) {
            float* nb = NST + (size_t)chain * NCH * 128 + tid; float s = 0.f;
            for (int i = 0; i < NCH; ++i) { const int cc = proc_chunk(dir, i); const float v = nb[cc * 128]; nb[cc * 128] = s; s = fmaf(dec[i], s, scl[i] * v); }
        }
    }
}

DEVI void mlstm_c_item(const P& p, int it, char* lds) {
    int tid = threadIdx.x; asm volatile("" : "+v"(tid));
    const int wid = __builtin_amdgcn_readfirstlane(tid >> 6), lane = tid & 63, r32 = lane & 31, hi = lane >> 5;
    const int cc = it % NCH, h = (it / NCH) & 3, b = it / (NCH * 4);
    const int row0 = b * TT + cc * 128;
    char* Kt = lds; char* Vimg = lds + 34816; char* Ct = lds + 67584;
    float* arr = (float*)(lds + 137216);
    float* wsc = arr + 1024 + wid * 64;
    float* xb = (float*)lds;
    const float* gates = (const float*)(p.ws + OFF_GATES);
    const u16* MLC = (const u16*)(p.ws + OFF_MLC); const u16* MLV = (const u16*)(p.ws + OFF_MLV);
    const u16* CST = (const u16*)(p.ws + OFF_CST); const float* NST = (const float*)(p.ws + OFF_NST); const float* MST = (const float*)(p.ws + OFF_MST);
    __syncthreads();
    if (wid < 2) { float total, amax; float* a4 = arr + wid * 512; chunk_scan(gates, row0, h, wid, a4, a4 + 128, a4 + 256, total, amax); }
    else if (wid < 6) { const int d2 = (wid - 2) >> 1, k = ((wid - 2) & 1) * 64 + lane; arr[d2 * 512 + 384 + k] = NST[(size_t)chain_slot(d2, b, h, cc) * 128 + k]; }
#pragma unroll
    for (int i = 0; i < 4; ++i) {
        const int idx = tid + 512 * i, l = idx >> 4, ch = idx & 15, c = ch * 8;
        const u32x4 v = *reinterpret_cast<const u32x4*>(MLV + (size_t)(row0 + l) * 512 + h * 128 + c);
        *reinterpret_cast<u32x4*>(Vimg + (l >> 6) * 16384 + v_st(l & 63, c)) = v;
        const u32x4 ok = *reinterpret_cast<const u32x4*>(MLC + (size_t)(row0 + l) * 1024 + 512 + h * 128 + c);
        *reinterpret_cast<u32x4*>(Kt + swz256(l, ch)) = ok;
#pragma unroll
        for (int d2 = 0; d2 < 2; ++d2) {
            const u32x4 cv = *reinterpret_cast<const u32x4*>(CST + (size_t)chain_slot(d2, b, h, cc) * 16384 + l * 128 + c);
            *reinterpret_cast<u32x4*>(Ct + d2 * 34816 + swz256(l, ch)) = cv;
        }
    }
    const int dir = wid >> 2, qb = wid & 3, q = qb * 32 + r32;
    bf16x8 qr[8];
    { const u16* qp = MLC + (size_t)(row0 + q) * 1024 + h * 128 + hi * 8;
#pragma unroll
      for (int d0 = 0; d0 < 8; ++d0) qr[d0] = *reinterpret_cast<const bf16x8*>(qp + d0 * 16); }
    __syncthreads();
    const float* a4 = arr + dir * 512;
    const float m_st = MST[chain_slot(dir, b, h, 0) + cc];
    const float Mq = fmaxf(m_st, a4[256 + q]);
    const float inter = __expf(m_st - Mq);
    float nq = 0.f;
#pragma unroll
    for (int d0 = 0; d0 < 8; ++d0) {
        const u32x4 w = *reinterpret_cast<const u32x4*>(&qr[d0]); const float* nn = a4 + 384 + d0 * 16 + hi * 8;
#pragma unroll
        for (int j = 0; j < 4; ++j) { nq = fmaf(bflo(w[j]), nn[2 * j], nq); nq = fmaf(bfhi(w[j]), nn[2 * j + 1], nq); }
    }
    { auto rr = __builtin_amdgcn_permlane32_swap(__float_as_uint(nq), __float_as_uint(nq), false, false); nq = __uint_as_float(rr[0]) + __uint_as_float(rr[1]); }
    f32x16 o[4] = {};
    const char* Cm = Ct + dir * 34816;
#pragma unroll
    for (int dk = 0; dk < 8; ++dk)
#pragma unroll
        for (int d0 = 0; d0 < 4; ++d0) o[d0] = __builtin_amdgcn_mfma_f32_32x32x16_bf16(qr[dk], lds_b128(Cm, swz256(d0 * 32 + r32, 2 * dk + hi)), o[d0], 0, 0, 0);
    if (hi == 0) wsc[r32] = inter;
    asm volatile("s_waitcnt lgkmcnt(0)" ::: "memory");
#pragma unroll
    for (int d0 = 0; d0 < 4; ++d0)
#pragma unroll
        for (int r = 0; r < 16; ++r) o[d0][r] *= wsc[crow(r, hi)];
    const int vb = (int)(uintptr_t)Vimg + v_rd_base(lane);
    float rs = 0.f;
#define KBLK(KB) do { if (dir == 0 ? (KB) <= qb : (KB) >= qb) { \
        f32x16 pp = {}; \
        _Pragma("unroll") for (int d0 = 0; d0 < 8; ++d0) pp = __builtin_amdgcn_mfma_f32_32x32x16_bf16(lds_b128(Kt, swz256((KB) * 32 + r32, 2 * d0 + hi)), qr[d0], pp, 0, 0, 0); \
        _Pragma("unroll") for (int g = 0; g < 4; ++g) { const f32x4 av4 = *reinterpret_cast<const f32x4*>(a4 + 128 + (KB) * 32 + 8 * g + 4 * hi); \
            _Pragma("unroll") for (int j = 0; j < 4; ++j) { const int key = (KB) * 32 + 8 * g + 4 * hi + j; const bool ok = dir == 0 ? key <= q : key >= q; \
                const float sv = ok ? pp[4 * g + j] * __expf(av4[j] - Mq) : 0.f; pp[4 * g + j] = sv; rs += sv; } } \
        bf16x8 f0, f1; pack_p(pp, f0, f1); \
        { s16x4 l0, h0, l1, h1, l2, h2, l3, h3; constexpr int HH = (KB) >> 1, K0 = ((KB) & 1) * 2; \
          tr_frag_issue<0, K0>(vb + HH * 16384, l0, h0); tr_frag_issue<1, K0>(vb + HH * 16384, l1, h1); tr_frag_issue<2, K0>(vb + HH * 16384, l2, h2); tr_frag_issue<3, K0>(vb + HH * 16384, l3, h3); LGKM0(); \
          o[0] = __builtin_amdgcn_mfma_f32_32x32x16_bf16(f0, PKLH(l0, h0), o[0], 0, 0, 0); o[1] = __builtin_amdgcn_mfma_f32_32x32x16_bf16(f0, PKLH(l1, h1), o[1], 0, 0, 0); \
          o[2] = __builtin_amdgcn_mfma_f32_32x32x16_bf16(f0, PKLH(l2, h2), o[2], 0, 0, 0); o[3] = __builtin_amdgcn_mfma_f32_32x32x16_bf16(f0, PKLH(l3, h3), o[3], 0, 0, 0); \
          tr_frag_issue<0, K0 + 1>(vb + HH * 16384, l0, h0); tr_frag_issue<1, K0 + 1>(vb + HH * 16384, l1, h1); tr_frag_issue<2, K0 + 1>(vb + HH * 16384, l2, h2); tr_frag_issue<3, K0 + 1>(vb + HH * 16384, l3, h3); LGKM0(); \
          o[0] = __builtin_amdgcn_mfma_f32_32x32x16_bf16(f1, PKLH(l0, h0), o[0], 0, 0, 0); o[1] = __builtin_amdgcn_mfma_f32_32x32x16_bf16(f1, PKLH(l1, h1), o[1], 0, 0, 0); \
          o[2] = __builtin_amdgcn_mfma_f32_32x32x16_bf16(f1, PKLH(l2, h2), o[2], 0, 0, 0); o[3] = __builtin_amdgcn_mfma_f32_32x32x16_bf16(f1, PKLH(l3, h3), o[3], 0, 0, 0); } } } while (0)
    KBLK(0); KBLK(1); KBLK(2); KBLK(3);
#undef KBLK
    { auto rr = __builtin_amdgcn_permlane32_swap(__float_as_uint(rs), __float_as_uint(rs), false, false); rs = __uint_as_float(rr[0]) + __uint_as_float(rr[1]); }
    const float nqt = inter * nq + rs;
    const float den = fmaxf(fabsf(nqt), __expf(-(a4[q] + Mq)));
    if (hi == 0) wsc[32 + r32] = 1.f / den;
    asm volatile("s_waitcnt lgkmcnt(0)" ::: "memory");
#pragma unroll
    for (int d0 = 0; d0 < 4; ++d0)
#pragma unroll
        for (int r = 0; r < 16; ++r) o[d0][r] *= wsc[32 + crow(r, hi)];
    __syncthreads();
    {
        float* xd = dir ? xb : (float*)(lds + 67584);
#pragma unroll
        for (int d0 = 0; d0 < 4; ++d0)
#pragma unroll
            for (int r = 0; r < 16; ++r) xd[(qb * 32 + crow(r, hi)) * 128 + d0 * 32 + r32] = o[d0][r];
    }
    __syncthreads();
    {
        const u16* OG = (const u16*)(p.ws + OFF_OG); u16* mix = (u16*)(p.ws + OFF_ACT);
        const float* xf = (const float*)(lds + 67584);
#pragma unroll
        for (int i = 0; i < 4; ++i) {
            const int idx = tid + 512 * i, ql = idx >> 4, c = (idx & 15) * 8;
            const f32x4 f0 = *reinterpret_cast<const f32x4*>(xf + ql * 128 + c), f1 = *reinterpret_cast<const f32x4*>(xf + ql * 128 + c + 4);
            const f32x4 b0 = *reinterpret_cast<const f32x4*>(xb + ql * 128 + c), b1 = *reinterpret_cast<const f32x4*>(xb + ql * 128 + c + 4);
            const u32x4 og = *reinterpret_cast<const u32x4*>(OG + (size_t)(row0 + ql) * 512 + h * 128 + c);
            u32x4 w;
            w[0] = cvtpk((f0[0] + b0[0]) * bflo(og[0]), (f0[1] + b0[1]) * bfhi(og[0]));
            w[1] = cvtpk((f0[2] + b0[2]) * bflo(og[1]), (f0[3] + b0[3]) * bfhi(og[1]));
            w[2] = cvtpk((f1[0] + b1[0]) * bflo(og[2]), (f1[1] + b1[1]) * bfhi(og[2]));
            w[3] = cvtpk((f1[2] + b1[2]) * bflo(og[3]), (f1[3] + b1[3]) * bfhi(og[3]));
            *reinterpret_cast<u32x4*>(mix + (size_t)(row0 + ql) * 1024 + 512 + h * 128 + c) = w;
        }
    }
}

#define KSWZ(row, colB) ((row) * 256 + ((colB) ^ (((row) & 15) << 4)))
constexpr float A2_SCALE = 0.125f, A2_THR = 8.f;
DEVI void a2_partialSM(f32x16& p0, f32x16& p1, float) {
#pragma unroll
    for (int r = 0; r < 16; ++r) p0[r] = __builtin_amdgcn_exp2f(p0[r]);
}
DEVI void a2_finishSM(f32x16& p0, f32x16& p1, float& l_reg, bf16x8& pa0, bf16x8& pa1, bf16x8& pa2, bf16x8& pa3) {
#pragma unroll
    for (int r = 0; r < 16; ++r) p1[r] = __builtin_amdgcn_exp2f(p1[r]);
    float ps = 0.f;
#pragma unroll
    for (int r = 0; r < 16; ++r) ps += p0[r];
#pragma unroll
    for (int r = 0; r < 16; ++r) ps += p1[r];
    l_reg += ps;
    pack_p_perm(p0, pa0, pa1); pack_p_perm(p1, pa2, pa3);
}
DEVI void a2_qkt(f32x16& p0, f32x16& p1, const char* Ks, const bf16x8 (&qr)[4], int r32, int hi, int grp, float mnC) {
#pragma unroll
    for (int r = 0; r < 16; ++r) { p0[r] = mnC; p1[r] = mnC; }
#pragma unroll
    for (int d0 = 0; d0 < 4; ++d0) { const int cb = (grp * 64 + d0 * 16 + hi * 8) * 2;
        const bf16x8 b0 = lds_b128(Ks, KSWZ(r32, cb)), b1 = lds_b128(Ks, KSWZ(32 + r32, cb));
        p0 = __builtin_amdgcn_mfma_f32_32x32x16_bf16(b0, qr[d0], p0, 0, 0, 0);
        p1 = __builtin_amdgcn_mfma_f32_32x32x16_bf16(b1, qr[d0], p1, 0, 0, 0); }
}
#define A2_VISSUE(D0, F) do { tr_frag_issue<D0, 0>(vb, F##l0, F##h0); tr_frag_issue<D0, 1>(vb, F##l1, F##h1); tr_frag_issue<D0, 2>(vb, F##l2, F##h2); tr_frag_issue<D0, 3>(vb, F##l3, F##h3); } while (0)
#define A2_VMMA(D0, F) do { \
    o[D0] = __builtin_amdgcn_mfma_f32_32x32x16_bf16(pa0, PKLH(F##l0, F##h0), o[D0], 0, 0, 0); o[D0] = __builtin_amdgcn_mfma_f32_32x32x16_bf16(pa1, PKLH(F##l1, F##h1), o[D0], 0, 0, 0); \
    o[D0] = __builtin_amdgcn_mfma_f32_32x32x16_bf16(pa2, PKLH(F##l2, F##h2), o[D0], 0, 0, 0); o[D0] = __builtin_amdgcn_mfma_f32_32x32x16_bf16(pa3, PKLH(F##l3, F##h3), o[D0], 0, 0, 0); } while (0)
#define A2_LGKM(N) do { asm volatile("s_waitcnt lgkmcnt(" #N ")" ::: "memory"); SBAR(); } while (0)
template <int S> DEVI void a2_psm_slice(f32x16& x0, f32x16&, float) {
#pragma unroll
    for (int r = 4 * S; r < 4 * S + 4; ++r) x0[r] = __builtin_amdgcn_exp2f(x0[r]);
}
DEVI void a2_pv(f32x16 (&o)[4], int vb, const bf16x8& pa0, const bf16x8& pa1, const bf16x8& pa2, const bf16x8& pa3, f32x16& x0, f32x16& x1, float mnC) {
    s16x4 al0, ah0, al1, ah1, al2, ah2, al3, ah3, bl0, bh0, bl1, bh1, bl2, bh2, bl3, bh3;
    A2_VISSUE(0, a); A2_VISSUE(1, b);
    A2_LGKM(8); a2_psm_slice<0>(x0, x1, mnC); A2_VMMA(0, a);
    A2_VISSUE(2, a);
    A2_LGKM(8); a2_psm_slice<1>(x0, x1, mnC); A2_VMMA(1, b);
    A2_VISSUE(3, b);
    A2_LGKM(8); a2_psm_slice<2>(x0, x1, mnC); A2_VMMA(2, a);
    A2_LGKM(0); a2_psm_slice<3>(x0, x1, mnC); A2_VMMA(3, b);
}
DEVI void a2_pv_last(f32x16 (&o)[4], int vb, const bf16x8& pa0, const bf16x8& pa1, const bf16x8& pa2, const bf16x8& pa3) {
    s16x4 al0, ah0, al1, ah1, al2, ah2, al3, ah3, bl0, bh0, bl1, bh1, bl2, bh2, bl3, bh3;
    A2_VISSUE(0, a); A2_VISSUE(1, b);
    A2_LGKM(8); A2_VMMA(0, a);
    A2_VISSUE(2, a);
    A2_LGKM(8); A2_VMMA(1, b);
    A2_VISSUE(3, b);
    A2_LGKM(8); A2_VMMA(2, a);
    A2_LGKM(0); A2_VMMA(3, b);
}
constexpr int A2_T = 16384;
DEVI void a2_body(const P& p, int q0, int k0row, int seq, int h, char* lds, int tid) {
    const int GRP = __builtin_amdgcn_readfirstlane(tid >> 8); const int wid = tid >> 6, lane = tid & 63, r32 = lane & 31, hi = lane >> 5, wq = wid & 3;
    const u16* Kh = (const u16*)(p.ws + OFF_K) + (size_t)k0row * 512 + h * 128;
    const u16* Vh = (const u16*)(p.ws + OFF_V) + (size_t)k0row * 512 + h * 128;
    char* V_lds = lds; char* K_lds = lds + 3 * A2_T;
    float* wsc = (float*)(lds + 6 * A2_T) + wid * 64; float* li_l = wsc;
    float l_reg = 0.f; f32x16 o[4] = {}; bf16x8 qr[4];
    { const u16* Qw = (const u16*)(p.ws + OFF_Q) + (size_t)(q0 + wq * 32 + r32) * 512 + h * 128 + GRP * 64 + hi * 8;
#pragma unroll
      for (int d0 = 0; d0 < 4; ++d0) qr[d0] = *reinterpret_cast<const bf16x8*>(Qw + d0 * 16); }
    float mnC;
    { float qq = 0.f;
#pragma unroll
      for (int d0 = 0; d0 < 4; ++d0) { const u32x4 w = *reinterpret_cast<const u32x4*>(&qr[d0]);
#pragma unroll
          for (int j = 0; j < 4; ++j) { const float a = bflo(w[j]), b2 = bfhi(w[j]); qq = fmaf(a, a, qq); qq = fmaf(b2, b2, qq); } }
      { auto rr = __builtin_amdgcn_permlane32_swap(__float_as_uint(qq), __float_as_uint(qq), false, false); qq = __uint_as_float(rr[0]) + __uint_as_float(rr[1]); }
      const int bq = k0row >= TT ? 1 : 0;
      const float k2 = __uint_as_float(((const unsigned*)(p.ws + OFF_CNT))[128 + bq * 8 + h * 2 + GRP]);
      mnC = -sqrtf(qq * k2) * (A2_SCALE * 1.4426950408889634f) * 1.001f;
#pragma unroll
      for (int d0 = 0; d0 < 4; ++d0) { u32x4 w = *reinterpret_cast<u32x4*>(&qr[d0]);
#pragma unroll
          for (int j = 0; j < 4; ++j) w[j] = cvtpk(bflo(w[j]) * (A2_SCALE * 1.4426950408889634f), bfhi(w[j]) * (A2_SCALE * 1.4426950408889634f));
          qr[d0] = *reinterpret_cast<bf16x8*>(&w); } }
    const int vb0 = (int)(uintptr_t)V_lds + v_rd_base(lane);
    const int krow = tid >> 4, kch = (tid & 15) ^ (krow & 15);
    const int vc = ((tid >> 5) & 3) * 32 + (tid & 3) * 8;
    const int kk0 = (tid >> 7) * 8 + ((tid & 31) >> 2), kk1 = kk0 + 32;
#define A2_DMA(slot, kk) do { \
    __builtin_amdgcn_global_load_lds((const unsigned*)(Kh + (size_t)((kk) + krow) * 512 + kch * 8), (LAS unsigned*)(K_lds + (slot) * A2_T + tid * 16), 16, 0, 0); \
    __builtin_amdgcn_global_load_lds((const unsigned*)(Kh + (size_t)((kk) + 32 + krow) * 512 + kch * 8), (LAS unsigned*)(K_lds + (slot) * A2_T + 8192 + tid * 16), 16, 0, 0); \
    __builtin_amdgcn_global_load_lds((const unsigned*)(Vh + (size_t)((kk) + kk0) * 512 + vc), (LAS unsigned*)(V_lds + (slot) * A2_T + tid * 16), 16, 0, 0); \
    __builtin_amdgcn_global_load_lds((const unsigned*)(Vh + (size_t)((kk) + kk1) * 512 + vc), (LAS unsigned*)(V_lds + (slot) * A2_T + 8192 + tid * 16), 16, 0, 0); } while (0)
    f32x16 pA0, pA1, pB0, pB1; bf16x8 pa0, pa1, pa2, pa3; const int NT = seq / 64;
    __syncthreads();
    A2_DMA(0, 0); asm volatile("s_waitcnt vmcnt(0)" ::: "memory"); __syncthreads();
    A2_DMA(1, 64);
    a2_qkt(pA0, pA1, K_lds, qr, r32, hi, GRP, mnC); a2_partialSM(pA0, pA1, mnC);
    asm volatile("s_waitcnt vmcnt(0)" ::: "memory"); __syncthreads();
    int bp = 0, bc = 1, bn = 2;
#define A2_HALF(X0, X1, Y0, Y1, J) do { \
        if ((J) + 1 < NT) A2_DMA(bn, ((J) + 1) * 64); \
        SBAR(); a2_qkt(X0, X1, K_lds + bc * A2_T, qr, r32, hi, GRP, mnC); \
        a2_finishSM(Y0, Y1, l_reg, pa0, pa1, pa2, pa3); SBAR(); \
        a2_pv(o, vb0 + bp * A2_T, pa0, pa1, pa2, pa3, X0, X1, mnC); \
        asm volatile("s_waitcnt vmcnt(0)" ::: "memory"); __syncthreads(); \
        { const int t_ = bp; bp = bc; bc = bn; bn = t_; } } while (0)
    for (int j = 1; j + 1 < NT; j += 2) {
        A2_HALF(pB0, pB1, pA0, pA1, j);
        A2_HALF(pA0, pA1, pB0, pB1, j + 1);
    }
    A2_HALF(pB0, pB1, pA0, pA1, NT - 1);
    a2_finishSM(pB0, pB1, l_reg, pa0, pa1, pa2, pa3); SBAR();
    a2_pv_last(o, vb0 + bp * A2_T, pa0, pa1, pa2, pa3);
#undef A2_HALF
#undef A2_DMA
    asm volatile("s_waitcnt vmcnt(0)" ::: "memory");
    int tz = threadIdx.x; asm volatile("" : "+v"(tz));
    const int wq_e = (tz >> 6) & 3, r32e = tz & 31, hie = (tz >> 5) & 1;
    float* li_e = (float*)(lds + 6 * A2_T) + (tz >> 6) * 64;
    const float lam = ((const float*)(p.ws + OFF_LAM))[0];
    { auto rr = __builtin_amdgcn_permlane32_swap(__float_as_uint(l_reg), __float_as_uint(l_reg), false, false); l_reg = __uint_as_float(rr[0]) + __uint_as_float(rr[1]); }
    if (hie == 0) li_e[r32e] = (GRP == 0 ? 1.f : -lam) / l_reg;
    asm volatile("s_waitcnt lgkmcnt(0)" ::: "memory");
#pragma unroll
    for (int r = 0; r < 16; ++r) { const float sc_ = li_e[crow(r, hie)];
#pragma unroll
        for (int d = 0; d < 4; ++d) o[d][r] *= sc_; }
    float* xb = (float*)lds;
    __syncthreads();
    if (GRP == 1) {
#pragma unroll
        for (int d = 0; d < 4; ++d)
#pragma unroll
            for (int r = 0; r < 16; ++r) xb[(wq_e * 32 + crow(r, hie)) * 128 + d * 32 + r32e] = o[d][r];
    }
    __syncthreads();
    if (GRP == 0) {
        float ssq[16];
#pragma unroll
        for (int r = 0; r < 16; ++r) { float s_ = 0.f;
#pragma unroll
            for (int d = 0; d < 4; ++d) { const float v = o[d][r] + xb[(wq_e * 32 + crow(r, hie)) * 128 + d * 32 + r32e]; o[d][r] = v; s_ = fmaf(v, v, s_); }
            ssq[r] = s_; }
#pragma unroll
        for (int r = 0; r < 16; ++r) { float s_ = ssq[r]; for (int of = 16; of; of >>= 1) s_ += __shfl_xor(s_, of); ssq[r] = rsqrtf(s_ * (1.f / 128.f) + 1e-6f) * 0.8f; }
        u16* mix = (u16*)(p.ws + OFF_ACT);
#pragma unroll
        for (int d = 0; d < 4; ++d) { const float gv = p.subln_g[d * 32 + r32e];
#pragma unroll
            for (int r = 0; r < 16; ++r) mix[(size_t)(q0 + wq_e * 32 + crow(r, hie)) * 1024 + h * 128 + d * 32 + r32e] = f2bf(o[d][r] * ssq[r] * gv); }
    }
}
DEVI void phase_attn(const P& p, char* lds) {
    const int G = gridDim.x;
    for (int it = blockIdx.x; it < 1024 + 16; it += G) {
        int q0, k0, seq, h;
        if (it < 1024) {
            int bh, qb;
            if ((G & 7) == 0) { bh = it & 7; qb = it >> 3; } else { bh = it >> 7; qb = it & 127; }
            const int b = bh >> 2; h = bh & 3; q0 = b * TT + TC + qb * 128; k0 = b * TT; seq = TT;
        } else { const int j = it - 1024, b = j >> 3; h = (j >> 1) & 3; q0 = b * TT + (j & 1) * 128; k0 = b * TT; seq = TC; }
        int tid = threadIdx.x; asm volatile("" : "+v"(tid));
        a2_body(p, q0, k0, seq, h, lds, tid);
    }
}
DEVI void phase_mlstm_c(const P& p, char* lds) {
    for (int it = blockIdx.x; it < NB * 4 * NCH; it += gridDim.x) mlstm_c_item(p, it, lds);
}

DEVI void tail_bg(const P& p, char* lds, int nunits, int first, int nitems) {
    const int G = gridDim.x, c = blockIdx.x, full = nunits / G, rem = nunits - full * G;
    __syncthreads();
    if (rem == 0) { for (int it = c; it < nitems; it += G) bg_item(p, first + it, (float*)lds); }
    else if (c >= rem) { for (int it = c - rem; it < nitems; it += G - rem) bg_item(p, first + it, (float*)lds); }
    __syncthreads();
}
DEVI void tail_convert(const P& p, char* lds, int layer, int nunits) {
    const int G = gridDim.x, c = blockIdx.x, full = nunits / G, rem = nunits - full * G;
    __syncthreads();
    if (rem == 0) { for (int it = c; it < N0_EXP; it += G) convert_expert_item(p, layer, it, (float*)lds); }
    else if (c >= rem) { for (int it = c - rem; it < N0_EXP; it += G - rem) convert_expert_item(p, layer, it, (float*)lds); }
    __syncthreads();
}
DEVI void phase_convert_l1(const P& p, char* lds) {
    for (int it = blockIdx.x; it < N0_EXP; it += gridDim.x) convert_expert_item(p, 1, it, (float*)lds);
}

constexpr int NPHASE = 19;
__global__ void __launch_bounds__(NTHR, 2) fwd_kernel(P p_) {
    extern __shared__ __attribute__((aligned(16))) char lds[];
    volatile LAS unsigned* st = (volatile LAS unsigned*)(lds + LDS_BYTES - 16);
    if (threadIdx.x == 0) { st[0] = 0u; st[1] = 0u; st[2] = 0u; st[3] = 0u; }
    __syncthreads();
    const int lo = p_.ph_lo, hi = p_.ph_hi;
    XcdBarrier bar; bar.bar = (unsigned*)(p_.ws + OFF_BAR); bar.x = 0; bar.st = st;
    if (hi - lo > 1) bar = xcd_barrier_post((unsigned*)(p_.ws + OFF_BAR), st);
#if defined(__HIP_DEVICE_COMPILE__)
#define PARAMS() const __attribute__((address_space(4))) P* kp_ = (const __attribute__((address_space(4))) P*)__builtin_amdgcn_kernarg_segment_ptr(); asm volatile("" : "+s"(kp_)); const P p = *kp_
#else
#define PARAMS() const P p = p_
#endif
#ifndef PHSEL
#define PHON(k) true
#else
#define PHON(k) ((k) == PHSEL)
#endif
#define IN(k) (lo <= (k) && (k) < hi)
#define SEAM(k) do { if (IN(k) && IN((k) + ((k) == 5 ? 2 : 1))) xcd_barrier(bar); } while (0)
    if (PHON(0) && IN(0)) { PARAMS(); phase_prologue(p, lds); if (((PROBE_DUP) >> 0) & 1u) { phase_prologue(p, lds); } }            SEAM(0);
    if (PHON(1) && IN(1)) { PARAMS(); phase_norm<0>(p, lds); if (((PROBE_DUP) >> 1) & 1u) { phase_norm<0>(p, lds); } }             SEAM(1);
    if (PHON(2) && IN(2)) { PARAMS(); phase_inproj(p, lds); tail_convert(p, lds, 0, (NTOK / 256) * 14); if (((PROBE_DUP) >> 2) & 1u) { phase_inproj(p, lds); } }              SEAM(2);
    if (PHON(3) && IN(3)) { PARAMS(); phase_mlstm_a(p, lds); tail_bg(p, lds, NB * 4 * NCH, 0, N0_WOUT); if (((PROBE_DUP) >> 3) & 1u) { phase_mlstm_a(p, lds); } }             SEAM(3);
    if (PHON(4) && IN(4)) { PARAMS(); phase_kmax(p, lds); phase_mlstm_b(p, lds); if (((PROBE_DUP) >> 4) & 1u) { xcd_barrier(bar); phase_mlstm_a(p, lds); xcd_barrier(bar); phase_mlstm_b(p, lds); } }             SEAM(4);
    if (PHON(5) && IN(5)) { PARAMS(); phase_attn(p, lds); phase_mlstm_c(p, lds); tail_bg(p, lds, NB * 4 * NCH, N0_WOUT, N0_FN); if (((PROBE_DUP) >> 5) & 1u) { phase_attn(p, lds); } if (((PROBE_DUP) >> 6) & 1u) { phase_mlstm_c(p, lds); } }   SEAM(5);
    if (PHON(7) && IN(7)) { PARAMS(); phase_outproj(p, lds); tail_convert(p, lds, 1, (NTOK / 256) * 4); if (((PROBE_DUP) >> 7) & 1u) { phase_outproj(p, lds); } }             SEAM(7);
    if (PHON(8) && IN(8)) { PARAMS(); phase_norm<1>(p, lds); if (((PROBE_DUP) >> 8) & 1u) { phase_norm<1, true>(p, lds); } }             SEAM(8);
    if (PHON(9) && IN(9)) { PARAMS(); phase_moe_up(p, 0, lds); if (((PROBE_DUP) >> 9) & 1u) { phase_moe_up(p, 0, lds); } }           SEAM(9);
    if (PHON(10) && IN(10)) { PARAMS(); phase_moe_down(p, 0, lds); if (((PROBE_DUP) >> 10) & 1u) { phase_moe_down<true>(p, 0, lds); } }        SEAM(10);
    if (PHON(11) && IN(11)) { PARAMS(); phase_norm<2>(p, lds); if (((PROBE_DUP) >> 11) & 1u) { phase_norm<2>(p, lds); } } SEAM(11);
    if (PHON(12) && IN(12)) { PARAMS(); phase_fnet_gemm(p, lds); if (((PROBE_DUP) >> 12) & 1u) { phase_fnet_gemm(p, lds); } }          SEAM(12);
    if (PHON(13) && IN(13)) { PARAMS(); phase_fft1(p, lds); if (((PROBE_DUP) >> 13) & 1u) { phase_fft1(p, lds); } }               SEAM(13);
    if (PHON(14) && IN(14)) { PARAMS(); phase_fft2(p, lds); if (((PROBE_DUP) >> 14) & 1u) { phase_fft2<true>(p, lds); } }               SEAM(14);
    if (PHON(15) && IN(15)) { PARAMS(); phase_norm<3>(p, lds); if (((PROBE_DUP) >> 15) & 1u) { phase_norm<3, true>(p, lds); } }            SEAM(15);
    if (PHON(16) && IN(16)) { PARAMS(); phase_moe_up(p, 1, lds); if (((PROBE_DUP) >> 16) & 1u) { phase_moe_up(p, 1, lds); } }          SEAM(16);
    if (PHON(17) && IN(17)) { PARAMS(); phase_moe_down(p, 1, lds); if (((PROBE_DUP) >> 17) & 1u) { phase_moe_down<true>(p, 1, lds); } }        SEAM(17);
    if (PHON(18) && IN(18)) { PARAMS(); phase_norm<4>(p, lds); if (((PROBE_DUP) >> 18) & 1u) { phase_norm<4>(p, lds); } }
#undef IN
#undef SEAM
}

#ifndef ONE_LAUNCH
#define ONE_LAUNCH 1
#endif
extern "C" void kernel_launch(void* const* d_in, const int* in_sizes, int n_in, void* d_out, int out_size, void* d_ws, size_t ws_size, hipStream_t stream) {
    static int grid = 0;
    if (grid == 0) {
        if (n_in != 21 || out_size != NLAT * DM || ws_size < OFF_END) { fprintf(stderr, "kernel_launch: unexpected shapes (n_in %d out %d ws %zu need %zu)\n", n_in, out_size, ws_size, (size_t)OFF_END); grid = -1; return; }
        int dev = 0, cus = 0;
        if (hipGetDevice(&dev) != hipSuccess || hipDeviceGetAttribute(&cus, hipDeviceAttributeMultiprocessorCount, dev) != hipSuccess) { grid = -1; return; }
        if (hipFuncSetAttribute((const void*)fwd_kernel, hipFuncAttributeMaxDynamicSharedMemorySize, LDS_BYTES) != hipSuccess) { fprintf(stderr, "kernel_launch: hipFuncSetAttribute failed\n"); grid = -1; return; }
        int per_cu = 0;
        if (hipOccupancyMaxActiveBlocksPerMultiprocessor(&per_cu, (const void*)fwd_kernel, NTHR, LDS_BYTES) != hipSuccess || per_cu < 1) { fprintf(stderr, "kernel_launch: occupancy query says %d\n", per_cu); (void)hipGetLastError(); grid = -1; return; }
        grid = cus;
    }
    if (grid < 0) return;
    (void)hipMemsetAsync(d_ws, 0, ZERO_BYTES, stream);
    P p{};
    const float* const* in = (const float* const*)d_in;
    p.x = in[0]; p.c = in[1]; p.ctx = in[2]; p.c_ctx = in[3]; p.ada_w = in[4]; p.ada_b = in[5]; p.nmix_g = in[6]; p.nffn_g = in[7];
    p.w_in = in[8]; p.w_out = in[9]; p.conv_w = in[10]; p.gate_b = in[11]; p.lamv = in[12]; p.subln_g = in[13]; p.w_fnet = in[14];
    p.router_w = in[15]; p.router_b = in[16]; p.w_gate = in[17]; p.w_up = in[18]; p.w_down = in[19]; p.final_g = in[20];
    p.out = (float*)d_out; p.ws = (char*)d_ws;
#if ONE_LAUNCH
    p.ph_lo = 0; p.ph_hi = NPHASE;
    hipLaunchKernelGGL(fwd_kernel, dim3(grid), dim3(NTHR), LDS_BYTES, stream, p);
#else
    for (int k = 0; k < NPHASE; ++k) { p.ph_lo = k; p.ph_hi = k + 1; hipLaunchKernelGGL(fwd_kernel, dim3(grid), dim3(NTHR), LDS_BYTES, stream, p); }
#endif
}
```

```cpp
#include <hip/hip_runtime.h>
#include <stdint.h>
#include <stdio.h>

#define DEVI __device__ __forceinline__
#define PROBE_DUP (0u)
typedef unsigned short u16;
typedef unsigned int u32;
using bf16x8 = __attribute__((ext_vector_type(8))) short;
using s16x4  = __attribute__((ext_vector_type(4))) short;
using f32x16 = __attribute__((ext_vector_type(16))) float;
using f32x4  = __attribute__((ext_vector_type(4))) float;
using u32x4  = __attribute__((ext_vector_type(4))) unsigned;
using u32x2  = __attribute__((ext_vector_type(2))) unsigned;

constexpr int DM = 1024, NB = 2, TL = 16384, TC = 256, TT = TL + TC, NTOK = NB * TT, NLAT = NB * TL;
constexpr int NCH = TT / 128;
constexpr int NTHR = 512;
constexpr int LDS_BYTES = 147456;

constexpr size_t al256(size_t x) { return (x + 255) / 256 * 256; }
constexpr size_t OFF_BAR   = 0;
constexpr size_t OFF_CNT   = 16384;
constexpr size_t ZERO_BYTES = 20480;
constexpr size_t OFF_MOD   = ZERO_BYTES;
constexpr size_t OFF_ROPER = OFF_MOD + al256(2 * 3 * 6144 * 4);
constexpr size_t OFF_ROPEC = OFF_ROPER + 256 * 16 * 8;
constexpr size_t OFF_TW    = OFF_ROPEC + 64 * 16 * 8;
constexpr size_t OFF_DFTC  = OFF_TW + 16384 * 8;
constexpr size_t OFF_DFTS  = OFF_DFTC + 32768;
constexpr size_t OFF_LAM   = OFF_DFTS + 32768;
constexpr size_t OFF_WG16  = OFF_LAM + 256;
constexpr size_t OFF_MSCAL = OFF_WG16 + 65536;
constexpr size_t OFF_MST   = OFF_MSCAL + al256(16 * NCH * 8);
constexpr size_t OFF_WINT  = OFF_MST + al256(16 * NCH * 4);
constexpr size_t OFF_WOUTT = OFF_WINT + (size_t)3584 * 1024 * 2;
constexpr size_t OFF_FNT   = OFF_WOUTT + (size_t)1024 * 1024 * 2;
constexpr size_t OFF_WGU   = OFF_FNT + (size_t)2048 * 1024 * 2;
constexpr size_t OFF_WDT   = OFF_WGU + (size_t)16 * 1024 * 1024 * 2;
constexpr size_t OFF_ACT   = OFF_WDT + (size_t)16 * 1024 * 512 * 2;
constexpr size_t SZ_ACT    = (size_t)NTOK * 1024 * 2;
constexpr size_t OFF_XC    = OFF_ACT + SZ_ACT;
constexpr size_t OFF_GATES = OFF_XC + (size_t)NB * TC * 1024 * 4;
constexpr size_t OFF_TOKW  = OFF_GATES + (size_t)NTOK * 16 * 4;
constexpr size_t OFF_LIST  = OFF_TOKW + al256((size_t)NTOK * 8);
constexpr size_t OFF_NST   = OFF_LIST + (size_t)24 * NTOK * 4;
constexpr size_t OFF_CST   = OFF_NST + (size_t)16 * NCH * 128 * 4;
constexpr size_t SZ_CST    = (size_t)16 * NCH * 16384 * 2;
constexpr size_t OFF_BIG   = OFF_CST + SZ_CST;
constexpr size_t OFF_Q     = OFF_BIG;
constexpr size_t OFF_K     = OFF_Q + (size_t)NTOK * 512 * 2;
constexpr size_t OFF_V     = OFF_K + (size_t)NTOK * 512 * 2;
constexpr size_t OFF_MLQK  = OFF_V + (size_t)NTOK * 512 * 2;
constexpr size_t OFF_MLV   = OFF_MLQK + (size_t)NTOK * 1024 * 2;
constexpr size_t OFF_OG    = OFF_MLV + (size_t)NTOK * 512 * 2;
constexpr size_t OFF_MLC   = OFF_OG + (size_t)NTOK * 512 * 2;
constexpr size_t OFF_END   = OFF_MLC + (size_t)NTOK * 1024 * 2;
constexpr size_t OFF_HE    = OFF_BIG;
constexpr size_t OFF_ZR    = OFF_BIG;
constexpr size_t OFF_ZI    = OFF_ZR + (size_t)NLAT * 1024 * 2;
constexpr size_t OFF_WGU1  = OFF_MLV + (size_t)2 * 1024 * 1024;
constexpr size_t OFF_WDT1  = OFF_WGU1 + (size_t)16 * 1024 * 1024 * 2;
static_assert(OFF_WDT1 + (size_t)16 * 1024 * 512 * 2 <= OFF_MLC && OFF_WGU1 >= OFF_BIG + (size_t)NLAT * 2048 * 2, "layer-1 expert region");
constexpr size_t OFF_YR    = OFF_CST;
constexpr size_t OFF_YI    = OFF_ACT;
static_assert((size_t)NLAT * 1024 * 2 <= SZ_CST && (size_t)NLAT * 1024 * 2 <= SZ_ACT, "alias sizes");
static_assert(OFF_END < (size_t)508 * 1024 * 1024, "workspace");

struct P {
    const float *x, *c, *ctx, *c_ctx, *ada_w, *ada_b, *nmix_g, *nffn_g, *w_in, *w_out, *conv_w, *gate_b, *lamv, *subln_g,
                *w_fnet, *router_w, *router_b, *w_gate, *w_up, *w_down, *final_g;
    float* out;
    char* ws;
    int ph_lo, ph_hi;
};

#define XB_TMO      128
#define XB_XCNT(j)  (256  + 64 * (j))
#define XB_XSUB(j)  (1280 + 64 * (j))
#define XB_XGEN(j)  (2304 + 64 * (j))
#define XB_TOP      3328
#define XB_TOPGEN   3392
#define XCD_BAR_WORDS 3456
#define XB_SPIN_CAP (1u << 18)
#define LAS __attribute__((address_space(3)))

__device__ __forceinline__ unsigned xb_ld(unsigned* p)              { return __hip_atomic_load(p, __ATOMIC_RELAXED, __HIP_MEMORY_SCOPE_AGENT); }
__device__ __forceinline__ unsigned xb_add(unsigned* p, unsigned v) { return __hip_atomic_fetch_add(p, v, __ATOMIC_RELAXED, __HIP_MEMORY_SCOPE_AGENT); }
__device__ __forceinline__ unsigned xb_xcc_id() { return (unsigned)__builtin_amdgcn_s_getreg((3 << 11) | 20) & 0xFu; }
#define XB_SPIN(cond, bar) do { unsigned _sp = 0; while (cond) { __builtin_amdgcn_s_sleep(1); \
    if ((++_sp & 255u) == 0u) { if (xb_ld(&(bar)[XB_TMO])) break; if (_sp > XB_SPIN_CAP) { atomicAdd(&(bar)[XB_TMO], 1u); break; } } } } while (0)

struct XcdBarrier { unsigned* bar; unsigned x; volatile LAS unsigned* st; };

__device__ __forceinline__ XcdBarrier xcd_barrier_post(unsigned* bar, volatile LAS unsigned* st) {
    XcdBarrier b; b.bar = bar; b.x = xb_xcc_id(); b.st = st;
    if (threadIdx.x == 0) (void)xb_add(&bar[XB_XCNT(b.x)], 1u);
    return b;
}
__device__ __forceinline__ void xcd_barrier_complete(unsigned* bar, unsigned x, unsigned& nloc, unsigned& nx) {
    const unsigned G = gridDim.x * gridDim.y * gridDim.z;
    unsigned sum, cnt, mine, sp = 0u;
    for (;;) {
        sum = 0u; cnt = 0u; mine = 0u;
#pragma unroll
        for (unsigned j = 0; j < 16; ++j) { const unsigned c = xb_ld(&bar[XB_XCNT(j)]); sum += c; cnt += (c > 0u) ? 1u : 0u; mine = (j == x) ? c : mine; }
        if (sum == G) break;
        __builtin_amdgcn_s_sleep(1);
        if ((++sp & 255u) == 0u) { if (xb_ld(&bar[XB_TMO])) break; if (sp > XB_SPIN_CAP) { atomicAdd(&bar[XB_TMO], 1u); break; } }
    }
    nloc = mine > 0u ? mine : 1u; nx = cnt > 0u ? cnt : 1u;
}
__device__ __forceinline__ void xcd_barrier(const XcdBarrier& b) {
    asm volatile("s_waitcnt vmcnt(0)" ::: "memory");
    __syncthreads();
    if (threadIdx.x == 0) {
        unsigned* bar = b.bar;
        __builtin_amdgcn_s_waitcnt(0);
        unsigned nloc = b.st[0], nx = b.st[1];
        if (nloc == 0u) { xcd_barrier_complete(bar, b.x, nloc, nx); b.st[0] = nloc; b.st[1] = nx; }
        const unsigned old = xb_add(&bar[XB_XSUB(b.x)], 1u);
        const unsigned gen = old / nloc;
        if (old + 1u == (gen + 1u) * nloc) {
            __builtin_amdgcn_fence(__ATOMIC_RELEASE, "agent");
            asm volatile("s_waitcnt vmcnt(0)" ::: "memory");
            const unsigned og = xb_add(&bar[XB_TOP], 1u);
            const unsigned tg = og / nx;
            if (og + 1u == (tg + 1u) * nx) xb_add(&bar[XB_TOPGEN], 1u);
            else XB_SPIN(xb_ld(&bar[XB_TOPGEN]) == tg, bar);
            __builtin_amdgcn_fence(__ATOMIC_ACQUIRE, "agent");
            xb_add(&bar[XB_XGEN(b.x)], 1u);
            asm volatile("s_waitcnt vmcnt(0)" ::: "memory");
        } else {
            XB_SPIN(xb_ld(&bar[XB_XGEN(b.x)]) == gen, bar);
            __builtin_amdgcn_fence(__ATOMIC_ACQUIRE, "agent");
            asm volatile("s_waitcnt vmcnt(0)" ::: "memory");
        }
    }
    __syncthreads();
}

DEVI u16 f2bf(float f) { u32 u = __float_as_uint(f); u += 0x7fffu + ((u >> 16) & 1u); return (u16)(u >> 16); }
DEVI float bf2f(u32 h) { return __uint_as_float(h << 16); }
DEVI u32 cvtpk(float lo, float hi) { u32 r; asm("v_cvt_pk_bf16_f32 %0, %1, %2" : "=v"(r) : "v"(lo), "v"(hi)); return r; }
DEVI float bflo(u32 w) { return __uint_as_float(w << 16); }
DEVI float bfhi(u32 w) { return __uint_as_float(w & 0xffff0000u); }
DEVI int crow(int r, int hi) { return (r & 3) + 8 * (r >> 2) + 4 * hi; }
DEVI float wave_sum(float v) { for (int o = 32; o; o >>= 1) v += __shfl_xor(v, o); return v; }
DEVI float wave_max(float v) { for (int o = 32; o; o >>= 1) v = fmaxf(v, __shfl_xor(v, o)); return v; }
DEVI float sigmoidf_(float x) { return __builtin_amdgcn_rcpf(1.f + __expf(-x)); }
DEVI float siluf_(float x) { return x * __builtin_amdgcn_rcpf(1.f + __expf(-x)); }
DEVI float logsigmoidf_(float x) { return fminf(x, 0.f) - log1pf(__expf(-fabsf(x))); }
#define SBAR() __builtin_amdgcn_sched_barrier(0)

DEVI void sincos2pi(double frac, double& s, double& c) {
    frac -= floor(frac);
    double q = rint(frac * 4.0);
    double r = (frac - q * 0.25) * 6.283185307179586476925;
    double r2 = r * r;
    double sr = r * (1.0 + r2 * (-1.0 / 6 + r2 * (1.0 / 120 + r2 * (-1.0 / 5040 + r2 * (1.0 / 362880 + r2 * (-1.0 / 39916800 + r2 * (1.0 / 6227020800.0 + r2 * (-1.0 / 1307674368000.0))))))));
    double cr = 1.0 + r2 * (-0.5 + r2 * (1.0 / 24 + r2 * (-1.0 / 720 + r2 * (1.0 / 40320 + r2 * (-1.0 / 3628800 + r2 * (1.0 / 479001600.0 + r2 * (-1.0 / 87178291200.0 + r2 * (1.0 / 20922789888000.0))))))));
    int qi = ((int)q) & 3;
    if (qi == 0) { s = sr; c = cr; } else if (qi == 1) { s = cr; c = -sr; } else if (qi == 2) { s = -sr; c = -cr; } else { s = -cr; c = sr; }
}

DEVI u16* xs_ptr(const P& p, int layer, int tok) {
    const int row = layer == 0 ? tok : (tok >> 14) * TT + TC + (tok & (TL - 1));
    return (u16*)(p.ws + OFF_MLC) + (size_t)row * DM;
}
DEVI f32x4 bf4_to_f32(u32x2 w) { f32x4 v; v[0] = bflo(w[0]); v[1] = bfhi(w[0]); v[2] = bflo(w[1]); v[3] = bfhi(w[1]); return v; }
DEVI const float* xin_ptr(const P& p, int tok) {
    int b = tok >= TT ? 1 : 0, t = tok - b * TT;
    if (t < TC) return p.ctx + (size_t)(b * TC + t) * DM;
    return p.x + (size_t)(b * TL + t - TC) * DM;
}
DEVI int modsel(int layer, int tok) {
    if (layer == 0) { int b = tok >= TT ? 1 : 0, t = tok - b * TT; return t < TC ? 2 : b; }
    return tok >> 14;
}

DEVI int swz128(int row, int chunk) { return row * 144 + (chunk << 4); }
DEVI int swz256(int row, int chunk) { return row * 272 + (chunk << 4); }
DEVI int v_st(int k, int c) { const int kk = (k & ~0xC) | ((k & 4) << 1) | ((k & 8) >> 1); return ((kk >> 3) * 4 + (c >> 5)) * 512 + ((kk & 7) * 32 + (c & 31)) * 2; }
DEVI int v_rd_base(int lane) { return ((lane & 3) << 3) | (((lane >> 2) & 3) << 6) | (((lane >> 4) & 1) << 5) | (((lane >> 5) & 1) << 8); }
constexpr int v_rd_off(int d0, int ks, int half) { return d0 * 512 + ks * 4096 + half * 2048; }
template <int OFF> DEVI s16x4 tr_read(int vb) {
    s16x4 r; asm volatile("ds_read_b64_tr_b16 %0, %1 offset:%2" : "=&v"(r) : "v"(vb), "i"(OFF) : "memory"); return r;
}
#define PKLH(L, H) (bf16x8){L[0], L[1], L[2], L[3], H[0], H[1], H[2], H[3]}
template <int D0, int KS> DEVI void tr_frag_issue(int vb, s16x4& l, s16x4& h) { l = tr_read<v_rd_off(D0, KS, 0)>(vb); h = tr_read<v_rd_off(D0, KS, 1)>(vb); }
#define LGKM0() do { asm volatile("s_waitcnt lgkmcnt(0)" ::: "memory"); SBAR(); } while (0)

DEVI bf16x8 lds_b128(const char* base, int off) { return *reinterpret_cast<const bf16x8*>(base + off); }

DEVI void pack_p(const f32x16& pp, bf16x8& f0, bf16x8& f1) {
#define PK4(BASE, OUT) do { unsigned a0 = cvtpk(pp[BASE + 0], pp[BASE + 1]), a1 = cvtpk(pp[BASE + 2], pp[BASE + 3]);   \
    unsigned b0 = cvtpk(pp[BASE + 4], pp[BASE + 5]), b1 = cvtpk(pp[BASE + 6], pp[BASE + 7]);                            \
    auto r0 = __builtin_amdgcn_permlane32_swap(a0, b0, false, false); auto r1 = __builtin_amdgcn_permlane32_swap(a1, b1, false, false); \
    u32x4 w = {r0[0], r1[0], r0[1], r1[1]}; OUT = *reinterpret_cast<bf16x8*>(&w); } while (0)
    PK4(0, f0); PK4(8, f1);
#undef PK4
}

DEVI void pack_p_perm(const f32x16& pp, bf16x8& f0, bf16x8& f1) {
    u32x4 a, b;
    a[0] = cvtpk(pp[0], pp[1]); a[1] = cvtpk(pp[2], pp[3]); a[2] = cvtpk(pp[4], pp[5]); a[3] = cvtpk(pp[6], pp[7]);
    b[0] = cvtpk(pp[8], pp[9]); b[1] = cvtpk(pp[10], pp[11]); b[2] = cvtpk(pp[12], pp[13]); b[3] = cvtpk(pp[14], pp[15]);
    f0 = *reinterpret_cast<bf16x8*>(&a); f1 = *reinterpret_cast<bf16x8*>(&b);
}
namespace g8 {
constexpr int BM = 256, BK = 64, HALF = 128, HTB = HALF * BK * 2, STAGE_BYTES = 8 * HTB, NXCD = 8, WGM = 8;
DEVI int lds_byte(int r, int c) { const int st = (r >> 4) * 2 + (c >> 5), rr = r & 15, cc = c & 31, ob = rr * 64 + cc * 2; return st * 1024 + (ob ^ (((ob >> 9) & 1) << 5)); }
DEVI void stage_rc(int b, int& R, int& C) { const int st = b / 1024, sb = b % 1024, swz = sb ^ (((sb >> 9) & 1) << 5); R = (st >> 1) * 16 + swz / 64; C = (st & 1) * 32 + (swz % 64) / 2; }
DEVI int perm32(int rho) { const int n = rho >> 4, i = rho & 15; return 8 * (i >> 2) + 4 * n + (i & 3); }
struct Unit { int pm, pn; const char* B0; const char* B1; int cls, r0, ncls; };
DEVI bool tile_order(int i, int G, int c, int nM, int nN, int& pm, int& pn) {
    const int nwg = nM * nN; const long L = (long)i * G + c; if (L >= nwg) return false;
    int wgid = (int)L; { const int q = nwg / NXCD, r = nwg % NXCD, xcd = wgid % NXCD, off = wgid / NXCD; wgid = (xcd < r ? xcd * (q + 1) : r * (q + 1) + (xcd - r) * q) + off; }
    const int nig = WGM * nN, gid = wgid / nig, fm = gid * WGM, gsz = (nM - fm) < WGM ? (nM - fm) : WGM;
    pm = fm + ((wgid % nig) % gsz); pn = (wgid % nig) / gsz; return true;
}
typedef float f32x4v __attribute__((ext_vector_type(4)));
template <class Epi, class Sched, int NT = 16  , int LDA = 2048  >
DEVI void gemm_phase(LAS unsigned char* lds, const char* Abase, int ldbB  , int ksplit  , const Sched& S, const Epi& E) {
    const int tid = threadIdx.x, wid = __builtin_amdgcn_readfirstlane(tid >> 6), lane = tid & 63, wr = wid >> 2, wc = wid & 3, fr = lane & 15, fq = lane >> 4;
    constexpr int nt = NT;
    unsigned voffB[2];
#pragma unroll
    for (int i = 0; i < 2; ++i) { int R, C; stage_rc(tid * 16 + i * 8192, R, C); const int Rb = Epi::PERM ? ((R & ~31) + perm32(R & 31)) : R; voffB[i] = (unsigned)(Rb * ldbB + C * 2); }
    const size_t kstep = (size_t)(BK * 2);
    const size_t hstepB = (size_t)HALF * ldbB;
    const unsigned ldsw = (unsigned)wid * 1024u;
    const int aoff = lds_byte(wr * 64 + fr, fq * 8), boff = lds_byte(wc * 32 + fr, fq * 8);
#define G8_SA(b, h) (((b) * 2 + (h)) * HTB)
#define G8_SB(b, h) ((4 + (b) * 2 + (h)) * HTB)
#define G8_STAGE(bufoff, gbase, voff) do { _Pragma("unroll") for (int _i = 0; _i < 2; ++_i) \
        __builtin_amdgcn_global_load_lds((const unsigned*)((const char*)(gbase) + (voff)[_i]), (LAS unsigned*)(lds + (bufoff) + ldsw + _i * 8192), 16, 0, 0); } while (0)
#define G8_LDA(dst, b, h) do { _Pragma("unroll") for (int m = 0; m < 4; ++m) _Pragma("unroll") for (int k = 0; k < 2; ++k) dst[m][k] = *(const LAS bf16x8*)(lds + G8_SA(b, h) + aoff + m * 2048 + k * 1024); } while (0)
#define G8_LDB(dst, b, h) do { _Pragma("unroll") for (int n = 0; n < 2; ++n) _Pragma("unroll") for (int k = 0; k < 2; ++k) dst[n][k] = *(const LAS bf16x8*)(lds + G8_SB(b, h) + boff + n * 2048 + k * 1024); } while (0)
#define G8_MMA(ai, bj, At, Bt) do { __builtin_amdgcn_s_setprio(1); _Pragma("unroll") for (int m = 0; m < 4; ++m) _Pragma("unroll") for (int n = 0; n < 2; ++n) _Pragma("unroll") for (int k = 0; k < 2; ++k) \
        acc[ai][bj][m][n] = __builtin_amdgcn_mfma_f32_16x16x32_bf16(Bt[n][k], At[m][k], acc[ai][bj][m][n], 0, 0, 0); __builtin_amdgcn_s_setprio(0); } while (0)
#define G8_WAIT_V(n) asm volatile("s_waitcnt vmcnt(" #n ")" ::: "memory")
#define G8_WAIT_L(n) asm volatile("s_waitcnt lgkmcnt(" #n ")" ::: "memory")
#define G8_BAR __builtin_amdgcn_s_barrier()
#define G8_SCHED __builtin_amdgcn_sched_barrier(0)
#define G8_BPTR(u, kt) (((kt) < ksplit ? (u).B0 : (u).B1) + (size_t)(kt) * kstep)
    Unit cur, nxt; int ui = 0;
    if (!S.next(0, cur)) return;
    f32x4v acc[2][2][4][2];
#pragma unroll
    for (int a = 0; a < 2; ++a)
#pragma unroll
        for (int b = 0; b < 2; ++b)
#pragma unroll
            for (int m = 0; m < 4; ++m)
#pragma unroll
                for (int n = 0; n < 2; ++n) acc[a][b][m][n] = (f32x4v){0.f, 0.f, 0.f, 0.f};
    bf16x8 At[4][2], B0[2][2], B1[2][2];
    unsigned voffA[2]; unsigned vs[2][2];
    constexpr size_t hstepA = (size_t)HALF * LDA, tstepA = 2 * hstepA;
    if constexpr (Sched::GATHER) S.aoffs(cur, vs);
    else {
#pragma unroll
        for (int i = 0; i < 2; ++i) { int R, C; stage_rc(tid * 16 + i * 8192, R, C); voffA[i] = (unsigned)(R * LDA + C * 2); }
    }
    const char* cA = Sched::GATHER ? Abase : S.abase(cur, Abase) + (size_t)cur.pm * tstepA;
#define G8_STAGE_A(bufoff, ptr, h) do { if constexpr (Sched::GATHER) G8_STAGE(bufoff, ptr, vs[h]); else G8_STAGE(bufoff, (ptr) + (h) * hstepA, voffA); } while (0)
    { const char* cB = G8_BPTR(cur, 0); const char* cB1 = G8_BPTR(cur, 1);
      G8_STAGE(G8_SB(0, 0), cB, voffB); G8_STAGE_A(G8_SA(0, 0), cA, 0); G8_STAGE(G8_SB(0, 1), cB + hstepB, voffB); G8_STAGE_A(G8_SA(0, 1), cA, 1);
      if (wr == 1) G8_BAR;
      G8_WAIT_V(4); G8_BAR;
      G8_STAGE(G8_SB(1, 0), cB1, voffB); G8_STAGE_A(G8_SA(1, 0), cA + kstep, 0); G8_STAGE(G8_SB(1, 1), cB1 + hstepB, voffB);
      G8_WAIT_V(6); G8_BAR; }
    for (;;) {
        bool has_next = false; const char* nA = cA;
        for (int t = 0; t < nt; t += 2) {
            const bool last = (t == nt - 2);
            const char* a1 = cA + (size_t)(t + 1) * kstep;
            G8_LDB(B0, 0, 0); G8_SCHED; G8_LDA(At, 0, 0); G8_STAGE_A(G8_SA(1, 1), a1, 1);
            G8_WAIT_L(8); G8_BAR; G8_WAIT_L(0); G8_MMA(0, 0, At, B0); G8_BAR; G8_SCHED;
            if (last) {
                has_next = S.next(ui + 1, nxt);
                if (has_next) { if constexpr (Sched::GATHER) S.aoffs(nxt, vs); else nA = S.abase(nxt, Abase) + (size_t)nxt.pm * tstepA; } else nxt = cur;
            }
            const char* a2 = last ? nA : cA + (size_t)(t + 2) * kstep; const char* a3 = a2 + kstep;
            const char* b2 = last ? G8_BPTR(nxt, 0) : G8_BPTR(cur, t + 2); const char* b3 = last ? G8_BPTR(nxt, 1) : G8_BPTR(cur, t + 3);
            G8_LDB(B1, 0, 1); G8_STAGE(G8_SB(0, 0), b2, voffB);
            G8_BAR; G8_WAIT_L(0); G8_MMA(0, 1, At, B1); G8_BAR;
            G8_LDA(At, 0, 1); G8_STAGE_A(G8_SA(0, 0), a2, 0);
            G8_BAR; G8_WAIT_L(0); G8_MMA(1, 0, At, B0); G8_BAR; G8_SCHED;
            G8_STAGE(G8_SB(0, 1), b2 + hstepB, voffB);
            G8_WAIT_V(6); G8_BAR; G8_MMA(1, 1, At, B1); G8_BAR;
            G8_LDB(B0, 1, 0); G8_SCHED; G8_LDA(At, 1, 0); G8_STAGE_A(G8_SA(0, 1), a2, 1);
            G8_WAIT_L(8); G8_BAR; G8_WAIT_L(0); G8_MMA(0, 0, At, B0); G8_BAR; G8_SCHED;
            G8_LDB(B1, 1, 1); G8_STAGE(G8_SB(1, 0), b3, voffB);
            G8_BAR; G8_WAIT_L(0); G8_MMA(0, 1, At, B1); G8_BAR;
            G8_LDA(At, 1, 1); G8_STAGE_A(G8_SA(1, 0), a3, 0);
            G8_BAR; G8_WAIT_L(0); G8_MMA(1, 0, At, B0); G8_BAR; G8_SCHED;
            G8_STAGE(G8_SB(1, 1), b3 + hstepB, voffB);
            G8_WAIT_V(6); G8_BAR; G8_MMA(1, 1, At, B1); G8_BAR;
        }
        cA = nA;
        { int tz = threadIdx.x; asm volatile("" : "+v"(tz));
          const int w2 = tz >> 6, l2 = tz & 63; E(acc, cur, w2 >> 2, w2 & 3, l2 & 15, l2 >> 4); }
        if (!has_next) break;
#pragma unroll
        for (int a = 0; a < 2; ++a)
#pragma unroll
            for (int b = 0; b < 2; ++b)
#pragma unroll
                for (int m = 0; m < 4; ++m)
#pragma unroll
                    for (int n = 0; n < 2; ++n) acc[a][b][m][n] = (f32x4v){0.f, 0.f, 0.f, 0.f};
        cur = nxt; ++ui;
    }
    G8_WAIT_V(0);
    if (wr == 0) G8_BAR;
    G8_BAR;
#undef G8_SA
#undef G8_SB
#undef G8_STAGE
#undef G8_STAGE_A
#undef G8_LDA
#undef G8_LDB
#undef G8_MMA
#undef G8_WAIT_V
#undef G8_WAIT_L
#undef G8_BAR
#undef G8_SCHED
#undef G8_BPTR
}
DEVI void lane_rc(int i, int& R, int& C) { int tz = threadIdx.x; asm volatile("" : "+v"(tz)); stage_rc(tz * 16 + i * 8192, R, C); }
struct DenseSched {
    static constexpr bool GATHER = false;
    const char* Bt; int nM, nN, G, c; size_t btile;
    DEVI const char* abase(const Unit&, const char* a) const { return a; }
    DEVI bool next(int i, Unit& u) const { if (!tile_order(i, G, c, nM, nN, u.pm, u.pn)) return false; u.B0 = u.B1 = Bt + (size_t)u.pn * btile; u.cls = 0; u.r0 = 0; u.ncls = 0; return true; }
    DEVI void aoffs(const Unit& u, unsigned (&v)[2][2]) const {
#pragma unroll
        for (int i = 0; i < 2; ++i) { int R, C; lane_rc(i, R, C);
#pragma unroll
            for (int h = 0; h < 2; ++h) v[h][i] = (unsigned)(((u.pm * 256 + h * 128 + R) * 1024 + C) * 2); }
    }
};
}

template <class PF>
DEVI void transpose_tile(PF colptr, int ldsrc, u16* dst, int lddst, int k0, int n0, float* tl) {
    const int t = threadIdx.x, nn = t & 63, kk = t >> 6;
    const float* sp = colptr(n0 + nn);
#pragma unroll
    for (int i = 0; i < 8; ++i) tl[(kk + 8 * i) * 65 + nn] = sp[(size_t)(k0 + kk + 8 * i) * ldsrc];
    __syncthreads();
    const int n = t >> 3, kc = t & 7;
    u32x4 w;
    w[0] = cvtpk(tl[(kc * 8 + 0) * 65 + n], tl[(kc * 8 + 1) * 65 + n]);
    w[1] = cvtpk(tl[(kc * 8 + 2) * 65 + n], tl[(kc * 8 + 3) * 65 + n]);
    w[2] = cvtpk(tl[(kc * 8 + 4) * 65 + n], tl[(kc * 8 + 5) * 65 + n]);
    w[3] = cvtpk(tl[(kc * 8 + 6) * 65 + n], tl[(kc * 8 + 7) * 65 + n]);
    *reinterpret_cast<u32x4*>(dst + (size_t)(n0 + n) * lddst + k0 + kc * 8) = w;
    __syncthreads();
}

DEVI void convert_expert_item(const P& p, int layer, int it, float* tl) {
    const int e = it / 384, r = it % 384;
    const float* wg = p.w_gate + ((size_t)layer * 16 + e) * 1024 * 512;
    const float* wu = p.w_up   + ((size_t)layer * 16 + e) * 1024 * 512;
    const float* wd = p.w_down + ((size_t)layer * 16 + e) * 512 * 1024;
    if (r < 256) {
        u16* dst = (u16*)(p.ws + (layer ? OFF_WGU1 : OFF_WGU)) + (size_t)e * 1024 * 1024;
        const int kt = r >> 4, nt = r & 15;
        transpose_tile([&](int n) { const int q = n >> 8, sgu = (n >> 7) & 1, j = n & 127; return (sgu ? wu : wg) + q * 128 + j; }, 512, dst, 1024, kt * 64, nt * 64, tl);
    } else {
        const int q = r - 256; u16* dst = (u16*)(p.ws + (layer ? OFF_WDT1 : OFF_WDT)) + (size_t)e * 1024 * 512;
        const int kt = q >> 4, nt = q & 15;
        transpose_tile([&](int n) { return wd + n; }, 1024, dst, 512, kt * 64, nt * 64, tl);
    }
}

constexpr int N0_WIN = 16 * 56, N0_WOUT = 256, N0_EXP = 16 * 384, N0_FN = 1024, N0_MOD = 192, N0_TAB = 128;
constexpr int N0_TOTAL = N0_WIN + N0_MOD + N0_TAB;
constexpr int NBG = N0_WOUT + N0_FN;
DEVI void bg_item(const P& p, int it, float* tl) {
    const int tid = threadIdx.x;
    int r = it;
    if (r < N0_WOUT) {
        const int kt = r >> 4, nt = r & 15; const float* w = p.w_out;
        transpose_tile([&](int n) { return w + n; }, 1024, (u16*)(p.ws + OFF_WOUTT), 1024, kt * 64, nt * 64, tl);
        return;
    }
    r -= N0_WOUT;
    {
        const int idx = r * 512 + tid, c = idx & 127, g = (idx >> 7) & 3, n = idx >> 9;
        double sd, cd; sincos2pi(c / 256.0, sd, cd);
        const float ct = (float)cd, st = (float)sd;
        const float* W = p.w_fnet + (size_t)(g * 256) * 1024 + n;
        float ac = 0.f, as = 0.f, a128 = 0.f, cr = 1.f, sr = 0.f, sg = 1.f;
        for (int c2 = 0; c2 < 256; ++c2) {
            const float w = W[(size_t)c2 * 1024];
            ac = fmaf(cr, w, ac); as = fmaf(sr, w, as); a128 = fmaf(sg, w, a128); sg = -sg;
            const float cn = cr * ct - sr * st; sr = fmaf(sr, ct, cr * st); cr = cn;
        }
        u16* Ah = (u16*)(p.ws + OFF_FNT); u16* Bh = Ah + (size_t)1024 * 512; float* A128 = (float*)(p.ws + OFF_FNT + (size_t)2 * 1024 * 512 * 2);
        Ah[(size_t)n * 512 + g * 128 + c] = f2bf(ac * (1.f / 2048.f)); Bh[(size_t)n * 512 + g * 128 + c] = f2bf(-as * (1.f / 2048.f));
        if (c == 0) A128[g * 1024 + n] = a128 * (1.f / 2048.f);
    }
}
DEVI void bg_fill(const P& p, char* lds, int q, int lo, int hi) {
    int* sh = (int*)(lds + 32768);
    for (;;) {
        __syncthreads();
        if (threadIdx.x == 0) *sh = lo + 4 * (int)atomicAdd((unsigned*)(p.ws + OFF_CNT) + 160 + q, 1u);
        __syncthreads();
        const int it0 = *sh;
        if (it0 >= hi) break;
        for (int it = it0; it < it0 + 4 && it < hi; ++it) bg_item(p, it, (float*)lds);
    }
    __syncthreads();
}

DEVI void phase_prologue(const P& p, char* lds) {
    float* tl = (float*)lds;
    const int tid = threadIdx.x;
    for (int it = blockIdx.x; it < N0_TOTAL; it += gridDim.x) {
        int r = it;
        if (r < N0_WIN) {
            const int kt = r / 56, nt = r % 56;
            const float* w = p.w_in;
            transpose_tile([&](int n) { return w + n; },
                           3600, (u16*)(p.ws + OFF_WINT), 1024, kt * 64, nt * 64, tl);
            continue;
        }
        r -= N0_WIN;
        if (r < N0_MOD) {
            float* sv = tl;
            float* part = tl + 3072;
            for (int i = tid; i < 3072; i += NTHR) { const int v = i >> 10, k = i & 1023; const float xv = v < 2 ? p.c[v * 1024 + k] : p.c_ctx[k]; sv[i] = siluf_(xv); }
            __syncthreads();
            const int j0 = r * 64, L = j0 / 6144, col0 = j0 % 6144, kg = tid >> 6, cl = tid & 63;
            const float* W = p.ada_w + (size_t)L * 1024 * 6144 + col0 + cl;
            float a0 = 0.f, a1 = 0.f, a2 = 0.f;
            for (int k = kg * 128; k < kg * 128 + 128; ++k) { const float w = W[(size_t)k * 6144]; a0 = fmaf(sv[k], w, a0); a1 = fmaf(sv[1024 + k], w, a1); a2 = fmaf(sv[2048 + k], w, a2); }
            part[(kg * 3 + 0) * 64 + cl] = a0; part[(kg * 3 + 1) * 64 + cl] = a1; part[(kg * 3 + 2) * 64 + cl] = a2;
            __syncthreads();
            if (tid < 192) {
                const int v = tid >> 6, c2 = tid & 63; float s = 0.f;
                for (int g = 0; g < 8; ++g) s += part[(g * 3 + v) * 64 + c2];
                ((float*)(p.ws + OFF_MOD))[(size_t)(L * 3 + v) * 6144 + col0 + c2] = s + p.ada_b[L * 6144 + col0 + c2];
            }
            __syncthreads();
            continue;
        }
        r -= N0_MOD;
        {
            const int e = r * 512 + tid;
            if (e < 4096 + 1024) {
                const bool isr = e < 4096; const int ee = isr ? e : e - 4096; const int pos = ee >> 4, j = ee & 15;
                double inv = 1.0; for (int q = 0; q < j; ++q) inv *= 0.56234132519034908;
                const float invf = (float)inv; const float ang = (float)pos * invf;
                double s, c; sincos2pi((double)ang * 0.15915494309189533577, s, c);
                float2 v = make_float2((float)c, (float)s);
                if (isr) ((float2*)(p.ws + OFF_ROPER))[ee] = v; else ((float2*)(p.ws + OFF_ROPEC))[ee] = v;
            } else if (e < 5120 + 16384) {
                const int m = e - 5120; double s, c; sincos2pi(m / 16384.0, s, c);
                ((float2*)(p.ws + OFF_TW))[m] = make_float2((float)c, (float)s);
            } else if (e < 5120 + 32768) {
                const int m = e - 5120 - 16384, k = m >> 7, t = m & 127; double s, c; sincos2pi(((k * t) & 127) / 128.0, s, c);
                ((u16*)(p.ws + OFF_DFTC))[m] = f2bf((float)c); ((u16*)(p.ws + OFF_DFTS))[m] = f2bf((float)s);
            } else if (e < 5120 + 49152) {
                const int m = e - 5120 - 32768, k = m >> 4, g = m & 15;
                ((float*)(p.ws + OFF_WG16))[m] = p.w_in[(size_t)k * 3600 + 3584 + g];
            } else if (e == 5120 + 49152) {
                float s01 = 0.f, s23 = 0.f;
                for (int i = 0; i < 64; ++i) { s01 += p.lamv[i] * p.lamv[64 + i]; s23 += p.lamv[128 + i] * p.lamv[192 + i]; }
                ((float*)(p.ws + OFF_LAM))[0] = expf(s01) - expf(s23) + 0.2f;
            }
        }
    }
}

template <int MODE, bool DRY = false>
DEVI void phase_norm(const P& p, char* lds) {
    constexpr int layer = (MODE == 0 || MODE == 1) ? 0 : 1;
    constexpr bool side = (MODE == 0 || MODE == 1 || MODE == 3);
    const int nrows = layer == 0 ? NTOK : NLAT;
    const int tid = threadIdx.x, lane = tid & 63, wid = tid >> 6;
    f32x4* sl = (f32x4*)lds;
    if (side) {
        const float* S = (MODE == 0) ? (const float*)(p.ws + OFF_WG16) : p.router_w;
        for (int i = tid; i < 4096; i += NTHR) { const int eg = i >> 10, col = i & 1023; const int pc = (col >> 8) * 256 + (col & 3) * 64 + ((col >> 2) & 63);
            sl[eg * 1024 + pc] = *reinterpret_cast<const f32x4*>(S + col * 16 + eg * 4); }
        __syncthreads();
    }
    const float* g = MODE == 0 ? p.nmix_g : MODE == 1 ? p.nffn_g : MODE == 2 ? p.nmix_g + 1024 : MODE == 3 ? p.nffn_g + 1024 : p.final_g;
    const float* modb = (const float*)(p.ws + OFF_MOD) + (size_t)layer * 3 * 6144;
    constexpr int sh_i = (MODE == 0 || MODE == 2) ? 0 : 3;
    u16* act = (u16*)(p.ws + OFF_ACT);
    int npend = 0, pcls = 0, prow = 0; float pwl = 0.f, pwh = 0.f; float keep[16];
#pragma unroll
    for (int e = 0; e < 16; ++e) keep[e] = 0.f;
    const int c0 = 4 * lane;
    f32x4 xn[4]; u32x2 xr[4];
#define NORM_REQ(R) do { if (MODE == 0) { const float* src_ = xin_ptr(p, (R)); _Pragma("unroll") for (int i = 0; i < 4; ++i) xn[i] = *reinterpret_cast<const f32x4*>(src_ + c0 + 256 * i); } \
        else { const u16* src_ = xs_ptr(p, layer, (R)); _Pragma("unroll") for (int i = 0; i < 4; ++i) xr[i] = *reinterpret_cast<const u32x2*>(src_ + c0 + 256 * i); } } while (0)
    { const int row0 = blockIdx.x * 8 + wid; if (row0 < nrows) NORM_REQ(row0); }
    for (int row = blockIdx.x * 8 + wid; row < nrows; row += gridDim.x * 8) {
        f32x4 xv[4]; float ss = 0.f;
#pragma unroll
        for (int i = 0; i < 4; ++i) xv[i] = (MODE == 0) ? xn[i] : bf4_to_f32(xr[i]);
        { const int nrow = row + gridDim.x * 8; if (nrow < nrows) NORM_REQ(nrow); }
#pragma unroll
        for (int i = 0; i < 4; ++i) { ss = fmaf(xv[i][0], xv[i][0], ss); ss = fmaf(xv[i][1], xv[i][1], ss); ss = fmaf(xv[i][2], xv[i][2], ss); ss = fmaf(xv[i][3], xv[i][3], ss); }
        ss = wave_sum(ss);
        const float rstd = rsqrtf(ss * (1.f / 1024.f) + 1e-6f);
        if (MODE == 4) {
            float* dst = p.out + (size_t)row * DM;
#pragma unroll
            for (int i = 0; i < 4; ++i) { const f32x4 gv = *reinterpret_cast<const f32x4*>(g + c0 + 256 * i); *reinterpret_cast<f32x4*>(dst + c0 + 256 * i) = xv[i] * rstd * gv; }
            continue;
        }
        const float* mv = modb + (size_t)modsel(layer, row) * 6144;
        float acc[16];
#pragma unroll
        for (int e = 0; e < 16; ++e) acc[e] = 0.f;
#pragma unroll
        for (int i = 0; i < 4; ++i) {
            const f32x4 gv = *reinterpret_cast<const f32x4*>(g + c0 + 256 * i), scv = *reinterpret_cast<const f32x4*>(mv + (sh_i + 1) * 1024 + c0 + 256 * i),
                        shv = *reinterpret_cast<const f32x4*>(mv + sh_i * 1024 + c0 + 256 * i);
            f32x4 h;
#pragma unroll
            for (int j = 0; j < 4; ++j) h[j] = xv[i][j] * rstd * gv[j] * (1.f + scv[j]) + shv[j];
            if (MODE == 2) {
                const float p0 = __shfl(h[0], (64 - lane) & 63), p1 = __shfl(h[3], 63 - lane), p2 = __shfl(h[2], 63 - lane), p3 = __shfl(h[1], 63 - lane), h128 = __shfl(h[0], 32);
                const float u0 = lane == 0 ? h[0] : h[0] + p0, v0 = lane == 0 ? h128 : h[0] - p0;
                if (lane < 32) {
                    u32x2 wu, wv; wu[0] = cvtpk(u0, h[1] + p1); wu[1] = cvtpk(h[2] + p2, h[3] + p3); wv[0] = cvtpk(v0, h[1] - p1); wv[1] = cvtpk(h[2] - p2, h[3] - p3);
                    *reinterpret_cast<u32x2*>((u16*)(p.ws + OFF_ACT) + (size_t)row * 512 + i * 128 + c0) = wu;
                    *reinterpret_cast<u32x2*>((u16*)(p.ws + OFF_ACT) + (size_t)NLAT * 512 + (size_t)row * 512 + i * 128 + c0) = wv;
                }
            } else {
                u32x2 w2; w2[0] = cvtpk(h[0], h[1]); w2[1] = cvtpk(h[2], h[3]);
                *reinterpret_cast<u32x2*>(act + (size_t)row * DM + c0 + 256 * i) = w2;
            }
            if (side) {
#pragma unroll
                for (int j = 0; j < 4; ++j) {
#pragma unroll
                    for (int eg = 0; eg < 4; ++eg) { const f32x4 w = sl[eg * 1024 + i * 256 + j * 64 + lane]; acc[eg * 4 + 0] = fmaf(h[j], w[0], acc[eg * 4 + 0]); acc[eg * 4 + 1] = fmaf(h[j], w[1], acc[eg * 4 + 1]);
                        acc[eg * 4 + 2] = fmaf(h[j], w[2], acc[eg * 4 + 2]); acc[eg * 4 + 3] = fmaf(h[j], w[3], acc[eg * 4 + 3]); }
                    if (j & 1) asm volatile("" ::: "memory");
                }
            }
        }
        if (side) {
            float r8[8], r4[4], r2[2], tot;
            { const bool up = lane & 32;
#pragma unroll
              for (int i = 0; i < 8; ++i) { const float snd = up ? acc[i] : acc[i + 8], kp = up ? acc[i + 8] : acc[i]; r8[i] = kp + __shfl_xor(snd, 32); } }
            { const bool up = lane & 16;
#pragma unroll
              for (int i = 0; i < 4; ++i) { const float snd = up ? r8[i] : r8[i + 4], kp = up ? r8[i + 4] : r8[i]; r4[i] = kp + __shfl_xor(snd, 16); } }
            { const bool up = lane & 8;
#pragma unroll
              for (int i = 0; i < 2; ++i) { const float snd = up ? r4[i] : r4[i + 2], kp = up ? r4[i + 2] : r4[i]; r2[i] = kp + __shfl_xor(snd, 8); } }
            { const bool up = lane & 4; const float snd = up ? r2[0] : r2[1], kp = up ? r2[1] : r2[0]; tot = kp + __shfl_xor(snd, 4); }
            tot += __shfl_xor(tot, 1); tot += __shfl_xor(tot, 2);
            if (MODE == 0) {
                if ((lane & 3) == 0) {
                    const int e = lane >> 2;
                    float v = tot + p.gate_b[e];
                    const int type = e >> 2;
                    if (type == 1 || type == 3) v = logsigmoidf_(v);
                    ((float*)(p.ws + OFF_GATES))[(size_t)row * 16 + e] = v;
                }
            } else {
#pragma unroll
                for (int e = 0; e < 16; ++e) { const float te = __uint_as_float(__builtin_amdgcn_readlane(__float_as_uint(tot), e << 2)); keep[e] = (lane == npend) ? te : keep[e]; }
                if (lane == npend) prow = row;
                ++npend;
            }
        }
    }
    if (MODE == 1 || MODE == 3) {
        {
            float aff[16], bi[16];
#pragma unroll
            for (int e = 0; e < 16; ++e) { aff[e] = sigmoidf_(keep[e]); bi[e] = aff[e] + p.router_b[e]; }
            int bg = 0, ba = 0, bb = 1; float bscore = -1e30f;
#pragma unroll
            for (int gq = 0; gq < 4; ++gq) {
                int ia = 0; float va = bi[gq * 4];
#pragma unroll
                for (int j = 1; j < 4; ++j) if (bi[gq * 4 + j] > va) { va = bi[gq * 4 + j]; ia = j; }
                int ib = -1; float vb = -1e30f;
#pragma unroll
                for (int j = 0; j < 4; ++j) if (j != ia && bi[gq * 4 + j] > vb) { vb = bi[gq * 4 + j]; ib = j; }
                const float sc = va + vb;
                if (sc > bscore) { bscore = sc; bg = gq; ba = ia; bb = ib; }
            }
            const int lo = ba < bb ? ba : bb, hi2 = ba < bb ? bb : ba;
            float alo = 0.f, ahi = 0.f;
#pragma unroll
            for (int e = 0; e < 16; ++e) { if (e == bg * 4 + lo) alo = aff[e]; if (e == bg * 4 + hi2) ahi = aff[e]; }
            const float inv = 1.f / (alo + ahi);
            const int pair = lo == 0 ? hi2 - 1 : (lo == 1 ? hi2 + 1 : 5);
            pcls = bg * 6 + pair; pwl = alo * inv; pwh = ahi * inv;
        }
        unsigned* lc = (unsigned*)(lds + 65536);
        __syncthreads();
        if (tid < 64) lc[tid] = 0u;
        __syncthreads();
        unsigned myrank = 0u;
        if (lane < npend) myrank = atomicAdd(&lc[pcls], 1u);
        __syncthreads();
        if (tid < 24) { unsigned* cnt = (unsigned*)(p.ws + OFF_CNT) + (DRY ? 2 : layer) * 32; const unsigned n = lc[tid]; lc[32 + tid] = n ? atomicAdd(&cnt[tid], n) : 0u; }
        __syncthreads();
        if (lane < npend) {
            ((int*)(p.ws + (DRY ? OFF_BIG : OFF_LIST)))[(size_t)pcls * NTOK + lc[32 + pcls] + myrank] = prow;
            ((float2*)(p.ws + (DRY ? OFF_BIG + (size_t)32 * NTOK * 4 : OFF_TOKW)))[prow] = make_float2(pwl, pwh);
        }
    }
}

using g8::f32x4v;
DEVI u32x4 pack8(const f32x4v& a, const f32x4v& b) { u32x4 w; w[0] = cvtpk(a[0], a[1]); w[1] = cvtpk(a[2], a[3]); w[2] = cvtpk(b[0], b[1]); w[3] = cvtpk(b[2], b[3]); return w; }

struct EpiInproj {
    static constexpr bool PERM = true;
    char* ws;
    DEVI void operator()(const f32x4v (&acc)[2][2][4][2], const g8::Unit& u, int wr, int wc, int fr, int fq) const {
        u16* dst; int ld, coff, kind;
        const int pn = u.pn;
        if (pn < 2)       { dst = (u16*)(ws + OFF_Q);    ld = 512;  coff = pn * 256;        kind = 1; }
        else if (pn < 4)  { dst = (u16*)(ws + OFF_K);    ld = 512;  coff = (pn - 2) * 256;  kind = 1; }
        else if (pn < 6)  { dst = (u16*)(ws + OFF_V);    ld = 512;  coff = (pn - 4) * 256;  kind = 0; }
        else if (pn < 10) { dst = (u16*)(ws + OFF_MLQK); ld = 1024; coff = (pn - 6) * 256;  kind = 0; }
        else if (pn < 12) { dst = (u16*)(ws + OFF_MLV);  ld = 512;  coff = (pn - 10) * 256; kind = 0; }
        else              { dst = (u16*)(ws + OFF_OG);   ld = 512;  coff = (pn - 12) * 256; kind = 2; }
        const int tb = u.pm % 65;
        const float2* tabR = (const float2*)(ws + OFF_ROPER); const float2* tabC = (const float2*)(ws + OFF_ROPEC);
#pragma unroll
        for (int ai = 0; ai < 2; ++ai)
#pragma unroll
            for (int m = 0; m < 4; ++m) {
                const int rl = ai * 128 + wr * 64 + m * 16 + fr;
                u16* rowp = dst + (size_t)(u.pm * 256 + rl) * ld + coff + wc * 32 + 8 * fq;
#pragma unroll
                for (int bj = 0; bj < 2; ++bj) {
                    f32x4v v0 = acc[ai][bj][m][0], v1 = acc[ai][bj][m][1];
                    if (kind == 1 && tb > 0) {
                        const int tl = (tb - 1) * 256 + rl;
                        const int p0 = ((wc * 32 + 8 * fq) & 63) >> 1;
                        const float* cs = (const float*)(p0 < 16 ? tabR + (tl >> 6) * 16 + p0 : tabC + (tl & 63) * 16 + (p0 - 16));
                        const f32x4v c01 = *reinterpret_cast<const f32x4v*>(cs), c23 = *reinterpret_cast<const f32x4v*>(cs + 4);
                        const f32x4v a = v0, b = v1;
                        v0[0] = a[0] * c01[0] - a[1] * c01[1]; v0[1] = a[0] * c01[1] + a[1] * c01[0];
                        v0[2] = a[2] * c01[2] - a[3] * c01[3]; v0[3] = a[2] * c01[3] + a[3] * c01[2];
                        v1[0] = b[0] * c23[0] - b[1] * c23[1]; v1[1] = b[0] * c23[1] + b[1] * c23[0];
                        v1[2] = b[2] * c23[2] - b[3] * c23[3]; v1[3] = b[2] * c23[3] + b[3] * c23[2];
                    } else if (kind == 2) {
#pragma unroll
                        for (int j = 0; j < 4; ++j) { v0[j] = sigmoidf_(v0[j]); v1[j] = sigmoidf_(v1[j]); }
                    }
                    *reinterpret_cast<u32x4*>(rowp + bj * 128) = pack8(v0, v1);
                }
            }
    }
};
DEVI void phase_inproj(const P& p, char* lds) {
    __syncthreads();
    g8::DenseSched S{p.ws + OFF_WINT, NTOK / 256, 14, (int)gridDim.x, (int)blockIdx.x, (size_t)256 * 2048};
    EpiInproj E{p.ws};
    g8::gemm_phase((LAS unsigned char*)lds, p.ws + OFF_ACT, 2048, 16, S, E);
}

struct EpiOutproj {
    static constexpr bool PERM = true;
    const float* xin_lat; const float* xin_ctx; u16* xs; const float* modb;
    DEVI void operator()(const f32x4v (&acc)[2][2][4][2], const g8::Unit& u, int wr, int wc, int fr, int fq) const {
        const int b = u.pm / 65, tb = u.pm % 65;
        const float* xi = tb == 0 ? xin_ctx + (size_t)(b * TC) * DM : xin_lat + (size_t)(b * TL + (tb - 1) * 256) * DM;
        u16* xo = xs + (size_t)(u.pm * 256) * DM;
        const float* gate = modb + (size_t)(tb == 0 ? 2 : b) * 6144 + 2 * 1024;
        const int col0 = u.pn * 256 + wc * 32 + 8 * fq;
        f32x4v gv[2][2];
#pragma unroll
        for (int bj = 0; bj < 2; ++bj)
#pragma unroll
            for (int n = 0; n < 2; ++n) gv[bj][n] = *reinterpret_cast<const f32x4v*>(gate + col0 + bj * 128 + n * 4);
#pragma unroll
        for (int ai = 0; ai < 2; ++ai) {
            f32x4v xv[4][2][2];
#pragma unroll
            for (int m = 0; m < 4; ++m) { const size_t ro = (size_t)(ai * 128 + wr * 64 + m * 16 + fr) * DM + col0;
#pragma unroll
                for (int bj = 0; bj < 2; ++bj)
#pragma unroll
                    for (int n = 0; n < 2; ++n) xv[m][bj][n] = *reinterpret_cast<const f32x4v*>(xi + ro + bj * 128 + n * 4); }
#pragma unroll
            for (int m = 0; m < 4; ++m) { const size_t ro = (size_t)(ai * 128 + wr * 64 + m * 16 + fr) * DM + col0;
#pragma unroll
                for (int bj = 0; bj < 2; ++bj)
                    *reinterpret_cast<u32x4*>(xo + ro + bj * 128) = pack8(xv[m][bj][0] + gv[bj][0] * acc[ai][bj][m][0], xv[m][bj][1] + gv[bj][1] * acc[ai][bj][m][1]); }
        }
    }
};
DEVI void phase_outproj(const P& p, char* lds) {
    __syncthreads();
    g8::DenseSched S{p.ws + OFF_WOUTT, NTOK / 256, 4, (int)gridDim.x, (int)blockIdx.x, (size_t)256 * 2048};
    EpiOutproj E{p.x, p.ctx, (u16*)(p.ws + OFF_MLC), (const float*)(p.ws + OFF_MOD)};
    g8::gemm_phase((LAS unsigned char*)lds, p.ws + OFF_ACT, 2048, 16, S, E);
}

DEVI int moe_table(const P& p, int layer, int* tb) {
    __syncthreads();
    if (threadIdx.x == 0) {
        const unsigned* cnt = (const unsigned*)(p.ws + OFF_CNT) + layer * 32; int o = 0;
        for (int c = 0; c < 24; ++c) { tb[c] = o; tb[32 + c] = (int)cnt[c]; o += ((int)cnt[c] + 255) >> 8; }
        tb[24] = o;
    }
    __syncthreads();
    return tb[24];
}
DEVI void cls_experts(int cls, int& elo, int& ehi) {
    const int g = cls / 6, pr = cls % 6;
    const int lo = pr < 3 ? 0 : (pr < 5 ? 1 : 2); const int hi = pr < 3 ? pr + 1 : (pr < 5 ? pr - 1 : 3);
    elo = g * 4 + lo; ehi = g * 4 + hi;
}
DEVI void moe_unit(const int* tb, int rt, g8::Unit& u) {
    int cls = 0; while (cls < 23 && tb[cls + 1] <= rt) ++cls;
    u.cls = cls; u.r0 = (rt - tb[cls]) * 256; u.ncls = tb[32 + cls];
}

struct MoeUpSched {
    static constexpr bool GATHER = true;
    DEVI const char* abase(const g8::Unit&, const char* a) const { return a; }
    const int* tb; int T, G, c; const int* list; const char* Wgu;
    DEVI bool next(int i, g8::Unit& u) const {
        if (!g8::tile_order(i, G, c, T, 8, u.pm, u.pn)) return false;
        moe_unit(tb, u.pm, u); int elo, ehi; cls_experts(u.cls, elo, ehi);
        const int e = u.pn < 4 ? elo : ehi;
        u.B0 = u.B1 = Wgu + ((size_t)e * 1024 + (size_t)(u.pn & 3) * 256) * 2048; return true;
    }
    DEVI void aoffs(const g8::Unit& u, unsigned (&v)[2][2]) const {
        const int* lst = list + (size_t)u.cls * NTOK + u.r0;
#pragma unroll
        for (int i = 0; i < 2; ++i) { int R, C; g8::lane_rc(i, R, C);
#pragma unroll
            for (int h = 0; h < 2; ++h) { const int rr = h * 128 + R; const int tok = lst[(u.r0 + rr < u.ncls) ? rr : 0]; v[h][i] = (unsigned)((tok * 1024 + C) * 2); } }
    }
};
struct EpiMoeUp {
    static constexpr bool PERM = true;
    const int* list; const float2* tokw; u16* HE;
    DEVI void operator()(const f32x4v (&acc)[2][2][4][2], const g8::Unit& u, int wr, int wc, int fr, int fq) const {
        const int* lst = list + (size_t)u.cls * NTOK + u.r0;
        const int s = u.pn >> 2;
        float wv[2][4];
        { int tk[2][4];
#pragma unroll
          for (int ai = 0; ai < 2; ++ai)
#pragma unroll
              for (int m = 0; m < 4; ++m) { const int rl = ai * 128 + wr * 64 + m * 16 + fr; tk[ai][m] = lst[(u.r0 + rl < u.ncls) ? rl : 0]; }
#pragma unroll
          for (int ai = 0; ai < 2; ++ai)
#pragma unroll
              for (int m = 0; m < 4; ++m) { const float2 w2 = tokw[tk[ai][m]]; wv[ai][m] = s ? w2.y : w2.x; } }
#pragma unroll
        for (int ai = 0; ai < 2; ++ai)
#pragma unroll
            for (int m = 0; m < 4; ++m) {
                const int rl = ai * 128 + wr * 64 + m * 16 + fr;
                if (u.r0 + rl < u.ncls) {
                    const float w = wv[ai][m];
                    u16* rowp = HE + (size_t)(u.pm * 256 + rl) * 1024 + s * 512 + (u.pn & 3) * 128 + wc * 32 + 8 * fq;
                    f32x4v h0, h1;
#pragma unroll
                    for (int j = 0; j < 4; ++j) { h0[j] = siluf_(acc[ai][0][m][0][j]) * acc[ai][1][m][0][j] * w; h1[j] = siluf_(acc[ai][0][m][1][j]) * acc[ai][1][m][1][j] * w; }
                    *reinterpret_cast<u32x4*>(rowp) = pack8(h0, h1);
                }
            }
    }
};
DEVI void phase_moe_up(const P& p, int layer, char* lds) {
    int* tb = (int*)(lds + g8::STAGE_BYTES);
    const int T = moe_table(p, layer, tb);
    MoeUpSched S{tb, T, (int)gridDim.x, (int)blockIdx.x, (const int*)(p.ws + OFF_LIST), p.ws + (layer ? OFF_WGU1 : OFF_WGU)};
    EpiMoeUp E{(const int*)(p.ws + OFF_LIST), (const float2*)(p.ws + OFF_TOKW), (u16*)(p.ws + OFF_HE)};
    g8::gemm_phase((LAS unsigned char*)lds, p.ws + OFF_ACT, 2048, 16, S, E);
}

struct MoeDownSched {
    static constexpr bool GATHER = false;
    DEVI const char* abase(const g8::Unit&, const char* a) const { return a; }
    const int* tb; int T, G, c; const char* WdT;
    DEVI bool next(int i, g8::Unit& u) const {
        if (!g8::tile_order(i, G, c, T, 4, u.pm, u.pn)) return false;
        moe_unit(tb, u.pm, u); int elo, ehi; cls_experts(u.cls, elo, ehi);
        u.B0 = WdT + ((size_t)elo * 1024 + (size_t)u.pn * 256) * 1024;
        u.B1 = WdT + ((size_t)ehi * 1024 + (size_t)u.pn * 256) * 1024 - (size_t)8 * 128; return true;
    }
    DEVI void aoffs(const g8::Unit& u, unsigned (&v)[2][2]) const {
#pragma unroll
        for (int i = 0; i < 2; ++i) { int R, C; g8::lane_rc(i, R, C);
#pragma unroll
            for (int h = 0; h < 2; ++h) v[h][i] = (unsigned)(((u.pm * 256 + h * 128 + R) * 1024 + C) * 2); }
    }
};
template <bool DRY>
struct EpiMoeDown {
    static constexpr bool PERM = true;
    const P* pp; int layer; const int* list; const float* modb;
    DEVI void operator()(const f32x4v (&acc)[2][2][4][2], const g8::Unit& u, int wr, int wc, int fr, int fq) const {
        const P& p = *pp;
        const int* lst = list + (size_t)u.cls * NTOK + u.r0;
        const int col0 = u.pn * 256 + wc * 32 + 8 * fq;
        int tk[2][4];
#pragma unroll
        for (int ai = 0; ai < 2; ++ai)
#pragma unroll
            for (int m = 0; m < 4; ++m) { const int rl = ai * 128 + wr * 64 + m * 16 + fr; tk[ai][m] = (u.r0 + rl < u.ncls) ? lst[rl] : -1; }
#pragma unroll
        for (int ai = 0; ai < 2; ++ai)
#pragma unroll
        for (int mh = 0; mh < 2; ++mh) {
            u32x4 xw[2][2]; f32x4v gv[2][2][2];
#pragma unroll
            for (int mm = 0; mm < 2; ++mm) { const int m = mh * 2 + mm; const int tok = tk[ai][m] < 0 ? lst[0] : tk[ai][m];
                const float* gate = modb + (size_t)modsel(layer, tok) * 6144 + 5 * 1024 + col0; const u16* xo = xs_ptr(p, layer, tok) + col0;
#pragma unroll
                for (int bj = 0; bj < 2; ++bj) { xw[mm][bj] = *reinterpret_cast<const u32x4*>(xo + bj * 128);
#pragma unroll
                    for (int n = 0; n < 2; ++n) gv[mm][bj][n] = *reinterpret_cast<const f32x4v*>(gate + bj * 128 + n * 4); } }
#pragma unroll
            for (int mm = 0; mm < 2; ++mm) { const int m = mh * 2 + mm; if (tk[ai][m] >= 0) { const int tok = tk[ai][m];
                u16* xd = DRY ? (u16*)(p.ws + OFF_MLQK) + (size_t)(tok & 8191) * 1024 + col0 : xs_ptr(p, layer, tok) + col0;
#pragma unroll
                for (int bj = 0; bj < 2; ++bj) {
                    f32x4v x0, x1; x0[0] = bflo(xw[mm][bj][0]); x0[1] = bfhi(xw[mm][bj][0]); x0[2] = bflo(xw[mm][bj][1]); x0[3] = bfhi(xw[mm][bj][1]);
                    x1[0] = bflo(xw[mm][bj][2]); x1[1] = bfhi(xw[mm][bj][2]); x1[2] = bflo(xw[mm][bj][3]); x1[3] = bfhi(xw[mm][bj][3]);
                    *reinterpret_cast<u32x4*>(xd + bj * 128) = pack8(x0 + gv[mm][bj][0] * acc[ai][bj][m][0], x1 + gv[mm][bj][1] * acc[ai][bj][m][1]); } } }
        }
    }
};
template <bool DRY = false>
DEVI void phase_moe_down(const P& p, int layer, char* lds) {
    int* tb = (int*)(lds + g8::STAGE_BYTES);
    const int T = moe_table(p, layer, tb);
    MoeDownSched S{tb, T, (int)gridDim.x, (int)blockIdx.x, p.ws + (layer ? OFF_WDT1 : OFF_WDT)};
    EpiMoeDown<DRY> E{&p, layer, (const int*)(p.ws + OFF_LIST), (const float*)(p.ws + OFF_MOD) + (size_t)layer * 3 * 6144};
    g8::gemm_phase((LAS unsigned char*)lds, p.ws + OFF_HE, 1024, 8, S, E);
}

constexpr size_t OFF_FU = OFF_ACT, OFF_FV = OFF_ACT + (size_t)NLAT * 512 * 2;
constexpr size_t OFF_FAH = OFF_FNT, OFF_FBH = OFF_FNT + (size_t)1024 * 512 * 2, OFF_FA128 = OFF_FNT + (size_t)2 * 1024 * 512 * 2;
struct FnetSched {
    static constexpr bool GATHER = false;
    const char* ws; int G, c;
    DEVI const char* abase(const g8::Unit& u, const char*) const { return ws + (u.pn < 4 ? OFF_FU : OFF_FV); }
    DEVI bool next(int i, g8::Unit& u) const {
        if (!g8::tile_order(i, G, c, NLAT / 256, 8, u.pm, u.pn)) return false;
        u.B0 = u.B1 = ws + (u.pn < 4 ? OFF_FAH : OFF_FBH) + (size_t)(u.pn & 3) * 256 * 1024; u.cls = 0; u.r0 = 0; u.ncls = 0; return true;
    }
    DEVI void aoffs(const g8::Unit&, unsigned (&)[2][2]) const {}
};
struct EpiFnet {
    static constexpr bool PERM = true;
    char* ws;
    DEVI void operator()(const f32x4v (&acc)[2][2][4][2], const g8::Unit& u, int wr, int wc, int fr, int fq) const {
        const int colt = (u.pn & 3) * 256 + wc * 32 + 8 * fq;
        u16* dst = (u16*)(ws + (u.pn < 4 ? OFF_ZR : OFF_ZI)) + colt;
        const u16* V = (const u16*)(ws + OFF_FV); const float* A128 = (const float*)(ws + OFF_FA128);
#pragma unroll
        for (int bj = 0; bj < 2; ++bj) {
            f32x4v a128[4][2];
            if (u.pn < 4) {
#pragma unroll
                for (int g = 0; g < 4; ++g) { a128[g][0] = *reinterpret_cast<const f32x4v*>(A128 + g * 1024 + colt + bj * 128); a128[g][1] = *reinterpret_cast<const f32x4v*>(A128 + g * 1024 + colt + bj * 128 + 4); }
            }
#pragma unroll
            for (int ai = 0; ai < 2; ++ai)
#pragma unroll
                for (int m = 0; m < 4; ++m) {
                    const size_t row = (size_t)(u.pm * 256 + ai * 128 + wr * 64 + m * 16 + fr);
                    f32x4v v0 = acc[ai][bj][m][0], v1 = acc[ai][bj][m][1];
                    if (u.pn < 4) {
#pragma unroll
                        for (int g = 0; g < 4; ++g) { const float hv = bf2f(V[row * 512 + g * 128]); v0 += a128[g][0] * hv; v1 += a128[g][1] * hv; }
                    }
                    *reinterpret_cast<u32x4*>(dst + row * 1024 + bj * 128) = pack8(v0, v1);
                }
        }
    }
};
DEVI void phase_fnet_gemm(const P& p, char* lds) {
    __syncthreads();
    FnetSched S{p.ws, (int)gridDim.x, (int)blockIdx.x};
    EpiFnet E{p.ws};
    g8::gemm_phase<EpiFnet, FnetSched, 8, 1024>((LAS unsigned char*)lds, p.ws, 1024, 8, S, E);
}

template <class RP>
DEVI void stage_tr128_load(RP rp, u32x4 (&v)[4]) {
    const int tid = threadIdx.x;
#pragma unroll
    for (int i = 0; i < 4; ++i) { const int idx = tid + 512 * i, k = idx >> 4, c = (idx & 15) * 8; v[i] = *reinterpret_cast<const u32x4*>(rp(k) + c); }
}
DEVI void stage_tr128_write(const u32x4 (&v)[4], char* img) {
    const int tid = threadIdx.x;
#pragma unroll
    for (int i = 0; i < 4; ++i) { const int idx = tid + 512 * i, k = idx >> 4, c = (idx & 15) * 8; *reinterpret_cast<u32x4*>(img + (k >> 6) * 16384 + v_st(k & 63, c)) = v[i]; }
}
DEVI void load_dft(const P& p, char* lds) {
    const int tid = threadIdx.x;
    for (int i = tid; i < 4096; i += NTHR) {
        const int m = i >> 11, j = i & 2047, row = j >> 4, ch = j & 15;
        const u32x4 v = *reinterpret_cast<const u32x4*>((const u16*)(p.ws + (m ? OFF_DFTS : OFF_DFTC)) + row * 128 + ch * 8);
        *reinterpret_cast<u32x4*>(lds + m * 34816 + swz256(row, ch)) = v;
    }
}
DEVI bf16x8 negbf(bf16x8 v) { u32x4 w = *reinterpret_cast<u32x4*>(&v); w[0] ^= 0x80008000u; w[1] ^= 0x80008000u; w[2] ^= 0x80008000u; w[3] ^= 0x80008000u; return *reinterpret_cast<bf16x8*>(&w); }

template <int KS, int WN, int MODE>
DEVI void fft_kstep(int vbr, int vbi, const bf16x8& aC, const bf16x8& aS, f32x16 (&yr)[2], f32x16 (&yi)[2]) {
    s16x4 rl0, rh0, rl1, rh1, il0, ih0, il1, ih1;
    tr_frag_issue<2 * WN, KS>(vbr, rl0, rh0); tr_frag_issue<2 * WN + 1, KS>(vbr, rl1, rh1);
    tr_frag_issue<2 * WN, KS>(vbi, il0, ih0); tr_frag_issue<2 * WN + 1, KS>(vbi, il1, ih1);
    LGKM0();
    const bf16x8 xr0 = PKLH(rl0, rh0), xr1 = PKLH(rl1, rh1), xi0 = PKLH(il0, ih0), xi1 = PKLH(il1, ih1);
    yr[0] = __builtin_amdgcn_mfma_f32_32x32x16_bf16(xr0, aC, yr[0], 0, 0, 0);
    yr[1] = __builtin_amdgcn_mfma_f32_32x32x16_bf16(xr1, aC, yr[1], 0, 0, 0);
    yr[0] = __builtin_amdgcn_mfma_f32_32x32x16_bf16(xi0, aS, yr[0], 0, 0, 0);
    yr[1] = __builtin_amdgcn_mfma_f32_32x32x16_bf16(xi1, aS, yr[1], 0, 0, 0);
    if (MODE == 0) {
        yi[0] = __builtin_amdgcn_mfma_f32_32x32x16_bf16(xi0, aC, yi[0], 0, 0, 0);
        yi[1] = __builtin_amdgcn_mfma_f32_32x32x16_bf16(xi1, aC, yi[1], 0, 0, 0);
        yi[0] = __builtin_amdgcn_mfma_f32_32x32x16_bf16(negbf(xr0), aS, yi[0], 0, 0, 0);
        yi[1] = __builtin_amdgcn_mfma_f32_32x32x16_bf16(negbf(xr1), aS, yi[1], 0, 0, 0);
    }
}
template <int WN, int MODE>
DEVI void fft_core(const char* lds, int xr_img, int xi_img, int wm, int lane, f32x16 (&yr)[2], f32x16 (&yi)[2]) {
    const int r32 = lane & 31, hi = lane >> 5;
    const char* Cm = lds; const char* Sm = lds + 34816;
    const int row = wm * 32 + r32;
    const int vb0 = xr_img + v_rd_base(lane), vb1 = xi_img + v_rd_base(lane);
#define KSTEP(H, KS) do { const int kk = (H) * 4 + (KS); \
        const bf16x8 aC = lds_b128(Cm, swz256(row, 2 * kk + hi)), aS = lds_b128(Sm, swz256(row, 2 * kk + hi)); \
        fft_kstep<KS, WN, MODE>(vb0 + (H) * 16384, vb1 + (H) * 16384, aC, aS, yr, yi); } while (0)
    KSTEP(0, 0); KSTEP(0, 1); KSTEP(0, 2); KSTEP(0, 3); KSTEP(1, 0); KSTEP(1, 1); KSTEP(1, 2); KSTEP(1, 3);
#undef KSTEP
}

DEVI void phase_fft1(const P& p, char* lds) {
    const int tid = threadIdx.x, lane = tid & 63, wid = __builtin_amdgcn_readfirstlane(tid >> 6), wm = wid >> 1, wn = wid & 1, r32 = lane & 31, hi = lane >> 5;
    load_dft(p, lds);
    char* imgR = lds + 69632; char* imgI = lds + 102400;
    const u16* Zr = (const u16*)(p.ws + OFF_ZR); const u16* Zi = (const u16*)(p.ws + OFF_ZI);
    u16* Yr = (u16*)(p.ws + OFF_YR); u16* Yi = (u16*)(p.ws + OFF_YI);
    const float2* TW = (const float2*)(p.ws + OFF_TW);
    u32x4 pr[4], pi[4];
#define FFT1_LOAD(U) do { const int cb_ = (U) & 7, t2_ = ((U) >> 3) & 127, b_ = (U) >> 10; \
        stage_tr128_load([&](int k) { return Zr + (size_t)(b_ * TL + 128 * k + t2_) * 1024 + cb_ * 128; }, pr); \
        stage_tr128_load([&](int k) { return Zi + (size_t)(b_ * TL + 128 * k + t2_) * 1024 + cb_ * 128; }, pi); } while (0)
    if ((int)blockIdx.x < NB * 128 * 8) FFT1_LOAD((int)blockIdx.x);
    for (int u = blockIdx.x; u < NB * 128 * 8; u += gridDim.x) {
        const int cb = u & 7, t2 = (u >> 3) & 127, b = u >> 10;
        __syncthreads();
        stage_tr128_write(pr, imgR); stage_tr128_write(pi, imgI);
        __syncthreads();
        if (u + (int)gridDim.x < NB * 128 * 8) FFT1_LOAD(u + (int)gridDim.x);
        f32x16 yr[2] = {}, yi[2] = {};
        const int xr_img = (int)(uintptr_t)imgR, xi_img = (int)(uintptr_t)imgI;
        if (wn == 0) fft_core<0, 0>(lds, xr_img, xi_img, wm, lane, yr, yi); else fft_core<1, 0>(lds, xr_img, xi_img, wm, lane, yr, yi);
        __syncthreads();
        {
            const int k1 = wm * 32 + r32;
            const float2 w = TW[t2 * k1];
            char* oR = imgR + k1 * 272; char* oI = imgR + 34816 + k1 * 272;
#pragma unroll
            for (int ni = 0; ni < 2; ++ni)
#pragma unroll
                for (int g = 0; g < 4; ++g) {
                    const int cbase = wn * 64 + ni * 32 + 8 * g + 4 * hi;
                    float re[4], im[4];
#pragma unroll
                    for (int j = 0; j < 4; ++j) { const float a = yr[ni][4 * g + j], bq = yi[ni][4 * g + j]; re[j] = a * w.x + bq * w.y; im[j] = bq * w.x - a * w.y; }
                    u32x2 pr, pi; pr[0] = cvtpk(re[0], re[1]); pr[1] = cvtpk(re[2], re[3]); pi[0] = cvtpk(im[0], im[1]); pi[1] = cvtpk(im[2], im[3]);
                    *reinterpret_cast<u32x2*>(oR + cbase * 2) = pr; *reinterpret_cast<u32x2*>(oI + cbase * 2) = pi;
                }
        }
        __syncthreads();
#pragma unroll
        for (int i = 0; i < 8; ++i) {
            const int idx = tid + 512 * i, pl = idx >> 11, j = idx & 2047, row = j >> 4, ch = j & 15;
            const u32x4 v = *reinterpret_cast<const u32x4*>(imgR + pl * 34816 + row * 272 + ch * 16);
            *reinterpret_cast<u32x4*>((pl ? Yi : Yr) + ((size_t)(b * 128 + row) * 128 + t2) * 1024 + cb * 128 + ch * 8) = v;
        }
    }
}
template <bool DRY = false>
DEVI void phase_fft2(const P& p, char* lds) {
    const int tid = threadIdx.x, lane = tid & 63, wid = __builtin_amdgcn_readfirstlane(tid >> 6), wm = wid >> 1, wn = wid & 1, r32 = lane & 31, hi = lane >> 5;
    load_dft(p, lds);
    char* imgR = lds + 69632; char* imgI = lds + 102400;
    const u16* Yr = (const u16*)(p.ws + OFF_YR); const u16* Yi = (const u16*)(p.ws + OFF_YI);
    const float* modb = (const float*)(p.ws + OFF_MOD) + (size_t)3 * 6144;
    u32x4 pr[4], pi[4];
#define FFT2_LOAD(U) do { const int cb_ = (U) & 7, k1_ = ((U) >> 3) & 127, b_ = (U) >> 10; \
        stage_tr128_load([&](int k) { return Yr + ((size_t)(b_ * 128 + k1_) * 128 + k) * 1024 + cb_ * 128; }, pr); \
        stage_tr128_load([&](int k) { return Yi + ((size_t)(b_ * 128 + k1_) * 128 + k) * 1024 + cb_ * 128; }, pi); } while (0)
    if ((int)blockIdx.x < NB * 128 * 8) FFT2_LOAD((int)blockIdx.x);
    for (int u = blockIdx.x; u < NB * 128 * 8; u += gridDim.x) {
        const int cb = u & 7, k1 = (u >> 3) & 127, b = u >> 10;
        __syncthreads();
        stage_tr128_write(pr, imgR); stage_tr128_write(pi, imgI);
        __syncthreads();
        if (u + (int)gridDim.x < NB * 128 * 8) FFT2_LOAD(u + (int)gridDim.x);
        f32x16 yr[2] = {}, yi[2] = {};
        const int xr_img = (int)(uintptr_t)imgR, xi_img = (int)(uintptr_t)imgI;
        if (wn == 0) fft_core<0, 1>(lds, xr_img, xi_img, wm, lane, yr, yi); else fft_core<1, 1>(lds, xr_img, xi_img, wm, lane, yr, yi);
        __syncthreads();
        {
            char* oR = imgR + (wm * 32 + r32) * 528;
#pragma unroll
            for (int ni = 0; ni < 2; ++ni)
#pragma unroll
                for (int g = 0; g < 4; ++g) {
                    const int cbase = wn * 64 + ni * 32 + 8 * g + 4 * hi;
                    f32x4 v; v[0] = yr[ni][4 * g]; v[1] = yr[ni][4 * g + 1]; v[2] = yr[ni][4 * g + 2]; v[3] = yr[ni][4 * g + 3];
                    *reinterpret_cast<f32x4*>(oR + cbase * 4) = v;
                }
        }
        __syncthreads();
        const float* gate = modb + (size_t)b * 6144 + 2 * 1024 + cb * 128;
#pragma unroll
        for (int i = 0; i < 4; ++i) {
            const int idx = tid + 512 * i, row = idx >> 4, ch = idx & 15;
            const f32x4 v0 = *reinterpret_cast<const f32x4*>(imgR + row * 528 + ch * 32), v1 = *reinterpret_cast<const f32x4*>(imgR + row * 528 + ch * 32 + 16);
            const f32x4 g0 = *reinterpret_cast<const f32x4*>(gate + ch * 8), g1 = *reinterpret_cast<const f32x4*>(gate + ch * 8 + 4);
            u16* xo = xs_ptr(p, 1, b * TL + k1 + 128 * row) + cb * 128 + ch * 8;
            u16* xd = DRY ? (u16*)(p.ws + OFF_ZR) + (size_t)(b * TL + k1 + 128 * row) * 1024 + cb * 128 + ch * 8 : xo;
            const u32x4 xw = *reinterpret_cast<const u32x4*>(xo);
            f32x4 x0, x1; x0[0] = bflo(xw[0]); x0[1] = bfhi(xw[0]); x0[2] = bflo(xw[1]); x0[3] = bfhi(xw[1]); x1[0] = bflo(xw[2]); x1[1] = bfhi(xw[2]); x1[2] = bflo(xw[3]); x1[3] = bfhi(xw[3]);
            const f32x4 r0 = x0 + g0 * v0, r1 = x1 + g1 * v1;
            u32x4 w; w[0] = cvtpk(r0[0], r0[1]); w[1] = cvtpk(r0[2], r0[3]); w[2] = cvtpk(r1[0], r1[1]); w[3] = cvtpk(r1[2], r1[3]);
            *reinterpret_cast<u32x4*>(xd) = w;
        }
    }
}

constexpr int AT_V = 16384, AT_K = 17408;
template <int HF, int DB>
DEVI void attn_half(const char* Ks, const bf16x8 (&qr)[8], float& m_reg, float& l_reg, f32x16 (&o)[4], int vb, float* al, int r32, int hi) {
    constexpr float SC = 0.125f, C = SC * 1.4426950408889634f, THR = 8.f;
    f32x16 pp = {};
#pragma unroll
    for (int d0 = 0; d0 < 4; ++d0) pp = __builtin_amdgcn_mfma_f32_32x32x16_bf16(lds_b128(Ks, swz256(HF * 32 + r32, 2 * (DB + d0) + hi)), qr[DB + d0], pp, 0, 0, 0);
    float pmax = pp[0];
#pragma unroll
    for (int r = 1; r < 16; ++r) pmax = fmaxf(pmax, pp[r]);
    { auto rr = __builtin_amdgcn_permlane32_swap(__float_as_uint(pmax), __float_as_uint(pmax), false, false);
      pmax = fmaxf(__uint_as_float(rr[0]), __uint_as_float(rr[1])); }
    float alpha = 1.f;
    if (!__all(pmax - m_reg <= THR / SC)) {
        const float mn = fmaxf(m_reg, pmax); alpha = __builtin_amdgcn_exp2f((m_reg - mn) * C); m_reg = mn;
        if (hi == 0) al[r32] = alpha;
        asm volatile("s_waitcnt lgkmcnt(0)" ::: "memory");
#pragma unroll
        for (int d = 0; d < 4; ++d)
#pragma unroll
            for (int r = 0; r < 16; ++r) o[d][r] *= al[crow(r, hi)];
    }
    const float mnC = -m_reg * C;
    float ps = 0.f;
#pragma unroll
    for (int r = 0; r < 16; ++r) { pp[r] = __builtin_amdgcn_exp2f(fmaf(pp[r], C, mnC)); ps += pp[r]; }
    { auto rr = __builtin_amdgcn_permlane32_swap(__float_as_uint(ps), __float_as_uint(ps), false, false);
      ps = __uint_as_float(rr[0]) + __uint_as_float(rr[1]); }
    l_reg = l_reg * alpha + ps;
    bf16x8 pa0, pa1;
    pack_p(pp, pa0, pa1);
#define PVD(D0) do { s16x4 l0, h0, l1, h1; tr_frag_issue<D0, 2 * HF>(vb, l0, h0); tr_frag_issue<D0, 2 * HF + 1>(vb, l1, h1); LGKM0(); \
        o[D0] = __builtin_amdgcn_mfma_f32_32x32x16_bf16(pa0, PKLH(l0, h0), o[D0], 0, 0, 0); \
        o[D0] = __builtin_amdgcn_mfma_f32_32x32x16_bf16(pa1, PKLH(l1, h1), o[D0], 0, 0, 0); } while (0)
    PVD(0); PVD(1); PVD(2); PVD(3);
#undef PVD
}

DEVI void diffattn_item(const P& p, int q0, int k0row, int seq, int h, char* lds) {
    int tid = threadIdx.x; asm volatile("" : "+v"(tid));
    const int wid = tid >> 6, lane = tid & 63, r32 = lane & 31, hi = lane >> 5;
    const u16* Q = (const u16*)(p.ws + OFF_Q); const u16* Kg = (const u16*)(p.ws + OFF_K) + (size_t)k0row * 512 + h * 128;
    const u16* Vg = (const u16*)(p.ws + OFF_V) + (size_t)k0row * 512 + h * 128;
    char* V_lds = lds; char* K_lds = lds + 2 * AT_V;
    float* al = (float*)(lds + 2 * AT_V + 2 * AT_K) + wid * 64;
    bf16x8 qr[8];
    { const u16* Qw = Q + (size_t)(q0 + wid * 32 + r32) * 512 + h * 128 + hi * 8;
#pragma unroll
      for (int d0 = 0; d0 < 8; ++d0) qr[d0] = *reinterpret_cast<const bf16x8*>(Qw + d0 * 16); }
    const int sr = tid >> 4, sc = (tid & 15) * 8;
    const int vb0 = (int)(uintptr_t)V_lds + v_rd_base(lane);
    const int vc = ((tid >> 5) & 3) * 32 + (tid & 3) * 8;
    const int kk0 = (tid >> 7) * 8 + ((tid & 31) >> 2), kk1 = kk0 + 32;
    const int vk0 = (kk0 & ~0xC) | ((kk0 & 4) << 1) | ((kk0 & 8) >> 1), vk1 = (kk1 & ~0xC) | ((kk1 & 4) << 1) | ((kk1 & 8) >> 1);
    u32x4 sk0, sk1;
#define SLOAD(kk, b) do { \
    __builtin_amdgcn_global_load_lds((const unsigned*)(Vg + (size_t)((kk) + vk0) * 512 + vc), (LAS unsigned*)(V_lds + (b) * AT_V + tid * 16), 16, 0, 0); \
    __builtin_amdgcn_global_load_lds((const unsigned*)(Vg + (size_t)((kk) + vk1) * 512 + vc), (LAS unsigned*)(V_lds + (b) * AT_V + 8192 + tid * 16), 16, 0, 0); \
    sk0 = *reinterpret_cast<const u32x4*>(Kg + (size_t)((kk) + sr) * 512 + sc); sk1 = *reinterpret_cast<const u32x4*>(Kg + (size_t)((kk) + 32 + sr) * 512 + sc); } while (0)
#define SWRITE(b) do { *reinterpret_cast<u32x4*>(K_lds + (b) * AT_K + swz256(sr, tid & 15)) = sk0; *reinterpret_cast<u32x4*>(K_lds + (b) * AT_K + swz256(32 + sr, tid & 15)) = sk1; } while (0)
    float m0 = -1e30f, m1 = -1e30f, l0 = 0.f, l1 = 0.f;
    f32x16 o0[4] = {}, o1[4] = {};
    const int NT = seq / 64;
    __syncthreads();
    SLOAD(0, 0); SWRITE(0); asm volatile("s_waitcnt vmcnt(0)" ::: "memory"); __syncthreads();
    if (NT > 1) SLOAD(64, 1);
    for (int j = 0; j < NT; ++j) {
        const int cur = j & 1;
        const char* Ks = K_lds + cur * AT_K;
        attn_half<0, 0>(Ks, qr, m0, l0, o0, vb0 + cur * AT_V, al, r32, hi);
        attn_half<1, 0>(Ks, qr, m0, l0, o0, vb0 + cur * AT_V, al, r32, hi);
        attn_half<0, 4>(Ks, qr, m1, l1, o1, vb0 + cur * AT_V, al, r32, hi);
        attn_half<1, 4>(Ks, qr, m1, l1, o1, vb0 + cur * AT_V, al, r32, hi);
        if (j + 1 < NT) SWRITE(cur ^ 1);
        asm volatile("s_waitcnt vmcnt(0)" ::: "memory");
        __syncthreads();
        if (j + 2 < NT) SLOAD((j + 2) * 64, cur);
    }
#undef SLOAD
#undef SWRITE
    int tz = threadIdx.x; asm volatile("" : "+v"(tz));
    const int wid2 = tz >> 6, lane2 = tz & 63, r32e = lane2 & 31, hie = lane2 >> 5;
    const float lam = ((const float*)(p.ws + OFF_LAM))[0];
    float* sc0 = (float*)(lds + 2 * AT_V + 2 * AT_K) + wid2 * 64; float* sc1 = sc0 + 32;
    if (hie == 0) { sc0[r32e] = 1.f / l0; sc1[r32e] = -lam / l1; }
    asm volatile("s_waitcnt lgkmcnt(0)" ::: "memory");
    float ssq[16];
#pragma unroll
    for (int r = 0; r < 16; ++r) {
        const float a = sc0[crow(r, hie)], b = sc1[crow(r, hie)]; float s = 0.f;
#pragma unroll
        for (int d = 0; d < 4; ++d) { const float v = o0[d][r] * a + o1[d][r] * b; o0[d][r] = v; s = fmaf(v, v, s); }
        ssq[r] = s;
    }
#pragma unroll
    for (int r = 0; r < 16; ++r) { float s = ssq[r]; for (int o = 16; o; o >>= 1) s += __shfl_xor(s, o); ssq[r] = rsqrtf(s * (1.f / 128.f) + 1e-6f) * 0.8f; }
    u16* mix = (u16*)(p.ws + OFF_ACT);
    const float* sg = p.subln_g;
#pragma unroll
    for (int d = 0; d < 4; ++d) {
        const float gv = sg[d * 32 + r32e];
#pragma unroll
        for (int r = 0; r < 16; ++r) mix[(size_t)(q0 + wid2 * 32 + crow(r, hie)) * 1024 + h * 128 + d * 32 + r32e] = f2bf(o0[d][r] * ssq[r] * gv);
    }
}

DEVI void chunk_scan(const float* gates, int row0, int head, int dir, float* Bq, float* av, float* pm, float& total, float& amax) {
    const int lane = threadIdx.x & 63;
    const int e0 = dir ? 127 - 2 * lane : 2 * lane, e1 = dir ? 126 - 2 * lane : 2 * lane + 1;
    const float lf0 = gates[(size_t)(row0 + e0) * 16 + (dir ? 12 : 4) + head], lf1 = gates[(size_t)(row0 + e1) * 16 + (dir ? 12 : 4) + head];
    const float li0 = gates[(size_t)(row0 + e0) * 16 + (dir ? 8 : 0) + head],  li1 = gates[(size_t)(row0 + e1) * 16 + (dir ? 8 : 0) + head];
    const float s1 = lf0 + lf1; float inc = s1;
#pragma unroll
    for (int o = 1; o < 64; o <<= 1) { const float t = __shfl_up(inc, o); if (lane >= o) inc += t; }
    const float exc = inc - s1;
    const float B0 = exc + lf0, B1 = exc + s1;
    const float a0 = li0 - B0, a1 = li1 - B1;
    const float m1 = fmaxf(a0, a1); float mx = m1;
#pragma unroll
    for (int o = 1; o < 64; o <<= 1) { const float t = __shfl_up(mx, o); if (lane >= o) mx = fmaxf(mx, t); }
    float mprev = __shfl_up(mx, 1); if (lane == 0) mprev = -1e30f;
    Bq[e0] = B0; Bq[e1] = B1; av[e0] = a0; av[e1] = a1; pm[e0] = fmaxf(mprev, a0); pm[e1] = mx;
    total = __shfl(inc, 63); amax = __shfl(mx, 63);
}

DEVI void conv_silu8(const u32x4& xm, const u32x4& x0, const u32x4& xp, const float* wc, bool hasm, bool hasp, float (&out)[8]) {
#pragma unroll
    for (int j = 0; j < 4; ++j) {
        const float w00 = wc[2 * j], w01 = wc[2 * j + 1], w10 = wc[1024 + 2 * j], w11 = wc[1024 + 2 * j + 1], w20 = wc[2048 + 2 * j], w21 = wc[2048 + 2 * j + 1];
        float a = w10 * bflo(x0[j]), b = w11 * bfhi(x0[j]);
        if (hasm) { a = fmaf(w00, bflo(xm[j]), a); b = fmaf(w01, bfhi(xm[j]), b); }
        if (hasp) { a = fmaf(w20, bflo(xp[j]), a); b = fmaf(w21, bfhi(xp[j]), b); }
        out[2 * j] = siluf_(a); out[2 * j + 1] = siluf_(b);
    }
}
DEVI void seg_edges(int t  , bool& hasm, bool& hasp) {
    hasm = !(t == 0 || t == TC); hasp = !(t == TC - 1 || t == TT - 1);
}
DEVI int chain_slot(int dir, int b, int h, int cc) { return ((dir * 2 + b) * 4 + h) * NCH + cc; }

DEVI void phase_mlstm_a(const P& p, char* lds) {
    const int tid = threadIdx.x, wid = __builtin_amdgcn_readfirstlane(tid >> 6), lane = tid & 63, r32 = lane & 31, hi = lane >> 5;
    char* Vimg = lds; char* Kf = lds + 32768; char* Kb = lds + 65536;
    float* arr = (float*)(lds + 98304);
    const float* gates = (const float*)(p.ws + OFF_GATES);
    const u16* MLQK = (const u16*)(p.ws + OFF_MLQK); const u16* MLV = (const u16*)(p.ws + OFF_MLV);
    u16* CST = (u16*)(p.ws + OFF_CST); float* NST = (float*)(p.ws + OFF_NST); u16* MLC = (u16*)(p.ws + OFF_MLC);
    float2* scal = (float2*)(p.ws + OFF_MSCAL);
    for (int it = blockIdx.x; it < NB * 4 * NCH; it += gridDim.x) {
        const int cc = it % NCH, h = (it / NCH) & 3, b = it / (NCH * 4);
        const int row0 = b * TT + cc * 128;
        __syncthreads();
        if (wid < 2) {
            float total, amax; float* a4 = arr + wid * 512;
            chunk_scan(gates, row0, h, wid, a4, a4 + 128, a4 + 256, total, amax);
            a4[384 + lane] = __expf(a4[128 + lane] - amax); a4[384 + 64 + lane] = __expf(a4[128 + 64 + lane] - amax);
            if (lane == 0) scal[chain_slot(wid, b, h, 0) + cc] = make_float2(total + amax, total);
        }
        __syncthreads();
#pragma unroll
        for (int i = 0; i < 4; ++i) {
            const int idx = tid + 512 * i, l = idx >> 4, c = (idx & 15) * 8;
            const u32x4 v = *reinterpret_cast<const u32x4*>(MLV + (size_t)(row0 + l) * 512 + h * 128 + c);
            *reinterpret_cast<u32x4*>(Vimg + (l >> 6) * 16384 + v_st(l & 63, c)) = v;
            const int t = cc * 128 + l; bool hasm, hasp; seg_edges(t, hasm, hasp);
            const u16* kp = MLQK + (size_t)(row0 + l) * 1024 + 512 + h * 128 + c;
            const u32x4 x0 = *reinterpret_cast<const u32x4*>(kp);
            const u32x4 xm = hasm ? *reinterpret_cast<const u32x4*>(kp - 1024) : x0;
            const u32x4 xp = hasp ? *reinterpret_cast<const u32x4*>(kp + 1024) : x0;
            float kv[8]; conv_silu8(xm, x0, xp, p.conv_w + 512 + h * 128 + c, hasm, hasp, kv);
            const float wf = arr[384 + l] * 0.08838834764831845f, wb = arr[512 + 384 + l] * 0.08838834764831845f;
            u32x4 of, ob, ok;
#pragma unroll
            for (int j = 0; j < 4; ++j) { of[j] = cvtpk(kv[2 * j] * wf, kv[2 * j + 1] * wf); ob[j] = cvtpk(kv[2 * j] * wb, kv[2 * j + 1] * wb);
                ok[j] = cvtpk(kv[2 * j] * 0.08838834764831845f, kv[2 * j + 1] * 0.08838834764831845f); }
            *reinterpret_cast<u32x4*>(MLC + (size_t)(row0 + l) * 1024 + 512 + h * 128 + c) = ok;
            {
                const u16* qp = kp - 512;
                const u32x4 q0 = *reinterpret_cast<const u32x4*>(qp);
                const u32x4 qm = hasm ? *reinterpret_cast<const u32x4*>(qp - 1024) : q0;
                const u32x4 qn = hasp ? *reinterpret_cast<const u32x4*>(qp + 1024) : q0;
                float qv[8]; conv_silu8(qm, q0, qn, p.conv_w + h * 128 + c, hasm, hasp, qv);
                u32x4 oq;
#pragma unroll
                for (int j = 0; j < 4; ++j) oq[j] = cvtpk(qv[2 * j], qv[2 * j + 1]);
                *reinterpret_cast<u32x4*>(MLC + (size_t)(row0 + l) * 1024 + h * 128 + c) = oq;
            }
            *reinterpret_cast<u32x4*>(Kf + (l >> 6) * 16384 + v_st(l & 63, c)) = of;
            *reinterpret_cast<u32x4*>(Kb + (l >> 6) * 16384 + v_st(l & 63, c)) = ob;
        }
        __syncthreads();
        const int dir = wid >> 2, vblk = wid & 3;
        const int va = (int)(uintptr_t)Vimg + v_rd_base(lane), ka = (int)(uintptr_t)(dir ? Kb : Kf) + v_rd_base(lane);
        f32x16 acc[4] = {};
#define ASTEP(H, KS) do { s16x4 al_, ah_, b0l, b0h, b1l, b1h, b2l, b2h, b3l, b3h; \
        if (vblk == 0) tr_frag_issue<0, KS>(va + (H) * 16384, al_, ah_); else if (vblk == 1) tr_frag_issue<1, KS>(va + (H) * 16384, al_, ah_); \
        else if (vblk == 2) tr_frag_issue<2, KS>(va + (H) * 16384, al_, ah_); else tr_frag_issue<3, KS>(va + (H) * 16384, al_, ah_); \
        tr_frag_issue<0, KS>(ka + (H) * 16384, b0l, b0h); tr_frag_issue<1, KS>(ka + (H) * 16384, b1l, b1h); \
        tr_frag_issue<2, KS>(ka + (H) * 16384, b2l, b2h); tr_frag_issue<3, KS>(ka + (H) * 16384, b3l, b3h); LGKM0(); \
        const bf16x8 af = PKLH(al_, ah_); \
        acc[0] = __builtin_amdgcn_mfma_f32_32x32x16_bf16(af, PKLH(b0l, b0h), acc[0], 0, 0, 0); \
        acc[1] = __builtin_amdgcn_mfma_f32_32x32x16_bf16(af, PKLH(b1l, b1h), acc[1], 0, 0, 0); \
        acc[2] = __builtin_amdgcn_mfma_f32_32x32x16_bf16(af, PKLH(b2l, b2h), acc[2], 0, 0, 0); \
        acc[3] = __builtin_amdgcn_mfma_f32_32x32x16_bf16(af, PKLH(b3l, b3h), acc[3], 0, 0, 0); } while (0)
        ASTEP(0, 0); ASTEP(0, 1); ASTEP(0, 2); ASTEP(0, 3); ASTEP(1, 0); ASTEP(1, 1); ASTEP(1, 2); ASTEP(1, 3);
#undef ASTEP
        u16* Cd = CST + (size_t)chain_slot(dir, b, h, cc) * 16384;
#pragma unroll
        for (int kb = 0; kb < 4; ++kb)
#pragma unroll
            for (int r = 0; r < 16; ++r) Cd[(vblk * 32 + crow(r, hi)) * 128 + kb * 32 + r32] = f2bf(acc[kb][r]);
        if (tid < 256) {
            const int d2 = tid >> 7, k = tid & 127; const char* img = d2 ? Kb : Kf; float s = 0.f;
            for (int l = 0; l < 128; ++l) s += bf2f(*reinterpret_cast<const u16*>(img + (l >> 6) * 16384 + v_st(l & 63, k & ~7) + (k & 7) * 2));
            NST[(size_t)chain_slot(d2, b, h, cc) * 128 + k] = s;
        }
    }
}

DEVI void phase_kmax(const P& p, char* lds) {
    const int tid = threadIdx.x; unsigned* lm = (unsigned*)lds;
    __syncthreads();
    if (tid < 16) lm[tid] = 0u;
    __syncthreads();
    const u16* K = (const u16*)(p.ws + OFF_K); const int hm = tid & 7;
    float mx0 = 0.f, mx1 = 0.f;
    for (int idx = blockIdx.x * NTHR + tid; idx < NTOK * 8; idx += gridDim.x * NTHR) {
        const int tok = idx >> 3; const u16* kp = K + (size_t)tok * 512 + hm * 64; float ss = 0.f;
#pragma unroll
        for (int c = 0; c < 8; ++c) { const u32x4 w = *reinterpret_cast<const u32x4*>(kp + c * 8);
#pragma unroll
            for (int j = 0; j < 4; ++j) { const float a = bflo(w[j]), b = bfhi(w[j]); ss = fmaf(a, a, ss); ss = fmaf(b, b, ss); } }
        if (tok < TT) mx0 = fmaxf(mx0, ss); else mx1 = fmaxf(mx1, ss);
    }
    atomicMax(&lm[hm], __float_as_uint(mx0)); atomicMax(&lm[8 + hm], __float_as_uint(mx1));
    __syncthreads();
    if (tid < 16) atomicMax((unsigned*)(p.ws + OFF_CNT) + 128 + tid, lm[tid]);
    __syncthreads();
}

DEVI int proc_chunk(int dir, int i) { return dir == 0 ? i : (i == 0 ? 1 : (i == 1 ? 0 : NCH + 1 - i)); }

DEVI void phase_mlstm_b(const P& p, char* lds) {
    const int tid = threadIdx.x;
    float* dec = (float*)lds; float* scl = dec + 160; float* mst = scl + 160;
    const float2* scal = (const float2*)(p.ws + OFF_MSCAL);
    u32* CST = (u32*)(p.ws + OFF_CST); float* NST = (float*)(p.ws + OFF_NST); float* MST = (float*)(p.ws + OFF_MST);
    for (int it = blockIdx.x; it < 16 * 16; it += gridDim.x) {
        const int chain = it >> 4, sub = it & 15, dir = chain >> 3;
        __syncthreads();
        if (tid == 0) {
            float m = 0.f;
            for (int i = 0; i < NCH; ++i) {
                const int cc = proc_chunk(dir, i); const float2 s = scal[chain * NCH + cc];
                const float mn = fmaxf(s.y + m, s.x);
                dec[i] = __expf(s.y + m - mn); scl[i] = __expf(s.x - mn); mst[i] = m;
                if (sub == 0) MST[chain * NCH + cc] = m;
                m = mn;
            }
        }
        __syncthreads();
        u32* base = CST + (size_t)chain * NCH * 8192 + sub * 512 + tid;
        float s0 = 0.f, s1 = 0.f;
        for (int i0 = 0; i0 < NCH; i0 += 10) {
            u32 v[10];
#pragma unroll
            for (int j = 0; j < 10; ++j) v[j] = base[(size_t)proc_chunk(dir, i0 + j) * 8192];
#pragma unroll
            for (int j = 0; j < 10; ++j) {
                base[(size_t)proc_chunk(dir, i0 + j) * 8192] = cvtpk(s0, s1);
                const float d = dec[i0 + j], sc = scl[i0 + j];
                s0 = fmaf(d, s0, sc * bflo(v[j])); s1 = fmaf(d, s1, sc * bfhi(v[j]));
            }
        }
        if (sub == 0 && tid < 128) {
            float* nb = NST + (size_t)chain * NCH * 128 + tid; float s = 0.f;
            for (int i = 0; i < NCH; ++i) { const int cc = proc_chunk(dir, i); const float v = nb[cc * 128]; nb[cc * 128] = s; s = fmaf(dec[i], s, scl[i] * v); }
        }
    }
}

DEVI void mlstm_c_item(const P& p, int it, char* lds) {
    int tid = threadIdx.x; asm volatile("" : "+v"(tid));
    const int wid = __builtin_amdgcn_readfirstlane(tid >> 6), lane = tid & 63, r32 = lane & 31, hi = lane >> 5;
    const int cc = it % NCH, h = (it / NCH) & 3, b = it / (NCH * 4);
    const int row0 = b * TT + cc * 128;
    char* Kt = lds; char* Vimg = lds + 34816; char* Ct = lds + 67584;
    float* arr = (float*)(lds + 137216);
    float* wsc = arr + 1024 + wid * 64;
    float* xb = (float*)lds;
    const float* gates = (const float*)(p.ws + OFF_GATES);
    const u16* MLC = (const u16*)(p.ws + OFF_MLC); const u16* MLV = (const u16*)(p.ws + OFF_MLV);
    const u16* CST = (const u16*)(p.ws + OFF_CST); const float* NST = (const float*)(p.ws + OFF_NST); const float* MST = (const float*)(p.ws + OFF_MST);
    __syncthreads();
    if (wid < 2) { float total, amax; float* a4 = arr + wid * 512; chunk_scan(gates, row0, h, wid, a4, a4 + 128, a4 + 256, total, amax); }
    else if (wid < 6) { const int d2 = (wid - 2) >> 1, k = ((wid - 2) & 1) * 64 + lane; arr[d2 * 512 + 384 + k] = NST[(size_t)chain_slot(d2, b, h, cc) * 128 + k]; }
#pragma unroll
    for (int i = 0; i < 4; ++i) {
        const int idx = tid + 512 * i, l = idx >> 4, ch = idx & 15, c = ch * 8;
        const u32x4 v = *reinterpret_cast<const u32x4*>(MLV + (size_t)(row0 + l) * 512 + h * 128 + c);
        *reinterpret_cast<u32x4*>(Vimg + (l >> 6) * 16384 + v_st(l & 63, c)) = v;
        const u32x4 ok = *reinterpret_cast<const u32x4*>(MLC + (size_t)(row0 + l) * 1024 + 512 + h * 128 + c);
        *reinterpret_cast<u32x4*>(Kt + swz256(l, ch)) = ok;
#pragma unroll
        for (int d2 = 0; d2 < 2; ++d2) {
            const u32x4 cv = *reinterpret_cast<const u32x4*>(CST + (size_t)chain_slot(d2, b, h, cc) * 16384 + l * 128 + c);
            *reinterpret_cast<u32x4*>(Ct + d2 * 34816 + swz256(l, ch)) = cv;
        }
    }
    const int dir = wid >> 2, qb = wid & 3, q = qb * 32 + r32;
    bf16x8 qr[8];
    { const u16* qp = MLC + (size_t)(row0 + q) * 1024 + h * 128 + hi * 8;
#pragma unroll
      for (int d0 = 0; d0 < 8; ++d0) qr[d0] = *reinterpret_cast<const bf16x8*>(qp + d0 * 16); }
    __syncthreads();
    const float* a4 = arr + dir * 512;
    const float m_st = MST[chain_slot(dir, b, h, 0) + cc];
    const float Mq = fmaxf(m_st, a4[256 + q]);
    const float inter = __expf(m_st - Mq);
    float nq = 0.f;
#pragma unroll
    for (int d0 = 0; d0 < 8; ++d0) {
        const u32x4 w = *reinterpret_cast<const u32x4*>(&qr[d0]); const float* nn = a4 + 384 + d0 * 16 + hi * 8;
#pragma unroll
        for (int j = 0; j < 4; ++j) { nq = fmaf(bflo(w[j]), nn[2 * j], nq); nq = fmaf(bfhi(w[j]), nn[2 * j + 1], nq); }
    }
    { auto rr = __builtin_amdgcn_permlane32_swap(__float_as_uint(nq), __float_as_uint(nq), false, false); nq = __uint_as_float(rr[0]) + __uint_as_float(rr[1]); }
    f32x16 o[4] = {};
    const char* Cm = Ct + dir * 34816;
#pragma unroll
    for (int dk = 0; dk < 8; ++dk)
#pragma unroll
        for (int d0 = 0; d0 < 4; ++d0) o[d0] = __builtin_amdgcn_mfma_f32_32x32x16_bf16(qr[dk], lds_b128(Cm, swz256(d0 * 32 + r32, 2 * dk + hi)), o[d0], 0, 0, 0);
    if (hi == 0) wsc[r32] = inter;
    asm volatile("s_waitcnt lgkmcnt(0)" ::: "memory");
#pragma unroll
    for (int d0 = 0; d0 < 4; ++d0)
#pragma unroll
        for (int r = 0; r < 16; ++r) o[d0][r] *= wsc[crow(r, hi)];
    const int vb = (int)(uintptr_t)Vimg + v_rd_base(lane);
    float rs = 0.f;
#define KBLK(KB) do { if (dir == 0 ? (KB) <= qb : (KB) >= qb) { \
        f32x16 pp = {}; \
        _Pragma("unroll") for (int d0 = 0; d0 < 8; ++d0) pp = __builtin_amdgcn_mfma_f32_32x32x16_bf16(lds_b128(Kt, swz256((KB) * 32 + r32, 2 * d0 + hi)), qr[d0], pp, 0, 0, 0); \
        _Pragma("unroll") for (int g = 0; g < 4; ++g) { const f32x4 av4 = *reinterpret_cast<const f32x4*>(a4 + 128 + (KB) * 32 + 8 * g + 4 * hi); \
            _Pragma("unroll") for (int j = 0; j < 4; ++j) { const int key = (KB) * 32 + 8 * g + 4 * hi + j; const bool ok = dir == 0 ? key <= q : key >= q; \
                const float sv = ok ? pp[4 * g + j] * __expf(av4[j] - Mq) : 0.f; pp[4 * g + j] = sv; rs += sv; } } \
        bf16x8 f0, f1; pack_p(pp, f0, f1); \
        { s16x4 l0, h0, l1, h1, l2, h2, l3, h3; constexpr int HH = (KB) >> 1, K0 = ((KB) & 1) * 2; \
          tr_frag_issue<0, K0>(vb + HH * 16384, l0, h0); tr_frag_issue<1, K0>(vb + HH * 16384, l1, h1); tr_frag_issue<2, K0>(vb + HH * 16384, l2, h2); tr_frag_issue<3, K0>(vb + HH * 16384, l3, h3); LGKM0(); \
          o[0] = __builtin_amdgcn_mfma_f32_32x32x16_bf16(f0, PKLH(l0, h0), o[0], 0, 0, 0); o[1] = __builtin_amdgcn_mfma_f32_32x32x16_bf16(f0, PKLH(l1, h1), o[1], 0, 0, 0); \
          o[2] = __builtin_amdgcn_mfma_f32_32x32x16_bf16(f0, PKLH(l2, h2), o[2], 0, 0, 0); o[3] = __builtin_amdgcn_mfma_f32_32x32x16_bf16(f0, PKLH(l3, h3), o[3], 0, 0, 0); \
          tr_frag_issue<0, K0 + 1>(vb + HH * 16384, l0, h0); tr_frag_issue<1, K0 + 1>(vb + HH * 16384, l1, h1); tr_frag_issue<2, K0 + 1>(vb + HH * 16384, l2, h2); tr_frag_issue<3, K0 + 1>(vb + HH * 16384, l3, h3); LGKM0(); \
          o[0] = __builtin_amdgcn_mfma_f32_32x32x16_bf16(f1, PKLH(l0, h0), o[0], 0, 0, 0); o[1] = __builtin_amdgcn_mfma_f32_32x32x16_bf16(f1, PKLH(l1, h1), o[1], 0, 0, 0); \
          o[2] = __builtin_amdgcn_mfma_f32_32x32x16_bf16(f1, PKLH(l2, h2), o[2], 0, 0, 0); o[3] = __builtin_amdgcn_mfma_f32_32x32x16_bf16(f1, PKLH(l3, h3), o[3], 0, 0, 0); } } } while (0)
    KBLK(0); KBLK(1); KBLK(2); KBLK(3);
#undef KBLK
    { auto rr = __builtin_amdgcn_permlane32_swap(__float_as_uint(rs), __float_as_uint(rs), false, false); rs = __uint_as_float(rr[0]) + __uint_as_float(rr[1]); }
    const float nqt = inter * nq + rs;
    const float den = fmaxf(fabsf(nqt), __expf(-(a4[q] + Mq)));
    if (hi == 0) wsc[32 + r32] = 1.f / den;
    asm volatile("s_waitcnt lgkmcnt(0)" ::: "memory");
#pragma unroll
    for (int d0 = 0; d0 < 4; ++d0)
#pragma unroll
        for (int r = 0; r < 16; ++r) o[d0][r] *= wsc[32 + crow(r, hi)];
    __syncthreads();
    {
        float* xd = dir ? xb : (float*)(lds + 67584);
#pragma unroll
        for (int d0 = 0; d0 < 4; ++d0)
#pragma unroll
            for (int r = 0; r < 16; ++r) xd[(qb * 32 + crow(r, hi)) * 128 + d0 * 32 + r32] = o[d0][r];
    }
    __syncthreads();
    {
        const u16* OG = (const u16*)(p.ws + OFF_OG); u16* mix = (u16*)(p.ws + OFF_ACT);
        const float* xf = (const float*)(lds + 67584);
#pragma unroll
        for (int i = 0; i < 4; ++i) {
            const int idx = tid + 512 * i, ql = idx >> 4, c = (idx & 15) * 8;
            const f32x4 f0 = *reinterpret_cast<const f32x4*>(xf + ql * 128 + c), f1 = *reinterpret_cast<const f32x4*>(xf + ql * 128 + c + 4);
            const f32x4 b0 = *reinterpret_cast<const f32x4*>(xb + ql * 128 + c), b1 = *reinterpret_cast<const f32x4*>(xb + ql * 128 + c + 4);
            const u32x4 og = *reinterpret_cast<const u32x4*>(OG + (size_t)(row0 + ql) * 512 + h * 128 + c);
            u32x4 w;
            w[0] = cvtpk((f0[0] + b0[0]) * bflo(og[0]), (f0[1] + b0[1]) * bfhi(og[0]));
            w[1] = cvtpk((f0[2] + b0[2]) * bflo(og[1]), (f0[3] + b0[3]) * bfhi(og[1]));
            w[2] = cvtpk((f1[0] + b1[0]) * bflo(og[2]), (f1[1] + b1[1]) * bfhi(og[2]));
            w[3] = cvtpk((f1[2] + b1[2]) * bflo(og[3]), (f1[3] + b1[3]) * bfhi(og[3]));
            *reinterpret_cast<u32x4*>(mix + (size_t)(row0 + ql) * 1024 + 512 + h * 128 + c) = w;
        }
    }
}

#define KSWZ(row, colB) ((row) * 256 + ((colB) ^ (((row) & 15) << 4)))
constexpr float A2_SCALE = 0.125f, A2_THR = 8.f;
DEVI void a2_partialSM(f32x16& p0, f32x16& p1, float) {
#pragma unroll
    for (int r = 0; r < 16; ++r) p0[r] = __builtin_amdgcn_exp2f(p0[r]);
}
DEVI void a2_finishSM(f32x16& p0, f32x16& p1, f32x16& lv, bf16x8& pa0, bf16x8& pa1, bf16x8& pa2, bf16x8& pa3) {
#pragma unroll
    for (int r = 0; r < 16; ++r) p1[r] = __builtin_amdgcn_exp2f(p1[r]);
#pragma unroll
    for (int r = 0; r < 16; ++r) lv[r] += p0[r] + p1[r];
    pack_p_perm(p0, pa0, pa1); pack_p_perm(p1, pa2, pa3);
}
DEVI void a2_qkt(f32x16& p0, f32x16& p1, const char* Ks, const bf16x8 (&qr)[4], int r32, int hi, int grp, const f32x16& cinit) {
#pragma unroll
    for (int d0 = 0; d0 < 4; ++d0) { const int cb = (grp * 64 + d0 * 16 + hi * 8) * 2;
        const bf16x8 b0 = lds_b128(Ks, KSWZ(r32, cb)), b1 = lds_b128(Ks, KSWZ(32 + r32, cb));
        if (d0 == 0) { p0 = __builtin_amdgcn_mfma_f32_32x32x16_bf16(b0, qr[0], cinit, 0, 0, 0); p1 = __builtin_amdgcn_mfma_f32_32x32x16_bf16(b1, qr[0], cinit, 0, 0, 0); }
        else { p0 = __builtin_amdgcn_mfma_f32_32x32x16_bf16(b0, qr[d0], p0, 0, 0, 0); p1 = __builtin_amdgcn_mfma_f32_32x32x16_bf16(b1, qr[d0], p1, 0, 0, 0); } }
}
#define A2_VISSUE(D0, F) do { tr_frag_issue<D0, 0>(vb, F##l0, F##h0); tr_frag_issue<D0, 1>(vb, F##l1, F##h1); tr_frag_issue<D0, 2>(vb, F##l2, F##h2); tr_frag_issue<D0, 3>(vb, F##l3, F##h3); } while (0)
#define A2_VMMA(D0, F) do { \
    o[D0] = __builtin_amdgcn_mfma_f32_32x32x16_bf16(pa0, PKLH(F##l0, F##h0), o[D0], 0, 0, 0); o[D0] = __builtin_amdgcn_mfma_f32_32x32x16_bf16(pa1, PKLH(F##l1, F##h1), o[D0], 0, 0, 0); \
    o[D0] = __builtin_amdgcn_mfma_f32_32x32x16_bf16(pa2, PKLH(F##l2, F##h2), o[D0], 0, 0, 0); o[D0] = __builtin_amdgcn_mfma_f32_32x32x16_bf16(pa3, PKLH(F##l3, F##h3), o[D0], 0, 0, 0); } while (0)
#define A2_LGKM(N) do { asm volatile("s_waitcnt lgkmcnt(" #N ")" ::: "memory"); SBAR(); } while (0)
template <int S> DEVI void a2_psm_slice(f32x16& x0, f32x16&, float) {
#pragma unroll
    for (int r = 4 * S; r < 4 * S + 4; ++r) x0[r] = __builtin_amdgcn_exp2f(x0[r]);
}
DEVI void a2_pv(f32x16 (&o)[4], int vb, const bf16x8& pa0, const bf16x8& pa1, const bf16x8& pa2, const bf16x8& pa3, f32x16& x0, f32x16& x1, float mnC) {
    s16x4 al0, ah0, al1, ah1, al2, ah2, al3, ah3, bl0, bh0, bl1, bh1, bl2, bh2, bl3, bh3;
    A2_VISSUE(0, a); A2_VISSUE(1, b);
    A2_LGKM(8); a2_psm_slice<0>(x0, x1, mnC); A2_VMMA(0, a);
    A2_VISSUE(2, a);
    A2_LGKM(8); a2_psm_slice<1>(x0, x1, mnC); A2_VMMA(1, b);
    A2_VISSUE(3, b);
    A2_LGKM(8); a2_psm_slice<2>(x0, x1, mnC); A2_VMMA(2, a);
    A2_LGKM(0); a2_psm_slice<3>(x0, x1, mnC); A2_VMMA(3, b);
}
DEVI void a2_pv_last(f32x16 (&o)[4], int vb, const bf16x8& pa0, const bf16x8& pa1, const bf16x8& pa2, const bf16x8& pa3) {
    s16x4 al0, ah0, al1, ah1, al2, ah2, al3, ah3, bl0, bh0, bl1, bh1, bl2, bh2, bl3, bh3;
    A2_VISSUE(0, a); A2_VISSUE(1, b);
    A2_LGKM(8); A2_VMMA(0, a);
    A2_VISSUE(2, a);
    A2_LGKM(8); A2_VMMA(1, b);
    A2_VISSUE(3, b);
    A2_LGKM(8); A2_VMMA(2, a);
    A2_LGKM(0); A2_VMMA(3, b);
}
constexpr int A2_T = 16384;
DEVI void a2_body(const P& p, int q0, int k0row, int seq, int h, char* lds, int tid) {
    const int GRP = __builtin_amdgcn_readfirstlane(tid >> 8); const int wid = tid >> 6, lane = tid & 63, r32 = lane & 31, hi = lane >> 5, wq = wid & 3;
    const u16* Kh = (const u16*)(p.ws + OFF_K) + (size_t)k0row * 512 + h * 128;
    const u16* Vh = (const u16*)(p.ws + OFF_V) + (size_t)k0row * 512 + h * 128;
    char* V_lds = lds; char* K_lds = lds + 3 * A2_T;
    float* wsc = (float*)(lds + 6 * A2_T) + wid * 64; float* li_l = wsc;
    float l_reg = 0.f; f32x16 o[4] = {}; bf16x8 qr[4];
    { const u16* Qw = (const u16*)(p.ws + OFF_Q) + (size_t)(q0 + wq * 32 + r32) * 512 + h * 128 + GRP * 64 + hi * 8;
#pragma unroll
      for (int d0 = 0; d0 < 4; ++d0) qr[d0] = *reinterpret_cast<const bf16x8*>(Qw + d0 * 16); }
    float mnC;
    { float qq = 0.f;
#pragma unroll
      for (int d0 = 0; d0 < 4; ++d0) { const u32x4 w = *reinterpret_cast<const u32x4*>(&qr[d0]);
#pragma unroll
          for (int j = 0; j < 4; ++j) { const float a = bflo(w[j]), b2 = bfhi(w[j]); qq = fmaf(a, a, qq); qq = fmaf(b2, b2, qq); } }
      { auto rr = __builtin_amdgcn_permlane32_swap(__float_as_uint(qq), __float_as_uint(qq), false, false); qq = __uint_as_float(rr[0]) + __uint_as_float(rr[1]); }
      const int bq = k0row >= TT ? 1 : 0;
      const float k2 = __uint_as_float(((const unsigned*)(p.ws + OFF_CNT))[128 + bq * 8 + h * 2 + GRP]);
      mnC = -sqrtf(qq * k2) * (A2_SCALE * 1.4426950408889634f) * 1.001f;
#pragma unroll
      for (int d0 = 0; d0 < 4; ++d0) { u32x4 w = *reinterpret_cast<u32x4*>(&qr[d0]);
#pragma unroll
          for (int j = 0; j < 4; ++j) w[j] = cvtpk(bflo(w[j]) * (A2_SCALE * 1.4426950408889634f), bfhi(w[j]) * (A2_SCALE * 1.4426950408889634f));
          qr[d0] = *reinterpret_cast<bf16x8*>(&w); } }
    const int vb0 = (int)(uintptr_t)V_lds + v_rd_base(lane);
    const int krow = tid >> 4, kch = (tid & 15) ^ (krow & 15);
    const int vc = ((tid >> 5) & 3) * 32 + (tid & 3) * 8;
    const int kk0 = (tid >> 7) * 8 + ((tid & 31) >> 2), kk1 = kk0 + 32;
#define A2_DMA(slot, kk) do { \
    __builtin_amdgcn_global_load_lds((const unsigned*)(Kh + (size_t)((kk) + krow) * 512 + kch * 8), (LAS unsigned*)(K_lds + (slot) * A2_T + tid * 16), 16, 0, 0); \
    __builtin_amdgcn_global_load_lds((const unsigned*)(Kh + (size_t)((kk) + 32 + krow) * 512 + kch * 8), (LAS unsigned*)(K_lds + (slot) * A2_T + 8192 + tid * 16), 16, 0, 0); \
    __builtin_amdgcn_global_load_lds((const unsigned*)(Vh + (size_t)((kk) + kk0) * 512 + vc), (LAS unsigned*)(V_lds + (slot) * A2_T + tid * 16), 16, 0, 0); \
    __builtin_amdgcn_global_load_lds((const unsigned*)(Vh + (size_t)((kk) + kk1) * 512 + vc), (LAS unsigned*)(V_lds + (slot) * A2_T + 8192 + tid * 16), 16, 0, 0); } while (0)
    f32x16 pA0, pA1, pB0, pB1; bf16x8 pa0, pa1, pa2, pa3; const int NT = seq / 64;
    f32x16 lv = {};
    f32x16 cinit;
#pragma unroll
    for (int r = 0; r < 16; ++r) cinit[r] = mnC;
    asm volatile("" : "+v"(cinit));
    __syncthreads();
    A2_DMA(0, 0); asm volatile("s_waitcnt vmcnt(0)" ::: "memory"); __syncthreads();
    A2_DMA(1, 64);
    a2_qkt(pA0, pA1, K_lds, qr, r32, hi, GRP, cinit); a2_partialSM(pA0, pA1, mnC);
    asm volatile("s_waitcnt vmcnt(0)" ::: "memory"); __syncthreads();
    int bp = 0, bc = 1, bn = 2;
#define A2_HALF(X0, X1, Y0, Y1, J) do { \
        if ((J) + 1 < NT) A2_DMA(bn, ((J) + 1) * 64); \
        SBAR(); a2_qkt(X0, X1, K_lds + bc * A2_T, qr, r32, hi, GRP, cinit); \
        a2_finishSM(Y0, Y1, lv, pa0, pa1, pa2, pa3); \
        __builtin_amdgcn_sched_group_barrier(0x100, 8, 0); \
        _Pragma("unroll") for (int g_ = 0; g_ < 8; ++g_) { __builtin_amdgcn_sched_group_barrier(0x8, 1, 0); __builtin_amdgcn_sched_group_barrier(0x2, 9, 0); } \
        SBAR(); \
        a2_pv(o, vb0 + bp * A2_T, pa0, pa1, pa2, pa3, X0, X1, mnC); \
        asm volatile("s_waitcnt vmcnt(0)" ::: "memory"); __syncthreads(); \
        { const int t_ = bp; bp = bc; bc = bn; bn = t_; } } while (0)
    for (int j = 1; j + 1 < NT; j += 2) {
        A2_HALF(pB0, pB1, pA0, pA1, j);
        A2_HALF(pA0, pA1, pB0, pB1, j + 1);
    }
    A2_HALF(pB0, pB1, pA0, pA1, NT - 1);
    a2_finishSM(pB0, pB1, lv, pa0, pa1, pa2, pa3); SBAR();
    a2_pv_last(o, vb0 + bp * A2_T, pa0, pa1, pa2, pa3);
#undef A2_HALF
#undef A2_DMA
    asm volatile("s_waitcnt vmcnt(0)" ::: "memory");
    int tz = threadIdx.x; asm volatile("" : "+v"(tz));
    const int wq_e = (tz >> 6) & 3, r32e = tz & 31, hie = (tz >> 5) & 1;
    float* li_e = (float*)(lds + 6 * A2_T) + (tz >> 6) * 64;
    const float lam = ((const float*)(p.ws + OFF_LAM))[0];
#pragma unroll
    for (int r = 0; r < 16; ++r) l_reg += lv[r];
    { auto rr = __builtin_amdgcn_permlane32_swap(__float_as_uint(l_reg), __float_as_uint(l_reg), false, false); l_reg = __uint_as_float(rr[0]) + __uint_as_float(rr[1]); }
    if (hie == 0) li_e[r32e] = (GRP == 0 ? 1.f : -lam) / l_reg;
    asm volatile("s_waitcnt lgkmcnt(0)" ::: "memory");
#pragma unroll
    for (int r = 0; r < 16; ++r) { const float sc_ = li_e[crow(r, hie)];
#pragma unroll
        for (int d = 0; d < 4; ++d) o[d][r] *= sc_; }
    float* xb = (float*)lds;
    __syncthreads();
    if (GRP == 1) {
#pragma unroll
        for (int d = 0; d < 4; ++d)
#pragma unroll
            for (int r = 0; r < 16; ++r) xb[(wq_e * 32 + crow(r, hie)) * 128 + d * 32 + r32e] = o[d][r];
    }
    __syncthreads();
    if (GRP == 0) {
        float ssq[16];
#pragma unroll
        for (int r = 0; r < 16; ++r) { float s_ = 0.f;
#pragma unroll
            for (int d = 0; d < 4; ++d) { const float v = o[d][r] + xb[(wq_e * 32 + crow(r, hie)) * 128 + d * 32 + r32e]; o[d][r] = v; s_ = fmaf(v, v, s_); }
            ssq[r] = s_; }
#pragma unroll
        for (int r = 0; r < 16; ++r) { float s_ = ssq[r]; for (int of = 16; of; of >>= 1) s_ += __shfl_xor(s_, of); ssq[r] = rsqrtf(s_ * (1.f / 128.f) + 1e-6f) * 0.8f; }
        u16* mix = (u16*)(p.ws + OFF_ACT);
#pragma unroll
        for (int d = 0; d < 4; ++d) { const float gv = p.subln_g[d * 32 + r32e];
#pragma unroll
            for (int r = 0; r < 16; ++r) mix[(size_t)(q0 + wq_e * 32 + crow(r, hie)) * 1024 + h * 128 + d * 32 + r32e] = f2bf(o[d][r] * ssq[r] * gv); }
    }
}
DEVI void phase_attn(const P& p, char* lds) {
    const int G = gridDim.x;
    for (int it = blockIdx.x; it < 1024 + 16; it += G) {
        int q0, k0, seq, h;
        if (it < 1024) {
            int bh, qb;
            if ((G & 7) == 0) { bh = it & 7; qb = it >> 3; } else { bh = it >> 7; qb = it & 127; }
            const int b = bh >> 2; h = bh & 3; q0 = b * TT + TC + qb * 128; k0 = b * TT; seq = TT;
        } else { const int j = it - 1024, b = j >> 3; h = (j >> 1) & 3; q0 = b * TT + (j & 1) * 128; k0 = b * TT; seq = TC; }
        int tid = threadIdx.x; asm volatile("" : "+v"(tid));
        a2_body(p, q0, k0, seq, h, lds, tid);
    }
}
DEVI void phase_mlstm_c(const P& p, char* lds) {
    for (int it = blockIdx.x; it < NB * 4 * NCH; it += gridDim.x) mlstm_c_item(p, it, lds);
}

DEVI void tail_bg(const P& p, char* lds, int nunits, int first, int nitems) {
    const int G = gridDim.x, c = blockIdx.x, full = nunits / G, rem = nunits - full * G;
    __syncthreads();
    if (rem == 0) { for (int it = c; it < nitems; it += G) bg_item(p, first + it, (float*)lds); }
    else if (c >= rem) { for (int it = c - rem; it < nitems; it += G - rem) bg_item(p, first + it, (float*)lds); }
    __syncthreads();
}
DEVI void tail_convert(const P& p, char* lds, int layer, int nunits) {
    const int G = gridDim.x, c = blockIdx.x, full = nunits / G, rem = nunits - full * G;
    __syncthreads();
    if (rem == 0) { for (int it = c; it < N0_EXP; it += G) convert_expert_item(p, layer, it, (float*)lds); }
    else if (c >= rem) { for (int it = c - rem; it < N0_EXP; it += G - rem) convert_expert_item(p, layer, it, (float*)lds); }
    __syncthreads();
}
DEVI void phase_convert_l1(const P& p, char* lds) {
    for (int it = blockIdx.x; it < N0_EXP; it += gridDim.x) convert_expert_item(p, 1, it, (float*)lds);
}

constexpr int NPHASE = 19;
__global__ void __launch_bounds__(NTHR, 2) fwd_kernel(P p_) {
    extern __shared__ __attribute__((aligned(16))) char lds[];
    volatile LAS unsigned* st = (volatile LAS unsigned*)(lds + LDS_BYTES - 16);
    if (threadIdx.x == 0) { st[0] = 0u; st[1] = 0u; st[2] = 0u; st[3] = 0u; }
    __syncthreads();
    const int lo = p_.ph_lo, hi = p_.ph_hi;
    XcdBarrier bar; bar.bar = (unsigned*)(p_.ws + OFF_BAR); bar.x = 0; bar.st = st;
    if (hi - lo > 1) bar = xcd_barrier_post((unsigned*)(p_.ws + OFF_BAR), st);
#if defined(__HIP_DEVICE_COMPILE__)
#define PARAMS() const __attribute__((address_space(4))) P* kp_ = (const __attribute__((address_space(4))) P*)__builtin_amdgcn_kernarg_segment_ptr(); asm volatile("" : "+s"(kp_)); const P p = *kp_
#else
#define PARAMS() const P p = p_
#endif
#ifndef PHSEL
#define PHON(k) true
#else
#define PHON(k) ((k) == PHSEL)
#endif
#define IN(k) (lo <= (k) && (k) < hi)
#define SEAM(k) do { if (IN(k) && IN((k) + ((k) == 5 ? 2 : 1))) xcd_barrier(bar); } while (0)
    if (PHON(0) && IN(0)) { PARAMS(); phase_prologue(p, lds); if (((PROBE_DUP) >> 0) & 1u) { phase_prologue(p, lds); } }            SEAM(0);
    if (PHON(1) && IN(1)) { PARAMS(); phase_norm<0>(p, lds); if (((PROBE_DUP) >> 1) & 1u) { phase_norm<0>(p, lds); } }             SEAM(1);
    if (PHON(2) && IN(2)) { PARAMS(); phase_inproj(p, lds); tail_convert(p, lds, 0, (NTOK / 256) * 14); if (((PROBE_DUP) >> 2) & 1u) { phase_inproj(p, lds); } }              SEAM(2);
    if (PHON(3) && IN(3)) { PARAMS(); phase_mlstm_a(p, lds); tail_bg(p, lds, NB * 4 * NCH, 0, N0_WOUT); if (((PROBE_DUP) >> 3) & 1u) { phase_mlstm_a(p, lds); } }             SEAM(3);
    if (PHON(4) && IN(4)) { PARAMS(); phase_kmax(p, lds); phase_mlstm_b(p, lds); if (((PROBE_DUP) >> 4) & 1u) { xcd_barrier(bar); phase_mlstm_a(p, lds); xcd_barrier(bar); phase_mlstm_b(p, lds); } }             SEAM(4);
    if (PHON(5) && IN(5)) { PARAMS(); phase_attn(p, lds); phase_mlstm_c(p, lds); tail_bg(p, lds, NB * 4 * NCH, N0_WOUT, N0_FN); if (((PROBE_DUP) >> 5) & 1u) { phase_attn(p, lds); } if (((PROBE_DUP) >> 6) & 1u) { phase_mlstm_c(p, lds); } }   SEAM(5);
    if (PHON(7) && IN(7)) { PARAMS(); phase_outproj(p, lds); tail_convert(p, lds, 1, (NTOK / 256) * 4); if (((PROBE_DUP) >> 7) & 1u) { phase_outproj(p, lds); } }             SEAM(7);
    if (PHON(8) && IN(8)) { PARAMS(); phase_norm<1>(p, lds); if (((PROBE_DUP) >> 8) & 1u) { phase_norm<1, true>(p, lds); } }             SEAM(8);
    if (PHON(9) && IN(9)) { PARAMS(); phase_moe_up(p, 0, lds); if (((PROBE_DUP) >> 9) & 1u) { phase_moe_up(p, 0, lds); } }           SEAM(9);
    if (PHON(10) && IN(10)) { PARAMS(); phase_moe_down(p, 0, lds); if (((PROBE_DUP) >> 10) & 1u) { phase_moe_down<true>(p, 0, lds); } }        SEAM(10);
    if (PHON(11) && IN(11)) { PARAMS(); phase_norm<2>(p, lds); if (((PROBE_DUP) >> 11) & 1u) { phase_norm<2>(p, lds); } } SEAM(11);
    if (PHON(12) && IN(12)) { PARAMS(); phase_fnet_gemm(p, lds); if (((PROBE_DUP) >> 12) & 1u) { phase_fnet_gemm(p, lds); } }          SEAM(12);
    if (PHON(13) && IN(13)) { PARAMS(); phase_fft1(p, lds); if (((PROBE_DUP) >> 13) & 1u) { phase_fft1(p, lds); } }               SEAM(13);
    if (PHON(14) && IN(14)) { PARAMS(); phase_fft2(p, lds); if (((PROBE_DUP) >> 14) & 1u) { phase_fft2<true>(p, lds); } }               SEAM(14);
    if (PHON(15) && IN(15)) { PARAMS(); phase_norm<3>(p, lds); if (((PROBE_DUP) >> 15) & 1u) { phase_norm<3, true>(p, lds); } }            SEAM(15);
    if (PHON(16) && IN(16)) { PARAMS(); phase_moe_up(p, 1, lds); if (((PROBE_DUP) >> 16) & 1u) { phase_moe_up(p, 1, lds); } }          SEAM(16);
    if (PHON(17) && IN(17)) { PARAMS(); phase_moe_down(p, 1, lds); if (((PROBE_DUP) >> 17) & 1u) { phase_moe_down<true>(p, 1, lds); } }        SEAM(17);
    if (PHON(18) && IN(18)) { PARAMS(); phase_norm<4>(p, lds); if (((PROBE_DUP) >> 18) & 1u) { phase_norm<4>(p, lds); } }
#undef IN
#undef SEAM
}

#ifndef ONE_LAUNCH
#define ONE_LAUNCH 1
#endif
extern "C" void kernel_launch(void* const* d_in, const int* in_sizes, int n_in, void* d_out, int out_size, void* d_ws, size_t ws_size, hipStream_t stream) {
    static int grid = 0;
    if (grid == 0) {
        if (n_in != 21 || out_size != NLAT * DM || ws_size < OFF_END) { fprintf(stderr, "kernel_launch: unexpected shapes (n_in %d out %d ws %zu need %zu)\n", n_in, out_size, ws_size, (size_t)OFF_END); grid = -1; return; }
        int dev = 0, cus = 0;
        if (hipGetDevice(&dev) != hipSuccess || hipDeviceGetAttribute(&cus, hipDeviceAttributeMultiprocessorCount, dev) != hipSuccess) { grid = -1; return; }
        if (hipFuncSetAttribute((const void*)fwd_kernel, hipFuncAttributeMaxDynamicSharedMemorySize, LDS_BYTES) != hipSuccess) { fprintf(stderr, "kernel_launch: hipFuncSetAttribute failed\n"); grid = -1; return; }
        int per_cu = 0;
        if (hipOccupancyMaxActiveBlocksPerMultiprocessor(&per_cu, (const void*)fwd_kernel, NTHR, LDS_BYTES) != hipSuccess || per_cu < 1) { fprintf(stderr, "kernel_launch: occupancy query says %d\n", per_cu); (void)hipGetLastError(); grid = -1; return; }
        grid = cus;
    }
    if (grid < 0) return;
    (void)hipMemsetAsync(d_ws, 0, ZERO_BYTES, stream);
    P p{};
    const float* const* in = (const float* const*)d_in;
    p.x = in[0]; p.c = in[1]; p.ctx = in[2]; p.c_ctx = in[3]; p.ada_w = in[4]; p.ada_b = in[5]; p.nmix_g = in[6]; p.nffn_g = in[7];
    p.w_in = in[8]; p.w_out = in[9]; p.conv_w = in[10]; p.gate_b = in[11]; p.lamv = in[12]; p.subln_g = in[13]; p.w_fnet = in[14];
    p.router_w = in[15]; p.router_b = in[16]; p.w_gate = in[17]; p.w_up = in[18]; p.w_down = in[19]; p.final_g = in[20];
    p.out = (float*)d_out; p.ws = (char*)d_ws;
#if ONE_LAUNCH
    p.ph_lo = 0; p.ph_hi = NPHASE;
    hipLaunchKernelGGL(fwd_kernel, dim3(grid), dim3(NTHR), LDS_BYTES, stream, p);
#else
    for (int k = 0; k < NPHASE; ++k) { p.ph_lo = k; p.ph_hi = k + 1; hipLaunchKernelGGL(fwd_kernel, dim3(grid), dim3(NTHR), LDS_BYTES, stream, p); }
#endif
}
```

```cpp
#include <hip/hip_runtime.h>
#include <stdint.h>
#include <stdio.h>

#define DEVI __device__ __forceinline__
#define PROBE_DUP (0u)
typedef unsigned short u16;
typedef unsigned int u32;
using bf16x8 = __attribute__((ext_vector_type(8))) short;
using s16x4  = __attribute__((ext_vector_type(4))) short;
using f32x16 = __attribute__((ext_vector_type(16))) float;
using f32x4  = __attribute__((ext_vector_type(4))) float;
using u32x4  = __attribute__((ext_vector_type(4))) unsigned;
using u32x2  = __attribute__((ext_vector_type(2))) unsigned;

constexpr int DM = 1024, NB = 2, TL = 16384, TC = 256, TT = TL + TC, NTOK = NB * TT, NLAT = NB * TL;
constexpr int NCH = TT / 128;
constexpr int NTHR = 512;
constexpr int LDS_BYTES = 147456;

constexpr size_t al256(size_t x) { return (x + 255) / 256 * 256; }
constexpr size_t OFF_BAR   = 0;
constexpr size_t OFF_CNT   = 16384;
constexpr size_t ZERO_BYTES = 20480;
constexpr size_t OFF_MOD   = ZERO_BYTES;
constexpr size_t OFF_ROPER = OFF_MOD + al256(2 * 3 * 6144 * 4);
constexpr size_t OFF_ROPEC = OFF_ROPER + 256 * 16 * 8;
constexpr size_t OFF_TW    = OFF_ROPEC + 64 * 16 * 8;
constexpr size_t OFF_DFTC  = OFF_TW + 16384 * 8;
constexpr size_t OFF_DFTS  = OFF_DFTC + 32768;
constexpr size_t OFF_LAM   = OFF_DFTS + 32768;
constexpr size_t OFF_WG16  = OFF_LAM + 256;
constexpr size_t OFF_MSCAL = OFF_WG16 + 65536;
constexpr size_t OFF_MST   = OFF_MSCAL + al256(16 * NCH * 8);
constexpr size_t OFF_WINT  = OFF_MST + al256(16 * NCH * 4);
constexpr size_t OFF_WOUTT = OFF_WINT + (size_t)3584 * 1024 * 2;
constexpr size_t OFF_FNT   = OFF_WOUTT + (size_t)1024 * 1024 * 2;
constexpr size_t OFF_WGU   = OFF_FNT + (size_t)2048 * 1024 * 2;
constexpr size_t OFF_WDT   = OFF_WGU + (size_t)16 * 1024 * 1024 * 2;
constexpr size_t OFF_ACT   = OFF_WDT + (size_t)16 * 1024 * 512 * 2;
constexpr size_t SZ_ACT    = (size_t)NTOK * 1024 * 2;
constexpr size_t OFF_XC    = OFF_ACT + SZ_ACT;
constexpr size_t OFF_GATES = OFF_XC + (size_t)NB * TC * 1024 * 4;
constexpr size_t OFF_TOKW  = OFF_GATES + (size_t)NTOK * 16 * 4;
constexpr size_t OFF_LIST  = OFF_TOKW + al256((size_t)NTOK * 8);
constexpr size_t OFF_NST   = OFF_LIST + (size_t)24 * NTOK * 4;
constexpr size_t OFF_CST   = OFF_NST + (size_t)16 * NCH * 128 * 4;
constexpr size_t SZ_CST    = (size_t)16 * NCH * 16384 * 2;
constexpr size_t OFF_BIG   = OFF_CST + SZ_CST;
constexpr size_t OFF_Q     = OFF_BIG;
constexpr size_t OFF_K     = OFF_Q + (size_t)NTOK * 512 * 2;
constexpr size_t OFF_V     = OFF_K + (size_t)NTOK * 512 * 2;
constexpr size_t OFF_MLQK  = OFF_V + (size_t)NTOK * 512 * 2;
constexpr size_t OFF_MLV   = OFF_MLQK + (size_t)NTOK * 1024 * 2;
constexpr size_t OFF_OG    = OFF_MLV + (size_t)NTOK * 512 * 2;
constexpr size_t OFF_MLC   = OFF_OG + (size_t)NTOK * 512 * 2;
constexpr size_t OFF_END   = OFF_MLC + (size_t)NTOK * 1024 * 2;
constexpr size_t OFF_HE    = OFF_BIG;
constexpr size_t OFF_ZR    = OFF_BIG;
constexpr size_t OFF_ZI    = OFF_ZR + (size_t)NLAT * 1024 * 2;
constexpr size_t OFF_WGU1  = OFF_MLV + (size_t)2 * 1024 * 1024;
constexpr size_t OFF_WDT1  = OFF_WGU1 + (size_t)16 * 1024 * 1024 * 2;
static_assert(OFF_WDT1 + (size_t)16 * 1024 * 512 * 2 <= OFF_MLC && OFF_WGU1 >= OFF_BIG + (size_t)NLAT * 2048 * 2, "layer-1 expert region");
constexpr size_t OFF_YR    = OFF_CST;
constexpr size_t OFF_YI    = OFF_ACT;
static_assert((size_t)NLAT * 1024 * 2 <= SZ_CST && (size_t)NLAT * 1024 * 2 <= SZ_ACT, "alias sizes");
static_assert(OFF_END < (size_t)508 * 1024 * 1024, "workspace");

struct P {
    const float *x, *c, *ctx, *c_ctx, *ada_w, *ada_b, *nmix_g, *nffn_g, *w_in, *w_out, *conv_w, *gate_b, *lamv, *subln_g,
                *w_fnet, *router_w, *router_b, *w_gate, *w_up, *w_down, *final_g;
    float* out;
    char* ws;
    int ph_lo, ph_hi;
};

#define XB_TMO      128
#define XB_XCNT(j)  (256  + 64 * (j))
#define XB_XSUB(j)  (1280 + 64 * (j))
#define XB_XGEN(j)  (2304 + 64 * (j))
#define XB_TOP      3328
#define XB_TOPGEN   3392
#define XCD_BAR_WORDS 3456
#define XB_SPIN_CAP (1u << 18)
#define LAS __attribute__((address_space(3)))

__device__ __forceinline__ unsigned xb_ld(unsigned* p)              { return __hip_atomic_load(p, __ATOMIC_RELAXED, __HIP_MEMORY_SCOPE_AGENT); }
__device__ __forceinline__ unsigned xb_add(unsigned* p, unsigned v) { return __hip_atomic_fetch_add(p, v, __ATOMIC_RELAXED, __HIP_MEMORY_SCOPE_AGENT); }
__device__ __forceinline__ unsigned xb_xcc_id() { return (unsigned)__builtin_amdgcn_s_getreg((3 << 11) | 20) & 0xFu; }
#define XB_SPIN(cond, bar) do { unsigned _sp = 0; while (cond) { __builtin_amdgcn_s_sleep(1); \
    if ((++_sp & 255u) == 0u) { if (xb_ld(&(bar)[XB_TMO])) break; if (_sp > XB_SPIN_CAP) { atomicAdd(&(bar)[XB_TMO], 1u); break; } } } } while (0)

struct XcdBarrier { unsigned* bar; unsigned x; volatile LAS unsigned* st; };

__device__ __forceinline__ XcdBarrier xcd_barrier_post(unsigned* bar, volatile LAS unsigned* st) {
    XcdBarrier b; b.bar = bar; b.x = xb_xcc_id(); b.st = st;
    if (threadIdx.x == 0) (void)xb_add(&bar[XB_XCNT(b.x)], 1u);
    return b;
}
__device__ __forceinline__ void xcd_barrier_complete(unsigned* bar, unsigned x, unsigned& nloc, unsigned& nx) {
    const unsigned G = gridDim.x * gridDim.y * gridDim.z;
    unsigned sum, cnt, mine, sp = 0u;
    for (;;) {
        sum = 0u; cnt = 0u; mine = 0u;
#pragma unroll
        for (unsigned j = 0; j < 16; ++j) { const unsigned c = xb_ld(&bar[XB_XCNT(j)]); sum += c; cnt += (c > 0u) ? 1u : 0u; mine = (j == x) ? c : mine; }
        if (sum == G) break;
        __builtin_amdgcn_s_sleep(1);
        if ((++sp & 255u) == 0u) { if (xb_ld(&bar[XB_TMO])) break; if (sp > XB_SPIN_CAP) { atomicAdd(&bar[XB_TMO], 1u); break; } }
    }
    nloc = mine > 0u ? mine : 1u; nx = cnt > 0u ? cnt : 1u;
}
__device__ __forceinline__ void xcd_barrier(const XcdBarrier& b) {
    asm volatile("s_waitcnt vmcnt(0)" ::: "memory");
    __syncthreads();
    if (threadIdx.x == 0) {
        unsigned* bar = b.bar;
        __builtin_amdgcn_s_waitcnt(0);
        unsigned nloc = b.st[0], nx = b.st[1];
        if (nloc == 0u) { xcd_barrier_complete(bar, b.x, nloc, nx); b.st[0] = nloc; b.st[1] = nx; }
        const unsigned old = xb_add(&bar[XB_XSUB(b.x)], 1u);
        const unsigned gen = old / nloc;
        if (old + 1u == (gen + 1u) * nloc) {
            __builtin_amdgcn_fence(__ATOMIC_RELEASE, "agent");
            asm volatile("s_waitcnt vmcnt(0)" ::: "memory");
            const unsigned og = xb_add(&bar[XB_TOP], 1u);
            const unsigned tg = og / nx;
            if (og + 1u == (tg + 1u) * nx) xb_add(&bar[XB_TOPGEN], 1u);
            else XB_SPIN(xb_ld(&bar[XB_TOPGEN]) == tg, bar);
            __builtin_amdgcn_fence(__ATOMIC_ACQUIRE, "agent");
            xb_add(&bar[XB_XGEN(b.x)], 1u);
            asm volatile("s_waitcnt vmcnt(0)" ::: "memory");
        } else {
            XB_SPIN(xb_ld(&bar[XB_XGEN(b.x)]) == gen, bar);
            __builtin_amdgcn_fence(__ATOMIC_ACQUIRE, "agent");
            asm volatile("s_waitcnt vmcnt(0)" ::: "memory");
        }
    }
    __syncthreads();
}

DEVI u16 f2bf(float f) { u32 u = __float_as_uint(f); u += 0x7fffu + ((u >> 16) & 1u); return (u16)(u >> 16); }
DEVI float bf2f(u32 h) { return __uint_as_float(h << 16); }
DEVI u32 cvtpk(float lo, float hi) { u32 r; asm("v_cvt_pk_bf16_f32 %0, %1, %2" : "=v"(r) : "v"(lo), "v"(hi)); return r; }
DEVI float bflo(u32 w) { return __uint_as_float(w << 16); }
DEVI float bfhi(u32 w) { return __uint_as_float(w & 0xffff0000u); }
DEVI int crow(int r, int hi) { return (r & 3) + 8 * (r >> 2) + 4 * hi; }
DEVI float wave_sum(float v) { for (int o = 32; o; o >>= 1) v += __shfl_xor(v, o); return v; }
DEVI float wave_max(float v) { for (int o = 32; o; o >>= 1) v = fmaxf(v, __shfl_xor(v, o)); return v; }
DEVI float sigmoidf_(float x) { return __builtin_amdgcn_rcpf(1.f + __expf(-x)); }
DEVI float siluf_(float x) { return x * __builtin_amdgcn_rcpf(1.f + __expf(-x)); }
DEVI float logsigmoidf_(float x) { return fminf(x, 0.f) - log1pf(__expf(-fabsf(x))); }
#define SBAR() __builtin_amdgcn_sched_barrier(0)

DEVI void sincos2pi(double frac, double& s, double& c) {
    frac -= floor(frac);
    double q = rint(frac * 4.0);
    double r = (frac - q * 0.25) * 6.283185307179586476925;
    double r2 = r * r;
    double sr = r * (1.0 + r2 * (-1.0 / 6 + r2 * (1.0 / 120 + r2 * (-1.0 / 5040 + r2 * (1.0 / 362880 + r2 * (-1.0 / 39916800 + r2 * (1.0 / 6227020800.0 + r2 * (-1.0 / 1307674368000.0))))))));
    double cr = 1.0 + r2 * (-0.5 + r2 * (1.0 / 24 + r2 * (-1.0 / 720 + r2 * (1.0 / 40320 + r2 * (-1.0 / 3628800 + r2 * (1.0 / 479001600.0 + r2 * (-1.0 / 87178291200.0 + r2 * (1.0 / 20922789888000.0))))))));
    int qi = ((int)q) & 3;
    if (qi == 0) { s = sr; c = cr; } else if (qi == 1) { s = cr; c = -sr; } else if (qi == 2) { s = -sr; c = -cr; } else { s = -cr; c = sr; }
}

DEVI u16* xs_ptr(const P& p, int layer, int tok) {
    const int row = layer == 0 ? tok : (tok >> 14) * TT + TC + (tok & (TL - 1));
    return (u16*)(p.ws + OFF_MLC) + (size_t)row * DM;
}
DEVI f32x4 bf4_to_f32(u32x2 w) { f32x4 v; v[0] = bflo(w[0]); v[1] = bfhi(w[0]); v[2] = bflo(w[1]); v[3] = bfhi(w[1]); return v; }
DEVI const float* xin_ptr(const P& p, int tok) {
    int b = tok >= TT ? 1 : 0, t = tok - b * TT;
    if (t < TC) return p.ctx + (size_t)(b * TC + t) * DM;
    return p.x + (size_t)(b * TL + t - TC) * DM;
}
DEVI int modsel(int layer, int tok) {
    if (layer == 0) { int b = tok >= TT ? 1 : 0, t = tok - b * TT; return t < TC ? 2 : b; }
    return tok >> 14;
}

DEVI int swz128(int row, int chunk) { return row * 144 + (chunk << 4); }
DEVI int swz256(int row, int chunk) { return row * 272 + (chunk << 4); }
DEVI int v_st(int k, int c) { const int kk = (k & ~0xC) | ((k & 4) << 1) | ((k & 8) >> 1); return ((kk >> 3) * 4 + (c >> 5)) * 512 + ((kk & 7) * 32 + (c & 31)) * 2; }
DEVI int v_rd_base(int lane) { return ((lane & 3) << 3) | (((lane >> 2) & 3) << 6) | (((lane >> 4) & 1) << 5) | (((lane >> 5) & 1) << 8); }
constexpr int v_rd_off(int d0, int ks, int half) { return d0 * 512 + ks * 4096 + half * 2048; }
template <int OFF> DEVI s16x4 tr_read(int vb) {
    s16x4 r; asm volatile("ds_read_b64_tr_b16 %0, %1 offset:%2" : "=&v"(r) : "v"(vb), "i"(OFF) : "memory"); return r;
}
#define PKLH(L, H) (bf16x8){L[0], L[1], L[2], L[3], H[0], H[1], H[2], H[3]}
template <int D0, int KS> DEVI void tr_frag_issue(int vb, s16x4& l, s16x4& h) { l = tr_read<v_rd_off(D0, KS, 0)>(vb); h = tr_read<v_rd_off(D0, KS, 1)>(vb); }
#define LGKM0() do { asm volatile("s_waitcnt lgkmcnt(0)" ::: "memory"); SBAR(); } while (0)

DEVI bf16x8 lds_b128(const char* base, int off) { return *reinterpret_cast<const bf16x8*>(base + off); }

DEVI void pack_p(const f32x16& pp, bf16x8& f0, bf16x8& f1) {
#define PK4(BASE, OUT) do { unsigned a0 = cvtpk(pp[BASE + 0], pp[BASE + 1]), a1 = cvtpk(pp[BASE + 2], pp[BASE + 3]);   \
    unsigned b0 = cvtpk(pp[BASE + 4], pp[BASE + 5]), b1 = cvtpk(pp[BASE + 6], pp[BASE + 7]);                            \
    auto r0 = __builtin_amdgcn_permlane32_swap(a0, b0, false, false); auto r1 = __builtin_amdgcn_permlane32_swap(a1, b1, false, false); \
    u32x4 w = {r0[0], r1[0], r0[1], r1[1]}; OUT = *reinterpret_cast<bf16x8*>(&w); } while (0)
    PK4(0, f0); PK4(8, f1);
#undef PK4
}

DEVI void pack_p_perm(const f32x16& pp, bf16x8& f0, bf16x8& f1) {
    u32x4 a, b;
    a[0] = cvtpk(pp[0], pp[1]); a[1] = cvtpk(pp[2], pp[3]); a[2] = cvtpk(pp[4], pp[5]); a[3] = cvtpk(pp[6], pp[7]);
    b[0] = cvtpk(pp[8], pp[9]); b[1] = cvtpk(pp[10], pp[11]); b[2] = cvtpk(pp[12], pp[13]); b[3] = cvtpk(pp[14], pp[15]);
    f0 = *reinterpret_cast<bf16x8*>(&a); f1 = *reinterpret_cast<bf16x8*>(&b);
}
namespace g8 {
constexpr int BM = 256, BK = 64, HALF = 128, HTB = HALF * BK * 2, STAGE_BYTES = 8 * HTB, NXCD = 8, WGM = 8;
DEVI int lds_byte(int r, int c) { const int st = (r >> 4) * 2 + (c >> 5), rr = r & 15, cc = c & 31, ob = rr * 64 + cc * 2; return st * 1024 + (ob ^ (((ob >> 9) & 1) << 5)); }
DEVI void stage_rc(int b, int& R, int& C) { const int st = b / 1024, sb = b % 1024, swz = sb ^ (((sb >> 9) & 1) << 5); R = (st >> 1) * 16 + swz / 64; C = (st & 1) * 32 + (swz % 64) / 2; }
DEVI int perm32(int rho) { const int n = rho >> 4, i = rho & 15; return 8 * (i >> 2) + 4 * n + (i & 3); }
struct Unit { int pm, pn; const char* B0; const char* B1; int cls, r0, ncls; };
DEVI bool tile_order(int i, int G, int c, int nM, int nN, int& pm, int& pn) {
    const int nwg = nM * nN; const long L = (long)i * G + c; if (L >= nwg) return false;
    int wgid = (int)L; { const int q = nwg / NXCD, r = nwg % NXCD, xcd = wgid % NXCD, off = wgid / NXCD; wgid = (xcd < r ? xcd * (q + 1) : r * (q + 1) + (xcd - r) * q) + off; }
    const int nig = WGM * nN, gid = wgid / nig, fm = gid * WGM, gsz = (nM - fm) < WGM ? (nM - fm) : WGM;
    pm = fm + ((wgid % nig) % gsz); pn = (wgid % nig) / gsz; return true;
}
typedef float f32x4v __attribute__((ext_vector_type(4)));
template <class Epi, class Sched, int NT = 16  , int LDA = 2048  >
DEVI void gemm_phase(LAS unsigned char* lds, const char* Abase, int ldbB  , int ksplit  , const Sched& S, const Epi& E) {
    const int tid = threadIdx.x, wid = __builtin_amdgcn_readfirstlane(tid >> 6), lane = tid & 63, wr = wid >> 2, wc = wid & 3, fr = lane & 15, fq = lane >> 4;
    constexpr int nt = NT;
    unsigned voffB[2];
#pragma unroll
    for (int i = 0; i < 2; ++i) { int R, C; stage_rc(tid * 16 + i * 8192, R, C); const int Rb = Epi::PERM ? ((R & ~31) + perm32(R & 31)) : R; voffB[i] = (unsigned)(Rb * ldbB + C * 2); }
    const size_t kstep = (size_t)(BK * 2);
    const size_t hstepB = (size_t)HALF * ldbB;
    const unsigned ldsw = (unsigned)wid * 1024u;
    const int aoff = lds_byte(wr * 64 + fr, fq * 8), boff = lds_byte(wc * 32 + fr, fq * 8);
#define G8_SA(b, h) (((b) * 2 + (h)) * HTB)
#define G8_SB(b, h) ((4 + (b) * 2 + (h)) * HTB)
#define G8_STAGE(bufoff, gbase, voff) do { _Pragma("unroll") for (int _i = 0; _i < 2; ++_i) \
        __builtin_amdgcn_global_load_lds((const unsigned*)((const char*)(gbase) + (voff)[_i]), (LAS unsigned*)(lds + (bufoff) + ldsw + _i * 8192), 16, 0, 0); } while (0)
#define G8_LDA(dst, b, h) do { _Pragma("unroll") for (int m = 0; m < 4; ++m) _Pragma("unroll") for (int k = 0; k < 2; ++k) dst[m][k] = *(const LAS bf16x8*)(lds + G8_SA(b, h) + aoff + m * 2048 + k * 1024); } while (0)
#define G8_LDB(dst, b, h) do { _Pragma("unroll") for (int n = 0; n < 2; ++n) _Pragma("unroll") for (int k = 0; k < 2; ++k) dst[n][k] = *(const LAS bf16x8*)(lds + G8_SB(b, h) + boff + n * 2048 + k * 1024); } while (0)
#define G8_MMA(ai, bj, At, Bt) do { __builtin_amdgcn_s_setprio(1); _Pragma("unroll") for (int m = 0; m < 4; ++m) _Pragma("unroll") for (int n = 0; n < 2; ++n) _Pragma("unroll") for (int k = 0; k < 2; ++k) \
        acc[ai][bj][m][n] = __builtin_amdgcn_mfma_f32_16x16x32_bf16(Bt[n][k], At[m][k], acc[ai][bj][m][n], 0, 0, 0); __builtin_amdgcn_s_setprio(0); } while (0)
#define G8_WAIT_V(n) asm volatile("s_waitcnt vmcnt(" #n ")" ::: "memory")
#define G8_WAIT_L(n) asm volatile("s_waitcnt lgkmcnt(" #n ")" ::: "memory")
#define G8_BAR __builtin_amdgcn_s_barrier()
#define G8_SCHED __builtin_amdgcn_sched_barrier(0)
#define G8_BPTR(u, kt) (((kt) < ksplit ? (u).B0 : (u).B1) + (size_t)(kt) * kstep)
    Unit cur, nxt; int ui = 0;
    if (!S.next(0, cur)) return;
    f32x4v acc[2][2][4][2];
#pragma unroll
    for (int a = 0; a < 2; ++a)
#pragma unroll
        for (int b = 0; b < 2; ++b)
#pragma unroll
            for (int m = 0; m < 4; ++m)
#pragma unroll
                for (int n = 0; n < 2; ++n) acc[a][b][m][n] = (f32x4v){0.f, 0.f, 0.f, 0.f};
    bf16x8 At[4][2], B0[2][2], B1[2][2];
    unsigned voffA[2]; unsigned vs[2][2];
    constexpr size_t hstepA = (size_t)HALF * LDA, tstepA = 2 * hstepA;
    if constexpr (Sched::GATHER) S.aoffs(cur, vs);
    else {
#pragma unroll
        for (int i = 0; i < 2; ++i) { int R, C; stage_rc(tid * 16 + i * 8192, R, C); voffA[i] = (unsigned)(R * LDA + C * 2); }
    }
    const char* cA = Sched::GATHER ? Abase : S.abase(cur, Abase) + (size_t)cur.pm * tstepA;
#define G8_STAGE_A(bufoff, ptr, h) do { if constexpr (Sched::GATHER) G8_STAGE(bufoff, ptr, vs[h]); else G8_STAGE(bufoff, (ptr) + (h) * hstepA, voffA); } while (0)
    { const char* cB = G8_BPTR(cur, 0); const char* cB1 = G8_BPTR(cur, 1);
      G8_STAGE(G8_SB(0, 0), cB, voffB); G8_STAGE_A(G8_SA(0, 0), cA, 0); G8_STAGE(G8_SB(0, 1), cB + hstepB, voffB); G8_STAGE_A(G8_SA(0, 1), cA, 1);
      if (wr == 1) G8_BAR;
      G8_WAIT_V(4); G8_BAR;
      G8_STAGE(G8_SB(1, 0), cB1, voffB); G8_STAGE_A(G8_SA(1, 0), cA + kstep, 0); G8_STAGE(G8_SB(1, 1), cB1 + hstepB, voffB);
      G8_WAIT_V(6); G8_BAR; }
    for (;;) {
        bool has_next = false; const char* nA = cA;
        for (int t = 0; t < nt; t += 2) {
            const bool last = (t == nt - 2);
            const char* a1 = cA + (size_t)(t + 1) * kstep;
            G8_LDB(B0, 0, 0); G8_SCHED; G8_LDA(At, 0, 0); G8_STAGE_A(G8_SA(1, 1), a1, 1);
            G8_WAIT_L(8); G8_BAR; G8_WAIT_L(0); G8_MMA(0, 0, At, B0); G8_BAR; G8_SCHED;
            if (last) {
                has_next = S.next(ui + 1, nxt);
                if (has_next) { if constexpr (Sched::GATHER) S.aoffs(nxt, vs); else nA = S.abase(nxt, Abase) + (size_t)nxt.pm * tstepA; } else nxt = cur;
            }
            const char* a2 = last ? nA : cA + (size_t)(t + 2) * kstep; const char* a3 = a2 + kstep;
            const char* b2 = last ? G8_BPTR(nxt, 0) : G8_BPTR(cur, t + 2); const char* b3 = last ? G8_BPTR(nxt, 1) : G8_BPTR(cur, t + 3);
            G8_LDB(B1, 0, 1); G8_STAGE(G8_SB(0, 0), b2, voffB);
            G8_BAR; G8_WAIT_L(0); G8_MMA(0, 1, At, B1); G8_BAR;
            G8_LDA(At, 0, 1); G8_STAGE_A(G8_SA(0, 0), a2, 0);
            G8_BAR; G8_WAIT_L(0); G8_MMA(1, 0, At, B0); G8_BAR; G8_SCHED;
            G8_STAGE(G8_SB(0, 1), b2 + hstepB, voffB);
            G8_WAIT_V(6); G8_BAR; G8_MMA(1, 1, At, B1); G8_BAR;
            G8_LDB(B0, 1, 0); G8_SCHED; G8_LDA(At, 1, 0); G8_STAGE_A(G8_SA(0, 1), a2, 1);
            G8_WAIT_L(8); G8_BAR; G8_WAIT_L(0); G8_MMA(0, 0, At, B0); G8_BAR; G8_SCHED;
            G8_LDB(B1, 1, 1); G8_STAGE(G8_SB(1, 0), b3, voffB);
            G8_BAR; G8_WAIT_L(0); G8_MMA(0, 1, At, B1); G8_BAR;
            G8_LDA(At, 1, 1); G8_STAGE_A(G8_SA(1, 0), a3, 0);
            G8_BAR; G8_WAIT_L(0); G8_MMA(1, 0, At, B0); G8_BAR; G8_SCHED;
            G8_STAGE(G8_SB(1, 1), b3 + hstepB, voffB);
            G8_WAIT_V(6); G8_BAR; G8_MMA(1, 1, At, B1); G8_BAR;
        }
        cA = nA;
        { int tz = threadIdx.x; asm volatile("" : "+v"(tz));
          const int w2 = tz >> 6, l2 = tz & 63; E(acc, cur, w2 >> 2, w2 & 3, l2 & 15, l2 >> 4); }
        if (!has_next) break;
#pragma unroll
        for (int a = 0; a < 2; ++a)
#pragma unroll
            for (int b = 0; b < 2; ++b)
#pragma unroll
                for (int m = 0; m < 4; ++m)
#pragma unroll
                    for (int n = 0; n < 2; ++n) acc[a][b][m][n] = (f32x4v){0.f, 0.f, 0.f, 0.f};
        cur = nxt; ++ui;
    }
    G8_WAIT_V(0);
    if (wr == 0) G8_BAR;
    G8_BAR;
#undef G8_SA
#undef G8_SB
#undef G8_STAGE
#undef G8_STAGE_A
#undef G8_LDA
#undef G8_LDB
#undef G8_MMA
#undef G8_WAIT_V
#undef G8_WAIT_L
#undef G8_BAR
#undef G8_SCHED
#undef G8_BPTR
}
DEVI void lane_rc(int i, int& R, int& C) { int tz = threadIdx.x; asm volatile("" : "+v"(tz)); stage_rc(tz * 16 + i * 8192, R, C); }
struct DenseSched {
    static constexpr bool GATHER = false;
    const char* Bt; int nM, nN, G, c; size_t btile;
    DEVI const char* abase(const Unit&, const char* a) const { return a; }
    DEVI bool next(int i, Unit& u) const { if (!tile_order(i, G, c, nM, nN, u.pm, u.pn)) return false; u.B0 = u.B1 = Bt + (size_t)u.pn * btile; u.cls = 0; u.r0 = 0; u.ncls = 0; return true; }
    DEVI void aoffs(const Unit& u, unsigned (&v)[2][2]) const {
#pragma unroll
        for (int i = 0; i < 2; ++i) { int R, C; lane_rc(i, R, C);
#pragma unroll
            for (int h = 0; h < 2; ++h) v[h][i] = (unsigned)(((u.pm * 256 + h * 128 + R) * 1024 + C) * 2); }
    }
};
}

template <class PF>
DEVI void transpose_tile(PF colptr, int ldsrc, u16* dst, int lddst, int k0, int n0, float* tl) {
    const int t = threadIdx.x, nn = t & 63, kk = t >> 6;
    const float* sp = colptr(n0 + nn);
#pragma unroll
    for (int i = 0; i < 8; ++i) tl[(kk + 8 * i) * 65 + nn] = sp[(size_t)(k0 + kk + 8 * i) * ldsrc];
    __syncthreads();
    const int n = t >> 3, kc = t & 7;
    u32x4 w;
    w[0] = cvtpk(tl[(kc * 8 + 0) * 65 + n], tl[(kc * 8 + 1) * 65 + n]);
    w[1] = cvtpk(tl[(kc * 8 + 2) * 65 + n], tl[(kc * 8 + 3) * 65 + n]);
    w[2] = cvtpk(tl[(kc * 8 + 4) * 65 + n], tl[(kc * 8 + 5) * 65 + n]);
    w[3] = cvtpk(tl[(kc * 8 + 6) * 65 + n], tl[(kc * 8 + 7) * 65 + n]);
    *reinterpret_cast<u32x4*>(dst + (size_t)(n0 + n) * lddst + k0 + kc * 8) = w;
    __syncthreads();
}

DEVI void convert_expert_item(const P& p, int layer, int it, float* tl) {
    const int e = it / 384, r = it % 384;
    const float* wg = p.w_gate + ((size_t)layer * 16 + e) * 1024 * 512;
    const float* wu = p.w_up   + ((size_t)layer * 16 + e) * 1024 * 512;
    const float* wd = p.w_down + ((size_t)layer * 16 + e) * 512 * 1024;
    if (r < 256) {
        u16* dst = (u16*)(p.ws + (layer ? OFF_WGU1 : OFF_WGU)) + (size_t)e * 1024 * 1024;
        const int kt = r >> 4, nt = r & 15;
        transpose_tile([&](int n) { const int q = n >> 8, sgu = (n >> 7) & 1, j = n & 127; return (sgu ? wu : wg) + q * 128 + j; }, 512, dst, 1024, kt * 64, nt * 64, tl);
    } else {
        const int q = r - 256; u16* dst = (u16*)(p.ws + (layer ? OFF_WDT1 : OFF_WDT)) + (size_t)e * 1024 * 512;
        const int kt = q >> 4, nt = q & 15;
        transpose_tile([&](int n) { return wd + n; }, 1024, dst, 512, kt * 64, nt * 64, tl);
    }
}

constexpr int N0_WIN = 16 * 56, N0_WOUT = 256, N0_EXP = 16 * 384, N0_FN = 1024, N0_MOD = 192, N0_TAB = 128;
constexpr int N0_TOTAL = N0_WIN + N0_MOD + N0_TAB;
constexpr int NBG = N0_WOUT + N0_FN;
DEVI void bg_item(const P& p, int it, float* tl) {
    const int tid = threadIdx.x;
    int r = it;
    if (r < N0_WOUT) {
        const int kt = r >> 4, nt = r & 15; const float* w = p.w_out;
        transpose_tile([&](int n) { return w + n; }, 1024, (u16*)(p.ws + OFF_WOUTT), 1024, kt * 64, nt * 64, tl);
        return;
    }
    r -= N0_WOUT;
    {
        const int idx = r * 512 + tid, c = idx & 127, g = (idx >> 7) & 3, n = idx >> 9;
        double sd, cd; sincos2pi(c / 256.0, sd, cd);
        const float ct = (float)cd, st = (float)sd;
        const float* W = p.w_fnet + (size_t)(g * 256) * 1024 + n;
        float ac = 0.f, as = 0.f, a128 = 0.f, cr = 1.f, sr = 0.f, sg = 1.f;
        for (int c2 = 0; c2 < 256; ++c2) {
            const float w = W[(size_t)c2 * 1024];
            ac = fmaf(cr, w, ac); as = fmaf(sr, w, as); a128 = fmaf(sg, w, a128); sg = -sg;
            const float cn = cr * ct - sr * st; sr = fmaf(sr, ct, cr * st); cr = cn;
        }
        u16* Ah = (u16*)(p.ws + OFF_FNT); u16* Bh = Ah + (size_t)1024 * 512; float* A128 = (float*)(p.ws + OFF_FNT + (size_t)2 * 1024 * 512 * 2);
        Ah[(size_t)n * 512 + g * 128 + c] = f2bf(ac * (1.f / 2048.f)); Bh[(size_t)n * 512 + g * 128 + c] = f2bf(-as * (1.f / 2048.f));
        if (c == 0) A128[g * 1024 + n] = a128 * (1.f / 2048.f);
    }
}
DEVI void bg_fill(const P& p, char* lds, int q, int lo, int hi) {
    int* sh = (int*)(lds + 32768);
    for (;;) {
        __syncthreads();
        if (threadIdx.x == 0) *sh = lo + 4 * (int)atomicAdd((unsigned*)(p.ws + OFF_CNT) + 160 + q, 1u);
        __syncthreads();
        const int it0 = *sh;
        if (it0 >= hi) break;
        for (int it = it0; it < it0 + 4 && it < hi; ++it) bg_item(p, it, (float*)lds);
    }
    __syncthreads();
}

DEVI void phase_prologue(const P& p, char* lds) {
    float* tl = (float*)lds;
    const int tid = threadIdx.x;
    for (int it = blockIdx.x; it < N0_TOTAL; it += gridDim.x) {
        int r = it;
        if (r < N0_WIN) {
            const int kt = r / 56, nt = r % 56;
            const float* w = p.w_in;
            transpose_tile([&](int n) { return w + n; },
                           3600, (u16*)(p.ws + OFF_WINT), 1024, kt * 64, nt * 64, tl);
            continue;
        }
        r -= N0_WIN;
        if (r < N0_MOD) {
            float* sv = tl;
            float* part = tl + 3072;
            for (int i = tid; i < 3072; i += NTHR) { const int v = i >> 10, k = i & 1023; const float xv = v < 2 ? p.c[v * 1024 + k] : p.c_ctx[k]; sv[i] = siluf_(xv); }
            __syncthreads();
            const int j0 = r * 64, L = j0 / 6144, col0 = j0 % 6144, kg = tid >> 6, cl = tid & 63;
            const float* W = p.ada_w + (size_t)L * 1024 * 6144 + col0 + cl;
            float a0 = 0.f, a1 = 0.f, a2 = 0.f;
            for (int k = kg * 128; k < kg * 128 + 128; ++k) { const float w = W[(size_t)k * 6144]; a0 = fmaf(sv[k], w, a0); a1 = fmaf(sv[1024 + k], w, a1); a2 = fmaf(sv[2048 + k], w, a2); }
            part[(kg * 3 + 0) * 64 + cl] = a0; part[(kg * 3 + 1) * 64 + cl] = a1; part[(kg * 3 + 2) * 64 + cl] = a2;
            __syncthreads();
            if (tid < 192) {
                const int v = tid >> 6, c2 = tid & 63; float s = 0.f;
                for (int g = 0; g < 8; ++g) s += part[(g * 3 + v) * 64 + c2];
                ((float*)(p.ws + OFF_MOD))[(size_t)(L * 3 + v) * 6144 + col0 + c2] = s + p.ada_b[L * 6144 + col0 + c2];
            }
            __syncthreads();
            continue;
        }
        r -= N0_MOD;
        {
            const int e = r * 512 + tid;
            if (e < 4096 + 1024) {
                const bool isr = e < 4096; const int ee = isr ? e : e - 4096; const int pos = ee >> 4, j = ee & 15;
                double inv = 1.0; for (int q = 0; q < j; ++q) inv *= 0.56234132519034908;
                const float invf = (float)inv; const float ang = (float)pos * invf;
                double s, c; sincos2pi((double)ang * 0.15915494309189533577, s, c);
                float2 v = make_float2((float)c, (float)s);
                if (isr) ((float2*)(p.ws + OFF_ROPER))[ee] = v; else ((float2*)(p.ws + OFF_ROPEC))[ee] = v;
            } else if (e < 5120 + 16384) {
                const int m = e - 5120; double s, c; sincos2pi(m / 16384.0, s, c);
                ((float2*)(p.ws + OFF_TW))[m] = make_float2((float)c, (float)s);
            } else if (e < 5120 + 32768) {
                const int m = e - 5120 - 16384, k = m >> 7, t = m & 127; double s, c; sincos2pi(((k * t) & 127) / 128.0, s, c);
                ((u16*)(p.ws + OFF_DFTC))[m] = f2bf((float)c); ((u16*)(p.ws + OFF_DFTS))[m] = f2bf((float)s);
            } else if (e < 5120 + 49152) {
                const int m = e - 5120 - 32768, k = m >> 4, g = m & 15;
                ((float*)(p.ws + OFF_WG16))[m] = p.w_in[(size_t)k * 3600 + 3584 + g];
            } else if (e == 5120 + 49152) {
                float s01 = 0.f, s23 = 0.f;
                for (int i = 0; i < 64; ++i) { s01 += p.lamv[i] * p.lamv[64 + i]; s23 += p.lamv[128 + i] * p.lamv[192 + i]; }
                ((float*)(p.ws + OFF_LAM))[0] = expf(s01) - expf(s23) + 0.2f;
            }
        }
    }
}

template <int MODE, bool DRY = false>
DEVI void phase_norm(const P& p, char* lds) {
    constexpr int layer = (MODE == 0 || MODE == 1) ? 0 : 1;
    constexpr bool side = (MODE == 0 || MODE == 1 || MODE == 3);
    const int nrows = layer == 0 ? NTOK : NLAT;
    const int tid = threadIdx.x, lane = tid & 63, wid = tid >> 6;
    f32x4* sl = (f32x4*)lds;
    if (side) {
        const float* S = (MODE == 0) ? (const float*)(p.ws + OFF_WG16) : p.router_w;
        for (int i = tid; i < 4096; i += NTHR) { const int eg = i >> 10, col = i & 1023; const int pc = (col >> 8) * 256 + (col & 3) * 64 + ((col >> 2) & 63);
            sl[eg * 1024 + pc] = *reinterpret_cast<const f32x4*>(S + col * 16 + eg * 4); }
        __syncthreads();
    }
    const float* g = MODE == 0 ? p.nmix_g : MODE == 1 ? p.nffn_g : MODE == 2 ? p.nmix_g + 1024 : MODE == 3 ? p.nffn_g + 1024 : p.final_g;
    const float* modb = (const float*)(p.ws + OFF_MOD) + (size_t)layer * 3 * 6144;
    constexpr int sh_i = (MODE == 0 || MODE == 2) ? 0 : 3;
    u16* act = (u16*)(p.ws + OFF_ACT);
    int npend = 0, pcls = 0, prow = 0; float pwl = 0.f, pwh = 0.f; float keep[16];
#pragma unroll
    for (int e = 0; e < 16; ++e) keep[e] = 0.f;
    const int c0 = 4 * lane;
    f32x4 xn[4]; u32x2 xr[4];
#define NORM_REQ(R) do { if (MODE == 0) { const float* src_ = xin_ptr(p, (R)); _Pragma("unroll") for (int i = 0; i < 4; ++i) xn[i] = *reinterpret_cast<const f32x4*>(src_ + c0 + 256 * i); } \
        else { const u16* src_ = xs_ptr(p, layer, (R)); _Pragma("unroll") for (int i = 0; i < 4; ++i) xr[i] = *reinterpret_cast<const u32x2*>(src_ + c0 + 256 * i); } } while (0)
    { const int row0 = blockIdx.x * 8 + wid; if (row0 < nrows) NORM_REQ(row0); }
    for (int row = blockIdx.x * 8 + wid; row < nrows; row += gridDim.x * 8) {
        f32x4 xv[4]; float ss = 0.f;
#pragma unroll
        for (int i = 0; i < 4; ++i) xv[i] = (MODE == 0) ? xn[i] : bf4_to_f32(xr[i]);
        { const int nrow = row + gridDim.x * 8; if (nrow < nrows) NORM_REQ(nrow); }
#pragma unroll
        for (int i = 0; i < 4; ++i) { ss = fmaf(xv[i][0], xv[i][0], ss); ss = fmaf(xv[i][1], xv[i][1], ss); ss = fmaf(xv[i][2], xv[i][2], ss); ss = fmaf(xv[i][3], xv[i][3], ss); }
        ss = wave_sum(ss);
        const float rstd = rsqrtf(ss * (1.f / 1024.f) + 1e-6f);
        if (MODE == 4) {
            float* dst = p.out + (size_t)row * DM;
#pragma unroll
            for (int i = 0; i < 4; ++i) { const f32x4 gv = *reinterpret_cast<const f32x4*>(g + c0 + 256 * i); *reinterpret_cast<f32x4*>(dst + c0 + 256 * i) = xv[i] * rstd * gv; }
            continue;
        }
        const float* mv = modb + (size_t)modsel(layer, row) * 6144;
        float acc[16];
#pragma unroll
        for (int e = 0; e < 16; ++e) acc[e] = 0.f;
#pragma unroll
        for (int i = 0; i < 4; ++i) {
            const f32x4 gv = *reinterpret_cast<const f32x4*>(g + c0 + 256 * i), scv = *reinterpret_cast<const f32x4*>(mv + (sh_i + 1) * 1024 + c0 + 256 * i),
                        shv = *reinterpret_cast<const f32x4*>(mv + sh_i * 1024 + c0 + 256 * i);
            f32x4 h;
#pragma unroll
            for (int j = 0; j < 4; ++j) h[j] = xv[i][j] * rstd * gv[j] * (1.f + scv[j]) + shv[j];
            if (MODE == 2) {
                const float p0 = __shfl(h[0], (64 - lane) & 63), p1 = __shfl(h[3], 63 - lane), p2 = __shfl(h[2], 63 - lane), p3 = __shfl(h[1], 63 - lane), h128 = __shfl(h[0], 32);
                const float u0 = lane == 0 ? h[0] : h[0] + p0, v0 = lane == 0 ? h128 : h[0] - p0;
                if (lane < 32) {
                    u32x2 wu, wv; wu[0] = cvtpk(u0, h[1] + p1); wu[1] = cvtpk(h[2] + p2, h[3] + p3); wv[0] = cvtpk(v0, h[1] - p1); wv[1] = cvtpk(h[2] - p2, h[3] - p3);
                    *reinterpret_cast<u32x2*>((u16*)(p.ws + OFF_ACT) + (size_t)row * 512 + i * 128 + c0) = wu;
                    *reinterpret_cast<u32x2*>((u16*)(p.ws + OFF_ACT) + (size_t)NLAT * 512 + (size_t)row * 512 + i * 128 + c0) = wv;
                }
            } else {
                u32x2 w2; w2[0] = cvtpk(h[0], h[1]); w2[1] = cvtpk(h[2], h[3]);
                *reinterpret_cast<u32x2*>(act + (size_t)row * DM + c0 + 256 * i) = w2;
            }
            if (side) {
#pragma unroll
                for (int j = 0; j < 4; ++j) {
#pragma unroll
                    for (int eg = 0; eg < 4; ++eg) { const f32x4 w = sl[eg * 1024 + i * 256 + j * 64 + lane]; acc[eg * 4 + 0] = fmaf(h[j], w[0], acc[eg * 4 + 0]); acc[eg * 4 + 1] = fmaf(h[j], w[1], acc[eg * 4 + 1]);
                        acc[eg * 4 + 2] = fmaf(h[j], w[2], acc[eg * 4 + 2]); acc[eg * 4 + 3] = fmaf(h[j], w[3], acc[eg * 4 + 3]); }
                    if (j & 1) asm volatile("" ::: "memory");
                }
            }
        }
        if (side) {
            float r8[8], r4[4], r2[2], tot;
            { const bool up = lane & 32;
#pragma unroll
              for (int i = 0; i < 8; ++i) { const float snd = up ? acc[i] : acc[i + 8], kp = up ? acc[i + 8] : acc[i]; r8[i] = kp + __shfl_xor(snd, 32); } }
            { const bool up = lane & 16;
#pragma unroll
              for (int i = 0; i < 4; ++i) { const float snd = up ? r8[i] : r8[i + 4], kp = up ? r8[i + 4] : r8[i]; r4[i] = kp + __shfl_xor(snd, 16); } }
            { const bool up = lane & 8;
#pragma unroll
              for (int i = 0; i < 2; ++i) { const float snd = up ? r4[i] : r4[i + 2], kp = up ? r4[i + 2] : r4[i]; r2[i] = kp + __shfl_xor(snd, 8); } }
            { const bool up = lane & 4; const float snd = up ? r2[0] : r2[1], kp = up ? r2[1] : r2[0]; tot = kp + __shfl_xor(snd, 4); }
            tot += __shfl_xor(tot, 1); tot += __shfl_xor(tot, 2);
            if (MODE == 0) {
                if ((lane & 3) == 0) {
                    const int e = lane >> 2;
                    float v = tot + p.gate_b[e];
                    const int type = e >> 2;
                    if (type == 1 || type == 3) v = logsigmoidf_(v);
                    ((float*)(p.ws + OFF_GATES))[(size_t)row * 16 + e] = v;
                }
            } else {
#pragma unroll
                for (int e = 0; e < 16; ++e) { const float te = __uint_as_float(__builtin_amdgcn_readlane(__float_as_uint(tot), e << 2)); keep[e] = (lane == npend) ? te : keep[e]; }
                if (lane == npend) prow = row;
                ++npend;
            }
        }
    }
    if (MODE == 1 || MODE == 3) {
        {
            float aff[16], bi[16];
#pragma unroll
            for (int e = 0; e < 16; ++e) { aff[e] = sigmoidf_(keep[e]); bi[e] = aff[e] + p.router_b[e]; }
            int bg = 0, ba = 0, bb = 1; float bscore = -1e30f;
#pragma unroll
            for (int gq = 0; gq < 4; ++gq) {
                int ia = 0; float va = bi[gq * 4];
#pragma unroll
                for (int j = 1; j < 4; ++j) if (bi[gq * 4 + j] > va) { va = bi[gq * 4 + j]; ia = j; }
                int ib = -1; float vb = -1e30f;
#pragma unroll
                for (int j = 0; j < 4; ++j) if (j != ia && bi[gq * 4 + j] > vb) { vb = bi[gq * 4 + j]; ib = j; }
                const float sc = va + vb;
                if (sc > bscore) { bscore = sc; bg = gq; ba = ia; bb = ib; }
            }
            const int lo = ba < bb ? ba : bb, hi2 = ba < bb ? bb : ba;
            float alo = 0.f, ahi = 0.f;
#pragma unroll
            for (int e = 0; e < 16; ++e) { if (e == bg * 4 + lo) alo = aff[e]; if (e == bg * 4 + hi2) ahi = aff[e]; }
            const float inv = 1.f / (alo + ahi);
            const int pair = lo == 0 ? hi2 - 1 : (lo == 1 ? hi2 + 1 : 5);
            pcls = bg * 6 + pair; pwl = alo * inv; pwh = ahi * inv;
        }
        unsigned* lc = (unsigned*)(lds + 65536);
        __syncthreads();
        if (tid < 64) lc[tid] = 0u;
        __syncthreads();
        unsigned myrank = 0u;
        if (lane < npend) myrank = atomicAdd(&lc[pcls], 1u);
        __syncthreads();
        if (tid < 24) { unsigned* cnt = (unsigned*)(p.ws + OFF_CNT) + (DRY ? 2 : layer) * 32; const unsigned n = lc[tid]; lc[32 + tid] = n ? atomicAdd(&cnt[tid], n) : 0u; }
        __syncthreads();
        if (lane < npend) {
            ((int*)(p.ws + (DRY ? OFF_BIG : OFF_LIST)))[(size_t)pcls * NTOK + lc[32 + pcls] + myrank] = prow;
            ((float2*)(p.ws + (DRY ? OFF_BIG + (size_t)32 * NTOK * 4 : OFF_TOKW)))[prow] = make_float2(pwl, pwh);
        }
    }
}

using g8::f32x4v;
DEVI u32x4 pack8(const f32x4v& a, const f32x4v& b) { u32x4 w; w[0] = cvtpk(a[0], a[1]); w[1] = cvtpk(a[2], a[3]); w[2] = cvtpk(b[0], b[1]); w[3] = cvtpk(b[2], b[3]); return w; }

struct EpiInproj {
    static constexpr bool PERM = true;
    char* ws;
    DEVI void operator()(const f32x4v (&acc)[2][2][4][2], const g8::Unit& u, int wr, int wc, int fr, int fq) const {
        u16* dst; int ld, coff, kind;
        const int pn = u.pn;
        if (pn < 2)       { dst = (u16*)(ws + OFF_Q);    ld = 512;  coff = pn * 256;        kind = 1; }
        else if (pn < 4)  { dst = (u16*)(ws + OFF_K);    ld = 512;  coff = (pn - 2) * 256;  kind = 1; }
        else if (pn < 6)  { dst = (u16*)(ws + OFF_V);    ld = 512;  coff = (pn - 4) * 256;  kind = 0; }
        else if (pn < 10) { dst = (u16*)(ws + OFF_MLQK); ld = 1024; coff = (pn - 6) * 256;  kind = 0; }
        else if (pn < 12) { dst = (u16*)(ws + OFF_MLV);  ld = 512;  coff = (pn - 10) * 256; kind = 0; }
        else              { dst = (u16*)(ws + OFF_OG);   ld = 512;  coff = (pn - 12) * 256; kind = 2; }
        const int tb = u.pm % 65;
        const float2* tabR = (const float2*)(ws + OFF_ROPER); const float2* tabC = (const float2*)(ws + OFF_ROPEC);
#pragma unroll
        for (int ai = 0; ai < 2; ++ai)
#pragma unroll
            for (int m = 0; m < 4; ++m) {
                const int rl = ai * 128 + wr * 64 + m * 16 + fr;
                u16* rowp = dst + (size_t)(u.pm * 256 + rl) * ld + coff + wc * 32 + 8 * fq;
#pragma unroll
                for (int bj = 0; bj < 2; ++bj) {
                    f32x4v v0 = acc[ai][bj][m][0], v1 = acc[ai][bj][m][1];
                    if (kind == 1 && tb > 0) {
                        const int tl = (tb - 1) * 256 + rl;
                        const int p0 = ((wc * 32 + 8 * fq) & 63) >> 1;
                        const float* cs = (const float*)(p0 < 16 ? tabR + (tl >> 6) * 16 + p0 : tabC + (tl & 63) * 16 + (p0 - 16));
                        const f32x4v c01 = *reinterpret_cast<const f32x4v*>(cs), c23 = *reinterpret_cast<const f32x4v*>(cs + 4);
                        const f32x4v a = v0, b = v1;
                        v0[0] = a[0] * c01[0] - a[1] * c01[1]; v0[1] = a[0] * c01[1] + a[1] * c01[0];
                        v0[2] = a[2] * c01[2] - a[3] * c01[3]; v0[3] = a[2] * c01[3] + a[3] * c01[2];
                        v1[0] = b[0] * c23[0] - b[1] * c23[1]; v1[1] = b[0] * c23[1] + b[1] * c23[0];
                        v1[2] = b[2] * c23[2] - b[3] * c23[3]; v1[3] = b[2] * c23[3] + b[3] * c23[2];
                    } else if (kind == 2) {
#pragma unroll
                        for (int j = 0; j < 4; ++j) { v0[j] = sigmoidf_(v0[j]); v1[j] = sigmoidf_(v1[j]); }
                    }
                    *reinterpret_cast<u32x4*>(rowp + bj * 128) = pack8(v0, v1);
                }
            }
    }
};
DEVI void phase_inproj(const P& p, char* lds) {
    __syncthreads();
    g8::DenseSched S{p.ws + OFF_WINT, NTOK / 256, 14, (int)gridDim.x, (int)blockIdx.x, (size_t)256 * 2048};
    EpiInproj E{p.ws};
    g8::gemm_phase((LAS unsigned char*)lds, p.ws + OFF_ACT, 2048, 16, S, E);
}

struct EpiOutproj {
    static constexpr bool PERM = true;
    const float* xin_lat; const float* xin_ctx; u16* xs; const float* modb;
    DEVI void operator()(const f32x4v (&acc)[2][2][4][2], const g8::Unit& u, int wr, int wc, int fr, int fq) const {
        const int b = u.pm / 65, tb = u.pm % 65;
        const float* xi = tb == 0 ? xin_ctx + (size_t)(b * TC) * DM : xin_lat + (size_t)(b * TL + (tb - 1) * 256) * DM;
        u16* xo = xs + (size_t)(u.pm * 256) * DM;
        const float* gate = modb + (size_t)(tb == 0 ? 2 : b) * 6144 + 2 * 1024;
        const int col0 = u.pn * 256 + wc * 32 + 8 * fq;
        f32x4v gv[2][2];
#pragma unroll
        for (int bj = 0; bj < 2; ++bj)
#pragma unroll
            for (int n = 0; n < 2; ++n) gv[bj][n] = *reinterpret_cast<const f32x4v*>(gate + col0 + bj * 128 + n * 4);
#pragma unroll
        for (int ai = 0; ai < 2; ++ai) {
            f32x4v xv[4][2][2];
#pragma unroll
            for (int m = 0; m < 4; ++m) { const size_t ro = (size_t)(ai * 128 + wr * 64 + m * 16 + fr) * DM + col0;
#pragma unroll
                for (int bj = 0; bj < 2; ++bj)
#pragma unroll
                    for (int n = 0; n < 2; ++n) xv[m][bj][n] = *reinterpret_cast<const f32x4v*>(xi + ro + bj * 128 + n * 4); }
#pragma unroll
            for (int m = 0; m < 4; ++m) { const size_t ro = (size_t)(ai * 128 + wr * 64 + m * 16 + fr) * DM + col0;
#pragma unroll
                for (int bj = 0; bj < 2; ++bj)
                    *reinterpret_cast<u32x4*>(xo + ro + bj * 128) = pack8(xv[m][bj][0] + gv[bj][0] * acc[ai][bj][m][0], xv[m][bj][1] + gv[bj][1] * acc[ai][bj][m][1]); }
        }
    }
};
DEVI void phase_outproj(const P& p, char* lds) {
    __syncthreads();
    g8::DenseSched S{p.ws + OFF_WOUTT, NTOK / 256, 4, (int)gridDim.x, (int)blockIdx.x, (size_t)256 * 2048};
    EpiOutproj E{p.x, p.ctx, (u16*)(p.ws + OFF_MLC), (const float*)(p.ws + OFF_MOD)};
    g8::gemm_phase((LAS unsigned char*)lds, p.ws + OFF_ACT, 2048, 16, S, E);
}

DEVI int moe_table(const P& p, int layer, int* tb) {
    __syncthreads();
    if (threadIdx.x == 0) {
        const unsigned* cnt = (const unsigned*)(p.ws + OFF_CNT) + layer * 32; int o = 0;
        for (int c = 0; c < 24; ++c) { tb[c] = o; tb[32 + c] = (int)cnt[c]; o += ((int)cnt[c] + 255) >> 8; }
        tb[24] = o;
    }
    __syncthreads();
    return tb[24];
}
DEVI void cls_experts(int cls, int& elo, int& ehi) {
    const int g = cls / 6, pr = cls % 6;
    const int lo = pr < 3 ? 0 : (pr < 5 ? 1 : 2); const int hi = pr < 3 ? pr + 1 : (pr < 5 ? pr - 1 : 3);
    elo = g * 4 + lo; ehi = g * 4 + hi;
}
DEVI void moe_unit(const int* tb, int rt, g8::Unit& u) {
    int cls = 0; while (cls < 23 && tb[cls + 1] <= rt) ++cls;
    u.cls = cls; u.r0 = (rt - tb[cls]) * 256; u.ncls = tb[32 + cls];
}

struct MoeUpSched {
    static constexpr bool GATHER = true;
    DEVI const char* abase(const g8::Unit&, const char* a) const { return a; }
    const int* tb; int T, G, c; const int* list; const char* Wgu;
    DEVI bool next(int i, g8::Unit& u) const {
        if (!g8::tile_order(i, G, c, T, 8, u.pm, u.pn)) return false;
        moe_unit(tb, u.pm, u); int elo, ehi; cls_experts(u.cls, elo, ehi);
        const int e = u.pn < 4 ? elo : ehi;
        u.B0 = u.B1 = Wgu + ((size_t)e * 1024 + (size_t)(u.pn & 3) * 256) * 2048; return true;
    }
    DEVI void aoffs(const g8::Unit& u, unsigned (&v)[2][2]) const {
        const int* lst = list + (size_t)u.cls * NTOK + u.r0;
#pragma unroll
        for (int i = 0; i < 2; ++i) { int R, C; g8::lane_rc(i, R, C);
#pragma unroll
            for (int h = 0; h < 2; ++h) { const int rr = h * 128 + R; const int tok = lst[(u.r0 + rr < u.ncls) ? rr : 0]; v[h][i] = (unsigned)((tok * 1024 + C) * 2); } }
    }
};
struct EpiMoeUp {
    static constexpr bool PERM = true;
    const int* list; const float2* tokw; u16* HE;
    DEVI void operator()(const f32x4v (&acc)[2][2][4][2], const g8::Unit& u, int wr, int wc, int fr, int fq) const {
        const int* lst = list + (size_t)u.cls * NTOK + u.r0;
        const int s = u.pn >> 2;
        float wv[2][4];
        { int tk[2][4];
#pragma unroll
          for (int ai = 0; ai < 2; ++ai)
#pragma unroll
              for (int m = 0; m < 4; ++m) { const int rl = ai * 128 + wr * 64 + m * 16 + fr; tk[ai][m] = lst[(u.r0 + rl < u.ncls) ? rl : 0]; }
#pragma unroll
          for (int ai = 0; ai < 2; ++ai)
#pragma unroll
              for (int m = 0; m < 4; ++m) { const float2 w2 = tokw[tk[ai][m]]; wv[ai][m] = s ? w2.y : w2.x; } }
#pragma unroll
        for (int ai = 0; ai < 2; ++ai)
#pragma unroll
            for (int m = 0; m < 4; ++m) {
                const int rl = ai * 128 + wr * 64 + m * 16 + fr;
                if (u.r0 + rl < u.ncls) {
                    const float w = wv[ai][m];
                    u16* rowp = HE + (size_t)(u.pm * 256 + rl) * 1024 + s * 512 + (u.pn & 3) * 128 + wc * 32 + 8 * fq;
                    f32x4v h0, h1;
#pragma unroll
                    for (int j = 0; j < 4; ++j) { h0[j] = siluf_(acc[ai][0][m][0][j]) * acc[ai][1][m][0][j] * w; h1[j] = siluf_(acc[ai][0][m][1][j]) * acc[ai][1][m][1][j] * w; }
                    *reinterpret_cast<u32x4*>(rowp) = pack8(h0, h1);
                }
            }
    }
};
DEVI void phase_moe_up(const P& p, int layer, char* lds) {
    int* tb = (int*)(lds + g8::STAGE_BYTES);
    const int T = moe_table(p, layer, tb);
    MoeUpSched S{tb, T, (int)gridDim.x, (int)blockIdx.x, (const int*)(p.ws + OFF_LIST), p.ws + (layer ? OFF_WGU1 : OFF_WGU)};
    EpiMoeUp E{(const int*)(p.ws + OFF_LIST), (const float2*)(p.ws + OFF_TOKW), (u16*)(p.ws + OFF_HE)};
    g8::gemm_phase((LAS unsigned char*)lds, p.ws + OFF_ACT, 2048, 16, S, E);
}

struct MoeDownSched {
    static constexpr bool GATHER = false;
    DEVI const char* abase(const g8::Unit&, const char* a) const { return a; }
    const int* tb; int T, G, c; const char* WdT;
    DEVI bool next(int i, g8::Unit& u) const {
        if (!g8::tile_order(i, G, c, T, 4, u.pm, u.pn)) return false;
        moe_unit(tb, u.pm, u); int elo, ehi; cls_experts(u.cls, elo, ehi);
        u.B0 = WdT + ((size_t)elo * 1024 + (size_t)u.pn * 256) * 1024;
        u.B1 = WdT + ((size_t)ehi * 1024 + (size_t)u.pn * 256) * 1024 - (size_t)8 * 128; return true;
    }
    DEVI void aoffs(const g8::Unit& u, unsigned (&v)[2][2]) const {
#pragma unroll
        for (int i = 0; i < 2; ++i) { int R, C; g8::lane_rc(i, R, C);
#pragma unroll
            for (int h = 0; h < 2; ++h) v[h][i] = (unsigned)(((u.pm * 256 + h * 128 + R) * 1024 + C) * 2); }
    }
};
template <bool DRY>
struct EpiMoeDown {
    static constexpr bool PERM = true;
    const P* pp; int layer; const int* list; const float* modb;
    DEVI void operator()(const f32x4v (&acc)[2][2][4][2], const g8::Unit& u, int wr, int wc, int fr, int fq) const {
        const P& p = *pp;
        const int* lst = list + (size_t)u.cls * NTOK + u.r0;
        const int col0 = u.pn * 256 + wc * 32 + 8 * fq;
        int tk[2][4];
#pragma unroll
        for (int ai = 0; ai < 2; ++ai)
#pragma unroll
            for (int m = 0; m < 4; ++m) { const int rl = ai * 128 + wr * 64 + m * 16 + fr; tk[ai][m] = (u.r0 + rl < u.ncls) ? lst[rl] : -1; }
#pragma unroll
        for (int ai = 0; ai < 2; ++ai)
#pragma unroll
        for (int mh = 0; mh < 2; ++mh) {
            u32x4 xw[2][2]; f32x4v gv[2][2][2];
#pragma unroll
            for (int mm = 0; mm < 2; ++mm) { const int m = mh * 2 + mm; const int tok = tk[ai][m] < 0 ? lst[0] : tk[ai][m];
                const float* gate = modb + (size_t)modsel(layer, tok) * 6144 + 5 * 1024 + col0; const u16* xo = xs_ptr(p, layer, tok) + col0;
#pragma unroll
                for (int bj = 0; bj < 2; ++bj) { xw[mm][bj] = *reinterpret_cast<const u32x4*>(xo + bj * 128);
#pragma unroll
                    for (int n = 0; n < 2; ++n) gv[mm][bj][n] = *reinterpret_cast<const f32x4v*>(gate + bj * 128 + n * 4); } }
#pragma unroll
            for (int mm = 0; mm < 2; ++mm) { const int m = mh * 2 + mm; if (tk[ai][m] >= 0) { const int tok = tk[ai][m];
                u16* xd = DRY ? (u16*)(p.ws + OFF_MLQK) + (size_t)(tok & 8191) * 1024 + col0 : xs_ptr(p, layer, tok) + col0;
#pragma unroll
                for (int bj = 0; bj < 2; ++bj) {
                    f32x4v x0, x1; x0[0] = bflo(xw[mm][bj][0]); x0[1] = bfhi(xw[mm][bj][0]); x0[2] = bflo(xw[mm][bj][1]); x0[3] = bfhi(xw[mm][bj][1]);
                    x1[0] = bflo(xw[mm][bj][2]); x1[1] = bfhi(xw[mm][bj][2]); x1[2] = bflo(xw[mm][bj][3]); x1[3] = bfhi(xw[mm][bj][3]);
                    *reinterpret_cast<u32x4*>(xd + bj * 128) = pack8(x0 + gv[mm][bj][0] * acc[ai][bj][m][0], x1 + gv[mm][bj][1] * acc[ai][bj][m][1]); } } }
        }
    }
};
template <bool DRY = false>
DEVI void phase_moe_down(const P& p, int layer, char* lds) {
    int* tb = (int*)(lds + g8::STAGE_BYTES);
    const int T = moe_table(p, layer, tb);
    MoeDownSched S{tb, T, (int)gridDim.x, (int)blockIdx.x, p.ws + (layer ? OFF_WDT1 : OFF_WDT)};
    EpiMoeDown<DRY> E{&p, layer, (const int*)(p.ws + OFF_LIST), (const float*)(p.ws + OFF_MOD) + (size_t)layer * 3 * 6144};
    g8::gemm_phase((LAS unsigned char*)lds, p.ws + OFF_HE, 1024, 8, S, E);
}

constexpr size_t OFF_FU = OFF_ACT, OFF_FV = OFF_ACT + (size_t)NLAT * 512 * 2;
constexpr size_t OFF_FAH = OFF_FNT, OFF_FBH = OFF_FNT + (size_t)1024 * 512 * 2, OFF_FA128 = OFF_FNT + (size_t)2 * 1024 * 512 * 2;
struct FnetSched {
    static constexpr bool GATHER = false;
    const char* ws; int G, c;
    DEVI const char* abase(const g8::Unit& u, const char*) const { return ws + (u.pn < 4 ? OFF_FU : OFF_FV); }
    DEVI bool next(int i, g8::Unit& u) const {
        if (!g8::tile_order(i, G, c, NLAT / 256, 8, u.pm, u.pn)) return false;
        u.B0 = u.B1 = ws + (u.pn < 4 ? OFF_FAH : OFF_FBH) + (size_t)(u.pn & 3) * 256 * 1024; u.cls = 0; u.r0 = 0; u.ncls = 0; return true;
    }
    DEVI void aoffs(const g8::Unit&, unsigned (&)[2][2]) const {}
};
struct EpiFnet {
    static constexpr bool PERM = true;
    char* ws;
    DEVI void operator()(const f32x4v (&acc)[2][2][4][2], const g8::Unit& u, int wr, int wc, int fr, int fq) const {
        const int colt = (u.pn & 3) * 256 + wc * 32 + 8 * fq;
        u16* dst = (u16*)(ws + (u.pn < 4 ? OFF_ZR : OFF_ZI)) + colt;
        const u16* V = (const u16*)(ws + OFF_FV); const float* A128 = (const float*)(ws + OFF_FA128);
#pragma unroll
        for (int bj = 0; bj < 2; ++bj) {
            f32x4v a128[4][2];
            if (u.pn < 4) {
#pragma unroll
                for (int g = 0; g < 4; ++g) { a128[g][0] = *reinterpret_cast<const f32x4v*>(A128 + g * 1024 + colt + bj * 128); a128[g][1] = *reinterpret_cast<const f32x4v*>(A128 + g * 1024 + colt + bj * 128 + 4); }
            }
#pragma unroll
            for (int ai = 0; ai < 2; ++ai)
#pragma unroll
                for (int m = 0; m < 4; ++m) {
                    const size_t row = (size_t)(u.pm * 256 + ai * 128 + wr * 64 + m * 16 + fr);
                    f32x4v v0 = acc[ai][bj][m][0], v1 = acc[ai][bj][m][1];
                    if (u.pn < 4) {
#pragma unroll
                        for (int g = 0; g < 4; ++g) { const float hv = bf2f(V[row * 512 + g * 128]); v0 += a128[g][0] * hv; v1 += a128[g][1] * hv; }
                    }
                    *reinterpret_cast<u32x4*>(dst + row * 1024 + bj * 128) = pack8(v0, v1);
                }
        }
    }
};
DEVI void phase_fnet_gemm(const P& p, char* lds) {
    __syncthreads();
    FnetSched S{p.ws, (int)gridDim.x, (int)blockIdx.x};
    EpiFnet E{p.ws};
    g8::gemm_phase<EpiFnet, FnetSched, 8, 1024>((LAS unsigned char*)lds, p.ws, 1024, 8, S, E);
}

template <class RP>
DEVI void stage_tr128_load(RP rp, u32x4 (&v)[4]) {
    const int tid = threadIdx.x;
#pragma unroll
    for (int i = 0; i < 4; ++i) { const int idx = tid + 512 * i, k = idx >> 4, c = (idx & 15) * 8; v[i] = *reinterpret_cast<const u32x4*>(rp(k) + c); }
}
DEVI void stage_tr128_write(const u32x4 (&v)[4], char* img) {
    const int tid = threadIdx.x;
#pragma unroll
    for (int i = 0; i < 4; ++i) { const int idx = tid + 512 * i, k = idx >> 4, c = (idx & 15) * 8; *reinterpret_cast<u32x4*>(img + (k >> 6) * 16384 + v_st(k & 63, c)) = v[i]; }
}
DEVI void load_dft(const P& p, char* lds) {
    const int tid = threadIdx.x;
    for (int i = tid; i < 4096; i += NTHR) {
        const int m = i >> 11, j = i & 2047, row = j >> 4, ch = j & 15;
        const u32x4 v = *reinterpret_cast<const u32x4*>((const u16*)(p.ws + (m ? OFF_DFTS : OFF_DFTC)) + row * 128 + ch * 8);
        *reinterpret_cast<u32x4*>(lds + m * 34816 + swz256(row, ch)) = v;
    }
}
DEVI bf16x8 negbf(bf16x8 v) { u32x4 w = *reinterpret_cast<u32x4*>(&v); w[0] ^= 0x80008000u; w[1] ^= 0x80008000u; w[2] ^= 0x80008000u; w[3] ^= 0x80008000u; return *reinterpret_cast<bf16x8*>(&w); }

template <int KS, int WN, int MODE>
DEVI void fft_kstep(int vbr, int vbi, const bf16x8& aC, const bf16x8& aS, f32x16 (&yr)[2], f32x16 (&yi)[2]) {
    s16x4 rl0, rh0, rl1, rh1, il0, ih0, il1, ih1;
    tr_frag_issue<2 * WN, KS>(vbr, rl0, rh0); tr_frag_issue<2 * WN + 1, KS>(vbr, rl1, rh1);
    tr_frag_issue<2 * WN, KS>(vbi, il0, ih0); tr_frag_issue<2 * WN + 1, KS>(vbi, il1, ih1);
    LGKM0();
    const bf16x8 xr0 = PKLH(rl0, rh0), xr1 = PKLH(rl1, rh1), xi0 = PKLH(il0, ih0), xi1 = PKLH(il1, ih1);
    yr[0] = __builtin_amdgcn_mfma_f32_32x32x16_bf16(xr0, aC, yr[0], 0, 0, 0);
    yr[1] = __builtin_amdgcn_mfma_f32_32x32x16_bf16(xr1, aC, yr[1], 0, 0, 0);
    yr[0] = __builtin_amdgcn_mfma_f32_32x32x16_bf16(xi0, aS, yr[0], 0, 0, 0);
    yr[1] = __builtin_amdgcn_mfma_f32_32x32x16_bf16(xi1, aS, yr[1], 0, 0, 0);
    if (MODE == 0) {
        yi[0] = __builtin_amdgcn_mfma_f32_32x32x16_bf16(xi0, aC, yi[0], 0, 0, 0);
        yi[1] = __builtin_amdgcn_mfma_f32_32x32x16_bf16(xi1, aC, yi[1], 0, 0, 0);
        yi[0] = __builtin_amdgcn_mfma_f32_32x32x16_bf16(negbf(xr0), aS, yi[0], 0, 0, 0);
        yi[1] = __builtin_amdgcn_mfma_f32_32x32x16_bf16(negbf(xr1), aS, yi[1], 0, 0, 0);
    }
}
template <int WN, int MODE>
DEVI void fft_core(const char* lds, int xr_img, int xi_img, int wm, int lane, f32x16 (&yr)[2], f32x16 (&yi)[2]) {
    const int r32 = lane & 31, hi = lane >> 5;
    const char* Cm = lds; const char* Sm = lds + 34816;
    const int row = wm * 32 + r32;
    const int vb0 = xr_img + v_rd_base(lane), vb1 = xi_img + v_rd_base(lane);
#define KSTEP(H, KS) do { const int kk = (H) * 4 + (KS); \
        const bf16x8 aC = lds_b128(Cm, swz256(row, 2 * kk + hi)), aS = lds_b128(Sm, swz256(row, 2 * kk + hi)); \
        fft_kstep<KS, WN, MODE>(vb0 + (H) * 16384, vb1 + (H) * 16384, aC, aS, yr, yi); } while (0)
    KSTEP(0, 0); KSTEP(0, 1); KSTEP(0, 2); KSTEP(0, 3); KSTEP(1, 0); KSTEP(1, 1); KSTEP(1, 2); KSTEP(1, 3);
#undef KSTEP
}

DEVI void phase_fft1(const P& p, char* lds) {
    const int tid = threadIdx.x, lane = tid & 63, wid = __builtin_amdgcn_readfirstlane(tid >> 6), wm = wid >> 1, wn = wid & 1, r32 = lane & 31, hi = lane >> 5;
    load_dft(p, lds);
    char* imgR = lds + 69632; char* imgI = lds + 102400;
    const u16* Zr = (const u16*)(p.ws + OFF_ZR); const u16* Zi = (const u16*)(p.ws + OFF_ZI);
    u16* Yr = (u16*)(p.ws + OFF_YR); u16* Yi = (u16*)(p.ws + OFF_YI);
    const float2* TW = (const float2*)(p.ws + OFF_TW);
    u32x4 pr[4], pi[4];
#define FFT1_LOAD(U) do { const int cb_ = (U) & 7, t2_ = ((U) >> 3) & 127, b_ = (U) >> 10; \
        stage_tr128_load([&](int k) { return Zr + (size_t)(b_ * TL + 128 * k + t2_) * 1024 + cb_ * 128; }, pr); \
        stage_tr128_load([&](int k) { return Zi + (size_t)(b_ * TL + 128 * k + t2_) * 1024 + cb_ * 128; }, pi); } while (0)
    if ((int)blockIdx.x < NB * 128 * 8) FFT1_LOAD((int)blockIdx.x);
    for (int u = blockIdx.x; u < NB * 128 * 8; u += gridDim.x) {
        const int cb = u & 7, t2 = (u >> 3) & 127, b = u >> 10;
        __syncthreads();
        stage_tr128_write(pr, imgR); stage_tr128_write(pi, imgI);
        __syncthreads();
        if (u + (int)gridDim.x < NB * 128 * 8) FFT1_LOAD(u + (int)gridDim.x);
        f32x16 yr[2] = {}, yi[2] = {};
        const int xr_img = (int)(uintptr_t)imgR, xi_img = (int)(uintptr_t)imgI;
        if (wn == 0) fft_core<0, 0>(lds, xr_img, xi_img, wm, lane, yr, yi); else fft_core<1, 0>(lds, xr_img, xi_img, wm, lane, yr, yi);
        __syncthreads();
        {
            const int k1 = wm * 32 + r32;
            const float2 w = TW[t2 * k1];
            char* oR = imgR + k1 * 272; char* oI = imgR + 34816 + k1 * 272;
#pragma unroll
            for (int ni = 0; ni < 2; ++ni)
#pragma unroll
                for (int g = 0; g < 4; ++g) {
                    const int cbase = wn * 64 + ni * 32 + 8 * g + 4 * hi;
                    float re[4], im[4];
#pragma unroll
                    for (int j = 0; j < 4; ++j) { const float a = yr[ni][4 * g + j], bq = yi[ni][4 * g + j]; re[j] = a * w.x + bq * w.y; im[j] = bq * w.x - a * w.y; }
                    u32x2 pr, pi; pr[0] = cvtpk(re[0], re[1]); pr[1] = cvtpk(re[2], re[3]); pi[0] = cvtpk(im[0], im[1]); pi[1] = cvtpk(im[2], im[3]);
                    *reinterpret_cast<u32x2*>(oR + cbase * 2) = pr; *reinterpret_cast<u32x2*>(oI + cbase * 2) = pi;
                }
        }
        __syncthreads();
#pragma unroll
        for (int i = 0; i < 8; ++i) {
            const int idx = tid + 512 * i, pl = idx >> 11, j = idx & 2047, row = j >> 4, ch = j & 15;
            const u32x4 v = *reinterpret_cast<const u32x4*>(imgR + pl * 34816 + row * 272 + ch * 16);
            *reinterpret_cast<u32x4*>((pl ? Yi : Yr) + ((size_t)(b * 128 + row) * 128 + t2) * 1024 + cb * 128 + ch * 8) = v;
        }
    }
}
template <bool DRY = false>
DEVI void phase_fft2(const P& p, char* lds) {
    const int tid = threadIdx.x, lane = tid & 63, wid = __builtin_amdgcn_readfirstlane(tid >> 6), wm = wid >> 1, wn = wid & 1, r32 = lane & 31, hi = lane >> 5;
    load_dft(p, lds);
    char* imgR = lds + 69632; char* imgI = lds + 102400;
    const u16* Yr = (const u16*)(p.ws + OFF_YR); const u16* Yi = (const u16*)(p.ws + OFF_YI);
    const float* modb = (const float*)(p.ws + OFF_MOD) + (size_t)3 * 6144;
    u32x4 pr[4], pi[4];
#define FFT2_LOAD(U) do { const int cb_ = (U) & 7, k1_ = ((U) >> 3) & 127, b_ = (U) >> 10; \
        stage_tr128_load([&](int k) { return Yr + ((size_t)(b_ * 128 + k1_) * 128 + k) * 1024 + cb_ * 128; }, pr); \
        stage_tr128_load([&](int k) { return Yi + ((size_t)(b_ * 128 + k1_) * 128 + k) * 1024 + cb_ * 128; }, pi); } while (0)
    if ((int)blockIdx.x < NB * 128 * 8) FFT2_LOAD((int)blockIdx.x);
    for (int u = blockIdx.x; u < NB * 128 * 8; u += gridDim.x) {
        const int cb = u & 7, k1 = (u >> 3) & 127, b = u >> 10;
        __syncthreads();
        stage_tr128_write(pr, imgR); stage_tr128_write(pi, imgI);
        __syncthreads();
        if (u + (int)gridDim.x < NB * 128 * 8) FFT2_LOAD(u + (int)gridDim.x);
        f32x16 yr[2] = {}, yi[2] = {};
        const int xr_img = (int)(uintptr_t)imgR, xi_img = (int)(uintptr_t)imgI;
        if (wn == 0) fft_core<0, 1>(lds, xr_img, xi_img, wm, lane, yr, yi); else fft_core<1, 1>(lds, xr_img, xi_img, wm, lane, yr, yi);
        __syncthreads();
        {
            char* oR = imgR + (wm * 32 + r32) * 528;
#pragma unroll
            for (int ni = 0; ni < 2; ++ni)
#pragma unroll
                for (int g = 0; g < 4; ++g) {
                    const int cbase = wn * 64 + ni * 32 + 8 * g + 4 * hi;
                    f32x4 v; v[0] = yr[ni][4 * g]; v[1] = yr[ni][4 * g + 1]; v[2] = yr[ni][4 * g + 2]; v[3] = yr[ni][4 * g + 3];
                    *reinterpret_cast<f32x4*>(oR + cbase * 4) = v;
                }
        }
        __syncthreads();
        const float* gate = modb + (size_t)b * 6144 + 2 * 1024 + cb * 128;
#pragma unroll
        for (int i = 0; i < 4; ++i) {
            const int idx = tid + 512 * i, row = idx >> 4, ch = idx & 15;
            const f32x4 v0 = *reinterpret_cast<const f32x4*>(imgR + row * 528 + ch * 32), v1 = *reinterpret_cast<const f32x4*>(imgR + row * 528 + ch * 32 + 16);
            const f32x4 g0 = *reinterpret_cast<const f32x4*>(gate + ch * 8), g1 = *reinterpret_cast<const f32x4*>(gate + ch * 8 + 4);
            u16* xo = xs_ptr(p, 1, b * TL + k1 + 128 * row) + cb * 128 + ch * 8;
            u16* xd = DRY ? (u16*)(p.ws + OFF_ZR) + (size_t)(b * TL + k1 + 128 * row) * 1024 + cb * 128 + ch * 8 : xo;
            const u32x4 xw = *reinterpret_cast<const u32x4*>(xo);
            f32x4 x0, x1; x0[0] = bflo(xw[0]); x0[1] = bfhi(xw[0]); x0[2] = bflo(xw[1]); x0[3] = bfhi(xw[1]); x1[0] = bflo(xw[2]); x1[1] = bfhi(xw[2]); x1[2] = bflo(xw[3]); x1[3] = bfhi(xw[3]);
            const f32x4 r0 = x0 + g0 * v0, r1 = x1 + g1 * v1;
            u32x4 w; w[0] = cvtpk(r0[0], r0[1]); w[1] = cvtpk(r0[2], r0[3]); w[2] = cvtpk(r1[0], r1[1]); w[3] = cvtpk(r1[2], r1[3]);
            *reinterpret_cast<u32x4*>(xd) = w;
        }
    }
}

DEVI void chunk_scan(const float* gates, int row0, int head, int dir, float* Bq, float* av, float* pm, float& total, float& amax) {
    const int lane = threadIdx.x & 63;
    const int e0 = dir ? 127 - 2 * lane : 2 * lane, e1 = dir ? 126 - 2 * lane : 2 * lane + 1;
    const float lf0 = gates[(size_t)(row0 + e0) * 16 + (dir ? 12 : 4) + head], lf1 = gates[(size_t)(row0 + e1) * 16 + (dir ? 12 : 4) + head];
    const float li0 = gates[(size_t)(row0 + e0) * 16 + (dir ? 8 : 0) + head],  li1 = gates[(size_t)(row0 + e1) * 16 + (dir ? 8 : 0) + head];
    const float s1 = lf0 + lf1; float inc = s1;
#pragma unroll
    for (int o = 1; o < 64; o <<= 1) { const float t = __shfl_up(inc, o); if (lane >= o) inc += t; }
    const float exc = inc - s1;
    const float B0 = exc + lf0, B1 = exc + s1;
    const float a0 = li0 - B0, a1 = li1 - B1;
    const float m1 = fmaxf(a0, a1); float mx = m1;
#pragma unroll
    for (int o = 1; o < 64; o <<= 1) { const float t = __shfl_up(mx, o); if (lane >= o) mx = fmaxf(mx, t); }
    float mprev = __shfl_up(mx, 1); if (lane == 0) mprev = -1e30f;
    Bq[e0] = B0; Bq[e1] = B1; av[e0] = a0; av[e1] = a1; pm[e0] = fmaxf(mprev, a0); pm[e1] = mx;
    total = __shfl(inc, 63); amax = __shfl(mx, 63);
}

DEVI void conv_silu8(const u32x4& xm, const u32x4& x0, const u32x4& xp, const float* wc, bool hasm, bool hasp, float (&out)[8]) {
#pragma unroll
    for (int j = 0; j < 4; ++j) {
        const float w00 = wc[2 * j], w01 = wc[2 * j + 1], w10 = wc[1024 + 2 * j], w11 = wc[1024 + 2 * j + 1], w20 = wc[2048 + 2 * j], w21 = wc[2048 + 2 * j + 1];
        float a = w10 * bflo(x0[j]), b = w11 * bfhi(x0[j]);
        if (hasm) { a = fmaf(w00, bflo(xm[j]), a); b = fmaf(w01, bfhi(xm[j]), b); }
        if (hasp) { a = fmaf(w20, bflo(xp[j]), a); b = fmaf(w21, bfhi(xp[j]), b); }
        out[2 * j] = siluf_(a); out[2 * j + 1] = siluf_(b);
    }
}
DEVI void seg_edges(int t  , bool& hasm, bool& hasp) {
    hasm = !(t == 0 || t == TC); hasp = !(t == TC - 1 || t == TT - 1);
}
DEVI int chain_slot(int dir, int b, int h, int cc) { return ((dir * 2 + b) * 4 + h) * NCH + cc; }

DEVI void phase_mlstm_a(const P& p, char* lds) {
    const int tid = threadIdx.x, wid = __builtin_amdgcn_readfirstlane(tid >> 6), lane = tid & 63, r32 = lane & 31, hi = lane >> 5;
    char* Vimg = lds; char* Kf = lds + 32768; char* Kb = lds + 65536;
    float* arr = (float*)(lds + 98304);
    const float* gates = (const float*)(p.ws + OFF_GATES);
    const u16* MLQK = (const u16*)(p.ws + OFF_MLQK); const u16* MLV = (const u16*)(p.ws + OFF_MLV);
    u16* CST = (u16*)(p.ws + OFF_CST); float* NST = (float*)(p.ws + OFF_NST); u16* MLC = (u16*)(p.ws + OFF_MLC);
    float2* scal = (float2*)(p.ws + OFF_MSCAL);
    for (int it = blockIdx.x; it < NB * 4 * NCH; it += gridDim.x) {
        const int cc = it % NCH, h = (it / NCH) & 3, b = it / (NCH * 4);
        const int row0 = b * TT + cc * 128;
        __syncthreads();
        if (wid < 2) {
            float total, amax; float* a4 = arr + wid * 512;
            chunk_scan(gates, row0, h, wid, a4, a4 + 128, a4 + 256, total, amax);
            a4[384 + lane] = __expf(a4[128 + lane] - amax); a4[384 + 64 + lane] = __expf(a4[128 + 64 + lane] - amax);
            if (lane == 0) scal[chain_slot(wid, b, h, 0) + cc] = make_float2(total + amax, total);
        }
        __syncthreads();
#pragma unroll
        for (int i = 0; i < 4; ++i) {
            const int idx = tid + 512 * i, l = idx >> 4, c = (idx & 15) * 8;
            const u32x4 v = *reinterpret_cast<const u32x4*>(MLV + (size_t)(row0 + l) * 512 + h * 128 + c);
            *reinterpret_cast<u32x4*>(Vimg + (l >> 6) * 16384 + v_st(l & 63, c)) = v;
            const int t = cc * 128 + l; bool hasm, hasp; seg_edges(t, hasm, hasp);
            const u16* kp = MLQK + (size_t)(row0 + l) * 1024 + 512 + h * 128 + c;
            const u32x4 x0 = *reinterpret_cast<const u32x4*>(kp);
            const u32x4 xm = hasm ? *reinterpret_cast<const u32x4*>(kp - 1024) : x0;
            const u32x4 xp = hasp ? *reinterpret_cast<const u32x4*>(kp + 1024) : x0;
            float kv[8]; conv_silu8(xm, x0, xp, p.conv_w + 512 + h * 128 + c, hasm, hasp, kv);
            const float wf = arr[384 + l] * 0.08838834764831845f, wb = arr[512 + 384 + l] * 0.08838834764831845f;
            u32x4 of, ob, ok;
#pragma unroll
            for (int j = 0; j < 4; ++j) { of[j] = cvtpk(kv[2 * j] * wf, kv[2 * j + 1] * wf); ob[j] = cvtpk(kv[2 * j] * wb, kv[2 * j + 1] * wb);
                ok[j] = cvtpk(kv[2 * j] * 0.08838834764831845f, kv[2 * j + 1] * 0.08838834764831845f); }
            *reinterpret_cast<u32x4*>(MLC + (size_t)(row0 + l) * 1024 + 512 + h * 128 + c) = ok;
            {
                const u16* qp = kp - 512;
                const u32x4 q0 = *reinterpret_cast<const u32x4*>(qp);
                const u32x4 qm = hasm ? *reinterpret_cast<const u32x4*>(qp - 1024) : q0;
                const u32x4 qn = hasp ? *reinterpret_cast<const u32x4*>(qp + 1024) : q0;
                float qv[8]; conv_silu8(qm, q0, qn, p.conv_w + h * 128 + c, hasm, hasp, qv);
                u32x4 oq;
#pragma unroll
                for (int j = 0; j < 4; ++j) oq[j] = cvtpk(qv[2 * j], qv[2 * j + 1]);
                *reinterpret_cast<u32x4*>(MLC + (size_t)(row0 + l) * 1024 + h * 128 + c) = oq;
            }
            *reinterpret_cast<u32x4*>(Kf + (l >> 6) * 16384 + v_st(l & 63, c)) = of;
            *reinterpret_cast<u32x4*>(Kb + (l >> 6) * 16384 + v_st(l & 63, c)) = ob;
        }
        __syncthreads();
        const int dir = wid >> 2, vblk = wid & 3;
        const int va = (int)(uintptr_t)Vimg + v_rd_base(lane), ka = (int)(uintptr_t)(dir ? Kb : Kf) + v_rd_base(lane);
        f32x16 acc[4] = {};
#define ASTEP(H, KS) do { s16x4 al_, ah_, b0l, b0h, b1l, b1h, b2l, b2h, b3l, b3h; \
        if (vblk == 0) tr_frag_issue<0, KS>(va + (H) * 16384, al_, ah_); else if (vblk == 1) tr_frag_issue<1, KS>(va + (H) * 16384, al_, ah_); \
        else if (vblk == 2) tr_frag_issue<2, KS>(va + (H) * 16384, al_, ah_); else tr_frag_issue<3, KS>(va + (H) * 16384, al_, ah_); \
        tr_frag_issue<0, KS>(ka + (H) * 16384, b0l, b0h); tr_frag_issue<1, KS>(ka + (H) * 16384, b1l, b1h); \
        tr_frag_issue<2, KS>(ka + (H) * 16384, b2l, b2h); tr_frag_issue<3, KS>(ka + (H) * 16384, b3l, b3h); LGKM0(); \
        const bf16x8 af = PKLH(al_, ah_); \
        acc[0] = __builtin_amdgcn_mfma_f32_32x32x16_bf16(af, PKLH(b0l, b0h), acc[0], 0, 0, 0); \
        acc[1] = __builtin_amdgcn_mfma_f32_32x32x16_bf16(af, PKLH(b1l, b1h), acc[1], 0, 0, 0); \
        acc[2] = __builtin_amdgcn_mfma_f32_32x32x16_bf16(af, PKLH(b2l, b2h), acc[2], 0, 0, 0); \
        acc[3] = __builtin_amdgcn_mfma_f32_32x32x16_bf16(af, PKLH(b3l, b3h), acc[3], 0, 0, 0); } while (0)
        ASTEP(0, 0); ASTEP(0, 1); ASTEP(0, 2); ASTEP(0, 3); ASTEP(1, 0); ASTEP(1, 1); ASTEP(1, 2); ASTEP(1, 3);
#undef ASTEP
        u16* Cd = CST + (size_t)chain_slot(dir, b, h, cc) * 16384;
#pragma unroll
        for (int kb = 0; kb < 4; ++kb)
#pragma unroll
            for (int r = 0; r < 16; ++r) Cd[(vblk * 32 + crow(r, hi)) * 128 + kb * 32 + r32] = f2bf(acc[kb][r]);
        if (tid < 256) {
            const int d2 = tid >> 7, k = tid & 127; const char* img = d2 ? Kb : Kf; float s = 0.f;
            for (int l = 0; l < 128; ++l) s += bf2f(*reinterpret_cast<const u16*>(img + (l >> 6) * 16384 + v_st(l & 63, k & ~7) + (k & 7) * 2));
            NST[(size_t)chain_slot(d2, b, h, cc) * 128 + k] = s;
        }
    }
}

DEVI void phase_kmax(const P& p, char* lds) {
    const int tid = threadIdx.x; unsigned* lm = (unsigned*)lds;
    __syncthreads();
    if (tid < 16) lm[tid] = 0u;
    __syncthreads();
    const u16* K = (const u16*)(p.ws + OFF_K); const int hm = tid & 7;
    float mx0 = 0.f, mx1 = 0.f;
    for (int idx = blockIdx.x * NTHR + tid; idx < NTOK * 8; idx += gridDim.x * NTHR) {
        const int tok = idx >> 3; const u16* kp = K + (size_t)tok * 512 + hm * 64; float ss = 0.f;
#pragma unroll
        for (int c = 0; c < 8; ++c) { const u32x4 w = *reinterpret_cast<const u32x4*>(kp + c * 8);
#pragma unroll
            for (int j = 0; j < 4; ++j) { const float a = bflo(w[j]), b = bfhi(w[j]); ss = fmaf(a, a, ss); ss = fmaf(b, b, ss); } }
        if (tok < TT) mx0 = fmaxf(mx0, ss); else mx1 = fmaxf(mx1, ss);
    }
    atomicMax(&lm[hm], __float_as_uint(mx0)); atomicMax(&lm[8 + hm], __float_as_uint(mx1));
    __syncthreads();
    if (tid < 16) atomicMax((unsigned*)(p.ws + OFF_CNT) + 128 + tid, lm[tid]);
    __syncthreads();
}

DEVI int proc_chunk(int dir, int i) { return dir == 0 ? i : (i == 0 ? 1 : (i == 1 ? 0 : NCH + 1 - i)); }

DEVI void phase_mlstm_b(const P& p, char* lds) {
    const int tid = threadIdx.x;
    float* dec = (float*)lds; float* scl = dec + 160; float* mst = scl + 160;
    const float2* scal = (const float2*)(p.ws + OFF_MSCAL);
    u32* CST = (u32*)(p.ws + OFF_CST); float* NST = (float*)(p.ws + OFF_NST); float* MST = (float*)(p.ws + OFF_MST);
    for (int it = blockIdx.x; it < 16 * 16; it += gridDim.x) {
        const int chain = it >> 4, sub = it & 15, dir = chain >> 3;
        __syncthreads();
        if (tid == 0) {
            float m = 0.f;
            for (int i = 0; i < NCH; ++i) {
                const int cc = proc_chunk(dir, i); const float2 s = scal[chain * NCH + cc];
                const float mn = fmaxf(s.y + m, s.x);
                dec[i] = __expf(s.y + m - mn); scl[i] = __expf(s.x - mn); mst[i] = m;
                if (sub == 0) MST[chain * NCH + cc] = m;
                m = mn;
            }
        }
        __syncthreads();
        u32* base = CST + (size_t)chain * NCH * 8192 + sub * 512 + tid;
        float s0 = 0.f, s1 = 0.f;
        for (int i0 = 0; i0 < NCH; i0 += 10) {
            u32 v[10];
#pragma unroll
            for (int j = 0; j < 10; ++j) v[j] = base[(size_t)proc_chunk(dir, i0 + j) * 8192];
#pragma unroll
            for (int j = 0; j < 10; ++j) {
                base[(size_t)proc_chunk(dir, i0 + j) * 8192] = cvtpk(s0, s1);
                const float d = dec[i0 + j], sc = scl[i0 + j];
                s0 = fmaf(d, s0, sc * bflo(v[j])); s1 = fmaf(d, s1, sc * bfhi(v[j]));
            }
        }
        if (sub == 0 && tid < 128) {
            float* nb = NST + (size_t)chain * NCH * 128 + tid; float s = 0.f;
            for (int i = 0; i < NCH; ++i) { const int cc = proc_chunk(dir, i); const float v = nb[cc * 128]; nb[cc * 128] = s; s = fmaf(dec[i], s, scl[i] * v); }
        }
    }
}

DEVI void mlstm_c_item(const P& p, int it, char* lds) {
    int tid = threadIdx.x; asm volatile("" : "+v"(tid));
    const int wid = __builtin_amdgcn_readfirstlane(tid >> 6), lane = tid & 63, r32 = lane & 31, hi = lane >> 5;
    const int cc = it % NCH, h = (it / NCH) & 3, b = it / (NCH * 4);
    const int row0 = b * TT + cc * 128;
    char* Kt = lds; char* Vimg = lds + 34816; char* Ct = lds + 67584;
    float* arr = (float*)(lds + 137216);
    float* wsc = arr + 1024 + wid * 64;
    float* xb = (float*)lds;
    const float* gates = (const float*)(p.ws + OFF_GATES);
    const u16* MLC = (const u16*)(p.ws + OFF_MLC); const u16* MLV = (const u16*)(p.ws + OFF_MLV);
    const u16* CST = (const u16*)(p.ws + OFF_CST); const float* NST = (const float*)(p.ws + OFF_NST); const float* MST = (const float*)(p.ws + OFF_MST);
    __syncthreads();
    if (wid < 2) { float total, amax; float* a4 = arr + wid * 512; chunk_scan(gates, row0, h, wid, a4, a4 + 128, a4 + 256, total, amax); }
    else if (wid < 6) { const int d2 = (wid - 2) >> 1, k = ((wid - 2) & 1) * 64 + lane; arr[d2 * 512 + 384 + k] = NST[(size_t)chain_slot(d2, b, h, cc) * 128 + k]; }
#pragma unroll
    for (int i = 0; i < 4; ++i) {
        const int idx = tid + 512 * i, l = idx >> 4, ch = idx & 15, c = ch * 8;
        const u32x4 v = *reinterpret_cast<const u32x4*>(MLV + (size_t)(row0 + l) * 512 + h * 128 + c);
        *reinterpret_cast<u32x4*>(Vimg + (l >> 6) * 16384 + v_st(l & 63, c)) = v;
        const u32x4 ok = *reinterpret_cast<const u32x4*>(MLC + (size_t)(row0 + l) * 1024 + 512 + h * 128 + c);
        *reinterpret_cast<u32x4*>(Kt + swz256(l, ch)) = ok;
#pragma unroll
        for (int d2 = 0; d2 < 2; ++d2) {
            const u32x4 cv = *reinterpret_cast<const u32x4*>(CST + (size_t)chain_slot(d2, b, h, cc) * 16384 + l * 128 + c);
            *reinterpret_cast<u32x4*>(Ct + d2 * 34816 + swz256(l, ch)) = cv;
        }
    }
    const int dir = wid >> 2, qb = wid & 3, q = qb * 32 + r32;
    bf16x8 qr[8];
    { const u16* qp = MLC + (size_t)(row0 + q) * 1024 + h * 128 + hi * 8;
#pragma unroll
      for (int d0 = 0; d0 < 8; ++d0) qr[d0] = *reinterpret_cast<const bf16x8*>(qp + d0 * 16); }
    __syncthreads();
    const float* a4 = arr + dir * 512;
    const float m_st = MST[chain_slot(dir, b, h, 0) + cc];
    const float Mq = fmaxf(m_st, a4[256 + q]);
    const float inter = __expf(m_st - Mq);
    float nq = 0.f;
#pragma unroll
    for (int d0 = 0; d0 < 8; ++d0) {
        const u32x4 w = *reinterpret_cast<const u32x4*>(&qr[d0]); const float* nn = a4 + 384 + d0 * 16 + hi * 8;
#pragma unroll
        for (int j = 0; j < 4; ++j) { nq = fmaf(bflo(w[j]), nn[2 * j], nq); nq = fmaf(bfhi(w[j]), nn[2 * j + 1], nq); }
    }
    { auto rr = __builtin_amdgcn_permlane32_swap(__float_as_uint(nq), __float_as_uint(nq), false, false); nq = __uint_as_float(rr[0]) + __uint_as_float(rr[1]); }
    f32x16 o[4] = {};
    const char* Cm = Ct + dir * 34816;
#pragma unroll
    for (int dk = 0; dk < 8; ++dk)
#pragma unroll
        for (int d0 = 0; d0 < 4; ++d0) o[d0] = __builtin_amdgcn_mfma_f32_32x32x16_bf16(qr[dk], lds_b128(Cm, swz256(d0 * 32 + r32, 2 * dk + hi)), o[d0], 0, 0, 0);
    if (hi == 0) wsc[r32] = inter;
    asm volatile("s_waitcnt lgkmcnt(0)" ::: "memory");
#pragma unroll
    for (int d0 = 0; d0 < 4; ++d0)
#pragma unroll
        for (int r = 0; r < 16; ++r) o[d0][r] *= wsc[crow(r, hi)];
    const int vb = (int)(uintptr_t)Vimg + v_rd_base(lane);
    float rs = 0.f;
#define KBLK(KB) do { if (dir == 0 ? (KB) <= qb : (KB) >= qb) { \
        f32x16 pp = {}; \
        _Pragma("unroll") for (int d0 = 0; d0 < 8; ++d0) pp = __builtin_amdgcn_mfma_f32_32x32x16_bf16(lds_b128(Kt, swz256((KB) * 32 + r32, 2 * d0 + hi)), qr[d0], pp, 0, 0, 0); \
        _Pragma("unroll") for (int g = 0; g < 4; ++g) { const f32x4 av4 = *reinterpret_cast<const f32x4*>(a4 + 128 + (KB) * 32 + 8 * g + 4 * hi); \
            _Pragma("unroll") for (int j = 0; j < 4; ++j) { const int key = (KB) * 32 + 8 * g + 4 * hi + j; const bool ok = dir == 0 ? key <= q : key >= q; \
                const float sv = ok ? pp[4 * g + j] * __expf(av4[j] - Mq) : 0.f; pp[4 * g + j] = sv; rs += sv; } } \
        bf16x8 f0, f1; pack_p(pp, f0, f1); \
        { s16x4 l0, h0, l1, h1, l2, h2, l3, h3; constexpr int HH = (KB) >> 1, K0 = ((KB) & 1) * 2; \
          tr_frag_issue<0, K0>(vb + HH * 16384, l0, h0); tr_frag_issue<1, K0>(vb + HH * 16384, l1, h1); tr_frag_issue<2, K0>(vb + HH * 16384, l2, h2); tr_frag_issue<3, K0>(vb + HH * 16384, l3, h3); LGKM0(); \
          o[0] = __builtin_amdgcn_mfma_f32_32x32x16_bf16(f0, PKLH(l0, h0), o[0], 0, 0, 0); o[1] = __builtin_amdgcn_mfma_f32_32x32x16_bf16(f0, PKLH(l1, h1), o[1], 0, 0, 0); \
          o[2] = __builtin_amdgcn_mfma_f32_32x32x16_bf16(f0, PKLH(l2, h2), o[2], 0, 0, 0); o[3] = __builtin_amdgcn_mfma_f32_32x32x16_bf16(f0, PKLH(l3, h3), o[3], 0, 0, 0); \
          tr_frag_issue<0, K0 + 1>(vb + HH * 16384, l0, h0); tr_frag_issue<1, K0 + 1>(vb + HH * 16384, l1, h1); tr_frag_issue<2, K0 + 1>(vb + HH * 16384, l2, h2); tr_frag_issue<3, K0 + 1>(vb + HH * 16384, l3, h3); LGKM0(); \
          o[0] = __builtin_amdgcn_mfma_f32_32x32x16_bf16(f1, PKLH(l0, h0), o[0], 0, 0, 0); o[1] = __builtin_amdgcn_mfma_f32_32x32x16_bf16(f1, PKLH(l1, h1), o[1], 0, 0, 0); \
          o[2] = __builtin_amdgcn_mfma_f32_32x32x16_bf16(f1, PKLH(l2, h2), o[2], 0, 0, 0); o[3] = __builtin_amdgcn_mfma_f32_32x32x16_bf16(f1, PKLH(l3, h3), o[3], 0, 0, 0); } } } while (0)
    KBLK(0); KBLK(1); KBLK(2); KBLK(3);
#undef KBLK
    { auto rr = __builtin_amdgcn_permlane32_swap(__float_as_uint(rs), __float_as_uint(rs), false, false); rs = __uint_as_float(rr[0]) + __uint_as_float(rr[1]); }
    const float nqt = inter * nq + rs;
    const float den = fmaxf(fabsf(nqt), __expf(-(a4[q] + Mq)));
    if (hi == 0) wsc[32 + r32] = 1.f / den;
    asm volatile("s_waitcnt lgkmcnt(0)" ::: "memory");
#pragma unroll
    for (int d0 = 0; d0 < 4; ++d0)
#pragma unroll
        for (int r = 0; r < 16; ++r) o[d0][r] *= wsc[32 + crow(r, hi)];
    __syncthreads();
    {
        float* xd = dir ? xb : (float*)(lds + 67584);
#pragma unroll
        for (int d0 = 0; d0 < 4; ++d0)
#pragma unroll
            for (int r = 0; r < 16; ++r) xd[(qb * 32 + crow(r, hi)) * 128 + d0 * 32 + r32] = o[d0][r];
    }
    __syncthreads();
    {
        const u16* OG = (const u16*)(p.ws + OFF_OG); u16* mix = (u16*)(p.ws + OFF_ACT);
        const float* xf = (const float*)(lds + 67584);
#pragma unroll
        for (int i = 0; i < 4; ++i) {
            const int idx = tid + 512 * i, ql = idx >> 4, c = (idx & 15) * 8;
            const f32x4 f0 = *reinterpret_cast<const f32x4*>(xf + ql * 128 + c), f1 = *reinterpret_cast<const f32x4*>(xf + ql * 128 + c + 4);
            const f32x4 b0 = *reinterpret_cast<const f32x4*>(xb + ql * 128 + c), b1 = *reinterpret_cast<const f32x4*>(xb + ql * 128 + c + 4);
            const u32x4 og = *reinterpret_cast<const u32x4*>(OG + (size_t)(row0 + ql) * 512 + h * 128 + c);
            u32x4 w;
            w[0] = cvtpk((f0[0] + b0[0]) * bflo(og[0]), (f0[1] + b0[1]) * bfhi(og[0]));
            w[1] = cvtpk((f0[2] + b0[2]) * bflo(og[1]), (f0[3] + b0[3]) * bfhi(og[1]));
            w[2] = cvtpk((f1[0] + b1[0]) * bflo(og[2]), (f1[1] + b1[1]) * bfhi(og[2]));
            w[3] = cvtpk((f1[2] + b1[2]) * bflo(og[3]), (f1[3] + b1[3]) * bfhi(og[3]));
            *reinterpret_cast<u32x4*>(mix + (size_t)(row0 + ql) * 1024 + 512 + h * 128 + c) = w;
        }
    }
}

#define KSWZ(row, colB) ((row) * 256 + ((colB) ^ (((row) & 15) << 4)))
constexpr float A2_SCALE = 0.125f, A2_THR = 8.f;
DEVI void a2_partialSM(f32x16& p0, f32x16& p1, float) {
#pragma unroll
    for (int r = 0; r < 16; ++r) p0[r] = __builtin_amdgcn_exp2f(p0[r]);
}
DEVI void a2_finishSM(f32x16& p0, f32x16& p1, f32x16& lv, bf16x8& pa0, bf16x8& pa1, bf16x8& pa2, bf16x8& pa3) {
#pragma unroll
    for (int r = 0; r < 16; ++r) p1[r] = __builtin_amdgcn_exp2f(p1[r]);
#pragma unroll
    for (int r = 0; r < 16; ++r) lv[r] += p0[r] + p1[r];
    pack_p_perm(p0, pa0, pa1); pack_p_perm(p1, pa2, pa3);
}
DEVI void a2_qkt(f32x16& p0, f32x16& p1, const char* Ks, const bf16x8 (&qr)[4], int r32, int hi, int grp, const f32x16& cinit) {
#pragma unroll
    for (int d0 = 0; d0 < 4; ++d0) { const int cb = (grp * 64 + d0 * 16 + hi * 8) * 2;
        const bf16x8 b0 = lds_b128(Ks, KSWZ(r32, cb)), b1 = lds_b128(Ks, KSWZ(32 + r32, cb));
        if (d0 == 0) { p0 = __builtin_amdgcn_mfma_f32_32x32x16_bf16(b0, qr[0], cinit, 0, 0, 0); p1 = __builtin_amdgcn_mfma_f32_32x32x16_bf16(b1, qr[0], cinit, 0, 0, 0); }
        else { p0 = __builtin_amdgcn_mfma_f32_32x32x16_bf16(b0, qr[d0], p0, 0, 0, 0); p1 = __builtin_amdgcn_mfma_f32_32x32x16_bf16(b1, qr[d0], p1, 0, 0, 0); } }
}
#define A2_VISSUE(D0, F) do { tr_frag_issue<D0, 0>(vb, F##l0, F##h0); tr_frag_issue<D0, 1>(vb, F##l1, F##h1); tr_frag_issue<D0, 2>(vb, F##l2, F##h2); tr_frag_issue<D0, 3>(vb, F##l3, F##h3); } while (0)
#define A2_VMMA(D0, F) do { \
    o[D0] = __builtin_amdgcn_mfma_f32_32x32x16_bf16(pa0, PKLH(F##l0, F##h0), o[D0], 0, 0, 0); o[D0] = __builtin_amdgcn_mfma_f32_32x32x16_bf16(pa1, PKLH(F##l1, F##h1), o[D0], 0, 0, 0); \
    o[D0] = __builtin_amdgcn_mfma_f32_32x32x16_bf16(pa2, PKLH(F##l2, F##h2), o[D0], 0, 0, 0); o[D0] = __builtin_amdgcn_mfma_f32_32x32x16_bf16(pa3, PKLH(F##l3, F##h3), o[D0], 0, 0, 0); } while (0)
#define A2_LGKM(N) do { asm volatile("s_waitcnt lgkmcnt(" #N ")" ::: "memory"); SBAR(); } while (0)
template <int S> DEVI void a2_psm_slice(f32x16& x0, f32x16&, float) {
#pragma unroll
    for (int r = 4 * S; r < 4 * S + 4; ++r) x0[r] = __builtin_amdgcn_exp2f(x0[r]);
}
DEVI void a2_pv(f32x16 (&o)[4], int vb, const bf16x8& pa0, const bf16x8& pa1, const bf16x8& pa2, const bf16x8& pa3, f32x16& x0, f32x16& x1, float mnC) {
    s16x4 al0, ah0, al1, ah1, al2, ah2, al3, ah3, bl0, bh0, bl1, bh1, bl2, bh2, bl3, bh3;
    A2_VISSUE(0, a); A2_VISSUE(1, b);
    A2_LGKM(8); a2_psm_slice<0>(x0, x1, mnC); A2_VMMA(0, a);
    A2_VISSUE(2, a);
    A2_LGKM(8); a2_psm_slice<1>(x0, x1, mnC); A2_VMMA(1, b);
    A2_VISSUE(3, b);
    A2_LGKM(8); a2_psm_slice<2>(x0, x1, mnC); A2_VMMA(2, a);
    A2_LGKM(0); a2_psm_slice<3>(x0, x1, mnC); A2_VMMA(3, b);
}
DEVI void a2_pv_last(f32x16 (&o)[4], int vb, const bf16x8& pa0, const bf16x8& pa1, const bf16x8& pa2, const bf16x8& pa3) {
    s16x4 al0, ah0, al1, ah1, al2, ah2, al3, ah3, bl0, bh0, bl1, bh1, bl2, bh2, bl3, bh3;
    A2_VISSUE(0, a); A2_VISSUE(1, b);
    A2_LGKM(8); A2_VMMA(0, a);
    A2_VISSUE(2, a);
    A2_LGKM(8); A2_VMMA(1, b);
    A2_VISSUE(3, b);
    A2_LGKM(8); A2_VMMA(2, a);
    A2_LGKM(0); A2_VMMA(3, b);
}
constexpr int A2_T = 16384;
DEVI void a2_body(const P& p, int q0, int k0row, int seq, int h, char* lds, int tid) {
    const int GRP = __builtin_amdgcn_readfirstlane(tid >> 8); const int wid = tid >> 6, lane = tid & 63, r32 = lane & 31, hi = lane >> 5, wq = wid & 3;
    const u16* Kh = (const u16*)(p.ws + OFF_K) + (size_t)k0row * 512 + h * 128;
    const u16* Vh = (const u16*)(p.ws + OFF_V) + (size_t)k0row * 512 + h * 128;
    char* V_lds = lds; char* K_lds = lds + 3 * A2_T;
    float* wsc = (float*)(lds + 6 * A2_T) + wid * 64; float* li_l = wsc;
    float l_reg = 0.f; f32x16 o[4] = {}; bf16x8 qr[4];
    { const u16* Qw = (const u16*)(p.ws + OFF_Q) + (size_t)(q0 + wq * 32 + r32) * 512 + h * 128 + GRP * 64 + hi * 8;
#pragma unroll
      for (int d0 = 0; d0 < 4; ++d0) qr[d0] = *reinterpret_cast<const bf16x8*>(Qw + d0 * 16); }
    float mnC;
    { float qq = 0.f;
#pragma unroll
      for (int d0 = 0; d0 < 4; ++d0) { const u32x4 w = *reinterpret_cast<const u32x4*>(&qr[d0]);
#pragma unroll
          for (int j = 0; j < 4; ++j) { const float a = bflo(w[j]), b2 = bfhi(w[j]); qq = fmaf(a, a, qq); qq = fmaf(b2, b2, qq); } }
      { auto rr = __builtin_amdgcn_permlane32_swap(__float_as_uint(qq), __float_as_uint(qq), false, false); qq = __uint_as_float(rr[0]) + __uint_as_float(rr[1]); }
      const int bq = k0row >= TT ? 1 : 0;
      const float k2 = __uint_as_float(((const unsigned*)(p.ws + OFF_CNT))[128 + bq * 8 + h * 2 + GRP]);
      mnC = -sqrtf(qq * k2) * (A2_SCALE * 1.4426950408889634f) * 1.001f;
#pragma unroll
      for (int d0 = 0; d0 < 4; ++d0) { u32x4 w = *reinterpret_cast<u32x4*>(&qr[d0]);
#pragma unroll
          for (int j = 0; j < 4; ++j) w[j] = cvtpk(bflo(w[j]) * (A2_SCALE * 1.4426950408889634f), bfhi(w[j]) * (A2_SCALE * 1.4426950408889634f));
          qr[d0] = *reinterpret_cast<bf16x8*>(&w); } }
    const int vb0 = (int)(uintptr_t)V_lds + v_rd_base(lane);
    const int krow = tid >> 4, kch = (tid & 15) ^ (krow & 15);
    const int vc = ((tid >> 5) & 3) * 32 + (tid & 3) * 8;
    const int kk0 = (tid >> 7) * 8 + ((tid & 31) >> 2), kk1 = kk0 + 32;
#define A2_DMA(slot, kk) do { \
    __builtin_amdgcn_global_load_lds((const unsigned*)(Kh + (size_t)((kk) + krow) * 512 + kch * 8), (LAS unsigned*)(K_lds + (slot) * A2_T + tid * 16), 16, 0, 0); \
    __builtin_amdgcn_global_load_lds((const unsigned*)(Kh + (size_t)((kk) + 32 + krow) * 512 + kch * 8), (LAS unsigned*)(K_lds + (slot) * A2_T + 8192 + tid * 16), 16, 0, 0); \
    __builtin_amdgcn_global_load_lds((const unsigned*)(Vh + (size_t)((kk) + kk0) * 512 + vc), (LAS unsigned*)(V_lds + (slot) * A2_T + tid * 16), 16, 0, 0); \
    __builtin_amdgcn_global_load_lds((const unsigned*)(Vh + (size_t)((kk) + kk1) * 512 + vc), (LAS unsigned*)(V_lds + (slot) * A2_T + 8192 + tid * 16), 16, 0, 0); } while (0)
    f32x16 pA0, pA1, pB0, pB1; bf16x8 pa0, pa1, pa2, pa3; const int NT = seq / 64;
    f32x16 lv = {};
    f32x16 cinit;
#pragma unroll
    for (int r = 0; r < 16; ++r) cinit[r] = mnC;
    asm volatile("" : "+v"(cinit));
    __syncthreads();
    A2_DMA(0, 0); asm volatile("s_waitcnt vmcnt(0)" ::: "memory"); __syncthreads();
    A2_DMA(1, 64);
    a2_qkt(pA0, pA1, K_lds, qr, r32, hi, GRP, cinit); a2_partialSM(pA0, pA1, mnC);
    asm volatile("s_waitcnt vmcnt(0)" ::: "memory"); __syncthreads();
    int bp = 0, bc = 1, bn = 2;
#define A2_HALF(X0, X1, Y0, Y1, J) do { \
        if ((J) + 1 < NT) A2_DMA(bn, ((J) + 1) * 64); \
        SBAR(); a2_qkt(X0, X1, K_lds + bc * A2_T, qr, r32, hi, GRP, cinit); \
        a2_finishSM(Y0, Y1, lv, pa0, pa1, pa2, pa3); \
        __builtin_amdgcn_sched_group_barrier(0x100, 8, 0); \
        _Pragma("unroll") for (int g_ = 0; g_ < 8; ++g_) { __builtin_amdgcn_sched_group_barrier(0x8, 1, 0); __builtin_amdgcn_sched_group_barrier(0x2, 9, 0); } \
        SBAR(); \
        a2_pv(o, vb0 + bp * A2_T, pa0, pa1, pa2, pa3, X0, X1, mnC); \
        asm volatile("s_waitcnt vmcnt(0)" ::: "memory"); __syncthreads(); \
        { const int t_ = bp; bp = bc; bc = bn; bn = t_; } } while (0)
    for (int j = 1; j + 1 < NT; j += 2) {
        A2_HALF(pB0, pB1, pA0, pA1, j);
        A2_HALF(pA0, pA1, pB0, pB1, j + 1);
    }
    A2_HALF(pB0, pB1, pA0, pA1, NT - 1);
    a2_finishSM(pB0, pB1, lv, pa0, pa1, pa2, pa3); SBAR();
    a2_pv_last(o, vb0 + bp * A2_T, pa0, pa1, pa2, pa3);
#undef A2_HALF
#undef A2_DMA
    asm volatile("s_waitcnt vmcnt(0)" ::: "memory");
    int tz = threadIdx.x; asm volatile("" : "+v"(tz));
    const int wq_e = (tz >> 6) & 3, r32e = tz & 31, hie = (tz >> 5) & 1;
    float* li_e = (float*)(lds + 6 * A2_T) + (tz >> 6) * 64;
    const float lam = ((const float*)(p.ws + OFF_LAM))[0];
#pragma unroll
    for (int r = 0; r < 16; ++r) l_reg += lv[r];
    { auto rr = __builtin_amdgcn_permlane32_swap(__float_as_uint(l_reg), __float_as_uint(l_reg), false, false); l_reg = __uint_as_float(rr[0]) + __uint_as_float(rr[1]); }
    if (hie == 0) li_e[r32e] = (GRP == 0 ? 1.f : -lam) / l_reg;
    asm volatile("s_waitcnt lgkmcnt(0)" ::: "memory");
#pragma unroll
    for (int r = 0; r < 16; ++r) { const float sc_ = li_e[crow(r, hie)];
#pragma unroll
        for (int d = 0; d < 4; ++d) o[d][r] *= sc_; }
    float* xb = (float*)lds;
    __syncthreads();
    if (GRP == 1) {
#pragma unroll
        for (int d = 0; d < 4; ++d)
#pragma unroll
            for (int r = 0; r < 16; ++r) xb[(wq_e * 32 + crow(r, hie)) * 128 + d * 32 + r32e] = o[d][r];
    }
    __syncthreads();
    if (GRP == 0) {
        float ssq[16];
#pragma unroll
        for (int r = 0; r < 16; ++r) { float s_ = 0.f;
#pragma unroll
            for (int d = 0; d < 4; ++d) { const float v = o[d][r] + xb[(wq_e * 32 + crow(r, hie)) * 128 + d * 32 + r32e]; o[d][r] = v; s_ = fmaf(v, v, s_); }
            ssq[r] = s_; }
#pragma unroll
        for (int r = 0; r < 16; ++r) { float s_ = ssq[r]; for (int of = 16; of; of >>= 1) s_ += __shfl_xor(s_, of); ssq[r] = rsqrtf(s_ * (1.f / 128.f) + 1e-6f) * 0.8f; }
        u16* mix = (u16*)(p.ws + OFF_ACT);
#pragma unroll
        for (int d = 0; d < 4; ++d) { const float gv = p.subln_g[d * 32 + r32e];
#pragma unroll
            for (int r = 0; r < 16; ++r) mix[(size_t)(q0 + wq_e * 32 + crow(r, hie)) * 1024 + h * 128 + d * 32 + r32e] = f2bf(o[d][r] * ssq[r] * gv); }
    }
}
DEVI void phase_attn(const P& p, char* lds) {
    const int G = gridDim.x;
    for (int it = blockIdx.x; it < 1024 + 16; it += G) {
        int q0, k0, seq, h;
        if (it < 1024) {
            int bh, qb;
            if ((G & 7) == 0) { bh = it & 7; qb = it >> 3; } else { bh = it >> 7; qb = it & 127; }
            const int b = bh >> 2; h = bh & 3; q0 = b * TT + TC + qb * 128; k0 = b * TT; seq = TT;
        } else { const int j = it - 1024, b = j >> 3; h = (j >> 1) & 3; q0 = b * TT + (j & 1) * 128; k0 = b * TT; seq = TC; }
        int tid = threadIdx.x; asm volatile("" : "+v"(tid));
        a2_body(p, q0, k0, seq, h, lds, tid);
    }
}
DEVI void phase_mlstm_c(const P& p, char* lds) {
    for (int it = blockIdx.x; it < NB * 4 * NCH; it += gridDim.x) mlstm_c_item(p, it, lds);
}

DEVI void tail_bg(const P& p, char* lds, int nunits, int first, int nitems) {
    const int G = gridDim.x, c = blockIdx.x, full = nunits / G, rem = nunits - full * G;
    __syncthreads();
    if (rem == 0) { for (int it = c; it < nitems; it += G) bg_item(p, first + it, (float*)lds); }
    else if (c >= rem) { for (int it = c - rem; it < nitems; it += G - rem) bg_item(p, first + it, (float*)lds); }
    __syncthreads();
}
DEVI void tail_convert(const P& p, char* lds, int layer, int nunits, int lo = 0, int hi = N0_EXP) {
    const int G = gridDim.x, c = blockIdx.x, full = nunits / G, rem = nunits - full * G;
    __syncthreads();
    if (rem == 0) { for (int it = lo + c; it < hi; it += G) convert_expert_item(p, layer, it, (float*)lds); }
    else if (c >= rem) { for (int it = lo + c - rem; it < hi; it += G - rem) convert_expert_item(p, layer, it, (float*)lds); }
    __syncthreads();
}
DEVI void phase_convert_l1(const P& p, char* lds) {
    for (int it = blockIdx.x; it < N0_EXP; it += gridDim.x) convert_expert_item(p, 1, it, (float*)lds);
}

constexpr int NPHASE = 19;
__global__ void __launch_bounds__(NTHR, 2) fwd_kernel(P p_) {
    extern __shared__ __attribute__((aligned(16))) char lds[];
    volatile LAS unsigned* st = (volatile LAS unsigned*)(lds + LDS_BYTES - 16);
    if (threadIdx.x == 0) { st[0] = 0u; st[1] = 0u; st[2] = 0u; st[3] = 0u; }
    __syncthreads();
    const int lo = p_.ph_lo, hi = p_.ph_hi;
    XcdBarrier bar; bar.bar = (unsigned*)(p_.ws + OFF_BAR); bar.x = 0; bar.st = st;
    if (hi - lo > 1) bar = xcd_barrier_post((unsigned*)(p_.ws + OFF_BAR), st);
#if defined(__HIP_DEVICE_COMPILE__)
#define PARAMS() const __attribute__((address_space(4))) P* kp_ = (const __attribute__((address_space(4))) P*)__builtin_amdgcn_kernarg_segment_ptr(); asm volatile("" : "+s"(kp_)); const P p = *kp_
#else
#define PARAMS() const P p = p_
#endif
#ifndef PHSEL
#define PHON(k) true
#else
#define PHON(k) ((k) == PHSEL)
#endif
#define IN(k) (lo <= (k) && (k) < hi)
#define SEAM(k) do { if (IN(k) && IN((k) + ((k) == 5 ? 2 : 1))) xcd_barrier(bar); } while (0)
    if (PHON(0) && IN(0)) { PARAMS(); phase_prologue(p, lds); if (((PROBE_DUP) >> 0) & 1u) { phase_prologue(p, lds); } }            SEAM(0);
    if (PHON(1) && IN(1)) { PARAMS(); phase_norm<0>(p, lds); if (((PROBE_DUP) >> 1) & 1u) { phase_norm<0>(p, lds); } }             SEAM(1);
    if (PHON(2) && IN(2)) { PARAMS(); phase_inproj(p, lds); tail_convert(p, lds, 0, (NTOK / 256) * 14, 0, 4608); if (((PROBE_DUP) >> 2) & 1u) { phase_inproj(p, lds); } }              SEAM(2);
    if (PHON(3) && IN(3)) { PARAMS(); phase_mlstm_a(p, lds); tail_bg(p, lds, NB * 4 * NCH, 0, N0_WOUT); tail_convert(p, lds, 0, NB * 4 * NCH, 4608, N0_EXP); if (((PROBE_DUP) >> 3) & 1u) { phase_mlstm_a(p, lds); } }             SEAM(3);
    if (PHON(4) && IN(4)) { PARAMS(); phase_kmax(p, lds); phase_mlstm_b(p, lds); if (((PROBE_DUP) >> 4) & 1u) { xcd_barrier(bar); phase_mlstm_a(p, lds); xcd_barrier(bar); phase_mlstm_b(p, lds); } }             SEAM(4);
    if (PHON(5) && IN(5)) { PARAMS(); phase_attn(p, lds); phase_mlstm_c(p, lds); tail_bg(p, lds, NB * 4 * NCH, N0_WOUT, N0_FN); if (((PROBE_DUP) >> 5) & 1u) { phase_attn(p, lds); } if (((PROBE_DUP) >> 6) & 1u) { phase_mlstm_c(p, lds); } }   SEAM(5);
    if (PHON(7) && IN(7)) { PARAMS(); phase_outproj(p, lds); tail_convert(p, lds, 1, (NTOK / 256) * 4); if (((PROBE_DUP) >> 7) & 1u) { phase_outproj(p, lds); } }             SEAM(7);
    if (PHON(8) && IN(8)) { PARAMS(); phase_norm<1>(p, lds); if (((PROBE_DUP) >> 8) & 1u) { phase_norm<1, true>(p, lds); } }             SEAM(8);
    if (PHON(9) && IN(9)) { PARAMS(); phase_moe_up(p, 0, lds); if (((PROBE_DUP) >> 9) & 1u) { phase_moe_up(p, 0, lds); } }           SEAM(9);
    if (PHON(10) && IN(10)) { PARAMS(); phase_moe_down(p, 0, lds); if (((PROBE_DUP) >> 10) & 1u) { phase_moe_down<true>(p, 0, lds); } }        SEAM(10);
    if (PHON(11) && IN(11)) { PARAMS(); phase_norm<2>(p, lds); if (((PROBE_DUP) >> 11) & 1u) { phase_norm<2>(p, lds); } } SEAM(11);
    if (PHON(12) && IN(12)) { PARAMS(); phase_fnet_gemm(p, lds); if (((PROBE_DUP) >> 12) & 1u) { phase_fnet_gemm(p, lds); } }          SEAM(12);
    if (PHON(13) && IN(13)) { PARAMS(); phase_fft1(p, lds); if (((PROBE_DUP) >> 13) & 1u) { phase_fft1(p, lds); } }               SEAM(13);
    if (PHON(14) && IN(14)) { PARAMS(); phase_fft2(p, lds); if (((PROBE_DUP) >> 14) & 1u) { phase_fft2<true>(p, lds); } }               SEAM(14);
    if (PHON(15) && IN(15)) { PARAMS(); phase_norm<3>(p, lds); if (((PROBE_DUP) >> 15) & 1u) { phase_norm<3, true>(p, lds); } }            SEAM(15);
    if (PHON(16) && IN(16)) { PARAMS(); phase_moe_up(p, 1, lds); if (((PROBE_DUP) >> 16) & 1u) { phase_moe_up(p, 1, lds); } }          SEAM(16);
    if (PHON(17) && IN(17)) { PARAMS(); phase_moe_down(p, 1, lds); if (((PROBE_DUP) >> 17) & 1u) { phase_moe_down<true>(p, 1, lds); } }        SEAM(17);
    if (PHON(18) && IN(18)) { PARAMS(); phase_norm<4>(p, lds); if (((PROBE_DUP) >> 18) & 1u) { phase_norm<4>(p, lds); } }
#undef IN
#undef SEAM
}

#ifndef ONE_LAUNCH
#define ONE_LAUNCH 1
#endif
extern "C" void kernel_launch(void* const* d_in, const int* in_sizes, int n_in, void* d_out, int out_size, void* d_ws, size_t ws_size, hipStream_t stream) {
    static int grid = 0;
    if (grid == 0) {
        if (n_in != 21 || out_size != NLAT * DM || ws_size < OFF_END) { fprintf(stderr, "kernel_launch: unexpected shapes (n_in %d out %d ws %zu need %zu)\n", n_in, out_size, ws_size, (size_t)OFF_END); grid = -1; return; }
        int dev = 0, cus = 0;
        if (hipGetDevice(&dev) != hipSuccess || hipDeviceGetAttribute(&cus, hipDeviceAttributeMultiprocessorCount, dev) != hipSuccess) { grid = -1; return; }
        if (hipFuncSetAttribute((const void*)fwd_kernel, hipFuncAttributeMaxDynamicSharedMemorySize, LDS_BYTES) != hipSuccess) { fprintf(stderr, "kernel_launch: hipFuncSetAttribute failed\n"); grid = -1; return; }
        int per_cu = 0;
        if (hipOccupancyMaxActiveBlocksPerMultiprocessor(&per_cu, (const void*)fwd_kernel, NTHR, LDS_BYTES) != hipSuccess || per_cu < 1) { fprintf(stderr, "kernel_launch: occupancy query says %d\n", per_cu); (void)hipGetLastError(); grid = -1; return; }
        grid = cus;
    }
    if (grid < 0) return;
    (void)hipMemsetAsync(d_ws, 0, ZERO_BYTES, stream);
    P p{};
    const float* const* in = (const float* const*)d_in;
    p.x = in[0]; p.c = in[1]; p.ctx = in[2]; p.c_ctx = in[3]; p.ada_w = in[4]; p.ada_b = in[5]; p.nmix_g = in[6]; p.nffn_g = in[7];
    p.w_in = in[8]; p.w_out = in[9]; p.conv_w = in[10]; p.gate_b = in[11]; p.lamv = in[12]; p.subln_g = in[13]; p.w_fnet = in[14];
    p.router_w = in[15]; p.router_b = in[16]; p.w_gate = in[17]; p.w_up = in[18]; p.w_down = in[19]; p.final_g = in[20];
    p.out = (float*)d_out; p.ws = (char*)d_ws;
#if ONE_LAUNCH
    p.ph_lo = 0; p.ph_hi = NPHASE;
    hipLaunchKernelGGL(fwd_kernel, dim3(grid), dim3(NTHR), LDS_BYTES, stream, p);
#else
    for (int k = 0; k < NPHASE; ++k) { p.ph_lo = k; p.ph_hi = k + 1; hipLaunchKernelGGL(fwd_kernel, dim3(grid), dim3(NTHR), LDS_BYTES, stream, p); }
#endif
}
```

```cpp
#include <hip/hip_runtime.h>
#include <stdint.h>
#include <stdio.h>

#define DEVI __device__ __forceinline__
#define PROBE_DUP (0u)
typedef unsigned short u16;
typedef unsigned int u32;
using bf16x8 = __attribute__((ext_vector_type(8))) short;
using s16x4  = __attribute__((ext_vector_type(4))) short;
using f32x16 = __attribute__((ext_vector_type(16))) float;
using f32x4  = __attribute__((ext_vector_type(4))) float;
using u32x4  = __attribute__((ext_vector_type(4))) unsigned;
using u32x2  = __attribute__((ext_vector_type(2))) unsigned;

constexpr int DM = 1024, NB = 2, TL = 16384, TC = 256, TT = TL + TC, NTOK = NB * TT, NLAT = NB * TL;
constexpr int NCH = TT / 128;
constexpr int NTHR = 512;
constexpr int LDS_BYTES = 147456;

constexpr size_t al256(size_t x) { return (x + 255) / 256 * 256; }
constexpr size_t OFF_BAR   = 0;
constexpr size_t OFF_CNT   = 16384;
constexpr size_t ZERO_BYTES = 20480;
constexpr size_t OFF_MOD   = ZERO_BYTES;
constexpr size_t OFF_ROPER = OFF_MOD + al256(2 * 3 * 6144 * 4);
constexpr size_t OFF_ROPEC = OFF_ROPER + 256 * 16 * 8;
constexpr size_t OFF_TW    = OFF_ROPEC + 64 * 16 * 8;
constexpr size_t OFF_DFTC  = OFF_TW + 16384 * 8;
constexpr size_t OFF_DFTS  = OFF_DFTC + 32768;
constexpr size_t OFF_LAM   = OFF_DFTS + 32768;
constexpr size_t OFF_WG16  = OFF_LAM + 256;
constexpr size_t OFF_MSCAL = OFF_WG16 + 65536;
constexpr size_t OFF_MST   = OFF_MSCAL + al256(16 * NCH * 8);
constexpr size_t OFF_WINT  = OFF_MST + al256(16 * NCH * 4);
constexpr size_t OFF_WOUTT = OFF_WINT + (size_t)3584 * 1024 * 2;
constexpr size_t OFF_FNT   = OFF_WOUTT + (size_t)1024 * 1024 * 2;
constexpr size_t OFF_WGU   = OFF_FNT + (size_t)2048 * 1024 * 2;
constexpr size_t OFF_WDT   = OFF_WGU + (size_t)16 * 1024 * 1024 * 2;
constexpr size_t OFF_ACT   = OFF_WDT + (size_t)16 * 1024 * 512 * 2;
constexpr size_t SZ_ACT    = (size_t)NTOK * 1024 * 2;
constexpr size_t OFF_XC    = OFF_ACT + SZ_ACT;
constexpr size_t OFF_GATES = OFF_XC + (size_t)NB * TC * 1024 * 4;
constexpr size_t OFF_TOKW  = OFF_GATES + (size_t)NTOK * 16 * 4;
constexpr size_t OFF_LIST  = OFF_TOKW + al256((size_t)NTOK * 8);
constexpr size_t OFF_NST   = OFF_LIST + (size_t)24 * NTOK * 4;
constexpr size_t OFF_CST   = OFF_NST + (size_t)16 * NCH * 128 * 4;
constexpr size_t SZ_CST    = (size_t)16 * NCH * 16384 * 2;
constexpr size_t OFF_BIG   = OFF_CST + SZ_CST;
constexpr size_t OFF_Q     = OFF_BIG;
constexpr size_t OFF_K     = OFF_Q + (size_t)NTOK * 512 * 2;
constexpr size_t OFF_V     = OFF_K + (size_t)NTOK * 512 * 2;
constexpr size_t OFF_MLQK  = OFF_V + (size_t)NTOK * 512 * 2;
constexpr size_t OFF_MLV   = OFF_MLQK + (size_t)NTOK * 1024 * 2;
constexpr size_t OFF_OG    = OFF_MLV + (size_t)NTOK * 512 * 2;
constexpr size_t OFF_MLC   = OFF_OG + (size_t)NTOK * 512 * 2;
constexpr size_t OFF_END   = OFF_MLC + (size_t)NTOK * 1024 * 2;
constexpr size_t OFF_HE    = OFF_BIG;
constexpr size_t OFF_ZR    = OFF_BIG;
constexpr size_t OFF_ZI    = OFF_ZR + (size_t)NLAT * 1024 * 2;
constexpr size_t OFF_WGU1  = OFF_MLV + (size_t)2 * 1024 * 1024;
constexpr size_t OFF_WDT1  = OFF_WGU1 + (size_t)16 * 1024 * 1024 * 2;
static_assert(OFF_WDT1 + (size_t)16 * 1024 * 512 * 2 <= OFF_MLC && OFF_WGU1 >= OFF_BIG + (size_t)NLAT * 2048 * 2, "layer-1 expert region");
constexpr size_t OFF_YR    = OFF_CST;
constexpr size_t OFF_YI    = OFF_ACT;
static_assert((size_t)NLAT * 1024 * 2 <= SZ_CST && (size_t)NLAT * 1024 * 2 <= SZ_ACT, "alias sizes");
static_assert(OFF_END < (size_t)508 * 1024 * 1024, "workspace");

struct P {
    const float *x, *c, *ctx, *c_ctx, *ada_w, *ada_b, *nmix_g, *nffn_g, *w_in, *w_out, *conv_w, *gate_b, *lamv, *subln_g,
                *w_fnet, *router_w, *router_b, *w_gate, *w_up, *w_down, *final_g;
    float* out;
    char* ws;
    int ph_lo, ph_hi;
};

#define XB_TMO      128
#define XB_XCNT(j)  (256  + 64 * (j))
#define XB_XSUB(j)  (1280 + 64 * (j))
#define XB_XGEN(j)  (2304 + 64 * (j))
#define XB_TOP      3328
#define XB_TOPGEN   3392
#define XCD_BAR_WORDS 3456
#define XB_SPIN_CAP (1u << 18)
#define LAS __attribute__((address_space(3)))

__device__ __forceinline__ unsigned xb_ld(unsigned* p)              { return __hip_atomic_load(p, __ATOMIC_RELAXED, __HIP_MEMORY_SCOPE_AGENT); }
__device__ __forceinline__ unsigned xb_add(unsigned* p, unsigned v) { return __hip_atomic_fetch_add(p, v, __ATOMIC_RELAXED, __HIP_MEMORY_SCOPE_AGENT); }
__device__ __forceinline__ unsigned xb_xcc_id() { return (unsigned)__builtin_amdgcn_s_getreg((3 << 11) | 20) & 0xFu; }
#define XB_SPIN(cond, bar) do { unsigned _sp = 0; while (cond) { __builtin_amdgcn_s_sleep(1); \
    if ((++_sp & 255u) == 0u) { if (xb_ld(&(bar)[XB_TMO])) break; if (_sp > XB_SPIN_CAP) { atomicAdd(&(bar)[XB_TMO], 1u); break; } } } } while (0)

struct XcdBarrier { unsigned* bar; unsigned x; volatile LAS unsigned* st; };

__device__ __forceinline__ XcdBarrier xcd_barrier_post(unsigned* bar, volatile LAS unsigned* st) {
    XcdBarrier b; b.bar = bar; b.x = xb_xcc_id(); b.st = st;
    if (threadIdx.x == 0) (void)xb_add(&bar[XB_XCNT(b.x)], 1u);
    return b;
}
__device__ __forceinline__ void xcd_barrier_complete(unsigned* bar, unsigned x, unsigned& nloc, unsigned& nx) {
    const unsigned G = gridDim.x * gridDim.y * gridDim.z;
    unsigned sum, cnt, mine, sp = 0u;
    for (;;) {
        sum = 0u; cnt = 0u; mine = 0u;
#pragma unroll
        for (unsigned j = 0; j < 16; ++j) { const unsigned c = xb_ld(&bar[XB_XCNT(j)]); sum += c; cnt += (c > 0u) ? 1u : 0u; mine = (j == x) ? c : mine; }
        if (sum == G) break;
        __builtin_amdgcn_s_sleep(1);
        if ((++sp & 255u) == 0u) { if (xb_ld(&bar[XB_TMO])) break; if (sp > XB_SPIN_CAP) { atomicAdd(&bar[XB_TMO], 1u); break; } }
    }
    nloc = mine > 0u ? mine : 1u; nx = cnt > 0u ? cnt : 1u;
}
__device__ __forceinline__ void xcd_barrier(const XcdBarrier& b) {
    asm volatile("s_waitcnt vmcnt(0)" ::: "memory");
    __syncthreads();
    if (threadIdx.x == 0) {
        unsigned* bar = b.bar;
        __builtin_amdgcn_s_waitcnt(0);
        unsigned nloc = b.st[0], nx = b.st[1];
        if (nloc == 0u) { xcd_barrier_complete(bar, b.x, nloc, nx); b.st[0] = nloc; b.st[1] = nx; }
        const unsigned old = xb_add(&bar[XB_XSUB(b.x)], 1u);
        const unsigned gen = old / nloc;
        if (old + 1u == (gen + 1u) * nloc) {
            __builtin_amdgcn_fence(__ATOMIC_RELEASE, "agent");
            asm volatile("s_waitcnt vmcnt(0)" ::: "memory");
            const unsigned og = xb_add(&bar[XB_TOP], 1u);
            const unsigned tg = og / nx;
            if (og + 1u == (tg + 1u) * nx) xb_add(&bar[XB_TOPGEN], 1u);
            else XB_SPIN(xb_ld(&bar[XB_TOPGEN]) == tg, bar);
            __builtin_amdgcn_fence(__ATOMIC_ACQUIRE, "agent");
            xb_add(&bar[XB_XGEN(b.x)], 1u);
            asm volatile("s_waitcnt vmcnt(0)" ::: "memory");
        } else {
            XB_SPIN(xb_ld(&bar[XB_XGEN(b.x)]) == gen, bar);
            __builtin_amdgcn_fence(__ATOMIC_ACQUIRE, "agent");
            asm volatile("s_waitcnt vmcnt(0)" ::: "memory");
        }
    }
    __syncthreads();
}

DEVI u16 f2bf(float f) { u32 u = __float_as_uint(f); u += 0x7fffu + ((u >> 16) & 1u); return (u16)(u >> 16); }
DEVI float bf2f(u32 h) { return __uint_as_float(h << 16); }
DEVI u32 cvtpk(float lo, float hi) { u32 r; asm("v_cvt_pk_bf16_f32 %0, %1, %2" : "=v"(r) : "v"(lo), "v"(hi)); return r; }
DEVI float bflo(u32 w) { return __uint_as_float(w << 16); }
DEVI float bfhi(u32 w) { return __uint_as_float(w & 0xffff0000u); }
DEVI int crow(int r, int hi) { return (r & 3) + 8 * (r >> 2) + 4 * hi; }
using f32x2 = __attribute__((ext_vector_type(2))) float;
template <int CTRL> DEVI float dppmov(float v) { return __int_as_float(__builtin_amdgcn_update_dpp(0, __float_as_int(v), CTRL, 0xf, 0xf, true)); }
DEVI float row16_sum(float v) { v += dppmov<0xB1>(v); v += dppmov<0x4E>(v); v += dppmov<0x141>(v); v += dppmov<0x140>(v); return v; }
DEVI float x4row_sum(float x) {
    auto s_ = __builtin_amdgcn_permlane16_swap(__float_as_uint(x), __float_as_uint(x), false, false); x = __uint_as_float(s_[0]) + __uint_as_float(s_[1]);
    auto t_ = __builtin_amdgcn_permlane32_swap(__float_as_uint(x), __float_as_uint(x), false, false); return __uint_as_float(t_[0]) + __uint_as_float(t_[1]);
}
DEVI float wave_sum(float v) { for (int o = 32; o; o >>= 1) v += __shfl_xor(v, o); return v; }
DEVI float wave_max(float v) { for (int o = 32; o; o >>= 1) v = fmaxf(v, __shfl_xor(v, o)); return v; }
DEVI float sigmoidf_(float x) { return __builtin_amdgcn_rcpf(1.f + __expf(-x)); }
DEVI float siluf_(float x) { return x * __builtin_amdgcn_rcpf(1.f + __expf(-x)); }
DEVI float logsigmoidf_(float x) { return fminf(x, 0.f) - log1pf(__expf(-fabsf(x))); }
#define SBAR() __builtin_amdgcn_sched_barrier(0)

DEVI void sincos2pi(double frac, double& s, double& c) {
    frac -= floor(frac);
    double q = rint(frac * 4.0);
    double r = (frac - q * 0.25) * 6.283185307179586476925;
    double r2 = r * r;
    double sr = r * (1.0 + r2 * (-1.0 / 6 + r2 * (1.0 / 120 + r2 * (-1.0 / 5040 + r2 * (1.0 / 362880 + r2 * (-1.0 / 39916800 + r2 * (1.0 / 6227020800.0 + r2 * (-1.0 / 1307674368000.0))))))));
    double cr = 1.0 + r2 * (-0.5 + r2 * (1.0 / 24 + r2 * (-1.0 / 720 + r2 * (1.0 / 40320 + r2 * (-1.0 / 3628800 + r2 * (1.0 / 479001600.0 + r2 * (-1.0 / 87178291200.0 + r2 * (1.0 / 20922789888000.0))))))));
    int qi = ((int)q) & 3;
    if (qi == 0) { s = sr; c = cr; } else if (qi == 1) { s = cr; c = -sr; } else if (qi == 2) { s = -sr; c = -cr; } else { s = -cr; c = sr; }
}

DEVI u16* xs_ptr(const P& p, int layer, int tok) {
    const int row = layer == 0 ? tok : (tok >> 14) * TT + TC + (tok & (TL - 1));
    return (u16*)(p.ws + OFF_MLC) + (size_t)row * DM;
}
DEVI f32x4 bf4_to_f32(u32x2 w) { f32x4 v; v[0] = bflo(w[0]); v[1] = bfhi(w[0]); v[2] = bflo(w[1]); v[3] = bfhi(w[1]); return v; }
DEVI const float* xin_ptr(const P& p, int tok) {
    int b = tok >= TT ? 1 : 0, t = tok - b * TT;
    if (t < TC) return p.ctx + (size_t)(b * TC + t) * DM;
    return p.x + (size_t)(b * TL + t - TC) * DM;
}
DEVI int modsel(int layer, int tok) {
    if (layer == 0) { int b = tok >= TT ? 1 : 0, t = tok - b * TT; return t < TC ? 2 : b; }
    return tok >> 14;
}

DEVI int swz128(int row, int chunk) { return row * 144 + (chunk << 4); }
DEVI int swz256(int row, int chunk) { return row * 272 + (chunk << 4); }
DEVI int v_st(int k, int c) { const int kk = (k & ~0xC) | ((k & 4) << 1) | ((k & 8) >> 1); return ((kk >> 3) * 4 + (c >> 5)) * 512 + ((kk & 7) * 32 + (c & 31)) * 2; }
DEVI int v_rd_base(int lane) { return ((lane & 3) << 3) | (((lane >> 2) & 3) << 6) | (((lane >> 4) & 1) << 5) | (((lane >> 5) & 1) << 8); }
constexpr int v_rd_off(int d0, int ks, int half) { return d0 * 512 + ks * 4096 + half * 2048; }
template <int OFF> DEVI s16x4 tr_read(int vb) {
    s16x4 r; asm volatile("ds_read_b64_tr_b16 %0, %1 offset:%2" : "=&v"(r) : "v"(vb), "i"(OFF) : "memory"); return r;
}
#define PKLH(L, H) (bf16x8){L[0], L[1], L[2], L[3], H[0], H[1], H[2], H[3]}
template <int D0, int KS> DEVI void tr_frag_issue(int vb, s16x4& l, s16x4& h) { l = tr_read<v_rd_off(D0, KS, 0)>(vb); h = tr_read<v_rd_off(D0, KS, 1)>(vb); }
#define LGKM0() do { asm volatile("s_waitcnt lgkmcnt(0)" ::: "memory"); SBAR(); } while (0)

DEVI bf16x8 lds_b128(const char* base, int off) { return *reinterpret_cast<const bf16x8*>(base + off); }

DEVI void pack_p(const f32x16& pp, bf16x8& f0, bf16x8& f1) {
#define PK4(BASE, OUT) do { unsigned a0 = cvtpk(pp[BASE + 0], pp[BASE + 1]), a1 = cvtpk(pp[BASE + 2], pp[BASE + 3]);   \
    unsigned b0 = cvtpk(pp[BASE + 4], pp[BASE + 5]), b1 = cvtpk(pp[BASE + 6], pp[BASE + 7]);                            \
    auto r0 = __builtin_amdgcn_permlane32_swap(a0, b0, false, false); auto r1 = __builtin_amdgcn_permlane32_swap(a1, b1, false, false); \
    u32x4 w = {r0[0], r1[0], r0[1], r1[1]}; OUT = *reinterpret_cast<bf16x8*>(&w); } while (0)
    PK4(0, f0); PK4(8, f1);
#undef PK4
}

DEVI void pack_p_perm(const f32x16& pp, bf16x8& f0, bf16x8& f1) {
    u32x4 a, b;
    a[0] = cvtpk(pp[0], pp[1]); a[1] = cvtpk(pp[2], pp[3]); a[2] = cvtpk(pp[4], pp[5]); a[3] = cvtpk(pp[6], pp[7]);
    b[0] = cvtpk(pp[8], pp[9]); b[1] = cvtpk(pp[10], pp[11]); b[2] = cvtpk(pp[12], pp[13]); b[3] = cvtpk(pp[14], pp[15]);
    f0 = *reinterpret_cast<bf16x8*>(&a); f1 = *reinterpret_cast<bf16x8*>(&b);
}
namespace g8 {
constexpr int BM = 256, BK = 64, HALF = 128, HTB = HALF * BK * 2, STAGE_BYTES = 8 * HTB, NXCD = 8, WGM = 8;
DEVI int lds_byte(int r, int c) { const int st = (r >> 4) * 2 + (c >> 5), rr = r & 15, cc = c & 31, ob = rr * 64 + cc * 2; return st * 1024 + (ob ^ (((ob >> 9) & 1) << 5)); }
DEVI void stage_rc(int b, int& R, int& C) { const int st = b / 1024, sb = b % 1024, swz = sb ^ (((sb >> 9) & 1) << 5); R = (st >> 1) * 16 + swz / 64; C = (st & 1) * 32 + (swz % 64) / 2; }
DEVI int perm32(int rho) { const int n = rho >> 4, i = rho & 15; return 8 * (i >> 2) + 4 * n + (i & 3); }
struct Unit { int pm, pn; const char* B0; const char* B1; int cls, r0, ncls; };
DEVI bool tile_order(int i, int G, int c, int nM, int nN, int& pm, int& pn) {
    const int nwg = nM * nN; const long L = (long)i * G + c; if (L >= nwg) return false;
    int wgid = (int)L; { const int q = nwg / NXCD, r = nwg % NXCD, xcd = wgid % NXCD, off = wgid / NXCD; wgid = (xcd < r ? xcd * (q + 1) : r * (q + 1) + (xcd - r) * q) + off; }
    const int nig = WGM * nN, gid = wgid / nig, fm = gid * WGM, gsz = (nM - fm) < WGM ? (nM - fm) : WGM;
    pm = fm + ((wgid % nig) % gsz); pn = (wgid % nig) / gsz; return true;
}
typedef float f32x4v __attribute__((ext_vector_type(4)));
template <class Epi, class Sched, int NT = 16  , int LDA = 2048  >
DEVI void gemm_phase(LAS unsigned char* lds, const char* Abase, int ldbB  , int ksplit  , const Sched& S, const Epi& E) {
    const int tid = threadIdx.x, wid = __builtin_amdgcn_readfirstlane(tid >> 6), lane = tid & 63, wr = wid >> 2, wc = wid & 3, fr = lane & 15, fq = lane >> 4;
    constexpr int nt = NT;
    unsigned voffB[2];
#pragma unroll
    for (int i = 0; i < 2; ++i) { int R, C; stage_rc(tid * 16 + i * 8192, R, C); const int Rb = Epi::PERM ? ((R & ~31) + perm32(R & 31)) : R; voffB[i] = (unsigned)(Rb * ldbB + C * 2); }
    const size_t kstep = (size_t)(BK * 2);
    const size_t hstepB = (size_t)HALF * ldbB;
    const unsigned ldsw = (unsigned)wid * 1024u;
    const int aoff = lds_byte(wr * 64 + fr, fq * 8), boff = lds_byte(wc * 32 + fr, fq * 8);
#define G8_SA(b, h) (((b) * 2 + (h)) * HTB)
#define G8_SB(b, h) ((4 + (b) * 2 + (h)) * HTB)
#define G8_STAGE(bufoff, gbase, voff) do { _Pragma("unroll") for (int _i = 0; _i < 2; ++_i) \
        __builtin_amdgcn_global_load_lds((const unsigned*)((const char*)(gbase) + (voff)[_i]), (LAS unsigned*)(lds + (bufoff) + ldsw + _i * 8192), 16, 0, 0); } while (0)
#define G8_LDA(dst, b, h) do { _Pragma("unroll") for (int m = 0; m < 4; ++m) _Pragma("unroll") for (int k = 0; k < 2; ++k) dst[m][k] = *(const LAS bf16x8*)(lds + G8_SA(b, h) + aoff + m * 2048 + k * 1024); } while (0)
#define G8_LDB(dst, b, h) do { _Pragma("unroll") for (int n = 0; n < 2; ++n) _Pragma("unroll") for (int k = 0; k < 2; ++k) dst[n][k] = *(const LAS bf16x8*)(lds + G8_SB(b, h) + boff + n * 2048 + k * 1024); } while (0)
#define G8_MMA(ai, bj, At, Bt) do { __builtin_amdgcn_s_setprio(1); _Pragma("unroll") for (int m = 0; m < 4; ++m) _Pragma("unroll") for (int n = 0; n < 2; ++n) _Pragma("unroll") for (int k = 0; k < 2; ++k) \
        acc[ai][bj][m][n] = __builtin_amdgcn_mfma_f32_16x16x32_bf16(Bt[n][k], At[m][k], acc[ai][bj][m][n], 0, 0, 0); __builtin_amdgcn_s_setprio(0); } while (0)
#define G8_WAIT_V(n) asm volatile("s_waitcnt vmcnt(" #n ")" ::: "memory")
#define G8_WAIT_L(n) asm volatile("s_waitcnt lgkmcnt(" #n ")" ::: "memory")
#define G8_BAR __builtin_amdgcn_s_barrier()
#define G8_SCHED __builtin_amdgcn_sched_barrier(0)
#define G8_BPTR(u, kt) (((kt) < ksplit ? (u).B0 : (u).B1) + (size_t)(kt) * kstep)
    Unit cur, nxt; int ui = 0;
    if (!S.next(0, cur)) return;
    f32x4v acc[2][2][4][2];
#pragma unroll
    for (int a = 0; a < 2; ++a)
#pragma unroll
        for (int b = 0; b < 2; ++b)
#pragma unroll
            for (int m = 0; m < 4; ++m)
#pragma unroll
                for (int n = 0; n < 2; ++n) acc[a][b][m][n] = (f32x4v){0.f, 0.f, 0.f, 0.f};
    bf16x8 At[4][2], B0[2][2], B1[2][2];
    unsigned voffA[2]; unsigned vs[2][2];
    constexpr size_t hstepA = (size_t)HALF * LDA, tstepA = 2 * hstepA;
    if constexpr (Sched::GATHER) S.aoffs(cur, vs);
    else {
#pragma unroll
        for (int i = 0; i < 2; ++i) { int R, C; stage_rc(tid * 16 + i * 8192, R, C); voffA[i] = (unsigned)(R * LDA + C * 2); }
    }
    const char* cA = Sched::GATHER ? Abase : S.abase(cur, Abase) + (size_t)cur.pm * tstepA;
#define G8_STAGE_A(bufoff, ptr, h) do { if constexpr (Sched::GATHER) G8_STAGE(bufoff, ptr, vs[h]); else G8_STAGE(bufoff, (ptr) + (h) * hstepA, voffA); } while (0)
    { const char* cB = G8_BPTR(cur, 0); const char* cB1 = G8_BPTR(cur, 1);
      G8_STAGE(G8_SB(0, 0), cB, voffB); G8_STAGE_A(G8_SA(0, 0), cA, 0); G8_STAGE(G8_SB(0, 1), cB + hstepB, voffB); G8_STAGE_A(G8_SA(0, 1), cA, 1);
      if (wr == 1) G8_BAR;
      G8_WAIT_V(4); G8_BAR;
      G8_STAGE(G8_SB(1, 0), cB1, voffB); G8_STAGE_A(G8_SA(1, 0), cA + kstep, 0); G8_STAGE(G8_SB(1, 1), cB1 + hstepB, voffB);
      G8_WAIT_V(6); G8_BAR; }
    for (;;) {
        bool has_next = false; const char* nA = cA;
        for (int t = 0; t < nt; t += 2) {
            const bool last = (t == nt - 2);
            const char* a1 = cA + (size_t)(t + 1) * kstep;
            G8_LDB(B0, 0, 0); G8_SCHED; G8_LDA(At, 0, 0); G8_STAGE_A(G8_SA(1, 1), a1, 1);
            G8_WAIT_L(8); G8_BAR; G8_WAIT_L(0); G8_MMA(0, 0, At, B0); G8_BAR; G8_SCHED;
            if (last) {
                has_next = S.next(ui + 1, nxt);
                if (has_next) { if constexpr (Sched::GATHER) S.aoffs(nxt, vs); else nA = S.abase(nxt, Abase) + (size_t)nxt.pm * tstepA; } else nxt = cur;
            }
            const char* a2 = last ? nA : cA + (size_t)(t + 2) * kstep; const char* a3 = a2 + kstep;
            const char* b2 = last ? G8_BPTR(nxt, 0) : G8_BPTR(cur, t + 2); const char* b3 = last ? G8_BPTR(nxt, 1) : G8_BPTR(cur, t + 3);
            G8_LDB(B1, 0, 1); G8_STAGE(G8_SB(0, 0), b2, voffB);
            G8_BAR; G8_WAIT_L(0); G8_MMA(0, 1, At, B1); G8_BAR;
            G8_LDA(At, 0, 1); G8_STAGE_A(G8_SA(0, 0), a2, 0);
            G8_BAR; G8_WAIT_L(0); G8_MMA(1, 0, At, B0); G8_BAR; G8_SCHED;
            G8_STAGE(G8_SB(0, 1), b2 + hstepB, voffB);
            G8_WAIT_V(6); G8_BAR; G8_MMA(1, 1, At, B1); G8_BAR;
            G8_LDB(B0, 1, 0); G8_SCHED; G8_LDA(At, 1, 0); G8_STAGE_A(G8_SA(0, 1), a2, 1);
            G8_WAIT_L(8); G8_BAR; G8_WAIT_L(0); G8_MMA(0, 0, At, B0); G8_BAR; G8_SCHED;
            G8_LDB(B1, 1, 1); G8_STAGE(G8_SB(1, 0), b3, voffB);
            G8_BAR; G8_WAIT_L(0); G8_MMA(0, 1, At, B1); G8_BAR;
            G8_LDA(At, 1, 1); G8_STAGE_A(G8_SA(1, 0), a3, 0);
            G8_BAR; G8_WAIT_L(0); G8_MMA(1, 0, At, B0); G8_BAR; G8_SCHED;
            G8_STAGE(G8_SB(1, 1), b3 + hstepB, voffB);
            G8_WAIT_V(6); G8_BAR; G8_MMA(1, 1, At, B1); G8_BAR;
        }
        cA = nA;
        { int tz = threadIdx.x; asm volatile("" : "+v"(tz));
          const int w2 = tz >> 6, l2 = tz & 63; E(acc, cur, w2 >> 2, w2 & 3, l2 & 15, l2 >> 4); }
        if (!has_next) break;
#pragma unroll
        for (int a = 0; a < 2; ++a)
#pragma unroll
            for (int b = 0; b < 2; ++b)
#pragma unroll
                for (int m = 0; m < 4; ++m)
#pragma unroll
                    for (int n = 0; n < 2; ++n) acc[a][b][m][n] = (f32x4v){0.f, 0.f, 0.f, 0.f};
        cur = nxt; ++ui;
    }
    G8_WAIT_V(0);
    if (wr == 0) G8_BAR;
    G8_BAR;
#undef G8_SA
#undef G8_SB
#undef G8_STAGE
#undef G8_STAGE_A
#undef G8_LDA
#undef G8_LDB
#undef G8_MMA
#undef G8_WAIT_V
#undef G8_WAIT_L
#undef G8_BAR
#undef G8_SCHED
#undef G8_BPTR
}
DEVI void lane_rc(int i, int& R, int& C) { int tz = threadIdx.x; asm volatile("" : "+v"(tz)); stage_rc(tz * 16 + i * 8192, R, C); }
struct DenseSched {
    static constexpr bool GATHER = false;
    const char* Bt; int nM, nN, G, c; size_t btile;
    DEVI const char* abase(const Unit&, const char* a) const { return a; }
    DEVI bool next(int i, Unit& u) const { if (!tile_order(i, G, c, nM, nN, u.pm, u.pn)) return false; u.B0 = u.B1 = Bt + (size_t)u.pn * btile; u.cls = 0; u.r0 = 0; u.ncls = 0; return true; }
    DEVI void aoffs(const Unit& u, unsigned (&v)[2][2]) const {
#pragma unroll
        for (int i = 0; i < 2; ++i) { int R, C; lane_rc(i, R, C);
#pragma unroll
            for (int h = 0; h < 2; ++h) v[h][i] = (unsigned)(((u.pm * 256 + h * 128 + R) * 1024 + C) * 2); }
    }
};
}

template <class PF>
DEVI void transpose_tile(PF colptr, int ldsrc, u16* dst, int lddst, int k0, int n0, float* tl) {
    const int t = threadIdx.x, nn = t & 63, kk = t >> 6;
    const float* sp = colptr(n0 + nn);
#pragma unroll
    for (int i = 0; i < 8; ++i) tl[(kk + 8 * i) * 65 + nn] = sp[(size_t)(k0 + kk + 8 * i) * ldsrc];
    __syncthreads();
    const int n = t >> 3, kc = t & 7;
    u32x4 w;
    w[0] = cvtpk(tl[(kc * 8 + 0) * 65 + n], tl[(kc * 8 + 1) * 65 + n]);
    w[1] = cvtpk(tl[(kc * 8 + 2) * 65 + n], tl[(kc * 8 + 3) * 65 + n]);
    w[2] = cvtpk(tl[(kc * 8 + 4) * 65 + n], tl[(kc * 8 + 5) * 65 + n]);
    w[3] = cvtpk(tl[(kc * 8 + 6) * 65 + n], tl[(kc * 8 + 7) * 65 + n]);
    *reinterpret_cast<u32x4*>(dst + (size_t)(n0 + n) * lddst + k0 + kc * 8) = w;
    __syncthreads();
}

DEVI void convert_expert_item(const P& p, int layer, int it, float* tl) {
    const int e = it / 384, r = it % 384;
    const float* wg = p.w_gate + ((size_t)layer * 16 + e) * 1024 * 512;
    const float* wu = p.w_up   + ((size_t)layer * 16 + e) * 1024 * 512;
    const float* wd = p.w_down + ((size_t)layer * 16 + e) * 512 * 1024;
    if (r < 256) {
        u16* dst = (u16*)(p.ws + (layer ? OFF_WGU1 : OFF_WGU)) + (size_t)e * 1024 * 1024;
        const int kt = r >> 4, nt = r & 15;
        transpose_tile([&](int n) { const int q = n >> 8, sgu = (n >> 7) & 1, j = n & 127; return (sgu ? wu : wg) + q * 128 + j; }, 512, dst, 1024, kt * 64, nt * 64, tl);
    } else {
        const int q = r - 256; u16* dst = (u16*)(p.ws + (layer ? OFF_WDT1 : OFF_WDT)) + (size_t)e * 1024 * 512;
        const int kt = q >> 4, nt = q & 15;
        transpose_tile([&](int n) { return wd + n; }, 1024, dst, 512, kt * 64, nt * 64, tl);
    }
}

constexpr int N0_WIN = 16 * 56, N0_WOUT = 256, N0_EXP = 16 * 384, N0_FN = 1024, N0_MOD = 192, N0_TAB = 128;
constexpr int N0_TOTAL = N0_WIN + N0_MOD + N0_TAB;
constexpr int NBG = N0_WOUT + N0_FN;
DEVI void bg_item(const P& p, int it, float* tl) {
    const int tid = threadIdx.x;
    int r = it;
    if (r < N0_WOUT) {
        const int kt = r >> 4, nt = r & 15; const float* w = p.w_out;
        transpose_tile([&](int n) { return w + n; }, 1024, (u16*)(p.ws + OFF_WOUTT), 1024, kt * 64, nt * 64, tl);
        return;
    }
    r -= N0_WOUT;
    {
        const int idx = r * 512 + tid, c = idx & 127, g = (idx >> 7) & 3, n = idx >> 9;
        double sd, cd; sincos2pi(c / 256.0, sd, cd);
        const float ct = (float)cd, st = (float)sd;
        const float* W = p.w_fnet + (size_t)(g * 256) * 1024 + n;
        float ac = 0.f, as = 0.f, a128 = 0.f, cr = 1.f, sr = 0.f, sg = 1.f;
        for (int c2 = 0; c2 < 256; ++c2) {
            const float w = W[(size_t)c2 * 1024];
            ac = fmaf(cr, w, ac); as = fmaf(sr, w, as); a128 = fmaf(sg, w, a128); sg = -sg;
            const float cn = cr * ct - sr * st; sr = fmaf(sr, ct, cr * st); cr = cn;
        }
        u16* Ah = (u16*)(p.ws + OFF_FNT); u16* Bh = Ah + (size_t)1024 * 512; float* A128 = (float*)(p.ws + OFF_FNT + (size_t)2 * 1024 * 512 * 2);
        Ah[(size_t)n * 512 + g * 128 + c] = f2bf(ac * (1.f / 2048.f)); Bh[(size_t)n * 512 + g * 128 + c] = f2bf(-as * (1.f / 2048.f));
        if (c == 0) A128[g * 1024 + n] = a128 * (1.f / 2048.f);
    }
}
DEVI void bg_fill(const P& p, char* lds, int q, int lo, int hi) {
    int* sh = (int*)(lds + 32768);
    for (;;) {
        __syncthreads();
        if (threadIdx.x == 0) *sh = lo + 4 * (int)atomicAdd((unsigned*)(p.ws + OFF_CNT) + 160 + q, 1u);
        __syncthreads();
        const int it0 = *sh;
        if (it0 >= hi) break;
        for (int it = it0; it < it0 + 4 && it < hi; ++it) bg_item(p, it, (float*)lds);
    }
    __syncthreads();
}

DEVI void phase_prologue(const P& p, char* lds) {
    float* tl = (float*)lds;
    const int tid = threadIdx.x;
    for (int it = blockIdx.x; it < N0_TOTAL; it += gridDim.x) {
        int r = it;
        if (r < N0_WIN) {
            const int kt = r / 56, nt = r % 56;
            const float* w = p.w_in;
            transpose_tile([&](int n) { return w + n; },
                           3600, (u16*)(p.ws + OFF_WINT), 1024, kt * 64, nt * 64, tl);
            continue;
        }
        r -= N0_WIN;
        if (r < N0_MOD) {
            float* sv = tl;
            float* part = tl + 3072;
            for (int i = tid; i < 3072; i += NTHR) { const int v = i >> 10, k = i & 1023; const float xv = v < 2 ? p.c[v * 1024 + k] : p.c_ctx[k]; sv[i] = siluf_(xv); }
            __syncthreads();
            const int j0 = r * 64, L = j0 / 6144, col0 = j0 % 6144, kg = tid >> 6, cl = tid & 63;
            const float* W = p.ada_w + (size_t)L * 1024 * 6144 + col0 + cl;
            float a0 = 0.f, a1 = 0.f, a2 = 0.f;
            for (int k = kg * 128; k < kg * 128 + 128; ++k) { const float w = W[(size_t)k * 6144]; a0 = fmaf(sv[k], w, a0); a1 = fmaf(sv[1024 + k], w, a1); a2 = fmaf(sv[2048 + k], w, a2); }
            part[(kg * 3 + 0) * 64 + cl] = a0; part[(kg * 3 + 1) * 64 + cl] = a1; part[(kg * 3 + 2) * 64 + cl] = a2;
            __syncthreads();
            if (tid < 192) {
                const int v = tid >> 6, c2 = tid & 63; float s = 0.f;
                for (int g = 0; g < 8; ++g) s += part[(g * 3 + v) * 64 + c2];
                ((float*)(p.ws + OFF_MOD))[(size_t)(L * 3 + v) * 6144 + col0 + c2] = s + p.ada_b[L * 6144 + col0 + c2];
            }
            __syncthreads();
            continue;
        }
        r -= N0_MOD;
        {
            const int e = r * 512 + tid;
            if (e < 4096 + 1024) {
                const bool isr = e < 4096; const int ee = isr ? e : e - 4096; const int pos = ee >> 4, j = ee & 15;
                double inv = 1.0; for (int q = 0; q < j; ++q) inv *= 0.56234132519034908;
                const float invf = (float)inv; const float ang = (float)pos * invf;
                double s, c; sincos2pi((double)ang * 0.15915494309189533577, s, c);
                float2 v = make_float2((float)c, (float)s);
                if (isr) ((float2*)(p.ws + OFF_ROPER))[ee] = v; else ((float2*)(p.ws + OFF_ROPEC))[ee] = v;
            } else if (e < 5120 + 16384) {
                const int m = e - 5120; double s, c; sincos2pi(m / 16384.0, s, c);
                ((float2*)(p.ws + OFF_TW))[m] = make_float2((float)c, (float)s);
            } else if (e < 5120 + 32768) {
                const int m = e - 5120 - 16384, k = m >> 7, t = m & 127; double s, c; sincos2pi(((k * t) & 127) / 128.0, s, c);
                ((u16*)(p.ws + OFF_DFTC))[m] = f2bf((float)c); ((u16*)(p.ws + OFF_DFTS))[m] = f2bf((float)s);
            } else if (e < 5120 + 49152) {
                const int m = e - 5120 - 32768, k = m >> 4, g = m & 15;
                ((float*)(p.ws + OFF_WG16))[m] = p.w_in[(size_t)k * 3600 + 3584 + g];
            } else if (e == 5120 + 49152) {
                float s01 = 0.f, s23 = 0.f;
                for (int i = 0; i < 64; ++i) { s01 += p.lamv[i] * p.lamv[64 + i]; s23 += p.lamv[128 + i] * p.lamv[192 + i]; }
                ((float*)(p.ws + OFF_LAM))[0] = expf(s01) - expf(s23) + 0.2f;
            }
        }
    }
}

template <int MODE, bool DRY = false>
DEVI void phase_norm(const P& p, char* lds) {
    constexpr int layer = (MODE == 0 || MODE == 1) ? 0 : 1;
    constexpr bool side = (MODE == 0 || MODE == 1 || MODE == 3);
    const int nrows = layer == 0 ? NTOK : NLAT;
    const int tid = threadIdx.x, lane = tid & 63, wid = __builtin_amdgcn_readfirstlane(tid >> 6);
    f32x4* sl = (f32x4*)lds;
    if (side) {
        const float* S = (MODE == 0) ? (const float*)(p.ws + OFF_WG16) : p.router_w;
        for (int i = tid; i < 4096; i += NTHR) { const int eg = i >> 10, col = i & 1023; const int pc = (col >> 8) * 256 + (col & 3) * 64 + ((col >> 2) & 63);
            sl[eg * 1024 + pc] = *reinterpret_cast<const f32x4*>(S + col * 16 + eg * 4); }
        __syncthreads();
    }
    const float* g = MODE == 0 ? p.nmix_g : MODE == 1 ? p.nffn_g : MODE == 2 ? p.nmix_g + 1024 : MODE == 3 ? p.nffn_g + 1024 : p.final_g;
    const float* modb = (const float*)(p.ws + OFF_MOD) + (size_t)layer * 3 * 6144;
    constexpr int sh_i = (MODE == 0 || MODE == 2) ? 0 : 3;
    u16* act = (u16*)(p.ws + OFF_ACT);
    int npend = 0, pcls = 0, prow = 0; float pwl = 0.f, pwh = 0.f; float keep[16];
#pragma unroll
    for (int e = 0; e < 16; ++e) keep[e] = 0.f;
    const int c0 = 4 * lane;
    const int rstep = gridDim.x * 8;
    float A[16], B[16]; int cur_ms = -1;
#pragma unroll
    for (int e = 0; e < 16; ++e) { A[e] = 0.f; B[e] = 0.f; }
    if (MODE == 4) {
#pragma unroll
        for (int i = 0; i < 4; ++i) { const f32x4 gv = *reinterpret_cast<const f32x4*>(g + c0 + 256 * i); A[4 * i] = gv[0]; A[4 * i + 1] = gv[1]; A[4 * i + 2] = gv[2]; A[4 * i + 3] = gv[3]; }
    }
    const int my_e = ((lane >> 2) & 1) * 8 + ((lane >> 1) & 1) * 4 + (lane & 1) * 2 + ((lane >> 3) & 1);
    float my_gb = 0.f; if (MODE == 0) my_gb = p.gate_b[my_e];
    f32x4 xfA[4], xfB[4]; u32x2 xbA[4], xbB[4];
#define NORM_REQ(R, XF, XB) do { if (MODE == 0) { const float* src_ = xin_ptr(p, (R)); _Pragma("unroll") for (int i = 0; i < 4; ++i) XF[i] = *reinterpret_cast<const f32x4*>(src_ + c0 + 256 * i); } \
        else { const u16* src_ = xs_ptr(p, layer, (R)); _Pragma("unroll") for (int i = 0; i < 4; ++i) XB[i] = *reinterpret_cast<const u32x2*>(src_ + c0 + 256 * i); } } while (0)
    const int row0 = blockIdx.x * 8 + wid;
    NORM_REQ(row0, xfA, xbA);
    NORM_REQ(row0 + rstep, xfB, xbB);
    auto body = [&](const int row, f32x4 (&xf)[4], u32x2 (&xb)[4]) __attribute__((always_inline)) {
        f32x4 xv[4]; float ss = 0.f;
#pragma unroll
        for (int i = 0; i < 4; ++i) xv[i] = (MODE == 0) ? xf[i] : bf4_to_f32(xb[i]);
        { const int nrow = min(row + 2 * rstep, nrows - 1); NORM_REQ(nrow, xf, xb); }
        f32x4 wq[2][8];
        if (side) {
#pragma unroll
            for (int jj = 0; jj < 2; ++jj)
#pragma unroll
                for (int eg = 0; eg < 4; ++eg) wq[0][jj * 4 + eg] = sl[eg * 1024 + jj * 64 + lane];
        }
#pragma unroll
        for (int i = 0; i < 4; ++i) { ss = fmaf(xv[i][0], xv[i][0], ss); ss = fmaf(xv[i][1], xv[i][1], ss); ss = fmaf(xv[i][2], xv[i][2], ss); ss = fmaf(xv[i][3], xv[i][3], ss); }
        ss = x4row_sum(row16_sum(ss));
        const float rstd = rsqrtf(ss * (1.f / 1024.f) + 1e-6f);
        if (MODE == 4) {
            float* dst = p.out + (size_t)row * DM;
#pragma unroll
            for (int i = 0; i < 4; ++i) { f32x4 o; o[0] = xv[i][0] * rstd * A[4 * i]; o[1] = xv[i][1] * rstd * A[4 * i + 1]; o[2] = xv[i][2] * rstd * A[4 * i + 2]; o[3] = xv[i][3] * rstd * A[4 * i + 3];
                *reinterpret_cast<f32x4*>(dst + c0 + 256 * i) = o; }
            return;
        }
        const int ms = modsel(layer, row);
        if (ms != cur_ms) {
            cur_ms = ms;
            const float* mv = modb + (size_t)ms * 6144;
#pragma unroll
            for (int i = 0; i < 4; ++i) {
                const f32x4 gv = *reinterpret_cast<const f32x4*>(g + c0 + 256 * i), scv = *reinterpret_cast<const f32x4*>(mv + (sh_i + 1) * 1024 + c0 + 256 * i),
                            shv = *reinterpret_cast<const f32x4*>(mv + sh_i * 1024 + c0 + 256 * i);
#pragma unroll
                for (int j = 0; j < 4; ++j) { A[4 * i + j] = gv[j] * (1.f + scv[j]); B[4 * i + j] = shv[j]; }
            }
            __builtin_amdgcn_s_waitcnt(0x0F70);
        }
        if (MODE == 2) {
            f32x4 h[4];
#pragma unroll
            for (int i = 0; i < 4; ++i)
#pragma unroll
                for (int j = 0; j < 4; ++j) h[i][j] = fmaf(xv[i][j] * rstd, A[4 * i + j], B[4 * i + j]);
#pragma unroll
            for (int i = 0; i < 4; ++i) {
                const float p0 = __shfl(h[i][0], (64 - lane) & 63), p1 = __shfl(h[i][3], 63 - lane), p2 = __shfl(h[i][2], 63 - lane), p3 = __shfl(h[i][1], 63 - lane), h128 = __shfl(h[i][0], 32);
                const float u0 = lane == 0 ? h[i][0] : h[i][0] + p0, v0 = lane == 0 ? h128 : h[i][0] - p0;
                if (lane < 32) {
                    u32x2 wu, wv; wu[0] = cvtpk(u0, h[i][1] + p1); wu[1] = cvtpk(h[i][2] + p2, h[i][3] + p3); wv[0] = cvtpk(v0, h[i][1] - p1); wv[1] = cvtpk(h[i][2] - p2, h[i][3] - p3);
                    *reinterpret_cast<u32x2*>((u16*)(p.ws + OFF_ACT) + (size_t)row * 512 + i * 128 + c0) = wu;
                    *reinterpret_cast<u32x2*>((u16*)(p.ws + OFF_ACT) + (size_t)NLAT * 512 + (size_t)row * 512 + i * 128 + c0) = wv;
                }
            }
            return;
        }
        f32x2 acc2[8];
#pragma unroll
        for (int e = 0; e < 8; ++e) { acc2[e][0] = 0.f; acc2[e][1] = 0.f; }
#pragma unroll
        for (int i = 0; i < 4; ++i) {
            f32x4 h;
#pragma unroll
            for (int j = 0; j < 4; ++j) h[j] = fmaf(xv[i][j] * rstd, A[4 * i + j], B[4 * i + j]);
            { u32x2 w2; w2[0] = cvtpk(h[0], h[1]); w2[1] = cvtpk(h[2], h[3]); *reinterpret_cast<u32x2*>(act + (size_t)row * DM + c0 + 256 * i) = w2; }
            if (side) {
#pragma unroll
                for (int jp = 0; jp < 2; ++jp) {
                    const int gi = i * 2 + jp;
                    if (gi + 1 < 8) {
#pragma unroll
                        for (int jj = 0; jj < 2; ++jj)
#pragma unroll
                            for (int eg = 0; eg < 4; ++eg) wq[(gi + 1) & 1][jj * 4 + eg] = sl[eg * 1024 + ((gi + 1) >> 1) * 256 + (((gi + 1) & 1) * 2 + jj) * 64 + lane];
                    }
                    asm volatile("" ::: "memory");
#pragma unroll
                    for (int jj = 0; jj < 2; ++jj) {
                        f32x2 hh; hh[0] = h[jp * 2 + jj]; hh[1] = hh[0];
#pragma unroll
                        for (int eg = 0; eg < 4; ++eg) { const f32x4 w = wq[gi & 1][jj * 4 + eg]; f32x2 wl, wh; wl[0] = w[0]; wl[1] = w[1]; wh[0] = w[2]; wh[1] = w[3];
                            acc2[eg * 2] = hh * wl + acc2[eg * 2]; acc2[eg * 2 + 1] = hh * wh + acc2[eg * 2 + 1]; }
                    }
                    asm volatile("" : "+v"(acc2[0]), "+v"(acc2[1]), "+v"(acc2[2]), "+v"(acc2[3]), "+v"(acc2[4]), "+v"(acc2[5]), "+v"(acc2[6]), "+v"(acc2[7]) :: "memory");
                }
            }
        }
        if (side) {
            float acc[16];
#pragma unroll
            for (int e = 0; e < 8; ++e) { acc[2 * e] = acc2[e][0]; acc[2 * e + 1] = acc2[e][1]; }
            float r8[8], r4[4], r2[2], tot;
            { const bool up = lane & 4;
#pragma unroll
              for (int i = 0; i < 8; ++i) { const float snd = up ? acc[i] : acc[i + 8], kp = up ? acc[i + 8] : acc[i]; r8[i] = kp + dppmov<0x141>(snd); } }
            { const bool up = lane & 2;
#pragma unroll
              for (int i = 0; i < 4; ++i) { const float snd = up ? r8[i] : r8[i + 4], kp = up ? r8[i + 4] : r8[i]; r4[i] = kp + dppmov<0x4E>(snd); } }
            { const bool up = lane & 1;
#pragma unroll
              for (int i = 0; i < 2; ++i) { const float snd = up ? r4[i] : r4[i + 2], kp = up ? r4[i + 2] : r4[i]; r2[i] = kp + dppmov<0xB1>(snd); } }
            { const bool up = lane & 8; const float snd = up ? r2[0] : r2[1], kp = up ? r2[1] : r2[0]; tot = kp + dppmov<0x128>(snd); }
            tot = x4row_sum(tot);
            if (MODE == 0) {
                if (lane < 16) {
                    float v = tot + my_gb;
                    const int type = my_e >> 2;
                    if (type == 1 || type == 3) v = logsigmoidf_(v);
                    ((float*)(p.ws + OFF_GATES))[(size_t)row * 16 + my_e] = v;
                }
            } else {
#pragma unroll
                for (int e = 0; e < 16; ++e) { constexpr int dummy = 0; (void)dummy; const int L = ((e >> 3) & 1) * 4 + ((e >> 2) & 1) * 2 + ((e >> 1) & 1) + (e & 1) * 8;
                    const float te = __uint_as_float(__builtin_amdgcn_readlane(__float_as_uint(tot), L)); keep[e] = (lane == npend) ? te : keep[e]; }
                if (lane == npend) prow = row;
                ++npend;
            }
        }
    };
    body(row0, xfA, xbA); body(row0 + rstep, xfB, xbB);
    int row = row0 + 2 * rstep;
    for (; row + rstep < nrows; row += 2 * rstep) { body(row, xfA, xbA); body(row + rstep, xfB, xbB); }
    if (row < nrows) body(row, xfA, xbA);
#undef NORM_REQ
    if (MODE == 1 || MODE == 3) {
        {
            float aff[16], bi[16];
#pragma unroll
            for (int e = 0; e < 16; ++e) { aff[e] = sigmoidf_(keep[e]); bi[e] = aff[e] + p.router_b[e]; }
            int bg = 0, ba = 0, bb = 1; float bscore = -1e30f;
#pragma unroll
            for (int gq = 0; gq < 4; ++gq) {
                int ia = 0; float va = bi[gq * 4];
#pragma unroll
                for (int j = 1; j < 4; ++j) if (bi[gq * 4 + j] > va) { va = bi[gq * 4 + j]; ia = j; }
                int ib = -1; float vb = -1e30f;
#pragma unroll
                for (int j = 0; j < 4; ++j) if (j != ia && bi[gq * 4 + j] > vb) { vb = bi[gq * 4 + j]; ib = j; }
                const float sc = va + vb;
                if (sc > bscore) { bscore = sc; bg = gq; ba = ia; bb = ib; }
            }
            const int lo = ba < bb ? ba : bb, hi2 = ba < bb ? bb : ba;
            float alo = 0.f, ahi = 0.f;
#pragma unroll
            for (int e = 0; e < 16; ++e) { if (e == bg * 4 + lo) alo = aff[e]; if (e == bg * 4 + hi2) ahi = aff[e]; }
            const float inv = 1.f / (alo + ahi);
            const int pair = lo == 0 ? hi2 - 1 : (lo == 1 ? hi2 + 1 : 5);
            pcls = bg * 6 + pair; pwl = alo * inv; pwh = ahi * inv;
        }
        unsigned* lc = (unsigned*)(lds + 65536);
        __syncthreads();
        if (tid < 64) lc[tid] = 0u;
        __syncthreads();
        unsigned myrank = 0u;
        if (lane < npend) myrank = atomicAdd(&lc[pcls], 1u);
        __syncthreads();
        if (tid < 24) { unsigned* cnt = (unsigned*)(p.ws + OFF_CNT) + (DRY ? 2 : layer) * 32; const unsigned n = lc[tid]; lc[32 + tid] = n ? atomicAdd(&cnt[tid], n) : 0u; }
        __syncthreads();
        if (lane < npend) {
            ((int*)(p.ws + (DRY ? OFF_BIG : OFF_LIST)))[(size_t)pcls * NTOK + lc[32 + pcls] + myrank] = prow;
            ((float2*)(p.ws + (DRY ? OFF_BIG + (size_t)32 * NTOK * 4 : OFF_TOKW)))[prow] = make_float2(pwl, pwh);
        }
    }
}

using g8::f32x4v;
DEVI u32x4 pack8(const f32x4v& a, const f32x4v& b) { u32x4 w; w[0] = cvtpk(a[0], a[1]); w[1] = cvtpk(a[2], a[3]); w[2] = cvtpk(b[0], b[1]); w[3] = cvtpk(b[2], b[3]); return w; }

struct EpiInproj {
    static constexpr bool PERM = true;
    char* ws;
    DEVI void operator()(const f32x4v (&acc)[2][2][4][2], const g8::Unit& u, int wr, int wc, int fr, int fq) const {
        u16* dst; int ld, coff, kind;
        const int pn = u.pn;
        if (pn < 2)       { dst = (u16*)(ws + OFF_Q);    ld = 512;  coff = pn * 256;        kind = 1; }
        else if (pn < 4)  { dst = (u16*)(ws + OFF_K);    ld = 512;  coff = (pn - 2) * 256;  kind = 1; }
        else if (pn < 6)  { dst = (u16*)(ws + OFF_V);    ld = 512;  coff = (pn - 4) * 256;  kind = 0; }
        else if (pn < 10) { dst = (u16*)(ws + OFF_MLQK); ld = 1024; coff = (pn - 6) * 256;  kind = 0; }
        else if (pn < 12) { dst = (u16*)(ws + OFF_MLV);  ld = 512;  coff = (pn - 10) * 256; kind = 0; }
        else              { dst = (u16*)(ws + OFF_OG);   ld = 512;  coff = (pn - 12) * 256; kind = 2; }
        const int tb = u.pm % 65;
        const float2* tabR = (const float2*)(ws + OFF_ROPER); const float2* tabC = (const float2*)(ws + OFF_ROPEC);
#pragma unroll
        for (int ai = 0; ai < 2; ++ai)
#pragma unroll
            for (int m = 0; m < 4; ++m) {
                const int rl = ai * 128 + wr * 64 + m * 16 + fr;
                u16* rowp = dst + (size_t)(u.pm * 256 + rl) * ld + coff + wc * 32 + 8 * fq;
#pragma unroll
                for (int bj = 0; bj < 2; ++bj) {
                    f32x4v v0 = acc[ai][bj][m][0], v1 = acc[ai][bj][m][1];
                    if (kind == 1 && tb > 0) {
                        const int tl = (tb - 1) * 256 + rl;
                        const int p0 = ((wc * 32 + 8 * fq) & 63) >> 1;
                        const float* cs = (const float*)(p0 < 16 ? tabR + (tl >> 6) * 16 + p0 : tabC + (tl & 63) * 16 + (p0 - 16));
                        const f32x4v c01 = *reinterpret_cast<const f32x4v*>(cs), c23 = *reinterpret_cast<const f32x4v*>(cs + 4);
                        const f32x4v a = v0, b = v1;
                        v0[0] = a[0] * c01[0] - a[1] * c01[1]; v0[1] = a[0] * c01[1] + a[1] * c01[0];
                        v0[2] = a[2] * c01[2] - a[3] * c01[3]; v0[3] = a[2] * c01[3] + a[3] * c01[2];
                        v1[0] = b[0] * c23[0] - b[1] * c23[1]; v1[1] = b[0] * c23[1] + b[1] * c23[0];
                        v1[2] = b[2] * c23[2] - b[3] * c23[3]; v1[3] = b[2] * c23[3] + b[3] * c23[2];
                    } else if (kind == 2) {
#pragma unroll
                        for (int j = 0; j < 4; ++j) { v0[j] = sigmoidf_(v0[j]); v1[j] = sigmoidf_(v1[j]); }
                    }
                    *reinterpret_cast<u32x4*>(rowp + bj * 128) = pack8(v0, v1);
                }
            }
    }
};
DEVI void phase_inproj(const P& p, char* lds) {
    __syncthreads();
    g8::DenseSched S{p.ws + OFF_WINT, NTOK / 256, 14, (int)gridDim.x, (int)blockIdx.x, (size_t)256 * 2048};
    EpiInproj E{p.ws};
    g8::gemm_phase((LAS unsigned char*)lds, p.ws + OFF_ACT, 2048, 16, S, E);
}

struct EpiOutproj {
    static constexpr bool PERM = true;
    const float* xin_lat; const float* xin_ctx; u16* xs; const float* modb;
    DEVI void operator()(const f32x4v (&acc)[2][2][4][2], const g8::Unit& u, int wr, int wc, int fr, int fq) const {
        const int b = u.pm / 65, tb = u.pm % 65;
        const float* xi = tb == 0 ? xin_ctx + (size_t)(b * TC) * DM : xin_lat + (size_t)(b * TL + (tb - 1) * 256) * DM;
        u16* xo = xs + (size_t)(u.pm * 256) * DM;
        const float* gate = modb + (size_t)(tb == 0 ? 2 : b) * 6144 + 2 * 1024;
        const int col0 = u.pn * 256 + wc * 32 + 8 * fq;
        f32x4v gv[2][2];
#pragma unroll
        for (int bj = 0; bj < 2; ++bj)
#pragma unroll
            for (int n = 0; n < 2; ++n) gv[bj][n] = *reinterpret_cast<const f32x4v*>(gate + col0 + bj * 128 + n * 4);
#pragma unroll
        for (int ai = 0; ai < 2; ++ai) {
            f32x4v xv[4][2][2];
#pragma unroll
            for (int m = 0; m < 4; ++m) { const size_t ro = (size_t)(ai * 128 + wr * 64 + m * 16 + fr) * DM + col0;
#pragma unroll
                for (int bj = 0; bj < 2; ++bj)
#pragma unroll
                    for (int n = 0; n < 2; ++n) xv[m][bj][n] = *reinterpret_cast<const f32x4v*>(xi + ro + bj * 128 + n * 4); }
#pragma unroll
            for (int m = 0; m < 4; ++m) { const size_t ro = (size_t)(ai * 128 + wr * 64 + m * 16 + fr) * DM + col0;
#pragma unroll
                for (int bj = 0; bj < 2; ++bj)
                    *reinterpret_cast<u32x4*>(xo + ro + bj * 128) = pack8(xv[m][bj][0] + gv[bj][0] * acc[ai][bj][m][0], xv[m][bj][1] + gv[bj][1] * acc[ai][bj][m][1]); }
        }
    }
};
DEVI void phase_outproj(const P& p, char* lds) {
    __syncthreads();
    g8::DenseSched S{p.ws + OFF_WOUTT, NTOK / 256, 4, (int)gridDim.x, (int)blockIdx.x, (size_t)256 * 2048};
    EpiOutproj E{p.x, p.ctx, (u16*)(p.ws + OFF_MLC), (const float*)(p.ws + OFF_MOD)};
    g8::gemm_phase((LAS unsigned char*)lds, p.ws + OFF_ACT, 2048, 16, S, E);
}

DEVI int moe_table(const P& p, int layer, int* tb) {
    __syncthreads();
    if (threadIdx.x == 0) {
        const unsigned* cnt = (const unsigned*)(p.ws + OFF_CNT) + layer * 32; int o = 0;
        for (int c = 0; c < 24; ++c) { tb[c] = o; tb[32 + c] = (int)cnt[c]; o += ((int)cnt[c] + 255) >> 8; }
        tb[24] = o;
    }
    __syncthreads();
    return tb[24];
}
DEVI void cls_experts(int cls, int& elo, int& ehi) {
    const int g = cls / 6, pr = cls % 6;
    const int lo = pr < 3 ? 0 : (pr < 5 ? 1 : 2); const int hi = pr < 3 ? pr + 1 : (pr < 5 ? pr - 1 : 3);
    elo = g * 4 + lo; ehi = g * 4 + hi;
}
DEVI void moe_unit(const int* tb, int rt, g8::Unit& u) {
    int cls = 0; while (cls < 23 && tb[cls + 1] <= rt) ++cls;
    u.cls = cls; u.r0 = (rt - tb[cls]) * 256; u.ncls = tb[32 + cls];
}

struct MoeUpSched {
    static constexpr bool GATHER = true;
    DEVI const char* abase(const g8::Unit&, const char* a) const { return a; }
    const int* tb; int T, G, c; const int* list; const char* Wgu;
    DEVI bool next(int i, g8::Unit& u) const {
        if (!g8::tile_order(i, G, c, T, 8, u.pm, u.pn)) return false;
        moe_unit(tb, u.pm, u); int elo, ehi; cls_experts(u.cls, elo, ehi);
        const int e = u.pn < 4 ? elo : ehi;
        u.B0 = u.B1 = Wgu + ((size_t)e * 1024 + (size_t)(u.pn & 3) * 256) * 2048; return true;
    }
    DEVI void aoffs(const g8::Unit& u, unsigned (&v)[2][2]) const {
        const int* lst = list + (size_t)u.cls * NTOK + u.r0;
#pragma unroll
        for (int i = 0; i < 2; ++i) { int R, C; g8::lane_rc(i, R, C);
#pragma unroll
            for (int h = 0; h < 2; ++h) { const int rr = h * 128 + R; const int tok = lst[(u.r0 + rr < u.ncls) ? rr : 0]; v[h][i] = (unsigned)((tok * 1024 + C) * 2); } }
    }
};
struct EpiMoeUp {
    static constexpr bool PERM = true;
    const int* list; const float2* tokw; u16* HE;
    DEVI void operator()(const f32x4v (&acc)[2][2][4][2], const g8::Unit& u, int wr, int wc, int fr, int fq) const {
        const int* lst = list + (size_t)u.cls * NTOK + u.r0;
        const int s = u.pn >> 2;
        float wv[2][4];
        { int tk[2][4];
#pragma unroll
          for (int ai = 0; ai < 2; ++ai)
#pragma unroll
              for (int m = 0; m < 4; ++m) { const int rl = ai * 128 + wr * 64 + m * 16 + fr; tk[ai][m] = lst[(u.r0 + rl < u.ncls) ? rl : 0]; }
#pragma unroll
          for (int ai = 0; ai < 2; ++ai)
#pragma unroll
              for (int m = 0; m < 4; ++m) { const float2 w2 = tokw[tk[ai][m]]; wv[ai][m] = s ? w2.y : w2.x; } }
#pragma unroll
        for (int ai = 0; ai < 2; ++ai)
#pragma unroll
            for (int m = 0; m < 4; ++m) {
                const int rl = ai * 128 + wr * 64 + m * 16 + fr;
                if (u.r0 + rl < u.ncls) {
                    const float w = wv[ai][m];
                    u16* rowp = HE + (size_t)(u.pm * 256 + rl) * 1024 + s * 512 + (u.pn & 3) * 128 + wc * 32 + 8 * fq;
                    f32x4v h0, h1;
#pragma unroll
                    for (int j = 0; j < 4; ++j) { h0[j] = siluf_(acc[ai][0][m][0][j]) * acc[ai][1][m][0][j] * w; h1[j] = siluf_(acc[ai][0][m][1][j]) * acc[ai][1][m][1][j] * w; }
                    *reinterpret_cast<u32x4*>(rowp) = pack8(h0, h1);
                }
            }
    }
};
DEVI void phase_moe_up(const P& p, int layer, char* lds) {
    int* tb = (int*)(lds + g8::STAGE_BYTES);
    const int T = moe_table(p, layer, tb);
    MoeUpSched S{tb, T, (int)gridDim.x, (int)blockIdx.x, (const int*)(p.ws + OFF_LIST), p.ws + (layer ? OFF_WGU1 : OFF_WGU)};
    EpiMoeUp E{(const int*)(p.ws + OFF_LIST), (const float2*)(p.ws + OFF_TOKW), (u16*)(p.ws + OFF_HE)};
    g8::gemm_phase((LAS unsigned char*)lds, p.ws + OFF_ACT, 2048, 16, S, E);
}

struct MoeDownSched {
    static constexpr bool GATHER = false;
    DEVI const char* abase(const g8::Unit&, const char* a) const { return a; }
    const int* tb; int T, G, c; const char* WdT;
    DEVI bool next(int i, g8::Unit& u) const {
        if (!g8::tile_order(i, G, c, T, 4, u.pm, u.pn)) return false;
        moe_unit(tb, u.pm, u); int elo, ehi; cls_experts(u.cls, elo, ehi);
        u.B0 = WdT + ((size_t)elo * 1024 + (size_t)u.pn * 256) * 1024;
        u.B1 = WdT + ((size_t)ehi * 1024 + (size_t)u.pn * 256) * 1024 - (size_t)8 * 128; return true;
    }
    DEVI void aoffs(const g8::Unit& u, unsigned (&v)[2][2]) const {
#pragma unroll
        for (int i = 0; i < 2; ++i) { int R, C; g8::lane_rc(i, R, C);
#pragma unroll
            for (int h = 0; h < 2; ++h) v[h][i] = (unsigned)(((u.pm * 256 + h * 128 + R) * 1024 + C) * 2); }
    }
};
template <bool DRY>
struct EpiMoeDown {
    static constexpr bool PERM = true;
    const P* pp; int layer; const int* list; const float* modb;
    DEVI void operator()(const f32x4v (&acc)[2][2][4][2], const g8::Unit& u, int wr, int wc, int fr, int fq) const {
        const P& p = *pp;
        const int* lst = list + (size_t)u.cls * NTOK + u.r0;
        const int col0 = u.pn * 256 + wc * 32 + 8 * fq;
        int tk[2][4];
#pragma unroll
        for (int ai = 0; ai < 2; ++ai)
#pragma unroll
            for (int m = 0; m < 4; ++m) { const int rl = ai * 128 + wr * 64 + m * 16 + fr; tk[ai][m] = (u.r0 + rl < u.ncls) ? lst[rl] : -1; }
#pragma unroll
        for (int ai = 0; ai < 2; ++ai)
#pragma unroll
        for (int mh = 0; mh < 2; ++mh) {
            u32x4 xw[2][2]; f32x4v gv[2][2][2];
#pragma unroll
            for (int mm = 0; mm < 2; ++mm) { const int m = mh * 2 + mm; const int tok = tk[ai][m] < 0 ? lst[0] : tk[ai][m];
                const float* gate = modb + (size_t)modsel(layer, tok) * 6144 + 5 * 1024 + col0; const u16* xo = xs_ptr(p, layer, tok) + col0;
#pragma unroll
                for (int bj = 0; bj < 2; ++bj) { xw[mm][bj] = *reinterpret_cast<const u32x4*>(xo + bj * 128);
#pragma unroll
                    for (int n = 0; n < 2; ++n) gv[mm][bj][n] = *reinterpret_cast<const f32x4v*>(gate + bj * 128 + n * 4); } }
#pragma unroll
            for (int mm = 0; mm < 2; ++mm) { const int m = mh * 2 + mm; if (tk[ai][m] >= 0) { const int tok = tk[ai][m];
                u16* xd = DRY ? (u16*)(p.ws + OFF_MLQK) + (size_t)(tok & 8191) * 1024 + col0 : xs_ptr(p, layer, tok) + col0;
#pragma unroll
                for (int bj = 0; bj < 2; ++bj) {
                    f32x4v x0, x1; x0[0] = bflo(xw[mm][bj][0]); x0[1] = bfhi(xw[mm][bj][0]); x0[2] = bflo(xw[mm][bj][1]); x0[3] = bfhi(xw[mm][bj][1]);
                    x1[0] = bflo(xw[mm][bj][2]); x1[1] = bfhi(xw[mm][bj][2]); x1[2] = bflo(xw[mm][bj][3]); x1[3] = bfhi(xw[mm][bj][3]);
                    *reinterpret_cast<u32x4*>(xd + bj * 128) = pack8(x0 + gv[mm][bj][0] * acc[ai][bj][m][0], x1 + gv[mm][bj][1] * acc[ai][bj][m][1]); } } }
        }
    }
};
template <bool DRY = false>
DEVI void phase_moe_down(const P& p, int layer, char* lds) {
    int* tb = (int*)(lds + g8::STAGE_BYTES);
    const int T = moe_table(p, layer, tb);
    MoeDownSched S{tb, T, (int)gridDim.x, (int)blockIdx.x, p.ws + (layer ? OFF_WDT1 : OFF_WDT)};
    EpiMoeDown<DRY> E{&p, layer, (const int*)(p.ws + OFF_LIST), (const float*)(p.ws + OFF_MOD) + (size_t)layer * 3 * 6144};
    g8::gemm_phase((LAS unsigned char*)lds, p.ws + OFF_HE, 1024, 8, S, E);
}

constexpr size_t OFF_FU = OFF_ACT, OFF_FV = OFF_ACT + (size_t)NLAT * 512 * 2;
constexpr size_t OFF_FAH = OFF_FNT, OFF_FBH = OFF_FNT + (size_t)1024 * 512 * 2, OFF_FA128 = OFF_FNT + (size_t)2 * 1024 * 512 * 2;
struct FnetSched {
    static constexpr bool GATHER = false;
    const char* ws; int G, c;
    DEVI const char* abase(const g8::Unit& u, const char*) const { return ws + (u.pn < 4 ? OFF_FU : OFF_FV); }
    DEVI bool next(int i, g8::Unit& u) const {
        if (!g8::tile_order(i, G, c, NLAT / 256, 8, u.pm, u.pn)) return false;
        u.B0 = u.B1 = ws + (u.pn < 4 ? OFF_FAH : OFF_FBH) + (size_t)(u.pn & 3) * 256 * 1024; u.cls = 0; u.r0 = 0; u.ncls = 0; return true;
    }
    DEVI void aoffs(const g8::Unit&, unsigned (&)[2][2]) const {}
};
struct EpiFnet {
    static constexpr bool PERM = true;
    char* ws;
    DEVI void operator()(const f32x4v (&acc)[2][2][4][2], const g8::Unit& u, int wr, int wc, int fr, int fq) const {
        const int colt = (u.pn & 3) * 256 + wc * 32 + 8 * fq;
        u16* dst = (u16*)(ws + (u.pn < 4 ? OFF_ZR : OFF_ZI)) + colt;
        const u16* V = (const u16*)(ws + OFF_FV); const float* A128 = (const float*)(ws + OFF_FA128);
#pragma unroll
        for (int bj = 0; bj < 2; ++bj) {
            f32x4v a128[4][2];
            if (u.pn < 4) {
#pragma unroll
                for (int g = 0; g < 4; ++g) { a128[g][0] = *reinterpret_cast<const f32x4v*>(A128 + g * 1024 + colt + bj * 128); a128[g][1] = *reinterpret_cast<const f32x4v*>(A128 + g * 1024 + colt + bj * 128 + 4); }
            }
#pragma unroll
            for (int ai = 0; ai < 2; ++ai)
#pragma unroll
                for (int m = 0; m < 4; ++m) {
                    const size_t row = (size_t)(u.pm * 256 + ai * 128 + wr * 64 + m * 16 + fr);
                    f32x4v v0 = acc[ai][bj][m][0], v1 = acc[ai][bj][m][1];
                    if (u.pn < 4) {
#pragma unroll
                        for (int g = 0; g < 4; ++g) { const float hv = bf2f(V[row * 512 + g * 128]); v0 += a128[g][0] * hv; v1 += a128[g][1] * hv; }
                    }
                    *reinterpret_cast<u32x4*>(dst + row * 1024 + bj * 128) = pack8(v0, v1);
                }
        }
    }
};
DEVI void phase_fnet_gemm(const P& p, char* lds) {
    __syncthreads();
    FnetSched S{p.ws, (int)gridDim.x, (int)blockIdx.x};
    EpiFnet E{p.ws};
    g8::gemm_phase<EpiFnet, FnetSched, 8, 1024>((LAS unsigned char*)lds, p.ws, 1024, 8, S, E);
}

template <class RP>
DEVI void stage_tr128_load(RP rp, u32x4 (&v)[4]) {
    const int tid = threadIdx.x;
#pragma unroll
    for (int i = 0; i < 4; ++i) { const int idx = tid + 512 * i, k = idx >> 4, c = (idx & 15) * 8; v[i] = *reinterpret_cast<const u32x4*>(rp(k) + c); }
}
DEVI void stage_tr128_write(const u32x4 (&v)[4], char* img) {
    const int tid = threadIdx.x;
#pragma unroll
    for (int i = 0; i < 4; ++i) { const int idx = tid + 512 * i, k = idx >> 4, c = (idx & 15) * 8; *reinterpret_cast<u32x4*>(img + (k >> 6) * 16384 + v_st(k & 63, c)) = v[i]; }
}
DEVI void load_dft(const P& p, char* lds) {
    const int tid = threadIdx.x;
    for (int i = tid; i < 4096; i += NTHR) {
        const int m = i >> 11, j = i & 2047, row = j >> 4, ch = j & 15;
        const u32x4 v = *reinterpret_cast<const u32x4*>((const u16*)(p.ws + (m ? OFF_DFTS : OFF_DFTC)) + row * 128 + ch * 8);
        *reinterpret_cast<u32x4*>(lds + m * 34816 + swz256(row, ch)) = v;
    }
}
DEVI bf16x8 negbf(bf16x8 v) { u32x4 w = *reinterpret_cast<u32x4*>(&v); w[0] ^= 0x80008000u; w[1] ^= 0x80008000u; w[2] ^= 0x80008000u; w[3] ^= 0x80008000u; return *reinterpret_cast<bf16x8*>(&w); }

template <int KS, int WN, int MODE>
DEVI void fft_kstep(int vbr, int vbi, const bf16x8& aC, const bf16x8& aS, f32x16 (&yr)[2], f32x16 (&yi)[2]) {
    s16x4 rl0, rh0, rl1, rh1, il0, ih0, il1, ih1;
    tr_frag_issue<2 * WN, KS>(vbr, rl0, rh0); tr_frag_issue<2 * WN + 1, KS>(vbr, rl1, rh1);
    tr_frag_issue<2 * WN, KS>(vbi, il0, ih0); tr_frag_issue<2 * WN + 1, KS>(vbi, il1, ih1);
    LGKM0();
    const bf16x8 xr0 = PKLH(rl0, rh0), xr1 = PKLH(rl1, rh1), xi0 = PKLH(il0, ih0), xi1 = PKLH(il1, ih1);
    yr[0] = __builtin_amdgcn_mfma_f32_32x32x16_bf16(xr0, aC, yr[0], 0, 0, 0);
    yr[1] = __builtin_amdgcn_mfma_f32_32x32x16_bf16(xr1, aC, yr[1], 0, 0, 0);
    yr[0] = __builtin_amdgcn_mfma_f32_32x32x16_bf16(xi0, aS, yr[0], 0, 0, 0);
    yr[1] = __builtin_amdgcn_mfma_f32_32x32x16_bf16(xi1, aS, yr[1], 0, 0, 0);
    if (MODE == 0) {
        yi[0] = __builtin_amdgcn_mfma_f32_32x32x16_bf16(xi0, aC, yi[0], 0, 0, 0);
        yi[1] = __builtin_amdgcn_mfma_f32_32x32x16_bf16(xi1, aC, yi[1], 0, 0, 0);
        yi[0] = __builtin_amdgcn_mfma_f32_32x32x16_bf16(negbf(xr0), aS, yi[0], 0, 0, 0);
        yi[1] = __builtin_amdgcn_mfma_f32_32x32x16_bf16(negbf(xr1), aS, yi[1], 0, 0, 0);
    }
}
template <int WN, int MODE>
DEVI void fft_core(const char* lds, int xr_img, int xi_img, int wm, int lane, f32x16 (&yr)[2], f32x16 (&yi)[2]) {
    const int r32 = lane & 31, hi = lane >> 5;
    const char* Cm = lds; const char* Sm = lds + 34816;
    const int row = wm * 32 + r32;
    const int vb0 = xr_img + v_rd_base(lane), vb1 = xi_img + v_rd_base(lane);
#define KSTEP(H, KS) do { const int kk = (H) * 4 + (KS); \
        const bf16x8 aC = lds_b128(Cm, swz256(row, 2 * kk + hi)), aS = lds_b128(Sm, swz256(row, 2 * kk + hi)); \
        fft_kstep<KS, WN, MODE>(vb0 + (H) * 16384, vb1 + (H) * 16384, aC, aS, yr, yi); } while (0)
    KSTEP(0, 0); KSTEP(0, 1); KSTEP(0, 2); KSTEP(0, 3); KSTEP(1, 0); KSTEP(1, 1); KSTEP(1, 2); KSTEP(1, 3);
#undef KSTEP
}

DEVI void phase_fft1(const P& p, char* lds) {
    const int tid = threadIdx.x, lane = tid & 63, wid = __builtin_amdgcn_readfirstlane(tid >> 6), wm = wid >> 1, wn = wid & 1, r32 = lane & 31, hi = lane >> 5;
    load_dft(p, lds);
    char* imgR = lds + 69632; char* imgI = lds + 102400;
    const u16* Zr = (const u16*)(p.ws + OFF_ZR); const u16* Zi = (const u16*)(p.ws + OFF_ZI);
    u16* Yr = (u16*)(p.ws + OFF_YR); u16* Yi = (u16*)(p.ws + OFF_YI);
    const float2* TW = (const float2*)(p.ws + OFF_TW);
    u32x4 pr[4], pi[4];
#define FFT1_LOAD(U) do { const int cb_ = (U) & 7, t2_ = ((U) >> 3) & 127, b_ = (U) >> 10; \
        stage_tr128_load([&](int k) { return Zr + (size_t)(b_ * TL + 128 * k + t2_) * 1024 + cb_ * 128; }, pr); \
        stage_tr128_load([&](int k) { return Zi + (size_t)(b_ * TL + 128 * k + t2_) * 1024 + cb_ * 128; }, pi); } while (0)
    if ((int)blockIdx.x < NB * 128 * 8) FFT1_LOAD((int)blockIdx.x);
    for (int u = blockIdx.x; u < NB * 128 * 8; u += gridDim.x) {
        const int cb = u & 7, t2 = (u >> 3) & 127, b = u >> 10;
        __syncthreads();
        stage_tr128_write(pr, imgR); stage_tr128_write(pi, imgI);
        __syncthreads();
        if (u + (int)gridDim.x < NB * 128 * 8) FFT1_LOAD(u + (int)gridDim.x);
        f32x16 yr[2] = {}, yi[2] = {};
        const int xr_img = (int)(uintptr_t)imgR, xi_img = (int)(uintptr_t)imgI;
        if (wn == 0) fft_core<0, 0>(lds, xr_img, xi_img, wm, lane, yr, yi); else fft_core<1, 0>(lds, xr_img, xi_img, wm, lane, yr, yi);
        __syncthreads();
        {
            const int k1 = wm * 32 + r32;
            const float2 w = TW[t2 * k1];
            char* oR = imgR + k1 * 272; char* oI = imgR + 34816 + k1 * 272;
#pragma unroll
            for (int ni = 0; ni < 2; ++ni)
#pragma unroll
                for (int g = 0; g < 4; ++g) {
                    const int cbase = wn * 64 + ni * 32 + 8 * g + 4 * hi;
                    float re[4], im[4];
#pragma unroll
                    for (int j = 0; j < 4; ++j) { const float a = yr[ni][4 * g + j], bq = yi[ni][4 * g + j]; re[j] = a * w.x + bq * w.y; im[j] = bq * w.x - a * w.y; }
                    u32x2 pr, pi; pr[0] = cvtpk(re[0], re[1]); pr[1] = cvtpk(re[2], re[3]); pi[0] = cvtpk(im[0], im[1]); pi[1] = cvtpk(im[2], im[3]);
                    *reinterpret_cast<u32x2*>(oR + cbase * 2) = pr; *reinterpret_cast<u32x2*>(oI + cbase * 2) = pi;
                }
        }
        __syncthreads();
#pragma unroll
        for (int i = 0; i < 8; ++i) {
            const int idx = tid + 512 * i, pl = idx >> 11, j = idx & 2047, row = j >> 4, ch = j & 15;
            const u32x4 v = *reinterpret_cast<const u32x4*>(imgR + pl * 34816 + row * 272 + ch * 16);
            *reinterpret_cast<u32x4*>((pl ? Yi : Yr) + ((size_t)(b * 128 + row) * 128 + t2) * 1024 + cb * 128 + ch * 8) = v;
        }
    }
}
template <bool DRY = false>
DEVI void phase_fft2(const P& p, char* lds) {
    const int tid = threadIdx.x, lane = tid & 63, wid = __builtin_amdgcn_readfirstlane(tid >> 6), wm = wid >> 1, wn = wid & 1, r32 = lane & 31, hi = lane >> 5;
    load_dft(p, lds);
    char* imgR = lds + 69632; char* imgI = lds + 102400;
    const u16* Yr = (const u16*)(p.ws + OFF_YR); const u16* Yi = (const u16*)(p.ws + OFF_YI);
    const float* modb = (const float*)(p.ws + OFF_MOD) + (size_t)3 * 6144;
    u32x4 pr[4], pi[4];
#define FFT2_LOAD(U) do { const int cb_ = (U) & 7, k1_ = ((U) >> 3) & 127, b_ = (U) >> 10; \
        stage_tr128_load([&](int k) { return Yr + ((size_t)(b_ * 128 + k1_) * 128 + k) * 1024 + cb_ * 128; }, pr); \
        stage_tr128_load([&](int k) { return Yi + ((size_t)(b_ * 128 + k1_) * 128 + k) * 1024 + cb_ * 128; }, pi); } while (0)
    if ((int)blockIdx.x < NB * 128 * 8) FFT2_LOAD((int)blockIdx.x);
    for (int u = blockIdx.x; u < NB * 128 * 8; u += gridDim.x) {
        const int cb = u & 7, k1 = (u >> 3) & 127, b = u >> 10;
        __syncthreads();
        stage_tr128_write(pr, imgR); stage_tr128_write(pi, imgI);
        __syncthreads();
        if (u + (int)gridDim.x < NB * 128 * 8) FFT2_LOAD(u + (int)gridDim.x);
        f32x16 yr[2] = {}, yi[2] = {};
        const int xr_img = (int)(uintptr_t)imgR, xi_img = (int)(uintptr_t)imgI;
        if (wn == 0) fft_core<0, 1>(lds, xr_img, xi_img, wm, lane, yr, yi); else fft_core<1, 1>(lds, xr_img, xi_img, wm, lane, yr, yi);
        __syncthreads();
        {
            char* oR = imgR + (wm * 32 + r32) * 528;
#pragma unroll
            for (int ni = 0; ni < 2; ++ni)
#pragma unroll
                for (int g = 0; g < 4; ++g) {
                    const int cbase = wn * 64 + ni * 32 + 8 * g + 4 * hi;
                    f32x4 v; v[0] = yr[ni][4 * g]; v[1] = yr[ni][4 * g + 1]; v[2] = yr[ni][4 * g + 2]; v[3] = yr[ni][4 * g + 3];
                    *reinterpret_cast<f32x4*>(oR + cbase * 4) = v;
                }
        }
        __syncthreads();
        const float* gate = modb + (size_t)b * 6144 + 2 * 1024 + cb * 128;
#pragma unroll
        for (int i = 0; i < 4; ++i) {
            const int idx = tid + 512 * i, row = idx >> 4, ch = idx & 15;
            const f32x4 v0 = *reinterpret_cast<const f32x4*>(imgR + row * 528 + ch * 32), v1 = *reinterpret_cast<const f32x4*>(imgR + row * 528 + ch * 32 + 16);
            const f32x4 g0 = *reinterpret_cast<const f32x4*>(gate + ch * 8), g1 = *reinterpret_cast<const f32x4*>(gate + ch * 8 + 4);
            u16* xo = xs_ptr(p, 1, b * TL + k1 + 128 * row) + cb * 128 + ch * 8;
            u16* xd = DRY ? (u16*)(p.ws + OFF_ZR) + (size_t)(b * TL + k1 + 128 * row) * 1024 + cb * 128 + ch * 8 : xo;
            const u32x4 xw = *reinterpret_cast<const u32x4*>(xo);
            f32x4 x0, x1; x0[0] = bflo(xw[0]); x0[1] = bfhi(xw[0]); x0[2] = bflo(xw[1]); x0[3] = bfhi(xw[1]); x1[0] = bflo(xw[2]); x1[1] = bfhi(xw[2]); x1[2] = bflo(xw[3]); x1[3] = bfhi(xw[3]);
            const f32x4 r0 = x0 + g0 * v0, r1 = x1 + g1 * v1;
            u32x4 w; w[0] = cvtpk(r0[0], r0[1]); w[1] = cvtpk(r0[2], r0[3]); w[2] = cvtpk(r1[0], r1[1]); w[3] = cvtpk(r1[2], r1[3]);
            *reinterpret_cast<u32x4*>(xd) = w;
        }
    }
}

DEVI void chunk_scan(const float* gates, int row0, int head, int dir, float* Bq, float* av, float* pm, float& total, float& amax) {
    const int lane = threadIdx.x & 63;
    const int e0 = dir ? 127 - 2 * lane : 2 * lane, e1 = dir ? 126 - 2 * lane : 2 * lane + 1;
    const float lf0 = gates[(size_t)(row0 + e0) * 16 + (dir ? 12 : 4) + head], lf1 = gates[(size_t)(row0 + e1) * 16 + (dir ? 12 : 4) + head];
    const float li0 = gates[(size_t)(row0 + e0) * 16 + (dir ? 8 : 0) + head],  li1 = gates[(size_t)(row0 + e1) * 16 + (dir ? 8 : 0) + head];
    const float s1 = lf0 + lf1; float inc = s1;
#pragma unroll
    for (int o = 1; o < 64; o <<= 1) { const float t = __shfl_up(inc, o); if (lane >= o) inc += t; }
    const float exc = inc - s1;
    const float B0 = exc + lf0, B1 = exc + s1;
    const float a0 = li0 - B0, a1 = li1 - B1;
    const float m1 = fmaxf(a0, a1); float mx = m1;
#pragma unroll
    for (int o = 1; o < 64; o <<= 1) { const float t = __shfl_up(mx, o); if (lane >= o) mx = fmaxf(mx, t); }
    float mprev = __shfl_up(mx, 1); if (lane == 0) mprev = -1e30f;
    Bq[e0] = B0; Bq[e1] = B1; av[e0] = a0; av[e1] = a1; pm[e0] = fmaxf(mprev, a0); pm[e1] = mx;
    total = __shfl(inc, 63); amax = __shfl(mx, 63);
}

DEVI void conv_silu8(const u32x4& xm, const u32x4& x0, const u32x4& xp, const float* wc, bool hasm, bool hasp, float (&out)[8]) {
#pragma unroll
    for (int j = 0; j < 4; ++j) {
        const float w00 = wc[2 * j], w01 = wc[2 * j + 1], w10 = wc[1024 + 2 * j], w11 = wc[1024 + 2 * j + 1], w20 = wc[2048 + 2 * j], w21 = wc[2048 + 2 * j + 1];
        float a = w10 * bflo(x0[j]), b = w11 * bfhi(x0[j]);
        if (hasm) { a = fmaf(w00, bflo(xm[j]), a); b = fmaf(w01, bfhi(xm[j]), b); }
        if (hasp) { a = fmaf(w20, bflo(xp[j]), a); b = fmaf(w21, bfhi(xp[j]), b); }
        out[2 * j] = siluf_(a); out[2 * j + 1] = siluf_(b);
    }
}
DEVI void seg_edges(int t  , bool& hasm, bool& hasp) {
    hasm = !(t == 0 || t == TC); hasp = !(t == TC - 1 || t == TT - 1);
}
DEVI int chain_slot(int dir, int b, int h, int cc) { return ((dir * 2 + b) * 4 + h) * NCH + cc; }

DEVI void phase_mlstm_a(const P& p, char* lds) {
    const int tid = threadIdx.x, wid = __builtin_amdgcn_readfirstlane(tid >> 6), lane = tid & 63, r32 = lane & 31, hi = lane >> 5;
    char* Vimg = lds; char* Kf = lds + 32768; char* Kb = lds + 65536;
    float* arr = (float*)(lds + 98304);
    const float* gates = (const float*)(p.ws + OFF_GATES);
    const u16* MLQK = (const u16*)(p.ws + OFF_MLQK); const u16* MLV = (const u16*)(p.ws + OFF_MLV);
    u16* CST = (u16*)(p.ws + OFF_CST); float* NST = (float*)(p.ws + OFF_NST); u16* MLC = (u16*)(p.ws + OFF_MLC);
    float2* scal = (float2*)(p.ws + OFF_MSCAL);
    for (int it = blockIdx.x; it < NB * 4 * NCH; it += gridDim.x) {
        const int cc = it % NCH, h = (it / NCH) & 3, b = it / (NCH * 4);
        const int row0 = b * TT + cc * 128;
        __syncthreads();
        if (wid < 2) {
            float total, amax; float* a4 = arr + wid * 512;
            chunk_scan(gates, row0, h, wid, a4, a4 + 128, a4 + 256, total, amax);
            a4[384 + lane] = __expf(a4[128 + lane] - amax); a4[384 + 64 + lane] = __expf(a4[128 + 64 + lane] - amax);
            if (lane == 0) scal[chain_slot(wid, b, h, 0) + cc] = make_float2(total + amax, total);
        }
        __syncthreads();
#pragma unroll
        for (int i = 0; i < 4; ++i) {
            const int idx = tid + 512 * i, l = idx >> 4, c = (idx & 15) * 8;
            const u32x4 v = *reinterpret_cast<const u32x4*>(MLV + (size_t)(row0 + l) * 512 + h * 128 + c);
            *reinterpret_cast<u32x4*>(Vimg + (l >> 6) * 16384 + v_st(l & 63, c)) = v;
            const int t = cc * 128 + l; bool hasm, hasp; seg_edges(t, hasm, hasp);
            const u16* kp = MLQK + (size_t)(row0 + l) * 1024 + 512 + h * 128 + c;
            const u32x4 x0 = *reinterpret_cast<const u32x4*>(kp);
            const u32x4 xm = hasm ? *reinterpret_cast<const u32x4*>(kp - 1024) : x0;
            const u32x4 xp = hasp ? *reinterpret_cast<const u32x4*>(kp + 1024) : x0;
            float kv[8]; conv_silu8(xm, x0, xp, p.conv_w + 512 + h * 128 + c, hasm, hasp, kv);
            const float wf = arr[384 + l] * 0.08838834764831845f, wb = arr[512 + 384 + l] * 0.08838834764831845f;
            u32x4 of, ob, ok;
#pragma unroll
            for (int j = 0; j < 4; ++j) { of[j] = cvtpk(kv[2 * j] * wf, kv[2 * j + 1] * wf); ob[j] = cvtpk(kv[2 * j] * wb, kv[2 * j + 1] * wb);
                ok[j] = cvtpk(kv[2 * j] * 0.08838834764831845f, kv[2 * j + 1] * 0.08838834764831845f); }
            *reinterpret_cast<u32x4*>(MLC + (size_t)(row0 + l) * 1024 + 512 + h * 128 + c) = ok;
            {
                const u16* qp = kp - 512;
                const u32x4 q0 = *reinterpret_cast<const u32x4*>(qp);
                const u32x4 qm = hasm ? *reinterpret_cast<const u32x4*>(qp - 1024) : q0;
                const u32x4 qn = hasp ? *reinterpret_cast<const u32x4*>(qp + 1024) : q0;
                float qv[8]; conv_silu8(qm, q0, qn, p.conv_w + h * 128 + c, hasm, hasp, qv);
                u32x4 oq;
#pragma unroll
                for (int j = 0; j < 4; ++j) oq[j] = cvtpk(qv[2 * j], qv[2 * j + 1]);
                *reinterpret_cast<u32x4*>(MLC + (size_t)(row0 + l) * 1024 + h * 128 + c) = oq;
            }
            *reinterpret_cast<u32x4*>(Kf + (l >> 6) * 16384 + v_st(l & 63, c)) = of;
            *reinterpret_cast<u32x4*>(Kb + (l >> 6) * 16384 + v_st(l & 63, c)) = ob;
        }
        __syncthreads();
        const int dir = wid >> 2, vblk = wid & 3;
        const int va = (int)(uintptr_t)Vimg + v_rd_base(lane), ka = (int)(uintptr_t)(dir ? Kb : Kf) + v_rd_base(lane);
        f32x16 acc[4] = {};
#define ASTEP(H, KS) do { s16x4 al_, ah_, b0l, b0h, b1l, b1h, b2l, b2h, b3l, b3h; \
        if (vblk == 0) tr_frag_issue<0, KS>(va + (H) * 16384, al_, ah_); else if (vblk == 1) tr_frag_issue<1, KS>(va + (H) * 16384, al_, ah_); \
        else if (vblk == 2) tr_frag_issue<2, KS>(va + (H) * 16384, al_, ah_); else tr_frag_issue<3, KS>(va + (H) * 16384, al_, ah_); \
        tr_frag_issue<0, KS>(ka + (H) * 16384, b0l, b0h); tr_frag_issue<1, KS>(ka + (H) * 16384, b1l, b1h); \
        tr_frag_issue<2, KS>(ka + (H) * 16384, b2l, b2h); tr_frag_issue<3, KS>(ka + (H) * 16384, b3l, b3h); LGKM0(); \
        const bf16x8 af = PKLH(al_, ah_); \
        acc[0] = __builtin_amdgcn_mfma_f32_32x32x16_bf16(af, PKLH(b0l, b0h), acc[0], 0, 0, 0); \
        acc[1] = __builtin_amdgcn_mfma_f32_32x32x16_bf16(af, PKLH(b1l, b1h), acc[1], 0, 0, 0); \
        acc[2] = __builtin_amdgcn_mfma_f32_32x32x16_bf16(af, PKLH(b2l, b2h), acc[2], 0, 0, 0); \
        acc[3] = __builtin_amdgcn_mfma_f32_32x32x16_bf16(af, PKLH(b3l, b3h), acc[3], 0, 0, 0); } while (0)
        ASTEP(0, 0); ASTEP(0, 1); ASTEP(0, 2); ASTEP(0, 3); ASTEP(1, 0); ASTEP(1, 1); ASTEP(1, 2); ASTEP(1, 3);
#undef ASTEP
        u16* Cd = CST + (size_t)chain_slot(dir, b, h, cc) * 16384;
#pragma unroll
        for (int kb = 0; kb < 4; ++kb)
#pragma unroll
            for (int r = 0; r < 16; ++r) Cd[(vblk * 32 + crow(r, hi)) * 128 + kb * 32 + r32] = f2bf(acc[kb][r]);
        if (tid < 256) {
            const int d2 = tid >> 7, k = tid & 127; const char* img = d2 ? Kb : Kf; float s = 0.f;
            for (int l = 0; l < 128; ++l) s += bf2f(*reinterpret_cast<const u16*>(img + (l >> 6) * 16384 + v_st(l & 63, k & ~7) + (k & 7) * 2));
            NST[(size_t)chain_slot(d2, b, h, cc) * 128 + k] = s;
        }
    }
}

DEVI void phase_kmax(const P& p, char* lds) {
    const int tid = threadIdx.x; unsigned* lm = (unsigned*)lds;
    __syncthreads();
    if (tid < 16) lm[tid] = 0u;
    __syncthreads();
    const u16* K = (const u16*)(p.ws + OFF_K); const int hm = tid & 7;
    float mx0 = 0.f, mx1 = 0.f;
    for (int idx = blockIdx.x * NTHR + tid; idx < NTOK * 8; idx += gridDim.x * NTHR) {
        const int tok = idx >> 3; const u16* kp = K + (size_t)tok * 512 + hm * 64; float ss = 0.f;
#pragma unroll
        for (int c = 0; c < 8; ++c) { const u32x4 w = *reinterpret_cast<const u32x4*>(kp + c * 8);
#pragma unroll
            for (int j = 0; j < 4; ++j) { const float a = bflo(w[j]), b = bfhi(w[j]); ss = fmaf(a, a, ss); ss = fmaf(b, b, ss); } }
        if (tok < TT) mx0 = fmaxf(mx0, ss); else mx1 = fmaxf(mx1, ss);
    }
    atomicMax(&lm[hm], __float_as_uint(mx0)); atomicMax(&lm[8 + hm], __float_as_uint(mx1));
    __syncthreads();
    if (tid < 16) atomicMax((unsigned*)(p.ws + OFF_CNT) + 128 + tid, lm[tid]);
    __syncthreads();
}

DEVI int proc_chunk(int dir, int i) { return dir == 0 ? i : (i == 0 ? 1 : (i == 1 ? 0 : NCH + 1 - i)); }

DEVI void phase_mlstm_b(const P& p, char* lds) {
    const int tid = threadIdx.x;
    float* dec = (float*)lds; float* scl = dec + 160; float* mst = scl + 160;
    const float2* scal = (const float2*)(p.ws + OFF_MSCAL);
    u32* CST = (u32*)(p.ws + OFF_CST); float* NST = (float*)(p.ws + OFF_NST); float* MST = (float*)(p.ws + OFF_MST);
    for (int it = blockIdx.x; it < 16 * 16; it += gridDim.x) {
        const int chain = it >> 4, sub = it & 15, dir = chain >> 3;
        __syncthreads();
        if (tid == 0) {
            float m = 0.f;
            for (int i = 0; i < NCH; ++i) {
                const int cc = proc_chunk(dir, i); const float2 s = scal[chain * NCH + cc];
                const float mn = fmaxf(s.y + m, s.x);
                dec[i] = __expf(s.y + m - mn); scl[i] = __expf(s.x - mn); mst[i] = m;
                if (sub == 0) MST[chain * NCH + cc] = m;
                m = mn;
            }
        }
        __syncthreads();
        u32* base = CST + (size_t)chain * NCH * 8192 + sub * 512 + tid;
        float s0 = 0.f, s1 = 0.f;
        for (int i0 = 0; i0 < NCH; i0 += 10) {
            u32 v[10];
#pragma unroll
            for (int j = 0; j < 10; ++j) v[j] = base[(size_t)proc_chunk(dir, i0 + j) * 8192];
#pragma unroll
            for (int j = 0; j < 10; ++j) {
                base[(size_t)proc_chunk(dir, i0 + j) * 8192] = cvtpk(s0, s1);
                const float d = dec[i0 + j], sc = scl[i0 + j];
                s0 = fmaf(d, s0, sc * bflo(v[j])); s1 = fmaf(d, s1, sc * bfhi(v[j]));
            }
        }
        if (sub == 0 && tid < 128) {
            float* nb = NST + (size_t)chain * NCH * 128 + tid; float s = 0.f;
            for (int i = 0; i < NCH; ++i) { const int cc = proc_chunk(dir, i); const float v = nb[cc * 128]; nb[cc * 128] = s; s = fmaf(dec[i], s, scl[i] * v); }
        }
    }
}

DEVI void mlstm_c_item(const P& p, int it, char* lds) {
    int tid = threadIdx.x; asm volatile("" : "+v"(tid));
    const int wid = __builtin_amdgcn_readfirstlane(tid >> 6), lane = tid & 63, r32 = lane & 31, hi = lane >> 5;
    const int cc = it % NCH, h = (it / NCH) & 3, b = it / (NCH * 4);
    const int row0 = b * TT + cc * 128;
    char* Kt = lds; char* Vimg = lds + 34816; char* Ct = lds + 67584;
    float* arr = (float*)(lds + 137216);
    float* wsc = arr + 1024 + wid * 64;
    float* xb = (float*)lds;
    const float* gates = (const float*)(p.ws + OFF_GATES);
    const u16* MLC = (const u16*)(p.ws + OFF_MLC); const u16* MLV = (const u16*)(p.ws + OFF_MLV);
    const u16* CST = (const u16*)(p.ws + OFF_CST); const float* NST = (const float*)(p.ws + OFF_NST); const float* MST = (const float*)(p.ws + OFF_MST);
    __syncthreads();
    if (wid < 2) { float total, amax; float* a4 = arr + wid * 512; chunk_scan(gates, row0, h, wid, a4, a4 + 128, a4 + 256, total, amax); }
    else if (wid < 6) { const int d2 = (wid - 2) >> 1, k = ((wid - 2) & 1) * 64 + lane; arr[d2 * 512 + 384 + k] = NST[(size_t)chain_slot(d2, b, h, cc) * 128 + k]; }
#pragma unroll
    for (int i = 0; i < 4; ++i) {
        const int idx = tid + 512 * i, l = idx >> 4, ch = idx & 15, c = ch * 8;
        const u32x4 v = *reinterpret_cast<const u32x4*>(MLV + (size_t)(row0 + l) * 512 + h * 128 + c);
        *reinterpret_cast<u32x4*>(Vimg + (l >> 6) * 16384 + v_st(l & 63, c)) = v;
        const u32x4 ok = *reinterpret_cast<const u32x4*>(MLC + (size_t)(row0 + l) * 1024 + 512 + h * 128 + c);
        *reinterpret_cast<u32x4*>(Kt + swz256(l, ch)) = ok;
#pragma unroll
        for (int d2 = 0; d2 < 2; ++d2) {
            const u32x4 cv = *reinterpret_cast<const u32x4*>(CST + (size_t)chain_slot(d2, b, h, cc) * 16384 + l * 128 + c);
            *reinterpret_cast<u32x4*>(Ct + d2 * 34816 + swz256(l, ch)) = cv;
        }
    }
    const int dir = wid >> 2, qb = wid & 3, q = qb * 32 + r32;
    bf16x8 qr[8];
    { const u16* qp = MLC + (size_t)(row0 + q) * 1024 + h * 128 + hi * 8;
#pragma unroll
      for (int d0 = 0; d0 < 8; ++d0) qr[d0] = *reinterpret_cast<const bf16x8*>(qp + d0 * 16); }
    __syncthreads();
    const float* a4 = arr + dir * 512;
    const float m_st = MST[chain_slot(dir, b, h, 0) + cc];
    const float Mq = fmaxf(m_st, a4[256 + q]);
    const float inter = __expf(m_st - Mq);
    float nq = 0.f;
#pragma unroll
    for (int d0 = 0; d0 < 8; ++d0) {
        const u32x4 w = *reinterpret_cast<const u32x4*>(&qr[d0]); const float* nn = a4 + 384 + d0 * 16 + hi * 8;
#pragma unroll
        for (int j = 0; j < 4; ++j) { nq = fmaf(bflo(w[j]), nn[2 * j], nq); nq = fmaf(bfhi(w[j]), nn[2 * j + 1], nq); }
    }
    { auto rr = __builtin_amdgcn_permlane32_swap(__float_as_uint(nq), __float_as_uint(nq), false, false); nq = __uint_as_float(rr[0]) + __uint_as_float(rr[1]); }
    f32x16 o[4] = {};
    const char* Cm = Ct + dir * 34816;
#pragma unroll
    for (int dk = 0; dk < 8; ++dk)
#pragma unroll
        for (int d0 = 0; d0 < 4; ++d0) o[d0] = __builtin_amdgcn_mfma_f32_32x32x16_bf16(qr[dk], lds_b128(Cm, swz256(d0 * 32 + r32, 2 * dk + hi)), o[d0], 0, 0, 0);
    if (hi == 0) wsc[r32] = inter;
    asm volatile("s_waitcnt lgkmcnt(0)" ::: "memory");
#pragma unroll
    for (int d0 = 0; d0 < 4; ++d0)
#pragma unroll
        for (int r = 0; r < 16; ++r) o[d0][r] *= wsc[crow(r, hi)];
    const int vb = (int)(uintptr_t)Vimg + v_rd_base(lane);
    float rs = 0.f;
#define KBLK(KB) do { if (dir == 0 ? (KB) <= qb : (KB) >= qb) { \
        f32x16 pp = {}; \
        _Pragma("unroll") for (int d0 = 0; d0 < 8; ++d0) pp = __builtin_amdgcn_mfma_f32_32x32x16_bf16(lds_b128(Kt, swz256((KB) * 32 + r32, 2 * d0 + hi)), qr[d0], pp, 0, 0, 0); \
        _Pragma("unroll") for (int g = 0; g < 4; ++g) { const f32x4 av4 = *reinterpret_cast<const f32x4*>(a4 + 128 + (KB) * 32 + 8 * g + 4 * hi); \
            _Pragma("unroll") for (int j = 0; j < 4; ++j) { const int key = (KB) * 32 + 8 * g + 4 * hi + j; const bool ok = dir == 0 ? key <= q : key >= q; \
                const float sv = ok ? pp[4 * g + j] * __expf(av4[j] - Mq) : 0.f; pp[4 * g + j] = sv; rs += sv; } } \
        bf16x8 f0, f1; pack_p(pp, f0, f1); \
        { s16x4 l0, h0, l1, h1, l2, h2, l3, h3; constexpr int HH = (KB) >> 1, K0 = ((KB) & 1) * 2; \
          tr_frag_issue<0, K0>(vb + HH * 16384, l0, h0); tr_frag_issue<1, K0>(vb + HH * 16384, l1, h1); tr_frag_issue<2, K0>(vb + HH * 16384, l2, h2); tr_frag_issue<3, K0>(vb + HH * 16384, l3, h3); LGKM0(); \
          o[0] = __builtin_amdgcn_mfma_f32_32x32x16_bf16(f0, PKLH(l0, h0), o[0], 0, 0, 0); o[1] = __builtin_amdgcn_mfma_f32_32x32x16_bf16(f0, PKLH(l1, h1), o[1], 0, 0, 0); \
          o[2] = __builtin_amdgcn_mfma_f32_32x32x16_bf16(f0, PKLH(l2, h2), o[2], 0, 0, 0); o[3] = __builtin_amdgcn_mfma_f32_32x32x16_bf16(f0, PKLH(l3, h3), o[3], 0, 0, 0); \
          tr_frag_issue<0, K0 + 1>(vb + HH * 16384, l0, h0); tr_frag_issue<1, K0 + 1>(vb + HH * 16384, l1, h1); tr_frag_issue<2, K0 + 1>(vb + HH * 16384, l2, h2); tr_frag_issue<3, K0 + 1>(vb + HH * 16384, l3, h3); LGKM0(); \
          o[0] = __builtin_amdgcn_mfma_f32_32x32x16_bf16(f1, PKLH(l0, h0), o[0], 0, 0, 0); o[1] = __builtin_amdgcn_mfma_f32_32x32x16_bf16(f1, PKLH(l1, h1), o[1], 0, 0, 0); \
          o[2] = __builtin_amdgcn_mfma_f32_32x32x16_bf16(f1, PKLH(l2, h2), o[2], 0, 0, 0); o[3] = __builtin_amdgcn_mfma_f32_32x32x16_bf16(f1, PKLH(l3, h3), o[3], 0, 0, 0); } } } while (0)
    KBLK(0); KBLK(1); KBLK(2); KBLK(3);
#undef KBLK
    { auto rr = __builtin_amdgcn_permlane32_swap(__float_as_uint(rs), __float_as_uint(rs), false, false); rs = __uint_as_float(rr[0]) + __uint_as_float(rr[1]); }
    const float nqt = inter * nq + rs;
    const float den = fmaxf(fabsf(nqt), __expf(-(a4[q] + Mq)));
    if (hi == 0) wsc[32 + r32] = 1.f / den;
    asm volatile("s_waitcnt lgkmcnt(0)" ::: "memory");
#pragma unroll
    for (int d0 = 0; d0 < 4; ++d0)
#pragma unroll
        for (int r = 0; r < 16; ++r) o[d0][r] *= wsc[32 + crow(r, hi)];
    __syncthreads();
    {
        float* xd = dir ? xb : (float*)(lds + 67584);
#pragma unroll
        for (int d0 = 0; d0 < 4; ++d0)
#pragma unroll
            for (int r = 0; r < 16; ++r) xd[(qb * 32 + crow(r, hi)) * 128 + d0 * 32 + r32] = o[d0][r];
    }
    __syncthreads();
    {
        const u16* OG = (const u16*)(p.ws + OFF_OG); u16* mix = (u16*)(p.ws + OFF_ACT);
        const float* xf = (const float*)(lds + 67584);
#pragma unroll
        for (int i = 0; i < 4; ++i) {
            const int idx = tid + 512 * i, ql = idx >> 4, c = (idx & 15) * 8;
            const f32x4 f0 = *reinterpret_cast<const f32x4*>(xf + ql * 128 + c), f1 = *reinterpret_cast<const f32x4*>(xf + ql * 128 + c + 4);
            const f32x4 b0 = *reinterpret_cast<const f32x4*>(xb + ql * 128 + c), b1 = *reinterpret_cast<const f32x4*>(xb + ql * 128 + c + 4);
            const u32x4 og = *reinterpret_cast<const u32x4*>(OG + (size_t)(row0 + ql) * 512 + h * 128 + c);
            u32x4 w;
            w[0] = cvtpk((f0[0] + b0[0]) * bflo(og[0]), (f0[1] + b0[1]) * bfhi(og[0]));
            w[1] = cvtpk((f0[2] + b0[2]) * bflo(og[1]), (f0[3] + b0[3]) * bfhi(og[1]));
            w[2] = cvtpk((f1[0] + b1[0]) * bflo(og[2]), (f1[1] + b1[1]) * bfhi(og[2]));
            w[3] = cvtpk((f1[2] + b1[2]) * bflo(og[3]), (f1[3] + b1[3]) * bfhi(og[3]));
            *reinterpret_cast<u32x4*>(mix + (size_t)(row0 + ql) * 1024 + 512 + h * 128 + c) = w;
        }
    }
}

#define KSWZ(row, colB) ((row) * 256 + ((colB) ^ (((row) & 15) << 4)))
constexpr float A2_SCALE = 0.125f, A2_THR = 8.f;
DEVI void a2_partialSM(f32x16& p0, f32x16& p1, float) {
#pragma unroll
    for (int r = 0; r < 16; ++r) p0[r] = __builtin_amdgcn_exp2f(p0[r]);
}
DEVI void a2_finishSM(f32x16& p0, f32x16& p1, f32x16& lv, bf16x8& pa0, bf16x8& pa1, bf16x8& pa2, bf16x8& pa3) {
#pragma unroll
    for (int r = 0; r < 16; ++r) p1[r] = __builtin_amdgcn_exp2f(p1[r]);
#pragma unroll
    for (int r = 0; r < 16; ++r) lv[r] += p0[r] + p1[r];
    pack_p_perm(p0, pa0, pa1); pack_p_perm(p1, pa2, pa3);
}
DEVI void a2_qkt(f32x16& p0, f32x16& p1, const char* Ks, const bf16x8 (&qr)[4], int r32, int hi, int grp, const f32x16& cinit) {
#pragma unroll
    for (int d0 = 0; d0 < 4; ++d0) { const int cb = (grp * 64 + d0 * 16 + hi * 8) * 2;
        const bf16x8 b0 = lds_b128(Ks, KSWZ(r32, cb)), b1 = lds_b128(Ks, KSWZ(32 + r32, cb));
        if (d0 == 0) { p0 = __builtin_amdgcn_mfma_f32_32x32x16_bf16(b0, qr[0], cinit, 0, 0, 0); p1 = __builtin_amdgcn_mfma_f32_32x32x16_bf16(b1, qr[0], cinit, 0, 0, 0); }
        else { p0 = __builtin_amdgcn_mfma_f32_32x32x16_bf16(b0, qr[d0], p0, 0, 0, 0); p1 = __builtin_amdgcn_mfma_f32_32x32x16_bf16(b1, qr[d0], p1, 0, 0, 0); } }
}
#define A2_VISSUE(D0, F) do { tr_frag_issue<D0, 0>(vb, F##l0, F##h0); tr_frag_issue<D0, 1>(vb, F##l1, F##h1); tr_frag_issue<D0, 2>(vb, F##l2, F##h2); tr_frag_issue<D0, 3>(vb, F##l3, F##h3); } while (0)
#define A2_VMMA(D0, F) do { \
    o[D0] = __builtin_amdgcn_mfma_f32_32x32x16_bf16(pa0, PKLH(F##l0, F##h0), o[D0], 0, 0, 0); o[D0] = __builtin_amdgcn_mfma_f32_32x32x16_bf16(pa1, PKLH(F##l1, F##h1), o[D0], 0, 0, 0); \
    o[D0] = __builtin_amdgcn_mfma_f32_32x32x16_bf16(pa2, PKLH(F##l2, F##h2), o[D0], 0, 0, 0); o[D0] = __builtin_amdgcn_mfma_f32_32x32x16_bf16(pa3, PKLH(F##l3, F##h3), o[D0], 0, 0, 0); } while (0)
#define A2_LGKM(N) do { asm volatile("s_waitcnt lgkmcnt(" #N ")" ::: "memory"); SBAR(); } while (0)
template <int S> DEVI void a2_psm_slice(f32x16& x0, f32x16&, float) {
#pragma unroll
    for (int r = 4 * S; r < 4 * S + 4; ++r) x0[r] = __builtin_amdgcn_exp2f(x0[r]);
}
DEVI void a2_pv(f32x16 (&o)[4], int vb, const bf16x8& pa0, const bf16x8& pa1, const bf16x8& pa2, const bf16x8& pa3, f32x16& x0, f32x16& x1, float mnC) {
    s16x4 al0, ah0, al1, ah1, al2, ah2, al3, ah3, bl0, bh0, bl1, bh1, bl2, bh2, bl3, bh3;
    A2_VISSUE(0, a); A2_VISSUE(1, b);
    A2_LGKM(8); a2_psm_slice<0>(x0, x1, mnC); A2_VMMA(0, a);
    A2_VISSUE(2, a);
    A2_LGKM(8); a2_psm_slice<1>(x0, x1, mnC); A2_VMMA(1, b);
    A2_VISSUE(3, b);
    A2_LGKM(8); a2_psm_slice<2>(x0, x1, mnC); A2_VMMA(2, a);
    A2_LGKM(0); a2_psm_slice<3>(x0, x1, mnC); A2_VMMA(3, b);
}
DEVI void a2_pv_last(f32x16 (&o)[4], int vb, const bf16x8& pa0, const bf16x8& pa1, const bf16x8& pa2, const bf16x8& pa3) {
    s16x4 al0, ah0, al1, ah1, al2, ah2, al3, ah3, bl0, bh0, bl1, bh1, bl2, bh2, bl3, bh3;
    A2_VISSUE(0, a); A2_VISSUE(1, b);
    A2_LGKM(8); A2_VMMA(0, a);
    A2_VISSUE(2, a);
    A2_LGKM(8); A2_VMMA(1, b);
    A2_VISSUE(3, b);
    A2_LGKM(8); A2_VMMA(2, a);
    A2_LGKM(0); A2_VMMA(3, b);
}
constexpr int A2_T = 16384;
DEVI void a2_body(const P& p, int q0, int k0row, int seq, int h, char* lds, int tid) {
    const int GRP = __builtin_amdgcn_readfirstlane(tid >> 8); const int wid = tid >> 6, lane = tid & 63, r32 = lane & 31, hi = lane >> 5, wq = wid & 3;
    const u16* Kh = (const u16*)(p.ws + OFF_K) + (size_t)k0row * 512 + h * 128;
    const u16* Vh = (const u16*)(p.ws + OFF_V) + (size_t)k0row * 512 + h * 128;
    char* V_lds = lds; char* K_lds = lds + 3 * A2_T;
    float* wsc = (float*)(lds + 6 * A2_T) + wid * 64; float* li_l = wsc;
    float l_reg = 0.f; f32x16 o[4] = {}; bf16x8 qr[4];
    { const u16* Qw = (const u16*)(p.ws + OFF_Q) + (size_t)(q0 + wq * 32 + r32) * 512 + h * 128 + GRP * 64 + hi * 8;
#pragma unroll
      for (int d0 = 0; d0 < 4; ++d0) qr[d0] = *reinterpret_cast<const bf16x8*>(Qw + d0 * 16); }
    float mnC;
    { float qq = 0.f;
#pragma unroll
      for (int d0 = 0; d0 < 4; ++d0) { const u32x4 w = *reinterpret_cast<const u32x4*>(&qr[d0]);
#pragma unroll
          for (int j = 0; j < 4; ++j) { const float a = bflo(w[j]), b2 = bfhi(w[j]); qq = fmaf(a, a, qq); qq = fmaf(b2, b2, qq); } }
      { auto rr = __builtin_amdgcn_permlane32_swap(__float_as_uint(qq), __float_as_uint(qq), false, false); qq = __uint_as_float(rr[0]) + __uint_as_float(rr[1]); }
      const int bq = k0row >= TT ? 1 : 0;
      const float k2 = __uint_as_float(((const unsigned*)(p.ws + OFF_CNT))[128 + bq * 8 + h * 2 + GRP]);
      mnC = -sqrtf(qq * k2) * (A2_SCALE * 1.4426950408889634f) * 1.001f;
#pragma unroll
      for (int d0 = 0; d0 < 4; ++d0) { u32x4 w = *reinterpret_cast<u32x4*>(&qr[d0]);
#pragma unroll
          for (int j = 0; j < 4; ++j) w[j] = cvtpk(bflo(w[j]) * (A2_SCALE * 1.4426950408889634f), bfhi(w[j]) * (A2_SCALE * 1.4426950408889634f));
          qr[d0] = *reinterpret_cast<bf16x8*>(&w); } }
    const int vb0 = (int)(uintptr_t)V_lds + v_rd_base(lane);
    const int krow = tid >> 4, kch = (tid & 15) ^ (krow & 15);
    const int vc = ((tid >> 5) & 3) * 32 + (tid & 3) * 8;
    const int kk0 = (tid >> 7) * 8 + ((tid & 31) >> 2), kk1 = kk0 + 32;
#define A2_DMA(slot, kk) do { \
    __builtin_amdgcn_global_load_lds((const unsigned*)(Kh + (size_t)((kk) + krow) * 512 + kch * 8), (LAS unsigned*)(K_lds + (slot) * A2_T + tid * 16), 16, 0, 0); \
    __builtin_amdgcn_global_load_lds((const unsigned*)(Kh + (size_t)((kk) + 32 + krow) * 512 + kch * 8), (LAS unsigned*)(K_lds + (slot) * A2_T + 8192 + tid * 16), 16, 0, 0); \
    __builtin_amdgcn_global_load_lds((const unsigned*)(Vh + (size_t)((kk) + kk0) * 512 + vc), (LAS unsigned*)(V_lds + (slot) * A2_T + tid * 16), 16, 0, 0); \
    __builtin_amdgcn_global_load_lds((const unsigned*)(Vh + (size_t)((kk) + kk1) * 512 + vc), (LAS unsigned*)(V_lds + (slot) * A2_T + 8192 + tid * 16), 16, 0, 0); } while (0)
    f32x16 pA0, pA1, pB0, pB1; bf16x8 pa0, pa1, pa2, pa3; const int NT = seq / 64;
    f32x16 lv = {};
    f32x16 cinit;
#pragma unroll
    for (int r = 0; r < 16; ++r) cinit[r] = mnC;
    asm volatile("" : "+v"(cinit));
    __syncthreads();
    A2_DMA(0, 0); asm volatile("s_waitcnt vmcnt(0)" ::: "memory"); __syncthreads();
    A2_DMA(1, 64);
    a2_qkt(pA0, pA1, K_lds, qr, r32, hi, GRP, cinit); a2_partialSM(pA0, pA1, mnC);
    asm volatile("s_waitcnt vmcnt(0)" ::: "memory"); __syncthreads();
    int bp = 0, bc = 1, bn = 2;
#define A2_HALF(X0, X1, Y0, Y1, J) do { \
        if ((J) + 1 < NT) A2_DMA(bn, ((J) + 1) * 64); \
        SBAR(); a2_qkt(X0, X1, K_lds + bc * A2_T, qr, r32, hi, GRP, cinit); \
        a2_finishSM(Y0, Y1, lv, pa0, pa1, pa2, pa3); \
        __builtin_amdgcn_sched_group_barrier(0x100, 8, 0); \
        _Pragma("unroll") for (int g_ = 0; g_ < 8; ++g_) { __builtin_amdgcn_sched_group_barrier(0x8, 1, 0); __builtin_amdgcn_sched_group_barrier(0x2, 9, 0); } \
        SBAR(); \
        a2_pv(o, vb0 + bp * A2_T, pa0, pa1, pa2, pa3, X0, X1, mnC); \
        asm volatile("s_waitcnt vmcnt(0)" ::: "memory"); __syncthreads(); \
        { const int t_ = bp; bp = bc; bc = bn; bn = t_; } } while (0)
    for (int j = 1; j + 1 < NT; j += 2) {
        A2_HALF(pB0, pB1, pA0, pA1, j);
        A2_HALF(pA0, pA1, pB0, pB1, j + 1);
    }
    A2_HALF(pB0, pB1, pA0, pA1, NT - 1);
    a2_finishSM(pB0, pB1, lv, pa0, pa1, pa2, pa3); SBAR();
    a2_pv_last(o, vb0 + bp * A2_T, pa0, pa1, pa2, pa3);
#undef A2_HALF
#undef A2_DMA
    asm volatile("s_waitcnt vmcnt(0)" ::: "memory");
    int tz = threadIdx.x; asm volatile("" : "+v"(tz));
    const int wq_e = (tz >> 6) & 3, r32e = tz & 31, hie = (tz >> 5) & 1;
    float* li_e = (float*)(lds + 6 * A2_T) + (tz >> 6) * 64;
    const float lam = ((const float*)(p.ws + OFF_LAM))[0];
#pragma unroll
    for (int r = 0; r < 16; ++r) l_reg += lv[r];
    { auto rr = __builtin_amdgcn_permlane32_swap(__float_as_uint(l_reg), __float_as_uint(l_reg), false, false); l_reg = __uint_as_float(rr[0]) + __uint_as_float(rr[1]); }
    if (hie == 0) li_e[r32e] = (GRP == 0 ? 1.f : -lam) / l_reg;
    asm volatile("s_waitcnt lgkmcnt(0)" ::: "memory");
#pragma unroll
    for (int r = 0; r < 16; ++r) { const float sc_ = li_e[crow(r, hie)];
#pragma unroll
        for (int d = 0; d < 4; ++d) o[d][r] *= sc_; }
    float* xb = (float*)lds;
    __syncthreads();
    if (GRP == 1) {
#pragma unroll
        for (int d = 0; d < 4; ++d)
#pragma unroll
            for (int r = 0; r < 16; ++r) xb[(wq_e * 32 + crow(r, hie)) * 128 + d * 32 + r32e] = o[d][r];
    }
    __syncthreads();
    if (GRP == 0) {
        float ssq[16];
#pragma unroll
        for (int r = 0; r < 16; ++r) { float s_ = 0.f;
#pragma unroll
            for (int d = 0; d < 4; ++d) { const float v = o[d][r] + xb[(wq_e * 32 + crow(r, hie)) * 128 + d * 32 + r32e]; o[d][r] = v; s_ = fmaf(v, v, s_); }
            ssq[r] = s_; }
#pragma unroll
        for (int r = 0; r < 16; ++r) { float s_ = ssq[r]; for (int of = 16; of; of >>= 1) s_ += __shfl_xor(s_, of); ssq[r] = rsqrtf(s_ * (1.f / 128.f) + 1e-6f) * 0.8f; }
        u16* mix = (u16*)(p.ws + OFF_ACT);
#pragma unroll
        for (int d = 0; d < 4; ++d) { const float gv = p.subln_g[d * 32 + r32e];
#pragma unroll
            for (int r = 0; r < 16; ++r) mix[(size_t)(q0 + wq_e * 32 + crow(r, hie)) * 1024 + h * 128 + d * 32 + r32e] = f2bf(o[d][r] * ssq[r] * gv); }
    }
}
DEVI void phase_attn(const P& p, char* lds) {
    const int G = gridDim.x;
    for (int it = blockIdx.x; it < 1024 + 16; it += G) {
        int q0, k0, seq, h;
        if (it < 1024) {
            int bh, qb;
            if ((G & 7) == 0) { bh = it & 7; qb = it >> 3; } else { bh = it >> 7; qb = it & 127; }
            const int b = bh >> 2; h = bh & 3; q0 = b * TT + TC + qb * 128; k0 = b * TT; seq = TT;
        } else { const int j = it - 1024, b = j >> 3; h = (j >> 1) & 3; q0 = b * TT + (j & 1) * 128; k0 = b * TT; seq = TC; }
        int tid = threadIdx.x; asm volatile("" : "+v"(tid));
        a2_body(p, q0, k0, seq, h, lds, tid);
    }
}
DEVI void phase_mlstm_c(const P& p, char* lds) {
    for (int it = blockIdx.x; it < NB * 4 * NCH; it += gridDim.x) mlstm_c_item(p, it, lds);
}

DEVI void tail_bg(const P& p, char* lds, int nunits, int first, int nitems) {
    const int G = gridDim.x, c = blockIdx.x, full = nunits / G, rem = nunits - full * G;
    __syncthreads();
    if (rem == 0) { for (int it = c; it < nitems; it += G) bg_item(p, first + it, (float*)lds); }
    else if (c >= rem) { for (int it = c - rem; it < nitems; it += G - rem) bg_item(p, first + it, (float*)lds); }
    __syncthreads();
}
DEVI void tail_convert(const P& p, char* lds, int layer, int nunits, int lo = 0, int hi = N0_EXP) {
    const int G = gridDim.x, c = blockIdx.x, full = nunits / G, rem = nunits - full * G;
    __syncthreads();
    if (rem == 0) { for (int it = lo + c; it < hi; it += G) convert_expert_item(p, layer, it, (float*)lds); }
    else if (c >= rem) { for (int it = lo + c - rem; it < hi; it += G - rem) convert_expert_item(p, layer, it, (float*)lds); }
    __syncthreads();
}
DEVI void phase_convert_l1(const P& p, char* lds) {
    for (int it = blockIdx.x; it < N0_EXP; it += gridDim.x) convert_expert_item(p, 1, it, (float*)lds);
}

constexpr int NPHASE = 19;
__global__ void __launch_bounds__(NTHR, 2) fwd_kernel(P p_) {
    extern __shared__ __attribute__((aligned(16))) char lds[];
    volatile LAS unsigned* st = (volatile LAS unsigned*)(lds + LDS_BYTES - 16);
    if (threadIdx.x == 0) { st[0] = 0u; st[1] = 0u; st[2] = 0u; st[3] = 0u; }
    __syncthreads();
    const int lo = p_.ph_lo, hi = p_.ph_hi;
    XcdBarrier bar; bar.bar = (unsigned*)(p_.ws + OFF_BAR); bar.x = 0; bar.st = st;
    if (hi - lo > 1) bar = xcd_barrier_post((unsigned*)(p_.ws + OFF_BAR), st);
#if defined(__HIP_DEVICE_COMPILE__)
#define PARAMS() const __attribute__((address_space(4))) P* kp_ = (const __attribute__((address_space(4))) P*)__builtin_amdgcn_kernarg_segment_ptr(); asm volatile("" : "+s"(kp_)); const P p = *kp_
#else
#define PARAMS() const P p = p_
#endif
#ifndef PHSEL
#define PHON(k) true
#else
#define PHON(k) ((k) == PHSEL)
#endif
#define IN(k) (lo <= (k) && (k) < hi)
#define SEAM(k) do { if (IN(k) && IN((k) + ((k) == 5 ? 2 : 1))) xcd_barrier(bar); } while (0)
    if (PHON(0) && IN(0)) { PARAMS(); phase_prologue(p, lds); if (((PROBE_DUP) >> 0) & 1u) { phase_prologue(p, lds); } }            SEAM(0);
    if (PHON(1) && IN(1)) { PARAMS(); phase_norm<0>(p, lds); if (((PROBE_DUP) >> 1) & 1u) { phase_norm<0>(p, lds); } }             SEAM(1);
    if (PHON(2) && IN(2)) { PARAMS(); phase_inproj(p, lds); tail_convert(p, lds, 0, (NTOK / 256) * 14, 0, 4608); if (((PROBE_DUP) >> 2) & 1u) { phase_inproj(p, lds); } }              SEAM(2);
    if (PHON(3) && IN(3)) { PARAMS(); phase_mlstm_a(p, lds); tail_bg(p, lds, NB * 4 * NCH, 0, N0_WOUT); tail_convert(p, lds, 0, NB * 4 * NCH, 4608, N0_EXP); if (((PROBE_DUP) >> 3) & 1u) { phase_mlstm_a(p, lds); } }             SEAM(3);
    if (PHON(4) && IN(4)) { PARAMS(); phase_kmax(p, lds); phase_mlstm_b(p, lds); if (((PROBE_DUP) >> 4) & 1u) { xcd_barrier(bar); phase_mlstm_a(p, lds); xcd_barrier(bar); phase_mlstm_b(p, lds); } }             SEAM(4);
    if (PHON(5) && IN(5)) { PARAMS(); phase_attn(p, lds); phase_mlstm_c(p, lds); tail_bg(p, lds, NB * 4 * NCH, N0_WOUT, N0_FN); if (((PROBE_DUP) >> 5) & 1u) { phase_attn(p, lds); } if (((PROBE_DUP) >> 6) & 1u) { phase_mlstm_c(p, lds); } }   SEAM(5);
    if (PHON(7) && IN(7)) { PARAMS(); phase_outproj(p, lds); tail_convert(p, lds, 1, (NTOK / 256) * 4); if (((PROBE_DUP) >> 7) & 1u) { phase_outproj(p, lds); } }             SEAM(7);
    if (PHON(8) && IN(8)) { PARAMS(); phase_norm<1>(p, lds); if (((PROBE_DUP) >> 8) & 1u) { phase_norm<1, true>(p, lds); } }             SEAM(8);
    if (PHON(9) && IN(9)) { PARAMS(); phase_moe_up(p, 0, lds); if (((PROBE_DUP) >> 9) & 1u) { phase_moe_up(p, 0, lds); } }           SEAM(9);
    if (PHON(10) && IN(10)) { PARAMS(); phase_moe_down(p, 0, lds); if (((PROBE_DUP) >> 10) & 1u) { phase_moe_down<true>(p, 0, lds); } }        SEAM(10);
    if (PHON(11) && IN(11)) { PARAMS(); phase_norm<2>(p, lds); if (((PROBE_DUP) >> 11) & 1u) { phase_norm<2>(p, lds); } } SEAM(11);
    if (PHON(12) && IN(12)) { PARAMS(); phase_fnet_gemm(p, lds); if (((PROBE_DUP) >> 12) & 1u) { phase_fnet_gemm(p, lds); } }          SEAM(12);
    if (PHON(13) && IN(13)) { PARAMS(); phase_fft1(p, lds); if (((PROBE_DUP) >> 13) & 1u) { phase_fft1(p, lds); } }               SEAM(13);
    if (PHON(14) && IN(14)) { PARAMS(); phase_fft2(p, lds); if (((PROBE_DUP) >> 14) & 1u) { phase_fft2<true>(p, lds); } }               SEAM(14);
    if (PHON(15) && IN(15)) { PARAMS(); phase_norm<3>(p, lds); if (((PROBE_DUP) >> 15) & 1u) { phase_norm<3, true>(p, lds); } }            SEAM(15);
    if (PHON(16) && IN(16)) { PARAMS(); phase_moe_up(p, 1, lds); if (((PROBE_DUP) >> 16) & 1u) { phase_moe_up(p, 1, lds); } }          SEAM(16);
    if (PHON(17) && IN(17)) { PARAMS(); phase_moe_down(p, 1, lds); if (((PROBE_DUP) >> 17) & 1u) { phase_moe_down<true>(p, 1, lds); } }        SEAM(17);
    if (PHON(18) && IN(18)) { PARAMS(); phase_norm<4>(p, lds); if (((PROBE_DUP) >> 18) & 1u) { phase_norm<4>(p, lds); } }
#undef IN
#undef SEAM
}

#ifndef ONE_LAUNCH
#define ONE_LAUNCH 1
#endif
extern "C" void kernel_launch(void* const* d_in, const int* in_sizes, int n_in, void* d_out, int out_size, void* d_ws, size_t ws_size, hipStream_t stream) {
    static int grid = 0;
    if (grid == 0) {
        if (n_in != 21 || out_size != NLAT * DM || ws_size < OFF_END) { fprintf(stderr, "kernel_launch: unexpected shapes (n_in %d out %d ws %zu need %zu)\n", n_in, out_size, ws_size, (size_t)OFF_END); grid = -1; return; }
        int dev = 0, cus = 0;
        if (hipGetDevice(&dev) != hipSuccess || hipDeviceGetAttribute(&cus, hipDeviceAttributeMultiprocessorCount, dev) != hipSuccess) { grid = -1; return; }
        if (hipFuncSetAttribute((const void*)fwd_kernel, hipFuncAttributeMaxDynamicSharedMemorySize, LDS_BYTES) != hipSuccess) { fprintf(stderr, "kernel_launch: hipFuncSetAttribute failed\n"); grid = -1; return; }
        int per_cu = 0;
        if (hipOccupancyMaxActiveBlocksPerMultiprocessor(&per_cu, (const void*)fwd_kernel, NTHR, LDS_BYTES) != hipSuccess || per_cu < 1) { fprintf(stderr, "kernel_launch: occupancy query says %d\n", per_cu); (void)hipGetLastError(); grid = -1; return; }
        grid = cus;
    }
    if (grid < 0) return;
    (void)hipMemsetAsync(d_ws, 0, ZERO_BYTES, stream);
    P p{};
    const float* const* in = (const float* const*)d_in;
    p.x = in[0]; p.c = in[1]; p.ctx = in[2]; p.c_ctx = in[3]; p.ada_w = in[4]; p.ada_b = in[5]; p.nmix_g = in[6]; p.nffn_g = in[7];
    p.w_in = in[8]; p.w_out = in[9]; p.conv_w = in[10]; p.gate_b = in[11]; p.lamv = in[12]; p.subln_g = in[13]; p.w_fnet = in[14];
    p.router_w = in[15]; p.router_b = in[16]; p.w_gate = in[17]; p.w_up = in[18]; p.w_down = in[19]; p.final_g = in[20];
    p.out = (float*)d_out; p.ws = (char*)d_ws;
#if ONE_LAUNCH
    p.ph_lo = 0; p.ph_hi = NPHASE;
    hipLaunchKernelGGL(fwd_kernel, dim3(grid), dim3(NTHR), LDS_BYTES, stream, p);
#else
    for (int k = 0; k < NPHASE; ++k) { p.ph_lo = k; p.ph_hi = k + 1; hipLaunchKernelGGL(fwd_kernel, dim3(grid), dim3(NTHR), LDS_BYTES, stream, p); }
#endif
}
```

```cpp
#include <hip/hip_runtime.h>
#include <stdint.h>
#include <stdio.h>

#define DEVI __device__ __forceinline__
#define PROBE_DUP (0u)
typedef unsigned short u16;
typedef unsigned int u32;
using bf16x8 = __attribute__((ext_vector_type(8))) short;
using s16x4  = __attribute__((ext_vector_type(4))) short;
using f32x16 = __attribute__((ext_vector_type(16))) float;
using f32x4  = __attribute__((ext_vector_type(4))) float;
using u32x4  = __attribute__((ext_vector_type(4))) unsigned;
using u32x2  = __attribute__((ext_vector_type(2))) unsigned;

constexpr int DM = 1024, NB = 2, TL = 16384, TC = 256, TT = TL + TC, NTOK = NB * TT, NLAT = NB * TL;
constexpr int NCH = TT / 128;
constexpr int NTHR = 512;
constexpr int LDS_BYTES = 147456;

constexpr size_t al256(size_t x) { return (x + 255) / 256 * 256; }
constexpr size_t OFF_BAR   = 0;
constexpr size_t OFF_CNT   = 16384;
constexpr size_t ZERO_BYTES = 20480;
constexpr size_t OFF_MOD   = ZERO_BYTES;
constexpr size_t OFF_ROPER = OFF_MOD + al256(2 * 3 * 6144 * 4);
constexpr size_t OFF_ROPEC = OFF_ROPER + 256 * 16 * 8;
constexpr size_t OFF_TW    = OFF_ROPEC + 64 * 16 * 8;
constexpr size_t OFF_DFTC  = OFF_TW + 16384 * 8;
constexpr size_t OFF_DFTS  = OFF_DFTC + 32768;
constexpr size_t OFF_LAM   = OFF_DFTS + 32768;
constexpr size_t OFF_WG16  = OFF_LAM + 256;
constexpr size_t OFF_MSCAL = OFF_WG16 + 65536;
constexpr size_t OFF_MST   = OFF_MSCAL + al256(16 * NCH * 8);
constexpr size_t OFF_WINT  = OFF_MST + al256(16 * NCH * 4);
constexpr size_t OFF_WOUTT = OFF_WINT + (size_t)3584 * 1024 * 2;
constexpr size_t OFF_FNT   = OFF_WOUTT + (size_t)1024 * 1024 * 2;
constexpr size_t OFF_WGU   = OFF_FNT + (size_t)2048 * 1024 * 2;
constexpr size_t OFF_WDT   = OFF_WGU + (size_t)16 * 1024 * 1024 * 2;
constexpr size_t OFF_ACT   = OFF_WDT + (size_t)16 * 1024 * 512 * 2;
constexpr size_t SZ_ACT    = (size_t)NTOK * 1024 * 2;
constexpr size_t OFF_XC    = OFF_ACT + SZ_ACT;
constexpr size_t OFF_GATES = OFF_XC + (size_t)NB * TC * 1024 * 4;
constexpr size_t OFF_TOKW  = OFF_GATES + (size_t)NTOK * 16 * 4;
constexpr size_t OFF_LIST  = OFF_TOKW + al256((size_t)NTOK * 8);
constexpr size_t OFF_NST   = OFF_LIST + (size_t)24 * NTOK * 4;
constexpr size_t OFF_CST   = OFF_NST + (size_t)16 * NCH * 128 * 4;
constexpr size_t SZ_CST    = (size_t)16 * NCH * 16384 * 2;
constexpr size_t OFF_BIG   = OFF_CST + SZ_CST;
constexpr size_t OFF_Q     = OFF_BIG;
constexpr size_t OFF_K     = OFF_Q + (size_t)NTOK * 512 * 2;
constexpr size_t OFF_V     = OFF_K + (size_t)NTOK * 512 * 2;
constexpr size_t OFF_MLQK  = OFF_V + (size_t)NTOK * 512 * 2;
constexpr size_t OFF_MLV   = OFF_MLQK + (size_t)NTOK * 1024 * 2;
constexpr size_t OFF_OG    = OFF_MLV + (size_t)NTOK * 512 * 2;
constexpr size_t OFF_MLC   = OFF_OG + (size_t)NTOK * 512 * 2;
constexpr size_t OFF_END   = OFF_MLC + (size_t)NTOK * 1024 * 2;
constexpr size_t OFF_HE    = OFF_BIG;
constexpr size_t OFF_ZR    = OFF_BIG;
constexpr size_t OFF_ZI    = OFF_ZR + (size_t)NLAT * 1024 * 2;
constexpr size_t OFF_WGU1  = OFF_MLV + (size_t)2 * 1024 * 1024;
constexpr size_t OFF_WDT1  = OFF_WGU1 + (size_t)16 * 1024 * 1024 * 2;
static_assert(OFF_WDT1 + (size_t)16 * 1024 * 512 * 2 <= OFF_MLC && OFF_WGU1 >= OFF_BIG + (size_t)NLAT * 2048 * 2, "layer-1 expert region");
constexpr size_t OFF_YR    = OFF_CST;
constexpr size_t OFF_YI    = OFF_ACT;
static_assert((size_t)NLAT * 1024 * 2 <= SZ_CST && (size_t)NLAT * 1024 * 2 <= SZ_ACT, "alias sizes");
static_assert(OFF_END < (size_t)508 * 1024 * 1024, "workspace");

struct P {
    const float *x, *c, *ctx, *c_ctx, *ada_w, *ada_b, *nmix_g, *nffn_g, *w_in, *w_out, *conv_w, *gate_b, *lamv, *subln_g,
                *w_fnet, *router_w, *router_b, *w_gate, *w_up, *w_down, *final_g;
    float* out;
    char* ws;
    int ph_lo, ph_hi;
};

#define XB_TMO      128
#define XB_XCNT(j)  (256  + 64 * (j))
#define XB_XSUB(j)  (1280 + 64 * (j))
#define XB_XGEN(j)  (2304 + 64 * (j))
#define XB_TOP      3328
#define XB_TOPGEN   3392
#define XCD_BAR_WORDS 3456
#define XB_SPIN_CAP (1u << 18)
#define LAS __attribute__((address_space(3)))

__device__ __forceinline__ unsigned xb_ld(unsigned* p)              { return __hip_atomic_load(p, __ATOMIC_RELAXED, __HIP_MEMORY_SCOPE_AGENT); }
__device__ __forceinline__ unsigned xb_add(unsigned* p, unsigned v) { return __hip_atomic_fetch_add(p, v, __ATOMIC_RELAXED, __HIP_MEMORY_SCOPE_AGENT); }
__device__ __forceinline__ unsigned xb_xcc_id() { return (unsigned)__builtin_amdgcn_s_getreg((3 << 11) | 20) & 0xFu; }
#define XB_SPIN(cond, bar) do { unsigned _sp = 0; while (cond) { __builtin_amdgcn_s_sleep(1); \
    if ((++_sp & 255u) == 0u) { if (xb_ld(&(bar)[XB_TMO])) break; if (_sp > XB_SPIN_CAP) { atomicAdd(&(bar)[XB_TMO], 1u); break; } } } } while (0)

struct XcdBarrier { unsigned* bar; unsigned x; volatile LAS unsigned* st; };

__device__ __forceinline__ XcdBarrier xcd_barrier_post(unsigned* bar, volatile LAS unsigned* st) {
    XcdBarrier b; b.bar = bar; b.x = xb_xcc_id(); b.st = st;
    if (threadIdx.x == 0) (void)xb_add(&bar[XB_XCNT(b.x)], 1u);
    return b;
}
__device__ __forceinline__ void xcd_barrier_complete(unsigned* bar, unsigned x, unsigned& nloc, unsigned& nx) {
    const unsigned G = gridDim.x * gridDim.y * gridDim.z;
    unsigned sum, cnt, mine, sp = 0u;
    for (;;) {
        sum = 0u; cnt = 0u; mine = 0u;
#pragma unroll
        for (unsigned j = 0; j < 16; ++j) { const unsigned c = xb_ld(&bar[XB_XCNT(j)]); sum += c; cnt += (c > 0u) ? 1u : 0u; mine = (j == x) ? c : mine; }
        if (sum == G) break;
        __builtin_amdgcn_s_sleep(1);
        if ((++sp & 255u) == 0u) { if (xb_ld(&bar[XB_TMO])) break; if (sp > XB_SPIN_CAP) { atomicAdd(&bar[XB_TMO], 1u); break; } }
    }
    nloc = mine > 0u ? mine : 1u; nx = cnt > 0u ? cnt : 1u;
}
__device__ __forceinline__ void xcd_barrier(const XcdBarrier& b) {
    asm volatile("s_waitcnt vmcnt(0)" ::: "memory");
    __syncthreads();
    if (threadIdx.x == 0) {
        unsigned* bar = b.bar;
        __builtin_amdgcn_s_waitcnt(0);
        unsigned nloc = b.st[0], nx = b.st[1];
        if (nloc == 0u) { xcd_barrier_complete(bar, b.x, nloc, nx); b.st[0] = nloc; b.st[1] = nx; }
        const unsigned old = xb_add(&bar[XB_XSUB(b.x)], 1u);
        const unsigned gen = old / nloc;
        if (old + 1u == (gen + 1u) * nloc) {
            __builtin_amdgcn_fence(__ATOMIC_RELEASE, "agent");
            asm volatile("s_waitcnt vmcnt(0)" ::: "memory");
            const unsigned og = xb_add(&bar[XB_TOP], 1u);
            const unsigned tg = og / nx;
            if (og + 1u == (tg + 1u) * nx) xb_add(&bar[XB_TOPGEN], 1u);
            else XB_SPIN(xb_ld(&bar[XB_TOPGEN]) == tg, bar);
            __builtin_amdgcn_fence(__ATOMIC_ACQUIRE, "agent");
            xb_add(&bar[XB_XGEN(b.x)], 1u);
            asm volatile("s_waitcnt vmcnt(0)" ::: "memory");
        } else {
            XB_SPIN(xb_ld(&bar[XB_XGEN(b.x)]) == gen, bar);
            __builtin_amdgcn_fence(__ATOMIC_ACQUIRE, "agent");
            asm volatile("s_waitcnt vmcnt(0)" ::: "memory");
        }
    }
    __syncthreads();
}

DEVI u16 f2bf(float f) { u32 u = __float_as_uint(f); u += 0x7fffu + ((u >> 16) & 1u); return (u16)(u >> 16); }
DEVI float bf2f(u32 h) { return __uint_as_float(h << 16); }
DEVI u32 cvtpk(float lo, float hi) { u32 r; asm("v_cvt_pk_bf16_f32 %0, %1, %2" : "=v"(r) : "v"(lo), "v"(hi)); return r; }
DEVI float bflo(u32 w) { return __uint_as_float(w << 16); }
DEVI float bfhi(u32 w) { return __uint_as_float(w & 0xffff0000u); }
DEVI int crow(int r, int hi) { return (r & 3) + 8 * (r >> 2) + 4 * hi; }
using f32x2 = __attribute__((ext_vector_type(2))) float;
template <int CTRL> DEVI float dppmov(float v) { return __int_as_float(__builtin_amdgcn_update_dpp(0, __float_as_int(v), CTRL, 0xf, 0xf, true)); }
DEVI float row16_sum(float v) { v += dppmov<0xB1>(v); v += dppmov<0x4E>(v); v += dppmov<0x141>(v); v += dppmov<0x140>(v); return v; }
DEVI float x4row_sum(float x) {
    auto s_ = __builtin_amdgcn_permlane16_swap(__float_as_uint(x), __float_as_uint(x), false, false); x = __uint_as_float(s_[0]) + __uint_as_float(s_[1]);
    auto t_ = __builtin_amdgcn_permlane32_swap(__float_as_uint(x), __float_as_uint(x), false, false); return __uint_as_float(t_[0]) + __uint_as_float(t_[1]);
}
DEVI float wave_sum(float v) { for (int o = 32; o; o >>= 1) v += __shfl_xor(v, o); return v; }
DEVI float wave_max(float v) { for (int o = 32; o; o >>= 1) v = fmaxf(v, __shfl_xor(v, o)); return v; }
DEVI float sigmoidf_(float x) { return __builtin_amdgcn_rcpf(1.f + __expf(-x)); }
DEVI float siluf_(float x) { return x * __builtin_amdgcn_rcpf(1.f + __expf(-x)); }
DEVI float logsigmoidf_(float x) { return fminf(x, 0.f) - log1pf(__expf(-fabsf(x))); }
#define SBAR() __builtin_amdgcn_sched_barrier(0)

DEVI void sincos2pi(double frac, double& s, double& c) {
    frac -= floor(frac);
    double q = rint(frac * 4.0);
    double r = (frac - q * 0.25) * 6.283185307179586476925;
    double r2 = r * r;
    double sr = r * (1.0 + r2 * (-1.0 / 6 + r2 * (1.0 / 120 + r2 * (-1.0 / 5040 + r2 * (1.0 / 362880 + r2 * (-1.0 / 39916800 + r2 * (1.0 / 6227020800.0 + r2 * (-1.0 / 1307674368000.0))))))));
    double cr = 1.0 + r2 * (-0.5 + r2 * (1.0 / 24 + r2 * (-1.0 / 720 + r2 * (1.0 / 40320 + r2 * (-1.0 / 3628800 + r2 * (1.0 / 479001600.0 + r2 * (-1.0 / 87178291200.0 + r2 * (1.0 / 20922789888000.0))))))));
    int qi = ((int)q) & 3;
    if (qi == 0) { s = sr; c = cr; } else if (qi == 1) { s = cr; c = -sr; } else if (qi == 2) { s = -sr; c = -cr; } else { s = -cr; c = sr; }
}

DEVI u16* xs_ptr(const P& p, int layer, int tok) {
    const int row = layer == 0 ? tok : (tok >> 14) * TT + TC + (tok & (TL - 1));
    return (u16*)(p.ws + OFF_MLC) + (size_t)row * DM;
}
DEVI f32x4 bf4_to_f32(u32x2 w) { f32x4 v; v[0] = bflo(w[0]); v[1] = bfhi(w[0]); v[2] = bflo(w[1]); v[3] = bfhi(w[1]); return v; }
DEVI const float* xin_ptr(const P& p, int tok) {
    int b = tok >= TT ? 1 : 0, t = tok - b * TT;
    if (t < TC) return p.ctx + (size_t)(b * TC + t) * DM;
    return p.x + (size_t)(b * TL + t - TC) * DM;
}
DEVI int modsel(int layer, int tok) {
    if (layer == 0) { int b = tok >= TT ? 1 : 0, t = tok - b * TT; return t < TC ? 2 : b; }
    return tok >> 14;
}

DEVI int swz128(int row, int chunk) { return row * 144 + (chunk << 4); }
DEVI int swz256(int row, int chunk) { return row * 272 + (chunk << 4); }
DEVI int v_st(int k, int c) { const int kk = (k & ~0xC) | ((k & 4) << 1) | ((k & 8) >> 1); return ((kk >> 3) * 4 + (c >> 5)) * 512 + ((kk & 7) * 32 + (c & 31)) * 2; }
DEVI int v_rd_base(int lane) { return ((lane & 3) << 3) | (((lane >> 2) & 3) << 6) | (((lane >> 4) & 1) << 5) | (((lane >> 5) & 1) << 8); }
constexpr int v_rd_off(int d0, int ks, int half) { return d0 * 512 + ks * 4096 + half * 2048; }
template <int OFF> DEVI s16x4 tr_read(int vb) {
    s16x4 r; asm volatile("ds_read_b64_tr_b16 %0, %1 offset:%2" : "=&v"(r) : "v"(vb), "i"(OFF) : "memory"); return r;
}
#define PKLH(L, H) (bf16x8){L[0], L[1], L[2], L[3], H[0], H[1], H[2], H[3]}
template <int D0, int KS> DEVI void tr_frag_issue(int vb, s16x4& l, s16x4& h) { l = tr_read<v_rd_off(D0, KS, 0)>(vb); h = tr_read<v_rd_off(D0, KS, 1)>(vb); }
#define LGKM0() do { asm volatile("s_waitcnt lgkmcnt(0)" ::: "memory"); SBAR(); } while (0)

DEVI bf16x8 lds_b128(const char* base, int off) { return *reinterpret_cast<const bf16x8*>(base + off); }

DEVI void pack_p(const f32x16& pp, bf16x8& f0, bf16x8& f1) {
#define PK4(BASE, OUT) do { unsigned a0 = cvtpk(pp[BASE + 0], pp[BASE + 1]), a1 = cvtpk(pp[BASE + 2], pp[BASE + 3]);   \
    unsigned b0 = cvtpk(pp[BASE + 4], pp[BASE + 5]), b1 = cvtpk(pp[BASE + 6], pp[BASE + 7]);                            \
    auto r0 = __builtin_amdgcn_permlane32_swap(a0, b0, false, false); auto r1 = __builtin_amdgcn_permlane32_swap(a1, b1, false, false); \
    u32x4 w = {r0[0], r1[0], r0[1], r1[1]}; OUT = *reinterpret_cast<bf16x8*>(&w); } while (0)
    PK4(0, f0); PK4(8, f1);
#undef PK4
}

DEVI void pack_p_perm(const f32x16& pp, bf16x8& f0, bf16x8& f1) {
    u32x4 a, b;
    a[0] = cvtpk(pp[0], pp[1]); a[1] = cvtpk(pp[2], pp[3]); a[2] = cvtpk(pp[4], pp[5]); a[3] = cvtpk(pp[6], pp[7]);
    b[0] = cvtpk(pp[8], pp[9]); b[1] = cvtpk(pp[10], pp[11]); b[2] = cvtpk(pp[12], pp[13]); b[3] = cvtpk(pp[14], pp[15]);
    f0 = *reinterpret_cast<bf16x8*>(&a); f1 = *reinterpret_cast<bf16x8*>(&b);
}
namespace g8 {
constexpr int BM = 256, BK = 64, HALF = 128, HTB = HALF * BK * 2, STAGE_BYTES = 8 * HTB, NXCD = 8, WGM = 8;
DEVI int lds_byte(int r, int c) { const int st = (r >> 4) * 2 + (c >> 5), rr = r & 15, cc = c & 31, ob = rr * 64 + cc * 2; return st * 1024 + (ob ^ (((ob >> 9) & 1) << 5)); }
DEVI void stage_rc(int b, int& R, int& C) { const int st = b / 1024, sb = b % 1024, swz = sb ^ (((sb >> 9) & 1) << 5); R = (st >> 1) * 16 + swz / 64; C = (st & 1) * 32 + (swz % 64) / 2; }
DEVI int perm32(int rho) { const int n = rho >> 4, i = rho & 15; return 8 * (i >> 2) + 4 * n + (i & 3); }
struct Unit { int pm, pn; const char* B0; const char* B1; int cls, r0, ncls; };
DEVI bool tile_order(int i, int G, int c, int nM, int nN, int& pm, int& pn) {
    const int nwg = nM * nN; const long L = (long)i * G + c; if (L >= nwg) return false;
    int wgid = (int)L; { const int q = nwg / NXCD, r = nwg % NXCD, xcd = wgid % NXCD, off = wgid / NXCD; wgid = (xcd < r ? xcd * (q + 1) : r * (q + 1) + (xcd - r) * q) + off; }
    const int nig = WGM * nN, gid = wgid / nig, fm = gid * WGM, gsz = (nM - fm) < WGM ? (nM - fm) : WGM;
    pm = fm + ((wgid % nig) % gsz); pn = (wgid % nig) / gsz; return true;
}
typedef float f32x4v __attribute__((ext_vector_type(4)));
template <class Epi, class Sched, int NT = 16  , int LDA = 2048  >
DEVI void gemm_phase(LAS unsigned char* lds, const char* Abase, int ldbB  , int ksplit  , const Sched& S, const Epi& E) {
    const int tid = threadIdx.x, wid = __builtin_amdgcn_readfirstlane(tid >> 6), lane = tid & 63, wr = wid >> 2, wc = wid & 3, fr = lane & 15, fq = lane >> 4;
    constexpr int nt = NT;
    unsigned voffB[2];
#pragma unroll
    for (int i = 0; i < 2; ++i) { int R, C; stage_rc(tid * 16 + i * 8192, R, C); const int Rb = Epi::PERM ? ((R & ~31) + perm32(R & 31)) : R; voffB[i] = (unsigned)(Rb * ldbB + C * 2); }
    const size_t kstep = (size_t)(BK * 2);
    const size_t hstepB = (size_t)HALF * ldbB;
    const unsigned ldsw = (unsigned)wid * 1024u;
    const int aoff = lds_byte(wr * 64 + fr, fq * 8), boff = lds_byte(wc * 32 + fr, fq * 8);
#define G8_SA(b, h) (((b) * 2 + (h)) * HTB)
#define G8_SB(b, h) ((4 + (b) * 2 + (h)) * HTB)
#define G8_STAGE(bufoff, gbase, voff) do { _Pragma("unroll") for (int _i = 0; _i < 2; ++_i) \
        __builtin_amdgcn_global_load_lds((const unsigned*)((const char*)(gbase) + (voff)[_i]), (LAS unsigned*)(lds + (bufoff) + ldsw + _i * 8192), 16, 0, 0); } while (0)
#define G8_LDA(dst, b, h) do { _Pragma("unroll") for (int m = 0; m < 4; ++m) _Pragma("unroll") for (int k = 0; k < 2; ++k) dst[m][k] = *(const LAS bf16x8*)(lds + G8_SA(b, h) + aoff + m * 2048 + k * 1024); } while (0)
#define G8_LDB(dst, b, h) do { _Pragma("unroll") for (int n = 0; n < 2; ++n) _Pragma("unroll") for (int k = 0; k < 2; ++k) dst[n][k] = *(const LAS bf16x8*)(lds + G8_SB(b, h) + boff + n * 2048 + k * 1024); } while (0)
#define G8_MMA(ai, bj, At, Bt) do { __builtin_amdgcn_s_setprio(1); _Pragma("unroll") for (int m = 0; m < 4; ++m) _Pragma("unroll") for (int n = 0; n < 2; ++n) _Pragma("unroll") for (int k = 0; k < 2; ++k) \
        acc[ai][bj][m][n] = __builtin_amdgcn_mfma_f32_16x16x32_bf16(Bt[n][k], At[m][k], acc[ai][bj][m][n], 0, 0, 0); __builtin_amdgcn_s_setprio(0); } while (0)
#define G8_WAIT_V(n) asm volatile("s_waitcnt vmcnt(" #n ")" ::: "memory")
#define G8_WAIT_L(n) asm volatile("s_waitcnt lgkmcnt(" #n ")" ::: "memory")
#define G8_BAR __builtin_amdgcn_s_barrier()
#define G8_SCHED __builtin_amdgcn_sched_barrier(0)
#define G8_BPTR(u, kt) (((kt) < ksplit ? (u).B0 : (u).B1) + (size_t)(kt) * kstep)
    Unit cur, nxt; int ui = 0;
    if (!S.next(0, cur)) return;
    f32x4v acc[2][2][4][2];
#pragma unroll
    for (int a = 0; a < 2; ++a)
#pragma unroll
        for (int b = 0; b < 2; ++b)
#pragma unroll
            for (int m = 0; m < 4; ++m)
#pragma unroll
                for (int n = 0; n < 2; ++n) acc[a][b][m][n] = (f32x4v){0.f, 0.f, 0.f, 0.f};
    bf16x8 At[4][2], B0[2][2], B1[2][2];
    unsigned voffA[2]; unsigned vs[2][2];
    constexpr size_t hstepA = (size_t)HALF * LDA, tstepA = 2 * hstepA;
    if constexpr (Sched::GATHER) S.aoffs(cur, vs);
    else {
#pragma unroll
        for (int i = 0; i < 2; ++i) { int R, C; stage_rc(tid * 16 + i * 8192, R, C); voffA[i] = (unsigned)(R * LDA + C * 2); }
    }
    const char* cA = Sched::GATHER ? Abase : S.abase(cur, Abase) + (size_t)cur.pm * tstepA;
#define G8_STAGE_A(bufoff, ptr, h) do { if constexpr (Sched::GATHER) G8_STAGE(bufoff, ptr, vs[h]); else G8_STAGE(bufoff, (ptr) + (h) * hstepA, voffA); } while (0)
    { const char* cB = G8_BPTR(cur, 0); const char* cB1 = G8_BPTR(cur, 1);
      G8_STAGE(G8_SB(0, 0), cB, voffB); G8_STAGE_A(G8_SA(0, 0), cA, 0); G8_STAGE(G8_SB(0, 1), cB + hstepB, voffB); G8_STAGE_A(G8_SA(0, 1), cA, 1);
      if (wr == 1) G8_BAR;
      G8_WAIT_V(4); G8_BAR;
      G8_STAGE(G8_SB(1, 0), cB1, voffB); G8_STAGE_A(G8_SA(1, 0), cA + kstep, 0); G8_STAGE(G8_SB(1, 1), cB1 + hstepB, voffB);
      G8_WAIT_V(6); G8_BAR; }
    for (;;) {
        bool has_next = false; const char* nA = cA;
        for (int t = 0; t < nt; t += 2) {
            const bool last = (t == nt - 2);
            const char* a1 = cA + (size_t)(t + 1) * kstep;
            G8_LDB(B0, 0, 0); G8_SCHED; G8_LDA(At, 0, 0); G8_STAGE_A(G8_SA(1, 1), a1, 1);
            G8_WAIT_L(8); G8_BAR; G8_WAIT_L(0); G8_MMA(0, 0, At, B0); G8_BAR; G8_SCHED;
            if (last) {
                has_next = S.next(ui + 1, nxt);
                if (has_next) { if constexpr (Sched::GATHER) S.aoffs(nxt, vs); else nA = S.abase(nxt, Abase) + (size_t)nxt.pm * tstepA; } else nxt = cur;
            }
            const char* a2 = last ? nA : cA + (size_t)(t + 2) * kstep; const char* a3 = a2 + kstep;
            const char* b2 = last ? G8_BPTR(nxt, 0) : G8_BPTR(cur, t + 2); const char* b3 = last ? G8_BPTR(nxt, 1) : G8_BPTR(cur, t + 3);
            G8_LDB(B1, 0, 1); G8_STAGE(G8_SB(0, 0), b2, voffB);
            G8_BAR; G8_WAIT_L(0); G8_MMA(0, 1, At, B1); G8_BAR;
            G8_LDA(At, 0, 1); G8_STAGE_A(G8_SA(0, 0), a2, 0);
            G8_BAR; G8_WAIT_L(0); G8_MMA(1, 0, At, B0); G8_BAR; G8_SCHED;
            G8_STAGE(G8_SB(0, 1), b2 + hstepB, voffB);
            G8_WAIT_V(6); G8_BAR; G8_MMA(1, 1, At, B1); G8_BAR;
            G8_LDB(B0, 1, 0); G8_SCHED; G8_LDA(At, 1, 0); G8_STAGE_A(G8_SA(0, 1), a2, 1);
            G8_WAIT_L(8); G8_BAR; G8_WAIT_L(0); G8_MMA(0, 0, At, B0); G8_BAR; G8_SCHED;
            G8_LDB(B1, 1, 1); G8_STAGE(G8_SB(1, 0), b3, voffB);
            G8_BAR; G8_WAIT_L(0); G8_MMA(0, 1, At, B1); G8_BAR;
            G8_LDA(At, 1, 1); G8_STAGE_A(G8_SA(1, 0), a3, 0);
            G8_BAR; G8_WAIT_L(0); G8_MMA(1, 0, At, B0); G8_BAR; G8_SCHED;
            G8_STAGE(G8_SB(1, 1), b3 + hstepB, voffB);
            G8_WAIT_V(6); G8_BAR; G8_MMA(1, 1, At, B1); G8_BAR;
        }
        cA = nA;
        { int tz = threadIdx.x; asm volatile("" : "+v"(tz));
          const int w2 = tz >> 6, l2 = tz & 63; E(acc, cur, w2 >> 2, w2 & 3, l2 & 15, l2 >> 4); }
        if (!has_next) break;
#pragma unroll
        for (int a = 0; a < 2; ++a)
#pragma unroll
            for (int b = 0; b < 2; ++b)
#pragma unroll
                for (int m = 0; m < 4; ++m)
#pragma unroll
                    for (int n = 0; n < 2; ++n) acc[a][b][m][n] = (f32x4v){0.f, 0.f, 0.f, 0.f};
        cur = nxt; ++ui;
    }
    G8_WAIT_V(0);
    if (wr == 0) G8_BAR;
    G8_BAR;
#undef G8_SA
#undef G8_SB
#undef G8_STAGE
#undef G8_STAGE_A
#undef G8_LDA
#undef G8_LDB
#undef G8_MMA
#undef G8_WAIT_V
#undef G8_WAIT_L
#undef G8_BAR
#undef G8_SCHED
#undef G8_BPTR
}
DEVI void lane_rc(int i, int& R, int& C) { int tz = threadIdx.x; asm volatile("" : "+v"(tz)); stage_rc(tz * 16 + i * 8192, R, C); }
struct DenseSched {
    static constexpr bool GATHER = false;
    const char* Bt; int nM, nN, G, c; size_t btile;
    DEVI const char* abase(const Unit&, const char* a) const { return a; }
    DEVI bool next(int i, Unit& u) const { if (!tile_order(i, G, c, nM, nN, u.pm, u.pn)) return false; u.B0 = u.B1 = Bt + (size_t)u.pn * btile; u.cls = 0; u.r0 = 0; u.ncls = 0; return true; }
    DEVI void aoffs(const Unit& u, unsigned (&v)[2][2]) const {
#pragma unroll
        for (int i = 0; i < 2; ++i) { int R, C; lane_rc(i, R, C);
#pragma unroll
            for (int h = 0; h < 2; ++h) v[h][i] = (unsigned)(((u.pm * 256 + h * 128 + R) * 1024 + C) * 2); }
    }
};
}

template <class PF>
DEVI void transpose_tile(PF colptr, int ldsrc, u16* dst, int lddst, int k0, int n0, float* tl) {
    const int t = threadIdx.x, nn = t & 63, kk = t >> 6;
    const float* sp = colptr(n0 + nn);
#pragma unroll
    for (int i = 0; i < 8; ++i) tl[(kk + 8 * i) * 65 + nn] = sp[(size_t)(k0 + kk + 8 * i) * ldsrc];
    __syncthreads();
    const int n = t >> 3, kc = t & 7;
    u32x4 w;
    w[0] = cvtpk(tl[(kc * 8 + 0) * 65 + n], tl[(kc * 8 + 1) * 65 + n]);
    w[1] = cvtpk(tl[(kc * 8 + 2) * 65 + n], tl[(kc * 8 + 3) * 65 + n]);
    w[2] = cvtpk(tl[(kc * 8 + 4) * 65 + n], tl[(kc * 8 + 5) * 65 + n]);
    w[3] = cvtpk(tl[(kc * 8 + 6) * 65 + n], tl[(kc * 8 + 7) * 65 + n]);
    *reinterpret_cast<u32x4*>(dst + (size_t)(n0 + n) * lddst + k0 + kc * 8) = w;
    __syncthreads();
}

DEVI void convert_expert_item(const P& p, int layer, int it, float* tl) {
    const int e = it / 384, r = it % 384;
    const float* wg = p.w_gate + ((size_t)layer * 16 + e) * 1024 * 512;
    const float* wu = p.w_up   + ((size_t)layer * 16 + e) * 1024 * 512;
    const float* wd = p.w_down + ((size_t)layer * 16 + e) * 512 * 1024;
    if (r < 256) {
        u16* dst = (u16*)(p.ws + (layer ? OFF_WGU1 : OFF_WGU)) + (size_t)e * 1024 * 1024;
        const int kt = r >> 4, nt = r & 15;
        transpose_tile([&](int n) { const int q = n >> 8, sgu = (n >> 7) & 1, j = n & 127; return (sgu ? wu : wg) + q * 128 + j; }, 512, dst, 1024, kt * 64, nt * 64, tl);
    } else {
        const int q = r - 256; u16* dst = (u16*)(p.ws + (layer ? OFF_WDT1 : OFF_WDT)) + (size_t)e * 1024 * 512;
        const int kt = q >> 4, nt = q & 15;
        transpose_tile([&](int n) { return wd + n; }, 1024, dst, 512, kt * 64, nt * 64, tl);
    }
}

constexpr int N0_WIN = 16 * 56, N0_WOUT = 256, N0_EXP = 16 * 384, N0_FN = 1024, N0_MOD = 192, N0_TAB = 128;
constexpr int N0_TOTAL = N0_WIN + N0_MOD + N0_TAB;
constexpr int NBG = N0_WOUT + N0_FN;
DEVI void bg_item(const P& p, int it, float* tl) {
    const int tid = threadIdx.x;
    int r = it;
    if (r < N0_WOUT) {
        const int kt = r >> 4, nt = r & 15; const float* w = p.w_out;
        transpose_tile([&](int n) { return w + n; }, 1024, (u16*)(p.ws + OFF_WOUTT), 1024, kt * 64, nt * 64, tl);
        return;
    }
    r -= N0_WOUT;
    {
        const int idx = r * 512 + tid, c = idx & 127, g = (idx >> 7) & 3, n = idx >> 9;
        double sd, cd; sincos2pi(c / 256.0, sd, cd);
        const float ct = (float)cd, st = (float)sd;
        const float* W = p.w_fnet + (size_t)(g * 256) * 1024 + n;
        float ac = 0.f, as = 0.f, a128 = 0.f, cr = 1.f, sr = 0.f, sg = 1.f;
        for (int c2 = 0; c2 < 256; ++c2) {
            const float w = W[(size_t)c2 * 1024];
            ac = fmaf(cr, w, ac); as = fmaf(sr, w, as); a128 = fmaf(sg, w, a128); sg = -sg;
            const float cn = cr * ct - sr * st; sr = fmaf(sr, ct, cr * st); cr = cn;
        }
        u16* Ah = (u16*)(p.ws + OFF_FNT); u16* Bh = Ah + (size_t)1024 * 512; float* A128 = (float*)(p.ws + OFF_FNT + (size_t)2 * 1024 * 512 * 2);
        Ah[(size_t)n * 512 + g * 128 + c] = f2bf(ac * (1.f / 2048.f)); Bh[(size_t)n * 512 + g * 128 + c] = f2bf(-as * (1.f / 2048.f));
        if (c == 0) A128[g * 1024 + n] = a128 * (1.f / 2048.f);
    }
}
DEVI void bg_fill(const P& p, char* lds, int q, int lo, int hi) {
    int* sh = (int*)(lds + 32768);
    for (;;) {
        __syncthreads();
        if (threadIdx.x == 0) *sh = lo + 4 * (int)atomicAdd((unsigned*)(p.ws + OFF_CNT) + 160 + q, 1u);
        __syncthreads();
        const int it0 = *sh;
        if (it0 >= hi) break;
        for (int it = it0; it < it0 + 4 && it < hi; ++it) bg_item(p, it, (float*)lds);
    }
    __syncthreads();
}

DEVI void phase_prologue(const P& p, char* lds) {
    float* tl = (float*)lds;
    const int tid = threadIdx.x;
    for (int it = blockIdx.x; it < N0_TOTAL; it += gridDim.x) {
        int r = it;
        if (r < N0_WIN) {
            const int kt = r / 56, nt = r % 56;
            const float* w = p.w_in;
            transpose_tile([&](int n) { return w + n; },
                           3600, (u16*)(p.ws + OFF_WINT), 1024, kt * 64, nt * 64, tl);
            continue;
        }
        r -= N0_WIN;
        if (r < N0_MOD) {
            float* sv = tl;
            float* part = tl + 3072;
            for (int i = tid; i < 3072; i += NTHR) { const int v = i >> 10, k = i & 1023; const float xv = v < 2 ? p.c[v * 1024 + k] : p.c_ctx[k]; sv[i] = siluf_(xv); }
            __syncthreads();
            const int j0 = r * 64, L = j0 / 6144, col0 = j0 % 6144, kg = tid >> 6, cl = tid & 63;
            const float* W = p.ada_w + (size_t)L * 1024 * 6144 + col0 + cl;
            float a0 = 0.f, a1 = 0.f, a2 = 0.f;
            for (int k = kg * 128; k < kg * 128 + 128; ++k) { const float w = W[(size_t)k * 6144]; a0 = fmaf(sv[k], w, a0); a1 = fmaf(sv[1024 + k], w, a1); a2 = fmaf(sv[2048 + k], w, a2); }
            part[(kg * 3 + 0) * 64 + cl] = a0; part[(kg * 3 + 1) * 64 + cl] = a1; part[(kg * 3 + 2) * 64 + cl] = a2;
            __syncthreads();
            if (tid < 192) {
                const int v = tid >> 6, c2 = tid & 63; float s = 0.f;
                for (int g = 0; g < 8; ++g) s += part[(g * 3 + v) * 64 + c2];
                ((float*)(p.ws + OFF_MOD))[(size_t)(L * 3 + v) * 6144 + col0 + c2] = s + p.ada_b[L * 6144 + col0 + c2];
            }
            __syncthreads();
            continue;
        }
        r -= N0_MOD;
        {
            const int e = r * 512 + tid;
            if (e < 4096 + 1024) {
                const bool isr = e < 4096; const int ee = isr ? e : e - 4096; const int pos = ee >> 4, j = ee & 15;
                double inv = 1.0; for (int q = 0; q < j; ++q) inv *= 0.56234132519034908;
                const float invf = (float)inv; const float ang = (float)pos * invf;
                double s, c; sincos2pi((double)ang * 0.15915494309189533577, s, c);
                float2 v = make_float2((float)c, (float)s);
                if (isr) ((float2*)(p.ws + OFF_ROPER))[ee] = v; else ((float2*)(p.ws + OFF_ROPEC))[ee] = v;
            } else if (e < 5120 + 16384) {
                const int m = e - 5120; double s, c; sincos2pi(m / 16384.0, s, c);
                ((float2*)(p.ws + OFF_TW))[m] = make_float2((float)c, (float)s);
            } else if (e < 5120 + 32768) {
                const int m = e - 5120 - 16384, k = m >> 7, t = m & 127; double s, c; sincos2pi(((k * t) & 127) / 128.0, s, c);
                ((u16*)(p.ws + OFF_DFTC))[m] = f2bf((float)c); ((u16*)(p.ws + OFF_DFTS))[m] = f2bf((float)s);
            } else if (e < 5120 + 49152) {
                const int m = e - 5120 - 32768, k = m >> 4, g = m & 15;
                ((float*)(p.ws + OFF_WG16))[m] = p.w_in[(size_t)k * 3600 + 3584 + g];
            } else if (e == 5120 + 49152) {
                float s01 = 0.f, s23 = 0.f;
                for (int i = 0; i < 64; ++i) { s01 += p.lamv[i] * p.lamv[64 + i]; s23 += p.lamv[128 + i] * p.lamv[192 + i]; }
                ((float*)(p.ws + OFF_LAM))[0] = expf(s01) - expf(s23) + 0.2f;
            }
        }
    }
}

template <int MODE, bool DRY = false>
DEVI void phase_norm(const P& p, char* lds) {
    constexpr int layer = (MODE == 0 || MODE == 1) ? 0 : 1;
    constexpr bool side = (MODE == 0 || MODE == 1 || MODE == 3);
    const int nrows = layer == 0 ? NTOK : NLAT;
    const int tid = threadIdx.x, lane = tid & 63, wid = __builtin_amdgcn_readfirstlane(tid >> 6);
    f32x4* sl = (f32x4*)lds;
    if (side) {
        const float* S = (MODE == 0) ? (const float*)(p.ws + OFF_WG16) : p.router_w;
        for (int i = tid; i < 4096; i += NTHR) { const int eg = i >> 10, col = i & 1023; const int pc = (col >> 8) * 256 + (col & 3) * 64 + ((col >> 2) & 63);
            sl[eg * 1024 + pc] = *reinterpret_cast<const f32x4*>(S + col * 16 + eg * 4); }
        __syncthreads();
    }
    const float* g = MODE == 0 ? p.nmix_g : MODE == 1 ? p.nffn_g : MODE == 2 ? p.nmix_g + 1024 : MODE == 3 ? p.nffn_g + 1024 : p.final_g;
    const float* modb = (const float*)(p.ws + OFF_MOD) + (size_t)layer * 3 * 6144;
    constexpr int sh_i = (MODE == 0 || MODE == 2) ? 0 : 3;
    u16* act = (u16*)(p.ws + OFF_ACT);
    int npend = 0, pcls = 0, prow = 0; float pwl = 0.f, pwh = 0.f; float keep[16];
#pragma unroll
    for (int e = 0; e < 16; ++e) keep[e] = 0.f;
    const int c0 = 4 * lane;
    const int rstep = gridDim.x * 8;
    float A[16], B[16]; int cur_ms = -1;
#pragma unroll
    for (int e = 0; e < 16; ++e) { A[e] = 0.f; B[e] = 0.f; }
    if (MODE == 4) {
#pragma unroll
        for (int i = 0; i < 4; ++i) { const f32x4 gv = *reinterpret_cast<const f32x4*>(g + c0 + 256 * i); A[4 * i] = gv[0]; A[4 * i + 1] = gv[1]; A[4 * i + 2] = gv[2]; A[4 * i + 3] = gv[3]; }
    }
    const int my_e = ((lane >> 2) & 1) * 8 + ((lane >> 1) & 1) * 4 + (lane & 1) * 2 + ((lane >> 3) & 1);
    float my_gb = 0.f; if (MODE == 0) my_gb = p.gate_b[my_e];
    f32x4 xfA[4], xfB[4]; u32x2 xbA[4], xbB[4];
#define NORM_REQ(R, XF, XB) do { if (MODE == 0) { const float* src_ = xin_ptr(p, (R)); _Pragma("unroll") for (int i = 0; i < 4; ++i) XF[i] = *reinterpret_cast<const f32x4*>(src_ + c0 + 256 * i); } \
        else { const u16* src_ = xs_ptr(p, layer, (R)); _Pragma("unroll") for (int i = 0; i < 4; ++i) XB[i] = *reinterpret_cast<const u32x2*>(src_ + c0 + 256 * i); } } while (0)
    const int row0 = blockIdx.x * 8 + wid;
    NORM_REQ(row0, xfA, xbA);
    NORM_REQ(row0 + rstep, xfB, xbB);
    auto body = [&](const int row, f32x4 (&xf)[4], u32x2 (&xb)[4]) __attribute__((always_inline)) {
        f32x4 xv[4]; float ss = 0.f;
#pragma unroll
        for (int i = 0; i < 4; ++i) xv[i] = (MODE == 0) ? xf[i] : bf4_to_f32(xb[i]);
        { const int nrow = min(row + 2 * rstep, nrows - 1); NORM_REQ(nrow, xf, xb); }
        f32x4 wq[2][8];
        if (side) {
#pragma unroll
            for (int jj = 0; jj < 2; ++jj)
#pragma unroll
                for (int eg = 0; eg < 4; ++eg) wq[0][jj * 4 + eg] = sl[eg * 1024 + jj * 64 + lane];
        }
#pragma unroll
        for (int i = 0; i < 4; ++i) { ss = fmaf(xv[i][0], xv[i][0], ss); ss = fmaf(xv[i][1], xv[i][1], ss); ss = fmaf(xv[i][2], xv[i][2], ss); ss = fmaf(xv[i][3], xv[i][3], ss); }
        ss = x4row_sum(row16_sum(ss));
        const float rstd = rsqrtf(ss * (1.f / 1024.f) + 1e-6f);
        if (MODE == 4) {
            float* dst = p.out + (size_t)row * DM;
#pragma unroll
            for (int i = 0; i < 4; ++i) { f32x4 o; o[0] = xv[i][0] * rstd * A[4 * i]; o[1] = xv[i][1] * rstd * A[4 * i + 1]; o[2] = xv[i][2] * rstd * A[4 * i + 2]; o[3] = xv[i][3] * rstd * A[4 * i + 3];
                *reinterpret_cast<f32x4*>(dst + c0 + 256 * i) = o; }
            return;
        }
        const int ms = modsel(layer, row);
        if (ms != cur_ms) {
            cur_ms = ms;
            const float* mv = modb + (size_t)ms * 6144;
#pragma unroll
            for (int i = 0; i < 4; ++i) {
                const f32x4 gv = *reinterpret_cast<const f32x4*>(g + c0 + 256 * i), scv = *reinterpret_cast<const f32x4*>(mv + (sh_i + 1) * 1024 + c0 + 256 * i),
                            shv = *reinterpret_cast<const f32x4*>(mv + sh_i * 1024 + c0 + 256 * i);
#pragma unroll
                for (int j = 0; j < 4; ++j) { A[4 * i + j] = gv[j] * (1.f + scv[j]); B[4 * i + j] = shv[j]; }
            }
            __builtin_amdgcn_s_waitcnt(0x0F70);
        }
        if (MODE == 2) {
            f32x4 h[4];
#pragma unroll
            for (int i = 0; i < 4; ++i)
#pragma unroll
                for (int j = 0; j < 4; ++j) h[i][j] = fmaf(xv[i][j] * rstd, A[4 * i + j], B[4 * i + j]);
#pragma unroll
            for (int i = 0; i < 4; ++i) {
                const float p0 = __shfl(h[i][0], (64 - lane) & 63), p1 = __shfl(h[i][3], 63 - lane), p2 = __shfl(h[i][2], 63 - lane), p3 = __shfl(h[i][1], 63 - lane), h128 = __shfl(h[i][0], 32);
                const float u0 = lane == 0 ? h[i][0] : h[i][0] + p0, v0 = lane == 0 ? h128 : h[i][0] - p0;
                if (lane < 32) {
                    u32x2 wu, wv; wu[0] = cvtpk(u0, h[i][1] + p1); wu[1] = cvtpk(h[i][2] + p2, h[i][3] + p3); wv[0] = cvtpk(v0, h[i][1] - p1); wv[1] = cvtpk(h[i][2] - p2, h[i][3] - p3);
                    *reinterpret_cast<u32x2*>((u16*)(p.ws + OFF_ACT) + (size_t)row * 512 + i * 128 + c0) = wu;
                    *reinterpret_cast<u32x2*>((u16*)(p.ws + OFF_ACT) + (size_t)NLAT * 512 + (size_t)row * 512 + i * 128 + c0) = wv;
                }
            }
            return;
        }
        f32x2 acc2[8];
#pragma unroll
        for (int e = 0; e < 8; ++e) { acc2[e][0] = 0.f; acc2[e][1] = 0.f; }
#pragma unroll
        for (int i = 0; i < 4; ++i) {
            f32x4 h;
#pragma unroll
            for (int j = 0; j < 4; ++j) h[j] = fmaf(xv[i][j] * rstd, A[4 * i + j], B[4 * i + j]);
            { u32x2 w2; w2[0] = cvtpk(h[0], h[1]); w2[1] = cvtpk(h[2], h[3]); *reinterpret_cast<u32x2*>(act + (size_t)row * DM + c0 + 256 * i) = w2; }
            if (side) {
#pragma unroll
                for (int jp = 0; jp < 2; ++jp) {
                    const int gi = i * 2 + jp;
                    if (gi + 1 < 8) {
#pragma unroll
                        for (int jj = 0; jj < 2; ++jj)
#pragma unroll
                            for (int eg = 0; eg < 4; ++eg) wq[(gi + 1) & 1][jj * 4 + eg] = sl[eg * 1024 + ((gi + 1) >> 1) * 256 + (((gi + 1) & 1) * 2 + jj) * 64 + lane];
                    }
                    asm volatile("" ::: "memory");
#pragma unroll
                    for (int jj = 0; jj < 2; ++jj) {
                        f32x2 hh; hh[0] = h[jp * 2 + jj]; hh[1] = hh[0];
#pragma unroll
                        for (int eg = 0; eg < 4; ++eg) { const f32x4 w = wq[gi & 1][jj * 4 + eg]; f32x2 wl, wh; wl[0] = w[0]; wl[1] = w[1]; wh[0] = w[2]; wh[1] = w[3];
                            acc2[eg * 2] = hh * wl + acc2[eg * 2]; acc2[eg * 2 + 1] = hh * wh + acc2[eg * 2 + 1]; }
                    }
                    asm volatile("" : "+v"(acc2[0]), "+v"(acc2[1]), "+v"(acc2[2]), "+v"(acc2[3]), "+v"(acc2[4]), "+v"(acc2[5]), "+v"(acc2[6]), "+v"(acc2[7]) :: "memory");
                }
            }
        }
        if (side) {
            float acc[16];
#pragma unroll
            for (int e = 0; e < 8; ++e) { acc[2 * e] = acc2[e][0]; acc[2 * e + 1] = acc2[e][1]; }
            float r8[8], r4[4], r2[2], tot;
            { const bool up = lane & 4;
#pragma unroll
              for (int i = 0; i < 8; ++i) { const float snd = up ? acc[i] : acc[i + 8], kp = up ? acc[i + 8] : acc[i]; r8[i] = kp + dppmov<0x141>(snd); } }
            { const bool up = lane & 2;
#pragma unroll
              for (int i = 0; i < 4; ++i) { const float snd = up ? r8[i] : r8[i + 4], kp = up ? r8[i + 4] : r8[i]; r4[i] = kp + dppmov<0x4E>(snd); } }
            { const bool up = lane & 1;
#pragma unroll
              for (int i = 0; i < 2; ++i) { const float snd = up ? r4[i] : r4[i + 2], kp = up ? r4[i + 2] : r4[i]; r2[i] = kp + dppmov<0xB1>(snd); } }
            { const bool up = lane & 8; const float snd = up ? r2[0] : r2[1], kp = up ? r2[1] : r2[0]; tot = kp + dppmov<0x128>(snd); }
            tot = x4row_sum(tot);
            if (MODE == 0) {
                if (lane < 16) {
                    float v = tot + my_gb;
                    const int type = my_e >> 2;
                    if (type == 1 || type == 3) v = logsigmoidf_(v);
                    ((float*)(p.ws + OFF_GATES))[(size_t)row * 16 + my_e] = v;
                }
            } else {
#pragma unroll
                for (int e = 0; e < 16; ++e) { constexpr int dummy = 0; (void)dummy; const int L = ((e >> 3) & 1) * 4 + ((e >> 2) & 1) * 2 + ((e >> 1) & 1) + (e & 1) * 8;
                    const float te = __uint_as_float(__builtin_amdgcn_readlane(__float_as_uint(tot), L)); keep[e] = (lane == npend) ? te : keep[e]; }
                if (lane == npend) prow = row;
                ++npend;
            }
        }
    };
    body(row0, xfA, xbA); body(row0 + rstep, xfB, xbB);
    int row = row0 + 2 * rstep;
    for (; row + rstep < nrows; row += 2 * rstep) { body(row, xfA, xbA); body(row + rstep, xfB, xbB); }
    if (row < nrows) body(row, xfA, xbA);
#undef NORM_REQ
    if (MODE == 1 || MODE == 3) {
        {
            float aff[16], bi[16];
#pragma unroll
            for (int e = 0; e < 16; ++e) { aff[e] = sigmoidf_(keep[e]); bi[e] = aff[e] + p.router_b[e]; }
            int bg = 0, ba = 0, bb = 1; float bscore = -1e30f;
#pragma unroll
            for (int gq = 0; gq < 4; ++gq) {
                int ia = 0; float va = bi[gq * 4];
#pragma unroll
                for (int j = 1; j < 4; ++j) if (bi[gq * 4 + j] > va) { va = bi[gq * 4 + j]; ia = j; }
                int ib = -1; float vb = -1e30f;
#pragma unroll
                for (int j = 0; j < 4; ++j) if (j != ia && bi[gq * 4 + j] > vb) { vb = bi[gq * 4 + j]; ib = j; }
                const float sc = va + vb;
                if (sc > bscore) { bscore = sc; bg = gq; ba = ia; bb = ib; }
            }
            const int lo = ba < bb ? ba : bb, hi2 = ba < bb ? bb : ba;
            float alo = 0.f, ahi = 0.f;
#pragma unroll
            for (int e = 0; e < 16; ++e) { if (e == bg * 4 + lo) alo = aff[e]; if (e == bg * 4 + hi2) ahi = aff[e]; }
            const float inv = 1.f / (alo + ahi);
            const int pair = lo == 0 ? hi2 - 1 : (lo == 1 ? hi2 + 1 : 5);
            pcls = bg * 6 + pair; pwl = alo * inv; pwh = ahi * inv;
        }
        unsigned* lc = (unsigned*)(lds + 65536);
        __syncthreads();
        if (tid < 64) lc[tid] = 0u;
        __syncthreads();
        unsigned myrank = 0u;
        if (lane < npend) myrank = atomicAdd(&lc[pcls], 1u);
        __syncthreads();
        if (tid < 24) { unsigned* cnt = (unsigned*)(p.ws + OFF_CNT) + (DRY ? 2 : layer) * 32; const unsigned n = lc[tid]; lc[32 + tid] = n ? atomicAdd(&cnt[tid], n) : 0u; }
        __syncthreads();
        if (lane < npend) {
            ((int*)(p.ws + (DRY ? OFF_BIG : OFF_LIST)))[(size_t)pcls * NTOK + lc[32 + pcls] + myrank] = prow;
            ((float2*)(p.ws + (DRY ? OFF_BIG + (size_t)32 * NTOK * 4 : OFF_TOKW)))[prow] = make_float2(pwl, pwh);
        }
    }
}

using g8::f32x4v;
DEVI u32x4 pack8(const f32x4v& a, const f32x4v& b) { u32x4 w; w[0] = cvtpk(a[0], a[1]); w[1] = cvtpk(a[2], a[3]); w[2] = cvtpk(b[0], b[1]); w[3] = cvtpk(b[2], b[3]); return w; }

struct EpiInproj {
    static constexpr bool PERM = true;
    char* ws;
    DEVI void operator()(const f32x4v (&acc)[2][2][4][2], const g8::Unit& u, int wr, int wc, int fr, int fq) const {
        u16* dst; int ld, coff, kind;
        const int pn = u.pn;
        if (pn < 2)       { dst = (u16*)(ws + OFF_Q);    ld = 512;  coff = pn * 256;        kind = 1; }
        else if (pn < 4)  { dst = (u16*)(ws + OFF_K);    ld = 512;  coff = (pn - 2) * 256;  kind = 1; }
        else if (pn < 6)  { dst = (u16*)(ws + OFF_V);    ld = 512;  coff = (pn - 4) * 256;  kind = 0; }
        else if (pn < 10) { dst = (u16*)(ws + OFF_MLQK); ld = 1024; coff = (pn - 6) * 256;  kind = 0; }
        else if (pn < 12) { dst = (u16*)(ws + OFF_MLV);  ld = 512;  coff = (pn - 10) * 256; kind = 0; }
        else              { dst = (u16*)(ws + OFF_OG);   ld = 512;  coff = (pn - 12) * 256; kind = 2; }
        const int tb = u.pm % 65;
        const float2* tabR = (const float2*)(ws + OFF_ROPER); const float2* tabC = (const float2*)(ws + OFF_ROPEC);
#pragma unroll
        for (int ai = 0; ai < 2; ++ai)
#pragma unroll
            for (int m = 0; m < 4; ++m) {
                const int rl = ai * 128 + wr * 64 + m * 16 + fr;
                u16* rowp = dst + (size_t)(u.pm * 256 + rl) * ld + coff + wc * 32 + 8 * fq;
#pragma unroll
                for (int bj = 0; bj < 2; ++bj) {
                    f32x4v v0 = acc[ai][bj][m][0], v1 = acc[ai][bj][m][1];
                    if (kind == 1 && tb > 0) {
                        const int tl = (tb - 1) * 256 + rl;
                        const int p0 = ((wc * 32 + 8 * fq) & 63) >> 1;
                        const float* cs = (const float*)(p0 < 16 ? tabR + (tl >> 6) * 16 + p0 : tabC + (tl & 63) * 16 + (p0 - 16));
                        const f32x4v c01 = *reinterpret_cast<const f32x4v*>(cs), c23 = *reinterpret_cast<const f32x4v*>(cs + 4);
                        const f32x4v a = v0, b = v1;
                        v0[0] = a[0] * c01[0] - a[1] * c01[1]; v0[1] = a[0] * c01[1] + a[1] * c01[0];
                        v0[2] = a[2] * c01[2] - a[3] * c01[3]; v0[3] = a[2] * c01[3] + a[3] * c01[2];
                        v1[0] = b[0] * c23[0] - b[1] * c23[1]; v1[1] = b[0] * c23[1] + b[1] * c23[0];
                        v1[2] = b[2] * c23[2] - b[3] * c23[3]; v1[3] = b[2] * c23[3] + b[3] * c23[2];
                    } else if (kind == 2) {
#pragma unroll
                        for (int j = 0; j < 4; ++j) { v0[j] = sigmoidf_(v0[j]); v1[j] = sigmoidf_(v1[j]); }
                    }
                    *reinterpret_cast<u32x4*>(rowp + bj * 128) = pack8(v0, v1);
                }
            }
    }
};
DEVI void phase_inproj(const P& p, char* lds) {
    __syncthreads();
    g8::DenseSched S{p.ws + OFF_WINT, NTOK / 256, 14, (int)gridDim.x, (int)blockIdx.x, (size_t)256 * 2048};
    EpiInproj E{p.ws};
    g8::gemm_phase((LAS unsigned char*)lds, p.ws + OFF_ACT, 2048, 16, S, E);
}

struct EpiOutproj {
    static constexpr bool PERM = true;
    const float* xin_lat; const float* xin_ctx; u16* xs; const float* modb;
    DEVI void operator()(const f32x4v (&acc)[2][2][4][2], const g8::Unit& u, int wr, int wc, int fr, int fq) const {
        const int b = u.pm / 65, tb = u.pm % 65;
        const float* xi = tb == 0 ? xin_ctx + (size_t)(b * TC) * DM : xin_lat + (size_t)(b * TL + (tb - 1) * 256) * DM;
        u16* xo = xs + (size_t)(u.pm * 256) * DM;
        const float* gate = modb + (size_t)(tb == 0 ? 2 : b) * 6144 + 2 * 1024;
        const int col0 = u.pn * 256 + wc * 32 + 8 * fq;
        f32x4v gv[2][2];
#pragma unroll
        for (int bj = 0; bj < 2; ++bj)
#pragma unroll
            for (int n = 0; n < 2; ++n) gv[bj][n] = *reinterpret_cast<const f32x4v*>(gate + col0 + bj * 128 + n * 4);
#pragma unroll
        for (int ai = 0; ai < 2; ++ai) {
            f32x4v xv[4][2][2];
#pragma unroll
            for (int m = 0; m < 4; ++m) { const size_t ro = (size_t)(ai * 128 + wr * 64 + m * 16 + fr) * DM + col0;
#pragma unroll
                for (int bj = 0; bj < 2; ++bj)
#pragma unroll
                    for (int n = 0; n < 2; ++n) xv[m][bj][n] = *reinterpret_cast<const f32x4v*>(xi + ro + bj * 128 + n * 4); }
#pragma unroll
            for (int m = 0; m < 4; ++m) { const size_t ro = (size_t)(ai * 128 + wr * 64 + m * 16 + fr) * DM + col0;
#pragma unroll
                for (int bj = 0; bj < 2; ++bj)
                    *reinterpret_cast<u32x4*>(xo + ro + bj * 128) = pack8(xv[m][bj][0] + gv[bj][0] * acc[ai][bj][m][0], xv[m][bj][1] + gv[bj][1] * acc[ai][bj][m][1]); }
        }
    }
};
DEVI void phase_outproj(const P& p, char* lds) {
    __syncthreads();
    g8::DenseSched S{p.ws + OFF_WOUTT, NTOK / 256, 4, (int)gridDim.x, (int)blockIdx.x, (size_t)256 * 2048};
    EpiOutproj E{p.x, p.ctx, (u16*)(p.ws + OFF_MLC), (const float*)(p.ws + OFF_MOD)};
    g8::gemm_phase((LAS unsigned char*)lds, p.ws + OFF_ACT, 2048, 16, S, E);
}

DEVI int moe_table(const P& p, int layer, int* tb) {
    __syncthreads();
    if (threadIdx.x == 0) {
        const unsigned* cnt = (const unsigned*)(p.ws + OFF_CNT) + layer * 32; int o = 0;
        for (int c = 0; c < 24; ++c) { tb[c] = o; tb[32 + c] = (int)cnt[c]; o += ((int)cnt[c] + 255) >> 8; }
        tb[24] = o;
    }
    __syncthreads();
    return tb[24];
}
DEVI void cls_experts(int cls, int& elo, int& ehi) {
    const int g = cls / 6, pr = cls % 6;
    const int lo = pr < 3 ? 0 : (pr < 5 ? 1 : 2); const int hi = pr < 3 ? pr + 1 : (pr < 5 ? pr - 1 : 3);
    elo = g * 4 + lo; ehi = g * 4 + hi;
}
DEVI void moe_unit(const int* tb, int rt, g8::Unit& u) {
    int cls = 0; while (cls < 23 && tb[cls + 1] <= rt) ++cls;
    u.cls = cls; u.r0 = (rt - tb[cls]) * 256; u.ncls = tb[32 + cls];
}

struct MoeUpSched {
    static constexpr bool GATHER = true;
    DEVI const char* abase(const g8::Unit&, const char* a) const { return a; }
    const int* tb; int T, G, c; const int* list; const char* Wgu;
    DEVI bool next(int i, g8::Unit& u) const {
        if (!g8::tile_order(i, G, c, T, 8, u.pm, u.pn)) return false;
        moe_unit(tb, u.pm, u); int elo, ehi; cls_experts(u.cls, elo, ehi);
        const int e = u.pn < 4 ? elo : ehi;
        u.B0 = u.B1 = Wgu + ((size_t)e * 1024 + (size_t)(u.pn & 3) * 256) * 2048; return true;
    }
    DEVI void aoffs(const g8::Unit& u, unsigned (&v)[2][2]) const {
        const int* lst = list + (size_t)u.cls * NTOK + u.r0;
#pragma unroll
        for (int i = 0; i < 2; ++i) { int R, C; g8::lane_rc(i, R, C);
#pragma unroll
            for (int h = 0; h < 2; ++h) { const int rr = h * 128 + R; const int tok = lst[(u.r0 + rr < u.ncls) ? rr : 0]; v[h][i] = (unsigned)((tok * 1024 + C) * 2); } }
    }
};
struct EpiMoeUp {
    static constexpr bool PERM = true;
    const int* list; const float2* tokw; u16* HE;
    DEVI void operator()(const f32x4v (&acc)[2][2][4][2], const g8::Unit& u, int wr, int wc, int fr, int fq) const {
        const int* lst = list + (size_t)u.cls * NTOK + u.r0;
        const int s = u.pn >> 2;
        float wv[2][4];
        { int tk[2][4];
#pragma unroll
          for (int ai = 0; ai < 2; ++ai)
#pragma unroll
              for (int m = 0; m < 4; ++m) { const int rl = ai * 128 + wr * 64 + m * 16 + fr; tk[ai][m] = lst[(u.r0 + rl < u.ncls) ? rl : 0]; }
#pragma unroll
          for (int ai = 0; ai < 2; ++ai)
#pragma unroll
              for (int m = 0; m < 4; ++m) { const float2 w2 = tokw[tk[ai][m]]; wv[ai][m] = s ? w2.y : w2.x; } }
#pragma unroll
        for (int ai = 0; ai < 2; ++ai)
#pragma unroll
            for (int m = 0; m < 4; ++m) {
                const int rl = ai * 128 + wr * 64 + m * 16 + fr;
                if (u.r0 + rl < u.ncls) {
                    const float w = wv[ai][m];
                    u16* rowp = HE + (size_t)(u.pm * 256 + rl) * 1024 + s * 512 + (u.pn & 3) * 128 + wc * 32 + 8 * fq;
                    f32x4v h0, h1;
#pragma unroll
                    for (int j = 0; j < 4; ++j) { h0[j] = siluf_(acc[ai][0][m][0][j]) * acc[ai][1][m][0][j] * w; h1[j] = siluf_(acc[ai][0][m][1][j]) * acc[ai][1][m][1][j] * w; }
                    *reinterpret_cast<u32x4*>(rowp) = pack8(h0, h1);
                }
            }
    }
};
DEVI void phase_moe_up(const P& p, int layer, char* lds) {
    int* tb = (int*)(lds + g8::STAGE_BYTES);
    const int T = moe_table(p, layer, tb);
    MoeUpSched S{tb, T, (int)gridDim.x, (int)blockIdx.x, (const int*)(p.ws + OFF_LIST), p.ws + (layer ? OFF_WGU1 : OFF_WGU)};
    EpiMoeUp E{(const int*)(p.ws + OFF_LIST), (const float2*)(p.ws + OFF_TOKW), (u16*)(p.ws + OFF_HE)};
    g8::gemm_phase((LAS unsigned char*)lds, p.ws + OFF_ACT, 2048, 16, S, E);
}

struct MoeDownSched {
    static constexpr bool GATHER = false;
    DEVI const char* abase(const g8::Unit&, const char* a) const { return a; }
    const int* tb; int T, G, c; const char* WdT;
    DEVI bool next(int i, g8::Unit& u) const {
        if (!g8::tile_order(i, G, c, T, 4, u.pm, u.pn)) return false;
        moe_unit(tb, u.pm, u); int elo, ehi; cls_experts(u.cls, elo, ehi);
        u.B0 = WdT + ((size_t)elo * 1024 + (size_t)u.pn * 256) * 1024;
        u.B1 = WdT + ((size_t)ehi * 1024 + (size_t)u.pn * 256) * 1024 - (size_t)8 * 128; return true;
    }
    DEVI void aoffs(const g8::Unit& u, unsigned (&v)[2][2]) const {
#pragma unroll
        for (int i = 0; i < 2; ++i) { int R, C; g8::lane_rc(i, R, C);
#pragma unroll
            for (int h = 0; h < 2; ++h) v[h][i] = (unsigned)(((u.pm * 256 + h * 128 + R) * 1024 + C) * 2); }
    }
};
template <bool DRY>
struct EpiMoeDown {
    static constexpr bool PERM = true;
    const P* pp; int layer; const int* list; const float* modb;
    DEVI void operator()(const f32x4v (&acc)[2][2][4][2], const g8::Unit& u, int wr, int wc, int fr, int fq) const {
        const P& p = *pp;
        const int* lst = list + (size_t)u.cls * NTOK + u.r0;
        const int col0 = u.pn * 256 + wc * 32 + 8 * fq;
        int tk[2][4];
#pragma unroll
        for (int ai = 0; ai < 2; ++ai)
#pragma unroll
            for (int m = 0; m < 4; ++m) { const int rl = ai * 128 + wr * 64 + m * 16 + fr; tk[ai][m] = (u.r0 + rl < u.ncls) ? lst[rl] : -1; }
#pragma unroll
        for (int ai = 0; ai < 2; ++ai)
#pragma unroll
        for (int mh = 0; mh < 2; ++mh) {
            u32x4 xw[2][2]; f32x4v gv[2][2][2];
#pragma unroll
            for (int mm = 0; mm < 2; ++mm) { const int m = mh * 2 + mm; const int tok = tk[ai][m] < 0 ? lst[0] : tk[ai][m];
                const float* gate = modb + (size_t)modsel(layer, tok) * 6144 + 5 * 1024 + col0; const u16* xo = xs_ptr(p, layer, tok) + col0;
#pragma unroll
                for (int bj = 0; bj < 2; ++bj) { xw[mm][bj] = *reinterpret_cast<const u32x4*>(xo + bj * 128);
#pragma unroll
                    for (int n = 0; n < 2; ++n) gv[mm][bj][n] = *reinterpret_cast<const f32x4v*>(gate + bj * 128 + n * 4); } }
#pragma unroll
            for (int mm = 0; mm < 2; ++mm) { const int m = mh * 2 + mm; if (tk[ai][m] >= 0) { const int tok = tk[ai][m];
                u16* xd = DRY ? (u16*)(p.ws + OFF_MLQK) + (size_t)(tok & 8191) * 1024 + col0 : xs_ptr(p, layer, tok) + col0;
#pragma unroll
                for (int bj = 0; bj < 2; ++bj) {
                    f32x4v x0, x1; x0[0] = bflo(xw[mm][bj][0]); x0[1] = bfhi(xw[mm][bj][0]); x0[2] = bflo(xw[mm][bj][1]); x0[3] = bfhi(xw[mm][bj][1]);
                    x1[0] = bflo(xw[mm][bj][2]); x1[1] = bfhi(xw[mm][bj][2]); x1[2] = bflo(xw[mm][bj][3]); x1[3] = bfhi(xw[mm][bj][3]);
                    *reinterpret_cast<u32x4*>(xd + bj * 128) = pack8(x0 + gv[mm][bj][0] * acc[ai][bj][m][0], x1 + gv[mm][bj][1] * acc[ai][bj][m][1]); } } }
        }
    }
};
template <bool DRY = false>
DEVI void phase_moe_down(const P& p, int layer, char* lds) {
    int* tb = (int*)(lds + g8::STAGE_BYTES);
    const int T = moe_table(p, layer, tb);
    MoeDownSched S{tb, T, (int)gridDim.x, (int)blockIdx.x, p.ws + (layer ? OFF_WDT1 : OFF_WDT)};
    EpiMoeDown<DRY> E{&p, layer, (const int*)(p.ws + OFF_LIST), (const float*)(p.ws + OFF_MOD) + (size_t)layer * 3 * 6144};
    g8::gemm_phase((LAS unsigned char*)lds, p.ws + OFF_HE, 1024, 8, S, E);
}

constexpr size_t OFF_FU = OFF_ACT, OFF_FV = OFF_ACT + (size_t)NLAT * 512 * 2;
constexpr size_t OFF_FAH = OFF_FNT, OFF_FBH = OFF_FNT + (size_t)1024 * 512 * 2, OFF_FA128 = OFF_FNT + (size_t)2 * 1024 * 512 * 2;
struct FnetSched {
    static constexpr bool GATHER = false;
    const char* ws; int G, c;
    DEVI const char* abase(const g8::Unit& u, const char*) const { return ws + (u.pn < 4 ? OFF_FU : OFF_FV); }
    DEVI bool next(int i, g8::Unit& u) const {
        if (!g8::tile_order(i, G, c, NLAT / 256, 8, u.pm, u.pn)) return false;
        u.B0 = u.B1 = ws + (u.pn < 4 ? OFF_FAH : OFF_FBH) + (size_t)(u.pn & 3) * 256 * 1024; u.cls = 0; u.r0 = 0; u.ncls = 0; return true;
    }
    DEVI void aoffs(const g8::Unit&, unsigned (&)[2][2]) const {}
};
struct EpiFnet {
    static constexpr bool PERM = true;
    char* ws;
    DEVI void operator()(const f32x4v (&acc)[2][2][4][2], const g8::Unit& u, int wr, int wc, int fr, int fq) const {
        const int colt = (u.pn & 3) * 256 + wc * 32 + 8 * fq;
        u16* dst = (u16*)(ws + (u.pn < 4 ? OFF_ZR : OFF_ZI)) + colt;
        const u16* V = (const u16*)(ws + OFF_FV); const float* A128 = (const float*)(ws + OFF_FA128);
#pragma unroll
        for (int bj = 0; bj < 2; ++bj) {
            f32x4v a128[4][2];
            if (u.pn < 4) {
#pragma unroll
                for (int g = 0; g < 4; ++g) { a128[g][0] = *reinterpret_cast<const f32x4v*>(A128 + g * 1024 + colt + bj * 128); a128[g][1] = *reinterpret_cast<const f32x4v*>(A128 + g * 1024 + colt + bj * 128 + 4); }
            }
#pragma unroll
            for (int ai = 0; ai < 2; ++ai)
#pragma unroll
                for (int m = 0; m < 4; ++m) {
                    const size_t row = (size_t)(u.pm * 256 + ai * 128 + wr * 64 + m * 16 + fr);
                    f32x4v v0 = acc[ai][bj][m][0], v1 = acc[ai][bj][m][1];
                    if (u.pn < 4) {
#pragma unroll
                        for (int g = 0; g < 4; ++g) { const float hv = bf2f(V[row * 512 + g * 128]); v0 += a128[g][0] * hv; v1 += a128[g][1] * hv; }
                    }
                    *reinterpret_cast<u32x4*>(dst + row * 1024 + bj * 128) = pack8(v0, v1);
                }
        }
    }
};
DEVI void phase_fnet_gemm(const P& p, char* lds) {
    __syncthreads();
    FnetSched S{p.ws, (int)gridDim.x, (int)blockIdx.x};
    EpiFnet E{p.ws};
    g8::gemm_phase<EpiFnet, FnetSched, 8, 1024>((LAS unsigned char*)lds, p.ws, 1024, 8, S, E);
}

template <class RP>
DEVI void stage_tr128_load(RP rp, u32x4 (&v)[4]) {
    const int tid = threadIdx.x;
#pragma unroll
    for (int i = 0; i < 4; ++i) { const int idx = tid + 512 * i, k = idx >> 4, c = (idx & 15) * 8; v[i] = *reinterpret_cast<const u32x4*>(rp(k) + c); }
}
DEVI void stage_tr128_write(const u32x4 (&v)[4], char* img) {
    const int tid = threadIdx.x;
#pragma unroll
    for (int i = 0; i < 4; ++i) { const int idx = tid + 512 * i, k = idx >> 4, c = (idx & 15) * 8; *reinterpret_cast<u32x4*>(img + (k >> 6) * 16384 + v_st(k & 63, c)) = v[i]; }
}
DEVI void load_dft(const P& p, char* lds) {
    const int tid = threadIdx.x;
    for (int i = tid; i < 4096; i += NTHR) {
        const int m = i >> 11, j = i & 2047, row = j >> 4, ch = j & 15;
        const u32x4 v = *reinterpret_cast<const u32x4*>((const u16*)(p.ws + (m ? OFF_DFTS : OFF_DFTC)) + row * 128 + ch * 8);
        *reinterpret_cast<u32x4*>(lds + m * 34816 + swz256(row, ch)) = v;
    }
}
DEVI bf16x8 negbf(bf16x8 v) { u32x4 w = *reinterpret_cast<u32x4*>(&v); w[0] ^= 0x80008000u; w[1] ^= 0x80008000u; w[2] ^= 0x80008000u; w[3] ^= 0x80008000u; return *reinterpret_cast<bf16x8*>(&w); }

template <int KS, int WN, int MODE>
DEVI void fft_kstep(int vbr, int vbi, const bf16x8& aC, const bf16x8& aS, f32x16 (&yr)[2], f32x16 (&yi)[2]) {
    s16x4 rl0, rh0, rl1, rh1, il0, ih0, il1, ih1;
    tr_frag_issue<2 * WN, KS>(vbr, rl0, rh0); tr_frag_issue<2 * WN + 1, KS>(vbr, rl1, rh1);
    tr_frag_issue<2 * WN, KS>(vbi, il0, ih0); tr_frag_issue<2 * WN + 1, KS>(vbi, il1, ih1);
    LGKM0();
    const bf16x8 xr0 = PKLH(rl0, rh0), xr1 = PKLH(rl1, rh1), xi0 = PKLH(il0, ih0), xi1 = PKLH(il1, ih1);
    yr[0] = __builtin_amdgcn_mfma_f32_32x32x16_bf16(xr0, aC, yr[0], 0, 0, 0);
    yr[1] = __builtin_amdgcn_mfma_f32_32x32x16_bf16(xr1, aC, yr[1], 0, 0, 0);
    yr[0] = __builtin_amdgcn_mfma_f32_32x32x16_bf16(xi0, aS, yr[0], 0, 0, 0);
    yr[1] = __builtin_amdgcn_mfma_f32_32x32x16_bf16(xi1, aS, yr[1], 0, 0, 0);
    if (MODE == 0) {
        yi[0] = __builtin_amdgcn_mfma_f32_32x32x16_bf16(xi0, aC, yi[0], 0, 0, 0);
        yi[1] = __builtin_amdgcn_mfma_f32_32x32x16_bf16(xi1, aC, yi[1], 0, 0, 0);
        yi[0] = __builtin_amdgcn_mfma_f32_32x32x16_bf16(negbf(xr0), aS, yi[0], 0, 0, 0);
        yi[1] = __builtin_amdgcn_mfma_f32_32x32x16_bf16(negbf(xr1), aS, yi[1], 0, 0, 0);
    }
}
template <int WN, int MODE>
DEVI void fft_core(const char* lds, int xr_img, int xi_img, int wm, int lane, f32x16 (&yr)[2], f32x16 (&yi)[2]) {
    const int r32 = lane & 31, hi = lane >> 5;
    const char* Cm = lds; const char* Sm = lds + 34816;
    const int row = wm * 32 + r32;
    const int vb0 = xr_img + v_rd_base(lane), vb1 = xi_img + v_rd_base(lane);
#define KSTEP(H, KS) do { const int kk = (H) * 4 + (KS); \
        const bf16x8 aC = lds_b128(Cm, swz256(row, 2 * kk + hi)), aS = lds_b128(Sm, swz256(row, 2 * kk + hi)); \
        fft_kstep<KS, WN, MODE>(vb0 + (H) * 16384, vb1 + (H) * 16384, aC, aS, yr, yi); } while (0)
    KSTEP(0, 0); KSTEP(0, 1); KSTEP(0, 2); KSTEP(0, 3); KSTEP(1, 0); KSTEP(1, 1); KSTEP(1, 2); KSTEP(1, 3);
#undef KSTEP
}

DEVI void phase_fft1(const P& p, char* lds) {
    const int tid = threadIdx.x, lane = tid & 63, wid = __builtin_amdgcn_readfirstlane(tid >> 6), wm = wid >> 1, wn = wid & 1, r32 = lane & 31, hi = lane >> 5;
    load_dft(p, lds);
    char* imgR = lds + 69632; char* imgI = lds + 102400;
    const u16* Zr = (const u16*)(p.ws + OFF_ZR); const u16* Zi = (const u16*)(p.ws + OFF_ZI);
    u16* Yr = (u16*)(p.ws + OFF_YR); u16* Yi = (u16*)(p.ws + OFF_YI);
    const float2* TW = (const float2*)(p.ws + OFF_TW);
    u32x4 pr[4], pi[4];
#define FFT1_LOAD(U) do { const int cb_ = (U) & 7, t2_ = ((U) >> 3) & 127, b_ = (U) >> 10; \
        stage_tr128_load([&](int k) { return Zr + (size_t)(b_ * TL + 128 * k + t2_) * 1024 + cb_ * 128; }, pr); \
        stage_tr128_load([&](int k) { return Zi + (size_t)(b_ * TL + 128 * k + t2_) * 1024 + cb_ * 128; }, pi); } while (0)
    if ((int)blockIdx.x < NB * 128 * 8) FFT1_LOAD((int)blockIdx.x);
    for (int u = blockIdx.x; u < NB * 128 * 8; u += gridDim.x) {
        const int cb = u & 7, t2 = (u >> 3) & 127, b = u >> 10;
        __syncthreads();
        stage_tr128_write(pr, imgR); stage_tr128_write(pi, imgI);
        __syncthreads();
        if (u + (int)gridDim.x < NB * 128 * 8) FFT1_LOAD(u + (int)gridDim.x);
        f32x16 yr[2] = {}, yi[2] = {};
        const int xr_img = (int)(uintptr_t)imgR, xi_img = (int)(uintptr_t)imgI;
        if (wn == 0) fft_core<0, 0>(lds, xr_img, xi_img, wm, lane, yr, yi); else fft_core<1, 0>(lds, xr_img, xi_img, wm, lane, yr, yi);
        __syncthreads();
        {
            const int k1 = wm * 32 + r32;
            const float2 w = TW[t2 * k1];
            char* oR = imgR + k1 * 272; char* oI = imgR + 34816 + k1 * 272;
#pragma unroll
            for (int ni = 0; ni < 2; ++ni)
#pragma unroll
                for (int g = 0; g < 4; ++g) {
                    const int cbase = wn * 64 + ni * 32 + 8 * g + 4 * hi;
                    float re[4], im[4];
#pragma unroll
                    for (int j = 0; j < 4; ++j) { const float a = yr[ni][4 * g + j], bq = yi[ni][4 * g + j]; re[j] = a * w.x + bq * w.y; im[j] = bq * w.x - a * w.y; }
                    u32x2 pr, pi; pr[0] = cvtpk(re[0], re[1]); pr[1] = cvtpk(re[2], re[3]); pi[0] = cvtpk(im[0], im[1]); pi[1] = cvtpk(im[2], im[3]);
                    *reinterpret_cast<u32x2*>(oR + cbase * 2) = pr; *reinterpret_cast<u32x2*>(oI + cbase * 2) = pi;
                }
        }
        __syncthreads();
#pragma unroll
        for (int i = 0; i < 8; ++i) {
            const int idx = tid + 512 * i, pl = idx >> 11, j = idx & 2047, row = j >> 4, ch = j & 15;
            const u32x4 v = *reinterpret_cast<const u32x4*>(imgR + pl * 34816 + row * 272 + ch * 16);
            *reinterpret_cast<u32x4*>((pl ? Yi : Yr) + ((size_t)(b * 128 + row) * 128 + t2) * 1024 + cb * 128 + ch * 8) = v;
        }
    }
}
template <bool DRY = false>
DEVI void phase_fft2(const P& p, char* lds) {
    const int tid = threadIdx.x, lane = tid & 63, wid = __builtin_amdgcn_readfirstlane(tid >> 6), wm = wid >> 1, wn = wid & 1, r32 = lane & 31, hi = lane >> 5;
    load_dft(p, lds);
    char* imgR = lds + 69632; char* imgI = lds + 102400;
    const u16* Yr = (const u16*)(p.ws + OFF_YR); const u16* Yi = (const u16*)(p.ws + OFF_YI);
    const float* modb = (const float*)(p.ws + OFF_MOD) + (size_t)3 * 6144;
    u32x4 pr[4], pi[4];
#define FFT2_LOAD(U) do { const int cb_ = (U) & 7, k1_ = ((U) >> 3) & 127, b_ = (U) >> 10; \
        stage_tr128_load([&](int k) { return Yr + ((size_t)(b_ * 128 + k1_) * 128 + k) * 1024 + cb_ * 128; }, pr); \
        stage_tr128_load([&](int k) { return Yi + ((size_t)(b_ * 128 + k1_) * 128 + k) * 1024 + cb_ * 128; }, pi); } while (0)
    if ((int)blockIdx.x < NB * 128 * 8) FFT2_LOAD((int)blockIdx.x);
    for (int u = blockIdx.x; u < NB * 128 * 8; u += gridDim.x) {
        const int cb = u & 7, k1 = (u >> 3) & 127, b = u >> 10;
        __syncthreads();
        stage_tr128_write(pr, imgR); stage_tr128_write(pi, imgI);
        __syncthreads();
        if (u + (int)gridDim.x < NB * 128 * 8) FFT2_LOAD(u + (int)gridDim.x);
        f32x16 yr[2] = {}, yi[2] = {};
        const int xr_img = (int)(uintptr_t)imgR, xi_img = (int)(uintptr_t)imgI;
        if (wn == 0) fft_core<0, 1>(lds, xr_img, xi_img, wm, lane, yr, yi); else fft_core<1, 1>(lds, xr_img, xi_img, wm, lane, yr, yi);
        __syncthreads();
        {
            char* oR = imgR + (wm * 32 + r32) * 528;
#pragma unroll
            for (int ni = 0; ni < 2; ++ni)
#pragma unroll
                for (int g = 0; g < 4; ++g) {
                    const int cbase = wn * 64 + ni * 32 + 8 * g + 4 * hi;
                    f32x4 v; v[0] = yr[ni][4 * g]; v[1] = yr[ni][4 * g + 1]; v[2] = yr[ni][4 * g + 2]; v[3] = yr[ni][4 * g + 3];
                    *reinterpret_cast<f32x4*>(oR + cbase * 4) = v;
                }
        }
        __syncthreads();
        const float* gate = modb + (size_t)b * 6144 + 2 * 1024 + cb * 128;
#pragma unroll
        for (int i = 0; i < 4; ++i) {
            const int idx = tid + 512 * i, row = idx >> 4, ch = idx & 15;
            const f32x4 v0 = *reinterpret_cast<const f32x4*>(imgR + row * 528 + ch * 32), v1 = *reinterpret_cast<const f32x4*>(imgR + row * 528 + ch * 32 + 16);
            const f32x4 g0 = *reinterpret_cast<const f32x4*>(gate + ch * 8), g1 = *reinterpret_cast<const f32x4*>(gate + ch * 8 + 4);
            u16* xo = xs_ptr(p, 1, b * TL + k1 + 128 * row) + cb * 128 + ch * 8;
            u16* xd = DRY ? (u16*)(p.ws + OFF_ZR) + (size_t)(b * TL + k1 + 128 * row) * 1024 + cb * 128 + ch * 8 : xo;
            const u32x4 xw = *reinterpret_cast<const u32x4*>(xo);
            f32x4 x0, x1; x0[0] = bflo(xw[0]); x0[1] = bfhi(xw[0]); x0[2] = bflo(xw[1]); x0[3] = bfhi(xw[1]); x1[0] = bflo(xw[2]); x1[1] = bfhi(xw[2]); x1[2] = bflo(xw[3]); x1[3] = bfhi(xw[3]);
            const f32x4 r0 = x0 + g0 * v0, r1 = x1 + g1 * v1;
            u32x4 w; w[0] = cvtpk(r0[0], r0[1]); w[1] = cvtpk(r0[2], r0[3]); w[2] = cvtpk(r1[0], r1[1]); w[3] = cvtpk(r1[2], r1[3]);
            *reinterpret_cast<u32x4*>(xd) = w;
        }
    }
}

DEVI void chunk_scan(const float* gates, int row0, int head, int dir, float* Bq, float* av, float* pm, float& total, float& amax) {
    const int lane = threadIdx.x & 63;
    const int e0 = dir ? 127 - 2 * lane : 2 * lane, e1 = dir ? 126 - 2 * lane : 2 * lane + 1;
    const float lf0 = gates[(size_t)(row0 + e0) * 16 + (dir ? 12 : 4) + head], lf1 = gates[(size_t)(row0 + e1) * 16 + (dir ? 12 : 4) + head];
    const float li0 = gates[(size_t)(row0 + e0) * 16 + (dir ? 8 : 0) + head],  li1 = gates[(size_t)(row0 + e1) * 16 + (dir ? 8 : 0) + head];
    const float s1 = lf0 + lf1; float inc = s1;
#pragma unroll
    for (int o = 1; o < 64; o <<= 1) { const float t = __shfl_up(inc, o); if (lane >= o) inc += t; }
    const float exc = inc - s1;
    const float B0 = exc + lf0, B1 = exc + s1;
    const float a0 = li0 - B0, a1 = li1 - B1;
    const float m1 = fmaxf(a0, a1); float mx = m1;
#pragma unroll
    for (int o = 1; o < 64; o <<= 1) { const float t = __shfl_up(mx, o); if (lane >= o) mx = fmaxf(mx, t); }
    float mprev = __shfl_up(mx, 1); if (lane == 0) mprev = -1e30f;
    Bq[e0] = B0; Bq[e1] = B1; av[e0] = a0; av[e1] = a1; pm[e0] = fmaxf(mprev, a0); pm[e1] = mx;
    total = __shfl(inc, 63); amax = __shfl(mx, 63);
}

DEVI void conv_silu8(const u32x4& xm, const u32x4& x0, const u32x4& xp, const float* wc, bool hasm, bool hasp, float (&out)[8]) {
#pragma unroll
    for (int j = 0; j < 4; ++j) {
        const float w00 = wc[2 * j], w01 = wc[2 * j + 1], w10 = wc[1024 + 2 * j], w11 = wc[1024 + 2 * j + 1], w20 = wc[2048 + 2 * j], w21 = wc[2048 + 2 * j + 1];
        float a = w10 * bflo(x0[j]), b = w11 * bfhi(x0[j]);
        if (hasm) { a = fmaf(w00, bflo(xm[j]), a); b = fmaf(w01, bfhi(xm[j]), b); }
        if (hasp) { a = fmaf(w20, bflo(xp[j]), a); b = fmaf(w21, bfhi(xp[j]), b); }
        out[2 * j] = siluf_(a); out[2 * j + 1] = siluf_(b);
    }
}
DEVI void seg_edges(int t  , bool& hasm, bool& hasp) {
    hasm = !(t == 0 || t == TC); hasp = !(t == TC - 1 || t == TT - 1);
}
DEVI int chain_slot(int dir, int b, int h, int cc) { return ((dir * 2 + b) * 4 + h) * NCH + cc; }

DEVI void phase_mlstm_a(const P& p, char* lds) {
    const int tid = threadIdx.x, wid = __builtin_amdgcn_readfirstlane(tid >> 6), lane = tid & 63, r32 = lane & 31, hi = lane >> 5;
    char* Vimg = lds; char* Kf = lds + 32768; char* Kb = lds + 65536;
    float* arr = (float*)(lds + 98304);
    const float* gates = (const float*)(p.ws + OFF_GATES);
    const u16* MLQK = (const u16*)(p.ws + OFF_MLQK); const u16* MLV = (const u16*)(p.ws + OFF_MLV);
    u16* CST = (u16*)(p.ws + OFF_CST); float* NST = (float*)(p.ws + OFF_NST); u16* MLC = (u16*)(p.ws + OFF_MLC);
    float2* scal = (float2*)(p.ws + OFF_MSCAL);
    for (int it = blockIdx.x; it < NB * 4 * NCH; it += gridDim.x) {
        const int cc = it % NCH, h = (it / NCH) & 3, b = it / (NCH * 4);
        const int row0 = b * TT + cc * 128;
        __syncthreads();
        if (wid < 2) {
            float total, amax; float* a4 = arr + wid * 512;
            chunk_scan(gates, row0, h, wid, a4, a4 + 128, a4 + 256, total, amax);
            a4[384 + lane] = __expf(a4[128 + lane] - amax); a4[384 + 64 + lane] = __expf(a4[128 + 64 + lane] - amax);
            if (lane == 0) scal[chain_slot(wid, b, h, 0) + cc] = make_float2(total + amax, total);
        }
        __syncthreads();
#pragma unroll
        for (int i = 0; i < 4; ++i) {
            const int idx = tid + 512 * i, l = idx >> 4, c = (idx & 15) * 8;
            const u32x4 v = *reinterpret_cast<const u32x4*>(MLV + (size_t)(row0 + l) * 512 + h * 128 + c);
            *reinterpret_cast<u32x4*>(Vimg + (l >> 6) * 16384 + v_st(l & 63, c)) = v;
            const int t = cc * 128 + l; bool hasm, hasp; seg_edges(t, hasm, hasp);
            const u16* kp = MLQK + (size_t)(row0 + l) * 1024 + 512 + h * 128 + c;
            const u32x4 x0 = *reinterpret_cast<const u32x4*>(kp);
            const u32x4 xm = hasm ? *reinterpret_cast<const u32x4*>(kp - 1024) : x0;
            const u32x4 xp = hasp ? *reinterpret_cast<const u32x4*>(kp + 1024) : x0;
            float kv[8]; conv_silu8(xm, x0, xp, p.conv_w + 512 + h * 128 + c, hasm, hasp, kv);
            const float wf = arr[384 + l] * 0.08838834764831845f, wb = arr[512 + 384 + l] * 0.08838834764831845f;
            u32x4 of, ob, ok;
#pragma unroll
            for (int j = 0; j < 4; ++j) { of[j] = cvtpk(kv[2 * j] * wf, kv[2 * j + 1] * wf); ob[j] = cvtpk(kv[2 * j] * wb, kv[2 * j + 1] * wb);
                ok[j] = cvtpk(kv[2 * j] * 0.08838834764831845f, kv[2 * j + 1] * 0.08838834764831845f); }
            *reinterpret_cast<u32x4*>(MLC + (size_t)(row0 + l) * 1024 + 512 + h * 128 + c) = ok;
            {
                const u16* qp = kp - 512;
                const u32x4 q0 = *reinterpret_cast<const u32x4*>(qp);
                const u32x4 qm = hasm ? *reinterpret_cast<const u32x4*>(qp - 1024) : q0;
                const u32x4 qn = hasp ? *reinterpret_cast<const u32x4*>(qp + 1024) : q0;
                float qv[8]; conv_silu8(qm, q0, qn, p.conv_w + h * 128 + c, hasm, hasp, qv);
                u32x4 oq;
#pragma unroll
                for (int j = 0; j < 4; ++j) oq[j] = cvtpk(qv[2 * j], qv[2 * j + 1]);
                *reinterpret_cast<u32x4*>(MLC + (size_t)(row0 + l) * 1024 + h * 128 + c) = oq;
            }
            *reinterpret_cast<u32x4*>(Kf + (l >> 6) * 16384 + v_st(l & 63, c)) = of;
            *reinterpret_cast<u32x4*>(Kb + (l >> 6) * 16384 + v_st(l & 63, c)) = ob;
        }
        __syncthreads();
        const int dir = wid >> 2, vblk = wid & 3;
        const int va = (int)(uintptr_t)Vimg + v_rd_base(lane), ka = (int)(uintptr_t)(dir ? Kb : Kf) + v_rd_base(lane);
        f32x16 acc[4] = {};
#define ASTEP(H, KS) do { s16x4 al_, ah_, b0l, b0h, b1l, b1h, b2l, b2h, b3l, b3h; \
        if (vblk == 0) tr_frag_issue<0, KS>(va + (H) * 16384, al_, ah_); else if (vblk == 1) tr_frag_issue<1, KS>(va + (H) * 16384, al_, ah_); \
        else if (vblk == 2) tr_frag_issue<2, KS>(va + (H) * 16384, al_, ah_); else tr_frag_issue<3, KS>(va + (H) * 16384, al_, ah_); \
        tr_frag_issue<0, KS>(ka + (H) * 16384, b0l, b0h); tr_frag_issue<1, KS>(ka + (H) * 16384, b1l, b1h); \
        tr_frag_issue<2, KS>(ka + (H) * 16384, b2l, b2h); tr_frag_issue<3, KS>(ka + (H) * 16384, b3l, b3h); LGKM0(); \
        const bf16x8 af = PKLH(al_, ah_); \
        acc[0] = __builtin_amdgcn_mfma_f32_32x32x16_bf16(af, PKLH(b0l, b0h), acc[0], 0, 0, 0); \
        acc[1] = __builtin_amdgcn_mfma_f32_32x32x16_bf16(af, PKLH(b1l, b1h), acc[1], 0, 0, 0); \
        acc[2] = __builtin_amdgcn_mfma_f32_32x32x16_bf16(af, PKLH(b2l, b2h), acc[2], 0, 0, 0); \
        acc[3] = __builtin_amdgcn_mfma_f32_32x32x16_bf16(af, PKLH(b3l, b3h), acc[3], 0, 0, 0); } while (0)
        ASTEP(0, 0); ASTEP(0, 1); ASTEP(0, 2); ASTEP(0, 3); ASTEP(1, 0); ASTEP(1, 1); ASTEP(1, 2); ASTEP(1, 3);
#undef ASTEP
        u16* Cd = CST + (size_t)chain_slot(dir, b, h, cc) * 16384;
#pragma unroll
        for (int kb = 0; kb < 4; ++kb)
#pragma unroll
            for (int r = 0; r < 16; ++r) Cd[(vblk * 32 + crow(r, hi)) * 128 + kb * 32 + r32] = f2bf(acc[kb][r]);
        if (tid < 256) {
            const int d2 = tid >> 7, k = tid & 127; const char* img = d2 ? Kb : Kf; float s = 0.f;
            for (int l = 0; l < 128; ++l) s += bf2f(*reinterpret_cast<const u16*>(img + (l >> 6) * 16384 + v_st(l & 63, k & ~7) + (k & 7) * 2));
            NST[(size_t)chain_slot(d2, b, h, cc) * 128 + k] = s;
        }
    }
}

DEVI void phase_kmax(const P& p, char* lds) {
    const int tid = threadIdx.x; unsigned* lm = (unsigned*)lds;
    __syncthreads();
    if (tid < 16) lm[tid] = 0u;
    __syncthreads();
    const u16* K = (const u16*)(p.ws + OFF_K); const int hm = tid & 7;
    float mx0 = 0.f, mx1 = 0.f;
    for (int idx = blockIdx.x * NTHR + tid; idx < NTOK * 8; idx += gridDim.x * NTHR) {
        const int tok = idx >> 3; const u16* kp = K + (size_t)tok * 512 + hm * 64; float ss = 0.f;
#pragma unroll
        for (int c = 0; c < 8; ++c) { const u32x4 w = *reinterpret_cast<const u32x4*>(kp + c * 8);
#pragma unroll
            for (int j = 0; j < 4; ++j) { const float a = bflo(w[j]), b = bfhi(w[j]); ss = fmaf(a, a, ss); ss = fmaf(b, b, ss); } }
        if (tok < TT) mx0 = fmaxf(mx0, ss); else mx1 = fmaxf(mx1, ss);
    }
    atomicMax(&lm[hm], __float_as_uint(mx0)); atomicMax(&lm[8 + hm], __float_as_uint(mx1));
    __syncthreads();
    if (tid < 16) atomicMax((unsigned*)(p.ws + OFF_CNT) + 128 + tid, lm[tid]);
    __syncthreads();
}

DEVI int proc_chunk(int dir, int i) { return dir == 0 ? i : (i == 0 ? 1 : (i == 1 ? 0 : NCH + 1 - i)); }

DEVI void phase_mlstm_b(const P& p, char* lds) {
    const int tid = threadIdx.x;
    float* dec = (float*)lds; float* scl = dec + 160; float* mst = scl + 160;
    const float2* scal = (const float2*)(p.ws + OFF_MSCAL);
    u32* CST = (u32*)(p.ws + OFF_CST); float* NST = (float*)(p.ws + OFF_NST); float* MST = (float*)(p.ws + OFF_MST);
    for (int it = blockIdx.x; it < 16 * 16; it += gridDim.x) {
        const int chain = it >> 4, sub = it & 15, dir = chain >> 3;
        __syncthreads();
        if (tid == 0) {
            float m = 0.f;
            for (int i = 0; i < NCH; ++i) {
                const int cc = proc_chunk(dir, i); const float2 s = scal[chain * NCH + cc];
                const float mn = fmaxf(s.y + m, s.x);
                dec[i] = __expf(s.y + m - mn); scl[i] = __expf(s.x - mn); mst[i] = m;
                if (sub == 0) MST[chain * NCH + cc] = m;
                m = mn;
            }
        }
        __syncthreads();
        u32* base = CST + (size_t)chain * NCH * 8192 + sub * 512 + tid;
        float s0 = 0.f, s1 = 0.f;
        for (int i0 = 0; i0 < NCH; i0 += 10) {
            u32 v[10];
#pragma unroll
            for (int j = 0; j < 10; ++j) v[j] = base[(size_t)proc_chunk(dir, i0 + j) * 8192];
#pragma unroll
            for (int j = 0; j < 10; ++j) {
                base[(size_t)proc_chunk(dir, i0 + j) * 8192] = cvtpk(s0, s1);
                const float d = dec[i0 + j], sc = scl[i0 + j];
                s0 = fmaf(d, s0, sc * bflo(v[j])); s1 = fmaf(d, s1, sc * bfhi(v[j]));
            }
        }
        if (sub == 0 && tid < 128) {
            float* nb = NST + (size_t)chain * NCH * 128 + tid; float s = 0.f;
            for (int i = 0; i < NCH; ++i) { const int cc = proc_chunk(dir, i); const float v = nb[cc * 128]; nb[cc * 128] = s; s = fmaf(dec[i], s, scl[i] * v); }
        }
    }
}

DEVI void mlstm_c_item(const P& p, int it, char* lds) {
    int tid = threadIdx.x; asm volatile("" : "+v"(tid));
    const int wid = __builtin_amdgcn_readfirstlane(tid >> 6), lane = tid & 63, r32 = lane & 31, hi = lane >> 5;
    const int cc = it % NCH, h = (it / NCH) & 3, b = it / (NCH * 4);
    const int row0 = b * TT + cc * 128;
    char* Kt = lds; char* Vimg = lds + 34816; char* Ct = lds + 67584;
    float* arr = (float*)(lds + 137216);
    float* wsc = arr + 1024 + wid * 64;
    float* xb = (float*)lds;
    const float* gates = (const float*)(p.ws + OFF_GATES);
    const u16* MLC = (const u16*)(p.ws + OFF_MLC); const u16* MLV = (const u16*)(p.ws + OFF_MLV);
    const u16* CST = (const u16*)(p.ws + OFF_CST); const float* NST = (const float*)(p.ws + OFF_NST); const float* MST = (const float*)(p.ws + OFF_MST);
    __syncthreads();
    if (wid < 2) { float total, amax; float* a4 = arr + wid * 512; chunk_scan(gates, row0, h, wid, a4, a4 + 128, a4 + 256, total, amax); }
    else if (wid < 6) { const int d2 = (wid - 2) >> 1, k = ((wid - 2) & 1) * 64 + lane; arr[d2 * 512 + 384 + k] = NST[(size_t)chain_slot(d2, b, h, cc) * 128 + k]; }
#pragma unroll
    for (int i = 0; i < 4; ++i) {
        const int idx = tid + 512 * i, l = idx >> 4, ch = idx & 15, c = ch * 8;
        const u32x4 v = *reinterpret_cast<const u32x4*>(MLV + (size_t)(row0 + l) * 512 + h * 128 + c);
        *reinterpret_cast<u32x4*>(Vimg + (l >> 6) * 16384 + v_st(l & 63, c)) = v;
        const u32x4 ok = *reinterpret_cast<const u32x4*>(MLC + (size_t)(row0 + l) * 1024 + 512 + h * 128 + c);
        *reinterpret_cast<u32x4*>(Kt + swz256(l, ch)) = ok;
#pragma unroll
        for (int d2 = 0; d2 < 2; ++d2) {
            const u32x4 cv = *reinterpret_cast<const u32x4*>(CST + (size_t)chain_slot(d2, b, h, cc) * 16384 + l * 128 + c);
            *reinterpret_cast<u32x4*>(Ct + d2 * 34816 + swz256(l, ch)) = cv;
        }
    }
    const int dir = wid >> 2, qb = wid & 3, q = qb * 32 + r32;
    bf16x8 qr[8];
    { const u16* qp = MLC + (size_t)(row0 + q) * 1024 + h * 128 + hi * 8;
#pragma unroll
      for (int d0 = 0; d0 < 8; ++d0) qr[d0] = *reinterpret_cast<const bf16x8*>(qp + d0 * 16); }
    __syncthreads();
    const float* a4 = arr + dir * 512;
    const float m_st = MST[chain_slot(dir, b, h, 0) + cc];
    const float Mq = fmaxf(m_st, a4[256 + q]);
    const float inter = __expf(m_st - Mq);
    float nq = 0.f;
#pragma unroll
    for (int d0 = 0; d0 < 8; ++d0) {
        const u32x4 w = *reinterpret_cast<const u32x4*>(&qr[d0]); const float* nn = a4 + 384 + d0 * 16 + hi * 8;
#pragma unroll
        for (int j = 0; j < 4; ++j) { nq = fmaf(bflo(w[j]), nn[2 * j], nq); nq = fmaf(bfhi(w[j]), nn[2 * j + 1], nq); }
    }
    { auto rr = __builtin_amdgcn_permlane32_swap(__float_as_uint(nq), __float_as_uint(nq), false, false); nq = __uint_as_float(rr[0]) + __uint_as_float(rr[1]); }
    f32x16 o[4] = {};
    const char* Cm = Ct + dir * 34816;
#pragma unroll
    for (int dk = 0; dk < 8; ++dk)
#pragma unroll
        for (int d0 = 0; d0 < 4; ++d0) o[d0] = __builtin_amdgcn_mfma_f32_32x32x16_bf16(qr[dk], lds_b128(Cm, swz256(d0 * 32 + r32, 2 * dk + hi)), o[d0], 0, 0, 0);
    if (hi == 0) wsc[r32] = inter;
    asm volatile("s_waitcnt lgkmcnt(0)" ::: "memory");
#pragma unroll
    for (int d0 = 0; d0 < 4; ++d0)
#pragma unroll
        for (int r = 0; r < 16; ++r) o[d0][r] *= wsc[crow(r, hi)];
    const int vb = (int)(uintptr_t)Vimg + v_rd_base(lane);
    float rs = 0.f;
#define KBLK(KB) do { if (dir == 0 ? (KB) <= qb : (KB) >= qb) { \
        f32x16 pp = {}; \
        _Pragma("unroll") for (int d0 = 0; d0 < 8; ++d0) pp = __builtin_amdgcn_mfma_f32_32x32x16_bf16(lds_b128(Kt, swz256((KB) * 32 + r32, 2 * d0 + hi)), qr[d0], pp, 0, 0, 0); \
        _Pragma("unroll") for (int g = 0; g < 4; ++g) { const f32x4 av4 = *reinterpret_cast<const f32x4*>(a4 + 128 + (KB) * 32 + 8 * g + 4 * hi); \
            _Pragma("unroll") for (int j = 0; j < 4; ++j) { const int key = (KB) * 32 + 8 * g + 4 * hi + j; const bool ok = dir == 0 ? key <= q : key >= q; \
                const float sv = ok ? pp[4 * g + j] * __expf(av4[j] - Mq) : 0.f; pp[4 * g + j] = sv; rs += sv; } } \
        bf16x8 f0, f1; pack_p(pp, f0, f1); \
        { s16x4 l0, h0, l1, h1, l2, h2, l3, h3; constexpr int HH = (KB) >> 1, K0 = ((KB) & 1) * 2; \
          tr_frag_issue<0, K0>(vb + HH * 16384, l0, h0); tr_frag_issue<1, K0>(vb + HH * 16384, l1, h1); tr_frag_issue<2, K0>(vb + HH * 16384, l2, h2); tr_frag_issue<3, K0>(vb + HH * 16384, l3, h3); LGKM0(); \
          o[0] = __builtin_amdgcn_mfma_f32_32x32x16_bf16(f0, PKLH(l0, h0), o[0], 0, 0, 0); o[1] = __builtin_amdgcn_mfma_f32_32x32x16_bf16(f0, PKLH(l1, h1), o[1], 0, 0, 0); \
          o[2] = __builtin_amdgcn_mfma_f32_32x32x16_bf16(f0, PKLH(l2, h2), o[2], 0, 0, 0); o[3] = __builtin_amdgcn_mfma_f32_32x32x16_bf16(f0, PKLH(l3, h3), o[3], 0, 0, 0); \
          tr_frag_issue<0, K0 + 1>(vb + HH * 16384, l0, h0); tr_frag_issue<1, K0 + 1>(vb + HH * 16384, l1, h1); tr_frag_issue<2, K0 + 1>(vb + HH * 16384, l2, h2); tr_frag_issue<3, K0 + 1>(vb + HH * 16384, l3, h3); LGKM0(); \
          o[0] = __builtin_amdgcn_mfma_f32_32x32x16_bf16(f1, PKLH(l0, h0), o[0], 0, 0, 0); o[1] = __builtin_amdgcn_mfma_f32_32x32x16_bf16(f1, PKLH(l1, h1), o[1], 0, 0, 0); \
          o[2] = __builtin_amdgcn_mfma_f32_32x32x16_bf16(f1, PKLH(l2, h2), o[2], 0, 0, 0); o[3] = __builtin_amdgcn_mfma_f32_32x32x16_bf16(f1, PKLH(l3, h3), o[3], 0, 0, 0); } } } while (0)
    KBLK(0); KBLK(1); KBLK(2); KBLK(3);
#undef KBLK
    { auto rr = __builtin_amdgcn_permlane32_swap(__float_as_uint(rs), __float_as_uint(rs), false, false); rs = __uint_as_float(rr[0]) + __uint_as_float(rr[1]); }
    const float nqt = inter * nq + rs;
    const float den = fmaxf(fabsf(nqt), __expf(-(a4[q] + Mq)));
    if (hi == 0) wsc[32 + r32] = 1.f / den;
    asm volatile("s_waitcnt lgkmcnt(0)" ::: "memory");
#pragma unroll
    for (int d0 = 0; d0 < 4; ++d0)
#pragma unroll
        for (int r = 0; r < 16; ++r) o[d0][r] *= wsc[32 + crow(r, hi)];
    __syncthreads();
    {
        float* xd = dir ? xb : (float*)(lds + 67584);
#pragma unroll
        for (int d0 = 0; d0 < 4; ++d0)
#pragma unroll
            for (int r = 0; r < 16; ++r) xd[(qb * 32 + crow(r, hi)) * 128 + d0 * 32 + r32] = o[d0][r];
    }
    __syncthreads();
    {
        const u16* OG = (const u16*)(p.ws + OFF_OG); u16* mix = (u16*)(p.ws + OFF_ACT);
        const float* xf = (const float*)(lds + 67584);
#pragma unroll
        for (int i = 0; i < 4; ++i) {
            const int idx = tid + 512 * i, ql = idx >> 4, c = (idx & 15) * 8;
            const f32x4 f0 = *reinterpret_cast<const f32x4*>(xf + ql * 128 + c), f1 = *reinterpret_cast<const f32x4*>(xf + ql * 128 + c + 4);
            const f32x4 b0 = *reinterpret_cast<const f32x4*>(xb + ql * 128 + c), b1 = *reinterpret_cast<const f32x4*>(xb + ql * 128 + c + 4);
            const u32x4 og = *reinterpret_cast<const u32x4*>(OG + (size_t)(row0 + ql) * 512 + h * 128 + c);
            u32x4 w;
            w[0] = cvtpk((f0[0] + b0[0]) * bflo(og[0]), (f0[1] + b0[1]) * bfhi(og[0]));
            w[1] = cvtpk((f0[2] + b0[2]) * bflo(og[1]), (f0[3] + b0[3]) * bfhi(og[1]));
            w[2] = cvtpk((f1[0] + b1[0]) * bflo(og[2]), (f1[1] + b1[1]) * bfhi(og[2]));
            w[3] = cvtpk((f1[2] + b1[2]) * bflo(og[3]), (f1[3] + b1[3]) * bfhi(og[3]));
            *reinterpret_cast<u32x4*>(mix + (size_t)(row0 + ql) * 1024 + 512 + h * 128 + c) = w;
        }
    }
}

#define KSWZ(row, colB) ((row) * 256 + ((colB) ^ (((row) & 15) << 4)))
constexpr float A2_SCALE = 0.125f, A2_THR = 8.f;
DEVI void a2_partialSM(f32x16& p0, f32x16& p1, float) {
#pragma unroll
    for (int r = 0; r < 16; ++r) p0[r] = __builtin_amdgcn_exp2f(p0[r]);
}
DEVI void a2_finishSM(f32x16& p0, f32x16& p1, f32x16& lv, bf16x8& pa0, bf16x8& pa1, bf16x8& pa2, bf16x8& pa3) {
#pragma unroll
    for (int r = 0; r < 16; ++r) p1[r] = __builtin_amdgcn_exp2f(p1[r]);
#pragma unroll
    for (int r = 0; r < 16; ++r) lv[r] += p0[r] + p1[r];
    pack_p_perm(p0, pa0, pa1); pack_p_perm(p1, pa2, pa3);
}
DEVI void a2_qkt(f32x16& p0, f32x16& p1, const char* Ks, const bf16x8 (&qr)[4], int r32, int hi, int grp, const f32x16& cinit) {
#pragma unroll
    for (int d0 = 0; d0 < 4; ++d0) { const int cb = (grp * 64 + d0 * 16 + hi * 8) * 2;
        const bf16x8 b0 = lds_b128(Ks, KSWZ(r32, cb)), b1 = lds_b128(Ks, KSWZ(32 + r32, cb));
        if (d0 == 0) { p0 = __builtin_amdgcn_mfma_f32_32x32x16_bf16(b0, qr[0], cinit, 0, 0, 0); p1 = __builtin_amdgcn_mfma_f32_32x32x16_bf16(b1, qr[0], cinit, 0, 0, 0); }
        else { p0 = __builtin_amdgcn_mfma_f32_32x32x16_bf16(b0, qr[d0], p0, 0, 0, 0); p1 = __builtin_amdgcn_mfma_f32_32x32x16_bf16(b1, qr[d0], p1, 0, 0, 0); } }
}
#define A2_VISSUE(D0, F) do { tr_frag_issue<D0, 0>(vb, F##l0, F##h0); tr_frag_issue<D0, 1>(vb, F##l1, F##h1); tr_frag_issue<D0, 2>(vb, F##l2, F##h2); tr_frag_issue<D0, 3>(vb, F##l3, F##h3); } while (0)
#define A2_VMMA(D0, F) do { \
    o[D0] = __builtin_amdgcn_mfma_f32_32x32x16_bf16(pa0, PKLH(F##l0, F##h0), o[D0], 0, 0, 0); o[D0] = __builtin_amdgcn_mfma_f32_32x32x16_bf16(pa1, PKLH(F##l1, F##h1), o[D0], 0, 0, 0); \
    o[D0] = __builtin_amdgcn_mfma_f32_32x32x16_bf16(pa2, PKLH(F##l2, F##h2), o[D0], 0, 0, 0); o[D0] = __builtin_amdgcn_mfma_f32_32x32x16_bf16(pa3, PKLH(F##l3, F##h3), o[D0], 0, 0, 0); } while (0)
#define A2_LGKM(N) do { asm volatile("s_waitcnt lgkmcnt(" #N ")" ::: "memory"); SBAR(); } while (0)
template <int S> DEVI void a2_psm_slice(f32x16& x0, f32x16&, float) {
#pragma unroll
    for (int r = 4 * S; r < 4 * S + 4; ++r) x0[r] = __builtin_amdgcn_exp2f(x0[r]);
}
DEVI void a2_pv(f32x16 (&o)[4], int vb, const bf16x8& pa0, const bf16x8& pa1, const bf16x8& pa2, const bf16x8& pa3, f32x16& x0, f32x16& x1, float mnC) {
    s16x4 al0, ah0, al1, ah1, al2, ah2, al3, ah3, bl0, bh0, bl1, bh1, bl2, bh2, bl3, bh3;
    A2_VISSUE(0, a); A2_VISSUE(1, b);
    A2_LGKM(8); a2_psm_slice<0>(x0, x1, mnC); A2_VMMA(0, a);
    A2_VISSUE(2, a);
    A2_LGKM(8); a2_psm_slice<1>(x0, x1, mnC); A2_VMMA(1, b);
    A2_VISSUE(3, b);
    A2_LGKM(8); a2_psm_slice<2>(x0, x1, mnC); A2_VMMA(2, a);
    A2_LGKM(0); a2_psm_slice<3>(x0, x1, mnC); A2_VMMA(3, b);
}
DEVI void a2_pv_last(f32x16 (&o)[4], int vb, const bf16x8& pa0, const bf16x8& pa1, const bf16x8& pa2, const bf16x8& pa3) {
    s16x4 al0, ah0, al1, ah1, al2, ah2, al3, ah3, bl0, bh0, bl1, bh1, bl2, bh2, bl3, bh3;
    A2_VISSUE(0, a); A2_VISSUE(1, b);
    A2_LGKM(8); A2_VMMA(0, a);
    A2_VISSUE(2, a);
    A2_LGKM(8); A2_VMMA(1, b);
    A2_VISSUE(3, b);
    A2_LGKM(8); A2_VMMA(2, a);
    A2_LGKM(0); A2_VMMA(3, b);
}
constexpr int A2_T = 16384;
DEVI void a2_body(const P& p, int q0, int k0row, int seq, int h, char* lds, int tid) {
    const int GRP = __builtin_amdgcn_readfirstlane(tid >> 8); const int wid = tid >> 6, lane = tid & 63, r32 = lane & 31, hi = lane >> 5, wq = wid & 3;
    const u16* Kh = (const u16*)(p.ws + OFF_K) + (size_t)k0row * 512 + h * 128;
    const u16* Vh = (const u16*)(p.ws + OFF_V) + (size_t)k0row * 512 + h * 128;
    char* V_lds = lds; char* K_lds = lds + 3 * A2_T;
    float* wsc = (float*)(lds + 6 * A2_T) + wid * 64; float* li_l = wsc;
    float l_reg = 0.f; f32x16 o[4] = {}; bf16x8 qr[4];
    { const u16* Qw = (const u16*)(p.ws + OFF_Q) + (size_t)(q0 + wq * 32 + r32) * 512 + h * 128 + GRP * 64 + hi * 8;
#pragma unroll
      for (int d0 = 0; d0 < 4; ++d0) qr[d0] = *reinterpret_cast<const bf16x8*>(Qw + d0 * 16); }
    float mnC;
    { float qq = 0.f;
#pragma unroll
      for (int d0 = 0; d0 < 4; ++d0) { const u32x4 w = *reinterpret_cast<const u32x4*>(&qr[d0]);
#pragma unroll
          for (int j = 0; j < 4; ++j) { const float a = bflo(w[j]), b2 = bfhi(w[j]); qq = fmaf(a, a, qq); qq = fmaf(b2, b2, qq); } }
      { auto rr = __builtin_amdgcn_permlane32_swap(__float_as_uint(qq), __float_as_uint(qq), false, false); qq = __uint_as_float(rr[0]) + __uint_as_float(rr[1]); }
      const int bq = k0row >= TT ? 1 : 0;
      const float k2 = __uint_as_float(((const unsigned*)(p.ws + OFF_CNT))[128 + bq * 8 + h * 2 + GRP]);
      mnC = -sqrtf(qq * k2) * (A2_SCALE * 1.4426950408889634f) * 1.001f;
#pragma unroll
      for (int d0 = 0; d0 < 4; ++d0) { u32x4 w = *reinterpret_cast<u32x4*>(&qr[d0]);
#pragma unroll
          for (int j = 0; j < 4; ++j) w[j] = cvtpk(bflo(w[j]) * (A2_SCALE * 1.4426950408889634f), bfhi(w[j]) * (A2_SCALE * 1.4426950408889634f));
          qr[d0] = *reinterpret_cast<bf16x8*>(&w); } }
    const int vb0 = (int)(uintptr_t)V_lds + v_rd_base(lane);
    const int krow = tid >> 4, kch = (tid & 15) ^ (krow & 15);
    const int vc = ((tid >> 5) & 3) * 32 + (tid & 3) * 8;
    const int kk0 = (tid >> 7) * 8 + ((tid & 31) >> 2), kk1 = kk0 + 32;
#define A2_DMA(slot, kk) do { \
    __builtin_amdgcn_global_load_lds((const unsigned*)(Kh + (size_t)((kk) + krow) * 512 + kch * 8), (LAS unsigned*)(K_lds + (slot) * A2_T + tid * 16), 16, 0, 0); \
    __builtin_amdgcn_global_load_lds((const unsigned*)(Kh + (size_t)((kk) + 32 + krow) * 512 + kch * 8), (LAS unsigned*)(K_lds + (slot) * A2_T + 8192 + tid * 16), 16, 0, 0); \
    __builtin_amdgcn_global_load_lds((const unsigned*)(Vh + (size_t)((kk) + kk0) * 512 + vc), (LAS unsigned*)(V_lds + (slot) * A2_T + tid * 16), 16, 0, 0); \
    __builtin_amdgcn_global_load_lds((const unsigned*)(Vh + (size_t)((kk) + kk1) * 512 + vc), (LAS unsigned*)(V_lds + (slot) * A2_T + 8192 + tid * 16), 16, 0, 0); } while (0)
    f32x16 pA0, pA1, pB0, pB1; bf16x8 pa0, pa1, pa2, pa3; const int NT = seq / 64;
    f32x16 lv = {};
    f32x16 cinit;
#pragma unroll
    for (int r = 0; r < 16; ++r) cinit[r] = mnC;
    asm volatile("" : "+v"(cinit));
    __syncthreads();
    A2_DMA(0, 0); asm volatile("s_waitcnt vmcnt(0)" ::: "memory"); __syncthreads();
    A2_DMA(1, 64);
    a2_qkt(pA0, pA1, K_lds, qr, r32, hi, GRP, cinit); a2_partialSM(pA0, pA1, mnC);
    asm volatile("s_waitcnt vmcnt(0)" ::: "memory"); __syncthreads();
    int bp = 0, bc = 1, bn = 2;
#define A2_HALF(X0, X1, Y0, Y1, J) do { \
        if ((J) + 1 < NT) A2_DMA(bn, ((J) + 1) * 64); \
        SBAR(); a2_qkt(X0, X1, K_lds + bc * A2_T, qr, r32, hi, GRP, cinit); \
        a2_finishSM(Y0, Y1, lv, pa0, pa1, pa2, pa3); \
        __builtin_amdgcn_sched_group_barrier(0x100, 8, 0); \
        _Pragma("unroll") for (int g_ = 0; g_ < 8; ++g_) { __builtin_amdgcn_sched_group_barrier(0x8, 1, 0); __builtin_amdgcn_sched_group_barrier(0x2, 9, 0); } \
        SBAR(); \
        a2_pv(o, vb0 + bp * A2_T, pa0, pa1, pa2, pa3, X0, X1, mnC); \
        asm volatile("s_waitcnt vmcnt(0)" ::: "memory"); __syncthreads(); \
        { const int t_ = bp; bp = bc; bc = bn; bn = t_; } } while (0)
    for (int j = 1; j + 1 < NT; j += 2) {
        A2_HALF(pB0, pB1, pA0, pA1, j);
        A2_HALF(pA0, pA1, pB0, pB1, j + 1);
    }
    A2_HALF(pB0, pB1, pA0, pA1, NT - 1);
    a2_finishSM(pB0, pB1, lv, pa0, pa1, pa2, pa3); SBAR();
    a2_pv_last(o, vb0 + bp * A2_T, pa0, pa1, pa2, pa3);
#undef A2_HALF
#undef A2_DMA
    asm volatile("s_waitcnt vmcnt(0)" ::: "memory");
    int tz = threadIdx.x; asm volatile("" : "+v"(tz));
    const int wq_e = (tz >> 6) & 3, r32e = tz & 31, hie = (tz >> 5) & 1;
    float* li_e = (float*)(lds + 6 * A2_T) + (tz >> 6) * 64;
    const float lam = ((const float*)(p.ws + OFF_LAM))[0];
#pragma unroll
    for (int r = 0; r < 16; ++r) l_reg += lv[r];
    { auto rr = __builtin_amdgcn_permlane32_swap(__float_as_uint(l_reg), __float_as_uint(l_reg), false, false); l_reg = __uint_as_float(rr[0]) + __uint_as_float(rr[1]); }
    if (hie == 0) li_e[r32e] = (GRP == 0 ? 1.f : -lam) / l_reg;
    asm volatile("s_waitcnt lgkmcnt(0)" ::: "memory");
#pragma unroll
    for (int r = 0; r < 16; ++r) { const float sc_ = li_e[crow(r, hie)];
#pragma unroll
        for (int d = 0; d < 4; ++d) o[d][r] *= sc_; }
    float* xb = (float*)lds;
    __syncthreads();
    if (GRP == 1) {
#pragma unroll
        for (int d = 0; d < 4; ++d)
#pragma unroll
            for (int r = 0; r < 16; ++r) xb[(wq_e * 32 + crow(r, hie)) * 128 + d * 32 + r32e] = o[d][r];
    }
    __syncthreads();
    if (GRP == 0) {
        float ssq[16];
#pragma unroll
        for (int r = 0; r < 16; ++r) { float s_ = 0.f;
#pragma unroll
            for (int d = 0; d < 4; ++d) { const float v = o[d][r] + xb[(wq_e * 32 + crow(r, hie)) * 128 + d * 32 + r32e]; o[d][r] = v; s_ = fmaf(v, v, s_); }
            ssq[r] = s_; }
#pragma unroll
        for (int r = 0; r < 16; ++r) { float s_ = ssq[r]; for (int of = 16; of; of >>= 1) s_ += __shfl_xor(s_, of); ssq[r] = rsqrtf(s_ * (1.f / 128.f) + 1e-6f) * 0.8f; }
        u16* mix = (u16*)(p.ws + OFF_ACT);
#pragma unroll
        for (int d = 0; d < 4; ++d) { const float gv = p.subln_g[d * 32 + r32e];
#pragma unroll
            for (int r = 0; r < 16; ++r) mix[(size_t)(q0 + wq_e * 32 + crow(r, hie)) * 1024 + h * 128 + d * 32 + r32e] = f2bf(o[d][r] * ssq[r] * gv); }
    }
}
DEVI void phase_attn(const P& p, char* lds) {
    const int G = gridDim.x;
    for (int it = blockIdx.x; it < 1024 + 16; it += G) {
        int q0, k0, seq, h;
        if (it < 1024) {
            int bh, qb;
            if ((G & 7) == 0) { bh = it & 7; qb = it >> 3; } else { bh = it >> 7; qb = it & 127; }
            const int b = bh >> 2; h = bh & 3; q0 = b * TT + TC + qb * 128; k0 = b * TT; seq = TT;
        } else { const int j = it - 1024, b = j >> 3; h = (j >> 1) & 3; q0 = b * TT + (j & 1) * 128; k0 = b * TT; seq = TC; }
        int tid = threadIdx.x; asm volatile("" : "+v"(tid));
        a2_body(p, q0, k0, seq, h, lds, tid);
    }
}
DEVI void phase_mlstm_c(const P& p, char* lds) {
    for (int it = blockIdx.x; it < NB * 4 * NCH; it += gridDim.x) mlstm_c_item(p, it, lds);
}

DEVI void tail_bg(const P& p, char* lds, int nunits, int first, int nitems) {
    const int G = gridDim.x, c = blockIdx.x, full = nunits / G, rem = nunits - full * G;
    __syncthreads();
    if (rem == 0) { for (int it = c; it < nitems; it += G) bg_item(p, first + it, (float*)lds); }
    else if (c >= rem) { for (int it = c - rem; it < nitems; it += G - rem) bg_item(p, first + it, (float*)lds); }
    __syncthreads();
}
DEVI void tail_convert(const P& p, char* lds, int layer, int nunits, int lo = 0, int hi = N0_EXP, int par = -1) {
    const int G = gridDim.x, c = blockIdx.x, full = nunits / G, rem = nunits - full * G;
    __syncthreads();
    if (par < 0 || (c & 1) == par) {
        if (rem == 0) { for (int it = lo + c; it < hi; it += G) convert_expert_item(p, layer, it, (float*)lds); }
        else if (c >= rem) { for (int it = lo + c - rem; it < hi; it += G - rem) convert_expert_item(p, layer, it, (float*)lds); }
    }
    __syncthreads();
}
DEVI void phase_convert_l1(const P& p, char* lds) {
    for (int it = blockIdx.x; it < N0_EXP; it += gridDim.x) convert_expert_item(p, 1, it, (float*)lds);
}

constexpr int NPHASE = 19;
__global__ void __launch_bounds__(NTHR, 2) fwd_kernel(P p_) {
    extern __shared__ __attribute__((aligned(16))) char lds[];
    volatile LAS unsigned* st = (volatile LAS unsigned*)(lds + LDS_BYTES - 16);
    if (threadIdx.x == 0) { st[0] = 0u; st[1] = 0u; st[2] = 0u; st[3] = 0u; }
    __syncthreads();
    const int lo = p_.ph_lo, hi = p_.ph_hi;
    XcdBarrier bar; bar.bar = (unsigned*)(p_.ws + OFF_BAR); bar.x = 0; bar.st = st;
    if (hi - lo > 1) bar = xcd_barrier_post((unsigned*)(p_.ws + OFF_BAR), st);
#if defined(__HIP_DEVICE_COMPILE__)
#define PARAMS() const __attribute__((address_space(4))) P* kp_ = (const __attribute__((address_space(4))) P*)__builtin_amdgcn_kernarg_segment_ptr(); asm volatile("" : "+s"(kp_)); const P p = *kp_
#else
#define PARAMS() const P p = p_
#endif
#ifndef PHSEL
#define PHON(k) true
#else
#define PHON(k) ((k) == PHSEL)
#endif
#define IN(k) (lo <= (k) && (k) < hi)
#define SEAM(k) do { if (IN(k) && IN((k) + ((k) == 5 ? 2 : 1))) xcd_barrier(bar); } while (0)
    if (PHON(0) && IN(0)) { PARAMS(); phase_prologue(p, lds); if (((PROBE_DUP) >> 0) & 1u) { phase_prologue(p, lds); } }            SEAM(0);
    if (PHON(1) && IN(1)) { PARAMS(); phase_norm<0>(p, lds); if (((PROBE_DUP) >> 1) & 1u) { phase_norm<0>(p, lds); } }             SEAM(1);
    if (PHON(2) && IN(2)) { PARAMS(); tail_convert(p, lds, 0, (NTOK / 256) * 14, 0, 4608, 1); phase_inproj(p, lds); tail_convert(p, lds, 0, (NTOK / 256) * 14, 0, 4608, 0); if (((PROBE_DUP) >> 2) & 1u) { phase_inproj(p, lds); } }              SEAM(2);
    if (PHON(3) && IN(3)) { PARAMS(); phase_mlstm_a(p, lds); tail_bg(p, lds, NB * 4 * NCH, 0, N0_WOUT); tail_convert(p, lds, 0, NB * 4 * NCH, 4608, N0_EXP); if (((PROBE_DUP) >> 3) & 1u) { phase_mlstm_a(p, lds); } }             SEAM(3);
    if (PHON(4) && IN(4)) { PARAMS(); phase_kmax(p, lds); phase_mlstm_b(p, lds); if (((PROBE_DUP) >> 4) & 1u) { xcd_barrier(bar); phase_mlstm_a(p, lds); xcd_barrier(bar); phase_mlstm_b(p, lds); } }             SEAM(4);
    if (PHON(5) && IN(5)) { PARAMS(); phase_attn(p, lds); phase_mlstm_c(p, lds); tail_bg(p, lds, NB * 4 * NCH, N0_WOUT, N0_FN); if (((PROBE_DUP) >> 5) & 1u) { phase_attn(p, lds); } if (((PROBE_DUP) >> 6) & 1u) { phase_mlstm_c(p, lds); } }   SEAM(5);
    if (PHON(7) && IN(7)) { PARAMS(); tail_convert(p, lds, 1, (NTOK / 256) * 4, 0, N0_EXP, 1); phase_outproj(p, lds); tail_convert(p, lds, 1, (NTOK / 256) * 4, 0, N0_EXP, 0); if (((PROBE_DUP) >> 7) & 1u) { phase_outproj(p, lds); } }             SEAM(7);
    if (PHON(8) && IN(8)) { PARAMS(); phase_norm<1>(p, lds); if (((PROBE_DUP) >> 8) & 1u) { phase_norm<1, true>(p, lds); } }             SEAM(8);
    if (PHON(9) && IN(9)) { PARAMS(); phase_moe_up(p, 0, lds); if (((PROBE_DUP) >> 9) & 1u) { phase_moe_up(p, 0, lds); } }           SEAM(9);
    if (PHON(10) && IN(10)) { PARAMS(); phase_moe_down(p, 0, lds); if (((PROBE_DUP) >> 10) & 1u) { phase_moe_down<true>(p, 0, lds); } }        SEAM(10);
    if (PHON(11) && IN(11)) { PARAMS(); phase_norm<2>(p, lds); if (((PROBE_DUP) >> 11) & 1u) { phase_norm<2>(p, lds); } } SEAM(11);
    if (PHON(12) && IN(12)) { PARAMS(); phase_fnet_gemm(p, lds); if (((PROBE_DUP) >> 12) & 1u) { phase_fnet_gemm(p, lds); } }          SEAM(12);
    if (PHON(13) && IN(13)) { PARAMS(); phase_fft1(p, lds); if (((PROBE_DUP) >> 13) & 1u) { phase_fft1(p, lds); } }               SEAM(13);
    if (PHON(14) && IN(14)) { PARAMS(); phase_fft2(p, lds); if (((PROBE_DUP) >> 14) & 1u) { phase_fft2<true>(p, lds); } }               SEAM(14);
    if (PHON(15) && IN(15)) { PARAMS(); phase_norm<3>(p, lds); if (((PROBE_DUP) >> 15) & 1u) { phase_norm<3, true>(p, lds); } }            SEAM(15);
    if (PHON(16) && IN(16)) { PARAMS(); phase_moe_up(p, 1, lds); if (((PROBE_DUP) >> 16) & 1u) { phase_moe_up(p, 1, lds); } }          SEAM(16);
    if (PHON(17) && IN(17)) { PARAMS(); phase_moe_down(p, 1, lds); if (((PROBE_DUP) >> 17) & 1u) { phase_moe_down<true>(p, 1, lds); } }        SEAM(17);
    if (PHON(18) && IN(18)) { PARAMS(); phase_norm<4>(p, lds); if (((PROBE_DUP) >> 18) & 1u) { phase_norm<4>(p, lds); } }
#undef IN
#undef SEAM
}

#ifndef ONE_LAUNCH
#define ONE_LAUNCH 1
#endif
extern "C" void kernel_launch(void* const* d_in, const int* in_sizes, int n_in, void* d_out, int out_size, void* d_ws, size_t ws_size, hipStream_t stream) {
    static int grid = 0;
    if (grid == 0) {
        if (n_in != 21 || out_size != NLAT * DM || ws_size < OFF_END) { fprintf(stderr, "kernel_launch: unexpected shapes (n_in %d out %d ws %zu need %zu)\n", n_in, out_size, ws_size, (size_t)OFF_END); grid = -1; return; }
        int dev = 0, cus = 0;
        if (hipGetDevice(&dev) != hipSuccess || hipDeviceGetAttribute(&cus, hipDeviceAttributeMultiprocessorCount, dev) != hipSuccess) { grid = -1; return; }
        if (hipFuncSetAttribute((const void*)fwd_kernel, hipFuncAttributeMaxDynamicSharedMemorySize, LDS_BYTES) != hipSuccess) { fprintf(stderr, "kernel_launch: hipFuncSetAttribute failed\n"); grid = -1; return; }
        int per_cu = 0;
        if (hipOccupancyMaxActiveBlocksPerMultiprocessor(&per_cu, (const void*)fwd_kernel, NTHR, LDS_BYTES) != hipSuccess || per_cu < 1) { fprintf(stderr, "kernel_launch: occupancy query says %d\n", per_cu); (void)hipGetLastError(); grid = -1; return; }
        grid = cus;
    }
    if (grid < 0) return;
    (void)hipMemsetAsync(d_ws, 0, ZERO_BYTES, stream);
    P p{};
    const float* const* in = (const float* const*)d_in;
    p.x = in[0]; p.c = in[1]; p.ctx = in[2]; p.c_ctx = in[3]; p.ada_w = in[4]; p.ada_b = in[5]; p.nmix_g = in[6]; p.nffn_g = in[7];
    p.w_in = in[8]; p.w_out = in[9]; p.conv_w = in[10]; p.gate_b = in[11]; p.lamv = in[12]; p.subln_g = in[13]; p.w_fnet = in[14];
    p.router_w = in[15]; p.router_b = in[16]; p.w_gate = in[17]; p.w_up = in[18]; p.w_down = in[19]; p.final_g = in[20];
    p.out = (float*)d_out; p.ws = (char*)d_ws;
#if ONE_LAUNCH
    p.ph_lo = 0; p.ph_hi = NPHASE;
    hipLaunchKernelGGL(fwd_kernel, dim3(grid), dim3(NTHR), LDS_BYTES, stream, p);
#else
    for (int k = 0; k < NPHASE; ++k) { p.ph_lo = k; p.ph_hi = k + 1; hipLaunchKernelGGL(fwd_kernel, dim3(grid), dim3(NTHR), LDS_BYTES, stream, p); }
#endif
}
```
